# Optimizing an MI355X kernel written in HIP

```python
import jax, jax.numpy as jnp
from jax import lax
import numpy as np

D_MODEL = 2048
BATCH = 4
SEQ = 8192
DEPTH = 1

MIX_WIDTH = D_MODEL
LRU_WIDTH = MIX_WIDTH // 2
GMLP_WIDTH = MIX_WIDTH - LRU_WIDTH
IN_WIDTH = 2 * LRU_WIDTH + 2 * GMLP_WIDTH
LRU_HEADS = 8
LRU_HEAD_DIM = LRU_WIDTH // LRU_HEADS
CONV_WIDTH = 4
CONV_LEFT = 2
LRU_C = 8.0
GMLP_HEADS = 8
GMLP_HEAD_DIM = GMLP_WIDTH // GMLP_HEADS
CHUNK = 128
PEER_HEADS = 8
PEER_KEYS = 128
PEER_EXPERTS = PEER_KEYS * PEER_KEYS
PEER_TOPK = 16
PEER_QDIM = 256
PEER_HALF = PEER_QDIM // 2
PEER_BLOCK = 128
EPS = 1e-6

kernel_name = "hybrid_rglru_spatialgate_peer_encoder"


def rms_norm(x, g):
    xf = x.astype(jnp.float32)
    y = xf * lax.rsqrt(jnp.mean(xf * xf, axis=-1, keepdims=True) + EPS)
    return (y * g.astype(jnp.float32)).astype(x.dtype)


def layer_norm(x, g, b):
    xf = x.astype(jnp.float32)
    mu = jnp.mean(xf, axis=-1, keepdims=True)
    xc = xf - mu
    y = xc * lax.rsqrt(jnp.mean(xc * xc, axis=-1, keepdims=True) + EPS)
    return (y * g.astype(jnp.float32) + b.astype(jnp.float32)).astype(x.dtype)


def centred_depthwise_conv(x, w, b):
    S = x.shape[1]
    xp = jnp.pad(x, ((0, 0), (CONV_LEFT, CONV_WIDTH - 1 - CONV_LEFT), (0, 0)))
    y = b + xp[:, 0:S] * w[0]
    for k in range(1, CONV_WIDTH):
        y = y + xp[:, k:k + S] * w[k]
    return y


def _recurrence_combine(left, right):
    a_l, b_l = left
    a_r, b_r = right
    return a_l * a_r, a_r * b_l + b_r


def rglru(x, w_a, b_a, w_x, b_x, lam, reverse):
    B, S, _ = x.shape
    xh = x.reshape(B, S, LRU_HEADS, LRU_HEAD_DIM)
    r = jax.nn.sigmoid(jnp.einsum('bshc,hce->bshe', xh, w_a.astype(jnp.float32)).reshape(B, S, LRU_WIDTH) + b_a.astype(jnp.float32))
    i = jax.nn.sigmoid(jnp.einsum('bshc,hce->bshe', xh, w_x.astype(jnp.float32)).reshape(B, S, LRU_WIDTH) + b_x.astype(jnp.float32))
    log_a = -LRU_C * jax.nn.softplus(-lam.astype(jnp.float32)) * r
    a = jnp.exp(log_a)
    u = jnp.sqrt(-jnp.expm1(2.0 * log_a)) * (i * x)
    _, h = lax.associative_scan(_recurrence_combine, (a, u), reverse=reverse, axis=1)
    return h


def recurrent_group(xr, gr, conv_w, conv_b, w_a, b_a, w_x, b_x, lam):
    xc = centred_depthwise_conv(xr, conv_w, conv_b).astype(jnp.float32)
    h = (rglru(xc, w_a[0], b_a[0], w_x[0], b_x[0], lam[0], reverse=False)
         + rglru(xc, w_a[1], b_a[1], w_x[1], b_x[1], lam[1], reverse=True))
    return (jax.nn.gelu(gr.astype(jnp.float32)) * h).astype(xr.dtype)


def spatial_gating_group(gu, gv, ln_g, ln_b, w_s, b_s):
    B, S, _ = gv.shape
    u = jax.nn.gelu(gu)
    v = layer_norm(jax.nn.gelu(gv), ln_g, ln_b)
    vc = v.reshape(B, S // CHUNK, CHUNK, GMLP_HEADS, GMLP_HEAD_DIM)
    mixed = jnp.einsum('hpq,bnqhc->bnphc', w_s, vc) + b_s.T[None, None, :, :, None]
    return u * mixed.reshape(B, S, GMLP_WIDTH)


def peer(x, w_q, sub_keys, expert_u, expert_v):
    B, S, D = x.shape
    q = (x @ w_q).reshape(B, S, PEER_HEADS, 2, PEER_HALF)
    s = jnp.einsum('bshpk,hpnk->bshpn', q, sub_keys).astype(jnp.float32)
    top_s, top_i = lax.top_k(s, PEER_TOPK)
    cand_s = (top_s[..., 0, :, None] + top_s[..., 1, None, :]).reshape(B, S, PEER_HEADS, PEER_TOPK * PEER_TOPK)
    cand_i = (top_i[..., 0, :, None] * PEER_KEYS + top_i[..., 1, None, :]).reshape(B, S, PEER_HEADS, PEER_TOPK * PEER_TOPK)
    best_s, pos = lax.top_k(cand_s, PEER_TOPK)
    ids = jnp.take_along_axis(cand_i, pos, axis=-1)
    g = jax.nn.softmax(best_s, axis=-1).astype(x.dtype)
    n_blk = (B * S) // PEER_BLOCK
    xb = x.reshape(n_blk, PEER_BLOCK, D)
    ib = ids.reshape(n_blk, PEER_BLOCK, PEER_HEADS * PEER_TOPK)
    gb = g.reshape(n_blk, PEER_BLOCK, PEER_HEADS * PEER_TOPK)

    def block(args):
        xt, it, gt = args
        u = jnp.take(expert_u, it, axis=0)
        act = jax.nn.gelu(jnp.einsum('td,tkd->tk', xt, u)) * gt
        v = jnp.take(expert_v, it, axis=0)
        return jnp.einsum('tk,tkd->td', act, v)

    out = lax.map(block, (xb, ib, gb))
    return out.reshape(B, S, D)


def setup_inputs(seed: int = 0) -> dict:
    key = jax.random.key(seed)
    ks = jax.random.split(key, 24)
    f32 = jnp.float32
    nrm = lambda k, shape, scale: jax.random.normal(k, shape, f32) * scale
    lam_u = jax.random.uniform(ks[10], (DEPTH, 2, LRU_WIDTH), f32, minval=0.9, maxval=0.999)
    lam_base = lam_u ** (1.0 / LRU_C)
    return {
        "x": nrm(ks[0], (BATCH, SEQ, D_MODEL), 1.0),
        "mix_norm_g": 1.0 + nrm(ks[1], (DEPTH, D_MODEL), 0.02),
        "w_in": nrm(ks[2], (DEPTH, D_MODEL, IN_WIDTH), D_MODEL ** -0.5),
        "conv_w": nrm(ks[3], (DEPTH, CONV_WIDTH, LRU_WIDTH), CONV_WIDTH ** -0.5),
        "conv_b": nrm(ks[4], (DEPTH, LRU_WIDTH), 0.02),
        "lru_w_a": nrm(ks[5], (DEPTH, 2, LRU_HEADS, LRU_HEAD_DIM, LRU_HEAD_DIM), LRU_HEAD_DIM ** -0.5),
        "lru_b_a": nrm(ks[6], (DEPTH, 2, LRU_WIDTH), 0.02),
        "lru_w_x": nrm(ks[7], (DEPTH, 2, LRU_HEADS, LRU_HEAD_DIM, LRU_HEAD_DIM), LRU_HEAD_DIM ** -0.5),
        "lru_b_x": nrm(ks[8], (DEPTH, 2, LRU_WIDTH), 0.02),
        "lru_lambda": jnp.log(lam_base) - jnp.log1p(-lam_base),
        "gmlp_ln_g": 1.0 + nrm(ks[11], (DEPTH, GMLP_WIDTH), 0.02),
        "gmlp_ln_b": nrm(ks[12], (DEPTH, GMLP_WIDTH), 0.02),
        "gmlp_w_s": nrm(ks[13], (DEPTH, GMLP_HEADS, CHUNK, CHUNK), 0.5 * CHUNK ** -0.5),
        "gmlp_b_s": 1.0 + nrm(ks[14], (DEPTH, GMLP_HEADS, CHUNK), 0.1),
        "w_out": nrm(ks[15], (DEPTH, MIX_WIDTH, D_MODEL), MIX_WIDTH ** -0.5),
        "ffn_norm_g": 1.0 + nrm(ks[16], (DEPTH, D_MODEL), 0.02),
        "peer_w_q": nrm(ks[17], (DEPTH, D_MODEL, PEER_HEADS * PEER_QDIM), D_MODEL ** -0.5),
        "peer_sub_keys": nrm(ks[18], (DEPTH, PEER_HEADS, 2, PEER_KEYS, PEER_HALF), PEER_HALF ** -0.5),
        "peer_u": nrm(ks[19], (DEPTH, PEER_EXPERTS, D_MODEL), D_MODEL ** -0.5),
        "peer_v": nrm(ks[20], (DEPTH, PEER_EXPERTS, D_MODEL), PEER_HEADS ** -0.5),
        "final_norm_g": 1.0 + nrm(ks[21], (D_MODEL,), 0.02),
    }


def reference(x, mix_norm_g, w_in, conv_w, conv_b, lru_w_a, lru_b_a, lru_w_x, lru_b_x, lru_lambda,
              gmlp_ln_g, gmlp_ln_b, gmlp_w_s, gmlp_b_s, w_out, ffn_norm_g, peer_w_q, peer_sub_keys,
              peer_u, peer_v, final_norm_g):
    h = x
    for l in range(DEPTH):
        n = rms_norm(h, mix_norm_g[l])
        z = n @ w_in[l]
        xr = z[..., :LRU_WIDTH]
        gr = z[..., LRU_WIDTH:2 * LRU_WIDTH]
        gu = z[..., 2 * LRU_WIDTH:2 * LRU_WIDTH + GMLP_WIDTH]
        gv = z[..., 2 * LRU_WIDTH + GMLP_WIDTH:]
        a_out = recurrent_group(xr, gr, conv_w[l], conv_b[l], lru_w_a[l], lru_b_a[l],
                                lru_w_x[l], lru_b_x[l], lru_lambda[l])
        b_out = spatial_gating_group(gu, gv, gmlp_ln_g[l], gmlp_ln_b[l], gmlp_w_s[l], gmlp_b_s[l])
        h = h + jnp.concatenate([a_out, b_out], axis=-1) @ w_out[l]
        h = h + peer(rms_norm(h, ffn_norm_g[l]), peer_w_q[l], peer_sub_keys[l], peer_u[l], peer_v[l])
    return rms_norm(h, final_norm_g)
```

```cpp
#include <hip/hip_runtime.h>
#include <cstdio>
#include <cstdint>
namespace pg8 {
#define PG8_LAS __attribute__((address_space(3)))
typedef unsigned short bf16_t;
typedef short bf16x8 __attribute__((ext_vector_type(8)));
typedef float f32x4 __attribute__((ext_vector_type(4)));
typedef unsigned u32x4 __attribute__((ext_vector_type(4)));
constexpr int BM = 256, BK = 64, HALF = 128, HTB = HALF * BK * 2  , STAGE_BYTES = 8 * HTB, NXCD = 8, WGM = 8;

__host__ __device__ __forceinline__ int lds_byte(int r, int c) { const int st = (r >> 4) * 2 + (c >> 5), rr = r & 15, cc = c & 31, ob = rr * 64 + cc * 2; return st * 1024 + (ob ^ (((ob >> 9) & 1) << 5)); }
__host__ __device__ __forceinline__ void stage_rc(int b, int& R, int& C) { const int st = b / 1024, sb = b % 1024, swz = sb ^ (((sb >> 9) & 1) << 5); R = (st >> 1) * 16 + swz / 64; C = (st & 1) * 32 + (swz % 64) / 2; }
__host__ __device__ __forceinline__ int perm32(int rho) { const int n = rho >> 4, i = rho & 15; return 8 * (i >> 2) + 4 * n + (i & 3); }

struct Unit { int pm, pn; };
struct Gemm { const bf16_t* A; const bf16_t* Bt; int M, N, K; };

struct StaticOrder {
    int nM, nN, nwg, G, c;
    __host__ __device__ void init(int M, int N, int G_, int c_) { nM = M / BM; nN = N / BM; nwg = nM * nN; G = G_; c = c_; }
    __host__ __device__ bool next(int i, Unit& u) const {
        const long L = (long)i * G + c; if (L >= nwg) return false;
        int wgid = (int)L; { const int q = nwg / NXCD, r = nwg % NXCD, xcd = wgid % NXCD, off = wgid / NXCD; wgid = (xcd < r ? xcd * (q + 1) : r * (q + 1) + (xcd - r) * q) + off; }
        const int nig = WGM * nN, gid = wgid / nig, fm = gid * WGM, gsz = (nM - fm) < WGM ? (nM - fm) : WGM;
        u.pm = fm + ((wgid % nig) % gsz); u.pn = (wgid % nig) / gsz; return true;
    }
    __device__ __forceinline__ void a_ready(const Unit&) const {}
    __device__ __forceinline__ void done(const Unit&) const {}
};

__device__ __forceinline__ unsigned cvt_pk_bf16(float lo, float hi) { unsigned r; asm volatile("v_cvt_pk_bf16_f32 %0, %1, %2" : "=v"(r) : "v"(lo), "v"(hi)); return r; }
__device__ __forceinline__ float gelu_tanh(float x) {
    const float t = x * (1.0f + 0.044715f * x * x);
    const float e = __builtin_amdgcn_exp2f(-2.3022081983f * t);
    return x * __builtin_amdgcn_rcpf(1.0f + e);
}
struct EpiZ {
    static constexpr bool PERM = true, AFTER_DRAIN = false;
    bf16_t* O; int ldc; int gelu_from;
    __device__ __forceinline__ void operator()(const f32x4 (&acc)[2][2][4][2], const Unit& u, int wr, int wc, int fr, int fq) const {
        const int row0 = u.pm * BM + wr * 64 + fr; const int col0 = u.pn * BM + wc * 32 + 8 * fq;
        const bool act = (u.pn * BM) >= gelu_from;
#pragma unroll
        for (int ai = 0; ai < 2; ++ai)
#pragma unroll
            for (int m = 0; m < 4; ++m) { bf16_t* rowp = O + (size_t)(row0 + ai * HALF + m * 16) * ldc + col0;
#pragma unroll
                for (int bj = 0; bj < 2; ++bj) { f32x4 v0 = acc[ai][bj][m][0], v1 = acc[ai][bj][m][1];
                    if (act) {
#pragma unroll
                        for (int j = 0; j < 4; ++j) { v0[j] = gelu_tanh(v0[j]); v1[j] = gelu_tanh(v1[j]); } }
                    u32x4 w; w.x = cvt_pk_bf16(v0[0], v0[1]); w.y = cvt_pk_bf16(v0[2], v0[3]); w.z = cvt_pk_bf16(v1[0], v1[1]); w.w = cvt_pk_bf16(v1[2], v1[3]);
                    *(u32x4*)(rowp + bj * HALF) = w; } }
    }
};
struct EpiH {
    static constexpr bool PERM = true, AFTER_DRAIN = false;
    bf16_t* O; const float* X; float* rowss; int ldc;
    __device__ __forceinline__ void operator()(const f32x4 (&acc)[2][2][4][2], const Unit& u, int wr, int wc, int fr, int fq) const {
        const int row0 = u.pm * BM + wr * 64 + fr; const int col0 = u.pn * BM + wc * 32 + 8 * fq;
#pragma unroll
        for (int ai = 0; ai < 2; ++ai)
#pragma unroll
            for (int m = 0; m < 4; ++m) { const int row = row0 + ai * HALF + m * 16; const size_t off = (size_t)row * ldc + col0; float ss = 0.f;
#pragma unroll
                for (int bj = 0; bj < 2; ++bj) {
                    const f32x4 x0 = *(const f32x4*)(X + off + bj * HALF), x1 = *(const f32x4*)(X + off + bj * HALF + 4);
                    const f32x4 v0 = acc[ai][bj][m][0] + x0, v1 = acc[ai][bj][m][1] + x1;
                    ss += (v0[0] * v0[0] + v0[1] * v0[1]) + (v0[2] * v0[2] + v0[3] * v0[3]) + (v1[0] * v1[0] + v1[1] * v1[1]) + (v1[2] * v1[2] + v1[3] * v1[3]);
                    u32x4 w; w.x = cvt_pk_bf16(v0[0], v0[1]); w.y = cvt_pk_bf16(v0[2], v0[3]); w.z = cvt_pk_bf16(v1[0], v1[1]); w.w = cvt_pk_bf16(v1[2], v1[3]);
                    *(u32x4*)(O + off + bj * HALF) = w; }
                ss += __shfl_xor(ss, 16); ss += __shfl_xor(ss, 32);
                if (fq == 0) atomicAdd(rowss + row, ss); }
    }
};
struct EpiQ {
    static constexpr bool PERM = false, AFTER_DRAIN = false;
    float* C; const float* rowss; int ldc;
    __device__ __forceinline__ void operator()(const f32x4 (&acc)[2][2][4][2], const Unit& u, int wr, int wc, int fr, int fq) const {
        const int row0 = u.pm * BM + wr * 64 + fr, col0 = u.pn * BM + wc * 32 + 4 * fq;
#pragma unroll
        for (int ai = 0; ai < 2; ++ai)
#pragma unroll
            for (int m = 0; m < 4; ++m) { const int row = row0 + ai * HALF + m * 16; const float rs = __builtin_amdgcn_rsqf(rowss[row] * (1.0f / 2048.0f) + 1e-6f);
                float* rowp = C + (size_t)row * ldc + col0;
#pragma unroll
                for (int bj = 0; bj < 2; ++bj)
#pragma unroll
                    for (int n = 0; n < 2; ++n) *(f32x4*)(rowp + bj * HALF + n * 16) = acc[ai][bj][m][n] * rs; }
    }
};
template <class Epi, class Sched, bool ALIGN_EPI = false, bool SP2 = false>
__device__ __forceinline__ void gemm_phase(PG8_LAS unsigned char* lds, const Gemm g, const Sched& S, const Epi& E) {
    const int tid = threadIdx.x, wid = __builtin_amdgcn_readfirstlane(tid >> 6), lane = tid & 63, wr = wid >> 2, wc = wid & 3, fr = lane & 15, fq = lane >> 4;
    const int K = g.K, nt = K / BK;
    unsigned voffA[2], voffB[2];
#pragma unroll
    for (int i = 0; i < 2; ++i) { int R, C; stage_rc(tid * 16 + i * 8192, R, C); const int Rb = Epi::PERM ? ((R & ~31) + perm32(R & 31)) : R;
        voffA[i] = (unsigned)(R * K + C) * 2u; voffB[i] = (unsigned)(Rb * K + C) * 2u; }
    const size_t kstep = (size_t)(BK * 2);
    const size_t hstep = (size_t)HALF * K * 2;
    const size_t tstep = 2 * hstep;
    const unsigned ldsw = (unsigned)wid * 1024u;
    const int aoff = lds_byte(wr * 64 + fr, fq * 8), boff = lds_byte(wc * 32 + fr, fq * 8);
#define PG8_SA(b, h) (((b) * 2 + (h)) * HTB)
#define PG8_SB(b, h) ((4 + (b) * 2 + (h)) * HTB)
#define PG8_STAGE(bufoff, gbase, voff) do { _Pragma("unroll") for (int _i = 0; _i < 2; ++_i) \
        __builtin_amdgcn_global_load_lds((const unsigned*)((const char*)(gbase) + (voff)[_i]), (PG8_LAS unsigned*)(lds + (bufoff) + ldsw + _i * 8192), 16, 0, 0); } while (0)
#define PG8_LDA(dst, b, h) do { _Pragma("unroll") for (int m = 0; m < 4; ++m) _Pragma("unroll") for (int k = 0; k < 2; ++k) dst[m][k] = *(const PG8_LAS bf16x8*)(lds + PG8_SA(b, h) + aoff + m * 2048 + k * 1024); } while (0)
#define PG8_LDB(dst, b, h) do { _Pragma("unroll") for (int n = 0; n < 2; ++n) _Pragma("unroll") for (int k = 0; k < 2; ++k) dst[n][k] = *(const PG8_LAS bf16x8*)(lds + PG8_SB(b, h) + boff + n * 2048 + k * 1024); } while (0)
#define PG8_MMA(ai, bj, At, Bt) do { __builtin_amdgcn_s_setprio(1); _Pragma("unroll") for (int m = 0; m < 4; ++m) _Pragma("unroll") for (int n = 0; n < 2; ++n) _Pragma("unroll") for (int k = 0; k < 2; ++k) \
        acc[ai][bj][m][n] = __builtin_amdgcn_mfma_f32_16x16x32_bf16(Bt[n][k], At[m][k], acc[ai][bj][m][n], 0, 0, 0); __builtin_amdgcn_s_setprio(0); } while (0)
#define PG8_WAIT_V(n) asm volatile("s_waitcnt vmcnt(" #n ")" ::: "memory")
#define PG8_WAIT_L(n) asm volatile("s_waitcnt lgkmcnt(" #n ")" ::: "memory")
#define PG8_BAR __builtin_amdgcn_s_barrier()
#define PG8_SCHED __builtin_amdgcn_sched_barrier(0)
    Unit cur, nxt; int ui = 0;
    if (!S.next(0, cur)) return;
    f32x4 acc[2][2][4][2];
#pragma unroll
    for (int a = 0; a < 2; ++a)
#pragma unroll
        for (int b = 0; b < 2; ++b)
#pragma unroll
            for (int m = 0; m < 4; ++m)
#pragma unroll
                for (int n = 0; n < 2; ++n) acc[a][b][m][n] = (f32x4){0.f, 0.f, 0.f, 0.f};
    bf16x8 At[4][2], B0[2][2], B1[2][2];
    const char* cA = (const char*)g.A + (size_t)cur.pm * tstep; const char* cB = (const char*)g.Bt + (size_t)cur.pn * tstep;
    S.a_ready(cur);
    if constexpr (SP2) {
        PG8_STAGE(PG8_SB(0, 0), cB, voffB); PG8_STAGE(PG8_SB(0, 1), cB + hstep, voffB); PG8_STAGE(PG8_SA(0, 0), cA, voffA); PG8_STAGE(PG8_SA(0, 1), cA + hstep, voffA);
        if (wr == 1) PG8_BAR;
        PG8_WAIT_V(2); PG8_BAR;
        PG8_STAGE(PG8_SB(1, 0), cB + kstep, voffB); PG8_STAGE(PG8_SA(1, 0), cA + kstep, voffA); PG8_STAGE(PG8_SB(1, 1), cB + hstep + kstep, voffB);
        PG8_WAIT_V(6); PG8_BAR;
    } else {
        PG8_STAGE(PG8_SB(0, 0), cB, voffB); PG8_STAGE(PG8_SA(0, 0), cA, voffA); PG8_STAGE(PG8_SB(0, 1), cB + hstep, voffB); PG8_STAGE(PG8_SA(0, 1), cA + hstep, voffA);
        if (wr == 1) PG8_BAR;
        PG8_WAIT_V(4); PG8_BAR;
        PG8_STAGE(PG8_SB(1, 0), cB + kstep, voffB); PG8_STAGE(PG8_SA(1, 0), cA + kstep, voffA); PG8_STAGE(PG8_SB(1, 1), cB + hstep + kstep, voffB);
        PG8_WAIT_V(6); PG8_BAR;
    }
    for (;;) {
        const bool has_next = S.next(ui + 1, nxt);
        const char* nA = has_next ? (const char*)g.A + (size_t)nxt.pm * tstep : cA; const char* nB = has_next ? (const char*)g.Bt + (size_t)nxt.pn * tstep : cB;
        for (int t = 0; t < nt; t += 2) {
            const bool last = (t == nt - 2);
            const char* a1 = cA + (size_t)(t + 1) * kstep;
            const char* a2 = last ? nA : cA + (size_t)(t + 2) * kstep; const char* b2 = last ? nB : cB + (size_t)(t + 2) * kstep;
            const char* a3 = a2 + kstep; const char* b3 = b2 + kstep;
            if (last && has_next) S.a_ready(nxt);
            if constexpr (SP2) {
            PG8_LDB(B0, 0, 0); PG8_LDB(B1, 0, 1); PG8_SCHED; PG8_LDA(At, 0, 0); PG8_STAGE(PG8_SA(1, 1), a1 + hstep, voffA);
            PG8_WAIT_V(8); PG8_WAIT_L(0); PG8_BAR; PG8_MMA(0, 0, At, B0); PG8_MMA(0, 1, At, B1); PG8_BAR; PG8_SCHED;
            PG8_LDA(At, 0, 1); PG8_STAGE(PG8_SB(0, 0), b2, voffB); PG8_STAGE(PG8_SB(0, 1), b2 + hstep, voffB); PG8_STAGE(PG8_SA(0, 0), a2, voffA);
            PG8_WAIT_V(8); PG8_WAIT_L(0); PG8_BAR; PG8_MMA(1, 0, At, B0); PG8_MMA(1, 1, At, B1); PG8_BAR; PG8_SCHED;
            PG8_LDB(B0, 1, 0); PG8_LDB(B1, 1, 1); PG8_SCHED; PG8_LDA(At, 1, 0); PG8_STAGE(PG8_SA(0, 1), a2 + hstep, voffA);
            PG8_WAIT_V(8); PG8_WAIT_L(0); PG8_BAR; PG8_MMA(0, 0, At, B0); PG8_MMA(0, 1, At, B1); PG8_BAR; PG8_SCHED;
            PG8_LDA(At, 1, 1); PG8_STAGE(PG8_SB(1, 0), b3, voffB); PG8_STAGE(PG8_SB(1, 1), b3 + hstep, voffB); PG8_STAGE(PG8_SA(1, 0), a3, voffA);
            PG8_WAIT_V(8); PG8_WAIT_L(0); PG8_BAR; PG8_MMA(1, 0, At, B0); PG8_MMA(1, 1, At, B1); PG8_BAR; PG8_SCHED;
            } else {
            PG8_LDB(B0, 0, 0); PG8_SCHED; PG8_LDA(At, 0, 0); PG8_STAGE(PG8_SA(1, 1), a1 + hstep, voffA);
            PG8_WAIT_L(8); PG8_BAR; PG8_WAIT_L(0); PG8_MMA(0, 0, At, B0); PG8_BAR; PG8_SCHED;
            PG8_LDB(B1, 0, 1); PG8_STAGE(PG8_SB(0, 0), b2, voffB);
            PG8_BAR; PG8_WAIT_L(0); PG8_MMA(0, 1, At, B1); PG8_BAR;
            PG8_LDA(At, 0, 1); PG8_STAGE(PG8_SA(0, 0), a2, voffA);
            PG8_BAR; PG8_WAIT_L(0); PG8_MMA(1, 0, At, B0); PG8_BAR; PG8_SCHED;
            PG8_STAGE(PG8_SB(0, 1), b2 + hstep, voffB);
            PG8_WAIT_V(6); PG8_BAR; PG8_MMA(1, 1, At, B1); PG8_BAR;
            PG8_LDB(B0, 1, 0); PG8_SCHED; PG8_LDA(At, 1, 0); PG8_STAGE(PG8_SA(0, 1), a2 + hstep, voffA);
            PG8_WAIT_L(8); PG8_BAR; PG8_WAIT_L(0); PG8_MMA(0, 0, At, B0); PG8_BAR; PG8_SCHED;
            PG8_LDB(B1, 1, 1); PG8_STAGE(PG8_SB(1, 0), b3, voffB);
            PG8_BAR; PG8_WAIT_L(0); PG8_MMA(0, 1, At, B1); PG8_BAR;
            PG8_LDA(At, 1, 1); PG8_STAGE(PG8_SA(1, 0), a3, voffA);
            PG8_BAR; PG8_WAIT_L(0); PG8_MMA(1, 0, At, B0); PG8_BAR; PG8_SCHED;
            PG8_STAGE(PG8_SB(1, 1), b3 + hstep, voffB);
            PG8_WAIT_V(6); PG8_BAR; PG8_MMA(1, 1, At, B1); PG8_BAR;
            }
        }
        if constexpr (ALIGN_EPI) { if (wr == 0) PG8_BAR; }
        if constexpr (!Epi::AFTER_DRAIN) { E(acc, cur, wr, wc, fr, fq); S.done(cur); }
        if (!has_next) break;
#pragma unroll
        for (int a = 0; a < 2; ++a)
#pragma unroll
            for (int b = 0; b < 2; ++b)
#pragma unroll
                for (int m = 0; m < 4; ++m)
#pragma unroll
                    for (int n = 0; n < 2; ++n) acc[a][b][m][n] = (f32x4){0.f, 0.f, 0.f, 0.f};
        cur = nxt; cA = nA; cB = nB; ++ui;
        if constexpr (ALIGN_EPI) { if (wr == 1) PG8_BAR; }
    }
    PG8_WAIT_V(0);
    if constexpr (!ALIGN_EPI) { if (wr == 0) PG8_BAR; }
    PG8_BAR;
    if constexpr (Epi::AFTER_DRAIN) { E.fused(acc, cur, wr, wc, fr, fq, lds, wid, lane); S.done(cur); }
#undef PG8_SA
#undef PG8_SB
#undef PG8_STAGE
#undef PG8_LDA
#undef PG8_LDB
#undef PG8_MMA
#undef PG8_WAIT_V
#undef PG8_WAIT_L
#undef PG8_BAR
#undef PG8_SCHED
}
}
constexpr int NWAVES = 8;
constexpr int BATCH = 4, SEQ = 8192, D = 2048, M = BATCH * SEQ, NIN = 4096, LW = 1024, CHUNK = 128, NCHUNK = SEQ / CHUNK;
constexpr int NEXP = 16384;
#ifndef MK_N_LAUNCHES
#define MK_N_LAUNCHES 1
#endif
constexpr int N_LAUNCHES = MK_N_LAUNCHES;
constexpr int PER_PHASE = 8;
constexpr size_t MiB = 1u << 20;
constexpr size_t WS_CTL = 0, CTL_ZERO_BYTES = 1 * MiB;
constexpr size_t WS_ROWSS = 512 * 1024;
constexpr size_t WS_WIN = 2 * MiB, WS_WOUT = 18 * MiB, WS_WQ = 26 * MiB, WS_LRUW = 34 * MiB, WS_WSB = 35 * MiB, WS_AGG = 36 * MiB;
constexpr size_t WS_U = 64 * MiB, WS_V = 128 * MiB, WS_XN = 192 * MiB  , WS_Z = 320 * MiB  ;
constexpr size_t WS_HB = 576 * MiB, WS_IDS = 704 * MiB, WS_GATES = 720 * MiB, WS_END = 736 * MiB;
constexpr int CW_BAR = 4096;
constexpr int RING_BYTES = 131072;
constexpr int LDSCTL_OFF = RING_BYTES, MISC_OFF = LDSCTL_OFF + 320;
constexpr int LDS_BYTES = 147456;
#define GAS __attribute__((address_space(1)))
#define LAS __attribute__((address_space(3)))
typedef unsigned short bf16;
typedef unsigned v4u __attribute__((ext_vector_type(4)));
typedef float f32x4 __attribute__((ext_vector_type(4)));
typedef short bf16x8 __attribute__((ext_vector_type(8)));
typedef GAS unsigned gu32;
typedef GAS unsigned long long gu64;
#define RLX_AGENT __ATOMIC_RELAXED, __HIP_MEMORY_SCOPE_AGENT
#define LDS_WAIT() asm volatile("s_waitcnt lgkmcnt(0)" ::: "memory")
#define VM_WAIT() asm volatile("s_waitcnt vmcnt(0)" ::: "memory")
__device__ __forceinline__ unsigned long long rt() { return __builtin_amdgcn_s_memrealtime(); }
__device__ __forceinline__ unsigned f2bf(float f) { unsigned u = __builtin_bit_cast(unsigned, f); return (u + 0x7fffu + ((u >> 16) & 1u)) >> 16; }
__device__ __forceinline__ unsigned pk2(float lo, float hi) { return f2bf(lo) | (f2bf(hi) << 16); }

#define XB_TMO      128
#define XB_XCNT(j)  (256  + 64 * (j))
#define XB_XSUB(j)  (1280 + 64 * (j))
#define XB_XGEN(j)  (2304 + 64 * (j))
#define XB_TOP      3328
#define XB_TOPGEN   3392
#define XCD_BAR_WORDS 3456
#define XB_SPIN_CAP (1u << 18)

__device__ __forceinline__ unsigned xb_ld(unsigned* p)              { return __hip_atomic_load(p, __ATOMIC_RELAXED, __HIP_MEMORY_SCOPE_AGENT); }
__device__ __forceinline__ unsigned xb_add(unsigned* p, unsigned v) { return __hip_atomic_fetch_add(p, v, __ATOMIC_RELAXED, __HIP_MEMORY_SCOPE_AGENT); }
__device__ __forceinline__ unsigned xb_xcc_id() { return (unsigned)__builtin_amdgcn_s_getreg((3 << 11) | 20) & 0xFu; }
#define XB_SPIN(cond, bar) do { unsigned _sp = 0; while (cond) { __builtin_amdgcn_s_sleep(1); \
    if ((++_sp & 255u) == 0u) { if (xb_ld(&(bar)[XB_TMO])) break; if (_sp > XB_SPIN_CAP) { atomicAdd(&(bar)[XB_TMO], 1u); break; } } } } while (0)

struct XcdBarrier {
    unsigned* bar; unsigned x;
    volatile LAS unsigned* st;
};

__device__ __forceinline__ XcdBarrier xcd_barrier_post(unsigned* bar, volatile LAS unsigned* st) {
    XcdBarrier b; b.bar = bar; b.x = xb_xcc_id(); b.st = st;
    if (threadIdx.x == 0) (void)xb_add(&bar[XB_XCNT(b.x)], 1u);
    return b;
}
__device__ __forceinline__ void xcd_barrier_complete(unsigned* bar, unsigned x, unsigned& nloc, unsigned& nx) {
    const unsigned G = gridDim.x * gridDim.y * gridDim.z;
    unsigned sum, cnt, mine, sp = 0u;
    for (;;) {
        sum = 0u; cnt = 0u; mine = 0u;
#pragma unroll
        for (unsigned j = 0; j < 16; ++j) { const unsigned c = xb_ld(&bar[XB_XCNT(j)]); sum += c; cnt += (c > 0u) ? 1u : 0u; mine = (j == x) ? c : mine; }
        if (sum == G) break;
        __builtin_amdgcn_s_sleep(1);
        if ((++sp & 255u) == 0u) { if (xb_ld(&bar[XB_TMO])) break; if (sp > XB_SPIN_CAP) { atomicAdd(&bar[XB_TMO], 1u); break; } }
    }
    nloc = mine > 0u ? mine : 1u; nx = cnt > 0u ? cnt : 1u;
}

__device__ __forceinline__ void xcd_barrier(const XcdBarrier& b) {
    asm volatile("s_waitcnt vmcnt(0)" ::: "memory");
    __syncthreads();
    if (threadIdx.x == 0) {
        unsigned* bar = b.bar;
        __builtin_amdgcn_s_waitcnt(0);
        unsigned nloc = b.st[0], nx = b.st[1];
        if (nloc == 0u) { xcd_barrier_complete(bar, b.x, nloc, nx); b.st[0] = nloc; b.st[1] = nx; }
        const unsigned old = xb_add(&bar[XB_XSUB(b.x)], 1u);
        const unsigned gen = old / nloc;
        if (old + 1u == (gen + 1u) * nloc) {
            __builtin_amdgcn_fence(__ATOMIC_RELEASE, "agent");
            asm volatile("s_waitcnt vmcnt(0)" ::: "memory");
            const unsigned og = xb_add(&bar[XB_TOP], 1u);
            const unsigned tg = og / nx;
            if (og + 1u == (tg + 1u) * nx) xb_add(&bar[XB_TOPGEN], 1u);
            else XB_SPIN(xb_ld(&bar[XB_TOPGEN]) == tg, bar);
            __builtin_amdgcn_fence(__ATOMIC_ACQUIRE, "agent");
            xb_add(&bar[XB_XGEN(b.x)], 1u);
            asm volatile("s_waitcnt vmcnt(0)" ::: "memory");
        } else {
            XB_SPIN(xb_ld(&bar[XB_XGEN(b.x)]) == gen, bar);
            __builtin_amdgcn_fence(__ATOMIC_ACQUIRE, "agent");
            asm volatile("s_waitcnt vmcnt(0)" ::: "memory");
        }
    }
    __syncthreads();
}
struct Frame {
    LAS unsigned char* lds;
    volatile LAS unsigned* MISC;
    gu32* ctl;
    int tid, lane, wave, vcu, G;
    const float* in[21]; float* out;
    bf16 *WIN, *WOUT, *WQ, *LRUW, *WSB, *U, *V, *XN, *MIX, *Z, *HB;
    float *ROWSS, *Q, *AGG, *GATES; int* IDS;
};
__device__ __forceinline__ float wave_sum(float v) {
#pragma unroll
    for (int o = 1; o < 64; o <<= 1) v += __shfl_xor(v, o);
    return v;
}
__device__ __forceinline__ float bf_lo(unsigned w) { return __builtin_bit_cast(float, w << 16); }
__device__ __forceinline__ float bf_hi(unsigned w) { return __builtin_bit_cast(float, w & 0xffff0000u); }
__device__ __forceinline__ float bf1(unsigned short h) { return __builtin_bit_cast(float, (unsigned)h << 16); }
__device__ __forceinline__ float sigmoidf_(float x) { return __builtin_amdgcn_rcpf(1.0f + __builtin_amdgcn_exp2f(-1.4426950409f * x)); }
using pg8::gelu_tanh;

__device__ __forceinline__ void p0_transpose_item(const float* W, int K, int N, bf16* WT, const float* kscale, LAS float* scr, int item, int lane) {
    const int nblk = N / 32, kb = item / nblk, nb = item % nblk, k0 = 64 * kb, n0 = 32 * nb;
#pragma unroll 8
    for (int i = 0; i < 32; ++i) { const int kk = 2 * i + (lane >> 5); const float sc = kscale ? kscale[k0 + kk] : 1.0f; scr[kk * 33 + (lane & 31)] = W[(size_t)(k0 + kk) * N + n0 + (lane & 31)] * sc; }
    LDS_WAIT(); asm volatile("" ::: "memory");
    const int c = lane & 7;
#pragma unroll
    for (int j = 0; j < 4; ++j) { const int n = (lane >> 3) + 8 * j; const LAS float* s = scr + (8 * c) * 33 + n;
        v4u o; o.x = pk2(s[0 * 33], s[1 * 33]); o.y = pk2(s[2 * 33], s[3 * 33]); o.z = pk2(s[4 * 33], s[5 * 33]); o.w = pk2(s[6 * 33], s[7 * 33]);
        *(GAS v4u*)(WT + (size_t)(n0 + n) * K + k0 + 8 * c) = o; }
    LDS_WAIT(); asm volatile("" ::: "memory");
}
__device__ __forceinline__ void p0_prologue(Frame& F) {
    LAS float* scr = (LAS float*)(F.lds + F.wave * 16384);
    const int gw = F.vcu * NWAVES + F.wave, NGW = F.G * NWAVES, lane = F.lane;
    constexpr int I_IN = (D / 64) * (NIN / 32), I_OUT = (D / 64) * (D / 32), I_Q = I_OUT, I_LRU = 32 * 8;
    constexpr int NITEMS = I_IN + I_OUT + I_Q + I_LRU;
    for (int it = gw; it < NITEMS; it += NGW) {
        int r = it;
        if (r < I_IN) { p0_transpose_item(F.in[2], D, NIN, F.WIN, F.in[1], scr, r, lane); continue; } r -= I_IN;
        if (r < I_OUT) { p0_transpose_item(F.in[14], D, D, F.WOUT, nullptr, scr, r, lane); continue; } r -= I_OUT;
        if (r < I_Q) { p0_transpose_item(F.in[16], D, D, F.WQ, F.in[15], scr, r, lane); continue; } r -= I_Q;
        { const int mi = r >> 3, sub = r & 7, gate = mi >> 4, rest = mi & 15;
          const float* src = (gate ? F.in[7] : F.in[5]) + (size_t)rest * 16384;
          p0_transpose_item(src, 128, 128, F.LRUW + (size_t)mi * 16384, nullptr, scr, sub, lane); }
    }
    const size_t gt = (size_t)gw * 64 + lane, NGT = (size_t)NGW * 64;
    const float* g2 = F.in[15];
    for (size_t ch = gt; ch < (size_t)NEXP * D / 8; ch += NGT) {
        const size_t e0 = ch * 8; const int k = (int)(e0 & (D - 1));
        const f32x4 a = *(const GAS f32x4*)(F.in[18] + e0), b = *(const GAS f32x4*)(F.in[18] + e0 + 4);
        const f32x4 ga = *(const GAS f32x4*)(g2 + k), gb = *(const GAS f32x4*)(g2 + k + 4);
        v4u o; o.x = pk2(a.x * ga.x, a.y * ga.y); o.y = pk2(a.z * ga.z, a.w * ga.w); o.z = pk2(b.x * gb.x, b.y * gb.y); o.w = pk2(b.z * gb.z, b.w * gb.w);
        *(GAS v4u*)(F.U + e0) = o;
        const f32x4 c = *(const GAS f32x4*)(F.in[19] + e0), d = *(const GAS f32x4*)(F.in[19] + e0 + 4);
        v4u p; p.x = pk2(c.x, c.y); p.y = pk2(c.z, c.w); p.z = pk2(d.x, d.y); p.w = pk2(d.z, d.w);
        *(GAS v4u*)(F.V + e0) = p;
    }
    for (size_t ch = gt; ch < (size_t)8 * 128 * 128 / 8; ch += NGT) {
        const size_t e0 = ch * 8;
        const f32x4 a = *(const GAS f32x4*)(F.in[12] + e0), b = *(const GAS f32x4*)(F.in[12] + e0 + 4);
        v4u o; o.x = pk2(a.x, a.y); o.y = pk2(a.z, a.w); o.z = pk2(b.x, b.y); o.w = pk2(b.z, b.w);
        *(GAS v4u*)(F.WSB + e0) = o;
    }
    for (int m = gw; m < M; m += NGW) {
        const GAS f32x4* xr = (const GAS f32x4*)(F.in[0] + (size_t)m * D) + lane;
        f32x4 v[8]; float s = 0.f;
#pragma unroll
        for (int j = 0; j < 8; ++j) { v[j] = xr[64 * j]; s += (v[j].x * v[j].x + v[j].y * v[j].y) + (v[j].z * v[j].z + v[j].w * v[j].w); }
        const float rstd = __builtin_amdgcn_rsqf(wave_sum(s) * (1.f / D) + 1e-6f);
        GAS unsigned long long* o8 = (GAS unsigned long long*)(F.XN + (size_t)m * D) + lane;
#pragma unroll
        for (int j = 0; j < 8; ++j) o8[64 * j] = (unsigned long long)pk2(v[j].x * rstd, v[j].y * rstd) | ((unsigned long long)pk2(v[j].z * rstd, v[j].w * rstd) << 32);
    }
}
typedef unsigned v2u __attribute__((ext_vector_type(2)));
typedef float f32x2 __attribute__((ext_vector_type(2)));
constexpr int LRU_XR = 0, LRU_XC = 33792, LRU_GR = 33792 + 34816;
constexpr float LOG2E = 1.4426950408889634f;

template <bool APPLY, int DIR>
__device__ __forceinline__ void lru_dir(Frame& F, int b, int c, int h, float (&hsum)[8][4]) {
    const int lane = F.lane, w = F.wave, fr = lane & 15, fq = lane >> 4;
    LAS unsigned char* XC = F.lds + LRU_XC;
    const int chl = 16 * w + fr, chg = h * 128 + chl;
    bf16x8 Ba[4], Bx[4];
    {
        const bf16* wa = F.LRUW + (size_t)((0 * 2 + DIR) * 8 + h) * 16384 + (size_t)chl * 128 + 8 * fq;
        const bf16* wx = F.LRUW + (size_t)((1 * 2 + DIR) * 8 + h) * 16384 + (size_t)chl * 128 + 8 * fq;
#pragma unroll
        for (int ks = 0; ks < 4; ++ks) { Ba[ks] = *(const GAS bf16x8*)(wa + 32 * ks); Bx[ks] = *(const GAS bf16x8*)(wx + 32 * ks); }
    }
    const float ba = F.in[6][DIR * LW + chg], bx = F.in[8][DIR * LW + chg], lam = F.in[9][DIR * LW + chg];
    const float cl = -8.0f * log1pf(__expf(-lam)) * LOG2E;
    float carry = 0.f;
    if (APPLY) {
        const f32x2* agg = (const f32x2*)F.AGG + (size_t)((b * 2 + DIR) * NCHUNK) * LW + chg;
        if (DIR == 0) {
#pragma unroll 4
            for (int cc = 0; cc < c; ++cc) { const f32x2 pe = agg[(size_t)cc * LW]; carry = pe.x * carry + pe.y; } }
        else {
#pragma unroll 4
            for (int cc = NCHUNK - 1; cc > c; --cc) { const f32x2 pe = agg[(size_t)cc * LW]; carry = pe.x * carry + pe.y; } }
    }
    float totA = 1.f, totB = 0.f;
    const int src1 = DIR == 0 ? lane - 16 : lane + 16, src2 = DIR == 0 ? lane - 32 : lane + 32;
    const bool v1 = DIR == 0 ? (fq >= 1) : (fq <= 2), v2 = DIR == 0 ? (fq >= 2) : (fq <= 1);
    const int lastl = DIR == 0 ? fr + 48 : fr;
#pragma unroll
    for (int mm = 0; mm < 8; ++mm) {
        const int m = DIR == 0 ? mm : 7 - mm;
        f32x4 R = (f32x4){0.f, 0.f, 0.f, 0.f}, I = (f32x4){0.f, 0.f, 0.f, 0.f};
#pragma unroll
        for (int ks = 0; ks < 4; ++ks) {
            const bf16x8 a = *(const LAS bf16x8*)(XC + (16 * m + fr) * 272 + (32 * ks + 8 * fq) * 2);
            R = __builtin_amdgcn_mfma_f32_16x16x32_bf16(a, Ba[ks], R, 0, 0, 0);
            I = __builtin_amdgcn_mfma_f32_16x16x32_bf16(a, Bx[ks], I, 0, 0, 0);
        }
#pragma unroll
        for (int j = 0; j < 4; ++j) {
            const float r = sigmoidf_(R[j] + ba), ig = sigmoidf_(I[j] + bx);
            const float a = __builtin_amdgcn_exp2f(cl * r);
            const float xc = bf1(*(const LAS unsigned short*)(XC + (16 * m + 4 * fq + j) * 272 + chl * 2));
            const float om = fmaxf(1.0f - a * a, 0.0f);
            R[j] = a; I[j] = __builtin_amdgcn_sqrtf(om) * (ig * xc);
        }
        float A = 1.f, B = 0.f;
#pragma unroll
        for (int jj = 0; jj < 4; ++jj) { const int j = DIR == 0 ? jj : 3 - jj; B = R[j] * B + I[j]; A = R[j] * A; }
        { const float pa = __shfl(A, src1), pb = __shfl(B, src1); if (v1) { B = A * pb + B; A = A * pa; } }
        { const float pa = __shfl(A, src2), pb = __shfl(B, src2); if (v2) { B = A * pb + B; A = A * pa; } }
        const float TA = __shfl(A, lastl), TB = __shfl(B, lastl);
        if (APPLY) {
            float EA = __shfl(A, src1), EB = __shfl(B, src1); if (!v1) { EA = 1.f; EB = 0.f; }
            float hh = EA * carry + EB;
#pragma unroll
            for (int jj = 0; jj < 4; ++jj) { const int j = DIR == 0 ? jj : 3 - jj; hh = R[j] * hh + I[j]; if (DIR == 0) hsum[m][j] = hh; else hsum[m][j] += hh; }
            carry = TA * carry + TB;
        } else { totB = TA * totB + TB; totA = TA * totA; }
    }
    if (!APPLY) { if (fq == 0) { f32x2* agg = (f32x2*)F.AGG + (size_t)((b * 2 + DIR) * NCHUNK + c) * LW + chg; *agg = (f32x2){totA, totB}; } }
}

template <bool APPLY>
__device__ __forceinline__ void lru_unit(Frame& F, int unit) {
    const int h = unit & 7, c = (unit >> 3) & 63, b = unit >> 9;
    const int tid = F.tid, lane = F.lane, w = F.wave, fr = lane & 15, fq = lane >> 4;
    const size_t t0 = (size_t)b * SEQ + (size_t)c * CHUNK;
    LAS unsigned char* XR = F.lds + LRU_XR; LAS unsigned char* XC = F.lds + LRU_XC; LAS unsigned char* GR = F.lds + LRU_GR;
    for (int p = tid; p < 131 * 16; p += 512) { const int r = p >> 4, cg = p & 15; const int s = c * CHUNK - 2 + r; v4u v = (v4u){0u, 0u, 0u, 0u};
        if (s >= 0 && s < SEQ) v = *(const GAS v4u*)(F.Z + ((size_t)b * SEQ + s) * NIN + h * 128 + cg * 8);
        *(LAS v4u*)(XR + r * 256 + cg * 16) = v; }
    if (APPLY) { for (int p = tid; p < 128 * 32; p += 512) { const int r = p >> 5, cg = p & 31;
        *(LAS v2u*)(GR + r * 264 + cg * 8) = *(const GAS v2u*)(F.Z + (t0 + r) * NIN + LW + h * 128 + cg * 4); } }
    __syncthreads();
    {
        const int ch2 = tid & 63, tg = tid >> 6, chg = h * 128 + 2 * ch2;
        float w0[4], w1[4];
#pragma unroll
        for (int k = 0; k < 4; ++k) { w0[k] = F.in[3][k * LW + chg]; w1[k] = F.in[3][k * LW + chg + 1]; }
        const float b0 = F.in[4][chg], b1 = F.in[4][chg + 1];
        float x0[4], x1[4];
#pragma unroll
        for (int k = 0; k < 3; ++k) { const unsigned u = *(const LAS unsigned*)(XR + (16 * tg + k) * 256 + ch2 * 4); x0[k] = bf_lo(u); x1[k] = bf_hi(u); }
#pragma unroll
        for (int j = 0; j < 16; ++j) {
            const unsigned u = *(const LAS unsigned*)(XR + (16 * tg + j + 3) * 256 + ch2 * 4); x0[3] = bf_lo(u); x1[3] = bf_hi(u);
            const float y0 = b0 + ((w0[0] * x0[0] + w0[1] * x0[1]) + (w0[2] * x0[2] + w0[3] * x0[3]));
            const float y1 = b1 + ((w1[0] * x1[0] + w1[1] * x1[1]) + (w1[2] * x1[2] + w1[3] * x1[3]));
            *(LAS unsigned*)(XC + (16 * tg + j) * 272 + ch2 * 4) = pk2(y0, y1);
            x0[0] = x0[1]; x0[1] = x0[2]; x0[2] = x0[3]; x1[0] = x1[1]; x1[1] = x1[2]; x1[2] = x1[3];
        }
    }
    __syncthreads();
    float hsum[8][4];
    lru_dir<APPLY, 0>(F, b, c, h, hsum);
    asm volatile("" ::: "memory"); __builtin_amdgcn_sched_barrier(0);
    lru_dir<APPLY, 1>(F, b, c, h, hsum);
    if (APPLY) {
        const int chl = 16 * w + fr;
#pragma unroll
        for (int m = 0; m < 8; ++m)
#pragma unroll
            for (int j = 0; j < 4; ++j) { LAS unsigned short* p = (LAS unsigned short*)(GR + (16 * m + 4 * fq + j) * 264 + chl * 2); *p = (unsigned short)f2bf(bf1(*p) * hsum[m][j]); }
        __syncthreads();
        for (int p = tid; p < 128 * 32; p += 512) { const int r = p >> 5, cg = p & 31;
            *(GAS v2u*)(F.MIX + (t0 + r) * D + h * 128 + cg * 4) = *(const LAS v2u*)(GR + r * 264 + cg * 8); }
    }
    __syncthreads();
}
constexpr int GM_ST = 0, GM_BS = 1024, GM_VT = 2048, GM_GU = 2048 + 34816;
__device__ __forceinline__ void gmlp_unit(Frame& F, int unit) {
    const int tid = F.tid, lane = F.lane, w = F.wave, fr = lane & 15, fq = lane >> 4;
    const size_t t0 = (size_t)unit * CHUNK;
    LAS float* ST = (LAS float*)(F.lds + GM_ST); LAS float* BS = (LAS float*)(F.lds + GM_BS);
    LAS unsigned char* VT = F.lds + GM_VT; LAS unsigned char* GU = F.lds + GM_GU;
    for (int rr = 0; rr < 16; ++rr) {
        const int row = 16 * w + rr;
        const bf16* p = F.Z + (t0 + row) * NIN + 3 * LW + lane * 8;
        const v4u a = *(const GAS v4u*)p, b = *(const GAS v4u*)(p + 512);
        float x[16] = {bf_lo(a.x), bf_hi(a.x), bf_lo(a.y), bf_hi(a.y), bf_lo(a.z), bf_hi(a.z), bf_lo(a.w), bf_hi(a.w),
                       bf_lo(b.x), bf_hi(b.x), bf_lo(b.y), bf_hi(b.y), bf_lo(b.z), bf_hi(b.z), bf_lo(b.w), bf_hi(b.w)};
        float s = 0.f;
#pragma unroll
        for (int i = 0; i < 16; ++i) s += x[i];
        const float mean = wave_sum(s) * (1.0f / LW);
        float q = 0.f;
#pragma unroll
        for (int i = 0; i < 16; ++i) { const float d = x[i] - mean; q += d * d; }
        const float rstd = __builtin_amdgcn_rsqf(wave_sum(q) * (1.0f / LW) + 1e-6f);
        if (lane == 0) { ST[2 * row] = mean; ST[2 * row + 1] = rstd; }
    }
    __syncthreads();
    for (int h = 0; h < 8; ++h) {
#pragma unroll
        for (int i = 0; i < 4; ++i) { const int pid = tid + 512 * i, q = pid >> 4, cg = pid & 15;
            const v4u a = *(const GAS v4u*)(F.Z + (t0 + q) * NIN + 3 * LW + h * 128 + cg * 8);
            const float mean = ST[2 * q], rstd = ST[2 * q + 1];
            const f32x4 g0 = *(const GAS f32x4*)(F.in[10] + h * 128 + cg * 8), g1 = *(const GAS f32x4*)(F.in[10] + h * 128 + cg * 8 + 4);
            const f32x4 b0 = *(const GAS f32x4*)(F.in[11] + h * 128 + cg * 8), b1 = *(const GAS f32x4*)(F.in[11] + h * 128 + cg * 8 + 4);
            const float x[8] = {bf_lo(a.x), bf_hi(a.x), bf_lo(a.y), bf_hi(a.y), bf_lo(a.z), bf_hi(a.z), bf_lo(a.w), bf_hi(a.w)};
            const float g[8] = {g0.x, g0.y, g0.z, g0.w, g1.x, g1.y, g1.z, g1.w}, bb[8] = {b0.x, b0.y, b0.z, b0.w, b1.x, b1.y, b1.z, b1.w};
#pragma unroll
            for (int e = 0; e < 8; ++e) *(LAS unsigned short*)(VT + (cg * 8 + e) * 272 + q * 2) = (unsigned short)f2bf((x[e] - mean) * rstd * g[e] + bb[e]);
        }
#pragma unroll
        for (int i = 0; i < 8; ++i) { const int pid = tid + 512 * i, r = pid >> 5, cg = pid & 31;
            *(LAS v2u*)(GU + r * 264 + cg * 8) = *(const GAS v2u*)(F.Z + (t0 + r) * NIN + 2 * LW + h * 128 + cg * 4); }
        if (tid < 128) BS[tid] = F.in[13][h * 128 + tid];
        __syncthreads();
        bf16x8 Bf[4];
#pragma unroll
        for (int ks = 0; ks < 4; ++ks) Bf[ks] = *(const LAS bf16x8*)(VT + (16 * w + fr) * 272 + (32 * ks + 8 * fq) * 2);
        f32x4 acc[8];
#pragma unroll
        for (int m = 0; m < 8; ++m) acc[m] = (f32x4){0.f, 0.f, 0.f, 0.f};
        const bf16* wsb = F.WSB + (size_t)h * 16384 + fr * 128 + 8 * fq;
#pragma unroll
        for (int m = 0; m < 8; ++m)
#pragma unroll
            for (int ks = 0; ks < 4; ++ks) { const bf16x8 a = *(const GAS bf16x8*)(wsb + (16 * m) * 128 + 32 * ks); acc[m] = __builtin_amdgcn_mfma_f32_16x16x32_bf16(a, Bf[ks], acc[m], 0, 0, 0); }
        const int cidx = 16 * w + fr;
#pragma unroll
        for (int m = 0; m < 8; ++m)
#pragma unroll
            for (int j = 0; j < 4; ++j) { const int p = 16 * m + 4 * fq + j; LAS unsigned short* ad = (LAS unsigned short*)(GU + p * 264 + cidx * 2);
                *ad = (unsigned short)f2bf(bf1(*ad) * (acc[m][j] + BS[p])); }
        __syncthreads();
#pragma unroll
        for (int i = 0; i < 8; ++i) { const int pid = tid + 512 * i, r = pid >> 5, cg = pid & 31;
            *(GAS v2u*)(F.MIX + (t0 + r) * D + LW + h * 128 + cg * 4) = *(const LAS v2u*)(GU + r * 264 + cg * 8); }
        __syncthreads();
    }
}
typedef float f32x16 __attribute__((ext_vector_type(16)));
__device__ __forceinline__ unsigned fkey(float f) { const unsigned u = __builtin_bit_cast(unsigned, f); return (u & 0x80000000u) ? ~u : (u | 0x80000000u); }
__device__ __forceinline__ float fkey_inv(unsigned k) { const unsigned u = (k & 0x80000000u) ? (k & 0x7fffffffu) : ~k; return __builtin_bit_cast(float, u); }
__device__ __forceinline__ unsigned umax_(unsigned a, unsigned b) { return a > b ? a : b; }
__device__ __forceinline__ unsigned umin_(unsigned a, unsigned b) { return a < b ? a : b; }
__device__ __forceinline__ void topk_unit(Frame& F, int wu) {
    const int tg = wu >> 3, hd = wu & 7, lane = F.lane, r = lane & 31, hh = lane >> 5;
    const int t = tg * 32 + r;
    const float* qrow = F.Q + (size_t)t * D + hd * 256 + 4 * hh;
    unsigned L[2][16];
#pragma unroll
    for (int p = 0; p < 2; ++p) {
        f32x16 acc[4];
#pragma unroll
        for (int nt = 0; nt < 4; ++nt)
#pragma unroll
            for (int i = 0; i < 16; ++i) acc[nt][i] = 0.f;
        const float* kbase = F.in[17] + ((size_t)(hd * 2 + p) * 128 + r) * 128 + 4 * hh;
        f32x4 qc = *(const GAS f32x4*)(qrow + p * 128), ac[4];
#pragma unroll
        for (int nt = 0; nt < 4; ++nt) ac[nt] = *(const GAS f32x4*)(kbase + (size_t)nt * 32 * 128);
#pragma unroll 1
        for (int s = 0; s < 16; ++s) {
            const int sn = (s + 1) & 15;
            const f32x4 qn = *(const GAS f32x4*)(qrow + p * 128 + 8 * sn);
            f32x4 an[4];
#pragma unroll
            for (int nt = 0; nt < 4; ++nt) an[nt] = *(const GAS f32x4*)(kbase + (size_t)nt * 32 * 128 + 8 * sn);
#pragma unroll
            for (int j = 0; j < 4; ++j)
#pragma unroll
                for (int nt = 0; nt < 4; ++nt) acc[nt] = __builtin_amdgcn_mfma_f32_32x32x2f32(ac[nt][j], qc[j], acc[nt], 0, 0, 0);
            qc = qn;
#pragma unroll
            for (int nt = 0; nt < 4; ++nt) ac[nt] = an[nt];
        }
        unsigned Lp[16];
#pragma unroll
        for (int i = 0; i < 16; ++i) Lp[i] = 0u;
#pragma unroll
        for (int nt = 0; nt < 4; ++nt)
#pragma unroll
            for (int rg = 0; rg < 16; ++rg) {
                const int n = 32 * nt + (rg & 3) + 8 * (rg >> 2) + 4 * hh;
                unsigned key = (fkey(acc[nt][rg]) & ~0x7Fu) | (unsigned)(127 - n);
#pragma unroll
                for (int i = 0; i < 16; ++i) { const unsigned mx = umax_(Lp[i], key), mn = umin_(Lp[i], key); Lp[i] = mx; key = mn; }
            }
        unsigned T[16];
#pragma unroll
        for (int i = 0; i < 16; ++i) T[i] = (unsigned)__shfl_xor((int)Lp[15 - i], 32);
#pragma unroll
        for (int i = 0; i < 16; ++i) T[i] = umax_(Lp[i], T[i]);
#pragma unroll
        for (int st = 8; st >= 1; st >>= 1)
#pragma unroll
            for (int i = 0; i < 16; ++i) if ((i & st) == 0) { const unsigned a_ = T[i], b_ = T[i + st]; T[i] = umax_(a_, b_); T[i + st] = umin_(a_, b_); }
#pragma unroll
        for (int i = 0; i < 16; ++i) L[p][i] = T[i];
    }
    float v0[16], v1[16];
#pragma unroll
    for (int i = 0; i < 16; ++i) { v0[i] = fkey_inv(L[0][i] & ~0x7Fu); v1[i] = fkey_inv(L[1][i] & ~0x7Fu); }
    unsigned best[16];
#pragma unroll
    for (int i = 0; i < 16; ++i) best[i] = 0u;
#pragma unroll
    for (int i = 0; i < 16; ++i)
#pragma unroll
        for (int j = 0; j < 16; ++j) if ((i + 1) * (j + 1) <= 16) {
            unsigned key = (fkey(v0[i] + v1[j]) & ~0xFFu) | (unsigned)(255 - (i * 16 + j));
#pragma unroll
            for (int k = 0; k < 16; ++k) { const unsigned mx = umax_(best[k], key), mn = umin_(best[k], key); best[k] = mx; key = mn; }
        }
    float sv[16]; int ids[16];
    const float smax = fkey_inv(best[0] & ~0xFFu);
    float ssum = 0.f;
#pragma unroll
    for (int k = 0; k < 16; ++k) {
        const unsigned pos = 255u - (best[k] & 0xFFu); const unsigned ii = pos >> 4, jj = pos & 15u;
        unsigned k0 = L[0][0], k1 = L[1][0];
#pragma unroll
        for (int i = 1; i < 16; ++i) { k0 = (ii == (unsigned)i) ? L[0][i] : k0; k1 = (jj == (unsigned)i) ? L[1][i] : k1; }
        ids[k] = (int)((127u - (k0 & 0x7Fu)) * 128u + (127u - (k1 & 0x7Fu)));
        sv[k] = __builtin_amdgcn_exp2f((fkey_inv(best[k] & ~0xFFu) - smax) * 1.4426950409f); ssum += sv[k];
    }
    const float inv = 1.0f / ssum;
    if (hh == 0) {
        int* o = F.IDS + (size_t)t * 128 + hd * 16;
#pragma unroll
        for (int k = 0; k < 16; k += 4) *(GAS v4u*)(o + k) = (v4u){(unsigned)ids[k], (unsigned)ids[k + 1], (unsigned)ids[k + 2], (unsigned)ids[k + 3]};
    } else {
        float* o = F.GATES + (size_t)t * 128 + hd * 16;
#pragma unroll
        for (int k = 0; k < 16; k += 4) *(GAS f32x4*)(o + k) = (f32x4){sv[k] * inv, sv[k + 1] * inv, sv[k + 2] * inv, sv[k + 3] * inv};
    }
}
__device__ __forceinline__ float dot8(const v4u u, const float* x) {
    return (bf_lo(u.x) * x[0] + bf_hi(u.x) * x[1]) + (bf_lo(u.y) * x[2] + bf_hi(u.y) * x[3]) + (bf_lo(u.z) * x[4] + bf_hi(u.z) * x[5]) + (bf_lo(u.w) * x[6] + bf_hi(u.w) * x[7]);
}
__device__ __forceinline__ void axpy8(const float a, const v4u v, float* acc) {
    acc[0] += a * bf_lo(v.x); acc[1] += a * bf_hi(v.x); acc[2] += a * bf_lo(v.y); acc[3] += a * bf_hi(v.y);
    acc[4] += a * bf_lo(v.z); acc[5] += a * bf_hi(v.z); acc[6] += a * bf_lo(v.w); acc[7] += a * bf_hi(v.w);
}
__device__ __forceinline__ void peer_token(Frame& F, int t) {
    const int lane = F.lane;
    float hx[32], acc[32];
    {
        const bf16* hp = F.HB + (size_t)t * D + lane * 8;
#pragma unroll
        for (int c = 0; c < 4; ++c) { const v4u a = *(const GAS v4u*)(hp + c * 512);
            hx[c * 8 + 0] = bf_lo(a.x); hx[c * 8 + 1] = bf_hi(a.x); hx[c * 8 + 2] = bf_lo(a.y); hx[c * 8 + 3] = bf_hi(a.y);
            hx[c * 8 + 4] = bf_lo(a.z); hx[c * 8 + 5] = bf_hi(a.z); hx[c * 8 + 6] = bf_lo(a.w); hx[c * 8 + 7] = bf_hi(a.w); }
    }
#pragma unroll
    for (int i = 0; i < 32; ++i) acc[i] = 0.f;
    const float rstd = __builtin_amdgcn_rsqf(F.ROWSS[t] * (1.0f / D) + 1e-6f);
#pragma unroll 1
    for (int half = 0; half < 2; ++half) {
        const int idv = F.IDS[(size_t)t * 128 + half * 64 + lane];
        const float gv = F.GATES[(size_t)t * 128 + half * 64 + lane];
#pragma unroll 1
        for (int kb = 0; kb < 64; kb += 4) {
            int e[4]; float g[4];
#pragma unroll
            for (int u = 0; u < 4; ++u) { e[u] = __builtin_amdgcn_readlane(idv, kb + u); g[u] = __builtin_bit_cast(float, __builtin_amdgcn_readlane(__builtin_bit_cast(int, gv), kb + u)); }
            v4u ur[4][4], vr[4][4];
#pragma unroll
            for (int u = 0; u < 4; ++u)
#pragma unroll
                for (int c = 0; c < 4; ++c) ur[u][c] = *(const GAS v4u*)(F.U + (size_t)e[u] * D + c * 512 + lane * 8);
#pragma unroll
            for (int u = 0; u < 4; ++u)
#pragma unroll
                for (int c = 0; c < 4; ++c) vr[u][c] = *(const GAS v4u*)(F.V + (size_t)e[u] * D + c * 512 + lane * 8);
            float d[4];
#pragma unroll
            for (int u = 0; u < 4; ++u) d[u] = (dot8(ur[u][0], hx) + dot8(ur[u][1], hx + 8)) + (dot8(ur[u][2], hx + 16) + dot8(ur[u][3], hx + 24));
#pragma unroll
            for (int o = 1; o < 64; o <<= 1) {
#pragma unroll
                for (int u = 0; u < 4; ++u) d[u] += __shfl_xor(d[u], o); }
#pragma unroll
            for (int u = 0; u < 4; ++u) { const float a = gelu_tanh(d[u] * rstd) * g[u];
#pragma unroll
                for (int c = 0; c < 4; ++c) axpy8(a, vr[u][c], acc + 8 * c); }
        }
    }
    float ss = 0.f;
#pragma unroll
    for (int i = 0; i < 32; ++i) { acc[i] += hx[i]; ss += acc[i] * acc[i]; }
    const float rs = __builtin_amdgcn_rsqf(wave_sum(ss) * (1.0f / D) + 1e-6f);
    const float* fg = F.in[20] + lane * 8; float* op = F.out + (size_t)t * D + lane * 8;
#pragma unroll
    for (int c = 0; c < 4; ++c) {
        const f32x4 g0 = *(const GAS f32x4*)(fg + c * 512), g1 = *(const GAS f32x4*)(fg + c * 512 + 4);
        *(GAS f32x4*)(op + c * 512) = (f32x4){acc[c * 8 + 0] * rs * g0.x, acc[c * 8 + 1] * rs * g0.y, acc[c * 8 + 2] * rs * g0.z, acc[c * 8 + 3] * rs * g0.w};
        *(GAS f32x4*)(op + c * 512 + 4) = (f32x4){acc[c * 8 + 4] * rs * g1.x, acc[c * 8 + 5] * rs * g1.y, acc[c * 8 + 6] * rs * g1.z, acc[c * 8 + 7] * rs * g1.w};
    }
}
struct Args { const float* in[21]; float* out; unsigned char* ws; int ph_lo, ph_hi; };
__global__ void __launch_bounds__(NWAVES * 64, 2) mk_fwd(Args args) {
    extern __shared__ __attribute__((aligned(16))) unsigned char lds[];
    Frame F;
    F.lds = (LAS unsigned char*)lds;
    F.MISC = (volatile LAS unsigned*)(F.lds + MISC_OFF);
    F.tid = threadIdx.x; F.lane = F.tid & 63; F.wave = __builtin_amdgcn_readfirstlane(F.tid >> 6);
    F.G = gridDim.x; { const int bx = blockIdx.x; F.vcu = (F.G % 8 == 0) ? (bx % 8) * (F.G / 8) + bx / 8 : bx; }
    unsigned char* ws = args.ws;
    F.ctl = (gu32*)(ws + WS_CTL);
#pragma unroll
    for (int i = 0; i < 21; ++i) F.in[i] = args.in[i];
    F.out = args.out;
    F.WIN = (bf16*)(ws + WS_WIN); F.WOUT = (bf16*)(ws + WS_WOUT); F.WQ = (bf16*)(ws + WS_WQ); F.LRUW = (bf16*)(ws + WS_LRUW); F.WSB = (bf16*)(ws + WS_WSB);
    F.U = (bf16*)(ws + WS_U); F.V = (bf16*)(ws + WS_V); F.XN = (bf16*)(ws + WS_XN); F.MIX = (bf16*)(ws + WS_XN); F.Z = (bf16*)(ws + WS_Z); F.HB = (bf16*)(ws + WS_HB);
    F.ROWSS = (float*)(ws + WS_ROWSS); F.Q = (float*)(ws + WS_Z); F.AGG = (float*)(ws + WS_AGG); F.GATES = (float*)(ws + WS_GATES); F.IDS = (int*)(ws + WS_IDS);
    for (int u = F.tid; u < (LDS_BYTES - LDSCTL_OFF) / 4; u += NWAVES * 64) ((LAS unsigned*)(F.lds + LDSCTL_OFF))[u] = 0u;
    __syncthreads();
    XcdBarrier bar; bar.bar = (unsigned*)(F.ctl + CW_BAR); bar.x = 0; bar.st = nullptr;
    if (N_LAUNCHES != PER_PHASE) bar = xcd_barrier_post((unsigned*)(F.ctl + CW_BAR), F.MISC + 8);
#define GRID_BAR() do { if (N_LAUNCHES != PER_PHASE) xcd_barrier(bar); } while (0)
    const int lo = args.ph_lo, hi = args.ph_hi;
#ifndef MK_PHASE_MASK
#define MK_PHASE_MASK 0xFF
#endif
#define IN(k) (((MK_PHASE_MASK >> (k)) & 1) && lo <= (k) && (k) < hi)
#define BOTH(k) (IN(k) && IN((k) + 1))
    const int gw = F.vcu * NWAVES + F.wave, NGW = F.G * NWAVES;
    if (IN(0)) { p0_prologue(F); if (BOTH(0)) GRID_BAR(); }
    if (IN(1)) {
        pg8::Gemm g{F.XN, F.WIN, M, NIN, D}; pg8::StaticOrder S; S.init(M, NIN, F.G, (int)blockIdx.x);
        pg8::EpiZ E{F.Z, NIN, LW};
        pg8::gemm_phase<pg8::EpiZ, pg8::StaticOrder, true, true>(F.lds, g, S, E);
        if (BOTH(1)) GRID_BAR();
    }
    if (IN(2)) {
        for (int u = blockIdx.x; u < BATCH * NCHUNK * 8; u += F.G) lru_unit<false>(F, u);
        for (int u = blockIdx.x; u < BATCH * NCHUNK; u += F.G) gmlp_unit(F, u);
        if (BOTH(2)) GRID_BAR();
    }
    if (IN(3)) {
        for (int u = blockIdx.x; u < BATCH * NCHUNK * 8; u += F.G) lru_unit<true>(F, u);
        if (BOTH(3)) GRID_BAR();
    }
    if (IN(4)) {
        pg8::Gemm g{F.MIX, F.WOUT, M, D, D}; pg8::StaticOrder S; S.init(M, D, F.G, (int)blockIdx.x);
        pg8::EpiH E{F.HB, F.in[0], F.ROWSS, D};
        pg8::gemm_phase<pg8::EpiH, pg8::StaticOrder, true, true>(F.lds, g, S, E);
        if (BOTH(4)) GRID_BAR();
    }
    if (IN(5)) {
        pg8::Gemm g{F.HB, F.WQ, M, D, D}; pg8::StaticOrder S; S.init(M, D, F.G, (int)blockIdx.x);
        pg8::EpiQ E{F.Q, F.ROWSS, D};
        pg8::gemm_phase<pg8::EpiQ, pg8::StaticOrder, true, true>(F.lds, g, S, E);
        if (BOTH(5)) GRID_BAR();
    }
    if (IN(6)) {
        for (int wu = gw; wu < (M / 32) * 8; wu += NGW) topk_unit(F, wu);
        if (BOTH(6)) GRID_BAR();
    }
    if (IN(7)) {
        for (int t = gw; t < M; t += NGW) peer_token(F, t);
    }
#undef IN
#undef BOTH
#undef GRID_BAR
}

extern "C" void kernel_launch(void* const* d_in, const int* in_sizes, int n_in, void* d_out, int out_size, void* d_ws, size_t ws_size, hipStream_t stream) {
    static int grid = 0;
    if (grid == 0) {
        if (n_in != 21 || in_sizes[0] != M * D || out_size != M * D || ws_size < WS_END) { fprintf(stderr, "kernel_launch: unexpected shapes (n_in %d, in0 %d, out %d, ws %zu)\n", n_in, n_in > 0 ? in_sizes[0] : -1, out_size, ws_size); grid = -1; return; }
        int dev = 0, cus = 0, per_cu = 0;
        if (hipGetDevice(&dev) != hipSuccess || hipDeviceGetAttribute(&cus, hipDeviceAttributeMultiprocessorCount, dev) != hipSuccess) { grid = -1; return; }
        if (hipFuncSetAttribute((const void*)mk_fwd, hipFuncAttributeMaxDynamicSharedMemorySize, LDS_BYTES) != hipSuccess) { fprintf(stderr, "kernel_launch: hipFuncSetAttribute failed\n"); grid = -1; return; }
        if (hipOccupancyMaxActiveBlocksPerMultiprocessor(&per_cu, (const void*)mk_fwd, NWAVES * 64, LDS_BYTES) != hipSuccess || per_cu < 1) { fprintf(stderr, "kernel_launch: occupancy query reports %d blocks per CU\n", per_cu); }
        (void)hipGetLastError();
        grid = cus;
    }
    if (grid < 0) return;
    (void)hipMemsetAsync((char*)d_ws + WS_CTL, 0, CTL_ZERO_BYTES, stream);
    Args a{};
    for (int i = 0; i < 21; ++i) a.in[i] = (const float*)d_in[i];
    a.out = (float*)d_out; a.ws = (unsigned char*)d_ws;
    for (int li = 0; li < N_LAUNCHES; ++li) {
        a.ph_lo = (N_LAUNCHES == PER_PHASE) ? li : 0; a.ph_hi = (N_LAUNCHES == PER_PHASE) ? li + 1 : PER_PHASE;
        hipLaunchKernelGGL(mk_fwd, dim3(grid), dim3(NWAVES * 64), LDS_BYTES, stream, a);
    }
}
```

```cpp
#include <hip/hip_runtime.h>
#include <cstdio>
#include <cstdint>
namespace pg8 {
#define PG8_LAS __attribute__((address_space(3)))
typedef unsigned short bf16_t;
typedef short bf16x8 __attribute__((ext_vector_type(8)));
typedef float f32x4 __attribute__((ext_vector_type(4)));
typedef unsigned u32x4 __attribute__((ext_vector_type(4)));
constexpr int BM = 256, BK = 64, HALF = 128, HTB = HALF * BK * 2  , STAGE_BYTES = 8 * HTB, NXCD = 8, WGM = 8;

__host__ __device__ __forceinline__ int lds_byte(int r, int c) { const int st = (r >> 4) * 2 + (c >> 5), rr = r & 15, cc = c & 31, ob = rr * 64 + cc * 2; return st * 1024 + (ob ^ (((ob >> 9) & 1) << 5)); }
__host__ __device__ __forceinline__ void stage_rc(int b, int& R, int& C) { const int st = b / 1024, sb = b % 1024, swz = sb ^ (((sb >> 9) & 1) << 5); R = (st >> 1) * 16 + swz / 64; C = (st & 1) * 32 + (swz % 64) / 2; }
__host__ __device__ __forceinline__ int perm32(int rho) { const int n = rho >> 4, i = rho & 15; return 8 * (i >> 2) + 4 * n + (i & 3); }

struct Unit { int pm, pn; };
struct Gemm { const bf16_t* A; const bf16_t* Bt; int M, N, K; };

struct StaticOrder {
    int nM, nN, nwg, G, c;
    __host__ __device__ void init(int M, int N, int G_, int c_) { nM = M / BM; nN = N / BM; nwg = nM * nN; G = G_; c = c_; }
    __host__ __device__ bool next(int i, Unit& u) const {
        const long L = (long)i * G + c; if (L >= nwg) return false;
        int wgid = (int)L; { const int q = nwg / NXCD, r = nwg % NXCD, xcd = wgid % NXCD, off = wgid / NXCD; wgid = (xcd < r ? xcd * (q + 1) : r * (q + 1) + (xcd - r) * q) + off; }
        const int nig = WGM * nN, gid = wgid / nig, fm = gid * WGM, gsz = (nM - fm) < WGM ? (nM - fm) : WGM;
        u.pm = fm + ((wgid % nig) % gsz); u.pn = (wgid % nig) / gsz; return true;
    }
    __device__ __forceinline__ void a_ready(const Unit&) const {}
    __device__ __forceinline__ void done(const Unit&) const {}
};

__device__ __forceinline__ unsigned cvt_pk_bf16(float lo, float hi) { unsigned r; asm volatile("v_cvt_pk_bf16_f32 %0, %1, %2" : "=v"(r) : "v"(lo), "v"(hi)); return r; }
__device__ __forceinline__ float gelu_tanh(float x) {
    const float t = x * (1.0f + 0.044715f * x * x);
    const float e = __builtin_amdgcn_exp2f(-2.3022081983f * t);
    return x * __builtin_amdgcn_rcpf(1.0f + e);
}
struct EpiZ {
    static constexpr bool PERM = true, AFTER_DRAIN = false;
    bf16_t* O; int ldc; int gelu_from;
    __device__ __forceinline__ void operator()(const f32x4 (&acc)[2][2][4][2], const Unit& u, int wr, int wc, int fr, int fq) const {
        const int row0 = u.pm * BM + wr * 64 + fr; const int col0 = u.pn * BM + wc * 32 + 8 * fq;
        const bool act = (u.pn * BM) >= gelu_from;
#pragma unroll
        for (int ai = 0; ai < 2; ++ai)
#pragma unroll
            for (int m = 0; m < 4; ++m) { bf16_t* rowp = O + (size_t)(row0 + ai * HALF + m * 16) * ldc + col0;
#pragma unroll
                for (int bj = 0; bj < 2; ++bj) { f32x4 v0 = acc[ai][bj][m][0], v1 = acc[ai][bj][m][1];
                    if (act) {
#pragma unroll
                        for (int j = 0; j < 4; ++j) { v0[j] = gelu_tanh(v0[j]); v1[j] = gelu_tanh(v1[j]); } }
                    u32x4 w; w.x = cvt_pk_bf16(v0[0], v0[1]); w.y = cvt_pk_bf16(v0[2], v0[3]); w.z = cvt_pk_bf16(v1[0], v1[1]); w.w = cvt_pk_bf16(v1[2], v1[3]);
                    *(u32x4*)(rowp + bj * HALF) = w; } }
    }
};
struct EpiH {
    static constexpr bool PERM = true, AFTER_DRAIN = false;
    bf16_t* O; bf16_t* OT; const float* X; float* rowss; int ldc; int mrows;
    __device__ __forceinline__ void operator()(const f32x4 (&acc)[2][2][4][2], const Unit& u, int wr, int wc, int fr, int fq) const {
        const int row0 = u.pm * BM + wr * 64 + fr; const int col0 = u.pn * BM + wc * 32 + 8 * fq;
#pragma unroll
        for (int ai = 0; ai < 2; ++ai)
#pragma unroll
            for (int m = 0; m < 4; ++m) { const int row = row0 + ai * HALF + m * 16; const size_t off = (size_t)row * ldc + col0; float ss = 0.f;
#pragma unroll
                for (int bj = 0; bj < 2; ++bj) {
                    const f32x4 x0 = *(const f32x4*)(X + off + bj * HALF), x1 = *(const f32x4*)(X + off + bj * HALF + 4);
                    const f32x4 v0 = acc[ai][bj][m][0] + x0, v1 = acc[ai][bj][m][1] + x1;
                    ss += (v0[0] * v0[0] + v0[1] * v0[1]) + (v0[2] * v0[2] + v0[3] * v0[3]) + (v1[0] * v1[0] + v1[1] * v1[1]) + (v1[2] * v1[2] + v1[3] * v1[3]);
                    u32x4 w; w.x = cvt_pk_bf16(v0[0], v0[1]); w.y = cvt_pk_bf16(v0[2], v0[3]); w.z = cvt_pk_bf16(v1[0], v1[1]); w.w = cvt_pk_bf16(v1[2], v1[3]);
                    *(u32x4*)(O + off + bj * HALF) = w;
                    *(u32x4*)(OT + ((size_t)((col0 + bj * HALF) >> 3) * mrows + row) * 8) = w; }
                ss += __shfl_xor(ss, 16); ss += __shfl_xor(ss, 32);
                if (fq == 0) atomicAdd(rowss + row, ss); }
    }
};
struct EpiQ {
    static constexpr bool PERM = false, AFTER_DRAIN = false;
    float* C; const float* rowss; int ldc;
    __device__ __forceinline__ void operator()(const f32x4 (&acc)[2][2][4][2], const Unit& u, int wr, int wc, int fr, int fq) const {
        const int row0 = u.pm * BM + wr * 64 + fr, col0 = u.pn * BM + wc * 32 + 4 * fq;
#pragma unroll
        for (int ai = 0; ai < 2; ++ai)
#pragma unroll
            for (int m = 0; m < 4; ++m) { const int row = row0 + ai * HALF + m * 16; const float rs = __builtin_amdgcn_rsqf(rowss[row] * (1.0f / 2048.0f) + 1e-6f);
                float* rowp = C + (size_t)row * ldc + col0;
#pragma unroll
                for (int bj = 0; bj < 2; ++bj)
#pragma unroll
                    for (int n = 0; n < 2; ++n) *(f32x4*)(rowp + bj * HALF + n * 16) = acc[ai][bj][m][n] * rs; }
    }
};
template <class Epi, class Sched, bool ALIGN_EPI = false, bool SP2 = false>
__device__ __forceinline__ void gemm_phase(PG8_LAS unsigned char* lds, const Gemm g, const Sched& S, const Epi& E) {
    const int tid = threadIdx.x, wid = __builtin_amdgcn_readfirstlane(tid >> 6), lane = tid & 63, wr = wid >> 2, wc = wid & 3, fr = lane & 15, fq = lane >> 4;
    const int K = g.K, nt = K / BK;
    unsigned voffA[2], voffB[2];
#pragma unroll
    for (int i = 0; i < 2; ++i) { int R, C; stage_rc(tid * 16 + i * 8192, R, C); const int Rb = Epi::PERM ? ((R & ~31) + perm32(R & 31)) : R;
        voffA[i] = (unsigned)(R * K + C) * 2u; voffB[i] = (unsigned)(Rb * K + C) * 2u; }
    const size_t kstep = (size_t)(BK * 2);
    const size_t hstep = (size_t)HALF * K * 2;
    const size_t tstep = 2 * hstep;
    const unsigned ldsw = (unsigned)wid * 1024u;
    const int aoff = lds_byte(wr * 64 + fr, fq * 8), boff = lds_byte(wc * 32 + fr, fq * 8);
#define PG8_SA(b, h) (((b) * 2 + (h)) * HTB)
#define PG8_SB(b, h) ((4 + (b) * 2 + (h)) * HTB)
#define PG8_STAGE(bufoff, gbase, voff) do { _Pragma("unroll") for (int _i = 0; _i < 2; ++_i) \
        __builtin_amdgcn_global_load_lds((const unsigned*)((const char*)(gbase) + (voff)[_i]), (PG8_LAS unsigned*)(lds + (bufoff) + ldsw + _i * 8192), 16, 0, 0); } while (0)
#define PG8_LDA(dst, b, h) do { _Pragma("unroll") for (int m = 0; m < 4; ++m) _Pragma("unroll") for (int k = 0; k < 2; ++k) dst[m][k] = *(const PG8_LAS bf16x8*)(lds + PG8_SA(b, h) + aoff + m * 2048 + k * 1024); } while (0)
#define PG8_LDB(dst, b, h) do { _Pragma("unroll") for (int n = 0; n < 2; ++n) _Pragma("unroll") for (int k = 0; k < 2; ++k) dst[n][k] = *(const PG8_LAS bf16x8*)(lds + PG8_SB(b, h) + boff + n * 2048 + k * 1024); } while (0)
#define PG8_MMA(ai, bj, At, Bt) do { __builtin_amdgcn_s_setprio(1); _Pragma("unroll") for (int m = 0; m < 4; ++m) _Pragma("unroll") for (int n = 0; n < 2; ++n) _Pragma("unroll") for (int k = 0; k < 2; ++k) \
        acc[ai][bj][m][n] = __builtin_amdgcn_mfma_f32_16x16x32_bf16(Bt[n][k], At[m][k], acc[ai][bj][m][n], 0, 0, 0); __builtin_amdgcn_s_setprio(0); } while (0)
#define PG8_WAIT_V(n) asm volatile("s_waitcnt vmcnt(" #n ")" ::: "memory")
#define PG8_WAIT_L(n) asm volatile("s_waitcnt lgkmcnt(" #n ")" ::: "memory")
#define PG8_BAR __builtin_amdgcn_s_barrier()
#define PG8_SCHED __builtin_amdgcn_sched_barrier(0)
    Unit cur, nxt; int ui = 0;
    if (!S.next(0, cur)) return;
    f32x4 acc[2][2][4][2];
#pragma unroll
    for (int a = 0; a < 2; ++a)
#pragma unroll
        for (int b = 0; b < 2; ++b)
#pragma unroll
            for (int m = 0; m < 4; ++m)
#pragma unroll
                for (int n = 0; n < 2; ++n) acc[a][b][m][n] = (f32x4){0.f, 0.f, 0.f, 0.f};
    bf16x8 At[4][2], B0[2][2], B1[2][2];
    const char* cA = (const char*)g.A + (size_t)cur.pm * tstep; const char* cB = (const char*)g.Bt + (size_t)cur.pn * tstep;
    S.a_ready(cur);
    if constexpr (SP2) {
        PG8_STAGE(PG8_SB(0, 0), cB, voffB); PG8_STAGE(PG8_SB(0, 1), cB + hstep, voffB); PG8_STAGE(PG8_SA(0, 0), cA, voffA); PG8_STAGE(PG8_SA(0, 1), cA + hstep, voffA);
        if (wr == 1) PG8_BAR;
        PG8_WAIT_V(2); PG8_BAR;
        PG8_STAGE(PG8_SB(1, 0), cB + kstep, voffB); PG8_STAGE(PG8_SA(1, 0), cA + kstep, voffA); PG8_STAGE(PG8_SB(1, 1), cB + hstep + kstep, voffB);
        PG8_WAIT_V(6); PG8_BAR;
    } else {
        PG8_STAGE(PG8_SB(0, 0), cB, voffB); PG8_STAGE(PG8_SA(0, 0), cA, voffA); PG8_STAGE(PG8_SB(0, 1), cB + hstep, voffB); PG8_STAGE(PG8_SA(0, 1), cA + hstep, voffA);
        if (wr == 1) PG8_BAR;
        PG8_WAIT_V(4); PG8_BAR;
        PG8_STAGE(PG8_SB(1, 0), cB + kstep, voffB); PG8_STAGE(PG8_SA(1, 0), cA + kstep, voffA); PG8_STAGE(PG8_SB(1, 1), cB + hstep + kstep, voffB);
        PG8_WAIT_V(6); PG8_BAR;
    }
    for (;;) {
        const bool has_next = S.next(ui + 1, nxt);
        const char* nA = has_next ? (const char*)g.A + (size_t)nxt.pm * tstep : cA; const char* nB = has_next ? (const char*)g.Bt + (size_t)nxt.pn * tstep : cB;
        for (int t = 0; t < nt; t += 2) {
            const bool last = (t == nt - 2);
            const char* a1 = cA + (size_t)(t + 1) * kstep;
            const char* a2 = last ? nA : cA + (size_t)(t + 2) * kstep; const char* b2 = last ? nB : cB + (size_t)(t + 2) * kstep;
            const char* a3 = a2 + kstep; const char* b3 = b2 + kstep;
            if (last && has_next) S.a_ready(nxt);
            if constexpr (SP2) {
            PG8_LDB(B0, 0, 0); PG8_LDB(B1, 0, 1); PG8_SCHED; PG8_LDA(At, 0, 0); PG8_STAGE(PG8_SA(1, 1), a1 + hstep, voffA);
            PG8_WAIT_V(8); PG8_WAIT_L(0); PG8_BAR; PG8_MMA(0, 0, At, B0); PG8_MMA(0, 1, At, B1); PG8_BAR; PG8_SCHED;
            PG8_LDA(At, 0, 1); PG8_STAGE(PG8_SB(0, 0), b2, voffB); PG8_STAGE(PG8_SB(0, 1), b2 + hstep, voffB); PG8_STAGE(PG8_SA(0, 0), a2, voffA);
            PG8_WAIT_V(8); PG8_WAIT_L(0); PG8_BAR; PG8_MMA(1, 0, At, B0); PG8_MMA(1, 1, At, B1); PG8_BAR; PG8_SCHED;
            PG8_LDB(B0, 1, 0); PG8_LDB(B1, 1, 1); PG8_SCHED; PG8_LDA(At, 1, 0); PG8_STAGE(PG8_SA(0, 1), a2 + hstep, voffA);
            PG8_WAIT_V(8); PG8_WAIT_L(0); PG8_BAR; PG8_MMA(0, 0, At, B0); PG8_MMA(0, 1, At, B1); PG8_BAR; PG8_SCHED;
            PG8_LDA(At, 1, 1); PG8_STAGE(PG8_SB(1, 0), b3, voffB); PG8_STAGE(PG8_SB(1, 1), b3 + hstep, voffB); PG8_STAGE(PG8_SA(1, 0), a3, voffA);
            PG8_WAIT_V(8); PG8_WAIT_L(0); PG8_BAR; PG8_MMA(1, 0, At, B0); PG8_MMA(1, 1, At, B1); PG8_BAR; PG8_SCHED;
            } else {
            PG8_LDB(B0, 0, 0); PG8_SCHED; PG8_LDA(At, 0, 0); PG8_STAGE(PG8_SA(1, 1), a1 + hstep, voffA);
            PG8_WAIT_L(8); PG8_BAR; PG8_WAIT_L(0); PG8_MMA(0, 0, At, B0); PG8_BAR; PG8_SCHED;
            PG8_LDB(B1, 0, 1); PG8_STAGE(PG8_SB(0, 0), b2, voffB);
            PG8_BAR; PG8_WAIT_L(0); PG8_MMA(0, 1, At, B1); PG8_BAR;
            PG8_LDA(At, 0, 1); PG8_STAGE(PG8_SA(0, 0), a2, voffA);
            PG8_BAR; PG8_WAIT_L(0); PG8_MMA(1, 0, At, B0); PG8_BAR; PG8_SCHED;
            PG8_STAGE(PG8_SB(0, 1), b2 + hstep, voffB);
            PG8_WAIT_V(6); PG8_BAR; PG8_MMA(1, 1, At, B1); PG8_BAR;
            PG8_LDB(B0, 1, 0); PG8_SCHED; PG8_LDA(At, 1, 0); PG8_STAGE(PG8_SA(0, 1), a2 + hstep, voffA);
            PG8_WAIT_L(8); PG8_BAR; PG8_WAIT_L(0); PG8_MMA(0, 0, At, B0); PG8_BAR; PG8_SCHED;
            PG8_LDB(B1, 1, 1); PG8_STAGE(PG8_SB(1, 0), b3, voffB);
            PG8_BAR; PG8_WAIT_L(0); PG8_MMA(0, 1, At, B1); PG8_BAR;
            PG8_LDA(At, 1, 1); PG8_STAGE(PG8_SA(1, 0), a3, voffA);
            PG8_BAR; PG8_WAIT_L(0); PG8_MMA(1, 0, At, B0); PG8_BAR; PG8_SCHED;
            PG8_STAGE(PG8_SB(1, 1), b3 + hstep, voffB);
            PG8_WAIT_V(6); PG8_BAR; PG8_MMA(1, 1, At, B1); PG8_BAR;
            }
        }
        if constexpr (ALIGN_EPI) { if (wr == 0) PG8_BAR; }
        if constexpr (!Epi::AFTER_DRAIN) { E(acc, cur, wr, wc, fr, fq); S.done(cur); }
        if (!has_next) break;
#pragma unroll
        for (int a = 0; a < 2; ++a)
#pragma unroll
            for (int b = 0; b < 2; ++b)
#pragma unroll
                for (int m = 0; m < 4; ++m)
#pragma unroll
                    for (int n = 0; n < 2; ++n) acc[a][b][m][n] = (f32x4){0.f, 0.f, 0.f, 0.f};
        cur = nxt; cA = nA; cB = nB; ++ui;
        if constexpr (ALIGN_EPI) { if (wr == 1) PG8_BAR; }
    }
    PG8_WAIT_V(0);
    if constexpr (!ALIGN_EPI) { if (wr == 0) PG8_BAR; }
    PG8_BAR;
    if constexpr (Epi::AFTER_DRAIN) { E.fused(acc, cur, wr, wc, fr, fq, lds, wid, lane); S.done(cur); }
#undef PG8_SA
#undef PG8_SB
#undef PG8_STAGE
#undef PG8_LDA
#undef PG8_LDB
#undef PG8_MMA
#undef PG8_WAIT_V
#undef PG8_WAIT_L
#undef PG8_BAR
#undef PG8_SCHED
}
}
constexpr int NWAVES = 8;
constexpr int BATCH = 4, SEQ = 8192, D = 2048, M = BATCH * SEQ, NIN = 4096, LW = 1024, CHUNK = 128, NCHUNK = SEQ / CHUNK;
constexpr int NEXP = 16384;
#ifndef MK_N_LAUNCHES
#define MK_N_LAUNCHES 1
#endif
constexpr int N_LAUNCHES = MK_N_LAUNCHES;
constexpr int PER_PHASE = 10;
constexpr size_t MiB = 1u << 20;
constexpr size_t WS_CTL = 0, CTL_ZERO_BYTES = 1 * MiB;
constexpr size_t WS_ROWSS = 512 * 1024;
constexpr size_t WS_WIN = 2 * MiB, WS_WOUT = 18 * MiB, WS_WQ = 26 * MiB, WS_LRUW = 34 * MiB, WS_WSB = 35 * MiB, WS_AGG = 36 * MiB;
constexpr size_t WS_U = 64 * MiB, WS_V = 128 * MiB, WS_XN = 192 * MiB  , WS_Z = 320 * MiB  ;
constexpr size_t WS_HB = 576 * MiB, WS_IDS = 704 * MiB, WS_GATES = 720 * MiB, WS_PAIRS = 736 * MiB, WS_HBT = 752 * MiB, WS_END = 880 * MiB;
constexpr size_t WS_USCALE = 40 * MiB, WS_VSCALE = 41 * MiB;
constexpr size_t WS_ROWSS2 = 640 * 1024;
constexpr size_t WS_Y = WS_Z;
constexpr int CW_BAR = 4096;
constexpr int RING_BYTES = 131072;
constexpr int LDSCTL_OFF = 143360, MISC_OFF = LDSCTL_OFF + 320;
constexpr int LDS_BYTES = 147456;
#define GAS __attribute__((address_space(1)))
#define LAS __attribute__((address_space(3)))
typedef unsigned short bf16;
typedef unsigned v4u __attribute__((ext_vector_type(4)));
typedef float f32x4 __attribute__((ext_vector_type(4)));
typedef short bf16x8 __attribute__((ext_vector_type(8)));
typedef GAS unsigned gu32;
typedef GAS unsigned long long gu64;
#define RLX_AGENT __ATOMIC_RELAXED, __HIP_MEMORY_SCOPE_AGENT
#define LDS_WAIT() asm volatile("s_waitcnt lgkmcnt(0)" ::: "memory")
#define VM_WAIT() asm volatile("s_waitcnt vmcnt(0)" ::: "memory")
__device__ __forceinline__ unsigned long long rt() { return __builtin_amdgcn_s_memrealtime(); }
__device__ __forceinline__ unsigned f2bf(float f) { unsigned u = __builtin_bit_cast(unsigned, f); return (u + 0x7fffu + ((u >> 16) & 1u)) >> 16; }
__device__ __forceinline__ unsigned pk2(float lo, float hi) { return f2bf(lo) | (f2bf(hi) << 16); }

#define XB_TMO      128
#define XB_XCNT(j)  (256  + 64 * (j))
#define XB_XSUB(j)  (1280 + 64 * (j))
#define XB_XGEN(j)  (2304 + 64 * (j))
#define XB_TOP      3328
#define XB_TOPGEN   3392
#define XCD_BAR_WORDS 3456
#define XB_SPIN_CAP (1u << 18)

__device__ __forceinline__ unsigned xb_ld(unsigned* p)              { return __hip_atomic_load(p, __ATOMIC_RELAXED, __HIP_MEMORY_SCOPE_AGENT); }
__device__ __forceinline__ unsigned xb_add(unsigned* p, unsigned v) { return __hip_atomic_fetch_add(p, v, __ATOMIC_RELAXED, __HIP_MEMORY_SCOPE_AGENT); }
__device__ __forceinline__ unsigned xb_xcc_id() { return (unsigned)__builtin_amdgcn_s_getreg((3 << 11) | 20) & 0xFu; }
#define XB_SPIN(cond, bar) do { unsigned _sp = 0; while (cond) { __builtin_amdgcn_s_sleep(1); \
    if ((++_sp & 255u) == 0u) { if (xb_ld(&(bar)[XB_TMO])) break; if (_sp > XB_SPIN_CAP) { atomicAdd(&(bar)[XB_TMO], 1u); break; } } } } while (0)

struct XcdBarrier {
    unsigned* bar; unsigned x;
    volatile LAS unsigned* st;
};

__device__ __forceinline__ XcdBarrier xcd_barrier_post(unsigned* bar, volatile LAS unsigned* st) {
    XcdBarrier b; b.bar = bar; b.x = xb_xcc_id(); b.st = st;
    if (threadIdx.x == 0) (void)xb_add(&bar[XB_XCNT(b.x)], 1u);
    return b;
}
__device__ __forceinline__ void xcd_barrier_complete(unsigned* bar, unsigned x, unsigned& nloc, unsigned& nx) {
    const unsigned G = gridDim.x * gridDim.y * gridDim.z;
    unsigned sum, cnt, mine, sp = 0u;
    for (;;) {
        sum = 0u; cnt = 0u; mine = 0u;
#pragma unroll
        for (unsigned j = 0; j < 16; ++j) { const unsigned c = xb_ld(&bar[XB_XCNT(j)]); sum += c; cnt += (c > 0u) ? 1u : 0u; mine = (j == x) ? c : mine; }
        if (sum == G) break;
        __builtin_amdgcn_s_sleep(1);
        if ((++sp & 255u) == 0u) { if (xb_ld(&bar[XB_TMO])) break; if (sp > XB_SPIN_CAP) { atomicAdd(&bar[XB_TMO], 1u); break; } }
    }
    nloc = mine > 0u ? mine : 1u; nx = cnt > 0u ? cnt : 1u;
}

__device__ __forceinline__ void xcd_barrier(const XcdBarrier& b) {
    asm volatile("s_waitcnt vmcnt(0)" ::: "memory");
    __syncthreads();
    if (threadIdx.x == 0) {
        unsigned* bar = b.bar;
        __builtin_amdgcn_s_waitcnt(0);
        unsigned nloc = b.st[0], nx = b.st[1];
        if (nloc == 0u) { xcd_barrier_complete(bar, b.x, nloc, nx); b.st[0] = nloc; b.st[1] = nx; }
        const unsigned old = xb_add(&bar[XB_XSUB(b.x)], 1u);
        const unsigned gen = old / nloc;
        if (old + 1u == (gen + 1u) * nloc) {
            __builtin_amdgcn_fence(__ATOMIC_RELEASE, "agent");
            asm volatile("s_waitcnt vmcnt(0)" ::: "memory");
            const unsigned og = xb_add(&bar[XB_TOP], 1u);
            const unsigned tg = og / nx;
            if (og + 1u == (tg + 1u) * nx) xb_add(&bar[XB_TOPGEN], 1u);
            else XB_SPIN(xb_ld(&bar[XB_TOPGEN]) == tg, bar);
            __builtin_amdgcn_fence(__ATOMIC_ACQUIRE, "agent");
            xb_add(&bar[XB_XGEN(b.x)], 1u);
            asm volatile("s_waitcnt vmcnt(0)" ::: "memory");
        } else {
            XB_SPIN(xb_ld(&bar[XB_XGEN(b.x)]) == gen, bar);
            __builtin_amdgcn_fence(__ATOMIC_ACQUIRE, "agent");
            asm volatile("s_waitcnt vmcnt(0)" ::: "memory");
        }
    }
    __syncthreads();
}
typedef unsigned v2u __attribute__((ext_vector_type(2)));
typedef float f32x2 __attribute__((ext_vector_type(2)));
struct Frame {
    LAS unsigned char* lds;
    volatile LAS unsigned* MISC;
    gu32* ctl;
    int tid, lane, wave, vcu, G;
    const float* in[21]; float* out;
    bf16 *WIN, *WOUT, *WQ, *LRUW, *WSB, *XN, *MIX, *Z, *HB, *HBT;
    unsigned char *U8, *V8T;
    float *ROWSS, *ROWSS2, *Q, *AGG, *GATES, *USCALE, *VSCALE, *Y; int* IDS; unsigned* PAIRS;
};
__device__ __forceinline__ float wave_sum(float v) {
#pragma unroll
    for (int o = 1; o < 64; o <<= 1) v += __shfl_xor(v, o);
    return v;
}
__device__ __forceinline__ float bf_lo(unsigned w) { return __builtin_bit_cast(float, w << 16); }
__device__ __forceinline__ float bf_hi(unsigned w) { return __builtin_bit_cast(float, w & 0xffff0000u); }
__device__ __forceinline__ float bf1(unsigned short h) { return __builtin_bit_cast(float, (unsigned)h << 16); }
__device__ __forceinline__ float sigmoidf_(float x) { return __builtin_amdgcn_rcpf(1.0f + __builtin_amdgcn_exp2f(-1.4426950409f * x)); }
using pg8::gelu_tanh;

__device__ __forceinline__ void p0_transpose_item(const float* W, int K, int N, bf16* WT, const float* kscale, LAS float* scr, int item, int lane) {
    const int nblk = N / 32, kb = item / nblk, nb = item % nblk, k0 = 64 * kb, n0 = 32 * nb;
#pragma unroll 8
    for (int i = 0; i < 32; ++i) { const int kk = 2 * i + (lane >> 5); const float sc = kscale ? kscale[k0 + kk] : 1.0f; scr[kk * 33 + (lane & 31)] = W[(size_t)(k0 + kk) * N + n0 + (lane & 31)] * sc; }
    LDS_WAIT(); asm volatile("" ::: "memory");
    const int c = lane & 7;
#pragma unroll
    for (int j = 0; j < 4; ++j) { const int n = (lane >> 3) + 8 * j; const LAS float* s = scr + (8 * c) * 33 + n;
        v4u o; o.x = pk2(s[0 * 33], s[1 * 33]); o.y = pk2(s[2 * 33], s[3 * 33]); o.z = pk2(s[4 * 33], s[5 * 33]); o.w = pk2(s[6 * 33], s[7 * 33]);
        *(GAS v4u*)(WT + (size_t)(n0 + n) * K + k0 + 8 * c) = o; }
    LDS_WAIT(); asm volatile("" ::: "memory");
}
__device__ __forceinline__ void p0_prologue(Frame& F) {
    LAS float* scr = (LAS float*)(F.lds + F.wave * 16384);
    const int gw = F.vcu * NWAVES + F.wave, NGW = F.G * NWAVES, lane = F.lane;
    constexpr int I_IN = (D / 64) * (NIN / 32), I_OUT = (D / 64) * (D / 32), I_Q = I_OUT, I_LRU = 32 * 8;
    constexpr int NITEMS = I_IN + I_OUT + I_Q + I_LRU;
    for (int it = gw; it < NITEMS; it += NGW) {
        int r = it;
        if (r < I_IN) { p0_transpose_item(F.in[2], D, NIN, F.WIN, F.in[1], scr, r, lane); continue; } r -= I_IN;
        if (r < I_OUT) { p0_transpose_item(F.in[14], D, D, F.WOUT, nullptr, scr, r, lane); continue; } r -= I_OUT;
        if (r < I_Q) { p0_transpose_item(F.in[16], D, D, F.WQ, F.in[15], scr, r, lane); continue; } r -= I_Q;
        { const int mi = r >> 3, sub = r & 7, gate = mi >> 4, rest = mi & 15;
          const float* src = (gate ? F.in[7] : F.in[5]) + (size_t)rest * 16384;
          p0_transpose_item(src, 128, 128, F.LRUW + (size_t)mi * 16384, nullptr, scr, sub, lane); }
    }
    const size_t gt = (size_t)gw * 64 + lane, NGT = (size_t)NGW * 64;
    {
        const float* g2 = F.in[15];
        f32x4 gg[8];
#pragma unroll
        for (int j = 0; j < 8; ++j) gg[j] = *(const GAS f32x4*)(g2 + j * 256 + lane * 4);
        for (int e = gw; e < NEXP; e += NGW) {
            const GAS f32x4* ur = (const GAS f32x4*)(F.in[18] + (size_t)e * D) + lane;
            f32x4 v[8]; float mx = 0.f;
#pragma unroll
            for (int j = 0; j < 8; ++j) { v[j] = ur[64 * j] * gg[j]; mx = fmaxf(mx, fmaxf(fmaxf(fabsf(v[j].x), fabsf(v[j].y)), fmaxf(fabsf(v[j].z), fabsf(v[j].w)))); }
#pragma unroll
            for (int o = 1; o < 64; o <<= 1) mx = fmaxf(mx, __shfl_xor(mx, o));
            const float sc = mx > 0.f ? 256.0f / mx : 1.0f;
            GAS unsigned* o4 = (GAS unsigned*)(F.U8 + (size_t)e * D) + lane;
#pragma unroll
            for (int j = 0; j < 8; ++j) { int w = 0; w = __builtin_amdgcn_cvt_pk_fp8_f32(v[j].x * sc, v[j].y * sc, w, false); w = __builtin_amdgcn_cvt_pk_fp8_f32(v[j].z * sc, v[j].w * sc, w, true); o4[64 * j] = (unsigned)w; }
            if (lane == 0) F.USCALE[e] = mx > 0.f ? mx * (1.0f / 256.0f) : 1.0f;
        }
    }
    __syncthreads();
    for (int un = blockIdx.x; un < NEXP / 64; un += F.G) {
        const int e0 = un * 64;
        for (int rr = 0; rr < 8; ++rr) {
            const int el = F.wave * 8 + rr, e = e0 + el;
            const GAS f32x4* vr = (const GAS f32x4*)(F.in[19] + (size_t)e * D) + lane;
            f32x4 v[8]; float mx = 0.f;
#pragma unroll
            for (int j = 0; j < 8; ++j) { v[j] = vr[64 * j]; mx = fmaxf(mx, fmaxf(fmaxf(fabsf(v[j].x), fabsf(v[j].y)), fmaxf(fabsf(v[j].z), fabsf(v[j].w)))); }
#pragma unroll
            for (int o = 1; o < 64; o <<= 1) mx = fmaxf(mx, __shfl_xor(mx, o));
            const float sc = mx > 0.f ? 256.0f / mx : 1.0f;
#pragma unroll
            for (int j = 0; j < 8; ++j) { int w = 0; w = __builtin_amdgcn_cvt_pk_fp8_f32(v[j].x * sc, v[j].y * sc, w, false); w = __builtin_amdgcn_cvt_pk_fp8_f32(v[j].z * sc, v[j].w * sc, w, true);
                *(LAS unsigned*)(F.lds + el * 2056 + j * 256 + lane * 4) = (unsigned)w; }
            if (lane == 0) F.VSCALE[e] = mx > 0.f ? mx * (1.0f / 256.0f) : 1.0f;
        }
        __syncthreads();
        for (int cc = 0; cc < 32; ++cc) { const int c = F.wave * 32 + cc;
            const v2u w = *(const LAS v2u*)(F.lds + lane * 2056 + c * 8);
            *(GAS v2u*)(F.V8T + ((size_t)c * NEXP + e0 + lane) * 8) = w; }
        __syncthreads();
    }
    for (size_t ch = gt; ch < (size_t)8 * 128 * 128 / 8; ch += NGT) {
        const size_t e0 = ch * 8;
        const f32x4 a = *(const GAS f32x4*)(F.in[12] + e0), b = *(const GAS f32x4*)(F.in[12] + e0 + 4);
        v4u o; o.x = pk2(a.x, a.y); o.y = pk2(a.z, a.w); o.z = pk2(b.x, b.y); o.w = pk2(b.z, b.w);
        *(GAS v4u*)(F.WSB + e0) = o;
    }
    for (int m = gw; m < M; m += NGW) {
        const GAS f32x4* xr = (const GAS f32x4*)(F.in[0] + (size_t)m * D) + lane;
        f32x4 v[8]; float s = 0.f;
#pragma unroll
        for (int j = 0; j < 8; ++j) { v[j] = xr[64 * j]; s += (v[j].x * v[j].x + v[j].y * v[j].y) + (v[j].z * v[j].z + v[j].w * v[j].w); }
        const float rstd = __builtin_amdgcn_rsqf(wave_sum(s) * (1.f / D) + 1e-6f);
        GAS unsigned long long* o8 = (GAS unsigned long long*)(F.XN + (size_t)m * D) + lane;
#pragma unroll
        for (int j = 0; j < 8; ++j) o8[64 * j] = (unsigned long long)pk2(v[j].x * rstd, v[j].y * rstd) | ((unsigned long long)pk2(v[j].z * rstd, v[j].w * rstd) << 32);
    }
}
constexpr int LRU_XR = 0, LRU_XC = 33792, LRU_GR = 33792 + 34816;
constexpr float LOG2E = 1.4426950408889634f;

template <bool APPLY, int DIR>
__device__ __forceinline__ void lru_dir(Frame& F, int b, int c, int h, float (&hsum)[8][4]) {
    const int lane = F.lane, w = F.wave, fr = lane & 15, fq = lane >> 4;
    LAS unsigned char* XC = F.lds + LRU_XC;
    const int chl = 16 * w + fr, chg = h * 128 + chl;
    bf16x8 Ba[4], Bx[4];
    {
        const bf16* wa = F.LRUW + (size_t)((0 * 2 + DIR) * 8 + h) * 16384 + (size_t)chl * 128 + 8 * fq;
        const bf16* wx = F.LRUW + (size_t)((1 * 2 + DIR) * 8 + h) * 16384 + (size_t)chl * 128 + 8 * fq;
#pragma unroll
        for (int ks = 0; ks < 4; ++ks) { Ba[ks] = *(const GAS bf16x8*)(wa + 32 * ks); Bx[ks] = *(const GAS bf16x8*)(wx + 32 * ks); }
    }
    const float ba = F.in[6][DIR * LW + chg], bx = F.in[8][DIR * LW + chg], lam = F.in[9][DIR * LW + chg];
    const float cl = -8.0f * log1pf(__expf(-lam)) * LOG2E;
    float carry = 0.f;
    if (APPLY) {
        const f32x2* agg = (const f32x2*)F.AGG + (size_t)((b * 2 + DIR) * NCHUNK) * LW + chg;
        if (DIR == 0) {
#pragma unroll 4
            for (int cc = 0; cc < c; ++cc) { const f32x2 pe = agg[(size_t)cc * LW]; carry = pe.x * carry + pe.y; } }
        else {
#pragma unroll 4
            for (int cc = NCHUNK - 1; cc > c; --cc) { const f32x2 pe = agg[(size_t)cc * LW]; carry = pe.x * carry + pe.y; } }
    }
    float totA = 1.f, totB = 0.f;
    const int src1 = DIR == 0 ? lane - 16 : lane + 16, src2 = DIR == 0 ? lane - 32 : lane + 32;
    const bool v1 = DIR == 0 ? (fq >= 1) : (fq <= 2), v2 = DIR == 0 ? (fq >= 2) : (fq <= 1);
    const int lastl = DIR == 0 ? fr + 48 : fr;
#pragma unroll
    for (int mm = 0; mm < 8; ++mm) {
        const int m = DIR == 0 ? mm : 7 - mm;
        f32x4 R = (f32x4){0.f, 0.f, 0.f, 0.f}, I = (f32x4){0.f, 0.f, 0.f, 0.f};
#pragma unroll
        for (int ks = 0; ks < 4; ++ks) {
            const bf16x8 a = *(const LAS bf16x8*)(XC + (16 * m + fr) * 272 + (32 * ks + 8 * fq) * 2);
            R = __builtin_amdgcn_mfma_f32_16x16x32_bf16(a, Ba[ks], R, 0, 0, 0);
            I = __builtin_amdgcn_mfma_f32_16x16x32_bf16(a, Bx[ks], I, 0, 0, 0);
        }
#pragma unroll
        for (int j = 0; j < 4; ++j) {
            const float r = sigmoidf_(R[j] + ba), ig = sigmoidf_(I[j] + bx);
            const float a = __builtin_amdgcn_exp2f(cl * r);
            const float xc = bf1(*(const LAS unsigned short*)(XC + (16 * m + 4 * fq + j) * 272 + chl * 2));
            const float om = fmaxf(1.0f - a * a, 0.0f);
            R[j] = a; I[j] = __builtin_amdgcn_sqrtf(om) * (ig * xc);
        }
        float A = 1.f, B = 0.f;
#pragma unroll
        for (int jj = 0; jj < 4; ++jj) { const int j = DIR == 0 ? jj : 3 - jj; B = R[j] * B + I[j]; A = R[j] * A; }
        { const float pa = __shfl(A, src1), pb = __shfl(B, src1); if (v1) { B = A * pb + B; A = A * pa; } }
        { const float pa = __shfl(A, src2), pb = __shfl(B, src2); if (v2) { B = A * pb + B; A = A * pa; } }
        const float TA = __shfl(A, lastl), TB = __shfl(B, lastl);
        if (APPLY) {
            float EA = __shfl(A, src1), EB = __shfl(B, src1); if (!v1) { EA = 1.f; EB = 0.f; }
            float hh = EA * carry + EB;
#pragma unroll
            for (int jj = 0; jj < 4; ++jj) { const int j = DIR == 0 ? jj : 3 - jj; hh = R[j] * hh + I[j]; if (DIR == 0) hsum[m][j] = hh; else hsum[m][j] += hh; }
            carry = TA * carry + TB;
        } else { totB = TA * totB + TB; totA = TA * totA; }
    }
    if (!APPLY) { if (fq == 0) { f32x2* agg = (f32x2*)F.AGG + (size_t)((b * 2 + DIR) * NCHUNK + c) * LW + chg; *agg = (f32x2){totA, totB}; } }
}

template <bool APPLY>
__device__ __forceinline__ void lru_unit(Frame& F, int unit) {
    const int h = unit & 7, c = (unit >> 3) & 63, b = unit >> 9;
    const int tid = F.tid, lane = F.lane, w = F.wave, fr = lane & 15, fq = lane >> 4;
    const size_t t0 = (size_t)b * SEQ + (size_t)c * CHUNK;
    LAS unsigned char* XR = F.lds + LRU_XR; LAS unsigned char* XC = F.lds + LRU_XC; LAS unsigned char* GR = F.lds + LRU_GR;
    for (int p = tid; p < 131 * 16; p += 512) { const int r = p >> 4, cg = p & 15; const int s = c * CHUNK - 2 + r; v4u v = (v4u){0u, 0u, 0u, 0u};
        if (s >= 0 && s < SEQ) v = *(const GAS v4u*)(F.Z + ((size_t)b * SEQ + s) * NIN + h * 128 + cg * 8);
        *(LAS v4u*)(XR + r * 256 + cg * 16) = v; }
    if (APPLY) { for (int p = tid; p < 128 * 32; p += 512) { const int r = p >> 5, cg = p & 31;
        *(LAS v2u*)(GR + r * 264 + cg * 8) = *(const GAS v2u*)(F.Z + (t0 + r) * NIN + LW + h * 128 + cg * 4); } }
    __syncthreads();
    {
        const int ch2 = tid & 63, tg = tid >> 6, chg = h * 128 + 2 * ch2;
        float w0[4], w1[4];
#pragma unroll
        for (int k = 0; k < 4; ++k) { w0[k] = F.in[3][k * LW + chg]; w1[k] = F.in[3][k * LW + chg + 1]; }
        const float b0 = F.in[4][chg], b1 = F.in[4][chg + 1];
        float x0[4], x1[4];
#pragma unroll
        for (int k = 0; k < 3; ++k) { const unsigned u = *(const LAS unsigned*)(XR + (16 * tg + k) * 256 + ch2 * 4); x0[k] = bf_lo(u); x1[k] = bf_hi(u); }
#pragma unroll
        for (int j = 0; j < 16; ++j) {
            const unsigned u = *(const LAS unsigned*)(XR + (16 * tg + j + 3) * 256 + ch2 * 4); x0[3] = bf_lo(u); x1[3] = bf_hi(u);
            const float y0 = b0 + ((w0[0] * x0[0] + w0[1] * x0[1]) + (w0[2] * x0[2] + w0[3] * x0[3]));
            const float y1 = b1 + ((w1[0] * x1[0] + w1[1] * x1[1]) + (w1[2] * x1[2] + w1[3] * x1[3]));
            *(LAS unsigned*)(XC + (16 * tg + j) * 272 + ch2 * 4) = pk2(y0, y1);
            x0[0] = x0[1]; x0[1] = x0[2]; x0[2] = x0[3]; x1[0] = x1[1]; x1[1] = x1[2]; x1[2] = x1[3];
        }
    }
    __syncthreads();
    float hsum[8][4];
    lru_dir<APPLY, 0>(F, b, c, h, hsum);
    asm volatile("" ::: "memory"); __builtin_amdgcn_sched_barrier(0);
    lru_dir<APPLY, 1>(F, b, c, h, hsum);
    if (APPLY) {
        const int chl = 16 * w + fr;
#pragma unroll
        for (int m = 0; m < 8; ++m)
#pragma unroll
            for (int j = 0; j < 4; ++j) { LAS unsigned short* p = (LAS unsigned short*)(GR + (16 * m + 4 * fq + j) * 264 + chl * 2); *p = (unsigned short)f2bf(bf1(*p) * hsum[m][j]); }
        __syncthreads();
        for (int p = tid; p < 128 * 32; p += 512) { const int r = p >> 5, cg = p & 31;
            *(GAS v2u*)(F.MIX + (t0 + r) * D + h * 128 + cg * 4) = *(const LAS v2u*)(GR + r * 264 + cg * 8); }
    }
    __syncthreads();
}
constexpr int GM_ST = 0, GM_BS = 1024, GM_VT = 2048, GM_GU = 2048 + 34816;
__device__ __forceinline__ void gmlp_unit(Frame& F, int unit) {
    const int tid = F.tid, lane = F.lane, w = F.wave, fr = lane & 15, fq = lane >> 4;
    const size_t t0 = (size_t)unit * CHUNK;
    LAS float* ST = (LAS float*)(F.lds + GM_ST); LAS float* BS = (LAS float*)(F.lds + GM_BS);
    LAS unsigned char* VT = F.lds + GM_VT; LAS unsigned char* GU = F.lds + GM_GU;
    for (int rr = 0; rr < 16; ++rr) {
        const int row = 16 * w + rr;
        const bf16* p = F.Z + (t0 + row) * NIN + 3 * LW + lane * 8;
        const v4u a = *(const GAS v4u*)p, b = *(const GAS v4u*)(p + 512);
        float x[16] = {bf_lo(a.x), bf_hi(a.x), bf_lo(a.y), bf_hi(a.y), bf_lo(a.z), bf_hi(a.z), bf_lo(a.w), bf_hi(a.w),
                       bf_lo(b.x), bf_hi(b.x), bf_lo(b.y), bf_hi(b.y), bf_lo(b.z), bf_hi(b.z), bf_lo(b.w), bf_hi(b.w)};
        float s = 0.f;
#pragma unroll
        for (int i = 0; i < 16; ++i) s += x[i];
        const float mean = wave_sum(s) * (1.0f / LW);
        float q = 0.f;
#pragma unroll
        for (int i = 0; i < 16; ++i) { const float d = x[i] - mean; q += d * d; }
        const float rstd = __builtin_amdgcn_rsqf(wave_sum(q) * (1.0f / LW) + 1e-6f);
        if (lane == 0) { ST[2 * row] = mean; ST[2 * row + 1] = rstd; }
    }
    __syncthreads();
    for (int h = 0; h < 8; ++h) {
#pragma unroll
        for (int i = 0; i < 4; ++i) { const int pid = tid + 512 * i, q = pid >> 4, cg = pid & 15;
            const v4u a = *(const GAS v4u*)(F.Z + (t0 + q) * NIN + 3 * LW + h * 128 + cg * 8);
            const float mean = ST[2 * q], rstd = ST[2 * q + 1];
            const f32x4 g0 = *(const GAS f32x4*)(F.in[10] + h * 128 + cg * 8), g1 = *(const GAS f32x4*)(F.in[10] + h * 128 + cg * 8 + 4);
            const f32x4 b0 = *(const GAS f32x4*)(F.in[11] + h * 128 + cg * 8), b1 = *(const GAS f32x4*)(F.in[11] + h * 128 + cg * 8 + 4);
            const float x[8] = {bf_lo(a.x), bf_hi(a.x), bf_lo(a.y), bf_hi(a.y), bf_lo(a.z), bf_hi(a.z), bf_lo(a.w), bf_hi(a.w)};
            const float g[8] = {g0.x, g0.y, g0.z, g0.w, g1.x, g1.y, g1.z, g1.w}, bb[8] = {b0.x, b0.y, b0.z, b0.w, b1.x, b1.y, b1.z, b1.w};
#pragma unroll
            for (int e = 0; e < 8; ++e) *(LAS unsigned short*)(VT + (cg * 8 + e) * 272 + q * 2) = (unsigned short)f2bf((x[e] - mean) * rstd * g[e] + bb[e]);
        }
#pragma unroll
        for (int i = 0; i < 8; ++i) { const int pid = tid + 512 * i, r = pid >> 5, cg = pid & 31;
            *(LAS v2u*)(GU + r * 264 + cg * 8) = *(const GAS v2u*)(F.Z + (t0 + r) * NIN + 2 * LW + h * 128 + cg * 4); }
        if (tid < 128) BS[tid] = F.in[13][h * 128 + tid];
        __syncthreads();
        bf16x8 Bf[4];
#pragma unroll
        for (int ks = 0; ks < 4; ++ks) Bf[ks] = *(const LAS bf16x8*)(VT + (16 * w + fr) * 272 + (32 * ks + 8 * fq) * 2);
        f32x4 acc[8];
#pragma unroll
        for (int m = 0; m < 8; ++m) acc[m] = (f32x4){0.f, 0.f, 0.f, 0.f};
        const bf16* wsb = F.WSB + (size_t)h * 16384 + fr * 128 + 8 * fq;
#pragma unroll
        for (int m = 0; m < 8; ++m)
#pragma unroll
            for (int ks = 0; ks < 4; ++ks) { const bf16x8 a = *(const GAS bf16x8*)(wsb + (16 * m) * 128 + 32 * ks); acc[m] = __builtin_amdgcn_mfma_f32_16x16x32_bf16(a, Bf[ks], acc[m], 0, 0, 0); }
        const int cidx = 16 * w + fr;
#pragma unroll
        for (int m = 0; m < 8; ++m)
#pragma unroll
            for (int j = 0; j < 4; ++j) { const int p = 16 * m + 4 * fq + j; LAS unsigned short* ad = (LAS unsigned short*)(GU + p * 264 + cidx * 2);
                *ad = (unsigned short)f2bf(bf1(*ad) * (acc[m][j] + BS[p])); }
        __syncthreads();
#pragma unroll
        for (int i = 0; i < 8; ++i) { const int pid = tid + 512 * i, r = pid >> 5, cg = pid & 31;
            *(GAS v2u*)(F.MIX + (t0 + r) * D + LW + h * 128 + cg * 4) = *(const LAS v2u*)(GU + r * 264 + cg * 8); }
        __syncthreads();
    }
}
typedef float f32x16 __attribute__((ext_vector_type(16)));
__device__ __forceinline__ unsigned fkey(float f) { const unsigned u = __builtin_bit_cast(unsigned, f); return (u & 0x80000000u) ? ~u : (u | 0x80000000u); }
__device__ __forceinline__ float fkey_inv(unsigned k) { const unsigned u = (k & 0x80000000u) ? (k & 0x7fffffffu) : ~k; return __builtin_bit_cast(float, u); }
__device__ __forceinline__ unsigned umax_(unsigned a, unsigned b) { return a > b ? a : b; }
__device__ __forceinline__ unsigned umin_(unsigned a, unsigned b) { return a < b ? a : b; }
__device__ __forceinline__ void topk_unit(Frame& F, int wu) {
    const int tg = wu >> 3, hd = wu & 7, lane = F.lane, r = lane & 31, hh = lane >> 5;
    const int t = tg * 32 + r;
    const float* qrow = F.Q + (size_t)t * D + hd * 256 + 4 * hh;
    unsigned L[2][16];
#pragma unroll
    for (int p = 0; p < 2; ++p) {
        f32x16 acc[4];
#pragma unroll
        for (int nt = 0; nt < 4; ++nt)
#pragma unroll
            for (int i = 0; i < 16; ++i) acc[nt][i] = 0.f;
        const float* kbase = F.in[17] + ((size_t)(hd * 2 + p) * 128 + r) * 128 + 4 * hh;
        f32x4 qc = *(const GAS f32x4*)(qrow + p * 128), ac[4];
#pragma unroll
        for (int nt = 0; nt < 4; ++nt) ac[nt] = *(const GAS f32x4*)(kbase + (size_t)nt * 32 * 128);
#pragma unroll 1
        for (int s = 0; s < 16; ++s) {
            const int sn = (s + 1) & 15;
            const f32x4 qn = *(const GAS f32x4*)(qrow + p * 128 + 8 * sn);
            f32x4 an[4];
#pragma unroll
            for (int nt = 0; nt < 4; ++nt) an[nt] = *(const GAS f32x4*)(kbase + (size_t)nt * 32 * 128 + 8 * sn);
#pragma unroll
            for (int j = 0; j < 4; ++j)
#pragma unroll
                for (int nt = 0; nt < 4; ++nt) acc[nt] = __builtin_amdgcn_mfma_f32_32x32x2f32(ac[nt][j], qc[j], acc[nt], 0, 0, 0);
            qc = qn;
#pragma unroll
            for (int nt = 0; nt < 4; ++nt) ac[nt] = an[nt];
        }
        unsigned Lp[16];
#pragma unroll
        for (int i = 0; i < 16; ++i) Lp[i] = 0u;
#pragma unroll
        for (int nt = 0; nt < 4; ++nt)
#pragma unroll
            for (int rg = 0; rg < 16; ++rg) {
                const int n = 32 * nt + (rg & 3) + 8 * (rg >> 2) + 4 * hh;
                unsigned key = (fkey(acc[nt][rg]) & ~0x7Fu) | (unsigned)(127 - n);
#pragma unroll
                for (int i = 0; i < 16; ++i) { const unsigned mx = umax_(Lp[i], key), mn = umin_(Lp[i], key); Lp[i] = mx; key = mn; }
            }
        unsigned T[16];
#pragma unroll
        for (int i = 0; i < 16; ++i) T[i] = (unsigned)__shfl_xor((int)Lp[15 - i], 32);
#pragma unroll
        for (int i = 0; i < 16; ++i) T[i] = umax_(Lp[i], T[i]);
#pragma unroll
        for (int st = 8; st >= 1; st >>= 1)
#pragma unroll
            for (int i = 0; i < 16; ++i) if ((i & st) == 0) { const unsigned a_ = T[i], b_ = T[i + st]; T[i] = umax_(a_, b_); T[i + st] = umin_(a_, b_); }
#pragma unroll
        for (int i = 0; i < 16; ++i) L[p][i] = T[i];
    }
    float v0[16], v1[16];
#pragma unroll
    for (int i = 0; i < 16; ++i) { v0[i] = fkey_inv(L[0][i] & ~0x7Fu); v1[i] = fkey_inv(L[1][i] & ~0x7Fu); }
    unsigned best[16];
#pragma unroll
    for (int i = 0; i < 16; ++i) best[i] = 0u;
#pragma unroll
    for (int i = 0; i < 16; ++i)
#pragma unroll
        for (int j = 0; j < 16; ++j) if ((i + 1) * (j + 1) <= 16) {
            unsigned key = (fkey(v0[i] + v1[j]) & ~0xFFu) | (unsigned)(255 - (i * 16 + j));
#pragma unroll
            for (int k = 0; k < 16; ++k) { const unsigned mx = umax_(best[k], key), mn = umin_(best[k], key); best[k] = mx; key = mn; }
        }
    float sv[16]; int ids[16];
    const float smax = fkey_inv(best[0] & ~0xFFu);
    float ssum = 0.f;
#pragma unroll
    for (int k = 0; k < 16; ++k) {
        const unsigned pos = 255u - (best[k] & 0xFFu); const unsigned ii = pos >> 4, jj = pos & 15u;
        unsigned k0 = L[0][0], k1 = L[1][0];
#pragma unroll
        for (int i = 1; i < 16; ++i) { k0 = (ii == (unsigned)i) ? L[0][i] : k0; k1 = (jj == (unsigned)i) ? L[1][i] : k1; }
        ids[k] = (int)((127u - (k0 & 0x7Fu)) * 128u + (127u - (k1 & 0x7Fu)));
        sv[k] = __builtin_amdgcn_exp2f((fkey_inv(best[k] & ~0xFFu) - smax) * 1.4426950409f); ssum += sv[k];
    }
    const float inv = 1.0f / ssum;
    if (hh == 0) {
        int* o = F.IDS + (size_t)t * 128 + hd * 16;
#pragma unroll
        for (int k = 0; k < 16; k += 4) *(GAS v4u*)(o + k) = (v4u){(unsigned)ids[k], (unsigned)ids[k + 1], (unsigned)ids[k + 2], (unsigned)ids[k + 3]};
    } else {
        float* o = F.GATES + (size_t)t * 128 + hd * 16;
#pragma unroll
        for (int k = 0; k < 16; k += 4) *(GAS f32x4*)(o + k) = (f32x4){sv[k] * inv, sv[k + 1] * inv, sv[k + 2] * inv, sv[k + 3] * inv};
    }
}
__device__ __forceinline__ float dot16_fp8(const v4u u, const float* x) {
    const f32x2 a0 = __builtin_amdgcn_cvt_pk_f32_fp8((int)u.x, false), a1 = __builtin_amdgcn_cvt_pk_f32_fp8((int)u.x, true);
    const f32x2 b0 = __builtin_amdgcn_cvt_pk_f32_fp8((int)u.y, false), b1 = __builtin_amdgcn_cvt_pk_f32_fp8((int)u.y, true);
    const f32x2 c0 = __builtin_amdgcn_cvt_pk_f32_fp8((int)u.z, false), c1 = __builtin_amdgcn_cvt_pk_f32_fp8((int)u.z, true);
    const f32x2 d0 = __builtin_amdgcn_cvt_pk_f32_fp8((int)u.w, false), d1 = __builtin_amdgcn_cvt_pk_f32_fp8((int)u.w, true);
    return ((a0.x * x[0] + a0.y * x[1]) + (a1.x * x[2] + a1.y * x[3])) + ((b0.x * x[4] + b0.y * x[5]) + (b1.x * x[6] + b1.y * x[7]))
         + ((c0.x * x[8] + c0.y * x[9]) + (c1.x * x[10] + c1.y * x[11])) + ((d0.x * x[12] + d0.y * x[13]) + (d1.x * x[14] + d1.y * x[15]));
}
__device__ __forceinline__ void peer_u_token(Frame& F, int t) {
    const int lane = F.lane;
    float hx[32];
    {
        const bf16* hp = F.HB + (size_t)t * D + lane * 16;
#pragma unroll
        for (int c = 0; c < 2; ++c)
#pragma unroll
            for (int q = 0; q < 2; ++q) { const v4u a = *(const GAS v4u*)(hp + c * 1024 + q * 8); float* x = hx + c * 16 + q * 8;
                x[0] = bf_lo(a.x); x[1] = bf_hi(a.x); x[2] = bf_lo(a.y); x[3] = bf_hi(a.y); x[4] = bf_lo(a.z); x[5] = bf_hi(a.z); x[6] = bf_lo(a.w); x[7] = bf_hi(a.w); }
    }
    const float rstd = __builtin_amdgcn_rsqf(F.ROWSS[t] * (1.0f / D) + 1e-6f);
    const bool b5 = (lane & 32) != 0, b4 = (lane & 16) != 0, b3 = (lane & 8) != 0;
    const int psel = (b5 ? 4 : 0) + (b4 ? 2 : 0) + (b3 ? 1 : 0);
    unsigned* pout = F.PAIRS + (size_t)(t >> 6) * 128 * 64 + (t & 63);
#pragma unroll 1
    for (int half = 0; half < 2; ++half) {
        const int idv = F.IDS[(size_t)t * 128 + half * 64 + lane];
        const float gv = F.GATES[(size_t)t * 128 + half * 64 + lane];
#pragma unroll 1
        for (int kb = 0; kb < 64; kb += 8) {
            v4u ur[8][2];
#pragma unroll
            for (int u = 0; u < 8; ++u) { const int e = __builtin_amdgcn_readlane(idv, kb + u);
                const unsigned char* rp = F.U8 + (size_t)e * D + lane * 16;
                ur[u][0] = *(const GAS v4u*)rp; ur[u][1] = *(const GAS v4u*)(rp + 1024); }
            float d[8];
#pragma unroll
            for (int u = 0; u < 8; ++u) d[u] = dot16_fp8(ur[u][0], hx) + dot16_fp8(ur[u][1], hx + 16);
            float w4[4], w2[2], w1;
#pragma unroll
            for (int i = 0; i < 4; ++i) { const float send = b5 ? d[i] : d[i + 4], keep = b5 ? d[i + 4] : d[i]; w4[i] = keep + __shfl_xor(send, 32); }
#pragma unroll
            for (int i = 0; i < 2; ++i) { const float send = b4 ? w4[i] : w4[i + 2], keep = b4 ? w4[i + 2] : w4[i]; w2[i] = keep + __shfl_xor(send, 16); }
            { const float send = b3 ? w2[0] : w2[1], keep = b3 ? w2[1] : w2[0]; w1 = keep + __shfl_xor(send, 8); }
            w1 += __shfl_xor(w1, 4); w1 += __shfl_xor(w1, 2); w1 += __shfl_xor(w1, 1);
            const int e = __shfl(idv, kb + psel); const float g = __shfl(gv, kb + psel);
            const float act = gelu_tanh(w1 * rstd * F.USCALE[e]) * g * F.VSCALE[e];
            if ((lane & 7) == 0) pout[(size_t)(half * 64 + kb + psel) * 64] = (f2bf(act) << 16) | (unsigned)e;
        }
    }
}
__device__ __forceinline__ void peer_v_slice(Frame& F, int c) {
    const int tid = F.tid, lane = F.lane;
    for (int i = tid; i < NEXP * 8 / 16; i += 512) *(LAS v4u*)(F.lds + i * 16) = *(const GAS v4u*)(F.V8T + (size_t)c * NEXP * 8 + (size_t)i * 16);
    __syncthreads();
    for (int blk = F.wave; blk < M / 64; blk += NWAVES) {
        const int t = blk * 64 + lane;
        const unsigned* pp = F.PAIRS + (size_t)blk * 128 * 64 + lane;
        float acc[8];
#pragma unroll
        for (int i = 0; i < 8; ++i) acc[i] = 0.f;
#pragma unroll 8
        for (int k = 0; k < 128; ++k) {
            const unsigned p = pp[k * 64];
            const float a = __builtin_bit_cast(float, p & 0xffff0000u);
            const v2u w = *(const LAS v2u*)(F.lds + (p & 0x3fffu) * 8);
            const f32x2 f0 = __builtin_amdgcn_cvt_pk_f32_fp8((int)w.x, false), f1 = __builtin_amdgcn_cvt_pk_f32_fp8((int)w.x, true);
            const f32x2 f2 = __builtin_amdgcn_cvt_pk_f32_fp8((int)w.y, false), f3 = __builtin_amdgcn_cvt_pk_f32_fp8((int)w.y, true);
            acc[0] += a * f0.x; acc[1] += a * f0.y; acc[2] += a * f1.x; acc[3] += a * f1.y;
            acc[4] += a * f2.x; acc[5] += a * f2.y; acc[6] += a * f3.x; acc[7] += a * f3.y;
        }
        const v4u hb = *(const GAS v4u*)(F.HBT + ((size_t)c * M + t) * 8);
        acc[0] += bf_lo(hb.x); acc[1] += bf_hi(hb.x); acc[2] += bf_lo(hb.y); acc[3] += bf_hi(hb.y);
        acc[4] += bf_lo(hb.z); acc[5] += bf_hi(hb.z); acc[6] += bf_lo(hb.w); acc[7] += bf_hi(hb.w);
        float* yp = F.Y + ((size_t)c * M + t) * 8;
        *(GAS f32x4*)yp = (f32x4){acc[0], acc[1], acc[2], acc[3]}; *(GAS f32x4*)(yp + 4) = (f32x4){acc[4], acc[5], acc[6], acc[7]};
        float ss = 0.f;
#pragma unroll
        for (int i = 0; i < 8; ++i) ss += acc[i] * acc[i];
        atomicAdd(F.ROWSS2 + t, ss);
    }
    __syncthreads();
}
__device__ __forceinline__ void final_unit(Frame& F, int unit) {
    const int tid = F.tid, blk = unit >> 3, cg = unit & 7, t0 = blk * 64;
    LAS float* T = (LAS float*)F.lds;
#pragma unroll
    for (int i = 0; i < 8; ++i) { const int pid = tid + 512 * i, cl = pid >> 7, tok = (pid >> 1) & 63, hf = pid & 1;
        const f32x4 v = *(const GAS f32x4*)(F.Y + ((size_t)(cg * 32 + cl) * M + t0 + tok) * 8 + hf * 4);
        *(LAS f32x4*)(T + tok * 260 + cl * 8 + hf * 4) = v; }
    __syncthreads();
#pragma unroll
    for (int i = 0; i < 8; ++i) { const int pid = tid + 512 * i, tok = pid >> 6, c4 = pid & 63;
        const float rs = __builtin_amdgcn_rsqf(F.ROWSS2[t0 + tok] * (1.0f / D) + 1e-6f);
        const f32x4 v = *(const LAS f32x4*)(T + tok * 260 + c4 * 4);
        const f32x4 g = *(const GAS f32x4*)(F.in[20] + cg * 256 + c4 * 4);
        *(GAS f32x4*)(F.out + (size_t)(t0 + tok) * D + cg * 256 + c4 * 4) = v * rs * g; }
    __syncthreads();
}
struct Args { const float* in[21]; float* out; unsigned char* ws; int ph_lo, ph_hi; };
__global__ void __launch_bounds__(NWAVES * 64, 2) mk_fwd(Args args) {
    extern __shared__ __attribute__((aligned(16))) unsigned char lds[];
    Frame F;
    F.lds = (LAS unsigned char*)lds;
    F.MISC = (volatile LAS unsigned*)(F.lds + MISC_OFF);
    F.tid = threadIdx.x; F.lane = F.tid & 63; F.wave = __builtin_amdgcn_readfirstlane(F.tid >> 6);
    F.G = gridDim.x; { const int bx = blockIdx.x; F.vcu = (F.G % 8 == 0) ? (bx % 8) * (F.G / 8) + bx / 8 : bx; }
    unsigned char* ws = args.ws;
    F.ctl = (gu32*)(ws + WS_CTL);
#pragma unroll
    for (int i = 0; i < 21; ++i) F.in[i] = args.in[i];
    F.out = args.out;
    F.WIN = (bf16*)(ws + WS_WIN); F.WOUT = (bf16*)(ws + WS_WOUT); F.WQ = (bf16*)(ws + WS_WQ); F.LRUW = (bf16*)(ws + WS_LRUW); F.WSB = (bf16*)(ws + WS_WSB);
    F.U8 = ws + WS_U; F.V8T = ws + WS_V; F.HBT = (bf16*)(ws + WS_HBT); F.USCALE = (float*)(ws + WS_USCALE); F.VSCALE = (float*)(ws + WS_VSCALE);
    F.ROWSS2 = (float*)(ws + WS_ROWSS2); F.Y = (float*)(ws + WS_Y); F.PAIRS = (unsigned*)(ws + WS_PAIRS);
    F.XN = (bf16*)(ws + WS_XN); F.MIX = (bf16*)(ws + WS_XN); F.Z = (bf16*)(ws + WS_Z); F.HB = (bf16*)(ws + WS_HB);
    F.ROWSS = (float*)(ws + WS_ROWSS); F.Q = (float*)(ws + WS_Z); F.AGG = (float*)(ws + WS_AGG); F.GATES = (float*)(ws + WS_GATES); F.IDS = (int*)(ws + WS_IDS);
    for (int u = F.tid; u < (LDS_BYTES - LDSCTL_OFF) / 4; u += NWAVES * 64) ((LAS unsigned*)(F.lds + LDSCTL_OFF))[u] = 0u;
    __syncthreads();
    XcdBarrier bar; bar.bar = (unsigned*)(F.ctl + CW_BAR); bar.x = 0; bar.st = nullptr;
    if (N_LAUNCHES != PER_PHASE) bar = xcd_barrier_post((unsigned*)(F.ctl + CW_BAR), F.MISC + 8);
#define GRID_BAR() do { if (N_LAUNCHES != PER_PHASE) xcd_barrier(bar); } while (0)
    const int lo = args.ph_lo, hi = args.ph_hi;
#ifndef MK_PHASE_MASK
#define MK_PHASE_MASK 0x3FF
#endif
#define IN(k) (((MK_PHASE_MASK >> (k)) & 1) && lo <= (k) && (k) < hi)
#define BOTH(k) (IN(k) && IN((k) + 1))
    const int gw = F.vcu * NWAVES + F.wave, NGW = F.G * NWAVES;
    if (IN(0)) { p0_prologue(F); if (BOTH(0)) GRID_BAR(); }
    if (IN(1)) {
        pg8::Gemm g{F.XN, F.WIN, M, NIN, D}; pg8::StaticOrder S; S.init(M, NIN, F.G, (int)blockIdx.x);
        pg8::EpiZ E{F.Z, NIN, LW};
        pg8::gemm_phase<pg8::EpiZ, pg8::StaticOrder, true, true>(F.lds, g, S, E);
        if (BOTH(1)) GRID_BAR();
    }
    if (IN(2)) {
        for (int u = blockIdx.x; u < BATCH * NCHUNK * 8; u += F.G) lru_unit<false>(F, u);
        for (int u = blockIdx.x; u < BATCH * NCHUNK; u += F.G) gmlp_unit(F, u);
        if (BOTH(2)) GRID_BAR();
    }
    if (IN(3)) {
        for (int u = blockIdx.x; u < BATCH * NCHUNK * 8; u += F.G) lru_unit<true>(F, u);
        if (BOTH(3)) GRID_BAR();
    }
    if (IN(4)) {
        pg8::Gemm g{F.MIX, F.WOUT, M, D, D}; pg8::StaticOrder S; S.init(M, D, F.G, (int)blockIdx.x);
        pg8::EpiH E{F.HB, F.HBT, F.in[0], F.ROWSS, D, M};
        pg8::gemm_phase<pg8::EpiH, pg8::StaticOrder, true, true>(F.lds, g, S, E);
        if (BOTH(4)) GRID_BAR();
    }
    if (IN(5)) {
        pg8::Gemm g{F.HB, F.WQ, M, D, D}; pg8::StaticOrder S; S.init(M, D, F.G, (int)blockIdx.x);
        pg8::EpiQ E{F.Q, F.ROWSS, D};
        pg8::gemm_phase<pg8::EpiQ, pg8::StaticOrder, true, true>(F.lds, g, S, E);
        if (BOTH(5)) GRID_BAR();
    }
    if (IN(6)) {
        for (int wu = gw; wu < (M / 32) * 8; wu += NGW) topk_unit(F, wu);
        if (BOTH(6)) GRID_BAR();
    }
    if (IN(7)) {
        for (int t = gw; t < M; t += NGW) peer_u_token(F, t);
        if (BOTH(7)) GRID_BAR();
    }
    if (IN(8)) {
        for (int c = blockIdx.x; c < D / 8; c += F.G) peer_v_slice(F, c);
        if (BOTH(8)) GRID_BAR();
    }
    if (IN(9)) {
        for (int u = blockIdx.x; u < (M / 64) * 8; u += F.G) final_unit(F, u);
    }
#undef IN
#undef BOTH
#undef GRID_BAR
}

extern "C" void kernel_launch(void* const* d_in, const int* in_sizes, int n_in, void* d_out, int out_size, void* d_ws, size_t ws_size, hipStream_t stream) {
    static int grid = 0;
    if (grid == 0) {
        if (n_in != 21 || in_sizes[0] != M * D || out_size != M * D || ws_size < WS_END) { fprintf(stderr, "kernel_launch: unexpected shapes (n_in %d, in0 %d, out %d, ws %zu)\n", n_in, n_in > 0 ? in_sizes[0] : -1, out_size, ws_size); grid = -1; return; }
        int dev = 0, cus = 0, per_cu = 0;
        if (hipGetDevice(&dev) != hipSuccess || hipDeviceGetAttribute(&cus, hipDeviceAttributeMultiprocessorCount, dev) != hipSuccess) { grid = -1; return; }
        if (hipFuncSetAttribute((const void*)mk_fwd, hipFuncAttributeMaxDynamicSharedMemorySize, LDS_BYTES) != hipSuccess) { fprintf(stderr, "kernel_launch: hipFuncSetAttribute failed\n"); grid = -1; return; }
        if (hipOccupancyMaxActiveBlocksPerMultiprocessor(&per_cu, (const void*)mk_fwd, NWAVES * 64, LDS_BYTES) != hipSuccess || per_cu < 1) { fprintf(stderr, "kernel_launch: occupancy query reports %d blocks per CU\n", per_cu); }
        (void)hipGetLastError();
        grid = cus;
    }
    if (grid < 0) return;
    (void)hipMemsetAsync((char*)d_ws + WS_CTL, 0, CTL_ZERO_BYTES, stream);
    Args a{};
    for (int i = 0; i < 21; ++i) a.in[i] = (const float*)d_in[i];
    a.out = (float*)d_out; a.ws = (unsigned char*)d_ws;
    for (int li = 0; li < N_LAUNCHES; ++li) {
        a.ph_lo = (N_LAUNCHES == PER_PHASE) ? li : 0; a.ph_hi = (N_LAUNCHES == PER_PHASE) ? li + 1 : PER_PHASE;
        hipLaunchKernelGGL(mk_fwd, dim3(grid), dim3(NWAVES * 64), LDS_BYTES, stream, a);
    }
}
```

```cpp
#include <hip/hip_runtime.h>
#include <cstdio>
#include <cstdint>
namespace pg8 {
#define PG8_LAS __attribute__((address_space(3)))
typedef unsigned short bf16_t;
typedef short bf16x8 __attribute__((ext_vector_type(8)));
typedef float f32x4 __attribute__((ext_vector_type(4)));
typedef unsigned u32x4 __attribute__((ext_vector_type(4)));
constexpr int BM = 256, BK = 64, HALF = 128, HTB = HALF * BK * 2  , STAGE_BYTES = 8 * HTB, NXCD = 8, WGM = 8;

__host__ __device__ __forceinline__ int lds_byte(int r, int c) { const int st = (r >> 4) * 2 + (c >> 5), rr = r & 15, cc = c & 31, ob = rr * 64 + cc * 2; return st * 1024 + (ob ^ (((ob >> 9) & 1) << 5)); }
__host__ __device__ __forceinline__ void stage_rc(int b, int& R, int& C) { const int st = b / 1024, sb = b % 1024, swz = sb ^ (((sb >> 9) & 1) << 5); R = (st >> 1) * 16 + swz / 64; C = (st & 1) * 32 + (swz % 64) / 2; }
__host__ __device__ __forceinline__ int perm32(int rho) { const int n = rho >> 4, i = rho & 15; return 8 * (i >> 2) + 4 * n + (i & 3); }

struct Unit { int pm, pn; };
struct Gemm { const bf16_t* A; const bf16_t* Bt; int M, N, K; };

struct StaticOrder {
    int nM, nN, nwg, G, c;
    __host__ __device__ void init(int M, int N, int G_, int c_) { nM = M / BM; nN = N / BM; nwg = nM * nN; G = G_; c = c_; }
    __host__ __device__ bool next(int i, Unit& u) const {
        const long L = (long)i * G + c; if (L >= nwg) return false;
        int wgid = (int)L; { const int q = nwg / NXCD, r = nwg % NXCD, xcd = wgid % NXCD, off = wgid / NXCD; wgid = (xcd < r ? xcd * (q + 1) : r * (q + 1) + (xcd - r) * q) + off; }
        const int nig = WGM * nN, gid = wgid / nig, fm = gid * WGM, gsz = (nM - fm) < WGM ? (nM - fm) : WGM;
        u.pm = fm + ((wgid % nig) % gsz); u.pn = (wgid % nig) / gsz; return true;
    }
    __device__ __forceinline__ void a_ready(const Unit&) const {}
    __device__ __forceinline__ void done(const Unit&) const {}
};

__device__ __forceinline__ unsigned cvt_pk_bf16(float lo, float hi) { unsigned r; asm volatile("v_cvt_pk_bf16_f32 %0, %1, %2" : "=v"(r) : "v"(lo), "v"(hi)); return r; }
__device__ __forceinline__ float gelu_tanh(float x) {
    const float t = x * (1.0f + 0.044715f * x * x);
    const float e = __builtin_amdgcn_exp2f(-2.3022081983f * t);
    return x * __builtin_amdgcn_rcpf(1.0f + e);
}
struct EpiZ {
    static constexpr bool PERM = true, AFTER_DRAIN = false;
    bf16_t* O; int ldc; int gelu_from;
    __device__ __forceinline__ void operator()(const f32x4 (&acc)[2][2][4][2], const Unit& u, int wr, int wc, int fr, int fq) const {
        const int row0 = u.pm * BM + wr * 64 + fr; const int col0 = u.pn * BM + wc * 32 + 8 * fq;
        const bool act = (u.pn * BM) >= gelu_from;
#pragma unroll
        for (int ai = 0; ai < 2; ++ai)
#pragma unroll
            for (int m = 0; m < 4; ++m) { bf16_t* rowp = O + (size_t)(row0 + ai * HALF + m * 16) * ldc + col0;
#pragma unroll
                for (int bj = 0; bj < 2; ++bj) { f32x4 v0 = acc[ai][bj][m][0], v1 = acc[ai][bj][m][1];
                    if (act) {
#pragma unroll
                        for (int j = 0; j < 4; ++j) { v0[j] = gelu_tanh(v0[j]); v1[j] = gelu_tanh(v1[j]); } }
                    u32x4 w; w.x = cvt_pk_bf16(v0[0], v0[1]); w.y = cvt_pk_bf16(v0[2], v0[3]); w.z = cvt_pk_bf16(v1[0], v1[1]); w.w = cvt_pk_bf16(v1[2], v1[3]);
                    *(u32x4*)(rowp + bj * HALF) = w; } }
    }
};
struct EpiH {
    static constexpr bool PERM = true, AFTER_DRAIN = false;
    bf16_t* O; bf16_t* OT; const float* X; float* rowss; int ldc; int mrows;
    __device__ __forceinline__ void operator()(const f32x4 (&acc)[2][2][4][2], const Unit& u, int wr, int wc, int fr, int fq) const {
        const int row0 = u.pm * BM + wr * 64 + fr; const int col0 = u.pn * BM + wc * 32 + 8 * fq;
#pragma unroll
        for (int ai = 0; ai < 2; ++ai)
#pragma unroll
            for (int m = 0; m < 4; ++m) { const int row = row0 + ai * HALF + m * 16; const size_t off = (size_t)row * ldc + col0; float ss = 0.f;
#pragma unroll
                for (int bj = 0; bj < 2; ++bj) {
                    const f32x4 x0 = *(const f32x4*)(X + off + bj * HALF), x1 = *(const f32x4*)(X + off + bj * HALF + 4);
                    const f32x4 v0 = acc[ai][bj][m][0] + x0, v1 = acc[ai][bj][m][1] + x1;
                    ss += (v0[0] * v0[0] + v0[1] * v0[1]) + (v0[2] * v0[2] + v0[3] * v0[3]) + (v1[0] * v1[0] + v1[1] * v1[1]) + (v1[2] * v1[2] + v1[3] * v1[3]);
                    u32x4 w; w.x = cvt_pk_bf16(v0[0], v0[1]); w.y = cvt_pk_bf16(v0[2], v0[3]); w.z = cvt_pk_bf16(v1[0], v1[1]); w.w = cvt_pk_bf16(v1[2], v1[3]);
                    *(u32x4*)(O + off + bj * HALF) = w;
                    *(u32x4*)(OT + ((size_t)((col0 + bj * HALF) >> 3) * mrows + row) * 8) = w; }
                ss += __shfl_xor(ss, 16); ss += __shfl_xor(ss, 32);
                if (fq == 0) atomicAdd(rowss + row, ss); }
    }
};
struct EpiQ {
    static constexpr bool PERM = true, AFTER_DRAIN = false;
    bf16_t* QH; const float* rowss; int ldc;
    __device__ __forceinline__ void operator()(const f32x4 (&acc)[2][2][4][2], const Unit& u, int wr, int wc, int fr, int fq) const {
        const int row0 = u.pm * BM + wr * 64 + fr, col0 = u.pn * BM + wc * 32 + 8 * fq;
#pragma unroll
        for (int ai = 0; ai < 2; ++ai)
#pragma unroll
            for (int m = 0; m < 4; ++m) { const int row = row0 + ai * HALF + m * 16; const float rs = __builtin_amdgcn_rsqf(rowss[row] * (1.0f / 2048.0f) + 1e-6f);
                const size_t off = (size_t)row * ldc + col0;
#pragma unroll
                for (int bj = 0; bj < 2; ++bj) { const f32x4 v0 = acc[ai][bj][m][0] * rs, v1 = acc[ai][bj][m][1] * rs;
                    u32x4 wh; wh.x = cvt_pk_bf16(v0[0], v0[1]); wh.y = cvt_pk_bf16(v0[2], v0[3]); wh.z = cvt_pk_bf16(v1[0], v1[1]); wh.w = cvt_pk_bf16(v1[2], v1[3]);
                    *(u32x4*)(QH + off + bj * HALF) = wh; } }
    }
};
template <class Epi, class Sched, bool ALIGN_EPI = false, bool SP2 = false>
__device__ __forceinline__ void gemm_phase(PG8_LAS unsigned char* lds, const Gemm g, const Sched& S, const Epi& E) {
    const int tid = threadIdx.x, wid = __builtin_amdgcn_readfirstlane(tid >> 6), lane = tid & 63, wr = wid >> 2, wc = wid & 3, fr = lane & 15, fq = lane >> 4;
    const int K = g.K, nt = K / BK;
    unsigned voffA[2], voffB[2];
#pragma unroll
    for (int i = 0; i < 2; ++i) { int R, C; stage_rc(tid * 16 + i * 8192, R, C); const int Rb = Epi::PERM ? ((R & ~31) + perm32(R & 31)) : R;
        voffA[i] = (unsigned)(R * K + C) * 2u; voffB[i] = (unsigned)(Rb * K + C) * 2u; }
    const size_t kstep = (size_t)(BK * 2);
    const size_t hstep = (size_t)HALF * K * 2;
    const size_t tstep = 2 * hstep;
    const unsigned ldsw = (unsigned)wid * 1024u;
    const int aoff = lds_byte(wr * 64 + fr, fq * 8), boff = lds_byte(wc * 32 + fr, fq * 8);
#define PG8_SA(b, h) (((b) * 2 + (h)) * HTB)
#define PG8_SB(b, h) ((4 + (b) * 2 + (h)) * HTB)
#define PG8_STAGE(bufoff, gbase, voff) do { _Pragma("unroll") for (int _i = 0; _i < 2; ++_i) \
        __builtin_amdgcn_global_load_lds((const unsigned*)((const char*)(gbase) + (voff)[_i]), (PG8_LAS unsigned*)(lds + (bufoff) + ldsw + _i * 8192), 16, 0, 0); } while (0)
#define PG8_LDA(dst, b, h) do { _Pragma("unroll") for (int m = 0; m < 4; ++m) _Pragma("unroll") for (int k = 0; k < 2; ++k) dst[m][k] = *(const PG8_LAS bf16x8*)(lds + PG8_SA(b, h) + aoff + m * 2048 + k * 1024); } while (0)
#define PG8_LDB(dst, b, h) do { _Pragma("unroll") for (int n = 0; n < 2; ++n) _Pragma("unroll") for (int k = 0; k < 2; ++k) dst[n][k] = *(const PG8_LAS bf16x8*)(lds + PG8_SB(b, h) + boff + n * 2048 + k * 1024); } while (0)
#define PG8_MMA(ai, bj, At, Bt) do { __builtin_amdgcn_s_setprio(1); _Pragma("unroll") for (int m = 0; m < 4; ++m) _Pragma("unroll") for (int n = 0; n < 2; ++n) _Pragma("unroll") for (int k = 0; k < 2; ++k) \
        acc[ai][bj][m][n] = __builtin_amdgcn_mfma_f32_16x16x32_bf16(Bt[n][k], At[m][k], acc[ai][bj][m][n], 0, 0, 0); __builtin_amdgcn_s_setprio(0); } while (0)
#define PG8_WAIT_V(n) asm volatile("s_waitcnt vmcnt(" #n ")" ::: "memory")
#define PG8_WAIT_L(n) asm volatile("s_waitcnt lgkmcnt(" #n ")" ::: "memory")
#define PG8_BAR __builtin_amdgcn_s_barrier()
#define PG8_SCHED __builtin_amdgcn_sched_barrier(0)
    Unit cur, nxt; int ui = 0;
    if (!S.next(0, cur)) return;
    f32x4 acc[2][2][4][2];
#pragma unroll
    for (int a = 0; a < 2; ++a)
#pragma unroll
        for (int b = 0; b < 2; ++b)
#pragma unroll
            for (int m = 0; m < 4; ++m)
#pragma unroll
                for (int n = 0; n < 2; ++n) acc[a][b][m][n] = (f32x4){0.f, 0.f, 0.f, 0.f};
    bf16x8 At[4][2], B0[2][2], B1[2][2];
    const char* cA = (const char*)g.A + (size_t)cur.pm * tstep; const char* cB = (const char*)g.Bt + (size_t)cur.pn * tstep;
    S.a_ready(cur);
    if constexpr (SP2) {
        PG8_STAGE(PG8_SB(0, 0), cB, voffB); PG8_STAGE(PG8_SB(0, 1), cB + hstep, voffB); PG8_STAGE(PG8_SA(0, 0), cA, voffA); PG8_STAGE(PG8_SA(0, 1), cA + hstep, voffA);
        if (wr == 1) PG8_BAR;
        PG8_WAIT_V(2); PG8_BAR;
        PG8_STAGE(PG8_SB(1, 0), cB + kstep, voffB); PG8_STAGE(PG8_SA(1, 0), cA + kstep, voffA); PG8_STAGE(PG8_SB(1, 1), cB + hstep + kstep, voffB);
        PG8_WAIT_V(6); PG8_BAR;
    } else {
        PG8_STAGE(PG8_SB(0, 0), cB, voffB); PG8_STAGE(PG8_SA(0, 0), cA, voffA); PG8_STAGE(PG8_SB(0, 1), cB + hstep, voffB); PG8_STAGE(PG8_SA(0, 1), cA + hstep, voffA);
        if (wr == 1) PG8_BAR;
        PG8_WAIT_V(4); PG8_BAR;
        PG8_STAGE(PG8_SB(1, 0), cB + kstep, voffB); PG8_STAGE(PG8_SA(1, 0), cA + kstep, voffA); PG8_STAGE(PG8_SB(1, 1), cB + hstep + kstep, voffB);
        PG8_WAIT_V(6); PG8_BAR;
    }
    for (;;) {
        const bool has_next = S.next(ui + 1, nxt);
        const char* nA = has_next ? (const char*)g.A + (size_t)nxt.pm * tstep : cA; const char* nB = has_next ? (const char*)g.Bt + (size_t)nxt.pn * tstep : cB;
        for (int t = 0; t < nt; t += 2) {
            const bool last = (t == nt - 2);
            const char* a1 = cA + (size_t)(t + 1) * kstep;
            const char* a2 = last ? nA : cA + (size_t)(t + 2) * kstep; const char* b2 = last ? nB : cB + (size_t)(t + 2) * kstep;
            const char* a3 = a2 + kstep; const char* b3 = b2 + kstep;
            if (last && has_next) S.a_ready(nxt);
            if constexpr (SP2) {
            PG8_LDB(B0, 0, 0); PG8_LDB(B1, 0, 1); PG8_SCHED; PG8_LDA(At, 0, 0); PG8_STAGE(PG8_SA(1, 1), a1 + hstep, voffA);
            PG8_WAIT_V(8); PG8_WAIT_L(0); PG8_BAR; PG8_MMA(0, 0, At, B0); PG8_MMA(0, 1, At, B1); PG8_BAR; PG8_SCHED;
            PG8_LDA(At, 0, 1); PG8_STAGE(PG8_SB(0, 0), b2, voffB); PG8_STAGE(PG8_SB(0, 1), b2 + hstep, voffB); PG8_STAGE(PG8_SA(0, 0), a2, voffA);
            PG8_WAIT_V(8); PG8_WAIT_L(0); PG8_BAR; PG8_MMA(1, 0, At, B0); PG8_MMA(1, 1, At, B1); PG8_BAR; PG8_SCHED;
            PG8_LDB(B0, 1, 0); PG8_LDB(B1, 1, 1); PG8_SCHED; PG8_LDA(At, 1, 0); PG8_STAGE(PG8_SA(0, 1), a2 + hstep, voffA);
            PG8_WAIT_V(8); PG8_WAIT_L(0); PG8_BAR; PG8_MMA(0, 0, At, B0); PG8_MMA(0, 1, At, B1); PG8_BAR; PG8_SCHED;
            PG8_LDA(At, 1, 1); PG8_STAGE(PG8_SB(1, 0), b3, voffB); PG8_STAGE(PG8_SB(1, 1), b3 + hstep, voffB); PG8_STAGE(PG8_SA(1, 0), a3, voffA);
            PG8_WAIT_V(8); PG8_WAIT_L(0); PG8_BAR; PG8_MMA(1, 0, At, B0); PG8_MMA(1, 1, At, B1); PG8_BAR; PG8_SCHED;
            } else {
            PG8_LDB(B0, 0, 0); PG8_SCHED; PG8_LDA(At, 0, 0); PG8_STAGE(PG8_SA(1, 1), a1 + hstep, voffA);
            PG8_WAIT_L(8); PG8_BAR; PG8_WAIT_L(0); PG8_MMA(0, 0, At, B0); PG8_BAR; PG8_SCHED;
            PG8_LDB(B1, 0, 1); PG8_STAGE(PG8_SB(0, 0), b2, voffB);
            PG8_BAR; PG8_WAIT_L(0); PG8_MMA(0, 1, At, B1); PG8_BAR;
            PG8_LDA(At, 0, 1); PG8_STAGE(PG8_SA(0, 0), a2, voffA);
            PG8_BAR; PG8_WAIT_L(0); PG8_MMA(1, 0, At, B0); PG8_BAR; PG8_SCHED;
            PG8_STAGE(PG8_SB(0, 1), b2 + hstep, voffB);
            PG8_WAIT_V(6); PG8_BAR; PG8_MMA(1, 1, At, B1); PG8_BAR;
            PG8_LDB(B0, 1, 0); PG8_SCHED; PG8_LDA(At, 1, 0); PG8_STAGE(PG8_SA(0, 1), a2 + hstep, voffA);
            PG8_WAIT_L(8); PG8_BAR; PG8_WAIT_L(0); PG8_MMA(0, 0, At, B0); PG8_BAR; PG8_SCHED;
            PG8_LDB(B1, 1, 1); PG8_STAGE(PG8_SB(1, 0), b3, voffB);
            PG8_BAR; PG8_WAIT_L(0); PG8_MMA(0, 1, At, B1); PG8_BAR;
            PG8_LDA(At, 1, 1); PG8_STAGE(PG8_SA(1, 0), a3, voffA);
            PG8_BAR; PG8_WAIT_L(0); PG8_MMA(1, 0, At, B0); PG8_BAR; PG8_SCHED;
            PG8_STAGE(PG8_SB(1, 1), b3 + hstep, voffB);
            PG8_WAIT_V(6); PG8_BAR; PG8_MMA(1, 1, At, B1); PG8_BAR;
            }
        }
        if constexpr (ALIGN_EPI) { if (wr == 0) PG8_BAR; }
        if constexpr (!Epi::AFTER_DRAIN) { E(acc, cur, wr, wc, fr, fq); S.done(cur); }
        if (!has_next) break;
#pragma unroll
        for (int a = 0; a < 2; ++a)
#pragma unroll
            for (int b = 0; b < 2; ++b)
#pragma unroll
                for (int m = 0; m < 4; ++m)
#pragma unroll
                    for (int n = 0; n < 2; ++n) acc[a][b][m][n] = (f32x4){0.f, 0.f, 0.f, 0.f};
        cur = nxt; cA = nA; cB = nB; ++ui;
        if constexpr (ALIGN_EPI) { if (wr == 1) PG8_BAR; }
    }
    PG8_WAIT_V(0);
    if constexpr (!ALIGN_EPI) { if (wr == 0) PG8_BAR; }
    PG8_BAR;
    if constexpr (Epi::AFTER_DRAIN) { E.fused(acc, cur, wr, wc, fr, fq, lds, wid, lane); S.done(cur); }
#undef PG8_SA
#undef PG8_SB
#undef PG8_STAGE
#undef PG8_LDA
#undef PG8_LDB
#undef PG8_MMA
#undef PG8_WAIT_V
#undef PG8_WAIT_L
#undef PG8_BAR
#undef PG8_SCHED
}
}
constexpr int NWAVES = 8;
constexpr int BATCH = 4, SEQ = 8192, D = 2048, M = BATCH * SEQ, NIN = 4096, LW = 1024, CHUNK = 128, NCHUNK = SEQ / CHUNK;
constexpr int NEXP = 16384;
#ifndef MK_N_LAUNCHES
#define MK_N_LAUNCHES 1
#endif
constexpr int N_LAUNCHES = MK_N_LAUNCHES;
constexpr int PER_PHASE = 10;
constexpr size_t MiB = 1u << 20;
constexpr size_t WS_CTL = 0, CTL_ZERO_BYTES = 1 * MiB;
constexpr size_t WS_ROWSS = 512 * 1024;
constexpr size_t WS_WIN = 2 * MiB, WS_WOUT = 18 * MiB, WS_WQ = 26 * MiB, WS_LRUW = 34 * MiB, WS_WSB = 35 * MiB, WS_AGG = 36 * MiB;
constexpr size_t WS_U = 64 * MiB, WS_V = 128 * MiB, WS_XN = 192 * MiB  , WS_Z = 320 * MiB  ;
constexpr size_t WS_HB = 576 * MiB, WS_IDS = 704 * MiB, WS_GATES = 720 * MiB, WS_PAIRS = 736 * MiB, WS_HBT = 752 * MiB, WS_END = 880 * MiB;
constexpr size_t WS_USCALE = 40 * MiB, WS_VSCALE = 41 * MiB;
constexpr size_t WS_ASCALE = 42 * MiB, WS_KH = 43 * MiB;
constexpr size_t WS_IDW = WS_PAIRS, WS_AW = WS_PAIRS + 8 * MiB;
constexpr size_t WS_ROWSS2 = 640 * 1024;
constexpr size_t WS_Y = WS_Z;
constexpr int CW_BAR = 4096;
constexpr int RING_BYTES = 131072;
constexpr int LDSCTL_OFF = 143360, MISC_OFF = LDSCTL_OFF + 320;
constexpr int LDS_BYTES = 147456;
#define GAS __attribute__((address_space(1)))
#define LAS __attribute__((address_space(3)))
typedef unsigned short bf16;
typedef unsigned v4u __attribute__((ext_vector_type(4)));
typedef float f32x4 __attribute__((ext_vector_type(4)));
typedef short bf16x8 __attribute__((ext_vector_type(8)));
typedef GAS unsigned gu32;
typedef GAS unsigned long long gu64;
#define RLX_AGENT __ATOMIC_RELAXED, __HIP_MEMORY_SCOPE_AGENT
#define LDS_WAIT() asm volatile("s_waitcnt lgkmcnt(0)" ::: "memory")
#define VM_WAIT() asm volatile("s_waitcnt vmcnt(0)" ::: "memory")
__device__ __forceinline__ unsigned long long rt() { return __builtin_amdgcn_s_memrealtime(); }
__device__ __forceinline__ unsigned f2bf(float f) { unsigned u = __builtin_bit_cast(unsigned, f); return (u + 0x7fffu + ((u >> 16) & 1u)) >> 16; }
__device__ __forceinline__ unsigned pk2(float lo, float hi) { return f2bf(lo) | (f2bf(hi) << 16); }

#define XB_TMO      128
#define XB_XCNT(j)  (256  + 64 * (j))
#define XB_XSUB(j)  (1280 + 64 * (j))
#define XB_XGEN(j)  (2304 + 64 * (j))
#define XB_TOP      3328
#define XB_TOPGEN   3392
#define XCD_BAR_WORDS 3456
#define XB_SPIN_CAP (1u << 18)

__device__ __forceinline__ unsigned xb_ld(unsigned* p)              { return __hip_atomic_load(p, __ATOMIC_RELAXED, __HIP_MEMORY_SCOPE_AGENT); }
__device__ __forceinline__ unsigned xb_add(unsigned* p, unsigned v) { return __hip_atomic_fetch_add(p, v, __ATOMIC_RELAXED, __HIP_MEMORY_SCOPE_AGENT); }
__device__ __forceinline__ unsigned xb_xcc_id() { return (unsigned)__builtin_amdgcn_s_getreg((3 << 11) | 20) & 0xFu; }
#define XB_SPIN(cond, bar) do { unsigned _sp = 0; while (cond) { __builtin_amdgcn_s_sleep(1); \
    if ((++_sp & 255u) == 0u) { if (xb_ld(&(bar)[XB_TMO])) break; if (_sp > XB_SPIN_CAP) { atomicAdd(&(bar)[XB_TMO], 1u); break; } } } } while (0)

struct XcdBarrier {
    unsigned* bar; unsigned x;
    volatile LAS unsigned* st;
};

__device__ __forceinline__ XcdBarrier xcd_barrier_post(unsigned* bar, volatile LAS unsigned* st) {
    XcdBarrier b; b.bar = bar; b.x = xb_xcc_id(); b.st = st;
    if (threadIdx.x == 0) (void)xb_add(&bar[XB_XCNT(b.x)], 1u);
    return b;
}
__device__ __forceinline__ void xcd_barrier_complete(unsigned* bar, unsigned x, unsigned& nloc, unsigned& nx) {
    const unsigned G = gridDim.x * gridDim.y * gridDim.z;
    unsigned sum, cnt, mine, sp = 0u;
    for (;;) {
        sum = 0u; cnt = 0u; mine = 0u;
#pragma unroll
        for (unsigned j = 0; j < 16; ++j) { const unsigned c = xb_ld(&bar[XB_XCNT(j)]); sum += c; cnt += (c > 0u) ? 1u : 0u; mine = (j == x) ? c : mine; }
        if (sum == G) break;
        __builtin_amdgcn_s_sleep(1);
        if ((++sp & 255u) == 0u) { if (xb_ld(&bar[XB_TMO])) break; if (sp > XB_SPIN_CAP) { atomicAdd(&bar[XB_TMO], 1u); break; } }
    }
    nloc = mine > 0u ? mine : 1u; nx = cnt > 0u ? cnt : 1u;
}

__device__ __forceinline__ void xcd_barrier(const XcdBarrier& b) {
    asm volatile("s_waitcnt vmcnt(0)" ::: "memory");
    __syncthreads();
    if (threadIdx.x == 0) {
        unsigned* bar = b.bar;
        __builtin_amdgcn_s_waitcnt(0);
        unsigned nloc = b.st[0], nx = b.st[1];
        if (nloc == 0u) { xcd_barrier_complete(bar, b.x, nloc, nx); b.st[0] = nloc; b.st[1] = nx; }
        const unsigned old = xb_add(&bar[XB_XSUB(b.x)], 1u);
        const unsigned gen = old / nloc;
        if (old + 1u == (gen + 1u) * nloc) {
            __builtin_amdgcn_fence(__ATOMIC_RELEASE, "agent");
            asm volatile("s_waitcnt vmcnt(0)" ::: "memory");
            const unsigned og = xb_add(&bar[XB_TOP], 1u);
            const unsigned tg = og / nx;
            if (og + 1u == (tg + 1u) * nx) xb_add(&bar[XB_TOPGEN], 1u);
            else XB_SPIN(xb_ld(&bar[XB_TOPGEN]) == tg, bar);
            __builtin_amdgcn_fence(__ATOMIC_ACQUIRE, "agent");
            xb_add(&bar[XB_XGEN(b.x)], 1u);
            asm volatile("s_waitcnt vmcnt(0)" ::: "memory");
        } else {
            XB_SPIN(xb_ld(&bar[XB_XGEN(b.x)]) == gen, bar);
            __builtin_amdgcn_fence(__ATOMIC_ACQUIRE, "agent");
            asm volatile("s_waitcnt vmcnt(0)" ::: "memory");
        }
    }
    __syncthreads();
}
typedef unsigned v2u __attribute__((ext_vector_type(2)));
typedef float f32x2 __attribute__((ext_vector_type(2)));
struct Args { const float* in[21]; float* out; unsigned char* ws; int ph_lo, ph_hi; };
struct Frame {
    const Args& A;
    LAS unsigned char* lds;
    volatile LAS unsigned* MISC;
    gu32* ctl;
    unsigned char* ws;
    int tid, lane, wave, vcu, G;
    __device__ __forceinline__ Frame(const Args& a) : A(a) {}
#define WSP(name, type, off) __device__ __forceinline__ type* name() const { return (type*)(ws + (off)); }
    WSP(WIN, bf16, WS_WIN) WSP(WOUT, bf16, WS_WOUT) WSP(WQ, bf16, WS_WQ) WSP(LRUW, bf16, WS_LRUW) WSP(WSB, bf16, WS_WSB)
    WSP(XN, bf16, WS_XN) WSP(MIX, bf16, WS_XN) WSP(Z, bf16, WS_Z) WSP(HB, bf16, WS_HB) WSP(HBT, bf16, WS_HBT)
    WSP(U8, unsigned char, WS_U) WSP(V8T, unsigned char, WS_V)
    WSP(ROWSS, float, WS_ROWSS) WSP(ROWSS2, float, WS_ROWSS2) WSP(QH, bf16, WS_Z) WSP(QL, bf16, WS_Z + 128 * MiB) WSP(KH, bf16, WS_KH) WSP(KL, bf16, WS_KH + 512 * 1024) WSP(AGG, float, WS_AGG) WSP(GATES, float, WS_GATES)
    WSP(USCALE, float, WS_USCALE) WSP(VSCALE, float, WS_VSCALE) WSP(Y, float, WS_Y) WSP(IDS, int, WS_IDS) WSP(ASCALE, float, WS_ASCALE) WSP(IDW, v2u, WS_IDW) WSP(AW, unsigned, WS_AW)
#undef WSP
};
__device__ __forceinline__ float wave_sum(float v) {
#pragma unroll
    for (int o = 1; o < 64; o <<= 1) v += __shfl_xor(v, o);
    return v;
}
__device__ __forceinline__ float bf_lo(unsigned w) { return __builtin_bit_cast(float, w << 16); }
__device__ __forceinline__ float bf_hi(unsigned w) { return __builtin_bit_cast(float, w & 0xffff0000u); }
__device__ __forceinline__ float bf1(unsigned short h) { return __builtin_bit_cast(float, (unsigned)h << 16); }
__device__ __forceinline__ float sigmoidf_(float x) { return __builtin_amdgcn_rcpf(1.0f + __builtin_amdgcn_exp2f(-1.4426950409f * x)); }
using pg8::gelu_tanh;
__device__ __forceinline__ unsigned pack_i8x4(float a, float b, float c, float d) {
    const int ia = (int)__builtin_rintf(a), ib = (int)__builtin_rintf(b), ic = (int)__builtin_rintf(c), id = (int)__builtin_rintf(d);
    return (unsigned)(ia & 0xff) | ((unsigned)(ib & 0xff) << 8) | ((unsigned)(ic & 0xff) << 16) | ((unsigned)id << 24);
}

__device__ __forceinline__ void p0_transpose_item(const float* W, int K, int N, bf16* WT, const float* kscale, LAS float* scr, int item, int lane) {
    const int nblk = N / 32, kb = item / nblk, nb = item % nblk, k0 = 64 * kb, n0 = 32 * nb;
#pragma unroll 8
    for (int i = 0; i < 32; ++i) { const int kk = 2 * i + (lane >> 5); const float sc = kscale ? kscale[k0 + kk] : 1.0f; scr[kk * 33 + (lane & 31)] = W[(size_t)(k0 + kk) * N + n0 + (lane & 31)] * sc; }
    LDS_WAIT(); asm volatile("" ::: "memory");
    const int c = lane & 7;
#pragma unroll
    for (int j = 0; j < 4; ++j) { const int n = (lane >> 3) + 8 * j; const LAS float* s = scr + (8 * c) * 33 + n;
        v4u o; o.x = pk2(s[0 * 33], s[1 * 33]); o.y = pk2(s[2 * 33], s[3 * 33]); o.z = pk2(s[4 * 33], s[5 * 33]); o.w = pk2(s[6 * 33], s[7 * 33]);
        *(GAS v4u*)(WT + (size_t)(n0 + n) * K + k0 + 8 * c) = o; }
    LDS_WAIT(); asm volatile("" ::: "memory");
}
__device__ __forceinline__ void p0_prologue(Frame& F) {
    LAS float* scr = (LAS float*)(F.lds + F.wave * 16384);
    const int gw = F.vcu * NWAVES + F.wave, NGW = F.G * NWAVES, lane = F.lane;
    constexpr int I_IN = (D / 64) * (NIN / 32), I_OUT = (D / 64) * (D / 32), I_Q = I_OUT, I_LRU = 32 * 8;
    constexpr int NITEMS = I_IN + I_OUT + I_Q + I_LRU;
    for (int it = gw; it < NITEMS; it += NGW) {
        int r = it;
        if (r < I_IN) { p0_transpose_item(F.A.in[2], D, NIN, F.WIN(), F.A.in[1], scr, r, lane); continue; } r -= I_IN;
        if (r < I_OUT) { p0_transpose_item(F.A.in[14], D, D, F.WOUT(), nullptr, scr, r, lane); continue; } r -= I_OUT;
        if (r < I_Q) { p0_transpose_item(F.A.in[16], D, D, F.WQ(), F.A.in[15], scr, r, lane); continue; } r -= I_Q;
        { const int mi = r >> 3, sub = r & 7, gate = mi >> 4, rest = mi & 15;
          const float* src = (gate ? F.A.in[7] : F.A.in[5]) + (size_t)rest * 16384;
          p0_transpose_item(src, 128, 128, F.LRUW() + (size_t)mi * 16384, nullptr, scr, sub, lane); }
    }
    const size_t gt = (size_t)gw * 64 + lane, NGT = (size_t)NGW * 64;
    {
        const float* g2 = F.A.in[15];
        f32x4 gg[8];
#pragma unroll
        for (int j = 0; j < 8; ++j) gg[j] = *(const GAS f32x4*)(g2 + j * 256 + lane * 4);
        for (int e = gw; e < NEXP; e += NGW) {
            const GAS f32x4* ur = (const GAS f32x4*)(F.A.in[18] + (size_t)e * D) + lane;
            f32x4 v[8]; float mx = 0.f;
#pragma unroll
            for (int j = 0; j < 8; ++j) { v[j] = ur[64 * j] * gg[j]; mx = fmaxf(mx, fmaxf(fmaxf(fabsf(v[j].x), fabsf(v[j].y)), fmaxf(fabsf(v[j].z), fabsf(v[j].w)))); }
#pragma unroll
            for (int o = 1; o < 64; o <<= 1) mx = fmaxf(mx, __shfl_xor(mx, o));
            const float sc = mx > 0.f ? 127.0f / mx : 1.0f;
            GAS unsigned* o4 = (GAS unsigned*)(F.U8() + (size_t)e * D) + lane;
#pragma unroll
            for (int j = 0; j < 8; ++j) o4[64 * j] = pack_i8x4(v[j].x * sc, v[j].y * sc, v[j].z * sc, v[j].w * sc);
            if (lane == 0) F.USCALE()[e] = mx > 0.f ? mx * (1.0f / 127.0f) : 1.0f;
        }
    }
    __syncthreads();
    for (int un = blockIdx.x; un < NEXP / 64; un += F.G) {
        const int e0 = un * 64;
        for (int rr = 0; rr < 8; ++rr) {
            const int el = F.wave * 8 + rr, e = e0 + el;
            const GAS f32x4* vr = (const GAS f32x4*)(F.A.in[19] + (size_t)e * D) + lane;
            f32x4 v[8]; float mx = 0.f;
#pragma unroll
            for (int j = 0; j < 8; ++j) { v[j] = vr[64 * j]; mx = fmaxf(mx, fmaxf(fmaxf(fabsf(v[j].x), fabsf(v[j].y)), fmaxf(fabsf(v[j].z), fabsf(v[j].w)))); }
#pragma unroll
            for (int o = 1; o < 64; o <<= 1) mx = fmaxf(mx, __shfl_xor(mx, o));
            const float sc = mx > 0.f ? 127.0f / mx : 1.0f;
#pragma unroll
            for (int j = 0; j < 8; ++j) *(LAS unsigned*)(F.lds + el * 2056 + j * 256 + lane * 4) = pack_i8x4(v[j].x * sc, v[j].y * sc, v[j].z * sc, v[j].w * sc);
            if (lane == 0) F.VSCALE()[e] = mx > 0.f ? mx * (1.0f / 127.0f) : 1.0f;
        }
        __syncthreads();
        for (int cc = 0; cc < 32; ++cc) { const int c = F.wave * 32 + cc;
            const v2u w = *(const LAS v2u*)(F.lds + lane * 2056 + c * 8);
            *(GAS v2u*)(F.V8T() + ((size_t)c * NEXP + e0 + lane) * 8) = w; }
        __syncthreads();
    }
    for (size_t ch = gt; ch < (size_t)8 * 128 * 128 / 8; ch += NGT) {
        const size_t e0 = ch * 8;
        const f32x4 a = *(const GAS f32x4*)(F.A.in[12] + e0), b = *(const GAS f32x4*)(F.A.in[12] + e0 + 4);
        v4u o; o.x = pk2(a.x, a.y); o.y = pk2(a.z, a.w); o.z = pk2(b.x, b.y); o.w = pk2(b.z, b.w);
        *(GAS v4u*)(F.WSB() + e0) = o;
    }
    for (size_t ch = gt; ch < (size_t)16 * 128 * 128 / 8; ch += NGT) {
        const size_t e0 = ch * 8;
        const f32x4 a = *(const GAS f32x4*)(F.A.in[17] + e0), b = *(const GAS f32x4*)(F.A.in[17] + e0 + 4);
        v4u hi; hi.x = pk2(a.x, a.y); hi.y = pk2(a.z, a.w); hi.z = pk2(b.x, b.y); hi.w = pk2(b.z, b.w);
        *(GAS v4u*)(F.KH() + e0) = hi;
    }
    for (int m = gw; m < M; m += NGW) {
        const GAS f32x4* xr = (const GAS f32x4*)(F.A.in[0] + (size_t)m * D) + lane;
        f32x4 v[8]; float s = 0.f;
#pragma unroll
        for (int j = 0; j < 8; ++j) { v[j] = xr[64 * j]; s += (v[j].x * v[j].x + v[j].y * v[j].y) + (v[j].z * v[j].z + v[j].w * v[j].w); }
        const float rstd = __builtin_amdgcn_rsqf(wave_sum(s) * (1.f / D) + 1e-6f);
        GAS unsigned long long* o8 = (GAS unsigned long long*)(F.XN() + (size_t)m * D) + lane;
#pragma unroll
        for (int j = 0; j < 8; ++j) o8[64 * j] = (unsigned long long)pk2(v[j].x * rstd, v[j].y * rstd) | ((unsigned long long)pk2(v[j].z * rstd, v[j].w * rstd) << 32);
    }
}
constexpr int LRU_XR = 0, LRU_XC = 33792, LRU_GR = 33792 + 34816;
constexpr float LOG2E = 1.4426950408889634f;

template <bool APPLY, int DIR>
__device__ __forceinline__ void lru_dir(Frame& F, int b, int c, int h, float (&hsum)[8][4]) {
    const int lane = F.lane, w = F.wave, fr = lane & 15, fq = lane >> 4;
    LAS unsigned char* XC = F.lds + LRU_XC;
    const int chl = 16 * w + fr, chg = h * 128 + chl;
    bf16x8 Ba[4], Bx[4];
    {
        const bf16* wa = F.LRUW() + (size_t)((0 * 2 + DIR) * 8 + h) * 16384 + (size_t)chl * 128 + 8 * fq;
        const bf16* wx = F.LRUW() + (size_t)((1 * 2 + DIR) * 8 + h) * 16384 + (size_t)chl * 128 + 8 * fq;
#pragma unroll
        for (int ks = 0; ks < 4; ++ks) { Ba[ks] = *(const GAS bf16x8*)(wa + 32 * ks); Bx[ks] = *(const GAS bf16x8*)(wx + 32 * ks); }
    }
    const float ba = F.A.in[6][DIR * LW + chg], bx = F.A.in[8][DIR * LW + chg], lam = F.A.in[9][DIR * LW + chg];
    const float cl = -8.0f * log1pf(__expf(-lam)) * LOG2E;
    float carry = 0.f;
    if (APPLY) {
        const f32x2* aggb = (const f32x2*)F.AGG() + (size_t)((b * 2 + DIR) * NCHUNK) * LW + h * 128 + 16 * w;
        const int cc = DIR == 0 ? lane : NCHUNK - 1 - lane;
        const int pos_c = DIR == 0 ? c : NCHUNK - 1 - c;
        f32x2 pe[16];
#pragma unroll
        for (int i = 0; i < 16; ++i) pe[i] = aggb[(size_t)cc * LW + i];
#pragma unroll
        for (int i = 0; i < 16; ++i) {
            float A = pe[i].x, B = pe[i].y;
#pragma unroll
            for (int o = 1; o < 64; o <<= 1) { const float pa = __shfl_up(A, o), pb = __shfl_up(B, o); if (lane >= o) { B = A * pb + B; A = A * pa; } }
            const float cv = __shfl(B, pos_c - 1);
            if (fr == i) carry = pos_c > 0 ? cv : 0.f;
        }
    }
    float totA = 1.f, totB = 0.f;
    const int src1 = DIR == 0 ? lane - 16 : lane + 16, src2 = DIR == 0 ? lane - 32 : lane + 32;
    const bool v1 = DIR == 0 ? (fq >= 1) : (fq <= 2), v2 = DIR == 0 ? (fq >= 2) : (fq <= 1);
    const int lastl = DIR == 0 ? fr + 48 : fr;
#pragma unroll
    for (int mm = 0; mm < 8; ++mm) {
        const int m = DIR == 0 ? mm : 7 - mm;
        f32x4 R = (f32x4){0.f, 0.f, 0.f, 0.f}, I = (f32x4){0.f, 0.f, 0.f, 0.f};
#pragma unroll
        for (int ks = 0; ks < 4; ++ks) {
            const bf16x8 a = *(const LAS bf16x8*)(XC + (16 * m + fr) * 272 + (32 * ks + 8 * fq) * 2);
            R = __builtin_amdgcn_mfma_f32_16x16x32_bf16(a, Ba[ks], R, 0, 0, 0);
            I = __builtin_amdgcn_mfma_f32_16x16x32_bf16(a, Bx[ks], I, 0, 0, 0);
        }
#pragma unroll
        for (int j = 0; j < 4; ++j) {
            const float r = sigmoidf_(R[j] + ba), ig = sigmoidf_(I[j] + bx);
            const float a = __builtin_amdgcn_exp2f(cl * r);
            const float xc = bf1(*(const LAS unsigned short*)(XC + (16 * m + 4 * fq + j) * 272 + chl * 2));
            const float om = fmaxf(1.0f - a * a, 0.0f);
            R[j] = a; I[j] = __builtin_amdgcn_sqrtf(om) * (ig * xc);
        }
        float A = 1.f, B = 0.f;
#pragma unroll
        for (int jj = 0; jj < 4; ++jj) { const int j = DIR == 0 ? jj : 3 - jj; B = R[j] * B + I[j]; A = R[j] * A; }
        { const float pa = __shfl(A, src1), pb = __shfl(B, src1); if (v1) { B = A * pb + B; A = A * pa; } }
        { const float pa = __shfl(A, src2), pb = __shfl(B, src2); if (v2) { B = A * pb + B; A = A * pa; } }
        const float TA = __shfl(A, lastl), TB = __shfl(B, lastl);
        if (APPLY) {
            float EA = __shfl(A, src1), EB = __shfl(B, src1); if (!v1) { EA = 1.f; EB = 0.f; }
            float hh = EA * carry + EB;
#pragma unroll
            for (int jj = 0; jj < 4; ++jj) { const int j = DIR == 0 ? jj : 3 - jj; hh = R[j] * hh + I[j]; if (DIR == 0) hsum[m][j] = hh; else hsum[m][j] += hh; }
            carry = TA * carry + TB;
        } else { totB = TA * totB + TB; totA = TA * totA; }
    }
    if (!APPLY) { if (fq == 0) { f32x2* agg = (f32x2*)F.AGG() + (size_t)((b * 2 + DIR) * NCHUNK + c) * LW + chg; *agg = (f32x2){totA, totB}; } }
}

template <bool APPLY>
__device__ __forceinline__ void lru_unit(Frame& F, int unit) {
    const int h = unit & 7, c = (unit >> 3) & 63, b = unit >> 9;
    const int tid = F.tid, lane = F.lane, w = F.wave, fr = lane & 15, fq = lane >> 4;
    const size_t t0 = (size_t)b * SEQ + (size_t)c * CHUNK;
    LAS unsigned char* XR = F.lds + LRU_XR; LAS unsigned char* XC = F.lds + LRU_XC; LAS unsigned char* GR = F.lds + LRU_GR;
    for (int p = tid; p < 131 * 16; p += 512) { const int r = p >> 4, cg = p & 15; const int s = c * CHUNK - 2 + r; v4u v = (v4u){0u, 0u, 0u, 0u};
        if (s >= 0 && s < SEQ) v = *(const GAS v4u*)(F.Z() + ((size_t)b * SEQ + s) * NIN + h * 128 + cg * 8);
        *(LAS v4u*)(XR + r * 256 + cg * 16) = v; }
    if (APPLY) { for (int p = tid; p < 128 * 32; p += 512) { const int r = p >> 5, cg = p & 31;
        *(LAS v2u*)(GR + r * 264 + cg * 8) = *(const GAS v2u*)(F.Z() + (t0 + r) * NIN + LW + h * 128 + cg * 4); } }
    __syncthreads();
    {
        const int ch2 = tid & 63, tg = tid >> 6, chg = h * 128 + 2 * ch2;
        float w0[4], w1[4];
#pragma unroll
        for (int k = 0; k < 4; ++k) { w0[k] = F.A.in[3][k * LW + chg]; w1[k] = F.A.in[3][k * LW + chg + 1]; }
        const float b0 = F.A.in[4][chg], b1 = F.A.in[4][chg + 1];
        float x0[4], x1[4];
#pragma unroll
        for (int k = 0; k < 3; ++k) { const unsigned u = *(const LAS unsigned*)(XR + (16 * tg + k) * 256 + ch2 * 4); x0[k] = bf_lo(u); x1[k] = bf_hi(u); }
#pragma unroll
        for (int j = 0; j < 16; ++j) {
            const unsigned u = *(const LAS unsigned*)(XR + (16 * tg + j + 3) * 256 + ch2 * 4); x0[3] = bf_lo(u); x1[3] = bf_hi(u);
            const float y0 = b0 + ((w0[0] * x0[0] + w0[1] * x0[1]) + (w0[2] * x0[2] + w0[3] * x0[3]));
            const float y1 = b1 + ((w1[0] * x1[0] + w1[1] * x1[1]) + (w1[2] * x1[2] + w1[3] * x1[3]));
            *(LAS unsigned*)(XC + (16 * tg + j) * 272 + ch2 * 4) = pk2(y0, y1);
            x0[0] = x0[1]; x0[1] = x0[2]; x0[2] = x0[3]; x1[0] = x1[1]; x1[1] = x1[2]; x1[2] = x1[3];
        }
    }
    __syncthreads();
    float hsum[8][4];
    lru_dir<APPLY, 0>(F, b, c, h, hsum);
    asm volatile("" ::: "memory"); __builtin_amdgcn_sched_barrier(0);
    lru_dir<APPLY, 1>(F, b, c, h, hsum);
    if (APPLY) {
        const int chl = 16 * w + fr;
#pragma unroll
        for (int m = 0; m < 8; ++m)
#pragma unroll
            for (int j = 0; j < 4; ++j) { LAS unsigned short* p = (LAS unsigned short*)(GR + (16 * m + 4 * fq + j) * 264 + chl * 2); *p = (unsigned short)f2bf(bf1(*p) * hsum[m][j]); }
        __syncthreads();
        for (int p = tid; p < 128 * 32; p += 512) { const int r = p >> 5, cg = p & 31;
            *(GAS v2u*)(F.MIX() + (t0 + r) * D + h * 128 + cg * 4) = *(const LAS v2u*)(GR + r * 264 + cg * 8); }
    }
    __syncthreads();
}
constexpr int GM_ST = 0, GM_BS = 1024, GM_VN = 2048, GM_GU = 2048 + 32768;
typedef short s16x4 __attribute__((ext_vector_type(4)));
__device__ __forceinline__ unsigned vn_off(unsigned row, unsigned ch) { return 256u * row + 16u * (ch ^ (((row & 3u) << 2) | ((row >> 2) & 3u))); }
__device__ __forceinline__ void gmlp_unit(Frame& F, int unit) {
    const int tid = F.tid, lane = F.lane, w = F.wave, fr = lane & 15, fq = lane >> 4;
    const size_t t0 = (size_t)unit * CHUNK;
    LAS float* ST = (LAS float*)(F.lds + GM_ST); LAS float* BS = (LAS float*)(F.lds + GM_BS);
    LAS unsigned char* VN = F.lds + GM_VN; LAS unsigned char* GU = F.lds + GM_GU;
    for (int rr = 0; rr < 16; ++rr) {
        const int row = 16 * w + rr;
        const bf16* p = F.Z() + (t0 + row) * NIN + 3 * LW + lane * 8;
        const v4u a = *(const GAS v4u*)p, b = *(const GAS v4u*)(p + 512);
        float x[16] = {bf_lo(a.x), bf_hi(a.x), bf_lo(a.y), bf_hi(a.y), bf_lo(a.z), bf_hi(a.z), bf_lo(a.w), bf_hi(a.w),
                       bf_lo(b.x), bf_hi(b.x), bf_lo(b.y), bf_hi(b.y), bf_lo(b.z), bf_hi(b.z), bf_lo(b.w), bf_hi(b.w)};
        float s = 0.f;
#pragma unroll
        for (int i = 0; i < 16; ++i) s += x[i];
        const float mean = wave_sum(s) * (1.0f / LW);
        float q = 0.f;
#pragma unroll
        for (int i = 0; i < 16; ++i) { const float d = x[i] - mean; q += d * d; }
        const float rstd = __builtin_amdgcn_rsqf(wave_sum(q) * (1.0f / LW) + 1e-6f);
        if (lane == 0) { ST[2 * row] = mean; ST[2 * row + 1] = rstd; }
    }
    __syncthreads();
    const unsigned trq = (unsigned)(lane & 15) >> 2, trp = (unsigned)lane & 3u;
    for (int h = 0; h < 8; ++h) {
#pragma unroll
        for (int i = 0; i < 4; ++i) { const int pid = tid + 512 * i, q = pid >> 4, cg = pid & 15;
            const v4u a = *(const GAS v4u*)(F.Z() + (t0 + q) * NIN + 3 * LW + h * 128 + cg * 8);
            const float mean = ST[2 * q], rstd = ST[2 * q + 1];
            const f32x4 g0 = *(const GAS f32x4*)(F.A.in[10] + h * 128 + cg * 8), g1 = *(const GAS f32x4*)(F.A.in[10] + h * 128 + cg * 8 + 4);
            const f32x4 b0 = *(const GAS f32x4*)(F.A.in[11] + h * 128 + cg * 8), b1 = *(const GAS f32x4*)(F.A.in[11] + h * 128 + cg * 8 + 4);
            v4u o;
            o.x = pk2((bf_lo(a.x) - mean) * rstd * g0.x + b0.x, (bf_hi(a.x) - mean) * rstd * g0.y + b0.y);
            o.y = pk2((bf_lo(a.y) - mean) * rstd * g0.z + b0.z, (bf_hi(a.y) - mean) * rstd * g0.w + b0.w);
            o.z = pk2((bf_lo(a.z) - mean) * rstd * g1.x + b1.x, (bf_hi(a.z) - mean) * rstd * g1.y + b1.y);
            o.w = pk2((bf_lo(a.w) - mean) * rstd * g1.z + b1.z, (bf_hi(a.w) - mean) * rstd * g1.w + b1.w);
            *(LAS v4u*)(VN + vn_off((unsigned)q, (unsigned)cg)) = o;
        }
#pragma unroll
        for (int i = 0; i < 8; ++i) { const int pid = tid + 512 * i, r = pid >> 5, cg = pid & 31;
            *(LAS v2u*)(GU + r * 264 + cg * 8) = *(const GAS v2u*)(F.Z() + (t0 + r) * NIN + 2 * LW + h * 128 + cg * 4); }
        if (tid < 128) BS[tid] = F.A.in[13][h * 128 + tid];
        bf16x8 Af[4];
        { const bf16* wsb = F.WSB() + (size_t)h * 16384 + (size_t)(16 * w + fr) * 128 + 8 * fq;
#pragma unroll
          for (int ks = 0; ks < 4; ++ks) Af[ks] = *(const GAS bf16x8*)(wsb + 32 * ks); }
        __syncthreads();
        f32x4 acc[8];
#pragma unroll
        for (int n = 0; n < 8; ++n) {
            acc[n] = (f32x4){0.f, 0.f, 0.f, 0.f};
#pragma unroll
            for (int ks = 0; ks < 4; ++ks) {
                const s16x4 b0 = __builtin_amdgcn_ds_read_tr16_b64_v4i16((LAS s16x4*)(VN + vn_off(32u * ks + 8u * fq + trq, 2u * n + (trp >> 1)) + 8u * (trp & 1u)));
                const s16x4 b1 = __builtin_amdgcn_ds_read_tr16_b64_v4i16((LAS s16x4*)(VN + vn_off(32u * ks + 8u * fq + 4u + trq, 2u * n + (trp >> 1)) + 8u * (trp & 1u)));
                const bf16x8 bb = (bf16x8){b0[0], b0[1], b0[2], b0[3], b1[0], b1[1], b1[2], b1[3]};
                acc[n] = __builtin_amdgcn_mfma_f32_16x16x32_bf16(Af[ks], bb, acc[n], 0, 0, 0);
            }
        }
#pragma unroll
        for (int n = 0; n < 8; ++n)
#pragma unroll
            for (int j = 0; j < 4; ++j) { const int p = 16 * w + 4 * fq + j; LAS unsigned short* ad = (LAS unsigned short*)(GU + p * 264 + (16 * n + fr) * 2);
                *ad = (unsigned short)f2bf(bf1(*ad) * (acc[n][j] + BS[p])); }
        __syncthreads();
#pragma unroll
        for (int i = 0; i < 8; ++i) { const int pid = tid + 512 * i, r = pid >> 5, cg = pid & 31;
            *(GAS v2u*)(F.MIX() + (t0 + r) * D + LW + h * 128 + cg * 4) = *(const LAS v2u*)(GU + r * 264 + cg * 8); }
        __syncthreads();
    }
}
typedef float f32x16 __attribute__((ext_vector_type(16)));
__device__ __forceinline__ unsigned fkey(float f) { const unsigned u = __builtin_bit_cast(unsigned, f); return (u & 0x80000000u) ? ~u : (u | 0x80000000u); }
__device__ __forceinline__ float fkey_inv(unsigned k) { const unsigned u = (k & 0x80000000u) ? (k & 0x7fffffffu) : ~k; return __builtin_bit_cast(float, u); }
__device__ __forceinline__ unsigned umax_(unsigned a, unsigned b) { return a > b ? a : b; }
__device__ __forceinline__ unsigned umin_(unsigned a, unsigned b) { return a < b ? a : b; }
#define CE_DESC(x, y) do { const unsigned a_ = (x), b_ = (y); (x) = umax_(a_, b_); (y) = umin_(a_, b_); } while (0)
__device__ __forceinline__ void sort16_desc(unsigned (&a)[16]) {
#pragma unroll
    for (int k = 2; k <= 16; k <<= 1)
#pragma unroll
        for (int j = k >> 1; j >= 1; j >>= 1)
#pragma unroll
            for (int i = 0; i < 16; ++i) { const int l = i ^ j; if (l > i) { if ((i & k) == 0) CE_DESC(a[i], a[l]); else CE_DESC(a[l], a[i]); } }
}
__device__ __forceinline__ void merge16_desc(unsigned (&a)[16], const unsigned (&b)[16]) {
#pragma unroll
    for (int i = 0; i < 16; ++i) a[i] = umax_(a[i], b[15 - i]);
#pragma unroll
    for (int j = 8; j >= 1; j >>= 1)
#pragma unroll
        for (int i = 0; i < 16; ++i) if ((i & j) == 0) CE_DESC(a[i], a[i + j]);
}
typedef short bf16x8s __attribute__((ext_vector_type(8)));
__device__ __forceinline__ void topk_unit(Frame& F, int wu) {
    const int tg = wu >> 3, hd = wu & 7, lane = F.lane, r = lane & 31, hh = lane >> 5;
    const int t = tg * 32 + r;
    const size_t qoff = (size_t)t * D + hd * 256 + 8 * hh;
    unsigned L[2][16];
    unsigned hh4 = (unsigned)hh << 2; asm volatile("" : "+v"(hh4));
#pragma unroll
    for (int p = 0; p < 2; ++p) {
        f32x16 acc[4];
#pragma unroll
        for (int nt = 0; nt < 4; ++nt)
#pragma unroll
            for (int i = 0; i < 16; ++i) acc[nt][i] = 0.f;
        const size_t koff = ((size_t)(hd * 2 + p) * 128 + r) * 128 + 8 * hh;
        const bf16* qp = F.QH() + qoff + p * 128; const bf16* kp0 = F.KH() + koff; const bf16* kp1 = kp0 + 32 * 128; const bf16* kp2 = kp0 + 64 * 128; const bf16* kp3 = kp0 + 96 * 128;
        asm volatile("" : "+v"(qp), "+v"(kp0), "+v"(kp1), "+v"(kp2), "+v"(kp3));
#define P6_LOAD(Q, K, ks0, n) _Pragma("unroll") for (int i_ = 0; i_ < (n); ++i_) { Q[i_] = *(const GAS bf16x8s*)(qp + 16 * ((ks0) + i_)); \
            K[i_][0] = *(const GAS bf16x8s*)(kp0 + 16 * ((ks0) + i_)); K[i_][1] = *(const GAS bf16x8s*)(kp1 + 16 * ((ks0) + i_)); \
            K[i_][2] = *(const GAS bf16x8s*)(kp2 + 16 * ((ks0) + i_)); K[i_][3] = *(const GAS bf16x8s*)(kp3 + 16 * ((ks0) + i_)); }
#define P6_MMA(Q, K, n) _Pragma("unroll") for (int i_ = 0; i_ < (n); ++i_) _Pragma("unroll") for (int nt = 0; nt < 4; ++nt) acc[nt] = __builtin_amdgcn_mfma_f32_32x32x16_bf16(K[i_][nt], Q[i_], acc[nt], 0, 0, 0);
        bf16x8s qa[3], ka[3][4], qb[3], kb[3][4];
        P6_LOAD(qa, ka, 0, 3); P6_LOAD(qb, kb, 3, 3);
        __builtin_amdgcn_sched_barrier(0);
        P6_MMA(qa, ka, 3);
        __builtin_amdgcn_sched_barrier(0);
        P6_LOAD(qa, ka, 6, 2);
        __builtin_amdgcn_sched_barrier(0);
        P6_MMA(qb, kb, 3);
        __builtin_amdgcn_sched_barrier(0);
        P6_MMA(qa, ka, 2);
        __builtin_amdgcn_sched_barrier(0);
#undef P6_LOAD
#undef P6_MMA
        unsigned S[4][16];
#pragma unroll
        for (int nt = 0; nt < 4; ++nt) {
#pragma unroll
            for (int rg = 0; rg < 16; ++rg) { const int nc = 32 * nt + (rg & 3) + 8 * (rg >> 2); S[nt][rg] = ((fkey(acc[nt][rg]) & ~0x7Fu) | (unsigned)(127 - nc)) ^ hh4; }
            sort16_desc(S[nt]);
        }
        merge16_desc(S[0], S[1]); merge16_desc(S[2], S[3]); merge16_desc(S[0], S[2]);
        unsigned T[16];
#pragma unroll
        for (int i = 0; i < 16; ++i) T[i] = (unsigned)__shfl_xor((int)S[0][i], 32);
        merge16_desc(S[0], T);
#pragma unroll
        for (int i = 0; i < 16; ++i) L[p][i] = S[0][i];
        __builtin_amdgcn_sched_barrier(0);
    }
    float v0[16], v1[16];
#pragma unroll
    for (int i = 0; i < 16; ++i) { v0[i] = fkey_inv(L[0][i] & ~0x7Fu); v1[i] = fkey_inv(L[1][i] & ~0x7Fu); }
    unsigned C[4][16];
    {
        int cnt = 0;
#pragma unroll
        for (int i = 0; i < 16; ++i)
#pragma unroll
            for (int j = 0; j < 16; ++j) if ((i + 1) * (j + 1) <= 16) { C[cnt >> 4][cnt & 15] = (fkey(v0[i] + v1[j]) & ~0xFFu) | (unsigned)(255 - (i * 16 + j)); ++cnt; }
#pragma unroll
        for (int q = 50; q < 64; ++q) C[q >> 4][q & 15] = 0u;
    }
    sort16_desc(C[0]); sort16_desc(C[1]); sort16_desc(C[2]); sort16_desc(C[3]);
    merge16_desc(C[0], C[1]); merge16_desc(C[2], C[3]); merge16_desc(C[0], C[2]);
    unsigned best[16];
#pragma unroll
    for (int i = 0; i < 16; ++i) best[i] = C[0][i];
    float sv[16]; int ids[16];
    const float smax = fkey_inv(best[0] & ~0xFFu);
    float ssum = 0.f;
#pragma unroll
    for (int k = 0; k < 16; ++k) {
        const unsigned pos = 255u - (best[k] & 0xFFu); const unsigned ii = pos >> 4, jj = pos & 15u;
        unsigned k0 = L[0][0], k1 = L[1][0];
#pragma unroll
        for (int i = 1; i < 16; ++i) { k0 = (ii == (unsigned)i) ? L[0][i] : k0; k1 = (jj == (unsigned)i) ? L[1][i] : k1; }
        ids[k] = (int)((127u - (k0 & 0x7Fu)) * 128u + (127u - (k1 & 0x7Fu)));
        sv[k] = __builtin_amdgcn_exp2f((fkey_inv(best[k] & ~0xFFu) - smax) * 1.4426950409f); ssum += sv[k];
    }
    const float inv = 1.0f / ssum;
    if (hh == 0) {
        int* o = F.IDS() + (size_t)t * 128 + hd * 16;
#pragma unroll
        for (int k = 0; k < 16; k += 4) *(GAS v4u*)(o + k) = (v4u){(unsigned)ids[k], (unsigned)ids[k + 1], (unsigned)ids[k + 2], (unsigned)ids[k + 3]};
    } else {
        float* o = F.GATES() + (size_t)t * 128 + hd * 16;
#pragma unroll
        for (int k = 0; k < 16; k += 4) *(GAS f32x4*)(o + k) = (f32x4){sv[k] * inv, sv[k + 1] * inv, sv[k + 2] * inv, sv[k + 3] * inv};
    }
}
__device__ __forceinline__ int idot16(const v4u u, const unsigned* h, int acc) {
    acc = __builtin_amdgcn_sdot4((int)u.x, (int)h[0], acc, false); acc = __builtin_amdgcn_sdot4((int)u.y, (int)h[1], acc, false);
    acc = __builtin_amdgcn_sdot4((int)u.z, (int)h[2], acc, false); acc = __builtin_amdgcn_sdot4((int)u.w, (int)h[3], acc, false);
    return acc;
}
__device__ __forceinline__ void peer_u_token(Frame& F, int t) {
    const int lane = F.lane;
    LAS float* abuf = (LAS float*)(F.lds + F.wave * 1024); LAS int* ibuf = (LAS int*)(F.lds + F.wave * 1024 + 512);
    unsigned hq[8]; float hs;
    {
        float hx[32]; float mx = 0.f;
        const bf16* hp = F.HB() + (size_t)t * D + lane * 16;
#pragma unroll
        for (int c = 0; c < 2; ++c)
#pragma unroll
            for (int q = 0; q < 2; ++q) { const v4u a = *(const GAS v4u*)(hp + c * 1024 + q * 8); float* x = hx + c * 16 + q * 8;
                x[0] = bf_lo(a.x); x[1] = bf_hi(a.x); x[2] = bf_lo(a.y); x[3] = bf_hi(a.y); x[4] = bf_lo(a.z); x[5] = bf_hi(a.z); x[6] = bf_lo(a.w); x[7] = bf_hi(a.w); }
#pragma unroll
        for (int i = 0; i < 32; ++i) mx = fmaxf(mx, fabsf(hx[i]));
#pragma unroll
        for (int o = 1; o < 64; o <<= 1) mx = fmaxf(mx, __shfl_xor(mx, o));
        const float sc = mx > 0.f ? 127.0f / mx : 1.0f; hs = mx > 0.f ? mx * (1.0f / 127.0f) : 1.0f;
#pragma unroll
        for (int i = 0; i < 8; ++i) hq[i] = pack_i8x4(hx[4 * i] * sc, hx[4 * i + 1] * sc, hx[4 * i + 2] * sc, hx[4 * i + 3] * sc);
    }
    const float rstd = __builtin_amdgcn_rsqf(F.ROWSS()[t] * (1.0f / D) + 1e-6f) * hs;
    const bool b5 = (lane & 32) != 0, b4 = (lane & 16) != 0, b3 = (lane & 8) != 0;
    const int psel = (b5 ? 4 : 0) + (b4 ? 2 : 0) + (b3 ? 1 : 0);
#pragma unroll 1
    for (int half = 0; half < 2; ++half) {
        const int idv = F.IDS()[(size_t)t * 128 + half * 64 + lane];
        const float gv = F.GATES()[(size_t)t * 128 + half * 64 + lane];
        ibuf[half * 64 + lane] = idv;
#pragma unroll 1
        for (int kb = 0; kb < 64; kb += 8) {
            v4u ur[8][2];
#pragma unroll
            for (int u = 0; u < 8; ++u) { const int e = __builtin_amdgcn_readlane(idv, kb + u);
                const unsigned char* rp = F.U8() + (size_t)e * D + lane * 16;
                ur[u][0] = *(const GAS v4u*)rp; ur[u][1] = *(const GAS v4u*)(rp + 1024); }
            int d[8];
#pragma unroll
            for (int u = 0; u < 8; ++u) d[u] = idot16(ur[u][1], hq + 4, idot16(ur[u][0], hq, 0));
            int w4[4], w2[2], w1;
#pragma unroll
            for (int i = 0; i < 4; ++i) { const int send = b5 ? d[i] : d[i + 4], keep = b5 ? d[i + 4] : d[i]; w4[i] = keep + __shfl_xor(send, 32); }
#pragma unroll
            for (int i = 0; i < 2; ++i) { const int send = b4 ? w4[i] : w4[i + 2], keep = b4 ? w4[i + 2] : w4[i]; w2[i] = keep + __shfl_xor(send, 16); }
            { const int send = b3 ? w2[0] : w2[1], keep = b3 ? w2[1] : w2[0]; w1 = keep + __shfl_xor(send, 8); }
            w1 += __shfl_xor(w1, 4); w1 += __shfl_xor(w1, 2); w1 += __shfl_xor(w1, 1);
            const int e = __shfl(idv, kb + psel); const float g = __shfl(gv, kb + psel);
            const float act = gelu_tanh((float)w1 * rstd * F.USCALE()[e]) * g * F.VSCALE()[e];
            if ((lane & 7) == 0) abuf[half * 64 + kb + psel] = act;
        }
    }
    const float a0 = abuf[lane], a1 = abuf[lane + 64];
    float amax = fmaxf(fabsf(a0), fabsf(a1));
#pragma unroll
    for (int o = 1; o < 64; o <<= 1) amax = fmaxf(amax, __shfl_xor(amax, o));
    const float asc = amax > 0.f ? 127.0f / amax : 1.0f;
    if (lane == 0) F.ASCALE()[t] = amax > 0.f ? amax * (1.0f / 127.0f) : 1.0f;
    if (lane < 32) {
        const f32x4 av = *(const LAS f32x4*)(abuf + 4 * lane); const v4u iv = *(const LAS v4u*)(ibuf + 4 * lane);
        const size_t o = ((size_t)(t >> 6) * 32 + lane) * 64 + (t & 63);
        F.IDW()[o] = (v2u){iv.x | (iv.y << 16), iv.z | (iv.w << 16)};
        F.AW()[o] = pack_i8x4(av.x * asc, av.y * asc, av.z * asc, av.w * asc);
    }
}
__device__ __forceinline__ void tr4x4(const unsigned r0, const unsigned r1, const unsigned r2, const unsigned r3, unsigned (&c)[4]) {
    const unsigned t01l = __builtin_amdgcn_perm(r1, r0, 0x05010400u), t01h = __builtin_amdgcn_perm(r1, r0, 0x07030602u);
    const unsigned t23l = __builtin_amdgcn_perm(r3, r2, 0x05010400u), t23h = __builtin_amdgcn_perm(r3, r2, 0x07030602u);
    c[0] = __builtin_amdgcn_perm(t23l, t01l, 0x05040100u); c[1] = __builtin_amdgcn_perm(t23l, t01l, 0x07060302u);
    c[2] = __builtin_amdgcn_perm(t23h, t01h, 0x05040100u); c[3] = __builtin_amdgcn_perm(t23h, t01h, 0x07060302u);
}
template <int MODE>
__device__ __forceinline__ void peer_v_slice(Frame& F, int c, bool do_atomic) {
    const int tid = F.tid, lane = F.lane;
    for (int i = tid; i < NEXP * 8 / 16; i += 512) *(LAS v4u*)(F.lds + i * 16) = *(const GAS v4u*)(F.V8T() + (size_t)c * NEXP * 8 + (size_t)i * 16);
    __syncthreads();
    const v2u* ibase = F.IDW() + lane; const unsigned* abase = F.AW() + lane;
    constexpr int NBLK = M / 64, PD = 16;
    v2u iq[PD]; unsigned aq[PD]; v2u rw[2][4];
    {
        const size_t o = (size_t)F.wave * 32 * 64;
#pragma unroll
        for (int j = 0; j < PD; ++j) { iq[j] = *(const GAS v2u*)(ibase + o + j * 64); aq[j] = abase[o + j * 64]; }
    }
#define LROW(dst, q) do { dst[0] = *(const LAS v2u*)(F.lds + ((q).x & 0xffffu) * 8); dst[1] = *(const LAS v2u*)(F.lds + ((q).x >> 16) * 8); \
                          dst[2] = *(const LAS v2u*)(F.lds + ((q).y & 0xffffu) * 8); dst[3] = *(const LAS v2u*)(F.lds + ((q).y >> 16) * 8); } while (0)
    for (int blk = F.wave; blk < NBLK; blk += NWAVES) {
        const int t = blk * 64 + lane;
        const size_t o = (size_t)blk * 32 * 64;
        const int nblk = (blk + NWAVES < NBLK) ? blk + NWAVES : blk;
        const size_t on = (size_t)nblk * 32 * 64;
        int acc[8];
#pragma unroll
        for (int i = 0; i < 8; ++i) acc[i] = 0;
        LROW(rw[0], iq[0]);
#pragma unroll
        for (int j = 0; j < 32; ++j) {
            if (j + 1 < 32) LROW(rw[(j + 1) & 1], iq[(j + 1) % PD]);
            const unsigned aw = aq[j % PD];
            unsigned cl[4], ch[4];
            tr4x4(rw[j & 1][0].x, rw[j & 1][1].x, rw[j & 1][2].x, rw[j & 1][3].x, cl);
            tr4x4(rw[j & 1][0].y, rw[j & 1][1].y, rw[j & 1][2].y, rw[j & 1][3].y, ch);
#pragma unroll
            for (int i = 0; i < 4; ++i) { acc[i] = __builtin_amdgcn_sdot4((int)aw, (int)cl[i], acc[i], false); acc[4 + i] = __builtin_amdgcn_sdot4((int)aw, (int)ch[i], acc[4 + i], false); }
            { const size_t oo = (j + PD < 32) ? o + (size_t)(j + PD) * 64 : on + (size_t)(j + PD - 32) * 64;
              iq[j % PD] = *(const GAS v2u*)(ibase + oo); aq[j % PD] = abase[oo]; }
            __builtin_amdgcn_sched_barrier(0);
        }
        const float asc = F.ASCALE()[t];
        float accf[8];
#pragma unroll
        for (int i = 0; i < 8; ++i) accf[i] = (float)acc[i] * asc;
        const v4u hb = *(const GAS v4u*)(F.HBT() + ((size_t)c * M + t) * 8);
        accf[0] += bf_lo(hb.x); accf[1] += bf_hi(hb.x); accf[2] += bf_lo(hb.y); accf[3] += bf_hi(hb.y);
        accf[4] += bf_lo(hb.z); accf[5] += bf_hi(hb.z); accf[6] += bf_lo(hb.w); accf[7] += bf_hi(hb.w);
        float* yp = (MODE == 0) ? F.Y() + ((size_t)c * M + t) * 8 : (float*)F.XN() + ((((size_t)c * M + t) * 8) & (size_t)0x1ffffff);
        *(GAS f32x4*)yp = (f32x4){accf[0], accf[1], accf[2], accf[3]}; *(GAS f32x4*)(yp + 4) = (f32x4){accf[4], accf[5], accf[6], accf[7]};
        float ss = 0.f;
#pragma unroll
        for (int i = 0; i < 8; ++i) ss += accf[i] * accf[i];
        if (do_atomic) atomicAdd(F.ROWSS2() + t, ss);
    }
#undef LROW
    __syncthreads();
}
__device__ __forceinline__ void final_unit(Frame& F, int unit) {
    const int tid = F.tid, blk = unit >> 3, cg = unit & 7, t0 = blk * 64;
    LAS float* T = (LAS float*)F.lds;
#pragma unroll
    for (int i = 0; i < 8; ++i) { const int pid = tid + 512 * i, cl = pid >> 7, tok = (pid >> 1) & 63, hf = pid & 1;
        const f32x4 v = *(const GAS f32x4*)(F.Y() + ((size_t)(cg * 32 + cl) * M + t0 + tok) * 8 + hf * 4);
        *(LAS f32x4*)(T + tok * 260 + cl * 8 + hf * 4) = v; }
    __syncthreads();
#pragma unroll
    for (int i = 0; i < 8; ++i) { const int pid = tid + 512 * i, tok = pid >> 6, c4 = pid & 63;
        const float rs = __builtin_amdgcn_rsqf(F.ROWSS2()[t0 + tok] * (1.0f / D) + 1e-6f);
        const f32x4 v = *(const LAS f32x4*)(T + tok * 260 + c4 * 4);
        const f32x4 g = *(const GAS f32x4*)(F.A.in[20] + cg * 256 + c4 * 4);
        *(GAS f32x4*)(F.A.out + (size_t)(t0 + tok) * D + cg * 256 + c4 * 4) = v * rs * g; }
    __syncthreads();
}
__global__ void __launch_bounds__(NWAVES * 64, 2) mk_fwd(Args args) {
    extern __shared__ __attribute__((aligned(16))) unsigned char lds[];
    Frame F(args);
    F.lds = (LAS unsigned char*)lds;
    F.MISC = (volatile LAS unsigned*)(F.lds + MISC_OFF);
    F.tid = threadIdx.x; F.lane = F.tid & 63; F.wave = __builtin_amdgcn_readfirstlane(F.tid >> 6);
    F.G = gridDim.x; { const int bx = blockIdx.x; F.vcu = (F.G % 8 == 0) ? (bx % 8) * (F.G / 8) + bx / 8 : bx; }
    F.ws = args.ws;
    F.ctl = (gu32*)(args.ws + WS_CTL);
    for (int u = F.tid; u < (LDS_BYTES - LDSCTL_OFF) / 4; u += NWAVES * 64) ((LAS unsigned*)(F.lds + LDSCTL_OFF))[u] = 0u;
    __syncthreads();
    XcdBarrier bar; bar.bar = (unsigned*)(F.ctl + CW_BAR); bar.x = 0; bar.st = nullptr;
    if (N_LAUNCHES != PER_PHASE) bar = xcd_barrier_post((unsigned*)(F.ctl + CW_BAR), F.MISC + 8);
#define GRID_BAR() do { if (N_LAUNCHES != PER_PHASE) xcd_barrier(bar); } while (0)
    const int lo = args.ph_lo, hi = args.ph_hi;
#ifndef MK_PHASE_MASK
#define MK_PHASE_MASK 0x3FF
#endif
#define IN(k) (((MK_PHASE_MASK >> (k)) & 1) && lo <= (k) && (k) < hi)
#define BOTH(k) (IN(k) && IN((k) + 1))
#ifndef MK_REP_MASK
#define MK_REP_MASK 0
#endif
#ifndef MK_REP_N
#define MK_REP_N 2
#endif
#define REPS(k) for (int rep_ = 0; rep_ < ((((MK_REP_MASK) >> (k)) & 1) ? 1 + MK_REP_N : 1); ++rep_)
    const int gw = F.vcu * NWAVES + F.wave, NGW = F.G * NWAVES;
    if (IN(0)) { REPS(0) { p0_prologue(F); __syncthreads(); } if (BOTH(0)) GRID_BAR(); }
    if (IN(1)) {
        pg8::Gemm g{F.XN(), F.WIN(), M, NIN, D}; pg8::StaticOrder S; S.init(M, NIN, F.G, (int)blockIdx.x);
        pg8::EpiZ E{F.Z(), NIN, LW};
        REPS(1) pg8::gemm_phase<pg8::EpiZ, pg8::StaticOrder, true, true>(F.lds, g, S, E);
        if (BOTH(1)) GRID_BAR();
    }
    if (IN(2)) {
        REPS(10) for (int u = blockIdx.x; u < BATCH * NCHUNK * 8; u += F.G) lru_unit<false>(F, u);
        REPS(11) for (int u = blockIdx.x; u < BATCH * NCHUNK; u += F.G) gmlp_unit(F, u);
        if (BOTH(2)) GRID_BAR();
    }
    if (IN(3)) {
        REPS(3) for (int u = blockIdx.x; u < BATCH * NCHUNK * 8; u += F.G) lru_unit<true>(F, u);
        if (BOTH(3)) GRID_BAR();
    }
    if (IN(4)) {
        pg8::Gemm g{F.MIX(), F.WOUT(), M, D, D}; pg8::StaticOrder S; S.init(M, D, F.G, (int)blockIdx.x);
        pg8::EpiH E{F.HB(), F.HBT(), F.A.in[0], F.ROWSS(), D, M};
        pg8::gemm_phase<pg8::EpiH, pg8::StaticOrder, true, true>(F.lds, g, S, E);
        if (BOTH(4)) GRID_BAR();
    }
    if (IN(5)) {
        pg8::Gemm g{F.HB(), F.WQ(), M, D, D}; pg8::StaticOrder S; S.init(M, D, F.G, (int)blockIdx.x);
        pg8::EpiQ E{F.QH(), F.ROWSS(), D};
        REPS(5) pg8::gemm_phase<pg8::EpiQ, pg8::StaticOrder, true, true>(F.lds, g, S, E);
        if (BOTH(5)) GRID_BAR();
    }
    if (IN(6)) {
        REPS(6) for (int wu = gw; wu < (M / 32) * 8; wu += NGW) topk_unit(F, wu);
        if (BOTH(6)) GRID_BAR();
    }
    if (IN(7)) {
        REPS(7) for (int t = gw; t < M; t += NGW) peer_u_token(F, t);
        if (BOTH(7)) GRID_BAR();
    }
    if (IN(8)) {
#ifndef MK_P8_MODE
#define MK_P8_MODE 0
#endif
        for (int c = blockIdx.x; c < D / 8; c += F.G) peer_v_slice<0>(F, c, true);
        if ((MK_REP_MASK >> 8) & 1) { for (int rep_ = 0; rep_ < MK_REP_N; ++rep_) for (int c = blockIdx.x; c < D / 8; c += F.G) peer_v_slice<MK_P8_MODE>(F, c, false); }
        if (BOTH(8)) GRID_BAR();
    }
    if (IN(9)) {
        REPS(9) for (int u = blockIdx.x; u < (M / 64) * 8; u += F.G) final_unit(F, u);
    }
#undef IN
#undef BOTH
#undef GRID_BAR
}

extern "C" void kernel_launch(void* const* d_in, const int* in_sizes, int n_in, void* d_out, int out_size, void* d_ws, size_t ws_size, hipStream_t stream) {
    static int grid = 0;
    if (grid == 0) {
        if (n_in != 21 || in_sizes[0] != M * D || out_size != M * D || ws_size < WS_END) { fprintf(stderr, "kernel_launch: unexpected shapes (n_in %d, in0 %d, out %d, ws %zu)\n", n_in, n_in > 0 ? in_sizes[0] : -1, out_size, ws_size); grid = -1; return; }
        int dev = 0, cus = 0, per_cu = 0;
        if (hipGetDevice(&dev) != hipSuccess || hipDeviceGetAttribute(&cus, hipDeviceAttributeMultiprocessorCount, dev) != hipSuccess) { grid = -1; return; }
        if (hipFuncSetAttribute((const void*)mk_fwd, hipFuncAttributeMaxDynamicSharedMemorySize, LDS_BYTES) != hipSuccess) { fprintf(stderr, "kernel_launch: hipFuncSetAttribute failed\n"); grid = -1; return; }
        if (hipOccupancyMaxActiveBlocksPerMultiprocessor(&per_cu, (const void*)mk_fwd, NWAVES * 64, LDS_BYTES) != hipSuccess || per_cu < 1) { fprintf(stderr, "kernel_launch: occupancy query reports %d blocks per CU\n", per_cu); }
        (void)hipGetLastError();
        grid = cus;
    }
    if (grid < 0) return;
    (void)hipMemsetAsync((char*)d_ws + WS_CTL, 0, CTL_ZERO_BYTES, stream);
    Args a{};
    for (int i = 0; i < 21; ++i) a.in[i] = (const float*)d_in[i];
    a.out = (float*)d_out; a.ws = (unsigned char*)d_ws;
    for (int li = 0; li < N_LAUNCHES; ++li) {
        a.ph_lo = (N_LAUNCHES == PER_PHASE) ? li : 0; a.ph_hi = (N_LAUNCHES == PER_PHASE) ? li + 1 : PER_PHASE;
        hipLaunchKernelGGL(mk_fwd, dim3(grid), dim3(NWAVES * 64), LDS_BYTES, stream, a);
    }
}
```

```cpp
#include <hip/hip_runtime.h>
#include <cstdio>
#include <cstdint>
namespace pg8 {
#define PG8_LAS __attribute__((address_space(3)))
typedef unsigned short bf16_t;
typedef short bf16x8 __attribute__((ext_vector_type(8)));
typedef float f32x4 __attribute__((ext_vector_type(4)));
typedef unsigned u32x4 __attribute__((ext_vector_type(4)));
constexpr int BM = 256, BK = 64, HALF = 128, HTB = HALF * BK * 2  , STAGE_BYTES = 8 * HTB, NXCD = 8, WGM = 8;

__host__ __device__ __forceinline__ int lds_byte(int r, int c) { const int st = (r >> 4) * 2 + (c >> 5), rr = r & 15, cc = c & 31, ob = rr * 64 + cc * 2; return st * 1024 + (ob ^ (((ob >> 9) & 1) << 5)); }
__host__ __device__ __forceinline__ void stage_rc(int b, int& R, int& C) { const int st = b / 1024, sb = b % 1024, swz = sb ^ (((sb >> 9) & 1) << 5); R = (st >> 1) * 16 + swz / 64; C = (st & 1) * 32 + (swz % 64) / 2; }
__host__ __device__ __forceinline__ int perm32(int rho) { const int n = rho >> 4, i = rho & 15; return 8 * (i >> 2) + 4 * n + (i & 3); }

struct Unit { int pm, pn; };
struct Gemm { const bf16_t* A; const bf16_t* Bt; int M, N, K; };

struct StaticOrder {
    int nM, nN, nwg, G, c;
    __host__ __device__ void init(int M, int N, int G_, int c_) { nM = M / BM; nN = N / BM; nwg = nM * nN; G = G_; c = c_; }
    __host__ __device__ bool next(int i, Unit& u) const {
        const long L = (long)i * G + c; if (L >= nwg) return false;
        int wgid = (int)L; { const int q = nwg / NXCD, r = nwg % NXCD, xcd = wgid % NXCD, off = wgid / NXCD; wgid = (xcd < r ? xcd * (q + 1) : r * (q + 1) + (xcd - r) * q) + off; }
        const int nig = WGM * nN, gid = wgid / nig, fm = gid * WGM, gsz = (nM - fm) < WGM ? (nM - fm) : WGM;
        u.pm = fm + ((wgid % nig) % gsz); u.pn = (wgid % nig) / gsz; return true;
    }
    __device__ __forceinline__ void a_ready(const Unit&) const {}
    __device__ __forceinline__ void done(const Unit&) const {}
};

__device__ __forceinline__ unsigned cvt_pk_bf16(float lo, float hi) { unsigned r; asm volatile("v_cvt_pk_bf16_f32 %0, %1, %2" : "=v"(r) : "v"(lo), "v"(hi)); return r; }
__device__ __forceinline__ float gelu_tanh(float x) {
    const float t = x * (1.0f + 0.044715f * x * x);
    const float e = __builtin_amdgcn_exp2f(-2.3022081983f * t);
    return x * __builtin_amdgcn_rcpf(1.0f + e);
}
struct EpiZ {
    static constexpr bool PERM = true, AFTER_DRAIN = false;
    bf16_t* O; int ldc; int gelu_from;
    __device__ __forceinline__ void operator()(const f32x4 (&acc)[2][2][4][2], const Unit& u, int wr, int wc, int fr, int fq) const {
        const int row0 = u.pm * BM + wr * 64 + fr; const int col0 = u.pn * BM + wc * 32 + 8 * fq;
        const bool act = (u.pn * BM) >= gelu_from;
#pragma unroll
        for (int ai = 0; ai < 2; ++ai)
#pragma unroll
            for (int m = 0; m < 4; ++m) { bf16_t* rowp = O + (size_t)(row0 + ai * HALF + m * 16) * ldc + col0;
#pragma unroll
                for (int bj = 0; bj < 2; ++bj) { f32x4 v0 = acc[ai][bj][m][0], v1 = acc[ai][bj][m][1];
                    if (act) {
#pragma unroll
                        for (int j = 0; j < 4; ++j) { v0[j] = gelu_tanh(v0[j]); v1[j] = gelu_tanh(v1[j]); } }
                    u32x4 w; w.x = cvt_pk_bf16(v0[0], v0[1]); w.y = cvt_pk_bf16(v0[2], v0[3]); w.z = cvt_pk_bf16(v1[0], v1[1]); w.w = cvt_pk_bf16(v1[2], v1[3]);
                    *(u32x4*)(rowp + bj * HALF) = w; } }
    }
};
struct EpiH {
    static constexpr bool PERM = true, AFTER_DRAIN = false;
    bf16_t* O; bf16_t* OT; const float* X; float* rowss; int ldc; int mrows;
    __device__ __forceinline__ void operator()(const f32x4 (&acc)[2][2][4][2], const Unit& u, int wr, int wc, int fr, int fq) const {
        const int row0 = u.pm * BM + wr * 64 + fr; const int col0 = u.pn * BM + wc * 32 + 8 * fq;
#pragma unroll
        for (int ai = 0; ai < 2; ++ai)
#pragma unroll
            for (int m = 0; m < 4; ++m) { const int row = row0 + ai * HALF + m * 16; const size_t off = (size_t)row * ldc + col0; float ss = 0.f;
#pragma unroll
                for (int bj = 0; bj < 2; ++bj) {
                    const f32x4 x0 = *(const f32x4*)(X + off + bj * HALF), x1 = *(const f32x4*)(X + off + bj * HALF + 4);
                    const f32x4 v0 = acc[ai][bj][m][0] + x0, v1 = acc[ai][bj][m][1] + x1;
                    ss += (v0[0] * v0[0] + v0[1] * v0[1]) + (v0[2] * v0[2] + v0[3] * v0[3]) + (v1[0] * v1[0] + v1[1] * v1[1]) + (v1[2] * v1[2] + v1[3] * v1[3]);
                    u32x4 w; w.x = cvt_pk_bf16(v0[0], v0[1]); w.y = cvt_pk_bf16(v0[2], v0[3]); w.z = cvt_pk_bf16(v1[0], v1[1]); w.w = cvt_pk_bf16(v1[2], v1[3]);
                    *(u32x4*)(O + off + bj * HALF) = w;
                    *(u32x4*)(OT + ((size_t)((col0 + bj * HALF) >> 3) * mrows + row) * 8) = w; }
                ss += __shfl_xor(ss, 16); ss += __shfl_xor(ss, 32);
                if (fq == 0) atomicAdd(rowss + row, ss); }
    }
};
struct EpiQ {
    static constexpr bool PERM = true, AFTER_DRAIN = false;
    bf16_t* QH; const float* rowss; int ldc;
    __device__ __forceinline__ void operator()(const f32x4 (&acc)[2][2][4][2], const Unit& u, int wr, int wc, int fr, int fq) const {
        const int row0 = u.pm * BM + wr * 64 + fr, col0 = u.pn * BM + wc * 32 + 8 * fq;
#pragma unroll
        for (int ai = 0; ai < 2; ++ai)
#pragma unroll
            for (int m = 0; m < 4; ++m) { const int row = row0 + ai * HALF + m * 16; const float rs = __builtin_amdgcn_rsqf(rowss[row] * (1.0f / 2048.0f) + 1e-6f);
                const size_t off = (size_t)row * ldc + col0;
#pragma unroll
                for (int bj = 0; bj < 2; ++bj) { const f32x4 v0 = acc[ai][bj][m][0] * rs, v1 = acc[ai][bj][m][1] * rs;
                    u32x4 wh; wh.x = cvt_pk_bf16(v0[0], v0[1]); wh.y = cvt_pk_bf16(v0[2], v0[3]); wh.z = cvt_pk_bf16(v1[0], v1[1]); wh.w = cvt_pk_bf16(v1[2], v1[3]);
                    *(u32x4*)(QH + off + bj * HALF) = wh; } }
    }
};
template <class Epi, class Sched, bool ALIGN_EPI = false, bool SP2 = false>
__device__ __forceinline__ void gemm_phase(PG8_LAS unsigned char* lds, const Gemm g, const Sched& S, const Epi& E) {
    const int tid = threadIdx.x, wid = __builtin_amdgcn_readfirstlane(tid >> 6), lane = tid & 63, wr = wid >> 2, wc = wid & 3, fr = lane & 15, fq = lane >> 4;
    const int K = g.K, nt = K / BK;
    unsigned voffA[2], voffB[2];
#pragma unroll
    for (int i = 0; i < 2; ++i) { int R, C; stage_rc(tid * 16 + i * 8192, R, C); const int Rb = Epi::PERM ? ((R & ~31) + perm32(R & 31)) : R;
        voffA[i] = (unsigned)(R * K + C) * 2u; voffB[i] = (unsigned)(Rb * K + C) * 2u; }
    const size_t kstep = (size_t)(BK * 2);
    const size_t hstep = (size_t)HALF * K * 2;
    const size_t tstep = 2 * hstep;
    const unsigned ldsw = (unsigned)wid * 1024u;
    const int aoff = lds_byte(wr * 64 + fr, fq * 8), boff = lds_byte(wc * 32 + fr, fq * 8);
#define PG8_SA(b, h) (((b) * 2 + (h)) * HTB)
#define PG8_SB(b, h) ((4 + (b) * 2 + (h)) * HTB)
#define PG8_STAGE(bufoff, gbase, voff) do { _Pragma("unroll") for (int _i = 0; _i < 2; ++_i) \
        __builtin_amdgcn_global_load_lds((const unsigned*)((const char*)(gbase) + (voff)[_i]), (PG8_LAS unsigned*)(lds + (bufoff) + ldsw + _i * 8192), 16, 0, 0); } while (0)
#define PG8_LDA(dst, b, h) do { _Pragma("unroll") for (int m = 0; m < 4; ++m) _Pragma("unroll") for (int k = 0; k < 2; ++k) dst[m][k] = *(const PG8_LAS bf16x8*)(lds + PG8_SA(b, h) + aoff + m * 2048 + k * 1024); } while (0)
#define PG8_LDB(dst, b, h) do { _Pragma("unroll") for (int n = 0; n < 2; ++n) _Pragma("unroll") for (int k = 0; k < 2; ++k) dst[n][k] = *(const PG8_LAS bf16x8*)(lds + PG8_SB(b, h) + boff + n * 2048 + k * 1024); } while (0)
#define PG8_MMA(ai, bj, At, Bt) do { __builtin_amdgcn_s_setprio(1); _Pragma("unroll") for (int m = 0; m < 4; ++m) _Pragma("unroll") for (int n = 0; n < 2; ++n) _Pragma("unroll") for (int k = 0; k < 2; ++k) \
        acc[ai][bj][m][n] = __builtin_amdgcn_mfma_f32_16x16x32_bf16(Bt[n][k], At[m][k], acc[ai][bj][m][n], 0, 0, 0); __builtin_amdgcn_s_setprio(0); } while (0)
#define PG8_WAIT_V(n) asm volatile("s_waitcnt vmcnt(" #n ")" ::: "memory")
#define PG8_WAIT_L(n) asm volatile("s_waitcnt lgkmcnt(" #n ")" ::: "memory")
#define PG8_BAR __builtin_amdgcn_s_barrier()
#define PG8_SCHED __builtin_amdgcn_sched_barrier(0)
    Unit cur, nxt; int ui = 0;
    if (!S.next(0, cur)) return;
    f32x4 acc[2][2][4][2];
#pragma unroll
    for (int a = 0; a < 2; ++a)
#pragma unroll
        for (int b = 0; b < 2; ++b)
#pragma unroll
            for (int m = 0; m < 4; ++m)
#pragma unroll
                for (int n = 0; n < 2; ++n) acc[a][b][m][n] = (f32x4){0.f, 0.f, 0.f, 0.f};
    bf16x8 At[4][2], B0[2][2], B1[2][2];
    const char* cA = (const char*)g.A + (size_t)cur.pm * tstep; const char* cB = (const char*)g.Bt + (size_t)cur.pn * tstep;
    S.a_ready(cur);
    if constexpr (SP2) {
        PG8_STAGE(PG8_SB(0, 0), cB, voffB); PG8_STAGE(PG8_SB(0, 1), cB + hstep, voffB); PG8_STAGE(PG8_SA(0, 0), cA, voffA); PG8_STAGE(PG8_SA(0, 1), cA + hstep, voffA);
        if (wr == 1) PG8_BAR;
        PG8_WAIT_V(2); PG8_BAR;
        PG8_STAGE(PG8_SB(1, 0), cB + kstep, voffB); PG8_STAGE(PG8_SA(1, 0), cA + kstep, voffA); PG8_STAGE(PG8_SB(1, 1), cB + hstep + kstep, voffB);
        PG8_WAIT_V(6); PG8_BAR;
    } else {
        PG8_STAGE(PG8_SB(0, 0), cB, voffB); PG8_STAGE(PG8_SA(0, 0), cA, voffA); PG8_STAGE(PG8_SB(0, 1), cB + hstep, voffB); PG8_STAGE(PG8_SA(0, 1), cA + hstep, voffA);
        if (wr == 1) PG8_BAR;
        PG8_WAIT_V(4); PG8_BAR;
        PG8_STAGE(PG8_SB(1, 0), cB + kstep, voffB); PG8_STAGE(PG8_SA(1, 0), cA + kstep, voffA); PG8_STAGE(PG8_SB(1, 1), cB + hstep + kstep, voffB);
        PG8_WAIT_V(6); PG8_BAR;
    }
    for (;;) {
        const bool has_next = S.next(ui + 1, nxt);
        const char* nA = has_next ? (const char*)g.A + (size_t)nxt.pm * tstep : cA; const char* nB = has_next ? (const char*)g.Bt + (size_t)nxt.pn * tstep : cB;
        for (int t = 0; t < nt; t += 2) {
            const bool last = (t == nt - 2);
            const char* a1 = cA + (size_t)(t + 1) * kstep;
            const char* a2 = last ? nA : cA + (size_t)(t + 2) * kstep; const char* b2 = last ? nB : cB + (size_t)(t + 2) * kstep;
            const char* a3 = a2 + kstep; const char* b3 = b2 + kstep;
            if (last && has_next) S.a_ready(nxt);
            if constexpr (SP2) {
            PG8_LDB(B0, 0, 0); PG8_LDB(B1, 0, 1); PG8_SCHED; PG8_LDA(At, 0, 0); PG8_STAGE(PG8_SA(1, 1), a1 + hstep, voffA);
            PG8_WAIT_V(8); PG8_WAIT_L(0); PG8_BAR; PG8_MMA(0, 0, At, B0); PG8_MMA(0, 1, At, B1); PG8_BAR; PG8_SCHED;
            PG8_LDA(At, 0, 1); PG8_STAGE(PG8_SB(0, 0), b2, voffB); PG8_STAGE(PG8_SB(0, 1), b2 + hstep, voffB); PG8_STAGE(PG8_SA(0, 0), a2, voffA);
            PG8_WAIT_V(8); PG8_WAIT_L(0); PG8_BAR; PG8_MMA(1, 0, At, B0); PG8_MMA(1, 1, At, B1); PG8_BAR; PG8_SCHED;
            PG8_LDB(B0, 1, 0); PG8_LDB(B1, 1, 1); PG8_SCHED; PG8_LDA(At, 1, 0); PG8_STAGE(PG8_SA(0, 1), a2 + hstep, voffA);
            PG8_WAIT_V(8); PG8_WAIT_L(0); PG8_BAR; PG8_MMA(0, 0, At, B0); PG8_MMA(0, 1, At, B1); PG8_BAR; PG8_SCHED;
            PG8_LDA(At, 1, 1); PG8_STAGE(PG8_SB(1, 0), b3, voffB); PG8_STAGE(PG8_SB(1, 1), b3 + hstep, voffB); PG8_STAGE(PG8_SA(1, 0), a3, voffA);
            PG8_WAIT_V(8); PG8_WAIT_L(0); PG8_BAR; PG8_MMA(1, 0, At, B0); PG8_MMA(1, 1, At, B1); PG8_BAR; PG8_SCHED;
            } else {
            PG8_LDB(B0, 0, 0); PG8_SCHED; PG8_LDA(At, 0, 0); PG8_STAGE(PG8_SA(1, 1), a1 + hstep, voffA);
            PG8_WAIT_L(8); PG8_BAR; PG8_WAIT_L(0); PG8_MMA(0, 0, At, B0); PG8_BAR; PG8_SCHED;
            PG8_LDB(B1, 0, 1); PG8_STAGE(PG8_SB(0, 0), b2, voffB);
            PG8_BAR; PG8_WAIT_L(0); PG8_MMA(0, 1, At, B1); PG8_BAR;
            PG8_LDA(At, 0, 1); PG8_STAGE(PG8_SA(0, 0), a2, voffA);
            PG8_BAR; PG8_WAIT_L(0); PG8_MMA(1, 0, At, B0); PG8_BAR; PG8_SCHED;
            PG8_STAGE(PG8_SB(0, 1), b2 + hstep, voffB);
            PG8_WAIT_V(6); PG8_BAR; PG8_MMA(1, 1, At, B1); PG8_BAR;
            PG8_LDB(B0, 1, 0); PG8_SCHED; PG8_LDA(At, 1, 0); PG8_STAGE(PG8_SA(0, 1), a2 + hstep, voffA);
            PG8_WAIT_L(8); PG8_BAR; PG8_WAIT_L(0); PG8_MMA(0, 0, At, B0); PG8_BAR; PG8_SCHED;
            PG8_LDB(B1, 1, 1); PG8_STAGE(PG8_SB(1, 0), b3, voffB);
            PG8_BAR; PG8_WAIT_L(0); PG8_MMA(0, 1, At, B1); PG8_BAR;
            PG8_LDA(At, 1, 1); PG8_STAGE(PG8_SA(1, 0), a3, voffA);
            PG8_BAR; PG8_WAIT_L(0); PG8_MMA(1, 0, At, B0); PG8_BAR; PG8_SCHED;
            PG8_STAGE(PG8_SB(1, 1), b3 + hstep, voffB);
            PG8_WAIT_V(6); PG8_BAR; PG8_MMA(1, 1, At, B1); PG8_BAR;
            }
        }
        if constexpr (ALIGN_EPI) { if (wr == 0) PG8_BAR; }
        if constexpr (!Epi::AFTER_DRAIN) { E(acc, cur, wr, wc, fr, fq); S.done(cur); }
        if (!has_next) break;
#pragma unroll
        for (int a = 0; a < 2; ++a)
#pragma unroll
            for (int b = 0; b < 2; ++b)
#pragma unroll
                for (int m = 0; m < 4; ++m)
#pragma unroll
                    for (int n = 0; n < 2; ++n) acc[a][b][m][n] = (f32x4){0.f, 0.f, 0.f, 0.f};
        cur = nxt; cA = nA; cB = nB; ++ui;
        if constexpr (ALIGN_EPI) { if (wr == 1) PG8_BAR; }
    }
    PG8_WAIT_V(0);
    if constexpr (!ALIGN_EPI) { if (wr == 0) PG8_BAR; }
    PG8_BAR;
    if constexpr (Epi::AFTER_DRAIN) { E.fused(acc, cur, wr, wc, fr, fq, lds, wid, lane); S.done(cur); }
#undef PG8_SA
#undef PG8_SB
#undef PG8_STAGE
#undef PG8_LDA
#undef PG8_LDB
#undef PG8_MMA
#undef PG8_WAIT_V
#undef PG8_WAIT_L
#undef PG8_BAR
#undef PG8_SCHED
}
}
constexpr int NWAVES = 8;
constexpr int BATCH = 4, SEQ = 8192, D = 2048, M = BATCH * SEQ, NIN = 4096, LW = 1024, CHUNK = 128, NCHUNK = SEQ / CHUNK;
constexpr int NEXP = 16384;
#ifndef MK_N_LAUNCHES
#define MK_N_LAUNCHES 1
#endif
constexpr int N_LAUNCHES = MK_N_LAUNCHES;
constexpr int PER_PHASE = 11;
constexpr size_t MiB = 1u << 20;
constexpr size_t WS_CTL = 0, CTL_ZERO_BYTES = 1 * MiB;
constexpr size_t WS_ROWSS = 512 * 1024;
constexpr size_t WS_WIN = 2 * MiB, WS_WOUT = 18 * MiB, WS_WQ = 26 * MiB, WS_LRUW = 34 * MiB, WS_WSB = 35 * MiB, WS_AGG = 36 * MiB;
constexpr size_t WS_U = 64 * MiB, WS_V = 128 * MiB, WS_XN = 192 * MiB  , WS_Z = 320 * MiB  ;
constexpr size_t WS_HB = 576 * MiB, WS_IDS = 704 * MiB, WS_GATES = 720 * MiB, WS_PAIRS = 736 * MiB, WS_HBT = 752 * MiB, WS_END = 880 * MiB;
constexpr size_t WS_USCALE = 40 * MiB, WS_VSCALE = 41 * MiB;
constexpr size_t WS_HSCALE = 44 * MiB;
constexpr size_t WS_H8 = WS_XN, WS_PART = WS_XN + 64 * MiB;
constexpr size_t WS_ASCALE = 42 * MiB, WS_KH = 43 * MiB;
constexpr size_t WS_IDW = WS_PAIRS, WS_AW = WS_PAIRS + 8 * MiB;
constexpr size_t WS_ROWSS2 = 640 * 1024;
constexpr size_t WS_Y = WS_Z;
constexpr int CW_BAR = 4096;
constexpr int RING_BYTES = 131072;
constexpr int LDSCTL_OFF = 143360, MISC_OFF = LDSCTL_OFF + 320;
constexpr int LDS_BYTES = 147456;
#define GAS __attribute__((address_space(1)))
#define LAS __attribute__((address_space(3)))
typedef unsigned short bf16;
typedef unsigned v4u __attribute__((ext_vector_type(4)));
typedef float f32x4 __attribute__((ext_vector_type(4)));
typedef short bf16x8 __attribute__((ext_vector_type(8)));
typedef GAS unsigned gu32;
typedef GAS unsigned long long gu64;
#define RLX_AGENT __ATOMIC_RELAXED, __HIP_MEMORY_SCOPE_AGENT
#define LDS_WAIT() asm volatile("s_waitcnt lgkmcnt(0)" ::: "memory")
#define VM_WAIT() asm volatile("s_waitcnt vmcnt(0)" ::: "memory")
__device__ __forceinline__ unsigned long long rt() { return __builtin_amdgcn_s_memrealtime(); }
__device__ __forceinline__ unsigned f2bf(float f) { unsigned u = __builtin_bit_cast(unsigned, f); return (u + 0x7fffu + ((u >> 16) & 1u)) >> 16; }
__device__ __forceinline__ unsigned pk2(float lo, float hi) { return f2bf(lo) | (f2bf(hi) << 16); }

#define XB_TMO      128
#define XB_XCNT(j)  (256  + 64 * (j))
#define XB_XSUB(j)  (1280 + 64 * (j))
#define XB_XGEN(j)  (2304 + 64 * (j))
#define XB_TOP      3328
#define XB_TOPGEN   3392
#define XCD_BAR_WORDS 3456
#define XB_SPIN_CAP (1u << 18)

__device__ __forceinline__ unsigned xb_ld(unsigned* p)              { return __hip_atomic_load(p, __ATOMIC_RELAXED, __HIP_MEMORY_SCOPE_AGENT); }
__device__ __forceinline__ unsigned xb_add(unsigned* p, unsigned v) { return __hip_atomic_fetch_add(p, v, __ATOMIC_RELAXED, __HIP_MEMORY_SCOPE_AGENT); }
__device__ __forceinline__ unsigned xb_xcc_id() { return (unsigned)__builtin_amdgcn_s_getreg((3 << 11) | 20) & 0xFu; }
#define XB_SPIN(cond, bar) do { unsigned _sp = 0; while (cond) { __builtin_amdgcn_s_sleep(1); \
    if ((++_sp & 255u) == 0u) { if (xb_ld(&(bar)[XB_TMO])) break; if (_sp > XB_SPIN_CAP) { atomicAdd(&(bar)[XB_TMO], 1u); break; } } } } while (0)

struct XcdBarrier {
    unsigned* bar; unsigned x;
    volatile LAS unsigned* st;
};

__device__ __forceinline__ XcdBarrier xcd_barrier_post(unsigned* bar, volatile LAS unsigned* st) {
    XcdBarrier b; b.bar = bar; b.x = xb_xcc_id(); b.st = st;
    if (threadIdx.x == 0) (void)xb_add(&bar[XB_XCNT(b.x)], 1u);
    return b;
}
__device__ __forceinline__ void xcd_barrier_complete(unsigned* bar, unsigned x, unsigned& nloc, unsigned& nx) {
    const unsigned G = gridDim.x * gridDim.y * gridDim.z;
    unsigned sum, cnt, mine, sp = 0u;
    for (;;) {
        sum = 0u; cnt = 0u; mine = 0u;
#pragma unroll
        for (unsigned j = 0; j < 16; ++j) { const unsigned c = xb_ld(&bar[XB_XCNT(j)]); sum += c; cnt += (c > 0u) ? 1u : 0u; mine = (j == x) ? c : mine; }
        if (sum == G) break;
        __builtin_amdgcn_s_sleep(1);
        if ((++sp & 255u) == 0u) { if (xb_ld(&bar[XB_TMO])) break; if (sp > XB_SPIN_CAP) { atomicAdd(&bar[XB_TMO], 1u); break; } }
    }
    nloc = mine > 0u ? mine : 1u; nx = cnt > 0u ? cnt : 1u;
}

__device__ __forceinline__ void xcd_barrier(const XcdBarrier& b) {
    asm volatile("s_waitcnt vmcnt(0)" ::: "memory");
    __syncthreads();
    if (threadIdx.x == 0) {
        unsigned* bar = b.bar;
        __builtin_amdgcn_s_waitcnt(0);
        unsigned nloc = b.st[0], nx = b.st[1];
        if (nloc == 0u) { xcd_barrier_complete(bar, b.x, nloc, nx); b.st[0] = nloc; b.st[1] = nx; }
        const unsigned old = xb_add(&bar[XB_XSUB(b.x)], 1u);
        const unsigned gen = old / nloc;
        if (old + 1u == (gen + 1u) * nloc) {
            __builtin_amdgcn_fence(__ATOMIC_RELEASE, "agent");
            asm volatile("s_waitcnt vmcnt(0)" ::: "memory");
            const unsigned og = xb_add(&bar[XB_TOP], 1u);
            const unsigned tg = og / nx;
            if (og + 1u == (tg + 1u) * nx) xb_add(&bar[XB_TOPGEN], 1u);
            else XB_SPIN(xb_ld(&bar[XB_TOPGEN]) == tg, bar);
            __builtin_amdgcn_fence(__ATOMIC_ACQUIRE, "agent");
            xb_add(&bar[XB_XGEN(b.x)], 1u);
            asm volatile("s_waitcnt vmcnt(0)" ::: "memory");
        } else {
            XB_SPIN(xb_ld(&bar[XB_XGEN(b.x)]) == gen, bar);
            __builtin_amdgcn_fence(__ATOMIC_ACQUIRE, "agent");
            asm volatile("s_waitcnt vmcnt(0)" ::: "memory");
        }
    }
    __syncthreads();
}
typedef unsigned v2u __attribute__((ext_vector_type(2)));
typedef float f32x2 __attribute__((ext_vector_type(2)));
struct Args { const float* in[21]; float* out; unsigned char* ws; int ph_lo, ph_hi; };
struct Frame {
    const Args& A;
    LAS unsigned char* lds;
    volatile LAS unsigned* MISC;
    gu32* ctl;
    unsigned char* ws;
    int tid, lane, wave, vcu, G;
    __device__ __forceinline__ Frame(const Args& a) : A(a) {}
#define WSP(name, type, off) __device__ __forceinline__ type* name() const { return (type*)(ws + (off)); }
    WSP(WIN, bf16, WS_WIN) WSP(WOUT, bf16, WS_WOUT) WSP(WQ, bf16, WS_WQ) WSP(LRUW, bf16, WS_LRUW) WSP(WSB, bf16, WS_WSB)
    WSP(XN, bf16, WS_XN) WSP(MIX, bf16, WS_XN) WSP(Z, bf16, WS_Z) WSP(HB, bf16, WS_HB) WSP(HBT, bf16, WS_HBT)
    WSP(U8, unsigned char, WS_U) WSP(V8T, unsigned char, WS_V)
    WSP(ROWSS, float, WS_ROWSS) WSP(ROWSS2, float, WS_ROWSS2) WSP(QH, bf16, WS_Z) WSP(QL, bf16, WS_Z + 128 * MiB) WSP(KH, bf16, WS_KH) WSP(KL, bf16, WS_KH + 512 * 1024) WSP(AGG, float, WS_AGG) WSP(GATES, float, WS_GATES)
    WSP(USCALE, float, WS_USCALE) WSP(VSCALE, float, WS_VSCALE) WSP(Y, float, WS_Y) WSP(IDS, int, WS_IDS) WSP(ASCALE, float, WS_ASCALE) WSP(IDW, v2u, WS_IDW) WSP(AW, unsigned, WS_AW) WSP(H8, unsigned char, WS_H8) WSP(HSCALE, float, WS_HSCALE) WSP(PART, int, WS_PART)
#undef WSP
};
__device__ __forceinline__ float wave_sum(float v) {
#pragma unroll
    for (int o = 1; o < 64; o <<= 1) v += __shfl_xor(v, o);
    return v;
}
__device__ __forceinline__ float bf_lo(unsigned w) { return __builtin_bit_cast(float, w << 16); }
__device__ __forceinline__ float bf_hi(unsigned w) { return __builtin_bit_cast(float, w & 0xffff0000u); }
__device__ __forceinline__ float bf1(unsigned short h) { return __builtin_bit_cast(float, (unsigned)h << 16); }
__device__ __forceinline__ float sigmoidf_(float x) { return __builtin_amdgcn_rcpf(1.0f + __builtin_amdgcn_exp2f(-1.4426950409f * x)); }
using pg8::gelu_tanh;
__device__ __forceinline__ unsigned pack_i8x4(float a, float b, float c, float d) {
    const int ia = (int)__builtin_rintf(a), ib = (int)__builtin_rintf(b), ic = (int)__builtin_rintf(c), id = (int)__builtin_rintf(d);
    return (unsigned)(ia & 0xff) | ((unsigned)(ib & 0xff) << 8) | ((unsigned)(ic & 0xff) << 16) | ((unsigned)id << 24);
}

__device__ __forceinline__ void p0_transpose_item(const float* W, int K, int N, bf16* WT, const float* kscale, LAS float* scr, int item, int lane) {
    const int nblk = N / 32, kb = item / nblk, nb = item % nblk, k0 = 64 * kb, n0 = 32 * nb;
#pragma unroll 8
    for (int i = 0; i < 32; ++i) { const int kk = 2 * i + (lane >> 5); const float sc = kscale ? kscale[k0 + kk] : 1.0f; scr[kk * 33 + (lane & 31)] = W[(size_t)(k0 + kk) * N + n0 + (lane & 31)] * sc; }
    LDS_WAIT(); asm volatile("" ::: "memory");
    const int c = lane & 7;
#pragma unroll
    for (int j = 0; j < 4; ++j) { const int n = (lane >> 3) + 8 * j; const LAS float* s = scr + (8 * c) * 33 + n;
        v4u o; o.x = pk2(s[0 * 33], s[1 * 33]); o.y = pk2(s[2 * 33], s[3 * 33]); o.z = pk2(s[4 * 33], s[5 * 33]); o.w = pk2(s[6 * 33], s[7 * 33]);
        *(GAS v4u*)(WT + (size_t)(n0 + n) * K + k0 + 8 * c) = o; }
    LDS_WAIT(); asm volatile("" ::: "memory");
}
__device__ __forceinline__ void p0_prologue(Frame& F) {
    LAS float* scr = (LAS float*)(F.lds + F.wave * 16384);
    const int gw = F.vcu * NWAVES + F.wave, NGW = F.G * NWAVES, lane = F.lane;
    constexpr int I_IN = (D / 64) * (NIN / 32), I_OUT = (D / 64) * (D / 32), I_Q = I_OUT, I_LRU = 32 * 8;
    constexpr int NITEMS = I_IN + I_OUT + I_Q + I_LRU;
    for (int it = gw; it < NITEMS; it += NGW) {
        int r = it;
        if (r < I_IN) { p0_transpose_item(F.A.in[2], D, NIN, F.WIN(), F.A.in[1], scr, r, lane); continue; } r -= I_IN;
        if (r < I_OUT) { p0_transpose_item(F.A.in[14], D, D, F.WOUT(), nullptr, scr, r, lane); continue; } r -= I_OUT;
        if (r < I_Q) { p0_transpose_item(F.A.in[16], D, D, F.WQ(), F.A.in[15], scr, r, lane); continue; } r -= I_Q;
        { const int mi = r >> 3, sub = r & 7, gate = mi >> 4, rest = mi & 15;
          const float* src = (gate ? F.A.in[7] : F.A.in[5]) + (size_t)rest * 16384;
          p0_transpose_item(src, 128, 128, F.LRUW() + (size_t)mi * 16384, nullptr, scr, sub, lane); }
    }
    const size_t gt = (size_t)gw * 64 + lane, NGT = (size_t)NGW * 64;
    {
        const float* g2 = F.A.in[15];
        f32x4 gg[8];
#pragma unroll
        for (int j = 0; j < 8; ++j) gg[j] = *(const GAS f32x4*)(g2 + j * 256 + lane * 4);
        for (int e = gw; e < NEXP; e += NGW) {
            const GAS f32x4* ur = (const GAS f32x4*)(F.A.in[18] + (size_t)e * D) + lane;
            f32x4 v[8]; float mx = 0.f;
#pragma unroll
            for (int j = 0; j < 8; ++j) { v[j] = ur[64 * j] * gg[j]; mx = fmaxf(mx, fmaxf(fmaxf(fabsf(v[j].x), fabsf(v[j].y)), fmaxf(fabsf(v[j].z), fabsf(v[j].w)))); }
#pragma unroll
            for (int o = 1; o < 64; o <<= 1) mx = fmaxf(mx, __shfl_xor(mx, o));
            const float sc = mx > 0.f ? 127.0f / mx : 1.0f;
            GAS unsigned* o4 = (GAS unsigned*)(F.U8() + (size_t)e * D) + lane;
#pragma unroll
            for (int j = 0; j < 8; ++j) o4[64 * j] = pack_i8x4(v[j].x * sc, v[j].y * sc, v[j].z * sc, v[j].w * sc);
            if (lane == 0) F.USCALE()[e] = mx > 0.f ? mx * (1.0f / 127.0f) : 1.0f;
        }
    }
    __syncthreads();
    for (int un = blockIdx.x; un < NEXP / 64; un += F.G) {
        const int e0 = un * 64;
        for (int rr = 0; rr < 8; ++rr) {
            const int el = F.wave * 8 + rr, e = e0 + el;
            const GAS f32x4* vr = (const GAS f32x4*)(F.A.in[19] + (size_t)e * D) + lane;
            f32x4 v[8]; float mx = 0.f;
#pragma unroll
            for (int j = 0; j < 8; ++j) { v[j] = vr[64 * j]; mx = fmaxf(mx, fmaxf(fmaxf(fabsf(v[j].x), fabsf(v[j].y)), fmaxf(fabsf(v[j].z), fabsf(v[j].w)))); }
#pragma unroll
            for (int o = 1; o < 64; o <<= 1) mx = fmaxf(mx, __shfl_xor(mx, o));
            const float sc = mx > 0.f ? 127.0f / mx : 1.0f;
#pragma unroll
            for (int j = 0; j < 8; ++j) *(LAS unsigned*)(F.lds + el * 2056 + j * 256 + lane * 4) = pack_i8x4(v[j].x * sc, v[j].y * sc, v[j].z * sc, v[j].w * sc);
            if (lane == 0) F.VSCALE()[e] = mx > 0.f ? mx * (1.0f / 127.0f) : 1.0f;
        }
        __syncthreads();
        for (int cc = 0; cc < 32; ++cc) { const int c = F.wave * 32 + cc;
            const v2u w = *(const LAS v2u*)(F.lds + lane * 2056 + c * 8);
            *(GAS v2u*)(F.V8T() + ((size_t)c * NEXP + e0 + lane) * 8) = w; }
        __syncthreads();
    }
    for (size_t ch = gt; ch < (size_t)8 * 128 * 128 / 8; ch += NGT) {
        const size_t e0 = ch * 8;
        const f32x4 a = *(const GAS f32x4*)(F.A.in[12] + e0), b = *(const GAS f32x4*)(F.A.in[12] + e0 + 4);
        v4u o; o.x = pk2(a.x, a.y); o.y = pk2(a.z, a.w); o.z = pk2(b.x, b.y); o.w = pk2(b.z, b.w);
        *(GAS v4u*)(F.WSB() + e0) = o;
    }
    for (size_t ch = gt; ch < (size_t)16 * 128 * 128 / 8; ch += NGT) {
        const size_t e0 = ch * 8;
        const f32x4 a = *(const GAS f32x4*)(F.A.in[17] + e0), b = *(const GAS f32x4*)(F.A.in[17] + e0 + 4);
        v4u hi; hi.x = pk2(a.x, a.y); hi.y = pk2(a.z, a.w); hi.z = pk2(b.x, b.y); hi.w = pk2(b.z, b.w);
        *(GAS v4u*)(F.KH() + e0) = hi;
    }
    for (int m = gw; m < M; m += NGW) {
        const GAS f32x4* xr = (const GAS f32x4*)(F.A.in[0] + (size_t)m * D) + lane;
        f32x4 v[8]; float s = 0.f;
#pragma unroll
        for (int j = 0; j < 8; ++j) { v[j] = xr[64 * j]; s += (v[j].x * v[j].x + v[j].y * v[j].y) + (v[j].z * v[j].z + v[j].w * v[j].w); }
        const float rstd = __builtin_amdgcn_rsqf(wave_sum(s) * (1.f / D) + 1e-6f);
        GAS unsigned long long* o8 = (GAS unsigned long long*)(F.XN() + (size_t)m * D) + lane;
#pragma unroll
        for (int j = 0; j < 8; ++j) o8[64 * j] = (unsigned long long)pk2(v[j].x * rstd, v[j].y * rstd) | ((unsigned long long)pk2(v[j].z * rstd, v[j].w * rstd) << 32);
    }
}
constexpr int LRU_XR = 0, LRU_XC = 33792, LRU_GR = 33792 + 34816;
constexpr float LOG2E = 1.4426950408889634f;

template <bool APPLY, int DIR>
__device__ __forceinline__ void lru_dir(Frame& F, int b, int c, int h, float (&hsum)[8][4]) {
    const int lane = F.lane, w = F.wave, fr = lane & 15, fq = lane >> 4;
    LAS unsigned char* XC = F.lds + LRU_XC;
    const int chl = 16 * w + fr, chg = h * 128 + chl;
    bf16x8 Ba[4], Bx[4];
    {
        const bf16* wa = F.LRUW() + (size_t)((0 * 2 + DIR) * 8 + h) * 16384 + (size_t)chl * 128 + 8 * fq;
        const bf16* wx = F.LRUW() + (size_t)((1 * 2 + DIR) * 8 + h) * 16384 + (size_t)chl * 128 + 8 * fq;
#pragma unroll
        for (int ks = 0; ks < 4; ++ks) { Ba[ks] = *(const GAS bf16x8*)(wa + 32 * ks); Bx[ks] = *(const GAS bf16x8*)(wx + 32 * ks); }
    }
    const float ba = F.A.in[6][DIR * LW + chg], bx = F.A.in[8][DIR * LW + chg], lam = F.A.in[9][DIR * LW + chg];
    const float cl = -8.0f * log1pf(__expf(-lam)) * LOG2E;
    float carry = 0.f;
    if (APPLY) {
        const f32x2* aggb = (const f32x2*)F.AGG() + (size_t)((b * 2 + DIR) * NCHUNK) * LW + h * 128 + 16 * w;
        const int cc = DIR == 0 ? lane : NCHUNK - 1 - lane;
        const int pos_c = DIR == 0 ? c : NCHUNK - 1 - c;
        f32x2 pe[16];
#pragma unroll
        for (int i = 0; i < 16; ++i) pe[i] = aggb[(size_t)cc * LW + i];
#pragma unroll
        for (int i = 0; i < 16; ++i) {
            float A = pe[i].x, B = pe[i].y;
#pragma unroll
            for (int o = 1; o < 64; o <<= 1) { const float pa = __shfl_up(A, o), pb = __shfl_up(B, o); if (lane >= o) { B = A * pb + B; A = A * pa; } }
            const float cv = __shfl(B, pos_c - 1);
            if (fr == i) carry = pos_c > 0 ? cv : 0.f;
        }
    }
    float totA = 1.f, totB = 0.f;
    const int src1 = DIR == 0 ? lane - 16 : lane + 16, src2 = DIR == 0 ? lane - 32 : lane + 32;
    const bool v1 = DIR == 0 ? (fq >= 1) : (fq <= 2), v2 = DIR == 0 ? (fq >= 2) : (fq <= 1);
    const int lastl = DIR == 0 ? fr + 48 : fr;
#pragma unroll
    for (int mm = 0; mm < 8; ++mm) {
        const int m = DIR == 0 ? mm : 7 - mm;
        f32x4 R = (f32x4){0.f, 0.f, 0.f, 0.f}, I = (f32x4){0.f, 0.f, 0.f, 0.f};
#pragma unroll
        for (int ks = 0; ks < 4; ++ks) {
            const bf16x8 a = *(const LAS bf16x8*)(XC + (16 * m + fr) * 272 + (32 * ks + 8 * fq) * 2);
            R = __builtin_amdgcn_mfma_f32_16x16x32_bf16(a, Ba[ks], R, 0, 0, 0);
            I = __builtin_amdgcn_mfma_f32_16x16x32_bf16(a, Bx[ks], I, 0, 0, 0);
        }
#pragma unroll
        for (int j = 0; j < 4; ++j) {
            const float r = sigmoidf_(R[j] + ba), ig = sigmoidf_(I[j] + bx);
            const float a = __builtin_amdgcn_exp2f(cl * r);
            const float xc = bf1(*(const LAS unsigned short*)(XC + (16 * m + 4 * fq + j) * 272 + chl * 2));
            const float om = fmaxf(1.0f - a * a, 0.0f);
            R[j] = a; I[j] = __builtin_amdgcn_sqrtf(om) * (ig * xc);
        }
        float A = 1.f, B = 0.f;
#pragma unroll
        for (int jj = 0; jj < 4; ++jj) { const int j = DIR == 0 ? jj : 3 - jj; B = R[j] * B + I[j]; A = R[j] * A; }
        { const float pa = __shfl(A, src1), pb = __shfl(B, src1); if (v1) { B = A * pb + B; A = A * pa; } }
        { const float pa = __shfl(A, src2), pb = __shfl(B, src2); if (v2) { B = A * pb + B; A = A * pa; } }
        const float TA = __shfl(A, lastl), TB = __shfl(B, lastl);
        if (APPLY) {
            float EA = __shfl(A, src1), EB = __shfl(B, src1); if (!v1) { EA = 1.f; EB = 0.f; }
            float hh = EA * carry + EB;
#pragma unroll
            for (int jj = 0; jj < 4; ++jj) { const int j = DIR == 0 ? jj : 3 - jj; hh = R[j] * hh + I[j]; if (DIR == 0) hsum[m][j] = hh; else hsum[m][j] += hh; }
            carry = TA * carry + TB;
        } else { totB = TA * totB + TB; totA = TA * totA; }
    }
    if (!APPLY) { if (fq == 0) { f32x2* agg = (f32x2*)F.AGG() + (size_t)((b * 2 + DIR) * NCHUNK + c) * LW + chg; *agg = (f32x2){totA, totB}; } }
}

template <bool APPLY>
__device__ __forceinline__ void lru_unit(Frame& F, int unit) {
    const int h = unit & 7, c = (unit >> 3) & 63, b = unit >> 9;
    const int tid = F.tid, lane = F.lane, w = F.wave, fr = lane & 15, fq = lane >> 4;
    const size_t t0 = (size_t)b * SEQ + (size_t)c * CHUNK;
    LAS unsigned char* XR = F.lds + LRU_XR; LAS unsigned char* XC = F.lds + LRU_XC; LAS unsigned char* GR = F.lds + LRU_GR;
    for (int p = tid; p < 131 * 16; p += 512) { const int r = p >> 4, cg = p & 15; const int s = c * CHUNK - 2 + r; v4u v = (v4u){0u, 0u, 0u, 0u};
        if (s >= 0 && s < SEQ) v = *(const GAS v4u*)(F.Z() + ((size_t)b * SEQ + s) * NIN + h * 128 + cg * 8);
        *(LAS v4u*)(XR + r * 256 + cg * 16) = v; }
    if (APPLY) { for (int p = tid; p < 128 * 32; p += 512) { const int r = p >> 5, cg = p & 31;
        *(LAS v2u*)(GR + r * 264 + cg * 8) = *(const GAS v2u*)(F.Z() + (t0 + r) * NIN + LW + h * 128 + cg * 4); } }
    __syncthreads();
    {
        const int ch2 = tid & 63, tg = tid >> 6, chg = h * 128 + 2 * ch2;
        float w0[4], w1[4];
#pragma unroll
        for (int k = 0; k < 4; ++k) { w0[k] = F.A.in[3][k * LW + chg]; w1[k] = F.A.in[3][k * LW + chg + 1]; }
        const float b0 = F.A.in[4][chg], b1 = F.A.in[4][chg + 1];
        float x0[4], x1[4];
#pragma unroll
        for (int k = 0; k < 3; ++k) { const unsigned u = *(const LAS unsigned*)(XR + (16 * tg + k) * 256 + ch2 * 4); x0[k] = bf_lo(u); x1[k] = bf_hi(u); }
#pragma unroll
        for (int j = 0; j < 16; ++j) {
            const unsigned u = *(const LAS unsigned*)(XR + (16 * tg + j + 3) * 256 + ch2 * 4); x0[3] = bf_lo(u); x1[3] = bf_hi(u);
            const float y0 = b0 + ((w0[0] * x0[0] + w0[1] * x0[1]) + (w0[2] * x0[2] + w0[3] * x0[3]));
            const float y1 = b1 + ((w1[0] * x1[0] + w1[1] * x1[1]) + (w1[2] * x1[2] + w1[3] * x1[3]));
            *(LAS unsigned*)(XC + (16 * tg + j) * 272 + ch2 * 4) = pk2(y0, y1);
            x0[0] = x0[1]; x0[1] = x0[2]; x0[2] = x0[3]; x1[0] = x1[1]; x1[1] = x1[2]; x1[2] = x1[3];
        }
    }
    __syncthreads();
    float hsum[8][4];
    lru_dir<APPLY, 0>(F, b, c, h, hsum);
    asm volatile("" ::: "memory"); __builtin_amdgcn_sched_barrier(0);
    lru_dir<APPLY, 1>(F, b, c, h, hsum);
    if (APPLY) {
        const int chl = 16 * w + fr;
#pragma unroll
        for (int m = 0; m < 8; ++m)
#pragma unroll
            for (int j = 0; j < 4; ++j) { LAS unsigned short* p = (LAS unsigned short*)(GR + (16 * m + 4 * fq + j) * 264 + chl * 2); *p = (unsigned short)f2bf(bf1(*p) * hsum[m][j]); }
        __syncthreads();
        for (int p = tid; p < 128 * 32; p += 512) { const int r = p >> 5, cg = p & 31;
            *(GAS v2u*)(F.MIX() + (t0 + r) * D + h * 128 + cg * 4) = *(const LAS v2u*)(GR + r * 264 + cg * 8); }
    }
    __syncthreads();
}
constexpr int GM_ST = 0, GM_BS = 1024, GM_VN = 2048, GM_GU = 2048 + 32768;
typedef short s16x4 __attribute__((ext_vector_type(4)));
__device__ __forceinline__ unsigned vn_off(unsigned row, unsigned ch) { return 256u * row + 16u * (ch ^ (((row & 3u) << 2) | ((row >> 2) & 3u))); }
__device__ __forceinline__ void gmlp_unit(Frame& F, int unit) {
    const int tid = F.tid, lane = F.lane, w = F.wave, fr = lane & 15, fq = lane >> 4;
    const size_t t0 = (size_t)unit * CHUNK;
    LAS float* ST = (LAS float*)(F.lds + GM_ST); LAS float* BS = (LAS float*)(F.lds + GM_BS);
    LAS unsigned char* VN = F.lds + GM_VN; LAS unsigned char* GU = F.lds + GM_GU;
    for (int rr = 0; rr < 16; ++rr) {
        const int row = 16 * w + rr;
        const bf16* p = F.Z() + (t0 + row) * NIN + 3 * LW + lane * 8;
        const v4u a = *(const GAS v4u*)p, b = *(const GAS v4u*)(p + 512);
        float x[16] = {bf_lo(a.x), bf_hi(a.x), bf_lo(a.y), bf_hi(a.y), bf_lo(a.z), bf_hi(a.z), bf_lo(a.w), bf_hi(a.w),
                       bf_lo(b.x), bf_hi(b.x), bf_lo(b.y), bf_hi(b.y), bf_lo(b.z), bf_hi(b.z), bf_lo(b.w), bf_hi(b.w)};
        float s = 0.f;
#pragma unroll
        for (int i = 0; i < 16; ++i) s += x[i];
        const float mean = wave_sum(s) * (1.0f / LW);
        float q = 0.f;
#pragma unroll
        for (int i = 0; i < 16; ++i) { const float d = x[i] - mean; q += d * d; }
        const float rstd = __builtin_amdgcn_rsqf(wave_sum(q) * (1.0f / LW) + 1e-6f);
        if (lane == 0) { ST[2 * row] = mean; ST[2 * row + 1] = rstd; }
    }
    __syncthreads();
    const unsigned trq = (unsigned)(lane & 15) >> 2, trp = (unsigned)lane & 3u;
    for (int h = 0; h < 8; ++h) {
#pragma unroll
        for (int i = 0; i < 4; ++i) { const int pid = tid + 512 * i, q = pid >> 4, cg = pid & 15;
            const v4u a = *(const GAS v4u*)(F.Z() + (t0 + q) * NIN + 3 * LW + h * 128 + cg * 8);
            const float mean = ST[2 * q], rstd = ST[2 * q + 1];
            const f32x4 g0 = *(const GAS f32x4*)(F.A.in[10] + h * 128 + cg * 8), g1 = *(const GAS f32x4*)(F.A.in[10] + h * 128 + cg * 8 + 4);
            const f32x4 b0 = *(const GAS f32x4*)(F.A.in[11] + h * 128 + cg * 8), b1 = *(const GAS f32x4*)(F.A.in[11] + h * 128 + cg * 8 + 4);
            v4u o;
            o.x = pk2((bf_lo(a.x) - mean) * rstd * g0.x + b0.x, (bf_hi(a.x) - mean) * rstd * g0.y + b0.y);
            o.y = pk2((bf_lo(a.y) - mean) * rstd * g0.z + b0.z, (bf_hi(a.y) - mean) * rstd * g0.w + b0.w);
            o.z = pk2((bf_lo(a.z) - mean) * rstd * g1.x + b1.x, (bf_hi(a.z) - mean) * rstd * g1.y + b1.y);
            o.w = pk2((bf_lo(a.w) - mean) * rstd * g1.z + b1.z, (bf_hi(a.w) - mean) * rstd * g1.w + b1.w);
            *(LAS v4u*)(VN + vn_off((unsigned)q, (unsigned)cg)) = o;
        }
#pragma unroll
        for (int i = 0; i < 8; ++i) { const int pid = tid + 512 * i, r = pid >> 5, cg = pid & 31;
            *(LAS v2u*)(GU + r * 264 + cg * 8) = *(const GAS v2u*)(F.Z() + (t0 + r) * NIN + 2 * LW + h * 128 + cg * 4); }
        if (tid < 128) BS[tid] = F.A.in[13][h * 128 + tid];
        bf16x8 Af[4];
        { const bf16* wsb = F.WSB() + (size_t)h * 16384 + (size_t)(16 * w + fr) * 128 + 8 * fq;
#pragma unroll
          for (int ks = 0; ks < 4; ++ks) Af[ks] = *(const GAS bf16x8*)(wsb + 32 * ks); }
        __syncthreads();
        f32x4 acc[8];
#pragma unroll
        for (int n = 0; n < 8; ++n) {
            acc[n] = (f32x4){0.f, 0.f, 0.f, 0.f};
#pragma unroll
            for (int ks = 0; ks < 4; ++ks) {
                const s16x4 b0 = __builtin_amdgcn_ds_read_tr16_b64_v4i16((LAS s16x4*)(VN + vn_off(32u * ks + 8u * fq + trq, 2u * n + (trp >> 1)) + 8u * (trp & 1u)));
                const s16x4 b1 = __builtin_amdgcn_ds_read_tr16_b64_v4i16((LAS s16x4*)(VN + vn_off(32u * ks + 8u * fq + 4u + trq, 2u * n + (trp >> 1)) + 8u * (trp & 1u)));
                const bf16x8 bb = (bf16x8){b0[0], b0[1], b0[2], b0[3], b1[0], b1[1], b1[2], b1[3]};
                acc[n] = __builtin_amdgcn_mfma_f32_16x16x32_bf16(Af[ks], bb, acc[n], 0, 0, 0);
            }
        }
#pragma unroll
        for (int n = 0; n < 8; ++n)
#pragma unroll
            for (int j = 0; j < 4; ++j) { const int p = 16 * w + 4 * fq + j; LAS unsigned short* ad = (LAS unsigned short*)(GU + p * 264 + (16 * n + fr) * 2);
                *ad = (unsigned short)f2bf(bf1(*ad) * (acc[n][j] + BS[p])); }
        __syncthreads();
#pragma unroll
        for (int i = 0; i < 8; ++i) { const int pid = tid + 512 * i, r = pid >> 5, cg = pid & 31;
            *(GAS v2u*)(F.MIX() + (t0 + r) * D + LW + h * 128 + cg * 4) = *(const LAS v2u*)(GU + r * 264 + cg * 8); }
        __syncthreads();
    }
}
typedef float f32x16 __attribute__((ext_vector_type(16)));
__device__ __forceinline__ unsigned fkey(float f) { const unsigned u = __builtin_bit_cast(unsigned, f); return (u & 0x80000000u) ? ~u : (u | 0x80000000u); }
__device__ __forceinline__ float fkey_inv(unsigned k) { const unsigned u = (k & 0x80000000u) ? (k & 0x7fffffffu) : ~k; return __builtin_bit_cast(float, u); }
__device__ __forceinline__ unsigned umax_(unsigned a, unsigned b) { return a > b ? a : b; }
__device__ __forceinline__ unsigned umin_(unsigned a, unsigned b) { return a < b ? a : b; }
#define CE_DESC(x, y) do { const unsigned a_ = (x), b_ = (y); (x) = umax_(a_, b_); (y) = umin_(a_, b_); } while (0)
__device__ __forceinline__ void sort16_desc(unsigned (&a)[16]) {
#pragma unroll
    for (int k = 2; k <= 16; k <<= 1)
#pragma unroll
        for (int j = k >> 1; j >= 1; j >>= 1)
#pragma unroll
            for (int i = 0; i < 16; ++i) { const int l = i ^ j; if (l > i) { if ((i & k) == 0) CE_DESC(a[i], a[l]); else CE_DESC(a[l], a[i]); } }
}
__device__ __forceinline__ void merge16_desc(unsigned (&a)[16], const unsigned (&b)[16]) {
#pragma unroll
    for (int i = 0; i < 16; ++i) a[i] = umax_(a[i], b[15 - i]);
#pragma unroll
    for (int j = 8; j >= 1; j >>= 1)
#pragma unroll
        for (int i = 0; i < 16; ++i) if ((i & j) == 0) CE_DESC(a[i], a[i + j]);
}
typedef short bf16x8s __attribute__((ext_vector_type(8)));
__device__ __forceinline__ void topk_unit(Frame& F, int wu) {
    const int tg = wu >> 3, hd = wu & 7, lane = F.lane, r = lane & 31, hh = lane >> 5;
    const int t = tg * 32 + r;
    const size_t qoff = (size_t)t * D + hd * 256 + 8 * hh;
    unsigned L[2][16];
    unsigned hh4 = (unsigned)hh << 2; asm volatile("" : "+v"(hh4));
#pragma unroll
    for (int p = 0; p < 2; ++p) {
        f32x16 acc[4];
#pragma unroll
        for (int nt = 0; nt < 4; ++nt)
#pragma unroll
            for (int i = 0; i < 16; ++i) acc[nt][i] = 0.f;
        const size_t koff = ((size_t)(hd * 2 + p) * 128 + r) * 128 + 8 * hh;
        const bf16* qp = F.QH() + qoff + p * 128; const bf16* kp0 = F.KH() + koff; const bf16* kp1 = kp0 + 32 * 128; const bf16* kp2 = kp0 + 64 * 128; const bf16* kp3 = kp0 + 96 * 128;
        asm volatile("" : "+v"(qp), "+v"(kp0), "+v"(kp1), "+v"(kp2), "+v"(kp3));
#define P6_LOAD(Q, K, ks0, n) _Pragma("unroll") for (int i_ = 0; i_ < (n); ++i_) { Q[i_] = *(const GAS bf16x8s*)(qp + 16 * ((ks0) + i_)); \
            K[i_][0] = *(const GAS bf16x8s*)(kp0 + 16 * ((ks0) + i_)); K[i_][1] = *(const GAS bf16x8s*)(kp1 + 16 * ((ks0) + i_)); \
            K[i_][2] = *(const GAS bf16x8s*)(kp2 + 16 * ((ks0) + i_)); K[i_][3] = *(const GAS bf16x8s*)(kp3 + 16 * ((ks0) + i_)); }
#define P6_MMA(Q, K, n) _Pragma("unroll") for (int i_ = 0; i_ < (n); ++i_) _Pragma("unroll") for (int nt = 0; nt < 4; ++nt) acc[nt] = __builtin_amdgcn_mfma_f32_32x32x16_bf16(K[i_][nt], Q[i_], acc[nt], 0, 0, 0);
        bf16x8s qa[3], ka[3][4], qb[3], kb[3][4];
        P6_LOAD(qa, ka, 0, 3); P6_LOAD(qb, kb, 3, 3);
        __builtin_amdgcn_sched_barrier(0);
        P6_MMA(qa, ka, 3);
        __builtin_amdgcn_sched_barrier(0);
        P6_LOAD(qa, ka, 6, 2);
        __builtin_amdgcn_sched_barrier(0);
        P6_MMA(qb, kb, 3);
        __builtin_amdgcn_sched_barrier(0);
        P6_MMA(qa, ka, 2);
        __builtin_amdgcn_sched_barrier(0);
#undef P6_LOAD
#undef P6_MMA
        unsigned S[4][16];
#pragma unroll
        for (int nt = 0; nt < 4; ++nt) {
#pragma unroll
            for (int rg = 0; rg < 16; ++rg) { const int nc = 32 * nt + (rg & 3) + 8 * (rg >> 2); S[nt][rg] = ((fkey(acc[nt][rg]) & ~0x7Fu) | (unsigned)(127 - nc)) ^ hh4; }
            sort16_desc(S[nt]);
        }
        merge16_desc(S[0], S[1]); merge16_desc(S[2], S[3]); merge16_desc(S[0], S[2]);
        unsigned T[16];
#pragma unroll
        for (int i = 0; i < 16; ++i) T[i] = (unsigned)__shfl_xor((int)S[0][i], 32);
        merge16_desc(S[0], T);
#pragma unroll
        for (int i = 0; i < 16; ++i) L[p][i] = S[0][i];
        __builtin_amdgcn_sched_barrier(0);
    }
    float v0[16], v1[16];
#pragma unroll
    for (int i = 0; i < 16; ++i) { v0[i] = fkey_inv(L[0][i] & ~0x7Fu); v1[i] = fkey_inv(L[1][i] & ~0x7Fu); }
    unsigned C[4][16];
    {
        int cnt = 0;
#pragma unroll
        for (int i = 0; i < 16; ++i)
#pragma unroll
            for (int j = 0; j < 16; ++j) if ((i + 1) * (j + 1) <= 16) { C[cnt >> 4][cnt & 15] = (fkey(v0[i] + v1[j]) & ~0xFFu) | (unsigned)(255 - (i * 16 + j)); ++cnt; }
#pragma unroll
        for (int q = 50; q < 64; ++q) C[q >> 4][q & 15] = 0u;
    }
    sort16_desc(C[0]); sort16_desc(C[1]); sort16_desc(C[2]); sort16_desc(C[3]);
    merge16_desc(C[0], C[1]); merge16_desc(C[2], C[3]); merge16_desc(C[0], C[2]);
    unsigned best[16];
#pragma unroll
    for (int i = 0; i < 16; ++i) best[i] = C[0][i];
    float sv[16]; int ids[16];
    const float smax = fkey_inv(best[0] & ~0xFFu);
    float ssum = 0.f;
#pragma unroll
    for (int k = 0; k < 16; ++k) {
        const unsigned pos = 255u - (best[k] & 0xFFu); const unsigned ii = pos >> 4, jj = pos & 15u;
        unsigned k0 = L[0][0], k1 = L[1][0];
#pragma unroll
        for (int i = 1; i < 16; ++i) { k0 = (ii == (unsigned)i) ? L[0][i] : k0; k1 = (jj == (unsigned)i) ? L[1][i] : k1; }
        ids[k] = (int)((127u - (k0 & 0x7Fu)) * 128u + (127u - (k1 & 0x7Fu)));
        sv[k] = __builtin_amdgcn_exp2f((fkey_inv(best[k] & ~0xFFu) - smax) * 1.4426950409f); ssum += sv[k];
    }
    const float inv = 1.0f / ssum;
    if (hh == 0) {
        int* o = F.IDS() + (size_t)t * 128 + hd * 16;
#pragma unroll
        for (int k = 0; k < 16; k += 4) *(GAS v4u*)(o + k) = (v4u){(unsigned)ids[k], (unsigned)ids[k + 1], (unsigned)ids[k + 2], (unsigned)ids[k + 3]};
    } else {
        float* o = F.GATES() + (size_t)t * 128 + hd * 16;
#pragma unroll
        for (int k = 0; k < 16; k += 4) *(GAS f32x4*)(o + k) = (f32x4){sv[k] * inv, sv[k + 1] * inv, sv[k + 2] * inv, sv[k + 3] * inv};
    }
}
__device__ __forceinline__ int idot16(const v4u u, const unsigned* h, int acc) {
    acc = __builtin_amdgcn_sdot4((int)u.x, (int)h[0], acc, false); acc = __builtin_amdgcn_sdot4((int)u.y, (int)h[1], acc, false);
    acc = __builtin_amdgcn_sdot4((int)u.z, (int)h[2], acc, false); acc = __builtin_amdgcn_sdot4((int)u.w, (int)h[3], acc, false);
    return acc;
}
__device__ __forceinline__ void h8_row(Frame& F, int t) {
    const int lane = F.lane;
    float hx[32]; float mx = 0.f;
    const bf16* hp = F.HB() + (size_t)t * D + lane * 16;
#pragma unroll
    for (int c = 0; c < 2; ++c)
#pragma unroll
        for (int q = 0; q < 2; ++q) { const v4u a = *(const GAS v4u*)(hp + c * 1024 + q * 8); float* x = hx + c * 16 + q * 8;
            x[0] = bf_lo(a.x); x[1] = bf_hi(a.x); x[2] = bf_lo(a.y); x[3] = bf_hi(a.y); x[4] = bf_lo(a.z); x[5] = bf_hi(a.z); x[6] = bf_lo(a.w); x[7] = bf_hi(a.w); }
#pragma unroll
    for (int i = 0; i < 32; ++i) mx = fmaxf(mx, fabsf(hx[i]));
#pragma unroll
    for (int o = 1; o < 64; o <<= 1) mx = fmaxf(mx, __shfl_xor(mx, o));
    const float sc = mx > 0.f ? 127.0f / mx : 1.0f;
#pragma unroll
    for (int c = 0; c < 2; ++c) { v4u o; o.x = pack_i8x4(hx[c * 16 + 0] * sc, hx[c * 16 + 1] * sc, hx[c * 16 + 2] * sc, hx[c * 16 + 3] * sc);
        o.y = pack_i8x4(hx[c * 16 + 4] * sc, hx[c * 16 + 5] * sc, hx[c * 16 + 6] * sc, hx[c * 16 + 7] * sc);
        o.z = pack_i8x4(hx[c * 16 + 8] * sc, hx[c * 16 + 9] * sc, hx[c * 16 + 10] * sc, hx[c * 16 + 11] * sc);
        o.w = pack_i8x4(hx[c * 16 + 12] * sc, hx[c * 16 + 13] * sc, hx[c * 16 + 14] * sc, hx[c * 16 + 15] * sc);
        *(GAS v4u*)(F.H8() + (size_t)t * D + c * 1024 + lane * 16) = o; }
    if (lane == 0) F.HSCALE()[t] = mx > 0.f ? mx * (1.0f / 127.0f) : 1.0f;
}
__device__ __forceinline__ int row_sum16(int v) {
    v += __builtin_amdgcn_update_dpp(0, v, 0x128, 0xf, 0xf, false);
    v += __builtin_amdgcn_update_dpp(0, v, 0x124, 0xf, 0xf, false);
    v += __builtin_amdgcn_update_dpp(0, v, 0x122, 0xf, 0xf, false);
    v += __builtin_amdgcn_update_dpp(0, v, 0x121, 0xf, 0xf, false);
    return v;
}
__device__ __forceinline__ void peer_u_xcd(Frame& F) {
    const int lane = F.lane, x = blockIdx.x & 7, jcu = blockIdx.x >> 3, ncu = ((int)F.G - x + 7) >> 3;
    const int tpc = (M + ncu - 1) / ncu, tpw = (tpc + NWAVES - 1) / NWAVES;
    const int tbase = jcu * tpc + F.wave * tpw;
    int nw = M - tbase; { const int lim = (jcu + 1) * tpc - tbase; nw = nw < lim ? nw : lim; nw = nw < tpw ? nw : tpw; nw = nw < 0 ? 0 : nw; }
    const int NV = 2 * nw;
    LAS unsigned char* wl = F.lds + F.wave * 9216;
    LAS int* lst = (LAS int*)wl; LAS int* res = (LAS int*)(wl + 512); LAS unsigned char* hsl = wl + 1024;
    const int q4 = lane >> 4, i16 = lane & 15;
    const unsigned char* ubase = F.U8() + (size_t)x * 2048 * D;
    const unsigned lanepart = (unsigned)i16 * 16u;
    int r_idlo = 0, r_idhi = 0, r_t = 0, r_g = 0; v4u r_hq = (v4u){0u, 0u, 0u, 0u};
    int v_cl0 = 0, v_cl1 = 0, v_n = 0, v_r0 = 0, v_t = 0, v_g = 0, v_slot = 0; unsigned long long v_mlo = 0, v_mhi = 0; bool v_live = false;
    int vset = 0, nvalid = 0, idle = 0;
    if (NV == 0) return;
#define U_RAW() do { const int vi_ = vset < NV ? vset : NV - 1; r_g = vi_ >= nw ? 1 : 0; r_t = tbase + (vi_ - r_g * nw); \
        r_idlo = F.IDS()[(size_t)r_t * 128 + lane]; r_idhi = F.IDS()[(size_t)r_t * 128 + 64 + lane]; \
        r_hq = *(const GAS v4u*)(F.H8() + (size_t)r_t * D + r_g * 1024 + lane * 16); } while (0)
#define U_NEXT() do { if (v_live && v_r0 + 16 < v_n) { v_r0 += 16; } else if (vset < NV) { const bool slo = (r_idlo >> 11) == x, shi = (r_idhi >> 11) == x; \
            v_mlo = __ballot(slo); v_mhi = __ballot(shi); const int nlo = __popcll(v_mlo); v_n = nlo + __popcll(v_mhi); \
            const int plo = __builtin_amdgcn_mbcnt_hi((unsigned)(v_mlo >> 32), __builtin_amdgcn_mbcnt_lo((unsigned)v_mlo, 0)); \
            const int phi = nlo + __builtin_amdgcn_mbcnt_hi((unsigned)(v_mhi >> 32), __builtin_amdgcn_mbcnt_lo((unsigned)v_mhi, 0)); \
            if (slo) lst[plo] = (r_idlo & 2047) | (lane << 16); if (shi) lst[phi] = (r_idhi & 2047) | ((64 + lane) << 16); \
            v_slot = (nvalid++) & 7; *(LAS v4u*)(hsl + v_slot * 1024 + lane * 16) = r_hq; \
            v_cl0 = lst[lane]; v_cl1 = lst[64 + lane]; v_t = r_t; v_g = r_g; v_r0 = 0; ++vset; v_live = true; } \
        else { v_live = false; v_n = 0; v_r0 = 0; v_mlo = 0; v_mhi = 0; ++idle; } } while (0)
#define U_ISSUE(BUF, DS) do { { const int rem_ = v_n - v_r0; DS##_cnt = rem_ < 0 ? 0 : (rem_ < 16 ? rem_ : 16); } \
        DS##_slot = v_slot; DS##_t = v_t; DS##_g = v_g; DS##_mlo = v_mlo; DS##_mhi = v_mhi; DS##_last = v_live && (v_r0 + 16 >= v_n); \
        const unsigned char* rb_ = ubase + v_g * 1024; \
        _Pragma("unroll") for (int gp = 0; gp < 4; ++gp) { const int ix_ = v_r0 + 4 * gp + q4; const int a_ = __shfl(v_cl0, ix_ & 63), b_ = __shfl(v_cl1, ix_ & 63); DS##_ent[gp] = ix_ < 64 ? a_ : b_; \
            const unsigned of_ = (4 * gp + q4 < DS##_cnt ? ((unsigned)(DS##_ent[gp] & 2047) << 11) : 0u) + lanepart; \
            _Pragma("unroll") for (int c = 0; c < 4; ++c) BUF[4 * gp + c] = *(const GAS v4u*)(rb_ + of_ + c * 256); } } while (0)
#define U_COMPUTE(BUF, DS) do { const volatile LAS v4u* hp_ = (const volatile LAS v4u*)(hsl + DS##_slot * 1024 + i16 * 16); \
        _Pragma("unroll") for (int gp = 0; gp < 4; ++gp) { int a_ = 0; \
            _Pragma("unroll") for (int c = 0; c < 4; ++c) { const v4u r_ = BUF[4 * gp + c]; const v4u h_ = hp_[c * 16]; a_ = __builtin_amdgcn_sdot4((int)r_.x, (int)h_.x, a_, false); a_ = __builtin_amdgcn_sdot4((int)r_.y, (int)h_.y, a_, false); \
                a_ = __builtin_amdgcn_sdot4((int)r_.z, (int)h_.z, a_, false); a_ = __builtin_amdgcn_sdot4((int)r_.w, (int)h_.w, a_, false); } \
            a_ = row_sum16(a_); if (i16 == 0 && 4 * gp + q4 < DS##_cnt) res[DS##_ent[gp] >> 16] = a_; } \
        if (DS##_last) { int* po_ = F.PART() + ((size_t)DS##_g * M + DS##_t) * 128; \
            if ((DS##_mlo >> lane) & 1ull) po_[lane] = res[lane]; if ((DS##_mhi >> lane) & 1ull) po_[64 + lane] = res[64 + lane]; } } while (0)
    v4u bufA[16], bufB[16], bufC[16];
    int dA_cnt = 0, dA_ent[4] = {0, 0, 0, 0}, dA_t = 0, dA_g = 0, dA_slot = 0; unsigned long long dA_mlo = 0, dA_mhi = 0; bool dA_last = false;
    int dB_cnt = 0, dB_ent[4] = {0, 0, 0, 0}, dB_t = 0, dB_g = 0, dB_slot = 0; unsigned long long dB_mlo = 0, dB_mhi = 0; bool dB_last = false;
    int dC_cnt = 0, dC_ent[4] = {0, 0, 0, 0}, dC_t = 0, dC_g = 0, dC_slot = 0; unsigned long long dC_mlo = 0, dC_mhi = 0; bool dC_last = false;
    U_RAW();
    U_NEXT(); U_RAW(); U_ISSUE(bufA, dA);
    U_NEXT(); U_RAW(); U_ISSUE(bufB, dB);
    while (idle < 3) {
        U_NEXT(); U_RAW(); U_ISSUE(bufC, dC); U_COMPUTE(bufA, dA);
        U_NEXT(); U_RAW(); U_ISSUE(bufA, dA); U_COMPUTE(bufB, dB);
        U_NEXT(); U_RAW(); U_ISSUE(bufB, dB); U_COMPUTE(bufC, dC);
    }
#undef U_RAW
#undef U_NEXT
#undef U_ISSUE
#undef U_COMPUTE
}
__device__ __forceinline__ void peer_act_token(Frame& F, int t) {
    const int lane = F.lane;
    LAS float* abuf = (LAS float*)(F.lds + F.wave * 1024); LAS int* ibuf = (LAS int*)(F.lds + F.wave * 1024 + 512);
    const float sc = __builtin_amdgcn_rsqf(F.ROWSS()[t] * (1.0f / D) + 1e-6f) * F.HSCALE()[t];
    float am = 0.f;
#pragma unroll
    for (int half = 0; half < 2; ++half) {
        const size_t o = (size_t)t * 128 + half * 64 + lane;
        const int e = F.IDS()[o]; const float g = F.GATES()[o];
        const int dsum = F.PART()[o] + F.PART()[(size_t)M * 128 + o];
        const float act = gelu_tanh((float)dsum * sc * F.USCALE()[e]) * g * F.VSCALE()[e];
        abuf[half * 64 + lane] = act; ibuf[half * 64 + lane] = e; am = fmaxf(am, fabsf(act));
    }
#pragma unroll
    for (int o = 1; o < 64; o <<= 1) am = fmaxf(am, __shfl_xor(am, o));
    const float asc = am > 0.f ? 127.0f / am : 1.0f;
    if (lane == 0) F.ASCALE()[t] = am > 0.f ? am * (1.0f / 127.0f) : 1.0f;
    if (lane < 32) {
        const f32x4 av = *(const LAS f32x4*)(abuf + 4 * lane); const v4u iv = *(const LAS v4u*)(ibuf + 4 * lane);
        const size_t o = ((size_t)(t >> 6) * 32 + lane) * 64 + (t & 63);
        F.IDW()[o] = (v2u){iv.x | (iv.y << 16), iv.z | (iv.w << 16)};
        F.AW()[o] = pack_i8x4(av.x * asc, av.y * asc, av.z * asc, av.w * asc);
    }
}
__device__ __forceinline__ void tr4x4(const unsigned r0, const unsigned r1, const unsigned r2, const unsigned r3, unsigned (&c)[4]) {
    const unsigned t01l = __builtin_amdgcn_perm(r1, r0, 0x05010400u), t01h = __builtin_amdgcn_perm(r1, r0, 0x07030602u);
    const unsigned t23l = __builtin_amdgcn_perm(r3, r2, 0x05010400u), t23h = __builtin_amdgcn_perm(r3, r2, 0x07030602u);
    c[0] = __builtin_amdgcn_perm(t23l, t01l, 0x05040100u); c[1] = __builtin_amdgcn_perm(t23l, t01l, 0x07060302u);
    c[2] = __builtin_amdgcn_perm(t23h, t01h, 0x05040100u); c[3] = __builtin_amdgcn_perm(t23h, t01h, 0x07060302u);
}
template <int MODE>
__device__ __forceinline__ void peer_v_slice(Frame& F, int c, bool do_atomic) {
    const int tid = F.tid, lane = F.lane;
    for (int i = tid; i < NEXP * 8 / 16; i += 512) *(LAS v4u*)(F.lds + i * 16) = *(const GAS v4u*)(F.V8T() + (size_t)c * NEXP * 8 + (size_t)i * 16);
    __syncthreads();
    const v2u* ibase = F.IDW() + lane; const unsigned* abase = F.AW() + lane;
    constexpr int NBLK = M / 64, PD = 16;
    v2u iq[PD]; unsigned aq[PD]; v2u rw[2][4];
    {
        const size_t o = (size_t)F.wave * 32 * 64;
#pragma unroll
        for (int j = 0; j < PD; ++j) { iq[j] = *(const GAS v2u*)(ibase + o + j * 64); aq[j] = abase[o + j * 64]; }
    }
#define LROW(dst, q) do { dst[0] = *(const LAS v2u*)(F.lds + ((q).x & 0xffffu) * 8); dst[1] = *(const LAS v2u*)(F.lds + ((q).x >> 16) * 8); \
                          dst[2] = *(const LAS v2u*)(F.lds + ((q).y & 0xffffu) * 8); dst[3] = *(const LAS v2u*)(F.lds + ((q).y >> 16) * 8); } while (0)
    for (int blk = F.wave; blk < NBLK; blk += NWAVES) {
        const int t = blk * 64 + lane;
        const size_t o = (size_t)blk * 32 * 64;
        const int nblk = (blk + NWAVES < NBLK) ? blk + NWAVES : blk;
        const size_t on = (size_t)nblk * 32 * 64;
        int acc[8];
#pragma unroll
        for (int i = 0; i < 8; ++i) acc[i] = 0;
        LROW(rw[0], iq[0]);
#pragma unroll
        for (int j = 0; j < 32; ++j) {
            if (j + 1 < 32) LROW(rw[(j + 1) & 1], iq[(j + 1) % PD]);
            const unsigned aw = aq[j % PD];
            unsigned cl[4], ch[4];
            tr4x4(rw[j & 1][0].x, rw[j & 1][1].x, rw[j & 1][2].x, rw[j & 1][3].x, cl);
            tr4x4(rw[j & 1][0].y, rw[j & 1][1].y, rw[j & 1][2].y, rw[j & 1][3].y, ch);
#pragma unroll
            for (int i = 0; i < 4; ++i) { acc[i] = __builtin_amdgcn_sdot4((int)aw, (int)cl[i], acc[i], false); acc[4 + i] = __builtin_amdgcn_sdot4((int)aw, (int)ch[i], acc[4 + i], false); }
            { const size_t oo = (j + PD < 32) ? o + (size_t)(j + PD) * 64 : on + (size_t)(j + PD - 32) * 64;
              iq[j % PD] = *(const GAS v2u*)(ibase + oo); aq[j % PD] = abase[oo]; }
            __builtin_amdgcn_sched_barrier(0);
        }
        const float asc = F.ASCALE()[t];
        float accf[8];
#pragma unroll
        for (int i = 0; i < 8; ++i) accf[i] = (float)acc[i] * asc;
        const v4u hb = *(const GAS v4u*)(F.HBT() + ((size_t)c * M + t) * 8);
        accf[0] += bf_lo(hb.x); accf[1] += bf_hi(hb.x); accf[2] += bf_lo(hb.y); accf[3] += bf_hi(hb.y);
        accf[4] += bf_lo(hb.z); accf[5] += bf_hi(hb.z); accf[6] += bf_lo(hb.w); accf[7] += bf_hi(hb.w);
        float* yp = (MODE == 0) ? F.Y() + ((size_t)c * M + t) * 8 : (float*)F.XN() + ((((size_t)c * M + t) * 8) & (size_t)0x1ffffff);
        *(GAS f32x4*)yp = (f32x4){accf[0], accf[1], accf[2], accf[3]}; *(GAS f32x4*)(yp + 4) = (f32x4){accf[4], accf[5], accf[6], accf[7]};
        float ss = 0.f;
#pragma unroll
        for (int i = 0; i < 8; ++i) ss += accf[i] * accf[i];
        if (do_atomic) atomicAdd(F.ROWSS2() + t, ss);
    }
#undef LROW
    __syncthreads();
}
__device__ __forceinline__ void final_unit(Frame& F, int unit) {
    const int tid = F.tid, blk = unit >> 3, cg = unit & 7, t0 = blk * 64;
    LAS float* T = (LAS float*)F.lds;
#pragma unroll
    for (int i = 0; i < 8; ++i) { const int pid = tid + 512 * i, cl = pid >> 7, tok = (pid >> 1) & 63, hf = pid & 1;
        const f32x4 v = *(const GAS f32x4*)(F.Y() + ((size_t)(cg * 32 + cl) * M + t0 + tok) * 8 + hf * 4);
        *(LAS f32x4*)(T + tok * 260 + cl * 8 + hf * 4) = v; }
    __syncthreads();
#pragma unroll
    for (int i = 0; i < 8; ++i) { const int pid = tid + 512 * i, tok = pid >> 6, c4 = pid & 63;
        const float rs = __builtin_amdgcn_rsqf(F.ROWSS2()[t0 + tok] * (1.0f / D) + 1e-6f);
        const f32x4 v = *(const LAS f32x4*)(T + tok * 260 + c4 * 4);
        const f32x4 g = *(const GAS f32x4*)(F.A.in[20] + cg * 256 + c4 * 4);
        *(GAS f32x4*)(F.A.out + (size_t)(t0 + tok) * D + cg * 256 + c4 * 4) = v * rs * g; }
    __syncthreads();
}
__global__ void __launch_bounds__(NWAVES * 64, 2) mk_fwd(Args args) {
    extern __shared__ __attribute__((aligned(16))) unsigned char lds[];
    Frame F(args);
    F.lds = (LAS unsigned char*)lds;
    F.MISC = (volatile LAS unsigned*)(F.lds + MISC_OFF);
    F.tid = threadIdx.x; F.lane = F.tid & 63; F.wave = __builtin_amdgcn_readfirstlane(F.tid >> 6);
    F.G = gridDim.x; { const int bx = blockIdx.x; F.vcu = (F.G % 8 == 0) ? (bx % 8) * (F.G / 8) + bx / 8 : bx; }
    F.ws = args.ws;
    F.ctl = (gu32*)(args.ws + WS_CTL);
    for (int u = F.tid; u < (LDS_BYTES - LDSCTL_OFF) / 4; u += NWAVES * 64) ((LAS unsigned*)(F.lds + LDSCTL_OFF))[u] = 0u;
    __syncthreads();
    XcdBarrier bar; bar.bar = (unsigned*)(F.ctl + CW_BAR); bar.x = 0; bar.st = nullptr;
    if (N_LAUNCHES != PER_PHASE) bar = xcd_barrier_post((unsigned*)(F.ctl + CW_BAR), F.MISC + 8);
#define GRID_BAR() do { if (N_LAUNCHES != PER_PHASE) xcd_barrier(bar); } while (0)
    const int lo = args.ph_lo, hi = args.ph_hi;
#ifndef MK_PHASE_MASK
#define MK_PHASE_MASK 0x7FF
#endif
#define IN(k) (((MK_PHASE_MASK >> (k)) & 1) && lo <= (k) && (k) < hi)
#define BOTH(k) (IN(k) && IN((k) + 1))
#ifndef MK_REP_MASK
#define MK_REP_MASK 0
#endif
#ifndef MK_REP_N
#define MK_REP_N 2
#endif
#define REPS(k) for (int rep_ = 0; rep_ < ((((MK_REP_MASK) >> (k)) & 1) ? 1 + MK_REP_N : 1); ++rep_)
    const int gw = F.vcu * NWAVES + F.wave, NGW = F.G * NWAVES;
    if (IN(0)) { REPS(0) { p0_prologue(F); __syncthreads(); } if (BOTH(0)) GRID_BAR(); }
    if (IN(1)) {
        pg8::Gemm g{F.XN(), F.WIN(), M, NIN, D}; pg8::StaticOrder S; S.init(M, NIN, F.G, (int)blockIdx.x);
        pg8::EpiZ E{F.Z(), NIN, LW};
        REPS(1) pg8::gemm_phase<pg8::EpiZ, pg8::StaticOrder, true, true>(F.lds, g, S, E);
        if (BOTH(1)) GRID_BAR();
    }
    if (IN(2)) {
        REPS(12) for (int u = blockIdx.x; u < BATCH * NCHUNK * 8; u += F.G) lru_unit<false>(F, u);
        REPS(13) for (int u = blockIdx.x; u < BATCH * NCHUNK; u += F.G) gmlp_unit(F, u);
        if (BOTH(2)) GRID_BAR();
    }
    if (IN(3)) {
        REPS(3) for (int u = blockIdx.x; u < BATCH * NCHUNK * 8; u += F.G) lru_unit<true>(F, u);
        if (BOTH(3)) GRID_BAR();
    }
    if (IN(4)) {
        pg8::Gemm g{F.MIX(), F.WOUT(), M, D, D}; pg8::StaticOrder S; S.init(M, D, F.G, (int)blockIdx.x);
        pg8::EpiH E{F.HB(), F.HBT(), F.A.in[0], F.ROWSS(), D, M};
        pg8::gemm_phase<pg8::EpiH, pg8::StaticOrder, true, true>(F.lds, g, S, E);
        if (BOTH(4)) GRID_BAR();
    }
    if (IN(5)) {
        pg8::Gemm g{F.HB(), F.WQ(), M, D, D}; pg8::StaticOrder S; S.init(M, D, F.G, (int)blockIdx.x);
        pg8::EpiQ E{F.QH(), F.ROWSS(), D};
        REPS(5) pg8::gemm_phase<pg8::EpiQ, pg8::StaticOrder, true, true>(F.lds, g, S, E);
        if (BOTH(5)) GRID_BAR();
    }
    if (IN(6)) {
        REPS(6) { for (int wu = gw; wu < (M / 32) * 8; wu += NGW) topk_unit(F, wu);
                  for (int t = gw; t < M; t += NGW) h8_row(F, t); }
        if (BOTH(6)) GRID_BAR();
    }
    if (IN(7)) {
        REPS(7) peer_u_xcd(F);
        if (BOTH(7)) GRID_BAR();
    }
    if (IN(8)) {
        REPS(8) for (int t = gw; t < M; t += NGW) peer_act_token(F, t);
        if (BOTH(8)) GRID_BAR();
    }
    if (IN(9)) {
        for (int c = blockIdx.x; c < D / 8; c += F.G) peer_v_slice<0>(F, c, true);
        if ((MK_REP_MASK >> 9) & 1) { for (int rep_ = 0; rep_ < MK_REP_N; ++rep_) for (int c = blockIdx.x; c < D / 8; c += F.G) peer_v_slice<1>(F, c, false); }
        if (BOTH(9)) GRID_BAR();
    }
    if (IN(10)) {
        REPS(10) for (int u = blockIdx.x; u < (M / 64) * 8; u += F.G) final_unit(F, u);
    }
#undef IN
#undef BOTH
#undef GRID_BAR
}

extern "C" void kernel_launch(void* const* d_in, const int* in_sizes, int n_in, void* d_out, int out_size, void* d_ws, size_t ws_size, hipStream_t stream) {
    static int grid = 0;
    if (grid == 0) {
        if (n_in != 21 || in_sizes[0] != M * D || out_size != M * D || ws_size < WS_END) { fprintf(stderr, "kernel_launch: unexpected shapes (n_in %d, in0 %d, out %d, ws %zu)\n", n_in, n_in > 0 ? in_sizes[0] : -1, out_size, ws_size); grid = -1; return; }
        int dev = 0, cus = 0, per_cu = 0;
        if (hipGetDevice(&dev) != hipSuccess || hipDeviceGetAttribute(&cus, hipDeviceAttributeMultiprocessorCount, dev) != hipSuccess) { grid = -1; return; }
        if (hipFuncSetAttribute((const void*)mk_fwd, hipFuncAttributeMaxDynamicSharedMemorySize, LDS_BYTES) != hipSuccess) { fprintf(stderr, "kernel_launch: hipFuncSetAttribute failed\n"); grid = -1; return; }
        if (hipOccupancyMaxActiveBlocksPerMultiprocessor(&per_cu, (const void*)mk_fwd, NWAVES * 64, LDS_BYTES) != hipSuccess || per_cu < 1) { fprintf(stderr, "kernel_launch: occupancy query reports %d blocks per CU\n", per_cu); }
        (void)hipGetLastError();
        grid = cus;
    }
    if (grid < 0) return;
    (void)hipMemsetAsync((char*)d_ws + WS_CTL, 0, CTL_ZERO_BYTES, stream);
    Args a{};
    for (int i = 0; i < 21; ++i) a.in[i] = (const float*)d_in[i];
    a.out = (float*)d_out; a.ws = (unsigned char*)d_ws;
    for (int li = 0; li < N_LAUNCHES; ++li) {
        a.ph_lo = (N_LAUNCHES == PER_PHASE) ? li : 0; a.ph_hi = (N_LAUNCHES == PER_PHASE) ? li + 1 : PER_PHASE;
        hipLaunchKernelGGL(mk_fwd, dim3(grid), dim3(NWAVES * 64), LDS_BYTES, stream, a);
    }
}
```

```cpp
#include <hip/hip_runtime.h>
#include <cstdio>
#include <cstdint>
namespace pg8 {
#define PG8_LAS __attribute__((address_space(3)))
typedef unsigned short bf16_t;
typedef short bf16x8 __attribute__((ext_vector_type(8)));
typedef float f32x4 __attribute__((ext_vector_type(4)));
typedef unsigned u32x4 __attribute__((ext_vector_type(4)));
constexpr int BM = 256, BK = 64, HALF = 128, HTB = HALF * BK * 2  , STAGE_BYTES = 8 * HTB, NXCD = 8, WGM = 8;

__host__ __device__ __forceinline__ int lds_byte(int r, int c) { const int st = (r >> 4) * 2 + (c >> 5), rr = r & 15, cc = c & 31, ob = rr * 64 + cc * 2; return st * 1024 + (ob ^ (((ob >> 9) & 1) << 5)); }
__host__ __device__ __forceinline__ void stage_rc(int b, int& R, int& C) { const int st = b / 1024, sb = b % 1024, swz = sb ^ (((sb >> 9) & 1) << 5); R = (st >> 1) * 16 + swz / 64; C = (st & 1) * 32 + (swz % 64) / 2; }
__host__ __device__ __forceinline__ int perm32(int rho) { const int n = rho >> 4, i = rho & 15; return 8 * (i >> 2) + 4 * n + (i & 3); }

struct Unit { int pm, pn; };
struct Gemm { const bf16_t* A; const bf16_t* Bt; int M, N, K; };

struct StaticOrder {
    int nM, nN, nwg, G, c;
    __host__ __device__ void init(int M, int N, int G_, int c_) { nM = M / BM; nN = N / BM; nwg = nM * nN; G = G_; c = c_; }
    __host__ __device__ bool next(int i, Unit& u) const {
        const long L = (long)i * G + c; if (L >= nwg) return false;
        int wgid = (int)L; { const int q = nwg / NXCD, r = nwg % NXCD, xcd = wgid % NXCD, off = wgid / NXCD; wgid = (xcd < r ? xcd * (q + 1) : r * (q + 1) + (xcd - r) * q) + off; }
        const int nig = WGM * nN, gid = wgid / nig, fm = gid * WGM, gsz = (nM - fm) < WGM ? (nM - fm) : WGM;
        u.pm = fm + ((wgid % nig) % gsz); u.pn = (wgid % nig) / gsz; return true;
    }
    __device__ __forceinline__ void a_ready(const Unit&) const {}
    __device__ __forceinline__ void done(const Unit&) const {}
};

__device__ __forceinline__ unsigned cvt_pk_bf16(float lo, float hi) { unsigned r; asm volatile("v_cvt_pk_bf16_f32 %0, %1, %2" : "=v"(r) : "v"(lo), "v"(hi)); return r; }
__device__ __forceinline__ float gelu_tanh(float x) {
    const float t = x * (1.0f + 0.044715f * x * x);
    const float e = __builtin_amdgcn_exp2f(-2.3022081983f * t);
    return x * __builtin_amdgcn_rcpf(1.0f + e);
}
struct EpiZ {
    static constexpr bool PERM = true, AFTER_DRAIN = false;
    bf16_t* O; int ldc; int gelu_from;
    __device__ __forceinline__ void operator()(const f32x4 (&acc)[2][2][4][2], const Unit& u, int wr, int wc, int fr, int fq) const {
        const int row0 = u.pm * BM + wr * 64 + fr; const int col0 = u.pn * BM + wc * 32 + 8 * fq;
        const bool act = (u.pn * BM) >= gelu_from;
#pragma unroll
        for (int ai = 0; ai < 2; ++ai)
#pragma unroll
            for (int m = 0; m < 4; ++m) { bf16_t* rowp = O + (size_t)(row0 + ai * HALF + m * 16) * ldc + col0;
#pragma unroll
                for (int bj = 0; bj < 2; ++bj) { f32x4 v0 = acc[ai][bj][m][0], v1 = acc[ai][bj][m][1];
                    if (act) {
#pragma unroll
                        for (int j = 0; j < 4; ++j) { v0[j] = gelu_tanh(v0[j]); v1[j] = gelu_tanh(v1[j]); } }
                    u32x4 w; w.x = cvt_pk_bf16(v0[0], v0[1]); w.y = cvt_pk_bf16(v0[2], v0[3]); w.z = cvt_pk_bf16(v1[0], v1[1]); w.w = cvt_pk_bf16(v1[2], v1[3]);
                    *(u32x4*)(rowp + bj * HALF) = w; } }
    }
};
struct EpiH {
    static constexpr bool PERM = true, AFTER_DRAIN = false;
    bf16_t* O; bf16_t* OT; const float* X; float* rowss; int ldc; int mrows;
    __device__ __forceinline__ void operator()(const f32x4 (&acc)[2][2][4][2], const Unit& u, int wr, int wc, int fr, int fq) const {
        const int row0 = u.pm * BM + wr * 64 + fr; const int col0 = u.pn * BM + wc * 32 + 8 * fq;
#pragma unroll
        for (int ai = 0; ai < 2; ++ai)
#pragma unroll
            for (int m = 0; m < 4; ++m) { const int row = row0 + ai * HALF + m * 16; const size_t off = (size_t)row * ldc + col0; float ss = 0.f;
#pragma unroll
                for (int bj = 0; bj < 2; ++bj) {
                    const f32x4 x0 = *(const f32x4*)(X + off + bj * HALF), x1 = *(const f32x4*)(X + off + bj * HALF + 4);
                    const f32x4 v0 = acc[ai][bj][m][0] + x0, v1 = acc[ai][bj][m][1] + x1;
                    ss += (v0[0] * v0[0] + v0[1] * v0[1]) + (v0[2] * v0[2] + v0[3] * v0[3]) + (v1[0] * v1[0] + v1[1] * v1[1]) + (v1[2] * v1[2] + v1[3] * v1[3]);
                    u32x4 w; w.x = cvt_pk_bf16(v0[0], v0[1]); w.y = cvt_pk_bf16(v0[2], v0[3]); w.z = cvt_pk_bf16(v1[0], v1[1]); w.w = cvt_pk_bf16(v1[2], v1[3]);
                    *(u32x4*)(O + off + bj * HALF) = w;
                    *(u32x4*)(OT + ((size_t)((col0 + bj * HALF) >> 3) * mrows + row) * 8) = w; }
                ss += __shfl_xor(ss, 16); ss += __shfl_xor(ss, 32);
                if (fq == 0) atomicAdd(rowss + row, ss); }
    }
};
struct EpiQ {
    static constexpr bool PERM = true, AFTER_DRAIN = false;
    bf16_t* QH; const float* rowss; int ldc;
    __device__ __forceinline__ void operator()(const f32x4 (&acc)[2][2][4][2], const Unit& u, int wr, int wc, int fr, int fq) const {
        const int row0 = u.pm * BM + wr * 64 + fr, col0 = u.pn * BM + wc * 32 + 8 * fq;
#pragma unroll
        for (int ai = 0; ai < 2; ++ai)
#pragma unroll
            for (int m = 0; m < 4; ++m) { const int row = row0 + ai * HALF + m * 16; const float rs = __builtin_amdgcn_rsqf(rowss[row] * (1.0f / 2048.0f) + 1e-6f);
                const size_t off = (size_t)row * ldc + col0;
#pragma unroll
                for (int bj = 0; bj < 2; ++bj) { const f32x4 v0 = acc[ai][bj][m][0] * rs, v1 = acc[ai][bj][m][1] * rs;
                    u32x4 wh; wh.x = cvt_pk_bf16(v0[0], v0[1]); wh.y = cvt_pk_bf16(v0[2], v0[3]); wh.z = cvt_pk_bf16(v1[0], v1[1]); wh.w = cvt_pk_bf16(v1[2], v1[3]);
                    *(u32x4*)(QH + off + bj * HALF) = wh; } }
    }
};
template <class Epi, class Sched, bool ALIGN_EPI = false, bool SP2 = false>
__device__ __forceinline__ void gemm_phase(PG8_LAS unsigned char* lds, const Gemm g, const Sched& S, const Epi& E) {
    const int tid = threadIdx.x, wid = __builtin_amdgcn_readfirstlane(tid >> 6), lane = tid & 63, wr = wid >> 2, wc = wid & 3, fr = lane & 15, fq = lane >> 4;
    const int K = g.K, nt = K / BK;
    unsigned voffA[2], voffB[2];
#pragma unroll
    for (int i = 0; i < 2; ++i) { int R, C; stage_rc(tid * 16 + i * 8192, R, C); const int Rb = Epi::PERM ? ((R & ~31) + perm32(R & 31)) : R;
        voffA[i] = (unsigned)(R * K + C) * 2u; voffB[i] = (unsigned)(Rb * K + C) * 2u; }
    const size_t kstep = (size_t)(BK * 2);
    const size_t hstep = (size_t)HALF * K * 2;
    const size_t tstep = 2 * hstep;
    const unsigned ldsw = (unsigned)wid * 1024u;
    const int aoff = lds_byte(wr * 64 + fr, fq * 8), boff = lds_byte(wc * 32 + fr, fq * 8);
#define PG8_SA(b, h) (((b) * 2 + (h)) * HTB)
#define PG8_SB(b, h) ((4 + (b) * 2 + (h)) * HTB)
#define PG8_STAGE(bufoff, gbase, voff) do { _Pragma("unroll") for (int _i = 0; _i < 2; ++_i) \
        __builtin_amdgcn_global_load_lds((const unsigned*)((const char*)(gbase) + (voff)[_i]), (PG8_LAS unsigned*)(lds + (bufoff) + ldsw + _i * 8192), 16, 0, 0); } while (0)
#define PG8_LDA(dst, b, h) do { _Pragma("unroll") for (int m = 0; m < 4; ++m) _Pragma("unroll") for (int k = 0; k < 2; ++k) dst[m][k] = *(const PG8_LAS bf16x8*)(lds + PG8_SA(b, h) + aoff + m * 2048 + k * 1024); } while (0)
#define PG8_LDB(dst, b, h) do { _Pragma("unroll") for (int n = 0; n < 2; ++n) _Pragma("unroll") for (int k = 0; k < 2; ++k) dst[n][k] = *(const PG8_LAS bf16x8*)(lds + PG8_SB(b, h) + boff + n * 2048 + k * 1024); } while (0)
#define PG8_MMA(ai, bj, At, Bt) do { __builtin_amdgcn_s_setprio(1); _Pragma("unroll") for (int m = 0; m < 4; ++m) _Pragma("unroll") for (int n = 0; n < 2; ++n) _Pragma("unroll") for (int k = 0; k < 2; ++k) \
        acc[ai][bj][m][n] = __builtin_amdgcn_mfma_f32_16x16x32_bf16(Bt[n][k], At[m][k], acc[ai][bj][m][n], 0, 0, 0); __builtin_amdgcn_s_setprio(0); } while (0)
#define PG8_WAIT_V(n) asm volatile("s_waitcnt vmcnt(" #n ")" ::: "memory")
#define PG8_WAIT_L(n) asm volatile("s_waitcnt lgkmcnt(" #n ")" ::: "memory")
#define PG8_BAR __builtin_amdgcn_s_barrier()
#define PG8_SCHED __builtin_amdgcn_sched_barrier(0)
    Unit cur, nxt; int ui = 0;
    if (!S.next(0, cur)) return;
    f32x4 acc[2][2][4][2];
#pragma unroll
    for (int a = 0; a < 2; ++a)
#pragma unroll
        for (int b = 0; b < 2; ++b)
#pragma unroll
            for (int m = 0; m < 4; ++m)
#pragma unroll
                for (int n = 0; n < 2; ++n) acc[a][b][m][n] = (f32x4){0.f, 0.f, 0.f, 0.f};
    bf16x8 At[4][2], B0[2][2], B1[2][2];
    const char* cA = (const char*)g.A + (size_t)cur.pm * tstep; const char* cB = (const char*)g.Bt + (size_t)cur.pn * tstep;
    S.a_ready(cur);
    if constexpr (SP2) {
        PG8_STAGE(PG8_SB(0, 0), cB, voffB); PG8_STAGE(PG8_SB(0, 1), cB + hstep, voffB); PG8_STAGE(PG8_SA(0, 0), cA, voffA); PG8_STAGE(PG8_SA(0, 1), cA + hstep, voffA);
        if (wr == 1) PG8_BAR;
        PG8_WAIT_V(2); PG8_BAR;
        PG8_STAGE(PG8_SB(1, 0), cB + kstep, voffB); PG8_STAGE(PG8_SA(1, 0), cA + kstep, voffA); PG8_STAGE(PG8_SB(1, 1), cB + hstep + kstep, voffB);
        PG8_WAIT_V(6); PG8_BAR;
    } else {
        PG8_STAGE(PG8_SB(0, 0), cB, voffB); PG8_STAGE(PG8_SA(0, 0), cA, voffA); PG8_STAGE(PG8_SB(0, 1), cB + hstep, voffB); PG8_STAGE(PG8_SA(0, 1), cA + hstep, voffA);
        if (wr == 1) PG8_BAR;
        PG8_WAIT_V(4); PG8_BAR;
        PG8_STAGE(PG8_SB(1, 0), cB + kstep, voffB); PG8_STAGE(PG8_SA(1, 0), cA + kstep, voffA); PG8_STAGE(PG8_SB(1, 1), cB + hstep + kstep, voffB);
        PG8_WAIT_V(6); PG8_BAR;
    }
    for (;;) {
        const bool has_next = S.next(ui + 1, nxt);
        const char* nA = has_next ? (const char*)g.A + (size_t)nxt.pm * tstep : cA; const char* nB = has_next ? (const char*)g.Bt + (size_t)nxt.pn * tstep : cB;
        for (int t = 0; t < nt; t += 2) {
            const bool last = (t == nt - 2);
            const char* a1 = cA + (size_t)(t + 1) * kstep;
            const char* a2 = last ? nA : cA + (size_t)(t + 2) * kstep; const char* b2 = last ? nB : cB + (size_t)(t + 2) * kstep;
            const char* a3 = a2 + kstep; const char* b3 = b2 + kstep;
            if (last && has_next) S.a_ready(nxt);
            if constexpr (SP2) {
            PG8_LDB(B0, 0, 0); PG8_LDB(B1, 0, 1); PG8_SCHED; PG8_LDA(At, 0, 0); PG8_STAGE(PG8_SA(1, 1), a1 + hstep, voffA);
            PG8_WAIT_V(8); PG8_WAIT_L(0); PG8_BAR; PG8_MMA(0, 0, At, B0); PG8_MMA(0, 1, At, B1); PG8_BAR; PG8_SCHED;
            PG8_LDA(At, 0, 1); PG8_STAGE(PG8_SB(0, 0), b2, voffB); PG8_STAGE(PG8_SB(0, 1), b2 + hstep, voffB); PG8_STAGE(PG8_SA(0, 0), a2, voffA);
            PG8_WAIT_V(8); PG8_WAIT_L(0); PG8_BAR; PG8_MMA(1, 0, At, B0); PG8_MMA(1, 1, At, B1); PG8_BAR; PG8_SCHED;
            PG8_LDB(B0, 1, 0); PG8_LDB(B1, 1, 1); PG8_SCHED; PG8_LDA(At, 1, 0); PG8_STAGE(PG8_SA(0, 1), a2 + hstep, voffA);
            PG8_WAIT_V(8); PG8_WAIT_L(0); PG8_BAR; PG8_MMA(0, 0, At, B0); PG8_MMA(0, 1, At, B1); PG8_BAR; PG8_SCHED;
            PG8_LDA(At, 1, 1); PG8_STAGE(PG8_SB(1, 0), b3, voffB); PG8_STAGE(PG8_SB(1, 1), b3 + hstep, voffB); PG8_STAGE(PG8_SA(1, 0), a3, voffA);
            PG8_WAIT_V(8); PG8_WAIT_L(0); PG8_BAR; PG8_MMA(1, 0, At, B0); PG8_MMA(1, 1, At, B1); PG8_BAR; PG8_SCHED;
            } else {
            PG8_LDB(B0, 0, 0); PG8_SCHED; PG8_LDA(At, 0, 0); PG8_STAGE(PG8_SA(1, 1), a1 + hstep, voffA);
            PG8_WAIT_L(8); PG8_BAR; PG8_WAIT_L(0); PG8_MMA(0, 0, At, B0); PG8_BAR; PG8_SCHED;
            PG8_LDB(B1, 0, 1); PG8_STAGE(PG8_SB(0, 0), b2, voffB);
            PG8_BAR; PG8_WAIT_L(0); PG8_MMA(0, 1, At, B1); PG8_BAR;
            PG8_LDA(At, 0, 1); PG8_STAGE(PG8_SA(0, 0), a2, voffA);
            PG8_BAR; PG8_WAIT_L(0); PG8_MMA(1, 0, At, B0); PG8_BAR; PG8_SCHED;
            PG8_STAGE(PG8_SB(0, 1), b2 + hstep, voffB);
            PG8_WAIT_V(6); PG8_BAR; PG8_MMA(1, 1, At, B1); PG8_BAR;
            PG8_LDB(B0, 1, 0); PG8_SCHED; PG8_LDA(At, 1, 0); PG8_STAGE(PG8_SA(0, 1), a2 + hstep, voffA);
            PG8_WAIT_L(8); PG8_BAR; PG8_WAIT_L(0); PG8_MMA(0, 0, At, B0); PG8_BAR; PG8_SCHED;
            PG8_LDB(B1, 1, 1); PG8_STAGE(PG8_SB(1, 0), b3, voffB);
            PG8_BAR; PG8_WAIT_L(0); PG8_MMA(0, 1, At, B1); PG8_BAR;
            PG8_LDA(At, 1, 1); PG8_STAGE(PG8_SA(1, 0), a3, voffA);
            PG8_BAR; PG8_WAIT_L(0); PG8_MMA(1, 0, At, B0); PG8_BAR; PG8_SCHED;
            PG8_STAGE(PG8_SB(1, 1), b3 + hstep, voffB);
            PG8_WAIT_V(6); PG8_BAR; PG8_MMA(1, 1, At, B1); PG8_BAR;
            }
        }
        if constexpr (ALIGN_EPI) { if (wr == 0) PG8_BAR; }
        if constexpr (!Epi::AFTER_DRAIN) { E(acc, cur, wr, wc, fr, fq); S.done(cur); }
        if (!has_next) break;
#pragma unroll
        for (int a = 0; a < 2; ++a)
#pragma unroll
            for (int b = 0; b < 2; ++b)
#pragma unroll
                for (int m = 0; m < 4; ++m)
#pragma unroll
                    for (int n = 0; n < 2; ++n) acc[a][b][m][n] = (f32x4){0.f, 0.f, 0.f, 0.f};
        cur = nxt; cA = nA; cB = nB; ++ui;
        if constexpr (ALIGN_EPI) { if (wr == 1) PG8_BAR; }
    }
    PG8_WAIT_V(0);
    if constexpr (!ALIGN_EPI) { if (wr == 0) PG8_BAR; }
    PG8_BAR;
    if constexpr (Epi::AFTER_DRAIN) { E.fused(acc, cur, wr, wc, fr, fq, lds, wid, lane); S.done(cur); }
#undef PG8_SA
#undef PG8_SB
#undef PG8_STAGE
#undef PG8_LDA
#undef PG8_LDB
#undef PG8_MMA
#undef PG8_WAIT_V
#undef PG8_WAIT_L
#undef PG8_BAR
#undef PG8_SCHED
}
}
constexpr int NWAVES = 8;
constexpr int BATCH = 4, SEQ = 8192, D = 2048, M = BATCH * SEQ, NIN = 4096, LW = 1024, CHUNK = 128, NCHUNK = SEQ / CHUNK;
constexpr int NEXP = 16384;
#ifndef MK_N_LAUNCHES
#define MK_N_LAUNCHES 1
#endif
constexpr int N_LAUNCHES = MK_N_LAUNCHES;
constexpr int PER_PHASE = 11;
constexpr size_t MiB = 1u << 20;
constexpr size_t WS_CTL = 0, CTL_ZERO_BYTES = 1 * MiB;
constexpr size_t WS_ROWSS = 512 * 1024;
constexpr size_t WS_WIN = 2 * MiB, WS_WOUT = 18 * MiB, WS_WQ = 26 * MiB, WS_LRUW = 34 * MiB, WS_WSB = 35 * MiB, WS_AGG = 36 * MiB;
constexpr size_t WS_U = 64 * MiB, WS_V = 128 * MiB, WS_XN = 192 * MiB  , WS_Z = 320 * MiB  ;
constexpr size_t WS_HB = 576 * MiB, WS_IDS = 704 * MiB, WS_GATES = 720 * MiB, WS_PAIRS = 736 * MiB, WS_HBT = 752 * MiB, WS_END = 884 * MiB;
constexpr size_t WS_USCALE = 40 * MiB, WS_VSCALE = 41 * MiB;
constexpr size_t WS_HSCALE = 44 * MiB, WS_CARRY = 45 * MiB;
constexpr size_t WS_H8 = WS_XN, WS_PART = WS_XN + 64 * MiB;
constexpr size_t WS_ASCALE = 42 * MiB, WS_KH = 43 * MiB;
constexpr size_t WS_IDW = WS_PAIRS, WS_AW = 880 * MiB;
constexpr size_t WS_ROWSS2 = 640 * 1024;
constexpr size_t WS_Y = WS_Z;
constexpr int CW_BAR = 4096;
constexpr int RING_BYTES = 131072;
constexpr int LDSCTL_OFF = 143360, MISC_OFF = LDSCTL_OFF + 320;
constexpr int LDS_BYTES = 147456;
#define GAS __attribute__((address_space(1)))
#define LAS __attribute__((address_space(3)))
typedef unsigned short bf16;
typedef unsigned v4u __attribute__((ext_vector_type(4)));
typedef float f32x4 __attribute__((ext_vector_type(4)));
typedef short bf16x8 __attribute__((ext_vector_type(8)));
typedef GAS unsigned gu32;
typedef GAS unsigned long long gu64;
#define RLX_AGENT __ATOMIC_RELAXED, __HIP_MEMORY_SCOPE_AGENT
#define LDS_WAIT() asm volatile("s_waitcnt lgkmcnt(0)" ::: "memory")
#define VM_WAIT() asm volatile("s_waitcnt vmcnt(0)" ::: "memory")
__device__ __forceinline__ unsigned long long rt() { return __builtin_amdgcn_s_memrealtime(); }
__device__ __forceinline__ unsigned f2bf(float f) { unsigned u = __builtin_bit_cast(unsigned, f); return (u + 0x7fffu + ((u >> 16) & 1u)) >> 16; }
__device__ __forceinline__ unsigned pk2(float lo, float hi) { return f2bf(lo) | (f2bf(hi) << 16); }

#define XB_TMO      128
#define XB_XCNT(j)  (256  + 64 * (j))
#define XB_XSUB(j)  (1280 + 64 * (j))
#define XB_XGEN(j)  (2304 + 64 * (j))
#define XB_TOP      3328
#define XB_TOPGEN   3392
#define XCD_BAR_WORDS 3456
#define XB_SPIN_CAP (1u << 18)

__device__ __forceinline__ unsigned xb_ld(unsigned* p)              { return __hip_atomic_load(p, __ATOMIC_RELAXED, __HIP_MEMORY_SCOPE_AGENT); }
__device__ __forceinline__ unsigned xb_add(unsigned* p, unsigned v) { return __hip_atomic_fetch_add(p, v, __ATOMIC_RELAXED, __HIP_MEMORY_SCOPE_AGENT); }
__device__ __forceinline__ unsigned xb_xcc_id() { return (unsigned)__builtin_amdgcn_s_getreg((3 << 11) | 20) & 0xFu; }
#define XB_SPIN(cond, bar) do { unsigned _sp = 0; while (cond) { __builtin_amdgcn_s_sleep(1); \
    if ((++_sp & 255u) == 0u) { if (xb_ld(&(bar)[XB_TMO])) break; if (_sp > XB_SPIN_CAP) { atomicAdd(&(bar)[XB_TMO], 1u); break; } } } } while (0)

struct XcdBarrier {
    unsigned* bar; unsigned x;
    volatile LAS unsigned* st;
};

__device__ __forceinline__ XcdBarrier xcd_barrier_post(unsigned* bar, volatile LAS unsigned* st) {
    XcdBarrier b; b.bar = bar; b.x = xb_xcc_id(); b.st = st;
    if (threadIdx.x == 0) (void)xb_add(&bar[XB_XCNT(b.x)], 1u);
    return b;
}
__device__ __forceinline__ void xcd_barrier_complete(unsigned* bar, unsigned x, unsigned& nloc, unsigned& nx) {
    const unsigned G = gridDim.x * gridDim.y * gridDim.z;
    unsigned sum, cnt, mine, sp = 0u;
    for (;;) {
        sum = 0u; cnt = 0u; mine = 0u;
#pragma unroll
        for (unsigned j = 0; j < 16; ++j) { const unsigned c = xb_ld(&bar[XB_XCNT(j)]); sum += c; cnt += (c > 0u) ? 1u : 0u; mine = (j == x) ? c : mine; }
        if (sum == G) break;
        __builtin_amdgcn_s_sleep(1);
        if ((++sp & 255u) == 0u) { if (xb_ld(&bar[XB_TMO])) break; if (sp > XB_SPIN_CAP) { atomicAdd(&bar[XB_TMO], 1u); break; } }
    }
    nloc = mine > 0u ? mine : 1u; nx = cnt > 0u ? cnt : 1u;
}

__device__ __forceinline__ void xcd_barrier(const XcdBarrier& b) {
    asm volatile("s_waitcnt vmcnt(0)" ::: "memory");
    __syncthreads();
    if (threadIdx.x == 0) {
        unsigned* bar = b.bar;
        __builtin_amdgcn_s_waitcnt(0);
        unsigned nloc = b.st[0], nx = b.st[1];
        if (nloc == 0u) { xcd_barrier_complete(bar, b.x, nloc, nx); b.st[0] = nloc; b.st[1] = nx; }
        const unsigned old = xb_add(&bar[XB_XSUB(b.x)], 1u);
        const unsigned gen = old / nloc;
        if (old + 1u == (gen + 1u) * nloc) {
            __builtin_amdgcn_fence(__ATOMIC_RELEASE, "agent");
            asm volatile("s_waitcnt vmcnt(0)" ::: "memory");
            const unsigned og = xb_add(&bar[XB_TOP], 1u);
            const unsigned tg = og / nx;
            if (og + 1u == (tg + 1u) * nx) xb_add(&bar[XB_TOPGEN], 1u);
            else XB_SPIN(xb_ld(&bar[XB_TOPGEN]) == tg, bar);
            __builtin_amdgcn_fence(__ATOMIC_ACQUIRE, "agent");
            xb_add(&bar[XB_XGEN(b.x)], 1u);
            asm volatile("s_waitcnt vmcnt(0)" ::: "memory");
        } else {
            XB_SPIN(xb_ld(&bar[XB_XGEN(b.x)]) == gen, bar);
            __builtin_amdgcn_fence(__ATOMIC_ACQUIRE, "agent");
            asm volatile("s_waitcnt vmcnt(0)" ::: "memory");
        }
    }
    __syncthreads();
}
typedef unsigned v2u __attribute__((ext_vector_type(2)));
typedef float f32x2 __attribute__((ext_vector_type(2)));
struct Args { const float* in[21]; float* out; unsigned char* ws; int ph_lo, ph_hi; };
struct Frame {
    const Args& A;
    LAS unsigned char* lds;
    volatile LAS unsigned* MISC;
    gu32* ctl;
    unsigned char* ws;
    int tid, lane, wave, vcu, G;
    __device__ __forceinline__ Frame(const Args& a) : A(a) {}
#define WSP(name, type, off) __device__ __forceinline__ type* name() const { return (type*)(ws + (off)); }
    WSP(WIN, bf16, WS_WIN) WSP(WOUT, bf16, WS_WOUT) WSP(WQ, bf16, WS_WQ) WSP(LRUW, bf16, WS_LRUW) WSP(WSB, bf16, WS_WSB)
    WSP(XN, bf16, WS_XN) WSP(MIX, bf16, WS_XN) WSP(Z, bf16, WS_Z) WSP(HB, bf16, WS_HB) WSP(HBT, bf16, WS_HBT)
    WSP(U8, unsigned char, WS_U) WSP(V8T, unsigned char, WS_V)
    WSP(ROWSS, float, WS_ROWSS) WSP(ROWSS2, float, WS_ROWSS2) WSP(QH, bf16, WS_Z) WSP(QL, bf16, WS_Z + 128 * MiB) WSP(KH, bf16, WS_KH) WSP(KL, bf16, WS_KH + 512 * 1024) WSP(AGG, float, WS_AGG) WSP(CARRY, float, WS_CARRY) WSP(GATES, float, WS_GATES)
    WSP(USCALE, float, WS_USCALE) WSP(VSCALE, float, WS_VSCALE) WSP(Y, bf16, WS_Y) WSP(IDS, int, WS_IDS) WSP(ASCALE, float, WS_ASCALE) WSP(IDW, v4u, WS_IDW) WSP(AW, unsigned, WS_AW) WSP(H8, unsigned char, WS_H8) WSP(HSCALE, float, WS_HSCALE) WSP(PART, int, WS_PART)
#undef WSP
};
__device__ __forceinline__ float wave_sum(float v) {
#pragma unroll
    for (int o = 1; o < 64; o <<= 1) v += __shfl_xor(v, o);
    return v;
}
__device__ __forceinline__ float bf_lo(unsigned w) { return __builtin_bit_cast(float, w << 16); }
__device__ __forceinline__ float bf_hi(unsigned w) { return __builtin_bit_cast(float, w & 0xffff0000u); }
__device__ __forceinline__ float bf1(unsigned short h) { return __builtin_bit_cast(float, (unsigned)h << 16); }
__device__ __forceinline__ float sigmoidf_(float x) { return __builtin_amdgcn_rcpf(1.0f + __builtin_amdgcn_exp2f(-1.4426950409f * x)); }
using pg8::gelu_tanh;
__device__ __forceinline__ unsigned pack_i8x4(float a, float b, float c, float d) {
    const int ia = (int)__builtin_rintf(a), ib = (int)__builtin_rintf(b), ic = (int)__builtin_rintf(c), id = (int)__builtin_rintf(d);
    return (unsigned)(ia & 0xff) | ((unsigned)(ib & 0xff) << 8) | ((unsigned)(ic & 0xff) << 16) | ((unsigned)id << 24);
}

__device__ __forceinline__ void p0_transpose_item(const float* W, int K, int N, bf16* WT, const float* kscale, LAS float* scr, int item, int lane) {
    const int nblk = N / 32, kb = item / nblk, nb = item % nblk, k0 = 64 * kb, n0 = 32 * nb;
#pragma unroll 8
    for (int i = 0; i < 32; ++i) { const int kk = 2 * i + (lane >> 5); const float sc = kscale ? kscale[k0 + kk] : 1.0f; scr[kk * 33 + (lane & 31)] = W[(size_t)(k0 + kk) * N + n0 + (lane & 31)] * sc; }
    LDS_WAIT(); asm volatile("" ::: "memory");
    const int c = lane & 7;
#pragma unroll
    for (int j = 0; j < 4; ++j) { const int n = (lane >> 3) + 8 * j; const LAS float* s = scr + (8 * c) * 33 + n;
        v4u o; o.x = pk2(s[0 * 33], s[1 * 33]); o.y = pk2(s[2 * 33], s[3 * 33]); o.z = pk2(s[4 * 33], s[5 * 33]); o.w = pk2(s[6 * 33], s[7 * 33]);
        *(GAS v4u*)(WT + (size_t)(n0 + n) * K + k0 + 8 * c) = o; }
    LDS_WAIT(); asm volatile("" ::: "memory");
}
__device__ __forceinline__ void p0_prologue(Frame& F) {
    LAS float* scr = (LAS float*)(F.lds + F.wave * 16384);
    const int gw = F.vcu * NWAVES + F.wave, NGW = F.G * NWAVES, lane = F.lane;
    constexpr int I_IN = (D / 64) * (NIN / 32), I_OUT = (D / 64) * (D / 32), I_Q = I_OUT, I_LRU = 32 * 8;
    constexpr int NITEMS = I_IN + I_OUT + I_Q + I_LRU;
    for (int it = gw; it < NITEMS; it += NGW) {
        int r = it;
        if (r < I_IN) { p0_transpose_item(F.A.in[2], D, NIN, F.WIN(), F.A.in[1], scr, r, lane); continue; } r -= I_IN;
        if (r < I_OUT) { p0_transpose_item(F.A.in[14], D, D, F.WOUT(), nullptr, scr, r, lane); continue; } r -= I_OUT;
        if (r < I_Q) { p0_transpose_item(F.A.in[16], D, D, F.WQ(), F.A.in[15], scr, r, lane); continue; } r -= I_Q;
        { const int mi = r >> 3, sub = r & 7, gate = mi >> 4, rest = mi & 15;
          const float* src = (gate ? F.A.in[7] : F.A.in[5]) + (size_t)rest * 16384;
          p0_transpose_item(src, 128, 128, F.LRUW() + (size_t)mi * 16384, nullptr, scr, sub, lane); }
    }
    const size_t gt = (size_t)gw * 64 + lane, NGT = (size_t)NGW * 64;
    {
        const float* g2 = F.A.in[15];
        f32x4 gg[8];
#pragma unroll
        for (int j = 0; j < 8; ++j) gg[j] = *(const GAS f32x4*)(g2 + j * 256 + lane * 4);
        for (int e = gw; e < NEXP; e += NGW) {
            const GAS f32x4* ur = (const GAS f32x4*)(F.A.in[18] + (size_t)e * D) + lane;
            f32x4 v[8]; float mx = 0.f;
#pragma unroll
            for (int j = 0; j < 8; ++j) { v[j] = ur[64 * j] * gg[j]; mx = fmaxf(mx, fmaxf(fmaxf(fabsf(v[j].x), fabsf(v[j].y)), fmaxf(fabsf(v[j].z), fabsf(v[j].w)))); }
#pragma unroll
            for (int o = 1; o < 64; o <<= 1) mx = fmaxf(mx, __shfl_xor(mx, o));
            const float sc = mx > 0.f ? 127.0f / mx : 1.0f;
            GAS unsigned* o4 = (GAS unsigned*)(F.U8() + (size_t)e * D) + lane;
#pragma unroll
            for (int j = 0; j < 8; ++j) o4[64 * j] = pack_i8x4(v[j].x * sc, v[j].y * sc, v[j].z * sc, v[j].w * sc);
            if (lane == 0) F.USCALE()[e] = mx > 0.f ? mx * (1.0f / 127.0f) : 1.0f;
        }
    }
    __syncthreads();
    for (int un = blockIdx.x; un < NEXP / 64; un += F.G) {
        const int e0 = un * 64;
        for (int rr = 0; rr < 8; ++rr) {
            const int el = F.wave * 8 + rr, e = e0 + el;
            const GAS f32x4* vr = (const GAS f32x4*)(F.A.in[19] + (size_t)e * D) + lane;
            f32x4 v[8]; float mx = 0.f;
#pragma unroll
            for (int j = 0; j < 8; ++j) { v[j] = vr[64 * j]; mx = fmaxf(mx, fmaxf(fmaxf(fabsf(v[j].x), fabsf(v[j].y)), fmaxf(fabsf(v[j].z), fabsf(v[j].w)))); }
#pragma unroll
            for (int o = 1; o < 64; o <<= 1) mx = fmaxf(mx, __shfl_xor(mx, o));
            const float sc = mx > 0.f ? 127.0f / mx : 1.0f;
#pragma unroll
            for (int j = 0; j < 8; ++j) *(LAS unsigned*)(F.lds + el * 2056 + j * 256 + lane * 4) = pack_i8x4(v[j].x * sc, v[j].y * sc, v[j].z * sc, v[j].w * sc);
            if (lane == 0) F.VSCALE()[e] = mx > 0.f ? mx * (1.0f / 127.0f) : 1.0f;
        }
        __syncthreads();
        for (int cc = 0; cc < 32; ++cc) { const int c = F.wave * 32 + cc;
            const v2u w = *(const LAS v2u*)(F.lds + lane * 2056 + c * 8);
            *(GAS v2u*)(F.V8T() + ((size_t)c * NEXP + e0 + lane) * 8) = w; }
        __syncthreads();
    }
    for (size_t ch = gt; ch < (size_t)8 * 128 * 128 / 8; ch += NGT) {
        const size_t e0 = ch * 8;
        const f32x4 a = *(const GAS f32x4*)(F.A.in[12] + e0), b = *(const GAS f32x4*)(F.A.in[12] + e0 + 4);
        v4u o; o.x = pk2(a.x, a.y); o.y = pk2(a.z, a.w); o.z = pk2(b.x, b.y); o.w = pk2(b.z, b.w);
        *(GAS v4u*)(F.WSB() + e0) = o;
    }
    for (size_t ch = gt; ch < (size_t)16 * 128 * 128 / 8; ch += NGT) {
        const size_t e0 = ch * 8;
        const f32x4 a = *(const GAS f32x4*)(F.A.in[17] + e0), b = *(const GAS f32x4*)(F.A.in[17] + e0 + 4);
        v4u hi; hi.x = pk2(a.x, a.y); hi.y = pk2(a.z, a.w); hi.z = pk2(b.x, b.y); hi.w = pk2(b.z, b.w);
        *(GAS v4u*)(F.KH() + e0) = hi;
    }
    for (int m = gw; m < M; m += NGW) {
        const GAS f32x4* xr = (const GAS f32x4*)(F.A.in[0] + (size_t)m * D) + lane;
        f32x4 v[8]; float s = 0.f;
#pragma unroll
        for (int j = 0; j < 8; ++j) { v[j] = xr[64 * j]; s += (v[j].x * v[j].x + v[j].y * v[j].y) + (v[j].z * v[j].z + v[j].w * v[j].w); }
        const float rstd = __builtin_amdgcn_rsqf(wave_sum(s) * (1.f / D) + 1e-6f);
        GAS unsigned long long* o8 = (GAS unsigned long long*)(F.XN() + (size_t)m * D) + lane;
#pragma unroll
        for (int j = 0; j < 8; ++j) o8[64 * j] = (unsigned long long)pk2(v[j].x * rstd, v[j].y * rstd) | ((unsigned long long)pk2(v[j].z * rstd, v[j].w * rstd) << 32);
    }
}
constexpr int LRU_XR = 0, LRU_XC = 33792, LRU_GR = 33792 + 40960;
constexpr float LOG2E = 1.4426950408889634f;
__device__ __forceinline__ int xc_off(int tok, int ch) { return tok * 320 + (tok >> 5) * 16 + ch * 2; }
template <bool APPLY, int DIR>
__device__ __forceinline__ void lru_dir(Frame& F, int b, int c, int h, const bf16x8 (&Ba)[4], const bf16x8 (&Bx)[4], float (&hsum)[8][4]) {
    const int lane = F.lane, w = F.wave, fr = lane & 15, fq = lane >> 4;
    LAS unsigned char* XC = F.lds + LRU_XC;
    const int chl = 16 * w + fr, chg = h * 128 + chl;
    const float ba = F.A.in[6][DIR * LW + chg], bx = F.A.in[8][DIR * LW + chg], lam = F.A.in[9][DIR * LW + chg];
    const float cl = -8.0f * log1pf(__expf(-lam)) * LOG2E;
    float carry = 0.f;
    if (APPLY) carry = F.CARRY()[(size_t)((b * 2 + DIR) * NCHUNK + c) * LW + chg];
    f32x4 R[8], I[8];
    const int arow = (fr >> 2) * 32 + (fr & 3);
#pragma unroll
    for (int m = 0; m < 8; ++m) {
        R[m] = (f32x4){0.f, 0.f, 0.f, 0.f}; I[m] = (f32x4){0.f, 0.f, 0.f, 0.f};
#pragma unroll
        for (int ks = 0; ks < 4; ++ks) {
            const bf16x8 a = *(const LAS bf16x8*)(XC + xc_off(arow + 4 * m, 32 * ks + 8 * fq));
            R[m] = __builtin_amdgcn_mfma_f32_16x16x32_bf16(a, Ba[ks], R[m], 0, 0, 0);
            I[m] = __builtin_amdgcn_mfma_f32_16x16x32_bf16(a, Bx[ks], I[m], 0, 0, 0);
        }
    }
    float P = 1.f, L = 0.f;
#pragma unroll
    for (int mm = 0; mm < 8; ++mm) {
        const int m = DIR == 0 ? mm : 7 - mm;
#pragma unroll
        for (int jj = 0; jj < 4; ++jj) {
            const int j = DIR == 0 ? jj : 3 - jj;
            const float r = sigmoidf_(R[m][j] + ba), ig = sigmoidf_(I[m][j] + bx);
            const float a = __builtin_amdgcn_exp2f(cl * r);
            const float xc = bf1(*(const LAS unsigned short*)(XC + xc_off(32 * fq + 4 * m + j, chl)));
            const float u = __builtin_amdgcn_sqrtf(fmaxf(1.0f - a * a, 0.0f)) * (ig * xc);
            L = a * L + u; P = a * P;
            R[m][j] = P; I[m][j] = L;
        }
    }
    const int src1 = DIR == 0 ? lane - 16 : lane + 16, src2 = DIR == 0 ? lane - 32 : lane + 32;
    const bool v1 = DIR == 0 ? (fq >= 1) : (fq <= 2), v2 = DIR == 0 ? (fq >= 2) : (fq <= 1);
    float A = P, B = L;
    { const float pa = __shfl(A, src1), pb = __shfl(B, src1); if (v1) { B = A * pb + B; A = A * pa; } }
    { const float pa = __shfl(A, src2), pb = __shfl(B, src2); if (v2) { B = A * pb + B; A = A * pa; } }
    if (APPLY) {
        float EA = __shfl(A, src1), EB = __shfl(B, src1); if (!v1) { EA = 1.f; EB = 0.f; }
        const float hin = EA * carry + EB;
#pragma unroll
        for (int m = 0; m < 8; ++m)
#pragma unroll
            for (int j = 0; j < 4; ++j) { const float hh = R[m][j] * hin + I[m][j]; if (DIR == 0) hsum[m][j] = hh; else hsum[m][j] += hh; }
    } else {
        const bool lastlane = DIR == 0 ? (fq == 3) : (fq == 0);
        if (lastlane) { f32x2* agg = (f32x2*)F.AGG() + (size_t)((b * 2 + DIR) * NCHUNK + c) * LW + chg; *agg = (f32x2){A, B}; }
    }
}

template <bool APPLY>
__device__ __forceinline__ void lru_unit(Frame& F, int unit) {
    const int h = unit & 7, c = (unit >> 3) & 63, b = unit >> 9;
    const int tid = F.tid, lane = F.lane, w = F.wave, fr = lane & 15, fq = lane >> 4;
    const size_t t0 = (size_t)b * SEQ + (size_t)c * CHUNK;
    LAS unsigned char* XR = F.lds + LRU_XR; LAS unsigned char* XC = F.lds + LRU_XC; LAS unsigned char* GR = F.lds + LRU_GR;
    bf16x8 Ba0[4], Bx0[4], Ba1[4], Bx1[4];
    {
        const bf16* wb = F.LRUW() + (size_t)h * 16384 + (size_t)(16 * w + fr) * 128 + 8 * fq;
#pragma unroll
        for (int ks = 0; ks < 4; ++ks) { Ba0[ks] = *(const GAS bf16x8*)(wb + 32 * ks); Ba1[ks] = *(const GAS bf16x8*)(wb + (size_t)8 * 16384 + 32 * ks);
            Bx0[ks] = *(const GAS bf16x8*)(wb + (size_t)16 * 16384 + 32 * ks); Bx1[ks] = *(const GAS bf16x8*)(wb + (size_t)24 * 16384 + 32 * ks); }
    }
    for (int p = tid; p < 131 * 16; p += 512) { const int r = p >> 4, cg = p & 15; const int s = c * CHUNK - 2 + r; v4u v = (v4u){0u, 0u, 0u, 0u};
        if (s >= 0 && s < SEQ) v = *(const GAS v4u*)(F.Z() + ((size_t)b * SEQ + s) * NIN + h * 128 + cg * 8);
        *(LAS v4u*)(XR + r * 256 + cg * 16) = v; }
    if (APPLY) { for (int p = tid; p < 128 * 32; p += 512) { const int r = p >> 5, cg = p & 31;
        *(LAS v2u*)(GR + r * 264 + cg * 8) = *(const GAS v2u*)(F.Z() + (t0 + r) * NIN + LW + h * 128 + cg * 4); } }
    __syncthreads();
    {
        const int ch2 = tid & 63, tg = tid >> 6, chg = h * 128 + 2 * ch2;
        float w0[4], w1[4];
#pragma unroll
        for (int k = 0; k < 4; ++k) { w0[k] = F.A.in[3][k * LW + chg]; w1[k] = F.A.in[3][k * LW + chg + 1]; }
        const float b0 = F.A.in[4][chg], b1 = F.A.in[4][chg + 1];
        float x0[4], x1[4];
#pragma unroll
        for (int k = 0; k < 3; ++k) { const unsigned u = *(const LAS unsigned*)(XR + (16 * tg + k) * 256 + ch2 * 4); x0[k] = bf_lo(u); x1[k] = bf_hi(u); }
#pragma unroll
        for (int j = 0; j < 16; ++j) {
            const unsigned u = *(const LAS unsigned*)(XR + (16 * tg + j + 3) * 256 + ch2 * 4); x0[3] = bf_lo(u); x1[3] = bf_hi(u);
            const float y0 = b0 + ((w0[0] * x0[0] + w0[1] * x0[1]) + (w0[2] * x0[2] + w0[3] * x0[3]));
            const float y1 = b1 + ((w1[0] * x1[0] + w1[1] * x1[1]) + (w1[2] * x1[2] + w1[3] * x1[3]));
            *(LAS unsigned*)(XC + xc_off(16 * tg + j, 2 * ch2)) = pk2(y0, y1);
            x0[0] = x0[1]; x0[1] = x0[2]; x0[2] = x0[3]; x1[0] = x1[1]; x1[1] = x1[2]; x1[2] = x1[3];
        }
    }
    __syncthreads();
    float hsum[8][4];
    lru_dir<APPLY, 0>(F, b, c, h, Ba0, Bx0, hsum);
    asm volatile("" ::: "memory"); __builtin_amdgcn_sched_barrier(0);
    lru_dir<APPLY, 1>(F, b, c, h, Ba1, Bx1, hsum);
    if (APPLY) {
        const int chl = 16 * w + fr;
#pragma unroll
        for (int m = 0; m < 8; ++m)
#pragma unroll
            for (int j = 0; j < 4; ++j) { LAS unsigned short* p = (LAS unsigned short*)(GR + (32 * fq + 4 * m + j) * 264 + chl * 2); *p = (unsigned short)f2bf(bf1(*p) * hsum[m][j]); }
        __syncthreads();
        for (int p = tid; p < 128 * 32; p += 512) { const int r = p >> 5, cg = p & 31;
            *(GAS v2u*)(F.MIX() + (t0 + r) * D + h * 128 + cg * 4) = *(const LAS v2u*)(GR + r * 264 + cg * 8); }
    }
    __syncthreads();
}
__device__ __forceinline__ void lru_carry(Frame& F) {
    const int idx = (F.vcu * NWAVES + F.wave) * 64 + F.lane;
    if (idx >= BATCH * 2 * LW) return;
    const int ch = idx & (LW - 1), bd = idx >> 10, dir = bd & 1;
    const f32x2* agg = (const f32x2*)F.AGG() + (size_t)bd * NCHUNK * LW + ch; float* cr = F.CARRY() + (size_t)bd * NCHUNK * LW + ch;
    float st = 0.f;
#pragma unroll 8
    for (int i = 0; i < NCHUNK; ++i) { const int cc = dir == 0 ? i : NCHUNK - 1 - i; const f32x2 pe = agg[(size_t)cc * LW]; cr[(size_t)cc * LW] = st; st = pe.x * st + pe.y; }
}
constexpr int GM_ST = 0, GM_BS = 1024, GM_VN = 2048, GM_GU = 2048 + 32768;
typedef short s16x4 __attribute__((ext_vector_type(4)));
__device__ __forceinline__ unsigned vn_off(unsigned row, unsigned ch) { return 256u * row + 16u * (ch ^ (((row & 3u) << 2) | ((row >> 2) & 3u))); }
__device__ __forceinline__ void gmlp_unit(Frame& F, int unit) {
    const int tid = F.tid, lane = F.lane, w = F.wave, fr = lane & 15, fq = lane >> 4;
    const size_t t0 = (size_t)unit * CHUNK;
    LAS float* ST = (LAS float*)(F.lds + GM_ST); LAS float* BS = (LAS float*)(F.lds + GM_BS);
    LAS unsigned char* VN = F.lds + GM_VN; LAS unsigned char* GU = F.lds + GM_GU;
    for (int rr = 0; rr < 16; ++rr) {
        const int row = 16 * w + rr;
        const bf16* p = F.Z() + (t0 + row) * NIN + 3 * LW + lane * 8;
        const v4u a = *(const GAS v4u*)p, b = *(const GAS v4u*)(p + 512);
        float x[16] = {bf_lo(a.x), bf_hi(a.x), bf_lo(a.y), bf_hi(a.y), bf_lo(a.z), bf_hi(a.z), bf_lo(a.w), bf_hi(a.w),
                       bf_lo(b.x), bf_hi(b.x), bf_lo(b.y), bf_hi(b.y), bf_lo(b.z), bf_hi(b.z), bf_lo(b.w), bf_hi(b.w)};
        float s = 0.f;
#pragma unroll
        for (int i = 0; i < 16; ++i) s += x[i];
        const float mean = wave_sum(s) * (1.0f / LW);
        float q = 0.f;
#pragma unroll
        for (int i = 0; i < 16; ++i) { const float d = x[i] - mean; q += d * d; }
        const float rstd = __builtin_amdgcn_rsqf(wave_sum(q) * (1.0f / LW) + 1e-6f);
        if (lane == 0) { ST[2 * row] = mean; ST[2 * row + 1] = rstd; }
    }
    __syncthreads();
    const unsigned trq = (unsigned)(lane & 15) >> 2, trp = (unsigned)lane & 3u;
    for (int h = 0; h < 8; ++h) {
#pragma unroll
        for (int i = 0; i < 4; ++i) { const int pid = tid + 512 * i, q = pid >> 4, cg = pid & 15;
            const v4u a = *(const GAS v4u*)(F.Z() + (t0 + q) * NIN + 3 * LW + h * 128 + cg * 8);
            const float mean = ST[2 * q], rstd = ST[2 * q + 1];
            const f32x4 g0 = *(const GAS f32x4*)(F.A.in[10] + h * 128 + cg * 8), g1 = *(const GAS f32x4*)(F.A.in[10] + h * 128 + cg * 8 + 4);
            const f32x4 b0 = *(const GAS f32x4*)(F.A.in[11] + h * 128 + cg * 8), b1 = *(const GAS f32x4*)(F.A.in[11] + h * 128 + cg * 8 + 4);
            v4u o;
            o.x = pk2((bf_lo(a.x) - mean) * rstd * g0.x + b0.x, (bf_hi(a.x) - mean) * rstd * g0.y + b0.y);
            o.y = pk2((bf_lo(a.y) - mean) * rstd * g0.z + b0.z, (bf_hi(a.y) - mean) * rstd * g0.w + b0.w);
            o.z = pk2((bf_lo(a.z) - mean) * rstd * g1.x + b1.x, (bf_hi(a.z) - mean) * rstd * g1.y + b1.y);
            o.w = pk2((bf_lo(a.w) - mean) * rstd * g1.z + b1.z, (bf_hi(a.w) - mean) * rstd * g1.w + b1.w);
            *(LAS v4u*)(VN + vn_off((unsigned)q, (unsigned)cg)) = o;
        }
#pragma unroll
        for (int i = 0; i < 8; ++i) { const int pid = tid + 512 * i, r = pid >> 5, cg = pid & 31;
            *(LAS v2u*)(GU + r * 264 + cg * 8) = *(const GAS v2u*)(F.Z() + (t0 + r) * NIN + 2 * LW + h * 128 + cg * 4); }
        if (tid < 128) BS[tid] = F.A.in[13][h * 128 + tid];
        bf16x8 Af[4];
        { const bf16* wsb = F.WSB() + (size_t)h * 16384 + (size_t)(16 * w + fr) * 128 + 8 * fq;
#pragma unroll
          for (int ks = 0; ks < 4; ++ks) Af[ks] = *(const GAS bf16x8*)(wsb + 32 * ks); }
        __syncthreads();
        f32x4 acc[8];
#pragma unroll
        for (int n = 0; n < 8; ++n) {
            acc[n] = (f32x4){0.f, 0.f, 0.f, 0.f};
#pragma unroll
            for (int ks = 0; ks < 4; ++ks) {
                const s16x4 b0 = __builtin_amdgcn_ds_read_tr16_b64_v4i16((LAS s16x4*)(VN + vn_off(32u * ks + 8u * fq + trq, 2u * n + (trp >> 1)) + 8u * (trp & 1u)));
                const s16x4 b1 = __builtin_amdgcn_ds_read_tr16_b64_v4i16((LAS s16x4*)(VN + vn_off(32u * ks + 8u * fq + 4u + trq, 2u * n + (trp >> 1)) + 8u * (trp & 1u)));
                const bf16x8 bb = (bf16x8){b0[0], b0[1], b0[2], b0[3], b1[0], b1[1], b1[2], b1[3]};
                acc[n] = __builtin_amdgcn_mfma_f32_16x16x32_bf16(Af[ks], bb, acc[n], 0, 0, 0);
            }
        }
#pragma unroll
        for (int n = 0; n < 8; ++n)
#pragma unroll
            for (int j = 0; j < 4; ++j) { const int p = 16 * w + 4 * fq + j; LAS unsigned short* ad = (LAS unsigned short*)(GU + p * 264 + (16 * n + fr) * 2);
                *ad = (unsigned short)f2bf(bf1(*ad) * (acc[n][j] + BS[p])); }
        __syncthreads();
#pragma unroll
        for (int i = 0; i < 8; ++i) { const int pid = tid + 512 * i, r = pid >> 5, cg = pid & 31;
            *(GAS v2u*)(F.MIX() + (t0 + r) * D + LW + h * 128 + cg * 4) = *(const LAS v2u*)(GU + r * 264 + cg * 8); }
        __syncthreads();
    }
}
typedef float f32x16 __attribute__((ext_vector_type(16)));
__device__ __forceinline__ unsigned fkey(float f) { const unsigned u = __builtin_bit_cast(unsigned, f); return (u & 0x80000000u) ? ~u : (u | 0x80000000u); }
__device__ __forceinline__ float fkey_inv(unsigned k) { const unsigned u = (k & 0x80000000u) ? (k & 0x7fffffffu) : ~k; return __builtin_bit_cast(float, u); }
__device__ __forceinline__ unsigned umax_(unsigned a, unsigned b) { return a > b ? a : b; }
__device__ __forceinline__ unsigned umin_(unsigned a, unsigned b) { return a < b ? a : b; }
#define CE_DESC(x, y) do { const unsigned a_ = (x), b_ = (y); (x) = umax_(a_, b_); (y) = umin_(a_, b_); } while (0)
__device__ __forceinline__ void sort16_desc(unsigned (&a)[16]) {
#pragma unroll
    for (int k = 2; k <= 16; k <<= 1)
#pragma unroll
        for (int j = k >> 1; j >= 1; j >>= 1)
#pragma unroll
            for (int i = 0; i < 16; ++i) { const int l = i ^ j; if (l > i) { if ((i & k) == 0) CE_DESC(a[i], a[l]); else CE_DESC(a[l], a[i]); } }
}
__device__ __forceinline__ void merge16_desc(unsigned (&a)[16], const unsigned (&b)[16]) {
#pragma unroll
    for (int i = 0; i < 16; ++i) a[i] = umax_(a[i], b[15 - i]);
#pragma unroll
    for (int j = 8; j >= 1; j >>= 1)
#pragma unroll
        for (int i = 0; i < 16; ++i) if ((i & j) == 0) CE_DESC(a[i], a[i + j]);
}
typedef short bf16x8s __attribute__((ext_vector_type(8)));
__device__ __forceinline__ void topk_unit(Frame& F, int wu) {
    const int tg = wu >> 3, hd = wu & 7, lane = F.lane, r = lane & 31, hh = lane >> 5;
    const int t = tg * 32 + r;
    const size_t qoff = (size_t)t * D + hd * 256 + 8 * hh;
    unsigned L[2][16];
    unsigned hh4 = (unsigned)hh << 2; asm volatile("" : "+v"(hh4));
#pragma unroll
    for (int p = 0; p < 2; ++p) {
        f32x16 acc[4];
#pragma unroll
        for (int nt = 0; nt < 4; ++nt)
#pragma unroll
            for (int i = 0; i < 16; ++i) acc[nt][i] = 0.f;
        const size_t koff = ((size_t)(hd * 2 + p) * 128 + r) * 128 + 8 * hh;
        const bf16* qp = F.QH() + qoff + p * 128; const bf16* kp0 = F.KH() + koff; const bf16* kp1 = kp0 + 32 * 128; const bf16* kp2 = kp0 + 64 * 128; const bf16* kp3 = kp0 + 96 * 128;
        asm volatile("" : "+v"(qp), "+v"(kp0), "+v"(kp1), "+v"(kp2), "+v"(kp3));
#define P6_LOAD(Q, K, ks0, n) _Pragma("unroll") for (int i_ = 0; i_ < (n); ++i_) { Q[i_] = *(const GAS bf16x8s*)(qp + 16 * ((ks0) + i_)); \
            K[i_][0] = *(const GAS bf16x8s*)(kp0 + 16 * ((ks0) + i_)); K[i_][1] = *(const GAS bf16x8s*)(kp1 + 16 * ((ks0) + i_)); \
            K[i_][2] = *(const GAS bf16x8s*)(kp2 + 16 * ((ks0) + i_)); K[i_][3] = *(const GAS bf16x8s*)(kp3 + 16 * ((ks0) + i_)); }
#define P6_MMA(Q, K, n) _Pragma("unroll") for (int i_ = 0; i_ < (n); ++i_) _Pragma("unroll") for (int nt = 0; nt < 4; ++nt) acc[nt] = __builtin_amdgcn_mfma_f32_32x32x16_bf16(K[i_][nt], Q[i_], acc[nt], 0, 0, 0);
        bf16x8s qa[3], ka[3][4], qb[3], kb[3][4];
        P6_LOAD(qa, ka, 0, 3); P6_LOAD(qb, kb, 3, 3);
        __builtin_amdgcn_sched_barrier(0);
        P6_MMA(qa, ka, 3);
        __builtin_amdgcn_sched_barrier(0);
        P6_LOAD(qa, ka, 6, 2);
        __builtin_amdgcn_sched_barrier(0);
        P6_MMA(qb, kb, 3);
        __builtin_amdgcn_sched_barrier(0);
        P6_MMA(qa, ka, 2);
        __builtin_amdgcn_sched_barrier(0);
#undef P6_LOAD
#undef P6_MMA
        unsigned S[4][16];
#pragma unroll
        for (int nt = 0; nt < 4; ++nt) {
#pragma unroll
            for (int rg = 0; rg < 16; ++rg) { const int nc = 32 * nt + (rg & 3) + 8 * (rg >> 2); S[nt][rg] = ((fkey(acc[nt][rg]) & ~0x7Fu) | (unsigned)(127 - nc)) ^ hh4; }
            sort16_desc(S[nt]);
        }
        merge16_desc(S[0], S[1]); merge16_desc(S[2], S[3]); merge16_desc(S[0], S[2]);
        unsigned T[16];
#pragma unroll
        for (int i = 0; i < 16; ++i) T[i] = (unsigned)__shfl_xor((int)S[0][i], 32);
        merge16_desc(S[0], T);
#pragma unroll
        for (int i = 0; i < 16; ++i) L[p][i] = S[0][i];
        __builtin_amdgcn_sched_barrier(0);
    }
    float v0[16], v1[16];
#pragma unroll
    for (int i = 0; i < 16; ++i) { v0[i] = fkey_inv(L[0][i] & ~0x7Fu); v1[i] = fkey_inv(L[1][i] & ~0x7Fu); }
    unsigned C[4][16];
    {
        int cnt = 0;
#pragma unroll
        for (int i = 0; i < 16; ++i)
#pragma unroll
            for (int j = 0; j < 16; ++j) if ((i + 1) * (j + 1) <= 16) { C[cnt >> 4][cnt & 15] = (fkey(v0[i] + v1[j]) & ~0xFFu) | (unsigned)(255 - (i * 16 + j)); ++cnt; }
#pragma unroll
        for (int q = 50; q < 64; ++q) C[q >> 4][q & 15] = 0u;
    }
    sort16_desc(C[0]); sort16_desc(C[1]); sort16_desc(C[2]); sort16_desc(C[3]);
    merge16_desc(C[0], C[1]); merge16_desc(C[2], C[3]); merge16_desc(C[0], C[2]);
    unsigned best[16];
#pragma unroll
    for (int i = 0; i < 16; ++i) best[i] = C[0][i];
    float sv[16]; int ids[16];
    const float smax = fkey_inv(best[0] & ~0xFFu);
    float ssum = 0.f;
#pragma unroll
    for (int k = 0; k < 16; ++k) {
        const unsigned pos = 255u - (best[k] & 0xFFu); const unsigned ii = pos >> 4, jj = pos & 15u;
        unsigned k0 = L[0][0], k1 = L[1][0];
#pragma unroll
        for (int i = 1; i < 16; ++i) { k0 = (ii == (unsigned)i) ? L[0][i] : k0; k1 = (jj == (unsigned)i) ? L[1][i] : k1; }
        ids[k] = (int)((127u - (k0 & 0x7Fu)) * 128u + (127u - (k1 & 0x7Fu)));
        sv[k] = __builtin_amdgcn_exp2f((fkey_inv(best[k] & ~0xFFu) - smax) * 1.4426950409f); ssum += sv[k];
    }
    const float inv = 1.0f / ssum;
    if (hh == 0) {
        int* o = F.IDS() + (size_t)t * 128 + hd * 16;
#pragma unroll
        for (int k = 0; k < 16; k += 4) *(GAS v4u*)(o + k) = (v4u){(unsigned)ids[k], (unsigned)ids[k + 1], (unsigned)ids[k + 2], (unsigned)ids[k + 3]};
    } else {
        float* o = F.GATES() + (size_t)t * 128 + hd * 16;
#pragma unroll
        for (int k = 0; k < 16; k += 4) *(GAS f32x4*)(o + k) = (f32x4){sv[k] * inv, sv[k + 1] * inv, sv[k + 2] * inv, sv[k + 3] * inv};
    }
}
__device__ __forceinline__ int idot16(const v4u u, const unsigned* h, int acc) {
    acc = __builtin_amdgcn_sdot4((int)u.x, (int)h[0], acc, false); acc = __builtin_amdgcn_sdot4((int)u.y, (int)h[1], acc, false);
    acc = __builtin_amdgcn_sdot4((int)u.z, (int)h[2], acc, false); acc = __builtin_amdgcn_sdot4((int)u.w, (int)h[3], acc, false);
    return acc;
}
__device__ __forceinline__ void h8_row(Frame& F, int t) {
    const int lane = F.lane;
    float hx[32]; float mx = 0.f;
    const bf16* hp = F.HB() + (size_t)t * D + lane * 16;
#pragma unroll
    for (int c = 0; c < 2; ++c)
#pragma unroll
        for (int q = 0; q < 2; ++q) { const v4u a = *(const GAS v4u*)(hp + c * 1024 + q * 8); float* x = hx + c * 16 + q * 8;
            x[0] = bf_lo(a.x); x[1] = bf_hi(a.x); x[2] = bf_lo(a.y); x[3] = bf_hi(a.y); x[4] = bf_lo(a.z); x[5] = bf_hi(a.z); x[6] = bf_lo(a.w); x[7] = bf_hi(a.w); }
#pragma unroll
    for (int i = 0; i < 32; ++i) mx = fmaxf(mx, fabsf(hx[i]));
#pragma unroll
    for (int o = 1; o < 64; o <<= 1) mx = fmaxf(mx, __shfl_xor(mx, o));
    const float sc = mx > 0.f ? 127.0f / mx : 1.0f;
#pragma unroll
    for (int c = 0; c < 2; ++c) { v4u o; o.x = pack_i8x4(hx[c * 16 + 0] * sc, hx[c * 16 + 1] * sc, hx[c * 16 + 2] * sc, hx[c * 16 + 3] * sc);
        o.y = pack_i8x4(hx[c * 16 + 4] * sc, hx[c * 16 + 5] * sc, hx[c * 16 + 6] * sc, hx[c * 16 + 7] * sc);
        o.z = pack_i8x4(hx[c * 16 + 8] * sc, hx[c * 16 + 9] * sc, hx[c * 16 + 10] * sc, hx[c * 16 + 11] * sc);
        o.w = pack_i8x4(hx[c * 16 + 12] * sc, hx[c * 16 + 13] * sc, hx[c * 16 + 14] * sc, hx[c * 16 + 15] * sc);
        *(GAS v4u*)(F.H8() + (size_t)t * D + c * 1024 + lane * 16) = o; }
    if (lane == 0) F.HSCALE()[t] = mx > 0.f ? mx * (1.0f / 127.0f) : 1.0f;
}
__device__ __forceinline__ int row_sum16(int v) {
    v += __builtin_amdgcn_update_dpp(0, v, 0x128, 0xf, 0xf, false);
    v += __builtin_amdgcn_update_dpp(0, v, 0x124, 0xf, 0xf, false);
    v += __builtin_amdgcn_update_dpp(0, v, 0x122, 0xf, 0xf, false);
    v += __builtin_amdgcn_update_dpp(0, v, 0x121, 0xf, 0xf, false);
    return v;
}
__device__ __forceinline__ void peer_u_xcd(Frame& F) {
    const int lane = F.lane, x = blockIdx.x & 7, jcu = blockIdx.x >> 3, ncu = ((int)F.G - x + 7) >> 3;
    const int tpc = (M + ncu - 1) / ncu, tpw = (tpc + NWAVES - 1) / NWAVES;
    const int tbase = jcu * tpc + F.wave * tpw;
    int nw = M - tbase; { const int lim = (jcu + 1) * tpc - tbase; nw = nw < lim ? nw : lim; nw = nw < tpw ? nw : tpw; nw = nw < 0 ? 0 : nw; }
    const int NV = 2 * nw;
    LAS unsigned char* wl = F.lds + F.wave * 9216;
    LAS int* lst = (LAS int*)wl; LAS int* res = (LAS int*)(wl + 512); LAS unsigned char* hsl = wl + 1024;
    const int q4 = lane >> 4, i16 = lane & 15;
    const unsigned char* ubase = F.U8() + (size_t)x * 2048 * D;
    const unsigned lanepart = (unsigned)i16 * 16u;
    int r_idlo = 0, r_idhi = 0, r_t = 0, r_g = 0; v4u r_hq = (v4u){0u, 0u, 0u, 0u};
    int v_cl0 = 0, v_cl1 = 0, v_n = 0, v_r0 = 0, v_t = 0, v_g = 0, v_slot = 0; unsigned long long v_mlo = 0, v_mhi = 0; bool v_live = false;
    int vset = 0, nvalid = 0, idle = 0;
    if (NV == 0) return;
#define U_RAW() do { const int vi_ = vset < NV ? vset : NV - 1; r_g = vi_ >= nw ? 1 : 0; r_t = tbase + (vi_ - r_g * nw); \
        r_idlo = F.IDS()[(size_t)r_t * 128 + lane]; r_idhi = F.IDS()[(size_t)r_t * 128 + 64 + lane]; \
        r_hq = *(const GAS v4u*)(F.H8() + (size_t)r_t * D + r_g * 1024 + lane * 16); } while (0)
#define U_NEXT() do { if (v_live && v_r0 + 16 < v_n) { v_r0 += 16; } else if (vset < NV) { const bool slo = (r_idlo >> 11) == x, shi = (r_idhi >> 11) == x; \
            v_mlo = __ballot(slo); v_mhi = __ballot(shi); const int nlo = __popcll(v_mlo); v_n = nlo + __popcll(v_mhi); \
            const int plo = __builtin_amdgcn_mbcnt_hi((unsigned)(v_mlo >> 32), __builtin_amdgcn_mbcnt_lo((unsigned)v_mlo, 0)); \
            const int phi = nlo + __builtin_amdgcn_mbcnt_hi((unsigned)(v_mhi >> 32), __builtin_amdgcn_mbcnt_lo((unsigned)v_mhi, 0)); \
            if (slo) lst[plo] = (r_idlo & 2047) | (lane << 16); if (shi) lst[phi] = (r_idhi & 2047) | ((64 + lane) << 16); \
            v_slot = (nvalid++) & 7; *(LAS v4u*)(hsl + v_slot * 1024 + lane * 16) = r_hq; \
            v_cl0 = lst[lane]; v_cl1 = lst[64 + lane]; v_t = r_t; v_g = r_g; v_r0 = 0; ++vset; v_live = true; } \
        else { v_live = false; v_n = 0; v_r0 = 0; v_mlo = 0; v_mhi = 0; ++idle; } } while (0)
#define U_ISSUE(BUF, DS) do { { const int rem_ = v_n - v_r0; DS##_cnt = rem_ < 0 ? 0 : (rem_ < 16 ? rem_ : 16); } \
        DS##_slot = v_slot; DS##_t = v_t; DS##_g = v_g; DS##_mlo = v_mlo; DS##_mhi = v_mhi; DS##_last = v_live && (v_r0 + 16 >= v_n); \
        const unsigned char* rb_ = ubase + v_g * 1024; \
        _Pragma("unroll") for (int gp = 0; gp < 4; ++gp) { const int ix_ = v_r0 + 4 * gp + q4; const int a_ = __shfl(v_cl0, ix_ & 63), b_ = __shfl(v_cl1, ix_ & 63); DS##_ent[gp] = ix_ < 64 ? a_ : b_; \
            const unsigned of_ = (4 * gp + q4 < DS##_cnt ? ((unsigned)(DS##_ent[gp] & 2047) << 11) : 0u) + lanepart; \
            _Pragma("unroll") for (int c = 0; c < 4; ++c) BUF[4 * gp + c] = *(const GAS v4u*)(rb_ + of_ + c * 256); } } while (0)
#define U_COMPUTE(BUF, DS) do { const volatile LAS v4u* hp_ = (const volatile LAS v4u*)(hsl + DS##_slot * 1024 + i16 * 16); \
        _Pragma("unroll") for (int gp = 0; gp < 4; ++gp) { int a_ = 0; \
            _Pragma("unroll") for (int c = 0; c < 4; ++c) { const v4u r_ = BUF[4 * gp + c]; const v4u h_ = hp_[c * 16]; a_ = __builtin_amdgcn_sdot4((int)r_.x, (int)h_.x, a_, false); a_ = __builtin_amdgcn_sdot4((int)r_.y, (int)h_.y, a_, false); \
                a_ = __builtin_amdgcn_sdot4((int)r_.z, (int)h_.z, a_, false); a_ = __builtin_amdgcn_sdot4((int)r_.w, (int)h_.w, a_, false); } \
            a_ = row_sum16(a_); if (i16 == 0 && 4 * gp + q4 < DS##_cnt) res[DS##_ent[gp] >> 16] = a_; } \
        if (DS##_last) { int* po_ = F.PART() + ((size_t)DS##_g * M + DS##_t) * 128; \
            if ((DS##_mlo >> lane) & 1ull) po_[lane] = res[lane]; if ((DS##_mhi >> lane) & 1ull) po_[64 + lane] = res[64 + lane]; } } while (0)
    v4u bufA[16], bufB[16], bufC[16];
    int dA_cnt = 0, dA_ent[4] = {0, 0, 0, 0}, dA_t = 0, dA_g = 0, dA_slot = 0; unsigned long long dA_mlo = 0, dA_mhi = 0; bool dA_last = false;
    int dB_cnt = 0, dB_ent[4] = {0, 0, 0, 0}, dB_t = 0, dB_g = 0, dB_slot = 0; unsigned long long dB_mlo = 0, dB_mhi = 0; bool dB_last = false;
    int dC_cnt = 0, dC_ent[4] = {0, 0, 0, 0}, dC_t = 0, dC_g = 0, dC_slot = 0; unsigned long long dC_mlo = 0, dC_mhi = 0; bool dC_last = false;
    U_RAW();
    U_NEXT(); U_RAW(); U_ISSUE(bufA, dA);
    U_NEXT(); U_RAW(); U_ISSUE(bufB, dB);
    while (idle < 3) {
        U_NEXT(); U_RAW(); U_ISSUE(bufC, dC); U_COMPUTE(bufA, dA);
        U_NEXT(); U_RAW(); U_ISSUE(bufA, dA); U_COMPUTE(bufB, dB);
        U_NEXT(); U_RAW(); U_ISSUE(bufB, dB); U_COMPUTE(bufC, dC);
    }
#undef U_RAW
#undef U_NEXT
#undef U_ISSUE
#undef U_COMPUTE
}
__device__ __forceinline__ void peer_act_token(Frame& F, int t) {
    const int lane = F.lane;
    LAS float* abuf = (LAS float*)(F.lds + F.wave * 1024); LAS int* ibuf = (LAS int*)(F.lds + F.wave * 1024 + 512);
    const float sc = __builtin_amdgcn_rsqf(F.ROWSS()[t] * (1.0f / D) + 1e-6f) * F.HSCALE()[t];
    float am = 0.f;
#pragma unroll
    for (int half = 0; half < 2; ++half) {
        const size_t o = (size_t)t * 128 + half * 64 + lane;
        const int e = F.IDS()[o]; const float g = F.GATES()[o];
        const int dsum = F.PART()[o] + F.PART()[(size_t)M * 128 + o];
        const float act = gelu_tanh((float)dsum * sc * F.USCALE()[e]) * g * F.VSCALE()[e];
        abuf[half * 64 + lane] = act; ibuf[half * 64 + lane] = e; am = fmaxf(am, fabsf(act));
    }
#pragma unroll
    for (int o = 1; o < 64; o <<= 1) am = fmaxf(am, __shfl_xor(am, o));
    const float asc = am > 0.f ? 127.0f / am : 1.0f;
    if (lane == 0) F.ASCALE()[t] = am > 0.f ? am * (1.0f / 127.0f) : 1.0f;
    if (lane < 32) {
        const f32x4 av = *(const LAS f32x4*)(abuf + 4 * lane); const v4u iv = *(const LAS v4u*)(ibuf + 4 * lane);
        const size_t o = ((size_t)(t >> 6) * 32 + lane) * 64 + (t & 63);
        F.IDW()[o] = (v4u){iv.x << 3, iv.y << 3, iv.z << 3, iv.w << 3};
        F.AW()[o] = pack_i8x4(av.x * asc, av.y * asc, av.z * asc, av.w * asc);
    }
}
__device__ __forceinline__ void tr4x4(const unsigned r0, const unsigned r1, const unsigned r2, const unsigned r3, unsigned (&c)[4]) {
    const unsigned t01l = __builtin_amdgcn_perm(r1, r0, 0x05010400u), t01h = __builtin_amdgcn_perm(r1, r0, 0x07030602u);
    const unsigned t23l = __builtin_amdgcn_perm(r3, r2, 0x05010400u), t23h = __builtin_amdgcn_perm(r3, r2, 0x07030602u);
    c[0] = __builtin_amdgcn_perm(t23l, t01l, 0x05040100u); c[1] = __builtin_amdgcn_perm(t23l, t01l, 0x07060302u);
    c[2] = __builtin_amdgcn_perm(t23h, t01h, 0x05040100u); c[3] = __builtin_amdgcn_perm(t23h, t01h, 0x07060302u);
}
template <int MODE>
__device__ __forceinline__ void peer_v_slice(Frame& F, int c, bool do_atomic) {
    const int tid = F.tid, lane = F.lane;
    for (int i = tid; i < NEXP * 8 / 16; i += 512) *(LAS v4u*)(F.lds + i * 16) = *(const GAS v4u*)(F.V8T() + (size_t)c * NEXP * 8 + (size_t)i * 16);
    __syncthreads();
    const v4u* ibase = F.IDW() + lane; const unsigned* abase = F.AW() + lane;
    constexpr int NBLK = M / 64, PD = 16;
    v4u iq[PD]; unsigned aq[PD]; v2u rw[2][4];
    {
        const size_t o = (size_t)F.wave * 32 * 64;
#pragma unroll
        for (int j = 0; j < PD; ++j) { iq[j] = *(const GAS v4u*)(ibase + o + j * 64); aq[j] = abase[o + j * 64]; }
    }
#define LROW(dst, q) do { dst[0] = *(const LAS v2u*)(F.lds + (q).x); dst[1] = *(const LAS v2u*)(F.lds + (q).y); \
                          dst[2] = *(const LAS v2u*)(F.lds + (q).z); dst[3] = *(const LAS v2u*)(F.lds + (q).w); } while (0)
    for (int blk = F.wave; blk < NBLK; blk += NWAVES) {
        const int t = blk * 64 + lane;
        const size_t o = (size_t)blk * 32 * 64;
        const int nblk = (blk + NWAVES < NBLK) ? blk + NWAVES : blk;
        const size_t on = (size_t)nblk * 32 * 64;
        int acc[8];
#pragma unroll
        for (int i = 0; i < 8; ++i) acc[i] = 0;
        LROW(rw[0], iq[0]);
#pragma unroll
        for (int j = 0; j < 32; ++j) {
            if (j + 1 < 32) LROW(rw[(j + 1) & 1], iq[(j + 1) % PD]);
            const unsigned aw = aq[j % PD];
            unsigned cl[4], ch[4];
            tr4x4(rw[j & 1][0].x, rw[j & 1][1].x, rw[j & 1][2].x, rw[j & 1][3].x, cl);
            tr4x4(rw[j & 1][0].y, rw[j & 1][1].y, rw[j & 1][2].y, rw[j & 1][3].y, ch);
#pragma unroll
            for (int i = 0; i < 4; ++i) { acc[i] = __builtin_amdgcn_sdot4((int)aw, (int)cl[i], acc[i], false); acc[4 + i] = __builtin_amdgcn_sdot4((int)aw, (int)ch[i], acc[4 + i], false); }
            { const size_t oo = (j + PD < 32) ? o + (size_t)(j + PD) * 64 : on + (size_t)(j + PD - 32) * 64;
              iq[j % PD] = *(const GAS v4u*)(ibase + oo); aq[j % PD] = abase[oo]; }
            __builtin_amdgcn_sched_barrier(0);
        }
        const float asc = F.ASCALE()[t];
        float accf[8];
#pragma unroll
        for (int i = 0; i < 8; ++i) accf[i] = (float)acc[i] * asc;
        const v4u hb = *(const GAS v4u*)(F.HBT() + ((size_t)c * M + t) * 8);
        accf[0] += bf_lo(hb.x); accf[1] += bf_hi(hb.x); accf[2] += bf_lo(hb.y); accf[3] += bf_hi(hb.y);
        accf[4] += bf_lo(hb.z); accf[5] += bf_hi(hb.z); accf[6] += bf_lo(hb.w); accf[7] += bf_hi(hb.w);
        bf16* yp = (MODE == 0) ? F.Y() + ((size_t)c * M + t) * 8 : (bf16*)F.XN() + ((((size_t)c * M + t) * 8) & (size_t)0x1ffffff);
        *(GAS v4u*)yp = (v4u){pk2(accf[0], accf[1]), pk2(accf[2], accf[3]), pk2(accf[4], accf[5]), pk2(accf[6], accf[7])};
        float ss = 0.f;
#pragma unroll
        for (int i = 0; i < 8; ++i) ss += accf[i] * accf[i];
        if (do_atomic) atomicAdd(F.ROWSS2() + t, ss);
    }
#undef LROW
    __syncthreads();
}
__device__ __forceinline__ void final_unit(Frame& F, int unit) {
    const int tid = F.tid, blk = unit >> 3, cg = unit & 7, t0 = blk * 64;
    LAS float* T = (LAS float*)F.lds;
#pragma unroll
    for (int i = 0; i < 4; ++i) { const int pid = tid + 512 * i, cl = pid >> 6, tok = pid & 63;
        const v4u v = *(const GAS v4u*)(F.Y() + ((size_t)(cg * 32 + cl) * M + t0 + tok) * 8);
        *(LAS f32x4*)(T + tok * 260 + cl * 8) = (f32x4){bf_lo(v.x), bf_hi(v.x), bf_lo(v.y), bf_hi(v.y)};
        *(LAS f32x4*)(T + tok * 260 + cl * 8 + 4) = (f32x4){bf_lo(v.z), bf_hi(v.z), bf_lo(v.w), bf_hi(v.w)}; }
    __syncthreads();
#pragma unroll
    for (int i = 0; i < 8; ++i) { const int pid = tid + 512 * i, tok = pid >> 6, c4 = pid & 63;
        const float rs = __builtin_amdgcn_rsqf(F.ROWSS2()[t0 + tok] * (1.0f / D) + 1e-6f);
        const f32x4 v = *(const LAS f32x4*)(T + tok * 260 + c4 * 4);
        const f32x4 g = *(const GAS f32x4*)(F.A.in[20] + cg * 256 + c4 * 4);
        *(GAS f32x4*)(F.A.out + (size_t)(t0 + tok) * D + cg * 256 + c4 * 4) = v * rs * g; }
    __syncthreads();
}
__global__ void __launch_bounds__(NWAVES * 64, 2) mk_fwd(Args args) {
    __shared__ __attribute__((aligned(16))) unsigned char lds[LDS_BYTES];
    Frame F(args);
    F.lds = (LAS unsigned char*)lds;
    F.MISC = (volatile LAS unsigned*)(F.lds + MISC_OFF);
    F.tid = threadIdx.x; F.lane = F.tid & 63; F.wave = __builtin_amdgcn_readfirstlane(F.tid >> 6);
    F.G = gridDim.x; { const int bx = blockIdx.x; F.vcu = (F.G % 8 == 0) ? (bx % 8) * (F.G / 8) + bx / 8 : bx; }
    F.ws = args.ws;
    F.ctl = (gu32*)(args.ws + WS_CTL);
    for (int u = F.tid; u < (LDS_BYTES - LDSCTL_OFF) / 4; u += NWAVES * 64) ((LAS unsigned*)(F.lds + LDSCTL_OFF))[u] = 0u;
    __syncthreads();
    XcdBarrier bar; bar.bar = (unsigned*)(F.ctl + CW_BAR); bar.x = 0; bar.st = nullptr;
    if (N_LAUNCHES != PER_PHASE) bar = xcd_barrier_post((unsigned*)(F.ctl + CW_BAR), F.MISC + 8);
#define GRID_BAR() do { if (N_LAUNCHES != PER_PHASE) xcd_barrier(bar); } while (0)
    const int lo = args.ph_lo, hi = args.ph_hi;
#ifndef MK_PHASE_MASK
#define MK_PHASE_MASK 0x7FF
#endif
#define IN(k) (((MK_PHASE_MASK >> (k)) & 1) && lo <= (k) && (k) < hi)
#undef MK_PHASE_MASK
#define MK_PHASE_MASK 0xFFFF
#define BOTH(k) (true)
#ifndef MK_REP_MASK
#define MK_REP_MASK 0
#endif
#ifndef MK_REP_N
#define MK_REP_N 2
#endif
#define REPS(k) for (int rep_ = 0; rep_ < ((((MK_REP_MASK) >> (k)) & 1) ? 1 + MK_REP_N : 1); ++rep_)
    const int gw = F.vcu * NWAVES + F.wave, NGW = F.G * NWAVES;
    if (IN(0)) { REPS(0) { p0_prologue(F); __syncthreads(); } if (BOTH(0)) GRID_BAR(); }
    if (IN(1)) {
        pg8::Gemm g{F.XN(), F.WIN(), M, NIN, D}; pg8::StaticOrder S; S.init(M, NIN, F.G, (int)blockIdx.x);
        pg8::EpiZ E{F.Z(), NIN, LW};
        REPS(1) pg8::gemm_phase<pg8::EpiZ, pg8::StaticOrder, true, true>(F.lds, g, S, E);
        if (BOTH(1)) GRID_BAR();
    }
    if (IN(2)) {
        REPS(12) for (int u = blockIdx.x; u < BATCH * NCHUNK * 8; u += F.G) lru_unit<false>(F, u);
        if (BOTH(2)) GRID_BAR();
    }
    if (IN(3)) {
        lru_carry(F);
        REPS(13) for (int u = blockIdx.x; u < BATCH * NCHUNK; u += F.G) gmlp_unit(F, u);
        if (BOTH(3)) GRID_BAR();
    }
    if (IN(11)) {
        REPS(3) for (int u = blockIdx.x; u < BATCH * NCHUNK * 8; u += F.G) lru_unit<true>(F, u);
        GRID_BAR();
    }
    if (IN(4)) {
        pg8::Gemm g{F.MIX(), F.WOUT(), M, D, D}; pg8::StaticOrder S; S.init(M, D, F.G, (int)blockIdx.x);
        pg8::EpiH E{F.HB(), F.HBT(), F.A.in[0], F.ROWSS(), D, M};
        pg8::gemm_phase<pg8::EpiH, pg8::StaticOrder, true, true>(F.lds, g, S, E);
        if (BOTH(4)) GRID_BAR();
    }
    if (IN(5)) {
        pg8::Gemm g{F.HB(), F.WQ(), M, D, D}; pg8::StaticOrder S; S.init(M, D, F.G, (int)blockIdx.x);
        pg8::EpiQ E{F.QH(), F.ROWSS(), D};
        REPS(5) pg8::gemm_phase<pg8::EpiQ, pg8::StaticOrder, true, true>(F.lds, g, S, E);
        if (BOTH(5)) GRID_BAR();
    }
    if (IN(6)) {
        REPS(6) { for (int wu = gw; wu < (M / 32) * 8; wu += NGW) topk_unit(F, wu);
                  for (int t = gw; t < M; t += NGW) h8_row(F, t); }
        if (BOTH(6)) GRID_BAR();
    }
    if (IN(7)) {
        REPS(7) peer_u_xcd(F);
        if (BOTH(7)) GRID_BAR();
    }
    if (IN(8)) {
        REPS(8) for (int t = gw; t < M; t += NGW) peer_act_token(F, t);
        if (BOTH(8)) GRID_BAR();
    }
    if (IN(9)) {
        for (int c = blockIdx.x; c < D / 8; c += F.G) peer_v_slice<0>(F, c, true);
        if ((MK_REP_MASK >> 9) & 1) { for (int rep_ = 0; rep_ < MK_REP_N; ++rep_) for (int c = blockIdx.x; c < D / 8; c += F.G) peer_v_slice<1>(F, c, false); }
        if (BOTH(9)) GRID_BAR();
    }
    if (IN(10)) {
        REPS(10) for (int u = blockIdx.x; u < (M / 64) * 8; u += F.G) final_unit(F, u);
    }
#undef IN
#undef BOTH
#undef GRID_BAR
}

extern "C" void kernel_launch(void* const* d_in, const int* in_sizes, int n_in, void* d_out, int out_size, void* d_ws, size_t ws_size, hipStream_t stream) {
    static int grid = 0;
    if (grid == 0) {
        if (n_in != 21 || in_sizes[0] != M * D || out_size != M * D || ws_size < WS_END) { fprintf(stderr, "kernel_launch: unexpected shapes (n_in %d, in0 %d, out %d, ws %zu)\n", n_in, n_in > 0 ? in_sizes[0] : -1, out_size, ws_size); grid = -1; return; }
        int dev = 0, cus = 0, per_cu = 0;
        if (hipGetDevice(&dev) != hipSuccess || hipDeviceGetAttribute(&cus, hipDeviceAttributeMultiprocessorCount, dev) != hipSuccess) { grid = -1; return; }
        if (hipOccupancyMaxActiveBlocksPerMultiprocessor(&per_cu, (const void*)mk_fwd, NWAVES * 64, 0) != hipSuccess || per_cu < 1) { fprintf(stderr, "kernel_launch: occupancy query reports %d blocks per CU\n", per_cu); }
        (void)hipGetLastError();
        grid = cus;
    }
    if (grid < 0) return;
    (void)hipMemsetAsync((char*)d_ws + WS_CTL, 0, CTL_ZERO_BYTES, stream);
    Args a{};
    for (int i = 0; i < 21; ++i) a.in[i] = (const float*)d_in[i];
    a.out = (float*)d_out; a.ws = (unsigned char*)d_ws;
    for (int li = 0; li < N_LAUNCHES; ++li) {
        a.ph_lo = 0; a.ph_hi = 99;
        hipLaunchKernelGGL(mk_fwd, dim3(grid), dim3(NWAVES * 64), 0, stream, a);
    }
}
```

```cpp
#include <hip/hip_runtime.h>
#include <cstdio>
#include <cstdint>
namespace pg8 {
#define PG8_LAS __attribute__((address_space(3)))
typedef unsigned short bf16_t;
typedef short bf16x8 __attribute__((ext_vector_type(8)));
typedef float f32x4 __attribute__((ext_vector_type(4)));
typedef unsigned u32x4 __attribute__((ext_vector_type(4)));
constexpr int BM = 256, BK = 64, HALF = 128, HTB = HALF * BK * 2  , STAGE_BYTES = 8 * HTB, NXCD = 8, WGM = 8;

__host__ __device__ __forceinline__ int lds_byte(int r, int c) { const int st = (r >> 4) * 2 + (c >> 5), rr = r & 15, cc = c & 31, ob = rr * 64 + cc * 2; return st * 1024 + (ob ^ (((ob >> 9) & 1) << 5)); }
__host__ __device__ __forceinline__ void stage_rc(int b, int& R, int& C) { const int st = b / 1024, sb = b % 1024, swz = sb ^ (((sb >> 9) & 1) << 5); R = (st >> 1) * 16 + swz / 64; C = (st & 1) * 32 + (swz % 64) / 2; }
__host__ __device__ __forceinline__ int perm32(int rho) { const int n = rho >> 4, i = rho & 15; return 8 * (i >> 2) + 4 * n + (i & 3); }

struct Unit { int pm, pn; };
struct Gemm { const bf16_t* A; const bf16_t* Bt; int M, N, K; };

struct StaticOrder {
    int nM, nN, nwg, G, c;
    __host__ __device__ void init(int M, int N, int G_, int c_) { nM = M / BM; nN = N / BM; nwg = nM * nN; G = G_; c = c_; }
    __host__ __device__ bool next(int i, Unit& u) const {
        const long L = (long)i * G + c; if (L >= nwg) return false;
        int wgid = (int)L; { const int q = nwg / NXCD, r = nwg % NXCD, xcd = wgid % NXCD, off = wgid / NXCD; wgid = (xcd < r ? xcd * (q + 1) : r * (q + 1) + (xcd - r) * q) + off; }
        const int nig = WGM * nN, gid = wgid / nig, fm = gid * WGM, gsz = (nM - fm) < WGM ? (nM - fm) : WGM;
        u.pm = fm + ((wgid % nig) % gsz); u.pn = (wgid % nig) / gsz; return true;
    }
    __device__ __forceinline__ void a_ready(const Unit&) const {}
    __device__ __forceinline__ void done(const Unit&) const {}
};

__device__ __forceinline__ unsigned cvt_pk_bf16(float lo, float hi) { unsigned r; asm volatile("v_cvt_pk_bf16_f32 %0, %1, %2" : "=v"(r) : "v"(lo), "v"(hi)); return r; }
__device__ __forceinline__ float gelu_tanh(float x) {
    const float t = x * (1.0f + 0.044715f * x * x);
    const float e = __builtin_amdgcn_exp2f(-2.3022081983f * t);
    return x * __builtin_amdgcn_rcpf(1.0f + e);
}
struct EpiZ {
    static constexpr bool PERM = true, AFTER_DRAIN = false;
    bf16_t* O; int ldc; int gelu_from;
    __device__ __forceinline__ void operator()(const f32x4 (&acc)[2][2][4][2], const Unit& u, int wr, int wc, int fr, int fq) const {
        const int row0 = u.pm * BM + wr * 64 + fr; const int col0 = u.pn * BM + wc * 32 + 8 * fq;
        const bool act = (u.pn * BM) >= gelu_from;
#pragma unroll
        for (int ai = 0; ai < 2; ++ai)
#pragma unroll
            for (int m = 0; m < 4; ++m) { bf16_t* rowp = O + (size_t)(row0 + ai * HALF + m * 16) * ldc + col0;
#pragma unroll
                for (int bj = 0; bj < 2; ++bj) { f32x4 v0 = acc[ai][bj][m][0], v1 = acc[ai][bj][m][1];
                    if (act) {
#pragma unroll
                        for (int j = 0; j < 4; ++j) { v0[j] = gelu_tanh(v0[j]); v1[j] = gelu_tanh(v1[j]); } }
                    u32x4 w; w.x = cvt_pk_bf16(v0[0], v0[1]); w.y = cvt_pk_bf16(v0[2], v0[3]); w.z = cvt_pk_bf16(v1[0], v1[1]); w.w = cvt_pk_bf16(v1[2], v1[3]);
                    *(u32x4*)(rowp + bj * HALF) = w; } }
    }
};
struct EpiH {
    static constexpr bool PERM = true, AFTER_DRAIN = false;
    bf16_t* O; bf16_t* OT; const float* X; float* rowss; int ldc; int mrows;
    __device__ __forceinline__ void operator()(const f32x4 (&acc)[2][2][4][2], const Unit& u, int wr, int wc, int fr, int fq) const {
        const int row0 = u.pm * BM + wr * 64 + fr; const int col0 = u.pn * BM + wc * 32 + 8 * fq;
#pragma unroll
        for (int ai = 0; ai < 2; ++ai)
#pragma unroll
            for (int m = 0; m < 4; ++m) { const int row = row0 + ai * HALF + m * 16; const size_t off = (size_t)row * ldc + col0; float ss = 0.f;
#pragma unroll
                for (int bj = 0; bj < 2; ++bj) {
                    const f32x4 x0 = *(const f32x4*)(X + off + bj * HALF), x1 = *(const f32x4*)(X + off + bj * HALF + 4);
                    const f32x4 v0 = acc[ai][bj][m][0] + x0, v1 = acc[ai][bj][m][1] + x1;
                    ss += (v0[0] * v0[0] + v0[1] * v0[1]) + (v0[2] * v0[2] + v0[3] * v0[3]) + (v1[0] * v1[0] + v1[1] * v1[1]) + (v1[2] * v1[2] + v1[3] * v1[3]);
                    u32x4 w; w.x = cvt_pk_bf16(v0[0], v0[1]); w.y = cvt_pk_bf16(v0[2], v0[3]); w.z = cvt_pk_bf16(v1[0], v1[1]); w.w = cvt_pk_bf16(v1[2], v1[3]);
                    *(u32x4*)(O + off + bj * HALF) = w;
                    *(u32x4*)(OT + ((size_t)((col0 + bj * HALF) >> 3) * mrows + row) * 8) = w; }
                ss += __shfl_xor(ss, 16); ss += __shfl_xor(ss, 32);
                if (fq == 0) atomicAdd(rowss + row, ss); }
    }
};
struct EpiQ {
    static constexpr bool PERM = true, AFTER_DRAIN = false;
    bf16_t* QH; const float* rowss; int ldc;
    __device__ __forceinline__ void operator()(const f32x4 (&acc)[2][2][4][2], const Unit& u, int wr, int wc, int fr, int fq) const {
        const int row0 = u.pm * BM + wr * 64 + fr, col0 = u.pn * BM + wc * 32 + 8 * fq;
#pragma unroll
        for (int ai = 0; ai < 2; ++ai)
#pragma unroll
            for (int m = 0; m < 4; ++m) { const int row = row0 + ai * HALF + m * 16; const float rs = __builtin_amdgcn_rsqf(rowss[row] * (1.0f / 2048.0f) + 1e-6f);
                const size_t off = (size_t)row * ldc + col0;
#pragma unroll
                for (int bj = 0; bj < 2; ++bj) { const f32x4 v0 = acc[ai][bj][m][0] * rs, v1 = acc[ai][bj][m][1] * rs;
                    u32x4 wh; wh.x = cvt_pk_bf16(v0[0], v0[1]); wh.y = cvt_pk_bf16(v0[2], v0[3]); wh.z = cvt_pk_bf16(v1[0], v1[1]); wh.w = cvt_pk_bf16(v1[2], v1[3]);
                    *(u32x4*)(QH + off + bj * HALF) = wh; } }
    }
};
template <class Epi, class Sched, bool ALIGN_EPI = false, bool SP2 = false>
__device__ __forceinline__ void gemm_phase(PG8_LAS unsigned char* lds, const Gemm g, const Sched& S, const Epi& E) {
    const int tid = threadIdx.x, wid = __builtin_amdgcn_readfirstlane(tid >> 6), lane = tid & 63, wr = wid >> 2, wc = wid & 3, fr = lane & 15, fq = lane >> 4;
    const int K = g.K, nt = K / BK;
    unsigned voffA[2], voffB[2];
#pragma unroll
    for (int i = 0; i < 2; ++i) { int R, C; stage_rc(tid * 16 + i * 8192, R, C); const int Rb = Epi::PERM ? ((R & ~31) + perm32(R & 31)) : R;
        voffA[i] = (unsigned)(R * K + C) * 2u; voffB[i] = (unsigned)(Rb * K + C) * 2u; }
    const size_t kstep = (size_t)(BK * 2);
    const size_t hstep = (size_t)HALF * K * 2;
    const size_t tstep = 2 * hstep;
    const unsigned ldsw = (unsigned)wid * 1024u;
    const int aoff = lds_byte(wr * 64 + fr, fq * 8), boff = lds_byte(wc * 32 + fr, fq * 8);
#define PG8_SA(b, h) (((b) * 2 + (h)) * HTB)
#define PG8_SB(b, h) ((4 + (b) * 2 + (h)) * HTB)
#define PG8_STAGE(bufoff, gbase, voff) do { _Pragma("unroll") for (int _i = 0; _i < 2; ++_i) \
        __builtin_amdgcn_global_load_lds((const unsigned*)((const char*)(gbase) + (voff)[_i]), (PG8_LAS unsigned*)(lds + (bufoff) + ldsw + _i * 8192), 16, 0, 0); } while (0)
#define PG8_LDA(dst, b, h) do { _Pragma("unroll") for (int m = 0; m < 4; ++m) _Pragma("unroll") for (int k = 0; k < 2; ++k) dst[m][k] = *(const PG8_LAS bf16x8*)(lds + PG8_SA(b, h) + aoff + m * 2048 + k * 1024); } while (0)
#define PG8_LDB(dst, b, h) do { _Pragma("unroll") for (int n = 0; n < 2; ++n) _Pragma("unroll") for (int k = 0; k < 2; ++k) dst[n][k] = *(const PG8_LAS bf16x8*)(lds + PG8_SB(b, h) + boff + n * 2048 + k * 1024); } while (0)
#define PG8_MMA(ai, bj, At, Bt) do { __builtin_amdgcn_s_setprio(1); _Pragma("unroll") for (int m = 0; m < 4; ++m) _Pragma("unroll") for (int n = 0; n < 2; ++n) _Pragma("unroll") for (int k = 0; k < 2; ++k) \
        acc[ai][bj][m][n] = __builtin_amdgcn_mfma_f32_16x16x32_bf16(Bt[n][k], At[m][k], acc[ai][bj][m][n], 0, 0, 0); __builtin_amdgcn_s_setprio(0); } while (0)
#define PG8_WAIT_V(n) asm volatile("s_waitcnt vmcnt(" #n ")" ::: "memory")
#define PG8_WAIT_L(n) asm volatile("s_waitcnt lgkmcnt(" #n ")" ::: "memory")
#define PG8_BAR __builtin_amdgcn_s_barrier()
#define PG8_SCHED __builtin_amdgcn_sched_barrier(0)
    Unit cur, nxt; int ui = 0;
    if (!S.next(0, cur)) return;
    f32x4 acc[2][2][4][2];
#pragma unroll
    for (int a = 0; a < 2; ++a)
#pragma unroll
        for (int b = 0; b < 2; ++b)
#pragma unroll
            for (int m = 0; m < 4; ++m)
#pragma unroll
                for (int n = 0; n < 2; ++n) acc[a][b][m][n] = (f32x4){0.f, 0.f, 0.f, 0.f};
    bf16x8 At[4][2], B0[2][2], B1[2][2];
    const char* cA = (const char*)g.A + (size_t)cur.pm * tstep; const char* cB = (const char*)g.Bt + (size_t)cur.pn * tstep;
    S.a_ready(cur);
    if constexpr (SP2) {
        PG8_STAGE(PG8_SB(0, 0), cB, voffB); PG8_STAGE(PG8_SB(0, 1), cB + hstep, voffB); PG8_STAGE(PG8_SA(0, 0), cA, voffA); PG8_STAGE(PG8_SA(0, 1), cA + hstep, voffA);
        if (wr == 1) PG8_BAR;
        PG8_WAIT_V(2); PG8_BAR;
        PG8_STAGE(PG8_SB(1, 0), cB + kstep, voffB); PG8_STAGE(PG8_SA(1, 0), cA + kstep, voffA); PG8_STAGE(PG8_SB(1, 1), cB + hstep + kstep, voffB);
        PG8_WAIT_V(6); PG8_BAR;
    } else {
        PG8_STAGE(PG8_SB(0, 0), cB, voffB); PG8_STAGE(PG8_SA(0, 0), cA, voffA); PG8_STAGE(PG8_SB(0, 1), cB + hstep, voffB); PG8_STAGE(PG8_SA(0, 1), cA + hstep, voffA);
        if (wr == 1) PG8_BAR;
        PG8_WAIT_V(4); PG8_BAR;
        PG8_STAGE(PG8_SB(1, 0), cB + kstep, voffB); PG8_STAGE(PG8_SA(1, 0), cA + kstep, voffA); PG8_STAGE(PG8_SB(1, 1), cB + hstep + kstep, voffB);
        PG8_WAIT_V(6); PG8_BAR;
    }
    for (;;) {
        const bool has_next = S.next(ui + 1, nxt);
        const char* nA = has_next ? (const char*)g.A + (size_t)nxt.pm * tstep : cA; const char* nB = has_next ? (const char*)g.Bt + (size_t)nxt.pn * tstep : cB;
        for (int t = 0; t < nt; t += 2) {
            const bool last = (t == nt - 2);
            const char* a1 = cA + (size_t)(t + 1) * kstep;
            const char* a2 = last ? nA : cA + (size_t)(t + 2) * kstep; const char* b2 = last ? nB : cB + (size_t)(t + 2) * kstep;
            const char* a3 = a2 + kstep; const char* b3 = b2 + kstep;
            if (last && has_next) S.a_ready(nxt);
            if constexpr (SP2) {
            PG8_LDB(B0, 0, 0); PG8_LDB(B1, 0, 1); PG8_SCHED; PG8_LDA(At, 0, 0); PG8_STAGE(PG8_SA(1, 1), a1 + hstep, voffA);
            PG8_WAIT_V(8); PG8_WAIT_L(0); PG8_BAR; PG8_MMA(0, 0, At, B0); PG8_MMA(0, 1, At, B1); PG8_BAR; PG8_SCHED;
            PG8_LDA(At, 0, 1); PG8_STAGE(PG8_SB(0, 0), b2, voffB); PG8_STAGE(PG8_SB(0, 1), b2 + hstep, voffB); PG8_STAGE(PG8_SA(0, 0), a2, voffA);
            PG8_WAIT_V(8); PG8_WAIT_L(0); PG8_BAR; PG8_MMA(1, 0, At, B0); PG8_MMA(1, 1, At, B1); PG8_BAR; PG8_SCHED;
            PG8_LDB(B0, 1, 0); PG8_LDB(B1, 1, 1); PG8_SCHED; PG8_LDA(At, 1, 0); PG8_STAGE(PG8_SA(0, 1), a2 + hstep, voffA);
            PG8_WAIT_V(8); PG8_WAIT_L(0); PG8_BAR; PG8_MMA(0, 0, At, B0); PG8_MMA(0, 1, At, B1); PG8_BAR; PG8_SCHED;
            PG8_LDA(At, 1, 1); PG8_STAGE(PG8_SB(1, 0), b3, voffB); PG8_STAGE(PG8_SB(1, 1), b3 + hstep, voffB); PG8_STAGE(PG8_SA(1, 0), a3, voffA);
            PG8_WAIT_V(8); PG8_WAIT_L(0); PG8_BAR; PG8_MMA(1, 0, At, B0); PG8_MMA(1, 1, At, B1); PG8_BAR; PG8_SCHED;
            } else {
            PG8_LDB(B0, 0, 0); PG8_SCHED; PG8_LDA(At, 0, 0); PG8_STAGE(PG8_SA(1, 1), a1 + hstep, voffA);
            PG8_WAIT_L(8); PG8_BAR; PG8_WAIT_L(0); PG8_MMA(0, 0, At, B0); PG8_BAR; PG8_SCHED;
            PG8_LDB(B1, 0, 1); PG8_STAGE(PG8_SB(0, 0), b2, voffB);
            PG8_BAR; PG8_WAIT_L(0); PG8_MMA(0, 1, At, B1); PG8_BAR;
            PG8_LDA(At, 0, 1); PG8_STAGE(PG8_SA(0, 0), a2, voffA);
            PG8_BAR; PG8_WAIT_L(0); PG8_MMA(1, 0, At, B0); PG8_BAR; PG8_SCHED;
            PG8_STAGE(PG8_SB(0, 1), b2 + hstep, voffB);
            PG8_WAIT_V(6); PG8_BAR; PG8_MMA(1, 1, At, B1); PG8_BAR;
            PG8_LDB(B0, 1, 0); PG8_SCHED; PG8_LDA(At, 1, 0); PG8_STAGE(PG8_SA(0, 1), a2 + hstep, voffA);
            PG8_WAIT_L(8); PG8_BAR; PG8_WAIT_L(0); PG8_MMA(0, 0, At, B0); PG8_BAR; PG8_SCHED;
            PG8_LDB(B1, 1, 1); PG8_STAGE(PG8_SB(1, 0), b3, voffB);
            PG8_BAR; PG8_WAIT_L(0); PG8_MMA(0, 1, At, B1); PG8_BAR;
            PG8_LDA(At, 1, 1); PG8_STAGE(PG8_SA(1, 0), a3, voffA);
            PG8_BAR; PG8_WAIT_L(0); PG8_MMA(1, 0, At, B0); PG8_BAR; PG8_SCHED;
            PG8_STAGE(PG8_SB(1, 1), b3 + hstep, voffB);
            PG8_WAIT_V(6); PG8_BAR; PG8_MMA(1, 1, At, B1); PG8_BAR;
            }
        }
        if constexpr (ALIGN_EPI) { if (wr == 0) PG8_BAR; }
        if constexpr (!Epi::AFTER_DRAIN) { E(acc, cur, wr, wc, fr, fq); S.done(cur); }
        if (!has_next) break;
#pragma unroll
        for (int a = 0; a < 2; ++a)
#pragma unroll
            for (int b = 0; b < 2; ++b)
#pragma unroll
                for (int m = 0; m < 4; ++m)
#pragma unroll
                    for (int n = 0; n < 2; ++n) acc[a][b][m][n] = (f32x4){0.f, 0.f, 0.f, 0.f};
        cur = nxt; cA = nA; cB = nB; ++ui;
        if constexpr (ALIGN_EPI) { if (wr == 1) PG8_BAR; }
    }
    PG8_WAIT_V(0);
    if constexpr (!ALIGN_EPI) { if (wr == 0) PG8_BAR; }
    PG8_BAR;
    if constexpr (Epi::AFTER_DRAIN) { E.fused(acc, cur, wr, wc, fr, fq, lds, wid, lane); S.done(cur); }
#undef PG8_SA
#undef PG8_SB
#undef PG8_STAGE
#undef PG8_LDA
#undef PG8_LDB
#undef PG8_MMA
#undef PG8_WAIT_V
#undef PG8_WAIT_L
#undef PG8_BAR
#undef PG8_SCHED
}
}
constexpr int NWAVES = 8;
constexpr int BATCH = 4, SEQ = 8192, D = 2048, M = BATCH * SEQ, NIN = 4096, LW = 1024, CHUNK = 128, NCHUNK = SEQ / CHUNK;
constexpr int NEXP = 16384;
#ifndef MK_N_LAUNCHES
#define MK_N_LAUNCHES 1
#endif
constexpr int N_LAUNCHES = MK_N_LAUNCHES;
constexpr int PER_PHASE = 11;
constexpr size_t MiB = 1u << 20;
constexpr size_t WS_CTL = 0, CTL_ZERO_BYTES = 1 * MiB;
constexpr size_t WS_ROWSS = 512 * 1024;
constexpr size_t WS_WIN = 2 * MiB, WS_WOUT = 18 * MiB, WS_WQ = 26 * MiB, WS_LRUW = 34 * MiB, WS_WSB = 35 * MiB, WS_AGG = 36 * MiB;
constexpr size_t WS_U = 64 * MiB, WS_V = 128 * MiB, WS_XN = 192 * MiB  , WS_Z = 320 * MiB  ;
constexpr size_t WS_HB = 576 * MiB, WS_IDS = 704 * MiB, WS_GATES = 720 * MiB, WS_PAIRS = 736 * MiB, WS_HBT = 752 * MiB, WS_END = 884 * MiB;
constexpr size_t WS_USCALE = 40 * MiB, WS_VSCALE = 41 * MiB;
constexpr size_t WS_HSCALE = 44 * MiB, WS_CARRY = 45 * MiB;
constexpr size_t WS_H8 = WS_XN, WS_PART = WS_XN + 64 * MiB;
constexpr size_t WS_ASCALE = 42 * MiB, WS_KH = 43 * MiB;
constexpr size_t WS_IDW = WS_PAIRS, WS_AW = 880 * MiB;
constexpr size_t WS_ROWSS2 = 640 * 1024;
constexpr size_t WS_Y = WS_Z;
constexpr int CW_BAR = 4096;
constexpr int RING_BYTES = 131072;
constexpr int LDSCTL_OFF = 143360, MISC_OFF = LDSCTL_OFF + 320;
constexpr int LDS_BYTES = 147456;
#define GAS __attribute__((address_space(1)))
#define LAS __attribute__((address_space(3)))
typedef unsigned short bf16;
typedef unsigned v4u __attribute__((ext_vector_type(4)));
typedef float f32x4 __attribute__((ext_vector_type(4)));
typedef short bf16x8 __attribute__((ext_vector_type(8)));
typedef GAS unsigned gu32;
typedef GAS unsigned long long gu64;
#define RLX_AGENT __ATOMIC_RELAXED, __HIP_MEMORY_SCOPE_AGENT
#define LDS_WAIT() asm volatile("s_waitcnt lgkmcnt(0)" ::: "memory")
#define VM_WAIT() asm volatile("s_waitcnt vmcnt(0)" ::: "memory")
__device__ __forceinline__ unsigned long long rt() { return __builtin_amdgcn_s_memrealtime(); }
__device__ __forceinline__ unsigned f2bf(float f) { unsigned u = __builtin_bit_cast(unsigned, f); return (u + 0x7fffu + ((u >> 16) & 1u)) >> 16; }
__device__ __forceinline__ unsigned pk2(float lo, float hi) { return f2bf(lo) | (f2bf(hi) << 16); }

#define XB_TMO      128
#define XB_XCNT(j)  (256  + 64 * (j))
#define XB_XSUB(j)  (1280 + 64 * (j))
#define XB_XGEN(j)  (2304 + 64 * (j))
#define XB_TOP      3328
#define XB_TOPGEN   3392
#define XCD_BAR_WORDS 3456
#define XB_SPIN_CAP (1u << 18)

__device__ __forceinline__ unsigned xb_ld(unsigned* p)              { return __hip_atomic_load(p, __ATOMIC_RELAXED, __HIP_MEMORY_SCOPE_AGENT); }
__device__ __forceinline__ unsigned xb_add(unsigned* p, unsigned v) { return __hip_atomic_fetch_add(p, v, __ATOMIC_RELAXED, __HIP_MEMORY_SCOPE_AGENT); }
__device__ __forceinline__ unsigned xb_xcc_id() { return (unsigned)__builtin_amdgcn_s_getreg((3 << 11) | 20) & 0xFu; }
#define XB_SPIN(cond, bar) do { unsigned _sp = 0; while (cond) { __builtin_amdgcn_s_sleep(1); \
    if ((++_sp & 255u) == 0u) { if (xb_ld(&(bar)[XB_TMO])) break; if (_sp > XB_SPIN_CAP) { atomicAdd(&(bar)[XB_TMO], 1u); break; } } } } while (0)

struct XcdBarrier {
    unsigned* bar; unsigned x;
    volatile LAS unsigned* st;
};

__device__ __forceinline__ XcdBarrier xcd_barrier_post(unsigned* bar, volatile LAS unsigned* st) {
    XcdBarrier b; b.bar = bar; b.x = xb_xcc_id(); b.st = st;
    if (threadIdx.x == 0) (void)xb_add(&bar[XB_XCNT(b.x)], 1u);
    return b;
}
__device__ __forceinline__ void xcd_barrier_complete(unsigned* bar, unsigned x, unsigned& nloc, unsigned& nx) {
    const unsigned G = gridDim.x * gridDim.y * gridDim.z;
    unsigned sum, cnt, mine, sp = 0u;
    for (;;) {
        sum = 0u; cnt = 0u; mine = 0u;
#pragma unroll
        for (unsigned j = 0; j < 16; ++j) { const unsigned c = xb_ld(&bar[XB_XCNT(j)]); sum += c; cnt += (c > 0u) ? 1u : 0u; mine = (j == x) ? c : mine; }
        if (sum == G) break;
        __builtin_amdgcn_s_sleep(1);
        if ((++sp & 255u) == 0u) { if (xb_ld(&bar[XB_TMO])) break; if (sp > XB_SPIN_CAP) { atomicAdd(&bar[XB_TMO], 1u); break; } }
    }
    nloc = mine > 0u ? mine : 1u; nx = cnt > 0u ? cnt : 1u;
}

__device__ __forceinline__ void xcd_barrier(const XcdBarrier& b) {
    asm volatile("s_waitcnt vmcnt(0)" ::: "memory");
    __syncthreads();
    if (threadIdx.x == 0) {
        unsigned* bar = b.bar;
        __builtin_amdgcn_s_waitcnt(0);
        unsigned nloc = b.st[0], nx = b.st[1];
        if (nloc == 0u) { xcd_barrier_complete(bar, b.x, nloc, nx); b.st[0] = nloc; b.st[1] = nx; }
        const unsigned old = xb_add(&bar[XB_XSUB(b.x)], 1u);
        const unsigned gen = old / nloc;
        if (old + 1u == (gen + 1u) * nloc) {
            __builtin_amdgcn_fence(__ATOMIC_RELEASE, "agent");
            asm volatile("s_waitcnt vmcnt(0)" ::: "memory");
            const unsigned og = xb_add(&bar[XB_TOP], 1u);
            const unsigned tg = og / nx;
            if (og + 1u == (tg + 1u) * nx) xb_add(&bar[XB_TOPGEN], 1u);
            else XB_SPIN(xb_ld(&bar[XB_TOPGEN]) == tg, bar);
            __builtin_amdgcn_fence(__ATOMIC_ACQUIRE, "agent");
            xb_add(&bar[XB_XGEN(b.x)], 1u);
            asm volatile("s_waitcnt vmcnt(0)" ::: "memory");
        } else {
            XB_SPIN(xb_ld(&bar[XB_XGEN(b.x)]) == gen, bar);
            __builtin_amdgcn_fence(__ATOMIC_ACQUIRE, "agent");
            asm volatile("s_waitcnt vmcnt(0)" ::: "memory");
        }
    }
    __syncthreads();
}
typedef unsigned v2u __attribute__((ext_vector_type(2)));
typedef float f32x2 __attribute__((ext_vector_type(2)));
struct Args { const float* in[21]; float* out; unsigned char* ws; int ph_lo, ph_hi; };
struct Frame {
    const Args& A;
    LAS unsigned char* lds;
    volatile LAS unsigned* MISC;
    gu32* ctl;
    unsigned char* ws;
    int tid, lane, wave, vcu, G;
    __device__ __forceinline__ Frame(const Args& a) : A(a) {}
#define WSP(name, type, off) __device__ __forceinline__ type* name() const { return (type*)(ws + (off)); }
    WSP(WIN, bf16, WS_WIN) WSP(WOUT, bf16, WS_WOUT) WSP(WQ, bf16, WS_WQ) WSP(LRUW, bf16, WS_LRUW) WSP(WSB, bf16, WS_WSB)
    WSP(XN, bf16, WS_XN) WSP(MIX, bf16, WS_XN) WSP(Z, bf16, WS_Z) WSP(HB, bf16, WS_HB) WSP(HBT, bf16, WS_HBT)
    WSP(U8, unsigned char, WS_U) WSP(V8T, unsigned char, WS_V)
    WSP(ROWSS, float, WS_ROWSS) WSP(ROWSS2, float, WS_ROWSS2) WSP(QH, bf16, WS_Z) WSP(QL, bf16, WS_Z + 128 * MiB) WSP(KH, bf16, WS_KH) WSP(KL, bf16, WS_KH + 512 * 1024) WSP(AGG, float, WS_AGG) WSP(CARRY, float, WS_CARRY) WSP(GATES, float, WS_GATES)
    WSP(USCALE, float, WS_USCALE) WSP(VSCALE, float, WS_VSCALE) WSP(Y, bf16, WS_Y) WSP(IDS, int, WS_IDS) WSP(ASCALE, float, WS_ASCALE) WSP(IDW, v4u, WS_IDW) WSP(AW, unsigned, WS_AW) WSP(H8, unsigned char, WS_H8) WSP(HSCALE, float, WS_HSCALE) WSP(PART, int, WS_PART)
#undef WSP
};
__device__ __forceinline__ float wave_sum(float v) {
#pragma unroll
    for (int o = 1; o < 64; o <<= 1) v += __shfl_xor(v, o);
    return v;
}
__device__ __forceinline__ float bf_lo(unsigned w) { return __builtin_bit_cast(float, w << 16); }
__device__ __forceinline__ float bf_hi(unsigned w) { return __builtin_bit_cast(float, w & 0xffff0000u); }
__device__ __forceinline__ float bf1(unsigned short h) { return __builtin_bit_cast(float, (unsigned)h << 16); }
__device__ __forceinline__ float sigmoidf_(float x) { return __builtin_amdgcn_rcpf(1.0f + __builtin_amdgcn_exp2f(-1.4426950409f * x)); }
using pg8::gelu_tanh;
__device__ __forceinline__ unsigned pack_i8x4(float a, float b, float c, float d) {
    const int ia = (int)__builtin_rintf(a), ib = (int)__builtin_rintf(b), ic = (int)__builtin_rintf(c), id = (int)__builtin_rintf(d);
    return (unsigned)(ia & 0xff) | ((unsigned)(ib & 0xff) << 8) | ((unsigned)(ic & 0xff) << 16) | ((unsigned)id << 24);
}

__device__ __forceinline__ void p0_transpose_item(const float* W, int K, int N, bf16* WT, const float* kscale, LAS float* scr, int item, int lane) {
    const int nblk = N / 32, kb = item / nblk, nb = item % nblk, k0 = 64 * kb, n0 = 32 * nb;
#pragma unroll 8
    for (int i = 0; i < 32; ++i) { const int kk = 2 * i + (lane >> 5); const float sc = kscale ? kscale[k0 + kk] : 1.0f; scr[kk * 33 + (lane & 31)] = W[(size_t)(k0 + kk) * N + n0 + (lane & 31)] * sc; }
    LDS_WAIT(); asm volatile("" ::: "memory");
    const int c = lane & 7;
#pragma unroll
    for (int j = 0; j < 4; ++j) { const int n = (lane >> 3) + 8 * j; const LAS float* s = scr + (8 * c) * 33 + n;
        v4u o; o.x = pk2(s[0 * 33], s[1 * 33]); o.y = pk2(s[2 * 33], s[3 * 33]); o.z = pk2(s[4 * 33], s[5 * 33]); o.w = pk2(s[6 * 33], s[7 * 33]);
        *(GAS v4u*)(WT + (size_t)(n0 + n) * K + k0 + 8 * c) = o; }
    LDS_WAIT(); asm volatile("" ::: "memory");
}
__device__ __forceinline__ void p0_prologue(Frame& F) {
    LAS float* scr = (LAS float*)(F.lds + F.wave * 16384);
    const int gw = F.vcu * NWAVES + F.wave, NGW = F.G * NWAVES, lane = F.lane;
    constexpr int I_IN = (D / 64) * (NIN / 32), I_OUT = (D / 64) * (D / 32), I_Q = I_OUT, I_LRU = 32 * 8;
    constexpr int NITEMS = I_IN + I_OUT + I_Q + I_LRU;
    for (int it = gw; it < NITEMS; it += NGW) {
        int r = it;
        if (r < I_IN) { p0_transpose_item(F.A.in[2], D, NIN, F.WIN(), F.A.in[1], scr, r, lane); continue; } r -= I_IN;
        if (r < I_OUT) { p0_transpose_item(F.A.in[14], D, D, F.WOUT(), nullptr, scr, r, lane); continue; } r -= I_OUT;
        if (r < I_Q) { p0_transpose_item(F.A.in[16], D, D, F.WQ(), F.A.in[15], scr, r, lane); continue; } r -= I_Q;
        { const int mi = r >> 3, sub = r & 7, gate = mi >> 4, rest = mi & 15;
          const float* src = (gate ? F.A.in[7] : F.A.in[5]) + (size_t)rest * 16384;
          p0_transpose_item(src, 128, 128, F.LRUW() + (size_t)mi * 16384, nullptr, scr, sub, lane); }
    }
    const size_t gt = (size_t)gw * 64 + lane, NGT = (size_t)NGW * 64;
    {
        const float* g2 = F.A.in[15];
        f32x4 gg[8];
#pragma unroll
        for (int j = 0; j < 8; ++j) gg[j] = *(const GAS f32x4*)(g2 + j * 256 + lane * 4);
        for (int e = gw; e < NEXP; e += NGW) {
            const GAS f32x4* ur = (const GAS f32x4*)(F.A.in[18] + (size_t)e * D) + lane;
            f32x4 v[8]; float mx = 0.f;
#pragma unroll
            for (int j = 0; j < 8; ++j) { v[j] = ur[64 * j] * gg[j]; mx = fmaxf(mx, fmaxf(fmaxf(fabsf(v[j].x), fabsf(v[j].y)), fmaxf(fabsf(v[j].z), fabsf(v[j].w)))); }
#pragma unroll
            for (int o = 1; o < 64; o <<= 1) mx = fmaxf(mx, __shfl_xor(mx, o));
            const float sc = mx > 0.f ? 127.0f / mx : 1.0f;
            GAS unsigned* o4 = (GAS unsigned*)(F.U8() + (size_t)e * D) + lane;
#pragma unroll
            for (int j = 0; j < 8; ++j) o4[64 * j] = pack_i8x4(v[j].x * sc, v[j].y * sc, v[j].z * sc, v[j].w * sc);
            if (lane == 0) F.USCALE()[e] = mx > 0.f ? mx * (1.0f / 127.0f) : 1.0f;
        }
    }
    __syncthreads();
    for (int un = blockIdx.x; un < NEXP / 64; un += F.G) {
        const int e0 = un * 64;
        for (int rr = 0; rr < 8; ++rr) {
            const int el = F.wave * 8 + rr, e = e0 + el;
            const GAS f32x4* vr = (const GAS f32x4*)(F.A.in[19] + (size_t)e * D) + lane;
            f32x4 v[8]; float mx = 0.f;
#pragma unroll
            for (int j = 0; j < 8; ++j) { v[j] = vr[64 * j]; mx = fmaxf(mx, fmaxf(fmaxf(fabsf(v[j].x), fabsf(v[j].y)), fmaxf(fabsf(v[j].z), fabsf(v[j].w)))); }
#pragma unroll
            for (int o = 1; o < 64; o <<= 1) mx = fmaxf(mx, __shfl_xor(mx, o));
            const float sc = mx > 0.f ? 127.0f / mx : 1.0f;
#pragma unroll
            for (int j = 0; j < 8; ++j) *(LAS unsigned*)(F.lds + el * 2056 + j * 256 + lane * 4) = pack_i8x4(v[j].x * sc, v[j].y * sc, v[j].z * sc, v[j].w * sc);
            if (lane == 0) F.VSCALE()[e] = mx > 0.f ? mx * (1.0f / 127.0f) : 1.0f;
        }
        __syncthreads();
        for (int cc = 0; cc < 32; ++cc) { const int c = F.wave * 32 + cc;
            const v2u w = *(const LAS v2u*)(F.lds + lane * 2056 + c * 8);
            *(GAS v2u*)(F.V8T() + ((size_t)c * NEXP + e0 + lane) * 8) = w; }
        __syncthreads();
    }
    for (size_t ch = gt; ch < (size_t)8 * 128 * 128 / 8; ch += NGT) {
        const size_t e0 = ch * 8;
        const f32x4 a = *(const GAS f32x4*)(F.A.in[12] + e0), b = *(const GAS f32x4*)(F.A.in[12] + e0 + 4);
        v4u o; o.x = pk2(a.x, a.y); o.y = pk2(a.z, a.w); o.z = pk2(b.x, b.y); o.w = pk2(b.z, b.w);
        *(GAS v4u*)(F.WSB() + e0) = o;
    }
    for (size_t ch = gt; ch < (size_t)16 * 128 * 128 / 8; ch += NGT) {
        const size_t e0 = ch * 8;
        const f32x4 a = *(const GAS f32x4*)(F.A.in[17] + e0), b = *(const GAS f32x4*)(F.A.in[17] + e0 + 4);
        v4u hi; hi.x = pk2(a.x, a.y); hi.y = pk2(a.z, a.w); hi.z = pk2(b.x, b.y); hi.w = pk2(b.z, b.w);
        *(GAS v4u*)(F.KH() + e0) = hi;
    }
    for (int m = gw; m < M; m += NGW) {
        const GAS f32x4* xr = (const GAS f32x4*)(F.A.in[0] + (size_t)m * D) + lane;
        f32x4 v[8]; float s = 0.f;
#pragma unroll
        for (int j = 0; j < 8; ++j) { v[j] = xr[64 * j]; s += (v[j].x * v[j].x + v[j].y * v[j].y) + (v[j].z * v[j].z + v[j].w * v[j].w); }
        const float rstd = __builtin_amdgcn_rsqf(wave_sum(s) * (1.f / D) + 1e-6f);
        GAS unsigned long long* o8 = (GAS unsigned long long*)(F.XN() + (size_t)m * D) + lane;
#pragma unroll
        for (int j = 0; j < 8; ++j) o8[64 * j] = (unsigned long long)pk2(v[j].x * rstd, v[j].y * rstd) | ((unsigned long long)pk2(v[j].z * rstd, v[j].w * rstd) << 32);
    }
}
constexpr int LRU_XR = 0, LRU_XC = 33792, LRU_GR = 33792 + 40960;
constexpr float LOG2E = 1.4426950408889634f;
__device__ __forceinline__ int xc_off(int tok, int ch) { return tok * 320 + (tok >> 5) * 16 + ch * 2; }
template <bool APPLY, int DIR>
__device__ __forceinline__ void lru_dir(Frame& F, int b, int c, int h, const bf16x8 (&Ba)[4], const bf16x8 (&Bx)[4], float (&hsum)[8][4]) {
    const int lane = F.lane, w = F.wave, fr = lane & 15, fq = lane >> 4;
    LAS unsigned char* XC = F.lds + LRU_XC;
    const int chl = 16 * w + fr, chg = h * 128 + chl;
    const float ba = F.A.in[6][DIR * LW + chg], bx = F.A.in[8][DIR * LW + chg], lam = F.A.in[9][DIR * LW + chg];
    const float cl = -8.0f * log1pf(__expf(-lam)) * LOG2E;
    float carry = 0.f;
    if (APPLY) carry = F.CARRY()[(size_t)((b * 2 + DIR) * NCHUNK + c) * LW + chg];
    f32x4 R[8], I[8];
    const int arow = (fr >> 2) * 32 + (fr & 3);
#pragma unroll
    for (int m = 0; m < 8; ++m) {
        R[m] = (f32x4){0.f, 0.f, 0.f, 0.f}; I[m] = (f32x4){0.f, 0.f, 0.f, 0.f};
#pragma unroll
        for (int ks = 0; ks < 4; ++ks) {
            const bf16x8 a = *(const LAS bf16x8*)(XC + xc_off(arow + 4 * m, 32 * ks + 8 * fq));
            R[m] = __builtin_amdgcn_mfma_f32_16x16x32_bf16(a, Ba[ks], R[m], 0, 0, 0);
            I[m] = __builtin_amdgcn_mfma_f32_16x16x32_bf16(a, Bx[ks], I[m], 0, 0, 0);
        }
    }
    float P = 1.f, L = 0.f;
#pragma unroll
    for (int mm = 0; mm < 8; ++mm) {
        const int m = DIR == 0 ? mm : 7 - mm;
#pragma unroll
        for (int jj = 0; jj < 4; ++jj) {
            const int j = DIR == 0 ? jj : 3 - jj;
            const float r = sigmoidf_(R[m][j] + ba), ig = sigmoidf_(I[m][j] + bx);
            const float a = __builtin_amdgcn_exp2f(cl * r);
            const float xc = bf1(*(const LAS unsigned short*)(XC + xc_off(32 * fq + 4 * m + j, chl)));
            const float u = __builtin_amdgcn_sqrtf(fmaxf(1.0f - a * a, 0.0f)) * (ig * xc);
            L = a * L + u; P = a * P;
            R[m][j] = P; I[m][j] = L;
        }
    }
    const int src1 = DIR == 0 ? lane - 16 : lane + 16, src2 = DIR == 0 ? lane - 32 : lane + 32;
    const bool v1 = DIR == 0 ? (fq >= 1) : (fq <= 2), v2 = DIR == 0 ? (fq >= 2) : (fq <= 1);
    float A = P, B = L;
    { const float pa = __shfl(A, src1), pb = __shfl(B, src1); if (v1) { B = A * pb + B; A = A * pa; } }
    { const float pa = __shfl(A, src2), pb = __shfl(B, src2); if (v2) { B = A * pb + B; A = A * pa; } }
    if (APPLY) {
        float EA = __shfl(A, src1), EB = __shfl(B, src1); if (!v1) { EA = 1.f; EB = 0.f; }
        const float hin = EA * carry + EB;
#pragma unroll
        for (int m = 0; m < 8; ++m)
#pragma unroll
            for (int j = 0; j < 4; ++j) { const float hh = R[m][j] * hin + I[m][j]; if (DIR == 0) hsum[m][j] = hh; else hsum[m][j] += hh; }
    } else {
        const bool lastlane = DIR == 0 ? (fq == 3) : (fq == 0);
        if (lastlane) { f32x2* agg = (f32x2*)F.AGG() + (size_t)((b * 2 + DIR) * NCHUNK + c) * LW + chg; *agg = (f32x2){A, B}; }
    }
}

template <bool APPLY>
__device__ __forceinline__ void lru_unit(Frame& F, int unit) {
    const int h = unit & 7, c = (unit >> 3) & 63, b = unit >> 9;
    const int tid = F.tid, lane = F.lane, w = F.wave, fr = lane & 15, fq = lane >> 4;
    const size_t t0 = (size_t)b * SEQ + (size_t)c * CHUNK;
    LAS unsigned char* XR = F.lds + LRU_XR; LAS unsigned char* XC = F.lds + LRU_XC; LAS unsigned char* GR = F.lds + LRU_GR;
    bf16x8 Ba0[4], Bx0[4], Ba1[4], Bx1[4];
    {
        const bf16* wb = F.LRUW() + (size_t)h * 16384 + (size_t)(16 * w + fr) * 128 + 8 * fq;
#pragma unroll
        for (int ks = 0; ks < 4; ++ks) { Ba0[ks] = *(const GAS bf16x8*)(wb + 32 * ks); Ba1[ks] = *(const GAS bf16x8*)(wb + (size_t)8 * 16384 + 32 * ks);
            Bx0[ks] = *(const GAS bf16x8*)(wb + (size_t)16 * 16384 + 32 * ks); Bx1[ks] = *(const GAS bf16x8*)(wb + (size_t)24 * 16384 + 32 * ks); }
    }
    for (int p = tid; p < 131 * 16; p += 512) { const int r = p >> 4, cg = p & 15; const int s = c * CHUNK - 2 + r; v4u v = (v4u){0u, 0u, 0u, 0u};
        if (s >= 0 && s < SEQ) v = *(const GAS v4u*)(F.Z() + ((size_t)b * SEQ + s) * NIN + h * 128 + cg * 8);
        *(LAS v4u*)(XR + r * 256 + cg * 16) = v; }
    if (APPLY) { for (int p = tid; p < 128 * 32; p += 512) { const int r = p >> 5, cg = p & 31;
        *(LAS v2u*)(GR + r * 264 + cg * 8) = *(const GAS v2u*)(F.Z() + (t0 + r) * NIN + LW + h * 128 + cg * 4); } }
    __syncthreads();
    {
        const int ch2 = tid & 63, tg = tid >> 6, chg = h * 128 + 2 * ch2;
        float w0[4], w1[4];
#pragma unroll
        for (int k = 0; k < 4; ++k) { w0[k] = F.A.in[3][k * LW + chg]; w1[k] = F.A.in[3][k * LW + chg + 1]; }
        const float b0 = F.A.in[4][chg], b1 = F.A.in[4][chg + 1];
        float x0[4], x1[4];
#pragma unroll
        for (int k = 0; k < 3; ++k) { const unsigned u = *(const LAS unsigned*)(XR + (16 * tg + k) * 256 + ch2 * 4); x0[k] = bf_lo(u); x1[k] = bf_hi(u); }
#pragma unroll
        for (int j = 0; j < 16; ++j) {
            const unsigned u = *(const LAS unsigned*)(XR + (16 * tg + j + 3) * 256 + ch2 * 4); x0[3] = bf_lo(u); x1[3] = bf_hi(u);
            const float y0 = b0 + ((w0[0] * x0[0] + w0[1] * x0[1]) + (w0[2] * x0[2] + w0[3] * x0[3]));
            const float y1 = b1 + ((w1[0] * x1[0] + w1[1] * x1[1]) + (w1[2] * x1[2] + w1[3] * x1[3]));
            *(LAS unsigned*)(XC + xc_off(16 * tg + j, 2 * ch2)) = pk2(y0, y1);
            x0[0] = x0[1]; x0[1] = x0[2]; x0[2] = x0[3]; x1[0] = x1[1]; x1[1] = x1[2]; x1[2] = x1[3];
        }
    }
    __syncthreads();
    float hsum[8][4];
    lru_dir<APPLY, 0>(F, b, c, h, Ba0, Bx0, hsum);
    asm volatile("" ::: "memory"); __builtin_amdgcn_sched_barrier(0);
    lru_dir<APPLY, 1>(F, b, c, h, Ba1, Bx1, hsum);
    if (APPLY) {
        const int chl = 16 * w + fr;
#pragma unroll
        for (int m = 0; m < 8; ++m)
#pragma unroll
            for (int j = 0; j < 4; ++j) { LAS unsigned short* p = (LAS unsigned short*)(GR + (32 * fq + 4 * m + j) * 264 + chl * 2); *p = (unsigned short)f2bf(bf1(*p) * hsum[m][j]); }
        __syncthreads();
        for (int p = tid; p < 128 * 32; p += 512) { const int r = p >> 5, cg = p & 31;
            *(GAS v2u*)(F.MIX() + (t0 + r) * D + h * 128 + cg * 4) = *(const LAS v2u*)(GR + r * 264 + cg * 8); }
    }
    __syncthreads();
}
__device__ __forceinline__ void lru_carry(Frame& F) {
    const int idx = (F.vcu * NWAVES + F.wave) * 64 + F.lane;
    if (idx >= BATCH * 2 * LW) return;
    const int ch = idx & (LW - 1), bd = idx >> 10, dir = bd & 1;
    const f32x2* agg = (const f32x2*)F.AGG() + (size_t)bd * NCHUNK * LW + ch; float* cr = F.CARRY() + (size_t)bd * NCHUNK * LW + ch;
    float st = 0.f;
#pragma unroll 8
    for (int i = 0; i < NCHUNK; ++i) { const int cc = dir == 0 ? i : NCHUNK - 1 - i; const f32x2 pe = agg[(size_t)cc * LW]; cr[(size_t)cc * LW] = st; st = pe.x * st + pe.y; }
}
constexpr int GM_ST = 0, GM_BS = 1024, GM_VN = 2048, GM_GU = 2048 + 32768;
typedef short s16x4 __attribute__((ext_vector_type(4)));
__device__ __forceinline__ unsigned vn_off(unsigned row, unsigned ch) { return 256u * row + 16u * (ch ^ (((row & 3u) << 2) | ((row >> 2) & 3u))); }
__device__ __forceinline__ void gmlp_unit(Frame& F, int unit) {
    const int tid = F.tid, lane = F.lane, w = F.wave, fr = lane & 15, fq = lane >> 4;
    const size_t t0 = (size_t)unit * CHUNK;
    LAS float* ST = (LAS float*)(F.lds + GM_ST); LAS float* BS = (LAS float*)(F.lds + GM_BS);
    LAS unsigned char* VN = F.lds + GM_VN; LAS unsigned char* GU = F.lds + GM_GU;
    for (int rr = 0; rr < 16; ++rr) {
        const int row = 16 * w + rr;
        const bf16* p = F.Z() + (t0 + row) * NIN + 3 * LW + lane * 8;
        const v4u a = *(const GAS v4u*)p, b = *(const GAS v4u*)(p + 512);
        float x[16] = {bf_lo(a.x), bf_hi(a.x), bf_lo(a.y), bf_hi(a.y), bf_lo(a.z), bf_hi(a.z), bf_lo(a.w), bf_hi(a.w),
                       bf_lo(b.x), bf_hi(b.x), bf_lo(b.y), bf_hi(b.y), bf_lo(b.z), bf_hi(b.z), bf_lo(b.w), bf_hi(b.w)};
        float s = 0.f;
#pragma unroll
        for (int i = 0; i < 16; ++i) s += x[i];
        const float mean = wave_sum(s) * (1.0f / LW);
        float q = 0.f;
#pragma unroll
        for (int i = 0; i < 16; ++i) { const float d = x[i] - mean; q += d * d; }
        const float rstd = __builtin_amdgcn_rsqf(wave_sum(q) * (1.0f / LW) + 1e-6f);
        if (lane == 0) { ST[2 * row] = mean; ST[2 * row + 1] = rstd; }
    }
    __syncthreads();
    const unsigned trq = (unsigned)(lane & 15) >> 2, trp = (unsigned)lane & 3u;
    for (int h = 0; h < 8; ++h) {
#pragma unroll
        for (int i = 0; i < 4; ++i) { const int pid = tid + 512 * i, q = pid >> 4, cg = pid & 15;
            const v4u a = *(const GAS v4u*)(F.Z() + (t0 + q) * NIN + 3 * LW + h * 128 + cg * 8);
            const float mean = ST[2 * q], rstd = ST[2 * q + 1];
            const f32x4 g0 = *(const GAS f32x4*)(F.A.in[10] + h * 128 + cg * 8), g1 = *(const GAS f32x4*)(F.A.in[10] + h * 128 + cg * 8 + 4);
            const f32x4 b0 = *(const GAS f32x4*)(F.A.in[11] + h * 128 + cg * 8), b1 = *(const GAS f32x4*)(F.A.in[11] + h * 128 + cg * 8 + 4);
            v4u o;
            o.x = pk2((bf_lo(a.x) - mean) * rstd * g0.x + b0.x, (bf_hi(a.x) - mean) * rstd * g0.y + b0.y);
            o.y = pk2((bf_lo(a.y) - mean) * rstd * g0.z + b0.z, (bf_hi(a.y) - mean) * rstd * g0.w + b0.w);
            o.z = pk2((bf_lo(a.z) - mean) * rstd * g1.x + b1.x, (bf_hi(a.z) - mean) * rstd * g1.y + b1.y);
            o.w = pk2((bf_lo(a.w) - mean) * rstd * g1.z + b1.z, (bf_hi(a.w) - mean) * rstd * g1.w + b1.w);
            *(LAS v4u*)(VN + vn_off((unsigned)q, (unsigned)cg)) = o;
        }
#pragma unroll
        for (int i = 0; i < 8; ++i) { const int pid = tid + 512 * i, r = pid >> 5, cg = pid & 31;
            *(LAS v2u*)(GU + r * 264 + cg * 8) = *(const GAS v2u*)(F.Z() + (t0 + r) * NIN + 2 * LW + h * 128 + cg * 4); }
        if (tid < 128) BS[tid] = F.A.in[13][h * 128 + tid];
        bf16x8 Af[4];
        { const bf16* wsb = F.WSB() + (size_t)h * 16384 + (size_t)(16 * w + fr) * 128 + 8 * fq;
#pragma unroll
          for (int ks = 0; ks < 4; ++ks) Af[ks] = *(const GAS bf16x8*)(wsb + 32 * ks); }
        __syncthreads();
        f32x4 acc[8];
#pragma unroll
        for (int n = 0; n < 8; ++n) {
            acc[n] = (f32x4){0.f, 0.f, 0.f, 0.f};
#pragma unroll
            for (int ks = 0; ks < 4; ++ks) {
                const s16x4 b0 = __builtin_amdgcn_ds_read_tr16_b64_v4i16((LAS s16x4*)(VN + vn_off(32u * ks + 8u * fq + trq, 2u * n + (trp >> 1)) + 8u * (trp & 1u)));
                const s16x4 b1 = __builtin_amdgcn_ds_read_tr16_b64_v4i16((LAS s16x4*)(VN + vn_off(32u * ks + 8u * fq + 4u + trq, 2u * n + (trp >> 1)) + 8u * (trp & 1u)));
                const bf16x8 bb = (bf16x8){b0[0], b0[1], b0[2], b0[3], b1[0], b1[1], b1[2], b1[3]};
                acc[n] = __builtin_amdgcn_mfma_f32_16x16x32_bf16(Af[ks], bb, acc[n], 0, 0, 0);
            }
        }
#pragma unroll
        for (int n = 0; n < 8; ++n)
#pragma unroll
            for (int j = 0; j < 4; ++j) { const int p = 16 * w + 4 * fq + j; LAS unsigned short* ad = (LAS unsigned short*)(GU + p * 264 + (16 * n + fr) * 2);
                *ad = (unsigned short)f2bf(bf1(*ad) * (acc[n][j] + BS[p])); }
        __syncthreads();
#pragma unroll
        for (int i = 0; i < 8; ++i) { const int pid = tid + 512 * i, r = pid >> 5, cg = pid & 31;
            *(GAS v2u*)(F.MIX() + (t0 + r) * D + LW + h * 128 + cg * 4) = *(const LAS v2u*)(GU + r * 264 + cg * 8); }
        __syncthreads();
    }
}
typedef float f32x16 __attribute__((ext_vector_type(16)));
__device__ __forceinline__ unsigned fkey(float f) { const int u = __builtin_bit_cast(int, f); return (unsigned)(u ^ ((u >> 31) & 0x7fffffff)); }
__device__ __forceinline__ float fkey_inv(unsigned k) { const int u = (int)k; return __builtin_bit_cast(float, u ^ ((u >> 31) & 0x7fffffff)); }
__device__ __forceinline__ unsigned umax_(unsigned a, unsigned b) { return (int)a > (int)b ? a : b; }
__device__ __forceinline__ unsigned umin_(unsigned a, unsigned b) { return (int)a < (int)b ? a : b; }
#define CE_DESC(x, y) do { const unsigned a_ = (x), b_ = (y); (x) = umax_(a_, b_); (y) = umin_(a_, b_); } while (0)
__device__ __forceinline__ void sort16_desc(unsigned (&a)[16]) {
#pragma unroll
    for (int k = 2; k <= 16; k <<= 1)
#pragma unroll
        for (int j = k >> 1; j >= 1; j >>= 1)
#pragma unroll
            for (int i = 0; i < 16; ++i) { const int l = i ^ j; if (l > i) { if ((i & k) == 0) CE_DESC(a[i], a[l]); else CE_DESC(a[l], a[i]); } }
}
__device__ __forceinline__ void merge16_desc(unsigned (&a)[16], const unsigned (&b)[16]) {
#pragma unroll
    for (int i = 0; i < 16; ++i) a[i] = umax_(a[i], b[15 - i]);
#pragma unroll
    for (int j = 8; j >= 1; j >>= 1)
#pragma unroll
        for (int i = 0; i < 16; ++i) if ((i & j) == 0) CE_DESC(a[i], a[i + j]);
}
typedef short bf16x8s __attribute__((ext_vector_type(8)));
__device__ __forceinline__ void topk_unit(Frame& F, int wu) {
    const int tg = wu >> 3, hd = wu & 7, lane = F.lane, r = lane & 31, hh = lane >> 5;
    const int t = tg * 32 + r;
    const size_t qoff = (size_t)t * D + hd * 256 + 8 * hh;
    unsigned L[2][16];
    unsigned hh4 = (unsigned)hh << 2; asm volatile("" : "+v"(hh4));
#pragma unroll
    for (int p = 0; p < 2; ++p) {
        f32x16 acc[4];
#pragma unroll
        for (int nt = 0; nt < 4; ++nt)
#pragma unroll
            for (int i = 0; i < 16; ++i) acc[nt][i] = 0.f;
        const size_t koff = ((size_t)(hd * 2 + p) * 128 + r) * 128 + 8 * hh;
        const bf16* qp = F.QH() + qoff + p * 128; const bf16* kp0 = F.KH() + koff; const bf16* kp1 = kp0 + 32 * 128; const bf16* kp2 = kp0 + 64 * 128; const bf16* kp3 = kp0 + 96 * 128;
        asm volatile("" : "+v"(qp), "+v"(kp0), "+v"(kp1), "+v"(kp2), "+v"(kp3));
#define P6_LOAD(Q, K, ks0, n) _Pragma("unroll") for (int i_ = 0; i_ < (n); ++i_) { Q[i_] = *(const GAS bf16x8s*)(qp + 16 * ((ks0) + i_)); \
            K[i_][0] = *(const GAS bf16x8s*)(kp0 + 16 * ((ks0) + i_)); K[i_][1] = *(const GAS bf16x8s*)(kp1 + 16 * ((ks0) + i_)); \
            K[i_][2] = *(const GAS bf16x8s*)(kp2 + 16 * ((ks0) + i_)); K[i_][3] = *(const GAS bf16x8s*)(kp3 + 16 * ((ks0) + i_)); }
#define P6_MMA(Q, K, n) _Pragma("unroll") for (int i_ = 0; i_ < (n); ++i_) _Pragma("unroll") for (int nt = 0; nt < 4; ++nt) acc[nt] = __builtin_amdgcn_mfma_f32_32x32x16_bf16(K[i_][nt], Q[i_], acc[nt], 0, 0, 0);
        bf16x8s qa[3], ka[3][4], qb[3], kb[3][4];
        P6_LOAD(qa, ka, 0, 3); P6_LOAD(qb, kb, 3, 3);
        __builtin_amdgcn_sched_barrier(0);
        P6_MMA(qa, ka, 3);
        __builtin_amdgcn_sched_barrier(0);
        P6_LOAD(qa, ka, 6, 2);
        __builtin_amdgcn_sched_barrier(0);
        P6_MMA(qb, kb, 3);
        __builtin_amdgcn_sched_barrier(0);
        P6_MMA(qa, ka, 2);
        __builtin_amdgcn_sched_barrier(0);
#undef P6_LOAD
#undef P6_MMA
        unsigned S[4][16];
#pragma unroll
        for (int nt = 0; nt < 4; ++nt) {
#pragma unroll
            for (int rg = 0; rg < 16; ++rg) { const int nc = 32 * nt + (rg & 3) + 8 * (rg >> 2); S[nt][rg] = ((fkey(acc[nt][rg]) & ~0x7Fu) | (unsigned)(127 - nc)) ^ hh4; }
            sort16_desc(S[nt]);
        }
        merge16_desc(S[0], S[1]); merge16_desc(S[2], S[3]); merge16_desc(S[0], S[2]);
        unsigned T[16];
#pragma unroll
        for (int i = 0; i < 16; ++i) T[i] = (unsigned)__shfl_xor((int)S[0][i], 32);
        merge16_desc(S[0], T);
#pragma unroll
        for (int i = 0; i < 16; ++i) L[p][i] = S[0][i];
        __builtin_amdgcn_sched_barrier(0);
    }
    float v0[16], v1[16];
#pragma unroll
    for (int i = 0; i < 16; ++i) { v0[i] = fkey_inv(L[0][i] & ~0x7Fu); v1[i] = fkey_inv(L[1][i] & ~0x7Fu); }
    unsigned C[4][16];
    {
        int cnt = 0;
#pragma unroll
        for (int i = 0; i < 16; ++i)
#pragma unroll
            for (int j = 0; j < 16; ++j) if ((i + 1) * (j + 1) <= 16) { C[cnt >> 4][cnt & 15] = (fkey(v0[i] + v1[j]) & ~0xFFu) | (unsigned)(255 - (i * 16 + j)); ++cnt; }
#pragma unroll
        for (int q = 50; q < 64; ++q) C[q >> 4][q & 15] = 0x80000000u;
    }
    sort16_desc(C[0]); sort16_desc(C[1]); sort16_desc(C[2]); sort16_desc(C[3]);
    merge16_desc(C[0], C[1]); merge16_desc(C[2], C[3]); merge16_desc(C[0], C[2]);
    unsigned best[16];
#pragma unroll
    for (int i = 0; i < 16; ++i) best[i] = C[0][i];
    LAS unsigned* tab = (LAS unsigned*)(F.lds + F.wave * 8192) + lane;
#pragma unroll
    for (int i = 0; i < 16; ++i) { tab[i * 64] = 127u - (L[0][i] & 0x7Fu); tab[(16 + i) * 64] = 127u - (L[1][i] & 0x7Fu); }
    const float smax = fkey_inv(best[0] & ~0xFFu);
    float sv[8]; unsigned idv[8]; float ssum = 0.f;
#pragma unroll
    for (int k = 0; k < 8; ++k) {
        const unsigned bk = hh ? best[8 + k] : best[k];
        const unsigned pos = 255u - (bk & 0xFFu);
        idv[k] = tab[(pos >> 4) * 64] * 128u + tab[(16 + (pos & 15u)) * 64];
        sv[k] = __builtin_amdgcn_exp2f((fkey_inv(bk & ~0xFFu) - smax) * 1.4426950409f); ssum += sv[k];
    }
    ssum += __shfl_xor(ssum, 32);
    const float inv = 1.0f / ssum;
    {
        int* o = F.IDS() + (size_t)t * 128 + hd * 16 + 8 * hh; float* og = F.GATES() + (size_t)t * 128 + hd * 16 + 8 * hh;
        *(GAS v4u*)o = (v4u){idv[0], idv[1], idv[2], idv[3]}; *(GAS v4u*)(o + 4) = (v4u){idv[4], idv[5], idv[6], idv[7]};
        *(GAS f32x4*)og = (f32x4){sv[0] * inv, sv[1] * inv, sv[2] * inv, sv[3] * inv}; *(GAS f32x4*)(og + 4) = (f32x4){sv[4] * inv, sv[5] * inv, sv[6] * inv, sv[7] * inv};
    }
}
__device__ __forceinline__ void h8_row(Frame& F, int t) {
    const int lane = F.lane;
    float hx[32]; float mx = 0.f;
    const bf16* hp = F.HB() + (size_t)t * D + lane * 16;
#pragma unroll
    for (int c = 0; c < 2; ++c)
#pragma unroll
        for (int q = 0; q < 2; ++q) { const v4u a = *(const GAS v4u*)(hp + c * 1024 + q * 8); float* x = hx + c * 16 + q * 8;
            x[0] = bf_lo(a.x); x[1] = bf_hi(a.x); x[2] = bf_lo(a.y); x[3] = bf_hi(a.y); x[4] = bf_lo(a.z); x[5] = bf_hi(a.z); x[6] = bf_lo(a.w); x[7] = bf_hi(a.w); }
#pragma unroll
    for (int i = 0; i < 32; ++i) mx = fmaxf(mx, fabsf(hx[i]));
#pragma unroll
    for (int o = 1; o < 64; o <<= 1) mx = fmaxf(mx, __shfl_xor(mx, o));
    const float sc = mx > 0.f ? 127.0f / mx : 1.0f;
#pragma unroll
    for (int c = 0; c < 2; ++c) { v4u o; o.x = pack_i8x4(hx[c * 16 + 0] * sc, hx[c * 16 + 1] * sc, hx[c * 16 + 2] * sc, hx[c * 16 + 3] * sc);
        o.y = pack_i8x4(hx[c * 16 + 4] * sc, hx[c * 16 + 5] * sc, hx[c * 16 + 6] * sc, hx[c * 16 + 7] * sc);
        o.z = pack_i8x4(hx[c * 16 + 8] * sc, hx[c * 16 + 9] * sc, hx[c * 16 + 10] * sc, hx[c * 16 + 11] * sc);
        o.w = pack_i8x4(hx[c * 16 + 12] * sc, hx[c * 16 + 13] * sc, hx[c * 16 + 14] * sc, hx[c * 16 + 15] * sc);
        *(GAS v4u*)(F.H8() + (size_t)t * D + c * 1024 + lane * 16) = o; }
    if (lane == 0) F.HSCALE()[t] = mx > 0.f ? mx * (1.0f / 127.0f) : 1.0f;
}
__device__ __forceinline__ int row_sum16(int v) {
    v += __builtin_amdgcn_update_dpp(0, v, 0x128, 0xf, 0xf, false);
    v += __builtin_amdgcn_update_dpp(0, v, 0x124, 0xf, 0xf, false);
    v += __builtin_amdgcn_update_dpp(0, v, 0x122, 0xf, 0xf, false);
    v += __builtin_amdgcn_update_dpp(0, v, 0x121, 0xf, 0xf, false);
    return v;
}
__device__ __forceinline__ void peer_u_xcd(Frame& F) {
    const int lane = F.lane, x = blockIdx.x & 7, jcu = blockIdx.x >> 3, ncu = ((int)F.G - x + 7) >> 3;
    const int tpc = (M + ncu - 1) / ncu, tpw = (tpc + NWAVES - 1) / NWAVES;
    const int tbase = jcu * tpc + F.wave * tpw;
    int nw = M - tbase; { const int lim = (jcu + 1) * tpc - tbase; nw = nw < lim ? nw : lim; nw = nw < tpw ? nw : tpw; nw = nw < 0 ? 0 : nw; }
    const int NV = 2 * nw;
    LAS unsigned char* wl = F.lds + F.wave * 9216;
    LAS int* lst = (LAS int*)wl; LAS int* res = (LAS int*)(wl + 512); LAS unsigned char* hsl = wl + 1024;
    const int q4 = lane >> 4, i16 = lane & 15;
    const unsigned char* ubase = F.U8() + (size_t)x * 2048 * D;
    const unsigned lanepart = (unsigned)i16 * 16u;
    int r_idlo = 0, r_idhi = 0, r_t = 0, r_g = 0; v4u r_hq = (v4u){0u, 0u, 0u, 0u};
    int v_cl0 = 0, v_cl1 = 0, v_n = 0, v_r0 = 0, v_t = 0, v_g = 0, v_slot = 0; unsigned long long v_mlo = 0, v_mhi = 0; bool v_live = false;
    int vset = 0, nvalid = 0, idle = 0;
    if (NV == 0) return;
#define U_RAW() do { const int vi_ = vset < NV ? vset : NV - 1; r_g = vi_ >= nw ? 1 : 0; r_t = tbase + (vi_ - r_g * nw); \
        r_idlo = F.IDS()[(size_t)r_t * 128 + lane]; r_idhi = F.IDS()[(size_t)r_t * 128 + 64 + lane]; \
        r_hq = *(const GAS v4u*)(F.H8() + (size_t)r_t * D + r_g * 1024 + lane * 16); } while (0)
#define U_NEXT() do { if (v_live && v_r0 + 16 < v_n) { v_r0 += 16; } else if (vset < NV) { const bool slo = (r_idlo >> 11) == x, shi = (r_idhi >> 11) == x; \
            v_mlo = __ballot(slo); v_mhi = __ballot(shi); const int nlo = __popcll(v_mlo); v_n = nlo + __popcll(v_mhi); \
            const int plo = __builtin_amdgcn_mbcnt_hi((unsigned)(v_mlo >> 32), __builtin_amdgcn_mbcnt_lo((unsigned)v_mlo, 0)); \
            const int phi = nlo + __builtin_amdgcn_mbcnt_hi((unsigned)(v_mhi >> 32), __builtin_amdgcn_mbcnt_lo((unsigned)v_mhi, 0)); \
            if (slo) lst[plo] = (r_idlo & 2047) | (lane << 16); if (shi) lst[phi] = (r_idhi & 2047) | ((64 + lane) << 16); \
            v_slot = (nvalid++) & 7; *(LAS v4u*)(hsl + v_slot * 1024 + lane * 16) = r_hq; \
            v_cl0 = lst[lane]; v_cl1 = lst[64 + lane]; v_t = r_t; v_g = r_g; v_r0 = 0; ++vset; v_live = true; } \
        else { v_live = false; v_n = 0; v_r0 = 0; v_mlo = 0; v_mhi = 0; ++idle; } } while (0)
#define U_ISSUE(BUF, DS) do { { const int rem_ = v_n - v_r0; DS##_cnt = rem_ < 0 ? 0 : (rem_ < 16 ? rem_ : 16); } \
        DS##_slot = v_slot; DS##_t = v_t; DS##_g = v_g; DS##_mlo = v_mlo; DS##_mhi = v_mhi; DS##_last = v_live && (v_r0 + 16 >= v_n); \
        const unsigned char* rb_ = ubase + v_g * 1024; \
        _Pragma("unroll") for (int gp = 0; gp < 4; ++gp) { const int ix_ = v_r0 + 4 * gp + q4; const int a_ = __shfl(v_cl0, ix_ & 63), b_ = __shfl(v_cl1, ix_ & 63); DS##_ent[gp] = ix_ < 64 ? a_ : b_; \
            const unsigned of_ = (4 * gp + q4 < DS##_cnt ? ((unsigned)(DS##_ent[gp] & 2047) << 11) : 0u) + lanepart; \
            _Pragma("unroll") for (int c = 0; c < 4; ++c) BUF[4 * gp + c] = *(const GAS v4u*)(rb_ + of_ + c * 256); } } while (0)
#define U_COMPUTE(BUF, DS) do { const volatile LAS v4u* hp_ = (const volatile LAS v4u*)(hsl + DS##_slot * 1024 + i16 * 16); \
        _Pragma("unroll") for (int gp = 0; gp < 4; ++gp) if (4 * gp < DS##_cnt) { int a_ = 0; \
            _Pragma("unroll") for (int c = 0; c < 4; ++c) { const v4u r_ = BUF[4 * gp + c]; const v4u h_ = hp_[c * 16]; a_ = __builtin_amdgcn_sdot4((int)r_.x, (int)h_.x, a_, false); a_ = __builtin_amdgcn_sdot4((int)r_.y, (int)h_.y, a_, false); \
                a_ = __builtin_amdgcn_sdot4((int)r_.z, (int)h_.z, a_, false); a_ = __builtin_amdgcn_sdot4((int)r_.w, (int)h_.w, a_, false); } \
            a_ = row_sum16(a_); if (i16 == 0 && 4 * gp + q4 < DS##_cnt) res[DS##_ent[gp] >> 16] = a_; } \
        if (DS##_last) { int* po_ = F.PART() + ((size_t)DS##_g * M + DS##_t) * 128; \
            if ((DS##_mlo >> lane) & 1ull) po_[lane] = res[lane]; if ((DS##_mhi >> lane) & 1ull) po_[64 + lane] = res[64 + lane]; } } while (0)
    v4u bufA[16], bufB[16], bufC[16];
    int dA_cnt = 0, dA_ent[4] = {0, 0, 0, 0}, dA_t = 0, dA_g = 0, dA_slot = 0; unsigned long long dA_mlo = 0, dA_mhi = 0; bool dA_last = false;
    int dB_cnt = 0, dB_ent[4] = {0, 0, 0, 0}, dB_t = 0, dB_g = 0, dB_slot = 0; unsigned long long dB_mlo = 0, dB_mhi = 0; bool dB_last = false;
    int dC_cnt = 0, dC_ent[4] = {0, 0, 0, 0}, dC_t = 0, dC_g = 0, dC_slot = 0; unsigned long long dC_mlo = 0, dC_mhi = 0; bool dC_last = false;
    U_RAW();
    U_NEXT(); U_RAW(); U_ISSUE(bufA, dA);
    U_NEXT(); U_RAW(); U_ISSUE(bufB, dB);
    while (idle < 3) {
        U_NEXT(); U_RAW(); U_ISSUE(bufC, dC); U_COMPUTE(bufA, dA);
        U_NEXT(); U_RAW(); U_ISSUE(bufA, dA); U_COMPUTE(bufB, dB);
        U_NEXT(); U_RAW(); U_ISSUE(bufB, dB); U_COMPUTE(bufC, dC);
    }
#undef U_RAW
#undef U_NEXT
#undef U_ISSUE
#undef U_COMPUTE
}
__device__ __forceinline__ void peer_act_token(Frame& F, int t) {
    const int lane = F.lane;
    LAS unsigned char* wl = F.lds + F.wave * 4096;
    LAS float* abuf = (LAS float*)wl; LAS int* ibuf = (LAS int*)(wl + 512); LAS int* cnt = (LAS int*)(wl + 1024);
    LAS int* ovf = (LAS int*)(wl + 1280); LAS int* fre = (LAS int*)(wl + 1792); LAS int* sop = (LAS int*)(wl + 2304);
#define WFENCE() asm volatile("s_waitcnt lgkmcnt(0)" ::: "memory")
    const float sc = __builtin_amdgcn_rsqf(F.ROWSS()[t] * (1.0f / D) + 1e-6f) * F.HSCALE()[t];
    if (lane < 34) cnt[lane] = 0;
    float am = 0.f; float actv[2]; int idv[2], slotv[2];
    const int l32 = t & 31;
#pragma unroll
    for (int half = 0; half < 2; ++half) {
        const size_t o = (size_t)t * 128 + half * 64 + lane;
        const int e = F.IDS()[o]; const float g = F.GATES()[o];
        const int dsum = F.PART()[o] + F.PART()[(size_t)M * 128 + o];
        actv[half] = gelu_tanh((float)dsum * sc * F.USCALE()[e]) * g * F.VSCALE()[e]; idv[half] = e; am = fmaxf(am, fabsf(actv[half]));
    }
    WFENCE();
#pragma unroll
    for (int half = 0; half < 2; ++half) {
        const int r = idv[half] & 31;
        const int j = __hip_atomic_fetch_add(cnt + r, 1, __ATOMIC_RELAXED, __HIP_MEMORY_SCOPE_WORKGROUP);
        if (j < 4) slotv[half] = ((r - l32) & 31) + 32 * j;
        else { const int q = __hip_atomic_fetch_add(cnt + 32, 1, __ATOMIC_RELAXED, __HIP_MEMORY_SCOPE_WORKGROUP); ovf[q] = half * 64 + lane; slotv[half] = -1; }
    }
    WFENCE();
    if (lane < 32) { const int n = cnt[lane];
        for (int j = n; j < 4; ++j) { const int q = __hip_atomic_fetch_add(cnt + 33, 1, __ATOMIC_RELAXED, __HIP_MEMORY_SCOPE_WORKGROUP); fre[q] = ((lane - l32) & 31) + 32 * j; } }
    WFENCE();
    const int nov = cnt[32];
#pragma unroll
    for (int half = 0; half < 2; ++half) { const int i = half * 64 + lane; if (i < nov) sop[ovf[i]] = fre[i]; }
    WFENCE();
#pragma unroll
    for (int half = 0; half < 2; ++half) { if (slotv[half] < 0) slotv[half] = sop[half * 64 + lane]; abuf[slotv[half]] = actv[half]; ibuf[slotv[half]] = idv[half]; }
    WFENCE();
#pragma unroll
    for (int o = 1; o < 64; o <<= 1) am = fmaxf(am, __shfl_xor(am, o));
    const float asc = am > 0.f ? 127.0f / am : 1.0f;
    if (lane == 0) F.ASCALE()[t] = am > 0.f ? am * (1.0f / 127.0f) : 1.0f;
    if (lane < 32) {
        const f32x4 av = *(const LAS f32x4*)(abuf + 4 * lane); const v4u iv = *(const LAS v4u*)(ibuf + 4 * lane);
        const size_t o = ((size_t)(t >> 6) * 32 + lane) * 64 + (t & 63);
        F.IDW()[o] = (v4u){iv.x << 3, iv.y << 3, iv.z << 3, iv.w << 3};
        F.AW()[o] = pack_i8x4(av.x * asc, av.y * asc, av.z * asc, av.w * asc);
    }
    WFENCE();
#undef WFENCE
}
__device__ __forceinline__ void tr4x4(const unsigned r0, const unsigned r1, const unsigned r2, const unsigned r3, unsigned (&c)[4]) {
    const unsigned t01l = __builtin_amdgcn_perm(r1, r0, 0x05010400u), t01h = __builtin_amdgcn_perm(r1, r0, 0x07030602u);
    const unsigned t23l = __builtin_amdgcn_perm(r3, r2, 0x05010400u), t23h = __builtin_amdgcn_perm(r3, r2, 0x07030602u);
    c[0] = __builtin_amdgcn_perm(t23l, t01l, 0x05040100u); c[1] = __builtin_amdgcn_perm(t23l, t01l, 0x07060302u);
    c[2] = __builtin_amdgcn_perm(t23h, t01h, 0x05040100u); c[3] = __builtin_amdgcn_perm(t23h, t01h, 0x07060302u);
}
template <int MODE>
__device__ __forceinline__ void peer_v_slice(Frame& F, int c, bool do_atomic) {
    const int tid = F.tid, lane = F.lane;
    for (int i = tid; i < NEXP * 8 / 16; i += 512) *(LAS v4u*)(F.lds + i * 16) = *(const GAS v4u*)(F.V8T() + (size_t)c * NEXP * 8 + (size_t)i * 16);
    __syncthreads();
    const v4u* ibase = F.IDW() + lane; const unsigned* abase = F.AW() + lane;
    constexpr int NBLK = M / 64, PD = 16;
    v4u iq[PD]; unsigned aq[PD]; v2u rw[2][4];
    {
        const size_t o = (size_t)F.wave * 32 * 64;
#pragma unroll
        for (int j = 0; j < PD; ++j) { iq[j] = *(const GAS v4u*)(ibase + o + j * 64); aq[j] = abase[o + j * 64]; }
    }
#define LROW(dst, q) do { dst[0] = *(const LAS v2u*)(F.lds + (q).x); dst[1] = *(const LAS v2u*)(F.lds + (q).y); \
                          dst[2] = *(const LAS v2u*)(F.lds + (q).z); dst[3] = *(const LAS v2u*)(F.lds + (q).w); } while (0)
    for (int blk = F.wave; blk < NBLK; blk += NWAVES) {
        const int t = blk * 64 + lane;
        const size_t o = (size_t)blk * 32 * 64;
        const int nblk = (blk + NWAVES < NBLK) ? blk + NWAVES : blk;
        const size_t on = (size_t)nblk * 32 * 64;
        int acc[8];
#pragma unroll
        for (int i = 0; i < 8; ++i) acc[i] = 0;
        LROW(rw[0], iq[0]);
#pragma unroll
        for (int j = 0; j < 32; ++j) {
            if (j + 1 < 32) LROW(rw[(j + 1) & 1], iq[(j + 1) % PD]);
            const unsigned aw = aq[j % PD];
            unsigned cl[4], ch[4];
            tr4x4(rw[j & 1][0].x, rw[j & 1][1].x, rw[j & 1][2].x, rw[j & 1][3].x, cl);
            tr4x4(rw[j & 1][0].y, rw[j & 1][1].y, rw[j & 1][2].y, rw[j & 1][3].y, ch);
#pragma unroll
            for (int i = 0; i < 4; ++i) { acc[i] = __builtin_amdgcn_sdot4((int)aw, (int)cl[i], acc[i], false); acc[4 + i] = __builtin_amdgcn_sdot4((int)aw, (int)ch[i], acc[4 + i], false); }
            { const size_t oo = (j + PD < 32) ? o + (size_t)(j + PD) * 64 : on + (size_t)(j + PD - 32) * 64;
              iq[j % PD] = *(const GAS v4u*)(ibase + oo); aq[j % PD] = abase[oo]; }
            __builtin_amdgcn_sched_barrier(0);
        }
        const float asc = F.ASCALE()[t];
        float accf[8];
#pragma unroll
        for (int i = 0; i < 8; ++i) accf[i] = (float)acc[i] * asc;
        const v4u hb = *(const GAS v4u*)(F.HBT() + ((size_t)c * M + t) * 8);
        accf[0] += bf_lo(hb.x); accf[1] += bf_hi(hb.x); accf[2] += bf_lo(hb.y); accf[3] += bf_hi(hb.y);
        accf[4] += bf_lo(hb.z); accf[5] += bf_hi(hb.z); accf[6] += bf_lo(hb.w); accf[7] += bf_hi(hb.w);
        bf16* yp = (MODE == 0) ? F.Y() + ((size_t)c * M + t) * 8 : (bf16*)F.XN() + ((((size_t)c * M + t) * 8) & (size_t)0x1ffffff);
        *(GAS v4u*)yp = (v4u){pk2(accf[0], accf[1]), pk2(accf[2], accf[3]), pk2(accf[4], accf[5]), pk2(accf[6], accf[7])};
        float ss = 0.f;
#pragma unroll
        for (int i = 0; i < 8; ++i) ss += accf[i] * accf[i];
        if (do_atomic) atomicAdd(F.ROWSS2() + t, ss);
    }
#undef LROW
    __syncthreads();
}
__device__ __forceinline__ void final_unit(Frame& F, int unit) {
    const int tid = F.tid, blk = unit >> 3, cg = unit & 7, t0 = blk * 64;
    LAS float* T = (LAS float*)F.lds;
#pragma unroll
    for (int i = 0; i < 4; ++i) { const int pid = tid + 512 * i, cl = pid >> 6, tok = pid & 63;
        const v4u v = *(const GAS v4u*)(F.Y() + ((size_t)(cg * 32 + cl) * M + t0 + tok) * 8);
        *(LAS f32x4*)(T + tok * 260 + cl * 8) = (f32x4){bf_lo(v.x), bf_hi(v.x), bf_lo(v.y), bf_hi(v.y)};
        *(LAS f32x4*)(T + tok * 260 + cl * 8 + 4) = (f32x4){bf_lo(v.z), bf_hi(v.z), bf_lo(v.w), bf_hi(v.w)}; }
    __syncthreads();
#pragma unroll
    for (int i = 0; i < 8; ++i) { const int pid = tid + 512 * i, tok = pid >> 6, c4 = pid & 63;
        const float rs = __builtin_amdgcn_rsqf(F.ROWSS2()[t0 + tok] * (1.0f / D) + 1e-6f);
        const f32x4 v = *(const LAS f32x4*)(T + tok * 260 + c4 * 4);
        const f32x4 g = *(const GAS f32x4*)(F.A.in[20] + cg * 256 + c4 * 4);
        *(GAS f32x4*)(F.A.out + (size_t)(t0 + tok) * D + cg * 256 + c4 * 4) = v * rs * g; }
    __syncthreads();
}
__global__ void __launch_bounds__(NWAVES * 64, 2) mk_fwd(Args args) {
    __shared__ __attribute__((aligned(16))) unsigned char lds[LDS_BYTES];
    Frame F(args);
    F.lds = (LAS unsigned char*)lds;
    F.MISC = (volatile LAS unsigned*)(F.lds + MISC_OFF);
    F.tid = threadIdx.x; F.lane = F.tid & 63; F.wave = __builtin_amdgcn_readfirstlane(F.tid >> 6);
    F.G = gridDim.x; { const int bx = blockIdx.x; F.vcu = (F.G % 8 == 0) ? (bx % 8) * (F.G / 8) + bx / 8 : bx; }
    F.ws = args.ws;
    F.ctl = (gu32*)(args.ws + WS_CTL);
    for (int u = F.tid; u < (LDS_BYTES - LDSCTL_OFF) / 4; u += NWAVES * 64) ((LAS unsigned*)(F.lds + LDSCTL_OFF))[u] = 0u;
    __syncthreads();
    XcdBarrier bar; bar.bar = (unsigned*)(F.ctl + CW_BAR); bar.x = 0; bar.st = nullptr;
    if (N_LAUNCHES != PER_PHASE) bar = xcd_barrier_post((unsigned*)(F.ctl + CW_BAR), F.MISC + 8);
#define GRID_BAR() do { if (N_LAUNCHES != PER_PHASE) xcd_barrier(bar); } while (0)
    const int lo = args.ph_lo, hi = args.ph_hi;
#ifndef MK_PHASE_MASK
#define MK_PHASE_MASK 0x7FF
#endif
#define IN(k) (((MK_PHASE_MASK >> (k)) & 1) && lo <= (k) && (k) < hi)
#undef MK_PHASE_MASK
#define MK_PHASE_MASK 0xFFFF
#define BOTH(k) (true)
#ifndef MK_REP_MASK
#define MK_REP_MASK 0
#endif
#ifndef MK_REP_N
#define MK_REP_N 2
#endif
#define REPS(k) for (int rep_ = 0; rep_ < ((((MK_REP_MASK) >> (k)) & 1) ? 1 + MK_REP_N : 1); ++rep_)
    const int gw = F.vcu * NWAVES + F.wave, NGW = F.G * NWAVES;
    if (IN(0)) { REPS(0) { p0_prologue(F); __syncthreads(); } if (BOTH(0)) GRID_BAR(); }
    if (IN(1)) {
        pg8::Gemm g{F.XN(), F.WIN(), M, NIN, D}; pg8::StaticOrder S; S.init(M, NIN, F.G, (int)blockIdx.x);
        pg8::EpiZ E{F.Z(), NIN, LW};
        REPS(1) pg8::gemm_phase<pg8::EpiZ, pg8::StaticOrder, true, true>(F.lds, g, S, E);
        if (BOTH(1)) GRID_BAR();
    }
    if (IN(2)) {
        REPS(12) for (int u = blockIdx.x; u < BATCH * NCHUNK * 8; u += F.G) lru_unit<false>(F, u);
        if (BOTH(2)) GRID_BAR();
    }
    if (IN(3)) {
        lru_carry(F);
        REPS(13) for (int u = blockIdx.x; u < BATCH * NCHUNK; u += F.G) gmlp_unit(F, u);
        if (BOTH(3)) GRID_BAR();
    }
    if (IN(11)) {
        REPS(3) for (int u = blockIdx.x; u < BATCH * NCHUNK * 8; u += F.G) lru_unit<true>(F, u);
        GRID_BAR();
    }
    if (IN(4)) {
        pg8::Gemm g{F.MIX(), F.WOUT(), M, D, D}; pg8::StaticOrder S; S.init(M, D, F.G, (int)blockIdx.x);
        pg8::EpiH E{F.HB(), F.HBT(), F.A.in[0], F.ROWSS(), D, M};
        pg8::gemm_phase<pg8::EpiH, pg8::StaticOrder, true, true>(F.lds, g, S, E);
        if (BOTH(4)) GRID_BAR();
    }
    if (IN(5)) {
        pg8::Gemm g{F.HB(), F.WQ(), M, D, D}; pg8::StaticOrder S; S.init(M, D, F.G, (int)blockIdx.x);
        pg8::EpiQ E{F.QH(), F.ROWSS(), D};
        REPS(5) pg8::gemm_phase<pg8::EpiQ, pg8::StaticOrder, true, true>(F.lds, g, S, E);
        if (BOTH(5)) GRID_BAR();
    }
    if (IN(6)) {
        REPS(6) { for (int wu = gw; wu < (M / 32) * 8; wu += NGW) topk_unit(F, wu);
                  for (int t = gw; t < M; t += NGW) h8_row(F, t); }
        if (BOTH(6)) GRID_BAR();
    }
    if (IN(7)) {
        REPS(7) peer_u_xcd(F);
        if (BOTH(7)) GRID_BAR();
    }
    if (IN(8)) {
        REPS(8) for (int t = gw; t < M; t += NGW) peer_act_token(F, t);
        if (BOTH(8)) GRID_BAR();
    }
    if (IN(9)) {
        for (int c = blockIdx.x; c < D / 8; c += F.G) peer_v_slice<0>(F, c, true);
        if ((MK_REP_MASK >> 9) & 1) { for (int rep_ = 0; rep_ < MK_REP_N; ++rep_) for (int c = blockIdx.x; c < D / 8; c += F.G) peer_v_slice<1>(F, c, false); }
        if (BOTH(9)) GRID_BAR();
    }
    if (IN(10)) {
        REPS(10) for (int u = blockIdx.x; u < (M / 64) * 8; u += F.G) final_unit(F, u);
    }
#undef IN
#undef BOTH
#undef GRID_BAR
}

extern "C" void kernel_launch(void* const* d_in, const int* in_sizes, int n_in, void* d_out, int out_size, void* d_ws, size_t ws_size, hipStream_t stream) {
    static int grid = 0;
    if (grid == 0) {
        if (n_in != 21 || in_sizes[0] != M * D || out_size != M * D || ws_size < WS_END) { fprintf(stderr, "kernel_launch: unexpected shapes (n_in %d, in0 %d, out %d, ws %zu)\n", n_in, n_in > 0 ? in_sizes[0] : -1, out_size, ws_size); grid = -1; return; }
        int dev = 0, cus = 0, per_cu = 0;
        if (hipGetDevice(&dev) != hipSuccess || hipDeviceGetAttribute(&cus, hipDeviceAttributeMultiprocessorCount, dev) != hipSuccess) { grid = -1; return; }
        if (hipOccupancyMaxActiveBlocksPerMultiprocessor(&per_cu, (const void*)mk_fwd, NWAVES * 64, 0) != hipSuccess || per_cu < 1) { fprintf(stderr, "kernel_launch: occupancy query reports %d blocks per CU\n", per_cu); }
        (void)hipGetLastError();
        grid = cus;
    }
    if (grid < 0) return;
    (void)hipMemsetAsync((char*)d_ws + WS_CTL, 0, CTL_ZERO_BYTES, stream);
    Args a{};
    for (int i = 0; i < 21; ++i) a.in[i] = (const float*)d_in[i];
    a.out = (float*)d_out; a.ws = (unsigned char*)d_ws;
    for (int li = 0; li < N_LAUNCHES; ++li) {
        a.ph_lo = 0; a.ph_hi = 99;
        hipLaunchKernelGGL(mk_fwd, dim3(grid), dim3(NWAVES * 64), 0, stream, a);
    }
}
```

```cpp
#include <hip/hip_runtime.h>
#include <cstdio>
#include <cstdint>
namespace pg8 {
#define PG8_LAS __attribute__((address_space(3)))
typedef unsigned short bf16_t;
typedef short bf16x8 __attribute__((ext_vector_type(8)));
typedef float f32x4 __attribute__((ext_vector_type(4)));
typedef unsigned u32x4 __attribute__((ext_vector_type(4)));
constexpr int BM = 256, BK = 64, HALF = 128, HTB = HALF * BK * 2  , STAGE_BYTES = 8 * HTB, NXCD = 8, WGM = 8;

__host__ __device__ __forceinline__ int lds_byte(int r, int c) { const int st = (r >> 4) * 2 + (c >> 5), rr = r & 15, cc = c & 31, ob = rr * 64 + cc * 2; return st * 1024 + (ob ^ (((ob >> 9) & 1) << 5)); }
__host__ __device__ __forceinline__ void stage_rc(int b, int& R, int& C) { const int st = b / 1024, sb = b % 1024, swz = sb ^ (((sb >> 9) & 1) << 5); R = (st >> 1) * 16 + swz / 64; C = (st & 1) * 32 + (swz % 64) / 2; }
__host__ __device__ __forceinline__ int perm32(int rho) { const int n = rho >> 4, i = rho & 15; return 8 * (i >> 2) + 4 * n + (i & 3); }

struct Unit { int pm, pn; };
struct Gemm { const bf16_t* A; const bf16_t* Bt; int M, N, K; };

struct StaticOrder {
    int nM, nN, nwg, G, c;
    __host__ __device__ void init(int M, int N, int G_, int c_) { nM = M / BM; nN = N / BM; nwg = nM * nN; G = G_; c = c_; }
    __host__ __device__ bool next(int i, Unit& u) const {
        const long L = (long)i * G + c; if (L >= nwg) return false;
        int wgid = (int)L; { const int q = nwg / NXCD, r = nwg % NXCD, xcd = wgid % NXCD, off = wgid / NXCD; wgid = (xcd < r ? xcd * (q + 1) : r * (q + 1) + (xcd - r) * q) + off; }
        const int nig = WGM * nN, gid = wgid / nig, fm = gid * WGM, gsz = (nM - fm) < WGM ? (nM - fm) : WGM;
        u.pm = fm + ((wgid % nig) % gsz); u.pn = (wgid % nig) / gsz; return true;
    }
    __device__ __forceinline__ void a_ready(const Unit&) const {}
    __device__ __forceinline__ void done(const Unit&) const {}
};

__device__ __forceinline__ unsigned cvt_pk_bf16(float lo, float hi) { unsigned r; asm volatile("v_cvt_pk_bf16_f32 %0, %1, %2" : "=v"(r) : "v"(lo), "v"(hi)); return r; }
__device__ __forceinline__ float gelu_tanh(float x) {
    const float t = x * (1.0f + 0.044715f * x * x);
    const float e = __builtin_amdgcn_exp2f(-2.3022081983f * t);
    return x * __builtin_amdgcn_rcpf(1.0f + e);
}
struct EpiZ {
    static constexpr bool PERM = true, AFTER_DRAIN = false;
    bf16_t* O; int ldc; int gelu_from;
    __device__ __forceinline__ void operator()(const f32x4 (&acc)[2][2][4][2], const Unit& u, int wr, int wc, int fr, int fq) const {
        const int row0 = u.pm * BM + wr * 64 + fr; const int col0 = u.pn * BM + wc * 32 + 8 * fq;
        const bool act = (u.pn * BM) >= gelu_from;
#pragma unroll
        for (int ai = 0; ai < 2; ++ai)
#pragma unroll
            for (int m = 0; m < 4; ++m) { bf16_t* rowp = O + (size_t)(row0 + ai * HALF + m * 16) * ldc + col0;
#pragma unroll
                for (int bj = 0; bj < 2; ++bj) { f32x4 v0 = acc[ai][bj][m][0], v1 = acc[ai][bj][m][1];
                    if (act) {
#pragma unroll
                        for (int j = 0; j < 4; ++j) { v0[j] = gelu_tanh(v0[j]); v1[j] = gelu_tanh(v1[j]); } }
                    u32x4 w; w.x = cvt_pk_bf16(v0[0], v0[1]); w.y = cvt_pk_bf16(v0[2], v0[3]); w.z = cvt_pk_bf16(v1[0], v1[1]); w.w = cvt_pk_bf16(v1[2], v1[3]);
                    *(u32x4*)(rowp + bj * HALF) = w; } }
    }
};
struct EpiH {
    static constexpr bool PERM = true, AFTER_DRAIN = false;
    bf16_t* O; bf16_t* OT; const float* X; float* rowss; int ldc; int mrows;
    __device__ __forceinline__ void operator()(const f32x4 (&acc)[2][2][4][2], const Unit& u, int wr, int wc, int fr, int fq) const {
        const int row0 = u.pm * BM + wr * 64 + fr; const int col0 = u.pn * BM + wc * 32 + 8 * fq;
#pragma unroll
        for (int ai = 0; ai < 2; ++ai)
#pragma unroll
            for (int m = 0; m < 4; ++m) { const int row = row0 + ai * HALF + m * 16; const size_t off = (size_t)row * ldc + col0; float ss = 0.f;
#pragma unroll
                for (int bj = 0; bj < 2; ++bj) {
                    const f32x4 x0 = *(const f32x4*)(X + off + bj * HALF), x1 = *(const f32x4*)(X + off + bj * HALF + 4);
                    const f32x4 v0 = acc[ai][bj][m][0] + x0, v1 = acc[ai][bj][m][1] + x1;
                    ss += (v0[0] * v0[0] + v0[1] * v0[1]) + (v0[2] * v0[2] + v0[3] * v0[3]) + (v1[0] * v1[0] + v1[1] * v1[1]) + (v1[2] * v1[2] + v1[3] * v1[3]);
                    u32x4 w; w.x = cvt_pk_bf16(v0[0], v0[1]); w.y = cvt_pk_bf16(v0[2], v0[3]); w.z = cvt_pk_bf16(v1[0], v1[1]); w.w = cvt_pk_bf16(v1[2], v1[3]);
                    *(u32x4*)(O + off + bj * HALF) = w;
                    *(u32x4*)(OT + ((size_t)((col0 + bj * HALF) >> 3) * mrows + row) * 8) = w; }
                ss += __shfl_xor(ss, 16); ss += __shfl_xor(ss, 32);
                if (fq == 0) atomicAdd(rowss + row, ss); }
    }
};
struct EpiQ {
    static constexpr bool PERM = true, AFTER_DRAIN = false;
    bf16_t* QH; const float* rowss; int ldc;
    __device__ __forceinline__ void operator()(const f32x4 (&acc)[2][2][4][2], const Unit& u, int wr, int wc, int fr, int fq) const {
        const int row0 = u.pm * BM + wr * 64 + fr, col0 = u.pn * BM + wc * 32 + 8 * fq;
#pragma unroll
        for (int ai = 0; ai < 2; ++ai)
#pragma unroll
            for (int m = 0; m < 4; ++m) { const int row = row0 + ai * HALF + m * 16; const float rs = __builtin_amdgcn_rsqf(rowss[row] * (1.0f / 2048.0f) + 1e-6f);
                const size_t off = (size_t)row * ldc + col0;
#pragma unroll
                for (int bj = 0; bj < 2; ++bj) { const f32x4 v0 = acc[ai][bj][m][0] * rs, v1 = acc[ai][bj][m][1] * rs;
                    u32x4 wh; wh.x = cvt_pk_bf16(v0[0], v0[1]); wh.y = cvt_pk_bf16(v0[2], v0[3]); wh.z = cvt_pk_bf16(v1[0], v1[1]); wh.w = cvt_pk_bf16(v1[2], v1[3]);
                    *(u32x4*)(QH + off + bj * HALF) = wh; } }
    }
};
template <class Epi, class Sched, bool ALIGN_EPI = false, bool SP2 = false>
__device__ __forceinline__ void gemm_phase(PG8_LAS unsigned char* lds, const Gemm g, const Sched& S, const Epi& E) {
    const int tid = threadIdx.x, wid = __builtin_amdgcn_readfirstlane(tid >> 6), lane = tid & 63, wr = wid >> 2, wc = wid & 3, fr = lane & 15, fq = lane >> 4;
    const int K = g.K, nt = K / BK;
    unsigned voffA[2], voffB[2];
#pragma unroll
    for (int i = 0; i < 2; ++i) { int R, C; stage_rc(tid * 16 + i * 8192, R, C); const int Rb = Epi::PERM ? ((R & ~31) + perm32(R & 31)) : R;
        voffA[i] = (unsigned)(R * K + C) * 2u; voffB[i] = (unsigned)(Rb * K + C) * 2u; }
    const size_t kstep = (size_t)(BK * 2);
    const size_t hstep = (size_t)HALF * K * 2;
    const size_t tstep = 2 * hstep;
    const unsigned ldsw = (unsigned)wid * 1024u;
    const int aoff = lds_byte(wr * 64 + fr, fq * 8), boff = lds_byte(wc * 32 + fr, fq * 8);
#define PG8_SA(b, h) (((b) * 2 + (h)) * HTB)
#define PG8_SB(b, h) ((4 + (b) * 2 + (h)) * HTB)
#define PG8_STAGE(bufoff, gbase, voff) do { _Pragma("unroll") for (int _i = 0; _i < 2; ++_i) \
        __builtin_amdgcn_global_load_lds((const unsigned*)((const char*)(gbase) + (voff)[_i]), (PG8_LAS unsigned*)(lds + (bufoff) + ldsw + _i * 8192), 16, 0, 0); } while (0)
#define PG8_LDA(dst, b, h) do { _Pragma("unroll") for (int m = 0; m < 4; ++m) _Pragma("unroll") for (int k = 0; k < 2; ++k) dst[m][k] = *(const PG8_LAS bf16x8*)(lds + PG8_SA(b, h) + aoff + m * 2048 + k * 1024); } while (0)
#define PG8_LDB(dst, b, h) do { _Pragma("unroll") for (int n = 0; n < 2; ++n) _Pragma("unroll") for (int k = 0; k < 2; ++k) dst[n][k] = *(const PG8_LAS bf16x8*)(lds + PG8_SB(b, h) + boff + n * 2048 + k * 1024); } while (0)
#define PG8_MMA(ai, bj, At, Bt) do { __builtin_amdgcn_s_setprio(1); _Pragma("unroll") for (int m = 0; m < 4; ++m) _Pragma("unroll") for (int n = 0; n < 2; ++n) _Pragma("unroll") for (int k = 0; k < 2; ++k) \
        acc[ai][bj][m][n] = __builtin_amdgcn_mfma_f32_16x16x32_bf16(Bt[n][k], At[m][k], acc[ai][bj][m][n], 0, 0, 0); __builtin_amdgcn_s_setprio(0); } while (0)
#define PG8_WAIT_V(n) asm volatile("s_waitcnt vmcnt(" #n ")" ::: "memory")
#define PG8_WAIT_L(n) asm volatile("s_waitcnt lgkmcnt(" #n ")" ::: "memory")
#define PG8_BAR __builtin_amdgcn_s_barrier()
#define PG8_SCHED __builtin_amdgcn_sched_barrier(0)
    Unit cur, nxt; int ui = 0;
    if (!S.next(0, cur)) return;
    f32x4 acc[2][2][4][2];
#pragma unroll
    for (int a = 0; a < 2; ++a)
#pragma unroll
        for (int b = 0; b < 2; ++b)
#pragma unroll
            for (int m = 0; m < 4; ++m)
#pragma unroll
                for (int n = 0; n < 2; ++n) acc[a][b][m][n] = (f32x4){0.f, 0.f, 0.f, 0.f};
    bf16x8 At[4][2], B0[2][2], B1[2][2];
    const char* cA = (const char*)g.A + (size_t)cur.pm * tstep; const char* cB = (const char*)g.Bt + (size_t)cur.pn * tstep;
    S.a_ready(cur);
    if constexpr (SP2) {
        PG8_STAGE(PG8_SB(0, 0), cB, voffB); PG8_STAGE(PG8_SB(0, 1), cB + hstep, voffB); PG8_STAGE(PG8_SA(0, 0), cA, voffA); PG8_STAGE(PG8_SA(0, 1), cA + hstep, voffA);
        if (wr == 1) PG8_BAR;
        PG8_WAIT_V(2); PG8_BAR;
        PG8_STAGE(PG8_SB(1, 0), cB + kstep, voffB); PG8_STAGE(PG8_SA(1, 0), cA + kstep, voffA); PG8_STAGE(PG8_SB(1, 1), cB + hstep + kstep, voffB);
        PG8_WAIT_V(6); PG8_BAR;
    } else {
        PG8_STAGE(PG8_SB(0, 0), cB, voffB); PG8_STAGE(PG8_SA(0, 0), cA, voffA); PG8_STAGE(PG8_SB(0, 1), cB + hstep, voffB); PG8_STAGE(PG8_SA(0, 1), cA + hstep, voffA);
        if (wr == 1) PG8_BAR;
        PG8_WAIT_V(4); PG8_BAR;
        PG8_STAGE(PG8_SB(1, 0), cB + kstep, voffB); PG8_STAGE(PG8_SA(1, 0), cA + kstep, voffA); PG8_STAGE(PG8_SB(1, 1), cB + hstep + kstep, voffB);
        PG8_WAIT_V(6); PG8_BAR;
    }
    for (;;) {
        const bool has_next = S.next(ui + 1, nxt);
        const char* nA = has_next ? (const char*)g.A + (size_t)nxt.pm * tstep : cA; const char* nB = has_next ? (const char*)g.Bt + (size_t)nxt.pn * tstep : cB;
        for (int t = 0; t < nt; t += 2) {
            const bool last = (t == nt - 2);
            const char* a1 = cA + (size_t)(t + 1) * kstep;
            const char* a2 = last ? nA : cA + (size_t)(t + 2) * kstep; const char* b2 = last ? nB : cB + (size_t)(t + 2) * kstep;
            const char* a3 = a2 + kstep; const char* b3 = b2 + kstep;
            if (last && has_next) S.a_ready(nxt);
            if constexpr (SP2) {
            PG8_LDB(B0, 0, 0); PG8_LDB(B1, 0, 1); PG8_SCHED; PG8_LDA(At, 0, 0); PG8_STAGE(PG8_SA(1, 1), a1 + hstep, voffA);
            PG8_WAIT_V(8); PG8_WAIT_L(0); PG8_BAR; PG8_MMA(0, 0, At, B0); PG8_MMA(0, 1, At, B1); PG8_BAR; PG8_SCHED;
            PG8_LDA(At, 0, 1); PG8_STAGE(PG8_SB(0, 0), b2, voffB); PG8_STAGE(PG8_SB(0, 1), b2 + hstep, voffB); PG8_STAGE(PG8_SA(0, 0), a2, voffA);
            PG8_WAIT_V(8); PG8_WAIT_L(0); PG8_BAR; PG8_MMA(1, 0, At, B0); PG8_MMA(1, 1, At, B1); PG8_BAR; PG8_SCHED;
            PG8_LDB(B0, 1, 0); PG8_LDB(B1, 1, 1); PG8_SCHED; PG8_LDA(At, 1, 0); PG8_STAGE(PG8_SA(0, 1), a2 + hstep, voffA);
            PG8_WAIT_V(8); PG8_WAIT_L(0); PG8_BAR; PG8_MMA(0, 0, At, B0); PG8_MMA(0, 1, At, B1); PG8_BAR; PG8_SCHED;
            PG8_LDA(At, 1, 1); PG8_STAGE(PG8_SB(1, 0), b3, voffB); PG8_STAGE(PG8_SB(1, 1), b3 + hstep, voffB); PG8_STAGE(PG8_SA(1, 0), a3, voffA);
            PG8_WAIT_V(8); PG8_WAIT_L(0); PG8_BAR; PG8_MMA(1, 0, At, B0); PG8_MMA(1, 1, At, B1); PG8_BAR; PG8_SCHED;
            } else {
            PG8_LDB(B0, 0, 0); PG8_SCHED; PG8_LDA(At, 0, 0); PG8_STAGE(PG8_SA(1, 1), a1 + hstep, voffA);
            PG8_WAIT_L(8); PG8_BAR; PG8_WAIT_L(0); PG8_MMA(0, 0, At, B0); PG8_BAR; PG8_SCHED;
            PG8_LDB(B1, 0, 1); PG8_STAGE(PG8_SB(0, 0), b2, voffB);
            PG8_BAR; PG8_WAIT_L(0); PG8_MMA(0, 1, At, B1); PG8_BAR;
            PG8_LDA(At, 0, 1); PG8_STAGE(PG8_SA(0, 0), a2, voffA);
            PG8_BAR; PG8_WAIT_L(0); PG8_MMA(1, 0, At, B0); PG8_BAR; PG8_SCHED;
            PG8_STAGE(PG8_SB(0, 1), b2 + hstep, voffB);
            PG8_WAIT_V(6); PG8_BAR; PG8_MMA(1, 1, At, B1); PG8_BAR;
            PG8_LDB(B0, 1, 0); PG8_SCHED; PG8_LDA(At, 1, 0); PG8_STAGE(PG8_SA(0, 1), a2 + hstep, voffA);
            PG8_WAIT_L(8); PG8_BAR; PG8_WAIT_L(0); PG8_MMA(0, 0, At, B0); PG8_BAR; PG8_SCHED;
            PG8_LDB(B1, 1, 1); PG8_STAGE(PG8_SB(1, 0), b3, voffB);
            PG8_BAR; PG8_WAIT_L(0); PG8_MMA(0, 1, At, B1); PG8_BAR;
            PG8_LDA(At, 1, 1); PG8_STAGE(PG8_SA(1, 0), a3, voffA);
            PG8_BAR; PG8_WAIT_L(0); PG8_MMA(1, 0, At, B0); PG8_BAR; PG8_SCHED;
            PG8_STAGE(PG8_SB(1, 1), b3 + hstep, voffB);
            PG8_WAIT_V(6); PG8_BAR; PG8_MMA(1, 1, At, B1); PG8_BAR;
            }
        }
        if constexpr (ALIGN_EPI) { if (wr == 0) PG8_BAR; }
        if constexpr (!Epi::AFTER_DRAIN) { E(acc, cur, wr, wc, fr, fq); S.done(cur); }
        if (!has_next) break;
#pragma unroll
        for (int a = 0; a < 2; ++a)
#pragma unroll
            for (int b = 0; b < 2; ++b)
#pragma unroll
                for (int m = 0; m < 4; ++m)
#pragma unroll
                    for (int n = 0; n < 2; ++n) acc[a][b][m][n] = (f32x4){0.f, 0.f, 0.f, 0.f};
        cur = nxt; cA = nA; cB = nB; ++ui;
        if constexpr (ALIGN_EPI) { if (wr == 1) PG8_BAR; }
    }
    PG8_WAIT_V(0);
    if constexpr (!ALIGN_EPI) { if (wr == 0) PG8_BAR; }
    PG8_BAR;
    if constexpr (Epi::AFTER_DRAIN) { E.fused(acc, cur, wr, wc, fr, fq, lds, wid, lane); S.done(cur); }
#undef PG8_SA
#undef PG8_SB
#undef PG8_STAGE
#undef PG8_LDA
#undef PG8_LDB
#undef PG8_MMA
#undef PG8_WAIT_V
#undef PG8_WAIT_L
#undef PG8_BAR
#undef PG8_SCHED
}
}
constexpr int NWAVES = 8;
constexpr int BATCH = 4, SEQ = 8192, D = 2048, M = BATCH * SEQ, NIN = 4096, LW = 1024, CHUNK = 128, NCHUNK = SEQ / CHUNK;
constexpr int NEXP = 16384;
#ifndef MK_N_LAUNCHES
#define MK_N_LAUNCHES 1
#endif
constexpr int N_LAUNCHES = MK_N_LAUNCHES;
constexpr int PER_PHASE = 11;
constexpr size_t MiB = 1u << 20;
constexpr size_t WS_CTL = 0, CTL_ZERO_BYTES = 1 * MiB;
constexpr size_t WS_ROWSS = 512 * 1024;
constexpr size_t WS_WIN = 2 * MiB, WS_WOUT = 18 * MiB, WS_WQ = 26 * MiB, WS_LRUW = 34 * MiB, WS_WSB = 35 * MiB, WS_AGG = 36 * MiB;
constexpr size_t WS_U = 64 * MiB, WS_V = 128 * MiB, WS_XN = 192 * MiB  , WS_Z = 320 * MiB  ;
constexpr size_t WS_HB = 576 * MiB, WS_IDS = 704 * MiB, WS_GATES = 720 * MiB, WS_PAIRS = 736 * MiB, WS_HBT = 752 * MiB, WS_END = 884 * MiB;
constexpr size_t WS_USCALE = 40 * MiB, WS_VSCALE = 41 * MiB;
constexpr size_t WS_HSCALE = 44 * MiB, WS_CARRY = 45 * MiB;
constexpr size_t WS_H8 = WS_XN, WS_PART = WS_XN + 64 * MiB;
constexpr size_t WS_ASCALE = 42 * MiB, WS_KH = 43 * MiB;
constexpr size_t WS_IDW = WS_PAIRS, WS_AW = 880 * MiB;
constexpr size_t WS_ROWSS2 = 640 * 1024;
constexpr size_t WS_Y = WS_Z;
constexpr int CW_BAR = 4096;
constexpr int RING_BYTES = 131072;
constexpr int LDSCTL_OFF = 143360, MISC_OFF = LDSCTL_OFF + 320;
constexpr int LDS_BYTES = 147456;
#define GAS __attribute__((address_space(1)))
#define LAS __attribute__((address_space(3)))
typedef unsigned short bf16;
typedef unsigned v4u __attribute__((ext_vector_type(4)));
typedef float f32x4 __attribute__((ext_vector_type(4)));
typedef short bf16x8 __attribute__((ext_vector_type(8)));
typedef GAS unsigned gu32;
typedef GAS unsigned long long gu64;
#define RLX_AGENT __ATOMIC_RELAXED, __HIP_MEMORY_SCOPE_AGENT
#define LDS_WAIT() asm volatile("s_waitcnt lgkmcnt(0)" ::: "memory")
#define VM_WAIT() asm volatile("s_waitcnt vmcnt(0)" ::: "memory")
__device__ __forceinline__ unsigned long long rt() { return __builtin_amdgcn_s_memrealtime(); }
__device__ __forceinline__ unsigned f2bf(float f) { unsigned u = __builtin_bit_cast(unsigned, f); return (u + 0x7fffu + ((u >> 16) & 1u)) >> 16; }
__device__ __forceinline__ unsigned pk2(float lo, float hi) { return f2bf(lo) | (f2bf(hi) << 16); }

#define XB_TMO      128
#define XB_XCNT(j)  (256  + 64 * (j))
#define XB_XSUB(j)  (1280 + 64 * (j))
#define XB_XGEN(j)  (2304 + 64 * (j))
#define XB_TOP      3328
#define XB_TOPGEN   3392
#define XCD_BAR_WORDS 3456
#define XB_SPIN_CAP (1u << 18)

__device__ __forceinline__ unsigned xb_ld(unsigned* p)              { return __hip_atomic_load(p, __ATOMIC_RELAXED, __HIP_MEMORY_SCOPE_AGENT); }
__device__ __forceinline__ unsigned xb_add(unsigned* p, unsigned v) { return __hip_atomic_fetch_add(p, v, __ATOMIC_RELAXED, __HIP_MEMORY_SCOPE_AGENT); }
__device__ __forceinline__ unsigned xb_xcc_id() { return (unsigned)__builtin_amdgcn_s_getreg((3 << 11) | 20) & 0xFu; }
#define XB_SPIN(cond, bar) do { unsigned _sp = 0; while (cond) { __builtin_amdgcn_s_sleep(1); \
    if ((++_sp & 255u) == 0u) { if (xb_ld(&(bar)[XB_TMO])) break; if (_sp > XB_SPIN_CAP) { atomicAdd(&(bar)[XB_TMO], 1u); break; } } } } while (0)

struct XcdBarrier {
    unsigned* bar; unsigned x;
    volatile LAS unsigned* st;
};

__device__ __forceinline__ XcdBarrier xcd_barrier_post(unsigned* bar, volatile LAS unsigned* st) {
    XcdBarrier b; b.bar = bar; b.x = xb_xcc_id(); b.st = st;
    if (threadIdx.x == 0) (void)xb_add(&bar[XB_XCNT(b.x)], 1u);
    return b;
}
__device__ __forceinline__ void xcd_barrier_complete(unsigned* bar, unsigned x, unsigned& nloc, unsigned& nx) {
    const unsigned G = gridDim.x * gridDim.y * gridDim.z;
    unsigned sum, cnt, mine, sp = 0u;
    for (;;) {
        sum = 0u; cnt = 0u; mine = 0u;
#pragma unroll
        for (unsigned j = 0; j < 16; ++j) { const unsigned c = xb_ld(&bar[XB_XCNT(j)]); sum += c; cnt += (c > 0u) ? 1u : 0u; mine = (j == x) ? c : mine; }
        if (sum == G) break;
        __builtin_amdgcn_s_sleep(1);
        if ((++sp & 255u) == 0u) { if (xb_ld(&bar[XB_TMO])) break; if (sp > XB_SPIN_CAP) { atomicAdd(&bar[XB_TMO], 1u); break; } }
    }
    nloc = mine > 0u ? mine : 1u; nx = cnt > 0u ? cnt : 1u;
}

__device__ __forceinline__ void xcd_barrier(const XcdBarrier& b) {
    asm volatile("s_waitcnt vmcnt(0)" ::: "memory");
    __syncthreads();
    if (threadIdx.x == 0) {
        unsigned* bar = b.bar;
        __builtin_amdgcn_s_waitcnt(0);
        unsigned nloc = b.st[0], nx = b.st[1];
        if (nloc == 0u) { xcd_barrier_complete(bar, b.x, nloc, nx); b.st[0] = nloc; b.st[1] = nx; }
        const unsigned old = xb_add(&bar[XB_XSUB(b.x)], 1u);
        const unsigned gen = old / nloc;
        if (old + 1u == (gen + 1u) * nloc) {
            __builtin_amdgcn_fence(__ATOMIC_RELEASE, "agent");
            asm volatile("s_waitcnt vmcnt(0)" ::: "memory");
            const unsigned og = xb_add(&bar[XB_TOP], 1u);
            const unsigned tg = og / nx;
            if (og + 1u == (tg + 1u) * nx) xb_add(&bar[XB_TOPGEN], 1u);
            else XB_SPIN(xb_ld(&bar[XB_TOPGEN]) == tg, bar);
            __builtin_amdgcn_fence(__ATOMIC_ACQUIRE, "agent");
            xb_add(&bar[XB_XGEN(b.x)], 1u);
            asm volatile("s_waitcnt vmcnt(0)" ::: "memory");
        } else {
            XB_SPIN(xb_ld(&bar[XB_XGEN(b.x)]) == gen, bar);
            __builtin_amdgcn_fence(__ATOMIC_ACQUIRE, "agent");
            asm volatile("s_waitcnt vmcnt(0)" ::: "memory");
        }
    }
    __syncthreads();
}
typedef unsigned v2u __attribute__((ext_vector_type(2)));
typedef float f32x2 __attribute__((ext_vector_type(2)));
struct Args { const float* in[21]; float* out; unsigned char* ws; int ph_lo, ph_hi; };
struct Frame {
    const Args& A;
    LAS unsigned char* lds;
    volatile LAS unsigned* MISC;
    gu32* ctl;
    unsigned char* ws;
    int tid, lane, wave, vcu, G;
    __device__ __forceinline__ Frame(const Args& a) : A(a) {}
#define WSP(name, type, off) __device__ __forceinline__ type* name() const { return (type*)(ws + (off)); }
    WSP(WIN, bf16, WS_WIN) WSP(WOUT, bf16, WS_WOUT) WSP(WQ, bf16, WS_WQ) WSP(LRUW, bf16, WS_LRUW) WSP(WSB, bf16, WS_WSB)
    WSP(XN, bf16, WS_XN) WSP(MIX, bf16, WS_XN) WSP(Z, bf16, WS_Z) WSP(HB, bf16, WS_HB) WSP(HBT, bf16, WS_HBT)
    WSP(U8, unsigned char, WS_U) WSP(V8T, unsigned char, WS_V)
    WSP(ROWSS, float, WS_ROWSS) WSP(ROWSS2, float, WS_ROWSS2) WSP(QH, bf16, WS_Z) WSP(QL, bf16, WS_Z + 128 * MiB) WSP(KH, bf16, WS_KH) WSP(KL, bf16, WS_KH + 512 * 1024) WSP(AGG, float, WS_AGG) WSP(CARRY, float, WS_CARRY) WSP(GATES, float, WS_GATES)
    WSP(USCALE, float, WS_USCALE) WSP(VSCALE, float, WS_VSCALE) WSP(Y, bf16, WS_Y) WSP(IDS, int, WS_IDS) WSP(ASCALE, float, WS_ASCALE) WSP(IDW, v4u, WS_IDW) WSP(AW, unsigned, WS_AW) WSP(H8, unsigned char, WS_H8) WSP(HSCALE, float, WS_HSCALE) WSP(PART, int, WS_PART)
#undef WSP
};
__device__ __forceinline__ float wave_sum(float v) {
#pragma unroll
    for (int o = 1; o < 64; o <<= 1) v += __shfl_xor(v, o);
    return v;
}
__device__ __forceinline__ float bf_lo(unsigned w) { return __builtin_bit_cast(float, w << 16); }
__device__ __forceinline__ float bf_hi(unsigned w) { return __builtin_bit_cast(float, w & 0xffff0000u); }
__device__ __forceinline__ float bf1(unsigned short h) { return __builtin_bit_cast(float, (unsigned)h << 16); }
__device__ __forceinline__ float sigmoidf_(float x) { return __builtin_amdgcn_rcpf(1.0f + __builtin_amdgcn_exp2f(-1.4426950409f * x)); }
using pg8::gelu_tanh;
__device__ __forceinline__ unsigned pack_i8x4(float a, float b, float c, float d) {
    const int ia = (int)__builtin_rintf(a), ib = (int)__builtin_rintf(b), ic = (int)__builtin_rintf(c), id = (int)__builtin_rintf(d);
    return (unsigned)(ia & 0xff) | ((unsigned)(ib & 0xff) << 8) | ((unsigned)(ic & 0xff) << 16) | ((unsigned)id << 24);
}

__device__ __forceinline__ void p0_transpose_item(const float* W, int K, int N, bf16* WT, const float* kscale, LAS float* scr, int item, int lane) {
    const int nblk = N / 32, kb = item / nblk, nb = item % nblk, k0 = 64 * kb, n0 = 32 * nb;
#pragma unroll 8
    for (int i = 0; i < 32; ++i) { const int kk = 2 * i + (lane >> 5); const float sc = kscale ? kscale[k0 + kk] : 1.0f; scr[kk * 33 + (lane & 31)] = W[(size_t)(k0 + kk) * N + n0 + (lane & 31)] * sc; }
    LDS_WAIT(); asm volatile("" ::: "memory");
    const int c = lane & 7;
#pragma unroll
    for (int j = 0; j < 4; ++j) { const int n = (lane >> 3) + 8 * j; const LAS float* s = scr + (8 * c) * 33 + n;
        v4u o; o.x = pk2(s[0 * 33], s[1 * 33]); o.y = pk2(s[2 * 33], s[3 * 33]); o.z = pk2(s[4 * 33], s[5 * 33]); o.w = pk2(s[6 * 33], s[7 * 33]);
        *(GAS v4u*)(WT + (size_t)(n0 + n) * K + k0 + 8 * c) = o; }
    LDS_WAIT(); asm volatile("" ::: "memory");
}
__device__ __forceinline__ void p0_prologue(Frame& F) {
    LAS float* scr = (LAS float*)(F.lds + F.wave * 16384);
    const int gw = F.vcu * NWAVES + F.wave, NGW = F.G * NWAVES, lane = F.lane;
    constexpr int I_IN = (D / 64) * (NIN / 32), I_OUT = (D / 64) * (D / 32), I_Q = I_OUT, I_LRU = 32 * 8;
    constexpr int NITEMS = I_IN + I_OUT + I_Q + I_LRU;
    for (int it = gw; it < NITEMS; it += NGW) {
        int r = it;
        if (r < I_IN) { p0_transpose_item(F.A.in[2], D, NIN, F.WIN(), F.A.in[1], scr, r, lane); continue; } r -= I_IN;
        if (r < I_OUT) { p0_transpose_item(F.A.in[14], D, D, F.WOUT(), nullptr, scr, r, lane); continue; } r -= I_OUT;
        if (r < I_Q) { p0_transpose_item(F.A.in[16], D, D, F.WQ(), F.A.in[15], scr, r, lane); continue; } r -= I_Q;
        { const int mi = r >> 3, sub = r & 7, gate = mi >> 4, rest = mi & 15;
          const float* src = (gate ? F.A.in[7] : F.A.in[5]) + (size_t)rest * 16384;
          p0_transpose_item(src, 128, 128, F.LRUW() + (size_t)mi * 16384, nullptr, scr, sub, lane); }
    }
    const size_t gt = (size_t)gw * 64 + lane, NGT = (size_t)NGW * 64;
    {
        const float* g2 = F.A.in[15];
        f32x4 gg[8];
#pragma unroll
        for (int j = 0; j < 8; ++j) gg[j] = *(const GAS f32x4*)(g2 + j * 256 + lane * 4);
        for (int e = gw; e < NEXP; e += NGW) {
            const GAS f32x4* ur = (const GAS f32x4*)(F.A.in[18] + (size_t)e * D) + lane;
            f32x4 v[8]; float ss = 0.f;
#pragma unroll
            for (int j = 0; j < 8; ++j) { v[j] = ur[64 * j] * gg[j]; ss += (v[j].x * v[j].x + v[j].y * v[j].y) + (v[j].z * v[j].z + v[j].w * v[j].w); }
            const float rms = __builtin_amdgcn_sqrtf(wave_sum(ss) * (1.0f / D));
            const float sc = rms > 0.f ? 7.0f / (2.8f * rms) : 1.0f;
            GAS unsigned* o4 = (GAS unsigned*)(F.U8() + (size_t)e * 1024) + (lane >> 1);
#pragma unroll
            for (int j = 0; j < 8; ++j) {
                const float c0 = fminf(fmaxf(__builtin_rintf(v[j].x * sc), -7.f), 7.f) + 8.f, c1 = fminf(fmaxf(__builtin_rintf(v[j].y * sc), -7.f), 7.f) + 8.f;
                const float c2 = fminf(fmaxf(__builtin_rintf(v[j].z * sc), -7.f), 7.f) + 8.f, c3 = fminf(fmaxf(__builtin_rintf(v[j].w * sc), -7.f), 7.f) + 8.f;
                const unsigned cw = (unsigned)c0 | ((unsigned)c1 << 8) | ((unsigned)c2 << 16) | ((unsigned)c3 << 24);
                const unsigned pw = (unsigned)__shfl_xor((int)cw, 1);
                if ((lane & 1) == 0) o4[32 * j] = cw | (pw << 4);
            }
            if (lane == 0) F.USCALE()[e] = rms > 0.f ? 2.8f * rms * (1.0f / 7.0f) : 1.0f;
        }
    }
    __syncthreads();
    for (int un = blockIdx.x; un < NEXP / 64; un += F.G) {
        const int e0 = un * 64;
        for (int rr = 0; rr < 8; ++rr) {
            const int el = F.wave * 8 + rr, e = e0 + el;
            const GAS f32x4* vr = (const GAS f32x4*)(F.A.in[19] + (size_t)e * D) + lane;
            f32x4 v[8]; float mx = 0.f;
#pragma unroll
            for (int j = 0; j < 8; ++j) { v[j] = vr[64 * j]; mx = fmaxf(mx, fmaxf(fmaxf(fabsf(v[j].x), fabsf(v[j].y)), fmaxf(fabsf(v[j].z), fabsf(v[j].w)))); }
#pragma unroll
            for (int o = 1; o < 64; o <<= 1) mx = fmaxf(mx, __shfl_xor(mx, o));
            const float sc = mx > 0.f ? 127.0f / mx : 1.0f;
#pragma unroll
            for (int j = 0; j < 8; ++j) *(LAS unsigned*)(F.lds + el * 2056 + j * 256 + lane * 4) = pack_i8x4(v[j].x * sc, v[j].y * sc, v[j].z * sc, v[j].w * sc);
            if (lane == 0) F.VSCALE()[e] = mx > 0.f ? mx * (1.0f / 127.0f) : 1.0f;
        }
        __syncthreads();
        for (int cc = 0; cc < 32; ++cc) { const int c = F.wave * 32 + cc;
            const v2u w = *(const LAS v2u*)(F.lds + lane * 2056 + c * 8);
            *(GAS v2u*)(F.V8T() + ((size_t)c * NEXP + e0 + lane) * 8) = w; }
        __syncthreads();
    }
    for (size_t ch = gt; ch < (size_t)8 * 128 * 128 / 8; ch += NGT) {
        const size_t e0 = ch * 8;
        const f32x4 a = *(const GAS f32x4*)(F.A.in[12] + e0), b = *(const GAS f32x4*)(F.A.in[12] + e0 + 4);
        v4u o; o.x = pk2(a.x, a.y); o.y = pk2(a.z, a.w); o.z = pk2(b.x, b.y); o.w = pk2(b.z, b.w);
        *(GAS v4u*)(F.WSB() + e0) = o;
    }
    for (size_t ch = gt; ch < (size_t)16 * 128 * 128 / 8; ch += NGT) {
        const size_t e0 = ch * 8;
        const f32x4 a = *(const GAS f32x4*)(F.A.in[17] + e0), b = *(const GAS f32x4*)(F.A.in[17] + e0 + 4);
        v4u hi; hi.x = pk2(a.x, a.y); hi.y = pk2(a.z, a.w); hi.z = pk2(b.x, b.y); hi.w = pk2(b.z, b.w);
        *(GAS v4u*)(F.KH() + e0) = hi;
    }
    for (int m = gw; m < M; m += NGW) {
        const GAS f32x4* xr = (const GAS f32x4*)(F.A.in[0] + (size_t)m * D) + lane;
        f32x4 v[8]; float s = 0.f;
#pragma unroll
        for (int j = 0; j < 8; ++j) { v[j] = xr[64 * j]; s += (v[j].x * v[j].x + v[j].y * v[j].y) + (v[j].z * v[j].z + v[j].w * v[j].w); }
        const float rstd = __builtin_amdgcn_rsqf(wave_sum(s) * (1.f / D) + 1e-6f);
        GAS unsigned long long* o8 = (GAS unsigned long long*)(F.XN() + (size_t)m * D) + lane;
#pragma unroll
        for (int j = 0; j < 8; ++j) o8[64 * j] = (unsigned long long)pk2(v[j].x * rstd, v[j].y * rstd) | ((unsigned long long)pk2(v[j].z * rstd, v[j].w * rstd) << 32);
    }
}
constexpr int LRU_XR = 0, LRU_XC = 33792, LRU_GR = 33792 + 40960;
constexpr float LOG2E = 1.4426950408889634f;
__device__ __forceinline__ int xc_off(int tok, int ch) { return tok * 320 + (tok >> 5) * 16 + ch * 2; }
template <bool APPLY, int DIR>
__device__ __forceinline__ void lru_dir(Frame& F, int b, int c, int h, const bf16x8 (&Ba)[4], const bf16x8 (&Bx)[4], float (&hsum)[8][4]) {
    const int lane = F.lane, w = F.wave, fr = lane & 15, fq = lane >> 4;
    LAS unsigned char* XC = F.lds + LRU_XC;
    const int chl = 16 * w + fr, chg = h * 128 + chl;
    const float ba = F.A.in[6][DIR * LW + chg], bx = F.A.in[8][DIR * LW + chg], lam = F.A.in[9][DIR * LW + chg];
    const float cl = -8.0f * log1pf(__expf(-lam)) * LOG2E;
    float carry = 0.f;
    if (APPLY) carry = F.CARRY()[(size_t)((b * 2 + DIR) * NCHUNK + c) * LW + chg];
    f32x4 R[8], I[8];
    const int arow = (fr >> 2) * 32 + (fr & 3);
#pragma unroll
    for (int m = 0; m < 8; ++m) {
        R[m] = (f32x4){0.f, 0.f, 0.f, 0.f}; I[m] = (f32x4){0.f, 0.f, 0.f, 0.f};
#pragma unroll
        for (int ks = 0; ks < 4; ++ks) {
            const bf16x8 a = *(const LAS bf16x8*)(XC + xc_off(arow + 4 * m, 32 * ks + 8 * fq));
            R[m] = __builtin_amdgcn_mfma_f32_16x16x32_bf16(a, Ba[ks], R[m], 0, 0, 0);
            I[m] = __builtin_amdgcn_mfma_f32_16x16x32_bf16(a, Bx[ks], I[m], 0, 0, 0);
        }
    }
    float P = 1.f, L = 0.f;
#pragma unroll
    for (int mm = 0; mm < 8; ++mm) {
        const int m = DIR == 0 ? mm : 7 - mm;
#pragma unroll
        for (int jj = 0; jj < 4; ++jj) {
            const int j = DIR == 0 ? jj : 3 - jj;
            const float r = sigmoidf_(R[m][j] + ba), ig = sigmoidf_(I[m][j] + bx);
            const float a = __builtin_amdgcn_exp2f(cl * r);
            const float xc = bf1(*(const LAS unsigned short*)(XC + xc_off(32 * fq + 4 * m + j, chl)));
            const float u = __builtin_amdgcn_sqrtf(fmaxf(1.0f - a * a, 0.0f)) * (ig * xc);
            L = a * L + u; P = a * P;
            R[m][j] = P; I[m][j] = L;
        }
    }
    const int src1 = DIR == 0 ? lane - 16 : lane + 16, src2 = DIR == 0 ? lane - 32 : lane + 32;
    const bool v1 = DIR == 0 ? (fq >= 1) : (fq <= 2), v2 = DIR == 0 ? (fq >= 2) : (fq <= 1);
    float A = P, B = L;
    { const float pa = __shfl(A, src1), pb = __shfl(B, src1); if (v1) { B = A * pb + B; A = A * pa; } }
    { const float pa = __shfl(A, src2), pb = __shfl(B, src2); if (v2) { B = A * pb + B; A = A * pa; } }
    if (APPLY) {
        float EA = __shfl(A, src1), EB = __shfl(B, src1); if (!v1) { EA = 1.f; EB = 0.f; }
        const float hin = EA * carry + EB;
#pragma unroll
        for (int m = 0; m < 8; ++m)
#pragma unroll
            for (int j = 0; j < 4; ++j) { const float hh = R[m][j] * hin + I[m][j]; if (DIR == 0) hsum[m][j] = hh; else hsum[m][j] += hh; }
    } else {
        const bool lastlane = DIR == 0 ? (fq == 3) : (fq == 0);
        if (lastlane) { f32x2* agg = (f32x2*)F.AGG() + (size_t)((b * 2 + DIR) * NCHUNK + c) * LW + chg; *agg = (f32x2){A, B}; }
    }
}

template <bool APPLY>
__device__ __forceinline__ void lru_unit(Frame& F, int unit) {
    const int h = unit & 7, c = (unit >> 3) & 63, b = unit >> 9;
    const int tid = F.tid, lane = F.lane, w = F.wave, fr = lane & 15, fq = lane >> 4;
    const size_t t0 = (size_t)b * SEQ + (size_t)c * CHUNK;
    LAS unsigned char* XR = F.lds + LRU_XR; LAS unsigned char* XC = F.lds + LRU_XC; LAS unsigned char* GR = F.lds + LRU_GR;
    bf16x8 Ba0[4], Bx0[4], Ba1[4], Bx1[4];
    {
        const bf16* wb = F.LRUW() + (size_t)h * 16384 + (size_t)(16 * w + fr) * 128 + 8 * fq;
#pragma unroll
        for (int ks = 0; ks < 4; ++ks) { Ba0[ks] = *(const GAS bf16x8*)(wb + 32 * ks); Ba1[ks] = *(const GAS bf16x8*)(wb + (size_t)8 * 16384 + 32 * ks);
            Bx0[ks] = *(const GAS bf16x8*)(wb + (size_t)16 * 16384 + 32 * ks); Bx1[ks] = *(const GAS bf16x8*)(wb + (size_t)24 * 16384 + 32 * ks); }
    }
    for (int p = tid; p < 131 * 16; p += 512) { const int r = p >> 4, cg = p & 15; const int s = c * CHUNK - 2 + r; v4u v = (v4u){0u, 0u, 0u, 0u};
        if (s >= 0 && s < SEQ) v = *(const GAS v4u*)(F.Z() + ((size_t)b * SEQ + s) * NIN + h * 128 + cg * 8);
        *(LAS v4u*)(XR + r * 256 + cg * 16) = v; }
    if (APPLY) { for (int p = tid; p < 128 * 32; p += 512) { const int r = p >> 5, cg = p & 31;
        *(LAS v2u*)(GR + r * 264 + cg * 8) = *(const GAS v2u*)(F.Z() + (t0 + r) * NIN + LW + h * 128 + cg * 4); } }
    __syncthreads();
    {
        const int ch2 = tid & 63, tg = tid >> 6, chg = h * 128 + 2 * ch2;
        float w0[4], w1[4];
#pragma unroll
        for (int k = 0; k < 4; ++k) { w0[k] = F.A.in[3][k * LW + chg]; w1[k] = F.A.in[3][k * LW + chg + 1]; }
        const float b0 = F.A.in[4][chg], b1 = F.A.in[4][chg + 1];
        float x0[4], x1[4];
#pragma unroll
        for (int k = 0; k < 3; ++k) { const unsigned u = *(const LAS unsigned*)(XR + (16 * tg + k) * 256 + ch2 * 4); x0[k] = bf_lo(u); x1[k] = bf_hi(u); }
#pragma unroll
        for (int j = 0; j < 16; ++j) {
            const unsigned u = *(const LAS unsigned*)(XR + (16 * tg + j + 3) * 256 + ch2 * 4); x0[3] = bf_lo(u); x1[3] = bf_hi(u);
            const float y0 = b0 + ((w0[0] * x0[0] + w0[1] * x0[1]) + (w0[2] * x0[2] + w0[3] * x0[3]));
            const float y1 = b1 + ((w1[0] * x1[0] + w1[1] * x1[1]) + (w1[2] * x1[2] + w1[3] * x1[3]));
            *(LAS unsigned*)(XC + xc_off(16 * tg + j, 2 * ch2)) = pk2(y0, y1);
            x0[0] = x0[1]; x0[1] = x0[2]; x0[2] = x0[3]; x1[0] = x1[1]; x1[1] = x1[2]; x1[2] = x1[3];
        }
    }
    __syncthreads();
    float hsum[8][4];
    lru_dir<APPLY, 0>(F, b, c, h, Ba0, Bx0, hsum);
    asm volatile("" ::: "memory"); __builtin_amdgcn_sched_barrier(0);
    lru_dir<APPLY, 1>(F, b, c, h, Ba1, Bx1, hsum);
    if (APPLY) {
        const int chl = 16 * w + fr;
#pragma unroll
        for (int m = 0; m < 8; ++m)
#pragma unroll
            for (int j = 0; j < 4; ++j) { LAS unsigned short* p = (LAS unsigned short*)(GR + (32 * fq + 4 * m + j) * 264 + chl * 2); *p = (unsigned short)f2bf(bf1(*p) * hsum[m][j]); }
        __syncthreads();
        for (int p = tid; p < 128 * 32; p += 512) { const int r = p >> 5, cg = p & 31;
            *(GAS v2u*)(F.MIX() + (t0 + r) * D + h * 128 + cg * 4) = *(const LAS v2u*)(GR + r * 264 + cg * 8); }
    }
    __syncthreads();
}
__device__ __forceinline__ void lru_carry(Frame& F) {
    const int idx = (F.vcu * NWAVES + F.wave) * 64 + F.lane;
    if (idx >= BATCH * 2 * LW) return;
    const int ch = idx & (LW - 1), bd = idx >> 10, dir = bd & 1;
    const f32x2* agg = (const f32x2*)F.AGG() + (size_t)bd * NCHUNK * LW + ch; float* cr = F.CARRY() + (size_t)bd * NCHUNK * LW + ch;
    float st = 0.f;
#pragma unroll 8
    for (int i = 0; i < NCHUNK; ++i) { const int cc = dir == 0 ? i : NCHUNK - 1 - i; const f32x2 pe = agg[(size_t)cc * LW]; cr[(size_t)cc * LW] = st; st = pe.x * st + pe.y; }
}
constexpr int GM_ST = 0, GM_BS = 1024, GM_VN = 2048, GM_GU = 2048 + 32768;
typedef short s16x4 __attribute__((ext_vector_type(4)));
__device__ __forceinline__ unsigned vn_off(unsigned row, unsigned ch) { return 256u * row + 16u * (ch ^ (((row & 3u) << 2) | ((row >> 2) & 3u))); }
__device__ __forceinline__ void gmlp_unit(Frame& F, int unit) {
    const int tid = F.tid, lane = F.lane, w = F.wave, fr = lane & 15, fq = lane >> 4;
    const size_t t0 = (size_t)unit * CHUNK;
    LAS float* ST = (LAS float*)(F.lds + GM_ST); LAS float* BS = (LAS float*)(F.lds + GM_BS);
    LAS unsigned char* VN = F.lds + GM_VN; LAS unsigned char* GU = F.lds + GM_GU;
    for (int rr = 0; rr < 16; ++rr) {
        const int row = 16 * w + rr;
        const bf16* p = F.Z() + (t0 + row) * NIN + 3 * LW + lane * 8;
        const v4u a = *(const GAS v4u*)p, b = *(const GAS v4u*)(p + 512);
        float x[16] = {bf_lo(a.x), bf_hi(a.x), bf_lo(a.y), bf_hi(a.y), bf_lo(a.z), bf_hi(a.z), bf_lo(a.w), bf_hi(a.w),
                       bf_lo(b.x), bf_hi(b.x), bf_lo(b.y), bf_hi(b.y), bf_lo(b.z), bf_hi(b.z), bf_lo(b.w), bf_hi(b.w)};
        float s = 0.f;
#pragma unroll
        for (int i = 0; i < 16; ++i) s += x[i];
        const float mean = wave_sum(s) * (1.0f / LW);
        float q = 0.f;
#pragma unroll
        for (int i = 0; i < 16; ++i) { const float d = x[i] - mean; q += d * d; }
        const float rstd = __builtin_amdgcn_rsqf(wave_sum(q) * (1.0f / LW) + 1e-6f);
        if (lane == 0) { ST[2 * row] = mean; ST[2 * row + 1] = rstd; }
    }
    __syncthreads();
    const unsigned trq = (unsigned)(lane & 15) >> 2, trp = (unsigned)lane & 3u;
    for (int h = 0; h < 8; ++h) {
#pragma unroll
        for (int i = 0; i < 4; ++i) { const int pid = tid + 512 * i, q = pid >> 4, cg = pid & 15;
            const v4u a = *(const GAS v4u*)(F.Z() + (t0 + q) * NIN + 3 * LW + h * 128 + cg * 8);
            const float mean = ST[2 * q], rstd = ST[2 * q + 1];
            const f32x4 g0 = *(const GAS f32x4*)(F.A.in[10] + h * 128 + cg * 8), g1 = *(const GAS f32x4*)(F.A.in[10] + h * 128 + cg * 8 + 4);
            const f32x4 b0 = *(const GAS f32x4*)(F.A.in[11] + h * 128 + cg * 8), b1 = *(const GAS f32x4*)(F.A.in[11] + h * 128 + cg * 8 + 4);
            v4u o;
            o.x = pk2((bf_lo(a.x) - mean) * rstd * g0.x + b0.x, (bf_hi(a.x) - mean) * rstd * g0.y + b0.y);
            o.y = pk2((bf_lo(a.y) - mean) * rstd * g0.z + b0.z, (bf_hi(a.y) - mean) * rstd * g0.w + b0.w);
            o.z = pk2((bf_lo(a.z) - mean) * rstd * g1.x + b1.x, (bf_hi(a.z) - mean) * rstd * g1.y + b1.y);
            o.w = pk2((bf_lo(a.w) - mean) * rstd * g1.z + b1.z, (bf_hi(a.w) - mean) * rstd * g1.w + b1.w);
            *(LAS v4u*)(VN + vn_off((unsigned)q, (unsigned)cg)) = o;
        }
#pragma unroll
        for (int i = 0; i < 8; ++i) { const int pid = tid + 512 * i, r = pid >> 5, cg = pid & 31;
            *(LAS v2u*)(GU + r * 264 + cg * 8) = *(const GAS v2u*)(F.Z() + (t0 + r) * NIN + 2 * LW + h * 128 + cg * 4); }
        if (tid < 128) BS[tid] = F.A.in[13][h * 128 + tid];
        bf16x8 Af[4];
        { const bf16* wsb = F.WSB() + (size_t)h * 16384 + (size_t)(16 * w + fr) * 128 + 8 * fq;
#pragma unroll
          for (int ks = 0; ks < 4; ++ks) Af[ks] = *(const GAS bf16x8*)(wsb + 32 * ks); }
        __syncthreads();
        f32x4 acc[8];
#pragma unroll
        for (int n = 0; n < 8; ++n) {
            acc[n] = (f32x4){0.f, 0.f, 0.f, 0.f};
#pragma unroll
            for (int ks = 0; ks < 4; ++ks) {
                const s16x4 b0 = __builtin_amdgcn_ds_read_tr16_b64_v4i16((LAS s16x4*)(VN + vn_off(32u * ks + 8u * fq + trq, 2u * n + (trp >> 1)) + 8u * (trp & 1u)));
                const s16x4 b1 = __builtin_amdgcn_ds_read_tr16_b64_v4i16((LAS s16x4*)(VN + vn_off(32u * ks + 8u * fq + 4u + trq, 2u * n + (trp >> 1)) + 8u * (trp & 1u)));
                const bf16x8 bb = (bf16x8){b0[0], b0[1], b0[2], b0[3], b1[0], b1[1], b1[2], b1[3]};
                acc[n] = __builtin_amdgcn_mfma_f32_16x16x32_bf16(Af[ks], bb, acc[n], 0, 0, 0);
            }
        }
#pragma unroll
        for (int n = 0; n < 8; ++n)
#pragma unroll
            for (int j = 0; j < 4; ++j) { const int p = 16 * w + 4 * fq + j; LAS unsigned short* ad = (LAS unsigned short*)(GU + p * 264 + (16 * n + fr) * 2);
                *ad = (unsigned short)f2bf(bf1(*ad) * (acc[n][j] + BS[p])); }
        __syncthreads();
#pragma unroll
        for (int i = 0; i < 8; ++i) { const int pid = tid + 512 * i, r = pid >> 5, cg = pid & 31;
            *(GAS v2u*)(F.MIX() + (t0 + r) * D + LW + h * 128 + cg * 4) = *(const LAS v2u*)(GU + r * 264 + cg * 8); }
        __syncthreads();
    }
}
typedef float f32x16 __attribute__((ext_vector_type(16)));
__device__ __forceinline__ unsigned fkey(float f) { const int u = __builtin_bit_cast(int, f); return (unsigned)(u ^ ((u >> 31) & 0x7fffffff)); }
__device__ __forceinline__ float fkey_inv(unsigned k) { const int u = (int)k; return __builtin_bit_cast(float, u ^ ((u >> 31) & 0x7fffffff)); }
__device__ __forceinline__ unsigned umax_(unsigned a, unsigned b) { return (int)a > (int)b ? a : b; }
__device__ __forceinline__ unsigned umin_(unsigned a, unsigned b) { return (int)a < (int)b ? a : b; }
#define CE_DESC(x, y) do { const unsigned a_ = (x), b_ = (y); (x) = umax_(a_, b_); (y) = umin_(a_, b_); } while (0)
__device__ __forceinline__ void sort16_desc(unsigned (&a)[16]) {
#pragma unroll
    for (int k = 2; k <= 16; k <<= 1)
#pragma unroll
        for (int j = k >> 1; j >= 1; j >>= 1)
#pragma unroll
            for (int i = 0; i < 16; ++i) { const int l = i ^ j; if (l > i) { if ((i & k) == 0) CE_DESC(a[i], a[l]); else CE_DESC(a[l], a[i]); } }
}
__device__ __forceinline__ void merge16_desc(unsigned (&a)[16], const unsigned (&b)[16]) {
#pragma unroll
    for (int i = 0; i < 16; ++i) a[i] = umax_(a[i], b[15 - i]);
#pragma unroll
    for (int j = 8; j >= 1; j >>= 1)
#pragma unroll
        for (int i = 0; i < 16; ++i) if ((i & j) == 0) CE_DESC(a[i], a[i + j]);
}
typedef short bf16x8s __attribute__((ext_vector_type(8)));
__device__ __forceinline__ void topk_unit(Frame& F, int wu) {
    const int tg = wu >> 3, hd = wu & 7, lane = F.lane, r = lane & 31, hh = lane >> 5;
    const int t = tg * 32 + r;
    const size_t qoff = (size_t)t * D + hd * 256 + 8 * hh;
    unsigned L[2][16];
    unsigned hh4 = (unsigned)hh << 2; asm volatile("" : "+v"(hh4));
#pragma unroll
    for (int p = 0; p < 2; ++p) {
        f32x16 acc[4];
#pragma unroll
        for (int nt = 0; nt < 4; ++nt)
#pragma unroll
            for (int i = 0; i < 16; ++i) acc[nt][i] = 0.f;
        const size_t koff = ((size_t)(hd * 2 + p) * 128 + r) * 128 + 8 * hh;
        const bf16* qp = F.QH() + qoff + p * 128; const bf16* kp0 = F.KH() + koff; const bf16* kp1 = kp0 + 32 * 128; const bf16* kp2 = kp0 + 64 * 128; const bf16* kp3 = kp0 + 96 * 128;
        asm volatile("" : "+v"(qp), "+v"(kp0), "+v"(kp1), "+v"(kp2), "+v"(kp3));
#define P6_LOAD(Q, K, ks0, n) _Pragma("unroll") for (int i_ = 0; i_ < (n); ++i_) { Q[i_] = *(const GAS bf16x8s*)(qp + 16 * ((ks0) + i_)); \
            K[i_][0] = *(const GAS bf16x8s*)(kp0 + 16 * ((ks0) + i_)); K[i_][1] = *(const GAS bf16x8s*)(kp1 + 16 * ((ks0) + i_)); \
            K[i_][2] = *(const GAS bf16x8s*)(kp2 + 16 * ((ks0) + i_)); K[i_][3] = *(const GAS bf16x8s*)(kp3 + 16 * ((ks0) + i_)); }
#define P6_MMA(Q, K, n) _Pragma("unroll") for (int i_ = 0; i_ < (n); ++i_) _Pragma("unroll") for (int nt = 0; nt < 4; ++nt) acc[nt] = __builtin_amdgcn_mfma_f32_32x32x16_bf16(K[i_][nt], Q[i_], acc[nt], 0, 0, 0);
        bf16x8s qa[3], ka[3][4], qb[3], kb[3][4];
        P6_LOAD(qa, ka, 0, 3); P6_LOAD(qb, kb, 3, 3);
        __builtin_amdgcn_sched_barrier(0);
        P6_MMA(qa, ka, 3);
        __builtin_amdgcn_sched_barrier(0);
        P6_LOAD(qa, ka, 6, 2);
        __builtin_amdgcn_sched_barrier(0);
        P6_MMA(qb, kb, 3);
        __builtin_amdgcn_sched_barrier(0);
        P6_MMA(qa, ka, 2);
        __builtin_amdgcn_sched_barrier(0);
#undef P6_LOAD
#undef P6_MMA
        unsigned S[4][16];
#pragma unroll
        for (int nt = 0; nt < 4; ++nt) {
#pragma unroll
            for (int rg = 0; rg < 16; ++rg) { const int nc = 32 * nt + (rg & 3) + 8 * (rg >> 2); S[nt][rg] = ((fkey(acc[nt][rg]) & ~0x7Fu) | (unsigned)(127 - nc)) ^ hh4; }
            sort16_desc(S[nt]);
        }
        merge16_desc(S[0], S[1]); merge16_desc(S[2], S[3]); merge16_desc(S[0], S[2]);
        unsigned T[16];
#pragma unroll
        for (int i = 0; i < 16; ++i) T[i] = (unsigned)__shfl_xor((int)S[0][i], 32);
        merge16_desc(S[0], T);
#pragma unroll
        for (int i = 0; i < 16; ++i) L[p][i] = S[0][i];
        __builtin_amdgcn_sched_barrier(0);
    }
    float v0[16], v1[16];
#pragma unroll
    for (int i = 0; i < 16; ++i) { v0[i] = fkey_inv(L[0][i] & ~0x7Fu); v1[i] = fkey_inv(L[1][i] & ~0x7Fu); }
    unsigned C[4][16];
    {
        int cnt = 0;
#pragma unroll
        for (int i = 0; i < 16; ++i)
#pragma unroll
            for (int j = 0; j < 16; ++j) if ((i + 1) * (j + 1) <= 16) { C[cnt >> 4][cnt & 15] = (fkey(v0[i] + v1[j]) & ~0xFFu) | (unsigned)(255 - (i * 16 + j)); ++cnt; }
#pragma unroll
        for (int q = 50; q < 64; ++q) C[q >> 4][q & 15] = 0x80000000u;
    }
    sort16_desc(C[0]); sort16_desc(C[1]); sort16_desc(C[2]); sort16_desc(C[3]);
    merge16_desc(C[0], C[1]); merge16_desc(C[2], C[3]); merge16_desc(C[0], C[2]);
    unsigned best[16];
#pragma unroll
    for (int i = 0; i < 16; ++i) best[i] = C[0][i];
    LAS unsigned* tab = (LAS unsigned*)(F.lds + F.wave * 8192) + lane;
#pragma unroll
    for (int i = 0; i < 16; ++i) { tab[i * 64] = 127u - (L[0][i] & 0x7Fu); tab[(16 + i) * 64] = 127u - (L[1][i] & 0x7Fu); }
    const float smax = fkey_inv(best[0] & ~0xFFu);
    float sv[8]; unsigned idv[8]; float ssum = 0.f;
#pragma unroll
    for (int k = 0; k < 8; ++k) {
        const unsigned bk = hh ? best[8 + k] : best[k];
        const unsigned pos = 255u - (bk & 0xFFu);
        idv[k] = tab[(pos >> 4) * 64] * 128u + tab[(16 + (pos & 15u)) * 64];
        sv[k] = __builtin_amdgcn_exp2f((fkey_inv(bk & ~0xFFu) - smax) * 1.4426950409f); ssum += sv[k];
    }
    ssum += __shfl_xor(ssum, 32);
    const float inv = 1.0f / ssum;
    {
        int* o = F.IDS() + (size_t)t * 128 + hd * 16 + 8 * hh; float* og = F.GATES() + (size_t)t * 128 + hd * 16 + 8 * hh;
        *(GAS v4u*)o = (v4u){idv[0], idv[1], idv[2], idv[3]}; *(GAS v4u*)(o + 4) = (v4u){idv[4], idv[5], idv[6], idv[7]};
        *(GAS f32x4*)og = (f32x4){sv[0] * inv, sv[1] * inv, sv[2] * inv, sv[3] * inv}; *(GAS f32x4*)(og + 4) = (f32x4){sv[4] * inv, sv[5] * inv, sv[6] * inv, sv[7] * inv};
    }
}
__device__ __forceinline__ void h8_row(Frame& F, int t) {
    const int lane = F.lane;
    float hx[32]; float mx = 0.f;
    const bf16* hp = F.HB() + (size_t)t * D + lane * 16;
#pragma unroll
    for (int c = 0; c < 2; ++c)
#pragma unroll
        for (int q = 0; q < 2; ++q) { const v4u a = *(const GAS v4u*)(hp + c * 1024 + q * 8); float* x = hx + c * 16 + q * 8;
            x[0] = bf_lo(a.x); x[1] = bf_hi(a.x); x[2] = bf_lo(a.y); x[3] = bf_hi(a.y); x[4] = bf_lo(a.z); x[5] = bf_hi(a.z); x[6] = bf_lo(a.w); x[7] = bf_hi(a.w); }
#pragma unroll
    for (int i = 0; i < 32; ++i) mx = fmaxf(mx, fabsf(hx[i]));
#pragma unroll
    for (int o = 1; o < 64; o <<= 1) mx = fmaxf(mx, __shfl_xor(mx, o));
    const float sc = mx > 0.f ? 127.0f / mx : 1.0f;
#pragma unroll
    for (int c = 0; c < 2; ++c) { v4u o; o.x = pack_i8x4(hx[c * 16 + 0] * sc, hx[c * 16 + 1] * sc, hx[c * 16 + 2] * sc, hx[c * 16 + 3] * sc);
        o.y = pack_i8x4(hx[c * 16 + 4] * sc, hx[c * 16 + 5] * sc, hx[c * 16 + 6] * sc, hx[c * 16 + 7] * sc);
        o.z = pack_i8x4(hx[c * 16 + 8] * sc, hx[c * 16 + 9] * sc, hx[c * 16 + 10] * sc, hx[c * 16 + 11] * sc);
        o.w = pack_i8x4(hx[c * 16 + 12] * sc, hx[c * 16 + 13] * sc, hx[c * 16 + 14] * sc, hx[c * 16 + 15] * sc);
        *(GAS v4u*)(F.H8() + (size_t)t * D + c * 1024 + lane * 16) = o; }
    if (lane == 0) F.HSCALE()[t] = mx > 0.f ? mx * (1.0f / 127.0f) : 1.0f;
}
__device__ __forceinline__ int row_sum16(int v) {
    v += __builtin_amdgcn_update_dpp(0, v, 0x128, 0xf, 0xf, false);
    v += __builtin_amdgcn_update_dpp(0, v, 0x124, 0xf, 0xf, false);
    v += __builtin_amdgcn_update_dpp(0, v, 0x122, 0xf, 0xf, false);
    v += __builtin_amdgcn_update_dpp(0, v, 0x121, 0xf, 0xf, false);
    return v;
}
__device__ __forceinline__ void peer_u_xcd(Frame& F) {
    const int lane = F.lane, x = blockIdx.x & 7, jcu = blockIdx.x >> 3, ncu = ((int)F.G - x + 7) >> 3;
    const int tpc = (M + ncu - 1) / ncu, tpw = (tpc + NWAVES - 1) / NWAVES;
    const int tbase = jcu * tpc + F.wave * tpw;
    int nw = M - tbase; { const int lim = (jcu + 1) * tpc - tbase; nw = nw < lim ? nw : lim; nw = nw < tpw ? nw : tpw; nw = nw < 0 ? 0 : nw; }
    const int NV = nw;
    LAS unsigned char* wl = F.lds + F.wave * 14848;
    LAS int* lst = (LAS int*)wl; LAS int* res = (LAS int*)(wl + 512); LAS unsigned char* hsl = wl + 1024;
    const int q4 = lane >> 4, i16 = lane & 15;
    const unsigned char* ubase = F.U8() + (size_t)x * 2048 * 1024;
    const unsigned lanepart = (unsigned)i16 * 16u;
    int r_idlo = 0, r_idhi = 0, r_t = 0; v4u r_h0 = (v4u){0u, 0u, 0u, 0u}, r_h1 = (v4u){0u, 0u, 0u, 0u};
    int v_cl0 = 0, v_cl1 = 0, v_n = 0, v_r0 = 0, v_t = 0, v_slot = 0; unsigned long long v_mlo = 0, v_mhi = 0; bool v_live = false;
    int vset = 0, nvalid = 0, idle = 0;
    if (NV == 0) return;
#define U_RAW() do { const int vi_ = vset < NV ? vset : NV - 1; r_t = tbase + vi_; \
        r_idlo = F.IDS()[(size_t)r_t * 128 + lane]; r_idhi = F.IDS()[(size_t)r_t * 128 + 64 + lane]; \
        r_h0 = *(const GAS v4u*)(F.H8() + (size_t)r_t * D + lane * 32); r_h1 = *(const GAS v4u*)(F.H8() + (size_t)r_t * D + lane * 32 + 16); } while (0)
#define U_NEXT() do { if (v_live && v_r0 + 16 < v_n) { v_r0 += 16; } else if (vset < NV) { const bool slo = (r_idlo >> 11) == x, shi = (r_idhi >> 11) == x; \
            v_mlo = __ballot(slo); v_mhi = __ballot(shi); const int nlo = __popcll(v_mlo); v_n = nlo + __popcll(v_mhi); \
            const int plo = __builtin_amdgcn_mbcnt_hi((unsigned)(v_mlo >> 32), __builtin_amdgcn_mbcnt_lo((unsigned)v_mlo, 0)); \
            const int phi = nlo + __builtin_amdgcn_mbcnt_hi((unsigned)(v_mhi >> 32), __builtin_amdgcn_mbcnt_lo((unsigned)v_mhi, 0)); \
            if (slo) lst[plo] = (r_idlo & 2047) | (lane << 16); if (shi) lst[phi] = (r_idhi & 2047) | ((64 + lane) << 16); \
            v_slot = nvalid % 6; ++nvalid; { LAS unsigned char* sp_ = hsl + v_slot * 2304; *(LAS v4u*)(sp_ + lane * 32) = r_h0; *(LAS v4u*)(sp_ + lane * 32 + 16) = r_h1; \
                int bs_ = __builtin_amdgcn_sdot4((int)r_h0.x, 0x01010101, 0, false); bs_ = __builtin_amdgcn_sdot4((int)r_h0.y, 0x01010101, bs_, false); bs_ = __builtin_amdgcn_sdot4((int)r_h0.z, 0x01010101, bs_, false); bs_ = __builtin_amdgcn_sdot4((int)r_h0.w, 0x01010101, bs_, false); \
                bs_ = __builtin_amdgcn_sdot4((int)r_h1.x, 0x01010101, bs_, false); bs_ = __builtin_amdgcn_sdot4((int)r_h1.y, 0x01010101, bs_, false); bs_ = __builtin_amdgcn_sdot4((int)r_h1.z, 0x01010101, bs_, false); bs_ = __builtin_amdgcn_sdot4((int)r_h1.w, 0x01010101, bs_, false); \
                *(LAS int*)(sp_ + 2048 + lane * 4) = bs_; } \
            v_cl0 = lst[lane]; v_cl1 = lst[64 + lane]; v_t = r_t; v_r0 = 0; ++vset; v_live = true; } \
        else { v_live = false; v_n = 0; v_r0 = 0; v_mlo = 0; v_mhi = 0; ++idle; } } while (0)
#define U_ISSUE(BUF, DS) do { { const int rem_ = v_n - v_r0; DS##_cnt = rem_ < 0 ? 0 : (rem_ < 16 ? rem_ : 16); } \
        DS##_slot = v_slot; DS##_t = v_t; DS##_mlo = v_mlo; DS##_mhi = v_mhi; DS##_last = v_live && (v_r0 + 16 >= v_n); \
        _Pragma("unroll") for (int gp = 0; gp < 4; ++gp) { const int ix_ = v_r0 + 4 * gp + q4; const int a_ = __shfl(v_cl0, ix_ & 63), b_ = __shfl(v_cl1, ix_ & 63); DS##_ent[gp] = ix_ < 64 ? a_ : b_; \
            const unsigned of_ = (4 * gp + q4 < DS##_cnt ? ((unsigned)(DS##_ent[gp] & 2047) << 10) : 0u) + lanepart; \
            _Pragma("unroll") for (int c = 0; c < 4; ++c) BUF[4 * gp + c] = *(const GAS v4u*)(ubase + of_ + c * 256); } } while (0)
#define U_DOT8(W, HA, HB) do { a_ = __builtin_amdgcn_sdot4((int)((W) & 0x0f0f0f0fu), (int)(HA), a_, false); a_ = __builtin_amdgcn_sdot4((int)(((W) >> 4) & 0x0f0f0f0fu), (int)(HB), a_, false); } while (0)
#define U_COMPUTE(BUF, DS) do { const LAS unsigned char* sp_ = hsl + DS##_slot * 2304; const volatile LAS v4u* hp_ = (const volatile LAS v4u*)(sp_ + i16 * 32); \
        const LAS int* bsp_ = (const LAS int*)(sp_ + 2048) + i16; const int hsum_ = (bsp_[0] + bsp_[16]) + (bsp_[32] + bsp_[48]); \
        _Pragma("unroll") for (int gp = 0; gp < 4; ++gp) if (4 * gp < DS##_cnt) { int a_ = -8 * hsum_; \
            _Pragma("unroll") for (int c = 0; c < 4; ++c) { const v4u r_ = BUF[4 * gp + c]; const v4u h0_ = hp_[c * 32], h1_ = hp_[c * 32 + 1]; \
                U_DOT8(r_.x, h0_.x, h0_.y); U_DOT8(r_.y, h0_.z, h0_.w); U_DOT8(r_.z, h1_.x, h1_.y); U_DOT8(r_.w, h1_.z, h1_.w); } \
            a_ = row_sum16(a_); if (i16 == 0 && 4 * gp + q4 < DS##_cnt) res[DS##_ent[gp] >> 16] = a_; } \
        if (DS##_last) { int* po_ = F.PART() + (size_t)DS##_t * 128; \
            if ((DS##_mlo >> lane) & 1ull) po_[lane] = res[lane]; if ((DS##_mhi >> lane) & 1ull) po_[64 + lane] = res[64 + lane]; } } while (0)
    v4u bufA[16], bufB[16], bufC[16];
    int dA_cnt = 0, dA_ent[4] = {0, 0, 0, 0}, dA_t = 0, dA_slot = 0; unsigned long long dA_mlo = 0, dA_mhi = 0; bool dA_last = false;
    int dB_cnt = 0, dB_ent[4] = {0, 0, 0, 0}, dB_t = 0, dB_slot = 0; unsigned long long dB_mlo = 0, dB_mhi = 0; bool dB_last = false;
    int dC_cnt = 0, dC_ent[4] = {0, 0, 0, 0}, dC_t = 0, dC_slot = 0; unsigned long long dC_mlo = 0, dC_mhi = 0; bool dC_last = false;
    U_RAW();
    U_NEXT(); U_RAW(); U_ISSUE(bufA, dA);
    U_NEXT(); U_RAW(); U_ISSUE(bufB, dB);
    while (idle < 3) {
        U_NEXT(); U_RAW(); U_ISSUE(bufC, dC); U_COMPUTE(bufA, dA);
        U_NEXT(); U_RAW(); U_ISSUE(bufA, dA); U_COMPUTE(bufB, dB);
        U_NEXT(); U_RAW(); U_ISSUE(bufB, dB); U_COMPUTE(bufC, dC);
    }
#undef U_RAW
#undef U_NEXT
#undef U_ISSUE
#undef U_DOT8
#undef U_COMPUTE
}
__device__ __forceinline__ void peer_act_token(Frame& F, int t) {
    const int lane = F.lane;
    LAS unsigned char* wl = F.lds + F.wave * 4096;
    LAS float* abuf = (LAS float*)wl; LAS int* ibuf = (LAS int*)(wl + 512); LAS int* cnt = (LAS int*)(wl + 1024);
    LAS int* ovf = (LAS int*)(wl + 1280); LAS int* fre = (LAS int*)(wl + 1792); LAS int* sop = (LAS int*)(wl + 2304);
#define WFENCE() asm volatile("s_waitcnt lgkmcnt(0)" ::: "memory")
    const float sc = __builtin_amdgcn_rsqf(F.ROWSS()[t] * (1.0f / D) + 1e-6f) * F.HSCALE()[t];
    if (lane < 34) cnt[lane] = 0;
    float am = 0.f; float actv[2]; int idv[2], slotv[2];
    const int l32 = t & 31;
#pragma unroll
    for (int half = 0; half < 2; ++half) {
        const size_t o = (size_t)t * 128 + half * 64 + lane;
        const int e = F.IDS()[o]; const float g = F.GATES()[o];
        const int dsum = F.PART()[o];
        actv[half] = gelu_tanh((float)dsum * sc * F.USCALE()[e]) * g * F.VSCALE()[e]; idv[half] = e; am = fmaxf(am, fabsf(actv[half]));
    }
    WFENCE();
#pragma unroll
    for (int half = 0; half < 2; ++half) {
        const int r = idv[half] & 31;
        const int j = __hip_atomic_fetch_add(cnt + r, 1, __ATOMIC_RELAXED, __HIP_MEMORY_SCOPE_WORKGROUP);
        if (j < 4) slotv[half] = ((r - l32) & 31) + 32 * j;
        else { const int q = __hip_atomic_fetch_add(cnt + 32, 1, __ATOMIC_RELAXED, __HIP_MEMORY_SCOPE_WORKGROUP); ovf[q] = half * 64 + lane; slotv[half] = -1; }
    }
    WFENCE();
    if (lane < 32) { const int n = cnt[lane];
        for (int j = n; j < 4; ++j) { const int q = __hip_atomic_fetch_add(cnt + 33, 1, __ATOMIC_RELAXED, __HIP_MEMORY_SCOPE_WORKGROUP); fre[q] = ((lane - l32) & 31) + 32 * j; } }
    WFENCE();
    const int nov = cnt[32];
#pragma unroll
    for (int half = 0; half < 2; ++half) { const int i = half * 64 + lane; if (i < nov) sop[ovf[i]] = fre[i]; }
    WFENCE();
#pragma unroll
    for (int half = 0; half < 2; ++half) { if (slotv[half] < 0) slotv[half] = sop[half * 64 + lane]; abuf[slotv[half]] = actv[half]; ibuf[slotv[half]] = idv[half]; }
    WFENCE();
#pragma unroll
    for (int o = 1; o < 64; o <<= 1) am = fmaxf(am, __shfl_xor(am, o));
    const float asc = am > 0.f ? 127.0f / am : 1.0f;
    if (lane == 0) F.ASCALE()[t] = am > 0.f ? am * (1.0f / 127.0f) : 1.0f;
    if (lane < 32) {
        const f32x4 av = *(const LAS f32x4*)(abuf + 4 * lane); const v4u iv = *(const LAS v4u*)(ibuf + 4 * lane);
        const size_t o = ((size_t)(t >> 6) * 32 + lane) * 64 + (t & 63);
        F.IDW()[o] = (v4u){iv.x << 3, iv.y << 3, iv.z << 3, iv.w << 3};
        F.AW()[o] = pack_i8x4(av.x * asc, av.y * asc, av.z * asc, av.w * asc);
    }
    WFENCE();
#undef WFENCE
}
__device__ __forceinline__ void tr4x4(const unsigned r0, const unsigned r1, const unsigned r2, const unsigned r3, unsigned (&c)[4]) {
    const unsigned t01l = __builtin_amdgcn_perm(r1, r0, 0x05010400u), t01h = __builtin_amdgcn_perm(r1, r0, 0x07030602u);
    const unsigned t23l = __builtin_amdgcn_perm(r3, r2, 0x05010400u), t23h = __builtin_amdgcn_perm(r3, r2, 0x07030602u);
    c[0] = __builtin_amdgcn_perm(t23l, t01l, 0x05040100u); c[1] = __builtin_amdgcn_perm(t23l, t01l, 0x07060302u);
    c[2] = __builtin_amdgcn_perm(t23h, t01h, 0x05040100u); c[3] = __builtin_amdgcn_perm(t23h, t01h, 0x07060302u);
}
template <int MODE>
__device__ __forceinline__ void peer_v_slice(Frame& F, int c, bool do_atomic) {
    const int tid = F.tid, lane = F.lane;
    for (int i = tid; i < NEXP * 8 / 16; i += 512) *(LAS v4u*)(F.lds + i * 16) = *(const GAS v4u*)(F.V8T() + (size_t)c * NEXP * 8 + (size_t)i * 16);
    __syncthreads();
    const v4u* ibase = F.IDW() + lane; const unsigned* abase = F.AW() + lane;
    constexpr int NBLK = M / 64, PD = 16;
    v4u iq[PD]; unsigned aq[PD]; v2u rw[2][4];
    {
        const size_t o = (size_t)F.wave * 32 * 64;
#pragma unroll
        for (int j = 0; j < PD; ++j) { iq[j] = *(const GAS v4u*)(ibase + o + j * 64); aq[j] = abase[o + j * 64]; }
    }
#define LROW(dst, q) do { dst[0] = *(const LAS v2u*)(F.lds + (q).x); dst[1] = *(const LAS v2u*)(F.lds + (q).y); \
                          dst[2] = *(const LAS v2u*)(F.lds + (q).z); dst[3] = *(const LAS v2u*)(F.lds + (q).w); } while (0)
    for (int blk = F.wave; blk < NBLK; blk += NWAVES) {
        const int t = blk * 64 + lane;
        const size_t o = (size_t)blk * 32 * 64;
        const int nblk = (blk + NWAVES < NBLK) ? blk + NWAVES : blk;
        const size_t on = (size_t)nblk * 32 * 64;
        int acc[8];
#pragma unroll
        for (int i = 0; i < 8; ++i) acc[i] = 0;
        LROW(rw[0], iq[0]);
#pragma unroll
        for (int j = 0; j < 32; ++j) {
            if (j + 1 < 32) LROW(rw[(j + 1) & 1], iq[(j + 1) % PD]);
            const unsigned aw = aq[j % PD];
            unsigned cl[4], ch[4];
            tr4x4(rw[j & 1][0].x, rw[j & 1][1].x, rw[j & 1][2].x, rw[j & 1][3].x, cl);
            tr4x4(rw[j & 1][0].y, rw[j & 1][1].y, rw[j & 1][2].y, rw[j & 1][3].y, ch);
#pragma unroll
            for (int i = 0; i < 4; ++i) { acc[i] = __builtin_amdgcn_sdot4((int)aw, (int)cl[i], acc[i], false); acc[4 + i] = __builtin_amdgcn_sdot4((int)aw, (int)ch[i], acc[4 + i], false); }
            { const size_t oo = (j + PD < 32) ? o + (size_t)(j + PD) * 64 : on + (size_t)(j + PD - 32) * 64;
              iq[j % PD] = *(const GAS v4u*)(ibase + oo); aq[j % PD] = abase[oo]; }
            __builtin_amdgcn_sched_barrier(0);
        }
        const float asc = F.ASCALE()[t];
        float accf[8];
#pragma unroll
        for (int i = 0; i < 8; ++i) accf[i] = (float)acc[i] * asc;
        const v4u hb = *(const GAS v4u*)(F.HBT() + ((size_t)c * M + t) * 8);
        accf[0] += bf_lo(hb.x); accf[1] += bf_hi(hb.x); accf[2] += bf_lo(hb.y); accf[3] += bf_hi(hb.y);
        accf[4] += bf_lo(hb.z); accf[5] += bf_hi(hb.z); accf[6] += bf_lo(hb.w); accf[7] += bf_hi(hb.w);
        bf16* yp = (MODE == 0) ? F.Y() + ((size_t)c * M + t) * 8 : (bf16*)F.XN() + ((((size_t)c * M + t) * 8) & (size_t)0x1ffffff);
        *(GAS v4u*)yp = (v4u){pk2(accf[0], accf[1]), pk2(accf[2], accf[3]), pk2(accf[4], accf[5]), pk2(accf[6], accf[7])};
        float ss = 0.f;
#pragma unroll
        for (int i = 0; i < 8; ++i) ss += accf[i] * accf[i];
        if (do_atomic) atomicAdd(F.ROWSS2() + t, ss);
    }
#undef LROW
    __syncthreads();
}
__device__ __forceinline__ void final_unit(Frame& F, int unit) {
    const int tid = F.tid, blk = unit >> 3, cg = unit & 7, t0 = blk * 64;
    LAS float* T = (LAS float*)F.lds;
#pragma unroll
    for (int i = 0; i < 4; ++i) { const int pid = tid + 512 * i, cl = pid >> 6, tok = pid & 63;
        const v4u v = *(const GAS v4u*)(F.Y() + ((size_t)(cg * 32 + cl) * M + t0 + tok) * 8);
        *(LAS f32x4*)(T + tok * 260 + cl * 8) = (f32x4){bf_lo(v.x), bf_hi(v.x), bf_lo(v.y), bf_hi(v.y)};
        *(LAS f32x4*)(T + tok * 260 + cl * 8 + 4) = (f32x4){bf_lo(v.z), bf_hi(v.z), bf_lo(v.w), bf_hi(v.w)}; }
    __syncthreads();
#pragma unroll
    for (int i = 0; i < 8; ++i) { const int pid = tid + 512 * i, tok = pid >> 6, c4 = pid & 63;
        const float rs = __builtin_amdgcn_rsqf(F.ROWSS2()[t0 + tok] * (1.0f / D) + 1e-6f);
        const f32x4 v = *(const LAS f32x4*)(T + tok * 260 + c4 * 4);
        const f32x4 g = *(const GAS f32x4*)(F.A.in[20] + cg * 256 + c4 * 4);
        *(GAS f32x4*)(F.A.out + (size_t)(t0 + tok) * D + cg * 256 + c4 * 4) = v * rs * g; }
    __syncthreads();
}
__global__ void __launch_bounds__(NWAVES * 64, 2) mk_fwd(Args args) {
    __shared__ __attribute__((aligned(16))) unsigned char lds[LDS_BYTES];
    Frame F(args);
    F.lds = (LAS unsigned char*)lds;
    F.MISC = (volatile LAS unsigned*)(F.lds + MISC_OFF);
    F.tid = threadIdx.x; F.lane = F.tid & 63; F.wave = __builtin_amdgcn_readfirstlane(F.tid >> 6);
    F.G = gridDim.x; { const int bx = blockIdx.x; F.vcu = (F.G % 8 == 0) ? (bx % 8) * (F.G / 8) + bx / 8 : bx; }
    F.ws = args.ws;
    F.ctl = (gu32*)(args.ws + WS_CTL);
    for (int u = F.tid; u < (LDS_BYTES - LDSCTL_OFF) / 4; u += NWAVES * 64) ((LAS unsigned*)(F.lds + LDSCTL_OFF))[u] = 0u;
    __syncthreads();
    XcdBarrier bar; bar.bar = (unsigned*)(F.ctl + CW_BAR); bar.x = 0; bar.st = nullptr;
    if (N_LAUNCHES != PER_PHASE) bar = xcd_barrier_post((unsigned*)(F.ctl + CW_BAR), F.MISC + 8);
#define GRID_BAR() do { if (N_LAUNCHES != PER_PHASE) xcd_barrier(bar); } while (0)
    const int lo = args.ph_lo, hi = args.ph_hi;
#ifndef MK_PHASE_MASK
#define MK_PHASE_MASK 0x7FF
#endif
#define IN(k) (((MK_PHASE_MASK >> (k)) & 1) && lo <= (k) && (k) < hi)
#undef MK_PHASE_MASK
#define MK_PHASE_MASK 0xFFFF
#define BOTH(k) (true)
#ifndef MK_REP_MASK
#define MK_REP_MASK 0
#endif
#ifndef MK_REP_N
#define MK_REP_N 2
#endif
#define REPS(k) for (int rep_ = 0; rep_ < ((((MK_REP_MASK) >> (k)) & 1) ? 1 + MK_REP_N : 1); ++rep_)
    const int gw = F.vcu * NWAVES + F.wave, NGW = F.G * NWAVES;
    if (IN(0)) { REPS(0) { p0_prologue(F); __syncthreads(); } if (BOTH(0)) GRID_BAR(); }
    if (IN(1)) {
        pg8::Gemm g{F.XN(), F.WIN(), M, NIN, D}; pg8::StaticOrder S; S.init(M, NIN, F.G, (int)blockIdx.x);
        pg8::EpiZ E{F.Z(), NIN, LW};
        REPS(1) pg8::gemm_phase<pg8::EpiZ, pg8::StaticOrder, true, true>(F.lds, g, S, E);
        if (BOTH(1)) GRID_BAR();
    }
    if (IN(2)) {
        REPS(12) for (int u = blockIdx.x; u < BATCH * NCHUNK * 8; u += F.G) lru_unit<false>(F, u);
        if (BOTH(2)) GRID_BAR();
    }
    if (IN(3)) {
        lru_carry(F);
        REPS(13) for (int u = blockIdx.x; u < BATCH * NCHUNK; u += F.G) gmlp_unit(F, u);
        if (BOTH(3)) GRID_BAR();
    }
    if (IN(11)) {
        REPS(3) for (int u = blockIdx.x; u < BATCH * NCHUNK * 8; u += F.G) lru_unit<true>(F, u);
        GRID_BAR();
    }
    if (IN(4)) {
        pg8::Gemm g{F.MIX(), F.WOUT(), M, D, D}; pg8::StaticOrder S; S.init(M, D, F.G, (int)blockIdx.x);
        pg8::EpiH E{F.HB(), F.HBT(), F.A.in[0], F.ROWSS(), D, M};
        pg8::gemm_phase<pg8::EpiH, pg8::StaticOrder, true, true>(F.lds, g, S, E);
        if (BOTH(4)) GRID_BAR();
    }
    if (IN(5)) {
        pg8::Gemm g{F.HB(), F.WQ(), M, D, D}; pg8::StaticOrder S; S.init(M, D, F.G, (int)blockIdx.x);
        pg8::EpiQ E{F.QH(), F.ROWSS(), D};
        REPS(5) pg8::gemm_phase<pg8::EpiQ, pg8::StaticOrder, true, true>(F.lds, g, S, E);
        if (BOTH(5)) GRID_BAR();
    }
    if (IN(6)) {
        REPS(6) { for (int wu = gw; wu < (M / 32) * 8; wu += NGW) topk_unit(F, wu);
                  for (int t = gw; t < M; t += NGW) h8_row(F, t); }
        if (BOTH(6)) GRID_BAR();
    }
    if (IN(7)) {
        REPS(7) peer_u_xcd(F);
        if (BOTH(7)) GRID_BAR();
    }
    if (IN(8)) {
        REPS(8) for (int t = gw; t < M; t += NGW) peer_act_token(F, t);
        if (BOTH(8)) GRID_BAR();
    }
    if (IN(9)) {
        for (int c = blockIdx.x; c < D / 8; c += F.G) peer_v_slice<0>(F, c, true);
        if ((MK_REP_MASK >> 9) & 1) { for (int rep_ = 0; rep_ < MK_REP_N; ++rep_) for (int c = blockIdx.x; c < D / 8; c += F.G) peer_v_slice<1>(F, c, false); }
        if (BOTH(9)) GRID_BAR();
    }
    if (IN(10)) {
        REPS(10) for (int u = blockIdx.x; u < (M / 64) * 8; u += F.G) final_unit(F, u);
    }
#undef IN
#undef BOTH
#undef GRID_BAR
}

extern "C" void kernel_launch(void* const* d_in, const int* in_sizes, int n_in, void* d_out, int out_size, void* d_ws, size_t ws_size, hipStream_t stream) {
    static int grid = 0;
    if (grid == 0) {
        if (n_in != 21 || in_sizes[0] != M * D || out_size != M * D || ws_size < WS_END) { fprintf(stderr, "kernel_launch: unexpected shapes (n_in %d, in0 %d, out %d, ws %zu)\n", n_in, n_in > 0 ? in_sizes[0] : -1, out_size, ws_size); grid = -1; return; }
        int dev = 0, cus = 0, per_cu = 0;
        if (hipGetDevice(&dev) != hipSuccess || hipDeviceGetAttribute(&cus, hipDeviceAttributeMultiprocessorCount, dev) != hipSuccess) { grid = -1; return; }
        if (hipOccupancyMaxActiveBlocksPerMultiprocessor(&per_cu, (const void*)mk_fwd, NWAVES * 64, 0) != hipSuccess || per_cu < 1) { fprintf(stderr, "kernel_launch: occupancy query reports %d blocks per CU\n", per_cu); }
        (void)hipGetLastError();
        grid = cus;
    }
    if (grid < 0) return;
    (void)hipMemsetAsync((char*)d_ws + WS_CTL, 0, CTL_ZERO_BYTES, stream);
    Args a{};
    for (int i = 0; i < 21; ++i) a.in[i] = (const float*)d_in[i];
    a.out = (float*)d_out; a.ws = (unsigned char*)d_ws;
    for (int li = 0; li < N_LAUNCHES; ++li) {
        a.ph_lo = 0; a.ph_hi = 99;
        hipLaunchKernelGGL(mk_fwd, dim3(grid), dim3(NWAVES * 64), 0, stream, a);
    }
}
```

```cpp
#include <hip/hip_runtime.h>
#include <cstdio>
#include <cstdint>
namespace pg8 {
#define PG8_LAS __attribute__((address_space(3)))
typedef unsigned short bf16_t;
typedef short bf16x8 __attribute__((ext_vector_type(8)));
typedef float f32x4 __attribute__((ext_vector_type(4)));
typedef unsigned u32x4 __attribute__((ext_vector_type(4)));
constexpr int BM = 256, BK = 64, HALF = 128, HTB = HALF * BK * 2  , STAGE_BYTES = 8 * HTB, NXCD = 8, WGM = 8;

__host__ __device__ __forceinline__ int lds_byte(int r, int c) { const int st = (r >> 4) * 2 + (c >> 5), rr = r & 15, cc = c & 31, ob = rr * 64 + cc * 2; return st * 1024 + (ob ^ (((ob >> 9) & 1) << 5)); }
__host__ __device__ __forceinline__ void stage_rc(int b, int& R, int& C) { const int st = b / 1024, sb = b % 1024, swz = sb ^ (((sb >> 9) & 1) << 5); R = (st >> 1) * 16 + swz / 64; C = (st & 1) * 32 + (swz % 64) / 2; }
__host__ __device__ __forceinline__ int perm32(int rho) { const int n = rho >> 4, i = rho & 15; return 8 * (i >> 2) + 4 * n + (i & 3); }

struct Unit { int pm, pn; };
struct Gemm { const bf16_t* A; const bf16_t* Bt; int M, N, K; };

struct StaticOrder {
    int nM, nN, nwg, G, c;
    __host__ __device__ void init(int M, int N, int G_, int c_) { nM = M / BM; nN = N / BM; nwg = nM * nN; G = G_; c = c_; }
    __host__ __device__ bool next(int i, Unit& u) const {
        const long L = (long)i * G + c; if (L >= nwg) return false;
        int wgid = (int)L; { const int q = nwg / NXCD, r = nwg % NXCD, xcd = wgid % NXCD, off = wgid / NXCD; wgid = (xcd < r ? xcd * (q + 1) : r * (q + 1) + (xcd - r) * q) + off; }
        const int nig = WGM * nN, gid = wgid / nig, fm = gid * WGM, gsz = (nM - fm) < WGM ? (nM - fm) : WGM;
        u.pm = fm + ((wgid % nig) % gsz); u.pn = (wgid % nig) / gsz; return true;
    }
    __device__ __forceinline__ void a_ready(const Unit&) const {}
    __device__ __forceinline__ void done(const Unit&) const {}
};

__device__ __forceinline__ unsigned cvt_pk_bf16(float lo, float hi) { unsigned r; asm volatile("v_cvt_pk_bf16_f32 %0, %1, %2" : "=v"(r) : "v"(lo), "v"(hi)); return r; }
__device__ __forceinline__ float gelu_tanh(float x) {
    const float t = x * (1.0f + 0.044715f * x * x);
    const float e = __builtin_amdgcn_exp2f(-2.3022081983f * t);
    return x * __builtin_amdgcn_rcpf(1.0f + e);
}
struct EpiZ {
    static constexpr bool PERM = true, AFTER_DRAIN = false;
    bf16_t* O; int ldc; int gelu_from;
    __device__ __forceinline__ void operator()(const f32x4 (&acc)[2][2][4][2], const Unit& u, int wr, int wc, int fr, int fq) const {
        const int row0 = u.pm * BM + wr * 64 + fr; const int col0 = u.pn * BM + wc * 32 + 8 * fq;
        const bool act = (u.pn * BM) >= gelu_from;
#pragma unroll
        for (int ai = 0; ai < 2; ++ai)
#pragma unroll
            for (int m = 0; m < 4; ++m) { bf16_t* rowp = O + (size_t)(row0 + ai * HALF + m * 16) * ldc + col0;
#pragma unroll
                for (int bj = 0; bj < 2; ++bj) { f32x4 v0 = acc[ai][bj][m][0], v1 = acc[ai][bj][m][1];
                    if (act) {
#pragma unroll
                        for (int j = 0; j < 4; ++j) { v0[j] = gelu_tanh(v0[j]); v1[j] = gelu_tanh(v1[j]); } }
                    u32x4 w; w.x = cvt_pk_bf16(v0[0], v0[1]); w.y = cvt_pk_bf16(v0[2], v0[3]); w.z = cvt_pk_bf16(v1[0], v1[1]); w.w = cvt_pk_bf16(v1[2], v1[3]);
                    *(u32x4*)(rowp + bj * HALF) = w; } }
    }
};
struct EpiH {
    static constexpr bool PERM = true, AFTER_DRAIN = false;
    bf16_t* O; bf16_t* OT; const float* X; float* rowss; int ldc; int mrows;
    __device__ __forceinline__ void operator()(const f32x4 (&acc)[2][2][4][2], const Unit& u, int wr, int wc, int fr, int fq) const {
        const int row0 = u.pm * BM + wr * 64 + fr; const int col0 = u.pn * BM + wc * 32 + 8 * fq;
#pragma unroll
        for (int ai = 0; ai < 2; ++ai)
#pragma unroll
            for (int m = 0; m < 4; ++m) { const int row = row0 + ai * HALF + m * 16; const size_t off = (size_t)row * ldc + col0; float ss = 0.f;
#pragma unroll
                for (int bj = 0; bj < 2; ++bj) {
                    const f32x4 x0 = *(const f32x4*)(X + off + bj * HALF), x1 = *(const f32x4*)(X + off + bj * HALF + 4);
                    const f32x4 v0 = acc[ai][bj][m][0] + x0, v1 = acc[ai][bj][m][1] + x1;
                    ss += (v0[0] * v0[0] + v0[1] * v0[1]) + (v0[2] * v0[2] + v0[3] * v0[3]) + (v1[0] * v1[0] + v1[1] * v1[1]) + (v1[2] * v1[2] + v1[3] * v1[3]);
                    u32x4 w; w.x = cvt_pk_bf16(v0[0], v0[1]); w.y = cvt_pk_bf16(v0[2], v0[3]); w.z = cvt_pk_bf16(v1[0], v1[1]); w.w = cvt_pk_bf16(v1[2], v1[3]);
                    *(u32x4*)(O + off + bj * HALF) = w;
                    *(u32x4*)(OT + ((size_t)((col0 + bj * HALF) >> 3) * mrows + row) * 8) = w; }
                ss += __shfl_xor(ss, 16); ss += __shfl_xor(ss, 32);
                if (fq == 0) atomicAdd(rowss + row, ss); }
    }
};
struct EpiQ {
    static constexpr bool PERM = true, AFTER_DRAIN = false;
    bf16_t* QH; const float* rowss; int ldc;
    __device__ __forceinline__ void operator()(const f32x4 (&acc)[2][2][4][2], const Unit& u, int wr, int wc, int fr, int fq) const {
        const int row0 = u.pm * BM + wr * 64 + fr, col0 = u.pn * BM + wc * 32 + 8 * fq;
#pragma unroll
        for (int ai = 0; ai < 2; ++ai)
#pragma unroll
            for (int m = 0; m < 4; ++m) { const int row = row0 + ai * HALF + m * 16; const float rs = __builtin_amdgcn_rsqf(rowss[row] * (1.0f / 2048.0f) + 1e-6f);
                const size_t off = (size_t)row * ldc + col0;
#pragma unroll
                for (int bj = 0; bj < 2; ++bj) { const f32x4 v0 = acc[ai][bj][m][0] * rs, v1 = acc[ai][bj][m][1] * rs;
                    u32x4 wh; wh.x = cvt_pk_bf16(v0[0], v0[1]); wh.y = cvt_pk_bf16(v0[2], v0[3]); wh.z = cvt_pk_bf16(v1[0], v1[1]); wh.w = cvt_pk_bf16(v1[2], v1[3]);
                    *(u32x4*)(QH + off + bj * HALF) = wh; } }
    }
};
template <class Epi, class Sched, bool ALIGN_EPI = false, bool SP2 = false>
__device__ __forceinline__ void gemm_phase(PG8_LAS unsigned char* lds, const Gemm g, const Sched& S, const Epi& E) {
    const int tid = threadIdx.x, wid = __builtin_amdgcn_readfirstlane(tid >> 6), lane = tid & 63, wr = wid >> 2, wc = wid & 3, fr = lane & 15, fq = lane >> 4;
    const int K = g.K, nt = K / BK;
    unsigned voffA[2], voffB[2];
#pragma unroll
    for (int i = 0; i < 2; ++i) { int R, C; stage_rc(tid * 16 + i * 8192, R, C); const int Rb = Epi::PERM ? ((R & ~31) + perm32(R & 31)) : R;
        voffA[i] = (unsigned)(R * K + C) * 2u; voffB[i] = (unsigned)(Rb * K + C) * 2u; }
    const size_t kstep = (size_t)(BK * 2);
    const size_t hstep = (size_t)HALF * K * 2;
    const size_t tstep = 2 * hstep;
    const unsigned ldsw = (unsigned)wid * 1024u;
    const int aoff = lds_byte(wr * 64 + fr, fq * 8), boff = lds_byte(wc * 32 + fr, fq * 8);
#define PG8_SA(b, h) (((b) * 2 + (h)) * HTB)
#define PG8_SB(b, h) ((4 + (b) * 2 + (h)) * HTB)
#define PG8_STAGE(bufoff, gbase, voff) do { _Pragma("unroll") for (int _i = 0; _i < 2; ++_i) \
        __builtin_amdgcn_global_load_lds((const unsigned*)((const char*)(gbase) + (voff)[_i]), (PG8_LAS unsigned*)(lds + (bufoff) + ldsw + _i * 8192), 16, 0, 0); } while (0)
#define PG8_LDA(dst, b, h) do { _Pragma("unroll") for (int m = 0; m < 4; ++m) _Pragma("unroll") for (int k = 0; k < 2; ++k) dst[m][k] = *(const PG8_LAS bf16x8*)(lds + PG8_SA(b, h) + aoff + m * 2048 + k * 1024); } while (0)
#define PG8_LDB(dst, b, h) do { _Pragma("unroll") for (int n = 0; n < 2; ++n) _Pragma("unroll") for (int k = 0; k < 2; ++k) dst[n][k] = *(const PG8_LAS bf16x8*)(lds + PG8_SB(b, h) + boff + n * 2048 + k * 1024); } while (0)
#define PG8_MMA(ai, bj, At, Bt) do { __builtin_amdgcn_s_setprio(1); _Pragma("unroll") for (int m = 0; m < 4; ++m) _Pragma("unroll") for (int n = 0; n < 2; ++n) _Pragma("unroll") for (int k = 0; k < 2; ++k) \
        acc[ai][bj][m][n] = __builtin_amdgcn_mfma_f32_16x16x32_bf16(Bt[n][k], At[m][k], acc[ai][bj][m][n], 0, 0, 0); __builtin_amdgcn_s_setprio(0); } while (0)
#define PG8_WAIT_V(n) asm volatile("s_waitcnt vmcnt(" #n ")" ::: "memory")
#define PG8_WAIT_L(n) asm volatile("s_waitcnt lgkmcnt(" #n ")" ::: "memory")
#define PG8_BAR __builtin_amdgcn_s_barrier()
#define PG8_SCHED __builtin_amdgcn_sched_barrier(0)
    Unit cur, nxt; int ui = 0;
    if (!S.next(0, cur)) return;
    f32x4 acc[2][2][4][2];
#pragma unroll
    for (int a = 0; a < 2; ++a)
#pragma unroll
        for (int b = 0; b < 2; ++b)
#pragma unroll
            for (int m = 0; m < 4; ++m)
#pragma unroll
                for (int n = 0; n < 2; ++n) acc[a][b][m][n] = (f32x4){0.f, 0.f, 0.f, 0.f};
    bf16x8 At[4][2], B0[2][2], B1[2][2];
    const char* cA = (const char*)g.A + (size_t)cur.pm * tstep; const char* cB = (const char*)g.Bt + (size_t)cur.pn * tstep;
    S.a_ready(cur);
    if constexpr (SP2) {
        PG8_STAGE(PG8_SB(0, 0), cB, voffB); PG8_STAGE(PG8_SB(0, 1), cB + hstep, voffB); PG8_STAGE(PG8_SA(0, 0), cA, voffA); PG8_STAGE(PG8_SA(0, 1), cA + hstep, voffA);
        if (wr == 1) PG8_BAR;
        PG8_WAIT_V(2); PG8_BAR;
        PG8_STAGE(PG8_SB(1, 0), cB + kstep, voffB); PG8_STAGE(PG8_SA(1, 0), cA + kstep, voffA); PG8_STAGE(PG8_SB(1, 1), cB + hstep + kstep, voffB);
        PG8_WAIT_V(6); PG8_BAR;
    } else {
        PG8_STAGE(PG8_SB(0, 0), cB, voffB); PG8_STAGE(PG8_SA(0, 0), cA, voffA); PG8_STAGE(PG8_SB(0, 1), cB + hstep, voffB); PG8_STAGE(PG8_SA(0, 1), cA + hstep, voffA);
        if (wr == 1) PG8_BAR;
        PG8_WAIT_V(4); PG8_BAR;
        PG8_STAGE(PG8_SB(1, 0), cB + kstep, voffB); PG8_STAGE(PG8_SA(1, 0), cA + kstep, voffA); PG8_STAGE(PG8_SB(1, 1), cB + hstep + kstep, voffB);
        PG8_WAIT_V(6); PG8_BAR;
    }
    for (;;) {
        const bool has_next = S.next(ui + 1, nxt);
        const char* nA = has_next ? (const char*)g.A + (size_t)nxt.pm * tstep : cA; const char* nB = has_next ? (const char*)g.Bt + (size_t)nxt.pn * tstep : cB;
        for (int t = 0; t < nt; t += 2) {
            const bool last = (t == nt - 2);
            const char* a1 = cA + (size_t)(t + 1) * kstep;
            const char* a2 = last ? nA : cA + (size_t)(t + 2) * kstep; const char* b2 = last ? nB : cB + (size_t)(t + 2) * kstep;
            const char* a3 = a2 + kstep; const char* b3 = b2 + kstep;
            if (last && has_next) S.a_ready(nxt);
            if constexpr (SP2) {
            PG8_LDB(B0, 0, 0); PG8_LDB(B1, 0, 1); PG8_SCHED; PG8_LDA(At, 0, 0); PG8_STAGE(PG8_SA(1, 1), a1 + hstep, voffA);
            PG8_WAIT_V(8); PG8_WAIT_L(0); PG8_BAR; PG8_MMA(0, 0, At, B0); PG8_MMA(0, 1, At, B1); PG8_BAR; PG8_SCHED;
            PG8_LDA(At, 0, 1); PG8_STAGE(PG8_SB(0, 0), b2, voffB); PG8_STAGE(PG8_SB(0, 1), b2 + hstep, voffB); PG8_STAGE(PG8_SA(0, 0), a2, voffA);
            PG8_WAIT_V(8); PG8_WAIT_L(0); PG8_BAR; PG8_MMA(1, 0, At, B0); PG8_MMA(1, 1, At, B1); PG8_BAR; PG8_SCHED;
            PG8_LDB(B0, 1, 0); PG8_LDB(B1, 1, 1); PG8_SCHED; PG8_LDA(At, 1, 0); PG8_STAGE(PG8_SA(0, 1), a2 + hstep, voffA);
            PG8_WAIT_V(8); PG8_WAIT_L(0); PG8_BAR; PG8_MMA(0, 0, At, B0); PG8_MMA(0, 1, At, B1); PG8_BAR; PG8_SCHED;
            PG8_LDA(At, 1, 1); PG8_STAGE(PG8_SB(1, 0), b3, voffB); PG8_STAGE(PG8_SB(1, 1), b3 + hstep, voffB); PG8_STAGE(PG8_SA(1, 0), a3, voffA);
            PG8_WAIT_V(8); PG8_WAIT_L(0); PG8_BAR; PG8_MMA(1, 0, At, B0); PG8_MMA(1, 1, At, B1); PG8_BAR; PG8_SCHED;
            } else {
            PG8_LDB(B0, 0, 0); PG8_SCHED; PG8_LDA(At, 0, 0); PG8_STAGE(PG8_SA(1, 1), a1 + hstep, voffA);
            PG8_WAIT_L(8); PG8_BAR; PG8_WAIT_L(0); PG8_MMA(0, 0, At, B0); PG8_BAR; PG8_SCHED;
            PG8_LDB(B1, 0, 1); PG8_STAGE(PG8_SB(0, 0), b2, voffB);
            PG8_BAR; PG8_WAIT_L(0); PG8_MMA(0, 1, At, B1); PG8_BAR;
            PG8_LDA(At, 0, 1); PG8_STAGE(PG8_SA(0, 0), a2, voffA);
            PG8_BAR; PG8_WAIT_L(0); PG8_MMA(1, 0, At, B0); PG8_BAR; PG8_SCHED;
            PG8_STAGE(PG8_SB(0, 1), b2 + hstep, voffB);
            PG8_WAIT_V(6); PG8_BAR; PG8_MMA(1, 1, At, B1); PG8_BAR;
            PG8_LDB(B0, 1, 0); PG8_SCHED; PG8_LDA(At, 1, 0); PG8_STAGE(PG8_SA(0, 1), a2 + hstep, voffA);
            PG8_WAIT_L(8); PG8_BAR; PG8_WAIT_L(0); PG8_MMA(0, 0, At, B0); PG8_BAR; PG8_SCHED;
            PG8_LDB(B1, 1, 1); PG8_STAGE(PG8_SB(1, 0), b3, voffB);
            PG8_BAR; PG8_WAIT_L(0); PG8_MMA(0, 1, At, B1); PG8_BAR;
            PG8_LDA(At, 1, 1); PG8_STAGE(PG8_SA(1, 0), a3, voffA);
            PG8_BAR; PG8_WAIT_L(0); PG8_MMA(1, 0, At, B0); PG8_BAR; PG8_SCHED;
            PG8_STAGE(PG8_SB(1, 1), b3 + hstep, voffB);
            PG8_WAIT_V(6); PG8_BAR; PG8_MMA(1, 1, At, B1); PG8_BAR;
            }
        }
        if constexpr (ALIGN_EPI) { if (wr == 0) PG8_BAR; }
        if constexpr (!Epi::AFTER_DRAIN) { E(acc, cur, wr, wc, fr, fq); S.done(cur); }
        if (!has_next) break;
#pragma unroll
        for (int a = 0; a < 2; ++a)
#pragma unroll
            for (int b = 0; b < 2; ++b)
#pragma unroll
                for (int m = 0; m < 4; ++m)
#pragma unroll
                    for (int n = 0; n < 2; ++n) acc[a][b][m][n] = (f32x4){0.f, 0.f, 0.f, 0.f};
        cur = nxt; cA = nA; cB = nB; ++ui;
        if constexpr (ALIGN_EPI) { if (wr == 1) PG8_BAR; }
    }
    PG8_WAIT_V(0);
    if constexpr (!ALIGN_EPI) { if (wr == 0) PG8_BAR; }
    PG8_BAR;
    if constexpr (Epi::AFTER_DRAIN) { E.fused(acc, cur, wr, wc, fr, fq, lds, wid, lane); S.done(cur); }
#undef PG8_SA
#undef PG8_SB
#undef PG8_STAGE
#undef PG8_LDA
#undef PG8_LDB
#undef PG8_MMA
#undef PG8_WAIT_V
#undef PG8_WAIT_L
#undef PG8_BAR
#undef PG8_SCHED
}
}
constexpr int NWAVES = 8;
constexpr int BATCH = 4, SEQ = 8192, D = 2048, M = BATCH * SEQ, NIN = 4096, LW = 1024, CHUNK = 128, NCHUNK = SEQ / CHUNK;
constexpr int NEXP = 16384;
#ifndef MK_N_LAUNCHES
#define MK_N_LAUNCHES 1
#endif
constexpr int N_LAUNCHES = MK_N_LAUNCHES;
constexpr int PER_PHASE = 11;
constexpr size_t MiB = 1u << 20;
constexpr size_t WS_CTL = 0, CTL_ZERO_BYTES = 1 * MiB;
constexpr size_t WS_ROWSS = 512 * 1024;
constexpr size_t WS_WIN = 2 * MiB, WS_WOUT = 18 * MiB, WS_WQ = 26 * MiB, WS_LRUW = 34 * MiB, WS_WSB = 35 * MiB, WS_AGG = 36 * MiB;
constexpr size_t WS_U = 64 * MiB, WS_V = 128 * MiB, WS_XN = 192 * MiB  , WS_Z = 320 * MiB  ;
constexpr size_t WS_HB = 576 * MiB, WS_IDS = 704 * MiB, WS_GATES = 720 * MiB, WS_PAIRS = 736 * MiB, WS_HBT = 752 * MiB, WS_END = 884 * MiB;
constexpr size_t WS_USCALE = 40 * MiB, WS_VSCALE = 41 * MiB;
constexpr size_t WS_HSCALE = 44 * MiB, WS_CARRY = 45 * MiB;
constexpr size_t WS_H8 = WS_XN, WS_PART = WS_XN + 64 * MiB;
constexpr size_t WS_ASCALE = 42 * MiB, WS_KH = 43 * MiB;
constexpr size_t WS_IDW = WS_PAIRS, WS_AW = 880 * MiB;
constexpr size_t WS_ROWSS2 = 640 * 1024;
constexpr size_t WS_Y = WS_Z;
constexpr int CW_BAR = 4096;
constexpr int RING_BYTES = 131072;
constexpr int LDSCTL_OFF = 143360, MISC_OFF = LDSCTL_OFF + 320;
constexpr int LDS_BYTES = 147456;
#define GAS __attribute__((address_space(1)))
#define LAS __attribute__((address_space(3)))
typedef unsigned short bf16;
typedef unsigned v4u __attribute__((ext_vector_type(4)));
typedef float f32x4 __attribute__((ext_vector_type(4)));
typedef short bf16x8 __attribute__((ext_vector_type(8)));
typedef GAS unsigned gu32;
typedef GAS unsigned long long gu64;
#define RLX_AGENT __ATOMIC_RELAXED, __HIP_MEMORY_SCOPE_AGENT
#define LDS_WAIT() asm volatile("s_waitcnt lgkmcnt(0)" ::: "memory")
#define VM_WAIT() asm volatile("s_waitcnt vmcnt(0)" ::: "memory")
__device__ __forceinline__ unsigned long long rt() { return __builtin_amdgcn_s_memrealtime(); }
__device__ __forceinline__ unsigned f2bf(float f) { unsigned u = __builtin_bit_cast(unsigned, f); return (u + 0x7fffu + ((u >> 16) & 1u)) >> 16; }
__device__ __forceinline__ unsigned pk2(float lo, float hi) { return f2bf(lo) | (f2bf(hi) << 16); }

#define XB_TMO      128
#define XB_XCNT(j)  (256  + 64 * (j))
#define XB_XSUB(j)  (1280 + 64 * (j))
#define XB_XGEN(j)  (2304 + 64 * (j))
#define XB_TOP      3328
#define XB_TOPGEN   3392
#define XCD_BAR_WORDS 3456
#define XB_SPIN_CAP (1u << 18)

__device__ __forceinline__ unsigned xb_ld(unsigned* p)              { return __hip_atomic_load(p, __ATOMIC_RELAXED, __HIP_MEMORY_SCOPE_AGENT); }
__device__ __forceinline__ unsigned xb_add(unsigned* p, unsigned v) { return __hip_atomic_fetch_add(p, v, __ATOMIC_RELAXED, __HIP_MEMORY_SCOPE_AGENT); }
__device__ __forceinline__ unsigned xb_xcc_id() { return (unsigned)__builtin_amdgcn_s_getreg((3 << 11) | 20) & 0xFu; }
#define XB_SPIN(cond, bar) do { unsigned _sp = 0; while (cond) { __builtin_amdgcn_s_sleep(1); \
    if ((++_sp & 255u) == 0u) { if (xb_ld(&(bar)[XB_TMO])) break; if (_sp > XB_SPIN_CAP) { atomicAdd(&(bar)[XB_TMO], 1u); break; } } } } while (0)

struct XcdBarrier {
    unsigned* bar; unsigned x;
    volatile LAS unsigned* st;
};

__device__ __forceinline__ XcdBarrier xcd_barrier_post(unsigned* bar, volatile LAS unsigned* st) {
    XcdBarrier b; b.bar = bar; b.x = xb_xcc_id(); b.st = st;
    if (threadIdx.x == 0) (void)xb_add(&bar[XB_XCNT(b.x)], 1u);
    return b;
}
__device__ __forceinline__ void xcd_barrier_complete(unsigned* bar, unsigned x, unsigned& nloc, unsigned& nx) {
    const unsigned G = gridDim.x * gridDim.y * gridDim.z;
    unsigned sum, cnt, mine, sp = 0u;
    for (;;) {
        sum = 0u; cnt = 0u; mine = 0u;
#pragma unroll
        for (unsigned j = 0; j < 16; ++j) { const unsigned c = xb_ld(&bar[XB_XCNT(j)]); sum += c; cnt += (c > 0u) ? 1u : 0u; mine = (j == x) ? c : mine; }
        if (sum == G) break;
        __builtin_amdgcn_s_sleep(1);
        if ((++sp & 255u) == 0u) { if (xb_ld(&bar[XB_TMO])) break; if (sp > XB_SPIN_CAP) { atomicAdd(&bar[XB_TMO], 1u); break; } }
    }
    nloc = mine > 0u ? mine : 1u; nx = cnt > 0u ? cnt : 1u;
}

__device__ __forceinline__ void xcd_barrier(const XcdBarrier& b) {
    asm volatile("s_waitcnt vmcnt(0)" ::: "memory");
    __syncthreads();
    if (threadIdx.x == 0) {
        unsigned* bar = b.bar;
        __builtin_amdgcn_s_waitcnt(0);
        unsigned nloc = b.st[0], nx = b.st[1];
        if (nloc == 0u) { xcd_barrier_complete(bar, b.x, nloc, nx); b.st[0] = nloc; b.st[1] = nx; }
        const unsigned old = xb_add(&bar[XB_XSUB(b.x)], 1u);
        const unsigned gen = old / nloc;
        if (old + 1u == (gen + 1u) * nloc) {
            __builtin_amdgcn_fence(__ATOMIC_RELEASE, "agent");
            asm volatile("s_waitcnt vmcnt(0)" ::: "memory");
            const unsigned og = xb_add(&bar[XB_TOP], 1u);
            const unsigned tg = og / nx;
            if (og + 1u == (tg + 1u) * nx) xb_add(&bar[XB_TOPGEN], 1u);
            else XB_SPIN(xb_ld(&bar[XB_TOPGEN]) == tg, bar);
            __builtin_amdgcn_fence(__ATOMIC_ACQUIRE, "agent");
            xb_add(&bar[XB_XGEN(b.x)], 1u);
            asm volatile("s_waitcnt vmcnt(0)" ::: "memory");
        } else {
            XB_SPIN(xb_ld(&bar[XB_XGEN(b.x)]) == gen, bar);
            __builtin_amdgcn_fence(__ATOMIC_ACQUIRE, "agent");
            asm volatile("s_waitcnt vmcnt(0)" ::: "memory");
        }
    }
    __syncthreads();
}
typedef unsigned v2u __attribute__((ext_vector_type(2)));
typedef float f32x2 __attribute__((ext_vector_type(2)));
struct Args { const float* in[21]; float* out; unsigned char* ws; int ph_lo, ph_hi; };
struct Frame {
    const Args& A;
    LAS unsigned char* lds;
    volatile LAS unsigned* MISC;
    gu32* ctl;
    unsigned char* ws;
    int tid, lane, wave, vcu, G;
    __device__ __forceinline__ Frame(const Args& a) : A(a) {}
#define WSP(name, type, off) __device__ __forceinline__ type* name() const { return (type*)(ws + (off)); }
    WSP(WIN, bf16, WS_WIN) WSP(WOUT, bf16, WS_WOUT) WSP(WQ, bf16, WS_WQ) WSP(LRUW, bf16, WS_LRUW) WSP(WSB, bf16, WS_WSB)
    WSP(XN, bf16, WS_XN) WSP(MIX, bf16, WS_XN) WSP(Z, bf16, WS_Z) WSP(HB, bf16, WS_HB) WSP(HBT, bf16, WS_HBT)
    WSP(U8, unsigned char, WS_U) WSP(V8T, unsigned char, WS_V)
    WSP(ROWSS, float, WS_ROWSS) WSP(ROWSS2, float, WS_ROWSS2) WSP(QH, bf16, WS_Z) WSP(QL, bf16, WS_Z + 128 * MiB) WSP(KH, bf16, WS_KH) WSP(KL, bf16, WS_KH + 512 * 1024) WSP(AGG, float, WS_AGG) WSP(CARRY, float, WS_CARRY) WSP(GATES, float, WS_GATES)
    WSP(USCALE, float, WS_USCALE) WSP(VSCALE, float, WS_VSCALE) WSP(Y, bf16, WS_Y) WSP(IDS, int, WS_IDS) WSP(ASCALE, float, WS_ASCALE) WSP(IDW, v4u, WS_IDW) WSP(AW, unsigned, WS_AW) WSP(H8, unsigned char, WS_H8) WSP(HSCALE, float, WS_HSCALE) WSP(PART, int, WS_PART)
#undef WSP
};
__device__ __forceinline__ float wave_sum(float v) {
#pragma unroll
    for (int o = 1; o < 64; o <<= 1) v += __shfl_xor(v, o);
    return v;
}
__device__ __forceinline__ float bf_lo(unsigned w) { return __builtin_bit_cast(float, w << 16); }
__device__ __forceinline__ float bf_hi(unsigned w) { return __builtin_bit_cast(float, w & 0xffff0000u); }
__device__ __forceinline__ float bf1(unsigned short h) { return __builtin_bit_cast(float, (unsigned)h << 16); }
__device__ __forceinline__ float sigmoidf_(float x) { return __builtin_amdgcn_rcpf(1.0f + __builtin_amdgcn_exp2f(-1.4426950409f * x)); }
using pg8::gelu_tanh;
__device__ __forceinline__ unsigned pack_i8x4(float a, float b, float c, float d) {
    const int ia = (int)__builtin_rintf(a), ib = (int)__builtin_rintf(b), ic = (int)__builtin_rintf(c), id = (int)__builtin_rintf(d);
    return (unsigned)(ia & 0xff) | ((unsigned)(ib & 0xff) << 8) | ((unsigned)(ic & 0xff) << 16) | ((unsigned)id << 24);
}

__device__ __forceinline__ void p0_transpose_item(const float* W, int K, int N, bf16* WT, const float* kscale, LAS float* scr, int item, int lane) {
    const int nblk = N / 32, kb = item / nblk, nb = item % nblk, k0 = 64 * kb, n0 = 32 * nb;
#pragma unroll 8
    for (int i = 0; i < 32; ++i) { const int kk = 2 * i + (lane >> 5); const float sc = kscale ? kscale[k0 + kk] : 1.0f; scr[kk * 33 + (lane & 31)] = W[(size_t)(k0 + kk) * N + n0 + (lane & 31)] * sc; }
    LDS_WAIT(); asm volatile("" ::: "memory");
    const int c = lane & 7;
#pragma unroll
    for (int j = 0; j < 4; ++j) { const int n = (lane >> 3) + 8 * j; const LAS float* s = scr + (8 * c) * 33 + n;
        v4u o; o.x = pk2(s[0 * 33], s[1 * 33]); o.y = pk2(s[2 * 33], s[3 * 33]); o.z = pk2(s[4 * 33], s[5 * 33]); o.w = pk2(s[6 * 33], s[7 * 33]);
        *(GAS v4u*)(WT + (size_t)(n0 + n) * K + k0 + 8 * c) = o; }
    LDS_WAIT(); asm volatile("" ::: "memory");
}
__device__ __forceinline__ void p0_prologue(Frame& F) {
    LAS float* scr = (LAS float*)(F.lds + F.wave * 16384);
    const int gw = F.vcu * NWAVES + F.wave, NGW = F.G * NWAVES, lane = F.lane;
    constexpr int I_IN = (D / 64) * (NIN / 32), I_OUT = (D / 64) * (D / 32), I_Q = I_OUT, I_LRU = 32 * 8;
    constexpr int NITEMS = I_IN + I_OUT + I_Q + I_LRU;
    for (int it = gw; it < NITEMS; it += NGW) {
        int r = it;
        if (r < I_IN) { p0_transpose_item(F.A.in[2], D, NIN, F.WIN(), F.A.in[1], scr, r, lane); continue; } r -= I_IN;
        if (r < I_OUT) { p0_transpose_item(F.A.in[14], D, D, F.WOUT(), nullptr, scr, r, lane); continue; } r -= I_OUT;
        if (r < I_Q) { p0_transpose_item(F.A.in[16], D, D, F.WQ(), F.A.in[15], scr, r, lane); continue; } r -= I_Q;
        { const int mi = r >> 3, sub = r & 7, gate = mi >> 4, rest = mi & 15;
          const float* src = (gate ? F.A.in[7] : F.A.in[5]) + (size_t)rest * 16384;
          p0_transpose_item(src, 128, 128, F.LRUW() + (size_t)mi * 16384, nullptr, scr, sub, lane); }
    }
    const size_t gt = (size_t)gw * 64 + lane, NGT = (size_t)NGW * 64;
    {
        const float* g2 = F.A.in[15];
        f32x4 gg[8];
#pragma unroll
        for (int j = 0; j < 8; ++j) gg[j] = *(const GAS f32x4*)(g2 + j * 256 + lane * 4);
        for (int e = gw; e < NEXP; e += NGW) {
            const GAS f32x4* ur = (const GAS f32x4*)(F.A.in[18] + (size_t)e * D) + lane;
            f32x4 v[8]; float ss = 0.f;
#pragma unroll
            for (int j = 0; j < 8; ++j) { v[j] = ur[64 * j] * gg[j]; ss += (v[j].x * v[j].x + v[j].y * v[j].y) + (v[j].z * v[j].z + v[j].w * v[j].w); }
            const float rms = __builtin_amdgcn_sqrtf(wave_sum(ss) * (1.0f / D));
            const float sc = rms > 0.f ? 7.0f / (2.8f * rms) : 1.0f;
            GAS unsigned* o4 = (GAS unsigned*)(F.U8() + (size_t)e * 1024) + (lane >> 1);
#pragma unroll
            for (int j = 0; j < 8; ++j) {
                const int c0 = (int)fminf(fmaxf(__builtin_rintf(v[j].x * sc), -7.f), 7.f) & 15, c1 = (int)fminf(fmaxf(__builtin_rintf(v[j].y * sc), -7.f), 7.f) & 15;
                const int c2 = (int)fminf(fmaxf(__builtin_rintf(v[j].z * sc), -7.f), 7.f) & 15, c3 = (int)fminf(fmaxf(__builtin_rintf(v[j].w * sc), -7.f), 7.f) & 15;
                const unsigned cw = (unsigned)c0 | ((unsigned)c1 << 8) | ((unsigned)c2 << 16) | ((unsigned)c3 << 24);
                const unsigned pw = (unsigned)__shfl_xor((int)cw, 1);
                if ((lane & 1) == 0) o4[32 * j] = cw | (pw << 4);
            }
            if (lane == 0) F.USCALE()[e] = rms > 0.f ? 2.8f * rms * (1.0f / 7.0f) : 1.0f;
        }
    }
    __syncthreads();
    for (int un = blockIdx.x; un < NEXP / 64; un += F.G) {
        const int e0 = un * 64;
        for (int rr = 0; rr < 8; ++rr) {
            const int el = F.wave * 8 + rr, e = e0 + el;
            const GAS f32x4* vr = (const GAS f32x4*)(F.A.in[19] + (size_t)e * D) + lane;
            f32x4 v[8]; float mx = 0.f;
#pragma unroll
            for (int j = 0; j < 8; ++j) { v[j] = vr[64 * j]; mx = fmaxf(mx, fmaxf(fmaxf(fabsf(v[j].x), fabsf(v[j].y)), fmaxf(fabsf(v[j].z), fabsf(v[j].w)))); }
#pragma unroll
            for (int o = 1; o < 64; o <<= 1) mx = fmaxf(mx, __shfl_xor(mx, o));
            const float sc = mx > 0.f ? 127.0f / mx : 1.0f;
#pragma unroll
            for (int j = 0; j < 8; ++j) *(LAS unsigned*)(F.lds + el * 2056 + j * 256 + lane * 4) = pack_i8x4(v[j].x * sc, v[j].y * sc, v[j].z * sc, v[j].w * sc);
            if (lane == 0) F.VSCALE()[e] = mx > 0.f ? mx * (1.0f / 127.0f) : 1.0f;
        }
        __syncthreads();
        for (int cc = 0; cc < 32; ++cc) { const int c = F.wave * 32 + cc;
            const v2u w = *(const LAS v2u*)(F.lds + lane * 2056 + c * 8);
            *(GAS v2u*)(F.V8T() + ((size_t)c * NEXP + e0 + lane) * 8) = w; }
        __syncthreads();
    }
    for (size_t ch = gt; ch < (size_t)8 * 128 * 128 / 8; ch += NGT) {
        const size_t e0 = ch * 8;
        const f32x4 a = *(const GAS f32x4*)(F.A.in[12] + e0), b = *(const GAS f32x4*)(F.A.in[12] + e0 + 4);
        v4u o; o.x = pk2(a.x, a.y); o.y = pk2(a.z, a.w); o.z = pk2(b.x, b.y); o.w = pk2(b.z, b.w);
        *(GAS v4u*)(F.WSB() + e0) = o;
    }
    for (size_t ch = gt; ch < (size_t)16 * 128 * 128 / 8; ch += NGT) {
        const size_t e0 = ch * 8;
        const f32x4 a = *(const GAS f32x4*)(F.A.in[17] + e0), b = *(const GAS f32x4*)(F.A.in[17] + e0 + 4);
        v4u hi; hi.x = pk2(a.x, a.y); hi.y = pk2(a.z, a.w); hi.z = pk2(b.x, b.y); hi.w = pk2(b.z, b.w);
        *(GAS v4u*)(F.KH() + e0) = hi;
    }
    for (int m = gw; m < M; m += NGW) {
        const GAS f32x4* xr = (const GAS f32x4*)(F.A.in[0] + (size_t)m * D) + lane;
        f32x4 v[8]; float s = 0.f;
#pragma unroll
        for (int j = 0; j < 8; ++j) { v[j] = xr[64 * j]; s += (v[j].x * v[j].x + v[j].y * v[j].y) + (v[j].z * v[j].z + v[j].w * v[j].w); }
        const float rstd = __builtin_amdgcn_rsqf(wave_sum(s) * (1.f / D) + 1e-6f);
        GAS unsigned long long* o8 = (GAS unsigned long long*)(F.XN() + (size_t)m * D) + lane;
#pragma unroll
        for (int j = 0; j < 8; ++j) o8[64 * j] = (unsigned long long)pk2(v[j].x * rstd, v[j].y * rstd) | ((unsigned long long)pk2(v[j].z * rstd, v[j].w * rstd) << 32);
    }
}
constexpr int LRU_XR = 0, LRU_XC = 33792, LRU_GR = 33792 + 40960;
constexpr float LOG2E = 1.4426950408889634f;
__device__ __forceinline__ int xc_off(int tok, int ch) { return tok * 320 + (tok >> 5) * 16 + ch * 2; }
template <bool APPLY, int DIR>
__device__ __forceinline__ void lru_dir(Frame& F, int b, int c, int h, const bf16x8 (&Ba)[4], const bf16x8 (&Bx)[4], float (&hsum)[8][4]) {
    const int lane = F.lane, w = F.wave, fr = lane & 15, fq = lane >> 4;
    LAS unsigned char* XC = F.lds + LRU_XC;
    const int chl = 16 * w + fr, chg = h * 128 + chl;
    const float ba = F.A.in[6][DIR * LW + chg], bx = F.A.in[8][DIR * LW + chg], lam = F.A.in[9][DIR * LW + chg];
    const float cl = -8.0f * log1pf(__expf(-lam)) * LOG2E;
    float carry = 0.f;
    if (APPLY) carry = F.CARRY()[(size_t)((b * 2 + DIR) * NCHUNK + c) * LW + chg];
    f32x4 R[8], I[8];
    const int arow = (fr >> 2) * 32 + (fr & 3);
#pragma unroll
    for (int m = 0; m < 8; ++m) {
        R[m] = (f32x4){0.f, 0.f, 0.f, 0.f}; I[m] = (f32x4){0.f, 0.f, 0.f, 0.f};
#pragma unroll
        for (int ks = 0; ks < 4; ++ks) {
            const bf16x8 a = *(const LAS bf16x8*)(XC + xc_off(arow + 4 * m, 32 * ks + 8 * fq));
            R[m] = __builtin_amdgcn_mfma_f32_16x16x32_bf16(a, Ba[ks], R[m], 0, 0, 0);
            I[m] = __builtin_amdgcn_mfma_f32_16x16x32_bf16(a, Bx[ks], I[m], 0, 0, 0);
        }
    }
    float P = 1.f, L = 0.f;
#pragma unroll
    for (int mm = 0; mm < 8; ++mm) {
        const int m = DIR == 0 ? mm : 7 - mm;
#pragma unroll
        for (int jj = 0; jj < 4; ++jj) {
            const int j = DIR == 0 ? jj : 3 - jj;
            const float r = sigmoidf_(R[m][j] + ba), ig = sigmoidf_(I[m][j] + bx);
            const float a = __builtin_amdgcn_exp2f(cl * r);
            const float xc = bf1(*(const LAS unsigned short*)(XC + xc_off(32 * fq + 4 * m + j, chl)));
            const float u = __builtin_amdgcn_sqrtf(fmaxf(1.0f - a * a, 0.0f)) * (ig * xc);
            L = a * L + u; P = a * P;
            R[m][j] = P; I[m][j] = L;
        }
    }
    const int src1 = DIR == 0 ? lane - 16 : lane + 16, src2 = DIR == 0 ? lane - 32 : lane + 32;
    const bool v1 = DIR == 0 ? (fq >= 1) : (fq <= 2), v2 = DIR == 0 ? (fq >= 2) : (fq <= 1);
    float A = P, B = L;
    { const float pa = __shfl(A, src1), pb = __shfl(B, src1); if (v1) { B = A * pb + B; A = A * pa; } }
    { const float pa = __shfl(A, src2), pb = __shfl(B, src2); if (v2) { B = A * pb + B; A = A * pa; } }
    if (APPLY) {
        float EA = __shfl(A, src1), EB = __shfl(B, src1); if (!v1) { EA = 1.f; EB = 0.f; }
        const float hin = EA * carry + EB;
#pragma unroll
        for (int m = 0; m < 8; ++m)
#pragma unroll
            for (int j = 0; j < 4; ++j) { const float hh = R[m][j] * hin + I[m][j]; if (DIR == 0) hsum[m][j] = hh; else hsum[m][j] += hh; }
    } else {
        const bool lastlane = DIR == 0 ? (fq == 3) : (fq == 0);
        if (lastlane) { f32x2* agg = (f32x2*)F.AGG() + (size_t)((b * 2 + DIR) * NCHUNK + c) * LW + chg; *agg = (f32x2){A, B}; }
    }
}

template <bool APPLY>
__device__ __forceinline__ void lru_unit(Frame& F, int unit) {
    const int h = unit & 7, c = (unit >> 3) & 63, b = unit >> 9;
    const int tid = F.tid, lane = F.lane, w = F.wave, fr = lane & 15, fq = lane >> 4;
    const size_t t0 = (size_t)b * SEQ + (size_t)c * CHUNK;
    LAS unsigned char* XR = F.lds + LRU_XR; LAS unsigned char* XC = F.lds + LRU_XC; LAS unsigned char* GR = F.lds + LRU_GR;
    bf16x8 Ba0[4], Bx0[4], Ba1[4], Bx1[4];
    {
        const bf16* wb = F.LRUW() + (size_t)h * 16384 + (size_t)(16 * w + fr) * 128 + 8 * fq;
#pragma unroll
        for (int ks = 0; ks < 4; ++ks) { Ba0[ks] = *(const GAS bf16x8*)(wb + 32 * ks); Ba1[ks] = *(const GAS bf16x8*)(wb + (size_t)8 * 16384 + 32 * ks);
            Bx0[ks] = *(const GAS bf16x8*)(wb + (size_t)16 * 16384 + 32 * ks); Bx1[ks] = *(const GAS bf16x8*)(wb + (size_t)24 * 16384 + 32 * ks); }
    }
    for (int p = tid; p < 131 * 16; p += 512) { const int r = p >> 4, cg = p & 15; const int s = c * CHUNK - 2 + r; v4u v = (v4u){0u, 0u, 0u, 0u};
        if (s >= 0 && s < SEQ) v = *(const GAS v4u*)(F.Z() + ((size_t)b * SEQ + s) * NIN + h * 128 + cg * 8);
        *(LAS v4u*)(XR + r * 256 + cg * 16) = v; }
    if (APPLY) { for (int p = tid; p < 128 * 32; p += 512) { const int r = p >> 5, cg = p & 31;
        *(LAS v2u*)(GR + r * 264 + cg * 8) = *(const GAS v2u*)(F.Z() + (t0 + r) * NIN + LW + h * 128 + cg * 4); } }
    __syncthreads();
    {
        const int ch2 = tid & 63, tg = tid >> 6, chg = h * 128 + 2 * ch2;
        float w0[4], w1[4];
#pragma unroll
        for (int k = 0; k < 4; ++k) { w0[k] = F.A.in[3][k * LW + chg]; w1[k] = F.A.in[3][k * LW + chg + 1]; }
        const float b0 = F.A.in[4][chg], b1 = F.A.in[4][chg + 1];
        float x0[4], x1[4];
#pragma unroll
        for (int k = 0; k < 3; ++k) { const unsigned u = *(const LAS unsigned*)(XR + (16 * tg + k) * 256 + ch2 * 4); x0[k] = bf_lo(u); x1[k] = bf_hi(u); }
#pragma unroll
        for (int j = 0; j < 16; ++j) {
            const unsigned u = *(const LAS unsigned*)(XR + (16 * tg + j + 3) * 256 + ch2 * 4); x0[3] = bf_lo(u); x1[3] = bf_hi(u);
            const float y0 = b0 + ((w0[0] * x0[0] + w0[1] * x0[1]) + (w0[2] * x0[2] + w0[3] * x0[3]));
            const float y1 = b1 + ((w1[0] * x1[0] + w1[1] * x1[1]) + (w1[2] * x1[2] + w1[3] * x1[3]));
            *(LAS unsigned*)(XC + xc_off(16 * tg + j, 2 * ch2)) = pk2(y0, y1);
            x0[0] = x0[1]; x0[1] = x0[2]; x0[2] = x0[3]; x1[0] = x1[1]; x1[1] = x1[2]; x1[2] = x1[3];
        }
    }
    __syncthreads();
    float hsum[8][4];
    lru_dir<APPLY, 0>(F, b, c, h, Ba0, Bx0, hsum);
    asm volatile("" ::: "memory"); __builtin_amdgcn_sched_barrier(0);
    lru_dir<APPLY, 1>(F, b, c, h, Ba1, Bx1, hsum);
    if (APPLY) {
        const int chl = 16 * w + fr;
#pragma unroll
        for (int m = 0; m < 8; ++m)
#pragma unroll
            for (int j = 0; j < 4; ++j) { LAS unsigned short* p = (LAS unsigned short*)(GR + (32 * fq + 4 * m + j) * 264 + chl * 2); *p = (unsigned short)f2bf(bf1(*p) * hsum[m][j]); }
        __syncthreads();
        for (int p = tid; p < 128 * 32; p += 512) { const int r = p >> 5, cg = p & 31;
            *(GAS v2u*)(F.MIX() + (t0 + r) * D + h * 128 + cg * 4) = *(const LAS v2u*)(GR + r * 264 + cg * 8); }
    }
    __syncthreads();
}
__device__ __forceinline__ void lru_carry(Frame& F) {
    const int idx = (F.vcu * NWAVES + F.wave) * 64 + F.lane;
    if (idx >= BATCH * 2 * LW) return;
    const int ch = idx & (LW - 1), bd = idx >> 10, dir = bd & 1;
    const f32x2* agg = (const f32x2*)F.AGG() + (size_t)bd * NCHUNK * LW + ch; float* cr = F.CARRY() + (size_t)bd * NCHUNK * LW + ch;
    float st = 0.f;
#pragma unroll 8
    for (int i = 0; i < NCHUNK; ++i) { const int cc = dir == 0 ? i : NCHUNK - 1 - i; const f32x2 pe = agg[(size_t)cc * LW]; cr[(size_t)cc * LW] = st; st = pe.x * st + pe.y; }
}
constexpr int GM_ST = 0, GM_BS = 1024, GM_VN = 2048, GM_GU = 2048 + 32768;
typedef short s16x4 __attribute__((ext_vector_type(4)));
__device__ __forceinline__ unsigned vn_off(unsigned row, unsigned ch) { return 256u * row + 16u * (ch ^ (((row & 3u) << 2) | ((row >> 2) & 3u))); }
__device__ __forceinline__ void gmlp_unit(Frame& F, int unit) {
    const int tid = F.tid, lane = F.lane, w = F.wave, fr = lane & 15, fq = lane >> 4;
    const size_t t0 = (size_t)unit * CHUNK;
    LAS float* ST = (LAS float*)(F.lds + GM_ST); LAS float* BS = (LAS float*)(F.lds + GM_BS);
    LAS unsigned char* VN = F.lds + GM_VN; LAS unsigned char* GU = F.lds + GM_GU;
    for (int rr = 0; rr < 16; ++rr) {
        const int row = 16 * w + rr;
        const bf16* p = F.Z() + (t0 + row) * NIN + 3 * LW + lane * 8;
        const v4u a = *(const GAS v4u*)p, b = *(const GAS v4u*)(p + 512);
        float x[16] = {bf_lo(a.x), bf_hi(a.x), bf_lo(a.y), bf_hi(a.y), bf_lo(a.z), bf_hi(a.z), bf_lo(a.w), bf_hi(a.w),
                       bf_lo(b.x), bf_hi(b.x), bf_lo(b.y), bf_hi(b.y), bf_lo(b.z), bf_hi(b.z), bf_lo(b.w), bf_hi(b.w)};
        float s = 0.f;
#pragma unroll
        for (int i = 0; i < 16; ++i) s += x[i];
        const float mean = wave_sum(s) * (1.0f / LW);
        float q = 0.f;
#pragma unroll
        for (int i = 0; i < 16; ++i) { const float d = x[i] - mean; q += d * d; }
        const float rstd = __builtin_amdgcn_rsqf(wave_sum(q) * (1.0f / LW) + 1e-6f);
        if (lane == 0) { ST[2 * row] = mean; ST[2 * row + 1] = rstd; }
    }
    __syncthreads();
    const unsigned trq = (unsigned)(lane & 15) >> 2, trp = (unsigned)lane & 3u;
    for (int h = 0; h < 8; ++h) {
#pragma unroll
        for (int i = 0; i < 4; ++i) { const int pid = tid + 512 * i, q = pid >> 4, cg = pid & 15;
            const v4u a = *(const GAS v4u*)(F.Z() + (t0 + q) * NIN + 3 * LW + h * 128 + cg * 8);
            const float mean = ST[2 * q], rstd = ST[2 * q + 1];
            const f32x4 g0 = *(const GAS f32x4*)(F.A.in[10] + h * 128 + cg * 8), g1 = *(const GAS f32x4*)(F.A.in[10] + h * 128 + cg * 8 + 4);
            const f32x4 b0 = *(const GAS f32x4*)(F.A.in[11] + h * 128 + cg * 8), b1 = *(const GAS f32x4*)(F.A.in[11] + h * 128 + cg * 8 + 4);
            v4u o;
            o.x = pk2((bf_lo(a.x) - mean) * rstd * g0.x + b0.x, (bf_hi(a.x) - mean) * rstd * g0.y + b0.y);
            o.y = pk2((bf_lo(a.y) - mean) * rstd * g0.z + b0.z, (bf_hi(a.y) - mean) * rstd * g0.w + b0.w);
            o.z = pk2((bf_lo(a.z) - mean) * rstd * g1.x + b1.x, (bf_hi(a.z) - mean) * rstd * g1.y + b1.y);
            o.w = pk2((bf_lo(a.w) - mean) * rstd * g1.z + b1.z, (bf_hi(a.w) - mean) * rstd * g1.w + b1.w);
            *(LAS v4u*)(VN + vn_off((unsigned)q, (unsigned)cg)) = o;
        }
#pragma unroll
        for (int i = 0; i < 8; ++i) { const int pid = tid + 512 * i, r = pid >> 5, cg = pid & 31;
            *(LAS v2u*)(GU + r * 264 + cg * 8) = *(const GAS v2u*)(F.Z() + (t0 + r) * NIN + 2 * LW + h * 128 + cg * 4); }
        if (tid < 128) BS[tid] = F.A.in[13][h * 128 + tid];
        bf16x8 Af[4];
        { const bf16* wsb = F.WSB() + (size_t)h * 16384 + (size_t)(16 * w + fr) * 128 + 8 * fq;
#pragma unroll
          for (int ks = 0; ks < 4; ++ks) Af[ks] = *(const GAS bf16x8*)(wsb + 32 * ks); }
        __syncthreads();
        f32x4 acc[8];
#pragma unroll
        for (int n = 0; n < 8; ++n) {
            acc[n] = (f32x4){0.f, 0.f, 0.f, 0.f};
#pragma unroll
            for (int ks = 0; ks < 4; ++ks) {
                const s16x4 b0 = __builtin_amdgcn_ds_read_tr16_b64_v4i16((LAS s16x4*)(VN + vn_off(32u * ks + 8u * fq + trq, 2u * n + (trp >> 1)) + 8u * (trp & 1u)));
                const s16x4 b1 = __builtin_amdgcn_ds_read_tr16_b64_v4i16((LAS s16x4*)(VN + vn_off(32u * ks + 8u * fq + 4u + trq, 2u * n + (trp >> 1)) + 8u * (trp & 1u)));
                const bf16x8 bb = (bf16x8){b0[0], b0[1], b0[2], b0[3], b1[0], b1[1], b1[2], b1[3]};
                acc[n] = __builtin_amdgcn_mfma_f32_16x16x32_bf16(Af[ks], bb, acc[n], 0, 0, 0);
            }
        }
#pragma unroll
        for (int n = 0; n < 8; ++n)
#pragma unroll
            for (int j = 0; j < 4; ++j) { const int p = 16 * w + 4 * fq + j; LAS unsigned short* ad = (LAS unsigned short*)(GU + p * 264 + (16 * n + fr) * 2);
                *ad = (unsigned short)f2bf(bf1(*ad) * (acc[n][j] + BS[p])); }
        __syncthreads();
#pragma unroll
        for (int i = 0; i < 8; ++i) { const int pid = tid + 512 * i, r = pid >> 5, cg = pid & 31;
            *(GAS v2u*)(F.MIX() + (t0 + r) * D + LW + h * 128 + cg * 4) = *(const LAS v2u*)(GU + r * 264 + cg * 8); }
        __syncthreads();
    }
}
typedef float f32x16 __attribute__((ext_vector_type(16)));
__device__ __forceinline__ unsigned fkey(float f) { const int u = __builtin_bit_cast(int, f); return (unsigned)(u ^ ((u >> 31) & 0x7fffffff)); }
__device__ __forceinline__ float fkey_inv(unsigned k) { const int u = (int)k; return __builtin_bit_cast(float, u ^ ((u >> 31) & 0x7fffffff)); }
__device__ __forceinline__ unsigned umax_(unsigned a, unsigned b) { return (int)a > (int)b ? a : b; }
__device__ __forceinline__ unsigned umin_(unsigned a, unsigned b) { return (int)a < (int)b ? a : b; }
#define CE_DESC(x, y) do { const unsigned a_ = (x), b_ = (y); (x) = umax_(a_, b_); (y) = umin_(a_, b_); } while (0)
__device__ __forceinline__ void sort16_desc(unsigned (&a)[16]) {
#pragma unroll
    for (int k = 2; k <= 16; k <<= 1)
#pragma unroll
        for (int j = k >> 1; j >= 1; j >>= 1)
#pragma unroll
            for (int i = 0; i < 16; ++i) { const int l = i ^ j; if (l > i) { if ((i & k) == 0) CE_DESC(a[i], a[l]); else CE_DESC(a[l], a[i]); } }
}
__device__ __forceinline__ void merge16_desc(unsigned (&a)[16], const unsigned (&b)[16]) {
#pragma unroll
    for (int i = 0; i < 16; ++i) a[i] = umax_(a[i], b[15 - i]);
#pragma unroll
    for (int j = 8; j >= 1; j >>= 1)
#pragma unroll
        for (int i = 0; i < 16; ++i) if ((i & j) == 0) CE_DESC(a[i], a[i + j]);
}
typedef short bf16x8s __attribute__((ext_vector_type(8)));
__device__ __forceinline__ void topk_unit(Frame& F, int wu) {
    const int tg = wu >> 3, hd = wu & 7, lane = F.lane, r = lane & 31, hh = lane >> 5;
    const int t = tg * 32 + r;
    const size_t qoff = (size_t)t * D + hd * 256 + 8 * hh;
    unsigned L[2][16];
    unsigned hh4 = (unsigned)hh << 2; asm volatile("" : "+v"(hh4));
#pragma unroll
    for (int p = 0; p < 2; ++p) {
        f32x16 acc[4];
#pragma unroll
        for (int nt = 0; nt < 4; ++nt)
#pragma unroll
            for (int i = 0; i < 16; ++i) acc[nt][i] = 0.f;
        const size_t koff = ((size_t)(hd * 2 + p) * 128 + r) * 128 + 8 * hh;
        const bf16* qp = F.QH() + qoff + p * 128; const bf16* kp0 = F.KH() + koff; const bf16* kp1 = kp0 + 32 * 128; const bf16* kp2 = kp0 + 64 * 128; const bf16* kp3 = kp0 + 96 * 128;
        asm volatile("" : "+v"(qp), "+v"(kp0), "+v"(kp1), "+v"(kp2), "+v"(kp3));
#define P6_LOAD(Q, K, ks0, n) _Pragma("unroll") for (int i_ = 0; i_ < (n); ++i_) { Q[i_] = *(const GAS bf16x8s*)(qp + 16 * ((ks0) + i_)); \
            K[i_][0] = *(const GAS bf16x8s*)(kp0 + 16 * ((ks0) + i_)); K[i_][1] = *(const GAS bf16x8s*)(kp1 + 16 * ((ks0) + i_)); \
            K[i_][2] = *(const GAS bf16x8s*)(kp2 + 16 * ((ks0) + i_)); K[i_][3] = *(const GAS bf16x8s*)(kp3 + 16 * ((ks0) + i_)); }
#define P6_MMA(Q, K, n) _Pragma("unroll") for (int i_ = 0; i_ < (n); ++i_) _Pragma("unroll") for (int nt = 0; nt < 4; ++nt) acc[nt] = __builtin_amdgcn_mfma_f32_32x32x16_bf16(K[i_][nt], Q[i_], acc[nt], 0, 0, 0);
        bf16x8s qa[3], ka[3][4], qb[3], kb[3][4];
        P6_LOAD(qa, ka, 0, 3); P6_LOAD(qb, kb, 3, 3);
        __builtin_amdgcn_sched_barrier(0);
        P6_MMA(qa, ka, 3);
        __builtin_amdgcn_sched_barrier(0);
        P6_LOAD(qa, ka, 6, 2);
        __builtin_amdgcn_sched_barrier(0);
        P6_MMA(qb, kb, 3);
        __builtin_amdgcn_sched_barrier(0);
        P6_MMA(qa, ka, 2);
        __builtin_amdgcn_sched_barrier(0);
#undef P6_LOAD
#undef P6_MMA
        unsigned S[4][16];
#pragma unroll
        for (int nt = 0; nt < 4; ++nt) {
#pragma unroll
            for (int rg = 0; rg < 16; ++rg) { const int nc = 32 * nt + (rg & 3) + 8 * (rg >> 2); S[nt][rg] = ((fkey(acc[nt][rg]) & ~0x7Fu) | (unsigned)(127 - nc)) ^ hh4; }
            sort16_desc(S[nt]);
        }
        merge16_desc(S[0], S[1]); merge16_desc(S[2], S[3]); merge16_desc(S[0], S[2]);
        unsigned T[16];
#pragma unroll
        for (int i = 0; i < 16; ++i) T[i] = (unsigned)__shfl_xor((int)S[0][i], 32);
        merge16_desc(S[0], T);
#pragma unroll
        for (int i = 0; i < 16; ++i) L[p][i] = S[0][i];
        __builtin_amdgcn_sched_barrier(0);
    }
    float v0[16], v1[16];
#pragma unroll
    for (int i = 0; i < 16; ++i) { v0[i] = fkey_inv(L[0][i] & ~0x7Fu); v1[i] = fkey_inv(L[1][i] & ~0x7Fu); }
    unsigned C[4][16];
    {
        int cnt = 0;
#pragma unroll
        for (int i = 0; i < 16; ++i)
#pragma unroll
            for (int j = 0; j < 16; ++j) if ((i + 1) * (j + 1) <= 16) { C[cnt >> 4][cnt & 15] = (fkey(v0[i] + v1[j]) & ~0xFFu) | (unsigned)(255 - (i * 16 + j)); ++cnt; }
#pragma unroll
        for (int q = 50; q < 64; ++q) C[q >> 4][q & 15] = 0x80000000u;
    }
    sort16_desc(C[0]); sort16_desc(C[1]); sort16_desc(C[2]); sort16_desc(C[3]);
    merge16_desc(C[0], C[1]); merge16_desc(C[2], C[3]); merge16_desc(C[0], C[2]);
    unsigned best[16];
#pragma unroll
    for (int i = 0; i < 16; ++i) best[i] = C[0][i];
    LAS unsigned* tab = (LAS unsigned*)(F.lds + F.wave * 8192) + lane;
#pragma unroll
    for (int i = 0; i < 16; ++i) { tab[i * 64] = 127u - (L[0][i] & 0x7Fu); tab[(16 + i) * 64] = 127u - (L[1][i] & 0x7Fu); }
    const float smax = fkey_inv(best[0] & ~0xFFu);
    float sv[8]; unsigned idv[8]; float ssum = 0.f;
#pragma unroll
    for (int k = 0; k < 8; ++k) {
        const unsigned bk = hh ? best[8 + k] : best[k];
        const unsigned pos = 255u - (bk & 0xFFu);
        idv[k] = tab[(pos >> 4) * 64] * 128u + tab[(16 + (pos & 15u)) * 64];
        sv[k] = __builtin_amdgcn_exp2f((fkey_inv(bk & ~0xFFu) - smax) * 1.4426950409f); ssum += sv[k];
    }
    ssum += __shfl_xor(ssum, 32);
    const float inv = 1.0f / ssum;
    {
        int* o = F.IDS() + (size_t)t * 128 + hd * 16 + 8 * hh; float* og = F.GATES() + (size_t)t * 128 + hd * 16 + 8 * hh;
        *(GAS v4u*)o = (v4u){idv[0], idv[1], idv[2], idv[3]}; *(GAS v4u*)(o + 4) = (v4u){idv[4], idv[5], idv[6], idv[7]};
        *(GAS f32x4*)og = (f32x4){sv[0] * inv, sv[1] * inv, sv[2] * inv, sv[3] * inv}; *(GAS f32x4*)(og + 4) = (f32x4){sv[4] * inv, sv[5] * inv, sv[6] * inv, sv[7] * inv};
    }
}
__device__ __forceinline__ void h8_row(Frame& F, int t) {
    const int lane = F.lane;
    float hx[32]; float mx = 0.f;
    const bf16* hp = F.HB() + (size_t)t * D + lane * 16;
#pragma unroll
    for (int c = 0; c < 2; ++c)
#pragma unroll
        for (int q = 0; q < 2; ++q) { const v4u a = *(const GAS v4u*)(hp + c * 1024 + q * 8); float* x = hx + c * 16 + q * 8;
            x[0] = bf_lo(a.x); x[1] = bf_hi(a.x); x[2] = bf_lo(a.y); x[3] = bf_hi(a.y); x[4] = bf_lo(a.z); x[5] = bf_hi(a.z); x[6] = bf_lo(a.w); x[7] = bf_hi(a.w); }
#pragma unroll
    for (int i = 0; i < 32; ++i) mx = fmaxf(mx, fabsf(hx[i]));
#pragma unroll
    for (int o = 1; o < 64; o <<= 1) mx = fmaxf(mx, __shfl_xor(mx, o));
    const float sc = mx > 0.f ? 119.0f / mx : 1.0f;
#pragma unroll
    for (int c = 0; c < 2; ++c) {
        unsigned hw[2], lw[2];
#pragma unroll
        for (int g8 = 0; g8 < 2; ++g8) { unsigned hacc = 0u, lacc = 0u;
#pragma unroll
            for (int i = 0; i < 8; ++i) { const int q = (int)__builtin_rintf(hx[c * 16 + g8 * 8 + i] * sc); const int lo = ((q + 8) & 15) - 8, hi = (q - lo) >> 4;
                const int sh = (i & 3) * 8 + (i >> 2) * 4; hacc |= (unsigned)(hi & 15) << sh; lacc |= (unsigned)(lo & 15) << sh; }
            hw[g8] = hacc; lw[g8] = lacc; }
        unsigned char* hb_ = F.H8() + (size_t)t * D + c * 512 + lane * 8;
        *(GAS v2u*)hb_ = (v2u){hw[0], hw[1]}; *(GAS v2u*)(hb_ + 1024) = (v2u){lw[0], lw[1]};
    }
    if (lane == 0) F.HSCALE()[t] = mx > 0.f ? mx * (1.0f / 119.0f) : 1.0f;
}
__device__ __forceinline__ int row_sum16(int v) {
    v += __builtin_amdgcn_update_dpp(0, v, 0x128, 0xf, 0xf, false);
    v += __builtin_amdgcn_update_dpp(0, v, 0x124, 0xf, 0xf, false);
    v += __builtin_amdgcn_update_dpp(0, v, 0x122, 0xf, 0xf, false);
    v += __builtin_amdgcn_update_dpp(0, v, 0x121, 0xf, 0xf, false);
    return v;
}
__device__ __forceinline__ void peer_u_xcd(Frame& F) {
    const int lane = F.lane, x = blockIdx.x & 7, jcu = blockIdx.x >> 3, ncu = ((int)F.G - x + 7) >> 3;
    const int tpc = (M + ncu - 1) / ncu, tpw = (tpc + NWAVES - 1) / NWAVES;
    const int tbase = jcu * tpc + F.wave * tpw;
    int nw = M - tbase; { const int lim = (jcu + 1) * tpc - tbase; nw = nw < lim ? nw : lim; nw = nw < tpw ? nw : tpw; nw = nw < 0 ? 0 : nw; }
    const int NV = nw;
    LAS unsigned char* wl = F.lds + F.wave * 13312;
    LAS int* lst = (LAS int*)wl; LAS int* res = (LAS int*)(wl + 512); LAS unsigned char* hsl = wl + 1024;
    const int q4 = lane >> 4, i16 = lane & 15;
    const unsigned char* ubase = F.U8() + (size_t)x * 2048 * 1024;
    const unsigned lanepart = (unsigned)i16 * 16u;
    int r_idlo = 0, r_idhi = 0, r_t = 0; v4u r_h0 = (v4u){0u, 0u, 0u, 0u}, r_h1 = (v4u){0u, 0u, 0u, 0u};
    int v_cl0 = 0, v_cl1 = 0, v_n = 0, v_r0 = 0, v_t = 0, v_slot = 0; unsigned long long v_mlo = 0, v_mhi = 0; bool v_live = false;
    int vset = 0, nvalid = 0, idle = 0;
    if (NV == 0) return;
#define U_RAW() do { const int vi_ = vset < NV ? vset : NV - 1; r_t = tbase + vi_; \
        r_idlo = F.IDS()[(size_t)r_t * 128 + lane]; r_idhi = F.IDS()[(size_t)r_t * 128 + 64 + lane]; \
        r_h0 = *(const GAS v4u*)(F.H8() + (size_t)r_t * D + lane * 16); r_h1 = *(const GAS v4u*)(F.H8() + (size_t)r_t * D + 1024 + lane * 16); } while (0)
#define U_NEXT() do { if (v_live && v_r0 + 16 < v_n) { v_r0 += 16; } else if (vset < NV) { const bool slo = (r_idlo >> 11) == x, shi = (r_idhi >> 11) == x; \
            v_mlo = __ballot(slo); v_mhi = __ballot(shi); const int nlo = __popcll(v_mlo); v_n = nlo + __popcll(v_mhi); \
            const int plo = __builtin_amdgcn_mbcnt_hi((unsigned)(v_mlo >> 32), __builtin_amdgcn_mbcnt_lo((unsigned)v_mlo, 0)); \
            const int phi = nlo + __builtin_amdgcn_mbcnt_hi((unsigned)(v_mhi >> 32), __builtin_amdgcn_mbcnt_lo((unsigned)v_mhi, 0)); \
            if (slo) lst[plo] = (r_idlo & 2047) | (lane << 16); if (shi) lst[phi] = (r_idhi & 2047) | ((64 + lane) << 16); \
            v_slot = nvalid % 6; ++nvalid; { LAS unsigned char* sp_ = hsl + v_slot * 2048; *(LAS v4u*)(sp_ + lane * 16) = r_h0; *(LAS v4u*)(sp_ + 1024 + lane * 16) = r_h1; } \
            v_cl0 = lst[lane]; v_cl1 = lst[64 + lane]; v_t = r_t; v_r0 = 0; ++vset; v_live = true; } \
        else { v_live = false; v_n = 0; v_r0 = 0; v_mlo = 0; v_mhi = 0; ++idle; } } while (0)
#define U_ISSUE(BUF, DS) do { { const int rem_ = v_n - v_r0; DS##_cnt = rem_ < 0 ? 0 : (rem_ < 16 ? rem_ : 16); } \
        DS##_slot = v_slot; DS##_t = v_t; DS##_mlo = v_mlo; DS##_mhi = v_mhi; DS##_last = v_live && (v_r0 + 16 >= v_n); \
        _Pragma("unroll") for (int gp = 0; gp < 4; ++gp) { const int ix_ = v_r0 + 4 * gp + q4; const int a_ = __shfl(v_cl0, ix_ & 63), b_ = __shfl(v_cl1, ix_ & 63); DS##_ent[gp] = ix_ < 64 ? a_ : b_; \
            const unsigned of_ = (4 * gp + q4 < DS##_cnt ? ((unsigned)(DS##_ent[gp] & 2047) << 10) : 0u) + lanepart; \
            _Pragma("unroll") for (int c = 0; c < 4; ++c) BUF[4 * gp + c] = *(const GAS v4u*)(ubase + of_ + c * 256); } } while (0)
#define U_COMPUTE(BUF, DS) do { const LAS unsigned char* sp_ = hsl + DS##_slot * 2048; const volatile LAS v4u* hp_ = (const volatile LAS v4u*)(sp_ + i16 * 16); \
        _Pragma("unroll") for (int gp = 0; gp < 4; ++gp) if (4 * gp < DS##_cnt) { int ah_ = 0, al_ = 0; \
            _Pragma("unroll") for (int c = 0; c < 4; ++c) { const v4u r_ = BUF[4 * gp + c]; const v4u hh_ = hp_[c * 16], hl_ = hp_[64 + c * 16]; \
                ah_ = __builtin_amdgcn_sdot8((int)r_.x, (int)hh_.x, ah_, false); al_ = __builtin_amdgcn_sdot8((int)r_.x, (int)hl_.x, al_, false); \
                ah_ = __builtin_amdgcn_sdot8((int)r_.y, (int)hh_.y, ah_, false); al_ = __builtin_amdgcn_sdot8((int)r_.y, (int)hl_.y, al_, false); \
                ah_ = __builtin_amdgcn_sdot8((int)r_.z, (int)hh_.z, ah_, false); al_ = __builtin_amdgcn_sdot8((int)r_.z, (int)hl_.z, al_, false); \
                ah_ = __builtin_amdgcn_sdot8((int)r_.w, (int)hh_.w, ah_, false); al_ = __builtin_amdgcn_sdot8((int)r_.w, (int)hl_.w, al_, false); } \
            const int a_ = row_sum16((ah_ << 4) + al_); if (i16 == 0 && 4 * gp + q4 < DS##_cnt) res[DS##_ent[gp] >> 16] = a_; } \
        if (DS##_last) { int* po_ = F.PART() + (size_t)DS##_t * 128; \
            if ((DS##_mlo >> lane) & 1ull) po_[lane] = res[lane]; if ((DS##_mhi >> lane) & 1ull) po_[64 + lane] = res[64 + lane]; } } while (0)
    v4u bufA[16], bufB[16], bufC[16];
    int dA_cnt = 0, dA_ent[4] = {0, 0, 0, 0}, dA_t = 0, dA_slot = 0; unsigned long long dA_mlo = 0, dA_mhi = 0; bool dA_last = false;
    int dB_cnt = 0, dB_ent[4] = {0, 0, 0, 0}, dB_t = 0, dB_slot = 0; unsigned long long dB_mlo = 0, dB_mhi = 0; bool dB_last = false;
    int dC_cnt = 0, dC_ent[4] = {0, 0, 0, 0}, dC_t = 0, dC_slot = 0; unsigned long long dC_mlo = 0, dC_mhi = 0; bool dC_last = false;
    U_RAW();
    U_NEXT(); U_RAW(); U_ISSUE(bufA, dA);
    U_NEXT(); U_RAW(); U_ISSUE(bufB, dB);
    while (idle < 3) {
        U_NEXT(); U_RAW(); U_ISSUE(bufC, dC); U_COMPUTE(bufA, dA);
        U_NEXT(); U_RAW(); U_ISSUE(bufA, dA); U_COMPUTE(bufB, dB);
        U_NEXT(); U_RAW(); U_ISSUE(bufB, dB); U_COMPUTE(bufC, dC);
    }
#undef U_RAW
#undef U_NEXT
#undef U_ISSUE
#undef U_COMPUTE
}
__device__ __forceinline__ void peer_act_token(Frame& F, int t) {
    const int lane = F.lane;
    LAS unsigned char* wl = F.lds + F.wave * 4096;
    LAS float* abuf = (LAS float*)wl; LAS int* ibuf = (LAS int*)(wl + 512); LAS int* cnt = (LAS int*)(wl + 1024);
    LAS int* ovf = (LAS int*)(wl + 1280); LAS int* fre = (LAS int*)(wl + 1792); LAS int* sop = (LAS int*)(wl + 2304);
#define WFENCE() asm volatile("s_waitcnt lgkmcnt(0)" ::: "memory")
    const float sc = __builtin_amdgcn_rsqf(F.ROWSS()[t] * (1.0f / D) + 1e-6f) * F.HSCALE()[t];
    if (lane < 34) cnt[lane] = 0;
    float am = 0.f; float actv[2]; int idv[2], slotv[2];
    const int l32 = t & 31;
#pragma unroll
    for (int half = 0; half < 2; ++half) {
        const size_t o = (size_t)t * 128 + half * 64 + lane;
        const int e = F.IDS()[o]; const float g = F.GATES()[o];
        const int dsum = F.PART()[o];
        actv[half] = gelu_tanh((float)dsum * sc * F.USCALE()[e]) * g * F.VSCALE()[e]; idv[half] = e; am = fmaxf(am, fabsf(actv[half]));
    }
    WFENCE();
#pragma unroll
    for (int half = 0; half < 2; ++half) {
        const int r = idv[half] & 31;
        const int j = __hip_atomic_fetch_add(cnt + r, 1, __ATOMIC_RELAXED, __HIP_MEMORY_SCOPE_WORKGROUP);
        if (j < 4) slotv[half] = ((r - l32) & 31) + 32 * j;
        else { const int q = __hip_atomic_fetch_add(cnt + 32, 1, __ATOMIC_RELAXED, __HIP_MEMORY_SCOPE_WORKGROUP); ovf[q] = half * 64 + lane; slotv[half] = -1; }
    }
    WFENCE();
    if (lane < 32) { const int n = cnt[lane];
        for (int j = n; j < 4; ++j) { const int q = __hip_atomic_fetch_add(cnt + 33, 1, __ATOMIC_RELAXED, __HIP_MEMORY_SCOPE_WORKGROUP); fre[q] = ((lane - l32) & 31) + 32 * j; } }
    WFENCE();
    const int nov = cnt[32];
#pragma unroll
    for (int half = 0; half < 2; ++half) { const int i = half * 64 + lane; if (i < nov) sop[ovf[i]] = fre[i]; }
    WFENCE();
#pragma unroll
    for (int half = 0; half < 2; ++half) { if (slotv[half] < 0) slotv[half] = sop[half * 64 + lane]; abuf[slotv[half]] = actv[half]; ibuf[slotv[half]] = idv[half]; }
    WFENCE();
#pragma unroll
    for (int o = 1; o < 64; o <<= 1) am = fmaxf(am, __shfl_xor(am, o));
    const float asc = am > 0.f ? 127.0f / am : 1.0f;
    if (lane == 0) F.ASCALE()[t] = am > 0.f ? am * (1.0f / 127.0f) : 1.0f;
    if (lane < 32) {
        const f32x4 av = *(const LAS f32x4*)(abuf + 4 * lane); const v4u iv = *(const LAS v4u*)(ibuf + 4 * lane);
        const size_t o = ((size_t)(t >> 6) * 32 + lane) * 64 + (t & 63);
        F.IDW()[o] = (v4u){iv.x << 3, iv.y << 3, iv.z << 3, iv.w << 3};
        F.AW()[o] = pack_i8x4(av.x * asc, av.y * asc, av.z * asc, av.w * asc);
    }
    WFENCE();
#undef WFENCE
}
__device__ __forceinline__ void tr4x4(const unsigned r0, const unsigned r1, const unsigned r2, const unsigned r3, unsigned (&c)[4]) {
    const unsigned t01l = __builtin_amdgcn_perm(r1, r0, 0x05010400u), t01h = __builtin_amdgcn_perm(r1, r0, 0x07030602u);
    const unsigned t23l = __builtin_amdgcn_perm(r3, r2, 0x05010400u), t23h = __builtin_amdgcn_perm(r3, r2, 0x07030602u);
    c[0] = __builtin_amdgcn_perm(t23l, t01l, 0x05040100u); c[1] = __builtin_amdgcn_perm(t23l, t01l, 0x07060302u);
    c[2] = __builtin_amdgcn_perm(t23h, t01h, 0x05040100u); c[3] = __builtin_amdgcn_perm(t23h, t01h, 0x07060302u);
}
template <int MODE>
__device__ __forceinline__ void peer_v_slice(Frame& F, int c, bool do_atomic) {
    const int tid = F.tid, lane = F.lane;
    for (int i = tid; i < NEXP * 8 / 16; i += 512) *(LAS v4u*)(F.lds + i * 16) = *(const GAS v4u*)(F.V8T() + (size_t)c * NEXP * 8 + (size_t)i * 16);
    __syncthreads();
    const v4u* ibase = F.IDW() + lane; const unsigned* abase = F.AW() + lane;
    constexpr int NBLK = M / 64, PD = 16;
    v4u iq[PD]; unsigned aq[PD]; v2u rw[2][4];
    {
        const size_t o = (size_t)F.wave * 32 * 64;
#pragma unroll
        for (int j = 0; j < PD; ++j) { iq[j] = *(const GAS v4u*)(ibase + o + j * 64); aq[j] = abase[o + j * 64]; }
    }
#define LROW(dst, q) do { dst[0] = *(const LAS v2u*)(F.lds + (q).x); dst[1] = *(const LAS v2u*)(F.lds + (q).y); \
                          dst[2] = *(const LAS v2u*)(F.lds + (q).z); dst[3] = *(const LAS v2u*)(F.lds + (q).w); } while (0)
    for (int blk = F.wave; blk < NBLK; blk += NWAVES) {
        const int t = blk * 64 + lane;
        const size_t o = (size_t)blk * 32 * 64;
        const int nblk = (blk + NWAVES < NBLK) ? blk + NWAVES : blk;
        const size_t on = (size_t)nblk * 32 * 64;
        int acc[8];
#pragma unroll
        for (int i = 0; i < 8; ++i) acc[i] = 0;
        LROW(rw[0], iq[0]);
#pragma unroll
        for (int j = 0; j < 32; ++j) {
            if (j + 1 < 32) LROW(rw[(j + 1) & 1], iq[(j + 1) % PD]);
            const unsigned aw = aq[j % PD];
            unsigned cl[4], ch[4];
            tr4x4(rw[j & 1][0].x, rw[j & 1][1].x, rw[j & 1][2].x, rw[j & 1][3].x, cl);
            tr4x4(rw[j & 1][0].y, rw[j & 1][1].y, rw[j & 1][2].y, rw[j & 1][3].y, ch);
#pragma unroll
            for (int i = 0; i < 4; ++i) { acc[i] = __builtin_amdgcn_sdot4((int)aw, (int)cl[i], acc[i], false); acc[4 + i] = __builtin_amdgcn_sdot4((int)aw, (int)ch[i], acc[4 + i], false); }
            { const size_t oo = (j + PD < 32) ? o + (size_t)(j + PD) * 64 : on + (size_t)(j + PD - 32) * 64;
              iq[j % PD] = *(const GAS v4u*)(ibase + oo); aq[j % PD] = abase[oo]; }
            __builtin_amdgcn_sched_barrier(0);
        }
        const float asc = F.ASCALE()[t];
        float accf[8];
#pragma unroll
        for (int i = 0; i < 8; ++i) accf[i] = (float)acc[i] * asc;
        const v4u hb = *(const GAS v4u*)(F.HBT() + ((size_t)c * M + t) * 8);
        accf[0] += bf_lo(hb.x); accf[1] += bf_hi(hb.x); accf[2] += bf_lo(hb.y); accf[3] += bf_hi(hb.y);
        accf[4] += bf_lo(hb.z); accf[5] += bf_hi(hb.z); accf[6] += bf_lo(hb.w); accf[7] += bf_hi(hb.w);
        bf16* yp = (MODE == 0) ? F.Y() + ((size_t)c * M + t) * 8 : (bf16*)F.XN() + ((((size_t)c * M + t) * 8) & (size_t)0x1ffffff);
        *(GAS v4u*)yp = (v4u){pk2(accf[0], accf[1]), pk2(accf[2], accf[3]), pk2(accf[4], accf[5]), pk2(accf[6], accf[7])};
        float ss = 0.f;
#pragma unroll
        for (int i = 0; i < 8; ++i) ss += accf[i] * accf[i];
        if (do_atomic) atomicAdd(F.ROWSS2() + t, ss);
    }
#undef LROW
    __syncthreads();
}
__device__ __forceinline__ void final_unit(Frame& F, int unit) {
    const int tid = F.tid, blk = unit >> 3, cg = unit & 7, t0 = blk * 64;
    LAS float* T = (LAS float*)F.lds;
#pragma unroll
    for (int i = 0; i < 4; ++i) { const int pid = tid + 512 * i, cl = pid >> 6, tok = pid & 63;
        const v4u v = *(const GAS v4u*)(F.Y() + ((size_t)(cg * 32 + cl) * M + t0 + tok) * 8);
        *(LAS f32x4*)(T + tok * 260 + cl * 8) = (f32x4){bf_lo(v.x), bf_hi(v.x), bf_lo(v.y), bf_hi(v.y)};
        *(LAS f32x4*)(T + tok * 260 + cl * 8 + 4) = (f32x4){bf_lo(v.z), bf_hi(v.z), bf_lo(v.w), bf_hi(v.w)}; }
    __syncthreads();
#pragma unroll
    for (int i = 0; i < 8; ++i) { const int pid = tid + 512 * i, tok = pid >> 6, c4 = pid & 63;
        const float rs = __builtin_amdgcn_rsqf(F.ROWSS2()[t0 + tok] * (1.0f / D) + 1e-6f);
        const f32x4 v = *(const LAS f32x4*)(T + tok * 260 + c4 * 4);
        const f32x4 g = *(const GAS f32x4*)(F.A.in[20] + cg * 256 + c4 * 4);
        *(GAS f32x4*)(F.A.out + (size_t)(t0 + tok) * D + cg * 256 + c4 * 4) = v * rs * g; }
    __syncthreads();
}
__global__ void __launch_bounds__(NWAVES * 64, 2) mk_fwd(Args args) {
    __shared__ __attribute__((aligned(16))) unsigned char lds[LDS_BYTES];
    Frame F(args);
    F.lds = (LAS unsigned char*)lds;
    F.MISC = (volatile LAS unsigned*)(F.lds + MISC_OFF);
    F.tid = threadIdx.x; F.lane = F.tid & 63; F.wave = __builtin_amdgcn_readfirstlane(F.tid >> 6);
    F.G = gridDim.x; { const int bx = blockIdx.x; F.vcu = (F.G % 8 == 0) ? (bx % 8) * (F.G / 8) + bx / 8 : bx; }
    F.ws = args.ws;
    F.ctl = (gu32*)(args.ws + WS_CTL);
    for (int u = F.tid; u < (LDS_BYTES - LDSCTL_OFF) / 4; u += NWAVES * 64) ((LAS unsigned*)(F.lds + LDSCTL_OFF))[u] = 0u;
    __syncthreads();
    XcdBarrier bar; bar.bar = (unsigned*)(F.ctl + CW_BAR); bar.x = 0; bar.st = nullptr;
    if (N_LAUNCHES != PER_PHASE) bar = xcd_barrier_post((unsigned*)(F.ctl + CW_BAR), F.MISC + 8);
#define GRID_BAR() do { if (N_LAUNCHES != PER_PHASE) xcd_barrier(bar); } while (0)
    const int lo = args.ph_lo, hi = args.ph_hi;
#ifndef MK_PHASE_MASK
#define MK_PHASE_MASK 0x7FF
#endif
#define IN(k) (((MK_PHASE_MASK >> (k)) & 1) && lo <= (k) && (k) < hi)
#undef MK_PHASE_MASK
#define MK_PHASE_MASK 0xFFFF
#define BOTH(k) (true)
#ifndef MK_REP_MASK
#define MK_REP_MASK 0
#endif
#ifndef MK_REP_N
#define MK_REP_N 2
#endif
#define REPS(k) for (int rep_ = 0; rep_ < ((((MK_REP_MASK) >> (k)) & 1) ? 1 + MK_REP_N : 1); ++rep_)
    const int gw = F.vcu * NWAVES + F.wave, NGW = F.G * NWAVES;
    if (IN(0)) { REPS(0) { p0_prologue(F); __syncthreads(); } if (BOTH(0)) GRID_BAR(); }
    if (IN(1)) {
        pg8::Gemm g{F.XN(), F.WIN(), M, NIN, D}; pg8::StaticOrder S; S.init(M, NIN, F.G, (int)blockIdx.x);
        pg8::EpiZ E{F.Z(), NIN, LW};
        REPS(1) pg8::gemm_phase<pg8::EpiZ, pg8::StaticOrder, true, true>(F.lds, g, S, E);
        if (BOTH(1)) GRID_BAR();
    }
    if (IN(2)) {
        REPS(12) for (int u = blockIdx.x; u < BATCH * NCHUNK * 8; u += F.G) lru_unit<false>(F, u);
        if (BOTH(2)) GRID_BAR();
    }
    if (IN(3)) {
        lru_carry(F);
        REPS(13) for (int u = blockIdx.x; u < BATCH * NCHUNK; u += F.G) gmlp_unit(F, u);
        if (BOTH(3)) GRID_BAR();
    }
    if (IN(11)) {
        REPS(3) for (int u = blockIdx.x; u < BATCH * NCHUNK * 8; u += F.G) lru_unit<true>(F, u);
        GRID_BAR();
    }
    if (IN(4)) {
        pg8::Gemm g{F.MIX(), F.WOUT(), M, D, D}; pg8::StaticOrder S; S.init(M, D, F.G, (int)blockIdx.x);
        pg8::EpiH E{F.HB(), F.HBT(), F.A.in[0], F.ROWSS(), D, M};
        pg8::gemm_phase<pg8::EpiH, pg8::StaticOrder, true, true>(F.lds, g, S, E);
        if (BOTH(4)) GRID_BAR();
    }
    if (IN(5)) {
        pg8::Gemm g{F.HB(), F.WQ(), M, D, D}; pg8::StaticOrder S; S.init(M, D, F.G, (int)blockIdx.x);
        pg8::EpiQ E{F.QH(), F.ROWSS(), D};
        REPS(5) pg8::gemm_phase<pg8::EpiQ, pg8::StaticOrder, true, true>(F.lds, g, S, E);
        if (BOTH(5)) GRID_BAR();
    }
    if (IN(6)) {
        REPS(6) { for (int wu = gw; wu < (M / 32) * 8; wu += NGW) topk_unit(F, wu);
                  for (int t = gw; t < M; t += NGW) h8_row(F, t); }
        if (BOTH(6)) GRID_BAR();
    }
    if (IN(7)) {
        REPS(7) peer_u_xcd(F);
        if (BOTH(7)) GRID_BAR();
    }
    if (IN(8)) {
        REPS(8) for (int t = gw; t < M; t += NGW) peer_act_token(F, t);
        if (BOTH(8)) GRID_BAR();
    }
    if (IN(9)) {
        for (int c = blockIdx.x; c < D / 8; c += F.G) peer_v_slice<0>(F, c, true);
        if ((MK_REP_MASK >> 9) & 1) { for (int rep_ = 0; rep_ < MK_REP_N; ++rep_) for (int c = blockIdx.x; c < D / 8; c += F.G) peer_v_slice<1>(F, c, false); }
        if (BOTH(9)) GRID_BAR();
    }
    if (IN(10)) {
        REPS(10) for (int u = blockIdx.x; u < (M / 64) * 8; u += F.G) final_unit(F, u);
    }
#undef IN
#undef BOTH
#undef GRID_BAR
}

extern "C" void kernel_launch(void* const* d_in, const int* in_sizes, int n_in, void* d_out, int out_size, void* d_ws, size_t ws_size, hipStream_t stream) {
    static int grid = 0;
    if (grid == 0) {
        if (n_in != 21 || in_sizes[0] != M * D || out_size != M * D || ws_size < WS_END) { fprintf(stderr, "kernel_launch: unexpected shapes (n_in %d, in0 %d, out %d, ws %zu)\n", n_in, n_in > 0 ? in_sizes[0] : -1, out_size, ws_size); grid = -1; return; }
        int dev = 0, cus = 0, per_cu = 0;
        if (hipGetDevice(&dev) != hipSuccess || hipDeviceGetAttribute(&cus, hipDeviceAttributeMultiprocessorCount, dev) != hipSuccess) { grid = -1; return; }
        if (hipOccupancyMaxActiveBlocksPerMultiprocessor(&per_cu, (const void*)mk_fwd, NWAVES * 64, 0) != hipSuccess || per_cu < 1) { fprintf(stderr, "kernel_launch: occupancy query reports %d blocks per CU\n", per_cu); }
        (void)hipGetLastError();
        grid = cus;
    }
    if (grid < 0) return;
    (void)hipMemsetAsync((char*)d_ws + WS_CTL, 0, CTL_ZERO_BYTES, stream);
    Args a{};
    for (int i = 0; i < 21; ++i) a.in[i] = (const float*)d_in[i];
    a.out = (float*)d_out; a.ws = (unsigned char*)d_ws;
    for (int li = 0; li < N_LAUNCHES; ++li) {
        a.ph_lo = 0; a.ph_hi = 99;
        hipLaunchKernelGGL(mk_fwd, dim3(grid), dim3(NWAVES * 64), 0, stream, a);
    }
}
```

```cpp
#include <hip/hip_runtime.h>
#include <cstdio>
#include <cstdint>
namespace pg8 {
#define PG8_LAS __attribute__((address_space(3)))
typedef unsigned short bf16_t;
typedef short bf16x8 __attribute__((ext_vector_type(8)));
typedef float f32x4 __attribute__((ext_vector_type(4)));
typedef unsigned u32x4 __attribute__((ext_vector_type(4)));
constexpr int BM = 256, BK = 64, HALF = 128, HTB = HALF * BK * 2  , STAGE_BYTES = 8 * HTB, NXCD = 8, WGM = 8;

__host__ __device__ __forceinline__ int lds_byte(int r, int c) { const int st = (r >> 4) * 2 + (c >> 5), rr = r & 15, cc = c & 31, ob = rr * 64 + cc * 2; return st * 1024 + (ob ^ (((ob >> 9) & 1) << 5)); }
__host__ __device__ __forceinline__ void stage_rc(int b, int& R, int& C) { const int st = b / 1024, sb = b % 1024, swz = sb ^ (((sb >> 9) & 1) << 5); R = (st >> 1) * 16 + swz / 64; C = (st & 1) * 32 + (swz % 64) / 2; }
__host__ __device__ __forceinline__ int perm32(int rho) { const int n = rho >> 4, i = rho & 15; return 8 * (i >> 2) + 4 * n + (i & 3); }

struct Unit { int pm, pn; };
struct Gemm { const bf16_t* A; const bf16_t* Bt; int M, N, K; };

struct StaticOrder {
    int nM, nN, nwg, G, c;
    __host__ __device__ void init(int M, int N, int G_, int c_) { nM = M / BM; nN = N / BM; nwg = nM * nN; G = G_; c = c_; }
    __host__ __device__ bool next(int i, Unit& u) const {
        const long L = (long)i * G + c; if (L >= nwg) return false;
        int wgid = (int)L; { const int q = nwg / NXCD, r = nwg % NXCD, xcd = wgid % NXCD, off = wgid / NXCD; wgid = (xcd < r ? xcd * (q + 1) : r * (q + 1) + (xcd - r) * q) + off; }
        const int nig = WGM * nN, gid = wgid / nig, fm = gid * WGM, gsz = (nM - fm) < WGM ? (nM - fm) : WGM;
        u.pm = fm + ((wgid % nig) % gsz); u.pn = (wgid % nig) / gsz; return true;
    }
    __device__ __forceinline__ void a_ready(const Unit&) const {}
    __device__ __forceinline__ void done(const Unit&) const {}
};

__device__ __forceinline__ unsigned cvt_pk_bf16(float lo, float hi) { unsigned r; asm volatile("v_cvt_pk_bf16_f32 %0, %1, %2" : "=v"(r) : "v"(lo), "v"(hi)); return r; }
__device__ __forceinline__ float gelu_tanh(float x) {
    const float t = x * (1.0f + 0.044715f * x * x);
    const float e = __builtin_amdgcn_exp2f(-2.3022081983f * t);
    return x * __builtin_amdgcn_rcpf(1.0f + e);
}
struct EpiZ {
    static constexpr bool PERM = true, AFTER_DRAIN = false;
    bf16_t* O; int ldc; int gelu_from;
    __device__ __forceinline__ void operator()(const f32x4 (&acc)[2][2][4][2], const Unit& u, int wr, int wc, int fr, int fq) const {
        const int row0 = u.pm * BM + wr * 64 + fr; const int col0 = u.pn * BM + wc * 32 + 8 * fq;
        const bool act = (u.pn * BM) >= gelu_from;
#pragma unroll
        for (int ai = 0; ai < 2; ++ai)
#pragma unroll
            for (int m = 0; m < 4; ++m) { bf16_t* rowp = O + (size_t)(row0 + ai * HALF + m * 16) * ldc + col0;
#pragma unroll
                for (int bj = 0; bj < 2; ++bj) { f32x4 v0 = acc[ai][bj][m][0], v1 = acc[ai][bj][m][1];
                    if (act) {
#pragma unroll
                        for (int j = 0; j < 4; ++j) { v0[j] = gelu_tanh(v0[j]); v1[j] = gelu_tanh(v1[j]); } }
                    u32x4 w; w.x = cvt_pk_bf16(v0[0], v0[1]); w.y = cvt_pk_bf16(v0[2], v0[3]); w.z = cvt_pk_bf16(v1[0], v1[1]); w.w = cvt_pk_bf16(v1[2], v1[3]);
                    *(u32x4*)(rowp + bj * HALF) = w; } }
    }
};
struct EpiH {
    static constexpr bool PERM = true, AFTER_DRAIN = false;
    bf16_t* O; bf16_t* OT; const float* X; float* rowss; int ldc; int mrows;
    __device__ __forceinline__ void operator()(const f32x4 (&acc)[2][2][4][2], const Unit& u, int wr, int wc, int fr, int fq) const {
        const int row0 = u.pm * BM + wr * 64 + fr; const int col0 = u.pn * BM + wc * 32 + 8 * fq;
#pragma unroll
        for (int ai = 0; ai < 2; ++ai)
#pragma unroll
            for (int m = 0; m < 4; ++m) { const int row = row0 + ai * HALF + m * 16; const size_t off = (size_t)row * ldc + col0; float ss = 0.f;
#pragma unroll
                for (int bj = 0; bj < 2; ++bj) {
                    const f32x4 x0 = *(const f32x4*)(X + off + bj * HALF), x1 = *(const f32x4*)(X + off + bj * HALF + 4);
                    const f32x4 v0 = acc[ai][bj][m][0] + x0, v1 = acc[ai][bj][m][1] + x1;
                    ss += (v0[0] * v0[0] + v0[1] * v0[1]) + (v0[2] * v0[2] + v0[3] * v0[3]) + (v1[0] * v1[0] + v1[1] * v1[1]) + (v1[2] * v1[2] + v1[3] * v1[3]);
                    u32x4 w; w.x = cvt_pk_bf16(v0[0], v0[1]); w.y = cvt_pk_bf16(v0[2], v0[3]); w.z = cvt_pk_bf16(v1[0], v1[1]); w.w = cvt_pk_bf16(v1[2], v1[3]);
                    *(u32x4*)(O + off + bj * HALF) = w;
                    *(u32x4*)(OT + ((size_t)((col0 + bj * HALF) >> 3) * mrows + row) * 8) = w; }
                ss += __shfl_xor(ss, 16); ss += __shfl_xor(ss, 32);
                if (fq == 0) atomicAdd(rowss + row, ss); }
    }
};
struct EpiQ {
    static constexpr bool PERM = true, AFTER_DRAIN = false;
    bf16_t* QH; const float* rowss; int ldc;
    __device__ __forceinline__ void operator()(const f32x4 (&acc)[2][2][4][2], const Unit& u, int wr, int wc, int fr, int fq) const {
        const int row0 = u.pm * BM + wr * 64 + fr, col0 = u.pn * BM + wc * 32 + 8 * fq;
#pragma unroll
        for (int ai = 0; ai < 2; ++ai)
#pragma unroll
            for (int m = 0; m < 4; ++m) { const int row = row0 + ai * HALF + m * 16; const float rs = __builtin_amdgcn_rsqf(rowss[row] * (1.0f / 2048.0f) + 1e-6f);
                const size_t off = (size_t)row * ldc + col0;
#pragma unroll
                for (int bj = 0; bj < 2; ++bj) { const f32x4 v0 = acc[ai][bj][m][0] * rs, v1 = acc[ai][bj][m][1] * rs;
                    u32x4 wh; wh.x = cvt_pk_bf16(v0[0], v0[1]); wh.y = cvt_pk_bf16(v0[2], v0[3]); wh.z = cvt_pk_bf16(v1[0], v1[1]); wh.w = cvt_pk_bf16(v1[2], v1[3]);
                    *(u32x4*)(QH + off + bj * HALF) = wh; } }
    }
};
template <class Epi, class Sched, bool ALIGN_EPI = false, bool SP2 = false>
__device__ __forceinline__ void gemm_phase(PG8_LAS unsigned char* lds, const Gemm g, const Sched& S, const Epi& E) {
    const int tid = threadIdx.x, wid = __builtin_amdgcn_readfirstlane(tid >> 6), lane = tid & 63, wr = wid >> 2, wc = wid & 3, fr = lane & 15, fq = lane >> 4;
    const int K = g.K, nt = K / BK;
    unsigned voffA[2], voffB[2];
#pragma unroll
    for (int i = 0; i < 2; ++i) { int R, C; stage_rc(tid * 16 + i * 8192, R, C); const int Rb = Epi::PERM ? ((R & ~31) + perm32(R & 31)) : R;
        voffA[i] = (unsigned)(R * K + C) * 2u; voffB[i] = (unsigned)(Rb * K + C) * 2u; }
    const size_t kstep = (size_t)(BK * 2);
    const size_t hstep = (size_t)HALF * K * 2;
    const size_t tstep = 2 * hstep;
    const unsigned ldsw = (unsigned)wid * 1024u;
    const int aoff = lds_byte(wr * 64 + fr, fq * 8), boff = lds_byte(wc * 32 + fr, fq * 8);
#define PG8_SA(b, h) (((b) * 2 + (h)) * HTB)
#define PG8_SB(b, h) ((4 + (b) * 2 + (h)) * HTB)
#define PG8_STAGE(bufoff, gbase, voff) do { _Pragma("unroll") for (int _i = 0; _i < 2; ++_i) \
        __builtin_amdgcn_global_load_lds((const unsigned*)((const char*)(gbase) + (voff)[_i]), (PG8_LAS unsigned*)(lds + (bufoff) + ldsw + _i * 8192), 16, 0, 0); } while (0)
#define PG8_LDA(dst, b, h) do { _Pragma("unroll") for (int m = 0; m < 4; ++m) _Pragma("unroll") for (int k = 0; k < 2; ++k) dst[m][k] = *(const PG8_LAS bf16x8*)(lds + PG8_SA(b, h) + aoff + m * 2048 + k * 1024); } while (0)
#define PG8_LDB(dst, b, h) do { _Pragma("unroll") for (int n = 0; n < 2; ++n) _Pragma("unroll") for (int k = 0; k < 2; ++k) dst[n][k] = *(const PG8_LAS bf16x8*)(lds + PG8_SB(b, h) + boff + n * 2048 + k * 1024); } while (0)
#define PG8_MMA(ai, bj, At, Bt) do { __builtin_amdgcn_s_setprio(1); _Pragma("unroll") for (int m = 0; m < 4; ++m) _Pragma("unroll") for (int n = 0; n < 2; ++n) _Pragma("unroll") for (int k = 0; k < 2; ++k) \
        acc[ai][bj][m][n] = __builtin_amdgcn_mfma_f32_16x16x32_bf16(Bt[n][k], At[m][k], acc[ai][bj][m][n], 0, 0, 0); __builtin_amdgcn_s_setprio(0); } while (0)
#define PG8_WAIT_V(n) asm volatile("s_waitcnt vmcnt(" #n ")" ::: "memory")
#define PG8_WAIT_L(n) asm volatile("s_waitcnt lgkmcnt(" #n ")" ::: "memory")
#define PG8_BAR __builtin_amdgcn_s_barrier()
#define PG8_SCHED __builtin_amdgcn_sched_barrier(0)
    Unit cur, nxt; int ui = 0;
    if (!S.next(0, cur)) return;
    f32x4 acc[2][2][4][2];
#pragma unroll
    for (int a = 0; a < 2; ++a)
#pragma unroll
        for (int b = 0; b < 2; ++b)
#pragma unroll
            for (int m = 0; m < 4; ++m)
#pragma unroll
                for (int n = 0; n < 2; ++n) acc[a][b][m][n] = (f32x4){0.f, 0.f, 0.f, 0.f};
    bf16x8 At[4][2], B0[2][2], B1[2][2];
    const char* cA = (const char*)g.A + (size_t)cur.pm * tstep; const char* cB = (const char*)g.Bt + (size_t)cur.pn * tstep;
    S.a_ready(cur);
    if constexpr (SP2) {
        PG8_STAGE(PG8_SB(0, 0), cB, voffB); PG8_STAGE(PG8_SB(0, 1), cB + hstep, voffB); PG8_STAGE(PG8_SA(0, 0), cA, voffA); PG8_STAGE(PG8_SA(0, 1), cA + hstep, voffA);
        if (wr == 1) PG8_BAR;
        PG8_WAIT_V(2); PG8_BAR;
        PG8_STAGE(PG8_SB(1, 0), cB + kstep, voffB); PG8_STAGE(PG8_SA(1, 0), cA + kstep, voffA); PG8_STAGE(PG8_SB(1, 1), cB + hstep + kstep, voffB);
        PG8_WAIT_V(6); PG8_BAR;
    } else {
        PG8_STAGE(PG8_SB(0, 0), cB, voffB); PG8_STAGE(PG8_SA(0, 0), cA, voffA); PG8_STAGE(PG8_SB(0, 1), cB + hstep, voffB); PG8_STAGE(PG8_SA(0, 1), cA + hstep, voffA);
        if (wr == 1) PG8_BAR;
        PG8_WAIT_V(4); PG8_BAR;
        PG8_STAGE(PG8_SB(1, 0), cB + kstep, voffB); PG8_STAGE(PG8_SA(1, 0), cA + kstep, voffA); PG8_STAGE(PG8_SB(1, 1), cB + hstep + kstep, voffB);
        PG8_WAIT_V(6); PG8_BAR;
    }
    for (;;) {
        const bool has_next = S.next(ui + 1, nxt);
        const char* nA = has_next ? (const char*)g.A + (size_t)nxt.pm * tstep : cA; const char* nB = has_next ? (const char*)g.Bt + (size_t)nxt.pn * tstep : cB;
        for (int t = 0; t < nt; t += 2) {
            const bool last = (t == nt - 2);
            const char* a1 = cA + (size_t)(t + 1) * kstep;
            const char* a2 = last ? nA : cA + (size_t)(t + 2) * kstep; const char* b2 = last ? nB : cB + (size_t)(t + 2) * kstep;
            const char* a3 = a2 + kstep; const char* b3 = b2 + kstep;
            if (last && has_next) S.a_ready(nxt);
            if constexpr (SP2) {
            PG8_LDB(B0, 0, 0); PG8_LDB(B1, 0, 1); PG8_SCHED; PG8_LDA(At, 0, 0); PG8_STAGE(PG8_SA(1, 1), a1 + hstep, voffA);
            PG8_WAIT_V(8); PG8_WAIT_L(0); PG8_BAR; PG8_MMA(0, 0, At, B0); PG8_MMA(0, 1, At, B1); PG8_BAR; PG8_SCHED;
            PG8_LDA(At, 0, 1); PG8_STAGE(PG8_SB(0, 0), b2, voffB); PG8_STAGE(PG8_SB(0, 1), b2 + hstep, voffB); PG8_STAGE(PG8_SA(0, 0), a2, voffA);
            PG8_WAIT_V(8); PG8_WAIT_L(0); PG8_BAR; PG8_MMA(1, 0, At, B0); PG8_MMA(1, 1, At, B1); PG8_BAR; PG8_SCHED;
            PG8_LDB(B0, 1, 0); PG8_LDB(B1, 1, 1); PG8_SCHED; PG8_LDA(At, 1, 0); PG8_STAGE(PG8_SA(0, 1), a2 + hstep, voffA);
            PG8_WAIT_V(8); PG8_WAIT_L(0); PG8_BAR; PG8_MMA(0, 0, At, B0); PG8_MMA(0, 1, At, B1); PG8_BAR; PG8_SCHED;
            PG8_LDA(At, 1, 1); PG8_STAGE(PG8_SB(1, 0), b3, voffB); PG8_STAGE(PG8_SB(1, 1), b3 + hstep, voffB); PG8_STAGE(PG8_SA(1, 0), a3, voffA);
            PG8_WAIT_V(8); PG8_WAIT_L(0); PG8_BAR; PG8_MMA(1, 0, At, B0); PG8_MMA(1, 1, At, B1); PG8_BAR; PG8_SCHED;
            } else {
            PG8_LDB(B0, 0, 0); PG8_SCHED; PG8_LDA(At, 0, 0); PG8_STAGE(PG8_SA(1, 1), a1 + hstep, voffA);
            PG8_WAIT_L(8); PG8_BAR; PG8_WAIT_L(0); PG8_MMA(0, 0, At, B0); PG8_BAR; PG8_SCHED;
            PG8_LDB(B1, 0, 1); PG8_STAGE(PG8_SB(0, 0), b2, voffB);
            PG8_BAR; PG8_WAIT_L(0); PG8_MMA(0, 1, At, B1); PG8_BAR;
            PG8_LDA(At, 0, 1); PG8_STAGE(PG8_SA(0, 0), a2, voffA);
            PG8_BAR; PG8_WAIT_L(0); PG8_MMA(1, 0, At, B0); PG8_BAR; PG8_SCHED;
            PG8_STAGE(PG8_SB(0, 1), b2 + hstep, voffB);
            PG8_WAIT_V(6); PG8_BAR; PG8_MMA(1, 1, At, B1); PG8_BAR;
            PG8_LDB(B0, 1, 0); PG8_SCHED; PG8_LDA(At, 1, 0); PG8_STAGE(PG8_SA(0, 1), a2 + hstep, voffA);
            PG8_WAIT_L(8); PG8_BAR; PG8_WAIT_L(0); PG8_MMA(0, 0, At, B0); PG8_BAR; PG8_SCHED;
            PG8_LDB(B1, 1, 1); PG8_STAGE(PG8_SB(1, 0), b3, voffB);
            PG8_BAR; PG8_WAIT_L(0); PG8_MMA(0, 1, At, B1); PG8_BAR;
            PG8_LDA(At, 1, 1); PG8_STAGE(PG8_SA(1, 0), a3, voffA);
            PG8_BAR; PG8_WAIT_L(0); PG8_MMA(1, 0, At, B0); PG8_BAR; PG8_SCHED;
            PG8_STAGE(PG8_SB(1, 1), b3 + hstep, voffB);
            PG8_WAIT_V(6); PG8_BAR; PG8_MMA(1, 1, At, B1); PG8_BAR;
            }
        }
        if constexpr (ALIGN_EPI) { if (wr == 0) PG8_BAR; }
        if constexpr (!Epi::AFTER_DRAIN) { E(acc, cur, wr, wc, fr, fq); S.done(cur); }
        if (!has_next) break;
#pragma unroll
        for (int a = 0; a < 2; ++a)
#pragma unroll
            for (int b = 0; b < 2; ++b)
#pragma unroll
                for (int m = 0; m < 4; ++m)
#pragma unroll
                    for (int n = 0; n < 2; ++n) acc[a][b][m][n] = (f32x4){0.f, 0.f, 0.f, 0.f};
        cur = nxt; cA = nA; cB = nB; ++ui;
        if constexpr (ALIGN_EPI) { if (wr == 1) PG8_BAR; }
    }
    PG8_WAIT_V(0);
    if constexpr (!ALIGN_EPI) { if (wr == 0) PG8_BAR; }
    PG8_BAR;
    if constexpr (Epi::AFTER_DRAIN) { E.fused(acc, cur, wr, wc, fr, fq, lds, wid, lane); S.done(cur); }
#undef PG8_SA
#undef PG8_SB
#undef PG8_STAGE
#undef PG8_LDA
#undef PG8_LDB
#undef PG8_MMA
#undef PG8_WAIT_V
#undef PG8_WAIT_L
#undef PG8_BAR
#undef PG8_SCHED
}
}
constexpr int NWAVES = 8;
constexpr int BATCH = 4, SEQ = 8192, D = 2048, M = BATCH * SEQ, NIN = 4096, LW = 1024, CHUNK = 128, NCHUNK = SEQ / CHUNK;
constexpr int NEXP = 16384;
#ifndef MK_N_LAUNCHES
#define MK_N_LAUNCHES 1
#endif
constexpr int N_LAUNCHES = MK_N_LAUNCHES;
constexpr int PER_PHASE = 11;
constexpr size_t MiB = 1u << 20;
constexpr size_t WS_CTL = 0, CTL_ZERO_BYTES = 1 * MiB;
constexpr size_t WS_ROWSS = 512 * 1024;
constexpr size_t WS_WIN = 2 * MiB, WS_WOUT = 18 * MiB, WS_WQ = 26 * MiB, WS_LRUW = 34 * MiB, WS_WSB = 35 * MiB, WS_AGG = 36 * MiB;
constexpr size_t WS_U = 64 * MiB, WS_V = 128 * MiB, WS_XN = 192 * MiB  , WS_Z = 320 * MiB  ;
constexpr size_t WS_HB = 576 * MiB, WS_IDS = 704 * MiB, WS_GATES = 720 * MiB, WS_PAIRS = 736 * MiB, WS_HBT = 752 * MiB, WS_END = 884 * MiB;
constexpr size_t WS_USCALE = 40 * MiB, WS_VSCALE = 41 * MiB;
constexpr size_t WS_HSCALE = 44 * MiB, WS_CARRY = 45 * MiB;
constexpr size_t WS_H8 = WS_XN, WS_PART = WS_XN + 64 * MiB;
constexpr size_t WS_ASCALE = 42 * MiB, WS_KH = 43 * MiB;
constexpr size_t WS_IDW = WS_PAIRS, WS_AW = 880 * MiB;
constexpr size_t WS_ROWSS2 = 640 * 1024;
constexpr size_t WS_Y = WS_Z;
constexpr int CW_BAR = 4096;
constexpr int RING_BYTES = 131072;
constexpr int LDSCTL_OFF = 143360, MISC_OFF = LDSCTL_OFF + 320;
constexpr int LDS_BYTES = 147456;
#define GAS __attribute__((address_space(1)))
#define LAS __attribute__((address_space(3)))
typedef unsigned short bf16;
typedef unsigned v4u __attribute__((ext_vector_type(4)));
typedef float f32x4 __attribute__((ext_vector_type(4)));
typedef short bf16x8 __attribute__((ext_vector_type(8)));
typedef GAS unsigned gu32;
typedef GAS unsigned long long gu64;
#define RLX_AGENT __ATOMIC_RELAXED, __HIP_MEMORY_SCOPE_AGENT
#define LDS_WAIT() asm volatile("s_waitcnt lgkmcnt(0)" ::: "memory")
#define VM_WAIT() asm volatile("s_waitcnt vmcnt(0)" ::: "memory")
__device__ __forceinline__ unsigned long long rt() { return __builtin_amdgcn_s_memrealtime(); }
__device__ __forceinline__ unsigned f2bf(float f) { unsigned u = __builtin_bit_cast(unsigned, f); return (u + 0x7fffu + ((u >> 16) & 1u)) >> 16; }
__device__ __forceinline__ unsigned pk2(float lo, float hi) { return f2bf(lo) | (f2bf(hi) << 16); }

#define XB_TMO      128
#define XB_XCNT(j)  (256  + 64 * (j))
#define XB_XSUB(j)  (1280 + 64 * (j))
#define XB_XGEN(j)  (2304 + 64 * (j))
#define XB_TOP      3328
#define XB_TOPGEN   3392
#define XCD_BAR_WORDS 3456
#define XB_SPIN_CAP (1u << 18)

__device__ __forceinline__ unsigned xb_ld(unsigned* p)              { return __hip_atomic_load(p, __ATOMIC_RELAXED, __HIP_MEMORY_SCOPE_AGENT); }
__device__ __forceinline__ unsigned xb_add(unsigned* p, unsigned v) { return __hip_atomic_fetch_add(p, v, __ATOMIC_RELAXED, __HIP_MEMORY_SCOPE_AGENT); }
__device__ __forceinline__ unsigned xb_xcc_id() { return (unsigned)__builtin_amdgcn_s_getreg((3 << 11) | 20) & 0xFu; }
#define XB_SPIN(cond, bar) do { unsigned _sp = 0; while (cond) { __builtin_amdgcn_s_sleep(1); \
    if ((++_sp & 255u) == 0u) { if (xb_ld(&(bar)[XB_TMO])) break; if (_sp > XB_SPIN_CAP) { atomicAdd(&(bar)[XB_TMO], 1u); break; } } } } while (0)

struct XcdBarrier {
    unsigned* bar; unsigned x;
    volatile LAS unsigned* st;
};

__device__ __forceinline__ XcdBarrier xcd_barrier_post(unsigned* bar, volatile LAS unsigned* st) {
    XcdBarrier b; b.bar = bar; b.x = xb_xcc_id(); b.st = st;
    if (threadIdx.x == 0) (void)xb_add(&bar[XB_XCNT(b.x)], 1u);
    return b;
}
__device__ __forceinline__ void xcd_barrier_complete(unsigned* bar, unsigned x, unsigned& nloc, unsigned& nx) {
    const unsigned G = gridDim.x * gridDim.y * gridDim.z;
    unsigned sum, cnt, mine, sp = 0u;
    for (;;) {
        sum = 0u; cnt = 0u; mine = 0u;
#pragma unroll
        for (unsigned j = 0; j < 16; ++j) { const unsigned c = xb_ld(&bar[XB_XCNT(j)]); sum += c; cnt += (c > 0u) ? 1u : 0u; mine = (j == x) ? c : mine; }
        if (sum == G) break;
        __builtin_amdgcn_s_sleep(1);
        if ((++sp & 255u) == 0u) { if (xb_ld(&bar[XB_TMO])) break; if (sp > XB_SPIN_CAP) { atomicAdd(&bar[XB_TMO], 1u); break; } }
    }
    nloc = mine > 0u ? mine : 1u; nx = cnt > 0u ? cnt : 1u;
}

__device__ __forceinline__ void xcd_barrier(const XcdBarrier& b) {
    asm volatile("s_waitcnt vmcnt(0)" ::: "memory");
    __syncthreads();
    if (threadIdx.x == 0) {
        unsigned* bar = b.bar;
        __builtin_amdgcn_s_waitcnt(0);
        unsigned nloc = b.st[0], nx = b.st[1];
        if (nloc == 0u) { xcd_barrier_complete(bar, b.x, nloc, nx); b.st[0] = nloc; b.st[1] = nx; }
        const unsigned old = xb_add(&bar[XB_XSUB(b.x)], 1u);
        const unsigned gen = old / nloc;
        if (old + 1u == (gen + 1u) * nloc) {
            __builtin_amdgcn_fence(__ATOMIC_RELEASE, "agent");
            asm volatile("s_waitcnt vmcnt(0)" ::: "memory");
            const unsigned og = xb_add(&bar[XB_TOP], 1u);
            const unsigned tg = og / nx;
            if (og + 1u == (tg + 1u) * nx) xb_add(&bar[XB_TOPGEN], 1u);
            else XB_SPIN(xb_ld(&bar[XB_TOPGEN]) == tg, bar);
            __builtin_amdgcn_fence(__ATOMIC_ACQUIRE, "agent");
            xb_add(&bar[XB_XGEN(b.x)], 1u);
            asm volatile("s_waitcnt vmcnt(0)" ::: "memory");
        } else {
            XB_SPIN(xb_ld(&bar[XB_XGEN(b.x)]) == gen, bar);
            __builtin_amdgcn_fence(__ATOMIC_ACQUIRE, "agent");
            asm volatile("s_waitcnt vmcnt(0)" ::: "memory");
        }
    }
    __syncthreads();
}
typedef unsigned v2u __attribute__((ext_vector_type(2)));
typedef float f32x2 __attribute__((ext_vector_type(2)));
struct Args { const float* in[21]; float* out; unsigned char* ws; int ph_lo, ph_hi; };
struct Frame {
    const Args& A;
    LAS unsigned char* lds;
    volatile LAS unsigned* MISC;
    gu32* ctl;
    unsigned char* ws;
    int tid, lane, wave, vcu, G;
    __device__ __forceinline__ Frame(const Args& a) : A(a) {}
#define WSP(name, type, off) __device__ __forceinline__ type* name() const { return (type*)(ws + (off)); }
    WSP(WIN, bf16, WS_WIN) WSP(WOUT, bf16, WS_WOUT) WSP(WQ, bf16, WS_WQ) WSP(LRUW, bf16, WS_LRUW) WSP(WSB, bf16, WS_WSB)
    WSP(XN, bf16, WS_XN) WSP(MIX, bf16, WS_XN) WSP(Z, bf16, WS_Z) WSP(HB, bf16, WS_HB) WSP(HBT, bf16, WS_HBT)
    WSP(U8, unsigned char, WS_U) WSP(V8T, unsigned char, WS_V)
    WSP(ROWSS, float, WS_ROWSS) WSP(ROWSS2, float, WS_ROWSS2) WSP(QH, bf16, WS_Z) WSP(QL, bf16, WS_Z + 128 * MiB) WSP(KH, bf16, WS_KH) WSP(KL, bf16, WS_KH + 512 * 1024) WSP(AGG, float, WS_AGG) WSP(CARRY, float, WS_CARRY) WSP(GATES, float, WS_GATES)
    WSP(USCALE, float, WS_USCALE) WSP(VSCALE, float, WS_VSCALE) WSP(Y, bf16, WS_Y) WSP(IDS, int, WS_IDS) WSP(ASCALE, float, WS_ASCALE) WSP(IDW, v4u, WS_IDW) WSP(AW, unsigned, WS_AW) WSP(H8, unsigned char, WS_H8) WSP(HSCALE, float, WS_HSCALE) WSP(PART, int, WS_PART)
#undef WSP
};
__device__ __forceinline__ float wave_sum(float v) {
#pragma unroll
    for (int o = 1; o < 64; o <<= 1) v += __shfl_xor(v, o);
    return v;
}
__device__ __forceinline__ float bf_lo(unsigned w) { return __builtin_bit_cast(float, w << 16); }
__device__ __forceinline__ float bf_hi(unsigned w) { return __builtin_bit_cast(float, w & 0xffff0000u); }
__device__ __forceinline__ float bf1(unsigned short h) { return __builtin_bit_cast(float, (unsigned)h << 16); }
__device__ __forceinline__ float sigmoidf_(float x) { return __builtin_amdgcn_rcpf(1.0f + __builtin_amdgcn_exp2f(-1.4426950409f * x)); }
using pg8::gelu_tanh;
__device__ __forceinline__ unsigned pack_i8x4(float a, float b, float c, float d) {
    const int ia = (int)__builtin_rintf(a), ib = (int)__builtin_rintf(b), ic = (int)__builtin_rintf(c), id = (int)__builtin_rintf(d);
    return (unsigned)(ia & 0xff) | ((unsigned)(ib & 0xff) << 8) | ((unsigned)(ic & 0xff) << 16) | ((unsigned)id << 24);
}

__device__ __forceinline__ void p0_transpose_item(const float* W, int K, int N, bf16* WT, const float* kscale, LAS float* scr, int item, int lane) {
    const int nblk = N / 32, kb = item / nblk, nb = item % nblk, k0 = 64 * kb, n0 = 32 * nb;
#pragma unroll 8
    for (int i = 0; i < 32; ++i) { const int kk = 2 * i + (lane >> 5); const float sc = kscale ? kscale[k0 + kk] : 1.0f; scr[kk * 33 + (lane & 31)] = W[(size_t)(k0 + kk) * N + n0 + (lane & 31)] * sc; }
    LDS_WAIT(); asm volatile("" ::: "memory");
    const int c = lane & 7;
#pragma unroll
    for (int j = 0; j < 4; ++j) { const int n = (lane >> 3) + 8 * j; const LAS float* s = scr + (8 * c) * 33 + n;
        v4u o; o.x = pk2(s[0 * 33], s[1 * 33]); o.y = pk2(s[2 * 33], s[3 * 33]); o.z = pk2(s[4 * 33], s[5 * 33]); o.w = pk2(s[6 * 33], s[7 * 33]);
        *(GAS v4u*)(WT + (size_t)(n0 + n) * K + k0 + 8 * c) = o; }
    LDS_WAIT(); asm volatile("" ::: "memory");
}
__device__ __forceinline__ void p0_prologue(Frame& F) {
    LAS float* scr = (LAS float*)(F.lds + F.wave * 16384);
    const int gw = F.vcu * NWAVES + F.wave, NGW = F.G * NWAVES, lane = F.lane;
    constexpr int I_IN = (D / 64) * (NIN / 32), I_OUT = (D / 64) * (D / 32), I_Q = I_OUT, I_LRU = 32 * 8;
    constexpr int NITEMS = I_IN + I_OUT + I_Q + I_LRU;
    for (int it = gw; it < NITEMS; it += NGW) {
        int r = it;
        if (r < I_IN) { p0_transpose_item(F.A.in[2], D, NIN, F.WIN(), F.A.in[1], scr, r, lane); continue; } r -= I_IN;
        if (r < I_OUT) { p0_transpose_item(F.A.in[14], D, D, F.WOUT(), nullptr, scr, r, lane); continue; } r -= I_OUT;
        if (r < I_Q) { p0_transpose_item(F.A.in[16], D, D, F.WQ(), F.A.in[15], scr, r, lane); continue; } r -= I_Q;
        { const int mi = r >> 3, sub = r & 7, gate = mi >> 4, rest = mi & 15;
          const float* src = (gate ? F.A.in[7] : F.A.in[5]) + (size_t)rest * 16384;
          p0_transpose_item(src, 128, 128, F.LRUW() + (size_t)mi * 16384, nullptr, scr, sub, lane); }
    }
    const size_t gt = (size_t)gw * 64 + lane, NGT = (size_t)NGW * 64;
    {
        const float* g2 = F.A.in[15];
        f32x4 gg[8];
#pragma unroll
        for (int j = 0; j < 8; ++j) gg[j] = *(const GAS f32x4*)(g2 + j * 256 + lane * 4);
        for (int e = gw; e < NEXP; e += NGW) {
            const GAS f32x4* ur = (const GAS f32x4*)(F.A.in[18] + (size_t)e * D) + lane;
            f32x4 v[8]; float ss = 0.f;
#pragma unroll
            for (int j = 0; j < 8; ++j) { v[j] = ur[64 * j] * gg[j]; ss += (v[j].x * v[j].x + v[j].y * v[j].y) + (v[j].z * v[j].z + v[j].w * v[j].w); }
            const float rms = __builtin_amdgcn_sqrtf(wave_sum(ss) * (1.0f / D));
            const float sc = rms > 0.f ? 7.0f / (2.8f * rms) : 1.0f;
            GAS unsigned* o4 = (GAS unsigned*)(F.U8() + (size_t)e * 1024) + (lane >> 1);
#pragma unroll
            for (int j = 0; j < 8; ++j) {
                const int c0 = (int)fminf(fmaxf(__builtin_rintf(v[j].x * sc), -7.f), 7.f) & 15, c1 = (int)fminf(fmaxf(__builtin_rintf(v[j].y * sc), -7.f), 7.f) & 15;
                const int c2 = (int)fminf(fmaxf(__builtin_rintf(v[j].z * sc), -7.f), 7.f) & 15, c3 = (int)fminf(fmaxf(__builtin_rintf(v[j].w * sc), -7.f), 7.f) & 15;
                const unsigned cw = (unsigned)c0 | ((unsigned)c1 << 8) | ((unsigned)c2 << 16) | ((unsigned)c3 << 24);
                const unsigned pw = (unsigned)__shfl_xor((int)cw, 1);
                if ((lane & 1) == 0) o4[32 * j] = cw | (pw << 4);
            }
            if (lane == 0) F.USCALE()[e] = rms > 0.f ? 2.8f * rms * (1.0f / 7.0f) : 1.0f;
        }
    }
    __syncthreads();
    for (int un = blockIdx.x; un < NEXP / 64; un += F.G) {
        const int e0 = un * 64;
        for (int rr = 0; rr < 8; ++rr) {
            const int el = F.wave * 8 + rr, e = e0 + el;
            const GAS f32x4* vr = (const GAS f32x4*)(F.A.in[19] + (size_t)e * D) + lane;
            f32x4 v[8]; float mx = 0.f;
#pragma unroll
            for (int j = 0; j < 8; ++j) { v[j] = vr[64 * j]; mx = fmaxf(mx, fmaxf(fmaxf(fabsf(v[j].x), fabsf(v[j].y)), fmaxf(fabsf(v[j].z), fabsf(v[j].w)))); }
#pragma unroll
            for (int o = 1; o < 64; o <<= 1) mx = fmaxf(mx, __shfl_xor(mx, o));
            const float sc = mx > 0.f ? 127.0f / mx : 1.0f;
#pragma unroll
            for (int j = 0; j < 8; ++j) *(LAS unsigned*)(F.lds + el * 2056 + j * 256 + lane * 4) = pack_i8x4(v[j].x * sc, v[j].y * sc, v[j].z * sc, v[j].w * sc);
            if (lane == 0) F.VSCALE()[e] = mx > 0.f ? mx * (1.0f / 127.0f) : 1.0f;
        }
        __syncthreads();
        for (int cc = 0; cc < 32; ++cc) { const int c = F.wave * 32 + cc;
            const v2u w = *(const LAS v2u*)(F.lds + lane * 2056 + c * 8);
            *(GAS v2u*)(F.V8T() + ((size_t)c * NEXP + e0 + lane) * 8) = w; }
        __syncthreads();
    }
    for (size_t ch = gt; ch < (size_t)8 * 128 * 128 / 8; ch += NGT) {
        const size_t e0 = ch * 8;
        const f32x4 a = *(const GAS f32x4*)(F.A.in[12] + e0), b = *(const GAS f32x4*)(F.A.in[12] + e0 + 4);
        v4u o; o.x = pk2(a.x, a.y); o.y = pk2(a.z, a.w); o.z = pk2(b.x, b.y); o.w = pk2(b.z, b.w);
        *(GAS v4u*)(F.WSB() + e0) = o;
    }
    for (size_t ch = gt; ch < (size_t)16 * 128 * 128 / 8; ch += NGT) {
        const size_t e0 = ch * 8;
        const f32x4 a = *(const GAS f32x4*)(F.A.in[17] + e0), b = *(const GAS f32x4*)(F.A.in[17] + e0 + 4);
        v4u hi; hi.x = pk2(a.x, a.y); hi.y = pk2(a.z, a.w); hi.z = pk2(b.x, b.y); hi.w = pk2(b.z, b.w);
        *(GAS v4u*)(F.KH() + e0) = hi;
    }
    for (int m = gw; m < M; m += NGW) {
        const GAS f32x4* xr = (const GAS f32x4*)(F.A.in[0] + (size_t)m * D) + lane;
        f32x4 v[8]; float s = 0.f;
#pragma unroll
        for (int j = 0; j < 8; ++j) { v[j] = xr[64 * j]; s += (v[j].x * v[j].x + v[j].y * v[j].y) + (v[j].z * v[j].z + v[j].w * v[j].w); }
        const float rstd = __builtin_amdgcn_rsqf(wave_sum(s) * (1.f / D) + 1e-6f);
        GAS unsigned long long* o8 = (GAS unsigned long long*)(F.XN() + (size_t)m * D) + lane;
#pragma unroll
        for (int j = 0; j < 8; ++j) o8[64 * j] = (unsigned long long)pk2(v[j].x * rstd, v[j].y * rstd) | ((unsigned long long)pk2(v[j].z * rstd, v[j].w * rstd) << 32);
    }
}
constexpr int LRU_XR = 0, LRU_XC = 33792, LRU_GR = 33792 + 40960;
constexpr float LOG2E = 1.4426950408889634f;
__device__ __forceinline__ int xc_off(int tok, int ch) { return tok * 320 + (tok >> 5) * 16 + ch * 2; }
template <bool APPLY, int DIR>
__device__ __forceinline__ void lru_dir(Frame& F, int b, int c, int h, const bf16x8 (&Ba)[4], const bf16x8 (&Bx)[4], float (&hsum)[8][4]) {
    const int lane = F.lane, w = F.wave, fr = lane & 15, fq = lane >> 4;
    LAS unsigned char* XC = F.lds + LRU_XC;
    const int chl = 16 * w + fr, chg = h * 128 + chl;
    const float ba = F.A.in[6][DIR * LW + chg], bx = F.A.in[8][DIR * LW + chg], lam = F.A.in[9][DIR * LW + chg];
    const float cl = -8.0f * log1pf(__expf(-lam)) * LOG2E;
    float carry = 0.f;
    if (APPLY) carry = F.CARRY()[(size_t)((b * 2 + DIR) * NCHUNK + c) * LW + chg];
    f32x4 R[8], I[8];
    const int arow = (fr >> 2) * 32 + (fr & 3);
#pragma unroll
    for (int m = 0; m < 8; ++m) {
        R[m] = (f32x4){0.f, 0.f, 0.f, 0.f}; I[m] = (f32x4){0.f, 0.f, 0.f, 0.f};
#pragma unroll
        for (int ks = 0; ks < 4; ++ks) {
            const bf16x8 a = *(const LAS bf16x8*)(XC + xc_off(arow + 4 * m, 32 * ks + 8 * fq));
            R[m] = __builtin_amdgcn_mfma_f32_16x16x32_bf16(a, Ba[ks], R[m], 0, 0, 0);
            I[m] = __builtin_amdgcn_mfma_f32_16x16x32_bf16(a, Bx[ks], I[m], 0, 0, 0);
        }
    }
    float P = 1.f, L = 0.f;
#pragma unroll
    for (int mm = 0; mm < 8; ++mm) {
        const int m = DIR == 0 ? mm : 7 - mm;
#pragma unroll
        for (int jj = 0; jj < 4; ++jj) {
            const int j = DIR == 0 ? jj : 3 - jj;
            const float r = sigmoidf_(R[m][j] + ba), ig = sigmoidf_(I[m][j] + bx);
            const float a = __builtin_amdgcn_exp2f(cl * r);
            const float xc = bf1(*(const LAS unsigned short*)(XC + xc_off(32 * fq + 4 * m + j, chl)));
            const float u = __builtin_amdgcn_sqrtf(fmaxf(1.0f - a * a, 0.0f)) * (ig * xc);
            L = a * L + u; P = a * P;
            R[m][j] = P; I[m][j] = L;
        }
    }
    const int src1 = DIR == 0 ? lane - 16 : lane + 16, src2 = DIR == 0 ? lane - 32 : lane + 32;
    const bool v1 = DIR == 0 ? (fq >= 1) : (fq <= 2), v2 = DIR == 0 ? (fq >= 2) : (fq <= 1);
    float A = P, B = L;
    { const float pa = __shfl(A, src1), pb = __shfl(B, src1); if (v1) { B = A * pb + B; A = A * pa; } }
    { const float pa = __shfl(A, src2), pb = __shfl(B, src2); if (v2) { B = A * pb + B; A = A * pa; } }
    if (APPLY) {
        float EA = __shfl(A, src1), EB = __shfl(B, src1); if (!v1) { EA = 1.f; EB = 0.f; }
        const float hin = EA * carry + EB;
#pragma unroll
        for (int m = 0; m < 8; ++m)
#pragma unroll
            for (int j = 0; j < 4; ++j) { const float hh = R[m][j] * hin + I[m][j]; if (DIR == 0) hsum[m][j] = hh; else hsum[m][j] += hh; }
    } else {
        const bool lastlane = DIR == 0 ? (fq == 3) : (fq == 0);
        if (lastlane) { f32x2* agg = (f32x2*)F.AGG() + (size_t)((b * 2 + DIR) * NCHUNK + c) * LW + chg; *agg = (f32x2){A, B}; }
    }
}

template <bool APPLY>
__device__ __forceinline__ void lru_unit(Frame& F, int unit) {
    const int h = unit & 7, c = (unit >> 3) & 63, b = unit >> 9;
    const int tid = F.tid, lane = F.lane, w = F.wave, fr = lane & 15, fq = lane >> 4;
    const size_t t0 = (size_t)b * SEQ + (size_t)c * CHUNK;
    LAS unsigned char* XR = F.lds + LRU_XR; LAS unsigned char* XC = F.lds + LRU_XC; LAS unsigned char* GR = F.lds + LRU_GR;
    bf16x8 Ba0[4], Bx0[4], Ba1[4], Bx1[4];
    {
        const bf16* wb = F.LRUW() + (size_t)h * 16384 + (size_t)(16 * w + fr) * 128 + 8 * fq;
#pragma unroll
        for (int ks = 0; ks < 4; ++ks) { Ba0[ks] = *(const GAS bf16x8*)(wb + 32 * ks); Ba1[ks] = *(const GAS bf16x8*)(wb + (size_t)8 * 16384 + 32 * ks);
            Bx0[ks] = *(const GAS bf16x8*)(wb + (size_t)16 * 16384 + 32 * ks); Bx1[ks] = *(const GAS bf16x8*)(wb + (size_t)24 * 16384 + 32 * ks); }
    }
    for (int p = tid; p < 131 * 16; p += 512) { const int r = p >> 4, cg = p & 15; const int s = c * CHUNK - 2 + r; v4u v = (v4u){0u, 0u, 0u, 0u};
        if (s >= 0 && s < SEQ) v = *(const GAS v4u*)(F.Z() + ((size_t)b * SEQ + s) * NIN + h * 128 + cg * 8);
        *(LAS v4u*)(XR + r * 256 + cg * 16) = v; }
    if (APPLY) { for (int p = tid; p < 128 * 32; p += 512) { const int r = p >> 5, cg = p & 31;
        *(LAS v2u*)(GR + r * 264 + cg * 8) = *(const GAS v2u*)(F.Z() + (t0 + r) * NIN + LW + h * 128 + cg * 4); } }
    __syncthreads();
    {
        const int ch2 = tid & 63, tg = tid >> 6, chg = h * 128 + 2 * ch2;
        float w0[4], w1[4];
#pragma unroll
        for (int k = 0; k < 4; ++k) { w0[k] = F.A.in[3][k * LW + chg]; w1[k] = F.A.in[3][k * LW + chg + 1]; }
        const float b0 = F.A.in[4][chg], b1 = F.A.in[4][chg + 1];
        float x0[4], x1[4];
#pragma unroll
        for (int k = 0; k < 3; ++k) { const unsigned u = *(const LAS unsigned*)(XR + (16 * tg + k) * 256 + ch2 * 4); x0[k] = bf_lo(u); x1[k] = bf_hi(u); }
#pragma unroll
        for (int j = 0; j < 16; ++j) {
            const unsigned u = *(const LAS unsigned*)(XR + (16 * tg + j + 3) * 256 + ch2 * 4); x0[3] = bf_lo(u); x1[3] = bf_hi(u);
            const float y0 = b0 + ((w0[0] * x0[0] + w0[1] * x0[1]) + (w0[2] * x0[2] + w0[3] * x0[3]));
            const float y1 = b1 + ((w1[0] * x1[0] + w1[1] * x1[1]) + (w1[2] * x1[2] + w1[3] * x1[3]));
            *(LAS unsigned*)(XC + xc_off(16 * tg + j, 2 * ch2)) = pk2(y0, y1);
            x0[0] = x0[1]; x0[1] = x0[2]; x0[2] = x0[3]; x1[0] = x1[1]; x1[1] = x1[2]; x1[2] = x1[3];
        }
    }
    __syncthreads();
    float hsum[8][4];
    lru_dir<APPLY, 0>(F, b, c, h, Ba0, Bx0, hsum);
    asm volatile("" ::: "memory"); __builtin_amdgcn_sched_barrier(0);
    lru_dir<APPLY, 1>(F, b, c, h, Ba1, Bx1, hsum);
    if (APPLY) {
        const int chl = 16 * w + fr;
#pragma unroll
        for (int m = 0; m < 8; ++m)
#pragma unroll
            for (int j = 0; j < 4; ++j) { LAS unsigned short* p = (LAS unsigned short*)(GR + (32 * fq + 4 * m + j) * 264 + chl * 2); *p = (unsigned short)f2bf(bf1(*p) * hsum[m][j]); }
        __syncthreads();
        for (int p = tid; p < 128 * 32; p += 512) { const int r = p >> 5, cg = p & 31;
            *(GAS v2u*)(F.MIX() + (t0 + r) * D + h * 128 + cg * 4) = *(const LAS v2u*)(GR + r * 264 + cg * 8); }
    }
    __syncthreads();
}
__device__ __forceinline__ void lru_carry(Frame& F) {
    const int idx = (F.vcu * NWAVES + F.wave) * 64 + F.lane;
    if (idx >= BATCH * 2 * LW) return;
    const int ch = idx & (LW - 1), bd = idx >> 10, dir = bd & 1;
    const f32x2* agg = (const f32x2*)F.AGG() + (size_t)bd * NCHUNK * LW + ch; float* cr = F.CARRY() + (size_t)bd * NCHUNK * LW + ch;
    float st = 0.f;
#pragma unroll 8
    for (int i = 0; i < NCHUNK; ++i) { const int cc = dir == 0 ? i : NCHUNK - 1 - i; const f32x2 pe = agg[(size_t)cc * LW]; cr[(size_t)cc * LW] = st; st = pe.x * st + pe.y; }
}
constexpr int GM_ST = 0, GM_BS = 1024, GM_VN = 2048, GM_GU = 2048 + 32768;
typedef short s16x4 __attribute__((ext_vector_type(4)));
__device__ __forceinline__ unsigned vn_off(unsigned row, unsigned ch) { return 256u * row + 16u * (ch ^ (((row & 3u) << 2) | ((row >> 2) & 3u))); }
__device__ __forceinline__ void gmlp_unit(Frame& F, int unit) {
    const int tid = F.tid, lane = F.lane, w = F.wave, fr = lane & 15, fq = lane >> 4;
    const size_t t0 = (size_t)unit * CHUNK;
    LAS float* ST = (LAS float*)(F.lds + GM_ST); LAS float* BS = (LAS float*)(F.lds + GM_BS);
    LAS unsigned char* VN = F.lds + GM_VN; LAS unsigned char* GU = F.lds + GM_GU;
    for (int rr = 0; rr < 16; ++rr) {
        const int row = 16 * w + rr;
        const bf16* p = F.Z() + (t0 + row) * NIN + 3 * LW + lane * 8;
        const v4u a = *(const GAS v4u*)p, b = *(const GAS v4u*)(p + 512);
        float x[16] = {bf_lo(a.x), bf_hi(a.x), bf_lo(a.y), bf_hi(a.y), bf_lo(a.z), bf_hi(a.z), bf_lo(a.w), bf_hi(a.w),
                       bf_lo(b.x), bf_hi(b.x), bf_lo(b.y), bf_hi(b.y), bf_lo(b.z), bf_hi(b.z), bf_lo(b.w), bf_hi(b.w)};
        float s = 0.f;
#pragma unroll
        for (int i = 0; i < 16; ++i) s += x[i];
        const float mean = wave_sum(s) * (1.0f / LW);
        float q = 0.f;
#pragma unroll
        for (int i = 0; i < 16; ++i) { const float d = x[i] - mean; q += d * d; }
        const float rstd = __builtin_amdgcn_rsqf(wave_sum(q) * (1.0f / LW) + 1e-6f);
        if (lane == 0) { ST[2 * row] = mean; ST[2 * row + 1] = rstd; }
    }
    __syncthreads();
    const unsigned trq = (unsigned)(lane & 15) >> 2, trp = (unsigned)lane & 3u;
    for (int h = 0; h < 8; ++h) {
#pragma unroll
        for (int i = 0; i < 4; ++i) { const int pid = tid + 512 * i, q = pid >> 4, cg = pid & 15;
            const v4u a = *(const GAS v4u*)(F.Z() + (t0 + q) * NIN + 3 * LW + h * 128 + cg * 8);
            const float mean = ST[2 * q], rstd = ST[2 * q + 1];
            const f32x4 g0 = *(const GAS f32x4*)(F.A.in[10] + h * 128 + cg * 8), g1 = *(const GAS f32x4*)(F.A.in[10] + h * 128 + cg * 8 + 4);
            const f32x4 b0 = *(const GAS f32x4*)(F.A.in[11] + h * 128 + cg * 8), b1 = *(const GAS f32x4*)(F.A.in[11] + h * 128 + cg * 8 + 4);
            v4u o;
            o.x = pk2((bf_lo(a.x) - mean) * rstd * g0.x + b0.x, (bf_hi(a.x) - mean) * rstd * g0.y + b0.y);
            o.y = pk2((bf_lo(a.y) - mean) * rstd * g0.z + b0.z, (bf_hi(a.y) - mean) * rstd * g0.w + b0.w);
            o.z = pk2((bf_lo(a.z) - mean) * rstd * g1.x + b1.x, (bf_hi(a.z) - mean) * rstd * g1.y + b1.y);
            o.w = pk2((bf_lo(a.w) - mean) * rstd * g1.z + b1.z, (bf_hi(a.w) - mean) * rstd * g1.w + b1.w);
            *(LAS v4u*)(VN + vn_off((unsigned)q, (unsigned)cg)) = o;
        }
#pragma unroll
        for (int i = 0; i < 8; ++i) { const int pid = tid + 512 * i, r = pid >> 5, cg = pid & 31;
            *(LAS v2u*)(GU + r * 264 + cg * 8) = *(const GAS v2u*)(F.Z() + (t0 + r) * NIN + 2 * LW + h * 128 + cg * 4); }
        if (tid < 128) BS[tid] = F.A.in[13][h * 128 + tid];
        bf16x8 Af[4];
        { const bf16* wsb = F.WSB() + (size_t)h * 16384 + (size_t)(16 * w + fr) * 128 + 8 * fq;
#pragma unroll
          for (int ks = 0; ks < 4; ++ks) Af[ks] = *(const GAS bf16x8*)(wsb + 32 * ks); }
        __syncthreads();
        f32x4 acc[8];
#pragma unroll
        for (int n = 0; n < 8; ++n) {
            acc[n] = (f32x4){0.f, 0.f, 0.f, 0.f};
#pragma unroll
            for (int ks = 0; ks < 4; ++ks) {
                const s16x4 b0 = __builtin_amdgcn_ds_read_tr16_b64_v4i16((LAS s16x4*)(VN + vn_off(32u * ks + 8u * fq + trq, 2u * n + (trp >> 1)) + 8u * (trp & 1u)));
                const s16x4 b1 = __builtin_amdgcn_ds_read_tr16_b64_v4i16((LAS s16x4*)(VN + vn_off(32u * ks + 8u * fq + 4u + trq, 2u * n + (trp >> 1)) + 8u * (trp & 1u)));
                const bf16x8 bb = (bf16x8){b0[0], b0[1], b0[2], b0[3], b1[0], b1[1], b1[2], b1[3]};
                acc[n] = __builtin_amdgcn_mfma_f32_16x16x32_bf16(Af[ks], bb, acc[n], 0, 0, 0);
            }
        }
#pragma unroll
        for (int n = 0; n < 8; ++n)
#pragma unroll
            for (int j = 0; j < 4; ++j) { const int p = 16 * w + 4 * fq + j; LAS unsigned short* ad = (LAS unsigned short*)(GU + p * 264 + (16 * n + fr) * 2);
                *ad = (unsigned short)f2bf(bf1(*ad) * (acc[n][j] + BS[p])); }
        __syncthreads();
#pragma unroll
        for (int i = 0; i < 8; ++i) { const int pid = tid + 512 * i, r = pid >> 5, cg = pid & 31;
            *(GAS v2u*)(F.MIX() + (t0 + r) * D + LW + h * 128 + cg * 4) = *(const LAS v2u*)(GU + r * 264 + cg * 8); }
        __syncthreads();
    }
}
typedef float f32x16 __attribute__((ext_vector_type(16)));
__device__ __forceinline__ unsigned fkey(float f) { const int u = __builtin_bit_cast(int, f); return (unsigned)(u ^ ((u >> 31) & 0x7fffffff)); }
__device__ __forceinline__ float fkey_inv(unsigned k) { const int u = (int)k; return __builtin_bit_cast(float, u ^ ((u >> 31) & 0x7fffffff)); }
__device__ __forceinline__ unsigned umax_(unsigned a, unsigned b) { return (int)a > (int)b ? a : b; }
__device__ __forceinline__ unsigned umin_(unsigned a, unsigned b) { return (int)a < (int)b ? a : b; }
#define CE_DESC(x, y) do { const unsigned a_ = (x), b_ = (y); (x) = umax_(a_, b_); (y) = umin_(a_, b_); } while (0)
__device__ __forceinline__ void sort16_desc(unsigned (&a)[16]) {
#pragma unroll
    for (int k = 2; k <= 16; k <<= 1)
#pragma unroll
        for (int j = k >> 1; j >= 1; j >>= 1)
#pragma unroll
            for (int i = 0; i < 16; ++i) { const int l = i ^ j; if (l > i) { if ((i & k) == 0) CE_DESC(a[i], a[l]); else CE_DESC(a[l], a[i]); } }
}
__device__ __forceinline__ void merge16_desc(unsigned (&a)[16], const unsigned (&b)[16]) {
#pragma unroll
    for (int i = 0; i < 16; ++i) a[i] = umax_(a[i], b[15 - i]);
#pragma unroll
    for (int j = 8; j >= 1; j >>= 1)
#pragma unroll
        for (int i = 0; i < 16; ++i) if ((i & j) == 0) CE_DESC(a[i], a[i + j]);
}
typedef short bf16x8s __attribute__((ext_vector_type(8)));
__device__ __forceinline__ void topk_unit(Frame& F, int wu) {
    const int tg = wu >> 3, hd = wu & 7, lane = F.lane, r = lane & 31, hh = lane >> 5;
    const int t = tg * 32 + r;
    const size_t qoff = (size_t)t * D + hd * 256 + 8 * hh;
    unsigned L[2][16];
    unsigned hh4 = (unsigned)hh << 2; asm volatile("" : "+v"(hh4));
#pragma unroll
    for (int p = 0; p < 2; ++p) {
        f32x16 acc[4];
#pragma unroll
        for (int nt = 0; nt < 4; ++nt)
#pragma unroll
            for (int i = 0; i < 16; ++i) acc[nt][i] = 0.f;
        const size_t koff = ((size_t)(hd * 2 + p) * 128 + r) * 128 + 8 * hh;
        const bf16* qp = F.QH() + qoff + p * 128; const bf16* kp0 = F.KH() + koff; const bf16* kp1 = kp0 + 32 * 128; const bf16* kp2 = kp0 + 64 * 128; const bf16* kp3 = kp0 + 96 * 128;
        asm volatile("" : "+v"(qp), "+v"(kp0), "+v"(kp1), "+v"(kp2), "+v"(kp3));
#define P6_LOAD(Q, K, ks0, n) _Pragma("unroll") for (int i_ = 0; i_ < (n); ++i_) { Q[i_] = *(const GAS bf16x8s*)(qp + 16 * ((ks0) + i_)); \
            K[i_][0] = *(const GAS bf16x8s*)(kp0 + 16 * ((ks0) + i_)); K[i_][1] = *(const GAS bf16x8s*)(kp1 + 16 * ((ks0) + i_)); \
            K[i_][2] = *(const GAS bf16x8s*)(kp2 + 16 * ((ks0) + i_)); K[i_][3] = *(const GAS bf16x8s*)(kp3 + 16 * ((ks0) + i_)); }
#define P6_MMA(Q, K, n) _Pragma("unroll") for (int i_ = 0; i_ < (n); ++i_) _Pragma("unroll") for (int nt = 0; nt < 4; ++nt) acc[nt] = __builtin_amdgcn_mfma_f32_32x32x16_bf16(K[i_][nt], Q[i_], acc[nt], 0, 0, 0);
        bf16x8s qa[3], ka[3][4], qb[3], kb[3][4];
        P6_LOAD(qa, ka, 0, 3); P6_LOAD(qb, kb, 3, 3);
        __builtin_amdgcn_sched_barrier(0);
        P6_MMA(qa, ka, 3);
        __builtin_amdgcn_sched_barrier(0);
        P6_LOAD(qa, ka, 6, 2);
        __builtin_amdgcn_sched_barrier(0);
        P6_MMA(qb, kb, 3);
        __builtin_amdgcn_sched_barrier(0);
        P6_MMA(qa, ka, 2);
        __builtin_amdgcn_sched_barrier(0);
#undef P6_LOAD
#undef P6_MMA
        unsigned S[4][16];
#pragma unroll
        for (int nt = 0; nt < 4; ++nt) {
#pragma unroll
            for (int rg = 0; rg < 16; ++rg) { const int nc = 32 * nt + (rg & 3) + 8 * (rg >> 2); S[nt][rg] = ((fkey(acc[nt][rg]) & ~0x7Fu) | (unsigned)(127 - nc)) ^ hh4; }
            sort16_desc(S[nt]);
        }
        merge16_desc(S[0], S[1]); merge16_desc(S[2], S[3]); merge16_desc(S[0], S[2]);
        unsigned T[16];
#pragma unroll
        for (int i = 0; i < 16; ++i) T[i] = (unsigned)__shfl_xor((int)S[0][i], 32);
        merge16_desc(S[0], T);
#pragma unroll
        for (int i = 0; i < 16; ++i) L[p][i] = S[0][i];
        __builtin_amdgcn_sched_barrier(0);
    }
    float v0[16], v1[16];
#pragma unroll
    for (int i = 0; i < 16; ++i) { v0[i] = fkey_inv(L[0][i] & ~0x7Fu); v1[i] = fkey_inv(L[1][i] & ~0x7Fu); }
    unsigned C[4][16];
    {
        int cnt = 0;
#pragma unroll
        for (int i = 0; i < 16; ++i)
#pragma unroll
            for (int j = 0; j < 16; ++j) if ((i + 1) * (j + 1) <= 16) { C[cnt >> 4][cnt & 15] = (fkey(v0[i] + v1[j]) & ~0xFFu) | (unsigned)(255 - (i * 16 + j)); ++cnt; }
#pragma unroll
        for (int q = 50; q < 64; ++q) C[q >> 4][q & 15] = 0x80000000u;
    }
    sort16_desc(C[0]); sort16_desc(C[1]); sort16_desc(C[2]); sort16_desc(C[3]);
    merge16_desc(C[0], C[1]); merge16_desc(C[2], C[3]); merge16_desc(C[0], C[2]);
    unsigned best[16];
#pragma unroll
    for (int i = 0; i < 16; ++i) best[i] = C[0][i];
    LAS unsigned* tab = (LAS unsigned*)(F.lds + F.wave * 8192) + lane;
#pragma unroll
    for (int i = 0; i < 16; ++i) { tab[i * 64] = 127u - (L[0][i] & 0x7Fu); tab[(16 + i) * 64] = 127u - (L[1][i] & 0x7Fu); }
    const float smax = fkey_inv(best[0] & ~0xFFu);
    float sv[8]; unsigned idv[8]; float ssum = 0.f;
#pragma unroll
    for (int k = 0; k < 8; ++k) {
        const unsigned bk = hh ? best[8 + k] : best[k];
        const unsigned pos = 255u - (bk & 0xFFu);
        idv[k] = tab[(pos >> 4) * 64] * 128u + tab[(16 + (pos & 15u)) * 64];
        sv[k] = __builtin_amdgcn_exp2f((fkey_inv(bk & ~0xFFu) - smax) * 1.4426950409f); ssum += sv[k];
    }
    ssum += __shfl_xor(ssum, 32);
    const float inv = 1.0f / ssum;
    {
        int* o = F.IDS() + (size_t)t * 128 + hd * 16 + 8 * hh; float* og = F.GATES() + (size_t)t * 128 + hd * 16 + 8 * hh;
        *(GAS v4u*)o = (v4u){idv[0], idv[1], idv[2], idv[3]}; *(GAS v4u*)(o + 4) = (v4u){idv[4], idv[5], idv[6], idv[7]};
        *(GAS f32x4*)og = (f32x4){sv[0] * inv, sv[1] * inv, sv[2] * inv, sv[3] * inv}; *(GAS f32x4*)(og + 4) = (f32x4){sv[4] * inv, sv[5] * inv, sv[6] * inv, sv[7] * inv};
    }
}
__device__ __forceinline__ void h8_row(Frame& F, int t) {
    const int lane = F.lane;
    float hx[32]; float mx = 0.f;
    const bf16* hp = F.HB() + (size_t)t * D + lane * 16;
#pragma unroll
    for (int c = 0; c < 2; ++c)
#pragma unroll
        for (int q = 0; q < 2; ++q) { const v4u a = *(const GAS v4u*)(hp + c * 1024 + q * 8); float* x = hx + c * 16 + q * 8;
            x[0] = bf_lo(a.x); x[1] = bf_hi(a.x); x[2] = bf_lo(a.y); x[3] = bf_hi(a.y); x[4] = bf_lo(a.z); x[5] = bf_hi(a.z); x[6] = bf_lo(a.w); x[7] = bf_hi(a.w); }
#pragma unroll
    for (int i = 0; i < 32; ++i) mx = fmaxf(mx, fabsf(hx[i]));
#pragma unroll
    for (int o = 1; o < 64; o <<= 1) mx = fmaxf(mx, __shfl_xor(mx, o));
    const float sc = mx > 0.f ? 119.0f / mx : 1.0f;
#pragma unroll
    for (int c = 0; c < 2; ++c) {
        unsigned hw[2], lw[2];
#pragma unroll
        for (int g8 = 0; g8 < 2; ++g8) { unsigned hacc = 0u, lacc = 0u;
#pragma unroll
            for (int i = 0; i < 8; ++i) { const int q = (int)__builtin_rintf(hx[c * 16 + g8 * 8 + i] * sc); const int lo = ((q + 8) & 15) - 8, hi = (q - lo) >> 4;
                const int sh = (i & 3) * 8 + (i >> 2) * 4; hacc |= (unsigned)(hi & 15) << sh; lacc |= (unsigned)(lo & 15) << sh; }
            hw[g8] = hacc; lw[g8] = lacc; }
        unsigned char* hb_ = F.H8() + (size_t)t * D + c * 512 + lane * 8;
        *(GAS v2u*)hb_ = (v2u){hw[0], hw[1]}; *(GAS v2u*)(hb_ + 1024) = (v2u){lw[0], lw[1]};
    }
    if (lane == 0) F.HSCALE()[t] = mx > 0.f ? mx * (1.0f / 119.0f) : 1.0f;
}
__device__ __forceinline__ int row_sum16(int v) {
    v += __builtin_amdgcn_update_dpp(0, v, 0x128, 0xf, 0xf, false);
    v += __builtin_amdgcn_update_dpp(0, v, 0x124, 0xf, 0xf, false);
    v += __builtin_amdgcn_update_dpp(0, v, 0x122, 0xf, 0xf, false);
    v += __builtin_amdgcn_update_dpp(0, v, 0x121, 0xf, 0xf, false);
    return v;
}
__device__ __forceinline__ void peer_u_xcd(Frame& F) {
    const int lane = F.lane, x = blockIdx.x & 7, jcu = blockIdx.x >> 3, ncu = ((int)F.G - x + 7) >> 3;
    const int tpc = (M + ncu - 1) / ncu, tpw = (tpc + NWAVES - 1) / NWAVES;
    const int tbase = jcu * tpc + F.wave * tpw;
    int nw = M - tbase; { const int lim = (jcu + 1) * tpc - tbase; nw = nw < lim ? nw : lim; nw = nw < tpw ? nw : tpw; nw = nw < 0 ? 0 : nw; }
    const int NV = nw;
    LAS unsigned char* wl = F.lds + F.wave * 13312;
    LAS int* lst = (LAS int*)wl; LAS int* res = (LAS int*)(wl + 512); LAS unsigned char* hsl = wl + 1024;
    const int q4 = lane >> 4, i16 = lane & 15;
    const unsigned char* ubase = F.U8() + (size_t)x * 2048 * 1024;
    const unsigned lanepart = (unsigned)i16 * 16u;
    int r_idlo = 0, r_idhi = 0, r_t = 0; v4u r_h0 = (v4u){0u, 0u, 0u, 0u}, r_h1 = (v4u){0u, 0u, 0u, 0u};
    int v_cl0 = 0, v_cl1 = 0, v_n = 0, v_r0 = 0, v_t = 0, v_slot = 0; unsigned long long v_mlo = 0, v_mhi = 0; bool v_live = false;
    int vset = 0, nvalid = 0, idle = 0;
    if (NV == 0) return;
#define U_RAW() do { const int vi_ = vset < NV ? vset : NV - 1; r_t = tbase + vi_; \
        r_idlo = F.IDS()[(size_t)r_t * 128 + lane]; r_idhi = F.IDS()[(size_t)r_t * 128 + 64 + lane]; \
        r_h0 = *(const GAS v4u*)(F.H8() + (size_t)r_t * D + lane * 16); r_h1 = *(const GAS v4u*)(F.H8() + (size_t)r_t * D + 1024 + lane * 16); } while (0)
#define U_NEXT() do { if (v_live && v_r0 + 16 < v_n) { v_r0 += 16; } else if (vset < NV) { const bool slo = (r_idlo >> 11) == x, shi = (r_idhi >> 11) == x; \
            v_mlo = __ballot(slo); v_mhi = __ballot(shi); const int nlo = __popcll(v_mlo); v_n = nlo + __popcll(v_mhi); \
            const int plo = __builtin_amdgcn_mbcnt_hi((unsigned)(v_mlo >> 32), __builtin_amdgcn_mbcnt_lo((unsigned)v_mlo, 0)); \
            const int phi = nlo + __builtin_amdgcn_mbcnt_hi((unsigned)(v_mhi >> 32), __builtin_amdgcn_mbcnt_lo((unsigned)v_mhi, 0)); \
            if (slo) lst[plo] = (r_idlo & 2047) | (lane << 16); if (shi) lst[phi] = (r_idhi & 2047) | ((64 + lane) << 16); \
            v_slot = nvalid % 6; ++nvalid; { LAS unsigned char* sp_ = hsl + v_slot * 2048; *(LAS v4u*)(sp_ + lane * 16) = r_h0; *(LAS v4u*)(sp_ + 1024 + lane * 16) = r_h1; } \
            v_cl0 = lst[lane]; v_cl1 = lst[64 + lane]; v_t = r_t; v_r0 = 0; ++vset; v_live = true; } \
        else { v_live = false; v_n = 0; v_r0 = 0; v_mlo = 0; v_mhi = 0; ++idle; } } while (0)
#define U_ISSUE(BUF, DS) do { { const int rem_ = v_n - v_r0; DS##_cnt = rem_ < 0 ? 0 : (rem_ < 16 ? rem_ : 16); } \
        DS##_slot = v_slot; DS##_t = v_t; DS##_mlo = v_mlo; DS##_mhi = v_mhi; DS##_last = v_live && (v_r0 + 16 >= v_n); \
        _Pragma("unroll") for (int gp = 0; gp < 4; ++gp) { const int ix_ = v_r0 + 4 * gp + q4; const int a_ = __shfl(v_cl0, ix_ & 63), b_ = __shfl(v_cl1, ix_ & 63); DS##_ent[gp] = ix_ < 64 ? a_ : b_; \
            const unsigned of_ = (4 * gp + q4 < DS##_cnt ? ((unsigned)(DS##_ent[gp] & 2047) << 10) : 0u) + lanepart; \
            _Pragma("unroll") for (int c = 0; c < 4; ++c) BUF[4 * gp + c] = *(const GAS v4u*)(ubase + of_ + c * 256); } } while (0)
#define U_COMPUTE(BUF, DS) do { const LAS unsigned char* sp_ = hsl + DS##_slot * 2048; const LAS v4u* hp_ = (const LAS v4u*)(sp_ + i16 * 16); \
        _Pragma("unroll") for (int gp = 0; gp < 4; ++gp) if (4 * gp < DS##_cnt) { int ah_ = 0, al_ = 0; \
            _Pragma("unroll") for (int c = 0; c < 4; ++c) { const v4u r_ = BUF[4 * gp + c]; const v4u hh_ = hp_[c * 16], hl_ = hp_[64 + c * 16]; \
                ah_ = __builtin_amdgcn_sdot8((int)r_.x, (int)hh_.x, ah_, false); al_ = __builtin_amdgcn_sdot8((int)r_.x, (int)hl_.x, al_, false); \
                ah_ = __builtin_amdgcn_sdot8((int)r_.y, (int)hh_.y, ah_, false); al_ = __builtin_amdgcn_sdot8((int)r_.y, (int)hl_.y, al_, false); \
                ah_ = __builtin_amdgcn_sdot8((int)r_.z, (int)hh_.z, ah_, false); al_ = __builtin_amdgcn_sdot8((int)r_.z, (int)hl_.z, al_, false); \
                ah_ = __builtin_amdgcn_sdot8((int)r_.w, (int)hh_.w, ah_, false); al_ = __builtin_amdgcn_sdot8((int)r_.w, (int)hl_.w, al_, false); } \
            const int a_ = row_sum16((ah_ << 4) + al_); if (i16 == 0 && 4 * gp + q4 < DS##_cnt) res[DS##_ent[gp] >> 16] = a_; } \
        if (DS##_last) { int* po_ = F.PART() + (size_t)DS##_t * 128; \
            if ((DS##_mlo >> lane) & 1ull) po_[lane] = res[lane]; if ((DS##_mhi >> lane) & 1ull) po_[64 + lane] = res[64 + lane]; } } while (0)
    v4u bufA[16], bufB[16], bufC[16];
    int dA_cnt = 0, dA_ent[4] = {0, 0, 0, 0}, dA_t = 0, dA_slot = 0; unsigned long long dA_mlo = 0, dA_mhi = 0; bool dA_last = false;
    int dB_cnt = 0, dB_ent[4] = {0, 0, 0, 0}, dB_t = 0, dB_slot = 0; unsigned long long dB_mlo = 0, dB_mhi = 0; bool dB_last = false;
    int dC_cnt = 0, dC_ent[4] = {0, 0, 0, 0}, dC_t = 0, dC_slot = 0; unsigned long long dC_mlo = 0, dC_mhi = 0; bool dC_last = false;
    U_RAW();
    U_NEXT(); U_RAW(); U_ISSUE(bufA, dA);
    U_NEXT(); U_RAW(); U_ISSUE(bufB, dB);
    while (idle < 3) {
        U_NEXT(); U_RAW(); U_ISSUE(bufC, dC); U_COMPUTE(bufA, dA);
        U_NEXT(); U_RAW(); U_ISSUE(bufA, dA); U_COMPUTE(bufB, dB);
        U_NEXT(); U_RAW(); U_ISSUE(bufB, dB); U_COMPUTE(bufC, dC);
    }
#undef U_RAW
#undef U_NEXT
#undef U_ISSUE
#undef U_COMPUTE
}
__device__ __forceinline__ void peer_act_token(Frame& F, int t) {
    const int lane = F.lane;
    LAS unsigned char* wl = F.lds + F.wave * 4096;
    LAS float* abuf = (LAS float*)wl; LAS int* ibuf = (LAS int*)(wl + 512); LAS int* cnt = (LAS int*)(wl + 1024);
    LAS int* ovf = (LAS int*)(wl + 1280); LAS int* fre = (LAS int*)(wl + 1792); LAS int* sop = (LAS int*)(wl + 2304);
#define WFENCE() asm volatile("s_waitcnt lgkmcnt(0)" ::: "memory")
    const float sc = __builtin_amdgcn_rsqf(F.ROWSS()[t] * (1.0f / D) + 1e-6f) * F.HSCALE()[t];
    if (lane < 34) cnt[lane] = 0;
    float am = 0.f; float actv[2]; int idv[2], slotv[2];
    const int l32 = t & 31;
#pragma unroll
    for (int half = 0; half < 2; ++half) {
        const size_t o = (size_t)t * 128 + half * 64 + lane;
        const int e = F.IDS()[o]; const float g = F.GATES()[o];
        const int dsum = F.PART()[o];
        actv[half] = gelu_tanh((float)dsum * sc * F.USCALE()[e]) * g * F.VSCALE()[e]; idv[half] = e; am = fmaxf(am, fabsf(actv[half]));
    }
    WFENCE();
#pragma unroll
    for (int half = 0; half < 2; ++half) {
        const int r = idv[half] & 31;
        const int j = __hip_atomic_fetch_add(cnt + r, 1, __ATOMIC_RELAXED, __HIP_MEMORY_SCOPE_WORKGROUP);
        if (j < 4) slotv[half] = ((r - l32) & 31) + 32 * j;
        else { const int q = __hip_atomic_fetch_add(cnt + 32, 1, __ATOMIC_RELAXED, __HIP_MEMORY_SCOPE_WORKGROUP); ovf[q] = half * 64 + lane; slotv[half] = -1; }
    }
    WFENCE();
    if (lane < 32) { const int n = cnt[lane];
        for (int j = n; j < 4; ++j) { const int q = __hip_atomic_fetch_add(cnt + 33, 1, __ATOMIC_RELAXED, __HIP_MEMORY_SCOPE_WORKGROUP); fre[q] = ((lane - l32) & 31) + 32 * j; } }
    WFENCE();
    const int nov = cnt[32];
#pragma unroll
    for (int half = 0; half < 2; ++half) { const int i = half * 64 + lane; if (i < nov) sop[ovf[i]] = fre[i]; }
    WFENCE();
#pragma unroll
    for (int half = 0; half < 2; ++half) { if (slotv[half] < 0) slotv[half] = sop[half * 64 + lane]; abuf[slotv[half]] = actv[half]; ibuf[slotv[half]] = idv[half]; }
    WFENCE();
#pragma unroll
    for (int o = 1; o < 64; o <<= 1) am = fmaxf(am, __shfl_xor(am, o));
    const float asc = am > 0.f ? 127.0f / am : 1.0f;
    if (lane == 0) F.ASCALE()[t] = am > 0.f ? am * (1.0f / 127.0f) : 1.0f;
    if (lane < 32) {
        const f32x4 av = *(const LAS f32x4*)(abuf + 4 * lane); const v4u iv = *(const LAS v4u*)(ibuf + 4 * lane);
        const size_t o = ((size_t)(t >> 6) * 32 + lane) * 64 + (t & 63);
        F.IDW()[o] = (v4u){iv.x << 3, iv.y << 3, iv.z << 3, iv.w << 3};
        F.AW()[o] = pack_i8x4(av.x * asc, av.y * asc, av.z * asc, av.w * asc);
    }
    WFENCE();
#undef WFENCE
}
__device__ __forceinline__ void tr4x4(const unsigned r0, const unsigned r1, const unsigned r2, const unsigned r3, unsigned (&c)[4]) {
    const unsigned t01l = __builtin_amdgcn_perm(r1, r0, 0x05010400u), t01h = __builtin_amdgcn_perm(r1, r0, 0x07030602u);
    const unsigned t23l = __builtin_amdgcn_perm(r3, r2, 0x05010400u), t23h = __builtin_amdgcn_perm(r3, r2, 0x07030602u);
    c[0] = __builtin_amdgcn_perm(t23l, t01l, 0x05040100u); c[1] = __builtin_amdgcn_perm(t23l, t01l, 0x07060302u);
    c[2] = __builtin_amdgcn_perm(t23h, t01h, 0x05040100u); c[3] = __builtin_amdgcn_perm(t23h, t01h, 0x07060302u);
}
template <int MODE>
__device__ __forceinline__ void peer_v_slice(Frame& F, int c, bool do_atomic) {
    const int tid = F.tid, lane = F.lane;
    for (int i = tid; i < NEXP * 8 / 16; i += 512) *(LAS v4u*)(F.lds + i * 16) = *(const GAS v4u*)(F.V8T() + (size_t)c * NEXP * 8 + (size_t)i * 16);
    __syncthreads();
    const v4u* ibase = F.IDW() + lane; const unsigned* abase = F.AW() + lane;
    constexpr int NBLK = M / 64, PD = 16;
    v4u iq[PD]; unsigned aq[PD]; v2u rw[2][4];
    {
        const size_t o = (size_t)F.wave * 32 * 64;
#pragma unroll
        for (int j = 0; j < PD; ++j) { iq[j] = *(const GAS v4u*)(ibase + o + j * 64); aq[j] = abase[o + j * 64]; }
    }
#define LROW(dst, q) do { dst[0] = *(const LAS v2u*)(F.lds + (q).x); dst[1] = *(const LAS v2u*)(F.lds + (q).y); \
                          dst[2] = *(const LAS v2u*)(F.lds + (q).z); dst[3] = *(const LAS v2u*)(F.lds + (q).w); } while (0)
    for (int blk = F.wave; blk < NBLK; blk += NWAVES) {
        const int t = blk * 64 + lane;
        const size_t o = (size_t)blk * 32 * 64;
        const int nblk = (blk + NWAVES < NBLK) ? blk + NWAVES : blk;
        const size_t on = (size_t)nblk * 32 * 64;
        int acc[8];
#pragma unroll
        for (int i = 0; i < 8; ++i) acc[i] = 0;
        LROW(rw[0], iq[0]);
#pragma unroll
        for (int j = 0; j < 32; ++j) {
            if (j + 1 < 32) LROW(rw[(j + 1) & 1], iq[(j + 1) % PD]);
            const unsigned aw = aq[j % PD];
            unsigned cl[4], ch[4];
            tr4x4(rw[j & 1][0].x, rw[j & 1][1].x, rw[j & 1][2].x, rw[j & 1][3].x, cl);
            tr4x4(rw[j & 1][0].y, rw[j & 1][1].y, rw[j & 1][2].y, rw[j & 1][3].y, ch);
#pragma unroll
            for (int i = 0; i < 4; ++i) { acc[i] = __builtin_amdgcn_sdot4((int)aw, (int)cl[i], acc[i], false); acc[4 + i] = __builtin_amdgcn_sdot4((int)aw, (int)ch[i], acc[4 + i], false); }
            { const size_t oo = (j + PD < 32) ? o + (size_t)(j + PD) * 64 : on + (size_t)(j + PD - 32) * 64;
              iq[j % PD] = *(const GAS v4u*)(ibase + oo); aq[j % PD] = abase[oo]; }
            __builtin_amdgcn_sched_barrier(0);
        }
        const float asc = F.ASCALE()[t];
        float accf[8];
#pragma unroll
        for (int i = 0; i < 8; ++i) accf[i] = (float)acc[i] * asc;
        const v4u hb = *(const GAS v4u*)(F.HBT() + ((size_t)c * M + t) * 8);
        accf[0] += bf_lo(hb.x); accf[1] += bf_hi(hb.x); accf[2] += bf_lo(hb.y); accf[3] += bf_hi(hb.y);
        accf[4] += bf_lo(hb.z); accf[5] += bf_hi(hb.z); accf[6] += bf_lo(hb.w); accf[7] += bf_hi(hb.w);
        bf16* yp = (MODE == 0) ? F.Y() + ((size_t)c * M + t) * 8 : (bf16*)F.XN() + ((((size_t)c * M + t) * 8) & (size_t)0x1ffffff);
        *(GAS v4u*)yp = (v4u){pk2(accf[0], accf[1]), pk2(accf[2], accf[3]), pk2(accf[4], accf[5]), pk2(accf[6], accf[7])};
        float ss = 0.f;
#pragma unroll
        for (int i = 0; i < 8; ++i) ss += accf[i] * accf[i];
        if (do_atomic) atomicAdd(F.ROWSS2() + t, ss);
    }
#undef LROW
    __syncthreads();
}
__device__ __forceinline__ void final_unit(Frame& F, int unit) {
    const int tid = F.tid, blk = unit >> 3, cg = unit & 7, t0 = blk * 64;
    LAS float* T = (LAS float*)F.lds;
#pragma unroll
    for (int i = 0; i < 4; ++i) { const int pid = tid + 512 * i, cl = pid >> 6, tok = pid & 63;
        const v4u v = *(const GAS v4u*)(F.Y() + ((size_t)(cg * 32 + cl) * M + t0 + tok) * 8);
        *(LAS f32x4*)(T + tok * 260 + cl * 8) = (f32x4){bf_lo(v.x), bf_hi(v.x), bf_lo(v.y), bf_hi(v.y)};
        *(LAS f32x4*)(T + tok * 260 + cl * 8 + 4) = (f32x4){bf_lo(v.z), bf_hi(v.z), bf_lo(v.w), bf_hi(v.w)}; }
    __syncthreads();
#pragma unroll
    for (int i = 0; i < 8; ++i) { const int pid = tid + 512 * i, tok = pid >> 6, c4 = pid & 63;
        const float rs = __builtin_amdgcn_rsqf(F.ROWSS2()[t0 + tok] * (1.0f / D) + 1e-6f);
        const f32x4 v = *(const LAS f32x4*)(T + tok * 260 + c4 * 4);
        const f32x4 g = *(const GAS f32x4*)(F.A.in[20] + cg * 256 + c4 * 4);
        *(GAS f32x4*)(F.A.out + (size_t)(t0 + tok) * D + cg * 256 + c4 * 4) = v * rs * g; }
    __syncthreads();
}
__global__ void __launch_bounds__(NWAVES * 64, 2) mk_fwd(Args args) {
    __shared__ __attribute__((aligned(16))) unsigned char lds[LDS_BYTES];
    Frame F(args);
    F.lds = (LAS unsigned char*)lds;
    F.MISC = (volatile LAS unsigned*)(F.lds + MISC_OFF);
    F.tid = threadIdx.x; F.lane = F.tid & 63; F.wave = __builtin_amdgcn_readfirstlane(F.tid >> 6);
    F.G = gridDim.x; { const int bx = blockIdx.x; F.vcu = (F.G % 8 == 0) ? (bx % 8) * (F.G / 8) + bx / 8 : bx; }
    F.ws = args.ws;
    F.ctl = (gu32*)(args.ws + WS_CTL);
    for (int u = F.tid; u < (LDS_BYTES - LDSCTL_OFF) / 4; u += NWAVES * 64) ((LAS unsigned*)(F.lds + LDSCTL_OFF))[u] = 0u;
    __syncthreads();
    XcdBarrier bar; bar.bar = (unsigned*)(F.ctl + CW_BAR); bar.x = 0; bar.st = nullptr;
    if (N_LAUNCHES != PER_PHASE) bar = xcd_barrier_post((unsigned*)(F.ctl + CW_BAR), F.MISC + 8);
#define GRID_BAR() do { if (N_LAUNCHES != PER_PHASE) xcd_barrier(bar); } while (0)
    const int lo = args.ph_lo, hi = args.ph_hi;
#ifndef MK_PHASE_MASK
#define MK_PHASE_MASK 0x7FF
#endif
#define IN(k) (((MK_PHASE_MASK >> (k)) & 1) && lo <= (k) && (k) < hi)
#undef MK_PHASE_MASK
#define MK_PHASE_MASK 0xFFFF
#define BOTH(k) (true)
#ifndef MK_REP_MASK
#define MK_REP_MASK 0
#endif
#ifndef MK_REP_N
#define MK_REP_N 2
#endif
#define REPS(k) for (int rep_ = 0; rep_ < ((((MK_REP_MASK) >> (k)) & 1) ? 1 + MK_REP_N : 1); ++rep_)
    const int gw = F.vcu * NWAVES + F.wave, NGW = F.G * NWAVES;
    if (IN(0)) { REPS(0) { p0_prologue(F); __syncthreads(); } if (BOTH(0)) GRID_BAR(); }
    if (IN(1)) {
        pg8::Gemm g{F.XN(), F.WIN(), M, NIN, D}; pg8::StaticOrder S; S.init(M, NIN, F.G, (int)blockIdx.x);
        pg8::EpiZ E{F.Z(), NIN, LW};
        REPS(1) pg8::gemm_phase<pg8::EpiZ, pg8::StaticOrder, true, true>(F.lds, g, S, E);
        if (BOTH(1)) GRID_BAR();
    }
    if (IN(2)) {
        REPS(12) for (int u = blockIdx.x; u < BATCH * NCHUNK * 8; u += F.G) lru_unit<false>(F, u);
        if (BOTH(2)) GRID_BAR();
    }
    if (IN(3)) {
        lru_carry(F);
        REPS(13) for (int u = blockIdx.x; u < BATCH * NCHUNK; u += F.G) gmlp_unit(F, u);
        if (BOTH(3)) GRID_BAR();
    }
    if (IN(11)) {
        REPS(3) for (int u = blockIdx.x; u < BATCH * NCHUNK * 8; u += F.G) lru_unit<true>(F, u);
        GRID_BAR();
    }
    if (IN(4)) {
        pg8::Gemm g{F.MIX(), F.WOUT(), M, D, D}; pg8::StaticOrder S; S.init(M, D, F.G, (int)blockIdx.x);
        pg8::EpiH E{F.HB(), F.HBT(), F.A.in[0], F.ROWSS(), D, M};
        pg8::gemm_phase<pg8::EpiH, pg8::StaticOrder, true, true>(F.lds, g, S, E);
        if (BOTH(4)) GRID_BAR();
    }
    if (IN(5)) {
        pg8::Gemm g{F.HB(), F.WQ(), M, D, D}; pg8::StaticOrder S; S.init(M, D, F.G, (int)blockIdx.x);
        pg8::EpiQ E{F.QH(), F.ROWSS(), D};
        REPS(5) pg8::gemm_phase<pg8::EpiQ, pg8::StaticOrder, true, true>(F.lds, g, S, E);
        if (BOTH(5)) GRID_BAR();
    }
    if (IN(6)) {
        REPS(6) { for (int wu = gw; wu < (M / 32) * 8; wu += NGW) topk_unit(F, wu);
                  for (int t = gw; t < M; t += NGW) h8_row(F, t); }
        if (BOTH(6)) GRID_BAR();
    }
    if (IN(7)) {
        REPS(7) peer_u_xcd(F);
        if (BOTH(7)) GRID_BAR();
    }
    if (IN(8)) {
        REPS(8) for (int t = gw; t < M; t += NGW) peer_act_token(F, t);
        if (BOTH(8)) GRID_BAR();
    }
    if (IN(9)) {
        for (int c = blockIdx.x; c < D / 8; c += F.G) peer_v_slice<0>(F, c, true);
        if ((MK_REP_MASK >> 9) & 1) { for (int rep_ = 0; rep_ < MK_REP_N; ++rep_) for (int c = blockIdx.x; c < D / 8; c += F.G) peer_v_slice<1>(F, c, false); }
        if (BOTH(9)) GRID_BAR();
    }
    if (IN(10)) {
        REPS(10) for (int u = blockIdx.x; u < (M / 64) * 8; u += F.G) final_unit(F, u);
    }
#undef IN
#undef BOTH
#undef GRID_BAR
}

extern "C" void kernel_launch(void* const* d_in, const int* in_sizes, int n_in, void* d_out, int out_size, void* d_ws, size_t ws_size, hipStream_t stream) {
    static int grid = 0;
    if (grid == 0) {
        if (n_in != 21 || in_sizes[0] != M * D || out_size != M * D || ws_size < WS_END) { fprintf(stderr, "kernel_launch: unexpected shapes (n_in %d, in0 %d, out %d, ws %zu)\n", n_in, n_in > 0 ? in_sizes[0] : -1, out_size, ws_size); grid = -1; return; }
        int dev = 0, cus = 0, per_cu = 0;
        if (hipGetDevice(&dev) != hipSuccess || hipDeviceGetAttribute(&cus, hipDeviceAttributeMultiprocessorCount, dev) != hipSuccess) { grid = -1; return; }
        if (hipOccupancyMaxActiveBlocksPerMultiprocessor(&per_cu, (const void*)mk_fwd, NWAVES * 64, 0) != hipSuccess || per_cu < 1) { fprintf(stderr, "kernel_launch: occupancy query reports %d blocks per CU\n", per_cu); }
        (void)hipGetLastError();
        grid = cus;
    }
    if (grid < 0) return;
    (void)hipMemsetAsync((char*)d_ws + WS_CTL, 0, CTL_ZERO_BYTES, stream);
    Args a{};
    for (int i = 0; i < 21; ++i) a.in[i] = (const float*)d_in[i];
    a.out = (float*)d_out; a.ws = (unsigned char*)d_ws;
    for (int li = 0; li < N_LAUNCHES; ++li) {
        a.ph_lo = 0; a.ph_hi = 99;
        hipLaunchKernelGGL(mk_fwd, dim3(grid), dim3(NWAVES * 64), 0, stream, a);
    }
}
```

```cpp
#include <hip/hip_runtime.h>
#include <cstdio>
#include <cstdint>
namespace pg8 {
#define PG8_LAS __attribute__((address_space(3)))
typedef unsigned short bf16_t;
typedef short bf16x8 __attribute__((ext_vector_type(8)));
typedef float f32x4 __attribute__((ext_vector_type(4)));
typedef unsigned u32x4 __attribute__((ext_vector_type(4)));
constexpr int BM = 256, BK = 64, HALF = 128, HTB = HALF * BK * 2  , STAGE_BYTES = 8 * HTB, NXCD = 8, WGM = 8;

__host__ __device__ __forceinline__ int lds_byte(int r, int c) { const int st = (r >> 4) * 2 + (c >> 5), rr = r & 15, cc = c & 31, ob = rr * 64 + cc * 2; return st * 1024 + (ob ^ (((ob >> 9) & 1) << 5)); }
__host__ __device__ __forceinline__ void stage_rc(int b, int& R, int& C) { const int st = b / 1024, sb = b % 1024, swz = sb ^ (((sb >> 9) & 1) << 5); R = (st >> 1) * 16 + swz / 64; C = (st & 1) * 32 + (swz % 64) / 2; }
__host__ __device__ __forceinline__ int perm32(int rho) { const int n = rho >> 4, i = rho & 15; return 8 * (i >> 2) + 4 * n + (i & 3); }

struct Unit { int pm, pn; };
struct Gemm { const bf16_t* A; const bf16_t* Bt; int M, N, K; };

struct StaticOrder {
    int nM, nN, nwg, G, c;
    __host__ __device__ void init(int M, int N, int G_, int c_) { nM = M / BM; nN = N / BM; nwg = nM * nN; G = G_; c = c_; }
    __host__ __device__ bool next(int i, Unit& u) const {
        const long L = (long)i * G + c; if (L >= nwg) return false;
        int wgid = (int)L; { const int q = nwg / NXCD, r = nwg % NXCD, xcd = wgid % NXCD, off = wgid / NXCD; wgid = (xcd < r ? xcd * (q + 1) : r * (q + 1) + (xcd - r) * q) + off; }
        const int nig = WGM * nN, gid = wgid / nig, fm = gid * WGM, gsz = (nM - fm) < WGM ? (nM - fm) : WGM;
        u.pm = fm + ((wgid % nig) % gsz); u.pn = (wgid % nig) / gsz; return true;
    }
    __device__ __forceinline__ void a_ready(const Unit&) const {}
    __device__ __forceinline__ void done(const Unit&) const {}
};

__device__ __forceinline__ unsigned cvt_pk_bf16(float lo, float hi) { unsigned r; asm volatile("v_cvt_pk_bf16_f32 %0, %1, %2" : "=v"(r) : "v"(lo), "v"(hi)); return r; }
__device__ __forceinline__ float gelu_tanh(float x) {
    const float t = x * (1.0f + 0.044715f * x * x);
    const float e = __builtin_amdgcn_exp2f(-2.3022081983f * t);
    return x * __builtin_amdgcn_rcpf(1.0f + e);
}
struct EpiZ {
    static constexpr bool PERM = true, AFTER_DRAIN = false;
    bf16_t* O; int ldc; int gelu_from;
    __device__ __forceinline__ void operator()(const f32x4 (&acc)[2][2][4][2], const Unit& u, int wr, int wc, int fr, int fq) const {
        const int row0 = u.pm * BM + wr * 64 + fr; const int col0 = u.pn * BM + wc * 32 + 8 * fq;
        const bool act = (u.pn * BM) >= gelu_from;
#pragma unroll
        for (int ai = 0; ai < 2; ++ai)
#pragma unroll
            for (int m = 0; m < 4; ++m) { bf16_t* rowp = O + (size_t)(row0 + ai * HALF + m * 16) * ldc + col0;
#pragma unroll
                for (int bj = 0; bj < 2; ++bj) { f32x4 v0 = acc[ai][bj][m][0], v1 = acc[ai][bj][m][1];
                    if (act) {
#pragma unroll
                        for (int j = 0; j < 4; ++j) { v0[j] = gelu_tanh(v0[j]); v1[j] = gelu_tanh(v1[j]); } }
                    u32x4 w; w.x = cvt_pk_bf16(v0[0], v0[1]); w.y = cvt_pk_bf16(v0[2], v0[3]); w.z = cvt_pk_bf16(v1[0], v1[1]); w.w = cvt_pk_bf16(v1[2], v1[3]);
                    *(u32x4*)(rowp + bj * HALF) = w; } }
    }
};
struct EpiH {
    static constexpr bool PERM = true, AFTER_DRAIN = false;
    bf16_t* O; bf16_t* OT; const float* X; float* rowss; int ldc; int mrows;
    __device__ __forceinline__ void operator()(const f32x4 (&acc)[2][2][4][2], const Unit& u, int wr, int wc, int fr, int fq) const {
        const int row0 = u.pm * BM + wr * 64 + fr; const int col0 = u.pn * BM + wc * 32 + 8 * fq;
#pragma unroll
        for (int ai = 0; ai < 2; ++ai)
#pragma unroll
            for (int m = 0; m < 4; ++m) { const int row = row0 + ai * HALF + m * 16; const size_t off = (size_t)row * ldc + col0; float ss = 0.f;
#pragma unroll
                for (int bj = 0; bj < 2; ++bj) {
                    const f32x4 x0 = *(const f32x4*)(X + off + bj * HALF), x1 = *(const f32x4*)(X + off + bj * HALF + 4);
                    const f32x4 v0 = acc[ai][bj][m][0] + x0, v1 = acc[ai][bj][m][1] + x1;
                    ss += (v0[0] * v0[0] + v0[1] * v0[1]) + (v0[2] * v0[2] + v0[3] * v0[3]) + (v1[0] * v1[0] + v1[1] * v1[1]) + (v1[2] * v1[2] + v1[3] * v1[3]);
                    u32x4 w; w.x = cvt_pk_bf16(v0[0], v0[1]); w.y = cvt_pk_bf16(v0[2], v0[3]); w.z = cvt_pk_bf16(v1[0], v1[1]); w.w = cvt_pk_bf16(v1[2], v1[3]);
                    *(u32x4*)(O + off + bj * HALF) = w;
                    *(u32x4*)(OT + ((size_t)((col0 + bj * HALF) >> 3) * mrows + row) * 8) = w; }
                ss += __shfl_xor(ss, 16); ss += __shfl_xor(ss, 32);
                if (fq == 0) atomicAdd(rowss + row, ss); }
    }
};
struct EpiQ {
    static constexpr bool PERM = true, AFTER_DRAIN = false;
    bf16_t* QH; const float* rowss; int ldc;
    __device__ __forceinline__ void operator()(const f32x4 (&acc)[2][2][4][2], const Unit& u, int wr, int wc, int fr, int fq) const {
        const int row0 = u.pm * BM + wr * 64 + fr, col0 = u.pn * BM + wc * 32 + 8 * fq;
#pragma unroll
        for (int ai = 0; ai < 2; ++ai)
#pragma unroll
            for (int m = 0; m < 4; ++m) { const int row = row0 + ai * HALF + m * 16; const float rs = __builtin_amdgcn_rsqf(rowss[row] * (1.0f / 2048.0f) + 1e-6f);
                const size_t off = (size_t)row * ldc + col0;
#pragma unroll
                for (int bj = 0; bj < 2; ++bj) { const f32x4 v0 = acc[ai][bj][m][0] * rs, v1 = acc[ai][bj][m][1] * rs;
                    u32x4 wh; wh.x = cvt_pk_bf16(v0[0], v0[1]); wh.y = cvt_pk_bf16(v0[2], v0[3]); wh.z = cvt_pk_bf16(v1[0], v1[1]); wh.w = cvt_pk_bf16(v1[2], v1[3]);
                    *(u32x4*)(QH + off + bj * HALF) = wh; } }
    }
};
template <class Epi, class Sched, bool ALIGN_EPI = false, bool SP2 = false>
__device__ __forceinline__ void gemm_phase(PG8_LAS unsigned char* lds, const Gemm g, const Sched& S, const Epi& E) {
    const int tid = threadIdx.x, wid = __builtin_amdgcn_readfirstlane(tid >> 6), lane = tid & 63, wr = wid >> 2, wc = wid & 3, fr = lane & 15, fq = lane >> 4;
    const int K = g.K, nt = K / BK;
    unsigned voffA[2], voffB[2];
#pragma unroll
    for (int i = 0; i < 2; ++i) { int R, C; stage_rc(tid * 16 + i * 8192, R, C); const int Rb = Epi::PERM ? ((R & ~31) + perm32(R & 31)) : R;
        voffA[i] = (unsigned)(R * K + C) * 2u; voffB[i] = (unsigned)(Rb * K + C) * 2u; }
    const size_t kstep = (size_t)(BK * 2);
    const size_t hstep = (size_t)HALF * K * 2;
    const size_t tstep = 2 * hstep;
    const unsigned ldsw = (unsigned)wid * 1024u;
    const int aoff = lds_byte(wr * 64 + fr, fq * 8), boff = lds_byte(wc * 32 + fr, fq * 8);
#define PG8_SA(b, h) (((b) * 2 + (h)) * HTB)
#define PG8_SB(b, h) ((4 + (b) * 2 + (h)) * HTB)
#define PG8_STAGE(bufoff, gbase, voff) do { _Pragma("unroll") for (int _i = 0; _i < 2; ++_i) \
        __builtin_amdgcn_global_load_lds((const unsigned*)((const char*)(gbase) + (voff)[_i]), (PG8_LAS unsigned*)(lds + (bufoff) + ldsw + _i * 8192), 16, 0, 0); } while (0)
#define PG8_LDA(dst, b, h) do { _Pragma("unroll") for (int m = 0; m < 4; ++m) _Pragma("unroll") for (int k = 0; k < 2; ++k) dst[m][k] = *(const PG8_LAS bf16x8*)(lds + PG8_SA(b, h) + aoff + m * 2048 + k * 1024); } while (0)
#define PG8_LDB(dst, b, h) do { _Pragma("unroll") for (int n = 0; n < 2; ++n) _Pragma("unroll") for (int k = 0; k < 2; ++k) dst[n][k] = *(const PG8_LAS bf16x8*)(lds + PG8_SB(b, h) + boff + n * 2048 + k * 1024); } while (0)
#define PG8_MMA(ai, bj, At, Bt) do { __builtin_amdgcn_s_setprio(1); _Pragma("unroll") for (int m = 0; m < 4; ++m) _Pragma("unroll") for (int n = 0; n < 2; ++n) _Pragma("unroll") for (int k = 0; k < 2; ++k) \
        acc[ai][bj][m][n] = __builtin_amdgcn_mfma_f32_16x16x32_bf16(Bt[n][k], At[m][k], acc[ai][bj][m][n], 0, 0, 0); __builtin_amdgcn_s_setprio(0); } while (0)
#define PG8_WAIT_V(n) asm volatile("s_waitcnt vmcnt(" #n ")" ::: "memory")
#define PG8_WAIT_L(n) asm volatile("s_waitcnt lgkmcnt(" #n ")" ::: "memory")
#define PG8_BAR __builtin_amdgcn_s_barrier()
#define PG8_SCHED __builtin_amdgcn_sched_barrier(0)
    Unit cur, nxt; int ui = 0;
    if (!S.next(0, cur)) return;
    f32x4 acc[2][2][4][2];
#pragma unroll
    for (int a = 0; a < 2; ++a)
#pragma unroll
        for (int b = 0; b < 2; ++b)
#pragma unroll
            for (int m = 0; m < 4; ++m)
#pragma unroll
                for (int n = 0; n < 2; ++n) acc[a][b][m][n] = (f32x4){0.f, 0.f, 0.f, 0.f};
    bf16x8 At[4][2], B0[2][2], B1[2][2];
    const char* cA = (const char*)g.A + (size_t)cur.pm * tstep; const char* cB = (const char*)g.Bt + (size_t)cur.pn * tstep;
    S.a_ready(cur);
    if constexpr (SP2) {
        PG8_STAGE(PG8_SB(0, 0), cB, voffB); PG8_STAGE(PG8_SB(0, 1), cB + hstep, voffB); PG8_STAGE(PG8_SA(0, 0), cA, voffA); PG8_STAGE(PG8_SA(0, 1), cA + hstep, voffA);
        if (wr == 1) PG8_BAR;
        PG8_WAIT_V(2); PG8_BAR;
        PG8_STAGE(PG8_SB(1, 0), cB + kstep, voffB); PG8_STAGE(PG8_SA(1, 0), cA + kstep, voffA); PG8_STAGE(PG8_SB(1, 1), cB + hstep + kstep, voffB);
        PG8_WAIT_V(6); PG8_BAR;
    } else {
        PG8_STAGE(PG8_SB(0, 0), cB, voffB); PG8_STAGE(PG8_SA(0, 0), cA, voffA); PG8_STAGE(PG8_SB(0, 1), cB + hstep, voffB); PG8_STAGE(PG8_SA(0, 1), cA + hstep, voffA);
        if (wr == 1) PG8_BAR;
        PG8_WAIT_V(4); PG8_BAR;
        PG8_STAGE(PG8_SB(1, 0), cB + kstep, voffB); PG8_STAGE(PG8_SA(1, 0), cA + kstep, voffA); PG8_STAGE(PG8_SB(1, 1), cB + hstep + kstep, voffB);
        PG8_WAIT_V(6); PG8_BAR;
    }
    for (;;) {
        const bool has_next = S.next(ui + 1, nxt);
        const char* nA = has_next ? (const char*)g.A + (size_t)nxt.pm * tstep : cA; const char* nB = has_next ? (const char*)g.Bt + (size_t)nxt.pn * tstep : cB;
        for (int t = 0; t < nt; t += 2) {
            const bool last = (t == nt - 2);
            const char* a1 = cA + (size_t)(t + 1) * kstep;
            const char* a2 = last ? nA : cA + (size_t)(t + 2) * kstep; const char* b2 = last ? nB : cB + (size_t)(t + 2) * kstep;
            const char* a3 = a2 + kstep; const char* b3 = b2 + kstep;
            if (last && has_next) S.a_ready(nxt);
            if constexpr (SP2) {
            PG8_LDB(B0, 0, 0); PG8_LDB(B1, 0, 1); PG8_SCHED; PG8_LDA(At, 0, 0); PG8_STAGE(PG8_SA(1, 1), a1 + hstep, voffA);
            PG8_WAIT_V(8); PG8_WAIT_L(0); PG8_BAR; PG8_MMA(0, 0, At, B0); PG8_MMA(0, 1, At, B1); PG8_BAR; PG8_SCHED;
            PG8_LDA(At, 0, 1); PG8_STAGE(PG8_SB(0, 0), b2, voffB); PG8_STAGE(PG8_SB(0, 1), b2 + hstep, voffB); PG8_STAGE(PG8_SA(0, 0), a2, voffA);
            PG8_WAIT_V(8); PG8_WAIT_L(0); PG8_BAR; PG8_MMA(1, 0, At, B0); PG8_MMA(1, 1, At, B1); PG8_BAR; PG8_SCHED;
            PG8_LDB(B0, 1, 0); PG8_LDB(B1, 1, 1); PG8_SCHED; PG8_LDA(At, 1, 0); PG8_STAGE(PG8_SA(0, 1), a2 + hstep, voffA);
            PG8_WAIT_V(8); PG8_WAIT_L(0); PG8_BAR; PG8_MMA(0, 0, At, B0); PG8_MMA(0, 1, At, B1); PG8_BAR; PG8_SCHED;
            PG8_LDA(At, 1, 1); PG8_STAGE(PG8_SB(1, 0), b3, voffB); PG8_STAGE(PG8_SB(1, 1), b3 + hstep, voffB); PG8_STAGE(PG8_SA(1, 0), a3, voffA);
            PG8_WAIT_V(8); PG8_WAIT_L(0); PG8_BAR; PG8_MMA(1, 0, At, B0); PG8_MMA(1, 1, At, B1); PG8_BAR; PG8_SCHED;
            } else {
            PG8_LDB(B0, 0, 0); PG8_SCHED; PG8_LDA(At, 0, 0); PG8_STAGE(PG8_SA(1, 1), a1 + hstep, voffA);
            PG8_WAIT_L(8); PG8_BAR; PG8_WAIT_L(0); PG8_MMA(0, 0, At, B0); PG8_BAR; PG8_SCHED;
            PG8_LDB(B1, 0, 1); PG8_STAGE(PG8_SB(0, 0), b2, voffB);
            PG8_BAR; PG8_WAIT_L(0); PG8_MMA(0, 1, At, B1); PG8_BAR;
            PG8_LDA(At, 0, 1); PG8_STAGE(PG8_SA(0, 0), a2, voffA);
            PG8_BAR; PG8_WAIT_L(0); PG8_MMA(1, 0, At, B0); PG8_BAR; PG8_SCHED;
            PG8_STAGE(PG8_SB(0, 1), b2 + hstep, voffB);
            PG8_WAIT_V(6); PG8_BAR; PG8_MMA(1, 1, At, B1); PG8_BAR;
            PG8_LDB(B0, 1, 0); PG8_SCHED; PG8_LDA(At, 1, 0); PG8_STAGE(PG8_SA(0, 1), a2 + hstep, voffA);
            PG8_WAIT_L(8); PG8_BAR; PG8_WAIT_L(0); PG8_MMA(0, 0, At, B0); PG8_BAR; PG8_SCHED;
            PG8_LDB(B1, 1, 1); PG8_STAGE(PG8_SB(1, 0), b3, voffB);
            PG8_BAR; PG8_WAIT_L(0); PG8_MMA(0, 1, At, B1); PG8_BAR;
            PG8_LDA(At, 1, 1); PG8_STAGE(PG8_SA(1, 0), a3, voffA);
            PG8_BAR; PG8_WAIT_L(0); PG8_MMA(1, 0, At, B0); PG8_BAR; PG8_SCHED;
            PG8_STAGE(PG8_SB(1, 1), b3 + hstep, voffB);
            PG8_WAIT_V(6); PG8_BAR; PG8_MMA(1, 1, At, B1); PG8_BAR;
            }
        }
        if constexpr (ALIGN_EPI) { if (wr == 0) PG8_BAR; }
        if constexpr (!Epi::AFTER_DRAIN) { E(acc, cur, wr, wc, fr, fq); S.done(cur); }
        if (!has_next) break;
#pragma unroll
        for (int a = 0; a < 2; ++a)
#pragma unroll
            for (int b = 0; b < 2; ++b)
#pragma unroll
                for (int m = 0; m < 4; ++m)
#pragma unroll
                    for (int n = 0; n < 2; ++n) acc[a][b][m][n] = (f32x4){0.f, 0.f, 0.f, 0.f};
        cur = nxt; cA = nA; cB = nB; ++ui;
        if constexpr (ALIGN_EPI) { if (wr == 1) PG8_BAR; }
    }
    PG8_WAIT_V(0);
    if constexpr (!ALIGN_EPI) { if (wr == 0) PG8_BAR; }
    PG8_BAR;
    if constexpr (Epi::AFTER_DRAIN) { E.fused(acc, cur, wr, wc, fr, fq, lds, wid, lane); S.done(cur); }
#undef PG8_SA
#undef PG8_SB
#undef PG8_STAGE
#undef PG8_LDA
#undef PG8_LDB
#undef PG8_MMA
#undef PG8_WAIT_V
#undef PG8_WAIT_L
#undef PG8_BAR
#undef PG8_SCHED
}
}
constexpr int NWAVES = 8;
constexpr int BATCH = 4, SEQ = 8192, D = 2048, M = BATCH * SEQ, NIN = 4096, LW = 1024, CHUNK = 128, NCHUNK = SEQ / CHUNK;
constexpr int NEXP = 16384;
#ifndef MK_N_LAUNCHES
#define MK_N_LAUNCHES 1
#endif
constexpr int N_LAUNCHES = MK_N_LAUNCHES;
constexpr int PER_PHASE = 11;
constexpr size_t MiB = 1u << 20;
constexpr size_t WS_CTL = 0, CTL_ZERO_BYTES = 1 * MiB;
constexpr size_t WS_ROWSS = 512 * 1024;
constexpr size_t WS_WIN = 2 * MiB, WS_WOUT = 18 * MiB, WS_WQ = 26 * MiB, WS_LRUW = 34 * MiB, WS_WSB = 35 * MiB, WS_AGG = 36 * MiB;
constexpr size_t WS_U = 64 * MiB, WS_V = 128 * MiB, WS_XN = 192 * MiB  , WS_Z = 320 * MiB  ;
constexpr size_t WS_HB = 576 * MiB, WS_IDS = 704 * MiB, WS_GATES = 720 * MiB, WS_PAIRS = 736 * MiB, WS_HBT = 752 * MiB, WS_END = 884 * MiB;
constexpr size_t WS_USCALE = 40 * MiB, WS_VSCALE = 41 * MiB;
constexpr size_t WS_HSCALE = 44 * MiB, WS_CARRY = 45 * MiB;
constexpr size_t WS_H8 = WS_XN, WS_PART = WS_XN + 64 * MiB;
constexpr size_t WS_ASCALE = 42 * MiB, WS_KH = 43 * MiB;
constexpr size_t WS_IDW = WS_PAIRS, WS_AW = 880 * MiB;
constexpr size_t WS_ROWSS2 = 640 * 1024;
constexpr size_t WS_Y = WS_Z;
constexpr int CW_BAR = 4096;
constexpr int RING_BYTES = 131072;
constexpr int LDSCTL_OFF = 143360, MISC_OFF = LDSCTL_OFF + 320;
constexpr int LDS_BYTES = 147456;
#define GAS __attribute__((address_space(1)))
#define LAS __attribute__((address_space(3)))
typedef unsigned short bf16;
typedef unsigned v4u __attribute__((ext_vector_type(4)));
typedef float f32x4 __attribute__((ext_vector_type(4)));
typedef short bf16x8 __attribute__((ext_vector_type(8)));
typedef GAS unsigned gu32;
typedef GAS unsigned long long gu64;
#define RLX_AGENT __ATOMIC_RELAXED, __HIP_MEMORY_SCOPE_AGENT
#define LDS_WAIT() asm volatile("s_waitcnt lgkmcnt(0)" ::: "memory")
#define VM_WAIT() asm volatile("s_waitcnt vmcnt(0)" ::: "memory")
__device__ __forceinline__ unsigned long long rt() { return __builtin_amdgcn_s_memrealtime(); }
__device__ __forceinline__ unsigned f2bf(float f) { unsigned u = __builtin_bit_cast(unsigned, f); return (u + 0x7fffu + ((u >> 16) & 1u)) >> 16; }
__device__ __forceinline__ unsigned pk2(float lo, float hi) { return f2bf(lo) | (f2bf(hi) << 16); }

#define XB_TMO      128
#define XB_XCNT(j)  (256  + 64 * (j))
#define XB_XSUB(j)  (1280 + 64 * (j))
#define XB_XGEN(j)  (2304 + 64 * (j))
#define XB_TOP      3328
#define XB_TOPGEN   3392
#define XCD_BAR_WORDS 3456
#define XB_SPIN_CAP (1u << 18)

__device__ __forceinline__ unsigned xb_ld(unsigned* p)              { return __hip_atomic_load(p, __ATOMIC_RELAXED, __HIP_MEMORY_SCOPE_AGENT); }
__device__ __forceinline__ unsigned xb_add(unsigned* p, unsigned v) { return __hip_atomic_fetch_add(p, v, __ATOMIC_RELAXED, __HIP_MEMORY_SCOPE_AGENT); }
__device__ __forceinline__ unsigned xb_xcc_id() { return (unsigned)__builtin_amdgcn_s_getreg((3 << 11) | 20) & 0xFu; }
#define XB_SPIN(cond, bar) do { unsigned _sp = 0; while (cond) { __builtin_amdgcn_s_sleep(1); \
    if ((++_sp & 255u) == 0u) { if (xb_ld(&(bar)[XB_TMO])) break; if (_sp > XB_SPIN_CAP) { atomicAdd(&(bar)[XB_TMO], 1u); break; } } } } while (0)

struct XcdBarrier {
    unsigned* bar; unsigned x;
    volatile LAS unsigned* st;
};

__device__ __forceinline__ XcdBarrier xcd_barrier_post(unsigned* bar, volatile LAS unsigned* st) {
    XcdBarrier b; b.bar = bar; b.x = xb_xcc_id(); b.st = st;
    if (threadIdx.x == 0) (void)xb_add(&bar[XB_XCNT(b.x)], 1u);
    return b;
}
__device__ __forceinline__ void xcd_barrier_complete(unsigned* bar, unsigned x, unsigned& nloc, unsigned& nx) {
    const unsigned G = gridDim.x * gridDim.y * gridDim.z;
    unsigned sum, cnt, mine, sp = 0u;
    for (;;) {
        sum = 0u; cnt = 0u; mine = 0u;
#pragma unroll
        for (unsigned j = 0; j < 16; ++j) { const unsigned c = xb_ld(&bar[XB_XCNT(j)]); sum += c; cnt += (c > 0u) ? 1u : 0u; mine = (j == x) ? c : mine; }
        if (sum == G) break;
        __builtin_amdgcn_s_sleep(1);
        if ((++sp & 255u) == 0u) { if (xb_ld(&bar[XB_TMO])) break; if (sp > XB_SPIN_CAP) { atomicAdd(&bar[XB_TMO], 1u); break; } }
    }
    nloc = mine > 0u ? mine : 1u; nx = cnt > 0u ? cnt : 1u;
}

__device__ __forceinline__ void xcd_barrier(const XcdBarrier& b) {
    asm volatile("s_waitcnt vmcnt(0)" ::: "memory");
    __syncthreads();
    if (threadIdx.x == 0) {
        unsigned* bar = b.bar;
        __builtin_amdgcn_s_waitcnt(0);
        unsigned nloc = b.st[0], nx = b.st[1];
        if (nloc == 0u) { xcd_barrier_complete(bar, b.x, nloc, nx); b.st[0] = nloc; b.st[1] = nx; }
        const unsigned old = xb_add(&bar[XB_XSUB(b.x)], 1u);
        const unsigned gen = old / nloc;
        if (old + 1u == (gen + 1u) * nloc) {
            __builtin_amdgcn_fence(__ATOMIC_RELEASE, "agent");
            asm volatile("s_waitcnt vmcnt(0)" ::: "memory");
            const unsigned og = xb_add(&bar[XB_TOP], 1u);
            const unsigned tg = og / nx;
            if (og + 1u == (tg + 1u) * nx) xb_add(&bar[XB_TOPGEN], 1u);
            else XB_SPIN(xb_ld(&bar[XB_TOPGEN]) == tg, bar);
            __builtin_amdgcn_fence(__ATOMIC_ACQUIRE, "agent");
            xb_add(&bar[XB_XGEN(b.x)], 1u);
            asm volatile("s_waitcnt vmcnt(0)" ::: "memory");
        } else {
            XB_SPIN(xb_ld(&bar[XB_XGEN(b.x)]) == gen, bar);
            __builtin_amdgcn_fence(__ATOMIC_ACQUIRE, "agent");
            asm volatile("s_waitcnt vmcnt(0)" ::: "memory");
        }
    }
    __syncthreads();
}
typedef unsigned v2u __attribute__((ext_vector_type(2)));
typedef float f32x2 __attribute__((ext_vector_type(2)));
struct Args { const float* in[21]; float* out; unsigned char* ws; int ph_lo, ph_hi; };
struct Frame {
    const Args& A;
    LAS unsigned char* lds;
    volatile LAS unsigned* MISC;
    gu32* ctl;
    unsigned char* ws;
    int tid, lane, wave, vcu, G;
    __device__ __forceinline__ Frame(const Args& a) : A(a) {}
#define WSP(name, type, off) __device__ __forceinline__ type* name() const { return (type*)(ws + (off)); }
    WSP(WIN, bf16, WS_WIN) WSP(WOUT, bf16, WS_WOUT) WSP(WQ, bf16, WS_WQ) WSP(LRUW, bf16, WS_LRUW) WSP(WSB, bf16, WS_WSB)
    WSP(XN, bf16, WS_XN) WSP(MIX, bf16, WS_XN) WSP(Z, bf16, WS_Z) WSP(HB, bf16, WS_HB) WSP(HBT, bf16, WS_HBT)
    WSP(U8, unsigned char, WS_U) WSP(V8T, unsigned char, WS_V)
    WSP(ROWSS, float, WS_ROWSS) WSP(ROWSS2, float, WS_ROWSS2) WSP(QH, bf16, WS_Z) WSP(QL, bf16, WS_Z + 128 * MiB) WSP(KH, bf16, WS_KH) WSP(KL, bf16, WS_KH + 512 * 1024) WSP(AGG, float, WS_AGG) WSP(CARRY, float, WS_CARRY) WSP(AU, unsigned, WS_HB) WSP(GATES, float, WS_GATES)
    WSP(USCALE, float, WS_USCALE) WSP(VSCALE, float, WS_VSCALE) WSP(Y, bf16, WS_Y) WSP(IDS, int, WS_IDS) WSP(ASCALE, float, WS_ASCALE) WSP(IDW, v4u, WS_IDW) WSP(AW, unsigned, WS_AW) WSP(H8, unsigned char, WS_H8) WSP(HSCALE, float, WS_HSCALE) WSP(PART, int, WS_PART)
#undef WSP
};
__device__ __forceinline__ float wave_sum(float v) {
#pragma unroll
    for (int o = 1; o < 64; o <<= 1) v += __shfl_xor(v, o);
    return v;
}
__device__ __forceinline__ float bf_lo(unsigned w) { return __builtin_bit_cast(float, w << 16); }
__device__ __forceinline__ float bf_hi(unsigned w) { return __builtin_bit_cast(float, w & 0xffff0000u); }
__device__ __forceinline__ float bf1(unsigned short h) { return __builtin_bit_cast(float, (unsigned)h << 16); }
__device__ __forceinline__ float sigmoidf_(float x) { return __builtin_amdgcn_rcpf(1.0f + __builtin_amdgcn_exp2f(-1.4426950409f * x)); }
using pg8::gelu_tanh;
__device__ __forceinline__ unsigned pack_i8x4(float a, float b, float c, float d) {
    const int ia = (int)__builtin_rintf(a), ib = (int)__builtin_rintf(b), ic = (int)__builtin_rintf(c), id = (int)__builtin_rintf(d);
    return (unsigned)(ia & 0xff) | ((unsigned)(ib & 0xff) << 8) | ((unsigned)(ic & 0xff) << 16) | ((unsigned)id << 24);
}

__device__ __forceinline__ void p0_transpose_item(const float* W, int K, int N, bf16* WT, const float* kscale, LAS float* scr, int item, int lane) {
    const int nblk = N / 32, kb = item / nblk, nb = item % nblk, k0 = 64 * kb, n0 = 32 * nb;
#pragma unroll 8
    for (int i = 0; i < 32; ++i) { const int kk = 2 * i + (lane >> 5); const float sc = kscale ? kscale[k0 + kk] : 1.0f; scr[kk * 33 + (lane & 31)] = W[(size_t)(k0 + kk) * N + n0 + (lane & 31)] * sc; }
    LDS_WAIT(); asm volatile("" ::: "memory");
    const int c = lane & 7;
#pragma unroll
    for (int j = 0; j < 4; ++j) { const int n = (lane >> 3) + 8 * j; const LAS float* s = scr + (8 * c) * 33 + n;
        v4u o; o.x = pk2(s[0 * 33], s[1 * 33]); o.y = pk2(s[2 * 33], s[3 * 33]); o.z = pk2(s[4 * 33], s[5 * 33]); o.w = pk2(s[6 * 33], s[7 * 33]);
        *(GAS v4u*)(WT + (size_t)(n0 + n) * K + k0 + 8 * c) = o; }
    LDS_WAIT(); asm volatile("" ::: "memory");
}
__device__ __forceinline__ void p0_prologue(Frame& F) {
    LAS float* scr = (LAS float*)(F.lds + F.wave * 16384);
    const int gw = F.vcu * NWAVES + F.wave, NGW = F.G * NWAVES, lane = F.lane;
    constexpr int I_IN = (D / 64) * (NIN / 32), I_OUT = (D / 64) * (D / 32), I_Q = I_OUT, I_LRU = 32 * 8;
    constexpr int NITEMS = I_IN + I_OUT + I_Q + I_LRU;
    for (int it = gw; it < NITEMS; it += NGW) {
        int r = it;
        if (r < I_IN) { p0_transpose_item(F.A.in[2], D, NIN, F.WIN(), F.A.in[1], scr, r, lane); continue; } r -= I_IN;
        if (r < I_OUT) { p0_transpose_item(F.A.in[14], D, D, F.WOUT(), nullptr, scr, r, lane); continue; } r -= I_OUT;
        if (r < I_Q) { p0_transpose_item(F.A.in[16], D, D, F.WQ(), F.A.in[15], scr, r, lane); continue; } r -= I_Q;
        { const int mi = r >> 3, sub = r & 7, gate = mi >> 4, rest = mi & 15;
          const float* src = (gate ? F.A.in[7] : F.A.in[5]) + (size_t)rest * 16384;
          p0_transpose_item(src, 128, 128, F.LRUW() + (size_t)mi * 16384, nullptr, scr, sub, lane); }
    }
    const size_t gt = (size_t)gw * 64 + lane, NGT = (size_t)NGW * 64;
    {
        const float* g2 = F.A.in[15];
        f32x4 gg[8];
#pragma unroll
        for (int j = 0; j < 8; ++j) gg[j] = *(const GAS f32x4*)(g2 + j * 256 + lane * 4);
        for (int e = gw; e < NEXP; e += NGW) {
            const GAS f32x4* ur = (const GAS f32x4*)(F.A.in[18] + (size_t)e * D) + lane;
            f32x4 v[8]; float ss = 0.f;
#pragma unroll
            for (int j = 0; j < 8; ++j) { v[j] = ur[64 * j] * gg[j]; ss += (v[j].x * v[j].x + v[j].y * v[j].y) + (v[j].z * v[j].z + v[j].w * v[j].w); }
            const float rms = __builtin_amdgcn_sqrtf(wave_sum(ss) * (1.0f / D));
            const float sc = rms > 0.f ? 7.0f / (2.8f * rms) : 1.0f;
            GAS unsigned* o4 = (GAS unsigned*)(F.U8() + (size_t)e * 1024) + (lane >> 1);
#pragma unroll
            for (int j = 0; j < 8; ++j) {
                const int c0 = (int)fminf(fmaxf(__builtin_rintf(v[j].x * sc), -7.f), 7.f) & 15, c1 = (int)fminf(fmaxf(__builtin_rintf(v[j].y * sc), -7.f), 7.f) & 15;
                const int c2 = (int)fminf(fmaxf(__builtin_rintf(v[j].z * sc), -7.f), 7.f) & 15, c3 = (int)fminf(fmaxf(__builtin_rintf(v[j].w * sc), -7.f), 7.f) & 15;
                const unsigned cw = (unsigned)c0 | ((unsigned)c1 << 8) | ((unsigned)c2 << 16) | ((unsigned)c3 << 24);
                const unsigned pw = (unsigned)__shfl_xor((int)cw, 1);
                if ((lane & 1) == 0) o4[32 * j] = cw | (pw << 4);
            }
            if (lane == 0) F.USCALE()[e] = rms > 0.f ? 2.8f * rms * (1.0f / 7.0f) : 1.0f;
        }
    }
    __syncthreads();
    for (int un = blockIdx.x; un < NEXP / 64; un += F.G) {
        const int e0 = un * 64;
        for (int rr = 0; rr < 8; ++rr) {
            const int el = F.wave * 8 + rr, e = e0 + el;
            const GAS f32x4* vr = (const GAS f32x4*)(F.A.in[19] + (size_t)e * D) + lane;
            f32x4 v[8]; float mx = 0.f;
#pragma unroll
            for (int j = 0; j < 8; ++j) { v[j] = vr[64 * j]; mx = fmaxf(mx, fmaxf(fmaxf(fabsf(v[j].x), fabsf(v[j].y)), fmaxf(fabsf(v[j].z), fabsf(v[j].w)))); }
#pragma unroll
            for (int o = 1; o < 64; o <<= 1) mx = fmaxf(mx, __shfl_xor(mx, o));
            const float sc = mx > 0.f ? 127.0f / mx : 1.0f;
#pragma unroll
            for (int j = 0; j < 8; ++j) *(LAS unsigned*)(F.lds + el * 2056 + j * 256 + lane * 4) = pack_i8x4(v[j].x * sc, v[j].y * sc, v[j].z * sc, v[j].w * sc);
            if (lane == 0) F.VSCALE()[e] = mx > 0.f ? mx * (1.0f / 127.0f) : 1.0f;
        }
        __syncthreads();
        for (int cc = 0; cc < 32; ++cc) { const int c = F.wave * 32 + cc;
            const v2u w = *(const LAS v2u*)(F.lds + lane * 2056 + c * 8);
            *(GAS v2u*)(F.V8T() + ((size_t)c * NEXP + e0 + lane) * 8) = w; }
        __syncthreads();
    }
    for (size_t ch = gt; ch < (size_t)8 * 128 * 128 / 8; ch += NGT) {
        const size_t e0 = ch * 8;
        const f32x4 a = *(const GAS f32x4*)(F.A.in[12] + e0), b = *(const GAS f32x4*)(F.A.in[12] + e0 + 4);
        v4u o; o.x = pk2(a.x, a.y); o.y = pk2(a.z, a.w); o.z = pk2(b.x, b.y); o.w = pk2(b.z, b.w);
        *(GAS v4u*)(F.WSB() + e0) = o;
    }
    for (size_t ch = gt; ch < (size_t)16 * 128 * 128 / 8; ch += NGT) {
        const size_t e0 = ch * 8;
        const f32x4 a = *(const GAS f32x4*)(F.A.in[17] + e0), b = *(const GAS f32x4*)(F.A.in[17] + e0 + 4);
        v4u hi; hi.x = pk2(a.x, a.y); hi.y = pk2(a.z, a.w); hi.z = pk2(b.x, b.y); hi.w = pk2(b.z, b.w);
        *(GAS v4u*)(F.KH() + e0) = hi;
    }
    for (int m = gw; m < M; m += NGW) {
        const GAS f32x4* xr = (const GAS f32x4*)(F.A.in[0] + (size_t)m * D) + lane;
        f32x4 v[8]; float s = 0.f;
#pragma unroll
        for (int j = 0; j < 8; ++j) { v[j] = xr[64 * j]; s += (v[j].x * v[j].x + v[j].y * v[j].y) + (v[j].z * v[j].z + v[j].w * v[j].w); }
        const float rstd = __builtin_amdgcn_rsqf(wave_sum(s) * (1.f / D) + 1e-6f);
        GAS unsigned long long* o8 = (GAS unsigned long long*)(F.XN() + (size_t)m * D) + lane;
#pragma unroll
        for (int j = 0; j < 8; ++j) o8[64 * j] = (unsigned long long)pk2(v[j].x * rstd, v[j].y * rstd) | ((unsigned long long)pk2(v[j].z * rstd, v[j].w * rstd) << 32);
    }
}
constexpr int LRU_XR = 0, LRU_XC = 33792, LRU_GR = 33792 + 40960;
constexpr float LOG2E = 1.4426950408889634f;
__device__ __forceinline__ int xc_off(int tok, int ch) { return tok * 320 + (tok >> 5) * 16 + ch * 2; }
template <bool APPLY, int DIR>
__device__ __forceinline__ void lru_dir(Frame& F, int unit, int b, int c, int h, const bf16x8 (&Ba)[4], const bf16x8 (&Bx)[4], float (&hsum)[8][4]) {
    const int lane = F.lane, w = F.wave, fr = lane & 15, fq = lane >> 4;
    LAS unsigned char* XC = F.lds + LRU_XC;
    const int chl = 16 * w + fr, chg = h * 128 + chl;
    v4u* au = (v4u*)F.AU() + ((size_t)((unit * 2 + DIR) * NWAVES + w) * 8) * 64 + lane;
    f32x4 R[8], I[8];
    float carry = 0.f;
    if (APPLY) {
        carry = F.CARRY()[(size_t)((b * 2 + DIR) * NCHUNK + c) * LW + chg];
        v4u q[8];
#pragma unroll
        for (int m = 0; m < 8; ++m) q[m] = __builtin_nontemporal_load(au + m * 64);
#pragma unroll
        for (int m = 0; m < 8; ++m) {
            R[m] = (f32x4){__builtin_amdgcn_exp2f(bf_lo(q[m].x)), __builtin_amdgcn_exp2f(bf_lo(q[m].y)), __builtin_amdgcn_exp2f(bf_lo(q[m].z)), __builtin_amdgcn_exp2f(bf_lo(q[m].w))};
            I[m] = (f32x4){bf_hi(q[m].x), bf_hi(q[m].y), bf_hi(q[m].z), bf_hi(q[m].w)}; }
    } else {
        const float ba = F.A.in[6][DIR * LW + chg], bx = F.A.in[8][DIR * LW + chg], lam = F.A.in[9][DIR * LW + chg];
        const float cl = -8.0f * log1pf(__expf(-lam)) * LOG2E;
        const int arow = (fr >> 2) * 32 + (fr & 3);
#pragma unroll
        for (int m = 0; m < 8; ++m) {
            R[m] = (f32x4){0.f, 0.f, 0.f, 0.f}; I[m] = (f32x4){0.f, 0.f, 0.f, 0.f};
#pragma unroll
            for (int ks = 0; ks < 4; ++ks) {
                const bf16x8 a = *(const LAS bf16x8*)(XC + xc_off(arow + 4 * m, 32 * ks + 8 * fq));
                R[m] = __builtin_amdgcn_mfma_f32_16x16x32_bf16(a, Ba[ks], R[m], 0, 0, 0);
                I[m] = __builtin_amdgcn_mfma_f32_16x16x32_bf16(a, Bx[ks], I[m], 0, 0, 0);
            }
        }
#pragma unroll
        for (int m = 0; m < 8; ++m) {
            float la[4];
#pragma unroll
            for (int j = 0; j < 4; ++j) {
                const float r = sigmoidf_(R[m][j] + ba), ig = sigmoidf_(I[m][j] + bx);
                la[j] = cl * r;
                const float a = __builtin_amdgcn_exp2f(la[j]);
                const float xc = bf1(*(const LAS unsigned short*)(XC + xc_off(32 * fq + 4 * m + j, chl)));
                R[m][j] = a; I[m][j] = __builtin_amdgcn_sqrtf(fmaxf(1.0f - a * a, 0.0f)) * (ig * xc);
            }
            __builtin_nontemporal_store((v4u){pk2(la[0], I[m][0]), pk2(la[1], I[m][1]), pk2(la[2], I[m][2]), pk2(la[3], I[m][3])}, au + m * 64);
        }
    }
    float P = 1.f, L = 0.f;
#pragma unroll
    for (int mm = 0; mm < 8; ++mm) {
        const int m = DIR == 0 ? mm : 7 - mm;
#pragma unroll
        for (int jj = 0; jj < 4; ++jj) {
            const int j = DIR == 0 ? jj : 3 - jj;
            const float a = R[m][j], u = I[m][j];
            L = a * L + u; P = a * P;
            R[m][j] = P; I[m][j] = L;
        }
    }
    const int src1 = DIR == 0 ? lane - 16 : lane + 16, src2 = DIR == 0 ? lane - 32 : lane + 32;
    const bool v1 = DIR == 0 ? (fq >= 1) : (fq <= 2), v2 = DIR == 0 ? (fq >= 2) : (fq <= 1);
    float A = P, B = L;
    { const float pa = __shfl(A, src1), pb = __shfl(B, src1); if (v1) { B = A * pb + B; A = A * pa; } }
    { const float pa = __shfl(A, src2), pb = __shfl(B, src2); if (v2) { B = A * pb + B; A = A * pa; } }
    if (APPLY) {
        float EA = __shfl(A, src1), EB = __shfl(B, src1); if (!v1) { EA = 1.f; EB = 0.f; }
        const float hin = EA * carry + EB;
#pragma unroll
        for (int m = 0; m < 8; ++m)
#pragma unroll
            for (int j = 0; j < 4; ++j) { const float hh = R[m][j] * hin + I[m][j]; if (DIR == 0) hsum[m][j] = hh; else hsum[m][j] += hh; }
    } else {
        const bool lastlane = DIR == 0 ? (fq == 3) : (fq == 0);
        if (lastlane) { f32x2* agg = (f32x2*)F.AGG() + (size_t)((b * 2 + DIR) * NCHUNK + c) * LW + chg; *agg = (f32x2){A, B}; }
    }
}

template <bool APPLY>
__device__ __forceinline__ void lru_unit(Frame& F, int unit) {
    const int h = unit & 7, c = (unit >> 3) & 63, b = unit >> 9;
    const int tid = F.tid, lane = F.lane, w = F.wave, fr = lane & 15, fq = lane >> 4;
    const size_t t0 = (size_t)b * SEQ + (size_t)c * CHUNK;
    LAS unsigned char* XR = F.lds + LRU_XR; LAS unsigned char* XC = F.lds + LRU_XC; LAS unsigned char* GR = F.lds + LRU_GR;
    bf16x8 Ba0[4], Bx0[4], Ba1[4], Bx1[4];
    if (!APPLY) {
        const bf16* wb = F.LRUW() + (size_t)h * 16384 + (size_t)(16 * w + fr) * 128 + 8 * fq;
#pragma unroll
        for (int ks = 0; ks < 4; ++ks) { Ba0[ks] = *(const GAS bf16x8*)(wb + 32 * ks); Ba1[ks] = *(const GAS bf16x8*)(wb + (size_t)8 * 16384 + 32 * ks);
            Bx0[ks] = *(const GAS bf16x8*)(wb + (size_t)16 * 16384 + 32 * ks); Bx1[ks] = *(const GAS bf16x8*)(wb + (size_t)24 * 16384 + 32 * ks); }
        for (int p = tid; p < 131 * 16; p += 512) { const int r = p >> 4, cg = p & 15; const int s = c * CHUNK - 2 + r; v4u v = (v4u){0u, 0u, 0u, 0u};
            if (s >= 0 && s < SEQ) v = *(const GAS v4u*)(F.Z() + ((size_t)b * SEQ + s) * NIN + h * 128 + cg * 8);
            *(LAS v4u*)(XR + r * 256 + cg * 16) = v; }
        __syncthreads();
        {
            const int ch2 = tid & 63, tg = tid >> 6, chg = h * 128 + 2 * ch2;
            float w0[4], w1[4];
#pragma unroll
            for (int k = 0; k < 4; ++k) { w0[k] = F.A.in[3][k * LW + chg]; w1[k] = F.A.in[3][k * LW + chg + 1]; }
            const float b0 = F.A.in[4][chg], b1 = F.A.in[4][chg + 1];
            float x0[4], x1[4];
#pragma unroll
            for (int k = 0; k < 3; ++k) { const unsigned u = *(const LAS unsigned*)(XR + (16 * tg + k) * 256 + ch2 * 4); x0[k] = bf_lo(u); x1[k] = bf_hi(u); }
#pragma unroll
            for (int j = 0; j < 16; ++j) {
                const unsigned u = *(const LAS unsigned*)(XR + (16 * tg + j + 3) * 256 + ch2 * 4); x0[3] = bf_lo(u); x1[3] = bf_hi(u);
                const float y0 = b0 + ((w0[0] * x0[0] + w0[1] * x0[1]) + (w0[2] * x0[2] + w0[3] * x0[3]));
                const float y1 = b1 + ((w1[0] * x1[0] + w1[1] * x1[1]) + (w1[2] * x1[2] + w1[3] * x1[3]));
                *(LAS unsigned*)(XC + xc_off(16 * tg + j, 2 * ch2)) = pk2(y0, y1);
                x0[0] = x0[1]; x0[1] = x0[2]; x0[2] = x0[3]; x1[0] = x1[1]; x1[1] = x1[2]; x1[2] = x1[3];
            }
        }
        __syncthreads();
    } else {
#pragma unroll
        for (int ks = 0; ks < 4; ++ks) { Ba0[ks] = Ba1[ks] = Bx0[ks] = Bx1[ks] = (bf16x8){0, 0, 0, 0, 0, 0, 0, 0}; }
        for (int p = tid; p < 128 * 32; p += 512) { const int r = p >> 5, cg = p & 31;
            *(LAS v2u*)(GR + r * 264 + cg * 8) = *(const GAS v2u*)(F.Z() + (t0 + r) * NIN + LW + h * 128 + cg * 4); }
    }
    float hsum[8][4];
    lru_dir<APPLY, 0>(F, unit, b, c, h, Ba0, Bx0, hsum);
    asm volatile("" ::: "memory"); __builtin_amdgcn_sched_barrier(0);
    lru_dir<APPLY, 1>(F, unit, b, c, h, Ba1, Bx1, hsum);
    if (APPLY) {
        const int chl = 16 * w + fr;
        __syncthreads();
#pragma unroll
        for (int m = 0; m < 8; ++m)
#pragma unroll
            for (int j = 0; j < 4; ++j) { LAS unsigned short* p = (LAS unsigned short*)(GR + (32 * fq + 4 * m + j) * 264 + chl * 2); *p = (unsigned short)f2bf(bf1(*p) * hsum[m][j]); }
        __syncthreads();
        for (int p = tid; p < 128 * 32; p += 512) { const int r = p >> 5, cg = p & 31;
            *(GAS v2u*)(F.MIX() + (t0 + r) * D + h * 128 + cg * 4) = *(const LAS v2u*)(GR + r * 264 + cg * 8); }
    }
    __syncthreads();
}
__device__ __forceinline__ void lru_carry(Frame& F) {
    const int idx = (F.vcu * NWAVES + F.wave) * 64 + F.lane;
    if (idx >= BATCH * 2 * LW) return;
    const int ch = idx & (LW - 1), bd = idx >> 10, dir = bd & 1;
    const f32x2* agg = (const f32x2*)F.AGG() + (size_t)bd * NCHUNK * LW + ch; float* cr = F.CARRY() + (size_t)bd * NCHUNK * LW + ch;
    float st = 0.f;
#pragma unroll 8
    for (int i = 0; i < NCHUNK; ++i) { const int cc = dir == 0 ? i : NCHUNK - 1 - i; const f32x2 pe = agg[(size_t)cc * LW]; cr[(size_t)cc * LW] = st; st = pe.x * st + pe.y; }
}
constexpr int GM_ST = 0, GM_BS = 1024, GM_VN = 2048, GM_GU = 2048 + 32768;
typedef short s16x4 __attribute__((ext_vector_type(4)));
__device__ __forceinline__ unsigned vn_off(unsigned row, unsigned ch) { return 256u * row + 16u * (ch ^ (((row & 3u) << 2) | ((row >> 2) & 3u))); }
__device__ __forceinline__ void gmlp_unit(Frame& F, int unit) {
    const int tid = F.tid, lane = F.lane, w = F.wave, fr = lane & 15, fq = lane >> 4;
    const size_t t0 = (size_t)unit * CHUNK;
    LAS float* ST = (LAS float*)(F.lds + GM_ST); LAS float* BS = (LAS float*)(F.lds + GM_BS);
    LAS unsigned char* VN = F.lds + GM_VN; LAS unsigned char* GU = F.lds + GM_GU;
    for (int rr = 0; rr < 16; ++rr) {
        const int row = 16 * w + rr;
        const bf16* p = F.Z() + (t0 + row) * NIN + 3 * LW + lane * 8;
        const v4u a = *(const GAS v4u*)p, b = *(const GAS v4u*)(p + 512);
        float x[16] = {bf_lo(a.x), bf_hi(a.x), bf_lo(a.y), bf_hi(a.y), bf_lo(a.z), bf_hi(a.z), bf_lo(a.w), bf_hi(a.w),
                       bf_lo(b.x), bf_hi(b.x), bf_lo(b.y), bf_hi(b.y), bf_lo(b.z), bf_hi(b.z), bf_lo(b.w), bf_hi(b.w)};
        float s = 0.f;
#pragma unroll
        for (int i = 0; i < 16; ++i) s += x[i];
        const float mean = wave_sum(s) * (1.0f / LW);
        float q = 0.f;
#pragma unroll
        for (int i = 0; i < 16; ++i) { const float d = x[i] - mean; q += d * d; }
        const float rstd = __builtin_amdgcn_rsqf(wave_sum(q) * (1.0f / LW) + 1e-6f);
        if (lane == 0) { ST[2 * row] = mean; ST[2 * row + 1] = rstd; }
    }
    __syncthreads();
    const unsigned trq = (unsigned)(lane & 15) >> 2, trp = (unsigned)lane & 3u;
    for (int h = 0; h < 8; ++h) {
#pragma unroll
        for (int i = 0; i < 4; ++i) { const int pid = tid + 512 * i, q = pid >> 4, cg = pid & 15;
            const v4u a = *(const GAS v4u*)(F.Z() + (t0 + q) * NIN + 3 * LW + h * 128 + cg * 8);
            const float mean = ST[2 * q], rstd = ST[2 * q + 1];
            const f32x4 g0 = *(const GAS f32x4*)(F.A.in[10] + h * 128 + cg * 8), g1 = *(const GAS f32x4*)(F.A.in[10] + h * 128 + cg * 8 + 4);
            const f32x4 b0 = *(const GAS f32x4*)(F.A.in[11] + h * 128 + cg * 8), b1 = *(const GAS f32x4*)(F.A.in[11] + h * 128 + cg * 8 + 4);
            v4u o;
            o.x = pk2((bf_lo(a.x) - mean) * rstd * g0.x + b0.x, (bf_hi(a.x) - mean) * rstd * g0.y + b0.y);
            o.y = pk2((bf_lo(a.y) - mean) * rstd * g0.z + b0.z, (bf_hi(a.y) - mean) * rstd * g0.w + b0.w);
            o.z = pk2((bf_lo(a.z) - mean) * rstd * g1.x + b1.x, (bf_hi(a.z) - mean) * rstd * g1.y + b1.y);
            o.w = pk2((bf_lo(a.w) - mean) * rstd * g1.z + b1.z, (bf_hi(a.w) - mean) * rstd * g1.w + b1.w);
            *(LAS v4u*)(VN + vn_off((unsigned)q, (unsigned)cg)) = o;
        }
#pragma unroll
        for (int i = 0; i < 8; ++i) { const int pid = tid + 512 * i, r = pid >> 5, cg = pid & 31;
            *(LAS v2u*)(GU + r * 264 + cg * 8) = *(const GAS v2u*)(F.Z() + (t0 + r) * NIN + 2 * LW + h * 128 + cg * 4); }
        if (tid < 128) BS[tid] = F.A.in[13][h * 128 + tid];
        bf16x8 Af[4];
        { const bf16* wsb = F.WSB() + (size_t)h * 16384 + (size_t)(16 * w + fr) * 128 + 8 * fq;
#pragma unroll
          for (int ks = 0; ks < 4; ++ks) Af[ks] = *(const GAS bf16x8*)(wsb + 32 * ks); }
        __syncthreads();
        f32x4 acc[8];
#pragma unroll
        for (int n = 0; n < 8; ++n) {
            acc[n] = (f32x4){0.f, 0.f, 0.f, 0.f};
#pragma unroll
            for (int ks = 0; ks < 4; ++ks) {
                const s16x4 b0 = __builtin_amdgcn_ds_read_tr16_b64_v4i16((LAS s16x4*)(VN + vn_off(32u * ks + 8u * fq + trq, 2u * n + (trp >> 1)) + 8u * (trp & 1u)));
                const s16x4 b1 = __builtin_amdgcn_ds_read_tr16_b64_v4i16((LAS s16x4*)(VN + vn_off(32u * ks + 8u * fq + 4u + trq, 2u * n + (trp >> 1)) + 8u * (trp & 1u)));
                const bf16x8 bb = (bf16x8){b0[0], b0[1], b0[2], b0[3], b1[0], b1[1], b1[2], b1[3]};
                acc[n] = __builtin_amdgcn_mfma_f32_16x16x32_bf16(Af[ks], bb, acc[n], 0, 0, 0);
            }
        }
#pragma unroll
        for (int n = 0; n < 8; ++n)
#pragma unroll
            for (int j = 0; j < 4; ++j) { const int p = 16 * w + 4 * fq + j; LAS unsigned short* ad = (LAS unsigned short*)(GU + p * 264 + (16 * n + fr) * 2);
                *ad = (unsigned short)f2bf(bf1(*ad) * (acc[n][j] + BS[p])); }
        __syncthreads();
#pragma unroll
        for (int i = 0; i < 8; ++i) { const int pid = tid + 512 * i, r = pid >> 5, cg = pid & 31;
            *(GAS v2u*)(F.MIX() + (t0 + r) * D + LW + h * 128 + cg * 4) = *(const LAS v2u*)(GU + r * 264 + cg * 8); }
        __syncthreads();
    }
}
typedef float f32x16 __attribute__((ext_vector_type(16)));
__device__ __forceinline__ unsigned fkey(float f) { const int u = __builtin_bit_cast(int, f); return (unsigned)(u ^ ((u >> 31) & 0x7fffffff)); }
__device__ __forceinline__ float fkey_inv(unsigned k) { const int u = (int)k; return __builtin_bit_cast(float, u ^ ((u >> 31) & 0x7fffffff)); }
__device__ __forceinline__ unsigned umax_(unsigned a, unsigned b) { return (int)a > (int)b ? a : b; }
__device__ __forceinline__ unsigned umin_(unsigned a, unsigned b) { return (int)a < (int)b ? a : b; }
#define CE_DESC(x, y) do { const unsigned a_ = (x), b_ = (y); (x) = umax_(a_, b_); (y) = umin_(a_, b_); } while (0)
__device__ __forceinline__ void sort16_desc(unsigned (&a)[16]) {
#pragma unroll
    for (int k = 2; k <= 16; k <<= 1)
#pragma unroll
        for (int j = k >> 1; j >= 1; j >>= 1)
#pragma unroll
            for (int i = 0; i < 16; ++i) { const int l = i ^ j; if (l > i) { if ((i & k) == 0) CE_DESC(a[i], a[l]); else CE_DESC(a[l], a[i]); } }
}
__device__ __forceinline__ void merge16_desc(unsigned (&a)[16], const unsigned (&b)[16]) {
#pragma unroll
    for (int i = 0; i < 16; ++i) a[i] = umax_(a[i], b[15 - i]);
#pragma unroll
    for (int j = 8; j >= 1; j >>= 1)
#pragma unroll
        for (int i = 0; i < 16; ++i) if ((i & j) == 0) CE_DESC(a[i], a[i + j]);
}
typedef short bf16x8s __attribute__((ext_vector_type(8)));
__device__ __forceinline__ void topk_unit(Frame& F, int wu) {
    const int tg = wu >> 3, hd = wu & 7, lane = F.lane, r = lane & 31, hh = lane >> 5;
    const int t = tg * 32 + r;
    const size_t qoff = (size_t)t * D + hd * 256 + 8 * hh;
    unsigned L[2][16];
    unsigned hh4 = (unsigned)hh << 2; asm volatile("" : "+v"(hh4));
#pragma unroll
    for (int p = 0; p < 2; ++p) {
        f32x16 acc[4];
#pragma unroll
        for (int nt = 0; nt < 4; ++nt)
#pragma unroll
            for (int i = 0; i < 16; ++i) acc[nt][i] = 0.f;
        const size_t koff = ((size_t)(hd * 2 + p) * 128 + r) * 128 + 8 * hh;
        const bf16* qp = F.QH() + qoff + p * 128; const bf16* kp0 = F.KH() + koff; const bf16* kp1 = kp0 + 32 * 128; const bf16* kp2 = kp0 + 64 * 128; const bf16* kp3 = kp0 + 96 * 128;
        asm volatile("" : "+v"(qp), "+v"(kp0), "+v"(kp1), "+v"(kp2), "+v"(kp3));
#define P6_LOAD(Q, K, ks0, n) _Pragma("unroll") for (int i_ = 0; i_ < (n); ++i_) { Q[i_] = *(const GAS bf16x8s*)(qp + 16 * ((ks0) + i_)); \
            K[i_][0] = *(const GAS bf16x8s*)(kp0 + 16 * ((ks0) + i_)); K[i_][1] = *(const GAS bf16x8s*)(kp1 + 16 * ((ks0) + i_)); \
            K[i_][2] = *(const GAS bf16x8s*)(kp2 + 16 * ((ks0) + i_)); K[i_][3] = *(const GAS bf16x8s*)(kp3 + 16 * ((ks0) + i_)); }
#define P6_MMA(Q, K, n) _Pragma("unroll") for (int i_ = 0; i_ < (n); ++i_) _Pragma("unroll") for (int nt = 0; nt < 4; ++nt) acc[nt] = __builtin_amdgcn_mfma_f32_32x32x16_bf16(K[i_][nt], Q[i_], acc[nt], 0, 0, 0);
        bf16x8s qa[3], ka[3][4], qb[3], kb[3][4];
        P6_LOAD(qa, ka, 0, 3); P6_LOAD(qb, kb, 3, 3);
        __builtin_amdgcn_sched_barrier(0);
        P6_MMA(qa, ka, 3);
        __builtin_amdgcn_sched_barrier(0);
        P6_LOAD(qa, ka, 6, 2);
        __builtin_amdgcn_sched_barrier(0);
        P6_MMA(qb, kb, 3);
        __builtin_amdgcn_sched_barrier(0);
        P6_MMA(qa, ka, 2);
        __builtin_amdgcn_sched_barrier(0);
#undef P6_LOAD
#undef P6_MMA
        unsigned S[4][16];
#pragma unroll
        for (int nt = 0; nt < 4; ++nt) {
#pragma unroll
            for (int rg = 0; rg < 16; ++rg) { const int nc = 32 * nt + (rg & 3) + 8 * (rg >> 2); S[nt][rg] = ((fkey(acc[nt][rg]) & ~0x7Fu) | (unsigned)(127 - nc)) ^ hh4; }
            sort16_desc(S[nt]);
        }
        merge16_desc(S[0], S[1]); merge16_desc(S[2], S[3]); merge16_desc(S[0], S[2]);
        unsigned T[16];
#pragma unroll
        for (int i = 0; i < 16; ++i) T[i] = (unsigned)__shfl_xor((int)S[0][i], 32);
        merge16_desc(S[0], T);
#pragma unroll
        for (int i = 0; i < 16; ++i) L[p][i] = S[0][i];
        __builtin_amdgcn_sched_barrier(0);
    }
    float v0[16], v1[16];
#pragma unroll
    for (int i = 0; i < 16; ++i) { v0[i] = fkey_inv(L[0][i] & ~0x7Fu); v1[i] = fkey_inv(L[1][i] & ~0x7Fu); }
    unsigned C[4][16];
    {
        int cnt = 0;
#pragma unroll
        for (int i = 0; i < 16; ++i)
#pragma unroll
            for (int j = 0; j < 16; ++j) if ((i + 1) * (j + 1) <= 16) { C[cnt >> 4][cnt & 15] = (fkey(v0[i] + v1[j]) & ~0xFFu) | (unsigned)(255 - (i * 16 + j)); ++cnt; }
#pragma unroll
        for (int q = 50; q < 64; ++q) C[q >> 4][q & 15] = 0x80000000u;
    }
    sort16_desc(C[0]); sort16_desc(C[1]); sort16_desc(C[2]); sort16_desc(C[3]);
    merge16_desc(C[0], C[1]); merge16_desc(C[2], C[3]); merge16_desc(C[0], C[2]);
    unsigned best[16];
#pragma unroll
    for (int i = 0; i < 16; ++i) best[i] = C[0][i];
    LAS unsigned* tab = (LAS unsigned*)(F.lds + F.wave * 8192) + lane;
#pragma unroll
    for (int i = 0; i < 16; ++i) { tab[i * 64] = 127u - (L[0][i] & 0x7Fu); tab[(16 + i) * 64] = 127u - (L[1][i] & 0x7Fu); }
    const float smax = fkey_inv(best[0] & ~0xFFu);
    float sv[8]; unsigned idv[8]; float ssum = 0.f;
#pragma unroll
    for (int k = 0; k < 8; ++k) {
        const unsigned bk = hh ? best[8 + k] : best[k];
        const unsigned pos = 255u - (bk & 0xFFu);
        idv[k] = tab[(pos >> 4) * 64] * 128u + tab[(16 + (pos & 15u)) * 64];
        sv[k] = __builtin_amdgcn_exp2f((fkey_inv(bk & ~0xFFu) - smax) * 1.4426950409f); ssum += sv[k];
    }
    ssum += __shfl_xor(ssum, 32);
    const float inv = 1.0f / ssum;
    {
        int* o = F.IDS() + (size_t)t * 128 + hd * 16 + 8 * hh; float* og = F.GATES() + (size_t)t * 128 + hd * 16 + 8 * hh;
        *(GAS v4u*)o = (v4u){idv[0], idv[1], idv[2], idv[3]}; *(GAS v4u*)(o + 4) = (v4u){idv[4], idv[5], idv[6], idv[7]};
        *(GAS f32x4*)og = (f32x4){sv[0] * inv, sv[1] * inv, sv[2] * inv, sv[3] * inv}; *(GAS f32x4*)(og + 4) = (f32x4){sv[4] * inv, sv[5] * inv, sv[6] * inv, sv[7] * inv};
    }
}
__device__ __forceinline__ void h8_row(Frame& F, int t) {
    const int lane = F.lane;
    float hx[32]; float mx = 0.f;
    const bf16* hp = F.HB() + (size_t)t * D + lane * 16;
#pragma unroll
    for (int c = 0; c < 2; ++c)
#pragma unroll
        for (int q = 0; q < 2; ++q) { const v4u a = *(const GAS v4u*)(hp + c * 1024 + q * 8); float* x = hx + c * 16 + q * 8;
            x[0] = bf_lo(a.x); x[1] = bf_hi(a.x); x[2] = bf_lo(a.y); x[3] = bf_hi(a.y); x[4] = bf_lo(a.z); x[5] = bf_hi(a.z); x[6] = bf_lo(a.w); x[7] = bf_hi(a.w); }
#pragma unroll
    for (int i = 0; i < 32; ++i) mx = fmaxf(mx, fabsf(hx[i]));
#pragma unroll
    for (int o = 1; o < 64; o <<= 1) mx = fmaxf(mx, __shfl_xor(mx, o));
    const float sc = mx > 0.f ? 119.0f / mx : 1.0f;
#pragma unroll
    for (int c = 0; c < 2; ++c) {
        unsigned hw[2], lw[2];
#pragma unroll
        for (int g8 = 0; g8 < 2; ++g8) { unsigned hacc = 0u, lacc = 0u;
#pragma unroll
            for (int i = 0; i < 8; ++i) { const int q = (int)__builtin_rintf(hx[c * 16 + g8 * 8 + i] * sc); const int lo = ((q + 8) & 15) - 8, hi = (q - lo) >> 4;
                const int sh = (i & 3) * 8 + (i >> 2) * 4; hacc |= (unsigned)(hi & 15) << sh; lacc |= (unsigned)(lo & 15) << sh; }
            hw[g8] = hacc; lw[g8] = lacc; }
        unsigned char* hb_ = F.H8() + (size_t)t * D + c * 512 + lane * 8;
        *(GAS v2u*)hb_ = (v2u){hw[0], hw[1]}; *(GAS v2u*)(hb_ + 1024) = (v2u){lw[0], lw[1]};
    }
    if (lane == 0) F.HSCALE()[t] = mx > 0.f ? mx * (1.0f / 119.0f) : 1.0f;
}
__device__ __forceinline__ int row_sum16(int v) {
    v += __builtin_amdgcn_update_dpp(0, v, 0x128, 0xf, 0xf, false);
    v += __builtin_amdgcn_update_dpp(0, v, 0x124, 0xf, 0xf, false);
    v += __builtin_amdgcn_update_dpp(0, v, 0x122, 0xf, 0xf, false);
    v += __builtin_amdgcn_update_dpp(0, v, 0x121, 0xf, 0xf, false);
    return v;
}
__device__ __forceinline__ void peer_u_xcd(Frame& F) {
    const int lane = F.lane, x = blockIdx.x & 7, jcu = blockIdx.x >> 3, ncu = ((int)F.G - x + 7) >> 3;
    const int tpc = (M + ncu - 1) / ncu, tpw = (tpc + NWAVES - 1) / NWAVES;
    const int tbase = jcu * tpc + F.wave * tpw;
    int nw = M - tbase; { const int lim = (jcu + 1) * tpc - tbase; nw = nw < lim ? nw : lim; nw = nw < tpw ? nw : tpw; nw = nw < 0 ? 0 : nw; }
    const int NV = nw;
    LAS unsigned char* wl = F.lds + F.wave * 13312;
    LAS int* lst = (LAS int*)wl; LAS int* res = (LAS int*)(wl + 512); LAS unsigned char* hsl = wl + 1024;
    const int q4 = lane >> 4, i16 = lane & 15;
    const unsigned char* ubase = F.U8() + (size_t)x * 2048 * 1024;
    const unsigned lanepart = (unsigned)i16 * 16u;
    int r_idlo = 0, r_idhi = 0, r_t = 0; v4u r_h0 = (v4u){0u, 0u, 0u, 0u}, r_h1 = (v4u){0u, 0u, 0u, 0u};
    int v_cl0 = 0, v_cl1 = 0, v_n = 0, v_r0 = 0, v_t = 0, v_slot = 0; unsigned long long v_mlo = 0, v_mhi = 0; bool v_live = false;
    int vset = 0, nvalid = 0, idle = 0;
    if (NV == 0) return;
#define U_RAW() do { const int vi_ = vset < NV ? vset : NV - 1; r_t = tbase + vi_; \
        r_idlo = F.IDS()[(size_t)r_t * 128 + lane]; r_idhi = F.IDS()[(size_t)r_t * 128 + 64 + lane]; \
        r_h0 = *(const GAS v4u*)(F.H8() + (size_t)r_t * D + lane * 16); r_h1 = *(const GAS v4u*)(F.H8() + (size_t)r_t * D + 1024 + lane * 16); } while (0)
#define U_NEXT() do { if (v_live && v_r0 + 16 < v_n) { v_r0 += 16; } else if (vset < NV) { const bool slo = (r_idlo >> 11) == x, shi = (r_idhi >> 11) == x; \
            v_mlo = __ballot(slo); v_mhi = __ballot(shi); const int nlo = __popcll(v_mlo); v_n = nlo + __popcll(v_mhi); \
            const int plo = __builtin_amdgcn_mbcnt_hi((unsigned)(v_mlo >> 32), __builtin_amdgcn_mbcnt_lo((unsigned)v_mlo, 0)); \
            const int phi = nlo + __builtin_amdgcn_mbcnt_hi((unsigned)(v_mhi >> 32), __builtin_amdgcn_mbcnt_lo((unsigned)v_mhi, 0)); \
            if (slo) lst[plo] = (r_idlo & 2047) | (lane << 16); if (shi) lst[phi] = (r_idhi & 2047) | ((64 + lane) << 16); \
            v_slot = nvalid % 6; ++nvalid; { LAS unsigned char* sp_ = hsl + v_slot * 2048; *(LAS v4u*)(sp_ + lane * 16) = r_h0; *(LAS v4u*)(sp_ + 1024 + lane * 16) = r_h1; } \
            v_cl0 = lst[lane]; v_cl1 = lst[64 + lane]; v_t = r_t; v_r0 = 0; ++vset; v_live = true; } \
        else { v_live = false; v_n = 0; v_r0 = 0; v_mlo = 0; v_mhi = 0; ++idle; } } while (0)
#define U_ISSUE(BUF, DS) do { { const int rem_ = v_n - v_r0; DS##_cnt = rem_ < 0 ? 0 : (rem_ < 16 ? rem_ : 16); } \
        DS##_slot = v_slot; DS##_t = v_t; DS##_mlo = v_mlo; DS##_mhi = v_mhi; DS##_last = v_live && (v_r0 + 16 >= v_n); \
        _Pragma("unroll") for (int gp = 0; gp < 4; ++gp) { const int ix_ = v_r0 + 4 * gp + q4; const int a_ = __shfl(v_cl0, ix_ & 63), b_ = __shfl(v_cl1, ix_ & 63); DS##_ent[gp] = ix_ < 64 ? a_ : b_; \
            const unsigned of_ = (4 * gp + q4 < DS##_cnt ? ((unsigned)(DS##_ent[gp] & 2047) << 10) : 0u) + lanepart; \
            _Pragma("unroll") for (int c = 0; c < 4; ++c) BUF[4 * gp + c] = *(const GAS v4u*)(ubase + of_ + c * 256); } } while (0)
#define U_COMPUTE(BUF, DS) do { const LAS unsigned char* sp_ = hsl + DS##_slot * 2048; const LAS v4u* hp_ = (const LAS v4u*)(sp_ + i16 * 16); \
        _Pragma("unroll") for (int gp = 0; gp < 4; ++gp) if (4 * gp < DS##_cnt) { int ah_ = 0, al_ = 0; \
            _Pragma("unroll") for (int c = 0; c < 4; ++c) { const v4u r_ = BUF[4 * gp + c]; const v4u hh_ = hp_[c * 16], hl_ = hp_[64 + c * 16]; \
                ah_ = __builtin_amdgcn_sdot8((int)r_.x, (int)hh_.x, ah_, false); al_ = __builtin_amdgcn_sdot8((int)r_.x, (int)hl_.x, al_, false); \
                ah_ = __builtin_amdgcn_sdot8((int)r_.y, (int)hh_.y, ah_, false); al_ = __builtin_amdgcn_sdot8((int)r_.y, (int)hl_.y, al_, false); \
                ah_ = __builtin_amdgcn_sdot8((int)r_.z, (int)hh_.z, ah_, false); al_ = __builtin_amdgcn_sdot8((int)r_.z, (int)hl_.z, al_, false); \
                ah_ = __builtin_amdgcn_sdot8((int)r_.w, (int)hh_.w, ah_, false); al_ = __builtin_amdgcn_sdot8((int)r_.w, (int)hl_.w, al_, false); } \
            const int a_ = row_sum16((ah_ << 4) + al_); if (i16 == 0 && 4 * gp + q4 < DS##_cnt) res[DS##_ent[gp] >> 16] = a_; } \
        if (DS##_last) { int* po_ = F.PART() + (size_t)DS##_t * 128; \
            if ((DS##_mlo >> lane) & 1ull) po_[lane] = res[lane]; if ((DS##_mhi >> lane) & 1ull) po_[64 + lane] = res[64 + lane]; } } while (0)
    v4u bufA[16], bufB[16], bufC[16];
    int dA_cnt = 0, dA_ent[4] = {0, 0, 0, 0}, dA_t = 0, dA_slot = 0; unsigned long long dA_mlo = 0, dA_mhi = 0; bool dA_last = false;
    int dB_cnt = 0, dB_ent[4] = {0, 0, 0, 0}, dB_t = 0, dB_slot = 0; unsigned long long dB_mlo = 0, dB_mhi = 0; bool dB_last = false;
    int dC_cnt = 0, dC_ent[4] = {0, 0, 0, 0}, dC_t = 0, dC_slot = 0; unsigned long long dC_mlo = 0, dC_mhi = 0; bool dC_last = false;
    U_RAW();
    U_NEXT(); U_RAW(); U_ISSUE(bufA, dA);
    U_NEXT(); U_RAW(); U_ISSUE(bufB, dB);
    while (idle < 3) {
        U_NEXT(); U_RAW(); U_ISSUE(bufC, dC); U_COMPUTE(bufA, dA);
        U_NEXT(); U_RAW(); U_ISSUE(bufA, dA); U_COMPUTE(bufB, dB);
        U_NEXT(); U_RAW(); U_ISSUE(bufB, dB); U_COMPUTE(bufC, dC);
    }
#undef U_RAW
#undef U_NEXT
#undef U_ISSUE
#undef U_COMPUTE
}
__device__ __forceinline__ void peer_act_token(Frame& F, int t) {
    const int lane = F.lane;
    LAS unsigned char* wl = F.lds + F.wave * 4096;
    LAS float* abuf = (LAS float*)wl; LAS int* ibuf = (LAS int*)(wl + 512); LAS int* cnt = (LAS int*)(wl + 1024);
    LAS int* ovf = (LAS int*)(wl + 1280); LAS int* fre = (LAS int*)(wl + 1792); LAS int* sop = (LAS int*)(wl + 2304);
#define WFENCE() asm volatile("s_waitcnt lgkmcnt(0)" ::: "memory")
    const float sc = __builtin_amdgcn_rsqf(F.ROWSS()[t] * (1.0f / D) + 1e-6f) * F.HSCALE()[t];
    if (lane < 34) cnt[lane] = 0;
    float am = 0.f; float actv[2]; int idv[2], slotv[2];
    const int l32 = t & 31;
#pragma unroll
    for (int half = 0; half < 2; ++half) {
        const size_t o = (size_t)t * 128 + half * 64 + lane;
        const int e = F.IDS()[o]; const float g = F.GATES()[o];
        const int dsum = F.PART()[o];
        actv[half] = gelu_tanh((float)dsum * sc * F.USCALE()[e]) * g * F.VSCALE()[e]; idv[half] = e; am = fmaxf(am, fabsf(actv[half]));
    }
    WFENCE();
#pragma unroll
    for (int half = 0; half < 2; ++half) {
        const int r = idv[half] & 31;
        const int j = __hip_atomic_fetch_add(cnt + r, 1, __ATOMIC_RELAXED, __HIP_MEMORY_SCOPE_WORKGROUP);
        if (j < 4) slotv[half] = ((r - l32) & 31) + 32 * j;
        else { const int q = __hip_atomic_fetch_add(cnt + 32, 1, __ATOMIC_RELAXED, __HIP_MEMORY_SCOPE_WORKGROUP); ovf[q] = half * 64 + lane; slotv[half] = -1; }
    }
    WFENCE();
    if (lane < 32) { const int n = cnt[lane];
        for (int j = n; j < 4; ++j) { const int q = __hip_atomic_fetch_add(cnt + 33, 1, __ATOMIC_RELAXED, __HIP_MEMORY_SCOPE_WORKGROUP); fre[q] = ((lane - l32) & 31) + 32 * j; } }
    WFENCE();
    const int nov = cnt[32];
#pragma unroll
    for (int half = 0; half < 2; ++half) { const int i = half * 64 + lane; if (i < nov) sop[ovf[i]] = fre[i]; }
    WFENCE();
#pragma unroll
    for (int half = 0; half < 2; ++half) { if (slotv[half] < 0) slotv[half] = sop[half * 64 + lane]; abuf[slotv[half]] = actv[half]; ibuf[slotv[half]] = idv[half]; }
    WFENCE();
#pragma unroll
    for (int o = 1; o < 64; o <<= 1) am = fmaxf(am, __shfl_xor(am, o));
    const float asc = am > 0.f ? 127.0f / am : 1.0f;
    if (lane == 0) F.ASCALE()[t] = am > 0.f ? am * (1.0f / 127.0f) : 1.0f;
    if (lane < 32) {
        const f32x4 av = *(const LAS f32x4*)(abuf + 4 * lane); const v4u iv = *(const LAS v4u*)(ibuf + 4 * lane);
        const size_t o = ((size_t)(t >> 6) * 32 + lane) * 64 + (t & 63);
        F.IDW()[o] = (v4u){iv.x << 3, iv.y << 3, iv.z << 3, iv.w << 3};
        F.AW()[o] = pack_i8x4(av.x * asc, av.y * asc, av.z * asc, av.w * asc);
    }
    WFENCE();
#undef WFENCE
}
__device__ __forceinline__ void tr4x4(const unsigned r0, const unsigned r1, const unsigned r2, const unsigned r3, unsigned (&c)[4]) {
    const unsigned t01l = __builtin_amdgcn_perm(r1, r0, 0x05010400u), t01h = __builtin_amdgcn_perm(r1, r0, 0x07030602u);
    const unsigned t23l = __builtin_amdgcn_perm(r3, r2, 0x05010400u), t23h = __builtin_amdgcn_perm(r3, r2, 0x07030602u);
    c[0] = __builtin_amdgcn_perm(t23l, t01l, 0x05040100u); c[1] = __builtin_amdgcn_perm(t23l, t01l, 0x07060302u);
    c[2] = __builtin_amdgcn_perm(t23h, t01h, 0x05040100u); c[3] = __builtin_amdgcn_perm(t23h, t01h, 0x07060302u);
}
template <int MODE>
__device__ __forceinline__ void peer_v_slice(Frame& F, int c, bool do_atomic) {
    const int tid = F.tid, lane = F.lane;
    for (int i = tid; i < NEXP * 8 / 16; i += 512) *(LAS v4u*)(F.lds + i * 16) = *(const GAS v4u*)(F.V8T() + (size_t)c * NEXP * 8 + (size_t)i * 16);
    __syncthreads();
    const v4u* ibase = F.IDW() + lane; const unsigned* abase = F.AW() + lane;
    constexpr int NBLK = M / 64, PD = 16;
    v4u iq[PD]; unsigned aq[PD]; v2u rw[2][4];
    {
        const size_t o = (size_t)F.wave * 32 * 64;
#pragma unroll
        for (int j = 0; j < PD; ++j) { iq[j] = *(const GAS v4u*)(ibase + o + j * 64); aq[j] = abase[o + j * 64]; }
    }
#define LROW(dst, q) do { dst[0] = *(const LAS v2u*)(F.lds + (q).x); dst[1] = *(const LAS v2u*)(F.lds + (q).y); \
                          dst[2] = *(const LAS v2u*)(F.lds + (q).z); dst[3] = *(const LAS v2u*)(F.lds + (q).w); } while (0)
    for (int blk = F.wave; blk < NBLK; blk += NWAVES) {
        const int t = blk * 64 + lane;
        const size_t o = (size_t)blk * 32 * 64;
        const int nblk = (blk + NWAVES < NBLK) ? blk + NWAVES : blk;
        const size_t on = (size_t)nblk * 32 * 64;
        int acc[8];
#pragma unroll
        for (int i = 0; i < 8; ++i) acc[i] = 0;
        LROW(rw[0], iq[0]);
#pragma unroll
        for (int j = 0; j < 32; ++j) {
            if (j + 1 < 32) LROW(rw[(j + 1) & 1], iq[(j + 1) % PD]);
            const unsigned aw = aq[j % PD];
            unsigned cl[4], ch[4];
            tr4x4(rw[j & 1][0].x, rw[j & 1][1].x, rw[j & 1][2].x, rw[j & 1][3].x, cl);
            tr4x4(rw[j & 1][0].y, rw[j & 1][1].y, rw[j & 1][2].y, rw[j & 1][3].y, ch);
#pragma unroll
            for (int i = 0; i < 4; ++i) { acc[i] = __builtin_amdgcn_sdot4((int)aw, (int)cl[i], acc[i], false); acc[4 + i] = __builtin_amdgcn_sdot4((int)aw, (int)ch[i], acc[4 + i], false); }
            { const size_t oo = (j + PD < 32) ? o + (size_t)(j + PD) * 64 : on + (size_t)(j + PD - 32) * 64;
              iq[j % PD] = *(const GAS v4u*)(ibase + oo); aq[j % PD] = abase[oo]; }
            __builtin_amdgcn_sched_barrier(0);
        }
        const float asc = F.ASCALE()[t];
        float accf[8];
#pragma unroll
        for (int i = 0; i < 8; ++i) accf[i] = (float)acc[i] * asc;
        const v4u hb = *(const GAS v4u*)(F.HBT() + ((size_t)c * M + t) * 8);
        accf[0] += bf_lo(hb.x); accf[1] += bf_hi(hb.x); accf[2] += bf_lo(hb.y); accf[3] += bf_hi(hb.y);
        accf[4] += bf_lo(hb.z); accf[5] += bf_hi(hb.z); accf[6] += bf_lo(hb.w); accf[7] += bf_hi(hb.w);
        bf16* yp = (MODE == 0) ? F.Y() + ((size_t)c * M + t) * 8 : (bf16*)F.XN() + ((((size_t)c * M + t) * 8) & (size_t)0x1ffffff);
        *(GAS v4u*)yp = (v4u){pk2(accf[0], accf[1]), pk2(accf[2], accf[3]), pk2(accf[4], accf[5]), pk2(accf[6], accf[7])};
        float ss = 0.f;
#pragma unroll
        for (int i = 0; i < 8; ++i) ss += accf[i] * accf[i];
        if (do_atomic) atomicAdd(F.ROWSS2() + t, ss);
    }
#undef LROW
    __syncthreads();
}
__device__ __forceinline__ void final_unit(Frame& F, int unit) {
    const int tid = F.tid, blk = unit >> 3, cg = unit & 7, t0 = blk * 64;
    LAS float* T = (LAS float*)F.lds;
#pragma unroll
    for (int i = 0; i < 4; ++i) { const int pid = tid + 512 * i, cl = pid >> 6, tok = pid & 63;
        const v4u v = *(const GAS v4u*)(F.Y() + ((size_t)(cg * 32 + cl) * M + t0 + tok) * 8);
        *(LAS f32x4*)(T + tok * 260 + cl * 8) = (f32x4){bf_lo(v.x), bf_hi(v.x), bf_lo(v.y), bf_hi(v.y)};
        *(LAS f32x4*)(T + tok * 260 + cl * 8 + 4) = (f32x4){bf_lo(v.z), bf_hi(v.z), bf_lo(v.w), bf_hi(v.w)}; }
    __syncthreads();
#pragma unroll
    for (int i = 0; i < 8; ++i) { const int pid = tid + 512 * i, tok = pid >> 6, c4 = pid & 63;
        const float rs = __builtin_amdgcn_rsqf(F.ROWSS2()[t0 + tok] * (1.0f / D) + 1e-6f);
        const f32x4 v = *(const LAS f32x4*)(T + tok * 260 + c4 * 4);
        const f32x4 g = *(const GAS f32x4*)(F.A.in[20] + cg * 256 + c4 * 4);
        *(GAS f32x4*)(F.A.out + (size_t)(t0 + tok) * D + cg * 256 + c4 * 4) = v * rs * g; }
    __syncthreads();
}
__global__ void __launch_bounds__(NWAVES * 64, 2) mk_fwd(Args args) {
    __shared__ __attribute__((aligned(16))) unsigned char lds[LDS_BYTES];
    Frame F(args);
    F.lds = (LAS unsigned char*)lds;
    F.MISC = (volatile LAS unsigned*)(F.lds + MISC_OFF);
    F.tid = threadIdx.x; F.lane = F.tid & 63; F.wave = __builtin_amdgcn_readfirstlane(F.tid >> 6);
    F.G = gridDim.x; { const int bx = blockIdx.x; F.vcu = (F.G % 8 == 0) ? (bx % 8) * (F.G / 8) + bx / 8 : bx; }
    F.ws = args.ws;
    F.ctl = (gu32*)(args.ws + WS_CTL);
    for (int u = F.tid; u < (LDS_BYTES - LDSCTL_OFF) / 4; u += NWAVES * 64) ((LAS unsigned*)(F.lds + LDSCTL_OFF))[u] = 0u;
    __syncthreads();
    XcdBarrier bar; bar.bar = (unsigned*)(F.ctl + CW_BAR); bar.x = 0; bar.st = nullptr;
    if (N_LAUNCHES != PER_PHASE) bar = xcd_barrier_post((unsigned*)(F.ctl + CW_BAR), F.MISC + 8);
#define GRID_BAR() do { if (N_LAUNCHES != PER_PHASE) xcd_barrier(bar); } while (0)
    const int lo = args.ph_lo, hi = args.ph_hi;
#ifndef MK_PHASE_MASK
#define MK_PHASE_MASK 0x7FF
#endif
#define IN(k) (((MK_PHASE_MASK >> (k)) & 1) && lo <= (k) && (k) < hi)
#undef MK_PHASE_MASK
#define MK_PHASE_MASK 0xFFFF
#define BOTH(k) (true)
#ifndef MK_REP_MASK
#define MK_REP_MASK 0
#endif
#ifndef MK_REP_N
#define MK_REP_N 2
#endif
#define REPS(k) for (int rep_ = 0; rep_ < ((((MK_REP_MASK) >> (k)) & 1) ? 1 + MK_REP_N : 1); ++rep_)
    const int gw = F.vcu * NWAVES + F.wave, NGW = F.G * NWAVES;
    if (IN(0)) { REPS(0) { p0_prologue(F); __syncthreads(); } if (BOTH(0)) GRID_BAR(); }
    if (IN(1)) {
        pg8::Gemm g{F.XN(), F.WIN(), M, NIN, D}; pg8::StaticOrder S; S.init(M, NIN, F.G, (int)blockIdx.x);
        pg8::EpiZ E{F.Z(), NIN, LW};
        REPS(1) pg8::gemm_phase<pg8::EpiZ, pg8::StaticOrder, true, true>(F.lds, g, S, E);
        if (BOTH(1)) GRID_BAR();
    }
    if (IN(2)) {
        REPS(12) for (int u = blockIdx.x; u < BATCH * NCHUNK * 8; u += F.G) lru_unit<false>(F, u);
        if (BOTH(2)) GRID_BAR();
    }
    if (IN(3)) {
        lru_carry(F);
        REPS(13) for (int u = blockIdx.x; u < BATCH * NCHUNK; u += F.G) gmlp_unit(F, u);
        if (BOTH(3)) GRID_BAR();
    }
    if (IN(11)) {
        REPS(3) for (int u = blockIdx.x; u < BATCH * NCHUNK * 8; u += F.G) lru_unit<true>(F, u);
        GRID_BAR();
    }
    if (IN(4)) {
        pg8::Gemm g{F.MIX(), F.WOUT(), M, D, D}; pg8::StaticOrder S; S.init(M, D, F.G, (int)blockIdx.x);
        pg8::EpiH E{F.HB(), F.HBT(), F.A.in[0], F.ROWSS(), D, M};
        pg8::gemm_phase<pg8::EpiH, pg8::StaticOrder, true, true>(F.lds, g, S, E);
        if (BOTH(4)) GRID_BAR();
    }
    if (IN(5)) {
        pg8::Gemm g{F.HB(), F.WQ(), M, D, D}; pg8::StaticOrder S; S.init(M, D, F.G, (int)blockIdx.x);
        pg8::EpiQ E{F.QH(), F.ROWSS(), D};
        REPS(5) pg8::gemm_phase<pg8::EpiQ, pg8::StaticOrder, true, true>(F.lds, g, S, E);
        if (BOTH(5)) GRID_BAR();
    }
    if (IN(6)) {
        REPS(6) { for (int wu = gw; wu < (M / 32) * 8; wu += NGW) topk_unit(F, wu);
                  for (int t = gw; t < M; t += NGW) h8_row(F, t); }
        if (BOTH(6)) GRID_BAR();
    }
    if (IN(7)) {
        REPS(7) peer_u_xcd(F);
        if (BOTH(7)) GRID_BAR();
    }
    if (IN(8)) {
        REPS(8) for (int t = gw; t < M; t += NGW) peer_act_token(F, t);
        if (BOTH(8)) GRID_BAR();
    }
    if (IN(9)) {
        for (int c = blockIdx.x; c < D / 8; c += F.G) peer_v_slice<0>(F, c, true);
        if ((MK_REP_MASK >> 9) & 1) { for (int rep_ = 0; rep_ < MK_REP_N; ++rep_) for (int c = blockIdx.x; c < D / 8; c += F.G) peer_v_slice<1>(F, c, false); }
        if (BOTH(9)) GRID_BAR();
    }
    if (IN(10)) {
        REPS(10) for (int u = blockIdx.x; u < (M / 64) * 8; u += F.G) final_unit(F, u);
    }
#undef IN
#undef BOTH
#undef GRID_BAR
}

extern "C" void kernel_launch(void* const* d_in, const int* in_sizes, int n_in, void* d_out, int out_size, void* d_ws, size_t ws_size, hipStream_t stream) {
    static int grid = 0;
    if (grid == 0) {
        if (n_in != 21 || in_sizes[0] != M * D || out_size != M * D || ws_size < WS_END) { fprintf(stderr, "kernel_launch: unexpected shapes (n_in %d, in0 %d, out %d, ws %zu)\n", n_in, n_in > 0 ? in_sizes[0] : -1, out_size, ws_size); grid = -1; return; }
        int dev = 0, cus = 0, per_cu = 0;
        if (hipGetDevice(&dev) != hipSuccess || hipDeviceGetAttribute(&cus, hipDeviceAttributeMultiprocessorCount, dev) != hipSuccess) { grid = -1; return; }
        if (hipOccupancyMaxActiveBlocksPerMultiprocessor(&per_cu, (const void*)mk_fwd, NWAVES * 64, 0) != hipSuccess || per_cu < 1) { fprintf(stderr, "kernel_launch: occupancy query reports %d blocks per CU\n", per_cu); }
        (void)hipGetLastError();
        grid = cus;
    }
    if (grid < 0) return;
    (void)hipMemsetAsync((char*)d_ws + WS_CTL, 0, CTL_ZERO_BYTES, stream);
    Args a{};
    for (int i = 0; i < 21; ++i) a.in[i] = (const float*)d_in[i];
    a.out = (float*)d_out; a.ws = (unsigned char*)d_ws;
    for (int li = 0; li < N_LAUNCHES; ++li) {
        a.ph_lo = 0; a.ph_hi = 99;
        hipLaunchKernelGGL(mk_fwd, dim3(grid), dim3(NWAVES * 64), 0, stream, a);
    }
}
```

```cpp
#include <hip/hip_runtime.h>
#include <cstdio>
#include <cstdint>
namespace pg8 {
#define PG8_LAS __attribute__((address_space(3)))
typedef unsigned short bf16_t;
typedef short bf16x8 __attribute__((ext_vector_type(8)));
typedef float f32x4 __attribute__((ext_vector_type(4)));
typedef unsigned u32x4 __attribute__((ext_vector_type(4)));
constexpr int BM = 256, BK = 64, HALF = 128, HTB = HALF * BK * 2  , STAGE_BYTES = 8 * HTB, NXCD = 8, WGM = 8;

__host__ __device__ __forceinline__ int lds_byte(int r, int c) { const int st = (r >> 4) * 2 + (c >> 5), rr = r & 15, cc = c & 31, ob = rr * 64 + cc * 2; return st * 1024 + (ob ^ (((ob >> 9) & 1) << 5)); }
__host__ __device__ __forceinline__ void stage_rc(int b, int& R, int& C) { const int st = b / 1024, sb = b % 1024, swz = sb ^ (((sb >> 9) & 1) << 5); R = (st >> 1) * 16 + swz / 64; C = (st & 1) * 32 + (swz % 64) / 2; }
__host__ __device__ __forceinline__ int perm32(int rho) { const int n = rho >> 4, i = rho & 15; return 8 * (i >> 2) + 4 * n + (i & 3); }

struct Unit { int pm, pn; };
struct Gemm { const bf16_t* A; const bf16_t* Bt; int M, N, K; };

struct StaticOrder {
    int nM, nN, nwg, G, c;
    __host__ __device__ void init(int M, int N, int G_, int c_) { nM = M / BM; nN = N / BM; nwg = nM * nN; G = G_; c = c_; }
    __host__ __device__ bool next(int i, Unit& u) const {
        const long L = (long)i * G + c; if (L >= nwg) return false;
        int wgid = (int)L; { const int q = nwg / NXCD, r = nwg % NXCD, xcd = wgid % NXCD, off = wgid / NXCD; wgid = (xcd < r ? xcd * (q + 1) : r * (q + 1) + (xcd - r) * q) + off; }
        const int nig = WGM * nN, gid = wgid / nig, fm = gid * WGM, gsz = (nM - fm) < WGM ? (nM - fm) : WGM;
        u.pm = fm + ((wgid % nig) % gsz); u.pn = (wgid % nig) / gsz; return true;
    }
    __device__ __forceinline__ void a_ready(const Unit&) const {}
    __device__ __forceinline__ void done(const Unit&) const {}
};

__device__ __forceinline__ unsigned cvt_pk_bf16(float lo, float hi) { unsigned r; asm volatile("v_cvt_pk_bf16_f32 %0, %1, %2" : "=v"(r) : "v"(lo), "v"(hi)); return r; }
__device__ __forceinline__ float gelu_tanh(float x) {
    const float t = x * (1.0f + 0.044715f * x * x);
    const float e = __builtin_amdgcn_exp2f(-2.3022081983f * t);
    return x * __builtin_amdgcn_rcpf(1.0f + e);
}
struct EpiZ {
    static constexpr bool PERM = true, AFTER_DRAIN = false;
    bf16_t* O; int ldc; int gelu_from;
    __device__ __forceinline__ void operator()(const f32x4 (&acc)[2][2][4][2], const Unit& u, int wr, int wc, int fr, int fq) const {
        const int row0 = u.pm * BM + wr * 64 + fr; const int col0 = u.pn * BM + wc * 32 + 8 * fq;
        const bool act = (u.pn * BM) >= gelu_from;
#pragma unroll
        for (int ai = 0; ai < 2; ++ai)
#pragma unroll
            for (int m = 0; m < 4; ++m) { bf16_t* rowp = O + (size_t)(row0 + ai * HALF + m * 16) * ldc + col0;
#pragma unroll
                for (int bj = 0; bj < 2; ++bj) { f32x4 v0 = acc[ai][bj][m][0], v1 = acc[ai][bj][m][1];
                    if (act) {
#pragma unroll
                        for (int j = 0; j < 4; ++j) { v0[j] = gelu_tanh(v0[j]); v1[j] = gelu_tanh(v1[j]); } }
                    u32x4 w; w.x = cvt_pk_bf16(v0[0], v0[1]); w.y = cvt_pk_bf16(v0[2], v0[3]); w.z = cvt_pk_bf16(v1[0], v1[1]); w.w = cvt_pk_bf16(v1[2], v1[3]);
                    *(u32x4*)(rowp + bj * HALF) = w; } }
    }
};
struct EpiH {
    static constexpr bool PERM = true, AFTER_DRAIN = false;
    bf16_t* O; bf16_t* OT; const float* X; float* rowss; int ldc; int mrows;
    __device__ __forceinline__ void operator()(const f32x4 (&acc)[2][2][4][2], const Unit& u, int wr, int wc, int fr, int fq) const {
        const int row0 = u.pm * BM + wr * 64 + fr; const int col0 = u.pn * BM + wc * 32 + 8 * fq;
#pragma unroll
        for (int ai = 0; ai < 2; ++ai)
#pragma unroll
            for (int m = 0; m < 4; ++m) { const int row = row0 + ai * HALF + m * 16; const size_t off = (size_t)row * ldc + col0; float ss = 0.f;
#pragma unroll
                for (int bj = 0; bj < 2; ++bj) {
                    const f32x4 x0 = *(const f32x4*)(X + off + bj * HALF), x1 = *(const f32x4*)(X + off + bj * HALF + 4);
                    const f32x4 v0 = acc[ai][bj][m][0] + x0, v1 = acc[ai][bj][m][1] + x1;
                    ss += (v0[0] * v0[0] + v0[1] * v0[1]) + (v0[2] * v0[2] + v0[3] * v0[3]) + (v1[0] * v1[0] + v1[1] * v1[1]) + (v1[2] * v1[2] + v1[3] * v1[3]);
                    u32x4 w; w.x = cvt_pk_bf16(v0[0], v0[1]); w.y = cvt_pk_bf16(v0[2], v0[3]); w.z = cvt_pk_bf16(v1[0], v1[1]); w.w = cvt_pk_bf16(v1[2], v1[3]);
                    *(u32x4*)(O + off + bj * HALF) = w;
                    *(u32x4*)(OT + ((size_t)((col0 + bj * HALF) >> 3) * mrows + row) * 8) = w; }
                ss += __shfl_xor(ss, 16); ss += __shfl_xor(ss, 32);
                if (fq == 0) atomicAdd(rowss + row, ss); }
    }
};
struct EpiQ {
    static constexpr bool PERM = true, AFTER_DRAIN = false;
    bf16_t* QH; const float* rowss; int ldc;
    __device__ __forceinline__ void operator()(const f32x4 (&acc)[2][2][4][2], const Unit& u, int wr, int wc, int fr, int fq) const {
        const int row0 = u.pm * BM + wr * 64 + fr, col0 = u.pn * BM + wc * 32 + 8 * fq;
#pragma unroll
        for (int ai = 0; ai < 2; ++ai)
#pragma unroll
            for (int m = 0; m < 4; ++m) { const int row = row0 + ai * HALF + m * 16; const float rs = __builtin_amdgcn_rsqf(rowss[row] * (1.0f / 2048.0f) + 1e-6f);
                const size_t off = (size_t)row * ldc + col0;
#pragma unroll
                for (int bj = 0; bj < 2; ++bj) { const f32x4 v0 = acc[ai][bj][m][0] * rs, v1 = acc[ai][bj][m][1] * rs;
                    u32x4 wh; wh.x = cvt_pk_bf16(v0[0], v0[1]); wh.y = cvt_pk_bf16(v0[2], v0[3]); wh.z = cvt_pk_bf16(v1[0], v1[1]); wh.w = cvt_pk_bf16(v1[2], v1[3]);
                    *(u32x4*)(QH + off + bj * HALF) = wh; } }
    }
};
template <class Epi, class Sched, bool ALIGN_EPI = false, bool SP2 = false>
__device__ __forceinline__ void gemm_phase(PG8_LAS unsigned char* lds, const Gemm g, const Sched& S, const Epi& E) {
    const int tid = threadIdx.x, wid = __builtin_amdgcn_readfirstlane(tid >> 6), lane = tid & 63, wr = wid >> 2, wc = wid & 3, fr = lane & 15, fq = lane >> 4;
    const int K = g.K, nt = K / BK;
    unsigned voffA[2], voffB[2];
#pragma unroll
    for (int i = 0; i < 2; ++i) { int R, C; stage_rc(tid * 16 + i * 8192, R, C); const int Rb = Epi::PERM ? ((R & ~31) + perm32(R & 31)) : R;
        voffA[i] = (unsigned)(R * K + C) * 2u; voffB[i] = (unsigned)(Rb * K + C) * 2u; }
    const size_t kstep = (size_t)(BK * 2);
    const size_t hstep = (size_t)HALF * K * 2;
    const size_t tstep = 2 * hstep;
    const unsigned ldsw = (unsigned)wid * 1024u;
    const int aoff = lds_byte(wr * 64 + fr, fq * 8), boff = lds_byte(wc * 32 + fr, fq * 8);
#define PG8_SA(b, h) (((b) * 2 + (h)) * HTB)
#define PG8_SB(b, h) ((4 + (b) * 2 + (h)) * HTB)
#define PG8_STAGE(bufoff, gbase, voff) do { _Pragma("unroll") for (int _i = 0; _i < 2; ++_i) \
        __builtin_amdgcn_global_load_lds((const unsigned*)((const char*)(gbase) + (voff)[_i]), (PG8_LAS unsigned*)(lds + (bufoff) + ldsw + _i * 8192), 16, 0, 0); } while (0)
#define PG8_LDA(dst, b, h) do { _Pragma("unroll") for (int m = 0; m < 4; ++m) _Pragma("unroll") for (int k = 0; k < 2; ++k) dst[m][k] = *(const PG8_LAS bf16x8*)(lds + PG8_SA(b, h) + aoff + m * 2048 + k * 1024); } while (0)
#define PG8_LDB(dst, b, h) do { _Pragma("unroll") for (int n = 0; n < 2; ++n) _Pragma("unroll") for (int k = 0; k < 2; ++k) dst[n][k] = *(const PG8_LAS bf16x8*)(lds + PG8_SB(b, h) + boff + n * 2048 + k * 1024); } while (0)
#define PG8_MMA(ai, bj, At, Bt) do { __builtin_amdgcn_s_setprio(1); _Pragma("unroll") for (int m = 0; m < 4; ++m) _Pragma("unroll") for (int n = 0; n < 2; ++n) _Pragma("unroll") for (int k = 0; k < 2; ++k) \
        acc[ai][bj][m][n] = __builtin_amdgcn_mfma_f32_16x16x32_bf16(Bt[n][k], At[m][k], acc[ai][bj][m][n], 0, 0, 0); __builtin_amdgcn_s_setprio(0); } while (0)
#define PG8_WAIT_V(n) asm volatile("s_waitcnt vmcnt(" #n ")" ::: "memory")
#define PG8_WAIT_L(n) asm volatile("s_waitcnt lgkmcnt(" #n ")" ::: "memory")
#define PG8_BAR __builtin_amdgcn_s_barrier()
#define PG8_SCHED __builtin_amdgcn_sched_barrier(0)
    Unit cur, nxt; int ui = 0;
    if (!S.next(0, cur)) return;
    f32x4 acc[2][2][4][2];
#pragma unroll
    for (int a = 0; a < 2; ++a)
#pragma unroll
        for (int b = 0; b < 2; ++b)
#pragma unroll
            for (int m = 0; m < 4; ++m)
#pragma unroll
                for (int n = 0; n < 2; ++n) acc[a][b][m][n] = (f32x4){0.f, 0.f, 0.f, 0.f};
    bf16x8 At[4][2], B0[2][2], B1[2][2];
    const char* cA = (const char*)g.A + (size_t)cur.pm * tstep; const char* cB = (const char*)g.Bt + (size_t)cur.pn * tstep;
    S.a_ready(cur);
    if constexpr (SP2) {
        PG8_STAGE(PG8_SB(0, 0), cB, voffB); PG8_STAGE(PG8_SB(0, 1), cB + hstep, voffB); PG8_STAGE(PG8_SA(0, 0), cA, voffA); PG8_STAGE(PG8_SA(0, 1), cA + hstep, voffA);
        if (wr == 1) PG8_BAR;
        PG8_WAIT_V(2); PG8_BAR;
        PG8_STAGE(PG8_SB(1, 0), cB + kstep, voffB); PG8_STAGE(PG8_SA(1, 0), cA + kstep, voffA); PG8_STAGE(PG8_SB(1, 1), cB + hstep + kstep, voffB);
        PG8_WAIT_V(6); PG8_BAR;
    } else {
        PG8_STAGE(PG8_SB(0, 0), cB, voffB); PG8_STAGE(PG8_SA(0, 0), cA, voffA); PG8_STAGE(PG8_SB(0, 1), cB + hstep, voffB); PG8_STAGE(PG8_SA(0, 1), cA + hstep, voffA);
        if (wr == 1) PG8_BAR;
        PG8_WAIT_V(4); PG8_BAR;
        PG8_STAGE(PG8_SB(1, 0), cB + kstep, voffB); PG8_STAGE(PG8_SA(1, 0), cA + kstep, voffA); PG8_STAGE(PG8_SB(1, 1), cB + hstep + kstep, voffB);
        PG8_WAIT_V(6); PG8_BAR;
    }
    for (;;) {
        const bool has_next = S.next(ui + 1, nxt);
        const char* nA = has_next ? (const char*)g.A + (size_t)nxt.pm * tstep : cA; const char* nB = has_next ? (const char*)g.Bt + (size_t)nxt.pn * tstep : cB;
        for (int t = 0; t < nt; t += 2) {
            const bool last = (t == nt - 2);
            const char* a1 = cA + (size_t)(t + 1) * kstep;
            const char* a2 = last ? nA : cA + (size_t)(t + 2) * kstep; const char* b2 = last ? nB : cB + (size_t)(t + 2) * kstep;
            const char* a3 = a2 + kstep; const char* b3 = b2 + kstep;
            if (last && has_next) S.a_ready(nxt);
            if constexpr (SP2) {
            PG8_LDB(B0, 0, 0); PG8_LDB(B1, 0, 1); PG8_SCHED; PG8_LDA(At, 0, 0); PG8_STAGE(PG8_SA(1, 1), a1 + hstep, voffA);
            PG8_WAIT_V(8); PG8_WAIT_L(0); PG8_BAR; PG8_MMA(0, 0, At, B0); PG8_MMA(0, 1, At, B1); PG8_BAR; PG8_SCHED;
            PG8_LDA(At, 0, 1); PG8_STAGE(PG8_SB(0, 0), b2, voffB); PG8_STAGE(PG8_SB(0, 1), b2 + hstep, voffB); PG8_STAGE(PG8_SA(0, 0), a2, voffA);
            PG8_WAIT_V(8); PG8_WAIT_L(0); PG8_BAR; PG8_MMA(1, 0, At, B0); PG8_MMA(1, 1, At, B1); PG8_BAR; PG8_SCHED;
            PG8_LDB(B0, 1, 0); PG8_LDB(B1, 1, 1); PG8_SCHED; PG8_LDA(At, 1, 0); PG8_STAGE(PG8_SA(0, 1), a2 + hstep, voffA);
            PG8_WAIT_V(8); PG8_WAIT_L(0); PG8_BAR; PG8_MMA(0, 0, At, B0); PG8_MMA(0, 1, At, B1); PG8_BAR; PG8_SCHED;
            PG8_LDA(At, 1, 1); PG8_STAGE(PG8_SB(1, 0), b3, voffB); PG8_STAGE(PG8_SB(1, 1), b3 + hstep, voffB); PG8_STAGE(PG8_SA(1, 0), a3, voffA);
            PG8_WAIT_V(8); PG8_WAIT_L(0); PG8_BAR; PG8_MMA(1, 0, At, B0); PG8_MMA(1, 1, At, B1); PG8_BAR; PG8_SCHED;
            } else {
            PG8_LDB(B0, 0, 0); PG8_SCHED; PG8_LDA(At, 0, 0); PG8_STAGE(PG8_SA(1, 1), a1 + hstep, voffA);
            PG8_WAIT_L(8); PG8_BAR; PG8_WAIT_L(0); PG8_MMA(0, 0, At, B0); PG8_BAR; PG8_SCHED;
            PG8_LDB(B1, 0, 1); PG8_STAGE(PG8_SB(0, 0), b2, voffB);
            PG8_BAR; PG8_WAIT_L(0); PG8_MMA(0, 1, At, B1); PG8_BAR;
            PG8_LDA(At, 0, 1); PG8_STAGE(PG8_SA(0, 0), a2, voffA);
            PG8_BAR; PG8_WAIT_L(0); PG8_MMA(1, 0, At, B0); PG8_BAR; PG8_SCHED;
            PG8_STAGE(PG8_SB(0, 1), b2 + hstep, voffB);
            PG8_WAIT_V(6); PG8_BAR; PG8_MMA(1, 1, At, B1); PG8_BAR;
            PG8_LDB(B0, 1, 0); PG8_SCHED; PG8_LDA(At, 1, 0); PG8_STAGE(PG8_SA(0, 1), a2 + hstep, voffA);
            PG8_WAIT_L(8); PG8_BAR; PG8_WAIT_L(0); PG8_MMA(0, 0, At, B0); PG8_BAR; PG8_SCHED;
            PG8_LDB(B1, 1, 1); PG8_STAGE(PG8_SB(1, 0), b3, voffB);
            PG8_BAR; PG8_WAIT_L(0); PG8_MMA(0, 1, At, B1); PG8_BAR;
            PG8_LDA(At, 1, 1); PG8_STAGE(PG8_SA(1, 0), a3, voffA);
            PG8_BAR; PG8_WAIT_L(0); PG8_MMA(1, 0, At, B0); PG8_BAR; PG8_SCHED;
            PG8_STAGE(PG8_SB(1, 1), b3 + hstep, voffB);
            PG8_WAIT_V(6); PG8_BAR; PG8_MMA(1, 1, At, B1); PG8_BAR;
            }
        }
        if constexpr (ALIGN_EPI) { if (wr == 0) PG8_BAR; }
        if constexpr (!Epi::AFTER_DRAIN) { E(acc, cur, wr, wc, fr, fq); S.done(cur); }
        if (!has_next) break;
#pragma unroll
        for (int a = 0; a < 2; ++a)
#pragma unroll
            for (int b = 0; b < 2; ++b)
#pragma unroll
                for (int m = 0; m < 4; ++m)
#pragma unroll
                    for (int n = 0; n < 2; ++n) acc[a][b][m][n] = (f32x4){0.f, 0.f, 0.f, 0.f};
        cur = nxt; cA = nA; cB = nB; ++ui;
        if constexpr (ALIGN_EPI) { if (wr == 1) PG8_BAR; }
    }
    PG8_WAIT_V(0);
    if constexpr (!ALIGN_EPI) { if (wr == 0) PG8_BAR; }
    PG8_BAR;
    if constexpr (Epi::AFTER_DRAIN) { E.fused(acc, cur, wr, wc, fr, fq, lds, wid, lane); S.done(cur); }
#undef PG8_SA
#undef PG8_SB
#undef PG8_STAGE
#undef PG8_LDA
#undef PG8_LDB
#undef PG8_MMA
#undef PG8_WAIT_V
#undef PG8_WAIT_L
#undef PG8_BAR
#undef PG8_SCHED
}
}
constexpr int NWAVES = 8;
constexpr int BATCH = 4, SEQ = 8192, D = 2048, M = BATCH * SEQ, NIN = 4096, LW = 1024, CHUNK = 128, NCHUNK = SEQ / CHUNK;
constexpr int NEXP = 16384;
#ifndef MK_N_LAUNCHES
#define MK_N_LAUNCHES 1
#endif
constexpr int N_LAUNCHES = MK_N_LAUNCHES;
constexpr int PER_PHASE = 11;
constexpr size_t MiB = 1u << 20;
constexpr size_t WS_CTL = 0, CTL_ZERO_BYTES = 1 * MiB;
constexpr size_t WS_ROWSS = 512 * 1024;
constexpr size_t WS_WIN = 2 * MiB, WS_WOUT = 18 * MiB, WS_WQ = 26 * MiB, WS_LRUW = 34 * MiB, WS_WSB = 35 * MiB, WS_AGG = 36 * MiB;
constexpr size_t WS_U = 64 * MiB, WS_V = 128 * MiB, WS_XN = 192 * MiB  , WS_Z = 320 * MiB  ;
constexpr size_t WS_HB = 576 * MiB, WS_IDS = 704 * MiB, WS_GATES = 720 * MiB, WS_PAIRS = 736 * MiB, WS_HBT = 752 * MiB, WS_END = 884 * MiB;
constexpr size_t WS_USCALE = 40 * MiB, WS_VSCALE = 41 * MiB;
constexpr size_t WS_HSCALE = 44 * MiB, WS_CARRY = 45 * MiB;
constexpr size_t WS_H8 = WS_XN, WS_PART = WS_XN + 64 * MiB;
constexpr size_t WS_ASCALE = 42 * MiB, WS_KH = 43 * MiB;
constexpr size_t WS_IDW = WS_PAIRS, WS_AW = 880 * MiB;
constexpr size_t WS_ROWSS2 = 640 * 1024;
constexpr size_t WS_Y = WS_Z;
constexpr int CW_BAR = 4096;
constexpr int RING_BYTES = 131072;
constexpr int LDSCTL_OFF = 143360, MISC_OFF = LDSCTL_OFF + 320;
constexpr int LDS_BYTES = 147456;
#define GAS __attribute__((address_space(1)))
#define LAS __attribute__((address_space(3)))
typedef unsigned short bf16;
typedef unsigned v4u __attribute__((ext_vector_type(4)));
typedef float f32x4 __attribute__((ext_vector_type(4)));
typedef short bf16x8 __attribute__((ext_vector_type(8)));
typedef GAS unsigned gu32;
typedef GAS unsigned long long gu64;
#define RLX_AGENT __ATOMIC_RELAXED, __HIP_MEMORY_SCOPE_AGENT
#define LDS_WAIT() asm volatile("s_waitcnt lgkmcnt(0)" ::: "memory")
#define VM_WAIT() asm volatile("s_waitcnt vmcnt(0)" ::: "memory")
__device__ __forceinline__ unsigned long long rt() { return __builtin_amdgcn_s_memrealtime(); }
__device__ __forceinline__ unsigned f2bf(float f) { unsigned u = __builtin_bit_cast(unsigned, f); return (u + 0x7fffu + ((u >> 16) & 1u)) >> 16; }
__device__ __forceinline__ unsigned pk2(float lo, float hi) { return f2bf(lo) | (f2bf(hi) << 16); }

#define XB_TMO      128
#define XB_XCNT(j)  (256  + 64 * (j))
#define XB_XSUB(j)  (1280 + 64 * (j))
#define XB_XGEN(j)  (2304 + 64 * (j))
#define XB_TOP      3328
#define XB_TOPGEN   3392
#define XCD_BAR_WORDS 3456
#define XB_SPIN_CAP (1u << 18)

__device__ __forceinline__ unsigned xb_ld(unsigned* p)              { return __hip_atomic_load(p, __ATOMIC_RELAXED, __HIP_MEMORY_SCOPE_AGENT); }
__device__ __forceinline__ unsigned xb_add(unsigned* p, unsigned v) { return __hip_atomic_fetch_add(p, v, __ATOMIC_RELAXED, __HIP_MEMORY_SCOPE_AGENT); }
__device__ __forceinline__ unsigned xb_xcc_id() { return (unsigned)__builtin_amdgcn_s_getreg((3 << 11) | 20) & 0xFu; }
#define XB_SPIN(cond, bar) do { unsigned _sp = 0; while (cond) { __builtin_amdgcn_s_sleep(1); \
    if ((++_sp & 255u) == 0u) { if (xb_ld(&(bar)[XB_TMO])) break; if (_sp > XB_SPIN_CAP) { atomicAdd(&(bar)[XB_TMO], 1u); break; } } } } while (0)

struct XcdBarrier {
    unsigned* bar; unsigned x;
    volatile LAS unsigned* st;
};

__device__ __forceinline__ XcdBarrier xcd_barrier_post(unsigned* bar, volatile LAS unsigned* st) {
    XcdBarrier b; b.bar = bar; b.x = xb_xcc_id(); b.st = st;
    if (threadIdx.x == 0) (void)xb_add(&bar[XB_XCNT(b.x)], 1u);
    return b;
}
__device__ __forceinline__ void xcd_barrier_complete(unsigned* bar, unsigned x, unsigned& nloc, unsigned& nx) {
    const unsigned G = gridDim.x * gridDim.y * gridDim.z;
    unsigned sum, cnt, mine, sp = 0u;
    for (;;) {
        sum = 0u; cnt = 0u; mine = 0u;
#pragma unroll
        for (unsigned j = 0; j < 16; ++j) { const unsigned c = xb_ld(&bar[XB_XCNT(j)]); sum += c; cnt += (c > 0u) ? 1u : 0u; mine = (j == x) ? c : mine; }
        if (sum == G) break;
        __builtin_amdgcn_s_sleep(1);
        if ((++sp & 255u) == 0u) { if (xb_ld(&bar[XB_TMO])) break; if (sp > XB_SPIN_CAP) { atomicAdd(&bar[XB_TMO], 1u); break; } }
    }
    nloc = mine > 0u ? mine : 1u; nx = cnt > 0u ? cnt : 1u;
}

__device__ __forceinline__ void xcd_barrier(const XcdBarrier& b) {
    asm volatile("s_waitcnt vmcnt(0)" ::: "memory");
    __syncthreads();
    if (threadIdx.x == 0) {
        unsigned* bar = b.bar;
        __builtin_amdgcn_s_waitcnt(0);
        unsigned nloc = b.st[0], nx = b.st[1];
        if (nloc == 0u) { xcd_barrier_complete(bar, b.x, nloc, nx); b.st[0] = nloc; b.st[1] = nx; }
        const unsigned old = xb_add(&bar[XB_XSUB(b.x)], 1u);
        const unsigned gen = old / nloc;
        if (old + 1u == (gen + 1u) * nloc) {
            __builtin_amdgcn_fence(__ATOMIC_RELEASE, "agent");
            asm volatile("s_waitcnt vmcnt(0)" ::: "memory");
            const unsigned og = xb_add(&bar[XB_TOP], 1u);
            const unsigned tg = og / nx;
            if (og + 1u == (tg + 1u) * nx) xb_add(&bar[XB_TOPGEN], 1u);
            else XB_SPIN(xb_ld(&bar[XB_TOPGEN]) == tg, bar);
            __builtin_amdgcn_fence(__ATOMIC_ACQUIRE, "agent");
            xb_add(&bar[XB_XGEN(b.x)], 1u);
            asm volatile("s_waitcnt vmcnt(0)" ::: "memory");
        } else {
            XB_SPIN(xb_ld(&bar[XB_XGEN(b.x)]) == gen, bar);
            __builtin_amdgcn_fence(__ATOMIC_ACQUIRE, "agent");
            asm volatile("s_waitcnt vmcnt(0)" ::: "memory");
        }
    }
    __syncthreads();
}
typedef unsigned v2u __attribute__((ext_vector_type(2)));
typedef float f32x2 __attribute__((ext_vector_type(2)));
struct Args { const float* in[21]; float* out; unsigned char* ws; int ph_lo, ph_hi; };
struct Frame {
    const Args& A;
    LAS unsigned char* lds;
    volatile LAS unsigned* MISC;
    gu32* ctl;
    unsigned char* ws;
    int tid, lane, wave, vcu, G;
    __device__ __forceinline__ Frame(const Args& a) : A(a) {}
#define WSP(name, type, off) __device__ __forceinline__ type* name() const { return (type*)(ws + (off)); }
    WSP(WIN, bf16, WS_WIN) WSP(WOUT, bf16, WS_WOUT) WSP(WQ, bf16, WS_WQ) WSP(LRUW, bf16, WS_LRUW) WSP(WSB, bf16, WS_WSB)
    WSP(XN, bf16, WS_XN) WSP(MIX, bf16, WS_XN) WSP(Z, bf16, WS_Z) WSP(HB, bf16, WS_HB) WSP(HBT, bf16, WS_HBT)
    WSP(U8, unsigned char, WS_U) WSP(V8T, unsigned char, WS_V)
    WSP(ROWSS, float, WS_ROWSS) WSP(ROWSS2, float, WS_ROWSS2) WSP(QH, bf16, WS_Z) WSP(QL, bf16, WS_Z + 128 * MiB) WSP(KH, bf16, WS_KH) WSP(KL, bf16, WS_KH + 512 * 1024) WSP(AGG, float, WS_AGG) WSP(CARRY, float, WS_CARRY) WSP(AU, unsigned, WS_HB) WSP(GATES, float, WS_GATES)
    WSP(USCALE, float, WS_USCALE) WSP(VSCALE, float, WS_VSCALE) WSP(Y, bf16, WS_Y) WSP(IDS, int, WS_IDS) WSP(ASCALE, float, WS_ASCALE) WSP(IDW, v4u, WS_IDW) WSP(AW, unsigned, WS_AW) WSP(H8, unsigned char, WS_H8) WSP(HSCALE, float, WS_HSCALE) WSP(PART, int, WS_PART)
#undef WSP
};
__device__ __forceinline__ float wave_sum(float v) {
#pragma unroll
    for (int o = 1; o < 64; o <<= 1) v += __shfl_xor(v, o);
    return v;
}
__device__ __forceinline__ float bf_lo(unsigned w) { return __builtin_bit_cast(float, w << 16); }
__device__ __forceinline__ float bf_hi(unsigned w) { return __builtin_bit_cast(float, w & 0xffff0000u); }
__device__ __forceinline__ float bf1(unsigned short h) { return __builtin_bit_cast(float, (unsigned)h << 16); }
__device__ __forceinline__ float sigmoidf_(float x) { return __builtin_amdgcn_rcpf(1.0f + __builtin_amdgcn_exp2f(-1.4426950409f * x)); }
using pg8::gelu_tanh;
__device__ __forceinline__ unsigned pack_i8x4(float a, float b, float c, float d) {
    const int ia = (int)__builtin_rintf(a), ib = (int)__builtin_rintf(b), ic = (int)__builtin_rintf(c), id = (int)__builtin_rintf(d);
    return (unsigned)(ia & 0xff) | ((unsigned)(ib & 0xff) << 8) | ((unsigned)(ic & 0xff) << 16) | ((unsigned)id << 24);
}

__device__ __forceinline__ void p0_transpose_item(const float* W, int K, int N, bf16* WT, const float* kscale, LAS float* scr, int item, int lane) {
    const int nblk = N / 32, kb = item / nblk, nb = item % nblk, k0 = 64 * kb, n0 = 32 * nb;
#pragma unroll 8
    for (int i = 0; i < 32; ++i) { const int kk = 2 * i + (lane >> 5); const float sc = kscale ? kscale[k0 + kk] : 1.0f; scr[kk * 33 + (lane & 31)] = W[(size_t)(k0 + kk) * N + n0 + (lane & 31)] * sc; }
    LDS_WAIT(); asm volatile("" ::: "memory");
    const int c = lane & 7;
#pragma unroll
    for (int j = 0; j < 4; ++j) { const int n = (lane >> 3) + 8 * j; const LAS float* s = scr + (8 * c) * 33 + n;
        v4u o; o.x = pk2(s[0 * 33], s[1 * 33]); o.y = pk2(s[2 * 33], s[3 * 33]); o.z = pk2(s[4 * 33], s[5 * 33]); o.w = pk2(s[6 * 33], s[7 * 33]);
        *(GAS v4u*)(WT + (size_t)(n0 + n) * K + k0 + 8 * c) = o; }
    LDS_WAIT(); asm volatile("" ::: "memory");
}
__device__ __forceinline__ void p0_prologue(Frame& F) {
    LAS float* scr = (LAS float*)(F.lds + F.wave * 16384);
    const int gw = F.vcu * NWAVES + F.wave, NGW = F.G * NWAVES, lane = F.lane;
    constexpr int I_IN = (D / 64) * (NIN / 32), I_OUT = (D / 64) * (D / 32), I_Q = I_OUT, I_LRU = 32 * 8;
    constexpr int NITEMS = I_IN + I_OUT + I_Q + I_LRU;
    for (int it = gw; it < NITEMS; it += NGW) {
        int r = it;
        if (r < I_IN) { p0_transpose_item(F.A.in[2], D, NIN, F.WIN(), F.A.in[1], scr, r, lane); continue; } r -= I_IN;
        if (r < I_OUT) { p0_transpose_item(F.A.in[14], D, D, F.WOUT(), nullptr, scr, r, lane); continue; } r -= I_OUT;
        if (r < I_Q) { p0_transpose_item(F.A.in[16], D, D, F.WQ(), F.A.in[15], scr, r, lane); continue; } r -= I_Q;
        { const int mi = r >> 3, sub = r & 7, gate = mi >> 4, rest = mi & 15;
          const float* src = (gate ? F.A.in[7] : F.A.in[5]) + (size_t)rest * 16384;
          p0_transpose_item(src, 128, 128, F.LRUW() + (size_t)mi * 16384, nullptr, scr, sub, lane); }
    }
    const size_t gt = (size_t)gw * 64 + lane, NGT = (size_t)NGW * 64;
    {
        const float* g2 = F.A.in[15];
        f32x4 gg[8];
#pragma unroll
        for (int j = 0; j < 8; ++j) gg[j] = *(const GAS f32x4*)(g2 + j * 256 + lane * 4);
        for (int e = gw; e < NEXP; e += NGW) {
            const GAS f32x4* ur = (const GAS f32x4*)(F.A.in[18] + (size_t)e * D) + lane;
            f32x4 v[8]; float ss = 0.f;
#pragma unroll
            for (int j = 0; j < 8; ++j) { v[j] = __builtin_nontemporal_load(ur + 64 * j) * gg[j]; ss += (v[j].x * v[j].x + v[j].y * v[j].y) + (v[j].z * v[j].z + v[j].w * v[j].w); }
            const float rms = __builtin_amdgcn_sqrtf(wave_sum(ss) * (1.0f / D));
            const float sc = rms > 0.f ? 7.0f / (2.8f * rms) : 1.0f;
            GAS unsigned* o4 = (GAS unsigned*)(F.U8() + (size_t)e * 1024) + (lane >> 1);
#pragma unroll
            for (int j = 0; j < 8; ++j) {
                const int c0 = (int)fminf(fmaxf(__builtin_rintf(v[j].x * sc), -7.f), 7.f) & 15, c1 = (int)fminf(fmaxf(__builtin_rintf(v[j].y * sc), -7.f), 7.f) & 15;
                const int c2 = (int)fminf(fmaxf(__builtin_rintf(v[j].z * sc), -7.f), 7.f) & 15, c3 = (int)fminf(fmaxf(__builtin_rintf(v[j].w * sc), -7.f), 7.f) & 15;
                const unsigned cw = (unsigned)c0 | ((unsigned)c1 << 8) | ((unsigned)c2 << 16) | ((unsigned)c3 << 24);
                const unsigned pw = (unsigned)__shfl_xor((int)cw, 1);
                if ((lane & 1) == 0) __builtin_nontemporal_store(cw | (pw << 4), o4 + 32 * j);
            }
            if (lane == 0) F.USCALE()[e] = rms > 0.f ? 2.8f * rms * (1.0f / 7.0f) : 1.0f;
        }
    }
    __syncthreads();
    for (int un = blockIdx.x; un < NEXP / 64; un += F.G) {
        const int e0 = un * 64;
        for (int rr = 0; rr < 8; ++rr) {
            const int el = F.wave * 8 + rr, e = e0 + el;
            const GAS f32x4* vr = (const GAS f32x4*)(F.A.in[19] + (size_t)e * D) + lane;
            f32x4 v[8]; float mx = 0.f;
#pragma unroll
            for (int j = 0; j < 8; ++j) { v[j] = __builtin_nontemporal_load(vr + 64 * j); mx = fmaxf(mx, fmaxf(fmaxf(fabsf(v[j].x), fabsf(v[j].y)), fmaxf(fabsf(v[j].z), fabsf(v[j].w)))); }
#pragma unroll
            for (int o = 1; o < 64; o <<= 1) mx = fmaxf(mx, __shfl_xor(mx, o));
            const float sc = mx > 0.f ? 127.0f / mx : 1.0f;
#pragma unroll
            for (int j = 0; j < 8; ++j) *(LAS unsigned*)(F.lds + el * 2056 + j * 256 + lane * 4) = pack_i8x4(v[j].x * sc, v[j].y * sc, v[j].z * sc, v[j].w * sc);
            if (lane == 0) F.VSCALE()[e] = mx > 0.f ? mx * (1.0f / 127.0f) : 1.0f;
        }
        __syncthreads();
        for (int cc = 0; cc < 32; ++cc) { const int c = F.wave * 32 + cc;
            const v2u w = *(const LAS v2u*)(F.lds + lane * 2056 + c * 8);
            __builtin_nontemporal_store(w, (v2u*)(F.V8T() + ((size_t)c * NEXP + e0 + lane) * 8)); }
        __syncthreads();
    }
    for (size_t ch = gt; ch < (size_t)8 * 128 * 128 / 8; ch += NGT) {
        const size_t e0 = ch * 8;
        const f32x4 a = *(const GAS f32x4*)(F.A.in[12] + e0), b = *(const GAS f32x4*)(F.A.in[12] + e0 + 4);
        v4u o; o.x = pk2(a.x, a.y); o.y = pk2(a.z, a.w); o.z = pk2(b.x, b.y); o.w = pk2(b.z, b.w);
        *(GAS v4u*)(F.WSB() + e0) = o;
    }
    for (size_t ch = gt; ch < (size_t)16 * 128 * 128 / 8; ch += NGT) {
        const size_t e0 = ch * 8;
        const f32x4 a = *(const GAS f32x4*)(F.A.in[17] + e0), b = *(const GAS f32x4*)(F.A.in[17] + e0 + 4);
        v4u hi; hi.x = pk2(a.x, a.y); hi.y = pk2(a.z, a.w); hi.z = pk2(b.x, b.y); hi.w = pk2(b.z, b.w);
        *(GAS v4u*)(F.KH() + e0) = hi;
    }
    for (int m = gw; m < M; m += NGW) {
        const GAS f32x4* xr = (const GAS f32x4*)(F.A.in[0] + (size_t)m * D) + lane;
        f32x4 v[8]; float s = 0.f;
#pragma unroll
        for (int j = 0; j < 8; ++j) { v[j] = __builtin_nontemporal_load(xr + 64 * j); s += (v[j].x * v[j].x + v[j].y * v[j].y) + (v[j].z * v[j].z + v[j].w * v[j].w); }
        const float rstd = __builtin_amdgcn_rsqf(wave_sum(s) * (1.f / D) + 1e-6f);
        GAS unsigned long long* o8 = (GAS unsigned long long*)(F.XN() + (size_t)m * D) + lane;
#pragma unroll
        for (int j = 0; j < 8; ++j) o8[64 * j] = (unsigned long long)pk2(v[j].x * rstd, v[j].y * rstd) | ((unsigned long long)pk2(v[j].z * rstd, v[j].w * rstd) << 32);
    }
}
constexpr int LRU_XR = 0, LRU_XC = 33792, LRU_GR = 33792 + 40960;
constexpr float LOG2E = 1.4426950408889634f;
__device__ __forceinline__ int xc_off(int tok, int ch) { return tok * 320 + (tok >> 5) * 16 + ch * 2; }
template <bool APPLY, int DIR>
__device__ __forceinline__ void lru_dir(Frame& F, int unit, int b, int c, int h, const bf16x8 (&Ba)[4], const bf16x8 (&Bx)[4], float (&hsum)[8][4]) {
    const int lane = F.lane, w = F.wave, fr = lane & 15, fq = lane >> 4;
    LAS unsigned char* XC = F.lds + LRU_XC;
    const int chl = 16 * w + fr, chg = h * 128 + chl;
    v4u* au = (v4u*)F.AU() + ((size_t)((unit * 2 + DIR) * NWAVES + w) * 8) * 64 + lane;
    f32x4 R[8], I[8];
    float carry = 0.f;
    if (APPLY) {
        carry = F.CARRY()[(size_t)((b * 2 + DIR) * NCHUNK + c) * LW + chg];
        v4u q[8];
#pragma unroll
        for (int m = 0; m < 8; ++m) q[m] = __builtin_nontemporal_load(au + m * 64);
#pragma unroll
        for (int m = 0; m < 8; ++m) {
            R[m] = (f32x4){__builtin_amdgcn_exp2f(bf_lo(q[m].x)), __builtin_amdgcn_exp2f(bf_lo(q[m].y)), __builtin_amdgcn_exp2f(bf_lo(q[m].z)), __builtin_amdgcn_exp2f(bf_lo(q[m].w))};
            I[m] = (f32x4){bf_hi(q[m].x), bf_hi(q[m].y), bf_hi(q[m].z), bf_hi(q[m].w)}; }
    } else {
        const float ba = F.A.in[6][DIR * LW + chg], bx = F.A.in[8][DIR * LW + chg], lam = F.A.in[9][DIR * LW + chg];
        const float cl = -8.0f * log1pf(__expf(-lam)) * LOG2E;
        const int arow = (fr >> 2) * 32 + (fr & 3);
#pragma unroll
        for (int m = 0; m < 8; ++m) {
            R[m] = (f32x4){0.f, 0.f, 0.f, 0.f}; I[m] = (f32x4){0.f, 0.f, 0.f, 0.f};
#pragma unroll
            for (int ks = 0; ks < 4; ++ks) {
                const bf16x8 a = *(const LAS bf16x8*)(XC + xc_off(arow + 4 * m, 32 * ks + 8 * fq));
                R[m] = __builtin_amdgcn_mfma_f32_16x16x32_bf16(a, Ba[ks], R[m], 0, 0, 0);
                I[m] = __builtin_amdgcn_mfma_f32_16x16x32_bf16(a, Bx[ks], I[m], 0, 0, 0);
            }
        }
#pragma unroll
        for (int m = 0; m < 8; ++m) {
            float la[4];
#pragma unroll
            for (int j = 0; j < 4; ++j) {
                const float r = sigmoidf_(R[m][j] + ba), ig = sigmoidf_(I[m][j] + bx);
                la[j] = cl * r;
                const float a = __builtin_amdgcn_exp2f(la[j]);
                const float xc = bf1(*(const LAS unsigned short*)(XC + xc_off(32 * fq + 4 * m + j, chl)));
                R[m][j] = a; I[m][j] = __builtin_amdgcn_sqrtf(fmaxf(1.0f - a * a, 0.0f)) * (ig * xc);
            }
            __builtin_nontemporal_store((v4u){pk2(la[0], I[m][0]), pk2(la[1], I[m][1]), pk2(la[2], I[m][2]), pk2(la[3], I[m][3])}, au + m * 64);
        }
    }
    float P = 1.f, L = 0.f;
#pragma unroll
    for (int mm = 0; mm < 8; ++mm) {
        const int m = DIR == 0 ? mm : 7 - mm;
#pragma unroll
        for (int jj = 0; jj < 4; ++jj) {
            const int j = DIR == 0 ? jj : 3 - jj;
            const float a = R[m][j], u = I[m][j];
            L = a * L + u; P = a * P;
            R[m][j] = P; I[m][j] = L;
        }
    }
    const int src1 = DIR == 0 ? lane - 16 : lane + 16, src2 = DIR == 0 ? lane - 32 : lane + 32;
    const bool v1 = DIR == 0 ? (fq >= 1) : (fq <= 2), v2 = DIR == 0 ? (fq >= 2) : (fq <= 1);
    float A = P, B = L;
    { const float pa = __shfl(A, src1), pb = __shfl(B, src1); if (v1) { B = A * pb + B; A = A * pa; } }
    { const float pa = __shfl(A, src2), pb = __shfl(B, src2); if (v2) { B = A * pb + B; A = A * pa; } }
    if (APPLY) {
        float EA = __shfl(A, src1), EB = __shfl(B, src1); if (!v1) { EA = 1.f; EB = 0.f; }
        const float hin = EA * carry + EB;
#pragma unroll
        for (int m = 0; m < 8; ++m)
#pragma unroll
            for (int j = 0; j < 4; ++j) { const float hh = R[m][j] * hin + I[m][j]; if (DIR == 0) hsum[m][j] = hh; else hsum[m][j] += hh; }
    } else {
        const bool lastlane = DIR == 0 ? (fq == 3) : (fq == 0);
        if (lastlane) { f32x2* agg = (f32x2*)F.AGG() + (size_t)((b * 2 + DIR) * NCHUNK + c) * LW + chg; *agg = (f32x2){A, B}; }
    }
}

template <bool APPLY>
__device__ __forceinline__ void lru_unit(Frame& F, int unit) {
    const int h = unit & 7, c = (unit >> 3) & 63, b = unit >> 9;
    const int tid = F.tid, lane = F.lane, w = F.wave, fr = lane & 15, fq = lane >> 4;
    const size_t t0 = (size_t)b * SEQ + (size_t)c * CHUNK;
    LAS unsigned char* XR = F.lds + LRU_XR; LAS unsigned char* XC = F.lds + LRU_XC; LAS unsigned char* GR = F.lds + LRU_GR;
    bf16x8 Ba0[4], Bx0[4], Ba1[4], Bx1[4];
    if (!APPLY) {
        const bf16* wb = F.LRUW() + (size_t)h * 16384 + (size_t)(16 * w + fr) * 128 + 8 * fq;
#pragma unroll
        for (int ks = 0; ks < 4; ++ks) { Ba0[ks] = *(const GAS bf16x8*)(wb + 32 * ks); Ba1[ks] = *(const GAS bf16x8*)(wb + (size_t)8 * 16384 + 32 * ks);
            Bx0[ks] = *(const GAS bf16x8*)(wb + (size_t)16 * 16384 + 32 * ks); Bx1[ks] = *(const GAS bf16x8*)(wb + (size_t)24 * 16384 + 32 * ks); }
        for (int p = tid; p < 131 * 16; p += 512) { const int r = p >> 4, cg = p & 15; const int s = c * CHUNK - 2 + r; v4u v = (v4u){0u, 0u, 0u, 0u};
            if (s >= 0 && s < SEQ) v = *(const GAS v4u*)(F.Z() + ((size_t)b * SEQ + s) * NIN + h * 128 + cg * 8);
            *(LAS v4u*)(XR + r * 256 + cg * 16) = v; }
        __syncthreads();
        {
            const int ch2 = tid & 63, tg = tid >> 6, chg = h * 128 + 2 * ch2;
            float w0[4], w1[4];
#pragma unroll
            for (int k = 0; k < 4; ++k) { w0[k] = F.A.in[3][k * LW + chg]; w1[k] = F.A.in[3][k * LW + chg + 1]; }
            const float b0 = F.A.in[4][chg], b1 = F.A.in[4][chg + 1];
            float x0[4], x1[4];
#pragma unroll
            for (int k = 0; k < 3; ++k) { const unsigned u = *(const LAS unsigned*)(XR + (16 * tg + k) * 256 + ch2 * 4); x0[k] = bf_lo(u); x1[k] = bf_hi(u); }
#pragma unroll
            for (int j = 0; j < 16; ++j) {
                const unsigned u = *(const LAS unsigned*)(XR + (16 * tg + j + 3) * 256 + ch2 * 4); x0[3] = bf_lo(u); x1[3] = bf_hi(u);
                const float y0 = b0 + ((w0[0] * x0[0] + w0[1] * x0[1]) + (w0[2] * x0[2] + w0[3] * x0[3]));
                const float y1 = b1 + ((w1[0] * x1[0] + w1[1] * x1[1]) + (w1[2] * x1[2] + w1[3] * x1[3]));
                *(LAS unsigned*)(XC + xc_off(16 * tg + j, 2 * ch2)) = pk2(y0, y1);
                x0[0] = x0[1]; x0[1] = x0[2]; x0[2] = x0[3]; x1[0] = x1[1]; x1[1] = x1[2]; x1[2] = x1[3];
            }
        }
        __syncthreads();
    } else {
#pragma unroll
        for (int ks = 0; ks < 4; ++ks) { Ba0[ks] = Ba1[ks] = Bx0[ks] = Bx1[ks] = (bf16x8){0, 0, 0, 0, 0, 0, 0, 0}; }
        for (int p = tid; p < 128 * 32; p += 512) { const int r = p >> 5, cg = p & 31;
            *(LAS v2u*)(GR + r * 264 + cg * 8) = *(const GAS v2u*)(F.Z() + (t0 + r) * NIN + LW + h * 128 + cg * 4); }
    }
    float hsum[8][4];
    lru_dir<APPLY, 0>(F, unit, b, c, h, Ba0, Bx0, hsum);
    asm volatile("" ::: "memory"); __builtin_amdgcn_sched_barrier(0);
    lru_dir<APPLY, 1>(F, unit, b, c, h, Ba1, Bx1, hsum);
    if (APPLY) {
        const int chl = 16 * w + fr;
        __syncthreads();
#pragma unroll
        for (int m = 0; m < 8; ++m)
#pragma unroll
            for (int j = 0; j < 4; ++j) { LAS unsigned short* p = (LAS unsigned short*)(GR + (32 * fq + 4 * m + j) * 264 + chl * 2); *p = (unsigned short)f2bf(bf1(*p) * hsum[m][j]); }
        __syncthreads();
        for (int p = tid; p < 128 * 32; p += 512) { const int r = p >> 5, cg = p & 31;
            *(GAS v2u*)(F.MIX() + (t0 + r) * D + h * 128 + cg * 4) = *(const LAS v2u*)(GR + r * 264 + cg * 8); }
    }
    __syncthreads();
}
__device__ __forceinline__ void lru_carry(Frame& F) {
    const int idx = (F.vcu * NWAVES + F.wave) * 64 + F.lane;
    if (idx >= BATCH * 2 * LW) return;
    const int ch = idx & (LW - 1), bd = idx >> 10, dir = bd & 1;
    const f32x2* agg = (const f32x2*)F.AGG() + (size_t)bd * NCHUNK * LW + ch; float* cr = F.CARRY() + (size_t)bd * NCHUNK * LW + ch;
    float st = 0.f;
#pragma unroll 8
    for (int i = 0; i < NCHUNK; ++i) { const int cc = dir == 0 ? i : NCHUNK - 1 - i; const f32x2 pe = agg[(size_t)cc * LW]; cr[(size_t)cc * LW] = st; st = pe.x * st + pe.y; }
}
constexpr int GM_ST = 0, GM_BS = 1024, GM_VN = 2048, GM_GU = 2048 + 32768;
typedef short s16x4 __attribute__((ext_vector_type(4)));
__device__ __forceinline__ unsigned vn_off(unsigned row, unsigned ch) { return 256u * row + 16u * (ch ^ (((row & 3u) << 2) | ((row >> 2) & 3u))); }
__device__ __forceinline__ void gmlp_unit(Frame& F, int unit) {
    const int tid = F.tid, lane = F.lane, w = F.wave, fr = lane & 15, fq = lane >> 4;
    const size_t t0 = (size_t)unit * CHUNK;
    LAS float* ST = (LAS float*)(F.lds + GM_ST); LAS float* BS = (LAS float*)(F.lds + GM_BS);
    LAS unsigned char* VN = F.lds + GM_VN; LAS unsigned char* GU = F.lds + GM_GU;
    for (int rr = 0; rr < 16; ++rr) {
        const int row = 16 * w + rr;
        const bf16* p = F.Z() + (t0 + row) * NIN + 3 * LW + lane * 8;
        const v4u a = *(const GAS v4u*)p, b = *(const GAS v4u*)(p + 512);
        float x[16] = {bf_lo(a.x), bf_hi(a.x), bf_lo(a.y), bf_hi(a.y), bf_lo(a.z), bf_hi(a.z), bf_lo(a.w), bf_hi(a.w),
                       bf_lo(b.x), bf_hi(b.x), bf_lo(b.y), bf_hi(b.y), bf_lo(b.z), bf_hi(b.z), bf_lo(b.w), bf_hi(b.w)};
        float s = 0.f;
#pragma unroll
        for (int i = 0; i < 16; ++i) s += x[i];
        const float mean = wave_sum(s) * (1.0f / LW);
        float q = 0.f;
#pragma unroll
        for (int i = 0; i < 16; ++i) { const float d = x[i] - mean; q += d * d; }
        const float rstd = __builtin_amdgcn_rsqf(wave_sum(q) * (1.0f / LW) + 1e-6f);
        if (lane == 0) { ST[2 * row] = mean; ST[2 * row + 1] = rstd; }
    }
    __syncthreads();
    const unsigned trq = (unsigned)(lane & 15) >> 2, trp = (unsigned)lane & 3u;
    for (int h = 0; h < 8; ++h) {
#pragma unroll
        for (int i = 0; i < 4; ++i) { const int pid = tid + 512 * i, q = pid >> 4, cg = pid & 15;
            const v4u a = *(const GAS v4u*)(F.Z() + (t0 + q) * NIN + 3 * LW + h * 128 + cg * 8);
            const float mean = ST[2 * q], rstd = ST[2 * q + 1];
            const f32x4 g0 = *(const GAS f32x4*)(F.A.in[10] + h * 128 + cg * 8), g1 = *(const GAS f32x4*)(F.A.in[10] + h * 128 + cg * 8 + 4);
            const f32x4 b0 = *(const GAS f32x4*)(F.A.in[11] + h * 128 + cg * 8), b1 = *(const GAS f32x4*)(F.A.in[11] + h * 128 + cg * 8 + 4);
            v4u o;
            o.x = pk2((bf_lo(a.x) - mean) * rstd * g0.x + b0.x, (bf_hi(a.x) - mean) * rstd * g0.y + b0.y);
            o.y = pk2((bf_lo(a.y) - mean) * rstd * g0.z + b0.z, (bf_hi(a.y) - mean) * rstd * g0.w + b0.w);
            o.z = pk2((bf_lo(a.z) - mean) * rstd * g1.x + b1.x, (bf_hi(a.z) - mean) * rstd * g1.y + b1.y);
            o.w = pk2((bf_lo(a.w) - mean) * rstd * g1.z + b1.z, (bf_hi(a.w) - mean) * rstd * g1.w + b1.w);
            *(LAS v4u*)(VN + vn_off((unsigned)q, (unsigned)cg)) = o;
        }
#pragma unroll
        for (int i = 0; i < 8; ++i) { const int pid = tid + 512 * i, r = pid >> 5, cg = pid & 31;
            *(LAS v2u*)(GU + r * 264 + cg * 8) = *(const GAS v2u*)(F.Z() + (t0 + r) * NIN + 2 * LW + h * 128 + cg * 4); }
        if (tid < 128) BS[tid] = F.A.in[13][h * 128 + tid];
        bf16x8 Af[4];
        { const bf16* wsb = F.WSB() + (size_t)h * 16384 + (size_t)(16 * w + fr) * 128 + 8 * fq;
#pragma unroll
          for (int ks = 0; ks < 4; ++ks) Af[ks] = *(const GAS bf16x8*)(wsb + 32 * ks); }
        __syncthreads();
        f32x4 acc[8];
#pragma unroll
        for (int n = 0; n < 8; ++n) {
            acc[n] = (f32x4){0.f, 0.f, 0.f, 0.f};
#pragma unroll
            for (int ks = 0; ks < 4; ++ks) {
                const s16x4 b0 = __builtin_amdgcn_ds_read_tr16_b64_v4i16((LAS s16x4*)(VN + vn_off(32u * ks + 8u * fq + trq, 2u * n + (trp >> 1)) + 8u * (trp & 1u)));
                const s16x4 b1 = __builtin_amdgcn_ds_read_tr16_b64_v4i16((LAS s16x4*)(VN + vn_off(32u * ks + 8u * fq + 4u + trq, 2u * n + (trp >> 1)) + 8u * (trp & 1u)));
                const bf16x8 bb = (bf16x8){b0[0], b0[1], b0[2], b0[3], b1[0], b1[1], b1[2], b1[3]};
                acc[n] = __builtin_amdgcn_mfma_f32_16x16x32_bf16(Af[ks], bb, acc[n], 0, 0, 0);
            }
        }
#pragma unroll
        for (int n = 0; n < 8; ++n)
#pragma unroll
            for (int j = 0; j < 4; ++j) { const int p = 16 * w + 4 * fq + j; LAS unsigned short* ad = (LAS unsigned short*)(GU + p * 264 + (16 * n + fr) * 2);
                *ad = (unsigned short)f2bf(bf1(*ad) * (acc[n][j] + BS[p])); }
        __syncthreads();
#pragma unroll
        for (int i = 0; i < 8; ++i) { const int pid = tid + 512 * i, r = pid >> 5, cg = pid & 31;
            *(GAS v2u*)(F.MIX() + (t0 + r) * D + LW + h * 128 + cg * 4) = *(const LAS v2u*)(GU + r * 264 + cg * 8); }
        __syncthreads();
    }
}
typedef float f32x16 __attribute__((ext_vector_type(16)));
__device__ __forceinline__ unsigned fkey(float f) { const int u = __builtin_bit_cast(int, f); return (unsigned)(u ^ ((u >> 31) & 0x7fffffff)); }
__device__ __forceinline__ float fkey_inv(unsigned k) { const int u = (int)k; return __builtin_bit_cast(float, u ^ ((u >> 31) & 0x7fffffff)); }
__device__ __forceinline__ unsigned umax_(unsigned a, unsigned b) { return (int)a > (int)b ? a : b; }
__device__ __forceinline__ unsigned umin_(unsigned a, unsigned b) { return (int)a < (int)b ? a : b; }
#define CE_DESC(x, y) do { const unsigned a_ = (x), b_ = (y); (x) = umax_(a_, b_); (y) = umin_(a_, b_); } while (0)
__device__ __forceinline__ void sort16_desc(unsigned (&a)[16]) {
#pragma unroll
    for (int k = 2; k <= 16; k <<= 1)
#pragma unroll
        for (int j = k >> 1; j >= 1; j >>= 1)
#pragma unroll
            for (int i = 0; i < 16; ++i) { const int l = i ^ j; if (l > i) { if ((i & k) == 0) CE_DESC(a[i], a[l]); else CE_DESC(a[l], a[i]); } }
}
__device__ __forceinline__ void merge16_desc(unsigned (&a)[16], const unsigned (&b)[16]) {
#pragma unroll
    for (int i = 0; i < 16; ++i) a[i] = umax_(a[i], b[15 - i]);
#pragma unroll
    for (int j = 8; j >= 1; j >>= 1)
#pragma unroll
        for (int i = 0; i < 16; ++i) if ((i & j) == 0) CE_DESC(a[i], a[i + j]);
}
typedef short bf16x8s __attribute__((ext_vector_type(8)));
__device__ __forceinline__ void topk_unit(Frame& F, int wu) {
    const int tg = wu >> 3, hd = wu & 7, lane = F.lane, r = lane & 31, hh = lane >> 5;
    const int t = tg * 32 + r;
    const size_t qoff = (size_t)t * D + hd * 256 + 8 * hh;
    unsigned L[2][16];
    unsigned hh4 = (unsigned)hh << 2; asm volatile("" : "+v"(hh4));
#pragma unroll
    for (int p = 0; p < 2; ++p) {
        f32x16 acc[4];
#pragma unroll
        for (int nt = 0; nt < 4; ++nt)
#pragma unroll
            for (int i = 0; i < 16; ++i) acc[nt][i] = 0.f;
        const size_t koff = ((size_t)(hd * 2 + p) * 128 + r) * 128 + 8 * hh;
        const bf16* qp = F.QH() + qoff + p * 128; const bf16* kp0 = F.KH() + koff; const bf16* kp1 = kp0 + 32 * 128; const bf16* kp2 = kp0 + 64 * 128; const bf16* kp3 = kp0 + 96 * 128;
        asm volatile("" : "+v"(qp), "+v"(kp0), "+v"(kp1), "+v"(kp2), "+v"(kp3));
#define P6_LOAD(Q, K, ks0, n) _Pragma("unroll") for (int i_ = 0; i_ < (n); ++i_) { Q[i_] = *(const GAS bf16x8s*)(qp + 16 * ((ks0) + i_)); \
            K[i_][0] = *(const GAS bf16x8s*)(kp0 + 16 * ((ks0) + i_)); K[i_][1] = *(const GAS bf16x8s*)(kp1 + 16 * ((ks0) + i_)); \
            K[i_][2] = *(const GAS bf16x8s*)(kp2 + 16 * ((ks0) + i_)); K[i_][3] = *(const GAS bf16x8s*)(kp3 + 16 * ((ks0) + i_)); }
#define P6_MMA(Q, K, n) _Pragma("unroll") for (int i_ = 0; i_ < (n); ++i_) _Pragma("unroll") for (int nt = 0; nt < 4; ++nt) acc[nt] = __builtin_amdgcn_mfma_f32_32x32x16_bf16(K[i_][nt], Q[i_], acc[nt], 0, 0, 0);
        bf16x8s qa[3], ka[3][4], qb[3], kb[3][4];
        P6_LOAD(qa, ka, 0, 3); P6_LOAD(qb, kb, 3, 3);
        __builtin_amdgcn_sched_barrier(0);
        P6_MMA(qa, ka, 3);
        __builtin_amdgcn_sched_barrier(0);
        P6_LOAD(qa, ka, 6, 2);
        __builtin_amdgcn_sched_barrier(0);
        P6_MMA(qb, kb, 3);
        __builtin_amdgcn_sched_barrier(0);
        P6_MMA(qa, ka, 2);
        __builtin_amdgcn_sched_barrier(0);
#undef P6_LOAD
#undef P6_MMA
        unsigned S[4][16];
#pragma unroll
        for (int nt = 0; nt < 4; ++nt) {
#pragma unroll
            for (int rg = 0; rg < 16; ++rg) { const int nc = 32 * nt + (rg & 3) + 8 * (rg >> 2); S[nt][rg] = ((fkey(acc[nt][rg]) & ~0x7Fu) | (unsigned)(127 - nc)) ^ hh4; }
            sort16_desc(S[nt]);
        }
        merge16_desc(S[0], S[1]); merge16_desc(S[2], S[3]); merge16_desc(S[0], S[2]);
        unsigned T[16];
#pragma unroll
        for (int i = 0; i < 16; ++i) T[i] = (unsigned)__shfl_xor((int)S[0][i], 32);
        merge16_desc(S[0], T);
#pragma unroll
        for (int i = 0; i < 16; ++i) L[p][i] = S[0][i];
        __builtin_amdgcn_sched_barrier(0);
    }
    float v0[16], v1[16];
#pragma unroll
    for (int i = 0; i < 16; ++i) { v0[i] = fkey_inv(L[0][i] & ~0x7Fu); v1[i] = fkey_inv(L[1][i] & ~0x7Fu); }
    unsigned C[4][16];
    {
        int cnt = 0;
#pragma unroll
        for (int i = 0; i < 16; ++i)
#pragma unroll
            for (int j = 0; j < 16; ++j) if ((i + 1) * (j + 1) <= 16) { C[cnt >> 4][cnt & 15] = (fkey(v0[i] + v1[j]) & ~0xFFu) | (unsigned)(255 - (i * 16 + j)); ++cnt; }
#pragma unroll
        for (int q = 50; q < 64; ++q) C[q >> 4][q & 15] = 0x80000000u;
    }
    sort16_desc(C[0]); sort16_desc(C[1]); sort16_desc(C[2]); sort16_desc(C[3]);
    merge16_desc(C[0], C[1]); merge16_desc(C[2], C[3]); merge16_desc(C[0], C[2]);
    unsigned best[16];
#pragma unroll
    for (int i = 0; i < 16; ++i) best[i] = C[0][i];
    LAS unsigned* tab = (LAS unsigned*)(F.lds + F.wave * 8192) + lane;
#pragma unroll
    for (int i = 0; i < 16; ++i) { tab[i * 64] = 127u - (L[0][i] & 0x7Fu); tab[(16 + i) * 64] = 127u - (L[1][i] & 0x7Fu); }
    const float smax = fkey_inv(best[0] & ~0xFFu);
    float sv[8]; unsigned idv[8]; float ssum = 0.f;
#pragma unroll
    for (int k = 0; k < 8; ++k) {
        const unsigned bk = hh ? best[8 + k] : best[k];
        const unsigned pos = 255u - (bk & 0xFFu);
        idv[k] = tab[(pos >> 4) * 64] * 128u + tab[(16 + (pos & 15u)) * 64];
        sv[k] = __builtin_amdgcn_exp2f((fkey_inv(bk & ~0xFFu) - smax) * 1.4426950409f); ssum += sv[k];
    }
    ssum += __shfl_xor(ssum, 32);
    const float inv = 1.0f / ssum;
    {
        int* o = F.IDS() + (size_t)t * 128 + hd * 16 + 8 * hh; float* og = F.GATES() + (size_t)t * 128 + hd * 16 + 8 * hh;
        *(GAS v4u*)o = (v4u){idv[0], idv[1], idv[2], idv[3]}; *(GAS v4u*)(o + 4) = (v4u){idv[4], idv[5], idv[6], idv[7]};
        *(GAS f32x4*)og = (f32x4){sv[0] * inv, sv[1] * inv, sv[2] * inv, sv[3] * inv}; *(GAS f32x4*)(og + 4) = (f32x4){sv[4] * inv, sv[5] * inv, sv[6] * inv, sv[7] * inv};
    }
}
__device__ __forceinline__ void h8_row(Frame& F, int t) {
    const int lane = F.lane;
    float hx[32]; float mx = 0.f;
    const bf16* hp = F.HB() + (size_t)t * D + lane * 16;
#pragma unroll
    for (int c = 0; c < 2; ++c)
#pragma unroll
        for (int q = 0; q < 2; ++q) { const v4u a = *(const GAS v4u*)(hp + c * 1024 + q * 8); float* x = hx + c * 16 + q * 8;
            x[0] = bf_lo(a.x); x[1] = bf_hi(a.x); x[2] = bf_lo(a.y); x[3] = bf_hi(a.y); x[4] = bf_lo(a.z); x[5] = bf_hi(a.z); x[6] = bf_lo(a.w); x[7] = bf_hi(a.w); }
#pragma unroll
    for (int i = 0; i < 32; ++i) mx = fmaxf(mx, fabsf(hx[i]));
#pragma unroll
    for (int o = 1; o < 64; o <<= 1) mx = fmaxf(mx, __shfl_xor(mx, o));
    const float sc = mx > 0.f ? 119.0f / mx : 1.0f;
#pragma unroll
    for (int c = 0; c < 2; ++c) {
        unsigned hw[2], lw[2];
#pragma unroll
        for (int g8 = 0; g8 < 2; ++g8) { unsigned hacc = 0u, lacc = 0u;
#pragma unroll
            for (int i = 0; i < 8; ++i) { const int q = (int)__builtin_rintf(hx[c * 16 + g8 * 8 + i] * sc); const int lo = ((q + 8) & 15) - 8, hi = (q - lo) >> 4;
                const int sh = (i & 3) * 8 + (i >> 2) * 4; hacc |= (unsigned)(hi & 15) << sh; lacc |= (unsigned)(lo & 15) << sh; }
            hw[g8] = hacc; lw[g8] = lacc; }
        unsigned char* hb_ = F.H8() + (size_t)t * D + c * 512 + lane * 8;
        *(GAS v2u*)hb_ = (v2u){hw[0], hw[1]}; *(GAS v2u*)(hb_ + 1024) = (v2u){lw[0], lw[1]};
    }
    if (lane == 0) F.HSCALE()[t] = mx > 0.f ? mx * (1.0f / 119.0f) : 1.0f;
}
__device__ __forceinline__ int row_sum16(int v) {
    v += __builtin_amdgcn_update_dpp(0, v, 0x128, 0xf, 0xf, false);
    v += __builtin_amdgcn_update_dpp(0, v, 0x124, 0xf, 0xf, false);
    v += __builtin_amdgcn_update_dpp(0, v, 0x122, 0xf, 0xf, false);
    v += __builtin_amdgcn_update_dpp(0, v, 0x121, 0xf, 0xf, false);
    return v;
}
__device__ __forceinline__ void peer_u_xcd(Frame& F) {
    const int lane = F.lane, x = blockIdx.x & 7, jcu = blockIdx.x >> 3, ncu = ((int)F.G - x + 7) >> 3;
    const int tpc = (M + ncu - 1) / ncu, tpw = (tpc + NWAVES - 1) / NWAVES;
    const int tbase = jcu * tpc + F.wave * tpw;
    int nw = M - tbase; { const int lim = (jcu + 1) * tpc - tbase; nw = nw < lim ? nw : lim; nw = nw < tpw ? nw : tpw; nw = nw < 0 ? 0 : nw; }
    const int NV = nw;
    LAS unsigned char* wl = F.lds + F.wave * 13312;
    LAS int* lst = (LAS int*)wl; LAS int* res = (LAS int*)(wl + 512); LAS unsigned char* hsl = wl + 1024;
    const int q4 = lane >> 4, i16 = lane & 15;
    const unsigned char* ubase = F.U8() + (size_t)x * 2048 * 1024;
    const unsigned lanepart = (unsigned)i16 * 16u;
    int r_idlo = 0, r_idhi = 0, r_t = 0; v4u r_h0 = (v4u){0u, 0u, 0u, 0u}, r_h1 = (v4u){0u, 0u, 0u, 0u};
    int v_cl0 = 0, v_cl1 = 0, v_n = 0, v_r0 = 0, v_t = 0, v_slot = 0; unsigned long long v_mlo = 0, v_mhi = 0; bool v_live = false;
    int vset = 0, nvalid = 0, idle = 0;
    if (NV == 0) return;
#define U_RAW() do { const int vi_ = vset < NV ? vset : NV - 1; r_t = tbase + vi_; \
        r_idlo = F.IDS()[(size_t)r_t * 128 + lane]; r_idhi = F.IDS()[(size_t)r_t * 128 + 64 + lane]; \
        r_h0 = *(const GAS v4u*)(F.H8() + (size_t)r_t * D + lane * 16); r_h1 = *(const GAS v4u*)(F.H8() + (size_t)r_t * D + 1024 + lane * 16); } while (0)
#define U_NEXT() do { if (v_live && v_r0 + 16 < v_n) { v_r0 += 16; } else if (vset < NV) { const bool slo = (r_idlo >> 11) == x, shi = (r_idhi >> 11) == x; \
            v_mlo = __ballot(slo); v_mhi = __ballot(shi); const int nlo = __popcll(v_mlo); v_n = nlo + __popcll(v_mhi); \
            const int plo = __builtin_amdgcn_mbcnt_hi((unsigned)(v_mlo >> 32), __builtin_amdgcn_mbcnt_lo((unsigned)v_mlo, 0)); \
            const int phi = nlo + __builtin_amdgcn_mbcnt_hi((unsigned)(v_mhi >> 32), __builtin_amdgcn_mbcnt_lo((unsigned)v_mhi, 0)); \
            if (slo) lst[plo] = (r_idlo & 2047) | (lane << 16); if (shi) lst[phi] = (r_idhi & 2047) | ((64 + lane) << 16); \
            v_slot = nvalid % 6; ++nvalid; { LAS unsigned char* sp_ = hsl + v_slot * 2048; *(LAS v4u*)(sp_ + lane * 16) = r_h0; *(LAS v4u*)(sp_ + 1024 + lane * 16) = r_h1; } \
            v_cl0 = lst[lane]; v_cl1 = lst[64 + lane]; v_t = r_t; v_r0 = 0; ++vset; v_live = true; } \
        else { v_live = false; v_n = 0; v_r0 = 0; v_mlo = 0; v_mhi = 0; ++idle; } } while (0)
#define U_ISSUE(BUF, DS) do { { const int rem_ = v_n - v_r0; DS##_cnt = rem_ < 0 ? 0 : (rem_ < 16 ? rem_ : 16); } \
        DS##_slot = v_slot; DS##_t = v_t; DS##_mlo = v_mlo; DS##_mhi = v_mhi; DS##_last = v_live && (v_r0 + 16 >= v_n); \
        _Pragma("unroll") for (int gp = 0; gp < 4; ++gp) { const int ix_ = v_r0 + 4 * gp + q4; const int a_ = __shfl(v_cl0, ix_ & 63), b_ = __shfl(v_cl1, ix_ & 63); DS##_ent[gp] = ix_ < 64 ? a_ : b_; \
            const unsigned of_ = (4 * gp + q4 < DS##_cnt ? ((unsigned)(DS##_ent[gp] & 2047) << 10) : 0u) + lanepart; \
            _Pragma("unroll") for (int c = 0; c < 4; ++c) BUF[4 * gp + c] = *(const GAS v4u*)(ubase + of_ + c * 256); } } while (0)
#define U_COMPUTE(BUF, DS) do { const LAS unsigned char* sp_ = hsl + DS##_slot * 2048; const LAS v4u* hp_ = (const LAS v4u*)(sp_ + i16 * 16); \
        _Pragma("unroll") for (int gp = 0; gp < 4; ++gp) if (4 * gp < DS##_cnt) { int ah_ = 0, al_ = 0; \
            _Pragma("unroll") for (int c = 0; c < 4; ++c) { const v4u r_ = BUF[4 * gp + c]; const v4u hh_ = hp_[c * 16], hl_ = hp_[64 + c * 16]; \
                ah_ = __builtin_amdgcn_sdot8((int)r_.x, (int)hh_.x, ah_, false); al_ = __builtin_amdgcn_sdot8((int)r_.x, (int)hl_.x, al_, false); \
                ah_ = __builtin_amdgcn_sdot8((int)r_.y, (int)hh_.y, ah_, false); al_ = __builtin_amdgcn_sdot8((int)r_.y, (int)hl_.y, al_, false); \
                ah_ = __builtin_amdgcn_sdot8((int)r_.z, (int)hh_.z, ah_, false); al_ = __builtin_amdgcn_sdot8((int)r_.z, (int)hl_.z, al_, false); \
                ah_ = __builtin_amdgcn_sdot8((int)r_.w, (int)hh_.w, ah_, false); al_ = __builtin_amdgcn_sdot8((int)r_.w, (int)hl_.w, al_, false); } \
            const int a_ = row_sum16((ah_ << 4) + al_); if (i16 == 0 && 4 * gp + q4 < DS##_cnt) res[DS##_ent[gp] >> 16] = a_; } \
        if (DS##_last) { int* po_ = F.PART() + (size_t)DS##_t * 128; \
            if ((DS##_mlo >> lane) & 1ull) po_[lane] = res[lane]; if ((DS##_mhi >> lane) & 1ull) po_[64 + lane] = res[64 + lane]; } } while (0)
    v4u bufA[16], bufB[16], bufC[16];
    int dA_cnt = 0, dA_ent[4] = {0, 0, 0, 0}, dA_t = 0, dA_slot = 0; unsigned long long dA_mlo = 0, dA_mhi = 0; bool dA_last = false;
    int dB_cnt = 0, dB_ent[4] = {0, 0, 0, 0}, dB_t = 0, dB_slot = 0; unsigned long long dB_mlo = 0, dB_mhi = 0; bool dB_last = false;
    int dC_cnt = 0, dC_ent[4] = {0, 0, 0, 0}, dC_t = 0, dC_slot = 0; unsigned long long dC_mlo = 0, dC_mhi = 0; bool dC_last = false;
    U_RAW();
    U_NEXT(); U_RAW(); U_ISSUE(bufA, dA);
    U_NEXT(); U_RAW(); U_ISSUE(bufB, dB);
    while (idle < 3) {
        U_NEXT(); U_RAW(); U_ISSUE(bufC, dC); U_COMPUTE(bufA, dA);
        U_NEXT(); U_RAW(); U_ISSUE(bufA, dA); U_COMPUTE(bufB, dB);
        U_NEXT(); U_RAW(); U_ISSUE(bufB, dB); U_COMPUTE(bufC, dC);
    }
#undef U_RAW
#undef U_NEXT
#undef U_ISSUE
#undef U_COMPUTE
}
__device__ __forceinline__ void peer_act_token(Frame& F, int t) {
    const int lane = F.lane;
    LAS unsigned char* wl = F.lds + F.wave * 4096;
    LAS float* abuf = (LAS float*)wl; LAS int* ibuf = (LAS int*)(wl + 512); LAS int* cnt = (LAS int*)(wl + 1024);
    LAS int* ovf = (LAS int*)(wl + 1280); LAS int* fre = (LAS int*)(wl + 1792); LAS int* sop = (LAS int*)(wl + 2304);
#define WFENCE() asm volatile("s_waitcnt lgkmcnt(0)" ::: "memory")
    const float sc = __builtin_amdgcn_rsqf(F.ROWSS()[t] * (1.0f / D) + 1e-6f) * F.HSCALE()[t];
    if (lane < 34) cnt[lane] = 0;
    float am = 0.f; float actv[2]; int idv[2], slotv[2];
    const int l32 = t & 31;
#pragma unroll
    for (int half = 0; half < 2; ++half) {
        const size_t o = (size_t)t * 128 + half * 64 + lane;
        const int e = F.IDS()[o]; const float g = F.GATES()[o];
        const int dsum = F.PART()[o];
        actv[half] = gelu_tanh((float)dsum * sc * F.USCALE()[e]) * g * F.VSCALE()[e]; idv[half] = e; am = fmaxf(am, fabsf(actv[half]));
    }
    WFENCE();
#pragma unroll
    for (int half = 0; half < 2; ++half) {
        const int r = idv[half] & 31;
        const int j = __hip_atomic_fetch_add(cnt + r, 1, __ATOMIC_RELAXED, __HIP_MEMORY_SCOPE_WORKGROUP);
        if (j < 4) slotv[half] = ((r - l32) & 31) + 32 * j;
        else { const int q = __hip_atomic_fetch_add(cnt + 32, 1, __ATOMIC_RELAXED, __HIP_MEMORY_SCOPE_WORKGROUP); ovf[q] = half * 64 + lane; slotv[half] = -1; }
    }
    WFENCE();
    if (lane < 32) { const int n = cnt[lane];
        for (int j = n; j < 4; ++j) { const int q = __hip_atomic_fetch_add(cnt + 33, 1, __ATOMIC_RELAXED, __HIP_MEMORY_SCOPE_WORKGROUP); fre[q] = ((lane - l32) & 31) + 32 * j; } }
    WFENCE();
    const int nov = cnt[32];
#pragma unroll
    for (int half = 0; half < 2; ++half) { const int i = half * 64 + lane; if (i < nov) sop[ovf[i]] = fre[i]; }
    WFENCE();
#pragma unroll
    for (int half = 0; half < 2; ++half) { if (slotv[half] < 0) slotv[half] = sop[half * 64 + lane]; abuf[slotv[half]] = actv[half]; ibuf[slotv[half]] = idv[half]; }
    WFENCE();
#pragma unroll
    for (int o = 1; o < 64; o <<= 1) am = fmaxf(am, __shfl_xor(am, o));
    const float asc = am > 0.f ? 127.0f / am : 1.0f;
    if (lane == 0) F.ASCALE()[t] = am > 0.f ? am * (1.0f / 127.0f) : 1.0f;
    if (lane < 32) {
        const f32x4 av = *(const LAS f32x4*)(abuf + 4 * lane); const v4u iv = *(const LAS v4u*)(ibuf + 4 * lane);
        const size_t o = ((size_t)(t >> 6) * 32 + lane) * 64 + (t & 63);
        F.IDW()[o] = (v4u){iv.x << 3, iv.y << 3, iv.z << 3, iv.w << 3};
        F.AW()[o] = pack_i8x4(av.x * asc, av.y * asc, av.z * asc, av.w * asc);
    }
    WFENCE();
#undef WFENCE
}
__device__ __forceinline__ void tr4x4(const unsigned r0, const unsigned r1, const unsigned r2, const unsigned r3, unsigned (&c)[4]) {
    const unsigned t01l = __builtin_amdgcn_perm(r1, r0, 0x05010400u), t01h = __builtin_amdgcn_perm(r1, r0, 0x07030602u);
    const unsigned t23l = __builtin_amdgcn_perm(r3, r2, 0x05010400u), t23h = __builtin_amdgcn_perm(r3, r2, 0x07030602u);
    c[0] = __builtin_amdgcn_perm(t23l, t01l, 0x05040100u); c[1] = __builtin_amdgcn_perm(t23l, t01l, 0x07060302u);
    c[2] = __builtin_amdgcn_perm(t23h, t01h, 0x05040100u); c[3] = __builtin_amdgcn_perm(t23h, t01h, 0x07060302u);
}
template <int MODE>
__device__ __forceinline__ void peer_v_slice(Frame& F, int c, bool do_atomic) {
    const int tid = F.tid, lane = F.lane;
    for (int i = tid; i < NEXP * 8 / 16; i += 512) *(LAS v4u*)(F.lds + i * 16) = *(const GAS v4u*)(F.V8T() + (size_t)c * NEXP * 8 + (size_t)i * 16);
    __syncthreads();
    const v4u* ibase = F.IDW() + lane; const unsigned* abase = F.AW() + lane;
    constexpr int NBLK = M / 64, PD = 16;
    v4u iq[PD]; unsigned aq[PD]; v2u rw[2][4];
    {
        const size_t o = (size_t)F.wave * 32 * 64;
#pragma unroll
        for (int j = 0; j < PD; ++j) { iq[j] = *(const GAS v4u*)(ibase + o + j * 64); aq[j] = abase[o + j * 64]; }
    }
#define LROW(dst, q) do { dst[0] = *(const LAS v2u*)(F.lds + (q).x); dst[1] = *(const LAS v2u*)(F.lds + (q).y); \
                          dst[2] = *(const LAS v2u*)(F.lds + (q).z); dst[3] = *(const LAS v2u*)(F.lds + (q).w); } while (0)
    for (int blk = F.wave; blk < NBLK; blk += NWAVES) {
        const int t = blk * 64 + lane;
        const size_t o = (size_t)blk * 32 * 64;
        const int nblk = (blk + NWAVES < NBLK) ? blk + NWAVES : blk;
        const size_t on = (size_t)nblk * 32 * 64;
        int acc[8];
#pragma unroll
        for (int i = 0; i < 8; ++i) acc[i] = 0;
        LROW(rw[0], iq[0]);
#pragma unroll
        for (int j = 0; j < 32; ++j) {
            if (j + 1 < 32) LROW(rw[(j + 1) & 1], iq[(j + 1) % PD]);
            const unsigned aw = aq[j % PD];
            unsigned cl[4], ch[4];
            tr4x4(rw[j & 1][0].x, rw[j & 1][1].x, rw[j & 1][2].x, rw[j & 1][3].x, cl);
            tr4x4(rw[j & 1][0].y, rw[j & 1][1].y, rw[j & 1][2].y, rw[j & 1][3].y, ch);
#pragma unroll
            for (int i = 0; i < 4; ++i) { acc[i] = __builtin_amdgcn_sdot4((int)aw, (int)cl[i], acc[i], false); acc[4 + i] = __builtin_amdgcn_sdot4((int)aw, (int)ch[i], acc[4 + i], false); }
            { const size_t oo = (j + PD < 32) ? o + (size_t)(j + PD) * 64 : on + (size_t)(j + PD - 32) * 64;
              iq[j % PD] = *(const GAS v4u*)(ibase + oo); aq[j % PD] = abase[oo]; }
            __builtin_amdgcn_sched_barrier(0);
        }
        const float asc = F.ASCALE()[t];
        float accf[8];
#pragma unroll
        for (int i = 0; i < 8; ++i) accf[i] = (float)acc[i] * asc;
        const v4u hb = *(const GAS v4u*)(F.HBT() + ((size_t)c * M + t) * 8);
        accf[0] += bf_lo(hb.x); accf[1] += bf_hi(hb.x); accf[2] += bf_lo(hb.y); accf[3] += bf_hi(hb.y);
        accf[4] += bf_lo(hb.z); accf[5] += bf_hi(hb.z); accf[6] += bf_lo(hb.w); accf[7] += bf_hi(hb.w);
        bf16* yp = (MODE == 0) ? F.Y() + ((size_t)c * M + t) * 8 : (bf16*)F.XN() + ((((size_t)c * M + t) * 8) & (size_t)0x1ffffff);
        *(GAS v4u*)yp = (v4u){pk2(accf[0], accf[1]), pk2(accf[2], accf[3]), pk2(accf[4], accf[5]), pk2(accf[6], accf[7])};
        float ss = 0.f;
#pragma unroll
        for (int i = 0; i < 8; ++i) ss += accf[i] * accf[i];
        if (do_atomic) atomicAdd(F.ROWSS2() + t, ss);
    }
#undef LROW
    __syncthreads();
}
__device__ __forceinline__ void final_unit(Frame& F, int unit) {
    const int tid = F.tid, blk = unit >> 3, cg = unit & 7, t0 = blk * 64;
    LAS float* T = (LAS float*)F.lds;
#pragma unroll
    for (int i = 0; i < 4; ++i) { const int pid = tid + 512 * i, cl = pid >> 6, tok = pid & 63;
        const v4u v = *(const GAS v4u*)(F.Y() + ((size_t)(cg * 32 + cl) * M + t0 + tok) * 8);
        *(LAS f32x4*)(T + tok * 260 + cl * 8) = (f32x4){bf_lo(v.x), bf_hi(v.x), bf_lo(v.y), bf_hi(v.y)};
        *(LAS f32x4*)(T + tok * 260 + cl * 8 + 4) = (f32x4){bf_lo(v.z), bf_hi(v.z), bf_lo(v.w), bf_hi(v.w)}; }
    __syncthreads();
#pragma unroll
    for (int i = 0; i < 8; ++i) { const int pid = tid + 512 * i, tok = pid >> 6, c4 = pid & 63;
        const float rs = __builtin_amdgcn_rsqf(F.ROWSS2()[t0 + tok] * (1.0f / D) + 1e-6f);
        const f32x4 v = *(const LAS f32x4*)(T + tok * 260 + c4 * 4);
        const f32x4 g = *(const GAS f32x4*)(F.A.in[20] + cg * 256 + c4 * 4);
        *(GAS f32x4*)(F.A.out + (size_t)(t0 + tok) * D + cg * 256 + c4 * 4) = v * rs * g; }
    __syncthreads();
}
__global__ void __launch_bounds__(NWAVES * 64, 2) mk_fwd(Args args) {
    __shared__ __attribute__((aligned(16))) unsigned char lds[LDS_BYTES];
    Frame F(args);
    F.lds = (LAS unsigned char*)lds;
    F.MISC = (volatile LAS unsigned*)(F.lds + MISC_OFF);
    F.tid = threadIdx.x; F.lane = F.tid & 63; F.wave = __builtin_amdgcn_readfirstlane(F.tid >> 6);
    F.G = gridDim.x; { const int bx = blockIdx.x; F.vcu = (F.G % 8 == 0) ? (bx % 8) * (F.G / 8) + bx / 8 : bx; }
    F.ws = args.ws;
    F.ctl = (gu32*)(args.ws + WS_CTL);
    for (int u = F.tid; u < (LDS_BYTES - LDSCTL_OFF) / 4; u += NWAVES * 64) ((LAS unsigned*)(F.lds + LDSCTL_OFF))[u] = 0u;
    __syncthreads();
    XcdBarrier bar; bar.bar = (unsigned*)(F.ctl + CW_BAR); bar.x = 0; bar.st = nullptr;
    if (N_LAUNCHES != PER_PHASE) bar = xcd_barrier_post((unsigned*)(F.ctl + CW_BAR), F.MISC + 8);
#define GRID_BAR() do { if (N_LAUNCHES != PER_PHASE) xcd_barrier(bar); } while (0)
    const int lo = args.ph_lo, hi = args.ph_hi;
#ifndef MK_PHASE_MASK
#define MK_PHASE_MASK 0x7FF
#endif
#define IN(k) (((MK_PHASE_MASK >> (k)) & 1) && lo <= (k) && (k) < hi)
#undef MK_PHASE_MASK
#define MK_PHASE_MASK 0xFFFF
#define BOTH(k) (true)
#ifndef MK_REP_MASK
#define MK_REP_MASK 0
#endif
#ifndef MK_REP_N
#define MK_REP_N 2
#endif
#define REPS(k) for (int rep_ = 0; rep_ < ((((MK_REP_MASK) >> (k)) & 1) ? 1 + MK_REP_N : 1); ++rep_)
    const int gw = F.vcu * NWAVES + F.wave, NGW = F.G * NWAVES;
    if (IN(0)) { REPS(0) { p0_prologue(F); __syncthreads(); } if (BOTH(0)) GRID_BAR(); }
    if (IN(1)) {
        pg8::Gemm g{F.XN(), F.WIN(), M, NIN, D}; pg8::StaticOrder S; S.init(M, NIN, F.G, (int)blockIdx.x);
        pg8::EpiZ E{F.Z(), NIN, LW};
        REPS(1) pg8::gemm_phase<pg8::EpiZ, pg8::StaticOrder, true, true>(F.lds, g, S, E);
        if (BOTH(1)) GRID_BAR();
    }
    if (IN(2)) {
        REPS(12) for (int u = blockIdx.x; u < BATCH * NCHUNK * 8; u += F.G) lru_unit<false>(F, u);
        if (BOTH(2)) GRID_BAR();
    }
    if (IN(3)) {
        lru_carry(F);
        REPS(13) for (int u = blockIdx.x; u < BATCH * NCHUNK; u += F.G) gmlp_unit(F, u);
        if (BOTH(3)) GRID_BAR();
    }
    if (IN(11)) {
        REPS(3) for (int u = blockIdx.x; u < BATCH * NCHUNK * 8; u += F.G) lru_unit<true>(F, u);
        GRID_BAR();
    }
    if (IN(4)) {
        pg8::Gemm g{F.MIX(), F.WOUT(), M, D, D}; pg8::StaticOrder S; S.init(M, D, F.G, (int)blockIdx.x);
        pg8::EpiH E{F.HB(), F.HBT(), F.A.in[0], F.ROWSS(), D, M};
        pg8::gemm_phase<pg8::EpiH, pg8::StaticOrder, true, true>(F.lds, g, S, E);
        if (BOTH(4)) GRID_BAR();
    }
    if (IN(5)) {
        pg8::Gemm g{F.HB(), F.WQ(), M, D, D}; pg8::StaticOrder S; S.init(M, D, F.G, (int)blockIdx.x);
        pg8::EpiQ E{F.QH(), F.ROWSS(), D};
        REPS(5) pg8::gemm_phase<pg8::EpiQ, pg8::StaticOrder, true, true>(F.lds, g, S, E);
        if (BOTH(5)) GRID_BAR();
    }
    if (IN(6)) {
        REPS(6) { for (int wu = gw; wu < (M / 32) * 8; wu += NGW) topk_unit(F, wu);
                  for (int t = gw; t < M; t += NGW) h8_row(F, t); }
        if (BOTH(6)) GRID_BAR();
    }
    if (IN(7)) {
        REPS(7) peer_u_xcd(F);
        if (BOTH(7)) GRID_BAR();
    }
    if (IN(8)) {
        REPS(8) for (int t = gw; t < M; t += NGW) peer_act_token(F, t);
        if (BOTH(8)) GRID_BAR();
    }
    if (IN(9)) {
        for (int c = blockIdx.x; c < D / 8; c += F.G) peer_v_slice<0>(F, c, true);
        if ((MK_REP_MASK >> 9) & 1) { for (int rep_ = 0; rep_ < MK_REP_N; ++rep_) for (int c = blockIdx.x; c < D / 8; c += F.G) peer_v_slice<1>(F, c, false); }
        if (BOTH(9)) GRID_BAR();
    }
    if (IN(10)) {
        REPS(10) for (int u = blockIdx.x; u < (M / 64) * 8; u += F.G) final_unit(F, u);
    }
#undef IN
#undef BOTH
#undef GRID_BAR
}

extern "C" void kernel_launch(void* const* d_in, const int* in_sizes, int n_in, void* d_out, int out_size, void* d_ws, size_t ws_size, hipStream_t stream) {
    static int grid = 0;
    if (grid == 0) {
        if (n_in != 21 || in_sizes[0] != M * D || out_size != M * D || ws_size < WS_END) { fprintf(stderr, "kernel_launch: unexpected shapes (n_in %d, in0 %d, out %d, ws %zu)\n", n_in, n_in > 0 ? in_sizes[0] : -1, out_size, ws_size); grid = -1; return; }
        int dev = 0, cus = 0, per_cu = 0;
        if (hipGetDevice(&dev) != hipSuccess || hipDeviceGetAttribute(&cus, hipDeviceAttributeMultiprocessorCount, dev) != hipSuccess) { grid = -1; return; }
        if (hipOccupancyMaxActiveBlocksPerMultiprocessor(&per_cu, (const void*)mk_fwd, NWAVES * 64, 0) != hipSuccess || per_cu < 1) { fprintf(stderr, "kernel_launch: occupancy query reports %d blocks per CU\n", per_cu); }
        (void)hipGetLastError();
        grid = cus;
    }
    if (grid < 0) return;
    (void)hipMemsetAsync((char*)d_ws + WS_CTL, 0, CTL_ZERO_BYTES, stream);
    Args a{};
    for (int i = 0; i < 21; ++i) a.in[i] = (const float*)d_in[i];
    a.out = (float*)d_out; a.ws = (unsigned char*)d_ws;
    for (int li = 0; li < N_LAUNCHES; ++li) {
        a.ph_lo = 0; a.ph_hi = 99;
        hipLaunchKernelGGL(mk_fwd, dim3(grid), dim3(NWAVES * 64), 0, stream, a);
    }
}
```

```cpp
#include <hip/hip_runtime.h>
#include <cstdio>
#include <cstdint>
namespace pg8 {
#define PG8_LAS __attribute__((address_space(3)))
typedef unsigned short bf16_t;
typedef short bf16x8 __attribute__((ext_vector_type(8)));
typedef float f32x4 __attribute__((ext_vector_type(4)));
typedef unsigned u32x4 __attribute__((ext_vector_type(4)));
constexpr int BM = 256, BK = 64, HALF = 128, HTB = HALF * BK * 2  , STAGE_BYTES = 8 * HTB, NXCD = 8, WGM = 8;

__host__ __device__ __forceinline__ int lds_byte(int r, int c) { const int st = (r >> 4) * 2 + (c >> 5), rr = r & 15, cc = c & 31, ob = rr * 64 + cc * 2; return st * 1024 + (ob ^ (((ob >> 9) & 1) << 5)); }
__host__ __device__ __forceinline__ void stage_rc(int b, int& R, int& C) { const int st = b / 1024, sb = b % 1024, swz = sb ^ (((sb >> 9) & 1) << 5); R = (st >> 1) * 16 + swz / 64; C = (st & 1) * 32 + (swz % 64) / 2; }
__host__ __device__ __forceinline__ int perm32(int rho) { const int n = rho >> 4, i = rho & 15; return 8 * (i >> 2) + 4 * n + (i & 3); }

struct Unit { int pm, pn; };
struct Gemm { const bf16_t* A; const bf16_t* Bt; int M, N, K; };

struct StaticOrder {
    int nM, nN, nwg, G, c;
    __host__ __device__ void init(int M, int N, int G_, int c_) { nM = M / BM; nN = N / BM; nwg = nM * nN; G = G_; c = c_; }
    __host__ __device__ bool next(int i, Unit& u) const {
        const long L = (long)i * G + c; if (L >= nwg) return false;
        int wgid = (int)L; { const int q = nwg / NXCD, r = nwg % NXCD, xcd = wgid % NXCD, off = wgid / NXCD; wgid = (xcd < r ? xcd * (q + 1) : r * (q + 1) + (xcd - r) * q) + off; }
        const int nig = WGM * nN, gid = wgid / nig, fm = gid * WGM, gsz = (nM - fm) < WGM ? (nM - fm) : WGM;
        u.pm = fm + ((wgid % nig) % gsz); u.pn = (wgid % nig) / gsz; return true;
    }
    __device__ __forceinline__ void a_ready(const Unit&) const {}
    __device__ __forceinline__ void done(const Unit&) const {}
};

__device__ __forceinline__ unsigned cvt_pk_bf16(float lo, float hi) { unsigned r; asm volatile("v_cvt_pk_bf16_f32 %0, %1, %2" : "=v"(r) : "v"(lo), "v"(hi)); return r; }
__device__ __forceinline__ float gelu_tanh(float x) {
    const float t = x * (1.0f + 0.044715f * x * x);
    const float e = __builtin_amdgcn_exp2f(-2.3022081983f * t);
    return x * __builtin_amdgcn_rcpf(1.0f + e);
}
struct EpiZ {
    static constexpr bool PERM = true, AFTER_DRAIN = false;
    bf16_t* O; int ldc; int gelu_from;
    __device__ __forceinline__ void operator()(const f32x4 (&acc)[2][2][4][2], const Unit& u, int wr, int wc, int fr, int fq) const {
        const int row0 = u.pm * BM + wr * 64 + fr; const int col0 = u.pn * BM + wc * 32 + 8 * fq;
        const bool act = (u.pn * BM) >= gelu_from;
#pragma unroll
        for (int ai = 0; ai < 2; ++ai)
#pragma unroll
            for (int m = 0; m < 4; ++m) { bf16_t* rowp = O + (size_t)(row0 + ai * HALF + m * 16) * ldc + col0;
#pragma unroll
                for (int bj = 0; bj < 2; ++bj) { f32x4 v0 = acc[ai][bj][m][0], v1 = acc[ai][bj][m][1];
                    if (act) {
#pragma unroll
                        for (int j = 0; j < 4; ++j) { v0[j] = gelu_tanh(v0[j]); v1[j] = gelu_tanh(v1[j]); } }
                    u32x4 w; w.x = cvt_pk_bf16(v0[0], v0[1]); w.y = cvt_pk_bf16(v0[2], v0[3]); w.z = cvt_pk_bf16(v1[0], v1[1]); w.w = cvt_pk_bf16(v1[2], v1[3]);
                    *(u32x4*)(rowp + bj * HALF) = w; } }
    }
};
struct EpiH {
    static constexpr bool PERM = true, AFTER_DRAIN = false;
    bf16_t* O; bf16_t* OT; const float* X; float* rowss; int ldc; int mrows;
    __device__ __forceinline__ void operator()(const f32x4 (&acc)[2][2][4][2], const Unit& u, int wr, int wc, int fr, int fq) const {
        const int row0 = u.pm * BM + wr * 64 + fr; const int col0 = u.pn * BM + wc * 32 + 8 * fq;
#pragma unroll
        for (int ai = 0; ai < 2; ++ai)
#pragma unroll
            for (int m = 0; m < 4; ++m) { const int row = row0 + ai * HALF + m * 16; const size_t off = (size_t)row * ldc + col0; float ss = 0.f;
#pragma unroll
                for (int bj = 0; bj < 2; ++bj) {
                    const f32x4 x0 = *(const f32x4*)(X + off + bj * HALF), x1 = *(const f32x4*)(X + off + bj * HALF + 4);
                    const f32x4 v0 = acc[ai][bj][m][0] + x0, v1 = acc[ai][bj][m][1] + x1;
                    ss += (v0[0] * v0[0] + v0[1] * v0[1]) + (v0[2] * v0[2] + v0[3] * v0[3]) + (v1[0] * v1[0] + v1[1] * v1[1]) + (v1[2] * v1[2] + v1[3] * v1[3]);
                    u32x4 w; w.x = cvt_pk_bf16(v0[0], v0[1]); w.y = cvt_pk_bf16(v0[2], v0[3]); w.z = cvt_pk_bf16(v1[0], v1[1]); w.w = cvt_pk_bf16(v1[2], v1[3]);
                    *(u32x4*)(O + off + bj * HALF) = w;
                    *(u32x4*)(OT + ((size_t)((col0 + bj * HALF) >> 3) * mrows + row) * 8) = w; }
                ss += __shfl_xor(ss, 16); ss += __shfl_xor(ss, 32);
                if (fq == 0) atomicAdd(rowss + row, ss); }
    }
};
struct EpiQ {
    static constexpr bool PERM = true, AFTER_DRAIN = false;
    bf16_t* QH; const float* rowss; int ldc;
    __device__ __forceinline__ void operator()(const f32x4 (&acc)[2][2][4][2], const Unit& u, int wr, int wc, int fr, int fq) const {
        const int row0 = u.pm * BM + wr * 64 + fr, col0 = u.pn * BM + wc * 32 + 8 * fq;
#pragma unroll
        for (int ai = 0; ai < 2; ++ai)
#pragma unroll
            for (int m = 0; m < 4; ++m) { const int row = row0 + ai * HALF + m * 16; const float rs = __builtin_amdgcn_rsqf(rowss[row] * (1.0f / 2048.0f) + 1e-6f);
                const size_t off = (size_t)row * ldc + col0;
#pragma unroll
                for (int bj = 0; bj < 2; ++bj) { const f32x4 v0 = acc[ai][bj][m][0] * rs, v1 = acc[ai][bj][m][1] * rs;
                    u32x4 wh; wh.x = cvt_pk_bf16(v0[0], v0[1]); wh.y = cvt_pk_bf16(v0[2], v0[3]); wh.z = cvt_pk_bf16(v1[0], v1[1]); wh.w = cvt_pk_bf16(v1[2], v1[3]);
                    *(u32x4*)(QH + off + bj * HALF) = wh; } }
    }
};
template <class Epi, class Sched, bool ALIGN_EPI = false, bool SP2 = false>
__device__ __forceinline__ void gemm_phase(PG8_LAS unsigned char* lds, const Gemm g, const Sched& S, const Epi& E) {
    const int tid = threadIdx.x, wid = __builtin_amdgcn_readfirstlane(tid >> 6), lane = tid & 63, wr = wid >> 2, wc = wid & 3, fr = lane & 15, fq = lane >> 4;
    const int K = g.K, nt = K / BK;
    unsigned voffA[2], voffB[2];
#pragma unroll
    for (int i = 0; i < 2; ++i) { int R, C; stage_rc(tid * 16 + i * 8192, R, C); const int Rb = Epi::PERM ? ((R & ~31) + perm32(R & 31)) : R;
        voffA[i] = (unsigned)(R * K + C) * 2u; voffB[i] = (unsigned)(Rb * K + C) * 2u; }
    const size_t kstep = (size_t)(BK * 2);
    const size_t hstep = (size_t)HALF * K * 2;
    const size_t tstep = 2 * hstep;
    const unsigned ldsw = (unsigned)wid * 1024u;
    const int aoff = lds_byte(wr * 64 + fr, fq * 8), boff = lds_byte(wc * 32 + fr, fq * 8);
#define PG8_SA(b, h) (((b) * 2 + (h)) * HTB)
#define PG8_SB(b, h) ((4 + (b) * 2 + (h)) * HTB)
#define PG8_STAGE(bufoff, gbase, voff) do { _Pragma("unroll") for (int _i = 0; _i < 2; ++_i) \
        __builtin_amdgcn_global_load_lds((const unsigned*)((const char*)(gbase) + (voff)[_i]), (PG8_LAS unsigned*)(lds + (bufoff) + ldsw + _i * 8192), 16, 0, 0); } while (0)
#define PG8_LDA(dst, b, h) do { _Pragma("unroll") for (int m = 0; m < 4; ++m) _Pragma("unroll") for (int k = 0; k < 2; ++k) dst[m][k] = *(const PG8_LAS bf16x8*)(lds + PG8_SA(b, h) + aoff + m * 2048 + k * 1024); } while (0)
#define PG8_LDB(dst, b, h) do { _Pragma("unroll") for (int n = 0; n < 2; ++n) _Pragma("unroll") for (int k = 0; k < 2; ++k) dst[n][k] = *(const PG8_LAS bf16x8*)(lds + PG8_SB(b, h) + boff + n * 2048 + k * 1024); } while (0)
#define PG8_MMA(ai, bj, At, Bt) do { __builtin_amdgcn_s_setprio(1); _Pragma("unroll") for (int m = 0; m < 4; ++m) _Pragma("unroll") for (int n = 0; n < 2; ++n) _Pragma("unroll") for (int k = 0; k < 2; ++k) \
        acc[ai][bj][m][n] = __builtin_amdgcn_mfma_f32_16x16x32_bf16(Bt[n][k], At[m][k], acc[ai][bj][m][n], 0, 0, 0); __builtin_amdgcn_s_setprio(0); } while (0)
#define PG8_WAIT_V(n) asm volatile("s_waitcnt vmcnt(" #n ")" ::: "memory")
#define PG8_WAIT_L(n) asm volatile("s_waitcnt lgkmcnt(" #n ")" ::: "memory")
#define PG8_BAR __builtin_amdgcn_s_barrier()
#define PG8_SCHED __builtin_amdgcn_sched_barrier(0)
    Unit cur, nxt; int ui = 0;
    if (!S.next(0, cur)) return;
    f32x4 acc[2][2][4][2];
#pragma unroll
    for (int a = 0; a < 2; ++a)
#pragma unroll
        for (int b = 0; b < 2; ++b)
#pragma unroll
            for (int m = 0; m < 4; ++m)
#pragma unroll
                for (int n = 0; n < 2; ++n) acc[a][b][m][n] = (f32x4){0.f, 0.f, 0.f, 0.f};
    bf16x8 At[4][2], B0[2][2], B1[2][2];
    const char* cA = (const char*)g.A + (size_t)cur.pm * tstep; const char* cB = (const char*)g.Bt + (size_t)cur.pn * tstep;
    S.a_ready(cur);
    if constexpr (SP2) {
        PG8_STAGE(PG8_SB(0, 0), cB, voffB); PG8_STAGE(PG8_SB(0, 1), cB + hstep, voffB); PG8_STAGE(PG8_SA(0, 0), cA, voffA); PG8_STAGE(PG8_SA(0, 1), cA + hstep, voffA);
        if (wr == 1) PG8_BAR;
        PG8_WAIT_V(2); PG8_BAR;
        PG8_STAGE(PG8_SB(1, 0), cB + kstep, voffB); PG8_STAGE(PG8_SA(1, 0), cA + kstep, voffA); PG8_STAGE(PG8_SB(1, 1), cB + hstep + kstep, voffB);
        PG8_WAIT_V(6); PG8_BAR;
    } else {
        PG8_STAGE(PG8_SB(0, 0), cB, voffB); PG8_STAGE(PG8_SA(0, 0), cA, voffA); PG8_STAGE(PG8_SB(0, 1), cB + hstep, voffB); PG8_STAGE(PG8_SA(0, 1), cA + hstep, voffA);
        if (wr == 1) PG8_BAR;
        PG8_WAIT_V(4); PG8_BAR;
        PG8_STAGE(PG8_SB(1, 0), cB + kstep, voffB); PG8_STAGE(PG8_SA(1, 0), cA + kstep, voffA); PG8_STAGE(PG8_SB(1, 1), cB + hstep + kstep, voffB);
        PG8_WAIT_V(6); PG8_BAR;
    }
    for (;;) {
        const bool has_next = S.next(ui + 1, nxt);
        const char* nA = has_next ? (const char*)g.A + (size_t)nxt.pm * tstep : cA; const char* nB = has_next ? (const char*)g.Bt + (size_t)nxt.pn * tstep : cB;
        for (int t = 0; t < nt; t += 2) {
            const bool last = (t == nt - 2);
            const char* a1 = cA + (size_t)(t + 1) * kstep;
            const char* a2 = last ? nA : cA + (size_t)(t + 2) * kstep; const char* b2 = last ? nB : cB + (size_t)(t + 2) * kstep;
            const char* a3 = a2 + kstep; const char* b3 = b2 + kstep;
            if (last && has_next) S.a_ready(nxt);
            if constexpr (SP2) {
            PG8_LDB(B0, 0, 0); PG8_LDB(B1, 0, 1); PG8_SCHED; PG8_LDA(At, 0, 0); PG8_STAGE(PG8_SA(1, 1), a1 + hstep, voffA);
            PG8_WAIT_V(8); PG8_WAIT_L(0); PG8_BAR; PG8_MMA(0, 0, At, B0); PG8_MMA(0, 1, At, B1); PG8_BAR; PG8_SCHED;
            PG8_LDA(At, 0, 1); PG8_STAGE(PG8_SB(0, 0), b2, voffB); PG8_STAGE(PG8_SB(0, 1), b2 + hstep, voffB); PG8_STAGE(PG8_SA(0, 0), a2, voffA);
            PG8_WAIT_V(8); PG8_WAIT_L(0); PG8_BAR; PG8_MMA(1, 0, At, B0); PG8_MMA(1, 1, At, B1); PG8_BAR; PG8_SCHED;
            PG8_LDB(B0, 1, 0); PG8_LDB(B1, 1, 1); PG8_SCHED; PG8_LDA(At, 1, 0); PG8_STAGE(PG8_SA(0, 1), a2 + hstep, voffA);
            PG8_WAIT_V(8); PG8_WAIT_L(0); PG8_BAR; PG8_MMA(0, 0, At, B0); PG8_MMA(0, 1, At, B1); PG8_BAR; PG8_SCHED;
            PG8_LDA(At, 1, 1); PG8_STAGE(PG8_SB(1, 0), b3, voffB); PG8_STAGE(PG8_SB(1, 1), b3 + hstep, voffB); PG8_STAGE(PG8_SA(1, 0), a3, voffA);
            PG8_WAIT_V(8); PG8_WAIT_L(0); PG8_BAR; PG8_MMA(1, 0, At, B0); PG8_MMA(1, 1, At, B1); PG8_BAR; PG8_SCHED;
            } else {
            PG8_LDB(B0, 0, 0); PG8_SCHED; PG8_LDA(At, 0, 0); PG8_STAGE(PG8_SA(1, 1), a1 + hstep, voffA);
            PG8_WAIT_L(8); PG8_BAR; PG8_WAIT_L(0); PG8_MMA(0, 0, At, B0); PG8_BAR; PG8_SCHED;
            PG8_LDB(B1, 0, 1); PG8_STAGE(PG8_SB(0, 0), b2, voffB);
            PG8_BAR; PG8_WAIT_L(0); PG8_MMA(0, 1, At, B1); PG8_BAR;
            PG8_LDA(At, 0, 1); PG8_STAGE(PG8_SA(0, 0), a2, voffA);
            PG8_BAR; PG8_WAIT_L(0); PG8_MMA(1, 0, At, B0); PG8_BAR; PG8_SCHED;
            PG8_STAGE(PG8_SB(0, 1), b2 + hstep, voffB);
            PG8_WAIT_V(6); PG8_BAR; PG8_MMA(1, 1, At, B1); PG8_BAR;
            PG8_LDB(B0, 1, 0); PG8_SCHED; PG8_LDA(At, 1, 0); PG8_STAGE(PG8_SA(0, 1), a2 + hstep, voffA);
            PG8_WAIT_L(8); PG8_BAR; PG8_WAIT_L(0); PG8_MMA(0, 0, At, B0); PG8_BAR; PG8_SCHED;
            PG8_LDB(B1, 1, 1); PG8_STAGE(PG8_SB(1, 0), b3, voffB);
            PG8_BAR; PG8_WAIT_L(0); PG8_MMA(0, 1, At, B1); PG8_BAR;
            PG8_LDA(At, 1, 1); PG8_STAGE(PG8_SA(1, 0), a3, voffA);
            PG8_BAR; PG8_WAIT_L(0); PG8_MMA(1, 0, At, B0); PG8_BAR; PG8_SCHED;
            PG8_STAGE(PG8_SB(1, 1), b3 + hstep, voffB);
            PG8_WAIT_V(6); PG8_BAR; PG8_MMA(1, 1, At, B1); PG8_BAR;
            }
        }
        if constexpr (ALIGN_EPI) { if (wr == 0) PG8_BAR; }
        if constexpr (!Epi::AFTER_DRAIN) { E(acc, cur, wr, wc, fr, fq); S.done(cur); }
        if (!has_next) break;
#pragma unroll
        for (int a = 0; a < 2; ++a)
#pragma unroll
            for (int b = 0; b < 2; ++b)
#pragma unroll
                for (int m = 0; m < 4; ++m)
#pragma unroll
                    for (int n = 0; n < 2; ++n) acc[a][b][m][n] = (f32x4){0.f, 0.f, 0.f, 0.f};
        cur = nxt; cA = nA; cB = nB; ++ui;
        if constexpr (ALIGN_EPI) { if (wr == 1) PG8_BAR; }
    }
    PG8_WAIT_V(0);
    if constexpr (!ALIGN_EPI) { if (wr == 0) PG8_BAR; }
    PG8_BAR;
    if constexpr (Epi::AFTER_DRAIN) { E.fused(acc, cur, wr, wc, fr, fq, lds, wid, lane); S.done(cur); }
#undef PG8_SA
#undef PG8_SB
#undef PG8_STAGE
#undef PG8_LDA
#undef PG8_LDB
#undef PG8_MMA
#undef PG8_WAIT_V
#undef PG8_WAIT_L
#undef PG8_BAR
#undef PG8_SCHED
}
}
constexpr int NWAVES = 8;
constexpr int BATCH = 4, SEQ = 8192, D = 2048, M = BATCH * SEQ, NIN = 4096, LW = 1024, CHUNK = 128, NCHUNK = SEQ / CHUNK;
constexpr int NEXP = 16384;
#ifndef MK_N_LAUNCHES
#define MK_N_LAUNCHES 1
#endif
constexpr int N_LAUNCHES = MK_N_LAUNCHES;
constexpr int PER_PHASE = 11;
constexpr size_t MiB = 1u << 20;
constexpr size_t WS_CTL = 48 * MiB, CTL_ZERO_BYTES = 5 * MiB;
constexpr size_t WS_ROWSS = WS_CTL + 512 * 1024;
constexpr size_t WS_WIN = 2 * MiB, WS_WOUT = 18 * MiB, WS_WQ = 26 * MiB, WS_LRUW = 34 * MiB, WS_WSB = 35 * MiB, WS_AGG = 49 * MiB;
constexpr size_t WS_U = 64 * MiB, WS_V = 128 * MiB, WS_XN = 192 * MiB  , WS_Z = 320 * MiB  ;
constexpr size_t WS_HB = 576 * MiB, WS_IDS = 704 * MiB, WS_GATES = 720 * MiB, WS_PAIRS = 736 * MiB, WS_HBT = 752 * MiB, WS_END = 884 * MiB;
constexpr size_t WS_USCALE = 40 * MiB, WS_VSCALE = 41 * MiB;
constexpr size_t WS_HSCALE = 44 * MiB, WS_CARRY = 45 * MiB;
constexpr size_t WS_H8 = WS_XN, WS_PART = WS_XN + 64 * MiB;
constexpr size_t WS_ASCALE = 42 * MiB, WS_KH = 43 * MiB;
constexpr size_t WS_IDW = WS_PAIRS, WS_AW = 880 * MiB;
constexpr size_t WS_ROWSS2 = WS_CTL + 640 * 1024;
constexpr size_t WS_Y = WS_Z;
constexpr int CW_BAR = 4096;
constexpr int CW_LRUF = 8192;
constexpr int RING_BYTES = 131072;
constexpr int LDSCTL_OFF = 143360, MISC_OFF = LDSCTL_OFF + 320;
constexpr int LDS_BYTES = 147456;
#define GAS __attribute__((address_space(1)))
#define LAS __attribute__((address_space(3)))
typedef unsigned short bf16;
typedef unsigned v4u __attribute__((ext_vector_type(4)));
typedef float f32x4 __attribute__((ext_vector_type(4)));
typedef short bf16x8 __attribute__((ext_vector_type(8)));
typedef GAS unsigned gu32;
typedef GAS unsigned long long gu64;
#define RLX_AGENT __ATOMIC_RELAXED, __HIP_MEMORY_SCOPE_AGENT
#define LDS_WAIT() asm volatile("s_waitcnt lgkmcnt(0)" ::: "memory")
#define VM_WAIT() asm volatile("s_waitcnt vmcnt(0)" ::: "memory")
__device__ __forceinline__ unsigned long long rt() { return __builtin_amdgcn_s_memrealtime(); }
__device__ __forceinline__ unsigned f2bf(float f) { unsigned u = __builtin_bit_cast(unsigned, f); return (u + 0x7fffu + ((u >> 16) & 1u)) >> 16; }
__device__ __forceinline__ unsigned pk2(float lo, float hi) { return f2bf(lo) | (f2bf(hi) << 16); }

#define XB_TMO      128
#define XB_XCNT(j)  (256  + 64 * (j))
#define XB_XSUB(j)  (1280 + 64 * (j))
#define XB_XGEN(j)  (2304 + 64 * (j))
#define XB_TOP      3328
#define XB_TOPGEN   3392
#define XCD_BAR_WORDS 3456
#define XB_SPIN_CAP (1u << 18)

__device__ __forceinline__ unsigned xb_ld(unsigned* p)              { return __hip_atomic_load(p, __ATOMIC_RELAXED, __HIP_MEMORY_SCOPE_AGENT); }
__device__ __forceinline__ unsigned xb_add(unsigned* p, unsigned v) { return __hip_atomic_fetch_add(p, v, __ATOMIC_RELAXED, __HIP_MEMORY_SCOPE_AGENT); }
__device__ __forceinline__ unsigned xb_xcc_id() { return (unsigned)__builtin_amdgcn_s_getreg((3 << 11) | 20) & 0xFu; }
#define XB_SPIN(cond, bar) do { unsigned _sp = 0; while (cond) { __builtin_amdgcn_s_sleep(1); \
    if ((++_sp & 255u) == 0u) { if (xb_ld(&(bar)[XB_TMO])) break; if (_sp > XB_SPIN_CAP) { atomicAdd(&(bar)[XB_TMO], 1u); break; } } } } while (0)

struct XcdBarrier {
    unsigned* bar; unsigned x;
    volatile LAS unsigned* st;
};

__device__ __forceinline__ XcdBarrier xcd_barrier_post(unsigned* bar, volatile LAS unsigned* st) {
    XcdBarrier b; b.bar = bar; b.x = xb_xcc_id(); b.st = st;
    if (threadIdx.x == 0) (void)xb_add(&bar[XB_XCNT(b.x)], 1u);
    return b;
}
__device__ __forceinline__ void xcd_barrier_complete(unsigned* bar, unsigned x, unsigned& nloc, unsigned& nx) {
    const unsigned G = gridDim.x * gridDim.y * gridDim.z;
    unsigned sum, cnt, mine, sp = 0u;
    for (;;) {
        sum = 0u; cnt = 0u; mine = 0u;
#pragma unroll
        for (unsigned j = 0; j < 16; ++j) { const unsigned c = xb_ld(&bar[XB_XCNT(j)]); sum += c; cnt += (c > 0u) ? 1u : 0u; mine = (j == x) ? c : mine; }
        if (sum == G) break;
        __builtin_amdgcn_s_sleep(1);
        if ((++sp & 255u) == 0u) { if (xb_ld(&bar[XB_TMO])) break; if (sp > XB_SPIN_CAP) { atomicAdd(&bar[XB_TMO], 1u); break; } }
    }
    nloc = mine > 0u ? mine : 1u; nx = cnt > 0u ? cnt : 1u;
}

__device__ __forceinline__ void xcd_barrier(const XcdBarrier& b) {
    asm volatile("s_waitcnt vmcnt(0)" ::: "memory");
    __syncthreads();
    if (threadIdx.x == 0) {
        unsigned* bar = b.bar;
        __builtin_amdgcn_s_waitcnt(0);
        unsigned nloc = b.st[0], nx = b.st[1];
        if (nloc == 0u) { xcd_barrier_complete(bar, b.x, nloc, nx); b.st[0] = nloc; b.st[1] = nx; }
        const unsigned old = xb_add(&bar[XB_XSUB(b.x)], 1u);
        const unsigned gen = old / nloc;
        if (old + 1u == (gen + 1u) * nloc) {
            __builtin_amdgcn_fence(__ATOMIC_RELEASE, "agent");
            asm volatile("s_waitcnt vmcnt(0)" ::: "memory");
            const unsigned og = xb_add(&bar[XB_TOP], 1u);
            const unsigned tg = og / nx;
            if (og + 1u == (tg + 1u) * nx) xb_add(&bar[XB_TOPGEN], 1u);
            else XB_SPIN(xb_ld(&bar[XB_TOPGEN]) == tg, bar);
            __builtin_amdgcn_fence(__ATOMIC_ACQUIRE, "agent");
            xb_add(&bar[XB_XGEN(b.x)], 1u);
            asm volatile("s_waitcnt vmcnt(0)" ::: "memory");
        } else {
            XB_SPIN(xb_ld(&bar[XB_XGEN(b.x)]) == gen, bar);
            __builtin_amdgcn_fence(__ATOMIC_ACQUIRE, "agent");
            asm volatile("s_waitcnt vmcnt(0)" ::: "memory");
        }
    }
    __syncthreads();
}
typedef unsigned v2u __attribute__((ext_vector_type(2)));
typedef float f32x2 __attribute__((ext_vector_type(2)));
struct Args { const float* in[21]; float* out; unsigned char* ws; int ph_lo, ph_hi; };
struct Frame {
    const Args& A;
    LAS unsigned char* lds;
    volatile LAS unsigned* MISC;
    gu32* ctl;
    unsigned char* ws;
    int tid, lane, wave, vcu, G;
    __device__ __forceinline__ Frame(const Args& a) : A(a) {}
#define WSP(name, type, off) __device__ __forceinline__ type* name() const { return (type*)(ws + (off)); }
    WSP(WIN, bf16, WS_WIN) WSP(WOUT, bf16, WS_WOUT) WSP(WQ, bf16, WS_WQ) WSP(LRUW, bf16, WS_LRUW) WSP(WSB, bf16, WS_WSB)
    WSP(XN, bf16, WS_XN) WSP(MIX, bf16, WS_XN) WSP(Z, bf16, WS_Z) WSP(HB, bf16, WS_HB) WSP(HBT, bf16, WS_HBT)
    WSP(U8, unsigned char, WS_U) WSP(V8T, unsigned char, WS_V)
    WSP(ROWSS, float, WS_ROWSS) WSP(ROWSS2, float, WS_ROWSS2) WSP(QH, bf16, WS_Z) WSP(QL, bf16, WS_Z + 128 * MiB) WSP(KH, bf16, WS_KH) WSP(KL, bf16, WS_KH + 512 * 1024) WSP(AGG, float, WS_AGG) WSP(CARRY, float, WS_CARRY) WSP(AU, unsigned, WS_HB) WSP(GATES, float, WS_GATES)
    WSP(USCALE, float, WS_USCALE) WSP(VSCALE, float, WS_VSCALE) WSP(Y, bf16, WS_Y) WSP(IDS, int, WS_IDS) WSP(ASCALE, float, WS_ASCALE) WSP(IDW, v4u, WS_IDW) WSP(AW, unsigned, WS_AW) WSP(H8, unsigned char, WS_H8) WSP(HSCALE, float, WS_HSCALE) WSP(PART, int, WS_PART)
#undef WSP
};
__device__ __forceinline__ float wave_sum(float v) {
#pragma unroll
    for (int o = 1; o < 64; o <<= 1) v += __shfl_xor(v, o);
    return v;
}
__device__ __forceinline__ float bf_lo(unsigned w) { return __builtin_bit_cast(float, w << 16); }
__device__ __forceinline__ float bf_hi(unsigned w) { return __builtin_bit_cast(float, w & 0xffff0000u); }
__device__ __forceinline__ float bf1(unsigned short h) { return __builtin_bit_cast(float, (unsigned)h << 16); }
__device__ __forceinline__ float sigmoidf_(float x) { return __builtin_amdgcn_rcpf(1.0f + __builtin_amdgcn_exp2f(-1.4426950409f * x)); }
using pg8::gelu_tanh;
__device__ __forceinline__ unsigned pack_i8x4(float a, float b, float c, float d) {
    const int ia = (int)__builtin_rintf(a), ib = (int)__builtin_rintf(b), ic = (int)__builtin_rintf(c), id = (int)__builtin_rintf(d);
    return (unsigned)(ia & 0xff) | ((unsigned)(ib & 0xff) << 8) | ((unsigned)(ic & 0xff) << 16) | ((unsigned)id << 24);
}

__device__ __forceinline__ void p0_transpose_item(const float* W, int K, int N, bf16* WT, const float* kscale, LAS float* scr, int item, int lane) {
    const int nblk = N / 32, kb = item / nblk, nb = item % nblk, k0 = 64 * kb, n0 = 32 * nb;
#pragma unroll 8
    for (int i = 0; i < 32; ++i) { const int kk = 2 * i + (lane >> 5); const float sc = kscale ? kscale[k0 + kk] : 1.0f; scr[kk * 33 + (lane & 31)] = W[(size_t)(k0 + kk) * N + n0 + (lane & 31)] * sc; }
    LDS_WAIT(); asm volatile("" ::: "memory");
    const int c = lane & 7;
#pragma unroll
    for (int j = 0; j < 4; ++j) { const int n = (lane >> 3) + 8 * j; const LAS float* s = scr + (8 * c) * 33 + n;
        v4u o; o.x = pk2(s[0 * 33], s[1 * 33]); o.y = pk2(s[2 * 33], s[3 * 33]); o.z = pk2(s[4 * 33], s[5 * 33]); o.w = pk2(s[6 * 33], s[7 * 33]);
        *(GAS v4u*)(WT + (size_t)(n0 + n) * K + k0 + 8 * c) = o; }
    LDS_WAIT(); asm volatile("" ::: "memory");
}
__device__ __forceinline__ void p0_prologue(Frame& F) {
    LAS float* scr = (LAS float*)(F.lds + F.wave * 16384);
    const int gw = F.vcu * NWAVES + F.wave, NGW = F.G * NWAVES, lane = F.lane;
    constexpr int I_IN = (D / 64) * (NIN / 32), I_OUT = (D / 64) * (D / 32), I_Q = I_OUT, I_LRU = 32 * 8;
    constexpr int NITEMS = I_IN + I_OUT + I_Q + I_LRU;
    for (int it = gw; it < NITEMS; it += NGW) {
        int r = it;
        if (r < I_IN) { p0_transpose_item(F.A.in[2], D, NIN, F.WIN(), F.A.in[1], scr, r, lane); continue; } r -= I_IN;
        if (r < I_OUT) { p0_transpose_item(F.A.in[14], D, D, F.WOUT(), nullptr, scr, r, lane); continue; } r -= I_OUT;
        if (r < I_Q) { p0_transpose_item(F.A.in[16], D, D, F.WQ(), F.A.in[15], scr, r, lane); continue; } r -= I_Q;
        { const int mi = r >> 3, sub = r & 7, gate = mi >> 4, rest = mi & 15;
          const float* src = (gate ? F.A.in[7] : F.A.in[5]) + (size_t)rest * 16384;
          p0_transpose_item(src, 128, 128, F.LRUW() + (size_t)mi * 16384, nullptr, scr, sub, lane); }
    }
    const size_t gt = (size_t)gw * 64 + lane, NGT = (size_t)NGW * 64;
    {
        const float* g2 = F.A.in[15];
        f32x4 gg[8];
#pragma unroll
        for (int j = 0; j < 8; ++j) gg[j] = *(const GAS f32x4*)(g2 + j * 256 + lane * 4);
        for (int e = gw; e < NEXP; e += NGW) {
            const GAS f32x4* ur = (const GAS f32x4*)(F.A.in[18] + (size_t)e * D) + lane;
            f32x4 v[8]; float ss = 0.f;
#pragma unroll
            for (int j = 0; j < 8; ++j) { v[j] = __builtin_nontemporal_load(ur + 64 * j) * gg[j]; ss += (v[j].x * v[j].x + v[j].y * v[j].y) + (v[j].z * v[j].z + v[j].w * v[j].w); }
            const float rms = __builtin_amdgcn_sqrtf(wave_sum(ss) * (1.0f / D));
            const float sc = rms > 0.f ? 7.0f / (2.8f * rms) : 1.0f;
            GAS unsigned* o4 = (GAS unsigned*)(F.U8() + (size_t)e * 1024) + (lane >> 1);
#pragma unroll
            for (int j = 0; j < 8; ++j) {
                const int c0 = (int)fminf(fmaxf(__builtin_rintf(v[j].x * sc), -7.f), 7.f) & 15, c1 = (int)fminf(fmaxf(__builtin_rintf(v[j].y * sc), -7.f), 7.f) & 15;
                const int c2 = (int)fminf(fmaxf(__builtin_rintf(v[j].z * sc), -7.f), 7.f) & 15, c3 = (int)fminf(fmaxf(__builtin_rintf(v[j].w * sc), -7.f), 7.f) & 15;
                const unsigned cw = (unsigned)c0 | ((unsigned)c1 << 8) | ((unsigned)c2 << 16) | ((unsigned)c3 << 24);
                const unsigned pw = (unsigned)__shfl_xor((int)cw, 1);
                if ((lane & 1) == 0) __builtin_nontemporal_store(cw | (pw << 4), o4 + 32 * j);
            }
            if (lane == 0) F.USCALE()[e] = rms > 0.f ? 2.8f * rms * (1.0f / 7.0f) : 1.0f;
        }
    }
    __syncthreads();
    for (int un = blockIdx.x; un < NEXP / 64; un += F.G) {
        const int e0 = un * 64;
        for (int rr = 0; rr < 8; ++rr) {
            const int el = F.wave * 8 + rr, e = e0 + el;
            const GAS f32x4* vr = (const GAS f32x4*)(F.A.in[19] + (size_t)e * D) + lane;
            f32x4 v[8]; float mx = 0.f;
#pragma unroll
            for (int j = 0; j < 8; ++j) { v[j] = __builtin_nontemporal_load(vr + 64 * j); mx = fmaxf(mx, fmaxf(fmaxf(fabsf(v[j].x), fabsf(v[j].y)), fmaxf(fabsf(v[j].z), fabsf(v[j].w)))); }
#pragma unroll
            for (int o = 1; o < 64; o <<= 1) mx = fmaxf(mx, __shfl_xor(mx, o));
            const float sc = mx > 0.f ? 127.0f / mx : 1.0f;
#pragma unroll
            for (int j = 0; j < 8; ++j) *(LAS unsigned*)(F.lds + el * 2056 + j * 256 + lane * 4) = pack_i8x4(v[j].x * sc, v[j].y * sc, v[j].z * sc, v[j].w * sc);
            if (lane == 0) F.VSCALE()[e] = mx > 0.f ? mx * (1.0f / 127.0f) : 1.0f;
        }
        __syncthreads();
        for (int cc = 0; cc < 32; ++cc) { const int c = F.wave * 32 + cc;
            const v2u w = *(const LAS v2u*)(F.lds + lane * 2056 + c * 8);
            __builtin_nontemporal_store(w, (v2u*)(F.V8T() + ((size_t)c * NEXP + e0 + lane) * 8)); }
        __syncthreads();
    }
    for (size_t ch = gt; ch < (size_t)8 * 128 * 128 / 8; ch += NGT) {
        const size_t e0 = ch * 8;
        const f32x4 a = *(const GAS f32x4*)(F.A.in[12] + e0), b = *(const GAS f32x4*)(F.A.in[12] + e0 + 4);
        v4u o; o.x = pk2(a.x, a.y); o.y = pk2(a.z, a.w); o.z = pk2(b.x, b.y); o.w = pk2(b.z, b.w);
        *(GAS v4u*)(F.WSB() + e0) = o;
    }
    for (size_t ch = gt; ch < (size_t)16 * 128 * 128 / 8; ch += NGT) {
        const size_t e0 = ch * 8;
        const f32x4 a = *(const GAS f32x4*)(F.A.in[17] + e0), b = *(const GAS f32x4*)(F.A.in[17] + e0 + 4);
        v4u hi; hi.x = pk2(a.x, a.y); hi.y = pk2(a.z, a.w); hi.z = pk2(b.x, b.y); hi.w = pk2(b.z, b.w);
        *(GAS v4u*)(F.KH() + e0) = hi;
    }
    for (int m = gw; m < M; m += NGW) {
        const GAS f32x4* xr = (const GAS f32x4*)(F.A.in[0] + (size_t)m * D) + lane;
        f32x4 v[8]; float s = 0.f;
#pragma unroll
        for (int j = 0; j < 8; ++j) { v[j] = __builtin_nontemporal_load(xr + 64 * j); s += (v[j].x * v[j].x + v[j].y * v[j].y) + (v[j].z * v[j].z + v[j].w * v[j].w); }
        const float rstd = __builtin_amdgcn_rsqf(wave_sum(s) * (1.f / D) + 1e-6f);
        GAS unsigned long long* o8 = (GAS unsigned long long*)(F.XN() + (size_t)m * D) + lane;
#pragma unroll
        for (int j = 0; j < 8; ++j) o8[64 * j] = (unsigned long long)pk2(v[j].x * rstd, v[j].y * rstd) | ((unsigned long long)pk2(v[j].z * rstd, v[j].w * rstd) << 32);
    }
}
constexpr int LRU_XR = 0, LRU_XC = 33792, LRU_GR = 33792 + 40960;
constexpr float LOG2E = 1.4426950408889634f;
__device__ __forceinline__ int xc_off(int tok, int ch) { return tok * 320 + (tok >> 5) * 16 + ch * 2; }
template <bool APPLY, int DIR>
__device__ __forceinline__ void lru_dir(Frame& F, int unit, int b, int c, int h, const bf16x8 (&Ba)[4], const bf16x8 (&Bx)[4], float (&hsum)[8][4]) {
    const int lane = F.lane, w = F.wave, fr = lane & 15, fq = lane >> 4;
    LAS unsigned char* XC = F.lds + LRU_XC;
    const int chl = 16 * w + fr, chg = h * 128 + chl;
    v4u* au = (v4u*)F.AU() + ((size_t)((unit * 2 + DIR) * NWAVES + w) * 8) * 64 + lane;
    f32x4 R[8], I[8];
    float carry = 0.f;
    if (APPLY) {
        carry = F.CARRY()[(size_t)((b * 2 + DIR) * NCHUNK + c) * LW + chg];
        v4u q[8];
#pragma unroll
        for (int m = 0; m < 8; ++m) q[m] = __builtin_nontemporal_load(au + m * 64);
#pragma unroll
        for (int m = 0; m < 8; ++m) {
            R[m] = (f32x4){__builtin_amdgcn_exp2f(bf_lo(q[m].x)), __builtin_amdgcn_exp2f(bf_lo(q[m].y)), __builtin_amdgcn_exp2f(bf_lo(q[m].z)), __builtin_amdgcn_exp2f(bf_lo(q[m].w))};
            I[m] = (f32x4){bf_hi(q[m].x), bf_hi(q[m].y), bf_hi(q[m].z), bf_hi(q[m].w)}; }
    } else {
        const float ba = F.A.in[6][DIR * LW + chg], bx = F.A.in[8][DIR * LW + chg], lam = F.A.in[9][DIR * LW + chg];
        const float cl = -8.0f * log1pf(__expf(-lam)) * LOG2E;
        const int arow = (fr >> 2) * 32 + (fr & 3);
#pragma unroll
        for (int m = 0; m < 8; ++m) {
            R[m] = (f32x4){0.f, 0.f, 0.f, 0.f}; I[m] = (f32x4){0.f, 0.f, 0.f, 0.f};
#pragma unroll
            for (int ks = 0; ks < 4; ++ks) {
                const bf16x8 a = *(const LAS bf16x8*)(XC + xc_off(arow + 4 * m, 32 * ks + 8 * fq));
                R[m] = __builtin_amdgcn_mfma_f32_16x16x32_bf16(a, Ba[ks], R[m], 0, 0, 0);
                I[m] = __builtin_amdgcn_mfma_f32_16x16x32_bf16(a, Bx[ks], I[m], 0, 0, 0);
            }
        }
#pragma unroll
        for (int m = 0; m < 8; ++m) {
            float la[4];
#pragma unroll
            for (int j = 0; j < 4; ++j) {
                const float r = sigmoidf_(R[m][j] + ba), ig = sigmoidf_(I[m][j] + bx);
                la[j] = cl * r;
                const float a = __builtin_amdgcn_exp2f(la[j]);
                const float xc = bf1(*(const LAS unsigned short*)(XC + xc_off(32 * fq + 4 * m + j, chl)));
                R[m][j] = a; I[m][j] = __builtin_amdgcn_sqrtf(fmaxf(1.0f - a * a, 0.0f)) * (ig * xc);
            }
            __builtin_nontemporal_store((v4u){pk2(la[0], I[m][0]), pk2(la[1], I[m][1]), pk2(la[2], I[m][2]), pk2(la[3], I[m][3])}, au + m * 64);
        }
    }
    float P = 1.f, L = 0.f;
#pragma unroll
    for (int mm = 0; mm < 8; ++mm) {
        const int m = DIR == 0 ? mm : 7 - mm;
#pragma unroll
        for (int jj = 0; jj < 4; ++jj) {
            const int j = DIR == 0 ? jj : 3 - jj;
            const float a = R[m][j], u = I[m][j];
            L = a * L + u; P = a * P;
            R[m][j] = P; I[m][j] = L;
        }
    }
    const int src1 = DIR == 0 ? lane - 16 : lane + 16, src2 = DIR == 0 ? lane - 32 : lane + 32;
    const bool v1 = DIR == 0 ? (fq >= 1) : (fq <= 2), v2 = DIR == 0 ? (fq >= 2) : (fq <= 1);
    float A = P, B = L;
    { const float pa = __shfl(A, src1), pb = __shfl(B, src1); if (v1) { B = A * pb + B; A = A * pa; } }
    { const float pa = __shfl(A, src2), pb = __shfl(B, src2); if (v2) { B = A * pb + B; A = A * pa; } }
    if (APPLY) {
        float EA = __shfl(A, src1), EB = __shfl(B, src1); if (!v1) { EA = 1.f; EB = 0.f; }
        const float hin = EA * carry + EB;
#pragma unroll
        for (int m = 0; m < 8; ++m)
#pragma unroll
            for (int j = 0; j < 4; ++j) { const float hh = R[m][j] * hin + I[m][j]; if (DIR == 0) hsum[m][j] = hh; else hsum[m][j] += hh; }
    } else {
        const bool lastlane = DIR == 0 ? (fq == 3) : (fq == 0);
        if (lastlane) { f32x2* agg = (f32x2*)F.AGG() + (size_t)((b * 2 + DIR) * NCHUNK + c) * LW + chg; *agg = (f32x2){A, B}; }
    }
}

template <bool APPLY>
__device__ __forceinline__ void lru_unit(Frame& F, int unit) {
    const int h = unit & 7, c = (unit >> 3) & 63, b = unit >> 9;
    const int tid = F.tid, lane = F.lane, w = F.wave, fr = lane & 15, fq = lane >> 4;
    const size_t t0 = (size_t)b * SEQ + (size_t)c * CHUNK;
    LAS unsigned char* XR = F.lds + LRU_XR; LAS unsigned char* XC = F.lds + LRU_XC; LAS unsigned char* GR = F.lds + LRU_GR;
    bf16x8 Ba0[4], Bx0[4], Ba1[4], Bx1[4];
    if (!APPLY) {
        const bf16* wb = F.LRUW() + (size_t)h * 16384 + (size_t)(16 * w + fr) * 128 + 8 * fq;
#pragma unroll
        for (int ks = 0; ks < 4; ++ks) { Ba0[ks] = *(const GAS bf16x8*)(wb + 32 * ks); Ba1[ks] = *(const GAS bf16x8*)(wb + (size_t)8 * 16384 + 32 * ks);
            Bx0[ks] = *(const GAS bf16x8*)(wb + (size_t)16 * 16384 + 32 * ks); Bx1[ks] = *(const GAS bf16x8*)(wb + (size_t)24 * 16384 + 32 * ks); }
        for (int p = tid; p < 131 * 16; p += 512) { const int r = p >> 4, cg = p & 15; const int s = c * CHUNK - 2 + r; v4u v = (v4u){0u, 0u, 0u, 0u};
            if (s >= 0 && s < SEQ) v = *(const GAS v4u*)(F.Z() + ((size_t)b * SEQ + s) * NIN + h * 128 + cg * 8);
            *(LAS v4u*)(XR + r * 256 + cg * 16) = v; }
        __syncthreads();
        {
            const int ch2 = tid & 63, tg = tid >> 6, chg = h * 128 + 2 * ch2;
            float w0[4], w1[4];
#pragma unroll
            for (int k = 0; k < 4; ++k) { w0[k] = F.A.in[3][k * LW + chg]; w1[k] = F.A.in[3][k * LW + chg + 1]; }
            const float b0 = F.A.in[4][chg], b1 = F.A.in[4][chg + 1];
            float x0[4], x1[4];
#pragma unroll
            for (int k = 0; k < 3; ++k) { const unsigned u = *(const LAS unsigned*)(XR + (16 * tg + k) * 256 + ch2 * 4); x0[k] = bf_lo(u); x1[k] = bf_hi(u); }
#pragma unroll
            for (int j = 0; j < 16; ++j) {
                const unsigned u = *(const LAS unsigned*)(XR + (16 * tg + j + 3) * 256 + ch2 * 4); x0[3] = bf_lo(u); x1[3] = bf_hi(u);
                const float y0 = b0 + ((w0[0] * x0[0] + w0[1] * x0[1]) + (w0[2] * x0[2] + w0[3] * x0[3]));
                const float y1 = b1 + ((w1[0] * x1[0] + w1[1] * x1[1]) + (w1[2] * x1[2] + w1[3] * x1[3]));
                *(LAS unsigned*)(XC + xc_off(16 * tg + j, 2 * ch2)) = pk2(y0, y1);
                x0[0] = x0[1]; x0[1] = x0[2]; x0[2] = x0[3]; x1[0] = x1[1]; x1[1] = x1[2]; x1[2] = x1[3];
            }
        }
        __syncthreads();
    } else {
#pragma unroll
        for (int ks = 0; ks < 4; ++ks) { Ba0[ks] = Ba1[ks] = Bx0[ks] = Bx1[ks] = (bf16x8){0, 0, 0, 0, 0, 0, 0, 0}; }
        for (int p = tid; p < 128 * 32; p += 512) { const int r = p >> 5, cg = p & 31;
            *(LAS v2u*)(GR + r * 264 + cg * 8) = *(const GAS v2u*)(F.Z() + (t0 + r) * NIN + LW + h * 128 + cg * 4); }
    }
    float hsum[8][4];
    lru_dir<APPLY, 0>(F, unit, b, c, h, Ba0, Bx0, hsum);
    asm volatile("" ::: "memory"); __builtin_amdgcn_sched_barrier(0);
    lru_dir<APPLY, 1>(F, unit, b, c, h, Ba1, Bx1, hsum);
    if (APPLY) {
        const int chl = 16 * w + fr;
        __syncthreads();
#pragma unroll
        for (int m = 0; m < 8; ++m)
#pragma unroll
            for (int j = 0; j < 4; ++j) { LAS unsigned short* p = (LAS unsigned short*)(GR + (32 * fq + 4 * m + j) * 264 + chl * 2); *p = (unsigned short)f2bf(bf1(*p) * hsum[m][j]); }
        __syncthreads();
        for (int p = tid; p < 128 * 32; p += 512) { const int r = p >> 5, cg = p & 31;
            *(GAS v2u*)(F.MIX() + (t0 + r) * D + h * 128 + cg * 4) = *(const LAS v2u*)(GR + r * 264 + cg * 8); }
    }
    __syncthreads();
}

constexpr int LRU_PT = LRU_XR, LRU_CR = LRU_XR + 8192;
template <int DIR>
__device__ __forceinline__ void lru_scan_dir(Frame& F, int b, int c, int h, const bf16x8 (&Ba)[4], const bf16x8 (&Bx)[4], f32x4 (&R)[8], f32x4 (&I)[8], float& EA, float& EB) {
    const int lane = F.lane, w = F.wave, fr = lane & 15, fq = lane >> 4;
    LAS unsigned char* XC = F.lds + LRU_XC;
    const int chl = 16 * w + fr, chg = h * 128 + chl;
    {
        const float ba = F.A.in[6][DIR * LW + chg], bx = F.A.in[8][DIR * LW + chg], lam = F.A.in[9][DIR * LW + chg];
        const float cl = -8.0f * log1pf(__expf(-lam)) * LOG2E;
        const int arow = (fr >> 2) * 32 + (fr & 3);
#pragma unroll
        for (int m = 0; m < 8; ++m) {
            R[m] = (f32x4){0.f, 0.f, 0.f, 0.f}; I[m] = (f32x4){0.f, 0.f, 0.f, 0.f};
#pragma unroll
            for (int ks = 0; ks < 4; ++ks) {
                const bf16x8 a = *(const LAS bf16x8*)(XC + xc_off(arow + 4 * m, 32 * ks + 8 * fq));
                R[m] = __builtin_amdgcn_mfma_f32_16x16x32_bf16(a, Ba[ks], R[m], 0, 0, 0);
                I[m] = __builtin_amdgcn_mfma_f32_16x16x32_bf16(a, Bx[ks], I[m], 0, 0, 0);
            }
        }
#pragma unroll
        for (int m = 0; m < 8; ++m) {
#pragma unroll
            for (int j = 0; j < 4; ++j) {
                const float r = sigmoidf_(R[m][j] + ba), ig = sigmoidf_(I[m][j] + bx);
                const float a = __builtin_amdgcn_exp2f(cl * r);
                const float xc = bf1(*(const LAS unsigned short*)(XC + xc_off(32 * fq + 4 * m + j, chl)));
                R[m][j] = a; I[m][j] = __builtin_amdgcn_sqrtf(fmaxf(1.0f - a * a, 0.0f)) * (ig * xc);
            }
        }
    }
    float P = 1.f, L = 0.f;
#pragma unroll
    for (int mm = 0; mm < 8; ++mm) {
        const int m = DIR == 0 ? mm : 7 - mm;
#pragma unroll
        for (int jj = 0; jj < 4; ++jj) {
            const int j = DIR == 0 ? jj : 3 - jj;
            const float a = R[m][j], u = I[m][j];
            L = a * L + u; P = a * P;
            R[m][j] = P; I[m][j] = L;
        }
    }
    const int src1 = DIR == 0 ? lane - 16 : lane + 16, src2 = DIR == 0 ? lane - 32 : lane + 32;
    const bool v1 = DIR == 0 ? (fq >= 1) : (fq <= 2), v2 = DIR == 0 ? (fq >= 2) : (fq <= 1);
    float A = P, B = L;
    { const float pa = __shfl(A, src1), pb = __shfl(B, src1); if (v1) { B = A * pb + B; A = A * pa; } }
    { const float pa = __shfl(A, src2), pb = __shfl(B, src2); if (v2) { B = A * pb + B; A = A * pa; } }
    EA = __shfl(A, src1); EB = __shfl(B, src1); if (!v1) { EA = 1.f; EB = 0.f; }
    const bool lastlane = DIR == 0 ? (fq == 3) : (fq == 0);
    if (lastlane) {
        const unsigned long long word = (unsigned long long)(__builtin_bit_cast(unsigned, A) | 1u) | ((unsigned long long)__builtin_bit_cast(unsigned, B) << 32);
        __hip_atomic_store((unsigned long long*)F.AGG() + (size_t)((b * 2 + DIR) * NCHUNK + c) * LW + chg, word, RLX_AGENT);
    }
}
__device__ __forceinline__ void lru_decode(int unit, int& b, int& c, int& h) { const int rnd = unit >> 8, within = unit & 255; b = rnd >> 1; h = (rnd & 1) * 4 + (within & 3); c = within >> 2; }
__device__ __forceinline__ void lru_prefetch(Frame& F, int unit, int tid, v4u (&xr)[5]) {
    int b, c, h; lru_decode(unit, b, c, h);
#pragma unroll
    for (int i = 0; i < 5; ++i) { const int p = tid + 512 * i, r = p >> 4, cg = p & 15; const int s = c * CHUNK - 2 + r; xr[i] = (v4u){0u, 0u, 0u, 0u};
        if (p < 131 * 16 && s >= 0 && s < SEQ) xr[i] = *(const GAS v4u*)(F.Z() + ((size_t)b * SEQ + s) * NIN + h * 128 + cg * 8); }
}
__device__ __forceinline__ void lru_fused_unit(Frame& F, int unit, int next, v4u (&xr)[5]) {
    int b, c, h; lru_decode(unit, b, c, h);
    int tid = F.tid; asm volatile("" : "+v"(tid));
    const int lane = tid & 63, w = F.wave, fr = lane & 15, fq = lane >> 4;
    const size_t t0 = (size_t)b * SEQ + (size_t)c * CHUNK;
    LAS unsigned char* XR = F.lds + LRU_XR; LAS unsigned char* XC = F.lds + LRU_XC; LAS unsigned char* GR = F.lds + LRU_GR;
    bf16x8 Ba0[4], Bx0[4], Ba1[4], Bx1[4];
    {
        const bf16* wb = F.LRUW() + (size_t)h * 16384 + (size_t)(16 * w + fr) * 128 + 8 * fq;
#pragma unroll
        for (int ks = 0; ks < 4; ++ks) { Ba0[ks] = *(const GAS bf16x8*)(wb + 32 * ks); Ba1[ks] = *(const GAS bf16x8*)(wb + (size_t)8 * 16384 + 32 * ks);
            Bx0[ks] = *(const GAS bf16x8*)(wb + (size_t)16 * 16384 + 32 * ks); Bx1[ks] = *(const GAS bf16x8*)(wb + (size_t)24 * 16384 + 32 * ks); }
#pragma unroll
        for (int i = 0; i < 5; ++i) { const int p = tid + 512 * i, r = p >> 4, cg = p & 15; if (p < 131 * 16) *(LAS v4u*)(XR + r * 256 + cg * 16) = xr[i]; }
        v2u gr[8];
#pragma unroll
        for (int i = 0; i < 8; ++i) { const int p = tid + 512 * i, r = p >> 5, cg = p & 31;
            gr[i] = *(const GAS v2u*)(F.Z() + (t0 + r) * NIN + LW + h * 128 + cg * 4); }
        __syncthreads();
        {
            const int ch2 = tid & 63, tg = tid >> 6, chg = h * 128 + 2 * ch2;
            float w0[4], w1[4];
#pragma unroll
            for (int k = 0; k < 4; ++k) { w0[k] = F.A.in[3][k * LW + chg]; w1[k] = F.A.in[3][k * LW + chg + 1]; }
            const float b0 = F.A.in[4][chg], b1 = F.A.in[4][chg + 1];
            float x0[4], x1[4];
#pragma unroll
            for (int k = 0; k < 3; ++k) { const unsigned u = *(const LAS unsigned*)(XR + (16 * tg + k) * 256 + ch2 * 4); x0[k] = bf_lo(u); x1[k] = bf_hi(u); }
#pragma unroll
            for (int j = 0; j < 16; ++j) {
                const unsigned u = *(const LAS unsigned*)(XR + (16 * tg + j + 3) * 256 + ch2 * 4); x0[3] = bf_lo(u); x1[3] = bf_hi(u);
                const float y0 = b0 + ((w0[0] * x0[0] + w0[1] * x0[1]) + (w0[2] * x0[2] + w0[3] * x0[3]));
                const float y1 = b1 + ((w1[0] * x1[0] + w1[1] * x1[1]) + (w1[2] * x1[2] + w1[3] * x1[3]));
                *(LAS unsigned*)(XC + xc_off(16 * tg + j, 2 * ch2)) = pk2(y0, y1);
                x0[0] = x0[1]; x0[1] = x0[2]; x0[2] = x0[3]; x1[0] = x1[1]; x1[1] = x1[2]; x1[2] = x1[3];
            }
        }
#pragma unroll
        for (int i = 0; i < 8; ++i) { const int p = tid + 512 * i, r = p >> 5, cg = p & 31; *(LAS v2u*)(GR + r * 264 + cg * 8) = gr[i]; }
        __syncthreads();
    }
    f32x4 R0[8], I0[8], R1[8], I1[8]; float EA0, EB0, EA1, EB1;
    lru_scan_dir<0>(F, b, c, h, Ba0, Bx0, R0, I0, EA0, EB0);
    asm volatile("" ::: "memory"); __builtin_amdgcn_sched_barrier(0);
    lru_scan_dir<1>(F, b, c, h, Ba1, Bx1, R1, I1, EA1, EB1);
    VM_WAIT(); __syncthreads();
    unsigned* cnt = (unsigned*)(F.ctl + CW_LRUF + (b * 8 + h) * 64);
    if (tid == 0) (void)xb_add(cnt, 1u);
    if (next >= 0) lru_prefetch(F, next, tid, xr);
    if (tid == 0) { unsigned* bw = (unsigned*)(F.ctl + CW_BAR); XB_SPIN(xb_ld(cnt) < (unsigned)NCHUNK, bw); }
    __syncthreads();
    {
        const int ch = tid & 127, kq = tid >> 7;
        const unsigned long long* ab = (const unsigned long long*)F.AGG() + (size_t)b * 2 * NCHUNK * LW + h * 128 + ch;
        unsigned long long v[16];
#pragma unroll
        for (int i = 0; i < 16; ++i) { const int k = min(16 * kq + i, 62); const int row = k < c ? k : NCHUNK + k + 1;
            v[i] = __hip_atomic_load(ab + (size_t)row * LW, RLX_AGENT); }
        for (unsigned sp = 0; sp < (1u << 16); ++sp) {
            bool bad = false;
#pragma unroll
            for (int i = 0; i < 16; ++i) if (v[i] == 0ull) { const int k = min(16 * kq + i, 62); const int row = k < c ? k : NCHUNK + k + 1;
                v[i] = __hip_atomic_load(ab + (size_t)row * LW, RLX_AGENT); bad = bad || (v[i] == 0ull); }
            if (!bad) break;
            __builtin_amdgcn_s_sleep(2);
        }
        float fa = 1.f, fb = 0.f, ga = 1.f, gb = 0.f;
#pragma unroll
        for (int i = 0; i < 16; ++i) { const int k = 16 * kq + i; const float A = __builtin_bit_cast(float, (unsigned)v[i]), B = __builtin_bit_cast(float, (unsigned)(v[i] >> 32));
            if (k < c) { fb = A * fb + B; fa = A * fa; } }
#pragma unroll
        for (int i = 15; i >= 0; --i) { const int k = 16 * kq + i; const float A = __builtin_bit_cast(float, (unsigned)v[i]), B = __builtin_bit_cast(float, (unsigned)(v[i] >> 32));
            if (k >= c && k < 63) { gb = A * gb + B; ga = A * ga; } }
        *(LAS f32x4*)(F.lds + LRU_PT + (kq * 128 + ch) * 16) = (f32x4){fa, fb, ga, gb};
    }
    __syncthreads();
    if (tid < 256) {
        const int dir = tid >> 7, ch = tid & 127;
        f32x4 q[4];
#pragma unroll
        for (int k = 0; k < 4; ++k) q[k] = *(const LAS f32x4*)(F.lds + LRU_PT + (k * 128 + ch) * 16);
        float st = 0.f;
        if (dir == 0) { st = q[0].y; st = q[1].x * st + q[1].y; st = q[2].x * st + q[2].y; st = q[3].x * st + q[3].y; }
        else { st = q[3].w; st = q[2].z * st + q[2].w; st = q[1].z * st + q[1].w; st = q[0].z * st + q[0].w; }
        *(LAS float*)(F.lds + LRU_CR + tid * 4) = st;
    }
    __syncthreads();
    {
        const int chl = 16 * w + fr;
        const float hin0 = EA0 * *(const LAS float*)(F.lds + LRU_CR + chl * 4) + EB0, hin1 = EA1 * *(const LAS float*)(F.lds + LRU_CR + 512 + chl * 4) + EB1;
#pragma unroll
        for (int m = 0; m < 8; ++m)
#pragma unroll
            for (int j = 0; j < 4; ++j) { const float hs = (R0[m][j] * hin0 + I0[m][j]) + (R1[m][j] * hin1 + I1[m][j]);
                LAS unsigned short* p = (LAS unsigned short*)(GR + (32 * fq + 4 * m + j) * 264 + chl * 2); *p = (unsigned short)f2bf(bf1(*p) * hs); }
        __syncthreads();
        for (int p = tid; p < 128 * 32; p += 512) { const int r = p >> 5, cg = p & 31;
            *(GAS v2u*)(F.MIX() + (t0 + r) * D + h * 128 + cg * 4) = *(const LAS v2u*)(GR + r * 264 + cg * 8); }
    }
    __syncthreads();
}
__device__ __forceinline__ void lru_carry(Frame& F) {
    const int idx = (F.vcu * NWAVES + F.wave) * 64 + F.lane;
    if (idx >= BATCH * 2 * LW) return;
    const int ch = idx & (LW - 1), bd = idx >> 10, dir = bd & 1;
    const f32x2* agg = (const f32x2*)F.AGG() + (size_t)bd * NCHUNK * LW + ch; float* cr = F.CARRY() + (size_t)bd * NCHUNK * LW + ch;
    float st = 0.f;
#pragma unroll 8
    for (int i = 0; i < NCHUNK; ++i) { const int cc = dir == 0 ? i : NCHUNK - 1 - i; const f32x2 pe = agg[(size_t)cc * LW]; cr[(size_t)cc * LW] = st; st = pe.x * st + pe.y; }
}
constexpr int GM_ST = 0, GM_BS = 1024, GM_VN = 2048, GM_GU = 2048 + 32768;
typedef short s16x4 __attribute__((ext_vector_type(4)));
__device__ __forceinline__ unsigned vn_off(unsigned row, unsigned ch) { return 256u * row + 16u * (ch ^ (((row & 3u) << 2) | ((row >> 2) & 3u))); }
__device__ __forceinline__ void gmlp_unit(Frame& F, int unit) {
    const int tid = F.tid, lane = F.lane, w = F.wave, fr = lane & 15, fq = lane >> 4;
    const size_t t0 = (size_t)unit * CHUNK;
    LAS float* ST = (LAS float*)(F.lds + GM_ST); LAS float* BS = (LAS float*)(F.lds + GM_BS);
    LAS unsigned char* VN = F.lds + GM_VN; LAS unsigned char* GU = F.lds + GM_GU;
    for (int rr = 0; rr < 16; ++rr) {
        const int row = 16 * w + rr;
        const bf16* p = F.Z() + (t0 + row) * NIN + 3 * LW + lane * 8;
        const v4u a = *(const GAS v4u*)p, b = *(const GAS v4u*)(p + 512);
        float x[16] = {bf_lo(a.x), bf_hi(a.x), bf_lo(a.y), bf_hi(a.y), bf_lo(a.z), bf_hi(a.z), bf_lo(a.w), bf_hi(a.w),
                       bf_lo(b.x), bf_hi(b.x), bf_lo(b.y), bf_hi(b.y), bf_lo(b.z), bf_hi(b.z), bf_lo(b.w), bf_hi(b.w)};
        float s = 0.f;
#pragma unroll
        for (int i = 0; i < 16; ++i) s += x[i];
        const float mean = wave_sum(s) * (1.0f / LW);
        float q = 0.f;
#pragma unroll
        for (int i = 0; i < 16; ++i) { const float d = x[i] - mean; q += d * d; }
        const float rstd = __builtin_amdgcn_rsqf(wave_sum(q) * (1.0f / LW) + 1e-6f);
        if (lane == 0) { ST[2 * row] = mean; ST[2 * row + 1] = rstd; }
    }
    __syncthreads();
    const unsigned trq = (unsigned)(lane & 15) >> 2, trp = (unsigned)lane & 3u;
    for (int h = 0; h < 8; ++h) {
#pragma unroll
        for (int i = 0; i < 4; ++i) { const int pid = tid + 512 * i, q = pid >> 4, cg = pid & 15;
            const v4u a = *(const GAS v4u*)(F.Z() + (t0 + q) * NIN + 3 * LW + h * 128 + cg * 8);
            const float mean = ST[2 * q], rstd = ST[2 * q + 1];
            const f32x4 g0 = *(const GAS f32x4*)(F.A.in[10] + h * 128 + cg * 8), g1 = *(const GAS f32x4*)(F.A.in[10] + h * 128 + cg * 8 + 4);
            const f32x4 b0 = *(const GAS f32x4*)(F.A.in[11] + h * 128 + cg * 8), b1 = *(const GAS f32x4*)(F.A.in[11] + h * 128 + cg * 8 + 4);
            v4u o;
            o.x = pk2((bf_lo(a.x) - mean) * rstd * g0.x + b0.x, (bf_hi(a.x) - mean) * rstd * g0.y + b0.y);
            o.y = pk2((bf_lo(a.y) - mean) * rstd * g0.z + b0.z, (bf_hi(a.y) - mean) * rstd * g0.w + b0.w);
            o.z = pk2((bf_lo(a.z) - mean) * rstd * g1.x + b1.x, (bf_hi(a.z) - mean) * rstd * g1.y + b1.y);
            o.w = pk2((bf_lo(a.w) - mean) * rstd * g1.z + b1.z, (bf_hi(a.w) - mean) * rstd * g1.w + b1.w);
            *(LAS v4u*)(VN + vn_off((unsigned)q, (unsigned)cg)) = o;
        }
#pragma unroll
        for (int i = 0; i < 8; ++i) { const int pid = tid + 512 * i, r = pid >> 5, cg = pid & 31;
            *(LAS v2u*)(GU + r * 264 + cg * 8) = *(const GAS v2u*)(F.Z() + (t0 + r) * NIN + 2 * LW + h * 128 + cg * 4); }
        if (tid < 128) BS[tid] = F.A.in[13][h * 128 + tid];
        bf16x8 Af[4];
        { const bf16* wsb = F.WSB() + (size_t)h * 16384 + (size_t)(16 * w + fr) * 128 + 8 * fq;
#pragma unroll
          for (int ks = 0; ks < 4; ++ks) Af[ks] = *(const GAS bf16x8*)(wsb + 32 * ks); }
        __syncthreads();
        f32x4 acc[8];
#pragma unroll
        for (int n = 0; n < 8; ++n) {
            acc[n] = (f32x4){0.f, 0.f, 0.f, 0.f};
#pragma unroll
            for (int ks = 0; ks < 4; ++ks) {
                const s16x4 b0 = __builtin_amdgcn_ds_read_tr16_b64_v4i16((LAS s16x4*)(VN + vn_off(32u * ks + 8u * fq + trq, 2u * n + (trp >> 1)) + 8u * (trp & 1u)));
                const s16x4 b1 = __builtin_amdgcn_ds_read_tr16_b64_v4i16((LAS s16x4*)(VN + vn_off(32u * ks + 8u * fq + 4u + trq, 2u * n + (trp >> 1)) + 8u * (trp & 1u)));
                const bf16x8 bb = (bf16x8){b0[0], b0[1], b0[2], b0[3], b1[0], b1[1], b1[2], b1[3]};
                acc[n] = __builtin_amdgcn_mfma_f32_16x16x32_bf16(Af[ks], bb, acc[n], 0, 0, 0);
            }
        }
#pragma unroll
        for (int n = 0; n < 8; ++n)
#pragma unroll
            for (int j = 0; j < 4; ++j) { const int p = 16 * w + 4 * fq + j; LAS unsigned short* ad = (LAS unsigned short*)(GU + p * 264 + (16 * n + fr) * 2);
                *ad = (unsigned short)f2bf(bf1(*ad) * (acc[n][j] + BS[p])); }
        __syncthreads();
#pragma unroll
        for (int i = 0; i < 8; ++i) { const int pid = tid + 512 * i, r = pid >> 5, cg = pid & 31;
            *(GAS v2u*)(F.MIX() + (t0 + r) * D + LW + h * 128 + cg * 4) = *(const LAS v2u*)(GU + r * 264 + cg * 8); }
        __syncthreads();
    }
}
typedef float f32x16 __attribute__((ext_vector_type(16)));
__device__ __forceinline__ unsigned fkey(float f) { const int u = __builtin_bit_cast(int, f); return (unsigned)(u ^ ((u >> 31) & 0x7fffffff)); }
__device__ __forceinline__ float fkey_inv(unsigned k) { const int u = (int)k; return __builtin_bit_cast(float, u ^ ((u >> 31) & 0x7fffffff)); }
__device__ __forceinline__ unsigned umax_(unsigned a, unsigned b) { return (int)a > (int)b ? a : b; }
__device__ __forceinline__ unsigned umin_(unsigned a, unsigned b) { return (int)a < (int)b ? a : b; }
#define CE_DESC(x, y) do { const unsigned a_ = (x), b_ = (y); (x) = umax_(a_, b_); (y) = umin_(a_, b_); } while (0)
__device__ __forceinline__ void sort16_desc(unsigned (&a)[16]) {
#pragma unroll
    for (int k = 2; k <= 16; k <<= 1)
#pragma unroll
        for (int j = k >> 1; j >= 1; j >>= 1)
#pragma unroll
            for (int i = 0; i < 16; ++i) { const int l = i ^ j; if (l > i) { if ((i & k) == 0) CE_DESC(a[i], a[l]); else CE_DESC(a[l], a[i]); } }
}
__device__ __forceinline__ void merge16_desc(unsigned (&a)[16], const unsigned (&b)[16]) {
#pragma unroll
    for (int i = 0; i < 16; ++i) a[i] = umax_(a[i], b[15 - i]);
#pragma unroll
    for (int j = 8; j >= 1; j >>= 1)
#pragma unroll
        for (int i = 0; i < 16; ++i) if ((i & j) == 0) CE_DESC(a[i], a[i + j]);
}
typedef short bf16x8s __attribute__((ext_vector_type(8)));
__device__ __forceinline__ void topk_unit(Frame& F, int wu) {
    const int tg = wu >> 3, hd = wu & 7, lane = F.lane, r = lane & 31, hh = lane >> 5;
    const int t = tg * 32 + r;
    const size_t qoff = (size_t)t * D + hd * 256 + 8 * hh;
    unsigned L[2][16];
    unsigned hh4 = (unsigned)hh << 2; asm volatile("" : "+v"(hh4));
#pragma unroll
    for (int p = 0; p < 2; ++p) {
        f32x16 acc[4];
#pragma unroll
        for (int nt = 0; nt < 4; ++nt)
#pragma unroll
            for (int i = 0; i < 16; ++i) acc[nt][i] = 0.f;
        const size_t koff = ((size_t)(hd * 2 + p) * 128 + r) * 128 + 8 * hh;
        const bf16* qp = F.QH() + qoff + p * 128; const bf16* kp0 = F.KH() + koff; const bf16* kp1 = kp0 + 32 * 128; const bf16* kp2 = kp0 + 64 * 128; const bf16* kp3 = kp0 + 96 * 128;
        asm volatile("" : "+v"(qp), "+v"(kp0), "+v"(kp1), "+v"(kp2), "+v"(kp3));
#define P6_LOAD(Q, K, ks0, n) _Pragma("unroll") for (int i_ = 0; i_ < (n); ++i_) { Q[i_] = *(const GAS bf16x8s*)(qp + 16 * ((ks0) + i_)); \
            K[i_][0] = *(const GAS bf16x8s*)(kp0 + 16 * ((ks0) + i_)); K[i_][1] = *(const GAS bf16x8s*)(kp1 + 16 * ((ks0) + i_)); \
            K[i_][2] = *(const GAS bf16x8s*)(kp2 + 16 * ((ks0) + i_)); K[i_][3] = *(const GAS bf16x8s*)(kp3 + 16 * ((ks0) + i_)); }
#define P6_MMA(Q, K, n) _Pragma("unroll") for (int i_ = 0; i_ < (n); ++i_) _Pragma("unroll") for (int nt = 0; nt < 4; ++nt) acc[nt] = __builtin_amdgcn_mfma_f32_32x32x16_bf16(K[i_][nt], Q[i_], acc[nt], 0, 0, 0);
        bf16x8s qa[3], ka[3][4], qb[3], kb[3][4];
        P6_LOAD(qa, ka, 0, 3); P6_LOAD(qb, kb, 3, 3);
        __builtin_amdgcn_sched_barrier(0);
        P6_MMA(qa, ka, 3);
        __builtin_amdgcn_sched_barrier(0);
        P6_LOAD(qa, ka, 6, 2);
        __builtin_amdgcn_sched_barrier(0);
        P6_MMA(qb, kb, 3);
        __builtin_amdgcn_sched_barrier(0);
        P6_MMA(qa, ka, 2);
        __builtin_amdgcn_sched_barrier(0);
#undef P6_LOAD
#undef P6_MMA
        unsigned S[4][16];
#pragma unroll
        for (int nt = 0; nt < 4; ++nt) {
#pragma unroll
            for (int rg = 0; rg < 16; ++rg) { const int nc = 32 * nt + (rg & 3) + 8 * (rg >> 2); S[nt][rg] = ((fkey(acc[nt][rg]) & ~0x7Fu) | (unsigned)(127 - nc)) ^ hh4; }
            sort16_desc(S[nt]);
        }
        merge16_desc(S[0], S[1]); merge16_desc(S[2], S[3]); merge16_desc(S[0], S[2]);
        unsigned T[16];
#pragma unroll
        for (int i = 0; i < 16; ++i) T[i] = (unsigned)__shfl_xor((int)S[0][i], 32);
        merge16_desc(S[0], T);
#pragma unroll
        for (int i = 0; i < 16; ++i) L[p][i] = S[0][i];
        __builtin_amdgcn_sched_barrier(0);
    }
    float v0[16], v1[16];
#pragma unroll
    for (int i = 0; i < 16; ++i) { v0[i] = fkey_inv(L[0][i] & ~0x7Fu); v1[i] = fkey_inv(L[1][i] & ~0x7Fu); }
    unsigned C[4][16];
    {
        int cnt = 0;
#pragma unroll
        for (int i = 0; i < 16; ++i)
#pragma unroll
            for (int j = 0; j < 16; ++j) if ((i + 1) * (j + 1) <= 16) { C[cnt >> 4][cnt & 15] = (fkey(v0[i] + v1[j]) & ~0xFFu) | (unsigned)(255 - (i * 16 + j)); ++cnt; }
#pragma unroll
        for (int q = 50; q < 64; ++q) C[q >> 4][q & 15] = 0x80000000u;
    }
    sort16_desc(C[0]); sort16_desc(C[1]); sort16_desc(C[2]); sort16_desc(C[3]);
    merge16_desc(C[0], C[1]); merge16_desc(C[2], C[3]); merge16_desc(C[0], C[2]);
    unsigned best[16];
#pragma unroll
    for (int i = 0; i < 16; ++i) best[i] = C[0][i];
    LAS unsigned* tab = (LAS unsigned*)(F.lds + F.wave * 8192) + lane;
#pragma unroll
    for (int i = 0; i < 16; ++i) { tab[i * 64] = 127u - (L[0][i] & 0x7Fu); tab[(16 + i) * 64] = 127u - (L[1][i] & 0x7Fu); }
    const float smax = fkey_inv(best[0] & ~0xFFu);
    float sv[8]; unsigned idv[8]; float ssum = 0.f;
#pragma unroll
    for (int k = 0; k < 8; ++k) {
        const unsigned bk = hh ? best[8 + k] : best[k];
        const unsigned pos = 255u - (bk & 0xFFu);
        idv[k] = tab[(pos >> 4) * 64] * 128u + tab[(16 + (pos & 15u)) * 64];
        sv[k] = __builtin_amdgcn_exp2f((fkey_inv(bk & ~0xFFu) - smax) * 1.4426950409f); ssum += sv[k];
    }
    ssum += __shfl_xor(ssum, 32);
    const float inv = 1.0f / ssum;
    {
        int* o = F.IDS() + (size_t)t * 128 + hd * 16 + 8 * hh; float* og = F.GATES() + (size_t)t * 128 + hd * 16 + 8 * hh;
        *(GAS v4u*)o = (v4u){idv[0], idv[1], idv[2], idv[3]}; *(GAS v4u*)(o + 4) = (v4u){idv[4], idv[5], idv[6], idv[7]};
        *(GAS f32x4*)og = (f32x4){sv[0] * inv, sv[1] * inv, sv[2] * inv, sv[3] * inv}; *(GAS f32x4*)(og + 4) = (f32x4){sv[4] * inv, sv[5] * inv, sv[6] * inv, sv[7] * inv};
    }
}
__device__ __forceinline__ void h8_row(Frame& F, int t) {
    const int lane = F.lane;
    float hx[32]; float mx = 0.f;
    const bf16* hp = F.HB() + (size_t)t * D + lane * 16;
#pragma unroll
    for (int c = 0; c < 2; ++c)
#pragma unroll
        for (int q = 0; q < 2; ++q) { const v4u a = *(const GAS v4u*)(hp + c * 1024 + q * 8); float* x = hx + c * 16 + q * 8;
            x[0] = bf_lo(a.x); x[1] = bf_hi(a.x); x[2] = bf_lo(a.y); x[3] = bf_hi(a.y); x[4] = bf_lo(a.z); x[5] = bf_hi(a.z); x[6] = bf_lo(a.w); x[7] = bf_hi(a.w); }
#pragma unroll
    for (int i = 0; i < 32; ++i) mx = fmaxf(mx, fabsf(hx[i]));
#pragma unroll
    for (int o = 1; o < 64; o <<= 1) mx = fmaxf(mx, __shfl_xor(mx, o));
    const float sc = mx > 0.f ? 119.0f / mx : 1.0f;
#pragma unroll
    for (int c = 0; c < 2; ++c) {
        unsigned hw[2], lw[2];
#pragma unroll
        for (int g8 = 0; g8 < 2; ++g8) { unsigned hacc = 0u, lacc = 0u;
#pragma unroll
            for (int i = 0; i < 8; ++i) { const int q = (int)__builtin_rintf(hx[c * 16 + g8 * 8 + i] * sc); const int lo = ((q + 8) & 15) - 8, hi = (q - lo) >> 4;
                const int sh = (i & 3) * 8 + (i >> 2) * 4; hacc |= (unsigned)(hi & 15) << sh; lacc |= (unsigned)(lo & 15) << sh; }
            hw[g8] = hacc; lw[g8] = lacc; }
        unsigned char* hb_ = F.H8() + (size_t)t * D + c * 512 + lane * 8;
        *(GAS v2u*)hb_ = (v2u){hw[0], hw[1]}; *(GAS v2u*)(hb_ + 1024) = (v2u){lw[0], lw[1]};
    }
    if (lane == 0) F.HSCALE()[t] = mx > 0.f ? mx * (1.0f / 119.0f) : 1.0f;
}
__device__ __forceinline__ int row_sum16(int v) {
    v += __builtin_amdgcn_update_dpp(0, v, 0x128, 0xf, 0xf, false);
    v += __builtin_amdgcn_update_dpp(0, v, 0x124, 0xf, 0xf, false);
    v += __builtin_amdgcn_update_dpp(0, v, 0x122, 0xf, 0xf, false);
    v += __builtin_amdgcn_update_dpp(0, v, 0x121, 0xf, 0xf, false);
    return v;
}
__device__ __forceinline__ void peer_u_xcd(Frame& F) {
    const int lane = F.lane, x = blockIdx.x & 7, jcu = blockIdx.x >> 3, ncu = ((int)F.G - x + 7) >> 3;
    const int tpc = (M + ncu - 1) / ncu, tpw = (tpc + NWAVES - 1) / NWAVES;
    const int tbase = jcu * tpc + F.wave * tpw;
    int nw = M - tbase; { const int lim = (jcu + 1) * tpc - tbase; nw = nw < lim ? nw : lim; nw = nw < tpw ? nw : tpw; nw = nw < 0 ? 0 : nw; }
    const int NV = nw;
    LAS unsigned char* wl = F.lds + F.wave * 13312;
    LAS int* lst = (LAS int*)wl; LAS int* res = (LAS int*)(wl + 512); LAS unsigned char* hsl = wl + 1024;
    const int q4 = lane >> 4, i16 = lane & 15;
    const unsigned char* ubase = F.U8() + (size_t)x * 2048 * 1024;
    const unsigned lanepart = (unsigned)i16 * 16u;
    int r_idlo = 0, r_idhi = 0, r_t = 0; v4u r_h0 = (v4u){0u, 0u, 0u, 0u}, r_h1 = (v4u){0u, 0u, 0u, 0u};
    int v_cl0 = 0, v_cl1 = 0, v_n = 0, v_r0 = 0, v_t = 0, v_slot = 0; unsigned long long v_mlo = 0, v_mhi = 0; bool v_live = false;
    int vset = 0, nvalid = 0, idle = 0;
    if (NV == 0) return;
#define U_RAW() do { const int vi_ = vset < NV ? vset : NV - 1; r_t = tbase + vi_; \
        r_idlo = F.IDS()[(size_t)r_t * 128 + lane]; r_idhi = F.IDS()[(size_t)r_t * 128 + 64 + lane]; \
        r_h0 = *(const GAS v4u*)(F.H8() + (size_t)r_t * D + lane * 16); r_h1 = *(const GAS v4u*)(F.H8() + (size_t)r_t * D + 1024 + lane * 16); } while (0)
#define U_NEXT() do { if (v_live && v_r0 + 16 < v_n) { v_r0 += 16; } else if (vset < NV) { const bool slo = (r_idlo >> 11) == x, shi = (r_idhi >> 11) == x; \
            v_mlo = __ballot(slo); v_mhi = __ballot(shi); const int nlo = __popcll(v_mlo); v_n = nlo + __popcll(v_mhi); \
            const int plo = __builtin_amdgcn_mbcnt_hi((unsigned)(v_mlo >> 32), __builtin_amdgcn_mbcnt_lo((unsigned)v_mlo, 0)); \
            const int phi = nlo + __builtin_amdgcn_mbcnt_hi((unsigned)(v_mhi >> 32), __builtin_amdgcn_mbcnt_lo((unsigned)v_mhi, 0)); \
            if (slo) lst[plo] = (r_idlo & 2047) | (lane << 16); if (shi) lst[phi] = (r_idhi & 2047) | ((64 + lane) << 16); \
            v_slot = nvalid % 6; ++nvalid; { LAS unsigned char* sp_ = hsl + v_slot * 2048; *(LAS v4u*)(sp_ + lane * 16) = r_h0; *(LAS v4u*)(sp_ + 1024 + lane * 16) = r_h1; } \
            v_cl0 = lst[lane]; v_cl1 = lst[64 + lane]; v_t = r_t; v_r0 = 0; ++vset; v_live = true; } \
        else { v_live = false; v_n = 0; v_r0 = 0; v_mlo = 0; v_mhi = 0; ++idle; } } while (0)
#define U_ISSUE(BUF, DS) do { { const int rem_ = v_n - v_r0; DS##_cnt = rem_ < 0 ? 0 : (rem_ < 16 ? rem_ : 16); } \
        DS##_slot = v_slot; DS##_t = v_t; DS##_mlo = v_mlo; DS##_mhi = v_mhi; DS##_last = v_live && (v_r0 + 16 >= v_n); \
        _Pragma("unroll") for (int gp = 0; gp < 4; ++gp) { const int ix_ = v_r0 + 4 * gp + q4; const int a_ = __shfl(v_cl0, ix_ & 63), b_ = __shfl(v_cl1, ix_ & 63); DS##_ent[gp] = ix_ < 64 ? a_ : b_; \
            const unsigned of_ = (4 * gp + q4 < DS##_cnt ? ((unsigned)(DS##_ent[gp] & 2047) << 10) : 0u) + lanepart; \
            _Pragma("unroll") for (int c = 0; c < 4; ++c) BUF[4 * gp + c] = *(const GAS v4u*)(ubase + of_ + c * 256); } } while (0)
#define U_COMPUTE(BUF, DS) do { const LAS unsigned char* sp_ = hsl + DS##_slot * 2048; const LAS v4u* hp_ = (const LAS v4u*)(sp_ + i16 * 16); \
        _Pragma("unroll") for (int gp = 0; gp < 4; ++gp) if (4 * gp < DS##_cnt) { int ah_ = 0, al_ = 0; \
            _Pragma("unroll") for (int c = 0; c < 4; ++c) { const v4u r_ = BUF[4 * gp + c]; const v4u hh_ = hp_[c * 16], hl_ = hp_[64 + c * 16]; \
                ah_ = __builtin_amdgcn_sdot8((int)r_.x, (int)hh_.x, ah_, false); al_ = __builtin_amdgcn_sdot8((int)r_.x, (int)hl_.x, al_, false); \
                ah_ = __builtin_amdgcn_sdot8((int)r_.y, (int)hh_.y, ah_, false); al_ = __builtin_amdgcn_sdot8((int)r_.y, (int)hl_.y, al_, false); \
                ah_ = __builtin_amdgcn_sdot8((int)r_.z, (int)hh_.z, ah_, false); al_ = __builtin_amdgcn_sdot8((int)r_.z, (int)hl_.z, al_, false); \
                ah_ = __builtin_amdgcn_sdot8((int)r_.w, (int)hh_.w, ah_, false); al_ = __builtin_amdgcn_sdot8((int)r_.w, (int)hl_.w, al_, false); } \
            const int a_ = row_sum16((ah_ << 4) + al_); if (i16 == 0 && 4 * gp + q4 < DS##_cnt) res[DS##_ent[gp] >> 16] = a_; } \
        if (DS##_last) { int* po_ = F.PART() + (size_t)DS##_t * 128; \
            if ((DS##_mlo >> lane) & 1ull) po_[lane] = res[lane]; if ((DS##_mhi >> lane) & 1ull) po_[64 + lane] = res[64 + lane]; } } while (0)
    v4u bufA[16], bufB[16], bufC[16];
    int dA_cnt = 0, dA_ent[4] = {0, 0, 0, 0}, dA_t = 0, dA_slot = 0; unsigned long long dA_mlo = 0, dA_mhi = 0; bool dA_last = false;
    int dB_cnt = 0, dB_ent[4] = {0, 0, 0, 0}, dB_t = 0, dB_slot = 0; unsigned long long dB_mlo = 0, dB_mhi = 0; bool dB_last = false;
    int dC_cnt = 0, dC_ent[4] = {0, 0, 0, 0}, dC_t = 0, dC_slot = 0; unsigned long long dC_mlo = 0, dC_mhi = 0; bool dC_last = false;
    U_RAW();
    U_NEXT(); U_RAW(); U_ISSUE(bufA, dA);
    U_NEXT(); U_RAW(); U_ISSUE(bufB, dB);
    while (idle < 3) {
        U_NEXT(); U_RAW(); U_ISSUE(bufC, dC); U_COMPUTE(bufA, dA);
        U_NEXT(); U_RAW(); U_ISSUE(bufA, dA); U_COMPUTE(bufB, dB);
        U_NEXT(); U_RAW(); U_ISSUE(bufB, dB); U_COMPUTE(bufC, dC);
    }
#undef U_RAW
#undef U_NEXT
#undef U_ISSUE
#undef U_COMPUTE
}
__device__ __forceinline__ void peer_act_token(Frame& F, int t) {
    const int lane = F.lane;
    LAS unsigned char* wl = F.lds + F.wave * 4096;
    LAS float* abuf = (LAS float*)wl; LAS int* ibuf = (LAS int*)(wl + 512); LAS int* cnt = (LAS int*)(wl + 1024);
    LAS int* ovf = (LAS int*)(wl + 1280); LAS int* fre = (LAS int*)(wl + 1792); LAS int* sop = (LAS int*)(wl + 2304);
#define WFENCE() asm volatile("s_waitcnt lgkmcnt(0)" ::: "memory")
    const float sc = __builtin_amdgcn_rsqf(F.ROWSS()[t] * (1.0f / D) + 1e-6f) * F.HSCALE()[t];
    if (lane < 34) cnt[lane] = 0;
    float am = 0.f; float actv[2]; int idv[2], slotv[2];
    const int l32 = t & 31;
#pragma unroll
    for (int half = 0; half < 2; ++half) {
        const size_t o = (size_t)t * 128 + half * 64 + lane;
        const int e = F.IDS()[o]; const float g = F.GATES()[o];
        const int dsum = F.PART()[o];
        actv[half] = gelu_tanh((float)dsum * sc * F.USCALE()[e]) * g * F.VSCALE()[e]; idv[half] = e; am = fmaxf(am, fabsf(actv[half]));
    }
    WFENCE();
#pragma unroll
    for (int half = 0; half < 2; ++half) {
        const int r = idv[half] & 31;
        const int j = __hip_atomic_fetch_add(cnt + r, 1, __ATOMIC_RELAXED, __HIP_MEMORY_SCOPE_WORKGROUP);
        if (j < 4) slotv[half] = ((r - l32) & 31) + 32 * j;
        else { const int q = __hip_atomic_fetch_add(cnt + 32, 1, __ATOMIC_RELAXED, __HIP_MEMORY_SCOPE_WORKGROUP); ovf[q] = half * 64 + lane; slotv[half] = -1; }
    }
    WFENCE();
    if (lane < 32) { const int n = cnt[lane];
        for (int j = n; j < 4; ++j) { const int q = __hip_atomic_fetch_add(cnt + 33, 1, __ATOMIC_RELAXED, __HIP_MEMORY_SCOPE_WORKGROUP); fre[q] = ((lane - l32) & 31) + 32 * j; } }
    WFENCE();
    const int nov = cnt[32];
#pragma unroll
    for (int half = 0; half < 2; ++half) { const int i = half * 64 + lane; if (i < nov) sop[ovf[i]] = fre[i]; }
    WFENCE();
#pragma unroll
    for (int half = 0; half < 2; ++half) { if (slotv[half] < 0) slotv[half] = sop[half * 64 + lane]; abuf[slotv[half]] = actv[half]; ibuf[slotv[half]] = idv[half]; }
    WFENCE();
#pragma unroll
    for (int o = 1; o < 64; o <<= 1) am = fmaxf(am, __shfl_xor(am, o));
    const float asc = am > 0.f ? 127.0f / am : 1.0f;
    if (lane == 0) F.ASCALE()[t] = am > 0.f ? am * (1.0f / 127.0f) : 1.0f;
    if (lane < 32) {
        const f32x4 av = *(const LAS f32x4*)(abuf + 4 * lane); const v4u iv = *(const LAS v4u*)(ibuf + 4 * lane);
        const size_t o = ((size_t)(t >> 6) * 32 + lane) * 64 + (t & 63);
        F.IDW()[o] = (v4u){iv.x << 3, iv.y << 3, iv.z << 3, iv.w << 3};
        F.AW()[o] = pack_i8x4(av.x * asc, av.y * asc, av.z * asc, av.w * asc);
    }
    WFENCE();
#undef WFENCE
}
__device__ __forceinline__ void tr4x4(const unsigned r0, const unsigned r1, const unsigned r2, const unsigned r3, unsigned (&c)[4]) {
    const unsigned t01l = __builtin_amdgcn_perm(r1, r0, 0x05010400u), t01h = __builtin_amdgcn_perm(r1, r0, 0x07030602u);
    const unsigned t23l = __builtin_amdgcn_perm(r3, r2, 0x05010400u), t23h = __builtin_amdgcn_perm(r3, r2, 0x07030602u);
    c[0] = __builtin_amdgcn_perm(t23l, t01l, 0x05040100u); c[1] = __builtin_amdgcn_perm(t23l, t01l, 0x07060302u);
    c[2] = __builtin_amdgcn_perm(t23h, t01h, 0x05040100u); c[3] = __builtin_amdgcn_perm(t23h, t01h, 0x07060302u);
}
template <int MODE>
__device__ __forceinline__ void peer_v_slice(Frame& F, int c, bool do_atomic) {
    const int tid = F.tid, lane = F.lane;
    for (int i = tid; i < NEXP * 8 / 16; i += 512) *(LAS v4u*)(F.lds + i * 16) = *(const GAS v4u*)(F.V8T() + (size_t)c * NEXP * 8 + (size_t)i * 16);
    __syncthreads();
    const v4u* ibase = F.IDW() + lane; const unsigned* abase = F.AW() + lane;
    constexpr int NBLK = M / 64, PD = 16;
    v4u iq[PD]; unsigned aq[PD]; v2u rw[2][4];
    {
        const size_t o = (size_t)F.wave * 32 * 64;
#pragma unroll
        for (int j = 0; j < PD; ++j) { iq[j] = *(const GAS v4u*)(ibase + o + j * 64); aq[j] = abase[o + j * 64]; }
    }
#define LROW(dst, q) do { dst[0] = *(const LAS v2u*)(F.lds + (q).x); dst[1] = *(const LAS v2u*)(F.lds + (q).y); \
                          dst[2] = *(const LAS v2u*)(F.lds + (q).z); dst[3] = *(const LAS v2u*)(F.lds + (q).w); } while (0)
    for (int blk = F.wave; blk < NBLK; blk += NWAVES) {
        const int t = blk * 64 + lane;
        const size_t o = (size_t)blk * 32 * 64;
        const int nblk = (blk + NWAVES < NBLK) ? blk + NWAVES : blk;
        const size_t on = (size_t)nblk * 32 * 64;
        int acc[8];
#pragma unroll
        for (int i = 0; i < 8; ++i) acc[i] = 0;
        LROW(rw[0], iq[0]);
#pragma unroll
        for (int j = 0; j < 32; ++j) {
            if (j + 1 < 32) LROW(rw[(j + 1) & 1], iq[(j + 1) % PD]);
            const unsigned aw = aq[j % PD];
            unsigned cl[4], ch[4];
            tr4x4(rw[j & 1][0].x, rw[j & 1][1].x, rw[j & 1][2].x, rw[j & 1][3].x, cl);
            tr4x4(rw[j & 1][0].y, rw[j & 1][1].y, rw[j & 1][2].y, rw[j & 1][3].y, ch);
#pragma unroll
            for (int i = 0; i < 4; ++i) { acc[i] = __builtin_amdgcn_sdot4((int)aw, (int)cl[i], acc[i], false); acc[4 + i] = __builtin_amdgcn_sdot4((int)aw, (int)ch[i], acc[4 + i], false); }
            { const size_t oo = (j + PD < 32) ? o + (size_t)(j + PD) * 64 : on + (size_t)(j + PD - 32) * 64;
              iq[j % PD] = *(const GAS v4u*)(ibase + oo); aq[j % PD] = abase[oo]; }
            __builtin_amdgcn_sched_barrier(0);
        }
        const float asc = F.ASCALE()[t];
        float accf[8];
#pragma unroll
        for (int i = 0; i < 8; ++i) accf[i] = (float)acc[i] * asc;
        const v4u hb = *(const GAS v4u*)(F.HBT() + ((size_t)c * M + t) * 8);
        accf[0] += bf_lo(hb.x); accf[1] += bf_hi(hb.x); accf[2] += bf_lo(hb.y); accf[3] += bf_hi(hb.y);
        accf[4] += bf_lo(hb.z); accf[5] += bf_hi(hb.z); accf[6] += bf_lo(hb.w); accf[7] += bf_hi(hb.w);
        bf16* yp = (MODE == 0) ? F.Y() + ((size_t)c * M + t) * 8 : (bf16*)F.XN() + ((((size_t)c * M + t) * 8) & (size_t)0x1ffffff);
        *(GAS v4u*)yp = (v4u){pk2(accf[0], accf[1]), pk2(accf[2], accf[3]), pk2(accf[4], accf[5]), pk2(accf[6], accf[7])};
        float ss = 0.f;
#pragma unroll
        for (int i = 0; i < 8; ++i) ss += accf[i] * accf[i];
        if (do_atomic) atomicAdd(F.ROWSS2() + t, ss);
    }
#undef LROW
    __syncthreads();
}
__device__ __forceinline__ void final_unit(Frame& F, int unit) {
    const int tid = F.tid, blk = unit >> 3, cg = unit & 7, t0 = blk * 64;
    LAS float* T = (LAS float*)F.lds;
#pragma unroll
    for (int i = 0; i < 4; ++i) { const int pid = tid + 512 * i, cl = pid >> 6, tok = pid & 63;
        const v4u v = *(const GAS v4u*)(F.Y() + ((size_t)(cg * 32 + cl) * M + t0 + tok) * 8);
        *(LAS f32x4*)(T + tok * 260 + cl * 8) = (f32x4){bf_lo(v.x), bf_hi(v.x), bf_lo(v.y), bf_hi(v.y)};
        *(LAS f32x4*)(T + tok * 260 + cl * 8 + 4) = (f32x4){bf_lo(v.z), bf_hi(v.z), bf_lo(v.w), bf_hi(v.w)}; }
    __syncthreads();
#pragma unroll
    for (int i = 0; i < 8; ++i) { const int pid = tid + 512 * i, tok = pid >> 6, c4 = pid & 63;
        const float rs = __builtin_amdgcn_rsqf(F.ROWSS2()[t0 + tok] * (1.0f / D) + 1e-6f);
        const f32x4 v = *(const LAS f32x4*)(T + tok * 260 + c4 * 4);
        const f32x4 g = *(const GAS f32x4*)(F.A.in[20] + cg * 256 + c4 * 4);
        *(GAS f32x4*)(F.A.out + (size_t)(t0 + tok) * D + cg * 256 + c4 * 4) = v * rs * g; }
    __syncthreads();
}
__global__ void __launch_bounds__(NWAVES * 64, 2) mk_fwd(Args args) {
    __shared__ __attribute__((aligned(16))) unsigned char lds[LDS_BYTES];
    Frame F(args);
    F.lds = (LAS unsigned char*)lds;
    F.MISC = (volatile LAS unsigned*)(F.lds + MISC_OFF);
    F.tid = threadIdx.x; F.lane = F.tid & 63; F.wave = __builtin_amdgcn_readfirstlane(F.tid >> 6);
    F.G = gridDim.x; { const int bx = blockIdx.x; F.vcu = (F.G % 8 == 0) ? (bx % 8) * (F.G / 8) + bx / 8 : bx; }
    F.ws = args.ws;
    F.ctl = (gu32*)(args.ws + WS_CTL);
    for (int u = F.tid; u < (LDS_BYTES - LDSCTL_OFF) / 4; u += NWAVES * 64) ((LAS unsigned*)(F.lds + LDSCTL_OFF))[u] = 0u;
    __syncthreads();
    XcdBarrier bar; bar.bar = (unsigned*)(F.ctl + CW_BAR); bar.x = 0; bar.st = nullptr;
    if (N_LAUNCHES != PER_PHASE) bar = xcd_barrier_post((unsigned*)(F.ctl + CW_BAR), F.MISC + 8);
#define GRID_BAR() do { if (N_LAUNCHES != PER_PHASE) xcd_barrier(bar); } while (0)
    const int lo = args.ph_lo, hi = args.ph_hi;
#ifndef MK_PHASE_MASK
#define MK_PHASE_MASK 0x7FF
#endif
#define IN(k) (((MK_PHASE_MASK >> (k)) & 1) && lo <= (k) && (k) < hi)
#undef MK_PHASE_MASK
#define MK_PHASE_MASK 0xFFFF
#define BOTH(k) (true)
#ifndef MK_REP_MASK
#define MK_REP_MASK 0
#endif
#ifndef MK_REP_N
#define MK_REP_N 2
#endif
#define REPS(k) for (int rep_ = 0; rep_ < ((((MK_REP_MASK) >> (k)) & 1) ? 1 + MK_REP_N : 1); ++rep_)
    const int gw = F.vcu * NWAVES + F.wave, NGW = F.G * NWAVES;
    if (IN(0)) { REPS(0) { p0_prologue(F); __syncthreads(); } if (BOTH(0)) GRID_BAR(); }
    if (IN(1)) {
        pg8::Gemm g{F.XN(), F.WIN(), M, NIN, D}; pg8::StaticOrder S; S.init(M, NIN, F.G, (int)blockIdx.x);
        pg8::EpiZ E{F.Z(), NIN, LW};
        REPS(1) pg8::gemm_phase<pg8::EpiZ, pg8::StaticOrder, true, true>(F.lds, g, S, E);
        if (BOTH(1)) GRID_BAR();
    }
    if (IN(2)) {
        REPS(12) { v4u xr[5]; int u = blockIdx.x; lru_prefetch(F, u, F.tid, xr);
                   for (; u < BATCH * NCHUNK * 8; u += F.G) lru_fused_unit(F, u, u + F.G < BATCH * NCHUNK * 8 ? u + F.G : -1, xr); }
        asm volatile("" : "+v"(F.tid), "+v"(F.lane));
        REPS(13) for (int u = blockIdx.x; u < BATCH * NCHUNK; u += F.G) gmlp_unit(F, u);
        if (BOTH(2)) GRID_BAR();
    }
    if (IN(4)) {
        pg8::Gemm g{F.MIX(), F.WOUT(), M, D, D}; pg8::StaticOrder S; S.init(M, D, F.G, (int)blockIdx.x);
        pg8::EpiH E{F.HB(), F.HBT(), F.A.in[0], F.ROWSS(), D, M};
        pg8::gemm_phase<pg8::EpiH, pg8::StaticOrder, true, true>(F.lds, g, S, E);
        if (BOTH(4)) GRID_BAR();
    }
    if (IN(5)) {
        pg8::Gemm g{F.HB(), F.WQ(), M, D, D}; pg8::StaticOrder S; S.init(M, D, F.G, (int)blockIdx.x);
        pg8::EpiQ E{F.QH(), F.ROWSS(), D};
        REPS(5) pg8::gemm_phase<pg8::EpiQ, pg8::StaticOrder, true, true>(F.lds, g, S, E);
        if (BOTH(5)) GRID_BAR();
    }
    if (IN(6)) {
        REPS(6) { for (int wu = gw; wu < (M / 32) * 8; wu += NGW) topk_unit(F, wu);
                  for (int t = gw; t < M; t += NGW) h8_row(F, t); }
        if (BOTH(6)) GRID_BAR();
    }
    if (IN(7)) {
        REPS(7) peer_u_xcd(F);
        if (BOTH(7)) GRID_BAR();
    }
    if (IN(8)) {
        REPS(8) for (int t = gw; t < M; t += NGW) peer_act_token(F, t);
        if (BOTH(8)) GRID_BAR();
    }
    if (IN(9)) {
        for (int c = blockIdx.x; c < D / 8; c += F.G) peer_v_slice<0>(F, c, true);
        if ((MK_REP_MASK >> 9) & 1) { for (int rep_ = 0; rep_ < MK_REP_N; ++rep_) for (int c = blockIdx.x; c < D / 8; c += F.G) peer_v_slice<1>(F, c, false); }
        if (BOTH(9)) GRID_BAR();
    }
    if (IN(10)) {
        REPS(10) for (int u = blockIdx.x; u < (M / 64) * 8; u += F.G) final_unit(F, u);
    }
#undef IN
#undef BOTH
#undef GRID_BAR
}

extern "C" void kernel_launch(void* const* d_in, const int* in_sizes, int n_in, void* d_out, int out_size, void* d_ws, size_t ws_size, hipStream_t stream) {
    static int grid = 0;
    if (grid == 0) {
        if (n_in != 21 || in_sizes[0] != M * D || out_size != M * D || ws_size < WS_END) { fprintf(stderr, "kernel_launch: unexpected shapes (n_in %d, in0 %d, out %d, ws %zu)\n", n_in, n_in > 0 ? in_sizes[0] : -1, out_size, ws_size); grid = -1; return; }
        int dev = 0, cus = 0, per_cu = 0;
        if (hipGetDevice(&dev) != hipSuccess || hipDeviceGetAttribute(&cus, hipDeviceAttributeMultiprocessorCount, dev) != hipSuccess) { grid = -1; return; }
        if (hipOccupancyMaxActiveBlocksPerMultiprocessor(&per_cu, (const void*)mk_fwd, NWAVES * 64, 0) != hipSuccess || per_cu < 1) { fprintf(stderr, "kernel_launch: occupancy query reports %d blocks per CU\n", per_cu); }
        (void)hipGetLastError();
        grid = cus;
        if (cus < 256) { fprintf(stderr, "kernel_launch: the RG-LRU family hand-off needs >= 256 co-resident workgroups (have %d)\n", cus); grid = -1; return; }
    }
    if (grid < 0) return;
    (void)hipMemsetAsync((char*)d_ws + WS_CTL, 0, CTL_ZERO_BYTES, stream);
    Args a{};
    for (int i = 0; i < 21; ++i) a.in[i] = (const float*)d_in[i];
    a.out = (float*)d_out; a.ws = (unsigned char*)d_ws;
    for (int li = 0; li < N_LAUNCHES; ++li) {
        a.ph_lo = 0; a.ph_hi = 99;
        hipLaunchKernelGGL(mk_fwd, dim3(grid), dim3(NWAVES * 64), 0, stream, a);
    }
}
```

```cpp
#include <hip/hip_runtime.h>
#include <cstdio>
#include <cstdint>
namespace pg8 {
#define PG8_LAS __attribute__((address_space(3)))
typedef unsigned short bf16_t;
typedef short bf16x8 __attribute__((ext_vector_type(8)));
typedef float f32x4 __attribute__((ext_vector_type(4)));
typedef unsigned u32x4 __attribute__((ext_vector_type(4)));
constexpr int BM = 256, BK = 64, HALF = 128, HTB = HALF * BK * 2  , STAGE_BYTES = 8 * HTB, NXCD = 8, WGM = 8;

__host__ __device__ __forceinline__ int lds_byte(int r, int c) { const int st = (r >> 4) * 2 + (c >> 5), rr = r & 15, cc = c & 31, ob = rr * 64 + cc * 2; return st * 1024 + (ob ^ (((ob >> 9) & 1) << 5)); }
__host__ __device__ __forceinline__ void stage_rc(int b, int& R, int& C) { const int st = b / 1024, sb = b % 1024, swz = sb ^ (((sb >> 9) & 1) << 5); R = (st >> 1) * 16 + swz / 64; C = (st & 1) * 32 + (swz % 64) / 2; }
__host__ __device__ __forceinline__ int perm32(int rho) { const int n = rho >> 4, i = rho & 15; return 8 * (i >> 2) + 4 * n + (i & 3); }

struct Unit { int pm, pn; };
struct Gemm { const bf16_t* A; const bf16_t* Bt; int M, N, K; };

struct StaticOrder {
    int nM, nN, nwg, G, c;
    __host__ __device__ void init(int M, int N, int G_, int c_) { nM = M / BM; nN = N / BM; nwg = nM * nN; G = G_; c = c_; }
    __host__ __device__ bool next(int i, Unit& u) const {
        const long L = (long)i * G + c; if (L >= nwg) return false;
        int wgid = (int)L; { const int q = nwg / NXCD, r = nwg % NXCD, xcd = wgid % NXCD, off = wgid / NXCD; wgid = (xcd < r ? xcd * (q + 1) : r * (q + 1) + (xcd - r) * q) + off; }
        const int nig = WGM * nN, gid = wgid / nig, fm = gid * WGM, gsz = (nM - fm) < WGM ? (nM - fm) : WGM;
        u.pm = fm + ((wgid % nig) % gsz); u.pn = (wgid % nig) / gsz; return true;
    }
    __device__ __forceinline__ void a_ready(const Unit&) const {}
    __device__ __forceinline__ void done(const Unit&) const {}
};

__device__ __forceinline__ unsigned cvt_pk_bf16(float lo, float hi) { unsigned r; asm volatile("v_cvt_pk_bf16_f32 %0, %1, %2" : "=v"(r) : "v"(lo), "v"(hi)); return r; }
__device__ __forceinline__ float gelu_tanh(float x) {
    const float t = x * (1.0f + 0.044715f * x * x);
    const float e = __builtin_amdgcn_exp2f(-2.3022081983f * t);
    return x * __builtin_amdgcn_rcpf(1.0f + e);
}
struct EpiZ {
    static constexpr bool PERM = true, AFTER_DRAIN = false;
    bf16_t* O; int ldc; int gelu_from;
    __device__ __forceinline__ void operator()(const f32x4 (&acc)[2][2][4][2], const Unit& u, int wr, int wc, int fr, int fq) const {
        const int row0 = u.pm * BM + wr * 64 + fr; const int col0 = u.pn * BM + wc * 32 + 8 * fq;
        const bool act = (u.pn * BM) >= gelu_from;
#pragma unroll
        for (int ai = 0; ai < 2; ++ai)
#pragma unroll
            for (int m = 0; m < 4; ++m) { bf16_t* rowp = O + (size_t)(row0 + ai * HALF + m * 16) * ldc + col0;
#pragma unroll
                for (int bj = 0; bj < 2; ++bj) { f32x4 v0 = acc[ai][bj][m][0], v1 = acc[ai][bj][m][1];
                    if (act) {
#pragma unroll
                        for (int j = 0; j < 4; ++j) { v0[j] = gelu_tanh(v0[j]); v1[j] = gelu_tanh(v1[j]); } }
                    u32x4 w; w.x = cvt_pk_bf16(v0[0], v0[1]); w.y = cvt_pk_bf16(v0[2], v0[3]); w.z = cvt_pk_bf16(v1[0], v1[1]); w.w = cvt_pk_bf16(v1[2], v1[3]);
                    *(u32x4*)(rowp + bj * HALF) = w; } }
    }
};
struct EpiH {
    static constexpr bool PERM = true, AFTER_DRAIN = false;
    bf16_t* O; bf16_t* OT; const float* X; float* rowss; int ldc; int mrows;
    __device__ __forceinline__ void operator()(const f32x4 (&acc)[2][2][4][2], const Unit& u, int wr, int wc, int fr, int fq) const {
        const int row0 = u.pm * BM + wr * 64 + fr; const int col0 = u.pn * BM + wc * 32 + 8 * fq;
#pragma unroll
        for (int ai = 0; ai < 2; ++ai)
#pragma unroll
            for (int m = 0; m < 4; ++m) { const int row = row0 + ai * HALF + m * 16; const size_t off = (size_t)row * ldc + col0; float ss = 0.f;
#pragma unroll
                for (int bj = 0; bj < 2; ++bj) {
                    const f32x4 x0 = *(const f32x4*)(X + off + bj * HALF), x1 = *(const f32x4*)(X + off + bj * HALF + 4);
                    const f32x4 v0 = acc[ai][bj][m][0] + x0, v1 = acc[ai][bj][m][1] + x1;
                    ss += (v0[0] * v0[0] + v0[1] * v0[1]) + (v0[2] * v0[2] + v0[3] * v0[3]) + (v1[0] * v1[0] + v1[1] * v1[1]) + (v1[2] * v1[2] + v1[3] * v1[3]);
                    u32x4 w; w.x = cvt_pk_bf16(v0[0], v0[1]); w.y = cvt_pk_bf16(v0[2], v0[3]); w.z = cvt_pk_bf16(v1[0], v1[1]); w.w = cvt_pk_bf16(v1[2], v1[3]);
                    *(u32x4*)(O + off + bj * HALF) = w;
                    *(u32x4*)(OT + ((size_t)((col0 + bj * HALF) >> 3) * mrows + row) * 8) = w; }
                ss += __shfl_xor(ss, 16); ss += __shfl_xor(ss, 32);
                if (fq == 0) atomicAdd(rowss + row, ss); }
    }
};
struct EpiQ {
    static constexpr bool PERM = true, AFTER_DRAIN = false;
    bf16_t* QH; const float* rowss; int ldc;
    __device__ __forceinline__ void operator()(const f32x4 (&acc)[2][2][4][2], const Unit& u, int wr, int wc, int fr, int fq) const {
        const int row0 = u.pm * BM + wr * 64 + fr, col0 = u.pn * BM + wc * 32 + 8 * fq;
#pragma unroll
        for (int ai = 0; ai < 2; ++ai)
#pragma unroll
            for (int m = 0; m < 4; ++m) { const int row = row0 + ai * HALF + m * 16; const float rs = __builtin_amdgcn_rsqf(rowss[row] * (1.0f / 2048.0f) + 1e-6f);
                const size_t off = (size_t)row * ldc + col0;
#pragma unroll
                for (int bj = 0; bj < 2; ++bj) { const f32x4 v0 = acc[ai][bj][m][0] * rs, v1 = acc[ai][bj][m][1] * rs;
                    u32x4 wh; wh.x = cvt_pk_bf16(v0[0], v0[1]); wh.y = cvt_pk_bf16(v0[2], v0[3]); wh.z = cvt_pk_bf16(v1[0], v1[1]); wh.w = cvt_pk_bf16(v1[2], v1[3]);
                    *(u32x4*)(QH + off + bj * HALF) = wh; } }
    }
};
template <class Epi, class Sched, bool ALIGN_EPI = false, bool SP2 = false>
__device__ __forceinline__ void gemm_phase(PG8_LAS unsigned char* lds, const Gemm g, const Sched& S, const Epi& E) {
    const int tid = threadIdx.x, wid = __builtin_amdgcn_readfirstlane(tid >> 6), lane = tid & 63, wr = wid >> 2, wc = wid & 3, fr = lane & 15, fq = lane >> 4;
    const int K = g.K, nt = K / BK;
    unsigned voffA[2], voffB[2];
#pragma unroll
    for (int i = 0; i < 2; ++i) { int R, C; stage_rc(tid * 16 + i * 8192, R, C); const int Rb = Epi::PERM ? ((R & ~31) + perm32(R & 31)) : R;
        voffA[i] = (unsigned)(R * K + C) * 2u; voffB[i] = (unsigned)(Rb * K + C) * 2u; }
    const size_t kstep = (size_t)(BK * 2);
    const size_t hstep = (size_t)HALF * K * 2;
    const size_t tstep = 2 * hstep;
    const unsigned ldsw = (unsigned)wid * 1024u;
    const int aoff = lds_byte(wr * 64 + fr, fq * 8), boff = lds_byte(wc * 32 + fr, fq * 8);
#define PG8_SA(b, h) (((b) * 2 + (h)) * HTB)
#define PG8_SB(b, h) ((4 + (b) * 2 + (h)) * HTB)
#define PG8_STAGE(bufoff, gbase, voff) do { _Pragma("unroll") for (int _i = 0; _i < 2; ++_i) \
        __builtin_amdgcn_global_load_lds((const unsigned*)((const char*)(gbase) + (voff)[_i]), (PG8_LAS unsigned*)(lds + (bufoff) + ldsw + _i * 8192), 16, 0, 0); } while (0)
#define PG8_LDA(dst, b, h) do { _Pragma("unroll") for (int m = 0; m < 4; ++m) _Pragma("unroll") for (int k = 0; k < 2; ++k) dst[m][k] = *(const PG8_LAS bf16x8*)(lds + PG8_SA(b, h) + aoff + m * 2048 + k * 1024); } while (0)
#define PG8_LDB(dst, b, h) do { _Pragma("unroll") for (int n = 0; n < 2; ++n) _Pragma("unroll") for (int k = 0; k < 2; ++k) dst[n][k] = *(const PG8_LAS bf16x8*)(lds + PG8_SB(b, h) + boff + n * 2048 + k * 1024); } while (0)
#define PG8_MMA(ai, bj, At, Bt) do { __builtin_amdgcn_s_setprio(1); _Pragma("unroll") for (int m = 0; m < 4; ++m) _Pragma("unroll") for (int n = 0; n < 2; ++n) _Pragma("unroll") for (int k = 0; k < 2; ++k) \
        acc[ai][bj][m][n] = __builtin_amdgcn_mfma_f32_16x16x32_bf16(Bt[n][k], At[m][k], acc[ai][bj][m][n], 0, 0, 0); __builtin_amdgcn_s_setprio(0); } while (0)
#define PG8_WAIT_V(n) asm volatile("s_waitcnt vmcnt(" #n ")" ::: "memory")
#define PG8_WAIT_L(n) asm volatile("s_waitcnt lgkmcnt(" #n ")" ::: "memory")
#define PG8_BAR __builtin_amdgcn_s_barrier()
#define PG8_SCHED __builtin_amdgcn_sched_barrier(0)
    Unit cur, nxt; int ui = 0;
    if (!S.next(0, cur)) return;
    f32x4 acc[2][2][4][2];
#pragma unroll
    for (int a = 0; a < 2; ++a)
#pragma unroll
        for (int b = 0; b < 2; ++b)
#pragma unroll
            for (int m = 0; m < 4; ++m)
#pragma unroll
                for (int n = 0; n < 2; ++n) acc[a][b][m][n] = (f32x4){0.f, 0.f, 0.f, 0.f};
    bf16x8 At[4][2], B0[2][2], B1[2][2];
    const char* cA = (const char*)g.A + (size_t)cur.pm * tstep; const char* cB = (const char*)g.Bt + (size_t)cur.pn * tstep;
    S.a_ready(cur);
    if constexpr (SP2) {
        PG8_STAGE(PG8_SB(0, 0), cB, voffB); PG8_STAGE(PG8_SB(0, 1), cB + hstep, voffB); PG8_STAGE(PG8_SA(0, 0), cA, voffA); PG8_STAGE(PG8_SA(0, 1), cA + hstep, voffA);
        if (wr == 1) PG8_BAR;
        PG8_WAIT_V(2); PG8_BAR;
        PG8_STAGE(PG8_SB(1, 0), cB + kstep, voffB); PG8_STAGE(PG8_SA(1, 0), cA + kstep, voffA); PG8_STAGE(PG8_SB(1, 1), cB + hstep + kstep, voffB);
        PG8_WAIT_V(6); PG8_BAR;
    } else {
        PG8_STAGE(PG8_SB(0, 0), cB, voffB); PG8_STAGE(PG8_SA(0, 0), cA, voffA); PG8_STAGE(PG8_SB(0, 1), cB + hstep, voffB); PG8_STAGE(PG8_SA(0, 1), cA + hstep, voffA);
        if (wr == 1) PG8_BAR;
        PG8_WAIT_V(4); PG8_BAR;
        PG8_STAGE(PG8_SB(1, 0), cB + kstep, voffB); PG8_STAGE(PG8_SA(1, 0), cA + kstep, voffA); PG8_STAGE(PG8_SB(1, 1), cB + hstep + kstep, voffB);
        PG8_WAIT_V(6); PG8_BAR;
    }
    for (;;) {
        const bool has_next = S.next(ui + 1, nxt);
        const char* nA = has_next ? (const char*)g.A + (size_t)nxt.pm * tstep : cA; const char* nB = has_next ? (const char*)g.Bt + (size_t)nxt.pn * tstep : cB;
        for (int t = 0; t < nt; t += 2) {
            const bool last = (t == nt - 2);
            const char* a1 = cA + (size_t)(t + 1) * kstep;
            const char* a2 = last ? nA : cA + (size_t)(t + 2) * kstep; const char* b2 = last ? nB : cB + (size_t)(t + 2) * kstep;
            const char* a3 = a2 + kstep; const char* b3 = b2 + kstep;
            if (last && has_next) S.a_ready(nxt);
            if constexpr (SP2) {
            PG8_LDB(B0, 0, 0); PG8_LDB(B1, 0, 1); PG8_SCHED; PG8_LDA(At, 0, 0); PG8_STAGE(PG8_SA(1, 1), a1 + hstep, voffA);
            PG8_WAIT_V(8); PG8_WAIT_L(0); PG8_BAR; PG8_MMA(0, 0, At, B0); PG8_MMA(0, 1, At, B1); PG8_BAR; PG8_SCHED;
            PG8_LDA(At, 0, 1); PG8_STAGE(PG8_SB(0, 0), b2, voffB); PG8_STAGE(PG8_SB(0, 1), b2 + hstep, voffB); PG8_STAGE(PG8_SA(0, 0), a2, voffA);
            PG8_WAIT_V(8); PG8_WAIT_L(0); PG8_BAR; PG8_MMA(1, 0, At, B0); PG8_MMA(1, 1, At, B1); PG8_BAR; PG8_SCHED;
            PG8_LDB(B0, 1, 0); PG8_LDB(B1, 1, 1); PG8_SCHED; PG8_LDA(At, 1, 0); PG8_STAGE(PG8_SA(0, 1), a2 + hstep, voffA);
            PG8_WAIT_V(8); PG8_WAIT_L(0); PG8_BAR; PG8_MMA(0, 0, At, B0); PG8_MMA(0, 1, At, B1); PG8_BAR; PG8_SCHED;
            PG8_LDA(At, 1, 1); PG8_STAGE(PG8_SB(1, 0), b3, voffB); PG8_STAGE(PG8_SB(1, 1), b3 + hstep, voffB); PG8_STAGE(PG8_SA(1, 0), a3, voffA);
            PG8_WAIT_V(8); PG8_WAIT_L(0); PG8_BAR; PG8_MMA(1, 0, At, B0); PG8_MMA(1, 1, At, B1); PG8_BAR; PG8_SCHED;
            } else {
            PG8_LDB(B0, 0, 0); PG8_SCHED; PG8_LDA(At, 0, 0); PG8_STAGE(PG8_SA(1, 1), a1 + hstep, voffA);
            PG8_WAIT_L(8); PG8_BAR; PG8_WAIT_L(0); PG8_MMA(0, 0, At, B0); PG8_BAR; PG8_SCHED;
            PG8_LDB(B1, 0, 1); PG8_STAGE(PG8_SB(0, 0), b2, voffB);
            PG8_BAR; PG8_WAIT_L(0); PG8_MMA(0, 1, At, B1); PG8_BAR;
            PG8_LDA(At, 0, 1); PG8_STAGE(PG8_SA(0, 0), a2, voffA);
            PG8_BAR; PG8_WAIT_L(0); PG8_MMA(1, 0, At, B0); PG8_BAR; PG8_SCHED;
            PG8_STAGE(PG8_SB(0, 1), b2 + hstep, voffB);
            PG8_WAIT_V(6); PG8_BAR; PG8_MMA(1, 1, At, B1); PG8_BAR;
            PG8_LDB(B0, 1, 0); PG8_SCHED; PG8_LDA(At, 1, 0); PG8_STAGE(PG8_SA(0, 1), a2 + hstep, voffA);
            PG8_WAIT_L(8); PG8_BAR; PG8_WAIT_L(0); PG8_MMA(0, 0, At, B0); PG8_BAR; PG8_SCHED;
            PG8_LDB(B1, 1, 1); PG8_STAGE(PG8_SB(1, 0), b3, voffB);
            PG8_BAR; PG8_WAIT_L(0); PG8_MMA(0, 1, At, B1); PG8_BAR;
            PG8_LDA(At, 1, 1); PG8_STAGE(PG8_SA(1, 0), a3, voffA);
            PG8_BAR; PG8_WAIT_L(0); PG8_MMA(1, 0, At, B0); PG8_BAR; PG8_SCHED;
            PG8_STAGE(PG8_SB(1, 1), b3 + hstep, voffB);
            PG8_WAIT_V(6); PG8_BAR; PG8_MMA(1, 1, At, B1); PG8_BAR;
            }
        }
        if constexpr (ALIGN_EPI) { if (wr == 0) PG8_BAR; }
        if constexpr (!Epi::AFTER_DRAIN) { E(acc, cur, wr, wc, fr, fq); S.done(cur); }
        if (!has_next) break;
#pragma unroll
        for (int a = 0; a < 2; ++a)
#pragma unroll
            for (int b = 0; b < 2; ++b)
#pragma unroll
                for (int m = 0; m < 4; ++m)
#pragma unroll
                    for (int n = 0; n < 2; ++n) acc[a][b][m][n] = (f32x4){0.f, 0.f, 0.f, 0.f};
        cur = nxt; cA = nA; cB = nB; ++ui;
        if constexpr (ALIGN_EPI) { if (wr == 1) PG8_BAR; }
    }
    PG8_WAIT_V(0);
    if constexpr (!ALIGN_EPI) { if (wr == 0) PG8_BAR; }
    PG8_BAR;
    if constexpr (Epi::AFTER_DRAIN) { E.fused(acc, cur, wr, wc, fr, fq, lds, wid, lane); S.done(cur); }
#undef PG8_SA
#undef PG8_SB
#undef PG8_STAGE
#undef PG8_LDA
#undef PG8_LDB
#undef PG8_MMA
#undef PG8_WAIT_V
#undef PG8_WAIT_L
#undef PG8_BAR
#undef PG8_SCHED
}
}
constexpr int NWAVES = 8;
constexpr int BATCH = 4, SEQ = 8192, D = 2048, M = BATCH * SEQ, NIN = 4096, LW = 1024, CHUNK = 128, NCHUNK = SEQ / CHUNK;
constexpr int NEXP = 16384;
#ifndef MK_N_LAUNCHES
#define MK_N_LAUNCHES 1
#endif
constexpr int N_LAUNCHES = MK_N_LAUNCHES;
constexpr int PER_PHASE = 11;
constexpr size_t MiB = 1u << 20;
constexpr size_t WS_CTL = 48 * MiB, CTL_ZERO_BYTES = 5 * MiB;
constexpr size_t WS_ROWSS = WS_CTL + 512 * 1024;
constexpr size_t WS_WIN = 2 * MiB, WS_WOUT = 18 * MiB, WS_WQ = 26 * MiB, WS_LRUW = 34 * MiB, WS_WSB = 35 * MiB, WS_AGG = 49 * MiB;
constexpr size_t WS_U = 64 * MiB, WS_V = 128 * MiB, WS_XN = 192 * MiB  , WS_Z = 320 * MiB  ;
constexpr size_t WS_HB = 576 * MiB, WS_IDS = 704 * MiB, WS_GATES = 720 * MiB, WS_PAIRS = 736 * MiB, WS_HBT = 752 * MiB, WS_END = 884 * MiB;
constexpr size_t WS_USCALE = 40 * MiB, WS_VSCALE = 41 * MiB;
constexpr size_t WS_HSCALE = 44 * MiB, WS_CARRY = 45 * MiB;
constexpr size_t WS_H8 = WS_XN, WS_PART = WS_XN + 64 * MiB;
constexpr size_t WS_ASCALE = 42 * MiB, WS_KH = 43 * MiB;
constexpr size_t WS_IDW = WS_PAIRS, WS_AW = 880 * MiB;
constexpr size_t WS_ROWSS2 = WS_CTL + 640 * 1024;
constexpr size_t WS_Y = WS_Z;
constexpr int CW_BAR = 4096;
constexpr int CW_LRUF = 8192;
constexpr int RING_BYTES = 131072;
constexpr int LDSCTL_OFF = 143360, MISC_OFF = LDSCTL_OFF + 320;
constexpr int LDS_BYTES = 147456;
#define GAS __attribute__((address_space(1)))
#define LAS __attribute__((address_space(3)))
typedef unsigned short bf16;
typedef unsigned v4u __attribute__((ext_vector_type(4)));
typedef float f32x4 __attribute__((ext_vector_type(4)));
typedef short bf16x8 __attribute__((ext_vector_type(8)));
typedef GAS unsigned gu32;
typedef GAS unsigned long long gu64;
#define RLX_AGENT __ATOMIC_RELAXED, __HIP_MEMORY_SCOPE_AGENT
#define LDS_WAIT() asm volatile("s_waitcnt lgkmcnt(0)" ::: "memory")
#define VM_WAIT() asm volatile("s_waitcnt vmcnt(0)" ::: "memory")
__device__ __forceinline__ unsigned long long rt() { return __builtin_amdgcn_s_memrealtime(); }
__device__ __forceinline__ unsigned f2bf(float f) { unsigned u = __builtin_bit_cast(unsigned, f); return (u + 0x7fffu + ((u >> 16) & 1u)) >> 16; }
__device__ __forceinline__ unsigned pk2(float lo, float hi) { return f2bf(lo) | (f2bf(hi) << 16); }

#define XB_TMO      128
#define XB_XCNT(j)  (256  + 64 * (j))
#define XB_XSUB(j)  (1280 + 64 * (j))
#define XB_XGEN(j)  (2304 + 64 * (j))
#define XB_TOP      3328
#define XB_TOPGEN   3392
#define XCD_BAR_WORDS 3456
#define XB_SPIN_CAP (1u << 18)

__device__ __forceinline__ unsigned xb_ld(unsigned* p)              { return __hip_atomic_load(p, __ATOMIC_RELAXED, __HIP_MEMORY_SCOPE_AGENT); }
__device__ __forceinline__ unsigned xb_add(unsigned* p, unsigned v) { return __hip_atomic_fetch_add(p, v, __ATOMIC_RELAXED, __HIP_MEMORY_SCOPE_AGENT); }
__device__ __forceinline__ unsigned xb_xcc_id() { return (unsigned)__builtin_amdgcn_s_getreg((3 << 11) | 20) & 0xFu; }
#define XB_SPIN(cond, bar) do { unsigned _sp = 0; while (cond) { __builtin_amdgcn_s_sleep(1); \
    if ((++_sp & 255u) == 0u) { if (xb_ld(&(bar)[XB_TMO])) break; if (_sp > XB_SPIN_CAP) { atomicAdd(&(bar)[XB_TMO], 1u); break; } } } } while (0)

struct XcdBarrier {
    unsigned* bar; unsigned x;
    volatile LAS unsigned* st;
};

__device__ __forceinline__ XcdBarrier xcd_barrier_post(unsigned* bar, volatile LAS unsigned* st) {
    XcdBarrier b; b.bar = bar; b.x = xb_xcc_id(); b.st = st;
    if (threadIdx.x == 0) (void)xb_add(&bar[XB_XCNT(b.x)], 1u);
    return b;
}
__device__ __forceinline__ void xcd_barrier_complete(unsigned* bar, unsigned x, unsigned& nloc, unsigned& nx) {
    const unsigned G = gridDim.x * gridDim.y * gridDim.z;
    unsigned sum, cnt, mine, sp = 0u;
    for (;;) {
        sum = 0u; cnt = 0u; mine = 0u;
#pragma unroll
        for (unsigned j = 0; j < 16; ++j) { const unsigned c = xb_ld(&bar[XB_XCNT(j)]); sum += c; cnt += (c > 0u) ? 1u : 0u; mine = (j == x) ? c : mine; }
        if (sum == G) break;
        __builtin_amdgcn_s_sleep(1);
        if ((++sp & 255u) == 0u) { if (xb_ld(&bar[XB_TMO])) break; if (sp > XB_SPIN_CAP) { atomicAdd(&bar[XB_TMO], 1u); break; } }
    }
    nloc = mine > 0u ? mine : 1u; nx = cnt > 0u ? cnt : 1u;
}

__device__ __forceinline__ void xcd_barrier(const XcdBarrier& b) {
    asm volatile("s_waitcnt vmcnt(0)" ::: "memory");
    __syncthreads();
    if (threadIdx.x == 0) {
        unsigned* bar = b.bar;
        __builtin_amdgcn_s_waitcnt(0);
        unsigned nloc = b.st[0], nx = b.st[1];
        if (nloc == 0u) { xcd_barrier_complete(bar, b.x, nloc, nx); b.st[0] = nloc; b.st[1] = nx; }
        const unsigned old = xb_add(&bar[XB_XSUB(b.x)], 1u);
        const unsigned gen = old / nloc;
        if (old + 1u == (gen + 1u) * nloc) {
            __builtin_amdgcn_fence(__ATOMIC_RELEASE, "agent");
            asm volatile("s_waitcnt vmcnt(0)" ::: "memory");
            const unsigned og = xb_add(&bar[XB_TOP], 1u);
            const unsigned tg = og / nx;
            if (og + 1u == (tg + 1u) * nx) xb_add(&bar[XB_TOPGEN], 1u);
            else XB_SPIN(xb_ld(&bar[XB_TOPGEN]) == tg, bar);
            __builtin_amdgcn_fence(__ATOMIC_ACQUIRE, "agent");
            xb_add(&bar[XB_XGEN(b.x)], 1u);
            asm volatile("s_waitcnt vmcnt(0)" ::: "memory");
        } else {
            XB_SPIN(xb_ld(&bar[XB_XGEN(b.x)]) == gen, bar);
            __builtin_amdgcn_fence(__ATOMIC_ACQUIRE, "agent");
            asm volatile("s_waitcnt vmcnt(0)" ::: "memory");
        }
    }
    __syncthreads();
}
typedef unsigned v2u __attribute__((ext_vector_type(2)));
typedef float f32x2 __attribute__((ext_vector_type(2)));
struct Args { const float* in[21]; float* out; unsigned char* ws; int ph_lo, ph_hi; };
struct Frame {
    const Args& A;
    LAS unsigned char* lds;
    volatile LAS unsigned* MISC;
    gu32* ctl;
    unsigned char* ws;
    int tid, lane, wave, vcu, G;
    __device__ __forceinline__ Frame(const Args& a) : A(a) {}
#define WSP(name, type, off) __device__ __forceinline__ type* name() const { return (type*)(ws + (off)); }
    WSP(WIN, bf16, WS_WIN) WSP(WOUT, bf16, WS_WOUT) WSP(WQ, bf16, WS_WQ) WSP(LRUW, bf16, WS_LRUW) WSP(WSB, bf16, WS_WSB)
    WSP(XN, bf16, WS_XN) WSP(MIX, bf16, WS_XN) WSP(Z, bf16, WS_Z) WSP(HB, bf16, WS_HB) WSP(HBT, bf16, WS_HBT)
    WSP(U8, unsigned char, WS_U) WSP(V8T, unsigned char, WS_V)
    WSP(ROWSS, float, WS_ROWSS) WSP(ROWSS2, float, WS_ROWSS2) WSP(QH, bf16, WS_Z) WSP(QL, bf16, WS_Z + 128 * MiB) WSP(KH, bf16, WS_KH) WSP(KL, bf16, WS_KH + 512 * 1024) WSP(AGG, float, WS_AGG) WSP(CARRY, float, WS_CARRY) WSP(AU, unsigned, WS_HB) WSP(GATES, float, WS_GATES)
    WSP(USCALE, float, WS_USCALE) WSP(VSCALE, float, WS_VSCALE) WSP(Y, bf16, WS_Y) WSP(IDS, int, WS_IDS) WSP(ASCALE, float, WS_ASCALE) WSP(IDW, v4u, WS_IDW) WSP(AW, unsigned, WS_AW) WSP(H8, unsigned char, WS_H8) WSP(HSCALE, float, WS_HSCALE) WSP(PART, int, WS_PART)
#undef WSP
};
__device__ __forceinline__ float wave_sum(float v) {
#pragma unroll
    for (int o = 1; o < 64; o <<= 1) v += __shfl_xor(v, o);
    return v;
}
__device__ __forceinline__ float bf_lo(unsigned w) { return __builtin_bit_cast(float, w << 16); }
__device__ __forceinline__ float bf_hi(unsigned w) { return __builtin_bit_cast(float, w & 0xffff0000u); }
__device__ __forceinline__ float bf1(unsigned short h) { return __builtin_bit_cast(float, (unsigned)h << 16); }
__device__ __forceinline__ float sigmoidf_(float x) { return __builtin_amdgcn_rcpf(1.0f + __builtin_amdgcn_exp2f(-1.4426950409f * x)); }
using pg8::gelu_tanh;
__device__ __forceinline__ unsigned pack_i8x4(float a, float b, float c, float d) {
    const int ia = (int)__builtin_rintf(a), ib = (int)__builtin_rintf(b), ic = (int)__builtin_rintf(c), id = (int)__builtin_rintf(d);
    return (unsigned)(ia & 0xff) | ((unsigned)(ib & 0xff) << 8) | ((unsigned)(ic & 0xff) << 16) | ((unsigned)id << 24);
}

__device__ __forceinline__ void p0_transpose_item(const float* W, int K, int N, bf16* WT, const float* kscale, LAS float* scr, int item, int lane) {
    const int nblk = N / 32, kb = item / nblk, nb = item % nblk, k0 = 64 * kb, n0 = 32 * nb;
#pragma unroll 8
    for (int i = 0; i < 32; ++i) { const int kk = 2 * i + (lane >> 5); const float sc = kscale ? kscale[k0 + kk] : 1.0f; scr[kk * 33 + (lane & 31)] = W[(size_t)(k0 + kk) * N + n0 + (lane & 31)] * sc; }
    LDS_WAIT(); asm volatile("" ::: "memory");
    const int c = lane & 7;
#pragma unroll
    for (int j = 0; j < 4; ++j) { const int n = (lane >> 3) + 8 * j; const LAS float* s = scr + (8 * c) * 33 + n;
        v4u o; o.x = pk2(s[0 * 33], s[1 * 33]); o.y = pk2(s[2 * 33], s[3 * 33]); o.z = pk2(s[4 * 33], s[5 * 33]); o.w = pk2(s[6 * 33], s[7 * 33]);
        *(GAS v4u*)(WT + (size_t)(n0 + n) * K + k0 + 8 * c) = o; }
    LDS_WAIT(); asm volatile("" ::: "memory");
}
__device__ __forceinline__ void p0_prologue(Frame& F) {
    LAS float* scr = (LAS float*)(F.lds + F.wave * 16384);
    const int gw = F.vcu * NWAVES + F.wave, NGW = F.G * NWAVES, lane = F.lane;
    constexpr int I_IN = (D / 64) * (NIN / 32), I_OUT = (D / 64) * (D / 32), I_Q = I_OUT, I_LRU = 32 * 8;
    constexpr int NITEMS = I_IN + I_OUT + I_Q + I_LRU;
    for (int it = gw; it < NITEMS; it += NGW) {
        int r = it;
        if (r < I_IN) { p0_transpose_item(F.A.in[2], D, NIN, F.WIN(), F.A.in[1], scr, r, lane); continue; } r -= I_IN;
        if (r < I_OUT) { p0_transpose_item(F.A.in[14], D, D, F.WOUT(), nullptr, scr, r, lane); continue; } r -= I_OUT;
        if (r < I_Q) { p0_transpose_item(F.A.in[16], D, D, F.WQ(), F.A.in[15], scr, r, lane); continue; } r -= I_Q;
        { const int mi = r >> 3, sub = r & 7, gate = mi >> 4, rest = mi & 15;
          const float* src = (gate ? F.A.in[7] : F.A.in[5]) + (size_t)rest * 16384;
          p0_transpose_item(src, 128, 128, F.LRUW() + (size_t)mi * 16384, nullptr, scr, sub, lane); }
    }
    const size_t gt = (size_t)gw * 64 + lane, NGT = (size_t)NGW * 64;
    {
        const float* g2 = F.A.in[15];
        f32x4 gg[8];
#pragma unroll
        for (int j = 0; j < 8; ++j) gg[j] = *(const GAS f32x4*)(g2 + j * 256 + lane * 4);
        for (int e = gw; e < NEXP; e += NGW) {
            const GAS f32x4* ur = (const GAS f32x4*)(F.A.in[18] + (size_t)e * D) + lane;
            f32x4 v[8]; float ss = 0.f;
#pragma unroll
            for (int j = 0; j < 8; ++j) { v[j] = __builtin_nontemporal_load(ur + 64 * j) * gg[j]; ss += (v[j].x * v[j].x + v[j].y * v[j].y) + (v[j].z * v[j].z + v[j].w * v[j].w); }
            const float rms = __builtin_amdgcn_sqrtf(wave_sum(ss) * (1.0f / D));
            const float sc = rms > 0.f ? 7.0f / (2.8f * rms) : 1.0f;
            GAS unsigned* o4 = (GAS unsigned*)(F.U8() + (size_t)e * 1024) + (lane >> 1);
#pragma unroll
            for (int j = 0; j < 8; ++j) {
                const int c0 = (int)fminf(fmaxf(__builtin_rintf(v[j].x * sc), -7.f), 7.f) & 15, c1 = (int)fminf(fmaxf(__builtin_rintf(v[j].y * sc), -7.f), 7.f) & 15;
                const int c2 = (int)fminf(fmaxf(__builtin_rintf(v[j].z * sc), -7.f), 7.f) & 15, c3 = (int)fminf(fmaxf(__builtin_rintf(v[j].w * sc), -7.f), 7.f) & 15;
                const unsigned cw = (unsigned)c0 | ((unsigned)c1 << 8) | ((unsigned)c2 << 16) | ((unsigned)c3 << 24);
                const unsigned pw = (unsigned)__shfl_xor((int)cw, 1);
                if ((lane & 1) == 0) __builtin_nontemporal_store(cw | (pw << 4), o4 + 32 * j);
            }
            if (lane == 0) F.USCALE()[e] = rms > 0.f ? 2.8f * rms * (1.0f / 7.0f) : 1.0f;
        }
    }
    __syncthreads();
    for (int un = blockIdx.x; un < NEXP / 64; un += F.G) {
        const int e0 = un * 64;
        for (int rr = 0; rr < 8; ++rr) {
            const int el = F.wave * 8 + rr, e = e0 + el;
            const GAS f32x4* vr = (const GAS f32x4*)(F.A.in[19] + (size_t)e * D) + lane;
            f32x4 v[8]; float mx = 0.f;
#pragma unroll
            for (int j = 0; j < 8; ++j) { v[j] = __builtin_nontemporal_load(vr + 64 * j); mx = fmaxf(mx, fmaxf(fmaxf(fabsf(v[j].x), fabsf(v[j].y)), fmaxf(fabsf(v[j].z), fabsf(v[j].w)))); }
#pragma unroll
            for (int o = 1; o < 64; o <<= 1) mx = fmaxf(mx, __shfl_xor(mx, o));
            const float sc = mx > 0.f ? 127.0f / mx : 1.0f;
#pragma unroll
            for (int j = 0; j < 8; ++j) *(LAS unsigned*)(F.lds + el * 2056 + j * 256 + lane * 4) = pack_i8x4(v[j].x * sc, v[j].y * sc, v[j].z * sc, v[j].w * sc);
            if (lane == 0) F.VSCALE()[e] = mx > 0.f ? mx * (1.0f / 127.0f) : 1.0f;
        }
        __syncthreads();
        for (int cc = 0; cc < 32; ++cc) { const int c = F.wave * 32 + cc;
            const v2u w = *(const LAS v2u*)(F.lds + lane * 2056 + c * 8);
            __builtin_nontemporal_store(w, (v2u*)(F.V8T() + ((size_t)c * NEXP + e0 + lane) * 8)); }
        __syncthreads();
    }
    for (size_t ch = gt; ch < (size_t)8 * 128 * 128 / 8; ch += NGT) {
        const size_t e0 = ch * 8;
        const f32x4 a = *(const GAS f32x4*)(F.A.in[12] + e0), b = *(const GAS f32x4*)(F.A.in[12] + e0 + 4);
        v4u o; o.x = pk2(a.x, a.y); o.y = pk2(a.z, a.w); o.z = pk2(b.x, b.y); o.w = pk2(b.z, b.w);
        *(GAS v4u*)(F.WSB() + e0) = o;
    }
    for (size_t ch = gt; ch < (size_t)16 * 128 * 128 / 8; ch += NGT) {
        const size_t e0 = ch * 8;
        const f32x4 a = *(const GAS f32x4*)(F.A.in[17] + e0), b = *(const GAS f32x4*)(F.A.in[17] + e0 + 4);
        v4u hi; hi.x = pk2(a.x, a.y); hi.y = pk2(a.z, a.w); hi.z = pk2(b.x, b.y); hi.w = pk2(b.z, b.w);
        *(GAS v4u*)(F.KH() + e0) = hi;
    }
    for (int m = gw; m < M; m += NGW) {
        const GAS f32x4* xr = (const GAS f32x4*)(F.A.in[0] + (size_t)m * D) + lane;
        f32x4 v[8]; float s = 0.f;
#pragma unroll
        for (int j = 0; j < 8; ++j) { v[j] = __builtin_nontemporal_load(xr + 64 * j); s += (v[j].x * v[j].x + v[j].y * v[j].y) + (v[j].z * v[j].z + v[j].w * v[j].w); }
        const float rstd = __builtin_amdgcn_rsqf(wave_sum(s) * (1.f / D) + 1e-6f);
        GAS unsigned long long* o8 = (GAS unsigned long long*)(F.XN() + (size_t)m * D) + lane;
#pragma unroll
        for (int j = 0; j < 8; ++j) o8[64 * j] = (unsigned long long)pk2(v[j].x * rstd, v[j].y * rstd) | ((unsigned long long)pk2(v[j].z * rstd, v[j].w * rstd) << 32);
    }
}
constexpr int LRU_XR = 0, LRU_XC = 33792, LRU_GR = 33792 + 40960;
constexpr float LOG2E = 1.4426950408889634f;
__device__ __forceinline__ int xc_off(int tok, int ch) { return tok * 320 + (tok >> 5) * 16 + ch * 2; }
template <bool APPLY, int DIR>
__device__ __forceinline__ void lru_dir(Frame& F, int unit, int b, int c, int h, const bf16x8 (&Ba)[4], const bf16x8 (&Bx)[4], float (&hsum)[8][4]) {
    const int lane = F.lane, w = F.wave, fr = lane & 15, fq = lane >> 4;
    LAS unsigned char* XC = F.lds + LRU_XC;
    const int chl = 16 * w + fr, chg = h * 128 + chl;
    v4u* au = (v4u*)F.AU() + ((size_t)((unit * 2 + DIR) * NWAVES + w) * 8) * 64 + lane;
    f32x4 R[8], I[8];
    float carry = 0.f;
    if (APPLY) {
        carry = F.CARRY()[(size_t)((b * 2 + DIR) * NCHUNK + c) * LW + chg];
        v4u q[8];
#pragma unroll
        for (int m = 0; m < 8; ++m) q[m] = __builtin_nontemporal_load(au + m * 64);
#pragma unroll
        for (int m = 0; m < 8; ++m) {
            R[m] = (f32x4){__builtin_amdgcn_exp2f(bf_lo(q[m].x)), __builtin_amdgcn_exp2f(bf_lo(q[m].y)), __builtin_amdgcn_exp2f(bf_lo(q[m].z)), __builtin_amdgcn_exp2f(bf_lo(q[m].w))};
            I[m] = (f32x4){bf_hi(q[m].x), bf_hi(q[m].y), bf_hi(q[m].z), bf_hi(q[m].w)}; }
    } else {
        const float ba = F.A.in[6][DIR * LW + chg], bx = F.A.in[8][DIR * LW + chg], lam = F.A.in[9][DIR * LW + chg];
        const float cl = -8.0f * log1pf(__expf(-lam)) * LOG2E;
        const int arow = (fr >> 2) * 32 + (fr & 3);
#pragma unroll
        for (int m = 0; m < 8; ++m) {
            R[m] = (f32x4){0.f, 0.f, 0.f, 0.f}; I[m] = (f32x4){0.f, 0.f, 0.f, 0.f};
#pragma unroll
            for (int ks = 0; ks < 4; ++ks) {
                const bf16x8 a = *(const LAS bf16x8*)(XC + xc_off(arow + 4 * m, 32 * ks + 8 * fq));
                R[m] = __builtin_amdgcn_mfma_f32_16x16x32_bf16(a, Ba[ks], R[m], 0, 0, 0);
                I[m] = __builtin_amdgcn_mfma_f32_16x16x32_bf16(a, Bx[ks], I[m], 0, 0, 0);
            }
        }
#pragma unroll
        for (int m = 0; m < 8; ++m) {
            float la[4];
#pragma unroll
            for (int j = 0; j < 4; ++j) {
                const float r = sigmoidf_(R[m][j] + ba), ig = sigmoidf_(I[m][j] + bx);
                la[j] = cl * r;
                const float a = __builtin_amdgcn_exp2f(la[j]);
                const float xc = bf1(*(const LAS unsigned short*)(XC + xc_off(32 * fq + 4 * m + j, chl)));
                R[m][j] = a; I[m][j] = __builtin_amdgcn_sqrtf(fmaxf(1.0f - a * a, 0.0f)) * (ig * xc);
            }
            __builtin_nontemporal_store((v4u){pk2(la[0], I[m][0]), pk2(la[1], I[m][1]), pk2(la[2], I[m][2]), pk2(la[3], I[m][3])}, au + m * 64);
        }
    }
    float P = 1.f, L = 0.f;
#pragma unroll
    for (int mm = 0; mm < 8; ++mm) {
        const int m = DIR == 0 ? mm : 7 - mm;
#pragma unroll
        for (int jj = 0; jj < 4; ++jj) {
            const int j = DIR == 0 ? jj : 3 - jj;
            const float a = R[m][j], u = I[m][j];
            L = a * L + u; P = a * P;
            R[m][j] = P; I[m][j] = L;
        }
    }
    const int src1 = DIR == 0 ? lane - 16 : lane + 16, src2 = DIR == 0 ? lane - 32 : lane + 32;
    const bool v1 = DIR == 0 ? (fq >= 1) : (fq <= 2), v2 = DIR == 0 ? (fq >= 2) : (fq <= 1);
    float A = P, B = L;
    { const float pa = __shfl(A, src1), pb = __shfl(B, src1); if (v1) { B = A * pb + B; A = A * pa; } }
    { const float pa = __shfl(A, src2), pb = __shfl(B, src2); if (v2) { B = A * pb + B; A = A * pa; } }
    if (APPLY) {
        float EA = __shfl(A, src1), EB = __shfl(B, src1); if (!v1) { EA = 1.f; EB = 0.f; }
        const float hin = EA * carry + EB;
#pragma unroll
        for (int m = 0; m < 8; ++m)
#pragma unroll
            for (int j = 0; j < 4; ++j) { const float hh = R[m][j] * hin + I[m][j]; if (DIR == 0) hsum[m][j] = hh; else hsum[m][j] += hh; }
    } else {
        const bool lastlane = DIR == 0 ? (fq == 3) : (fq == 0);
        if (lastlane) { f32x2* agg = (f32x2*)F.AGG() + (size_t)((b * 2 + DIR) * NCHUNK + c) * LW + chg; *agg = (f32x2){A, B}; }
    }
}

template <bool APPLY>
__device__ __forceinline__ void lru_unit(Frame& F, int unit) {
    const int h = unit & 7, c = (unit >> 3) & 63, b = unit >> 9;
    const int tid = F.tid, lane = F.lane, w = F.wave, fr = lane & 15, fq = lane >> 4;
    const size_t t0 = (size_t)b * SEQ + (size_t)c * CHUNK;
    LAS unsigned char* XR = F.lds + LRU_XR; LAS unsigned char* XC = F.lds + LRU_XC; LAS unsigned char* GR = F.lds + LRU_GR;
    bf16x8 Ba0[4], Bx0[4], Ba1[4], Bx1[4];
    if (!APPLY) {
        const bf16* wb = F.LRUW() + (size_t)h * 16384 + (size_t)(16 * w + fr) * 128 + 8 * fq;
#pragma unroll
        for (int ks = 0; ks < 4; ++ks) { Ba0[ks] = *(const GAS bf16x8*)(wb + 32 * ks); Ba1[ks] = *(const GAS bf16x8*)(wb + (size_t)8 * 16384 + 32 * ks);
            Bx0[ks] = *(const GAS bf16x8*)(wb + (size_t)16 * 16384 + 32 * ks); Bx1[ks] = *(const GAS bf16x8*)(wb + (size_t)24 * 16384 + 32 * ks); }
        for (int p = tid; p < 131 * 16; p += 512) { const int r = p >> 4, cg = p & 15; const int s = c * CHUNK - 2 + r; v4u v = (v4u){0u, 0u, 0u, 0u};
            if (s >= 0 && s < SEQ) v = *(const GAS v4u*)(F.Z() + ((size_t)b * SEQ + s) * NIN + h * 128 + cg * 8);
            *(LAS v4u*)(XR + r * 256 + cg * 16) = v; }
        __syncthreads();
        {
            const int ch2 = tid & 63, tg = tid >> 6, chg = h * 128 + 2 * ch2;
            float w0[4], w1[4];
#pragma unroll
            for (int k = 0; k < 4; ++k) { w0[k] = F.A.in[3][k * LW + chg]; w1[k] = F.A.in[3][k * LW + chg + 1]; }
            const float b0 = F.A.in[4][chg], b1 = F.A.in[4][chg + 1];
            float x0[4], x1[4];
#pragma unroll
            for (int k = 0; k < 3; ++k) { const unsigned u = *(const LAS unsigned*)(XR + (16 * tg + k) * 256 + ch2 * 4); x0[k] = bf_lo(u); x1[k] = bf_hi(u); }
#pragma unroll
            for (int j = 0; j < 16; ++j) {
                const unsigned u = *(const LAS unsigned*)(XR + (16 * tg + j + 3) * 256 + ch2 * 4); x0[3] = bf_lo(u); x1[3] = bf_hi(u);
                const float y0 = b0 + ((w0[0] * x0[0] + w0[1] * x0[1]) + (w0[2] * x0[2] + w0[3] * x0[3]));
                const float y1 = b1 + ((w1[0] * x1[0] + w1[1] * x1[1]) + (w1[2] * x1[2] + w1[3] * x1[3]));
                *(LAS unsigned*)(XC + xc_off(16 * tg + j, 2 * ch2)) = pk2(y0, y1);
                x0[0] = x0[1]; x0[1] = x0[2]; x0[2] = x0[3]; x1[0] = x1[1]; x1[1] = x1[2]; x1[2] = x1[3];
            }
        }
        __syncthreads();
    } else {
#pragma unroll
        for (int ks = 0; ks < 4; ++ks) { Ba0[ks] = Ba1[ks] = Bx0[ks] = Bx1[ks] = (bf16x8){0, 0, 0, 0, 0, 0, 0, 0}; }
        for (int p = tid; p < 128 * 32; p += 512) { const int r = p >> 5, cg = p & 31;
            *(LAS v2u*)(GR + r * 264 + cg * 8) = *(const GAS v2u*)(F.Z() + (t0 + r) * NIN + LW + h * 128 + cg * 4); }
    }
    float hsum[8][4];
    lru_dir<APPLY, 0>(F, unit, b, c, h, Ba0, Bx0, hsum);
    asm volatile("" ::: "memory"); __builtin_amdgcn_sched_barrier(0);
    lru_dir<APPLY, 1>(F, unit, b, c, h, Ba1, Bx1, hsum);
    if (APPLY) {
        const int chl = 16 * w + fr;
        __syncthreads();
#pragma unroll
        for (int m = 0; m < 8; ++m)
#pragma unroll
            for (int j = 0; j < 4; ++j) { LAS unsigned short* p = (LAS unsigned short*)(GR + (32 * fq + 4 * m + j) * 264 + chl * 2); *p = (unsigned short)f2bf(bf1(*p) * hsum[m][j]); }
        __syncthreads();
        for (int p = tid; p < 128 * 32; p += 512) { const int r = p >> 5, cg = p & 31;
            *(GAS v2u*)(F.MIX() + (t0 + r) * D + h * 128 + cg * 4) = *(const LAS v2u*)(GR + r * 264 + cg * 8); }
    }
    __syncthreads();
}

constexpr int LRU_PT = LRU_XR, LRU_CR = LRU_XR + 8192;
template <int DIR>
__device__ __forceinline__ void lru_scan_dir(Frame& F, int b, int c, int h, const bf16x8 (&Ba)[4], const bf16x8 (&Bx)[4], f32x4 (&R)[8], f32x4 (&I)[8], float& EA, float& EB) {
    const int lane = F.lane, w = F.wave, fr = lane & 15, fq = lane >> 4;
    LAS unsigned char* XC = F.lds + LRU_XC;
    const int chl = 16 * w + fr, chg = h * 128 + chl;
    {
        const float ba = F.A.in[6][DIR * LW + chg], bx = F.A.in[8][DIR * LW + chg], lam = F.A.in[9][DIR * LW + chg];
        const float cl = -8.0f * log1pf(__expf(-lam)) * LOG2E;
        const int arow = (fr >> 2) * 32 + (fr & 3);
#pragma unroll
        for (int m = 0; m < 8; ++m) {
            R[m] = (f32x4){0.f, 0.f, 0.f, 0.f}; I[m] = (f32x4){0.f, 0.f, 0.f, 0.f};
#pragma unroll
            for (int ks = 0; ks < 4; ++ks) {
                const bf16x8 a = *(const LAS bf16x8*)(XC + xc_off(arow + 4 * m, 32 * ks + 8 * fq));
                R[m] = __builtin_amdgcn_mfma_f32_16x16x32_bf16(a, Ba[ks], R[m], 0, 0, 0);
                I[m] = __builtin_amdgcn_mfma_f32_16x16x32_bf16(a, Bx[ks], I[m], 0, 0, 0);
            }
        }
#pragma unroll
        for (int m = 0; m < 8; ++m) {
#pragma unroll
            for (int j = 0; j < 4; ++j) {
                const float r = sigmoidf_(R[m][j] + ba), ig = sigmoidf_(I[m][j] + bx);
                const float a = __builtin_amdgcn_exp2f(cl * r);
                const float xc = bf1(*(const LAS unsigned short*)(XC + xc_off(32 * fq + 4 * m + j, chl)));
                R[m][j] = a; I[m][j] = __builtin_amdgcn_sqrtf(fmaxf(1.0f - a * a, 0.0f)) * (ig * xc);
            }
        }
    }
    float P = 1.f, L = 0.f;
#pragma unroll
    for (int mm = 0; mm < 8; ++mm) {
        const int m = DIR == 0 ? mm : 7 - mm;
#pragma unroll
        for (int jj = 0; jj < 4; ++jj) {
            const int j = DIR == 0 ? jj : 3 - jj;
            const float a = R[m][j], u = I[m][j];
            L = a * L + u; P = a * P;
            R[m][j] = P; I[m][j] = L;
        }
    }
    const int src1 = DIR == 0 ? lane - 16 : lane + 16, src2 = DIR == 0 ? lane - 32 : lane + 32;
    const bool v1 = DIR == 0 ? (fq >= 1) : (fq <= 2), v2 = DIR == 0 ? (fq >= 2) : (fq <= 1);
    float A = P, B = L;
    { const float pa = __shfl(A, src1), pb = __shfl(B, src1); if (v1) { B = A * pb + B; A = A * pa; } }
    { const float pa = __shfl(A, src2), pb = __shfl(B, src2); if (v2) { B = A * pb + B; A = A * pa; } }
    EA = __shfl(A, src1); EB = __shfl(B, src1); if (!v1) { EA = 1.f; EB = 0.f; }
    const bool lastlane = DIR == 0 ? (fq == 3) : (fq == 0);
    if (lastlane) {
        const unsigned long long word = (unsigned long long)(__builtin_bit_cast(unsigned, A) | 1u) | ((unsigned long long)__builtin_bit_cast(unsigned, B) << 32);
        __hip_atomic_store((unsigned long long*)F.AGG() + (size_t)((b * 2 + DIR) * NCHUNK + c) * LW + chg, word, RLX_AGENT);
    }
}
__device__ __forceinline__ void lru_decode(int unit, int& b, int& c, int& h) { const int rnd = unit >> 8, within = unit & 255; b = rnd >> 1; h = (rnd & 1) * 4 + (within & 3); c = within >> 2; }
__device__ __forceinline__ void lru_prefetch(Frame& F, int unit, int tid, v4u (&xr)[5]) {
    int b, c, h; lru_decode(unit, b, c, h);
#pragma unroll
    for (int i = 0; i < 5; ++i) { const int p = tid + 512 * i, r = p >> 4, cg = p & 15; const int s = c * CHUNK - 2 + r; xr[i] = (v4u){0u, 0u, 0u, 0u};
        if (p < 131 * 16 && s >= 0 && s < SEQ) xr[i] = *(const GAS v4u*)(F.Z() + ((size_t)b * SEQ + s) * NIN + h * 128 + cg * 8); }
}
__device__ __forceinline__ void lru_fused_unit(Frame& F, int unit, int next, v4u (&xr)[5]) {
    int b, c, h; lru_decode(unit, b, c, h);
    int tid = F.tid; asm volatile("" : "+v"(tid));
    const int lane = tid & 63, w = F.wave, fr = lane & 15, fq = lane >> 4;
    const size_t t0 = (size_t)b * SEQ + (size_t)c * CHUNK;
    LAS unsigned char* XR = F.lds + LRU_XR; LAS unsigned char* XC = F.lds + LRU_XC; LAS unsigned char* GR = F.lds + LRU_GR;
    bf16x8 Ba0[4], Bx0[4], Ba1[4], Bx1[4];
    {
        const bf16* wb = F.LRUW() + (size_t)h * 16384 + (size_t)(16 * w + fr) * 128 + 8 * fq;
#pragma unroll
        for (int ks = 0; ks < 4; ++ks) { Ba0[ks] = *(const GAS bf16x8*)(wb + 32 * ks); Ba1[ks] = *(const GAS bf16x8*)(wb + (size_t)8 * 16384 + 32 * ks);
            Bx0[ks] = *(const GAS bf16x8*)(wb + (size_t)16 * 16384 + 32 * ks); Bx1[ks] = *(const GAS bf16x8*)(wb + (size_t)24 * 16384 + 32 * ks); }
#pragma unroll
        for (int i = 0; i < 5; ++i) { const int p = tid + 512 * i, r = p >> 4, cg = p & 15; if (p < 131 * 16) *(LAS v4u*)(XR + r * 256 + cg * 16) = xr[i]; }
        v2u gr[8];
#pragma unroll
        for (int i = 0; i < 8; ++i) { const int p = tid + 512 * i, r = p >> 5, cg = p & 31;
            gr[i] = *(const GAS v2u*)(F.Z() + (t0 + r) * NIN + LW + h * 128 + cg * 4); }
        __syncthreads();
        {
            const int ch2 = tid & 63, tg = tid >> 6, chg = h * 128 + 2 * ch2;
            float w0[4], w1[4];
#pragma unroll
            for (int k = 0; k < 4; ++k) { w0[k] = F.A.in[3][k * LW + chg]; w1[k] = F.A.in[3][k * LW + chg + 1]; }
            const float b0 = F.A.in[4][chg], b1 = F.A.in[4][chg + 1];
            float x0[4], x1[4];
#pragma unroll
            for (int k = 0; k < 3; ++k) { const unsigned u = *(const LAS unsigned*)(XR + (16 * tg + k) * 256 + ch2 * 4); x0[k] = bf_lo(u); x1[k] = bf_hi(u); }
#pragma unroll
            for (int j = 0; j < 16; ++j) {
                const unsigned u = *(const LAS unsigned*)(XR + (16 * tg + j + 3) * 256 + ch2 * 4); x0[3] = bf_lo(u); x1[3] = bf_hi(u);
                const float y0 = b0 + ((w0[0] * x0[0] + w0[1] * x0[1]) + (w0[2] * x0[2] + w0[3] * x0[3]));
                const float y1 = b1 + ((w1[0] * x1[0] + w1[1] * x1[1]) + (w1[2] * x1[2] + w1[3] * x1[3]));
                *(LAS unsigned*)(XC + xc_off(16 * tg + j, 2 * ch2)) = pk2(y0, y1);
                x0[0] = x0[1]; x0[1] = x0[2]; x0[2] = x0[3]; x1[0] = x1[1]; x1[1] = x1[2]; x1[2] = x1[3];
            }
        }
#pragma unroll
        for (int i = 0; i < 8; ++i) { const int p = tid + 512 * i, r = p >> 5, cg = p & 31; *(LAS v2u*)(GR + r * 264 + cg * 8) = gr[i]; }
        __syncthreads();
    }
    f32x4 R0[8], I0[8], R1[8], I1[8]; float EA0, EB0, EA1, EB1;
    lru_scan_dir<0>(F, b, c, h, Ba0, Bx0, R0, I0, EA0, EB0);
    asm volatile("" ::: "memory"); __builtin_amdgcn_sched_barrier(0);
    lru_scan_dir<1>(F, b, c, h, Ba1, Bx1, R1, I1, EA1, EB1);
    if (next >= 0) lru_prefetch(F, next, tid, xr);
    {
        const int ch = tid & 127, kq = tid >> 7;
        const unsigned long long* ab = (const unsigned long long*)F.AGG() + (size_t)b * 2 * NCHUNK * LW + h * 128 + ch;
        unsigned long long v[16];
#pragma unroll
        for (int i = 0; i < 16; ++i) { const int k = min(16 * kq + i, 62); const int row = k < c ? k : NCHUNK + k + 1;
            v[i] = __hip_atomic_load(ab + (size_t)row * LW, RLX_AGENT); }
        for (unsigned sp = 0; sp < (1u << 16); ++sp) {
            bool bad = false;
#pragma unroll
            for (int i = 0; i < 16; ++i) if (v[i] == 0ull) { const int k = min(16 * kq + i, 62); const int row = k < c ? k : NCHUNK + k + 1;
                v[i] = __hip_atomic_load(ab + (size_t)row * LW, RLX_AGENT); bad = bad || (v[i] == 0ull); }
            if (!bad) break;
            __builtin_amdgcn_s_sleep(2);
        }
        float fa = 1.f, fb = 0.f, ga = 1.f, gb = 0.f;
#pragma unroll
        for (int i = 0; i < 16; ++i) { const int k = 16 * kq + i; const float A = __builtin_bit_cast(float, (unsigned)v[i]), B = __builtin_bit_cast(float, (unsigned)(v[i] >> 32));
            if (k < c) { fb = A * fb + B; fa = A * fa; } }
#pragma unroll
        for (int i = 15; i >= 0; --i) { const int k = 16 * kq + i; const float A = __builtin_bit_cast(float, (unsigned)v[i]), B = __builtin_bit_cast(float, (unsigned)(v[i] >> 32));
            if (k >= c && k < 63) { gb = A * gb + B; ga = A * ga; } }
        *(LAS f32x4*)(F.lds + LRU_PT + (kq * 128 + ch) * 16) = (f32x4){fa, fb, ga, gb};
    }
    __syncthreads();
    if (tid < 256) {
        const int dir = tid >> 7, ch = tid & 127;
        f32x4 q[4];
#pragma unroll
        for (int k = 0; k < 4; ++k) q[k] = *(const LAS f32x4*)(F.lds + LRU_PT + (k * 128 + ch) * 16);
        float st = 0.f;
        if (dir == 0) { st = q[0].y; st = q[1].x * st + q[1].y; st = q[2].x * st + q[2].y; st = q[3].x * st + q[3].y; }
        else { st = q[3].w; st = q[2].z * st + q[2].w; st = q[1].z * st + q[1].w; st = q[0].z * st + q[0].w; }
        *(LAS float*)(F.lds + LRU_CR + tid * 4) = st;
    }
    __syncthreads();
    {
        const int chl = 16 * w + fr;
        const float hin0 = EA0 * *(const LAS float*)(F.lds + LRU_CR + chl * 4) + EB0, hin1 = EA1 * *(const LAS float*)(F.lds + LRU_CR + 512 + chl * 4) + EB1;
#pragma unroll
        for (int m = 0; m < 8; ++m)
#pragma unroll
            for (int j = 0; j < 4; ++j) { const float hs = (R0[m][j] * hin0 + I0[m][j]) + (R1[m][j] * hin1 + I1[m][j]);
                LAS unsigned short* p = (LAS unsigned short*)(GR + (32 * fq + 4 * m + j) * 264 + chl * 2); *p = (unsigned short)f2bf(bf1(*p) * hs); }
        __syncthreads();
        for (int p = tid; p < 128 * 32; p += 512) { const int r = p >> 5, cg = p & 31;
            *(GAS v2u*)(F.MIX() + (t0 + r) * D + h * 128 + cg * 4) = *(const LAS v2u*)(GR + r * 264 + cg * 8); }
    }
    __syncthreads();
}
__device__ __forceinline__ void lru_carry(Frame& F) {
    const int idx = (F.vcu * NWAVES + F.wave) * 64 + F.lane;
    if (idx >= BATCH * 2 * LW) return;
    const int ch = idx & (LW - 1), bd = idx >> 10, dir = bd & 1;
    const f32x2* agg = (const f32x2*)F.AGG() + (size_t)bd * NCHUNK * LW + ch; float* cr = F.CARRY() + (size_t)bd * NCHUNK * LW + ch;
    float st = 0.f;
#pragma unroll 8
    for (int i = 0; i < NCHUNK; ++i) { const int cc = dir == 0 ? i : NCHUNK - 1 - i; const f32x2 pe = agg[(size_t)cc * LW]; cr[(size_t)cc * LW] = st; st = pe.x * st + pe.y; }
}
constexpr int GM_ST = 0, GM_BS = 1024, GM_VN = 2048, GM_GU = 2048 + 32768;
typedef short s16x4 __attribute__((ext_vector_type(4)));
__device__ __forceinline__ unsigned vn_off(unsigned row, unsigned ch) { return 256u * row + 16u * (ch ^ (((row & 3u) << 2) | ((row >> 2) & 3u))); }
__device__ __forceinline__ void gmlp_unit(Frame& F, int unit) {
    const int tid = F.tid, lane = F.lane, w = F.wave, fr = lane & 15, fq = lane >> 4;
    const size_t t0 = (size_t)unit * CHUNK;
    LAS float* ST = (LAS float*)(F.lds + GM_ST); LAS float* BS = (LAS float*)(F.lds + GM_BS);
    LAS unsigned char* VN = F.lds + GM_VN; LAS unsigned char* GU = F.lds + GM_GU;
    for (int rr = 0; rr < 16; ++rr) {
        const int row = 16 * w + rr;
        const bf16* p = F.Z() + (t0 + row) * NIN + 3 * LW + lane * 8;
        const v4u a = *(const GAS v4u*)p, b = *(const GAS v4u*)(p + 512);
        float x[16] = {bf_lo(a.x), bf_hi(a.x), bf_lo(a.y), bf_hi(a.y), bf_lo(a.z), bf_hi(a.z), bf_lo(a.w), bf_hi(a.w),
                       bf_lo(b.x), bf_hi(b.x), bf_lo(b.y), bf_hi(b.y), bf_lo(b.z), bf_hi(b.z), bf_lo(b.w), bf_hi(b.w)};
        float s = 0.f;
#pragma unroll
        for (int i = 0; i < 16; ++i) s += x[i];
        const float mean = wave_sum(s) * (1.0f / LW);
        float q = 0.f;
#pragma unroll
        for (int i = 0; i < 16; ++i) { const float d = x[i] - mean; q += d * d; }
        const float rstd = __builtin_amdgcn_rsqf(wave_sum(q) * (1.0f / LW) + 1e-6f);
        if (lane == 0) { ST[2 * row] = mean; ST[2 * row + 1] = rstd; }
    }
    __syncthreads();
    const unsigned trq = (unsigned)(lane & 15) >> 2, trp = (unsigned)lane & 3u;
    for (int h = 0; h < 8; ++h) {
#pragma unroll
        for (int i = 0; i < 4; ++i) { const int pid = tid + 512 * i, q = pid >> 4, cg = pid & 15;
            const v4u a = *(const GAS v4u*)(F.Z() + (t0 + q) * NIN + 3 * LW + h * 128 + cg * 8);
            const float mean = ST[2 * q], rstd = ST[2 * q + 1];
            const f32x4 g0 = *(const GAS f32x4*)(F.A.in[10] + h * 128 + cg * 8), g1 = *(const GAS f32x4*)(F.A.in[10] + h * 128 + cg * 8 + 4);
            const f32x4 b0 = *(const GAS f32x4*)(F.A.in[11] + h * 128 + cg * 8), b1 = *(const GAS f32x4*)(F.A.in[11] + h * 128 + cg * 8 + 4);
            v4u o;
            o.x = pk2((bf_lo(a.x) - mean) * rstd * g0.x + b0.x, (bf_hi(a.x) - mean) * rstd * g0.y + b0.y);
            o.y = pk2((bf_lo(a.y) - mean) * rstd * g0.z + b0.z, (bf_hi(a.y) - mean) * rstd * g0.w + b0.w);
            o.z = pk2((bf_lo(a.z) - mean) * rstd * g1.x + b1.x, (bf_hi(a.z) - mean) * rstd * g1.y + b1.y);
            o.w = pk2((bf_lo(a.w) - mean) * rstd * g1.z + b1.z, (bf_hi(a.w) - mean) * rstd * g1.w + b1.w);
            *(LAS v4u*)(VN + vn_off((unsigned)q, (unsigned)cg)) = o;
        }
#pragma unroll
        for (int i = 0; i < 8; ++i) { const int pid = tid + 512 * i, r = pid >> 5, cg = pid & 31;
            *(LAS v2u*)(GU + r * 264 + cg * 8) = *(const GAS v2u*)(F.Z() + (t0 + r) * NIN + 2 * LW + h * 128 + cg * 4); }
        if (tid < 128) BS[tid] = F.A.in[13][h * 128 + tid];
        bf16x8 Af[4];
        { const bf16* wsb = F.WSB() + (size_t)h * 16384 + (size_t)(16 * w + fr) * 128 + 8 * fq;
#pragma unroll
          for (int ks = 0; ks < 4; ++ks) Af[ks] = *(const GAS bf16x8*)(wsb + 32 * ks); }
        __syncthreads();
        f32x4 acc[8];
#pragma unroll
        for (int n = 0; n < 8; ++n) {
            acc[n] = (f32x4){0.f, 0.f, 0.f, 0.f};
#pragma unroll
            for (int ks = 0; ks < 4; ++ks) {
                const s16x4 b0 = __builtin_amdgcn_ds_read_tr16_b64_v4i16((LAS s16x4*)(VN + vn_off(32u * ks + 8u * fq + trq, 2u * n + (trp >> 1)) + 8u * (trp & 1u)));
                const s16x4 b1 = __builtin_amdgcn_ds_read_tr16_b64_v4i16((LAS s16x4*)(VN + vn_off(32u * ks + 8u * fq + 4u + trq, 2u * n + (trp >> 1)) + 8u * (trp & 1u)));
                const bf16x8 bb = (bf16x8){b0[0], b0[1], b0[2], b0[3], b1[0], b1[1], b1[2], b1[3]};
                acc[n] = __builtin_amdgcn_mfma_f32_16x16x32_bf16(Af[ks], bb, acc[n], 0, 0, 0);
            }
        }
#pragma unroll
        for (int n = 0; n < 8; ++n)
#pragma unroll
            for (int j = 0; j < 4; ++j) { const int p = 16 * w + 4 * fq + j; LAS unsigned short* ad = (LAS unsigned short*)(GU + p * 264 + (16 * n + fr) * 2);
                *ad = (unsigned short)f2bf(bf1(*ad) * (acc[n][j] + BS[p])); }
        __syncthreads();
#pragma unroll
        for (int i = 0; i < 8; ++i) { const int pid = tid + 512 * i, r = pid >> 5, cg = pid & 31;
            *(GAS v2u*)(F.MIX() + (t0 + r) * D + LW + h * 128 + cg * 4) = *(const LAS v2u*)(GU + r * 264 + cg * 8); }
        __syncthreads();
    }
}
typedef float f32x16 __attribute__((ext_vector_type(16)));
__device__ __forceinline__ unsigned fkey(float f) { const int u = __builtin_bit_cast(int, f); return (unsigned)(u ^ ((u >> 31) & 0x7fffffff)); }
__device__ __forceinline__ float fkey_inv(unsigned k) { const int u = (int)k; return __builtin_bit_cast(float, u ^ ((u >> 31) & 0x7fffffff)); }
__device__ __forceinline__ unsigned umax_(unsigned a, unsigned b) { return (int)a > (int)b ? a : b; }
__device__ __forceinline__ unsigned umin_(unsigned a, unsigned b) { return (int)a < (int)b ? a : b; }
#define CE_DESC(x, y) do { const unsigned a_ = (x), b_ = (y); (x) = umax_(a_, b_); (y) = umin_(a_, b_); } while (0)
__device__ __forceinline__ void sort16_desc(unsigned (&a)[16]) {
#pragma unroll
    for (int k = 2; k <= 16; k <<= 1)
#pragma unroll
        for (int j = k >> 1; j >= 1; j >>= 1)
#pragma unroll
            for (int i = 0; i < 16; ++i) { const int l = i ^ j; if (l > i) { if ((i & k) == 0) CE_DESC(a[i], a[l]); else CE_DESC(a[l], a[i]); } }
}
__device__ __forceinline__ void merge16_desc(unsigned (&a)[16], const unsigned (&b)[16]) {
#pragma unroll
    for (int i = 0; i < 16; ++i) a[i] = umax_(a[i], b[15 - i]);
#pragma unroll
    for (int j = 8; j >= 1; j >>= 1)
#pragma unroll
        for (int i = 0; i < 16; ++i) if ((i & j) == 0) CE_DESC(a[i], a[i + j]);
}
typedef short bf16x8s __attribute__((ext_vector_type(8)));
__device__ __forceinline__ void topk_unit(Frame& F, int wu) {
    const int tg = wu >> 3, hd = wu & 7, lane = F.lane, r = lane & 31, hh = lane >> 5;
    const int t = tg * 32 + r;
    const size_t qoff = (size_t)t * D + hd * 256 + 8 * hh;
    unsigned L[2][16];
    unsigned hh4 = (unsigned)hh << 2; asm volatile("" : "+v"(hh4));
#pragma unroll
    for (int p = 0; p < 2; ++p) {
        f32x16 acc[4];
#pragma unroll
        for (int nt = 0; nt < 4; ++nt)
#pragma unroll
            for (int i = 0; i < 16; ++i) acc[nt][i] = 0.f;
        const size_t koff = ((size_t)(hd * 2 + p) * 128 + r) * 128 + 8 * hh;
        const bf16* qp = F.QH() + qoff + p * 128; const bf16* kp0 = F.KH() + koff; const bf16* kp1 = kp0 + 32 * 128; const bf16* kp2 = kp0 + 64 * 128; const bf16* kp3 = kp0 + 96 * 128;
        asm volatile("" : "+v"(qp), "+v"(kp0), "+v"(kp1), "+v"(kp2), "+v"(kp3));
#define P6_LOAD(Q, K, ks0, n) _Pragma("unroll") for (int i_ = 0; i_ < (n); ++i_) { Q[i_] = *(const GAS bf16x8s*)(qp + 16 * ((ks0) + i_)); \
            K[i_][0] = *(const GAS bf16x8s*)(kp0 + 16 * ((ks0) + i_)); K[i_][1] = *(const GAS bf16x8s*)(kp1 + 16 * ((ks0) + i_)); \
            K[i_][2] = *(const GAS bf16x8s*)(kp2 + 16 * ((ks0) + i_)); K[i_][3] = *(const GAS bf16x8s*)(kp3 + 16 * ((ks0) + i_)); }
#define P6_MMA(Q, K, n) _Pragma("unroll") for (int i_ = 0; i_ < (n); ++i_) _Pragma("unroll") for (int nt = 0; nt < 4; ++nt) acc[nt] = __builtin_amdgcn_mfma_f32_32x32x16_bf16(K[i_][nt], Q[i_], acc[nt], 0, 0, 0);
        bf16x8s qa[3], ka[3][4], qb[3], kb[3][4];
        P6_LOAD(qa, ka, 0, 3); P6_LOAD(qb, kb, 3, 3);
        __builtin_amdgcn_sched_barrier(0);
        P6_MMA(qa, ka, 3);
        __builtin_amdgcn_sched_barrier(0);
        P6_LOAD(qa, ka, 6, 2);
        __builtin_amdgcn_sched_barrier(0);
        P6_MMA(qb, kb, 3);
        __builtin_amdgcn_sched_barrier(0);
        P6_MMA(qa, ka, 2);
        __builtin_amdgcn_sched_barrier(0);
#undef P6_LOAD
#undef P6_MMA
        unsigned S[4][16];
#pragma unroll
        for (int nt = 0; nt < 4; ++nt) {
#pragma unroll
            for (int rg = 0; rg < 16; ++rg) { const int nc = 32 * nt + (rg & 3) + 8 * (rg >> 2); S[nt][rg] = ((fkey(acc[nt][rg]) & ~0x7Fu) | (unsigned)(127 - nc)) ^ hh4; }
            sort16_desc(S[nt]);
        }
        merge16_desc(S[0], S[1]); merge16_desc(S[2], S[3]); merge16_desc(S[0], S[2]);
        unsigned T[16];
#pragma unroll
        for (int i = 0; i < 16; ++i) T[i] = (unsigned)__shfl_xor((int)S[0][i], 32);
        merge16_desc(S[0], T);
#pragma unroll
        for (int i = 0; i < 16; ++i) L[p][i] = S[0][i];
        __builtin_amdgcn_sched_barrier(0);
    }
    float v0[16], v1[16];
#pragma unroll
    for (int i = 0; i < 16; ++i) { v0[i] = fkey_inv(L[0][i] & ~0x7Fu); v1[i] = fkey_inv(L[1][i] & ~0x7Fu); }
    unsigned C[4][16];
    {
        int cnt = 0;
#pragma unroll
        for (int i = 0; i < 16; ++i)
#pragma unroll
            for (int j = 0; j < 16; ++j) if ((i + 1) * (j + 1) <= 16) { C[cnt >> 4][cnt & 15] = (fkey(v0[i] + v1[j]) & ~0xFFu) | (unsigned)(255 - (i * 16 + j)); ++cnt; }
#pragma unroll
        for (int q = 50; q < 64; ++q) C[q >> 4][q & 15] = 0x80000000u;
    }
    sort16_desc(C[0]); sort16_desc(C[1]); sort16_desc(C[2]); sort16_desc(C[3]);
    merge16_desc(C[0], C[1]); merge16_desc(C[2], C[3]); merge16_desc(C[0], C[2]);
    unsigned best[16];
#pragma unroll
    for (int i = 0; i < 16; ++i) best[i] = C[0][i];
    LAS unsigned* tab = (LAS unsigned*)(F.lds + F.wave * 8192) + lane;
#pragma unroll
    for (int i = 0; i < 16; ++i) { tab[i * 64] = 127u - (L[0][i] & 0x7Fu); tab[(16 + i) * 64] = 127u - (L[1][i] & 0x7Fu); }
    const float smax = fkey_inv(best[0] & ~0xFFu);
    float sv[8]; unsigned idv[8]; float ssum = 0.f;
#pragma unroll
    for (int k = 0; k < 8; ++k) {
        const unsigned bk = hh ? best[8 + k] : best[k];
        const unsigned pos = 255u - (bk & 0xFFu);
        idv[k] = tab[(pos >> 4) * 64] * 128u + tab[(16 + (pos & 15u)) * 64];
        sv[k] = __builtin_amdgcn_exp2f((fkey_inv(bk & ~0xFFu) - smax) * 1.4426950409f); ssum += sv[k];
    }
    ssum += __shfl_xor(ssum, 32);
    const float inv = 1.0f / ssum;
    {
        int* o = F.IDS() + (size_t)t * 128 + hd * 16 + 8 * hh; float* og = F.GATES() + (size_t)t * 128 + hd * 16 + 8 * hh;
        *(GAS v4u*)o = (v4u){idv[0], idv[1], idv[2], idv[3]}; *(GAS v4u*)(o + 4) = (v4u){idv[4], idv[5], idv[6], idv[7]};
        *(GAS f32x4*)og = (f32x4){sv[0] * inv, sv[1] * inv, sv[2] * inv, sv[3] * inv}; *(GAS f32x4*)(og + 4) = (f32x4){sv[4] * inv, sv[5] * inv, sv[6] * inv, sv[7] * inv};
    }
}
__device__ __forceinline__ void h8_row(Frame& F, int t) {
    const int lane = F.lane;
    float hx[32]; float mx = 0.f;
    const bf16* hp = F.HB() + (size_t)t * D + lane * 16;
#pragma unroll
    for (int c = 0; c < 2; ++c)
#pragma unroll
        for (int q = 0; q < 2; ++q) { const v4u a = *(const GAS v4u*)(hp + c * 1024 + q * 8); float* x = hx + c * 16 + q * 8;
            x[0] = bf_lo(a.x); x[1] = bf_hi(a.x); x[2] = bf_lo(a.y); x[3] = bf_hi(a.y); x[4] = bf_lo(a.z); x[5] = bf_hi(a.z); x[6] = bf_lo(a.w); x[7] = bf_hi(a.w); }
#pragma unroll
    for (int i = 0; i < 32; ++i) mx = fmaxf(mx, fabsf(hx[i]));
#pragma unroll
    for (int o = 1; o < 64; o <<= 1) mx = fmaxf(mx, __shfl_xor(mx, o));
    const float sc = mx > 0.f ? 119.0f / mx : 1.0f;
#pragma unroll
    for (int c = 0; c < 2; ++c) {
        unsigned hw[2], lw[2];
#pragma unroll
        for (int g8 = 0; g8 < 2; ++g8) { unsigned hacc = 0u, lacc = 0u;
#pragma unroll
            for (int i = 0; i < 8; ++i) { const int q = (int)__builtin_rintf(hx[c * 16 + g8 * 8 + i] * sc); const int lo = ((q + 8) & 15) - 8, hi = (q - lo) >> 4;
                const int sh = (i & 3) * 8 + (i >> 2) * 4; hacc |= (unsigned)(hi & 15) << sh; lacc |= (unsigned)(lo & 15) << sh; }
            hw[g8] = hacc; lw[g8] = lacc; }
        unsigned char* hb_ = F.H8() + (size_t)t * D + c * 512 + lane * 8;
        *(GAS v2u*)hb_ = (v2u){hw[0], hw[1]}; *(GAS v2u*)(hb_ + 1024) = (v2u){lw[0], lw[1]};
    }
    if (lane == 0) F.HSCALE()[t] = mx > 0.f ? mx * (1.0f / 119.0f) : 1.0f;
}
__device__ __forceinline__ int row_sum16(int v) {
    v += __builtin_amdgcn_update_dpp(0, v, 0x128, 0xf, 0xf, false);
    v += __builtin_amdgcn_update_dpp(0, v, 0x124, 0xf, 0xf, false);
    v += __builtin_amdgcn_update_dpp(0, v, 0x122, 0xf, 0xf, false);
    v += __builtin_amdgcn_update_dpp(0, v, 0x121, 0xf, 0xf, false);
    return v;
}
__device__ __forceinline__ void peer_u_xcd(Frame& F) {
    const int lane = F.lane, x = blockIdx.x & 7, jcu = blockIdx.x >> 3, ncu = ((int)F.G - x + 7) >> 3;
    const int tpc = (M + ncu - 1) / ncu, tpw = (tpc + NWAVES - 1) / NWAVES;
    const int tbase = jcu * tpc + F.wave * tpw;
    int nw = M - tbase; { const int lim = (jcu + 1) * tpc - tbase; nw = nw < lim ? nw : lim; nw = nw < tpw ? nw : tpw; nw = nw < 0 ? 0 : nw; }
    const int NV = nw;
    LAS unsigned char* wl = F.lds + F.wave * 13312;
    LAS int* lst = (LAS int*)wl; LAS int* res = (LAS int*)(wl + 512); LAS unsigned char* hsl = wl + 1024;
    const int q4 = lane >> 4, i16 = lane & 15;
    const unsigned char* ubase = F.U8() + (size_t)x * 2048 * 1024;
    const unsigned lanepart = (unsigned)i16 * 16u;
    int r_idlo = 0, r_idhi = 0, r_t = 0; v4u r_h0 = (v4u){0u, 0u, 0u, 0u}, r_h1 = (v4u){0u, 0u, 0u, 0u};
    int v_cl0 = 0, v_cl1 = 0, v_n = 0, v_r0 = 0, v_t = 0, v_slot = 0; unsigned long long v_mlo = 0, v_mhi = 0; bool v_live = false;
    int vset = 0, nvalid = 0, idle = 0;
    if (NV == 0) return;
#define U_RAW() do { const int vi_ = vset < NV ? vset : NV - 1; r_t = tbase + vi_; \
        r_idlo = F.IDS()[(size_t)r_t * 128 + lane]; r_idhi = F.IDS()[(size_t)r_t * 128 + 64 + lane]; \
        r_h0 = *(const GAS v4u*)(F.H8() + (size_t)r_t * D + lane * 16); r_h1 = *(const GAS v4u*)(F.H8() + (size_t)r_t * D + 1024 + lane * 16); } while (0)
#define U_NEXT() do { if (v_live && v_r0 + 16 < v_n) { v_r0 += 16; } else if (vset < NV) { const bool slo = (r_idlo >> 11) == x, shi = (r_idhi >> 11) == x; \
            v_mlo = __ballot(slo); v_mhi = __ballot(shi); const int nlo = __popcll(v_mlo); v_n = nlo + __popcll(v_mhi); \
            const int plo = __builtin_amdgcn_mbcnt_hi((unsigned)(v_mlo >> 32), __builtin_amdgcn_mbcnt_lo((unsigned)v_mlo, 0)); \
            const int phi = nlo + __builtin_amdgcn_mbcnt_hi((unsigned)(v_mhi >> 32), __builtin_amdgcn_mbcnt_lo((unsigned)v_mhi, 0)); \
            if (slo) lst[plo] = (r_idlo & 2047) | (lane << 16); if (shi) lst[phi] = (r_idhi & 2047) | ((64 + lane) << 16); \
            v_slot = nvalid % 6; ++nvalid; { LAS unsigned char* sp_ = hsl + v_slot * 2048; *(LAS v4u*)(sp_ + lane * 16) = r_h0; *(LAS v4u*)(sp_ + 1024 + lane * 16) = r_h1; } \
            v_cl0 = lst[lane]; v_cl1 = lst[64 + lane]; v_t = r_t; v_r0 = 0; ++vset; v_live = true; } \
        else { v_live = false; v_n = 0; v_r0 = 0; v_mlo = 0; v_mhi = 0; ++idle; } } while (0)
#define U_ISSUE(BUF, DS) do { { const int rem_ = v_n - v_r0; DS##_cnt = rem_ < 0 ? 0 : (rem_ < 16 ? rem_ : 16); } \
        DS##_slot = v_slot; DS##_t = v_t; DS##_mlo = v_mlo; DS##_mhi = v_mhi; DS##_last = v_live && (v_r0 + 16 >= v_n); \
        _Pragma("unroll") for (int gp = 0; gp < 4; ++gp) { const int ix_ = v_r0 + 4 * gp + q4; const int a_ = __shfl(v_cl0, ix_ & 63), b_ = __shfl(v_cl1, ix_ & 63); DS##_ent[gp] = ix_ < 64 ? a_ : b_; \
            const unsigned of_ = (4 * gp + q4 < DS##_cnt ? ((unsigned)(DS##_ent[gp] & 2047) << 10) : 0u) + lanepart; \
            _Pragma("unroll") for (int c = 0; c < 4; ++c) BUF[4 * gp + c] = *(const GAS v4u*)(ubase + of_ + c * 256); } } while (0)
#define U_COMPUTE(BUF, DS) do { const LAS unsigned char* sp_ = hsl + DS##_slot * 2048; const LAS v4u* hp_ = (const LAS v4u*)(sp_ + i16 * 16); \
        _Pragma("unroll") for (int gp = 0; gp < 4; ++gp) if (4 * gp < DS##_cnt) { int ah_ = 0, al_ = 0; \
            _Pragma("unroll") for (int c = 0; c < 4; ++c) { const v4u r_ = BUF[4 * gp + c]; const v4u hh_ = hp_[c * 16], hl_ = hp_[64 + c * 16]; \
                ah_ = __builtin_amdgcn_sdot8((int)r_.x, (int)hh_.x, ah_, false); al_ = __builtin_amdgcn_sdot8((int)r_.x, (int)hl_.x, al_, false); \
                ah_ = __builtin_amdgcn_sdot8((int)r_.y, (int)hh_.y, ah_, false); al_ = __builtin_amdgcn_sdot8((int)r_.y, (int)hl_.y, al_, false); \
                ah_ = __builtin_amdgcn_sdot8((int)r_.z, (int)hh_.z, ah_, false); al_ = __builtin_amdgcn_sdot8((int)r_.z, (int)hl_.z, al_, false); \
                ah_ = __builtin_amdgcn_sdot8((int)r_.w, (int)hh_.w, ah_, false); al_ = __builtin_amdgcn_sdot8((int)r_.w, (int)hl_.w, al_, false); } \
            const int a_ = row_sum16((ah_ << 4) + al_); if (i16 == 0 && 4 * gp + q4 < DS##_cnt) res[DS##_ent[gp] >> 16] = a_; } \
        if (DS##_last) { int* po_ = F.PART() + (size_t)DS##_t * 128; \
            if ((DS##_mlo >> lane) & 1ull) po_[lane] = res[lane]; if ((DS##_mhi >> lane) & 1ull) po_[64 + lane] = res[64 + lane]; } } while (0)
    v4u bufA[16], bufB[16], bufC[16];
    int dA_cnt = 0, dA_ent[4] = {0, 0, 0, 0}, dA_t = 0, dA_slot = 0; unsigned long long dA_mlo = 0, dA_mhi = 0; bool dA_last = false;
    int dB_cnt = 0, dB_ent[4] = {0, 0, 0, 0}, dB_t = 0, dB_slot = 0; unsigned long long dB_mlo = 0, dB_mhi = 0; bool dB_last = false;
    int dC_cnt = 0, dC_ent[4] = {0, 0, 0, 0}, dC_t = 0, dC_slot = 0; unsigned long long dC_mlo = 0, dC_mhi = 0; bool dC_last = false;
    U_RAW();
    U_NEXT(); U_RAW(); U_ISSUE(bufA, dA);
    U_NEXT(); U_RAW(); U_ISSUE(bufB, dB);
    while (idle < 3) {
        U_NEXT(); U_RAW(); U_ISSUE(bufC, dC); U_COMPUTE(bufA, dA);
        U_NEXT(); U_RAW(); U_ISSUE(bufA, dA); U_COMPUTE(bufB, dB);
        U_NEXT(); U_RAW(); U_ISSUE(bufB, dB); U_COMPUTE(bufC, dC);
    }
#undef U_RAW
#undef U_NEXT
#undef U_ISSUE
#undef U_COMPUTE
}
__device__ __forceinline__ void peer_act_token(Frame& F, int t) {
    const int lane = F.lane;
    LAS unsigned char* wl = F.lds + F.wave * 4096;
    LAS float* abuf = (LAS float*)wl; LAS int* ibuf = (LAS int*)(wl + 512); LAS int* cnt = (LAS int*)(wl + 1024);
    LAS int* ovf = (LAS int*)(wl + 1280); LAS int* fre = (LAS int*)(wl + 1792); LAS int* sop = (LAS int*)(wl + 2304);
#define WFENCE() asm volatile("s_waitcnt lgkmcnt(0)" ::: "memory")
    const float sc = __builtin_amdgcn_rsqf(F.ROWSS()[t] * (1.0f / D) + 1e-6f) * F.HSCALE()[t];
    if (lane < 34) cnt[lane] = 0;
    float am = 0.f; float actv[2]; int idv[2], slotv[2];
    const int l32 = t & 31;
#pragma unroll
    for (int half = 0; half < 2; ++half) {
        const size_t o = (size_t)t * 128 + half * 64 + lane;
        const int e = F.IDS()[o]; const float g = F.GATES()[o];
        const int dsum = F.PART()[o];
        actv[half] = gelu_tanh((float)dsum * sc * F.USCALE()[e]) * g * F.VSCALE()[e]; idv[half] = e; am = fmaxf(am, fabsf(actv[half]));
    }
    WFENCE();
#pragma unroll
    for (int half = 0; half < 2; ++half) {
        const int r = idv[half] & 31;
        const int j = __hip_atomic_fetch_add(cnt + r, 1, __ATOMIC_RELAXED, __HIP_MEMORY_SCOPE_WORKGROUP);
        if (j < 4) slotv[half] = ((r - l32) & 31) + 32 * j;
        else { const int q = __hip_atomic_fetch_add(cnt + 32, 1, __ATOMIC_RELAXED, __HIP_MEMORY_SCOPE_WORKGROUP); ovf[q] = half * 64 + lane; slotv[half] = -1; }
    }
    WFENCE();
    if (lane < 32) { const int n = cnt[lane];
        for (int j = n; j < 4; ++j) { const int q = __hip_atomic_fetch_add(cnt + 33, 1, __ATOMIC_RELAXED, __HIP_MEMORY_SCOPE_WORKGROUP); fre[q] = ((lane - l32) & 31) + 32 * j; } }
    WFENCE();
    const int nov = cnt[32];
#pragma unroll
    for (int half = 0; half < 2; ++half) { const int i = half * 64 + lane; if (i < nov) sop[ovf[i]] = fre[i]; }
    WFENCE();
#pragma unroll
    for (int half = 0; half < 2; ++half) { if (slotv[half] < 0) slotv[half] = sop[half * 64 + lane]; abuf[slotv[half]] = actv[half]; ibuf[slotv[half]] = idv[half]; }
    WFENCE();
#pragma unroll
    for (int o = 1; o < 64; o <<= 1) am = fmaxf(am, __shfl_xor(am, o));
    const float asc = am > 0.f ? 127.0f / am : 1.0f;
    if (lane == 0) F.ASCALE()[t] = am > 0.f ? am * (1.0f / 127.0f) : 1.0f;
    if (lane < 32) {
        const f32x4 av = *(const LAS f32x4*)(abuf + 4 * lane); const v4u iv = *(const LAS v4u*)(ibuf + 4 * lane);
        const size_t o = ((size_t)(t >> 6) * 32 + lane) * 64 + (t & 63);
        F.IDW()[o] = (v4u){iv.x << 3, iv.y << 3, iv.z << 3, iv.w << 3};
        F.AW()[o] = pack_i8x4(av.x * asc, av.y * asc, av.z * asc, av.w * asc);
    }
    WFENCE();
#undef WFENCE
}
__device__ __forceinline__ void tr4x4(const unsigned r0, const unsigned r1, const unsigned r2, const unsigned r3, unsigned (&c)[4]) {
    const unsigned t01l = __builtin_amdgcn_perm(r1, r0, 0x05010400u), t01h = __builtin_amdgcn_perm(r1, r0, 0x07030602u);
    const unsigned t23l = __builtin_amdgcn_perm(r3, r2, 0x05010400u), t23h = __builtin_amdgcn_perm(r3, r2, 0x07030602u);
    c[0] = __builtin_amdgcn_perm(t23l, t01l, 0x05040100u); c[1] = __builtin_amdgcn_perm(t23l, t01l, 0x07060302u);
    c[2] = __builtin_amdgcn_perm(t23h, t01h, 0x05040100u); c[3] = __builtin_amdgcn_perm(t23h, t01h, 0x07060302u);
}
template <int MODE>
__device__ __forceinline__ void peer_v_slice(Frame& F, int c, bool do_atomic) {
    const int tid = F.tid, lane = F.lane;
    for (int i = tid; i < NEXP * 8 / 16; i += 512) *(LAS v4u*)(F.lds + i * 16) = *(const GAS v4u*)(F.V8T() + (size_t)c * NEXP * 8 + (size_t)i * 16);
    __syncthreads();
    const v4u* ibase = F.IDW() + lane; const unsigned* abase = F.AW() + lane;
    constexpr int NBLK = M / 64, PD = 16;
    v4u iq[PD]; unsigned aq[PD]; v2u rw[2][4];
    {
        const size_t o = (size_t)F.wave * 32 * 64;
#pragma unroll
        for (int j = 0; j < PD; ++j) { iq[j] = *(const GAS v4u*)(ibase + o + j * 64); aq[j] = abase[o + j * 64]; }
    }
#define LROW(dst, q) do { dst[0] = *(const LAS v2u*)(F.lds + (q).x); dst[1] = *(const LAS v2u*)(F.lds + (q).y); \
                          dst[2] = *(const LAS v2u*)(F.lds + (q).z); dst[3] = *(const LAS v2u*)(F.lds + (q).w); } while (0)
    for (int blk = F.wave; blk < NBLK; blk += NWAVES) {
        const int t = blk * 64 + lane;
        const size_t o = (size_t)blk * 32 * 64;
        const int nblk = (blk + NWAVES < NBLK) ? blk + NWAVES : blk;
        const size_t on = (size_t)nblk * 32 * 64;
        int acc[8];
#pragma unroll
        for (int i = 0; i < 8; ++i) acc[i] = 0;
        LROW(rw[0], iq[0]);
#pragma unroll
        for (int j = 0; j < 32; ++j) {
            if (j + 1 < 32) LROW(rw[(j + 1) & 1], iq[(j + 1) % PD]);
            const unsigned aw = aq[j % PD];
            unsigned cl[4], ch[4];
            tr4x4(rw[j & 1][0].x, rw[j & 1][1].x, rw[j & 1][2].x, rw[j & 1][3].x, cl);
            tr4x4(rw[j & 1][0].y, rw[j & 1][1].y, rw[j & 1][2].y, rw[j & 1][3].y, ch);
#pragma unroll
            for (int i = 0; i < 4; ++i) { acc[i] = __builtin_amdgcn_sdot4((int)aw, (int)cl[i], acc[i], false); acc[4 + i] = __builtin_amdgcn_sdot4((int)aw, (int)ch[i], acc[4 + i], false); }
            { const size_t oo = (j + PD < 32) ? o + (size_t)(j + PD) * 64 : on + (size_t)(j + PD - 32) * 64;
              iq[j % PD] = *(const GAS v4u*)(ibase + oo); aq[j % PD] = abase[oo]; }
            __builtin_amdgcn_sched_barrier(0);
        }
        const float asc = F.ASCALE()[t];
        float accf[8];
#pragma unroll
        for (int i = 0; i < 8; ++i) accf[i] = (float)acc[i] * asc;
        const v4u hb = *(const GAS v4u*)(F.HBT() + ((size_t)c * M + t) * 8);
        accf[0] += bf_lo(hb.x); accf[1] += bf_hi(hb.x); accf[2] += bf_lo(hb.y); accf[3] += bf_hi(hb.y);
        accf[4] += bf_lo(hb.z); accf[5] += bf_hi(hb.z); accf[6] += bf_lo(hb.w); accf[7] += bf_hi(hb.w);
        bf16* yp = (MODE == 0) ? F.Y() + ((size_t)c * M + t) * 8 : (bf16*)F.XN() + ((((size_t)c * M + t) * 8) & (size_t)0x1ffffff);
        *(GAS v4u*)yp = (v4u){pk2(accf[0], accf[1]), pk2(accf[2], accf[3]), pk2(accf[4], accf[5]), pk2(accf[6], accf[7])};
        float ss = 0.f;
#pragma unroll
        for (int i = 0; i < 8; ++i) ss += accf[i] * accf[i];
        if (do_atomic) atomicAdd(F.ROWSS2() + t, ss);
    }
#undef LROW
    __syncthreads();
}
__device__ __forceinline__ void final_unit(Frame& F, int unit) {
    const int tid = F.tid, blk = unit >> 3, cg = unit & 7, t0 = blk * 64;
    LAS float* T = (LAS float*)F.lds;
#pragma unroll
    for (int i = 0; i < 4; ++i) { const int pid = tid + 512 * i, cl = pid >> 6, tok = pid & 63;
        const v4u v = *(const GAS v4u*)(F.Y() + ((size_t)(cg * 32 + cl) * M + t0 + tok) * 8);
        *(LAS f32x4*)(T + tok * 260 + cl * 8) = (f32x4){bf_lo(v.x), bf_hi(v.x), bf_lo(v.y), bf_hi(v.y)};
        *(LAS f32x4*)(T + tok * 260 + cl * 8 + 4) = (f32x4){bf_lo(v.z), bf_hi(v.z), bf_lo(v.w), bf_hi(v.w)}; }
    __syncthreads();
#pragma unroll
    for (int i = 0; i < 8; ++i) { const int pid = tid + 512 * i, tok = pid >> 6, c4 = pid & 63;
        const float rs = __builtin_amdgcn_rsqf(F.ROWSS2()[t0 + tok] * (1.0f / D) + 1e-6f);
        const f32x4 v = *(const LAS f32x4*)(T + tok * 260 + c4 * 4);
        const f32x4 g = *(const GAS f32x4*)(F.A.in[20] + cg * 256 + c4 * 4);
        *(GAS f32x4*)(F.A.out + (size_t)(t0 + tok) * D + cg * 256 + c4 * 4) = v * rs * g; }
    __syncthreads();
}
__global__ void __launch_bounds__(NWAVES * 64, 2) mk_fwd(Args args) {
    __shared__ __attribute__((aligned(16))) unsigned char lds[LDS_BYTES];
    Frame F(args);
    F.lds = (LAS unsigned char*)lds;
    F.MISC = (volatile LAS unsigned*)(F.lds + MISC_OFF);
    F.tid = threadIdx.x; F.lane = F.tid & 63; F.wave = __builtin_amdgcn_readfirstlane(F.tid >> 6);
    F.G = gridDim.x; { const int bx = blockIdx.x; F.vcu = (F.G % 8 == 0) ? (bx % 8) * (F.G / 8) + bx / 8 : bx; }
    F.ws = args.ws;
    F.ctl = (gu32*)(args.ws + WS_CTL);
    for (int u = F.tid; u < (LDS_BYTES - LDSCTL_OFF) / 4; u += NWAVES * 64) ((LAS unsigned*)(F.lds + LDSCTL_OFF))[u] = 0u;
    __syncthreads();
    XcdBarrier bar; bar.bar = (unsigned*)(F.ctl + CW_BAR); bar.x = 0; bar.st = nullptr;
    if (N_LAUNCHES != PER_PHASE) bar = xcd_barrier_post((unsigned*)(F.ctl + CW_BAR), F.MISC + 8);
#define GRID_BAR() do { if (N_LAUNCHES != PER_PHASE) xcd_barrier(bar); } while (0)
    const int lo = args.ph_lo, hi = args.ph_hi;
#ifndef MK_PHASE_MASK
#define MK_PHASE_MASK 0x7FF
#endif
#define IN(k) (((MK_PHASE_MASK >> (k)) & 1) && lo <= (k) && (k) < hi)
#undef MK_PHASE_MASK
#define MK_PHASE_MASK 0xFFFF
#define BOTH(k) (true)
#ifndef MK_REP_MASK
#define MK_REP_MASK 0
#endif
#ifndef MK_REP_N
#define MK_REP_N 2
#endif
#define REPS(k) for (int rep_ = 0; rep_ < ((((MK_REP_MASK) >> (k)) & 1) ? 1 + MK_REP_N : 1); ++rep_)
    const int gw = F.vcu * NWAVES + F.wave, NGW = F.G * NWAVES;
    if (IN(0)) { REPS(0) { p0_prologue(F); __syncthreads(); } if (BOTH(0)) GRID_BAR(); }
    if (IN(1)) {
        pg8::Gemm g{F.XN(), F.WIN(), M, NIN, D}; pg8::StaticOrder S; S.init(M, NIN, F.G, (int)blockIdx.x);
        pg8::EpiZ E{F.Z(), NIN, LW};
        REPS(1) pg8::gemm_phase<pg8::EpiZ, pg8::StaticOrder, true, true>(F.lds, g, S, E);
        if (BOTH(1)) GRID_BAR();
    }
    if (IN(2)) {
        REPS(12) { v4u xr[5]; int u = blockIdx.x; lru_prefetch(F, u, F.tid, xr);
                   for (; u < BATCH * NCHUNK * 8; u += F.G) lru_fused_unit(F, u, u + F.G < BATCH * NCHUNK * 8 ? u + F.G : -1, xr); }
        asm volatile("" : "+v"(F.tid), "+v"(F.lane));
        REPS(13) for (int u = blockIdx.x; u < BATCH * NCHUNK; u += F.G) gmlp_unit(F, u);
        if (BOTH(2)) GRID_BAR();
    }
    if (IN(4)) {
        pg8::Gemm g{F.MIX(), F.WOUT(), M, D, D}; pg8::StaticOrder S; S.init(M, D, F.G, (int)blockIdx.x);
        pg8::EpiH E{F.HB(), F.HBT(), F.A.in[0], F.ROWSS(), D, M};
        pg8::gemm_phase<pg8::EpiH, pg8::StaticOrder, true, true>(F.lds, g, S, E);
        if (BOTH(4)) GRID_BAR();
    }
    if (IN(5)) {
        pg8::Gemm g{F.HB(), F.WQ(), M, D, D}; pg8::StaticOrder S; S.init(M, D, F.G, (int)blockIdx.x);
        pg8::EpiQ E{F.QH(), F.ROWSS(), D};
        REPS(5) pg8::gemm_phase<pg8::EpiQ, pg8::StaticOrder, true, true>(F.lds, g, S, E);
        if (BOTH(5)) GRID_BAR();
    }
    if (IN(6)) {
        REPS(6) { for (int wu = gw; wu < (M / 32) * 8; wu += NGW) topk_unit(F, wu);
                  for (int t = gw; t < M; t += NGW) h8_row(F, t); }
        if (BOTH(6)) GRID_BAR();
    }
    if (IN(7)) {
        REPS(7) peer_u_xcd(F);
        if (BOTH(7)) GRID_BAR();
    }
    if (IN(8)) {
        REPS(8) for (int t = gw; t < M; t += NGW) peer_act_token(F, t);
        if (BOTH(8)) GRID_BAR();
    }
    if (IN(9)) {
        for (int c = blockIdx.x; c < D / 8; c += F.G) peer_v_slice<0>(F, c, true);
        if ((MK_REP_MASK >> 9) & 1) { for (int rep_ = 0; rep_ < MK_REP_N; ++rep_) for (int c = blockIdx.x; c < D / 8; c += F.G) peer_v_slice<1>(F, c, false); }
        if (BOTH(9)) GRID_BAR();
    }
    if (IN(10)) {
        REPS(10) for (int u = blockIdx.x; u < (M / 64) * 8; u += F.G) final_unit(F, u);
    }
#undef IN
#undef BOTH
#undef GRID_BAR
}

extern "C" void kernel_launch(void* const* d_in, const int* in_sizes, int n_in, void* d_out, int out_size, void* d_ws, size_t ws_size, hipStream_t stream) {
    static int grid = 0;
    if (grid == 0) {
        if (n_in != 21 || in_sizes[0] != M * D || out_size != M * D || ws_size < WS_END) { fprintf(stderr, "kernel_launch: unexpected shapes (n_in %d, in0 %d, out %d, ws %zu)\n", n_in, n_in > 0 ? in_sizes[0] : -1, out_size, ws_size); grid = -1; return; }
        int dev = 0, cus = 0, per_cu = 0;
        if (hipGetDevice(&dev) != hipSuccess || hipDeviceGetAttribute(&cus, hipDeviceAttributeMultiprocessorCount, dev) != hipSuccess) { grid = -1; return; }
        if (hipOccupancyMaxActiveBlocksPerMultiprocessor(&per_cu, (const void*)mk_fwd, NWAVES * 64, 0) != hipSuccess || per_cu < 1) { fprintf(stderr, "kernel_launch: occupancy query reports %d blocks per CU\n", per_cu); }
        (void)hipGetLastError();
        grid = cus;
        if (cus < 256) { fprintf(stderr, "kernel_launch: the RG-LRU family hand-off needs >= 256 co-resident workgroups (have %d)\n", cus); grid = -1; return; }
    }
    if (grid < 0) return;
    (void)hipMemsetAsync((char*)d_ws + WS_CTL, 0, CTL_ZERO_BYTES, stream);
    Args a{};
    for (int i = 0; i < 21; ++i) a.in[i] = (const float*)d_in[i];
    a.out = (float*)d_out; a.ws = (unsigned char*)d_ws;
    for (int li = 0; li < N_LAUNCHES; ++li) {
        a.ph_lo = 0; a.ph_hi = 99;
        hipLaunchKernelGGL(mk_fwd, dim3(grid), dim3(NWAVES * 64), 0, stream, a);
    }
}
```

```cpp
#include <hip/hip_runtime.h>
#include <cstdio>
#include <cstdint>
namespace pg8 {
#define PG8_LAS __attribute__((address_space(3)))
typedef unsigned short bf16_t;
typedef short bf16x8 __attribute__((ext_vector_type(8)));
typedef float f32x4 __attribute__((ext_vector_type(4)));
typedef unsigned u32x4 __attribute__((ext_vector_type(4)));
constexpr int BM = 256, BK = 64, HALF = 128, HTB = HALF * BK * 2  , STAGE_BYTES = 8 * HTB, NXCD = 8, WGM = 8;

__host__ __device__ __forceinline__ int lds_byte(int r, int c) { const int st = (r >> 4) * 2 + (c >> 5), rr = r & 15, cc = c & 31, ob = rr * 64 + cc * 2; return st * 1024 + (ob ^ (((ob >> 9) & 1) << 5)); }
__host__ __device__ __forceinline__ void stage_rc(int b, int& R, int& C) { const int st = b / 1024, sb = b % 1024, swz = sb ^ (((sb >> 9) & 1) << 5); R = (st >> 1) * 16 + swz / 64; C = (st & 1) * 32 + (swz % 64) / 2; }
__host__ __device__ __forceinline__ int perm32(int rho) { const int n = rho >> 4, i = rho & 15; return 8 * (i >> 2) + 4 * n + (i & 3); }

struct Unit { int pm, pn; };
struct Gemm { const bf16_t* A; const bf16_t* Bt; int M, N, K; };

struct StaticOrder {
    int nM, nN, nwg, G, c;
    __host__ __device__ void init(int M, int N, int G_, int c_) { nM = M / BM; nN = N / BM; nwg = nM * nN; G = G_; c = c_; }
    __host__ __device__ bool next(int i, Unit& u) const {
        const long L = (long)i * G + c; if (L >= nwg) return false;
        int wgid = (int)L; { const int q = nwg / NXCD, r = nwg % NXCD, xcd = wgid % NXCD, off = wgid / NXCD; wgid = (xcd < r ? xcd * (q + 1) : r * (q + 1) + (xcd - r) * q) + off; }
        const int nig = WGM * nN, gid = wgid / nig, fm = gid * WGM, gsz = (nM - fm) < WGM ? (nM - fm) : WGM;
        u.pm = fm + ((wgid % nig) % gsz); u.pn = (wgid % nig) / gsz; return true;
    }
    __device__ __forceinline__ void a_ready(const Unit&) const {}
    __device__ __forceinline__ void done(const Unit&) const {}
};

__device__ __forceinline__ unsigned cvt_pk_bf16(float lo, float hi) { unsigned r; asm volatile("v_cvt_pk_bf16_f32 %0, %1, %2" : "=v"(r) : "v"(lo), "v"(hi)); return r; }
__device__ __forceinline__ float gelu_tanh(float x) {
    const float t = x * (1.0f + 0.044715f * x * x);
    const float e = __builtin_amdgcn_exp2f(-2.3022081983f * t);
    return x * __builtin_amdgcn_rcpf(1.0f + e);
}
struct EpiZ {
    static constexpr bool PERM = true, AFTER_DRAIN = false;
    bf16_t* O; int ldc; int gelu_from;
    __device__ __forceinline__ void operator()(const f32x4 (&acc)[2][2][4][2], const Unit& u, int wr, int wc, int fr, int fq) const {
        const int row0 = u.pm * BM + wr * 64 + fr; const int col0 = u.pn * BM + wc * 32 + 8 * fq;
        const bool act = (u.pn * BM) >= gelu_from;
#pragma unroll
        for (int ai = 0; ai < 2; ++ai)
#pragma unroll
            for (int m = 0; m < 4; ++m) { bf16_t* rowp = O + (size_t)(row0 + ai * HALF + m * 16) * ldc + col0;
#pragma unroll
                for (int bj = 0; bj < 2; ++bj) { f32x4 v0 = acc[ai][bj][m][0], v1 = acc[ai][bj][m][1];
                    if (act) {
#pragma unroll
                        for (int j = 0; j < 4; ++j) { v0[j] = gelu_tanh(v0[j]); v1[j] = gelu_tanh(v1[j]); } }
                    u32x4 w; w.x = cvt_pk_bf16(v0[0], v0[1]); w.y = cvt_pk_bf16(v0[2], v0[3]); w.z = cvt_pk_bf16(v1[0], v1[1]); w.w = cvt_pk_bf16(v1[2], v1[3]);
                    *(u32x4*)(rowp + bj * HALF) = w; } }
    }
};
struct EpiH {
    static constexpr bool PERM = true, AFTER_DRAIN = false;
    bf16_t* O; bf16_t* OT; const float* X; float* rowss; int ldc; int mrows;
    __device__ __forceinline__ void operator()(const f32x4 (&acc)[2][2][4][2], const Unit& u, int wr, int wc, int fr, int fq) const {
        const int row0 = u.pm * BM + wr * 64 + fr; const int col0 = u.pn * BM + wc * 32 + 8 * fq;
#pragma unroll
        for (int ai = 0; ai < 2; ++ai)
#pragma unroll
            for (int m = 0; m < 4; ++m) { const int row = row0 + ai * HALF + m * 16; const size_t off = (size_t)row * ldc + col0; float ss = 0.f;
#pragma unroll
                for (int bj = 0; bj < 2; ++bj) {
                    const f32x4 x0 = *(const f32x4*)(X + off + bj * HALF), x1 = *(const f32x4*)(X + off + bj * HALF + 4);
                    const f32x4 v0 = acc[ai][bj][m][0] + x0, v1 = acc[ai][bj][m][1] + x1;
                    ss += (v0[0] * v0[0] + v0[1] * v0[1]) + (v0[2] * v0[2] + v0[3] * v0[3]) + (v1[0] * v1[0] + v1[1] * v1[1]) + (v1[2] * v1[2] + v1[3] * v1[3]);
                    u32x4 w; w.x = cvt_pk_bf16(v0[0], v0[1]); w.y = cvt_pk_bf16(v0[2], v0[3]); w.z = cvt_pk_bf16(v1[0], v1[1]); w.w = cvt_pk_bf16(v1[2], v1[3]);
                    *(u32x4*)(O + off + bj * HALF) = w;
                    *(u32x4*)(OT + ((size_t)((col0 + bj * HALF) >> 3) * mrows + row) * 8) = w; }
                ss += __shfl_xor(ss, 16); ss += __shfl_xor(ss, 32);
                if (fq == 0) atomicAdd(rowss + row, ss); }
    }
};
struct EpiQ {
    static constexpr bool PERM = true, AFTER_DRAIN = false;
    bf16_t* QH; const float* rowss; int ldc;
    __device__ __forceinline__ void operator()(const f32x4 (&acc)[2][2][4][2], const Unit& u, int wr, int wc, int fr, int fq) const {
        const int row0 = u.pm * BM + wr * 64 + fr, col0 = u.pn * BM + wc * 32 + 8 * fq;
#pragma unroll
        for (int ai = 0; ai < 2; ++ai)
#pragma unroll
            for (int m = 0; m < 4; ++m) { const int row = row0 + ai * HALF + m * 16; const float rs = __builtin_amdgcn_rsqf(rowss[row] * (1.0f / 2048.0f) + 1e-6f);
                const size_t off = (size_t)row * ldc + col0;
#pragma unroll
                for (int bj = 0; bj < 2; ++bj) { const f32x4 v0 = acc[ai][bj][m][0] * rs, v1 = acc[ai][bj][m][1] * rs;
                    u32x4 wh; wh.x = cvt_pk_bf16(v0[0], v0[1]); wh.y = cvt_pk_bf16(v0[2], v0[3]); wh.z = cvt_pk_bf16(v1[0], v1[1]); wh.w = cvt_pk_bf16(v1[2], v1[3]);
                    *(u32x4*)(QH + off + bj * HALF) = wh; } }
    }
};
template <class Epi, class Sched, bool ALIGN_EPI = false, bool SP2 = false>
__device__ __forceinline__ void gemm_phase(PG8_LAS unsigned char* lds, const Gemm g, const Sched& S, const Epi& E) {
    const int tid = threadIdx.x, wid = __builtin_amdgcn_readfirstlane(tid >> 6), lane = tid & 63, wr = wid >> 2, wc = wid & 3, fr = lane & 15, fq = lane >> 4;
    const int K = g.K, nt = K / BK;
    unsigned voffA[2], voffB[2];
#pragma unroll
    for (int i = 0; i < 2; ++i) { int R, C; stage_rc(tid * 16 + i * 8192, R, C); const int Rb = Epi::PERM ? ((R & ~31) + perm32(R & 31)) : R;
        voffA[i] = (unsigned)(R * K + C) * 2u; voffB[i] = (unsigned)(Rb * K + C) * 2u; }
    const size_t kstep = (size_t)(BK * 2);
    const size_t hstep = (size_t)HALF * K * 2;
    const size_t tstep = 2 * hstep;
    const unsigned ldsw = (unsigned)wid * 1024u;
    const int aoff = lds_byte(wr * 64 + fr, fq * 8), boff = lds_byte(wc * 32 + fr, fq * 8);
#define PG8_SA(b, h) (((b) * 2 + (h)) * HTB)
#define PG8_SB(b, h) ((4 + (b) * 2 + (h)) * HTB)
#define PG8_STAGE(bufoff, gbase, voff) do { _Pragma("unroll") for (int _i = 0; _i < 2; ++_i) \
        __builtin_amdgcn_global_load_lds((const unsigned*)((const char*)(gbase) + (voff)[_i]), (PG8_LAS unsigned*)(lds + (bufoff) + ldsw + _i * 8192), 16, 0, 0); } while (0)
#define PG8_LDA(dst, b, h) do { _Pragma("unroll") for (int m = 0; m < 4; ++m) _Pragma("unroll") for (int k = 0; k < 2; ++k) dst[m][k] = *(const PG8_LAS bf16x8*)(lds + PG8_SA(b, h) + aoff + m * 2048 + k * 1024); } while (0)
#define PG8_LDB(dst, b, h) do { _Pragma("unroll") for (int n = 0; n < 2; ++n) _Pragma("unroll") for (int k = 0; k < 2; ++k) dst[n][k] = *(const PG8_LAS bf16x8*)(lds + PG8_SB(b, h) + boff + n * 2048 + k * 1024); } while (0)
#define PG8_MMA(ai, bj, At, Bt) do { __builtin_amdgcn_s_setprio(1); _Pragma("unroll") for (int m = 0; m < 4; ++m) _Pragma("unroll") for (int n = 0; n < 2; ++n) _Pragma("unroll") for (int k = 0; k < 2; ++k) \
        acc[ai][bj][m][n] = __builtin_amdgcn_mfma_f32_16x16x32_bf16(Bt[n][k], At[m][k], acc[ai][bj][m][n], 0, 0, 0); __builtin_amdgcn_s_setprio(0); } while (0)
#define PG8_WAIT_V(n) asm volatile("s_waitcnt vmcnt(" #n ")" ::: "memory")
#define PG8_WAIT_L(n) asm volatile("s_waitcnt lgkmcnt(" #n ")" ::: "memory")
#define PG8_BAR __builtin_amdgcn_s_barrier()
#define PG8_SCHED __builtin_amdgcn_sched_barrier(0)
    Unit cur, nxt; int ui = 0;
    if (!S.next(0, cur)) return;
    f32x4 acc[2][2][4][2];
#pragma unroll
    for (int a = 0; a < 2; ++a)
#pragma unroll
        for (int b = 0; b < 2; ++b)
#pragma unroll
            for (int m = 0; m < 4; ++m)
#pragma unroll
                for (int n = 0; n < 2; ++n) acc[a][b][m][n] = (f32x4){0.f, 0.f, 0.f, 0.f};
    bf16x8 At[4][2], B0[2][2], B1[2][2];
    const char* cA = (const char*)g.A + (size_t)cur.pm * tstep; const char* cB = (const char*)g.Bt + (size_t)cur.pn * tstep;
    S.a_ready(cur);
    if constexpr (SP2) {
        PG8_STAGE(PG8_SB(0, 0), cB, voffB); PG8_STAGE(PG8_SB(0, 1), cB + hstep, voffB); PG8_STAGE(PG8_SA(0, 0), cA, voffA); PG8_STAGE(PG8_SA(0, 1), cA + hstep, voffA);
        if (wr == 1) PG8_BAR;
        PG8_WAIT_V(2); PG8_BAR;
        PG8_STAGE(PG8_SB(1, 0), cB + kstep, voffB); PG8_STAGE(PG8_SA(1, 0), cA + kstep, voffA); PG8_STAGE(PG8_SB(1, 1), cB + hstep + kstep, voffB);
        PG8_WAIT_V(6); PG8_BAR;
    } else {
        PG8_STAGE(PG8_SB(0, 0), cB, voffB); PG8_STAGE(PG8_SA(0, 0), cA, voffA); PG8_STAGE(PG8_SB(0, 1), cB + hstep, voffB); PG8_STAGE(PG8_SA(0, 1), cA + hstep, voffA);
        if (wr == 1) PG8_BAR;
        PG8_WAIT_V(4); PG8_BAR;
        PG8_STAGE(PG8_SB(1, 0), cB + kstep, voffB); PG8_STAGE(PG8_SA(1, 0), cA + kstep, voffA); PG8_STAGE(PG8_SB(1, 1), cB + hstep + kstep, voffB);
        PG8_WAIT_V(6); PG8_BAR;
    }
    for (;;) {
        const bool has_next = S.next(ui + 1, nxt);
        const char* nA = has_next ? (const char*)g.A + (size_t)nxt.pm * tstep : cA; const char* nB = has_next ? (const char*)g.Bt + (size_t)nxt.pn * tstep : cB;
        for (int t = 0; t < nt; t += 2) {
            const bool last = (t == nt - 2);
            const char* a1 = cA + (size_t)(t + 1) * kstep;
            const char* a2 = last ? nA : cA + (size_t)(t + 2) * kstep; const char* b2 = last ? nB : cB + (size_t)(t + 2) * kstep;
            const char* a3 = a2 + kstep; const char* b3 = b2 + kstep;
            if (last && has_next) S.a_ready(nxt);
            if constexpr (SP2) {
            PG8_LDB(B0, 0, 0); PG8_LDB(B1, 0, 1); PG8_SCHED; PG8_LDA(At, 0, 0); PG8_STAGE(PG8_SA(1, 1), a1 + hstep, voffA);
            PG8_WAIT_V(8); PG8_WAIT_L(0); PG8_BAR; PG8_MMA(0, 0, At, B0); PG8_MMA(0, 1, At, B1); PG8_BAR; PG8_SCHED;
            PG8_LDA(At, 0, 1); PG8_STAGE(PG8_SB(0, 0), b2, voffB); PG8_STAGE(PG8_SB(0, 1), b2 + hstep, voffB); PG8_STAGE(PG8_SA(0, 0), a2, voffA);
            PG8_WAIT_V(8); PG8_WAIT_L(0); PG8_BAR; PG8_MMA(1, 0, At, B0); PG8_MMA(1, 1, At, B1); PG8_BAR; PG8_SCHED;
            PG8_LDB(B0, 1, 0); PG8_LDB(B1, 1, 1); PG8_SCHED; PG8_LDA(At, 1, 0); PG8_STAGE(PG8_SA(0, 1), a2 + hstep, voffA);
            PG8_WAIT_V(8); PG8_WAIT_L(0); PG8_BAR; PG8_MMA(0, 0, At, B0); PG8_MMA(0, 1, At, B1); PG8_BAR; PG8_SCHED;
            PG8_LDA(At, 1, 1); PG8_STAGE(PG8_SB(1, 0), b3, voffB); PG8_STAGE(PG8_SB(1, 1), b3 + hstep, voffB); PG8_STAGE(PG8_SA(1, 0), a3, voffA);
            PG8_WAIT_V(8); PG8_WAIT_L(0); PG8_BAR; PG8_MMA(1, 0, At, B0); PG8_MMA(1, 1, At, B1); PG8_BAR; PG8_SCHED;
            } else {
            PG8_LDB(B0, 0, 0); PG8_SCHED; PG8_LDA(At, 0, 0); PG8_STAGE(PG8_SA(1, 1), a1 + hstep, voffA);
            PG8_WAIT_L(8); PG8_BAR; PG8_WAIT_L(0); PG8_MMA(0, 0, At, B0); PG8_BAR; PG8_SCHED;
            PG8_LDB(B1, 0, 1); PG8_STAGE(PG8_SB(0, 0), b2, voffB);
            PG8_BAR; PG8_WAIT_L(0); PG8_MMA(0, 1, At, B1); PG8_BAR;
            PG8_LDA(At, 0, 1); PG8_STAGE(PG8_SA(0, 0), a2, voffA);
            PG8_BAR; PG8_WAIT_L(0); PG8_MMA(1, 0, At, B0); PG8_BAR; PG8_SCHED;
            PG8_STAGE(PG8_SB(0, 1), b2 + hstep, voffB);
            PG8_WAIT_V(6); PG8_BAR; PG8_MMA(1, 1, At, B1); PG8_BAR;
            PG8_LDB(B0, 1, 0); PG8_SCHED; PG8_LDA(At, 1, 0); PG8_STAGE(PG8_SA(0, 1), a2 + hstep, voffA);
            PG8_WAIT_L(8); PG8_BAR; PG8_WAIT_L(0); PG8_MMA(0, 0, At, B0); PG8_BAR; PG8_SCHED;
            PG8_LDB(B1, 1, 1); PG8_STAGE(PG8_SB(1, 0), b3, voffB);
            PG8_BAR; PG8_WAIT_L(0); PG8_MMA(0, 1, At, B1); PG8_BAR;
            PG8_LDA(At, 1, 1); PG8_STAGE(PG8_SA(1, 0), a3, voffA);
            PG8_BAR; PG8_WAIT_L(0); PG8_MMA(1, 0, At, B0); PG8_BAR; PG8_SCHED;
            PG8_STAGE(PG8_SB(1, 1), b3 + hstep, voffB);
            PG8_WAIT_V(6); PG8_BAR; PG8_MMA(1, 1, At, B1); PG8_BAR;
            }
        }
        if constexpr (ALIGN_EPI) { if (wr == 0) PG8_BAR; }
        if constexpr (!Epi::AFTER_DRAIN) { E(acc, cur, wr, wc, fr, fq); S.done(cur); }
        if (!has_next) break;
#pragma unroll
        for (int a = 0; a < 2; ++a)
#pragma unroll
            for (int b = 0; b < 2; ++b)
#pragma unroll
                for (int m = 0; m < 4; ++m)
#pragma unroll
                    for (int n = 0; n < 2; ++n) acc[a][b][m][n] = (f32x4){0.f, 0.f, 0.f, 0.f};
        cur = nxt; cA = nA; cB = nB; ++ui;
        if constexpr (ALIGN_EPI) { if (wr == 1) PG8_BAR; }
    }
    PG8_WAIT_V(0);
    if constexpr (!ALIGN_EPI) { if (wr == 0) PG8_BAR; }
    PG8_BAR;
    if constexpr (Epi::AFTER_DRAIN) { E.fused(acc, cur, wr, wc, fr, fq, lds, wid, lane); S.done(cur); }
#undef PG8_SA
#undef PG8_SB
#undef PG8_STAGE
#undef PG8_LDA
#undef PG8_LDB
#undef PG8_MMA
#undef PG8_WAIT_V
#undef PG8_WAIT_L
#undef PG8_BAR
#undef PG8_SCHED
}
}
constexpr int NWAVES = 8;
constexpr int BATCH = 4, SEQ = 8192, D = 2048, M = BATCH * SEQ, NIN = 4096, LW = 1024, CHUNK = 128, NCHUNK = SEQ / CHUNK;
constexpr int NEXP = 16384;
#ifndef MK_N_LAUNCHES
#define MK_N_LAUNCHES 1
#endif
constexpr int N_LAUNCHES = MK_N_LAUNCHES;
constexpr int PER_PHASE = 11;
constexpr size_t MiB = 1u << 20;
constexpr size_t WS_CTL = 48 * MiB, CTL_ZERO_BYTES = 5 * MiB;
constexpr size_t WS_ROWSS = WS_CTL + 512 * 1024;
constexpr size_t WS_WIN = 2 * MiB, WS_WOUT = 18 * MiB, WS_WQ = 26 * MiB, WS_LRUW = 34 * MiB, WS_WSB = 35 * MiB, WS_AGG = 49 * MiB;
constexpr size_t WS_U = 64 * MiB, WS_V = 128 * MiB, WS_XN = 192 * MiB  , WS_Z = 320 * MiB  ;
constexpr size_t WS_HB = 576 * MiB, WS_IDS = 704 * MiB, WS_GATES = 720 * MiB, WS_PAIRS = 736 * MiB, WS_HBT = 752 * MiB, WS_END = 884 * MiB;
constexpr size_t WS_USCALE = 40 * MiB, WS_VSCALE = 41 * MiB;
constexpr size_t WS_HSCALE = 44 * MiB, WS_CARRY = 45 * MiB;
constexpr size_t WS_H8 = WS_XN, WS_PART = WS_XN + 64 * MiB;
constexpr size_t WS_ASCALE = 42 * MiB, WS_KH = 43 * MiB;
constexpr size_t WS_IDW = WS_PAIRS, WS_AW = 880 * MiB;
constexpr size_t WS_ROWSS2 = WS_CTL + 640 * 1024;
constexpr size_t WS_Y = WS_Z;
constexpr int CW_BAR = 4096;
constexpr int CW_LRUF = 8192;
constexpr int RING_BYTES = 131072;
constexpr int LDSCTL_OFF = 143360, MISC_OFF = LDSCTL_OFF + 320;
constexpr int LDS_BYTES = 147456;
#define GAS __attribute__((address_space(1)))
#define LAS __attribute__((address_space(3)))
typedef unsigned short bf16;
typedef unsigned v4u __attribute__((ext_vector_type(4)));
typedef float f32x4 __attribute__((ext_vector_type(4)));
typedef short bf16x8 __attribute__((ext_vector_type(8)));
typedef GAS unsigned gu32;
typedef GAS unsigned long long gu64;
#define RLX_AGENT __ATOMIC_RELAXED, __HIP_MEMORY_SCOPE_AGENT
#define LDS_WAIT() asm volatile("s_waitcnt lgkmcnt(0)" ::: "memory")
#define VM_WAIT() asm volatile("s_waitcnt vmcnt(0)" ::: "memory")
__device__ __forceinline__ unsigned long long rt() { return __builtin_amdgcn_s_memrealtime(); }
__device__ __forceinline__ unsigned f2bf(float f) { unsigned u = __builtin_bit_cast(unsigned, f); return (u + 0x7fffu + ((u >> 16) & 1u)) >> 16; }
__device__ __forceinline__ unsigned pk2(float lo, float hi) { return f2bf(lo) | (f2bf(hi) << 16); }

#define XB_TMO      128
#define XB_XCNT(j)  (256  + 64 * (j))
#define XB_XSUB(j)  (1280 + 64 * (j))
#define XB_XGEN(j)  (2304 + 64 * (j))
#define XB_TOP      3328
#define XB_TOPGEN   3392
#define XCD_BAR_WORDS 3456
#define XB_SPIN_CAP (1u << 18)

__device__ __forceinline__ unsigned xb_ld(unsigned* p)              { return __hip_atomic_load(p, __ATOMIC_RELAXED, __HIP_MEMORY_SCOPE_AGENT); }
__device__ __forceinline__ unsigned xb_add(unsigned* p, unsigned v) { return __hip_atomic_fetch_add(p, v, __ATOMIC_RELAXED, __HIP_MEMORY_SCOPE_AGENT); }
__device__ __forceinline__ unsigned xb_xcc_id() { return (unsigned)__builtin_amdgcn_s_getreg((3 << 11) | 20) & 0xFu; }
#define XB_SPIN(cond, bar) do { unsigned _sp = 0; while (cond) { __builtin_amdgcn_s_sleep(1); \
    if ((++_sp & 255u) == 0u) { if (xb_ld(&(bar)[XB_TMO])) break; if (_sp > XB_SPIN_CAP) { atomicAdd(&(bar)[XB_TMO], 1u); break; } } } } while (0)

struct XcdBarrier {
    unsigned* bar; unsigned x;
    volatile LAS unsigned* st;
};

__device__ __forceinline__ XcdBarrier xcd_barrier_post(unsigned* bar, volatile LAS unsigned* st) {
    XcdBarrier b; b.bar = bar; b.x = xb_xcc_id(); b.st = st;
    if (threadIdx.x == 0) (void)xb_add(&bar[XB_XCNT(b.x)], 1u);
    return b;
}
__device__ __forceinline__ void xcd_barrier_complete(unsigned* bar, unsigned x, unsigned& nloc, unsigned& nx) {
    const unsigned G = gridDim.x * gridDim.y * gridDim.z;
    unsigned sum, cnt, mine, sp = 0u;
    for (;;) {
        sum = 0u; cnt = 0u; mine = 0u;
#pragma unroll
        for (unsigned j = 0; j < 16; ++j) { const unsigned c = xb_ld(&bar[XB_XCNT(j)]); sum += c; cnt += (c > 0u) ? 1u : 0u; mine = (j == x) ? c : mine; }
        if (sum == G) break;
        __builtin_amdgcn_s_sleep(1);
        if ((++sp & 255u) == 0u) { if (xb_ld(&bar[XB_TMO])) break; if (sp > XB_SPIN_CAP) { atomicAdd(&bar[XB_TMO], 1u); break; } }
    }
    nloc = mine > 0u ? mine : 1u; nx = cnt > 0u ? cnt : 1u;
}

__device__ __forceinline__ void xcd_barrier(const XcdBarrier& b) {
    asm volatile("s_waitcnt vmcnt(0)" ::: "memory");
    __syncthreads();
    if (threadIdx.x == 0) {
        unsigned* bar = b.bar;
        __builtin_amdgcn_s_waitcnt(0);
        unsigned nloc = b.st[0], nx = b.st[1];
        if (nloc == 0u) { xcd_barrier_complete(bar, b.x, nloc, nx); b.st[0] = nloc; b.st[1] = nx; }
        const unsigned old = xb_add(&bar[XB_XSUB(b.x)], 1u);
        const unsigned gen = old / nloc;
        if (old + 1u == (gen + 1u) * nloc) {
            __builtin_amdgcn_fence(__ATOMIC_RELEASE, "agent");
            asm volatile("s_waitcnt vmcnt(0)" ::: "memory");
            const unsigned og = xb_add(&bar[XB_TOP], 1u);
            const unsigned tg = og / nx;
            if (og + 1u == (tg + 1u) * nx) xb_add(&bar[XB_TOPGEN], 1u);
            else XB_SPIN(xb_ld(&bar[XB_TOPGEN]) == tg, bar);
            __builtin_amdgcn_fence(__ATOMIC_ACQUIRE, "agent");
            xb_add(&bar[XB_XGEN(b.x)], 1u);
            asm volatile("s_waitcnt vmcnt(0)" ::: "memory");
        } else {
            XB_SPIN(xb_ld(&bar[XB_XGEN(b.x)]) == gen, bar);
            __builtin_amdgcn_fence(__ATOMIC_ACQUIRE, "agent");
            asm volatile("s_waitcnt vmcnt(0)" ::: "memory");
        }
    }
    __syncthreads();
}
typedef unsigned v2u __attribute__((ext_vector_type(2)));
typedef float f32x2 __attribute__((ext_vector_type(2)));
struct Args { const float* in[21]; float* out; unsigned char* ws; int ph_lo, ph_hi; };
struct Frame {
    const Args& A;
    LAS unsigned char* lds;
    volatile LAS unsigned* MISC;
    gu32* ctl;
    unsigned char* ws;
    int tid, lane, wave, vcu, G;
    __device__ __forceinline__ Frame(const Args& a) : A(a) {}
#define WSP(name, type, off) __device__ __forceinline__ type* name() const { return (type*)(ws + (off)); }
    WSP(WIN, bf16, WS_WIN) WSP(WOUT, bf16, WS_WOUT) WSP(WQ, bf16, WS_WQ) WSP(LRUW, bf16, WS_LRUW) WSP(WSB, bf16, WS_WSB)
    WSP(XN, bf16, WS_XN) WSP(MIX, bf16, WS_XN) WSP(Z, bf16, WS_Z) WSP(HB, bf16, WS_HB) WSP(HBT, bf16, WS_HBT)
    WSP(U8, unsigned char, WS_U) WSP(V8T, unsigned char, WS_V)
    WSP(ROWSS, float, WS_ROWSS) WSP(ROWSS2, float, WS_ROWSS2) WSP(QH, bf16, WS_Z) WSP(QL, bf16, WS_Z + 128 * MiB) WSP(KH, bf16, WS_KH) WSP(KL, bf16, WS_KH + 512 * 1024) WSP(AGG, float, WS_AGG) WSP(CARRY, float, WS_CARRY) WSP(AU, unsigned, WS_HB) WSP(GATES, float, WS_GATES)
    WSP(USCALE, float, WS_USCALE) WSP(VSCALE, float, WS_VSCALE) WSP(Y, bf16, WS_Y) WSP(IDS, int, WS_IDS) WSP(ASCALE, float, WS_ASCALE) WSP(IDW, v4u, WS_IDW) WSP(AW, unsigned, WS_AW) WSP(H8, unsigned char, WS_H8) WSP(HSCALE, float, WS_HSCALE) WSP(PART, int, WS_PART)
#undef WSP
};
__device__ __forceinline__ float wave_sum(float v) {
#pragma unroll
    for (int o = 1; o < 64; o <<= 1) v += __shfl_xor(v, o);
    return v;
}
__device__ __forceinline__ float bf_lo(unsigned w) { return __builtin_bit_cast(float, w << 16); }
__device__ __forceinline__ float bf_hi(unsigned w) { return __builtin_bit_cast(float, w & 0xffff0000u); }
__device__ __forceinline__ float bf1(unsigned short h) { return __builtin_bit_cast(float, (unsigned)h << 16); }
__device__ __forceinline__ float sigmoidf_(float x) { return __builtin_amdgcn_rcpf(1.0f + __builtin_amdgcn_exp2f(-1.4426950409f * x)); }
using pg8::gelu_tanh;
__device__ __forceinline__ unsigned pack_i8x4(float a, float b, float c, float d) {
    const int ia = (int)__builtin_rintf(a), ib = (int)__builtin_rintf(b), ic = (int)__builtin_rintf(c), id = (int)__builtin_rintf(d);
    return (unsigned)(ia & 0xff) | ((unsigned)(ib & 0xff) << 8) | ((unsigned)(ic & 0xff) << 16) | ((unsigned)id << 24);
}

__device__ __forceinline__ void p0_transpose_item(const float* W, int K, int N, bf16* WT, const float* kscale, LAS float* scr, int item, int lane) {
    const int nblk = N / 32, kb = item / nblk, nb = item % nblk, k0 = 64 * kb, n0 = 32 * nb;
#pragma unroll 8
    for (int i = 0; i < 32; ++i) { const int kk = 2 * i + (lane >> 5); const float sc = kscale ? kscale[k0 + kk] : 1.0f; scr[kk * 33 + (lane & 31)] = W[(size_t)(k0 + kk) * N + n0 + (lane & 31)] * sc; }
    LDS_WAIT(); asm volatile("" ::: "memory");
    const int c = lane & 7;
#pragma unroll
    for (int j = 0; j < 4; ++j) { const int n = (lane >> 3) + 8 * j; const LAS float* s = scr + (8 * c) * 33 + n;
        v4u o; o.x = pk2(s[0 * 33], s[1 * 33]); o.y = pk2(s[2 * 33], s[3 * 33]); o.z = pk2(s[4 * 33], s[5 * 33]); o.w = pk2(s[6 * 33], s[7 * 33]);
        *(GAS v4u*)(WT + (size_t)(n0 + n) * K + k0 + 8 * c) = o; }
    LDS_WAIT(); asm volatile("" ::: "memory");
}
__device__ __forceinline__ void p0_prologue(Frame& F) {
    LAS float* scr = (LAS float*)(F.lds + F.wave * 16384);
    const int gw = F.vcu * NWAVES + F.wave, NGW = F.G * NWAVES, lane = F.lane;
    constexpr int I_IN = (D / 64) * (NIN / 32), I_OUT = (D / 64) * (D / 32), I_Q = I_OUT, I_LRU = 32 * 8;
    constexpr int NITEMS = I_IN + I_OUT + I_Q + I_LRU;
    for (int it = gw; it < NITEMS; it += NGW) {
        int r = it;
        if (r < I_IN) { p0_transpose_item(F.A.in[2], D, NIN, F.WIN(), F.A.in[1], scr, r, lane); continue; } r -= I_IN;
        if (r < I_OUT) { p0_transpose_item(F.A.in[14], D, D, F.WOUT(), nullptr, scr, r, lane); continue; } r -= I_OUT;
        if (r < I_Q) { p0_transpose_item(F.A.in[16], D, D, F.WQ(), F.A.in[15], scr, r, lane); continue; } r -= I_Q;
        { const int mi = r >> 3, sub = r & 7, gate = mi >> 4, rest = mi & 15;
          const float* src = (gate ? F.A.in[7] : F.A.in[5]) + (size_t)rest * 16384;
          p0_transpose_item(src, 128, 128, F.LRUW() + (size_t)mi * 16384, nullptr, scr, sub, lane); }
    }
    const size_t gt = (size_t)gw * 64 + lane, NGT = (size_t)NGW * 64;
    {
        const float* g2 = F.A.in[15];
        f32x4 gg[8];
#pragma unroll
        for (int j = 0; j < 8; ++j) gg[j] = *(const GAS f32x4*)(g2 + j * 256 + lane * 4);
        for (int e = gw; e < NEXP; e += NGW) {
            const GAS f32x4* ur = (const GAS f32x4*)(F.A.in[18] + (size_t)e * D) + lane;
            f32x4 v[8]; float ss = 0.f;
#pragma unroll
            for (int j = 0; j < 8; ++j) { v[j] = __builtin_nontemporal_load(ur + 64 * j) * gg[j]; ss += (v[j].x * v[j].x + v[j].y * v[j].y) + (v[j].z * v[j].z + v[j].w * v[j].w); }
            const float rms = __builtin_amdgcn_sqrtf(wave_sum(ss) * (1.0f / D));
            const float sc = rms > 0.f ? 7.0f / (2.8f * rms) : 1.0f;
            GAS unsigned* o4 = (GAS unsigned*)(F.U8() + (size_t)e * 1024) + (lane >> 1);
#pragma unroll
            for (int j = 0; j < 8; ++j) {
                const int c0 = (int)fminf(fmaxf(__builtin_rintf(v[j].x * sc), -7.f), 7.f) & 15, c1 = (int)fminf(fmaxf(__builtin_rintf(v[j].y * sc), -7.f), 7.f) & 15;
                const int c2 = (int)fminf(fmaxf(__builtin_rintf(v[j].z * sc), -7.f), 7.f) & 15, c3 = (int)fminf(fmaxf(__builtin_rintf(v[j].w * sc), -7.f), 7.f) & 15;
                const unsigned cw = (unsigned)c0 | ((unsigned)c1 << 8) | ((unsigned)c2 << 16) | ((unsigned)c3 << 24);
                const unsigned pw = (unsigned)__shfl_xor((int)cw, 1);
                if ((lane & 1) == 0) __builtin_nontemporal_store(cw | (pw << 4), o4 + 32 * j);
            }
            if (lane == 0) F.USCALE()[e] = rms > 0.f ? 2.8f * rms * (1.0f / 7.0f) : 1.0f;
        }
    }
    __syncthreads();
    for (int un = blockIdx.x; un < NEXP / 64; un += F.G) {
        const int e0 = un * 64;
        for (int rr = 0; rr < 8; ++rr) {
            const int el = F.wave * 8 + rr, e = e0 + el;
            const GAS f32x4* vr = (const GAS f32x4*)(F.A.in[19] + (size_t)e * D) + lane;
            f32x4 v[8]; float mx = 0.f;
#pragma unroll
            for (int j = 0; j < 8; ++j) { v[j] = __builtin_nontemporal_load(vr + 64 * j); mx = fmaxf(mx, fmaxf(fmaxf(fabsf(v[j].x), fabsf(v[j].y)), fmaxf(fabsf(v[j].z), fabsf(v[j].w)))); }
#pragma unroll
            for (int o = 1; o < 64; o <<= 1) mx = fmaxf(mx, __shfl_xor(mx, o));
            const float sc = mx > 0.f ? 127.0f / mx : 1.0f;
#pragma unroll
            for (int j = 0; j < 8; ++j) *(LAS unsigned*)(F.lds + el * 2056 + j * 256 + lane * 4) = pack_i8x4(v[j].x * sc, v[j].y * sc, v[j].z * sc, v[j].w * sc);
            if (lane == 0) F.VSCALE()[e] = mx > 0.f ? mx * (1.0f / 127.0f) : 1.0f;
        }
        __syncthreads();
        for (int cc = 0; cc < 32; ++cc) { const int c = F.wave * 32 + cc;
            const v2u w = *(const LAS v2u*)(F.lds + lane * 2056 + c * 8);
            __builtin_nontemporal_store(w, (v2u*)(F.V8T() + ((size_t)c * NEXP + e0 + lane) * 8)); }
        __syncthreads();
    }
    for (size_t ch = gt; ch < (size_t)8 * 128 * 128 / 8; ch += NGT) {
        const size_t e0 = ch * 8;
        const f32x4 a = *(const GAS f32x4*)(F.A.in[12] + e0), b = *(const GAS f32x4*)(F.A.in[12] + e0 + 4);
        v4u o; o.x = pk2(a.x, a.y); o.y = pk2(a.z, a.w); o.z = pk2(b.x, b.y); o.w = pk2(b.z, b.w);
        *(GAS v4u*)(F.WSB() + e0) = o;
    }
    for (size_t ch = gt; ch < (size_t)16 * 128 * 128 / 8; ch += NGT) {
        const size_t e0 = ch * 8;
        const f32x4 a = *(const GAS f32x4*)(F.A.in[17] + e0), b = *(const GAS f32x4*)(F.A.in[17] + e0 + 4);
        v4u hi; hi.x = pk2(a.x, a.y); hi.y = pk2(a.z, a.w); hi.z = pk2(b.x, b.y); hi.w = pk2(b.z, b.w);
        *(GAS v4u*)(F.KH() + e0) = hi;
    }
    for (int m = gw; m < M; m += NGW) {
        const GAS f32x4* xr = (const GAS f32x4*)(F.A.in[0] + (size_t)m * D) + lane;
        f32x4 v[8]; float s = 0.f;
#pragma unroll
        for (int j = 0; j < 8; ++j) { v[j] = __builtin_nontemporal_load(xr + 64 * j); s += (v[j].x * v[j].x + v[j].y * v[j].y) + (v[j].z * v[j].z + v[j].w * v[j].w); }
        const float rstd = __builtin_amdgcn_rsqf(wave_sum(s) * (1.f / D) + 1e-6f);
        GAS unsigned long long* o8 = (GAS unsigned long long*)(F.XN() + (size_t)m * D) + lane;
#pragma unroll
        for (int j = 0; j < 8; ++j) o8[64 * j] = (unsigned long long)pk2(v[j].x * rstd, v[j].y * rstd) | ((unsigned long long)pk2(v[j].z * rstd, v[j].w * rstd) << 32);
    }
}
constexpr int LRU_XR = 0, LRU_XC = 33792, LRU_GR = 33792 + 40960;
constexpr float LOG2E = 1.4426950408889634f;
__device__ __forceinline__ int xc_off(int tok, int ch) { return tok * 320 + (tok >> 5) * 16 + ch * 2; }
template <bool APPLY, int DIR>
__device__ __forceinline__ void lru_dir(Frame& F, int unit, int b, int c, int h, const bf16x8 (&Ba)[4], const bf16x8 (&Bx)[4], float (&hsum)[8][4]) {
    const int lane = F.lane, w = F.wave, fr = lane & 15, fq = lane >> 4;
    LAS unsigned char* XC = F.lds + LRU_XC;
    const int chl = 16 * w + fr, chg = h * 128 + chl;
    v4u* au = (v4u*)F.AU() + ((size_t)((unit * 2 + DIR) * NWAVES + w) * 8) * 64 + lane;
    f32x4 R[8], I[8];
    float carry = 0.f;
    if (APPLY) {
        carry = F.CARRY()[(size_t)((b * 2 + DIR) * NCHUNK + c) * LW + chg];
        v4u q[8];
#pragma unroll
        for (int m = 0; m < 8; ++m) q[m] = __builtin_nontemporal_load(au + m * 64);
#pragma unroll
        for (int m = 0; m < 8; ++m) {
            R[m] = (f32x4){__builtin_amdgcn_exp2f(bf_lo(q[m].x)), __builtin_amdgcn_exp2f(bf_lo(q[m].y)), __builtin_amdgcn_exp2f(bf_lo(q[m].z)), __builtin_amdgcn_exp2f(bf_lo(q[m].w))};
            I[m] = (f32x4){bf_hi(q[m].x), bf_hi(q[m].y), bf_hi(q[m].z), bf_hi(q[m].w)}; }
    } else {
        const float ba = F.A.in[6][DIR * LW + chg], bx = F.A.in[8][DIR * LW + chg], lam = F.A.in[9][DIR * LW + chg];
        const float cl = -8.0f * log1pf(__expf(-lam)) * LOG2E;
        const int arow = (fr >> 2) * 32 + (fr & 3);
#pragma unroll
        for (int m = 0; m < 8; ++m) {
            R[m] = (f32x4){0.f, 0.f, 0.f, 0.f}; I[m] = (f32x4){0.f, 0.f, 0.f, 0.f};
#pragma unroll
            for (int ks = 0; ks < 4; ++ks) {
                const bf16x8 a = *(const LAS bf16x8*)(XC + xc_off(arow + 4 * m, 32 * ks + 8 * fq));
                R[m] = __builtin_amdgcn_mfma_f32_16x16x32_bf16(a, Ba[ks], R[m], 0, 0, 0);
                I[m] = __builtin_amdgcn_mfma_f32_16x16x32_bf16(a, Bx[ks], I[m], 0, 0, 0);
            }
        }
#pragma unroll
        for (int m = 0; m < 8; ++m) {
            float la[4];
#pragma unroll
            for (int j = 0; j < 4; ++j) {
                const float r = sigmoidf_(R[m][j] + ba), ig = sigmoidf_(I[m][j] + bx);
                la[j] = cl * r;
                const float a = __builtin_amdgcn_exp2f(la[j]);
                const float xc = bf1(*(const LAS unsigned short*)(XC + xc_off(32 * fq + 4 * m + j, chl)));
                R[m][j] = a; I[m][j] = __builtin_amdgcn_sqrtf(fmaxf(1.0f - a * a, 0.0f)) * (ig * xc);
            }
            __builtin_nontemporal_store((v4u){pk2(la[0], I[m][0]), pk2(la[1], I[m][1]), pk2(la[2], I[m][2]), pk2(la[3], I[m][3])}, au + m * 64);
        }
    }
    float P = 1.f, L = 0.f;
#pragma unroll
    for (int mm = 0; mm < 8; ++mm) {
        const int m = DIR == 0 ? mm : 7 - mm;
#pragma unroll
        for (int jj = 0; jj < 4; ++jj) {
            const int j = DIR == 0 ? jj : 3 - jj;
            const float a = R[m][j], u = I[m][j];
            L = a * L + u; P = a * P;
            R[m][j] = P; I[m][j] = L;
        }
    }
    const int src1 = DIR == 0 ? lane - 16 : lane + 16, src2 = DIR == 0 ? lane - 32 : lane + 32;
    const bool v1 = DIR == 0 ? (fq >= 1) : (fq <= 2), v2 = DIR == 0 ? (fq >= 2) : (fq <= 1);
    float A = P, B = L;
    { const float pa = __shfl(A, src1), pb = __shfl(B, src1); if (v1) { B = A * pb + B; A = A * pa; } }
    { const float pa = __shfl(A, src2), pb = __shfl(B, src2); if (v2) { B = A * pb + B; A = A * pa; } }
    if (APPLY) {
        float EA = __shfl(A, src1), EB = __shfl(B, src1); if (!v1) { EA = 1.f; EB = 0.f; }
        const float hin = EA * carry + EB;
#pragma unroll
        for (int m = 0; m < 8; ++m)
#pragma unroll
            for (int j = 0; j < 4; ++j) { const float hh = R[m][j] * hin + I[m][j]; if (DIR == 0) hsum[m][j] = hh; else hsum[m][j] += hh; }
    } else {
        const bool lastlane = DIR == 0 ? (fq == 3) : (fq == 0);
        if (lastlane) { f32x2* agg = (f32x2*)F.AGG() + (size_t)((b * 2 + DIR) * NCHUNK + c) * LW + chg; *agg = (f32x2){A, B}; }
    }
}

template <bool APPLY>
__device__ __forceinline__ void lru_unit(Frame& F, int unit) {
    const int h = unit & 7, c = (unit >> 3) & 63, b = unit >> 9;
    const int tid = F.tid, lane = F.lane, w = F.wave, fr = lane & 15, fq = lane >> 4;
    const size_t t0 = (size_t)b * SEQ + (size_t)c * CHUNK;
    LAS unsigned char* XR = F.lds + LRU_XR; LAS unsigned char* XC = F.lds + LRU_XC; LAS unsigned char* GR = F.lds + LRU_GR;
    bf16x8 Ba0[4], Bx0[4], Ba1[4], Bx1[4];
    if (!APPLY) {
        const bf16* wb = F.LRUW() + (size_t)h * 16384 + (size_t)(16 * w + fr) * 128 + 8 * fq;
#pragma unroll
        for (int ks = 0; ks < 4; ++ks) { Ba0[ks] = *(const GAS bf16x8*)(wb + 32 * ks); Ba1[ks] = *(const GAS bf16x8*)(wb + (size_t)8 * 16384 + 32 * ks);
            Bx0[ks] = *(const GAS bf16x8*)(wb + (size_t)16 * 16384 + 32 * ks); Bx1[ks] = *(const GAS bf16x8*)(wb + (size_t)24 * 16384 + 32 * ks); }
        for (int p = tid; p < 131 * 16; p += 512) { const int r = p >> 4, cg = p & 15; const int s = c * CHUNK - 2 + r; v4u v = (v4u){0u, 0u, 0u, 0u};
            if (s >= 0 && s < SEQ) v = *(const GAS v4u*)(F.Z() + ((size_t)b * SEQ + s) * NIN + h * 128 + cg * 8);
            *(LAS v4u*)(XR + r * 256 + cg * 16) = v; }
        __syncthreads();
        {
            const int ch2 = tid & 63, tg = tid >> 6, chg = h * 128 + 2 * ch2;
            float w0[4], w1[4];
#pragma unroll
            for (int k = 0; k < 4; ++k) { w0[k] = F.A.in[3][k * LW + chg]; w1[k] = F.A.in[3][k * LW + chg + 1]; }
            const float b0 = F.A.in[4][chg], b1 = F.A.in[4][chg + 1];
            float x0[4], x1[4];
#pragma unroll
            for (int k = 0; k < 3; ++k) { const unsigned u = *(const LAS unsigned*)(XR + (16 * tg + k) * 256 + ch2 * 4); x0[k] = bf_lo(u); x1[k] = bf_hi(u); }
#pragma unroll
            for (int j = 0; j < 16; ++j) {
                const unsigned u = *(const LAS unsigned*)(XR + (16 * tg + j + 3) * 256 + ch2 * 4); x0[3] = bf_lo(u); x1[3] = bf_hi(u);
                const float y0 = b0 + ((w0[0] * x0[0] + w0[1] * x0[1]) + (w0[2] * x0[2] + w0[3] * x0[3]));
                const float y1 = b1 + ((w1[0] * x1[0] + w1[1] * x1[1]) + (w1[2] * x1[2] + w1[3] * x1[3]));
                *(LAS unsigned*)(XC + xc_off(16 * tg + j, 2 * ch2)) = pk2(y0, y1);
                x0[0] = x0[1]; x0[1] = x0[2]; x0[2] = x0[3]; x1[0] = x1[1]; x1[1] = x1[2]; x1[2] = x1[3];
            }
        }
        __syncthreads();
    } else {
#pragma unroll
        for (int ks = 0; ks < 4; ++ks) { Ba0[ks] = Ba1[ks] = Bx0[ks] = Bx1[ks] = (bf16x8){0, 0, 0, 0, 0, 0, 0, 0}; }
        for (int p = tid; p < 128 * 32; p += 512) { const int r = p >> 5, cg = p & 31;
            *(LAS v2u*)(GR + r * 264 + cg * 8) = *(const GAS v2u*)(F.Z() + (t0 + r) * NIN + LW + h * 128 + cg * 4); }
    }
    float hsum[8][4];
    lru_dir<APPLY, 0>(F, unit, b, c, h, Ba0, Bx0, hsum);
    asm volatile("" ::: "memory"); __builtin_amdgcn_sched_barrier(0);
    lru_dir<APPLY, 1>(F, unit, b, c, h, Ba1, Bx1, hsum);
    if (APPLY) {
        const int chl = 16 * w + fr;
        __syncthreads();
#pragma unroll
        for (int m = 0; m < 8; ++m)
#pragma unroll
            for (int j = 0; j < 4; ++j) { LAS unsigned short* p = (LAS unsigned short*)(GR + (32 * fq + 4 * m + j) * 264 + chl * 2); *p = (unsigned short)f2bf(bf1(*p) * hsum[m][j]); }
        __syncthreads();
        for (int p = tid; p < 128 * 32; p += 512) { const int r = p >> 5, cg = p & 31;
            *(GAS v2u*)(F.MIX() + (t0 + r) * D + h * 128 + cg * 4) = *(const LAS v2u*)(GR + r * 264 + cg * 8); }
    }
    __syncthreads();
}

constexpr int LRU_PT = LRU_XR, LRU_CR = LRU_XR + 8192;
template <int DIR>
__device__ __forceinline__ void lru_scan_dir(Frame& F, int b, int c, int h, const bf16x8 (&Ba)[4], const bf16x8 (&Bx)[4], f32x4 (&R)[8], f32x4 (&I)[8], float& EA, float& EB) {
    const int lane = F.lane, w = F.wave, fr = lane & 15, fq = lane >> 4;
    LAS unsigned char* XC = F.lds + LRU_XC;
    const int chl = 16 * w + fr, chg = h * 128 + chl;
    {
        const float ba = F.A.in[6][DIR * LW + chg], bx = F.A.in[8][DIR * LW + chg], lam = F.A.in[9][DIR * LW + chg];
        const float cl = -8.0f * log1pf(__expf(-lam)) * LOG2E;
        const int arow = (fr >> 2) * 32 + (fr & 3);
#pragma unroll
        for (int m = 0; m < 8; ++m) {
            R[m] = (f32x4){0.f, 0.f, 0.f, 0.f}; I[m] = (f32x4){0.f, 0.f, 0.f, 0.f};
#pragma unroll
            for (int ks = 0; ks < 4; ++ks) {
                const bf16x8 a = *(const LAS bf16x8*)(XC + xc_off(arow + 4 * m, 32 * ks + 8 * fq));
                R[m] = __builtin_amdgcn_mfma_f32_16x16x32_bf16(a, Ba[ks], R[m], 0, 0, 0);
                I[m] = __builtin_amdgcn_mfma_f32_16x16x32_bf16(a, Bx[ks], I[m], 0, 0, 0);
            }
        }
#pragma unroll
        for (int m = 0; m < 8; ++m) {
#pragma unroll
            for (int j = 0; j < 4; ++j) {
                const float r = sigmoidf_(R[m][j] + ba), ig = sigmoidf_(I[m][j] + bx);
                const float a = __builtin_amdgcn_exp2f(cl * r);
                const float xc = bf1(*(const LAS unsigned short*)(XC + xc_off(32 * fq + 4 * m + j, chl)));
                R[m][j] = a; I[m][j] = __builtin_amdgcn_sqrtf(fmaxf(1.0f - a * a, 0.0f)) * (ig * xc);
            }
        }
    }
    float P = 1.f, L = 0.f;
#pragma unroll
    for (int mm = 0; mm < 8; ++mm) {
        const int m = DIR == 0 ? mm : 7 - mm;
#pragma unroll
        for (int jj = 0; jj < 4; ++jj) {
            const int j = DIR == 0 ? jj : 3 - jj;
            const float a = R[m][j], u = I[m][j];
            L = a * L + u; P = a * P;
            R[m][j] = P; I[m][j] = L;
        }
    }
    const int src1 = DIR == 0 ? lane - 16 : lane + 16, src2 = DIR == 0 ? lane - 32 : lane + 32;
    const bool v1 = DIR == 0 ? (fq >= 1) : (fq <= 2), v2 = DIR == 0 ? (fq >= 2) : (fq <= 1);
    float A = P, B = L;
    { const float pa = __shfl(A, src1), pb = __shfl(B, src1); if (v1) { B = A * pb + B; A = A * pa; } }
    { const float pa = __shfl(A, src2), pb = __shfl(B, src2); if (v2) { B = A * pb + B; A = A * pa; } }
    EA = __shfl(A, src1); EB = __shfl(B, src1); if (!v1) { EA = 1.f; EB = 0.f; }
    const bool lastlane = DIR == 0 ? (fq == 3) : (fq == 0);
    if (lastlane) {
        const unsigned long long word = (unsigned long long)(__builtin_bit_cast(unsigned, A) | 1u) | ((unsigned long long)__builtin_bit_cast(unsigned, B) << 32);
        __hip_atomic_store((unsigned long long*)F.AGG() + (size_t)((b * 2 + DIR) * NCHUNK + c) * LW + chg, word, RLX_AGENT);
    }
}
__device__ __forceinline__ void lru_decode(int unit, int& b, int& c, int& h) { const int rnd = unit >> 8, within = unit & 255; b = rnd >> 1; h = (rnd & 1) * 4 + (within & 3); c = within >> 2; }
__device__ __forceinline__ void lru_prefetch(Frame& F, int unit, int tid, v4u (&xr)[5]) {
    int b, c, h; lru_decode(unit, b, c, h);
#pragma unroll
    for (int i = 0; i < 5; ++i) { const int p = tid + 512 * i, r = p >> 4, cg = p & 15; const int s = c * CHUNK - 2 + r; xr[i] = (v4u){0u, 0u, 0u, 0u};
        if (p < 131 * 16 && s >= 0 && s < SEQ) xr[i] = *(const GAS v4u*)(F.Z() + ((size_t)b * SEQ + s) * NIN + h * 128 + cg * 8); }
}
__device__ __forceinline__ void lru_fused_unit(Frame& F, int unit, int next, v4u (&xr)[5]) {
    int b, c, h; lru_decode(unit, b, c, h);
    int tid = F.tid; asm volatile("" : "+v"(tid));
    const int lane = tid & 63, w = F.wave, fr = lane & 15, fq = lane >> 4;
    const size_t t0 = (size_t)b * SEQ + (size_t)c * CHUNK;
    LAS unsigned char* XR = F.lds + LRU_XR; LAS unsigned char* XC = F.lds + LRU_XC; LAS unsigned char* GR = F.lds + LRU_GR;
    bf16x8 Ba0[4], Bx0[4], Ba1[4], Bx1[4];
    {
        const bf16* wb = F.LRUW() + (size_t)h * 16384 + (size_t)(16 * w + fr) * 128 + 8 * fq;
#pragma unroll
        for (int ks = 0; ks < 4; ++ks) { Ba0[ks] = *(const GAS bf16x8*)(wb + 32 * ks); Ba1[ks] = *(const GAS bf16x8*)(wb + (size_t)8 * 16384 + 32 * ks);
            Bx0[ks] = *(const GAS bf16x8*)(wb + (size_t)16 * 16384 + 32 * ks); Bx1[ks] = *(const GAS bf16x8*)(wb + (size_t)24 * 16384 + 32 * ks); }
#pragma unroll
        for (int i = 0; i < 5; ++i) { const int p = tid + 512 * i, r = p >> 4, cg = p & 15; if (p < 131 * 16) *(LAS v4u*)(XR + r * 256 + cg * 16) = xr[i]; }
        v2u gr[8];
#pragma unroll
        for (int i = 0; i < 8; ++i) { const int p = tid + 512 * i, r = p >> 5, cg = p & 31;
            gr[i] = *(const GAS v2u*)(F.Z() + (t0 + r) * NIN + LW + h * 128 + cg * 4); }
        __syncthreads();
        {
            const int ch2 = tid & 63, tg = tid >> 6, chg = h * 128 + 2 * ch2;
            float w0[4], w1[4];
#pragma unroll
            for (int k = 0; k < 4; ++k) { w0[k] = F.A.in[3][k * LW + chg]; w1[k] = F.A.in[3][k * LW + chg + 1]; }
            const float b0 = F.A.in[4][chg], b1 = F.A.in[4][chg + 1];
            float x0[4], x1[4];
#pragma unroll
            for (int k = 0; k < 3; ++k) { const unsigned u = *(const LAS unsigned*)(XR + (16 * tg + k) * 256 + ch2 * 4); x0[k] = bf_lo(u); x1[k] = bf_hi(u); }
#pragma unroll
            for (int j = 0; j < 16; ++j) {
                const unsigned u = *(const LAS unsigned*)(XR + (16 * tg + j + 3) * 256 + ch2 * 4); x0[3] = bf_lo(u); x1[3] = bf_hi(u);
                const float y0 = b0 + ((w0[0] * x0[0] + w0[1] * x0[1]) + (w0[2] * x0[2] + w0[3] * x0[3]));
                const float y1 = b1 + ((w1[0] * x1[0] + w1[1] * x1[1]) + (w1[2] * x1[2] + w1[3] * x1[3]));
                *(LAS unsigned*)(XC + xc_off(16 * tg + j, 2 * ch2)) = pk2(y0, y1);
                x0[0] = x0[1]; x0[1] = x0[2]; x0[2] = x0[3]; x1[0] = x1[1]; x1[1] = x1[2]; x1[2] = x1[3];
            }
        }
#pragma unroll
        for (int i = 0; i < 8; ++i) { const int p = tid + 512 * i, r = p >> 5, cg = p & 31; *(LAS v2u*)(GR + r * 264 + cg * 8) = gr[i]; }
        __syncthreads();
    }
    f32x4 R0[8], I0[8], R1[8], I1[8]; float EA0, EB0, EA1, EB1;
    lru_scan_dir<0>(F, b, c, h, Ba0, Bx0, R0, I0, EA0, EB0);
    asm volatile("" ::: "memory"); __builtin_amdgcn_sched_barrier(0);
    lru_scan_dir<1>(F, b, c, h, Ba1, Bx1, R1, I1, EA1, EB1);
    if (next >= 0) lru_prefetch(F, next, tid, xr);
    {
        const int ch = tid & 127, kq = tid >> 7;
        const unsigned long long* ab = (const unsigned long long*)F.AGG() + (size_t)b * 2 * NCHUNK * LW + h * 128 + ch;
        unsigned long long v[16];
#pragma unroll
        for (int i = 0; i < 16; ++i) { const int k = min(16 * kq + i, 62); const int row = k < c ? k : NCHUNK + k + 1;
            v[i] = __hip_atomic_load(ab + (size_t)row * LW, RLX_AGENT); }
        for (unsigned sp = 0; sp < (1u << 16); ++sp) {
            bool bad = false;
#pragma unroll
            for (int i = 0; i < 16; ++i) if (v[i] == 0ull) { const int k = min(16 * kq + i, 62); const int row = k < c ? k : NCHUNK + k + 1;
                v[i] = __hip_atomic_load(ab + (size_t)row * LW, RLX_AGENT); bad = bad || (v[i] == 0ull); }
            if (!bad) break;
            __builtin_amdgcn_s_sleep(2);
        }
        float fa = 1.f, fb = 0.f, ga = 1.f, gb = 0.f;
#pragma unroll
        for (int i = 0; i < 16; ++i) { const int k = 16 * kq + i; const float A = __builtin_bit_cast(float, (unsigned)v[i]), B = __builtin_bit_cast(float, (unsigned)(v[i] >> 32));
            if (k < c) { fb = A * fb + B; fa = A * fa; } }
#pragma unroll
        for (int i = 15; i >= 0; --i) { const int k = 16 * kq + i; const float A = __builtin_bit_cast(float, (unsigned)v[i]), B = __builtin_bit_cast(float, (unsigned)(v[i] >> 32));
            if (k >= c && k < 63) { gb = A * gb + B; ga = A * ga; } }
        *(LAS f32x4*)(F.lds + LRU_PT + (kq * 128 + ch) * 16) = (f32x4){fa, fb, ga, gb};
    }
    __syncthreads();
    if (tid < 256) {
        const int dir = tid >> 7, ch = tid & 127;
        f32x4 q[4];
#pragma unroll
        for (int k = 0; k < 4; ++k) q[k] = *(const LAS f32x4*)(F.lds + LRU_PT + (k * 128 + ch) * 16);
        float st = 0.f;
        if (dir == 0) { st = q[0].y; st = q[1].x * st + q[1].y; st = q[2].x * st + q[2].y; st = q[3].x * st + q[3].y; }
        else { st = q[3].w; st = q[2].z * st + q[2].w; st = q[1].z * st + q[1].w; st = q[0].z * st + q[0].w; }
        *(LAS float*)(F.lds + LRU_CR + tid * 4) = st;
    }
    __syncthreads();
    {
        const int chl = 16 * w + fr;
        const float hin0 = EA0 * *(const LAS float*)(F.lds + LRU_CR + chl * 4) + EB0, hin1 = EA1 * *(const LAS float*)(F.lds + LRU_CR + 512 + chl * 4) + EB1;
#pragma unroll
        for (int m = 0; m < 8; ++m)
#pragma unroll
            for (int j = 0; j < 4; ++j) { const float hs = (R0[m][j] * hin0 + I0[m][j]) + (R1[m][j] * hin1 + I1[m][j]);
                LAS unsigned short* p = (LAS unsigned short*)(GR + (32 * fq + 4 * m + j) * 264 + chl * 2); *p = (unsigned short)f2bf(bf1(*p) * hs); }
        __syncthreads();
        for (int p = tid; p < 128 * 32; p += 512) { const int r = p >> 5, cg = p & 31;
            *(GAS v2u*)(F.MIX() + (t0 + r) * D + h * 128 + cg * 4) = *(const LAS v2u*)(GR + r * 264 + cg * 8); }
    }
    __syncthreads();
}
__device__ __forceinline__ void lru_carry(Frame& F) {
    const int idx = (F.vcu * NWAVES + F.wave) * 64 + F.lane;
    if (idx >= BATCH * 2 * LW) return;
    const int ch = idx & (LW - 1), bd = idx >> 10, dir = bd & 1;
    const f32x2* agg = (const f32x2*)F.AGG() + (size_t)bd * NCHUNK * LW + ch; float* cr = F.CARRY() + (size_t)bd * NCHUNK * LW + ch;
    float st = 0.f;
#pragma unroll 8
    for (int i = 0; i < NCHUNK; ++i) { const int cc = dir == 0 ? i : NCHUNK - 1 - i; const f32x2 pe = agg[(size_t)cc * LW]; cr[(size_t)cc * LW] = st; st = pe.x * st + pe.y; }
}
constexpr int GM_ST = 0, GM_BS = 1024, GM_VN = 2048, GM_GU = 2048 + 32768;
typedef short s16x4 __attribute__((ext_vector_type(4)));
__device__ __forceinline__ unsigned vn_off(unsigned row, unsigned ch) { return 256u * row + 16u * (ch ^ (((row & 3u) << 2) | ((row >> 2) & 3u))); }
struct GmlpRegs { v4u a[4]; v2u gu[8]; bf16x8 Af[4]; f32x4 g0, g1, b0, b1; float bs; };
__device__ __forceinline__ void gmlp_load(Frame& F, size_t t0, int h, int tid, GmlpRegs& G) {
    const int lane = tid & 63, w = tid >> 6, fr = lane & 15, fq = lane >> 4;
#pragma unroll
    for (int i = 0; i < 4; ++i) { const int pid = tid + 512 * i, q = pid >> 4, cg = pid & 15; G.a[i] = *(const GAS v4u*)(F.Z() + (t0 + q) * NIN + 3 * LW + h * 128 + cg * 8); }
#pragma unroll
    for (int i = 0; i < 8; ++i) { const int pid = tid + 512 * i, r = pid >> 5, cg = pid & 31; G.gu[i] = *(const GAS v2u*)(F.Z() + (t0 + r) * NIN + 2 * LW + h * 128 + cg * 4); }
    { const int cg = tid & 15;
      G.g0 = *(const GAS f32x4*)(F.A.in[10] + h * 128 + cg * 8); G.g1 = *(const GAS f32x4*)(F.A.in[10] + h * 128 + cg * 8 + 4);
      G.b0 = *(const GAS f32x4*)(F.A.in[11] + h * 128 + cg * 8); G.b1 = *(const GAS f32x4*)(F.A.in[11] + h * 128 + cg * 8 + 4); }
    G.bs = F.A.in[13][h * 128 + (tid & 127)];
    const bf16* wsb = F.WSB() + (size_t)h * 16384 + (size_t)(16 * w + fr) * 128 + 8 * fq;
#pragma unroll
    for (int ks = 0; ks < 4; ++ks) G.Af[ks] = *(const GAS bf16x8*)(wsb + 32 * ks);
}
__device__ __forceinline__ void gmlp_unit(Frame& F, int unit) {
    int tid = F.tid; asm volatile("" : "+v"(tid));
    const int lane = tid & 63, w = F.wave, fr = lane & 15, fq = lane >> 4;
    const size_t t0 = (size_t)unit * CHUNK;
    LAS float* ST = (LAS float*)(F.lds + GM_ST); LAS float* BS = (LAS float*)(F.lds + GM_BS);
    LAS unsigned char* VN = F.lds + GM_VN; LAS unsigned char* GU = F.lds + GM_GU;
    GmlpRegs G;
    gmlp_load(F, t0, 0, tid, G);
#pragma unroll
    for (int rb = 0; rb < 2; ++rb) {
        v4u ra[8], rc[8];
#pragma unroll
        for (int rr = 0; rr < 8; ++rr) { const bf16* p = F.Z() + (t0 + 16 * w + 8 * rb + rr) * NIN + 3 * LW + lane * 8; ra[rr] = *(const GAS v4u*)p; rc[rr] = *(const GAS v4u*)(p + 512); }
#pragma unroll
        for (int rr = 0; rr < 8; ++rr) {
            const int row = 16 * w + 8 * rb + rr;
            const v4u a = ra[rr], b = rc[rr];
            float x[16] = {bf_lo(a.x), bf_hi(a.x), bf_lo(a.y), bf_hi(a.y), bf_lo(a.z), bf_hi(a.z), bf_lo(a.w), bf_hi(a.w),
                           bf_lo(b.x), bf_hi(b.x), bf_lo(b.y), bf_hi(b.y), bf_lo(b.z), bf_hi(b.z), bf_lo(b.w), bf_hi(b.w)};
            float s = 0.f;
#pragma unroll
            for (int i = 0; i < 16; ++i) s += x[i];
            const float mean = wave_sum(s) * (1.0f / LW);
            float q = 0.f;
#pragma unroll
            for (int i = 0; i < 16; ++i) { const float d = x[i] - mean; q += d * d; }
            const float rstd = __builtin_amdgcn_rsqf(wave_sum(q) * (1.0f / LW) + 1e-6f);
            if (lane == 0) { ST[2 * row] = mean; ST[2 * row + 1] = rstd; }
        }
    }
    __syncthreads();
    const unsigned trq = (unsigned)(lane & 15) >> 2, trp = (unsigned)lane & 3u;
    for (int h = 0; h < 8; ++h) {
#pragma unroll
        for (int i = 0; i < 4; ++i) { const int pid = tid + 512 * i, q = pid >> 4, cg = pid & 15;
            const v4u a = G.a[i];
            const float mean = ST[2 * q], rstd = ST[2 * q + 1];
            const f32x4 g0 = G.g0, g1 = G.g1, b0 = G.b0, b1 = G.b1;
            v4u o;
            o.x = pk2((bf_lo(a.x) - mean) * rstd * g0.x + b0.x, (bf_hi(a.x) - mean) * rstd * g0.y + b0.y);
            o.y = pk2((bf_lo(a.y) - mean) * rstd * g0.z + b0.z, (bf_hi(a.y) - mean) * rstd * g0.w + b0.w);
            o.z = pk2((bf_lo(a.z) - mean) * rstd * g1.x + b1.x, (bf_hi(a.z) - mean) * rstd * g1.y + b1.y);
            o.w = pk2((bf_lo(a.w) - mean) * rstd * g1.z + b1.z, (bf_hi(a.w) - mean) * rstd * g1.w + b1.w);
            *(LAS v4u*)(VN + vn_off((unsigned)q, (unsigned)cg)) = o;
        }
#pragma unroll
        for (int i = 0; i < 8; ++i) { const int pid = tid + 512 * i, r = pid >> 5, cg = pid & 31; *(LAS v2u*)(GU + r * 264 + cg * 8) = G.gu[i]; }
        if (tid < 128) BS[tid] = G.bs;
        bf16x8 Af[4];
#pragma unroll
        for (int ks = 0; ks < 4; ++ks) Af[ks] = G.Af[ks];
        __syncthreads();
        if (h + 1 < 8) gmlp_load(F, t0, h + 1, tid, G);
        f32x4 acc[8];
#pragma unroll
        for (int n = 0; n < 8; ++n) {
            acc[n] = (f32x4){0.f, 0.f, 0.f, 0.f};
#pragma unroll
            for (int ks = 0; ks < 4; ++ks) {
                const s16x4 b0 = __builtin_amdgcn_ds_read_tr16_b64_v4i16((LAS s16x4*)(VN + vn_off(32u * ks + 8u * fq + trq, 2u * n + (trp >> 1)) + 8u * (trp & 1u)));
                const s16x4 b1 = __builtin_amdgcn_ds_read_tr16_b64_v4i16((LAS s16x4*)(VN + vn_off(32u * ks + 8u * fq + 4u + trq, 2u * n + (trp >> 1)) + 8u * (trp & 1u)));
                const bf16x8 bb = (bf16x8){b0[0], b0[1], b0[2], b0[3], b1[0], b1[1], b1[2], b1[3]};
                acc[n] = __builtin_amdgcn_mfma_f32_16x16x32_bf16(Af[ks], bb, acc[n], 0, 0, 0);
            }
        }
#pragma unroll
        for (int n = 0; n < 8; ++n)
#pragma unroll
            for (int j = 0; j < 4; ++j) { const int p = 16 * w + 4 * fq + j; LAS unsigned short* ad = (LAS unsigned short*)(GU + p * 264 + (16 * n + fr) * 2);
                *ad = (unsigned short)f2bf(bf1(*ad) * (acc[n][j] + BS[p])); }
        __syncthreads();
#pragma unroll
        for (int i = 0; i < 8; ++i) { const int pid = tid + 512 * i, r = pid >> 5, cg = pid & 31;
            *(GAS v2u*)(F.MIX() + (t0 + r) * D + LW + h * 128 + cg * 4) = *(const LAS v2u*)(GU + r * 264 + cg * 8); }
        __syncthreads();
    }
}
typedef float f32x16 __attribute__((ext_vector_type(16)));
__device__ __forceinline__ unsigned fkey(float f) { const int u = __builtin_bit_cast(int, f); return (unsigned)(u ^ ((u >> 31) & 0x7fffffff)); }
__device__ __forceinline__ float fkey_inv(unsigned k) { const int u = (int)k; return __builtin_bit_cast(float, u ^ ((u >> 31) & 0x7fffffff)); }
__device__ __forceinline__ unsigned umax_(unsigned a, unsigned b) { return (int)a > (int)b ? a : b; }
__device__ __forceinline__ unsigned umin_(unsigned a, unsigned b) { return (int)a < (int)b ? a : b; }
#define CE_DESC(x, y) do { const unsigned a_ = (x), b_ = (y); (x) = umax_(a_, b_); (y) = umin_(a_, b_); } while (0)
__device__ __forceinline__ void sort16_desc(unsigned (&a)[16]) {
#pragma unroll
    for (int k = 2; k <= 16; k <<= 1)
#pragma unroll
        for (int j = k >> 1; j >= 1; j >>= 1)
#pragma unroll
            for (int i = 0; i < 16; ++i) { const int l = i ^ j; if (l > i) { if ((i & k) == 0) CE_DESC(a[i], a[l]); else CE_DESC(a[l], a[i]); } }
}
__device__ __forceinline__ void merge16_desc(unsigned (&a)[16], const unsigned (&b)[16]) {
#pragma unroll
    for (int i = 0; i < 16; ++i) a[i] = umax_(a[i], b[15 - i]);
#pragma unroll
    for (int j = 8; j >= 1; j >>= 1)
#pragma unroll
        for (int i = 0; i < 16; ++i) if ((i & j) == 0) CE_DESC(a[i], a[i + j]);
}
typedef short bf16x8s __attribute__((ext_vector_type(8)));
__device__ __forceinline__ void topk_unit(Frame& F, int wu) {
    const int tg = wu >> 3, hd = wu & 7, lane = F.lane, r = lane & 31, hh = lane >> 5;
    const int t = tg * 32 + r;
    const size_t qoff = (size_t)t * D + hd * 256 + 8 * hh;
    unsigned L[2][16];
    unsigned hh4 = (unsigned)hh << 2; asm volatile("" : "+v"(hh4));
#pragma unroll
    for (int p = 0; p < 2; ++p) {
        f32x16 acc[4];
#pragma unroll
        for (int nt = 0; nt < 4; ++nt)
#pragma unroll
            for (int i = 0; i < 16; ++i) acc[nt][i] = 0.f;
        const size_t koff = ((size_t)(hd * 2 + p) * 128 + r) * 128 + 8 * hh;
        const bf16* qp = F.QH() + qoff + p * 128; const bf16* kp0 = F.KH() + koff; const bf16* kp1 = kp0 + 32 * 128; const bf16* kp2 = kp0 + 64 * 128; const bf16* kp3 = kp0 + 96 * 128;
        asm volatile("" : "+v"(qp), "+v"(kp0), "+v"(kp1), "+v"(kp2), "+v"(kp3));
#define P6_LOAD(Q, K, ks0, n) _Pragma("unroll") for (int i_ = 0; i_ < (n); ++i_) { Q[i_] = *(const GAS bf16x8s*)(qp + 16 * ((ks0) + i_)); \
            K[i_][0] = *(const GAS bf16x8s*)(kp0 + 16 * ((ks0) + i_)); K[i_][1] = *(const GAS bf16x8s*)(kp1 + 16 * ((ks0) + i_)); \
            K[i_][2] = *(const GAS bf16x8s*)(kp2 + 16 * ((ks0) + i_)); K[i_][3] = *(const GAS bf16x8s*)(kp3 + 16 * ((ks0) + i_)); }
#define P6_MMA(Q, K, n) _Pragma("unroll") for (int i_ = 0; i_ < (n); ++i_) _Pragma("unroll") for (int nt = 0; nt < 4; ++nt) acc[nt] = __builtin_amdgcn_mfma_f32_32x32x16_bf16(K[i_][nt], Q[i_], acc[nt], 0, 0, 0);
        bf16x8s qa[3], ka[3][4], qb[3], kb[3][4];
        P6_LOAD(qa, ka, 0, 3); P6_LOAD(qb, kb, 3, 3);
        __builtin_amdgcn_sched_barrier(0);
        P6_MMA(qa, ka, 3);
        __builtin_amdgcn_sched_barrier(0);
        P6_LOAD(qa, ka, 6, 2);
        __builtin_amdgcn_sched_barrier(0);
        P6_MMA(qb, kb, 3);
        __builtin_amdgcn_sched_barrier(0);
        P6_MMA(qa, ka, 2);
        __builtin_amdgcn_sched_barrier(0);
#undef P6_LOAD
#undef P6_MMA
        unsigned S[4][16];
#pragma unroll
        for (int nt = 0; nt < 4; ++nt) {
#pragma unroll
            for (int rg = 0; rg < 16; ++rg) { const int nc = 32 * nt + (rg & 3) + 8 * (rg >> 2); S[nt][rg] = ((fkey(acc[nt][rg]) & ~0x7Fu) | (unsigned)(127 - nc)) ^ hh4; }
            sort16_desc(S[nt]);
        }
        merge16_desc(S[0], S[1]); merge16_desc(S[2], S[3]); merge16_desc(S[0], S[2]);
        unsigned T[16];
#pragma unroll
        for (int i = 0; i < 16; ++i) T[i] = (unsigned)__shfl_xor((int)S[0][i], 32);
        merge16_desc(S[0], T);
#pragma unroll
        for (int i = 0; i < 16; ++i) L[p][i] = S[0][i];
        __builtin_amdgcn_sched_barrier(0);
    }
    float v0[16], v1[16];
#pragma unroll
    for (int i = 0; i < 16; ++i) { v0[i] = fkey_inv(L[0][i] & ~0x7Fu); v1[i] = fkey_inv(L[1][i] & ~0x7Fu); }
    unsigned C[4][16];
    {
        int cnt = 0;
#pragma unroll
        for (int i = 0; i < 16; ++i)
#pragma unroll
            for (int j = 0; j < 16; ++j) if ((i + 1) * (j + 1) <= 16) { C[cnt >> 4][cnt & 15] = (fkey(v0[i] + v1[j]) & ~0xFFu) | (unsigned)(255 - (i * 16 + j)); ++cnt; }
#pragma unroll
        for (int q = 50; q < 64; ++q) C[q >> 4][q & 15] = 0x80000000u;
    }
    sort16_desc(C[0]); sort16_desc(C[1]); sort16_desc(C[2]); sort16_desc(C[3]);
    merge16_desc(C[0], C[1]); merge16_desc(C[2], C[3]); merge16_desc(C[0], C[2]);
    unsigned best[16];
#pragma unroll
    for (int i = 0; i < 16; ++i) best[i] = C[0][i];
    LAS unsigned* tab = (LAS unsigned*)(F.lds + F.wave * 8192) + lane;
#pragma unroll
    for (int i = 0; i < 16; ++i) { tab[i * 64] = 127u - (L[0][i] & 0x7Fu); tab[(16 + i) * 64] = 127u - (L[1][i] & 0x7Fu); }
    const float smax = fkey_inv(best[0] & ~0xFFu);
    float sv[8]; unsigned idv[8]; float ssum = 0.f;
#pragma unroll
    for (int k = 0; k < 8; ++k) {
        const unsigned bk = hh ? best[8 + k] : best[k];
        const unsigned pos = 255u - (bk & 0xFFu);
        idv[k] = tab[(pos >> 4) * 64] * 128u + tab[(16 + (pos & 15u)) * 64];
        sv[k] = __builtin_amdgcn_exp2f((fkey_inv(bk & ~0xFFu) - smax) * 1.4426950409f); ssum += sv[k];
    }
    ssum += __shfl_xor(ssum, 32);
    const float inv = 1.0f / ssum;
    {
        int* o = F.IDS() + (size_t)t * 128 + hd * 16 + 8 * hh; float* og = F.GATES() + (size_t)t * 128 + hd * 16 + 8 * hh;
        *(GAS v4u*)o = (v4u){idv[0], idv[1], idv[2], idv[3]}; *(GAS v4u*)(o + 4) = (v4u){idv[4], idv[5], idv[6], idv[7]};
        *(GAS f32x4*)og = (f32x4){sv[0] * inv, sv[1] * inv, sv[2] * inv, sv[3] * inv}; *(GAS f32x4*)(og + 4) = (f32x4){sv[4] * inv, sv[5] * inv, sv[6] * inv, sv[7] * inv};
    }
}
__device__ __forceinline__ void h8_row(Frame& F, int t) {
    const int lane = F.lane;
    float hx[32]; float mx = 0.f;
    const bf16* hp = F.HB() + (size_t)t * D + lane * 16;
#pragma unroll
    for (int c = 0; c < 2; ++c)
#pragma unroll
        for (int q = 0; q < 2; ++q) { const v4u a = *(const GAS v4u*)(hp + c * 1024 + q * 8); float* x = hx + c * 16 + q * 8;
            x[0] = bf_lo(a.x); x[1] = bf_hi(a.x); x[2] = bf_lo(a.y); x[3] = bf_hi(a.y); x[4] = bf_lo(a.z); x[5] = bf_hi(a.z); x[6] = bf_lo(a.w); x[7] = bf_hi(a.w); }
#pragma unroll
    for (int i = 0; i < 32; ++i) mx = fmaxf(mx, fabsf(hx[i]));
#pragma unroll
    for (int o = 1; o < 64; o <<= 1) mx = fmaxf(mx, __shfl_xor(mx, o));
    const float sc = mx > 0.f ? 119.0f / mx : 1.0f;
#pragma unroll
    for (int c = 0; c < 2; ++c) {
        unsigned hw[2], lw[2];
#pragma unroll
        for (int g8 = 0; g8 < 2; ++g8) { unsigned hacc = 0u, lacc = 0u;
#pragma unroll
            for (int i = 0; i < 8; ++i) { const int q = (int)__builtin_rintf(hx[c * 16 + g8 * 8 + i] * sc); const int lo = ((q + 8) & 15) - 8, hi = (q - lo) >> 4;
                const int sh = (i & 3) * 8 + (i >> 2) * 4; hacc |= (unsigned)(hi & 15) << sh; lacc |= (unsigned)(lo & 15) << sh; }
            hw[g8] = hacc; lw[g8] = lacc; }
        unsigned char* hb_ = F.H8() + (size_t)t * D + c * 512 + lane * 8;
        *(GAS v2u*)hb_ = (v2u){hw[0], hw[1]}; *(GAS v2u*)(hb_ + 1024) = (v2u){lw[0], lw[1]};
    }
    if (lane == 0) F.HSCALE()[t] = mx > 0.f ? mx * (1.0f / 119.0f) : 1.0f;
}
__device__ __forceinline__ int row_sum16(int v) {
    v += __builtin_amdgcn_update_dpp(0, v, 0x128, 0xf, 0xf, false);
    v += __builtin_amdgcn_update_dpp(0, v, 0x124, 0xf, 0xf, false);
    v += __builtin_amdgcn_update_dpp(0, v, 0x122, 0xf, 0xf, false);
    v += __builtin_amdgcn_update_dpp(0, v, 0x121, 0xf, 0xf, false);
    return v;
}
__device__ __forceinline__ void peer_u_xcd(Frame& F) {
    const int lane = F.lane, x = blockIdx.x & 7, jcu = blockIdx.x >> 3, ncu = ((int)F.G - x + 7) >> 3;
    const int tpc = (M + ncu - 1) / ncu, tpw = (tpc + NWAVES - 1) / NWAVES;
    const int tbase = jcu * tpc + F.wave * tpw;
    int nw = M - tbase; { const int lim = (jcu + 1) * tpc - tbase; nw = nw < lim ? nw : lim; nw = nw < tpw ? nw : tpw; nw = nw < 0 ? 0 : nw; }
    const int NV = nw;
    LAS unsigned char* wl = F.lds + F.wave * 13312;
    LAS int* lst = (LAS int*)wl; LAS int* res = (LAS int*)(wl + 512); LAS unsigned char* hsl = wl + 1024;
    const int q4 = lane >> 4, i16 = lane & 15;
    const unsigned char* ubase = F.U8() + (size_t)x * 2048 * 1024;
    const unsigned lanepart = (unsigned)i16 * 16u;
    int r_idlo = 0, r_idhi = 0, r_t = 0; v4u r_h0 = (v4u){0u, 0u, 0u, 0u}, r_h1 = (v4u){0u, 0u, 0u, 0u};
    int v_cl0 = 0, v_cl1 = 0, v_n = 0, v_r0 = 0, v_t = 0, v_slot = 0; unsigned long long v_mlo = 0, v_mhi = 0; bool v_live = false;
    int vset = 0, nvalid = 0, idle = 0;
    if (NV == 0) return;
#define U_RAW() do { const int vi_ = vset < NV ? vset : NV - 1; r_t = tbase + vi_; \
        r_idlo = F.IDS()[(size_t)r_t * 128 + lane]; r_idhi = F.IDS()[(size_t)r_t * 128 + 64 + lane]; \
        r_h0 = *(const GAS v4u*)(F.H8() + (size_t)r_t * D + lane * 16); r_h1 = *(const GAS v4u*)(F.H8() + (size_t)r_t * D + 1024 + lane * 16); } while (0)
#define U_NEXT() do { if (v_live && v_r0 + 16 < v_n) { v_r0 += 16; } else if (vset < NV) { const bool slo = (r_idlo >> 11) == x, shi = (r_idhi >> 11) == x; \
            v_mlo = __ballot(slo); v_mhi = __ballot(shi); const int nlo = __popcll(v_mlo); v_n = nlo + __popcll(v_mhi); \
            const int plo = __builtin_amdgcn_mbcnt_hi((unsigned)(v_mlo >> 32), __builtin_amdgcn_mbcnt_lo((unsigned)v_mlo, 0)); \
            const int phi = nlo + __builtin_amdgcn_mbcnt_hi((unsigned)(v_mhi >> 32), __builtin_amdgcn_mbcnt_lo((unsigned)v_mhi, 0)); \
            if (slo) lst[plo] = (r_idlo & 2047) | (lane << 16); if (shi) lst[phi] = (r_idhi & 2047) | ((64 + lane) << 16); \
            v_slot = nvalid % 6; ++nvalid; { LAS unsigned char* sp_ = hsl + v_slot * 2048; *(LAS v4u*)(sp_ + lane * 16) = r_h0; *(LAS v4u*)(sp_ + 1024 + lane * 16) = r_h1; } \
            v_cl0 = lst[lane]; v_cl1 = lst[64 + lane]; v_t = r_t; v_r0 = 0; ++vset; v_live = true; } \
        else { v_live = false; v_n = 0; v_r0 = 0; v_mlo = 0; v_mhi = 0; ++idle; } } while (0)
#define U_ISSUE(BUF, DS) do { { const int rem_ = v_n - v_r0; DS##_cnt = rem_ < 0 ? 0 : (rem_ < 16 ? rem_ : 16); } \
        DS##_slot = v_slot; DS##_t = v_t; DS##_mlo = v_mlo; DS##_mhi = v_mhi; DS##_last = v_live && (v_r0 + 16 >= v_n); \
        _Pragma("unroll") for (int gp = 0; gp < 4; ++gp) { const int ix_ = v_r0 + 4 * gp + q4; const int a_ = __shfl(v_cl0, ix_ & 63), b_ = __shfl(v_cl1, ix_ & 63); DS##_ent[gp] = ix_ < 64 ? a_ : b_; \
            const unsigned of_ = (4 * gp + q4 < DS##_cnt ? ((unsigned)(DS##_ent[gp] & 2047) << 10) : 0u) + lanepart; \
            _Pragma("unroll") for (int c = 0; c < 4; ++c) BUF[4 * gp + c] = *(const GAS v4u*)(ubase + of_ + c * 256); } } while (0)
#define U_COMPUTE(BUF, DS) do { const LAS unsigned char* sp_ = hsl + DS##_slot * 2048; const LAS v4u* hp_ = (const LAS v4u*)(sp_ + i16 * 16); \
        _Pragma("unroll") for (int gp = 0; gp < 4; ++gp) if (4 * gp < DS##_cnt) { int ah_ = 0, al_ = 0; \
            _Pragma("unroll") for (int c = 0; c < 4; ++c) { const v4u r_ = BUF[4 * gp + c]; const v4u hh_ = hp_[c * 16], hl_ = hp_[64 + c * 16]; \
                ah_ = __builtin_amdgcn_sdot8((int)r_.x, (int)hh_.x, ah_, false); al_ = __builtin_amdgcn_sdot8((int)r_.x, (int)hl_.x, al_, false); \
                ah_ = __builtin_amdgcn_sdot8((int)r_.y, (int)hh_.y, ah_, false); al_ = __builtin_amdgcn_sdot8((int)r_.y, (int)hl_.y, al_, false); \
                ah_ = __builtin_amdgcn_sdot8((int)r_.z, (int)hh_.z, ah_, false); al_ = __builtin_amdgcn_sdot8((int)r_.z, (int)hl_.z, al_, false); \
                ah_ = __builtin_amdgcn_sdot8((int)r_.w, (int)hh_.w, ah_, false); al_ = __builtin_amdgcn_sdot8((int)r_.w, (int)hl_.w, al_, false); } \
            const int a_ = row_sum16((ah_ << 4) + al_); if (i16 == 0 && 4 * gp + q4 < DS##_cnt) res[DS##_ent[gp] >> 16] = a_; } \
        if (DS##_last) { int* po_ = F.PART() + (size_t)DS##_t * 128; \
            if ((DS##_mlo >> lane) & 1ull) po_[lane] = res[lane]; if ((DS##_mhi >> lane) & 1ull) po_[64 + lane] = res[64 + lane]; } } while (0)
    v4u bufA[16], bufB[16], bufC[16];
    int dA_cnt = 0, dA_ent[4] = {0, 0, 0, 0}, dA_t = 0, dA_slot = 0; unsigned long long dA_mlo = 0, dA_mhi = 0; bool dA_last = false;
    int dB_cnt = 0, dB_ent[4] = {0, 0, 0, 0}, dB_t = 0, dB_slot = 0; unsigned long long dB_mlo = 0, dB_mhi = 0; bool dB_last = false;
    int dC_cnt = 0, dC_ent[4] = {0, 0, 0, 0}, dC_t = 0, dC_slot = 0; unsigned long long dC_mlo = 0, dC_mhi = 0; bool dC_last = false;
    U_RAW();
    U_NEXT(); U_RAW(); U_ISSUE(bufA, dA);
    U_NEXT(); U_RAW(); U_ISSUE(bufB, dB);
    while (idle < 3) {
        U_NEXT(); U_RAW(); U_ISSUE(bufC, dC); U_COMPUTE(bufA, dA);
        U_NEXT(); U_RAW(); U_ISSUE(bufA, dA); U_COMPUTE(bufB, dB);
        U_NEXT(); U_RAW(); U_ISSUE(bufB, dB); U_COMPUTE(bufC, dC);
    }
#undef U_RAW
#undef U_NEXT
#undef U_ISSUE
#undef U_COMPUTE
}
__device__ __forceinline__ void peer_act_token(Frame& F, int t) {
    const int lane = F.lane;
    LAS unsigned char* wl = F.lds + F.wave * 4096;
    LAS float* abuf = (LAS float*)wl; LAS int* ibuf = (LAS int*)(wl + 512); LAS int* cnt = (LAS int*)(wl + 1024);
    LAS int* ovf = (LAS int*)(wl + 1280); LAS int* fre = (LAS int*)(wl + 1792); LAS int* sop = (LAS int*)(wl + 2304);
#define WFENCE() asm volatile("s_waitcnt lgkmcnt(0)" ::: "memory")
    const float sc = __builtin_amdgcn_rsqf(F.ROWSS()[t] * (1.0f / D) + 1e-6f) * F.HSCALE()[t];
    if (lane < 34) cnt[lane] = 0;
    float am = 0.f; float actv[2]; int idv[2], slotv[2];
    const int l32 = t & 31;
#pragma unroll
    for (int half = 0; half < 2; ++half) {
        const size_t o = (size_t)t * 128 + half * 64 + lane;
        const int e = F.IDS()[o]; const float g = F.GATES()[o];
        const int dsum = F.PART()[o];
        actv[half] = gelu_tanh((float)dsum * sc * F.USCALE()[e]) * g * F.VSCALE()[e]; idv[half] = e; am = fmaxf(am, fabsf(actv[half]));
    }
    WFENCE();
#pragma unroll
    for (int half = 0; half < 2; ++half) {
        const int r = idv[half] & 31;
        const int j = __hip_atomic_fetch_add(cnt + r, 1, __ATOMIC_RELAXED, __HIP_MEMORY_SCOPE_WORKGROUP);
        if (j < 4) slotv[half] = ((r - l32) & 31) + 32 * j;
        else { const int q = __hip_atomic_fetch_add(cnt + 32, 1, __ATOMIC_RELAXED, __HIP_MEMORY_SCOPE_WORKGROUP); ovf[q] = half * 64 + lane; slotv[half] = -1; }
    }
    WFENCE();
    if (lane < 32) { const int n = cnt[lane];
        for (int j = n; j < 4; ++j) { const int q = __hip_atomic_fetch_add(cnt + 33, 1, __ATOMIC_RELAXED, __HIP_MEMORY_SCOPE_WORKGROUP); fre[q] = ((lane - l32) & 31) + 32 * j; } }
    WFENCE();
    const int nov = cnt[32];
#pragma unroll
    for (int half = 0; half < 2; ++half) { const int i = half * 64 + lane; if (i < nov) sop[ovf[i]] = fre[i]; }
    WFENCE();
#pragma unroll
    for (int half = 0; half < 2; ++half) { if (slotv[half] < 0) slotv[half] = sop[half * 64 + lane]; abuf[slotv[half]] = actv[half]; ibuf[slotv[half]] = idv[half]; }
    WFENCE();
#pragma unroll
    for (int o = 1; o < 64; o <<= 1) am = fmaxf(am, __shfl_xor(am, o));
    const float asc = am > 0.f ? 127.0f / am : 1.0f;
    if (lane == 0) F.ASCALE()[t] = am > 0.f ? am * (1.0f / 127.0f) : 1.0f;
    if (lane < 32) {
        const f32x4 av = *(const LAS f32x4*)(abuf + 4 * lane); const v4u iv = *(const LAS v4u*)(ibuf + 4 * lane);
        const size_t o = ((size_t)(t >> 6) * 32 + lane) * 64 + (t & 63);
        F.IDW()[o] = (v4u){iv.x << 3, iv.y << 3, iv.z << 3, iv.w << 3};
        F.AW()[o] = pack_i8x4(av.x * asc, av.y * asc, av.z * asc, av.w * asc);
    }
    WFENCE();
#undef WFENCE
}
__device__ __forceinline__ void tr4x4(const unsigned r0, const unsigned r1, const unsigned r2, const unsigned r3, unsigned (&c)[4]) {
    const unsigned t01l = __builtin_amdgcn_perm(r1, r0, 0x05010400u), t01h = __builtin_amdgcn_perm(r1, r0, 0x07030602u);
    const unsigned t23l = __builtin_amdgcn_perm(r3, r2, 0x05010400u), t23h = __builtin_amdgcn_perm(r3, r2, 0x07030602u);
    c[0] = __builtin_amdgcn_perm(t23l, t01l, 0x05040100u); c[1] = __builtin_amdgcn_perm(t23l, t01l, 0x07060302u);
    c[2] = __builtin_amdgcn_perm(t23h, t01h, 0x05040100u); c[3] = __builtin_amdgcn_perm(t23h, t01h, 0x07060302u);
}
template <int MODE>
__device__ __forceinline__ void peer_v_slice(Frame& F, int c, bool do_atomic) {
    const int tid = F.tid, lane = F.lane;
    for (int i = tid; i < NEXP * 8 / 16; i += 512) *(LAS v4u*)(F.lds + i * 16) = *(const GAS v4u*)(F.V8T() + (size_t)c * NEXP * 8 + (size_t)i * 16);
    __syncthreads();
    const v4u* ibase = F.IDW() + lane; const unsigned* abase = F.AW() + lane;
    constexpr int NBLK = M / 64, PD = 16;
    v4u iq[PD]; unsigned aq[PD]; v2u rw[2][4];
    {
        const size_t o = (size_t)F.wave * 32 * 64;
#pragma unroll
        for (int j = 0; j < PD; ++j) { iq[j] = *(const GAS v4u*)(ibase + o + j * 64); aq[j] = abase[o + j * 64]; }
    }
#define LROW(dst, q) do { dst[0] = *(const LAS v2u*)(F.lds + (q).x); dst[1] = *(const LAS v2u*)(F.lds + (q).y); \
                          dst[2] = *(const LAS v2u*)(F.lds + (q).z); dst[3] = *(const LAS v2u*)(F.lds + (q).w); } while (0)
    for (int blk = F.wave; blk < NBLK; blk += NWAVES) {
        const int t = blk * 64 + lane;
        const size_t o = (size_t)blk * 32 * 64;
        const int nblk = (blk + NWAVES < NBLK) ? blk + NWAVES : blk;
        const size_t on = (size_t)nblk * 32 * 64;
        int acc[8];
#pragma unroll
        for (int i = 0; i < 8; ++i) acc[i] = 0;
        LROW(rw[0], iq[0]);
#pragma unroll
        for (int j = 0; j < 32; ++j) {
            if (j + 1 < 32) LROW(rw[(j + 1) & 1], iq[(j + 1) % PD]);
            const unsigned aw = aq[j % PD];
            unsigned cl[4], ch[4];
            tr4x4(rw[j & 1][0].x, rw[j & 1][1].x, rw[j & 1][2].x, rw[j & 1][3].x, cl);
            tr4x4(rw[j & 1][0].y, rw[j & 1][1].y, rw[j & 1][2].y, rw[j & 1][3].y, ch);
#pragma unroll
            for (int i = 0; i < 4; ++i) { acc[i] = __builtin_amdgcn_sdot4((int)aw, (int)cl[i], acc[i], false); acc[4 + i] = __builtin_amdgcn_sdot4((int)aw, (int)ch[i], acc[4 + i], false); }
            { const size_t oo = (j + PD < 32) ? o + (size_t)(j + PD) * 64 : on + (size_t)(j + PD - 32) * 64;
              iq[j % PD] = *(const GAS v4u*)(ibase + oo); aq[j % PD] = abase[oo]; }
            __builtin_amdgcn_sched_barrier(0);
        }
        const float asc = F.ASCALE()[t];
        float accf[8];
#pragma unroll
        for (int i = 0; i < 8; ++i) accf[i] = (float)acc[i] * asc;
        const v4u hb = *(const GAS v4u*)(F.HBT() + ((size_t)c * M + t) * 8);
        accf[0] += bf_lo(hb.x); accf[1] += bf_hi(hb.x); accf[2] += bf_lo(hb.y); accf[3] += bf_hi(hb.y);
        accf[4] += bf_lo(hb.z); accf[5] += bf_hi(hb.z); accf[6] += bf_lo(hb.w); accf[7] += bf_hi(hb.w);
        bf16* yp = (MODE == 0) ? F.Y() + ((size_t)c * M + t) * 8 : (bf16*)F.XN() + ((((size_t)c * M + t) * 8) & (size_t)0x1ffffff);
        *(GAS v4u*)yp = (v4u){pk2(accf[0], accf[1]), pk2(accf[2], accf[3]), pk2(accf[4], accf[5]), pk2(accf[6], accf[7])};
        float ss = 0.f;
#pragma unroll
        for (int i = 0; i < 8; ++i) ss += accf[i] * accf[i];
        if (do_atomic) atomicAdd(F.ROWSS2() + t, ss);
    }
#undef LROW
    __syncthreads();
}
__device__ __forceinline__ void final_unit(Frame& F, int unit) {
    const int tid = F.tid, blk = unit >> 3, cg = unit & 7, t0 = blk * 64;
    LAS float* T = (LAS float*)F.lds;
#pragma unroll
    for (int i = 0; i < 4; ++i) { const int pid = tid + 512 * i, cl = pid >> 6, tok = pid & 63;
        const v4u v = *(const GAS v4u*)(F.Y() + ((size_t)(cg * 32 + cl) * M + t0 + tok) * 8);
        *(LAS f32x4*)(T + tok * 260 + cl * 8) = (f32x4){bf_lo(v.x), bf_hi(v.x), bf_lo(v.y), bf_hi(v.y)};
        *(LAS f32x4*)(T + tok * 260 + cl * 8 + 4) = (f32x4){bf_lo(v.z), bf_hi(v.z), bf_lo(v.w), bf_hi(v.w)}; }
    __syncthreads();
#pragma unroll
    for (int i = 0; i < 8; ++i) { const int pid = tid + 512 * i, tok = pid >> 6, c4 = pid & 63;
        const float rs = __builtin_amdgcn_rsqf(F.ROWSS2()[t0 + tok] * (1.0f / D) + 1e-6f);
        const f32x4 v = *(const LAS f32x4*)(T + tok * 260 + c4 * 4);
        const f32x4 g = *(const GAS f32x4*)(F.A.in[20] + cg * 256 + c4 * 4);
        *(GAS f32x4*)(F.A.out + (size_t)(t0 + tok) * D + cg * 256 + c4 * 4) = v * rs * g; }
    __syncthreads();
}
__global__ void __launch_bounds__(NWAVES * 64, 2) mk_fwd(Args args) {
    __shared__ __attribute__((aligned(16))) unsigned char lds[LDS_BYTES];
    Frame F(args);
    F.lds = (LAS unsigned char*)lds;
    F.MISC = (volatile LAS unsigned*)(F.lds + MISC_OFF);
    F.tid = threadIdx.x; F.lane = F.tid & 63; F.wave = __builtin_amdgcn_readfirstlane(F.tid >> 6);
    F.G = gridDim.x; { const int bx = blockIdx.x; F.vcu = (F.G % 8 == 0) ? (bx % 8) * (F.G / 8) + bx / 8 : bx; }
    F.ws = args.ws;
    F.ctl = (gu32*)(args.ws + WS_CTL);
    for (int u = F.tid; u < (LDS_BYTES - LDSCTL_OFF) / 4; u += NWAVES * 64) ((LAS unsigned*)(F.lds + LDSCTL_OFF))[u] = 0u;
    __syncthreads();
    XcdBarrier bar; bar.bar = (unsigned*)(F.ctl + CW_BAR); bar.x = 0; bar.st = nullptr;
    if (N_LAUNCHES != PER_PHASE) bar = xcd_barrier_post((unsigned*)(F.ctl + CW_BAR), F.MISC + 8);
#define GRID_BAR() do { if (N_LAUNCHES != PER_PHASE) xcd_barrier(bar); } while (0)
    const int lo = args.ph_lo, hi = args.ph_hi;
#ifndef MK_PHASE_MASK
#define MK_PHASE_MASK 0x7FF
#endif
#define IN(k) (((MK_PHASE_MASK >> (k)) & 1) && lo <= (k) && (k) < hi)
#undef MK_PHASE_MASK
#define MK_PHASE_MASK 0xFFFF
#define BOTH(k) (true)
#ifndef MK_REP_MASK
#define MK_REP_MASK 0
#endif
#ifndef MK_REP_N
#define MK_REP_N 2
#endif
#define REPS(k) for (int rep_ = 0; rep_ < ((((MK_REP_MASK) >> (k)) & 1) ? 1 + MK_REP_N : 1); ++rep_)
    const int gw = F.vcu * NWAVES + F.wave, NGW = F.G * NWAVES;
    if (IN(0)) { REPS(0) { p0_prologue(F); __syncthreads(); } if (BOTH(0)) GRID_BAR(); }
    if (IN(1)) {
        pg8::Gemm g{F.XN(), F.WIN(), M, NIN, D}; pg8::StaticOrder S; S.init(M, NIN, F.G, (int)blockIdx.x);
        pg8::EpiZ E{F.Z(), NIN, LW};
        REPS(1) pg8::gemm_phase<pg8::EpiZ, pg8::StaticOrder, true, true>(F.lds, g, S, E);
        if (BOTH(1)) GRID_BAR();
    }
    if (IN(2)) {
        REPS(12) { v4u xr[5]; int u = blockIdx.x; lru_prefetch(F, u, F.tid, xr);
                   for (; u < BATCH * NCHUNK * 8; u += F.G) lru_fused_unit(F, u, u + F.G < BATCH * NCHUNK * 8 ? u + F.G : -1, xr); }
        asm volatile("" : "+v"(F.tid), "+v"(F.lane));
        REPS(13) for (int u = blockIdx.x; u < BATCH * NCHUNK; u += F.G) gmlp_unit(F, u);
        if (BOTH(2)) GRID_BAR();
    }
    if (IN(4)) {
        pg8::Gemm g{F.MIX(), F.WOUT(), M, D, D}; pg8::StaticOrder S; S.init(M, D, F.G, (int)blockIdx.x);
        pg8::EpiH E{F.HB(), F.HBT(), F.A.in[0], F.ROWSS(), D, M};
        pg8::gemm_phase<pg8::EpiH, pg8::StaticOrder, true, true>(F.lds, g, S, E);
        if (BOTH(4)) GRID_BAR();
    }
    if (IN(5)) {
        pg8::Gemm g{F.HB(), F.WQ(), M, D, D}; pg8::StaticOrder S; S.init(M, D, F.G, (int)blockIdx.x);
        pg8::EpiQ E{F.QH(), F.ROWSS(), D};
        REPS(5) pg8::gemm_phase<pg8::EpiQ, pg8::StaticOrder, true, true>(F.lds, g, S, E);
        if (BOTH(5)) GRID_BAR();
    }
    if (IN(6)) {
        REPS(6) { for (int wu = gw; wu < (M / 32) * 8; wu += NGW) topk_unit(F, wu);
                  for (int t = gw; t < M; t += NGW) h8_row(F, t); }
        if (BOTH(6)) GRID_BAR();
    }
    if (IN(7)) {
        REPS(7) peer_u_xcd(F);
        if (BOTH(7)) GRID_BAR();
    }
    if (IN(8)) {
        REPS(8) for (int t = gw; t < M; t += NGW) peer_act_token(F, t);
        if (BOTH(8)) GRID_BAR();
    }
    if (IN(9)) {
        for (int c = blockIdx.x; c < D / 8; c += F.G) peer_v_slice<0>(F, c, true);
        if ((MK_REP_MASK >> 9) & 1) { for (int rep_ = 0; rep_ < MK_REP_N; ++rep_) for (int c = blockIdx.x; c < D / 8; c += F.G) peer_v_slice<1>(F, c, false); }
        if (BOTH(9)) GRID_BAR();
    }
    if (IN(10)) {
        REPS(10) for (int u = blockIdx.x; u < (M / 64) * 8; u += F.G) final_unit(F, u);
    }
#undef IN
#undef BOTH
#undef GRID_BAR
}

extern "C" void kernel_launch(void* const* d_in, const int* in_sizes, int n_in, void* d_out, int out_size, void* d_ws, size_t ws_size, hipStream_t stream) {
    static int grid = 0;
    if (grid == 0) {
        if (n_in != 21 || in_sizes[0] != M * D || out_size != M * D || ws_size < WS_END) { fprintf(stderr, "kernel_launch: unexpected shapes (n_in %d, in0 %d, out %d, ws %zu)\n", n_in, n_in > 0 ? in_sizes[0] : -1, out_size, ws_size); grid = -1; return; }
        int dev = 0, cus = 0, per_cu = 0;
        if (hipGetDevice(&dev) != hipSuccess || hipDeviceGetAttribute(&cus, hipDeviceAttributeMultiprocessorCount, dev) != hipSuccess) { grid = -1; return; }
        if (hipOccupancyMaxActiveBlocksPerMultiprocessor(&per_cu, (const void*)mk_fwd, NWAVES * 64, 0) != hipSuccess || per_cu < 1) { fprintf(stderr, "kernel_launch: occupancy query reports %d blocks per CU\n", per_cu); }
        (void)hipGetLastError();
        grid = cus;
        if (cus < 256) { fprintf(stderr, "kernel_launch: the RG-LRU family hand-off needs >= 256 co-resident workgroups (have %d)\n", cus); grid = -1; return; }
    }
    if (grid < 0) return;
    (void)hipMemsetAsync((char*)d_ws + WS_CTL, 0, CTL_ZERO_BYTES, stream);
    Args a{};
    for (int i = 0; i < 21; ++i) a.in[i] = (const float*)d_in[i];
    a.out = (float*)d_out; a.ws = (unsigned char*)d_ws;
    for (int li = 0; li < N_LAUNCHES; ++li) {
        a.ph_lo = 0; a.ph_hi = 99;
        hipLaunchKernelGGL(mk_fwd, dim3(grid), dim3(NWAVES * 64), 0, stream, a);
    }
}
```

```cpp
#include <hip/hip_runtime.h>
#include <cstdio>
#include <cstdint>
namespace pg8 {
#define PG8_LAS __attribute__((address_space(3)))
typedef unsigned short bf16_t;
typedef short bf16x8 __attribute__((ext_vector_type(8)));
typedef float f32x4 __attribute__((ext_vector_type(4)));
typedef unsigned u32x4 __attribute__((ext_vector_type(4)));
constexpr int BM = 256, BK = 64, HALF = 128, HTB = HALF * BK * 2  , STAGE_BYTES = 8 * HTB, NXCD = 8, WGM = 8;

__host__ __device__ __forceinline__ int lds_byte(int r, int c) { const int st = (r >> 4) * 2 + (c >> 5), rr = r & 15, cc = c & 31, ob = rr * 64 + cc * 2; return st * 1024 + (ob ^ (((ob >> 9) & 1) << 5)); }
__host__ __device__ __forceinline__ void stage_rc(int b, int& R, int& C) { const int st = b / 1024, sb = b % 1024, swz = sb ^ (((sb >> 9) & 1) << 5); R = (st >> 1) * 16 + swz / 64; C = (st & 1) * 32 + (swz % 64) / 2; }
__host__ __device__ __forceinline__ int perm32(int rho) { const int n = rho >> 4, i = rho & 15; return 8 * (i >> 2) + 4 * n + (i & 3); }

struct Unit { int pm, pn; };
struct Gemm { const bf16_t* A; const bf16_t* Bt; int M, N, K; };

struct StaticOrder {
    int nM, nN, nwg, G, c;
    __host__ __device__ void init(int M, int N, int G_, int c_) { nM = M / BM; nN = N / BM; nwg = nM * nN; G = G_; c = c_; }
    __host__ __device__ bool next(int i, Unit& u) const {
        const long L = (long)i * G + c; if (L >= nwg) return false;
        int wgid = (int)L; { const int q = nwg / NXCD, r = nwg % NXCD, xcd = wgid % NXCD, off = wgid / NXCD; wgid = (xcd < r ? xcd * (q + 1) : r * (q + 1) + (xcd - r) * q) + off; }
        const int nig = WGM * nN, gid = wgid / nig, fm = gid * WGM, gsz = (nM - fm) < WGM ? (nM - fm) : WGM;
        u.pm = fm + ((wgid % nig) % gsz); u.pn = (wgid % nig) / gsz; return true;
    }
    __device__ __forceinline__ void a_ready(const Unit&) const {}
    __device__ __forceinline__ void done(const Unit&) const {}
};

__device__ __forceinline__ unsigned cvt_pk_bf16(float lo, float hi) { unsigned r; asm volatile("v_cvt_pk_bf16_f32 %0, %1, %2" : "=v"(r) : "v"(lo), "v"(hi)); return r; }
__device__ __forceinline__ float gelu_tanh(float x) {
    const float t = x * (1.0f + 0.044715f * x * x);
    const float e = __builtin_amdgcn_exp2f(-2.3022081983f * t);
    return x * __builtin_amdgcn_rcpf(1.0f + e);
}
struct EpiZ {
    static constexpr bool PERM = true, AFTER_DRAIN = false;
    bf16_t* O; int ldc; int gelu_from;
    __device__ __forceinline__ void operator()(const f32x4 (&acc)[2][2][4][2], const Unit& u, int wr, int wc, int fr, int fq) const {
        const int row0 = u.pm * BM + wr * 64 + fr; const int col0 = u.pn * BM + wc * 32 + 8 * fq;
        const bool act = (u.pn * BM) >= gelu_from;
#pragma unroll
        for (int ai = 0; ai < 2; ++ai)
#pragma unroll
            for (int m = 0; m < 4; ++m) { bf16_t* rowp = O + (size_t)(row0 + ai * HALF + m * 16) * ldc + col0;
#pragma unroll
                for (int bj = 0; bj < 2; ++bj) { f32x4 v0 = acc[ai][bj][m][0], v1 = acc[ai][bj][m][1];
                    if (act) {
#pragma unroll
                        for (int j = 0; j < 4; ++j) { v0[j] = gelu_tanh(v0[j]); v1[j] = gelu_tanh(v1[j]); } }
                    u32x4 w; w.x = cvt_pk_bf16(v0[0], v0[1]); w.y = cvt_pk_bf16(v0[2], v0[3]); w.z = cvt_pk_bf16(v1[0], v1[1]); w.w = cvt_pk_bf16(v1[2], v1[3]);
                    *(u32x4*)(rowp + bj * HALF) = w; } }
    }
};
struct EpiH {
    static constexpr bool PERM = true, AFTER_DRAIN = false;
    bf16_t* O; bf16_t* OT; const float* X; float* rowss; int ldc; int mrows;
    __device__ __forceinline__ void operator()(const f32x4 (&acc)[2][2][4][2], const Unit& u, int wr, int wc, int fr, int fq) const {
        const int row0 = u.pm * BM + wr * 64 + fr; const int col0 = u.pn * BM + wc * 32 + 8 * fq;
#pragma unroll
        for (int ai = 0; ai < 2; ++ai)
#pragma unroll
            for (int m = 0; m < 4; ++m) { const int row = row0 + ai * HALF + m * 16; const size_t off = (size_t)row * ldc + col0; float ss = 0.f;
#pragma unroll
                for (int bj = 0; bj < 2; ++bj) {
                    const f32x4 x0 = *(const f32x4*)(X + off + bj * HALF), x1 = *(const f32x4*)(X + off + bj * HALF + 4);
                    const f32x4 v0 = acc[ai][bj][m][0] + x0, v1 = acc[ai][bj][m][1] + x1;
                    ss += (v0[0] * v0[0] + v0[1] * v0[1]) + (v0[2] * v0[2] + v0[3] * v0[3]) + (v1[0] * v1[0] + v1[1] * v1[1]) + (v1[2] * v1[2] + v1[3] * v1[3]);
                    u32x4 w; w.x = cvt_pk_bf16(v0[0], v0[1]); w.y = cvt_pk_bf16(v0[2], v0[3]); w.z = cvt_pk_bf16(v1[0], v1[1]); w.w = cvt_pk_bf16(v1[2], v1[3]);
                    *(u32x4*)(O + off + bj * HALF) = w;
                    *(u32x4*)(OT + ((size_t)((col0 + bj * HALF) >> 3) * mrows + row) * 8) = w; }
                ss += __shfl_xor(ss, 16); ss += __shfl_xor(ss, 32);
                if (fq == 0) atomicAdd(rowss + row, ss); }
    }
};
struct EpiQ {
    static constexpr bool PERM = true, AFTER_DRAIN = false;
    bf16_t* QH; const float* rowss; int ldc;
    __device__ __forceinline__ void operator()(const f32x4 (&acc)[2][2][4][2], const Unit& u, int wr, int wc, int fr, int fq) const {
        const int row0 = u.pm * BM + wr * 64 + fr, col0 = u.pn * BM + wc * 32 + 8 * fq;
#pragma unroll
        for (int ai = 0; ai < 2; ++ai)
#pragma unroll
            for (int m = 0; m < 4; ++m) { const int row = row0 + ai * HALF + m * 16; const float rs = __builtin_amdgcn_rsqf(rowss[row] * (1.0f / 2048.0f) + 1e-6f);
                const size_t off = (size_t)row * ldc + col0;
#pragma unroll
                for (int bj = 0; bj < 2; ++bj) { const f32x4 v0 = acc[ai][bj][m][0] * rs, v1 = acc[ai][bj][m][1] * rs;
                    u32x4 wh; wh.x = cvt_pk_bf16(v0[0], v0[1]); wh.y = cvt_pk_bf16(v0[2], v0[3]); wh.z = cvt_pk_bf16(v1[0], v1[1]); wh.w = cvt_pk_bf16(v1[2], v1[3]);
                    *(u32x4*)(QH + off + bj * HALF) = wh; } }
    }
};
template <class Epi, class Sched, bool ALIGN_EPI = false, bool SP2 = false>
__device__ __forceinline__ void gemm_phase(PG8_LAS unsigned char* lds, const Gemm g, const Sched& S, const Epi& E) {
    const int tid = threadIdx.x, wid = __builtin_amdgcn_readfirstlane(tid >> 6), lane = tid & 63, wr = wid >> 2, wc = wid & 3, fr = lane & 15, fq = lane >> 4;
    const int K = g.K, nt = K / BK;
    unsigned voffA[2], voffB[2];
#pragma unroll
    for (int i = 0; i < 2; ++i) { int R, C; stage_rc(tid * 16 + i * 8192, R, C); const int Rb = Epi::PERM ? ((R & ~31) + perm32(R & 31)) : R;
        voffA[i] = (unsigned)(R * K + C) * 2u; voffB[i] = (unsigned)(Rb * K + C) * 2u; }
    const size_t kstep = (size_t)(BK * 2);
    const size_t hstep = (size_t)HALF * K * 2;
    const size_t tstep = 2 * hstep;
    const unsigned ldsw = (unsigned)wid * 1024u;
    const int aoff = lds_byte(wr * 64 + fr, fq * 8), boff = lds_byte(wc * 32 + fr, fq * 8);
#define PG8_SA(b, h) (((b) * 2 + (h)) * HTB)
#define PG8_SB(b, h) ((4 + (b) * 2 + (h)) * HTB)
#define PG8_STAGE(bufoff, gbase, voff) do { _Pragma("unroll") for (int _i = 0; _i < 2; ++_i) \
        __builtin_amdgcn_global_load_lds((const unsigned*)((const char*)(gbase) + (voff)[_i]), (PG8_LAS unsigned*)(lds + (bufoff) + ldsw + _i * 8192), 16, 0, 0); } while (0)
#define PG8_LDA(dst, b, h) do { _Pragma("unroll") for (int m = 0; m < 4; ++m) _Pragma("unroll") for (int k = 0; k < 2; ++k) dst[m][k] = *(const PG8_LAS bf16x8*)(lds + PG8_SA(b, h) + aoff + m * 2048 + k * 1024); } while (0)
#define PG8_LDB(dst, b, h) do { _Pragma("unroll") for (int n = 0; n < 2; ++n) _Pragma("unroll") for (int k = 0; k < 2; ++k) dst[n][k] = *(const PG8_LAS bf16x8*)(lds + PG8_SB(b, h) + boff + n * 2048 + k * 1024); } while (0)
#define PG8_MMA(ai, bj, At, Bt) do { __builtin_amdgcn_s_setprio(1); _Pragma("unroll") for (int m = 0; m < 4; ++m) _Pragma("unroll") for (int n = 0; n < 2; ++n) _Pragma("unroll") for (int k = 0; k < 2; ++k) \
        acc[ai][bj][m][n] = __builtin_amdgcn_mfma_f32_16x16x32_bf16(Bt[n][k], At[m][k], acc[ai][bj][m][n], 0, 0, 0); __builtin_amdgcn_s_setprio(0); } while (0)
#define PG8_WAIT_V(n) asm volatile("s_waitcnt vmcnt(" #n ")" ::: "memory")
#define PG8_WAIT_L(n) asm volatile("s_waitcnt lgkmcnt(" #n ")" ::: "memory")
#define PG8_BAR __builtin_amdgcn_s_barrier()
#define PG8_SCHED __builtin_amdgcn_sched_barrier(0)
    Unit cur, nxt; int ui = 0;
    if (!S.next(0, cur)) return;
    f32x4 acc[2][2][4][2];
#pragma unroll
    for (int a = 0; a < 2; ++a)
#pragma unroll
        for (int b = 0; b < 2; ++b)
#pragma unroll
            for (int m = 0; m < 4; ++m)
#pragma unroll
                for (int n = 0; n < 2; ++n) acc[a][b][m][n] = (f32x4){0.f, 0.f, 0.f, 0.f};
    bf16x8 At[4][2], B0[2][2], B1[2][2];
    const char* cA = (const char*)g.A + (size_t)cur.pm * tstep; const char* cB = (const char*)g.Bt + (size_t)cur.pn * tstep;
    S.a_ready(cur);
    if constexpr (SP2) {
        PG8_STAGE(PG8_SB(0, 0), cB, voffB); PG8_STAGE(PG8_SB(0, 1), cB + hstep, voffB); PG8_STAGE(PG8_SA(0, 0), cA, voffA); PG8_STAGE(PG8_SA(0, 1), cA + hstep, voffA);
        if (wr == 1) PG8_BAR;
        PG8_WAIT_V(2); PG8_BAR;
        PG8_STAGE(PG8_SB(1, 0), cB + kstep, voffB); PG8_STAGE(PG8_SA(1, 0), cA + kstep, voffA); PG8_STAGE(PG8_SB(1, 1), cB + hstep + kstep, voffB);
        PG8_WAIT_V(6); PG8_BAR;
    } else {
        PG8_STAGE(PG8_SB(0, 0), cB, voffB); PG8_STAGE(PG8_SA(0, 0), cA, voffA); PG8_STAGE(PG8_SB(0, 1), cB + hstep, voffB); PG8_STAGE(PG8_SA(0, 1), cA + hstep, voffA);
        if (wr == 1) PG8_BAR;
        PG8_WAIT_V(4); PG8_BAR;
        PG8_STAGE(PG8_SB(1, 0), cB + kstep, voffB); PG8_STAGE(PG8_SA(1, 0), cA + kstep, voffA); PG8_STAGE(PG8_SB(1, 1), cB + hstep + kstep, voffB);
        PG8_WAIT_V(6); PG8_BAR;
    }
    for (;;) {
        const bool has_next = S.next(ui + 1, nxt);
        const char* nA = has_next ? (const char*)g.A + (size_t)nxt.pm * tstep : cA; const char* nB = has_next ? (const char*)g.Bt + (size_t)nxt.pn * tstep : cB;
        for (int t = 0; t < nt; t += 2) {
            const bool last = (t == nt - 2);
            const char* a1 = cA + (size_t)(t + 1) * kstep;
            const char* a2 = last ? nA : cA + (size_t)(t + 2) * kstep; const char* b2 = last ? nB : cB + (size_t)(t + 2) * kstep;
            const char* a3 = a2 + kstep; const char* b3 = b2 + kstep;
            if (last && has_next) S.a_ready(nxt);
            if constexpr (SP2) {
            PG8_LDB(B0, 0, 0); PG8_LDB(B1, 0, 1); PG8_SCHED; PG8_LDA(At, 0, 0); PG8_STAGE(PG8_SA(1, 1), a1 + hstep, voffA);
            PG8_WAIT_V(8); PG8_WAIT_L(0); PG8_BAR; PG8_MMA(0, 0, At, B0); PG8_MMA(0, 1, At, B1); PG8_BAR; PG8_SCHED;
            PG8_LDA(At, 0, 1); PG8_STAGE(PG8_SB(0, 0), b2, voffB); PG8_STAGE(PG8_SB(0, 1), b2 + hstep, voffB); PG8_STAGE(PG8_SA(0, 0), a2, voffA);
            PG8_WAIT_V(8); PG8_WAIT_L(0); PG8_BAR; PG8_MMA(1, 0, At, B0); PG8_MMA(1, 1, At, B1); PG8_BAR; PG8_SCHED;
            PG8_LDB(B0, 1, 0); PG8_LDB(B1, 1, 1); PG8_SCHED; PG8_LDA(At, 1, 0); PG8_STAGE(PG8_SA(0, 1), a2 + hstep, voffA);
            PG8_WAIT_V(8); PG8_WAIT_L(0); PG8_BAR; PG8_MMA(0, 0, At, B0); PG8_MMA(0, 1, At, B1); PG8_BAR; PG8_SCHED;
            PG8_LDA(At, 1, 1); PG8_STAGE(PG8_SB(1, 0), b3, voffB); PG8_STAGE(PG8_SB(1, 1), b3 + hstep, voffB); PG8_STAGE(PG8_SA(1, 0), a3, voffA);
            PG8_WAIT_V(8); PG8_WAIT_L(0); PG8_BAR; PG8_MMA(1, 0, At, B0); PG8_MMA(1, 1, At, B1); PG8_BAR; PG8_SCHED;
            } else {
            PG8_LDB(B0, 0, 0); PG8_SCHED; PG8_LDA(At, 0, 0); PG8_STAGE(PG8_SA(1, 1), a1 + hstep, voffA);
            PG8_WAIT_L(8); PG8_BAR; PG8_WAIT_L(0); PG8_MMA(0, 0, At, B0); PG8_BAR; PG8_SCHED;
            PG8_LDB(B1, 0, 1); PG8_STAGE(PG8_SB(0, 0), b2, voffB);
            PG8_BAR; PG8_WAIT_L(0); PG8_MMA(0, 1, At, B1); PG8_BAR;
            PG8_LDA(At, 0, 1); PG8_STAGE(PG8_SA(0, 0), a2, voffA);
            PG8_BAR; PG8_WAIT_L(0); PG8_MMA(1, 0, At, B0); PG8_BAR; PG8_SCHED;
            PG8_STAGE(PG8_SB(0, 1), b2 + hstep, voffB);
            PG8_WAIT_V(6); PG8_BAR; PG8_MMA(1, 1, At, B1); PG8_BAR;
            PG8_LDB(B0, 1, 0); PG8_SCHED; PG8_LDA(At, 1, 0); PG8_STAGE(PG8_SA(0, 1), a2 + hstep, voffA);
            PG8_WAIT_L(8); PG8_BAR; PG8_WAIT_L(0); PG8_MMA(0, 0, At, B0); PG8_BAR; PG8_SCHED;
            PG8_LDB(B1, 1, 1); PG8_STAGE(PG8_SB(1, 0), b3, voffB);
            PG8_BAR; PG8_WAIT_L(0); PG8_MMA(0, 1, At, B1); PG8_BAR;
            PG8_LDA(At, 1, 1); PG8_STAGE(PG8_SA(1, 0), a3, voffA);
            PG8_BAR; PG8_WAIT_L(0); PG8_MMA(1, 0, At, B0); PG8_BAR; PG8_SCHED;
            PG8_STAGE(PG8_SB(1, 1), b3 + hstep, voffB);
            PG8_WAIT_V(6); PG8_BAR; PG8_MMA(1, 1, At, B1); PG8_BAR;
            }
        }
        if constexpr (ALIGN_EPI) { if (wr == 0) PG8_BAR; }
        if constexpr (!Epi::AFTER_DRAIN) { E(acc, cur, wr, wc, fr, fq); S.done(cur); }
        if (!has_next) break;
#pragma unroll
        for (int a = 0; a < 2; ++a)
#pragma unroll
            for (int b = 0; b < 2; ++b)
#pragma unroll
                for (int m = 0; m < 4; ++m)
#pragma unroll
                    for (int n = 0; n < 2; ++n) acc[a][b][m][n] = (f32x4){0.f, 0.f, 0.f, 0.f};
        cur = nxt; cA = nA; cB = nB; ++ui;
        if constexpr (ALIGN_EPI) { if (wr == 1) PG8_BAR; }
    }
    PG8_WAIT_V(0);
    if constexpr (!ALIGN_EPI) { if (wr == 0) PG8_BAR; }
    PG8_BAR;
    if constexpr (Epi::AFTER_DRAIN) { E.fused(acc, cur, wr, wc, fr, fq, lds, wid, lane); S.done(cur); }
#undef PG8_SA
#undef PG8_SB
#undef PG8_STAGE
#undef PG8_LDA
#undef PG8_LDB
#undef PG8_MMA
#undef PG8_WAIT_V
#undef PG8_WAIT_L
#undef PG8_BAR
#undef PG8_SCHED
}
}
constexpr int NWAVES = 8;
constexpr int BATCH = 4, SEQ = 8192, D = 2048, M = BATCH * SEQ, NIN = 4096, LW = 1024, CHUNK = 128, NCHUNK = SEQ / CHUNK;
constexpr int NEXP = 16384;
#ifndef MK_N_LAUNCHES
#define MK_N_LAUNCHES 1
#endif
constexpr int N_LAUNCHES = MK_N_LAUNCHES;
constexpr int PER_PHASE = 11;
constexpr size_t MiB = 1u << 20;
constexpr size_t WS_CTL = 48 * MiB, CTL_ZERO_BYTES = 5 * MiB;
constexpr size_t WS_ROWSS = WS_CTL + 512 * 1024;
constexpr size_t WS_WIN = 2 * MiB, WS_WOUT = 18 * MiB, WS_WQ = 26 * MiB, WS_LRUW = 34 * MiB, WS_WSB = 35 * MiB, WS_AGG = 49 * MiB;
constexpr size_t WS_U = 64 * MiB, WS_V = 128 * MiB, WS_XN = 192 * MiB  , WS_Z = 320 * MiB  ;
constexpr size_t WS_HB = 576 * MiB, WS_IDS = 704 * MiB, WS_GATES = 720 * MiB, WS_PAIRS = 736 * MiB, WS_HBT = 752 * MiB, WS_END = 884 * MiB;
constexpr size_t WS_USCALE = 40 * MiB, WS_VSCALE = 41 * MiB;
constexpr size_t WS_HSCALE = 44 * MiB, WS_CARRY = 45 * MiB;
constexpr size_t WS_H8 = WS_XN, WS_PART = WS_XN + 64 * MiB;
constexpr size_t WS_ASCALE = 42 * MiB, WS_KH = 43 * MiB;
constexpr size_t WS_IDW = WS_PAIRS, WS_AW = 880 * MiB;
constexpr size_t WS_ROWSS2 = WS_CTL + 640 * 1024;
constexpr size_t WS_Y = WS_Z;
constexpr int CW_BAR = 4096;
constexpr int CW_LRUF = 8192;
constexpr int RING_BYTES = 131072;
constexpr int LDSCTL_OFF = 143360, MISC_OFF = LDSCTL_OFF + 320;
constexpr int LDS_BYTES = 147456;
#define GAS __attribute__((address_space(1)))
#define LAS __attribute__((address_space(3)))
typedef unsigned short bf16;
typedef unsigned v4u __attribute__((ext_vector_type(4)));
typedef float f32x4 __attribute__((ext_vector_type(4)));
typedef short bf16x8 __attribute__((ext_vector_type(8)));
typedef GAS unsigned gu32;
typedef GAS unsigned long long gu64;
#define RLX_AGENT __ATOMIC_RELAXED, __HIP_MEMORY_SCOPE_AGENT
#define LDS_WAIT() asm volatile("s_waitcnt lgkmcnt(0)" ::: "memory")
#define VM_WAIT() asm volatile("s_waitcnt vmcnt(0)" ::: "memory")
__device__ __forceinline__ unsigned long long rt() { return __builtin_amdgcn_s_memrealtime(); }
__device__ __forceinline__ unsigned f2bf(float f) { unsigned u = __builtin_bit_cast(unsigned, f); return (u + 0x7fffu + ((u >> 16) & 1u)) >> 16; }
__device__ __forceinline__ unsigned pk2(float lo, float hi) { return f2bf(lo) | (f2bf(hi) << 16); }

#define XB_TMO      128
#define XB_XCNT(j)  (256  + 64 * (j))
#define XB_XSUB(j)  (1280 + 64 * (j))
#define XB_XGEN(j)  (2304 + 64 * (j))
#define XB_TOP      3328
#define XB_TOPGEN   3392
#define XCD_BAR_WORDS 3456
#define XB_SPIN_CAP (1u << 18)

__device__ __forceinline__ unsigned xb_ld(unsigned* p)              { return __hip_atomic_load(p, __ATOMIC_RELAXED, __HIP_MEMORY_SCOPE_AGENT); }
__device__ __forceinline__ unsigned xb_add(unsigned* p, unsigned v) { return __hip_atomic_fetch_add(p, v, __ATOMIC_RELAXED, __HIP_MEMORY_SCOPE_AGENT); }
__device__ __forceinline__ unsigned xb_xcc_id() { return (unsigned)__builtin_amdgcn_s_getreg((3 << 11) | 20) & 0xFu; }
#define XB_SPIN(cond, bar) do { unsigned _sp = 0; while (cond) { __builtin_amdgcn_s_sleep(1); \
    if ((++_sp & 255u) == 0u) { if (xb_ld(&(bar)[XB_TMO])) break; if (_sp > XB_SPIN_CAP) { atomicAdd(&(bar)[XB_TMO], 1u); break; } } } } while (0)

struct XcdBarrier {
    unsigned* bar; unsigned x;
    volatile LAS unsigned* st;
};

__device__ __forceinline__ XcdBarrier xcd_barrier_post(unsigned* bar, volatile LAS unsigned* st) {
    XcdBarrier b; b.bar = bar; b.x = xb_xcc_id(); b.st = st;
    if (threadIdx.x == 0) (void)xb_add(&bar[XB_XCNT(b.x)], 1u);
    return b;
}
__device__ __forceinline__ void xcd_barrier_complete(unsigned* bar, unsigned x, unsigned& nloc, unsigned& nx) {
    const unsigned G = gridDim.x * gridDim.y * gridDim.z;
    unsigned sum, cnt, mine, sp = 0u;
    for (;;) {
        sum = 0u; cnt = 0u; mine = 0u;
#pragma unroll
        for (unsigned j = 0; j < 16; ++j) { const unsigned c = xb_ld(&bar[XB_XCNT(j)]); sum += c; cnt += (c > 0u) ? 1u : 0u; mine = (j == x) ? c : mine; }
        if (sum == G) break;
        __builtin_amdgcn_s_sleep(1);
        if ((++sp & 255u) == 0u) { if (xb_ld(&bar[XB_TMO])) break; if (sp > XB_SPIN_CAP) { atomicAdd(&bar[XB_TMO], 1u); break; } }
    }
    nloc = mine > 0u ? mine : 1u; nx = cnt > 0u ? cnt : 1u;
}

__device__ __forceinline__ void xcd_barrier(const XcdBarrier& b) {
    asm volatile("s_waitcnt vmcnt(0)" ::: "memory");
    __syncthreads();
    if (threadIdx.x == 0) {
        unsigned* bar = b.bar;
        __builtin_amdgcn_s_waitcnt(0);
        unsigned nloc = b.st[0], nx = b.st[1];
        if (nloc == 0u) { xcd_barrier_complete(bar, b.x, nloc, nx); b.st[0] = nloc; b.st[1] = nx; }
        const unsigned old = xb_add(&bar[XB_XSUB(b.x)], 1u);
        const unsigned gen = old / nloc;
        if (old + 1u == (gen + 1u) * nloc) {
            __builtin_amdgcn_fence(__ATOMIC_RELEASE, "agent");
            asm volatile("s_waitcnt vmcnt(0)" ::: "memory");
            const unsigned og = xb_add(&bar[XB_TOP], 1u);
            const unsigned tg = og / nx;
            if (og + 1u == (tg + 1u) * nx) xb_add(&bar[XB_TOPGEN], 1u);
            else XB_SPIN(xb_ld(&bar[XB_TOPGEN]) == tg, bar);
            __builtin_amdgcn_fence(__ATOMIC_ACQUIRE, "agent");
            xb_add(&bar[XB_XGEN(b.x)], 1u);
            asm volatile("s_waitcnt vmcnt(0)" ::: "memory");
        } else {
            XB_SPIN(xb_ld(&bar[XB_XGEN(b.x)]) == gen, bar);
            __builtin_amdgcn_fence(__ATOMIC_ACQUIRE, "agent");
            asm volatile("s_waitcnt vmcnt(0)" ::: "memory");
        }
    }
    __syncthreads();
}
typedef unsigned v2u __attribute__((ext_vector_type(2)));
typedef float f32x2 __attribute__((ext_vector_type(2)));
struct Args { const float* in[21]; float* out; unsigned char* ws; int ph_lo, ph_hi; };
struct Frame {
    const Args& A;
    LAS unsigned char* lds;
    volatile LAS unsigned* MISC;
    gu32* ctl;
    unsigned char* ws;
    int tid, lane, wave, vcu, G;
    __device__ __forceinline__ Frame(const Args& a) : A(a) {}
#define WSP(name, type, off) __device__ __forceinline__ type* name() const { return (type*)(ws + (off)); }
    WSP(WIN, bf16, WS_WIN) WSP(WOUT, bf16, WS_WOUT) WSP(WQ, bf16, WS_WQ) WSP(LRUW, bf16, WS_LRUW) WSP(WSB, bf16, WS_WSB)
    WSP(XN, bf16, WS_XN) WSP(MIX, bf16, WS_XN) WSP(Z, bf16, WS_Z) WSP(HB, bf16, WS_HB) WSP(HBT, bf16, WS_HBT)
    WSP(U8, unsigned char, WS_U) WSP(V8T, unsigned char, WS_V)
    WSP(ROWSS, float, WS_ROWSS) WSP(ROWSS2, float, WS_ROWSS2) WSP(QH, bf16, WS_Z) WSP(QL, bf16, WS_Z + 128 * MiB) WSP(KH, bf16, WS_KH) WSP(KL, bf16, WS_KH + 512 * 1024) WSP(AGG, float, WS_AGG) WSP(CARRY, float, WS_CARRY) WSP(AU, unsigned, WS_HB) WSP(GATES, float, WS_GATES)
    WSP(USCALE, float, WS_USCALE) WSP(VSCALE, float, WS_VSCALE) WSP(Y, bf16, WS_Y) WSP(IDS, int, WS_IDS) WSP(ASCALE, float, WS_ASCALE) WSP(IDW, v4u, WS_IDW) WSP(AW, unsigned, WS_AW) WSP(H8, unsigned char, WS_H8) WSP(HSCALE, float, WS_HSCALE) WSP(PART, int, WS_PART)
#undef WSP
};
__device__ __forceinline__ float wave_sum(float v) {
#pragma unroll
    for (int o = 1; o < 64; o <<= 1) v += __shfl_xor(v, o);
    return v;
}
__device__ __forceinline__ float bf_lo(unsigned w) { return __builtin_bit_cast(float, w << 16); }
__device__ __forceinline__ float bf_hi(unsigned w) { return __builtin_bit_cast(float, w & 0xffff0000u); }
__device__ __forceinline__ float bf1(unsigned short h) { return __builtin_bit_cast(float, (unsigned)h << 16); }
__device__ __forceinline__ float sigmoidf_(float x) { return __builtin_amdgcn_rcpf(1.0f + __builtin_amdgcn_exp2f(-1.4426950409f * x)); }
using pg8::gelu_tanh;
__device__ __forceinline__ unsigned pack_i8x4(float a, float b, float c, float d) {
    const int ia = (int)__builtin_rintf(a), ib = (int)__builtin_rintf(b), ic = (int)__builtin_rintf(c), id = (int)__builtin_rintf(d);
    return (unsigned)(ia & 0xff) | ((unsigned)(ib & 0xff) << 8) | ((unsigned)(ic & 0xff) << 16) | ((unsigned)id << 24);
}

__device__ __forceinline__ void p0_transpose_item(const float* W, int K, int N, bf16* WT, const float* kscale, LAS float* scr, int item, int lane) {
    const int nblk = N / 32, kb = item / nblk, nb = item % nblk, k0 = 64 * kb, n0 = 32 * nb;
#pragma unroll 8
    for (int i = 0; i < 32; ++i) { const int kk = 2 * i + (lane >> 5); const float sc = kscale ? kscale[k0 + kk] : 1.0f; scr[kk * 33 + (lane & 31)] = W[(size_t)(k0 + kk) * N + n0 + (lane & 31)] * sc; }
    LDS_WAIT(); asm volatile("" ::: "memory");
    const int c = lane & 7;
#pragma unroll
    for (int j = 0; j < 4; ++j) { const int n = (lane >> 3) + 8 * j; const LAS float* s = scr + (8 * c) * 33 + n;
        v4u o; o.x = pk2(s[0 * 33], s[1 * 33]); o.y = pk2(s[2 * 33], s[3 * 33]); o.z = pk2(s[4 * 33], s[5 * 33]); o.w = pk2(s[6 * 33], s[7 * 33]);
        *(GAS v4u*)(WT + (size_t)(n0 + n) * K + k0 + 8 * c) = o; }
    LDS_WAIT(); asm volatile("" ::: "memory");
}
__device__ __forceinline__ void p0_prologue(Frame& F) {
    LAS float* scr = (LAS float*)(F.lds + F.wave * 16384);
    const int gw = F.vcu * NWAVES + F.wave, NGW = F.G * NWAVES, lane = F.lane;
    constexpr int I_IN = (D / 64) * (NIN / 32), I_OUT = (D / 64) * (D / 32), I_Q = I_OUT, I_LRU = 32 * 8;
    constexpr int NITEMS = I_IN + I_OUT + I_Q + I_LRU;
    for (int it = gw; it < NITEMS; it += NGW) {
        int r = it;
        if (r < I_IN) { p0_transpose_item(F.A.in[2], D, NIN, F.WIN(), F.A.in[1], scr, r, lane); continue; } r -= I_IN;
        if (r < I_OUT) { p0_transpose_item(F.A.in[14], D, D, F.WOUT(), nullptr, scr, r, lane); continue; } r -= I_OUT;
        if (r < I_Q) { p0_transpose_item(F.A.in[16], D, D, F.WQ(), F.A.in[15], scr, r, lane); continue; } r -= I_Q;
        { const int mi = r >> 3, sub = r & 7, gate = mi >> 4, rest = mi & 15;
          const float* src = (gate ? F.A.in[7] : F.A.in[5]) + (size_t)rest * 16384;
          p0_transpose_item(src, 128, 128, F.LRUW() + (size_t)mi * 16384, nullptr, scr, sub, lane); }
    }
    const size_t gt = (size_t)gw * 64 + lane, NGT = (size_t)NGW * 64;
    {
        const float* g2 = F.A.in[15];
        f32x4 gg[8];
#pragma unroll
        for (int j = 0; j < 8; ++j) gg[j] = *(const GAS f32x4*)(g2 + j * 256 + lane * 4);
        for (int e = gw; e < NEXP; e += NGW) {
            const GAS f32x4* ur = (const GAS f32x4*)(F.A.in[18] + (size_t)e * D) + lane;
            f32x4 v[8]; float ss = 0.f;
#pragma unroll
            for (int j = 0; j < 8; ++j) { v[j] = __builtin_nontemporal_load(ur + 64 * j) * gg[j]; ss += (v[j].x * v[j].x + v[j].y * v[j].y) + (v[j].z * v[j].z + v[j].w * v[j].w); }
            const float rms = __builtin_amdgcn_sqrtf(wave_sum(ss) * (1.0f / D));
            const float sc = rms > 0.f ? 7.0f / (2.8f * rms) : 1.0f;
            GAS unsigned* o4 = (GAS unsigned*)(F.U8() + (size_t)e * 1024) + (lane >> 1);
#pragma unroll
            for (int j = 0; j < 8; ++j) {
                const int c0 = (int)fminf(fmaxf(__builtin_rintf(v[j].x * sc), -7.f), 7.f) & 15, c1 = (int)fminf(fmaxf(__builtin_rintf(v[j].y * sc), -7.f), 7.f) & 15;
                const int c2 = (int)fminf(fmaxf(__builtin_rintf(v[j].z * sc), -7.f), 7.f) & 15, c3 = (int)fminf(fmaxf(__builtin_rintf(v[j].w * sc), -7.f), 7.f) & 15;
                const unsigned cw = (unsigned)c0 | ((unsigned)c1 << 8) | ((unsigned)c2 << 16) | ((unsigned)c3 << 24);
                const unsigned pw = (unsigned)__shfl_xor((int)cw, 1);
                if ((lane & 1) == 0) __builtin_nontemporal_store(cw | (pw << 4), o4 + 32 * j);
            }
            if (lane == 0) F.USCALE()[e] = rms > 0.f ? 2.8f * rms * (1.0f / 7.0f) : 1.0f;
        }
    }
    __syncthreads();
    for (int un = blockIdx.x; un < NEXP / 64; un += F.G) {
        const int e0 = un * 64;
        for (int rr = 0; rr < 8; ++rr) {
            const int el = F.wave * 8 + rr, e = e0 + el;
            const GAS f32x4* vr = (const GAS f32x4*)(F.A.in[19] + (size_t)e * D) + lane;
            f32x4 v[8]; float mx = 0.f;
#pragma unroll
            for (int j = 0; j < 8; ++j) { v[j] = __builtin_nontemporal_load(vr + 64 * j); mx = fmaxf(mx, fmaxf(fmaxf(fabsf(v[j].x), fabsf(v[j].y)), fmaxf(fabsf(v[j].z), fabsf(v[j].w)))); }
#pragma unroll
            for (int o = 1; o < 64; o <<= 1) mx = fmaxf(mx, __shfl_xor(mx, o));
            const float sc = mx > 0.f ? 127.0f / mx : 1.0f;
#pragma unroll
            for (int j = 0; j < 8; ++j) *(LAS unsigned*)(F.lds + el * 2056 + j * 256 + lane * 4) = pack_i8x4(v[j].x * sc, v[j].y * sc, v[j].z * sc, v[j].w * sc);
            if (lane == 0) F.VSCALE()[e] = mx > 0.f ? mx * (1.0f / 127.0f) : 1.0f;
        }
        __syncthreads();
        for (int cc = 0; cc < 32; ++cc) { const int c = F.wave * 32 + cc;
            const v2u w = *(const LAS v2u*)(F.lds + lane * 2056 + c * 8);
            __builtin_nontemporal_store(w, (v2u*)(F.V8T() + ((size_t)c * NEXP + e0 + lane) * 8)); }
        __syncthreads();
    }
    for (size_t ch = gt; ch < (size_t)8 * 128 * 128 / 8; ch += NGT) {
        const size_t e0 = ch * 8;
        const f32x4 a = *(const GAS f32x4*)(F.A.in[12] + e0), b = *(const GAS f32x4*)(F.A.in[12] + e0 + 4);
        v4u o; o.x = pk2(a.x, a.y); o.y = pk2(a.z, a.w); o.z = pk2(b.x, b.y); o.w = pk2(b.z, b.w);
        *(GAS v4u*)(F.WSB() + e0) = o;
    }
    for (size_t ch = gt; ch < (size_t)16 * 128 * 128 / 8; ch += NGT) {
        const size_t e0 = ch * 8;
        const f32x4 a = *(const GAS f32x4*)(F.A.in[17] + e0), b = *(const GAS f32x4*)(F.A.in[17] + e0 + 4);
        v4u hi; hi.x = pk2(a.x, a.y); hi.y = pk2(a.z, a.w); hi.z = pk2(b.x, b.y); hi.w = pk2(b.z, b.w);
        *(GAS v4u*)(F.KH() + e0) = hi;
    }
    for (int m = gw; m < M; m += NGW) {
        const GAS f32x4* xr = (const GAS f32x4*)(F.A.in[0] + (size_t)m * D) + lane;
        f32x4 v[8]; float s = 0.f;
#pragma unroll
        for (int j = 0; j < 8; ++j) { v[j] = __builtin_nontemporal_load(xr + 64 * j); s += (v[j].x * v[j].x + v[j].y * v[j].y) + (v[j].z * v[j].z + v[j].w * v[j].w); }
        const float rstd = __builtin_amdgcn_rsqf(wave_sum(s) * (1.f / D) + 1e-6f);
        GAS unsigned long long* o8 = (GAS unsigned long long*)(F.XN() + (size_t)m * D) + lane;
#pragma unroll
        for (int j = 0; j < 8; ++j) o8[64 * j] = (unsigned long long)pk2(v[j].x * rstd, v[j].y * rstd) | ((unsigned long long)pk2(v[j].z * rstd, v[j].w * rstd) << 32);
    }
}
constexpr int LRU_XR = 0, LRU_XC = 33792, LRU_GR = 33792 + 40960;
constexpr float LOG2E = 1.4426950408889634f;
__device__ __forceinline__ int xc_off(int tok, int ch) { return tok * 320 + (tok >> 5) * 16 + ch * 2; }
template <bool APPLY, int DIR>
__device__ __forceinline__ void lru_dir(Frame& F, int unit, int b, int c, int h, const bf16x8 (&Ba)[4], const bf16x8 (&Bx)[4], float (&hsum)[8][4]) {
    const int lane = F.lane, w = F.wave, fr = lane & 15, fq = lane >> 4;
    LAS unsigned char* XC = F.lds + LRU_XC;
    const int chl = 16 * w + fr, chg = h * 128 + chl;
    v4u* au = (v4u*)F.AU() + ((size_t)((unit * 2 + DIR) * NWAVES + w) * 8) * 64 + lane;
    f32x4 R[8], I[8];
    float carry = 0.f;
    if (APPLY) {
        carry = F.CARRY()[(size_t)((b * 2 + DIR) * NCHUNK + c) * LW + chg];
        v4u q[8];
#pragma unroll
        for (int m = 0; m < 8; ++m) q[m] = __builtin_nontemporal_load(au + m * 64);
#pragma unroll
        for (int m = 0; m < 8; ++m) {
            R[m] = (f32x4){__builtin_amdgcn_exp2f(bf_lo(q[m].x)), __builtin_amdgcn_exp2f(bf_lo(q[m].y)), __builtin_amdgcn_exp2f(bf_lo(q[m].z)), __builtin_amdgcn_exp2f(bf_lo(q[m].w))};
            I[m] = (f32x4){bf_hi(q[m].x), bf_hi(q[m].y), bf_hi(q[m].z), bf_hi(q[m].w)}; }
    } else {
        const float ba = F.A.in[6][DIR * LW + chg], bx = F.A.in[8][DIR * LW + chg], lam = F.A.in[9][DIR * LW + chg];
        const float cl = -8.0f * log1pf(__expf(-lam)) * LOG2E;
        const int arow = (fr >> 2) * 32 + (fr & 3);
#pragma unroll
        for (int m = 0; m < 8; ++m) {
            R[m] = (f32x4){0.f, 0.f, 0.f, 0.f}; I[m] = (f32x4){0.f, 0.f, 0.f, 0.f};
#pragma unroll
            for (int ks = 0; ks < 4; ++ks) {
                const bf16x8 a = *(const LAS bf16x8*)(XC + xc_off(arow + 4 * m, 32 * ks + 8 * fq));
                R[m] = __builtin_amdgcn_mfma_f32_16x16x32_bf16(a, Ba[ks], R[m], 0, 0, 0);
                I[m] = __builtin_amdgcn_mfma_f32_16x16x32_bf16(a, Bx[ks], I[m], 0, 0, 0);
            }
        }
#pragma unroll
        for (int m = 0; m < 8; ++m) {
            float la[4];
#pragma unroll
            for (int j = 0; j < 4; ++j) {
                const float r = sigmoidf_(R[m][j] + ba), ig = sigmoidf_(I[m][j] + bx);
                la[j] = cl * r;
                const float a = __builtin_amdgcn_exp2f(la[j]);
                const float xc = bf1(*(const LAS unsigned short*)(XC + xc_off(32 * fq + 4 * m + j, chl)));
                R[m][j] = a; I[m][j] = __builtin_amdgcn_sqrtf(fmaxf(1.0f - a * a, 0.0f)) * (ig * xc);
            }
            __builtin_nontemporal_store((v4u){pk2(la[0], I[m][0]), pk2(la[1], I[m][1]), pk2(la[2], I[m][2]), pk2(la[3], I[m][3])}, au + m * 64);
        }
    }
    float P = 1.f, L = 0.f;
#pragma unroll
    for (int mm = 0; mm < 8; ++mm) {
        const int m = DIR == 0 ? mm : 7 - mm;
#pragma unroll
        for (int jj = 0; jj < 4; ++jj) {
            const int j = DIR == 0 ? jj : 3 - jj;
            const float a = R[m][j], u = I[m][j];
            L = a * L + u; P = a * P;
            R[m][j] = P; I[m][j] = L;
        }
    }
    const int src1 = DIR == 0 ? lane - 16 : lane + 16, src2 = DIR == 0 ? lane - 32 : lane + 32;
    const bool v1 = DIR == 0 ? (fq >= 1) : (fq <= 2), v2 = DIR == 0 ? (fq >= 2) : (fq <= 1);
    float A = P, B = L;
    { const float pa = __shfl(A, src1), pb = __shfl(B, src1); if (v1) { B = A * pb + B; A = A * pa; } }
    { const float pa = __shfl(A, src2), pb = __shfl(B, src2); if (v2) { B = A * pb + B; A = A * pa; } }
    if (APPLY) {
        float EA = __shfl(A, src1), EB = __shfl(B, src1); if (!v1) { EA = 1.f; EB = 0.f; }
        const float hin = EA * carry + EB;
#pragma unroll
        for (int m = 0; m < 8; ++m)
#pragma unroll
            for (int j = 0; j < 4; ++j) { const float hh = R[m][j] * hin + I[m][j]; if (DIR == 0) hsum[m][j] = hh; else hsum[m][j] += hh; }
    } else {
        const bool lastlane = DIR == 0 ? (fq == 3) : (fq == 0);
        if (lastlane) { f32x2* agg = (f32x2*)F.AGG() + (size_t)((b * 2 + DIR) * NCHUNK + c) * LW + chg; *agg = (f32x2){A, B}; }
    }
}

template <bool APPLY>
__device__ __forceinline__ void lru_unit(Frame& F, int unit) {
    const int h = unit & 7, c = (unit >> 3) & 63, b = unit >> 9;
    const int tid = F.tid, lane = F.lane, w = F.wave, fr = lane & 15, fq = lane >> 4;
    const size_t t0 = (size_t)b * SEQ + (size_t)c * CHUNK;
    LAS unsigned char* XR = F.lds + LRU_XR; LAS unsigned char* XC = F.lds + LRU_XC; LAS unsigned char* GR = F.lds + LRU_GR;
    bf16x8 Ba0[4], Bx0[4], Ba1[4], Bx1[4];
    if (!APPLY) {
        const bf16* wb = F.LRUW() + (size_t)h * 16384 + (size_t)(16 * w + fr) * 128 + 8 * fq;
#pragma unroll
        for (int ks = 0; ks < 4; ++ks) { Ba0[ks] = *(const GAS bf16x8*)(wb + 32 * ks); Ba1[ks] = *(const GAS bf16x8*)(wb + (size_t)8 * 16384 + 32 * ks);
            Bx0[ks] = *(const GAS bf16x8*)(wb + (size_t)16 * 16384 + 32 * ks); Bx1[ks] = *(const GAS bf16x8*)(wb + (size_t)24 * 16384 + 32 * ks); }
        for (int p = tid; p < 131 * 16; p += 512) { const int r = p >> 4, cg = p & 15; const int s = c * CHUNK - 2 + r; v4u v = (v4u){0u, 0u, 0u, 0u};
            if (s >= 0 && s < SEQ) v = *(const GAS v4u*)(F.Z() + ((size_t)b * SEQ + s) * NIN + h * 128 + cg * 8);
            *(LAS v4u*)(XR + r * 256 + cg * 16) = v; }
        __syncthreads();
        {
            const int ch2 = tid & 63, tg = tid >> 6, chg = h * 128 + 2 * ch2;
            float w0[4], w1[4];
#pragma unroll
            for (int k = 0; k < 4; ++k) { w0[k] = F.A.in[3][k * LW + chg]; w1[k] = F.A.in[3][k * LW + chg + 1]; }
            const float b0 = F.A.in[4][chg], b1 = F.A.in[4][chg + 1];
            float x0[4], x1[4];
#pragma unroll
            for (int k = 0; k < 3; ++k) { const unsigned u = *(const LAS unsigned*)(XR + (16 * tg + k) * 256 + ch2 * 4); x0[k] = bf_lo(u); x1[k] = bf_hi(u); }
#pragma unroll
            for (int j = 0; j < 16; ++j) {
                const unsigned u = *(const LAS unsigned*)(XR + (16 * tg + j + 3) * 256 + ch2 * 4); x0[3] = bf_lo(u); x1[3] = bf_hi(u);
                const float y0 = b0 + ((w0[0] * x0[0] + w0[1] * x0[1]) + (w0[2] * x0[2] + w0[3] * x0[3]));
                const float y1 = b1 + ((w1[0] * x1[0] + w1[1] * x1[1]) + (w1[2] * x1[2] + w1[3] * x1[3]));
                *(LAS unsigned*)(XC + xc_off(16 * tg + j, 2 * ch2)) = pk2(y0, y1);
                x0[0] = x0[1]; x0[1] = x0[2]; x0[2] = x0[3]; x1[0] = x1[1]; x1[1] = x1[2]; x1[2] = x1[3];
            }
        }
        __syncthreads();
    } else {
#pragma unroll
        for (int ks = 0; ks < 4; ++ks) { Ba0[ks] = Ba1[ks] = Bx0[ks] = Bx1[ks] = (bf16x8){0, 0, 0, 0, 0, 0, 0, 0}; }
        for (int p = tid; p < 128 * 32; p += 512) { const int r = p >> 5, cg = p & 31;
            *(LAS v2u*)(GR + r * 264 + cg * 8) = *(const GAS v2u*)(F.Z() + (t0 + r) * NIN + LW + h * 128 + cg * 4); }
    }
    float hsum[8][4];
    lru_dir<APPLY, 0>(F, unit, b, c, h, Ba0, Bx0, hsum);
    asm volatile("" ::: "memory"); __builtin_amdgcn_sched_barrier(0);
    lru_dir<APPLY, 1>(F, unit, b, c, h, Ba1, Bx1, hsum);
    if (APPLY) {
        const int chl = 16 * w + fr;
        __syncthreads();
#pragma unroll
        for (int m = 0; m < 8; ++m)
#pragma unroll
            for (int j = 0; j < 4; ++j) { LAS unsigned short* p = (LAS unsigned short*)(GR + (32 * fq + 4 * m + j) * 264 + chl * 2); *p = (unsigned short)f2bf(bf1(*p) * hsum[m][j]); }
        __syncthreads();
        for (int p = tid; p < 128 * 32; p += 512) { const int r = p >> 5, cg = p & 31;
            *(GAS v2u*)(F.MIX() + (t0 + r) * D + h * 128 + cg * 4) = *(const LAS v2u*)(GR + r * 264 + cg * 8); }
    }
    __syncthreads();
}

constexpr int LRU_PT = LRU_XR, LRU_CR = LRU_XR + 8192;
template <int DIR>
__device__ __forceinline__ void lru_scan_dir(Frame& F, int b, int c, int h, const bf16x8 (&Ba)[4], const bf16x8 (&Bx)[4], f32x4 (&R)[8], f32x4 (&I)[8], float& EA, float& EB) {
    const int lane = F.lane, w = F.wave, fr = lane & 15, fq = lane >> 4;
    LAS unsigned char* XC = F.lds + LRU_XC;
    const int chl = 16 * w + fr, chg = h * 128 + chl;
    {
        const float ba = F.A.in[6][DIR * LW + chg], bx = F.A.in[8][DIR * LW + chg], lam = F.A.in[9][DIR * LW + chg];
        const float cl = -8.0f * log1pf(__expf(-lam)) * LOG2E;
        const int arow = (fr >> 2) * 32 + (fr & 3);
#pragma unroll
        for (int m = 0; m < 8; ++m) {
            R[m] = (f32x4){0.f, 0.f, 0.f, 0.f}; I[m] = (f32x4){0.f, 0.f, 0.f, 0.f};
#pragma unroll
            for (int ks = 0; ks < 4; ++ks) {
                const bf16x8 a = *(const LAS bf16x8*)(XC + xc_off(arow + 4 * m, 32 * ks + 8 * fq));
                R[m] = __builtin_amdgcn_mfma_f32_16x16x32_bf16(a, Ba[ks], R[m], 0, 0, 0);
                I[m] = __builtin_amdgcn_mfma_f32_16x16x32_bf16(a, Bx[ks], I[m], 0, 0, 0);
            }
        }
#pragma unroll
        for (int m = 0; m < 8; ++m) {
#pragma unroll
            for (int j = 0; j < 4; ++j) {
                const float r = sigmoidf_(R[m][j] + ba), ig = sigmoidf_(I[m][j] + bx);
                const float a = __builtin_amdgcn_exp2f(cl * r);
                const float xc = bf1(*(const LAS unsigned short*)(XC + xc_off(32 * fq + 4 * m + j, chl)));
                R[m][j] = a; I[m][j] = __builtin_amdgcn_sqrtf(fmaxf(1.0f - a * a, 0.0f)) * (ig * xc);
            }
        }
    }
    float P = 1.f, L = 0.f;
#pragma unroll
    for (int mm = 0; mm < 8; ++mm) {
        const int m = DIR == 0 ? mm : 7 - mm;
#pragma unroll
        for (int jj = 0; jj < 4; ++jj) {
            const int j = DIR == 0 ? jj : 3 - jj;
            const float a = R[m][j], u = I[m][j];
            L = a * L + u; P = a * P;
            R[m][j] = P; I[m][j] = L;
        }
    }
    const int src1 = DIR == 0 ? lane - 16 : lane + 16, src2 = DIR == 0 ? lane - 32 : lane + 32;
    const bool v1 = DIR == 0 ? (fq >= 1) : (fq <= 2), v2 = DIR == 0 ? (fq >= 2) : (fq <= 1);
    float A = P, B = L;
    { const float pa = __shfl(A, src1), pb = __shfl(B, src1); if (v1) { B = A * pb + B; A = A * pa; } }
    { const float pa = __shfl(A, src2), pb = __shfl(B, src2); if (v2) { B = A * pb + B; A = A * pa; } }
    EA = __shfl(A, src1); EB = __shfl(B, src1); if (!v1) { EA = 1.f; EB = 0.f; }
    const bool lastlane = DIR == 0 ? (fq == 3) : (fq == 0);
    if (lastlane) {
        const unsigned long long word = (unsigned long long)(__builtin_bit_cast(unsigned, A) | 1u) | ((unsigned long long)__builtin_bit_cast(unsigned, B) << 32);
        __hip_atomic_store((unsigned long long*)F.AGG() + (size_t)((b * 2 + DIR) * NCHUNK + c) * LW + chg, word, RLX_AGENT);
    }
}
__device__ __forceinline__ void lru_decode(int unit, int& b, int& c, int& h) { const int rnd = unit >> 8, within = unit & 255; b = rnd >> 1; h = (rnd & 1) * 4 + (within & 3); c = within >> 2; }
__device__ __forceinline__ void lru_prefetch(Frame& F, int unit, int tid, v4u (&xr)[5]) {
    int b, c, h; lru_decode(unit, b, c, h);
#pragma unroll
    for (int i = 0; i < 5; ++i) { const int p = tid + 512 * i, r = p >> 4, cg = p & 15; const int s = c * CHUNK - 2 + r; xr[i] = (v4u){0u, 0u, 0u, 0u};
        if (p < 131 * 16 && s >= 0 && s < SEQ) xr[i] = *(const GAS v4u*)(F.Z() + ((size_t)b * SEQ + s) * NIN + h * 128 + cg * 8); }
}
__device__ __forceinline__ void lru_fused_unit(Frame& F, int unit, int next, v4u (&xr)[5]) {
    int b, c, h; lru_decode(unit, b, c, h);
    int tid = F.tid; asm volatile("" : "+v"(tid));
    const int lane = tid & 63, w = F.wave, fr = lane & 15, fq = lane >> 4;
    const size_t t0 = (size_t)b * SEQ + (size_t)c * CHUNK;
    LAS unsigned char* XR = F.lds + LRU_XR; LAS unsigned char* XC = F.lds + LRU_XC; LAS unsigned char* GR = F.lds + LRU_GR;
    bf16x8 Ba0[4], Bx0[4], Ba1[4], Bx1[4];
    {
        const bf16* wb = F.LRUW() + (size_t)h * 16384 + (size_t)(16 * w + fr) * 128 + 8 * fq;
#pragma unroll
        for (int ks = 0; ks < 4; ++ks) { Ba0[ks] = *(const GAS bf16x8*)(wb + 32 * ks); Ba1[ks] = *(const GAS bf16x8*)(wb + (size_t)8 * 16384 + 32 * ks);
            Bx0[ks] = *(const GAS bf16x8*)(wb + (size_t)16 * 16384 + 32 * ks); Bx1[ks] = *(const GAS bf16x8*)(wb + (size_t)24 * 16384 + 32 * ks); }
#pragma unroll
        for (int i = 0; i < 5; ++i) { const int p = tid + 512 * i, r = p >> 4, cg = p & 15; if (p < 131 * 16) *(LAS v4u*)(XR + r * 256 + cg * 16) = xr[i]; }
        v2u gr[8];
#pragma unroll
        for (int i = 0; i < 8; ++i) { const int p = tid + 512 * i, r = p >> 5, cg = p & 31;
            gr[i] = *(const GAS v2u*)(F.Z() + (t0 + r) * NIN + LW + h * 128 + cg * 4); }
        __syncthreads();
        {
            const int ch2 = tid & 63, tg = tid >> 6, chg = h * 128 + 2 * ch2;
            float w0[4], w1[4];
#pragma unroll
            for (int k = 0; k < 4; ++k) { w0[k] = F.A.in[3][k * LW + chg]; w1[k] = F.A.in[3][k * LW + chg + 1]; }
            const float b0 = F.A.in[4][chg], b1 = F.A.in[4][chg + 1];
            float x0[4], x1[4];
#pragma unroll
            for (int k = 0; k < 3; ++k) { const unsigned u = *(const LAS unsigned*)(XR + (16 * tg + k) * 256 + ch2 * 4); x0[k] = bf_lo(u); x1[k] = bf_hi(u); }
#pragma unroll
            for (int j = 0; j < 16; ++j) {
                const unsigned u = *(const LAS unsigned*)(XR + (16 * tg + j + 3) * 256 + ch2 * 4); x0[3] = bf_lo(u); x1[3] = bf_hi(u);
                const float y0 = b0 + ((w0[0] * x0[0] + w0[1] * x0[1]) + (w0[2] * x0[2] + w0[3] * x0[3]));
                const float y1 = b1 + ((w1[0] * x1[0] + w1[1] * x1[1]) + (w1[2] * x1[2] + w1[3] * x1[3]));
                *(LAS unsigned*)(XC + xc_off(16 * tg + j, 2 * ch2)) = pk2(y0, y1);
                x0[0] = x0[1]; x0[1] = x0[2]; x0[2] = x0[3]; x1[0] = x1[1]; x1[1] = x1[2]; x1[2] = x1[3];
            }
        }
#pragma unroll
        for (int i = 0; i < 8; ++i) { const int p = tid + 512 * i, r = p >> 5, cg = p & 31; *(LAS v2u*)(GR + r * 264 + cg * 8) = gr[i]; }
        __syncthreads();
    }
    f32x4 R0[8], I0[8], R1[8], I1[8]; float EA0, EB0, EA1, EB1;
    lru_scan_dir<0>(F, b, c, h, Ba0, Bx0, R0, I0, EA0, EB0);
    asm volatile("" ::: "memory"); __builtin_amdgcn_sched_barrier(0);
    lru_scan_dir<1>(F, b, c, h, Ba1, Bx1, R1, I1, EA1, EB1);
    if (next >= 0) lru_prefetch(F, next, tid, xr);
    {
        const int ch = tid & 127, kq = tid >> 7;
        const unsigned long long* ab = (const unsigned long long*)F.AGG() + (size_t)b * 2 * NCHUNK * LW + h * 128 + ch;
        unsigned long long v[16];
#pragma unroll
        for (int i = 0; i < 16; ++i) { const int k = min(16 * kq + i, 62); const int row = k < c ? k : NCHUNK + k + 1;
            v[i] = __hip_atomic_load(ab + (size_t)row * LW, RLX_AGENT); }
        for (unsigned sp = 0; sp < (1u << 16); ++sp) {
            bool bad = false;
#pragma unroll
            for (int i = 0; i < 16; ++i) if (v[i] == 0ull) { const int k = min(16 * kq + i, 62); const int row = k < c ? k : NCHUNK + k + 1;
                v[i] = __hip_atomic_load(ab + (size_t)row * LW, RLX_AGENT); bad = bad || (v[i] == 0ull); }
            if (!bad) break;
            __builtin_amdgcn_s_sleep(2);
        }
        float fa = 1.f, fb = 0.f, ga = 1.f, gb = 0.f;
#pragma unroll
        for (int i = 0; i < 16; ++i) { const int k = 16 * kq + i; const float A = __builtin_bit_cast(float, (unsigned)v[i]), B = __builtin_bit_cast(float, (unsigned)(v[i] >> 32));
            if (k < c) { fb = A * fb + B; fa = A * fa; } }
#pragma unroll
        for (int i = 15; i >= 0; --i) { const int k = 16 * kq + i; const float A = __builtin_bit_cast(float, (unsigned)v[i]), B = __builtin_bit_cast(float, (unsigned)(v[i] >> 32));
            if (k >= c && k < 63) { gb = A * gb + B; ga = A * ga; } }
        *(LAS f32x4*)(F.lds + LRU_PT + (kq * 128 + ch) * 16) = (f32x4){fa, fb, ga, gb};
    }
    __syncthreads();
    if (tid < 256) {
        const int dir = tid >> 7, ch = tid & 127;
        f32x4 q[4];
#pragma unroll
        for (int k = 0; k < 4; ++k) q[k] = *(const LAS f32x4*)(F.lds + LRU_PT + (k * 128 + ch) * 16);
        float st = 0.f;
        if (dir == 0) { st = q[0].y; st = q[1].x * st + q[1].y; st = q[2].x * st + q[2].y; st = q[3].x * st + q[3].y; }
        else { st = q[3].w; st = q[2].z * st + q[2].w; st = q[1].z * st + q[1].w; st = q[0].z * st + q[0].w; }
        *(LAS float*)(F.lds + LRU_CR + tid * 4) = st;
    }
    __syncthreads();
    {
        const int chl = 16 * w + fr;
        const float hin0 = EA0 * *(const LAS float*)(F.lds + LRU_CR + chl * 4) + EB0, hin1 = EA1 * *(const LAS float*)(F.lds + LRU_CR + 512 + chl * 4) + EB1;
#pragma unroll
        for (int m = 0; m < 8; ++m)
#pragma unroll
            for (int j = 0; j < 4; ++j) { const float hs = (R0[m][j] * hin0 + I0[m][j]) + (R1[m][j] * hin1 + I1[m][j]);
                LAS unsigned short* p = (LAS unsigned short*)(GR + (32 * fq + 4 * m + j) * 264 + chl * 2); *p = (unsigned short)f2bf(bf1(*p) * hs); }
        __syncthreads();
        for (int p = tid; p < 128 * 32; p += 512) { const int r = p >> 5, cg = p & 31;
            *(GAS v2u*)(F.MIX() + (t0 + r) * D + h * 128 + cg * 4) = *(const LAS v2u*)(GR + r * 264 + cg * 8); }
    }
    __syncthreads();
}
__device__ __forceinline__ void lru_carry(Frame& F) {
    const int idx = (F.vcu * NWAVES + F.wave) * 64 + F.lane;
    if (idx >= BATCH * 2 * LW) return;
    const int ch = idx & (LW - 1), bd = idx >> 10, dir = bd & 1;
    const f32x2* agg = (const f32x2*)F.AGG() + (size_t)bd * NCHUNK * LW + ch; float* cr = F.CARRY() + (size_t)bd * NCHUNK * LW + ch;
    float st = 0.f;
#pragma unroll 8
    for (int i = 0; i < NCHUNK; ++i) { const int cc = dir == 0 ? i : NCHUNK - 1 - i; const f32x2 pe = agg[(size_t)cc * LW]; cr[(size_t)cc * LW] = st; st = pe.x * st + pe.y; }
}
constexpr int GM_ST = 0, GM_BS = 1024, GM_VN = 2048, GM_GU = 2048 + 32768;
typedef short s16x4 __attribute__((ext_vector_type(4)));
__device__ __forceinline__ unsigned vn_off(unsigned row, unsigned ch) { return 256u * row + 16u * (ch ^ (((row & 3u) << 2) | ((row >> 2) & 3u))); }
struct GmlpRegs { v4u a[4]; v2u gu[8]; bf16x8 Af[4]; f32x4 g0, g1, b0, b1; float bs; };
__device__ __forceinline__ void gmlp_load(Frame& F, size_t t0, int h, int tid, GmlpRegs& G) {
    const int lane = tid & 63, w = tid >> 6, fr = lane & 15, fq = lane >> 4;
#pragma unroll
    for (int i = 0; i < 4; ++i) { const int pid = tid + 512 * i, q = pid >> 4, cg = pid & 15; G.a[i] = *(const GAS v4u*)(F.Z() + (t0 + q) * NIN + 3 * LW + h * 128 + cg * 8); }
#pragma unroll
    for (int i = 0; i < 8; ++i) { const int pid = tid + 512 * i, r = pid >> 5, cg = pid & 31; G.gu[i] = *(const GAS v2u*)(F.Z() + (t0 + r) * NIN + 2 * LW + h * 128 + cg * 4); }
    { const int cg = tid & 15;
      G.g0 = *(const GAS f32x4*)(F.A.in[10] + h * 128 + cg * 8); G.g1 = *(const GAS f32x4*)(F.A.in[10] + h * 128 + cg * 8 + 4);
      G.b0 = *(const GAS f32x4*)(F.A.in[11] + h * 128 + cg * 8); G.b1 = *(const GAS f32x4*)(F.A.in[11] + h * 128 + cg * 8 + 4); }
    G.bs = F.A.in[13][h * 128 + (tid & 127)];
    const bf16* wsb = F.WSB() + (size_t)h * 16384 + (size_t)(16 * w + fr) * 128 + 8 * fq;
#pragma unroll
    for (int ks = 0; ks < 4; ++ks) G.Af[ks] = *(const GAS bf16x8*)(wsb + 32 * ks);
}
__device__ __forceinline__ void gmlp_unit(Frame& F, int unit) {
    int tid = F.tid; asm volatile("" : "+v"(tid));
    const int lane = tid & 63, w = F.wave, fr = lane & 15, fq = lane >> 4;
    const size_t t0 = (size_t)unit * CHUNK;
    LAS float* ST = (LAS float*)(F.lds + GM_ST); LAS float* BS = (LAS float*)(F.lds + GM_BS);
    LAS unsigned char* VN = F.lds + GM_VN; LAS unsigned char* GU = F.lds + GM_GU;
    GmlpRegs G;
    gmlp_load(F, t0, 0, tid, G);
#pragma unroll
    for (int rb = 0; rb < 2; ++rb) {
        v4u ra[8], rc[8];
#pragma unroll
        for (int rr = 0; rr < 8; ++rr) { const bf16* p = F.Z() + (t0 + 16 * w + 8 * rb + rr) * NIN + 3 * LW + lane * 8; ra[rr] = *(const GAS v4u*)p; rc[rr] = *(const GAS v4u*)(p + 512); }
#pragma unroll
        for (int rr = 0; rr < 8; ++rr) {
            const int row = 16 * w + 8 * rb + rr;
            const v4u a = ra[rr], b = rc[rr];
            float x[16] = {bf_lo(a.x), bf_hi(a.x), bf_lo(a.y), bf_hi(a.y), bf_lo(a.z), bf_hi(a.z), bf_lo(a.w), bf_hi(a.w),
                           bf_lo(b.x), bf_hi(b.x), bf_lo(b.y), bf_hi(b.y), bf_lo(b.z), bf_hi(b.z), bf_lo(b.w), bf_hi(b.w)};
            float s = 0.f;
#pragma unroll
            for (int i = 0; i < 16; ++i) s += x[i];
            const float mean = wave_sum(s) * (1.0f / LW);
            float q = 0.f;
#pragma unroll
            for (int i = 0; i < 16; ++i) { const float d = x[i] - mean; q += d * d; }
            const float rstd = __builtin_amdgcn_rsqf(wave_sum(q) * (1.0f / LW) + 1e-6f);
            if (lane == 0) { ST[2 * row] = mean; ST[2 * row + 1] = rstd; }
        }
    }
    __syncthreads();
    const unsigned trq = (unsigned)(lane & 15) >> 2, trp = (unsigned)lane & 3u;
    for (int h = 0; h < 8; ++h) {
#pragma unroll
        for (int i = 0; i < 4; ++i) { const int pid = tid + 512 * i, q = pid >> 4, cg = pid & 15;
            const v4u a = G.a[i];
            const float mean = ST[2 * q], rstd = ST[2 * q + 1];
            const f32x4 g0 = G.g0, g1 = G.g1, b0 = G.b0, b1 = G.b1;
            v4u o;
            o.x = pk2((bf_lo(a.x) - mean) * rstd * g0.x + b0.x, (bf_hi(a.x) - mean) * rstd * g0.y + b0.y);
            o.y = pk2((bf_lo(a.y) - mean) * rstd * g0.z + b0.z, (bf_hi(a.y) - mean) * rstd * g0.w + b0.w);
            o.z = pk2((bf_lo(a.z) - mean) * rstd * g1.x + b1.x, (bf_hi(a.z) - mean) * rstd * g1.y + b1.y);
            o.w = pk2((bf_lo(a.w) - mean) * rstd * g1.z + b1.z, (bf_hi(a.w) - mean) * rstd * g1.w + b1.w);
            *(LAS v4u*)(VN + vn_off((unsigned)q, (unsigned)cg)) = o;
        }
#pragma unroll
        for (int i = 0; i < 8; ++i) { const int pid = tid + 512 * i, r = pid >> 5, cg = pid & 31; *(LAS v2u*)(GU + r * 264 + cg * 8) = G.gu[i]; }
        if (tid < 128) BS[tid] = G.bs;
        bf16x8 Af[4];
#pragma unroll
        for (int ks = 0; ks < 4; ++ks) Af[ks] = G.Af[ks];
        __syncthreads();
        if (h + 1 < 8) gmlp_load(F, t0, h + 1, tid, G);
        f32x4 acc[8];
#pragma unroll
        for (int n = 0; n < 8; ++n) {
            acc[n] = (f32x4){0.f, 0.f, 0.f, 0.f};
#pragma unroll
            for (int ks = 0; ks < 4; ++ks) {
                const s16x4 b0 = __builtin_amdgcn_ds_read_tr16_b64_v4i16((LAS s16x4*)(VN + vn_off(32u * ks + 8u * fq + trq, 2u * n + (trp >> 1)) + 8u * (trp & 1u)));
                const s16x4 b1 = __builtin_amdgcn_ds_read_tr16_b64_v4i16((LAS s16x4*)(VN + vn_off(32u * ks + 8u * fq + 4u + trq, 2u * n + (trp >> 1)) + 8u * (trp & 1u)));
                const bf16x8 bb = (bf16x8){b0[0], b0[1], b0[2], b0[3], b1[0], b1[1], b1[2], b1[3]};
                acc[n] = __builtin_amdgcn_mfma_f32_16x16x32_bf16(Af[ks], bb, acc[n], 0, 0, 0);
            }
        }
#pragma unroll
        for (int n = 0; n < 8; ++n)
#pragma unroll
            for (int j = 0; j < 4; ++j) { const int p = 16 * w + 4 * fq + j; LAS unsigned short* ad = (LAS unsigned short*)(GU + p * 264 + (16 * n + fr) * 2);
                *ad = (unsigned short)f2bf(bf1(*ad) * (acc[n][j] + BS[p])); }
        __syncthreads();
#pragma unroll
        for (int i = 0; i < 8; ++i) { const int pid = tid + 512 * i, r = pid >> 5, cg = pid & 31;
            *(GAS v2u*)(F.MIX() + (t0 + r) * D + LW + h * 128 + cg * 4) = *(const LAS v2u*)(GU + r * 264 + cg * 8); }
        __syncthreads();
    }
}
__device__ __forceinline__ void h8_issue(Frame& F, int t, int lane, v4u (&a)[4]) {
    const bf16* hp = F.HB() + (size_t)t * D + lane * 16;
#pragma unroll
    for (int c = 0; c < 2; ++c)
#pragma unroll
        for (int q = 0; q < 2; ++q) a[c * 2 + q] = *(const GAS v4u*)(hp + c * 1024 + q * 8);
}
__device__ __forceinline__ void h8_finish(Frame& F, int t, int lane, const v4u (&av)[4]) {
    float hx[32]; float mx = 0.f;
#pragma unroll
    for (int c = 0; c < 2; ++c)
#pragma unroll
        for (int q = 0; q < 2; ++q) { const v4u a = av[c * 2 + q]; float* x = hx + c * 16 + q * 8;
            x[0] = bf_lo(a.x); x[1] = bf_hi(a.x); x[2] = bf_lo(a.y); x[3] = bf_hi(a.y); x[4] = bf_lo(a.z); x[5] = bf_hi(a.z); x[6] = bf_lo(a.w); x[7] = bf_hi(a.w); }
#pragma unroll
    for (int i = 0; i < 32; ++i) mx = fmaxf(mx, fabsf(hx[i]));
#pragma unroll
    for (int o = 1; o < 64; o <<= 1) mx = fmaxf(mx, __shfl_xor(mx, o));
    const float sc = mx > 0.f ? 119.0f / mx : 1.0f;
    const float MAGIC = 12582912.0f + 128.0f;
#pragma unroll
    for (int c = 0; c < 2; ++c) {
        unsigned hw[2], lw[2];
#pragma unroll
        for (int g8 = 0; g8 < 2; ++g8) {
            unsigned m[8];
#pragma unroll
            for (int i = 0; i < 8; ++i) m[i] = __builtin_bit_cast(unsigned, __builtin_fmaf(hx[c * 16 + g8 * 8 + i], sc, MAGIC));
            const unsigned B0 = __builtin_amdgcn_perm(__builtin_amdgcn_perm(m[3], m[2], 0x0c0c0400u), __builtin_amdgcn_perm(m[1], m[0], 0x0c0c0400u), 0x05040100u);
            const unsigned B1 = __builtin_amdgcn_perm(__builtin_amdgcn_perm(m[7], m[6], 0x0c0c0400u), __builtin_amdgcn_perm(m[5], m[4], 0x0c0c0400u), 0x05040100u);
            lw[g8] = (B0 & 0x0F0F0F0Fu) | ((B1 & 0x0F0F0F0Fu) << 4);
            const unsigned h0 = ((B0 + 0x08080808u) >> 4) & 0x0F0F0F0Fu, h1 = ((B1 + 0x08080808u) >> 4) & 0x0F0F0F0Fu;
            hw[g8] = (h0 | (h1 << 4)) ^ 0x88888888u; }
        unsigned char* hb_ = F.H8() + (size_t)t * D + c * 512 + lane * 8;
        *(GAS v2u*)hb_ = (v2u){hw[0], hw[1]}; *(GAS v2u*)(hb_ + 1024) = (v2u){lw[0], lw[1]};
    }
    if (lane == 0) F.HSCALE()[t] = mx > 0.f ? mx * (1.0f / 119.0f) : 1.0f;
}
__device__ __forceinline__ void h8_row(Frame& F, int t) { int lane = F.lane; asm volatile("" : "+v"(lane)); v4u a[4]; h8_issue(F, t, lane, a); h8_finish(F, t, lane, a); }
typedef float f32x16 __attribute__((ext_vector_type(16)));
__device__ __forceinline__ unsigned fkey(float f) { const int u = __builtin_bit_cast(int, f); return (unsigned)(u ^ ((u >> 31) & 0x7fffffff)); }
__device__ __forceinline__ float fkey_inv(unsigned k) { const int u = (int)k; return __builtin_bit_cast(float, u ^ ((u >> 31) & 0x7fffffff)); }
__device__ __forceinline__ unsigned umax_(unsigned a, unsigned b) { return (int)a > (int)b ? a : b; }
__device__ __forceinline__ unsigned umin_(unsigned a, unsigned b) { return (int)a < (int)b ? a : b; }
#define CE_DESC(x, y) do { const unsigned a_ = (x), b_ = (y); (x) = umax_(a_, b_); (y) = umin_(a_, b_); } while (0)
__device__ __forceinline__ void sort16_desc(unsigned (&a)[16]) {
#pragma unroll
    for (int k = 2; k <= 16; k <<= 1)
#pragma unroll
        for (int j = k >> 1; j >= 1; j >>= 1)
#pragma unroll
            for (int i = 0; i < 16; ++i) { const int l = i ^ j; if (l > i) { if ((i & k) == 0) CE_DESC(a[i], a[l]); else CE_DESC(a[l], a[i]); } }
}
__device__ __forceinline__ void merge16_desc(unsigned (&a)[16], const unsigned (&b)[16]) {
#pragma unroll
    for (int i = 0; i < 16; ++i) a[i] = umax_(a[i], b[15 - i]);
#pragma unroll
    for (int j = 8; j >= 1; j >>= 1)
#pragma unroll
        for (int i = 0; i < 16; ++i) if ((i & j) == 0) CE_DESC(a[i], a[i + j]);
}
typedef short bf16x8s __attribute__((ext_vector_type(8)));
__device__ __forceinline__ void topk_unit(Frame& F, int wu, bool doh, int th, int tstride) {
    v4u ha[4][4];
    const int tg = wu >> 3, hd = wu & 7, lane = F.lane, r = lane & 31, hh = lane >> 5;
    const int t = tg * 32 + r;
    const size_t qoff = (size_t)t * D + hd * 256 + 8 * hh;
    unsigned L[2][16];
    unsigned hh4 = (unsigned)hh << 2; asm volatile("" : "+v"(hh4));
#pragma unroll
    for (int p = 0; p < 2; ++p) {
        f32x16 acc[4];
#pragma unroll
        for (int nt = 0; nt < 4; ++nt)
#pragma unroll
            for (int i = 0; i < 16; ++i) acc[nt][i] = 0.f;
        const size_t koff = ((size_t)(hd * 2 + p) * 128 + r) * 128 + 8 * hh;
        const bf16* qp = F.QH() + qoff + p * 128; const bf16* kp0 = F.KH() + koff; const bf16* kp1 = kp0 + 32 * 128; const bf16* kp2 = kp0 + 64 * 128; const bf16* kp3 = kp0 + 96 * 128;
        asm volatile("" : "+v"(qp), "+v"(kp0), "+v"(kp1), "+v"(kp2), "+v"(kp3));
#define P6_LOAD(Q, K, ks0, n) _Pragma("unroll") for (int i_ = 0; i_ < (n); ++i_) { Q[i_] = *(const GAS bf16x8s*)(qp + 16 * ((ks0) + i_)); \
            K[i_][0] = *(const GAS bf16x8s*)(kp0 + 16 * ((ks0) + i_)); K[i_][1] = *(const GAS bf16x8s*)(kp1 + 16 * ((ks0) + i_)); \
            K[i_][2] = *(const GAS bf16x8s*)(kp2 + 16 * ((ks0) + i_)); K[i_][3] = *(const GAS bf16x8s*)(kp3 + 16 * ((ks0) + i_)); }
#define P6_MMA(Q, K, n) _Pragma("unroll") for (int i_ = 0; i_ < (n); ++i_) _Pragma("unroll") for (int nt = 0; nt < 4; ++nt) acc[nt] = __builtin_amdgcn_mfma_f32_32x32x16_bf16(K[i_][nt], Q[i_], acc[nt], 0, 0, 0);
        bf16x8s qa[3], ka[3][4], qb[3], kb[3][4];
        P6_LOAD(qa, ka, 0, 3); P6_LOAD(qb, kb, 3, 3);
        __builtin_amdgcn_sched_barrier(0);
        P6_MMA(qa, ka, 3);
        __builtin_amdgcn_sched_barrier(0);
        P6_LOAD(qa, ka, 6, 2);
        __builtin_amdgcn_sched_barrier(0);
        P6_MMA(qb, kb, 3);
        __builtin_amdgcn_sched_barrier(0);
        P6_MMA(qa, ka, 2);
        __builtin_amdgcn_sched_barrier(0);
        if (p == 1) {
#pragma unroll
            for (int i = 0; i < 4; ++i) { if (doh) h8_issue(F, th + i * tstride, lane, ha[i]); else { ha[i][0] = ha[i][1] = ha[i][2] = ha[i][3] = (v4u){0u, 0u, 0u, 0u}; } }
            __builtin_amdgcn_sched_barrier(0);
        }
#undef P6_LOAD
#undef P6_MMA
        unsigned S[4][16];
#pragma unroll
        for (int nt = 0; nt < 4; ++nt) {
#pragma unroll
            for (int rg = 0; rg < 16; ++rg) { const int nc = 32 * nt + (rg & 3) + 8 * (rg >> 2); S[nt][rg] = ((fkey(acc[nt][rg]) & ~0x7Fu) | (unsigned)(127 - nc)) ^ hh4; }
            sort16_desc(S[nt]);
        }
        merge16_desc(S[0], S[1]); merge16_desc(S[2], S[3]); merge16_desc(S[0], S[2]);
        unsigned T[16];
#pragma unroll
        for (int i = 0; i < 16; ++i) T[i] = (unsigned)__shfl_xor((int)S[0][i], 32);
        merge16_desc(S[0], T);
#pragma unroll
        for (int i = 0; i < 16; ++i) L[p][i] = S[0][i];
        __builtin_amdgcn_sched_barrier(0);
    }
    float v0[16], v1[16];
#pragma unroll
    for (int i = 0; i < 16; ++i) { v0[i] = fkey_inv(L[0][i] & ~0x7Fu); v1[i] = fkey_inv(L[1][i] & ~0x7Fu); }
    unsigned C[4][16];
    {
        int cnt = 0;
#pragma unroll
        for (int i = 0; i < 16; ++i)
#pragma unroll
            for (int j = 0; j < 16; ++j) if ((i + 1) * (j + 1) <= 16) { C[cnt >> 4][cnt & 15] = (fkey(v0[i] + v1[j]) & ~0xFFu) | (unsigned)(255 - (i * 16 + j)); ++cnt; }
#pragma unroll
        for (int q = 50; q < 64; ++q) C[q >> 4][q & 15] = 0x80000000u;
    }
    sort16_desc(C[0]); sort16_desc(C[1]); sort16_desc(C[2]); sort16_desc(C[3]);
    merge16_desc(C[0], C[1]); merge16_desc(C[2], C[3]); merge16_desc(C[0], C[2]);
    unsigned best[16];
#pragma unroll
    for (int i = 0; i < 16; ++i) best[i] = C[0][i];
    LAS unsigned* tab = (LAS unsigned*)(F.lds + F.wave * 8192) + lane;
#pragma unroll
    for (int i = 0; i < 16; ++i) { tab[i * 64] = 127u - (L[0][i] & 0x7Fu); tab[(16 + i) * 64] = 127u - (L[1][i] & 0x7Fu); }
    const float smax = fkey_inv(best[0] & ~0xFFu);
    float sv[8]; unsigned idv[8]; float ssum = 0.f;
#pragma unroll
    for (int k = 0; k < 8; ++k) {
        const unsigned bk = hh ? best[8 + k] : best[k];
        const unsigned pos = 255u - (bk & 0xFFu);
        idv[k] = tab[(pos >> 4) * 64] * 128u + tab[(16 + (pos & 15u)) * 64];
        sv[k] = __builtin_amdgcn_exp2f((fkey_inv(bk & ~0xFFu) - smax) * 1.4426950409f); ssum += sv[k];
    }
    ssum += __shfl_xor(ssum, 32);
    const float inv = 1.0f / ssum;
    {
        int* o = F.IDS() + (size_t)t * 128 + hd * 16 + 8 * hh; float* og = F.GATES() + (size_t)t * 128 + hd * 16 + 8 * hh;
        *(GAS v4u*)o = (v4u){idv[0], idv[1], idv[2], idv[3]}; *(GAS v4u*)(o + 4) = (v4u){idv[4], idv[5], idv[6], idv[7]};
        *(GAS f32x4*)og = (f32x4){sv[0] * inv, sv[1] * inv, sv[2] * inv, sv[3] * inv}; *(GAS f32x4*)(og + 4) = (f32x4){sv[4] * inv, sv[5] * inv, sv[6] * inv, sv[7] * inv};
    }
    if (doh) {
#pragma unroll
        for (int i = 0; i < 4; ++i) h8_finish(F, th + i * tstride, lane, ha[i]);
    }
}
__device__ __forceinline__ int row_sum16(int v) {
    v += __builtin_amdgcn_update_dpp(0, v, 0x128, 0xf, 0xf, false);
    v += __builtin_amdgcn_update_dpp(0, v, 0x124, 0xf, 0xf, false);
    v += __builtin_amdgcn_update_dpp(0, v, 0x122, 0xf, 0xf, false);
    v += __builtin_amdgcn_update_dpp(0, v, 0x121, 0xf, 0xf, false);
    return v;
}
__device__ __forceinline__ void peer_u_xcd(Frame& F) {
    const int lane = F.lane, x = blockIdx.x & 7, jcu = blockIdx.x >> 3, ncu = ((int)F.G - x + 7) >> 3;
    const int tpc = (M + ncu - 1) / ncu, tpw = (tpc + NWAVES - 1) / NWAVES;
    const int tbase = jcu * tpc + F.wave * tpw;
    int nw = M - tbase; { const int lim = (jcu + 1) * tpc - tbase; nw = nw < lim ? nw : lim; nw = nw < tpw ? nw : tpw; nw = nw < 0 ? 0 : nw; }
    const int NV = nw;
    LAS unsigned char* wl = F.lds + F.wave * 13312;
    LAS int* lst = (LAS int*)wl; LAS int* res = (LAS int*)(wl + 512); LAS unsigned char* hsl = wl + 1024;
    const int q4 = lane >> 4, i16 = lane & 15;
    const unsigned char* ubase = F.U8() + (size_t)x * 2048 * 1024;
    const unsigned lanepart = (unsigned)i16 * 16u;
    int r_idlo = 0, r_idhi = 0, r_t = 0; v4u r_h0 = (v4u){0u, 0u, 0u, 0u}, r_h1 = (v4u){0u, 0u, 0u, 0u};
    int v_cl0 = 0, v_cl1 = 0, v_n = 0, v_r0 = 0, v_t = 0, v_slot = 0; unsigned long long v_mlo = 0, v_mhi = 0; bool v_live = false;
    int vset = 0, nvalid = 0, idle = 0;
    if (NV == 0) return;
#define U_RAW() do { const int vi_ = vset < NV ? vset : NV - 1; r_t = tbase + vi_; \
        r_idlo = F.IDS()[(size_t)r_t * 128 + lane]; r_idhi = F.IDS()[(size_t)r_t * 128 + 64 + lane]; \
        r_h0 = *(const GAS v4u*)(F.H8() + (size_t)r_t * D + lane * 16); r_h1 = *(const GAS v4u*)(F.H8() + (size_t)r_t * D + 1024 + lane * 16); } while (0)
#define U_NEXT() do { if (v_live && v_r0 + 16 < v_n) { v_r0 += 16; } else if (vset < NV) { const bool slo = (r_idlo >> 11) == x, shi = (r_idhi >> 11) == x; \
            v_mlo = __ballot(slo); v_mhi = __ballot(shi); const int nlo = __popcll(v_mlo); v_n = nlo + __popcll(v_mhi); \
            const int plo = __builtin_amdgcn_mbcnt_hi((unsigned)(v_mlo >> 32), __builtin_amdgcn_mbcnt_lo((unsigned)v_mlo, 0)); \
            const int phi = nlo + __builtin_amdgcn_mbcnt_hi((unsigned)(v_mhi >> 32), __builtin_amdgcn_mbcnt_lo((unsigned)v_mhi, 0)); \
            if (slo) lst[plo] = (r_idlo & 2047) | (lane << 16); if (shi) lst[phi] = (r_idhi & 2047) | ((64 + lane) << 16); \
            v_slot = nvalid % 6; ++nvalid; { LAS unsigned char* sp_ = hsl + v_slot * 2048; *(LAS v4u*)(sp_ + lane * 16) = r_h0; *(LAS v4u*)(sp_ + 1024 + lane * 16) = r_h1; } \
            v_cl0 = lst[lane]; v_cl1 = lst[64 + lane]; v_t = r_t; v_r0 = 0; ++vset; v_live = true; } \
        else { v_live = false; v_n = 0; v_r0 = 0; v_mlo = 0; v_mhi = 0; ++idle; } } while (0)
#define U_ISSUE(BUF, DS) do { { const int rem_ = v_n - v_r0; DS##_cnt = rem_ < 0 ? 0 : (rem_ < 16 ? rem_ : 16); } \
        DS##_slot = v_slot; DS##_t = v_t; DS##_mlo = v_mlo; DS##_mhi = v_mhi; DS##_last = v_live && (v_r0 + 16 >= v_n); \
        _Pragma("unroll") for (int gp = 0; gp < 4; ++gp) { const int ix_ = v_r0 + 4 * gp + q4; const int a_ = __shfl(v_cl0, ix_ & 63), b_ = __shfl(v_cl1, ix_ & 63); DS##_ent[gp] = ix_ < 64 ? a_ : b_; \
            const unsigned of_ = (4 * gp + q4 < DS##_cnt ? ((unsigned)(DS##_ent[gp] & 2047) << 10) : 0u) + lanepart; \
            _Pragma("unroll") for (int c = 0; c < 4; ++c) BUF[4 * gp + c] = *(const GAS v4u*)(ubase + of_ + c * 256); } } while (0)
#define U_COMPUTE(BUF, DS) do { const LAS unsigned char* sp_ = hsl + DS##_slot * 2048; const LAS v4u* hp_ = (const LAS v4u*)(sp_ + i16 * 16); \
        _Pragma("unroll") for (int gp = 0; gp < 4; ++gp) if (4 * gp < DS##_cnt) { int ah_ = 0, al_ = 0; \
            _Pragma("unroll") for (int c = 0; c < 4; ++c) { const v4u r_ = BUF[4 * gp + c]; const v4u hh_ = hp_[c * 16], hl_ = hp_[64 + c * 16]; \
                ah_ = __builtin_amdgcn_sdot8((int)r_.x, (int)hh_.x, ah_, false); al_ = __builtin_amdgcn_sdot8((int)r_.x, (int)hl_.x, al_, false); \
                ah_ = __builtin_amdgcn_sdot8((int)r_.y, (int)hh_.y, ah_, false); al_ = __builtin_amdgcn_sdot8((int)r_.y, (int)hl_.y, al_, false); \
                ah_ = __builtin_amdgcn_sdot8((int)r_.z, (int)hh_.z, ah_, false); al_ = __builtin_amdgcn_sdot8((int)r_.z, (int)hl_.z, al_, false); \
                ah_ = __builtin_amdgcn_sdot8((int)r_.w, (int)hh_.w, ah_, false); al_ = __builtin_amdgcn_sdot8((int)r_.w, (int)hl_.w, al_, false); } \
            const int a_ = row_sum16((ah_ << 4) + al_); if (i16 == 0 && 4 * gp + q4 < DS##_cnt) res[DS##_ent[gp] >> 16] = a_; } \
        if (DS##_last) { int* po_ = F.PART() + (size_t)DS##_t * 128; \
            if ((DS##_mlo >> lane) & 1ull) po_[lane] = res[lane]; if ((DS##_mhi >> lane) & 1ull) po_[64 + lane] = res[64 + lane]; } } while (0)
    v4u bufA[16], bufB[16], bufC[16];
    int dA_cnt = 0, dA_ent[4] = {0, 0, 0, 0}, dA_t = 0, dA_slot = 0; unsigned long long dA_mlo = 0, dA_mhi = 0; bool dA_last = false;
    int dB_cnt = 0, dB_ent[4] = {0, 0, 0, 0}, dB_t = 0, dB_slot = 0; unsigned long long dB_mlo = 0, dB_mhi = 0; bool dB_last = false;
    int dC_cnt = 0, dC_ent[4] = {0, 0, 0, 0}, dC_t = 0, dC_slot = 0; unsigned long long dC_mlo = 0, dC_mhi = 0; bool dC_last = false;
    U_RAW();
    U_NEXT(); U_RAW(); U_ISSUE(bufA, dA);
    U_NEXT(); U_RAW(); U_ISSUE(bufB, dB);
    while (idle < 3) {
        U_NEXT(); U_RAW(); U_ISSUE(bufC, dC); U_COMPUTE(bufA, dA);
        U_NEXT(); U_RAW(); U_ISSUE(bufA, dA); U_COMPUTE(bufB, dB);
        U_NEXT(); U_RAW(); U_ISSUE(bufB, dB); U_COMPUTE(bufC, dC);
    }
#undef U_RAW
#undef U_NEXT
#undef U_ISSUE
#undef U_COMPUTE
}
__device__ __forceinline__ void peer_act_token(Frame& F, int t) {
    const int lane = F.lane;
    LAS unsigned char* wl = F.lds + F.wave * 4096;
    LAS float* abuf = (LAS float*)wl; LAS int* ibuf = (LAS int*)(wl + 512); LAS int* cnt = (LAS int*)(wl + 1024);
    LAS int* ovf = (LAS int*)(wl + 1280); LAS int* fre = (LAS int*)(wl + 1792); LAS int* sop = (LAS int*)(wl + 2304);
#define WFENCE() asm volatile("s_waitcnt lgkmcnt(0)" ::: "memory")
    const float sc = __builtin_amdgcn_rsqf(F.ROWSS()[t] * (1.0f / D) + 1e-6f) * F.HSCALE()[t];
    if (lane < 34) cnt[lane] = 0;
    float am = 0.f; float actv[2]; int idv[2], slotv[2];
    const int l32 = t & 31;
#pragma unroll
    for (int half = 0; half < 2; ++half) {
        const size_t o = (size_t)t * 128 + half * 64 + lane;
        const int e = F.IDS()[o]; const float g = F.GATES()[o];
        const int dsum = F.PART()[o];
        actv[half] = gelu_tanh((float)dsum * sc * F.USCALE()[e]) * g * F.VSCALE()[e]; idv[half] = e; am = fmaxf(am, fabsf(actv[half]));
    }
    WFENCE();
#pragma unroll
    for (int half = 0; half < 2; ++half) {
        const int r = idv[half] & 31;
        const int j = __hip_atomic_fetch_add(cnt + r, 1, __ATOMIC_RELAXED, __HIP_MEMORY_SCOPE_WORKGROUP);
        if (j < 4) slotv[half] = ((r - l32) & 31) + 32 * j;
        else { const int q = __hip_atomic_fetch_add(cnt + 32, 1, __ATOMIC_RELAXED, __HIP_MEMORY_SCOPE_WORKGROUP); ovf[q] = half * 64 + lane; slotv[half] = -1; }
    }
    WFENCE();
    if (lane < 32) { const int n = cnt[lane];
        for (int j = n; j < 4; ++j) { const int q = __hip_atomic_fetch_add(cnt + 33, 1, __ATOMIC_RELAXED, __HIP_MEMORY_SCOPE_WORKGROUP); fre[q] = ((lane - l32) & 31) + 32 * j; } }
    WFENCE();
    const int nov = cnt[32];
#pragma unroll
    for (int half = 0; half < 2; ++half) { const int i = half * 64 + lane; if (i < nov) sop[ovf[i]] = fre[i]; }
    WFENCE();
#pragma unroll
    for (int half = 0; half < 2; ++half) { if (slotv[half] < 0) slotv[half] = sop[half * 64 + lane]; abuf[slotv[half]] = actv[half]; ibuf[slotv[half]] = idv[half]; }
    WFENCE();
#pragma unroll
    for (int o = 1; o < 64; o <<= 1) am = fmaxf(am, __shfl_xor(am, o));
    const float asc = am > 0.f ? 127.0f / am : 1.0f;
    if (lane == 0) F.ASCALE()[t] = am > 0.f ? am * (1.0f / 127.0f) : 1.0f;
    if (lane < 32) {
        const f32x4 av = *(const LAS f32x4*)(abuf + 4 * lane); const v4u iv = *(const LAS v4u*)(ibuf + 4 * lane);
        const size_t o = ((size_t)(t >> 6) * 32 + lane) * 64 + (t & 63);
        F.IDW()[o] = (v4u){iv.x << 3, iv.y << 3, iv.z << 3, iv.w << 3};
        F.AW()[o] = pack_i8x4(av.x * asc, av.y * asc, av.z * asc, av.w * asc);
    }
    WFENCE();
#undef WFENCE
}
__device__ __forceinline__ void tr4x4(const unsigned r0, const unsigned r1, const unsigned r2, const unsigned r3, unsigned (&c)[4]) {
    const unsigned t01l = __builtin_amdgcn_perm(r1, r0, 0x05010400u), t01h = __builtin_amdgcn_perm(r1, r0, 0x07030602u);
    const unsigned t23l = __builtin_amdgcn_perm(r3, r2, 0x05010400u), t23h = __builtin_amdgcn_perm(r3, r2, 0x07030602u);
    c[0] = __builtin_amdgcn_perm(t23l, t01l, 0x05040100u); c[1] = __builtin_amdgcn_perm(t23l, t01l, 0x07060302u);
    c[2] = __builtin_amdgcn_perm(t23h, t01h, 0x05040100u); c[3] = __builtin_amdgcn_perm(t23h, t01h, 0x07060302u);
}
template <int MODE>
__device__ __forceinline__ void peer_v_slice(Frame& F, int c, bool do_atomic) {
    const int tid = F.tid, lane = F.lane;
    for (int i = tid; i < NEXP * 8 / 16; i += 512) *(LAS v4u*)(F.lds + i * 16) = *(const GAS v4u*)(F.V8T() + (size_t)c * NEXP * 8 + (size_t)i * 16);
    __syncthreads();
    const v4u* ibase = F.IDW() + lane; const unsigned* abase = F.AW() + lane;
    constexpr int NBLK = M / 64, PD = 16;
    v4u iq[PD]; unsigned aq[PD]; v2u rw[2][4];
    {
        const size_t o = (size_t)F.wave * 32 * 64;
#pragma unroll
        for (int j = 0; j < PD; ++j) { iq[j] = *(const GAS v4u*)(ibase + o + j * 64); aq[j] = abase[o + j * 64]; }
    }
#define LROW(dst, q) do { dst[0] = *(const LAS v2u*)(F.lds + (q).x); dst[1] = *(const LAS v2u*)(F.lds + (q).y); \
                          dst[2] = *(const LAS v2u*)(F.lds + (q).z); dst[3] = *(const LAS v2u*)(F.lds + (q).w); } while (0)
    for (int blk = F.wave; blk < NBLK; blk += NWAVES) {
        const int t = blk * 64 + lane;
        const size_t o = (size_t)blk * 32 * 64;
        const int nblk = (blk + NWAVES < NBLK) ? blk + NWAVES : blk;
        const size_t on = (size_t)nblk * 32 * 64;
        int acc[8];
#pragma unroll
        for (int i = 0; i < 8; ++i) acc[i] = 0;
        LROW(rw[0], iq[0]);
#pragma unroll
        for (int j = 0; j < 32; ++j) {
            if (j + 1 < 32) LROW(rw[(j + 1) & 1], iq[(j + 1) % PD]);
            const unsigned aw = aq[j % PD];
            unsigned cl[4], ch[4];
            tr4x4(rw[j & 1][0].x, rw[j & 1][1].x, rw[j & 1][2].x, rw[j & 1][3].x, cl);
            tr4x4(rw[j & 1][0].y, rw[j & 1][1].y, rw[j & 1][2].y, rw[j & 1][3].y, ch);
#pragma unroll
            for (int i = 0; i < 4; ++i) { acc[i] = __builtin_amdgcn_sdot4((int)aw, (int)cl[i], acc[i], false); acc[4 + i] = __builtin_amdgcn_sdot4((int)aw, (int)ch[i], acc[4 + i], false); }
            { const size_t oo = (j + PD < 32) ? o + (size_t)(j + PD) * 64 : on + (size_t)(j + PD - 32) * 64;
              iq[j % PD] = *(const GAS v4u*)(ibase + oo); aq[j % PD] = abase[oo]; }
            __builtin_amdgcn_sched_barrier(0);
        }
        const float asc = F.ASCALE()[t];
        float accf[8];
#pragma unroll
        for (int i = 0; i < 8; ++i) accf[i] = (float)acc[i] * asc;
        const v4u hb = *(const GAS v4u*)(F.HBT() + ((size_t)c * M + t) * 8);
        accf[0] += bf_lo(hb.x); accf[1] += bf_hi(hb.x); accf[2] += bf_lo(hb.y); accf[3] += bf_hi(hb.y);
        accf[4] += bf_lo(hb.z); accf[5] += bf_hi(hb.z); accf[6] += bf_lo(hb.w); accf[7] += bf_hi(hb.w);
        bf16* yp = (MODE == 0) ? F.Y() + ((size_t)c * M + t) * 8 : (bf16*)F.XN() + ((((size_t)c * M + t) * 8) & (size_t)0x1ffffff);
        *(GAS v4u*)yp = (v4u){pk2(accf[0], accf[1]), pk2(accf[2], accf[3]), pk2(accf[4], accf[5]), pk2(accf[6], accf[7])};
        float ss = 0.f;
#pragma unroll
        for (int i = 0; i < 8; ++i) ss += accf[i] * accf[i];
        if (do_atomic) atomicAdd(F.ROWSS2() + t, ss);
    }
#undef LROW
    __syncthreads();
}
__device__ __forceinline__ void final_unit(Frame& F, int unit) {
    const int tid = F.tid, blk = unit >> 3, cg = unit & 7, t0 = blk * 64;
    LAS float* T = (LAS float*)F.lds;
#pragma unroll
    for (int i = 0; i < 4; ++i) { const int pid = tid + 512 * i, cl = pid >> 6, tok = pid & 63;
        const v4u v = *(const GAS v4u*)(F.Y() + ((size_t)(cg * 32 + cl) * M + t0 + tok) * 8);
        *(LAS f32x4*)(T + tok * 260 + cl * 8) = (f32x4){bf_lo(v.x), bf_hi(v.x), bf_lo(v.y), bf_hi(v.y)};
        *(LAS f32x4*)(T + tok * 260 + cl * 8 + 4) = (f32x4){bf_lo(v.z), bf_hi(v.z), bf_lo(v.w), bf_hi(v.w)}; }
    __syncthreads();
#pragma unroll
    for (int i = 0; i < 8; ++i) { const int pid = tid + 512 * i, tok = pid >> 6, c4 = pid & 63;
        const float rs = __builtin_amdgcn_rsqf(F.ROWSS2()[t0 + tok] * (1.0f / D) + 1e-6f);
        const f32x4 v = *(const LAS f32x4*)(T + tok * 260 + c4 * 4);
        const f32x4 g = *(const GAS f32x4*)(F.A.in[20] + cg * 256 + c4 * 4);
        *(GAS f32x4*)(F.A.out + (size_t)(t0 + tok) * D + cg * 256 + c4 * 4) = v * rs * g; }
    __syncthreads();
}
__global__ void __launch_bounds__(NWAVES * 64, 2) mk_fwd(Args args) {
    __shared__ __attribute__((aligned(16))) unsigned char lds[LDS_BYTES];
    Frame F(args);
    F.lds = (LAS unsigned char*)lds;
    F.MISC = (volatile LAS unsigned*)(F.lds + MISC_OFF);
    F.tid = threadIdx.x; F.lane = F.tid & 63; F.wave = __builtin_amdgcn_readfirstlane(F.tid >> 6);
    F.G = gridDim.x; { const int bx = blockIdx.x; F.vcu = (F.G % 8 == 0) ? (bx % 8) * (F.G / 8) + bx / 8 : bx; }
    F.ws = args.ws;
    F.ctl = (gu32*)(args.ws + WS_CTL);
    for (int u = F.tid; u < (LDS_BYTES - LDSCTL_OFF) / 4; u += NWAVES * 64) ((LAS unsigned*)(F.lds + LDSCTL_OFF))[u] = 0u;
    __syncthreads();
    XcdBarrier bar; bar.bar = (unsigned*)(F.ctl + CW_BAR); bar.x = 0; bar.st = nullptr;
    if (N_LAUNCHES != PER_PHASE) bar = xcd_barrier_post((unsigned*)(F.ctl + CW_BAR), F.MISC + 8);
#define GRID_BAR() do { if (N_LAUNCHES != PER_PHASE) xcd_barrier(bar); } while (0)
    const int lo = args.ph_lo, hi = args.ph_hi;
#ifndef MK_PHASE_MASK
#define MK_PHASE_MASK 0x7FF
#endif
#define IN(k) (((MK_PHASE_MASK >> (k)) & 1) && lo <= (k) && (k) < hi)
#undef MK_PHASE_MASK
#define MK_PHASE_MASK 0xFFFF
#define BOTH(k) (true)
#ifndef MK_REP_MASK
#define MK_REP_MASK 0
#endif
#ifndef MK_REP_N
#define MK_REP_N 2
#endif
#ifndef H8_REP
#define H8_REP 1
#endif
#define REPS(k) for (int rep_ = 0; rep_ < ((((MK_REP_MASK) >> (k)) & 1) ? 1 + MK_REP_N : 1); ++rep_)
    const int gw = F.vcu * NWAVES + F.wave, NGW = F.G * NWAVES;
    if (IN(0)) { REPS(0) { p0_prologue(F); __syncthreads(); } if (BOTH(0)) GRID_BAR(); }
    if (IN(1)) {
        pg8::Gemm g{F.XN(), F.WIN(), M, NIN, D}; pg8::StaticOrder S; S.init(M, NIN, F.G, (int)blockIdx.x);
        pg8::EpiZ E{F.Z(), NIN, LW};
        REPS(1) pg8::gemm_phase<pg8::EpiZ, pg8::StaticOrder, true, true>(F.lds, g, S, E);
        if (BOTH(1)) GRID_BAR();
    }
    if (IN(2)) {
        REPS(12) { v4u xr[5]; int u = blockIdx.x; lru_prefetch(F, u, F.tid, xr);
                   for (; u < BATCH * NCHUNK * 8; u += F.G) lru_fused_unit(F, u, u + F.G < BATCH * NCHUNK * 8 ? u + F.G : -1, xr); }
        asm volatile("" : "+v"(F.tid), "+v"(F.lane));
        REPS(13) for (int u = blockIdx.x; u < BATCH * NCHUNK; u += F.G) gmlp_unit(F, u);
        if (BOTH(2)) GRID_BAR();
    }
    if (IN(4)) {
        pg8::Gemm g{F.MIX(), F.WOUT(), M, D, D}; pg8::StaticOrder S; S.init(M, D, F.G, (int)blockIdx.x);
        pg8::EpiH E{F.HB(), F.HBT(), F.A.in[0], F.ROWSS(), D, M};
        pg8::gemm_phase<pg8::EpiH, pg8::StaticOrder, true, true>(F.lds, g, S, E);
        if (BOTH(4)) GRID_BAR();
    }
    if (IN(5)) {
        pg8::Gemm g{F.HB(), F.WQ(), M, D, D}; pg8::StaticOrder S; S.init(M, D, F.G, (int)blockIdx.x);
        pg8::EpiQ E{F.QH(), F.ROWSS(), D};
        REPS(5) pg8::gemm_phase<pg8::EpiQ, pg8::StaticOrder, true, true>(F.lds, g, S, E);
        if (BOTH(5)) GRID_BAR();
    }
    if (IN(6)) {
        REPS(6) { int hk = 0;
                  for (int wu = gw; wu < (M / 32) * 8; wu += NGW) { const bool doh = gw + NGW * (hk + 3) < M; topk_unit(F, wu, doh, gw + NGW * hk, NGW); if (doh) hk += 4; }
                  for (int t = gw + NGW * hk; t < M; t += NGW) h8_row(F, t); }
        if (BOTH(6)) GRID_BAR();
    }
    if (IN(7)) {
        REPS(7) peer_u_xcd(F);
        if (BOTH(7)) GRID_BAR();
    }
    if (IN(8)) {
        REPS(8) for (int t = gw; t < M; t += NGW) peer_act_token(F, t);
        if (BOTH(8)) GRID_BAR();
    }
    if (IN(9)) {
        for (int c = blockIdx.x; c < D / 8; c += F.G) peer_v_slice<0>(F, c, true);
        if ((MK_REP_MASK >> 9) & 1) { for (int rep_ = 0; rep_ < MK_REP_N; ++rep_) for (int c = blockIdx.x; c < D / 8; c += F.G) peer_v_slice<1>(F, c, false); }
        if (BOTH(9)) GRID_BAR();
    }
    if (IN(10)) {
        REPS(10) for (int u = blockIdx.x; u < (M / 64) * 8; u += F.G) final_unit(F, u);
    }
#undef IN
#undef BOTH
#undef GRID_BAR
}

extern "C" void kernel_launch(void* const* d_in, const int* in_sizes, int n_in, void* d_out, int out_size, void* d_ws, size_t ws_size, hipStream_t stream) {
    static int grid = 0;
    if (grid == 0) {
        if (n_in != 21 || in_sizes[0] != M * D || out_size != M * D || ws_size < WS_END) { fprintf(stderr, "kernel_launch: unexpected shapes (n_in %d, in0 %d, out %d, ws %zu)\n", n_in, n_in > 0 ? in_sizes[0] : -1, out_size, ws_size); grid = -1; return; }
        int dev = 0, cus = 0, per_cu = 0;
        if (hipGetDevice(&dev) != hipSuccess || hipDeviceGetAttribute(&cus, hipDeviceAttributeMultiprocessorCount, dev) != hipSuccess) { grid = -1; return; }
        if (hipOccupancyMaxActiveBlocksPerMultiprocessor(&per_cu, (const void*)mk_fwd, NWAVES * 64, 0) != hipSuccess || per_cu < 1) { fprintf(stderr, "kernel_launch: occupancy query reports %d blocks per CU\n", per_cu); }
        (void)hipGetLastError();
        grid = cus;
        if (cus < 256) { fprintf(stderr, "kernel_launch: the RG-LRU family hand-off needs >= 256 co-resident workgroups (have %d)\n", cus); grid = -1; return; }
    }
    if (grid < 0) return;
    (void)hipMemsetAsync((char*)d_ws + WS_CTL, 0, CTL_ZERO_BYTES, stream);
    Args a{};
    for (int i = 0; i < 21; ++i) a.in[i] = (const float*)d_in[i];
    a.out = (float*)d_out; a.ws = (unsigned char*)d_ws;
    for (int li = 0; li < N_LAUNCHES; ++li) {
        a.ph_lo = 0; a.ph_hi = 99;
        hipLaunchKernelGGL(mk_fwd, dim3(grid), dim3(NWAVES * 64), 0, stream, a);
    }
}
```

```cpp
#include <hip/hip_runtime.h>
#include <cstdio>
#include <cstdint>
namespace pg8 {
#define PG8_LAS __attribute__((address_space(3)))
typedef unsigned short bf16_t;
typedef short bf16x8 __attribute__((ext_vector_type(8)));
typedef float f32x4 __attribute__((ext_vector_type(4)));
typedef unsigned u32x4 __attribute__((ext_vector_type(4)));
constexpr int BM = 256, BK = 64, HALF = 128, HTB = HALF * BK * 2  , STAGE_BYTES = 8 * HTB, NXCD = 8, WGM = 8;

__host__ __device__ __forceinline__ int lds_byte(int r, int c) { const int st = (r >> 4) * 2 + (c >> 5), rr = r & 15, cc = c & 31, ob = rr * 64 + cc * 2; return st * 1024 + (ob ^ (((ob >> 9) & 1) << 5)); }
__host__ __device__ __forceinline__ void stage_rc(int b, int& R, int& C) { const int st = b / 1024, sb = b % 1024, swz = sb ^ (((sb >> 9) & 1) << 5); R = (st >> 1) * 16 + swz / 64; C = (st & 1) * 32 + (swz % 64) / 2; }
__host__ __device__ __forceinline__ int perm32(int rho) { const int n = rho >> 4, i = rho & 15; return 8 * (i >> 2) + 4 * n + (i & 3); }

struct Unit { int pm, pn; };
struct Gemm { const bf16_t* A; const bf16_t* Bt; int M, N, K; };

struct StaticOrder {
    int nM, nN, nwg, G, c;
    __host__ __device__ void init(int M, int N, int G_, int c_) { nM = M / BM; nN = N / BM; nwg = nM * nN; G = G_; c = c_; }
    __host__ __device__ bool next(int i, Unit& u) const {
        const long L = (long)i * G + c; if (L >= nwg) return false;
        int wgid = (int)L; { const int q = nwg / NXCD, r = nwg % NXCD, xcd = wgid % NXCD, off = wgid / NXCD; wgid = (xcd < r ? xcd * (q + 1) : r * (q + 1) + (xcd - r) * q) + off; }
        const int nig = WGM * nN, gid = wgid / nig, fm = gid * WGM, gsz = (nM - fm) < WGM ? (nM - fm) : WGM;
        u.pm = fm + ((wgid % nig) % gsz); u.pn = (wgid % nig) / gsz; return true;
    }
    __device__ __forceinline__ void a_ready(const Unit&) const {}
    __device__ __forceinline__ void done(const Unit&) const {}
};

__device__ __forceinline__ unsigned cvt_pk_bf16(float lo, float hi) { unsigned r; asm volatile("v_cvt_pk_bf16_f32 %0, %1, %2" : "=v"(r) : "v"(lo), "v"(hi)); return r; }
__device__ __forceinline__ float gelu_tanh(float x) {
    const float t = x * (1.0f + 0.044715f * x * x);
    const float e = __builtin_amdgcn_exp2f(-2.3022081983f * t);
    return x * __builtin_amdgcn_rcpf(1.0f + e);
}
struct EpiZ {
    static constexpr bool PERM = true, AFTER_DRAIN = false;
    bf16_t* O; int ldc; int gelu_from;
    __device__ __forceinline__ void operator()(const f32x4 (&acc)[2][2][4][2], const Unit& u, int wr, int wc, int fr, int fq) const {
        const int row0 = u.pm * BM + wr * 64 + fr; const int col0 = u.pn * BM + wc * 32 + 8 * fq;
        const bool act = (u.pn * BM) >= gelu_from;
#pragma unroll
        for (int ai = 0; ai < 2; ++ai)
#pragma unroll
            for (int m = 0; m < 4; ++m) { bf16_t* rowp = O + (size_t)(row0 + ai * HALF + m * 16) * ldc + col0;
#pragma unroll
                for (int bj = 0; bj < 2; ++bj) { f32x4 v0 = acc[ai][bj][m][0], v1 = acc[ai][bj][m][1];
                    if (act) {
#pragma unroll
                        for (int j = 0; j < 4; ++j) { v0[j] = gelu_tanh(v0[j]); v1[j] = gelu_tanh(v1[j]); } }
                    u32x4 w; w.x = cvt_pk_bf16(v0[0], v0[1]); w.y = cvt_pk_bf16(v0[2], v0[3]); w.z = cvt_pk_bf16(v1[0], v1[1]); w.w = cvt_pk_bf16(v1[2], v1[3]);
                    *(u32x4*)(rowp + bj * HALF) = w; } }
    }
};
struct EpiH {
    static constexpr bool PERM = true, AFTER_DRAIN = false;
    bf16_t* O; bf16_t* OT; const float* X; float* rowss; int ldc; int mrows;
    __device__ __forceinline__ void operator()(const f32x4 (&acc)[2][2][4][2], const Unit& u, int wr, int wc, int fr, int fq) const {
        const int row0 = u.pm * BM + wr * 64 + fr; const int col0 = u.pn * BM + wc * 32 + 8 * fq;
#pragma unroll
        for (int ai = 0; ai < 2; ++ai)
#pragma unroll
            for (int m = 0; m < 4; ++m) { const int row = row0 + ai * HALF + m * 16; const size_t off = (size_t)row * ldc + col0; float ss = 0.f;
#pragma unroll
                for (int bj = 0; bj < 2; ++bj) {
                    const f32x4 x0 = *(const f32x4*)(X + off + bj * HALF), x1 = *(const f32x4*)(X + off + bj * HALF + 4);
                    const f32x4 v0 = acc[ai][bj][m][0] + x0, v1 = acc[ai][bj][m][1] + x1;
                    ss += (v0[0] * v0[0] + v0[1] * v0[1]) + (v0[2] * v0[2] + v0[3] * v0[3]) + (v1[0] * v1[0] + v1[1] * v1[1]) + (v1[2] * v1[2] + v1[3] * v1[3]);
                    u32x4 w; w.x = cvt_pk_bf16(v0[0], v0[1]); w.y = cvt_pk_bf16(v0[2], v0[3]); w.z = cvt_pk_bf16(v1[0], v1[1]); w.w = cvt_pk_bf16(v1[2], v1[3]);
                    *(u32x4*)(O + off + bj * HALF) = w;
                    *(u32x4*)(OT + ((size_t)((col0 + bj * HALF) >> 3) * mrows + row) * 8) = w; }
                ss += __shfl_xor(ss, 16); ss += __shfl_xor(ss, 32);
                if (fq == 0) atomicAdd(rowss + row, ss); }
    }
};
struct EpiQ {
    static constexpr bool PERM = true, AFTER_DRAIN = false;
    bf16_t* QH; const float* rowss; int ldc;
    __device__ __forceinline__ void operator()(const f32x4 (&acc)[2][2][4][2], const Unit& u, int wr, int wc, int fr, int fq) const {
        const int row0 = u.pm * BM + wr * 64 + fr, col0 = u.pn * BM + wc * 32 + 8 * fq;
#pragma unroll
        for (int ai = 0; ai < 2; ++ai)
#pragma unroll
            for (int m = 0; m < 4; ++m) { const int row = row0 + ai * HALF + m * 16; const float rs = __builtin_amdgcn_rsqf(rowss[row] * (1.0f / 2048.0f) + 1e-6f);
                const size_t off = (size_t)row * ldc + col0;
#pragma unroll
                for (int bj = 0; bj < 2; ++bj) { const f32x4 v0 = acc[ai][bj][m][0] * rs, v1 = acc[ai][bj][m][1] * rs;
                    u32x4 wh; wh.x = cvt_pk_bf16(v0[0], v0[1]); wh.y = cvt_pk_bf16(v0[2], v0[3]); wh.z = cvt_pk_bf16(v1[0], v1[1]); wh.w = cvt_pk_bf16(v1[2], v1[3]);
                    *(u32x4*)(QH + off + bj * HALF) = wh; } }
    }
};
template <class Epi, class Sched, bool ALIGN_EPI = false, bool SP2 = false>
__device__ __forceinline__ void gemm_phase(PG8_LAS unsigned char* lds, const Gemm g, const Sched& S, const Epi& E) {
    const int tid = threadIdx.x, wid = __builtin_amdgcn_readfirstlane(tid >> 6), lane = tid & 63, wr = wid >> 2, wc = wid & 3, fr = lane & 15, fq = lane >> 4;
    const int K = g.K, nt = K / BK;
    unsigned voffA[2], voffB[2];
#pragma unroll
    for (int i = 0; i < 2; ++i) { int R, C; stage_rc(tid * 16 + i * 8192, R, C); const int Rb = Epi::PERM ? ((R & ~31) + perm32(R & 31)) : R;
        voffA[i] = (unsigned)(R * K + C) * 2u; voffB[i] = (unsigned)(Rb * K + C) * 2u; }
    const size_t kstep = (size_t)(BK * 2);
    const size_t hstep = (size_t)HALF * K * 2;
    const size_t tstep = 2 * hstep;
    const unsigned ldsw = (unsigned)wid * 1024u;
    const int aoff = lds_byte(wr * 64 + fr, fq * 8), boff = lds_byte(wc * 32 + fr, fq * 8);
#define PG8_SA(b, h) (((b) * 2 + (h)) * HTB)
#define PG8_SB(b, h) ((4 + (b) * 2 + (h)) * HTB)
#define PG8_STAGE(bufoff, gbase, voff) do { _Pragma("unroll") for (int _i = 0; _i < 2; ++_i) \
        __builtin_amdgcn_global_load_lds((const unsigned*)((const char*)(gbase) + (voff)[_i]), (PG8_LAS unsigned*)(lds + (bufoff) + ldsw + _i * 8192), 16, 0, 0); } while (0)
#define PG8_LDA(dst, b, h) do { _Pragma("unroll") for (int m = 0; m < 4; ++m) _Pragma("unroll") for (int k = 0; k < 2; ++k) dst[m][k] = *(const PG8_LAS bf16x8*)(lds + PG8_SA(b, h) + aoff + m * 2048 + k * 1024); } while (0)
#define PG8_LDB(dst, b, h) do { _Pragma("unroll") for (int n = 0; n < 2; ++n) _Pragma("unroll") for (int k = 0; k < 2; ++k) dst[n][k] = *(const PG8_LAS bf16x8*)(lds + PG8_SB(b, h) + boff + n * 2048 + k * 1024); } while (0)
#define PG8_MMA(ai, bj, At, Bt) do { __builtin_amdgcn_s_setprio(1); _Pragma("unroll") for (int m = 0; m < 4; ++m) _Pragma("unroll") for (int n = 0; n < 2; ++n) _Pragma("unroll") for (int k = 0; k < 2; ++k) \
        acc[ai][bj][m][n] = __builtin_amdgcn_mfma_f32_16x16x32_bf16(Bt[n][k], At[m][k], acc[ai][bj][m][n], 0, 0, 0); __builtin_amdgcn_s_setprio(0); } while (0)
#define PG8_WAIT_V(n) asm volatile("s_waitcnt vmcnt(" #n ")" ::: "memory")
#define PG8_WAIT_L(n) asm volatile("s_waitcnt lgkmcnt(" #n ")" ::: "memory")
#define PG8_BAR __builtin_amdgcn_s_barrier()
#define PG8_SCHED __builtin_amdgcn_sched_barrier(0)
    Unit cur, nxt; int ui = 0;
    if (!S.next(0, cur)) return;
    f32x4 acc[2][2][4][2];
#pragma unroll
    for (int a = 0; a < 2; ++a)
#pragma unroll
        for (int b = 0; b < 2; ++b)
#pragma unroll
            for (int m = 0; m < 4; ++m)
#pragma unroll
                for (int n = 0; n < 2; ++n) acc[a][b][m][n] = (f32x4){0.f, 0.f, 0.f, 0.f};
    bf16x8 At[4][2], B0[2][2], B1[2][2];
    const char* cA = (const char*)g.A + (size_t)cur.pm * tstep; const char* cB = (const char*)g.Bt + (size_t)cur.pn * tstep;
    S.a_ready(cur);
    if constexpr (SP2) {
        PG8_STAGE(PG8_SB(0, 0), cB, voffB); PG8_STAGE(PG8_SB(0, 1), cB + hstep, voffB); PG8_STAGE(PG8_SA(0, 0), cA, voffA); PG8_STAGE(PG8_SA(0, 1), cA + hstep, voffA);
        if (wr == 1) PG8_BAR;
        PG8_WAIT_V(2); PG8_BAR;
        PG8_STAGE(PG8_SB(1, 0), cB + kstep, voffB); PG8_STAGE(PG8_SA(1, 0), cA + kstep, voffA); PG8_STAGE(PG8_SB(1, 1), cB + hstep + kstep, voffB);
        PG8_WAIT_V(6); PG8_BAR;
    } else {
        PG8_STAGE(PG8_SB(0, 0), cB, voffB); PG8_STAGE(PG8_SA(0, 0), cA, voffA); PG8_STAGE(PG8_SB(0, 1), cB + hstep, voffB); PG8_STAGE(PG8_SA(0, 1), cA + hstep, voffA);
        if (wr == 1) PG8_BAR;
        PG8_WAIT_V(4); PG8_BAR;
        PG8_STAGE(PG8_SB(1, 0), cB + kstep, voffB); PG8_STAGE(PG8_SA(1, 0), cA + kstep, voffA); PG8_STAGE(PG8_SB(1, 1), cB + hstep + kstep, voffB);
        PG8_WAIT_V(6); PG8_BAR;
    }
    for (;;) {
        const bool has_next = S.next(ui + 1, nxt);
        const char* nA = has_next ? (const char*)g.A + (size_t)nxt.pm * tstep : cA; const char* nB = has_next ? (const char*)g.Bt + (size_t)nxt.pn * tstep : cB;
        for (int t = 0; t < nt; t += 2) {
            const bool last = (t == nt - 2);
            const char* a1 = cA + (size_t)(t + 1) * kstep;
            const char* a2 = last ? nA : cA + (size_t)(t + 2) * kstep; const char* b2 = last ? nB : cB + (size_t)(t + 2) * kstep;
            const char* a3 = a2 + kstep; const char* b3 = b2 + kstep;
            if (last && has_next) S.a_ready(nxt);
            if constexpr (SP2) {
            PG8_LDB(B0, 0, 0); PG8_LDB(B1, 0, 1); PG8_SCHED; PG8_LDA(At, 0, 0); PG8_STAGE(PG8_SA(1, 1), a1 + hstep, voffA);
            PG8_WAIT_V(8); PG8_WAIT_L(0); PG8_BAR; PG8_MMA(0, 0, At, B0); PG8_MMA(0, 1, At, B1); PG8_BAR; PG8_SCHED;
            PG8_LDA(At, 0, 1); PG8_STAGE(PG8_SB(0, 0), b2, voffB); PG8_STAGE(PG8_SB(0, 1), b2 + hstep, voffB); PG8_STAGE(PG8_SA(0, 0), a2, voffA);
            PG8_WAIT_V(8); PG8_WAIT_L(0); PG8_BAR; PG8_MMA(1, 0, At, B0); PG8_MMA(1, 1, At, B1); PG8_BAR; PG8_SCHED;
            PG8_LDB(B0, 1, 0); PG8_LDB(B1, 1, 1); PG8_SCHED; PG8_LDA(At, 1, 0); PG8_STAGE(PG8_SA(0, 1), a2 + hstep, voffA);
            PG8_WAIT_V(8); PG8_WAIT_L(0); PG8_BAR; PG8_MMA(0, 0, At, B0); PG8_MMA(0, 1, At, B1); PG8_BAR; PG8_SCHED;
            PG8_LDA(At, 1, 1); PG8_STAGE(PG8_SB(1, 0), b3, voffB); PG8_STAGE(PG8_SB(1, 1), b3 + hstep, voffB); PG8_STAGE(PG8_SA(1, 0), a3, voffA);
            PG8_WAIT_V(8); PG8_WAIT_L(0); PG8_BAR; PG8_MMA(1, 0, At, B0); PG8_MMA(1, 1, At, B1); PG8_BAR; PG8_SCHED;
            } else {
            PG8_LDB(B0, 0, 0); PG8_SCHED; PG8_LDA(At, 0, 0); PG8_STAGE(PG8_SA(1, 1), a1 + hstep, voffA);
            PG8_WAIT_L(8); PG8_BAR; PG8_WAIT_L(0); PG8_MMA(0, 0, At, B0); PG8_BAR; PG8_SCHED;
            PG8_LDB(B1, 0, 1); PG8_STAGE(PG8_SB(0, 0), b2, voffB);
            PG8_BAR; PG8_WAIT_L(0); PG8_MMA(0, 1, At, B1); PG8_BAR;
            PG8_LDA(At, 0, 1); PG8_STAGE(PG8_SA(0, 0), a2, voffA);
            PG8_BAR; PG8_WAIT_L(0); PG8_MMA(1, 0, At, B0); PG8_BAR; PG8_SCHED;
            PG8_STAGE(PG8_SB(0, 1), b2 + hstep, voffB);
            PG8_WAIT_V(6); PG8_BAR; PG8_MMA(1, 1, At, B1); PG8_BAR;
            PG8_LDB(B0, 1, 0); PG8_SCHED; PG8_LDA(At, 1, 0); PG8_STAGE(PG8_SA(0, 1), a2 + hstep, voffA);
            PG8_WAIT_L(8); PG8_BAR; PG8_WAIT_L(0); PG8_MMA(0, 0, At, B0); PG8_BAR; PG8_SCHED;
            PG8_LDB(B1, 1, 1); PG8_STAGE(PG8_SB(1, 0), b3, voffB);
            PG8_BAR; PG8_WAIT_L(0); PG8_MMA(0, 1, At, B1); PG8_BAR;
            PG8_LDA(At, 1, 1); PG8_STAGE(PG8_SA(1, 0), a3, voffA);
            PG8_BAR; PG8_WAIT_L(0); PG8_MMA(1, 0, At, B0); PG8_BAR; PG8_SCHED;
            PG8_STAGE(PG8_SB(1, 1), b3 + hstep, voffB);
            PG8_WAIT_V(6); PG8_BAR; PG8_MMA(1, 1, At, B1); PG8_BAR;
            }
        }
        if constexpr (ALIGN_EPI) { if (wr == 0) PG8_BAR; }
        if constexpr (!Epi::AFTER_DRAIN) { E(acc, cur, wr, wc, fr, fq); S.done(cur); }
        if (!has_next) break;
#pragma unroll
        for (int a = 0; a < 2; ++a)
#pragma unroll
            for (int b = 0; b < 2; ++b)
#pragma unroll
                for (int m = 0; m < 4; ++m)
#pragma unroll
                    for (int n = 0; n < 2; ++n) acc[a][b][m][n] = (f32x4){0.f, 0.f, 0.f, 0.f};
        cur = nxt; cA = nA; cB = nB; ++ui;
        if constexpr (ALIGN_EPI) { if (wr == 1) PG8_BAR; }
    }
    PG8_WAIT_V(0);
    if constexpr (!ALIGN_EPI) { if (wr == 0) PG8_BAR; }
    PG8_BAR;
    if constexpr (Epi::AFTER_DRAIN) { E.fused(acc, cur, wr, wc, fr, fq, lds, wid, lane); S.done(cur); }
#undef PG8_SA
#undef PG8_SB
#undef PG8_STAGE
#undef PG8_LDA
#undef PG8_LDB
#undef PG8_MMA
#undef PG8_WAIT_V
#undef PG8_WAIT_L
#undef PG8_BAR
#undef PG8_SCHED
}
}
constexpr int NWAVES = 8;
constexpr int BATCH = 4, SEQ = 8192, D = 2048, M = BATCH * SEQ, NIN = 4096, LW = 1024, CHUNK = 128, NCHUNK = SEQ / CHUNK;
constexpr int NEXP = 16384;
#ifndef MK_N_LAUNCHES
#define MK_N_LAUNCHES 1
#endif
constexpr int N_LAUNCHES = MK_N_LAUNCHES;
constexpr int PER_PHASE = 11;
constexpr size_t MiB = 1u << 20;
constexpr size_t WS_CTL = 48 * MiB, CTL_ZERO_BYTES = 5 * MiB;
constexpr size_t WS_ROWSS = WS_CTL + 512 * 1024;
constexpr size_t WS_WIN = 2 * MiB, WS_WOUT = 18 * MiB, WS_WQ = 26 * MiB, WS_LRUW = 34 * MiB, WS_WSB = 35 * MiB, WS_AGG = 49 * MiB;
constexpr size_t WS_U = 64 * MiB, WS_V = 128 * MiB, WS_XN = 192 * MiB  , WS_Z = 320 * MiB  ;
constexpr size_t WS_HB = 576 * MiB, WS_IDS = 704 * MiB, WS_GATES = 720 * MiB, WS_PAIRS = 736 * MiB, WS_HBT = 752 * MiB, WS_END = 884 * MiB;
constexpr size_t WS_USCALE = 40 * MiB, WS_VSCALE = 41 * MiB;
constexpr size_t WS_HSCALE = 44 * MiB, WS_CARRY = 45 * MiB;
constexpr size_t WS_H8 = WS_XN, WS_PART = WS_XN + 64 * MiB;
constexpr size_t WS_ASCALE = 42 * MiB, WS_KH = 43 * MiB;
constexpr size_t WS_IDW = WS_PAIRS, WS_AW = 880 * MiB;
constexpr size_t WS_ROWSS2 = WS_CTL + 640 * 1024;
constexpr size_t WS_Y = WS_Z;
constexpr int CW_BAR = 4096;
constexpr int CW_LRUF = 8192;
constexpr int RING_BYTES = 131072;
constexpr int LDSCTL_OFF = 143360, MISC_OFF = LDSCTL_OFF + 320;
constexpr int LDS_BYTES = 147456;
#define GAS __attribute__((address_space(1)))
#define LAS __attribute__((address_space(3)))
typedef unsigned short bf16;
typedef unsigned v4u __attribute__((ext_vector_type(4)));
typedef float f32x4 __attribute__((ext_vector_type(4)));
typedef short bf16x8 __attribute__((ext_vector_type(8)));
typedef GAS unsigned gu32;
typedef GAS unsigned long long gu64;
#define RLX_AGENT __ATOMIC_RELAXED, __HIP_MEMORY_SCOPE_AGENT
#define LDS_WAIT() asm volatile("s_waitcnt lgkmcnt(0)" ::: "memory")
#define VM_WAIT() asm volatile("s_waitcnt vmcnt(0)" ::: "memory")
__device__ __forceinline__ unsigned long long rt() { return __builtin_amdgcn_s_memrealtime(); }
__device__ __forceinline__ unsigned f2bf(float f) { unsigned u = __builtin_bit_cast(unsigned, f); return (u + 0x7fffu + ((u >> 16) & 1u)) >> 16; }
__device__ __forceinline__ unsigned pk2(float lo, float hi) { return f2bf(lo) | (f2bf(hi) << 16); }

#define XB_TMO      128
#define XB_XCNT(j)  (256  + 64 * (j))
#define XB_XSUB(j)  (1280 + 64 * (j))
#define XB_XGEN(j)  (2304 + 64 * (j))
#define XB_TOP      3328
#define XB_TOPGEN   3392
#define XCD_BAR_WORDS 3456
#define XB_SPIN_CAP (1u << 18)

__device__ __forceinline__ unsigned xb_ld(unsigned* p)              { return __hip_atomic_load(p, __ATOMIC_RELAXED, __HIP_MEMORY_SCOPE_AGENT); }
__device__ __forceinline__ unsigned xb_add(unsigned* p, unsigned v) { return __hip_atomic_fetch_add(p, v, __ATOMIC_RELAXED, __HIP_MEMORY_SCOPE_AGENT); }
__device__ __forceinline__ unsigned xb_xcc_id() { return (unsigned)__builtin_amdgcn_s_getreg((3 << 11) | 20) & 0xFu; }
#define XB_SPIN(cond, bar) do { unsigned _sp = 0; while (cond) { __builtin_amdgcn_s_sleep(1); \
    if ((++_sp & 255u) == 0u) { if (xb_ld(&(bar)[XB_TMO])) break; if (_sp > XB_SPIN_CAP) { atomicAdd(&(bar)[XB_TMO], 1u); break; } } } } while (0)

struct XcdBarrier {
    unsigned* bar; unsigned x;
    volatile LAS unsigned* st;
};

__device__ __forceinline__ XcdBarrier xcd_barrier_post(unsigned* bar, volatile LAS unsigned* st) {
    XcdBarrier b; b.bar = bar; b.x = xb_xcc_id(); b.st = st;
    if (threadIdx.x == 0) (void)xb_add(&bar[XB_XCNT(b.x)], 1u);
    return b;
}
__device__ __forceinline__ void xcd_barrier_complete(unsigned* bar, unsigned x, unsigned& nloc, unsigned& nx) {
    const unsigned G = gridDim.x * gridDim.y * gridDim.z;
    unsigned sum, cnt, mine, sp = 0u;
    for (;;) {
        sum = 0u; cnt = 0u; mine = 0u;
#pragma unroll
        for (unsigned j = 0; j < 16; ++j) { const unsigned c = xb_ld(&bar[XB_XCNT(j)]); sum += c; cnt += (c > 0u) ? 1u : 0u; mine = (j == x) ? c : mine; }
        if (sum == G) break;
        __builtin_amdgcn_s_sleep(1);
        if ((++sp & 255u) == 0u) { if (xb_ld(&bar[XB_TMO])) break; if (sp > XB_SPIN_CAP) { atomicAdd(&bar[XB_TMO], 1u); break; } }
    }
    nloc = mine > 0u ? mine : 1u; nx = cnt > 0u ? cnt : 1u;
}

__device__ __forceinline__ void xcd_barrier(const XcdBarrier& b) {
    asm volatile("s_waitcnt vmcnt(0)" ::: "memory");
    __syncthreads();
    if (threadIdx.x == 0) {
        unsigned* bar = b.bar;
        __builtin_amdgcn_s_waitcnt(0);
        unsigned nloc = b.st[0], nx = b.st[1];
        if (nloc == 0u) { xcd_barrier_complete(bar, b.x, nloc, nx); b.st[0] = nloc; b.st[1] = nx; }
        const unsigned old = xb_add(&bar[XB_XSUB(b.x)], 1u);
        const unsigned gen = old / nloc;
        if (old + 1u == (gen + 1u) * nloc) {
            __builtin_amdgcn_fence(__ATOMIC_RELEASE, "agent");
            asm volatile("s_waitcnt vmcnt(0)" ::: "memory");
            const unsigned og = xb_add(&bar[XB_TOP], 1u);
            const unsigned tg = og / nx;
            if (og + 1u == (tg + 1u) * nx) xb_add(&bar[XB_TOPGEN], 1u);
            else XB_SPIN(xb_ld(&bar[XB_TOPGEN]) == tg, bar);
            __builtin_amdgcn_fence(__ATOMIC_ACQUIRE, "agent");
            xb_add(&bar[XB_XGEN(b.x)], 1u);
            asm volatile("s_waitcnt vmcnt(0)" ::: "memory");
        } else {
            XB_SPIN(xb_ld(&bar[XB_XGEN(b.x)]) == gen, bar);
            __builtin_amdgcn_fence(__ATOMIC_ACQUIRE, "agent");
            asm volatile("s_waitcnt vmcnt(0)" ::: "memory");
        }
    }
    __syncthreads();
}
typedef unsigned v2u __attribute__((ext_vector_type(2)));
typedef float f32x2 __attribute__((ext_vector_type(2)));
struct Args { const float* in[21]; float* out; unsigned char* ws; int ph_lo, ph_hi; };
struct Frame {
    const Args& A;
    LAS unsigned char* lds;
    volatile LAS unsigned* MISC;
    gu32* ctl;
    unsigned char* ws;
    int tid, lane, wave, vcu, G;
    __device__ __forceinline__ Frame(const Args& a) : A(a) {}
#define WSP(name, type, off) __device__ __forceinline__ type* name() const { return (type*)(ws + (off)); }
    WSP(WIN, bf16, WS_WIN) WSP(WOUT, bf16, WS_WOUT) WSP(WQ, bf16, WS_WQ) WSP(LRUW, bf16, WS_LRUW) WSP(WSB, bf16, WS_WSB)
    WSP(XN, bf16, WS_XN) WSP(MIX, bf16, WS_XN) WSP(Z, bf16, WS_Z) WSP(HB, bf16, WS_HB) WSP(HBT, bf16, WS_HBT)
    WSP(U8, unsigned char, WS_U) WSP(V8T, unsigned char, WS_V)
    WSP(ROWSS, float, WS_ROWSS) WSP(ROWSS2, float, WS_ROWSS2) WSP(QH, bf16, WS_Z) WSP(QL, bf16, WS_Z + 128 * MiB) WSP(KH, bf16, WS_KH) WSP(KL, bf16, WS_KH + 512 * 1024) WSP(AGG, float, WS_AGG) WSP(CARRY, float, WS_CARRY) WSP(AU, unsigned, WS_HB) WSP(GATES, float, WS_GATES)
    WSP(USCALE, float, WS_USCALE) WSP(VSCALE, float, WS_VSCALE) WSP(Y, bf16, WS_Y) WSP(IDS, int, WS_IDS) WSP(ASCALE, float, WS_ASCALE) WSP(IDW, v4u, WS_IDW) WSP(AW, unsigned, WS_AW) WSP(H8, unsigned char, WS_H8) WSP(HSCALE, float, WS_HSCALE) WSP(PART, int, WS_PART)
#undef WSP
};
__device__ __forceinline__ float wave_sum(float v) {
#pragma unroll
    for (int o = 1; o < 64; o <<= 1) v += __shfl_xor(v, o);
    return v;
}
__device__ __forceinline__ float bf_lo(unsigned w) { return __builtin_bit_cast(float, w << 16); }
__device__ __forceinline__ float bf_hi(unsigned w) { return __builtin_bit_cast(float, w & 0xffff0000u); }
__device__ __forceinline__ float bf1(unsigned short h) { return __builtin_bit_cast(float, (unsigned)h << 16); }
__device__ __forceinline__ float sigmoidf_(float x) { return __builtin_amdgcn_rcpf(1.0f + __builtin_amdgcn_exp2f(-1.4426950409f * x)); }
using pg8::gelu_tanh;
__device__ __forceinline__ unsigned pack_i8x4(float a, float b, float c, float d) {
    const int ia = (int)__builtin_rintf(a), ib = (int)__builtin_rintf(b), ic = (int)__builtin_rintf(c), id = (int)__builtin_rintf(d);
    return (unsigned)(ia & 0xff) | ((unsigned)(ib & 0xff) << 8) | ((unsigned)(ic & 0xff) << 16) | ((unsigned)id << 24);
}

__device__ __forceinline__ void p0_transpose_item(const float* W, int K, int N, bf16* WT, const float* kscale, LAS float* scr, int item, int lane) {
    const int nblk = N / 32, kb = item / nblk, nb = item % nblk, k0 = 64 * kb, n0 = 32 * nb;
#pragma unroll 8
    for (int i = 0; i < 32; ++i) { const int kk = 2 * i + (lane >> 5); const float sc = kscale ? kscale[k0 + kk] : 1.0f; scr[kk * 33 + (lane & 31)] = W[(size_t)(k0 + kk) * N + n0 + (lane & 31)] * sc; }
    LDS_WAIT(); asm volatile("" ::: "memory");
    const int c = lane & 7;
#pragma unroll
    for (int j = 0; j < 4; ++j) { const int n = (lane >> 3) + 8 * j; const LAS float* s = scr + (8 * c) * 33 + n;
        v4u o; o.x = pk2(s[0 * 33], s[1 * 33]); o.y = pk2(s[2 * 33], s[3 * 33]); o.z = pk2(s[4 * 33], s[5 * 33]); o.w = pk2(s[6 * 33], s[7 * 33]);
        *(GAS v4u*)(WT + (size_t)(n0 + n) * K + k0 + 8 * c) = o; }
    LDS_WAIT(); asm volatile("" ::: "memory");
}
__device__ __forceinline__ void p0_prologue(Frame& F) {
    LAS float* scr = (LAS float*)(F.lds + F.wave * 16384);
    const int gw = F.vcu * NWAVES + F.wave, NGW = F.G * NWAVES, lane = F.lane;
    constexpr int I_IN = (D / 64) * (NIN / 32), I_OUT = (D / 64) * (D / 32), I_Q = I_OUT, I_LRU = 32 * 8;
    constexpr int NITEMS = I_IN + I_OUT + I_Q + I_LRU;
    for (int it = gw; it < NITEMS; it += NGW) {
        int r = it;
        if (r < I_IN) { p0_transpose_item(F.A.in[2], D, NIN, F.WIN(), F.A.in[1], scr, r, lane); continue; } r -= I_IN;
        if (r < I_OUT) { p0_transpose_item(F.A.in[14], D, D, F.WOUT(), nullptr, scr, r, lane); continue; } r -= I_OUT;
        if (r < I_Q) { p0_transpose_item(F.A.in[16], D, D, F.WQ(), F.A.in[15], scr, r, lane); continue; } r -= I_Q;
        { const int mi = r >> 3, sub = r & 7, gate = mi >> 4, rest = mi & 15;
          const float* src = (gate ? F.A.in[7] : F.A.in[5]) + (size_t)rest * 16384;
          p0_transpose_item(src, 128, 128, F.LRUW() + (size_t)mi * 16384, nullptr, scr, sub, lane); }
    }
    const size_t gt = (size_t)gw * 64 + lane, NGT = (size_t)NGW * 64;
    {
        const float* g2 = F.A.in[15];
        f32x4 gg[8];
#pragma unroll
        for (int j = 0; j < 8; ++j) gg[j] = *(const GAS f32x4*)(g2 + j * 256 + lane * 4);
        for (int e = gw; e < NEXP; e += NGW) {
            const GAS f32x4* ur = (const GAS f32x4*)(F.A.in[18] + (size_t)e * D) + lane;
            f32x4 v[8]; float ss = 0.f;
#pragma unroll
            for (int j = 0; j < 8; ++j) { v[j] = __builtin_nontemporal_load(ur + 64 * j) * gg[j]; ss += (v[j].x * v[j].x + v[j].y * v[j].y) + (v[j].z * v[j].z + v[j].w * v[j].w); }
            const float rms = __builtin_amdgcn_sqrtf(wave_sum(ss) * (1.0f / D));
            const float sc = rms > 0.f ? 7.0f / (2.8f * rms) : 1.0f;
            GAS unsigned* o4 = (GAS unsigned*)(F.U8() + (size_t)e * 1024) + (lane >> 1);
#pragma unroll
            for (int j = 0; j < 8; ++j) {
                const int c0 = (int)fminf(fmaxf(__builtin_rintf(v[j].x * sc), -7.f), 7.f) & 15, c1 = (int)fminf(fmaxf(__builtin_rintf(v[j].y * sc), -7.f), 7.f) & 15;
                const int c2 = (int)fminf(fmaxf(__builtin_rintf(v[j].z * sc), -7.f), 7.f) & 15, c3 = (int)fminf(fmaxf(__builtin_rintf(v[j].w * sc), -7.f), 7.f) & 15;
                const unsigned cw = (unsigned)c0 | ((unsigned)c1 << 8) | ((unsigned)c2 << 16) | ((unsigned)c3 << 24);
                const unsigned pw = (unsigned)__shfl_xor((int)cw, 1);
                if ((lane & 1) == 0) __builtin_nontemporal_store(cw | (pw << 4), o4 + 32 * j);
            }
            if (lane == 0) F.USCALE()[e] = rms > 0.f ? 2.8f * rms * (1.0f / 7.0f) : 1.0f;
        }
    }
    __syncthreads();
    for (int un = blockIdx.x; un < NEXP / 64; un += F.G) {
        const int e0 = un * 64;
        for (int rr = 0; rr < 8; ++rr) {
            const int el = F.wave * 8 + rr, e = e0 + el;
            const GAS f32x4* vr = (const GAS f32x4*)(F.A.in[19] + (size_t)e * D) + lane;
            f32x4 v[8]; float mx = 0.f;
#pragma unroll
            for (int j = 0; j < 8; ++j) { v[j] = __builtin_nontemporal_load(vr + 64 * j); mx = fmaxf(mx, fmaxf(fmaxf(fabsf(v[j].x), fabsf(v[j].y)), fmaxf(fabsf(v[j].z), fabsf(v[j].w)))); }
#pragma unroll
            for (int o = 1; o < 64; o <<= 1) mx = fmaxf(mx, __shfl_xor(mx, o));
            const float sc = mx > 0.f ? 127.0f / mx : 1.0f;
#pragma unroll
            for (int j = 0; j < 8; ++j) *(LAS unsigned*)(F.lds + el * 2056 + j * 256 + lane * 4) = pack_i8x4(v[j].x * sc, v[j].y * sc, v[j].z * sc, v[j].w * sc);
            if (lane == 0) F.VSCALE()[e] = mx > 0.f ? mx * (1.0f / 127.0f) : 1.0f;
        }
        __syncthreads();
        for (int cc = 0; cc < 32; ++cc) { const int c = F.wave * 32 + cc;
            const v2u w = *(const LAS v2u*)(F.lds + lane * 2056 + c * 8);
            __builtin_nontemporal_store(w, (v2u*)(F.V8T() + ((size_t)c * NEXP + e0 + lane) * 8)); }
        __syncthreads();
    }
    for (size_t ch = gt; ch < (size_t)8 * 128 * 128 / 8; ch += NGT) {
        const size_t e0 = ch * 8;
        const f32x4 a = *(const GAS f32x4*)(F.A.in[12] + e0), b = *(const GAS f32x4*)(F.A.in[12] + e0 + 4);
        v4u o; o.x = pk2(a.x, a.y); o.y = pk2(a.z, a.w); o.z = pk2(b.x, b.y); o.w = pk2(b.z, b.w);
        *(GAS v4u*)(F.WSB() + e0) = o;
    }
    for (size_t ch = gt; ch < (size_t)16 * 128 * 128 / 8; ch += NGT) {
        const size_t e0 = ch * 8;
        const f32x4 a = *(const GAS f32x4*)(F.A.in[17] + e0), b = *(const GAS f32x4*)(F.A.in[17] + e0 + 4);
        v4u hi; hi.x = pk2(a.x, a.y); hi.y = pk2(a.z, a.w); hi.z = pk2(b.x, b.y); hi.w = pk2(b.z, b.w);
        *(GAS v4u*)(F.KH() + e0) = hi;
    }
    for (int m = gw; m < M; m += NGW) {
        const GAS f32x4* xr = (const GAS f32x4*)(F.A.in[0] + (size_t)m * D) + lane;
        f32x4 v[8]; float s = 0.f;
#pragma unroll
        for (int j = 0; j < 8; ++j) { v[j] = __builtin_nontemporal_load(xr + 64 * j); s += (v[j].x * v[j].x + v[j].y * v[j].y) + (v[j].z * v[j].z + v[j].w * v[j].w); }
        const float rstd = __builtin_amdgcn_rsqf(wave_sum(s) * (1.f / D) + 1e-6f);
        GAS unsigned long long* o8 = (GAS unsigned long long*)(F.XN() + (size_t)m * D) + lane;
#pragma unroll
        for (int j = 0; j < 8; ++j) o8[64 * j] = (unsigned long long)pk2(v[j].x * rstd, v[j].y * rstd) | ((unsigned long long)pk2(v[j].z * rstd, v[j].w * rstd) << 32);
    }
}
constexpr int LRU_XR = 0, LRU_XC = 33792, LRU_GR = 33792 + 40960;
constexpr float LOG2E = 1.4426950408889634f;
__device__ __forceinline__ int xc_off(int tok, int ch) { return tok * 320 + (tok >> 5) * 16 + ch * 2; }
template <bool APPLY, int DIR>
__device__ __forceinline__ void lru_dir(Frame& F, int unit, int b, int c, int h, const bf16x8 (&Ba)[4], const bf16x8 (&Bx)[4], float (&hsum)[8][4]) {
    const int lane = F.lane, w = F.wave, fr = lane & 15, fq = lane >> 4;
    LAS unsigned char* XC = F.lds + LRU_XC;
    const int chl = 16 * w + fr, chg = h * 128 + chl;
    v4u* au = (v4u*)F.AU() + ((size_t)((unit * 2 + DIR) * NWAVES + w) * 8) * 64 + lane;
    f32x4 R[8], I[8];
    float carry = 0.f;
    if (APPLY) {
        carry = F.CARRY()[(size_t)((b * 2 + DIR) * NCHUNK + c) * LW + chg];
        v4u q[8];
#pragma unroll
        for (int m = 0; m < 8; ++m) q[m] = __builtin_nontemporal_load(au + m * 64);
#pragma unroll
        for (int m = 0; m < 8; ++m) {
            R[m] = (f32x4){__builtin_amdgcn_exp2f(bf_lo(q[m].x)), __builtin_amdgcn_exp2f(bf_lo(q[m].y)), __builtin_amdgcn_exp2f(bf_lo(q[m].z)), __builtin_amdgcn_exp2f(bf_lo(q[m].w))};
            I[m] = (f32x4){bf_hi(q[m].x), bf_hi(q[m].y), bf_hi(q[m].z), bf_hi(q[m].w)}; }
    } else {
        const float ba = F.A.in[6][DIR * LW + chg], bx = F.A.in[8][DIR * LW + chg], lam = F.A.in[9][DIR * LW + chg];
        const float cl = -8.0f * log1pf(__expf(-lam)) * LOG2E;
        const int arow = (fr >> 2) * 32 + (fr & 3);
#pragma unroll
        for (int m = 0; m < 8; ++m) {
            R[m] = (f32x4){0.f, 0.f, 0.f, 0.f}; I[m] = (f32x4){0.f, 0.f, 0.f, 0.f};
#pragma unroll
            for (int ks = 0; ks < 4; ++ks) {
                const bf16x8 a = *(const LAS bf16x8*)(XC + xc_off(arow + 4 * m, 32 * ks + 8 * fq));
                R[m] = __builtin_amdgcn_mfma_f32_16x16x32_bf16(a, Ba[ks], R[m], 0, 0, 0);
                I[m] = __builtin_amdgcn_mfma_f32_16x16x32_bf16(a, Bx[ks], I[m], 0, 0, 0);
            }
        }
#pragma unroll
        for (int m = 0; m < 8; ++m) {
            float la[4];
#pragma unroll
            for (int j = 0; j < 4; ++j) {
                const float r = sigmoidf_(R[m][j] + ba), ig = sigmoidf_(I[m][j] + bx);
                la[j] = cl * r;
                const float a = __builtin_amdgcn_exp2f(la[j]);
                const float xc = bf1(*(const LAS unsigned short*)(XC + xc_off(32 * fq + 4 * m + j, chl)));
                R[m][j] = a; I[m][j] = __builtin_amdgcn_sqrtf(fmaxf(1.0f - a * a, 0.0f)) * (ig * xc);
            }
            __builtin_nontemporal_store((v4u){pk2(la[0], I[m][0]), pk2(la[1], I[m][1]), pk2(la[2], I[m][2]), pk2(la[3], I[m][3])}, au + m * 64);
        }
    }
    float P = 1.f, L = 0.f;
#pragma unroll
    for (int mm = 0; mm < 8; ++mm) {
        const int m = DIR == 0 ? mm : 7 - mm;
#pragma unroll
        for (int jj = 0; jj < 4; ++jj) {
            const int j = DIR == 0 ? jj : 3 - jj;
            const float a = R[m][j], u = I[m][j];
            L = a * L + u; P = a * P;
            R[m][j] = P; I[m][j] = L;
        }
    }
    const int src1 = DIR == 0 ? lane - 16 : lane + 16, src2 = DIR == 0 ? lane - 32 : lane + 32;
    const bool v1 = DIR == 0 ? (fq >= 1) : (fq <= 2), v2 = DIR == 0 ? (fq >= 2) : (fq <= 1);
    float A = P, B = L;
    { const float pa = __shfl(A, src1), pb = __shfl(B, src1); if (v1) { B = A * pb + B; A = A * pa; } }
    { const float pa = __shfl(A, src2), pb = __shfl(B, src2); if (v2) { B = A * pb + B; A = A * pa; } }
    if (APPLY) {
        float EA = __shfl(A, src1), EB = __shfl(B, src1); if (!v1) { EA = 1.f; EB = 0.f; }
        const float hin = EA * carry + EB;
#pragma unroll
        for (int m = 0; m < 8; ++m)
#pragma unroll
            for (int j = 0; j < 4; ++j) { const float hh = R[m][j] * hin + I[m][j]; if (DIR == 0) hsum[m][j] = hh; else hsum[m][j] += hh; }
    } else {
        const bool lastlane = DIR == 0 ? (fq == 3) : (fq == 0);
        if (lastlane) { f32x2* agg = (f32x2*)F.AGG() + (size_t)((b * 2 + DIR) * NCHUNK + c) * LW + chg; *agg = (f32x2){A, B}; }
    }
}

template <bool APPLY>
__device__ __forceinline__ void lru_unit(Frame& F, int unit) {
    const int h = unit & 7, c = (unit >> 3) & 63, b = unit >> 9;
    const int tid = F.tid, lane = F.lane, w = F.wave, fr = lane & 15, fq = lane >> 4;
    const size_t t0 = (size_t)b * SEQ + (size_t)c * CHUNK;
    LAS unsigned char* XR = F.lds + LRU_XR; LAS unsigned char* XC = F.lds + LRU_XC; LAS unsigned char* GR = F.lds + LRU_GR;
    bf16x8 Ba0[4], Bx0[4], Ba1[4], Bx1[4];
    if (!APPLY) {
        const bf16* wb = F.LRUW() + (size_t)h * 16384 + (size_t)(16 * w + fr) * 128 + 8 * fq;
#pragma unroll
        for (int ks = 0; ks < 4; ++ks) { Ba0[ks] = *(const GAS bf16x8*)(wb + 32 * ks); Ba1[ks] = *(const GAS bf16x8*)(wb + (size_t)8 * 16384 + 32 * ks);
            Bx0[ks] = *(const GAS bf16x8*)(wb + (size_t)16 * 16384 + 32 * ks); Bx1[ks] = *(const GAS bf16x8*)(wb + (size_t)24 * 16384 + 32 * ks); }
        for (int p = tid; p < 131 * 16; p += 512) { const int r = p >> 4, cg = p & 15; const int s = c * CHUNK - 2 + r; v4u v = (v4u){0u, 0u, 0u, 0u};
            if (s >= 0 && s < SEQ) v = *(const GAS v4u*)(F.Z() + ((size_t)b * SEQ + s) * NIN + h * 128 + cg * 8);
            *(LAS v4u*)(XR + r * 256 + cg * 16) = v; }
        __syncthreads();
        {
            const int ch2 = tid & 63, tg = tid >> 6, chg = h * 128 + 2 * ch2;
            float w0[4], w1[4];
#pragma unroll
            for (int k = 0; k < 4; ++k) { w0[k] = F.A.in[3][k * LW + chg]; w1[k] = F.A.in[3][k * LW + chg + 1]; }
            const float b0 = F.A.in[4][chg], b1 = F.A.in[4][chg + 1];
            float x0[4], x1[4];
#pragma unroll
            for (int k = 0; k < 3; ++k) { const unsigned u = *(const LAS unsigned*)(XR + (16 * tg + k) * 256 + ch2 * 4); x0[k] = bf_lo(u); x1[k] = bf_hi(u); }
#pragma unroll
            for (int j = 0; j < 16; ++j) {
                const unsigned u = *(const LAS unsigned*)(XR + (16 * tg + j + 3) * 256 + ch2 * 4); x0[3] = bf_lo(u); x1[3] = bf_hi(u);
                const float y0 = b0 + ((w0[0] * x0[0] + w0[1] * x0[1]) + (w0[2] * x0[2] + w0[3] * x0[3]));
                const float y1 = b1 + ((w1[0] * x1[0] + w1[1] * x1[1]) + (w1[2] * x1[2] + w1[3] * x1[3]));
                *(LAS unsigned*)(XC + xc_off(16 * tg + j, 2 * ch2)) = pk2(y0, y1);
                x0[0] = x0[1]; x0[1] = x0[2]; x0[2] = x0[3]; x1[0] = x1[1]; x1[1] = x1[2]; x1[2] = x1[3];
            }
        }
        __syncthreads();
    } else {
#pragma unroll
        for (int ks = 0; ks < 4; ++ks) { Ba0[ks] = Ba1[ks] = Bx0[ks] = Bx1[ks] = (bf16x8){0, 0, 0, 0, 0, 0, 0, 0}; }
        for (int p = tid; p < 128 * 32; p += 512) { const int r = p >> 5, cg = p & 31;
            *(LAS v2u*)(GR + r * 264 + cg * 8) = *(const GAS v2u*)(F.Z() + (t0 + r) * NIN + LW + h * 128 + cg * 4); }
    }
    float hsum[8][4];
    lru_dir<APPLY, 0>(F, unit, b, c, h, Ba0, Bx0, hsum);
    asm volatile("" ::: "memory"); __builtin_amdgcn_sched_barrier(0);
    lru_dir<APPLY, 1>(F, unit, b, c, h, Ba1, Bx1, hsum);
    if (APPLY) {
        const int chl = 16 * w + fr;
        __syncthreads();
#pragma unroll
        for (int m = 0; m < 8; ++m)
#pragma unroll
            for (int j = 0; j < 4; ++j) { LAS unsigned short* p = (LAS unsigned short*)(GR + (32 * fq + 4 * m + j) * 264 + chl * 2); *p = (unsigned short)f2bf(bf1(*p) * hsum[m][j]); }
        __syncthreads();
        for (int p = tid; p < 128 * 32; p += 512) { const int r = p >> 5, cg = p & 31;
            *(GAS v2u*)(F.MIX() + (t0 + r) * D + h * 128 + cg * 4) = *(const LAS v2u*)(GR + r * 264 + cg * 8); }
    }
    __syncthreads();
}

constexpr int LRU_PT = LRU_GR + 33792, LRU_CR = LRU_PT + 8192;
template <int DIR>
__device__ __forceinline__ void lru_scan_dir(Frame& F, int b, int c, int h, const bf16x8 (&Ba)[4], const bf16x8 (&Bx)[4], f32x4 (&R)[8], f32x4 (&I)[8], float& EA, float& EB) {
    const int lane = F.lane, w = F.wave, fr = lane & 15, fq = lane >> 4;
    LAS unsigned char* XC = F.lds + LRU_XC;
    const int chl = 16 * w + fr, chg = h * 128 + chl;
    {
        const float ba = F.A.in[6][DIR * LW + chg], bx = F.A.in[8][DIR * LW + chg], lam = F.A.in[9][DIR * LW + chg];
        const float cl = -8.0f * log1pf(__expf(-lam)) * LOG2E;
        const int arow = (fr >> 2) * 32 + (fr & 3);
#pragma unroll
        for (int m = 0; m < 8; ++m) {
            R[m] = (f32x4){0.f, 0.f, 0.f, 0.f}; I[m] = (f32x4){0.f, 0.f, 0.f, 0.f};
#pragma unroll
            for (int ks = 0; ks < 4; ++ks) {
                const bf16x8 a = *(const LAS bf16x8*)(XC + xc_off(arow + 4 * m, 32 * ks + 8 * fq));
                R[m] = __builtin_amdgcn_mfma_f32_16x16x32_bf16(a, Ba[ks], R[m], 0, 0, 0);
                I[m] = __builtin_amdgcn_mfma_f32_16x16x32_bf16(a, Bx[ks], I[m], 0, 0, 0);
            }
        }
#pragma unroll
        for (int m = 0; m < 8; ++m) {
#pragma unroll
            for (int j = 0; j < 4; ++j) {
                const float r = sigmoidf_(R[m][j] + ba), ig = sigmoidf_(I[m][j] + bx);
                const float a = __builtin_amdgcn_exp2f(cl * r);
                const float xc = bf1(*(const LAS unsigned short*)(XC + xc_off(32 * fq + 4 * m + j, chl)));
                R[m][j] = a; I[m][j] = __builtin_amdgcn_sqrtf(fmaxf(1.0f - a * a, 0.0f)) * (ig * xc);
            }
        }
    }
    float P = 1.f, L = 0.f;
#pragma unroll
    for (int mm = 0; mm < 8; ++mm) {
        const int m = DIR == 0 ? mm : 7 - mm;
#pragma unroll
        for (int jj = 0; jj < 4; ++jj) {
            const int j = DIR == 0 ? jj : 3 - jj;
            const float a = R[m][j], u = I[m][j];
            L = a * L + u; P = a * P;
            R[m][j] = P; I[m][j] = L;
        }
    }
    const int src1 = DIR == 0 ? lane - 16 : lane + 16, src2 = DIR == 0 ? lane - 32 : lane + 32;
    const bool v1 = DIR == 0 ? (fq >= 1) : (fq <= 2), v2 = DIR == 0 ? (fq >= 2) : (fq <= 1);
    float A = P, B = L;
    { const float pa = __shfl(A, src1), pb = __shfl(B, src1); if (v1) { B = A * pb + B; A = A * pa; } }
    { const float pa = __shfl(A, src2), pb = __shfl(B, src2); if (v2) { B = A * pb + B; A = A * pa; } }
    EA = __shfl(A, src1); EB = __shfl(B, src1); if (!v1) { EA = 1.f; EB = 0.f; }
    const bool lastlane = DIR == 0 ? (fq == 3) : (fq == 0);
    if (lastlane) {
        const unsigned long long word = (unsigned long long)(__builtin_bit_cast(unsigned, A) | 1u) | ((unsigned long long)__builtin_bit_cast(unsigned, B) << 32);
        __hip_atomic_store((unsigned long long*)F.AGG() + (size_t)((b * 2 + DIR) * NCHUNK + c) * LW + chg, word, RLX_AGENT);
    }
}
__device__ __forceinline__ void lru_decode(int unit, int& b, int& c, int& h) { const int rnd = unit >> 8, within = unit & 255; b = rnd >> 1; h = (rnd & 1) * 4 + (within & 3); c = within >> 2; }
__device__ __forceinline__ void lru_prefetch(Frame& F, int unit, int tid, v4u (&xr)[5]) {
    int b, c, h; lru_decode(unit, b, c, h);
#pragma unroll
    for (int i = 0; i < 5; ++i) { const int p = tid + 512 * i, r = p >> 4, cg = p & 15; const int s = c * CHUNK - 2 + r; xr[i] = (v4u){0u, 0u, 0u, 0u};
        if (p < 131 * 16 && s >= 0 && s < SEQ) xr[i] = *(const GAS v4u*)(F.Z() + ((size_t)b * SEQ + s) * NIN + h * 128 + cg * 8); }
}
__device__ __forceinline__ void lru_conv(Frame& F, int unit, int tid, const v4u (&xr)[5]) {
    int b, c, h; lru_decode(unit, b, c, h);
    LAS unsigned char* XR = F.lds + LRU_XR; LAS unsigned char* XC = F.lds + LRU_XC;
#pragma unroll
    for (int i = 0; i < 5; ++i) { const int p = tid + 512 * i, r = p >> 4, cg = p & 15; if (p < 131 * 16) *(LAS v4u*)(XR + r * 256 + cg * 16) = xr[i]; }
    __syncthreads();
    const int ch2 = tid & 63, tg = tid >> 6, chg = h * 128 + 2 * ch2;
    float w0[4], w1[4];
#pragma unroll
    for (int k = 0; k < 4; ++k) { w0[k] = F.A.in[3][k * LW + chg]; w1[k] = F.A.in[3][k * LW + chg + 1]; }
    const float b0 = F.A.in[4][chg], b1 = F.A.in[4][chg + 1];
    float x0[4], x1[4];
#pragma unroll
    for (int k = 0; k < 3; ++k) { const unsigned u = *(const LAS unsigned*)(XR + (16 * tg + k) * 256 + ch2 * 4); x0[k] = bf_lo(u); x1[k] = bf_hi(u); }
#pragma unroll
    for (int j = 0; j < 16; ++j) {
        const unsigned u = *(const LAS unsigned*)(XR + (16 * tg + j + 3) * 256 + ch2 * 4); x0[3] = bf_lo(u); x1[3] = bf_hi(u);
        const float y0 = b0 + ((w0[0] * x0[0] + w0[1] * x0[1]) + (w0[2] * x0[2] + w0[3] * x0[3]));
        const float y1 = b1 + ((w1[0] * x1[0] + w1[1] * x1[1]) + (w1[2] * x1[2] + w1[3] * x1[3]));
        *(LAS unsigned*)(XC + xc_off(16 * tg + j, 2 * ch2)) = pk2(y0, y1);
        x0[0] = x0[1]; x0[1] = x0[2]; x0[2] = x0[3]; x1[0] = x1[1]; x1[1] = x1[2]; x1[2] = x1[3];
    }
}
__device__ __forceinline__ void lru_fused_unit(Frame& F, int unit, int next, v4u (&xr)[5]) {
    int b, c, h; lru_decode(unit, b, c, h);
    int tid = F.tid; asm volatile("" : "+v"(tid));
    const int lane = tid & 63, w = F.wave, fr = lane & 15, fq = lane >> 4;
    const size_t t0 = (size_t)b * SEQ + (size_t)c * CHUNK;
    LAS unsigned char* GR = F.lds + LRU_GR;
    bf16x8 Ba0[4], Bx0[4], Ba1[4], Bx1[4];
    {
        const bf16* wb = F.LRUW() + (size_t)h * 16384 + (size_t)(16 * w + fr) * 128 + 8 * fq;
#pragma unroll
        for (int ks = 0; ks < 4; ++ks) { Ba0[ks] = *(const GAS bf16x8*)(wb + 32 * ks); Ba1[ks] = *(const GAS bf16x8*)(wb + (size_t)8 * 16384 + 32 * ks);
            Bx0[ks] = *(const GAS bf16x8*)(wb + (size_t)16 * 16384 + 32 * ks); Bx1[ks] = *(const GAS bf16x8*)(wb + (size_t)24 * 16384 + 32 * ks); }
    }
    f32x4 R0[8], I0[8], R1[8], I1[8]; float EA0, EB0, EA1, EB1;
    lru_scan_dir<0>(F, b, c, h, Ba0, Bx0, R0, I0, EA0, EB0);
    asm volatile("" ::: "memory"); __builtin_amdgcn_sched_barrier(0);
    if (next >= 0) lru_prefetch(F, next, tid, xr);
    lru_scan_dir<1>(F, b, c, h, Ba1, Bx1, R1, I1, EA1, EB1);
    {
        v2u gr[8];
#pragma unroll
        for (int i = 0; i < 8; ++i) { const int p = tid + 512 * i, r = p >> 5, cg = p & 31; gr[i] = *(const GAS v2u*)(F.Z() + (t0 + r) * NIN + LW + h * 128 + cg * 4); }
        if (next >= 0) lru_conv(F, next, tid, xr); else __syncthreads();
#pragma unroll
        for (int i = 0; i < 8; ++i) { const int p = tid + 512 * i, r = p >> 5, cg = p & 31; *(LAS v2u*)(GR + r * 264 + cg * 8) = gr[i]; }
    }
    {
        const int ch = tid & 127, kq = tid >> 7;
        const unsigned long long* ab = (const unsigned long long*)F.AGG() + (size_t)b * 2 * NCHUNK * LW + h * 128 + ch;
        unsigned long long v[16];
#pragma unroll
        for (int i = 0; i < 16; ++i) { const int k = min(16 * kq + i, 62); const int row = k < c ? k : NCHUNK + k + 1;
            v[i] = __hip_atomic_load(ab + (size_t)row * LW, RLX_AGENT); }
        for (unsigned sp = 0; sp < (1u << 16); ++sp) {
            bool bad = false;
#pragma unroll
            for (int i = 0; i < 16; ++i) if (v[i] == 0ull) { const int k = min(16 * kq + i, 62); const int row = k < c ? k : NCHUNK + k + 1;
                v[i] = __hip_atomic_load(ab + (size_t)row * LW, RLX_AGENT); bad = bad || (v[i] == 0ull); }
            if (!bad) break;
            __builtin_amdgcn_s_sleep(2);
        }
        float fa = 1.f, fb = 0.f, ga = 1.f, gb = 0.f;
#pragma unroll
        for (int i = 0; i < 16; ++i) { const int k = 16 * kq + i; const float A = __builtin_bit_cast(float, (unsigned)v[i]), B = __builtin_bit_cast(float, (unsigned)(v[i] >> 32));
            if (k < c) { fb = A * fb + B; fa = A * fa; } }
#pragma unroll
        for (int i = 15; i >= 0; --i) { const int k = 16 * kq + i; const float A = __builtin_bit_cast(float, (unsigned)v[i]), B = __builtin_bit_cast(float, (unsigned)(v[i] >> 32));
            if (k >= c && k < 63) { gb = A * gb + B; ga = A * ga; } }
        *(LAS f32x4*)(F.lds + LRU_PT + (kq * 128 + ch) * 16) = (f32x4){fa, fb, ga, gb};
    }
    __syncthreads();
    if (tid < 256) {
        const int dir = tid >> 7, ch = tid & 127;
        f32x4 q[4];
#pragma unroll
        for (int k = 0; k < 4; ++k) q[k] = *(const LAS f32x4*)(F.lds + LRU_PT + (k * 128 + ch) * 16);
        float st = 0.f;
        if (dir == 0) { st = q[0].y; st = q[1].x * st + q[1].y; st = q[2].x * st + q[2].y; st = q[3].x * st + q[3].y; }
        else { st = q[3].w; st = q[2].z * st + q[2].w; st = q[1].z * st + q[1].w; st = q[0].z * st + q[0].w; }
        *(LAS float*)(F.lds + LRU_CR + tid * 4) = st;
    }
    __syncthreads();
    {
        const int chl = 16 * w + fr;
        const float hin0 = EA0 * *(const LAS float*)(F.lds + LRU_CR + chl * 4) + EB0, hin1 = EA1 * *(const LAS float*)(F.lds + LRU_CR + 512 + chl * 4) + EB1;
#pragma unroll
        for (int m = 0; m < 8; ++m)
#pragma unroll
            for (int j = 0; j < 4; ++j) { const float hs = (R0[m][j] * hin0 + I0[m][j]) + (R1[m][j] * hin1 + I1[m][j]);
                LAS unsigned short* p = (LAS unsigned short*)(GR + (32 * fq + 4 * m + j) * 264 + chl * 2); *p = (unsigned short)f2bf(bf1(*p) * hs); }
        __syncthreads();
        for (int p = tid; p < 128 * 32; p += 512) { const int r = p >> 5, cg = p & 31;
            *(GAS v2u*)(F.MIX() + (t0 + r) * D + h * 128 + cg * 4) = *(const LAS v2u*)(GR + r * 264 + cg * 8); }
    }
    __syncthreads();
}
__device__ __forceinline__ void lru_carry(Frame& F) {
    const int idx = (F.vcu * NWAVES + F.wave) * 64 + F.lane;
    if (idx >= BATCH * 2 * LW) return;
    const int ch = idx & (LW - 1), bd = idx >> 10, dir = bd & 1;
    const f32x2* agg = (const f32x2*)F.AGG() + (size_t)bd * NCHUNK * LW + ch; float* cr = F.CARRY() + (size_t)bd * NCHUNK * LW + ch;
    float st = 0.f;
#pragma unroll 8
    for (int i = 0; i < NCHUNK; ++i) { const int cc = dir == 0 ? i : NCHUNK - 1 - i; const f32x2 pe = agg[(size_t)cc * LW]; cr[(size_t)cc * LW] = st; st = pe.x * st + pe.y; }
}
constexpr int GM_ST = 0, GM_BS = 1024, GM_VN = 2048, GM_GU = 2048 + 32768;
typedef short s16x4 __attribute__((ext_vector_type(4)));
__device__ __forceinline__ unsigned vn_off(unsigned row, unsigned ch) { return 256u * row + 16u * (ch ^ (((row & 3u) << 2) | ((row >> 2) & 3u))); }
struct GmlpRegs { v4u a[4]; v2u gu[8]; bf16x8 Af[4]; f32x4 g0, g1, b0, b1; float bs; };
__device__ __forceinline__ void gmlp_load(Frame& F, size_t t0, int h, int tid, GmlpRegs& G) {
    const int lane = tid & 63, w = tid >> 6, fr = lane & 15, fq = lane >> 4;
#pragma unroll
    for (int i = 0; i < 4; ++i) { const int pid = tid + 512 * i, q = pid >> 4, cg = pid & 15; G.a[i] = *(const GAS v4u*)(F.Z() + (t0 + q) * NIN + 3 * LW + h * 128 + cg * 8); }
#pragma unroll
    for (int i = 0; i < 8; ++i) { const int pid = tid + 512 * i, r = pid >> 5, cg = pid & 31; G.gu[i] = *(const GAS v2u*)(F.Z() + (t0 + r) * NIN + 2 * LW + h * 128 + cg * 4); }
    { const int cg = tid & 15;
      G.g0 = *(const GAS f32x4*)(F.A.in[10] + h * 128 + cg * 8); G.g1 = *(const GAS f32x4*)(F.A.in[10] + h * 128 + cg * 8 + 4);
      G.b0 = *(const GAS f32x4*)(F.A.in[11] + h * 128 + cg * 8); G.b1 = *(const GAS f32x4*)(F.A.in[11] + h * 128 + cg * 8 + 4); }
    G.bs = F.A.in[13][h * 128 + (tid & 127)];
    const bf16* wsb = F.WSB() + (size_t)h * 16384 + (size_t)(16 * w + fr) * 128 + 8 * fq;
#pragma unroll
    for (int ks = 0; ks < 4; ++ks) G.Af[ks] = *(const GAS bf16x8*)(wsb + 32 * ks);
}
__device__ __forceinline__ void gmlp_unit(Frame& F, int unit) {
    int tid = F.tid; asm volatile("" : "+v"(tid));
    const int lane = tid & 63, w = F.wave, fr = lane & 15, fq = lane >> 4;
    const size_t t0 = (size_t)unit * CHUNK;
    LAS float* ST = (LAS float*)(F.lds + GM_ST); LAS float* BS = (LAS float*)(F.lds + GM_BS);
    LAS unsigned char* VN = F.lds + GM_VN; LAS unsigned char* GU = F.lds + GM_GU;
    GmlpRegs G;
    gmlp_load(F, t0, 0, tid, G);
#pragma unroll
    for (int rb = 0; rb < 2; ++rb) {
        v4u ra[8], rc[8];
#pragma unroll
        for (int rr = 0; rr < 8; ++rr) { const bf16* p = F.Z() + (t0 + 16 * w + 8 * rb + rr) * NIN + 3 * LW + lane * 8; ra[rr] = *(const GAS v4u*)p; rc[rr] = *(const GAS v4u*)(p + 512); }
#pragma unroll
        for (int rr = 0; rr < 8; ++rr) {
            const int row = 16 * w + 8 * rb + rr;
            const v4u a = ra[rr], b = rc[rr];
            float x[16] = {bf_lo(a.x), bf_hi(a.x), bf_lo(a.y), bf_hi(a.y), bf_lo(a.z), bf_hi(a.z), bf_lo(a.w), bf_hi(a.w),
                           bf_lo(b.x), bf_hi(b.x), bf_lo(b.y), bf_hi(b.y), bf_lo(b.z), bf_hi(b.z), bf_lo(b.w), bf_hi(b.w)};
            float s = 0.f;
#pragma unroll
            for (int i = 0; i < 16; ++i) s += x[i];
            const float mean = wave_sum(s) * (1.0f / LW);
            float q = 0.f;
#pragma unroll
            for (int i = 0; i < 16; ++i) { const float d = x[i] - mean; q += d * d; }
            const float rstd = __builtin_amdgcn_rsqf(wave_sum(q) * (1.0f / LW) + 1e-6f);
            if (lane == 0) { ST[2 * row] = mean; ST[2 * row + 1] = rstd; }
        }
    }
    __syncthreads();
    const unsigned trq = (unsigned)(lane & 15) >> 2, trp = (unsigned)lane & 3u;
    for (int h = 0; h < 8; ++h) {
#pragma unroll
        for (int i = 0; i < 4; ++i) { const int pid = tid + 512 * i, q = pid >> 4, cg = pid & 15;
            const v4u a = G.a[i];
            const float mean = ST[2 * q], rstd = ST[2 * q + 1];
            const f32x4 g0 = G.g0, g1 = G.g1, b0 = G.b0, b1 = G.b1;
            v4u o;
            o.x = pk2((bf_lo(a.x) - mean) * rstd * g0.x + b0.x, (bf_hi(a.x) - mean) * rstd * g0.y + b0.y);
            o.y = pk2((bf_lo(a.y) - mean) * rstd * g0.z + b0.z, (bf_hi(a.y) - mean) * rstd * g0.w + b0.w);
            o.z = pk2((bf_lo(a.z) - mean) * rstd * g1.x + b1.x, (bf_hi(a.z) - mean) * rstd * g1.y + b1.y);
            o.w = pk2((bf_lo(a.w) - mean) * rstd * g1.z + b1.z, (bf_hi(a.w) - mean) * rstd * g1.w + b1.w);
            *(LAS v4u*)(VN + vn_off((unsigned)q, (unsigned)cg)) = o;
        }
#pragma unroll
        for (int i = 0; i < 8; ++i) { const int pid = tid + 512 * i, r = pid >> 5, cg = pid & 31; *(LAS v2u*)(GU + r * 264 + cg * 8) = G.gu[i]; }
        if (tid < 128) BS[tid] = G.bs;
        bf16x8 Af[4];
#pragma unroll
        for (int ks = 0; ks < 4; ++ks) Af[ks] = G.Af[ks];
        __syncthreads();
        if (h + 1 < 8) gmlp_load(F, t0, h + 1, tid, G);
        f32x4 acc[8];
#pragma unroll
        for (int n = 0; n < 8; ++n) {
            acc[n] = (f32x4){0.f, 0.f, 0.f, 0.f};
#pragma unroll
            for (int ks = 0; ks < 4; ++ks) {
                const s16x4 b0 = __builtin_amdgcn_ds_read_tr16_b64_v4i16((LAS s16x4*)(VN + vn_off(32u * ks + 8u * fq + trq, 2u * n + (trp >> 1)) + 8u * (trp & 1u)));
                const s16x4 b1 = __builtin_amdgcn_ds_read_tr16_b64_v4i16((LAS s16x4*)(VN + vn_off(32u * ks + 8u * fq + 4u + trq, 2u * n + (trp >> 1)) + 8u * (trp & 1u)));
                const bf16x8 bb = (bf16x8){b0[0], b0[1], b0[2], b0[3], b1[0], b1[1], b1[2], b1[3]};
                acc[n] = __builtin_amdgcn_mfma_f32_16x16x32_bf16(Af[ks], bb, acc[n], 0, 0, 0);
            }
        }
#pragma unroll
        for (int n = 0; n < 8; ++n)
#pragma unroll
            for (int j = 0; j < 4; ++j) { const int p = 16 * w + 4 * fq + j; LAS unsigned short* ad = (LAS unsigned short*)(GU + p * 264 + (16 * n + fr) * 2);
                *ad = (unsigned short)f2bf(bf1(*ad) * (acc[n][j] + BS[p])); }
        __syncthreads();
#pragma unroll
        for (int i = 0; i < 8; ++i) { const int pid = tid + 512 * i, r = pid >> 5, cg = pid & 31;
            *(GAS v2u*)(F.MIX() + (t0 + r) * D + LW + h * 128 + cg * 4) = *(const LAS v2u*)(GU + r * 264 + cg * 8); }
        __syncthreads();
    }
}
__device__ __forceinline__ void h8_issue(Frame& F, int t, int lane, v4u (&a)[4]) {
    const bf16* hp = F.HB() + (size_t)t * D + lane * 16;
#pragma unroll
    for (int c = 0; c < 2; ++c)
#pragma unroll
        for (int q = 0; q < 2; ++q) a[c * 2 + q] = *(const GAS v4u*)(hp + c * 1024 + q * 8);
}
__device__ __forceinline__ void h8_finish(Frame& F, int t, int lane, const v4u (&av)[4]) {
    float hx[32]; float mx = 0.f;
#pragma unroll
    for (int c = 0; c < 2; ++c)
#pragma unroll
        for (int q = 0; q < 2; ++q) { const v4u a = av[c * 2 + q]; float* x = hx + c * 16 + q * 8;
            x[0] = bf_lo(a.x); x[1] = bf_hi(a.x); x[2] = bf_lo(a.y); x[3] = bf_hi(a.y); x[4] = bf_lo(a.z); x[5] = bf_hi(a.z); x[6] = bf_lo(a.w); x[7] = bf_hi(a.w); }
#pragma unroll
    for (int i = 0; i < 32; ++i) mx = fmaxf(mx, fabsf(hx[i]));
#pragma unroll
    for (int o = 1; o < 64; o <<= 1) mx = fmaxf(mx, __shfl_xor(mx, o));
    const float sc = mx > 0.f ? 119.0f / mx : 1.0f;
    const float MAGIC = 12582912.0f + 128.0f;
#pragma unroll
    for (int c = 0; c < 2; ++c) {
        unsigned hw[2], lw[2];
#pragma unroll
        for (int g8 = 0; g8 < 2; ++g8) {
            unsigned m[8];
#pragma unroll
            for (int i = 0; i < 8; ++i) m[i] = __builtin_bit_cast(unsigned, __builtin_fmaf(hx[c * 16 + g8 * 8 + i], sc, MAGIC));
            const unsigned B0 = __builtin_amdgcn_perm(__builtin_amdgcn_perm(m[3], m[2], 0x0c0c0400u), __builtin_amdgcn_perm(m[1], m[0], 0x0c0c0400u), 0x05040100u);
            const unsigned B1 = __builtin_amdgcn_perm(__builtin_amdgcn_perm(m[7], m[6], 0x0c0c0400u), __builtin_amdgcn_perm(m[5], m[4], 0x0c0c0400u), 0x05040100u);
            lw[g8] = (B0 & 0x0F0F0F0Fu) | ((B1 & 0x0F0F0F0Fu) << 4);
            const unsigned h0 = ((B0 + 0x08080808u) >> 4) & 0x0F0F0F0Fu, h1 = ((B1 + 0x08080808u) >> 4) & 0x0F0F0F0Fu;
            hw[g8] = (h0 | (h1 << 4)) ^ 0x88888888u; }
        unsigned char* hb_ = F.H8() + (size_t)t * D + c * 512 + lane * 8;
        *(GAS v2u*)hb_ = (v2u){hw[0], hw[1]}; *(GAS v2u*)(hb_ + 1024) = (v2u){lw[0], lw[1]};
    }
    if (lane == 0) F.HSCALE()[t] = mx > 0.f ? mx * (1.0f / 119.0f) : 1.0f;
}
__device__ __forceinline__ void h8_row(Frame& F, int t) { int lane = F.lane; asm volatile("" : "+v"(lane)); v4u a[4]; h8_issue(F, t, lane, a); h8_finish(F, t, lane, a); }
typedef float f32x16 __attribute__((ext_vector_type(16)));
__device__ __forceinline__ unsigned fkey(float f) { const int u = __builtin_bit_cast(int, f); return (unsigned)(u ^ ((u >> 31) & 0x7fffffff)); }
__device__ __forceinline__ float fkey_inv(unsigned k) { const int u = (int)k; return __builtin_bit_cast(float, u ^ ((u >> 31) & 0x7fffffff)); }
__device__ __forceinline__ unsigned umax_(unsigned a, unsigned b) { return (int)a > (int)b ? a : b; }
__device__ __forceinline__ unsigned umin_(unsigned a, unsigned b) { return (int)a < (int)b ? a : b; }
#define CE_DESC(x, y) do { const unsigned a_ = (x), b_ = (y); (x) = umax_(a_, b_); (y) = umin_(a_, b_); } while (0)
__device__ __forceinline__ void sort16_desc(unsigned (&a)[16]) {
#pragma unroll
    for (int k = 2; k <= 16; k <<= 1)
#pragma unroll
        for (int j = k >> 1; j >= 1; j >>= 1)
#pragma unroll
            for (int i = 0; i < 16; ++i) { const int l = i ^ j; if (l > i) { if ((i & k) == 0) CE_DESC(a[i], a[l]); else CE_DESC(a[l], a[i]); } }
}
__device__ __forceinline__ void merge16_desc(unsigned (&a)[16], const unsigned (&b)[16]) {
#pragma unroll
    for (int i = 0; i < 16; ++i) a[i] = umax_(a[i], b[15 - i]);
#pragma unroll
    for (int j = 8; j >= 1; j >>= 1)
#pragma unroll
        for (int i = 0; i < 16; ++i) if ((i & j) == 0) CE_DESC(a[i], a[i + j]);
}
typedef short bf16x8s __attribute__((ext_vector_type(8)));
__device__ __forceinline__ void topk_unit(Frame& F, int wu, bool doh, int th, int tstride) {
    v4u ha[4][4];
    const int tg = wu >> 3, hd = wu & 7, lane = F.lane, r = lane & 31, hh = lane >> 5;
    const int t = tg * 32 + r;
    const size_t qoff = (size_t)t * D + hd * 256 + 8 * hh;
    unsigned L[2][16];
    unsigned hh4 = (unsigned)hh << 2; asm volatile("" : "+v"(hh4));
#pragma unroll
    for (int p = 0; p < 2; ++p) {
        f32x16 acc[4];
#pragma unroll
        for (int nt = 0; nt < 4; ++nt)
#pragma unroll
            for (int i = 0; i < 16; ++i) acc[nt][i] = 0.f;
        const size_t koff = ((size_t)(hd * 2 + p) * 128 + r) * 128 + 8 * hh;
        const bf16* qp = F.QH() + qoff + p * 128; const bf16* kp0 = F.KH() + koff; const bf16* kp1 = kp0 + 32 * 128; const bf16* kp2 = kp0 + 64 * 128; const bf16* kp3 = kp0 + 96 * 128;
        asm volatile("" : "+v"(qp), "+v"(kp0), "+v"(kp1), "+v"(kp2), "+v"(kp3));
#define P6_LOAD(Q, K, ks0, n) _Pragma("unroll") for (int i_ = 0; i_ < (n); ++i_) { Q[i_] = *(const GAS bf16x8s*)(qp + 16 * ((ks0) + i_)); \
            K[i_][0] = *(const GAS bf16x8s*)(kp0 + 16 * ((ks0) + i_)); K[i_][1] = *(const GAS bf16x8s*)(kp1 + 16 * ((ks0) + i_)); \
            K[i_][2] = *(const GAS bf16x8s*)(kp2 + 16 * ((ks0) + i_)); K[i_][3] = *(const GAS bf16x8s*)(kp3 + 16 * ((ks0) + i_)); }
#define P6_MMA(Q, K, n) _Pragma("unroll") for (int i_ = 0; i_ < (n); ++i_) _Pragma("unroll") for (int nt = 0; nt < 4; ++nt) acc[nt] = __builtin_amdgcn_mfma_f32_32x32x16_bf16(K[i_][nt], Q[i_], acc[nt], 0, 0, 0);
        bf16x8s qa[3], ka[3][4], qb[3], kb[3][4];
        P6_LOAD(qa, ka, 0, 3); P6_LOAD(qb, kb, 3, 3);
        __builtin_amdgcn_sched_barrier(0);
        P6_MMA(qa, ka, 3);
        __builtin_amdgcn_sched_barrier(0);
        P6_LOAD(qa, ka, 6, 2);
        __builtin_amdgcn_sched_barrier(0);
        P6_MMA(qb, kb, 3);
        __builtin_amdgcn_sched_barrier(0);
        P6_MMA(qa, ka, 2);
        __builtin_amdgcn_sched_barrier(0);
        if (p == 1) {
#pragma unroll
            for (int i = 0; i < 4; ++i) { if (doh) h8_issue(F, th + i * tstride, lane, ha[i]); else { ha[i][0] = ha[i][1] = ha[i][2] = ha[i][3] = (v4u){0u, 0u, 0u, 0u}; } }
            __builtin_amdgcn_sched_barrier(0);
        }
#undef P6_LOAD
#undef P6_MMA
        unsigned S[4][16];
#pragma unroll
        for (int nt = 0; nt < 4; ++nt) {
#pragma unroll
            for (int rg = 0; rg < 16; ++rg) { const int nc = 32 * nt + (rg & 3) + 8 * (rg >> 2); S[nt][rg] = ((fkey(acc[nt][rg]) & ~0x7Fu) | (unsigned)(127 - nc)) ^ hh4; }
            sort16_desc(S[nt]);
        }
        merge16_desc(S[0], S[1]); merge16_desc(S[2], S[3]); merge16_desc(S[0], S[2]);
        unsigned T[16];
#pragma unroll
        for (int i = 0; i < 16; ++i) T[i] = (unsigned)__shfl_xor((int)S[0][i], 32);
        merge16_desc(S[0], T);
#pragma unroll
        for (int i = 0; i < 16; ++i) L[p][i] = S[0][i];
        __builtin_amdgcn_sched_barrier(0);
    }
    float v0[16], v1[16];
#pragma unroll
    for (int i = 0; i < 16; ++i) { v0[i] = fkey_inv(L[0][i] & ~0x7Fu); v1[i] = fkey_inv(L[1][i] & ~0x7Fu); }
    unsigned C[4][16];
    {
        int cnt = 0;
#pragma unroll
        for (int i = 0; i < 16; ++i)
#pragma unroll
            for (int j = 0; j < 16; ++j) if ((i + 1) * (j + 1) <= 16) { C[cnt >> 4][cnt & 15] = (fkey(v0[i] + v1[j]) & ~0xFFu) | (unsigned)(255 - (i * 16 + j)); ++cnt; }
#pragma unroll
        for (int q = 50; q < 64; ++q) C[q >> 4][q & 15] = 0x80000000u;
    }
    sort16_desc(C[0]); sort16_desc(C[1]); sort16_desc(C[2]); sort16_desc(C[3]);
    merge16_desc(C[0], C[1]); merge16_desc(C[2], C[3]); merge16_desc(C[0], C[2]);
    unsigned best[16];
#pragma unroll
    for (int i = 0; i < 16; ++i) best[i] = C[0][i];
    LAS unsigned* tab = (LAS unsigned*)(F.lds + F.wave * 8192) + lane;
#pragma unroll
    for (int i = 0; i < 16; ++i) { tab[i * 64] = 127u - (L[0][i] & 0x7Fu); tab[(16 + i) * 64] = 127u - (L[1][i] & 0x7Fu); }
    const float smax = fkey_inv(best[0] & ~0xFFu);
    float sv[8]; unsigned idv[8]; float ssum = 0.f;
#pragma unroll
    for (int k = 0; k < 8; ++k) {
        const unsigned bk = hh ? best[8 + k] : best[k];
        const unsigned pos = 255u - (bk & 0xFFu);
        idv[k] = tab[(pos >> 4) * 64] * 128u + tab[(16 + (pos & 15u)) * 64];
        sv[k] = __builtin_amdgcn_exp2f((fkey_inv(bk & ~0xFFu) - smax) * 1.4426950409f); ssum += sv[k];
    }
    ssum += __shfl_xor(ssum, 32);
    const float inv = 1.0f / ssum;
    {
        int* o = F.IDS() + (size_t)t * 128 + hd * 16 + 8 * hh; float* og = F.GATES() + (size_t)t * 128 + hd * 16 + 8 * hh;
        *(GAS v4u*)o = (v4u){idv[0], idv[1], idv[2], idv[3]}; *(GAS v4u*)(o + 4) = (v4u){idv[4], idv[5], idv[6], idv[7]};
        *(GAS f32x4*)og = (f32x4){sv[0] * inv, sv[1] * inv, sv[2] * inv, sv[3] * inv}; *(GAS f32x4*)(og + 4) = (f32x4){sv[4] * inv, sv[5] * inv, sv[6] * inv, sv[7] * inv};
    }
    if (doh) {
#pragma unroll
        for (int i = 0; i < 4; ++i) h8_finish(F, th + i * tstride, lane, ha[i]);
    }
}
__device__ __forceinline__ int row_sum16(int v) {
    v += __builtin_amdgcn_update_dpp(0, v, 0x128, 0xf, 0xf, false);
    v += __builtin_amdgcn_update_dpp(0, v, 0x124, 0xf, 0xf, false);
    v += __builtin_amdgcn_update_dpp(0, v, 0x122, 0xf, 0xf, false);
    v += __builtin_amdgcn_update_dpp(0, v, 0x121, 0xf, 0xf, false);
    return v;
}
__device__ __forceinline__ void peer_u_xcd(Frame& F) {
    const int lane = F.lane, x = blockIdx.x & 7, jcu = blockIdx.x >> 3, ncu = ((int)F.G - x + 7) >> 3;
    const int tpc = (M + ncu - 1) / ncu, tpw = (tpc + NWAVES - 1) / NWAVES;
    const int tbase = jcu * tpc + F.wave * tpw;
    int nw = M - tbase; { const int lim = (jcu + 1) * tpc - tbase; nw = nw < lim ? nw : lim; nw = nw < tpw ? nw : tpw; nw = nw < 0 ? 0 : nw; }
    const int NV = nw;
    LAS unsigned char* wl = F.lds + F.wave * 13312;
    LAS int* lst = (LAS int*)wl; LAS int* res = (LAS int*)(wl + 512); LAS unsigned char* hsl = wl + 1024;
    const int q4 = lane >> 4, i16 = lane & 15;
    const unsigned char* ubase = F.U8() + (size_t)x * 2048 * 1024;
    const unsigned lanepart = (unsigned)i16 * 16u;
    int r_idlo = 0, r_idhi = 0, r_t = 0; v4u r_h0 = (v4u){0u, 0u, 0u, 0u}, r_h1 = (v4u){0u, 0u, 0u, 0u};
    int v_cl0 = 0, v_cl1 = 0, v_n = 0, v_r0 = 0, v_t = 0, v_slot = 0; unsigned long long v_mlo = 0, v_mhi = 0; bool v_live = false;
    int vset = 0, nvalid = 0, idle = 0;
    if (NV == 0) return;
#define U_RAW() do { const int vi_ = vset < NV ? vset : NV - 1; r_t = tbase + vi_; \
        r_idlo = F.IDS()[(size_t)r_t * 128 + lane]; r_idhi = F.IDS()[(size_t)r_t * 128 + 64 + lane]; \
        r_h0 = *(const GAS v4u*)(F.H8() + (size_t)r_t * D + lane * 16); r_h1 = *(const GAS v4u*)(F.H8() + (size_t)r_t * D + 1024 + lane * 16); } while (0)
#define U_NEXT() do { if (v_live && v_r0 + 16 < v_n) { v_r0 += 16; } else if (vset < NV) { const bool slo = (r_idlo >> 11) == x, shi = (r_idhi >> 11) == x; \
            v_mlo = __ballot(slo); v_mhi = __ballot(shi); const int nlo = __popcll(v_mlo); v_n = nlo + __popcll(v_mhi); \
            const int plo = __builtin_amdgcn_mbcnt_hi((unsigned)(v_mlo >> 32), __builtin_amdgcn_mbcnt_lo((unsigned)v_mlo, 0)); \
            const int phi = nlo + __builtin_amdgcn_mbcnt_hi((unsigned)(v_mhi >> 32), __builtin_amdgcn_mbcnt_lo((unsigned)v_mhi, 0)); \
            if (slo) lst[plo] = (r_idlo & 2047) | (lane << 16); if (shi) lst[phi] = (r_idhi & 2047) | ((64 + lane) << 16); \
            v_slot = nvalid % 6; ++nvalid; { LAS unsigned char* sp_ = hsl + v_slot * 2048; *(LAS v4u*)(sp_ + lane * 16) = r_h0; *(LAS v4u*)(sp_ + 1024 + lane * 16) = r_h1; } \
            v_cl0 = lst[lane]; v_cl1 = lst[64 + lane]; v_t = r_t; v_r0 = 0; ++vset; v_live = true; } \
        else { v_live = false; v_n = 0; v_r0 = 0; v_mlo = 0; v_mhi = 0; ++idle; } } while (0)
#define U_ISSUE(BUF, DS) do { { const int rem_ = v_n - v_r0; DS##_cnt = rem_ < 0 ? 0 : (rem_ < 16 ? rem_ : 16); } \
        DS##_slot = v_slot; DS##_t = v_t; DS##_mlo = v_mlo; DS##_mhi = v_mhi; DS##_last = v_live && (v_r0 + 16 >= v_n); \
        _Pragma("unroll") for (int gp = 0; gp < 4; ++gp) { const int ix_ = v_r0 + 4 * gp + q4; const int a_ = __shfl(v_cl0, ix_ & 63), b_ = __shfl(v_cl1, ix_ & 63); DS##_ent[gp] = ix_ < 64 ? a_ : b_; \
            const unsigned of_ = (4 * gp + q4 < DS##_cnt ? ((unsigned)(DS##_ent[gp] & 2047) << 10) : 0u) + lanepart; \
            _Pragma("unroll") for (int c = 0; c < 4; ++c) BUF[4 * gp + c] = *(const GAS v4u*)(ubase + of_ + c * 256); } } while (0)
#define U_COMPUTE(BUF, DS) do { const LAS unsigned char* sp_ = hsl + DS##_slot * 2048; const LAS v4u* hp_ = (const LAS v4u*)(sp_ + i16 * 16); \
        _Pragma("unroll") for (int gp = 0; gp < 4; ++gp) if (4 * gp < DS##_cnt) { int ah_ = 0, al_ = 0; \
            _Pragma("unroll") for (int c = 0; c < 4; ++c) { const v4u r_ = BUF[4 * gp + c]; const v4u hh_ = hp_[c * 16], hl_ = hp_[64 + c * 16]; \
                ah_ = __builtin_amdgcn_sdot8((int)r_.x, (int)hh_.x, ah_, false); al_ = __builtin_amdgcn_sdot8((int)r_.x, (int)hl_.x, al_, false); \
                ah_ = __builtin_amdgcn_sdot8((int)r_.y, (int)hh_.y, ah_, false); al_ = __builtin_amdgcn_sdot8((int)r_.y, (int)hl_.y, al_, false); \
                ah_ = __builtin_amdgcn_sdot8((int)r_.z, (int)hh_.z, ah_, false); al_ = __builtin_amdgcn_sdot8((int)r_.z, (int)hl_.z, al_, false); \
                ah_ = __builtin_amdgcn_sdot8((int)r_.w, (int)hh_.w, ah_, false); al_ = __builtin_amdgcn_sdot8((int)r_.w, (int)hl_.w, al_, false); } \
            const int a_ = row_sum16((ah_ << 4) + al_); if (i16 == 0 && 4 * gp + q4 < DS##_cnt) res[DS##_ent[gp] >> 16] = a_; } \
        if (DS##_last) { int* po_ = F.PART() + (size_t)DS##_t * 128; \
            if ((DS##_mlo >> lane) & 1ull) po_[lane] = res[lane]; if ((DS##_mhi >> lane) & 1ull) po_[64 + lane] = res[64 + lane]; } } while (0)
    v4u bufA[16], bufB[16], bufC[16];
    int dA_cnt = 0, dA_ent[4] = {0, 0, 0, 0}, dA_t = 0, dA_slot = 0; unsigned long long dA_mlo = 0, dA_mhi = 0; bool dA_last = false;
    int dB_cnt = 0, dB_ent[4] = {0, 0, 0, 0}, dB_t = 0, dB_slot = 0; unsigned long long dB_mlo = 0, dB_mhi = 0; bool dB_last = false;
    int dC_cnt = 0, dC_ent[4] = {0, 0, 0, 0}, dC_t = 0, dC_slot = 0; unsigned long long dC_mlo = 0, dC_mhi = 0; bool dC_last = false;
    U_RAW();
    U_NEXT(); U_RAW(); U_ISSUE(bufA, dA);
    U_NEXT(); U_RAW(); U_ISSUE(bufB, dB);
    while (idle < 3) {
        U_NEXT(); U_RAW(); U_ISSUE(bufC, dC); U_COMPUTE(bufA, dA);
        U_NEXT(); U_RAW(); U_ISSUE(bufA, dA); U_COMPUTE(bufB, dB);
        U_NEXT(); U_RAW(); U_ISSUE(bufB, dB); U_COMPUTE(bufC, dC);
    }
#undef U_RAW
#undef U_NEXT
#undef U_ISSUE
#undef U_COMPUTE
}
__device__ __forceinline__ void peer_act_token(Frame& F, int t) {
    const int lane = F.lane;
    LAS unsigned char* wl = F.lds + F.wave * 4096;
    LAS float* abuf = (LAS float*)wl; LAS int* ibuf = (LAS int*)(wl + 512); LAS int* cnt = (LAS int*)(wl + 1024);
    LAS int* ovf = (LAS int*)(wl + 1280); LAS int* fre = (LAS int*)(wl + 1792); LAS int* sop = (LAS int*)(wl + 2304);
#define WFENCE() asm volatile("s_waitcnt lgkmcnt(0)" ::: "memory")
    const float sc = __builtin_amdgcn_rsqf(F.ROWSS()[t] * (1.0f / D) + 1e-6f) * F.HSCALE()[t];
    if (lane < 34) cnt[lane] = 0;
    float am = 0.f; float actv[2]; int idv[2], slotv[2];
    const int l32 = t & 31;
#pragma unroll
    for (int half = 0; half < 2; ++half) {
        const size_t o = (size_t)t * 128 + half * 64 + lane;
        const int e = F.IDS()[o]; const float g = F.GATES()[o];
        const int dsum = F.PART()[o];
        actv[half] = gelu_tanh((float)dsum * sc * F.USCALE()[e]) * g * F.VSCALE()[e]; idv[half] = e; am = fmaxf(am, fabsf(actv[half]));
    }
    WFENCE();
#pragma unroll
    for (int half = 0; half < 2; ++half) {
        const int r = idv[half] & 31;
        const int j = __hip_atomic_fetch_add(cnt + r, 1, __ATOMIC_RELAXED, __HIP_MEMORY_SCOPE_WORKGROUP);
        if (j < 4) slotv[half] = ((r - l32) & 31) + 32 * j;
        else { const int q = __hip_atomic_fetch_add(cnt + 32, 1, __ATOMIC_RELAXED, __HIP_MEMORY_SCOPE_WORKGROUP); ovf[q] = half * 64 + lane; slotv[half] = -1; }
    }
    WFENCE();
    if (lane < 32) { const int n = cnt[lane];
        for (int j = n; j < 4; ++j) { const int q = __hip_atomic_fetch_add(cnt + 33, 1, __ATOMIC_RELAXED, __HIP_MEMORY_SCOPE_WORKGROUP); fre[q] = ((lane - l32) & 31) + 32 * j; } }
    WFENCE();
    const int nov = cnt[32];
#pragma unroll
    for (int half = 0; half < 2; ++half) { const int i = half * 64 + lane; if (i < nov) sop[ovf[i]] = fre[i]; }
    WFENCE();
#pragma unroll
    for (int half = 0; half < 2; ++half) { if (slotv[half] < 0) slotv[half] = sop[half * 64 + lane]; abuf[slotv[half]] = actv[half]; ibuf[slotv[half]] = idv[half]; }
    WFENCE();
#pragma unroll
    for (int o = 1; o < 64; o <<= 1) am = fmaxf(am, __shfl_xor(am, o));
    const float asc = am > 0.f ? 127.0f / am : 1.0f;
    if (lane == 0) F.ASCALE()[t] = am > 0.f ? am * (1.0f / 127.0f) : 1.0f;
    if (lane < 32) {
        const f32x4 av = *(const LAS f32x4*)(abuf + 4 * lane); const v4u iv = *(const LAS v4u*)(ibuf + 4 * lane);
        const size_t o = ((size_t)(t >> 6) * 32 + lane) * 64 + (t & 63);
        F.IDW()[o] = (v4u){iv.x << 3, iv.y << 3, iv.z << 3, iv.w << 3};
        F.AW()[o] = pack_i8x4(av.x * asc, av.y * asc, av.z * asc, av.w * asc);
    }
    WFENCE();
#undef WFENCE
}
__device__ __forceinline__ void tr4x4(const unsigned r0, const unsigned r1, const unsigned r2, const unsigned r3, unsigned (&c)[4]) {
    const unsigned t01l = __builtin_amdgcn_perm(r1, r0, 0x05010400u), t01h = __builtin_amdgcn_perm(r1, r0, 0x07030602u);
    const unsigned t23l = __builtin_amdgcn_perm(r3, r2, 0x05010400u), t23h = __builtin_amdgcn_perm(r3, r2, 0x07030602u);
    c[0] = __builtin_amdgcn_perm(t23l, t01l, 0x05040100u); c[1] = __builtin_amdgcn_perm(t23l, t01l, 0x07060302u);
    c[2] = __builtin_amdgcn_perm(t23h, t01h, 0x05040100u); c[3] = __builtin_amdgcn_perm(t23h, t01h, 0x07060302u);
}
template <int MODE>
__device__ __forceinline__ void peer_v_slice(Frame& F, int c, bool do_atomic) {
    const int tid = F.tid, lane = F.lane;
    for (int i = tid; i < NEXP * 8 / 16; i += 512) *(LAS v4u*)(F.lds + i * 16) = *(const GAS v4u*)(F.V8T() + (size_t)c * NEXP * 8 + (size_t)i * 16);
    __syncthreads();
    const v4u* ibase = F.IDW() + lane; const unsigned* abase = F.AW() + lane;
    constexpr int NBLK = M / 64, PD = 16;
    v4u iq[PD]; unsigned aq[PD]; v2u rw[2][4];
    {
        const size_t o = (size_t)F.wave * 32 * 64;
#pragma unroll
        for (int j = 0; j < PD; ++j) { iq[j] = *(const GAS v4u*)(ibase + o + j * 64); aq[j] = abase[o + j * 64]; }
    }
#define LROW(dst, q) do { dst[0] = *(const LAS v2u*)(F.lds + (q).x); dst[1] = *(const LAS v2u*)(F.lds + (q).y); \
                          dst[2] = *(const LAS v2u*)(F.lds + (q).z); dst[3] = *(const LAS v2u*)(F.lds + (q).w); } while (0)
    for (int blk = F.wave; blk < NBLK; blk += NWAVES) {
        const int t = blk * 64 + lane;
        const size_t o = (size_t)blk * 32 * 64;
        const int nblk = (blk + NWAVES < NBLK) ? blk + NWAVES : blk;
        const size_t on = (size_t)nblk * 32 * 64;
        int acc[8];
#pragma unroll
        for (int i = 0; i < 8; ++i) acc[i] = 0;
        LROW(rw[0], iq[0]);
#pragma unroll
        for (int j = 0; j < 32; ++j) {
            if (j + 1 < 32) LROW(rw[(j + 1) & 1], iq[(j + 1) % PD]);
            const unsigned aw = aq[j % PD];
            unsigned cl[4], ch[4];
            tr4x4(rw[j & 1][0].x, rw[j & 1][1].x, rw[j & 1][2].x, rw[j & 1][3].x, cl);
            tr4x4(rw[j & 1][0].y, rw[j & 1][1].y, rw[j & 1][2].y, rw[j & 1][3].y, ch);
#pragma unroll
            for (int i = 0; i < 4; ++i) { acc[i] = __builtin_amdgcn_sdot4((int)aw, (int)cl[i], acc[i], false); acc[4 + i] = __builtin_amdgcn_sdot4((int)aw, (int)ch[i], acc[4 + i], false); }
            { const size_t oo = (j + PD < 32) ? o + (size_t)(j + PD) * 64 : on + (size_t)(j + PD - 32) * 64;
              iq[j % PD] = *(const GAS v4u*)(ibase + oo); aq[j % PD] = abase[oo]; }
            __builtin_amdgcn_sched_barrier(0);
        }
        const float asc = F.ASCALE()[t];
        float accf[8];
#pragma unroll
        for (int i = 0; i < 8; ++i) accf[i] = (float)acc[i] * asc;
        const v4u hb = *(const GAS v4u*)(F.HBT() + ((size_t)c * M + t) * 8);
        accf[0] += bf_lo(hb.x); accf[1] += bf_hi(hb.x); accf[2] += bf_lo(hb.y); accf[3] += bf_hi(hb.y);
        accf[4] += bf_lo(hb.z); accf[5] += bf_hi(hb.z); accf[6] += bf_lo(hb.w); accf[7] += bf_hi(hb.w);
        bf16* yp = (MODE == 0) ? F.Y() + ((size_t)c * M + t) * 8 : (bf16*)F.XN() + ((((size_t)c * M + t) * 8) & (size_t)0x1ffffff);
        *(GAS v4u*)yp = (v4u){pk2(accf[0], accf[1]), pk2(accf[2], accf[3]), pk2(accf[4], accf[5]), pk2(accf[6], accf[7])};
        float ss = 0.f;
#pragma unroll
        for (int i = 0; i < 8; ++i) ss += accf[i] * accf[i];
        if (do_atomic) atomicAdd(F.ROWSS2() + t, ss);
    }
#undef LROW
    __syncthreads();
}
__device__ __forceinline__ void final_unit(Frame& F, int unit) {
    const int tid = F.tid, blk = unit >> 3, cg = unit & 7, t0 = blk * 64;
    LAS float* T = (LAS float*)F.lds;
#pragma unroll
    for (int i = 0; i < 4; ++i) { const int pid = tid + 512 * i, cl = pid >> 6, tok = pid & 63;
        const v4u v = *(const GAS v4u*)(F.Y() + ((size_t)(cg * 32 + cl) * M + t0 + tok) * 8);
        *(LAS f32x4*)(T + tok * 260 + cl * 8) = (f32x4){bf_lo(v.x), bf_hi(v.x), bf_lo(v.y), bf_hi(v.y)};
        *(LAS f32x4*)(T + tok * 260 + cl * 8 + 4) = (f32x4){bf_lo(v.z), bf_hi(v.z), bf_lo(v.w), bf_hi(v.w)}; }
    __syncthreads();
#pragma unroll
    for (int i = 0; i < 8; ++i) { const int pid = tid + 512 * i, tok = pid >> 6, c4 = pid & 63;
        const float rs = __builtin_amdgcn_rsqf(F.ROWSS2()[t0 + tok] * (1.0f / D) + 1e-6f);
        const f32x4 v = *(const LAS f32x4*)(T + tok * 260 + c4 * 4);
        const f32x4 g = *(const GAS f32x4*)(F.A.in[20] + cg * 256 + c4 * 4);
        *(GAS f32x4*)(F.A.out + (size_t)(t0 + tok) * D + cg * 256 + c4 * 4) = v * rs * g; }
    __syncthreads();
}
__global__ void __launch_bounds__(NWAVES * 64, 2) mk_fwd(Args args) {
    __shared__ __attribute__((aligned(16))) unsigned char lds[LDS_BYTES];
    Frame F(args);
    F.lds = (LAS unsigned char*)lds;
    F.MISC = (volatile LAS unsigned*)(F.lds + MISC_OFF);
    F.tid = threadIdx.x; F.lane = F.tid & 63; F.wave = __builtin_amdgcn_readfirstlane(F.tid >> 6);
    F.G = gridDim.x; { const int bx = blockIdx.x; F.vcu = (F.G % 8 == 0) ? (bx % 8) * (F.G / 8) + bx / 8 : bx; }
    F.ws = args.ws;
    F.ctl = (gu32*)(args.ws + WS_CTL);
    for (int u = F.tid; u < (LDS_BYTES - LDSCTL_OFF) / 4; u += NWAVES * 64) ((LAS unsigned*)(F.lds + LDSCTL_OFF))[u] = 0u;
    __syncthreads();
    XcdBarrier bar; bar.bar = (unsigned*)(F.ctl + CW_BAR); bar.x = 0; bar.st = nullptr;
    if (N_LAUNCHES != PER_PHASE) bar = xcd_barrier_post((unsigned*)(F.ctl + CW_BAR), F.MISC + 8);
#define GRID_BAR() do { if (N_LAUNCHES != PER_PHASE) xcd_barrier(bar); } while (0)
    const int lo = args.ph_lo, hi = args.ph_hi;
#ifndef MK_PHASE_MASK
#define MK_PHASE_MASK 0x7FF
#endif
#define IN(k) (((MK_PHASE_MASK >> (k)) & 1) && lo <= (k) && (k) < hi)
#undef MK_PHASE_MASK
#define MK_PHASE_MASK 0xFFFF
#define BOTH(k) (true)
#ifndef MK_REP_MASK
#define MK_REP_MASK 0
#endif
#ifndef MK_REP_N
#define MK_REP_N 2
#endif
#ifndef H8_REP
#define H8_REP 1
#endif
#define REPS(k) for (int rep_ = 0; rep_ < ((((MK_REP_MASK) >> (k)) & 1) ? 1 + MK_REP_N : 1); ++rep_)
    const int gw = F.vcu * NWAVES + F.wave, NGW = F.G * NWAVES;
    if (IN(0)) { REPS(0) { p0_prologue(F); __syncthreads(); } if (BOTH(0)) GRID_BAR(); }
    if (IN(1)) {
        pg8::Gemm g{F.XN(), F.WIN(), M, NIN, D}; pg8::StaticOrder S; S.init(M, NIN, F.G, (int)blockIdx.x);
        pg8::EpiZ E{F.Z(), NIN, LW};
        REPS(1) pg8::gemm_phase<pg8::EpiZ, pg8::StaticOrder, true, true>(F.lds, g, S, E);
        if (BOTH(1)) GRID_BAR();
    }
    if (IN(2)) {
        REPS(12) { v4u xr[5]; int u = blockIdx.x; lru_prefetch(F, u, F.tid, xr); lru_conv(F, u, F.tid, xr); __syncthreads();
                   for (; u < BATCH * NCHUNK * 8; u += F.G) lru_fused_unit(F, u, u + F.G < BATCH * NCHUNK * 8 ? u + F.G : -1, xr); }
        asm volatile("" : "+v"(F.tid), "+v"(F.lane));
        REPS(13) for (int u = blockIdx.x; u < BATCH * NCHUNK; u += F.G) gmlp_unit(F, u);
        if (BOTH(2)) GRID_BAR();
    }
    if (IN(4)) {
        pg8::Gemm g{F.MIX(), F.WOUT(), M, D, D}; pg8::StaticOrder S; S.init(M, D, F.G, (int)blockIdx.x);
        pg8::EpiH E{F.HB(), F.HBT(), F.A.in[0], F.ROWSS(), D, M};
        pg8::gemm_phase<pg8::EpiH, pg8::StaticOrder, true, true>(F.lds, g, S, E);
        if (BOTH(4)) GRID_BAR();
    }
    if (IN(5)) {
        pg8::Gemm g{F.HB(), F.WQ(), M, D, D}; pg8::StaticOrder S; S.init(M, D, F.G, (int)blockIdx.x);
        pg8::EpiQ E{F.QH(), F.ROWSS(), D};
        REPS(5) pg8::gemm_phase<pg8::EpiQ, pg8::StaticOrder, true, true>(F.lds, g, S, E);
        if (BOTH(5)) GRID_BAR();
    }
    if (IN(6)) {
        REPS(6) { int hk = 0;
                  for (int wu = gw; wu < (M / 32) * 8; wu += NGW) { const bool doh = gw + NGW * (hk + 3) < M; topk_unit(F, wu, doh, gw + NGW * hk, NGW); if (doh) hk += 4; }
                  for (int t = gw + NGW * hk; t < M; t += NGW) h8_row(F, t); }
        if (BOTH(6)) GRID_BAR();
    }
    if (IN(7)) {
        REPS(7) peer_u_xcd(F);
        if (BOTH(7)) GRID_BAR();
    }
    if (IN(8)) {
        REPS(8) for (int t = gw; t < M; t += NGW) peer_act_token(F, t);
        if (BOTH(8)) GRID_BAR();
    }
    if (IN(9)) {
        for (int c = blockIdx.x; c < D / 8; c += F.G) peer_v_slice<0>(F, c, true);
        if ((MK_REP_MASK >> 9) & 1) { for (int rep_ = 0; rep_ < MK_REP_N; ++rep_) for (int c = blockIdx.x; c < D / 8; c += F.G) peer_v_slice<1>(F, c, false); }
        if (BOTH(9)) GRID_BAR();
    }
    if (IN(10)) {
        REPS(10) for (int u = blockIdx.x; u < (M / 64) * 8; u += F.G) final_unit(F, u);
    }
#undef IN
#undef BOTH
#undef GRID_BAR
}

extern "C" void kernel_launch(void* const* d_in, const int* in_sizes, int n_in, void* d_out, int out_size, void* d_ws, size_t ws_size, hipStream_t stream) {
    static int grid = 0;
    if (grid == 0) {
        if (n_in != 21 || in_sizes[0] != M * D || out_size != M * D || ws_size < WS_END) { fprintf(stderr, "kernel_launch: unexpected shapes (n_in %d, in0 %d, out %d, ws %zu)\n", n_in, n_in > 0 ? in_sizes[0] : -1, out_size, ws_size); grid = -1; return; }
        int dev = 0, cus = 0, per_cu = 0;
        if (hipGetDevice(&dev) != hipSuccess || hipDeviceGetAttribute(&cus, hipDeviceAttributeMultiprocessorCount, dev) != hipSuccess) { grid = -1; return; }
        if (hipOccupancyMaxActiveBlocksPerMultiprocessor(&per_cu, (const void*)mk_fwd, NWAVES * 64, 0) != hipSuccess || per_cu < 1) { fprintf(stderr, "kernel_launch: occupancy query reports %d blocks per CU\n", per_cu); }
        (void)hipGetLastError();
        grid = cus;
        if (cus < 256) { fprintf(stderr, "kernel_launch: the RG-LRU family hand-off needs >= 256 co-resident workgroups (have %d)\n", cus); grid = -1; return; }
    }
    if (grid < 0) return;
    (void)hipMemsetAsync((char*)d_ws + WS_CTL, 0, CTL_ZERO_BYTES, stream);
    Args a{};
    for (int i = 0; i < 21; ++i) a.in[i] = (const float*)d_in[i];
    a.out = (float*)d_out; a.ws = (unsigned char*)d_ws;
    for (int li = 0; li < N_LAUNCHES; ++li) {
        a.ph_lo = 0; a.ph_hi = 99;
        hipLaunchKernelGGL(mk_fwd, dim3(grid), dim3(NWAVES * 64), 0, stream, a);
    }
}
```

```cpp
#include <hip/hip_runtime.h>
#include <cstdio>
#include <cstdint>
namespace pg8 {
#define PG8_LAS __attribute__((address_space(3)))
typedef unsigned short bf16_t;
typedef short bf16x8 __attribute__((ext_vector_type(8)));
typedef float f32x4 __attribute__((ext_vector_type(4)));
typedef unsigned u32x4 __attribute__((ext_vector_type(4)));
constexpr int BM = 256, BK = 64, HALF = 128, HTB = HALF * BK * 2  , STAGE_BYTES = 8 * HTB, NXCD = 8, WGM = 8;

__host__ __device__ __forceinline__ int lds_byte(int r, int c) { const int st = (r >> 4) * 2 + (c >> 5), rr = r & 15, cc = c & 31, ob = rr * 64 + cc * 2; return st * 1024 + (ob ^ (((ob >> 9) & 1) << 5)); }
__host__ __device__ __forceinline__ void stage_rc(int b, int& R, int& C) { const int st = b / 1024, sb = b % 1024, swz = sb ^ (((sb >> 9) & 1) << 5); R = (st >> 1) * 16 + swz / 64; C = (st & 1) * 32 + (swz % 64) / 2; }
__host__ __device__ __forceinline__ int perm32(int rho) { const int n = rho >> 4, i = rho & 15; return 8 * (i >> 2) + 4 * n + (i & 3); }

struct Unit { int pm, pn; };
struct Gemm { const bf16_t* A; const bf16_t* Bt; int M, N, K; };

struct StaticOrder {
    int nM, nN, nwg, G, c;
    __host__ __device__ void init(int M, int N, int G_, int c_) { nM = M / BM; nN = N / BM; nwg = nM * nN; G = G_; c = c_; }
    __host__ __device__ bool next(int i, Unit& u) const {
        const long L = (long)i * G + c; if (L >= nwg) return false;
        int wgid = (int)L; { const int q = nwg / NXCD, r = nwg % NXCD, xcd = wgid % NXCD, off = wgid / NXCD; wgid = (xcd < r ? xcd * (q + 1) : r * (q + 1) + (xcd - r) * q) + off; }
        const int nig = WGM * nN, gid = wgid / nig, fm = gid * WGM, gsz = (nM - fm) < WGM ? (nM - fm) : WGM;
        u.pm = fm + ((wgid % nig) % gsz); u.pn = (wgid % nig) / gsz; return true;
    }
    __device__ __forceinline__ void a_ready(const Unit&) const {}
    __device__ __forceinline__ void done(const Unit&) const {}
};

__device__ __forceinline__ unsigned cvt_pk_bf16(float lo, float hi) { unsigned r; asm volatile("v_cvt_pk_bf16_f32 %0, %1, %2" : "=v"(r) : "v"(lo), "v"(hi)); return r; }
__device__ __forceinline__ float gelu_tanh(float x) {
    const float t = x * (1.0f + 0.044715f * x * x);
    const float e = __builtin_amdgcn_exp2f(-2.3022081983f * t);
    return x * __builtin_amdgcn_rcpf(1.0f + e);
}
struct EpiZ {
    static constexpr bool PERM = true, AFTER_DRAIN = false;
    bf16_t* O; int ldc; int gelu_from;
    __device__ __forceinline__ void operator()(const f32x4 (&acc)[2][2][4][2], const Unit& u, int wr, int wc, int fr, int fq) const {
        const int row0 = u.pm * BM + wr * 64 + fr; const int col0 = u.pn * BM + wc * 32 + 8 * fq;
        const bool act = (u.pn * BM) >= gelu_from;
#pragma unroll
        for (int ai = 0; ai < 2; ++ai)
#pragma unroll
            for (int m = 0; m < 4; ++m) { bf16_t* rowp = O + (size_t)(row0 + ai * HALF + m * 16) * ldc + col0;
#pragma unroll
                for (int bj = 0; bj < 2; ++bj) { f32x4 v0 = acc[ai][bj][m][0], v1 = acc[ai][bj][m][1];
                    if (act) {
#pragma unroll
                        for (int j = 0; j < 4; ++j) { v0[j] = gelu_tanh(v0[j]); v1[j] = gelu_tanh(v1[j]); } }
                    u32x4 w; w.x = cvt_pk_bf16(v0[0], v0[1]); w.y = cvt_pk_bf16(v0[2], v0[3]); w.z = cvt_pk_bf16(v1[0], v1[1]); w.w = cvt_pk_bf16(v1[2], v1[3]);
                    *(u32x4*)(rowp + bj * HALF) = w; } }
    }
};
struct EpiH {
    static constexpr bool PERM = true, AFTER_DRAIN = false;
    bf16_t* O; bf16_t* OT; const float* X; float* rowss; int ldc; int mrows;
    __device__ __forceinline__ void operator()(const f32x4 (&acc)[2][2][4][2], const Unit& u, int wr, int wc, int fr, int fq) const {
        const int row0 = u.pm * BM + wr * 64 + fr; const int col0 = u.pn * BM + wc * 32 + 8 * fq;
#pragma unroll
        for (int ai = 0; ai < 2; ++ai)
#pragma unroll
            for (int m = 0; m < 4; ++m) { const int row = row0 + ai * HALF + m * 16; const size_t off = (size_t)row * ldc + col0; float ss = 0.f;
#pragma unroll
                for (int bj = 0; bj < 2; ++bj) {
                    const f32x4 x0 = *(const f32x4*)(X + off + bj * HALF), x1 = *(const f32x4*)(X + off + bj * HALF + 4);
                    const f32x4 v0 = acc[ai][bj][m][0] + x0, v1 = acc[ai][bj][m][1] + x1;
                    ss += (v0[0] * v0[0] + v0[1] * v0[1]) + (v0[2] * v0[2] + v0[3] * v0[3]) + (v1[0] * v1[0] + v1[1] * v1[1]) + (v1[2] * v1[2] + v1[3] * v1[3]);
                    u32x4 w; w.x = cvt_pk_bf16(v0[0], v0[1]); w.y = cvt_pk_bf16(v0[2], v0[3]); w.z = cvt_pk_bf16(v1[0], v1[1]); w.w = cvt_pk_bf16(v1[2], v1[3]);
                    *(u32x4*)(O + off + bj * HALF) = w;
                    *(u32x4*)(OT + ((size_t)((col0 + bj * HALF) >> 3) * mrows + row) * 8) = w; }
                ss += __shfl_xor(ss, 16); ss += __shfl_xor(ss, 32);
                if (fq == 0) atomicAdd(rowss + row, ss); }
    }
};
struct EpiQ {
    static constexpr bool PERM = true, AFTER_DRAIN = false;
    bf16_t* QH; const float* rowss; int ldc;
    __device__ __forceinline__ void operator()(const f32x4 (&acc)[2][2][4][2], const Unit& u, int wr, int wc, int fr, int fq) const {
        const int row0 = u.pm * BM + wr * 64 + fr, col0 = u.pn * BM + wc * 32 + 8 * fq;
#pragma unroll
        for (int ai = 0; ai < 2; ++ai)
#pragma unroll
            for (int m = 0; m < 4; ++m) { const int row = row0 + ai * HALF + m * 16; const float rs = __builtin_amdgcn_rsqf(rowss[row] * (1.0f / 2048.0f) + 1e-6f);
                const size_t off = (size_t)row * ldc + col0;
#pragma unroll
                for (int bj = 0; bj < 2; ++bj) { const f32x4 v0 = acc[ai][bj][m][0] * rs, v1 = acc[ai][bj][m][1] * rs;
                    u32x4 wh; wh.x = cvt_pk_bf16(v0[0], v0[1]); wh.y = cvt_pk_bf16(v0[2], v0[3]); wh.z = cvt_pk_bf16(v1[0], v1[1]); wh.w = cvt_pk_bf16(v1[2], v1[3]);
                    *(u32x4*)(QH + off + bj * HALF) = wh; } }
    }
};
template <class Epi, class Sched, bool ALIGN_EPI = false, bool SP2 = false>
__device__ __forceinline__ void gemm_phase(PG8_LAS unsigned char* lds, const Gemm g, const Sched& S, const Epi& E) {
    const int tid = threadIdx.x, wid = __builtin_amdgcn_readfirstlane(tid >> 6), lane = tid & 63, wr = wid >> 2, wc = wid & 3, fr = lane & 15, fq = lane >> 4;
    const int K = g.K, nt = K / BK;
    unsigned voffA[2], voffB[2];
#pragma unroll
    for (int i = 0; i < 2; ++i) { int R, C; stage_rc(tid * 16 + i * 8192, R, C); const int Rb = Epi::PERM ? ((R & ~31) + perm32(R & 31)) : R;
        voffA[i] = (unsigned)(R * K + C) * 2u; voffB[i] = (unsigned)(Rb * K + C) * 2u; }
    const size_t kstep = (size_t)(BK * 2);
    const size_t hstep = (size_t)HALF * K * 2;
    const size_t tstep = 2 * hstep;
    const unsigned ldsw = (unsigned)wid * 1024u;
    const int aoff = lds_byte(wr * 64 + fr, fq * 8), boff = lds_byte(wc * 32 + fr, fq * 8);
#define PG8_SA(b, h) (((b) * 2 + (h)) * HTB)
#define PG8_SB(b, h) ((4 + (b) * 2 + (h)) * HTB)
#define PG8_STAGE(bufoff, gbase, voff) do { _Pragma("unroll") for (int _i = 0; _i < 2; ++_i) \
        __builtin_amdgcn_global_load_lds((const unsigned*)((const char*)(gbase) + (voff)[_i]), (PG8_LAS unsigned*)(lds + (bufoff) + ldsw + _i * 8192), 16, 0, 0); } while (0)
#define PG8_LDA(dst, b, h) do { _Pragma("unroll") for (int m = 0; m < 4; ++m) _Pragma("unroll") for (int k = 0; k < 2; ++k) dst[m][k] = *(const PG8_LAS bf16x8*)(lds + PG8_SA(b, h) + aoff + m * 2048 + k * 1024); } while (0)
#define PG8_LDB(dst, b, h) do { _Pragma("unroll") for (int n = 0; n < 2; ++n) _Pragma("unroll") for (int k = 0; k < 2; ++k) dst[n][k] = *(const PG8_LAS bf16x8*)(lds + PG8_SB(b, h) + boff + n * 2048 + k * 1024); } while (0)
#define PG8_MMA(ai, bj, At, Bt) do { __builtin_amdgcn_s_setprio(1); _Pragma("unroll") for (int m = 0; m < 4; ++m) _Pragma("unroll") for (int n = 0; n < 2; ++n) _Pragma("unroll") for (int k = 0; k < 2; ++k) \
        acc[ai][bj][m][n] = __builtin_amdgcn_mfma_f32_16x16x32_bf16(Bt[n][k], At[m][k], acc[ai][bj][m][n], 0, 0, 0); __builtin_amdgcn_s_setprio(0); } while (0)
#define PG8_WAIT_V(n) asm volatile("s_waitcnt vmcnt(" #n ")" ::: "memory")
#define PG8_WAIT_L(n) asm volatile("s_waitcnt lgkmcnt(" #n ")" ::: "memory")
#define PG8_BAR __builtin_amdgcn_s_barrier()
#define PG8_SCHED __builtin_amdgcn_sched_barrier(0)
    Unit cur, nxt; int ui = 0;
    if (!S.next(0, cur)) return;
    f32x4 acc[2][2][4][2];
#pragma unroll
    for (int a = 0; a < 2; ++a)
#pragma unroll
        for (int b = 0; b < 2; ++b)
#pragma unroll
            for (int m = 0; m < 4; ++m)
#pragma unroll
                for (int n = 0; n < 2; ++n) acc[a][b][m][n] = (f32x4){0.f, 0.f, 0.f, 0.f};
    bf16x8 At[4][2], B0[2][2], B1[2][2];
    const char* cA = (const char*)g.A + (size_t)cur.pm * tstep; const char* cB = (const char*)g.Bt + (size_t)cur.pn * tstep;
    S.a_ready(cur);
    if constexpr (SP2) {
        PG8_STAGE(PG8_SB(0, 0), cB, voffB); PG8_STAGE(PG8_SB(0, 1), cB + hstep, voffB); PG8_STAGE(PG8_SA(0, 0), cA, voffA); PG8_STAGE(PG8_SA(0, 1), cA + hstep, voffA);
        if (wr == 1) PG8_BAR;
        PG8_WAIT_V(2); PG8_BAR;
        PG8_STAGE(PG8_SB(1, 0), cB + kstep, voffB); PG8_STAGE(PG8_SA(1, 0), cA + kstep, voffA); PG8_STAGE(PG8_SB(1, 1), cB + hstep + kstep, voffB);
        PG8_WAIT_V(6); PG8_BAR;
    } else {
        PG8_STAGE(PG8_SB(0, 0), cB, voffB); PG8_STAGE(PG8_SA(0, 0), cA, voffA); PG8_STAGE(PG8_SB(0, 1), cB + hstep, voffB); PG8_STAGE(PG8_SA(0, 1), cA + hstep, voffA);
        if (wr == 1) PG8_BAR;
        PG8_WAIT_V(4); PG8_BAR;
        PG8_STAGE(PG8_SB(1, 0), cB + kstep, voffB); PG8_STAGE(PG8_SA(1, 0), cA + kstep, voffA); PG8_STAGE(PG8_SB(1, 1), cB + hstep + kstep, voffB);
        PG8_WAIT_V(6); PG8_BAR;
    }
    for (;;) {
        const bool has_next = S.next(ui + 1, nxt);
        const char* nA = has_next ? (const char*)g.A + (size_t)nxt.pm * tstep : cA; const char* nB = has_next ? (const char*)g.Bt + (size_t)nxt.pn * tstep : cB;
        for (int t = 0; t < nt; t += 2) {
            const bool last = (t == nt - 2);
            const char* a1 = cA + (size_t)(t + 1) * kstep;
            const char* a2 = last ? nA : cA + (size_t)(t + 2) * kstep; const char* b2 = last ? nB : cB + (size_t)(t + 2) * kstep;
            const char* a3 = a2 + kstep; const char* b3 = b2 + kstep;
            if (last && has_next) S.a_ready(nxt);
            if constexpr (SP2) {
            PG8_LDB(B0, 0, 0); PG8_LDB(B1, 0, 1); PG8_SCHED; PG8_LDA(At, 0, 0); PG8_STAGE(PG8_SA(1, 1), a1 + hstep, voffA);
            PG8_WAIT_V(8); PG8_WAIT_L(0); PG8_BAR; PG8_MMA(0, 0, At, B0); PG8_MMA(0, 1, At, B1); PG8_BAR; PG8_SCHED;
            PG8_LDA(At, 0, 1); PG8_STAGE(PG8_SB(0, 0), b2, voffB); PG8_STAGE(PG8_SB(0, 1), b2 + hstep, voffB); PG8_STAGE(PG8_SA(0, 0), a2, voffA);
            PG8_WAIT_V(8); PG8_WAIT_L(0); PG8_BAR; PG8_MMA(1, 0, At, B0); PG8_MMA(1, 1, At, B1); PG8_BAR; PG8_SCHED;
            PG8_LDB(B0, 1, 0); PG8_LDB(B1, 1, 1); PG8_SCHED; PG8_LDA(At, 1, 0); PG8_STAGE(PG8_SA(0, 1), a2 + hstep, voffA);
            PG8_WAIT_V(8); PG8_WAIT_L(0); PG8_BAR; PG8_MMA(0, 0, At, B0); PG8_MMA(0, 1, At, B1); PG8_BAR; PG8_SCHED;
            PG8_LDA(At, 1, 1); PG8_STAGE(PG8_SB(1, 0), b3, voffB); PG8_STAGE(PG8_SB(1, 1), b3 + hstep, voffB); PG8_STAGE(PG8_SA(1, 0), a3, voffA);
            PG8_WAIT_V(8); PG8_WAIT_L(0); PG8_BAR; PG8_MMA(1, 0, At, B0); PG8_MMA(1, 1, At, B1); PG8_BAR; PG8_SCHED;
            } else {
            PG8_LDB(B0, 0, 0); PG8_SCHED; PG8_LDA(At, 0, 0); PG8_STAGE(PG8_SA(1, 1), a1 + hstep, voffA);
            PG8_WAIT_L(8); PG8_BAR; PG8_WAIT_L(0); PG8_MMA(0, 0, At, B0); PG8_BAR; PG8_SCHED;
            PG8_LDB(B1, 0, 1); PG8_STAGE(PG8_SB(0, 0), b2, voffB);
            PG8_BAR; PG8_WAIT_L(0); PG8_MMA(0, 1, At, B1); PG8_BAR;
            PG8_LDA(At, 0, 1); PG8_STAGE(PG8_SA(0, 0), a2, voffA);
            PG8_BAR; PG8_WAIT_L(0); PG8_MMA(1, 0, At, B0); PG8_BAR; PG8_SCHED;
            PG8_STAGE(PG8_SB(0, 1), b2 + hstep, voffB);
            PG8_WAIT_V(6); PG8_BAR; PG8_MMA(1, 1, At, B1); PG8_BAR;
            PG8_LDB(B0, 1, 0); PG8_SCHED; PG8_LDA(At, 1, 0); PG8_STAGE(PG8_SA(0, 1), a2 + hstep, voffA);
            PG8_WAIT_L(8); PG8_BAR; PG8_WAIT_L(0); PG8_MMA(0, 0, At, B0); PG8_BAR; PG8_SCHED;
            PG8_LDB(B1, 1, 1); PG8_STAGE(PG8_SB(1, 0), b3, voffB);
            PG8_BAR; PG8_WAIT_L(0); PG8_MMA(0, 1, At, B1); PG8_BAR;
            PG8_LDA(At, 1, 1); PG8_STAGE(PG8_SA(1, 0), a3, voffA);
            PG8_BAR; PG8_WAIT_L(0); PG8_MMA(1, 0, At, B0); PG8_BAR; PG8_SCHED;
            PG8_STAGE(PG8_SB(1, 1), b3 + hstep, voffB);
            PG8_WAIT_V(6); PG8_BAR; PG8_MMA(1, 1, At, B1); PG8_BAR;
            }
        }
        if constexpr (ALIGN_EPI) { if (wr == 0) PG8_BAR; }
        if constexpr (!Epi::AFTER_DRAIN) { E(acc, cur, wr, wc, fr, fq); S.done(cur); }
        if (!has_next) break;
#pragma unroll
        for (int a = 0; a < 2; ++a)
#pragma unroll
            for (int b = 0; b < 2; ++b)
#pragma unroll
                for (int m = 0; m < 4; ++m)
#pragma unroll
                    for (int n = 0; n < 2; ++n) acc[a][b][m][n] = (f32x4){0.f, 0.f, 0.f, 0.f};
        cur = nxt; cA = nA; cB = nB; ++ui;
        if constexpr (ALIGN_EPI) { if (wr == 1) PG8_BAR; }
    }
    PG8_WAIT_V(0);
    if constexpr (!ALIGN_EPI) { if (wr == 0) PG8_BAR; }
    PG8_BAR;
    if constexpr (Epi::AFTER_DRAIN) { E.fused(acc, cur, wr, wc, fr, fq, lds, wid, lane); S.done(cur); }
#undef PG8_SA
#undef PG8_SB
#undef PG8_STAGE
#undef PG8_LDA
#undef PG8_LDB
#undef PG8_MMA
#undef PG8_WAIT_V
#undef PG8_WAIT_L
#undef PG8_BAR
#undef PG8_SCHED
}
}
constexpr int NWAVES = 8;
constexpr int BATCH = 4, SEQ = 8192, D = 2048, M = BATCH * SEQ, NIN = 4096, LW = 1024, CHUNK = 128, NCHUNK = SEQ / CHUNK;
constexpr int NEXP = 16384;
#ifndef MK_N_LAUNCHES
#define MK_N_LAUNCHES 1
#endif
constexpr int N_LAUNCHES = MK_N_LAUNCHES;
constexpr int PER_PHASE = 11;
constexpr size_t MiB = 1u << 20;
constexpr size_t WS_CTL = 48 * MiB, CTL_ZERO_BYTES = 5 * MiB;
constexpr size_t WS_ROWSS = WS_CTL + 512 * 1024;
constexpr size_t WS_WIN = 2 * MiB, WS_WOUT = 18 * MiB, WS_WQ = 26 * MiB, WS_LRUW = 34 * MiB, WS_WSB = 35 * MiB, WS_AGG = 49 * MiB;
constexpr size_t WS_U = 64 * MiB, WS_V = 128 * MiB, WS_XN = 192 * MiB  , WS_Z = 320 * MiB  ;
constexpr size_t WS_HB = 576 * MiB, WS_IDS = 704 * MiB, WS_GATES = 720 * MiB, WS_PAIRS = 736 * MiB, WS_HBT = 752 * MiB, WS_END = 884 * MiB;
constexpr size_t WS_USCALE = 40 * MiB, WS_VSCALE = 41 * MiB;
constexpr size_t WS_HSCALE = 44 * MiB, WS_CARRY = 45 * MiB;
constexpr size_t WS_H8 = WS_XN, WS_PART = WS_XN + 64 * MiB;
constexpr size_t WS_ASCALE = 42 * MiB, WS_KH = 43 * MiB;
constexpr size_t WS_IDW = WS_PAIRS, WS_AW = 880 * MiB;
constexpr size_t WS_ROWSS2 = WS_CTL + 640 * 1024;
constexpr size_t WS_Y = WS_Z;
constexpr int CW_BAR = 4096;
constexpr int CW_LRUF = 8192;
constexpr int RING_BYTES = 131072;
constexpr int LDSCTL_OFF = 143360, MISC_OFF = LDSCTL_OFF + 320;
constexpr int LDS_BYTES = 147456;
#define GAS __attribute__((address_space(1)))
#define LAS __attribute__((address_space(3)))
typedef unsigned short bf16;
typedef unsigned v4u __attribute__((ext_vector_type(4)));
typedef float f32x4 __attribute__((ext_vector_type(4)));
typedef short bf16x8 __attribute__((ext_vector_type(8)));
typedef GAS unsigned gu32;
typedef GAS unsigned long long gu64;
#define RLX_AGENT __ATOMIC_RELAXED, __HIP_MEMORY_SCOPE_AGENT
#define LDS_WAIT() asm volatile("s_waitcnt lgkmcnt(0)" ::: "memory")
#define VM_WAIT() asm volatile("s_waitcnt vmcnt(0)" ::: "memory")
__device__ __forceinline__ unsigned long long rt() { return __builtin_amdgcn_s_memrealtime(); }
__device__ __forceinline__ unsigned f2bf(float f) { unsigned u = __builtin_bit_cast(unsigned, f); return (u + 0x7fffu + ((u >> 16) & 1u)) >> 16; }
__device__ __forceinline__ unsigned pk2(float lo, float hi) { return f2bf(lo) | (f2bf(hi) << 16); }

#define XB_TMO      128
#define XB_XCNT(j)  (256  + 64 * (j))
#define XB_XSUB(j)  (1280 + 64 * (j))
#define XB_XGEN(j)  (2304 + 64 * (j))
#define XB_TOP      3328
#define XB_TOPGEN   3392
#define XCD_BAR_WORDS 3456
#define XB_SPIN_CAP (1u << 18)

__device__ __forceinline__ unsigned xb_ld(unsigned* p)              { return __hip_atomic_load(p, __ATOMIC_RELAXED, __HIP_MEMORY_SCOPE_AGENT); }
__device__ __forceinline__ unsigned xb_add(unsigned* p, unsigned v) { return __hip_atomic_fetch_add(p, v, __ATOMIC_RELAXED, __HIP_MEMORY_SCOPE_AGENT); }
__device__ __forceinline__ unsigned xb_xcc_id() { return (unsigned)__builtin_amdgcn_s_getreg((3 << 11) | 20) & 0xFu; }
#define XB_SPIN(cond, bar) do { unsigned _sp = 0; while (cond) { __builtin_amdgcn_s_sleep(1); \
    if ((++_sp & 255u) == 0u) { if (xb_ld(&(bar)[XB_TMO])) break; if (_sp > XB_SPIN_CAP) { atomicAdd(&(bar)[XB_TMO], 1u); break; } } } } while (0)

struct XcdBarrier {
    unsigned* bar; unsigned x;
    volatile LAS unsigned* st;
};

__device__ __forceinline__ XcdBarrier xcd_barrier_post(unsigned* bar, volatile LAS unsigned* st) {
    XcdBarrier b; b.bar = bar; b.x = xb_xcc_id(); b.st = st;
    if (threadIdx.x == 0) (void)xb_add(&bar[XB_XCNT(b.x)], 1u);
    return b;
}
__device__ __forceinline__ void xcd_barrier_complete(unsigned* bar, unsigned x, unsigned& nloc, unsigned& nx) {
    const unsigned G = gridDim.x * gridDim.y * gridDim.z;
    unsigned sum, cnt, mine, sp = 0u;
    for (;;) {
        sum = 0u; cnt = 0u; mine = 0u;
#pragma unroll
        for (unsigned j = 0; j < 16; ++j) { const unsigned c = xb_ld(&bar[XB_XCNT(j)]); sum += c; cnt += (c > 0u) ? 1u : 0u; mine = (j == x) ? c : mine; }
        if (sum == G) break;
        __builtin_amdgcn_s_sleep(1);
        if ((++sp & 255u) == 0u) { if (xb_ld(&bar[XB_TMO])) break; if (sp > XB_SPIN_CAP) { atomicAdd(&bar[XB_TMO], 1u); break; } }
    }
    nloc = mine > 0u ? mine : 1u; nx = cnt > 0u ? cnt : 1u;
}

__device__ __forceinline__ void xcd_barrier(const XcdBarrier& b) {
    asm volatile("s_waitcnt vmcnt(0)" ::: "memory");
    __syncthreads();
    if (threadIdx.x == 0) {
        unsigned* bar = b.bar;
        __builtin_amdgcn_s_waitcnt(0);
        unsigned nloc = b.st[0], nx = b.st[1];
        if (nloc == 0u) { xcd_barrier_complete(bar, b.x, nloc, nx); b.st[0] = nloc; b.st[1] = nx; }
        const unsigned old = xb_add(&bar[XB_XSUB(b.x)], 1u);
        const unsigned gen = old / nloc;
        if (old + 1u == (gen + 1u) * nloc) {
            __builtin_amdgcn_fence(__ATOMIC_RELEASE, "agent");
            asm volatile("s_waitcnt vmcnt(0)" ::: "memory");
            const unsigned og = xb_add(&bar[XB_TOP], 1u);
            const unsigned tg = og / nx;
            if (og + 1u == (tg + 1u) * nx) xb_add(&bar[XB_TOPGEN], 1u);
            else XB_SPIN(xb_ld(&bar[XB_TOPGEN]) == tg, bar);
            __builtin_amdgcn_fence(__ATOMIC_ACQUIRE, "agent");
            xb_add(&bar[XB_XGEN(b.x)], 1u);
            asm volatile("s_waitcnt vmcnt(0)" ::: "memory");
        } else {
            XB_SPIN(xb_ld(&bar[XB_XGEN(b.x)]) == gen, bar);
            __builtin_amdgcn_fence(__ATOMIC_ACQUIRE, "agent");
            asm volatile("s_waitcnt vmcnt(0)" ::: "memory");
        }
    }
    __syncthreads();
}
typedef unsigned v2u __attribute__((ext_vector_type(2)));
typedef float f32x2 __attribute__((ext_vector_type(2)));
struct Args { const float* in[21]; float* out; unsigned char* ws; int ph_lo, ph_hi; };
struct Frame {
    const Args& A;
    LAS unsigned char* lds;
    volatile LAS unsigned* MISC;
    gu32* ctl;
    unsigned char* ws;
    int tid, lane, wave, vcu, G;
    __device__ __forceinline__ Frame(const Args& a) : A(a) {}
#define WSP(name, type, off) __device__ __forceinline__ type* name() const { return (type*)(ws + (off)); }
    WSP(WIN, bf16, WS_WIN) WSP(WOUT, bf16, WS_WOUT) WSP(WQ, bf16, WS_WQ) WSP(LRUW, bf16, WS_LRUW) WSP(WSB, bf16, WS_WSB)
    WSP(XN, bf16, WS_XN) WSP(MIX, bf16, WS_XN) WSP(Z, bf16, WS_Z) WSP(HB, bf16, WS_HB) WSP(HBT, bf16, WS_HBT)
    WSP(U8, unsigned char, WS_U) WSP(V8T, unsigned char, WS_V)
    WSP(ROWSS, float, WS_ROWSS) WSP(ROWSS2, float, WS_ROWSS2) WSP(QH, bf16, WS_Z) WSP(QL, bf16, WS_Z + 128 * MiB) WSP(KH, bf16, WS_KH) WSP(KL, bf16, WS_KH + 512 * 1024) WSP(AGG, float, WS_AGG) WSP(CARRY, float, WS_CARRY) WSP(AU, unsigned, WS_HB) WSP(GATES, float, WS_GATES)
    WSP(USCALE, float, WS_USCALE) WSP(VSCALE, float, WS_VSCALE) WSP(Y, bf16, WS_Y) WSP(IDS, int, WS_IDS) WSP(ASCALE, float, WS_ASCALE) WSP(IDW, v4u, WS_IDW) WSP(AW, unsigned, WS_AW) WSP(H8, unsigned char, WS_H8) WSP(HSCALE, float, WS_HSCALE) WSP(PART, int, WS_PART)
#undef WSP
};
__device__ __forceinline__ float wave_sum(float v) {
#pragma unroll
    for (int o = 1; o < 64; o <<= 1) v += __shfl_xor(v, o);
    return v;
}
__device__ __forceinline__ float bf_lo(unsigned w) { return __builtin_bit_cast(float, w << 16); }
__device__ __forceinline__ float bf_hi(unsigned w) { return __builtin_bit_cast(float, w & 0xffff0000u); }
__device__ __forceinline__ float bf1(unsigned short h) { return __builtin_bit_cast(float, (unsigned)h << 16); }
__device__ __forceinline__ float sigmoidf_(float x) { return __builtin_amdgcn_rcpf(1.0f + __builtin_amdgcn_exp2f(-1.4426950409f * x)); }
using pg8::gelu_tanh;
__device__ __forceinline__ unsigned pack_i8x4(float a, float b, float c, float d) {
    const int ia = (int)__builtin_rintf(a), ib = (int)__builtin_rintf(b), ic = (int)__builtin_rintf(c), id = (int)__builtin_rintf(d);
    return (unsigned)(ia & 0xff) | ((unsigned)(ib & 0xff) << 8) | ((unsigned)(ic & 0xff) << 16) | ((unsigned)id << 24);
}

__device__ __forceinline__ void p0_transpose_item(const float* W, int K, int N, bf16* WT, const float* kscale, LAS float* scr, int item, int lane) {
    const int nblk = N / 32, kb = item / nblk, nb = item % nblk, k0 = 64 * kb, n0 = 32 * nb;
#pragma unroll 8
    for (int i = 0; i < 32; ++i) { const int kk = 2 * i + (lane >> 5); const float sc = kscale ? kscale[k0 + kk] : 1.0f; scr[kk * 33 + (lane & 31)] = W[(size_t)(k0 + kk) * N + n0 + (lane & 31)] * sc; }
    LDS_WAIT(); asm volatile("" ::: "memory");
    const int c = lane & 7;
#pragma unroll
    for (int j = 0; j < 4; ++j) { const int n = (lane >> 3) + 8 * j; const LAS float* s = scr + (8 * c) * 33 + n;
        v4u o; o.x = pk2(s[0 * 33], s[1 * 33]); o.y = pk2(s[2 * 33], s[3 * 33]); o.z = pk2(s[4 * 33], s[5 * 33]); o.w = pk2(s[6 * 33], s[7 * 33]);
        *(GAS v4u*)(WT + (size_t)(n0 + n) * K + k0 + 8 * c) = o; }
    LDS_WAIT(); asm volatile("" ::: "memory");
}
__device__ __forceinline__ void p0_prologue(Frame& F) {
    LAS float* scr = (LAS float*)(F.lds + F.wave * 16384);
    const int gw = F.vcu * NWAVES + F.wave, NGW = F.G * NWAVES, lane = F.lane;
    constexpr int I_IN = (D / 64) * (NIN / 32), I_OUT = (D / 64) * (D / 32), I_Q = I_OUT, I_LRU = 32 * 8;
    constexpr int NITEMS = I_IN + I_OUT + I_Q + I_LRU;
    for (int it = gw; it < NITEMS; it += NGW) {
        int r = it;
        if (r < I_IN) { p0_transpose_item(F.A.in[2], D, NIN, F.WIN(), F.A.in[1], scr, r, lane); continue; } r -= I_IN;
        if (r < I_OUT) { p0_transpose_item(F.A.in[14], D, D, F.WOUT(), nullptr, scr, r, lane); continue; } r -= I_OUT;
        if (r < I_Q) { p0_transpose_item(F.A.in[16], D, D, F.WQ(), F.A.in[15], scr, r, lane); continue; } r -= I_Q;
        { const int mi = r >> 3, sub = r & 7, gate = mi >> 4, rest = mi & 15;
          const float* src = (gate ? F.A.in[7] : F.A.in[5]) + (size_t)rest * 16384;
          p0_transpose_item(src, 128, 128, F.LRUW() + (size_t)mi * 16384, nullptr, scr, sub, lane); }
    }
    const size_t gt = (size_t)gw * 64 + lane, NGT = (size_t)NGW * 64;
    {
        const float* g2 = F.A.in[15];
        f32x4 gg[8];
#pragma unroll
        for (int j = 0; j < 8; ++j) gg[j] = *(const GAS f32x4*)(g2 + j * 256 + lane * 4);
        for (int e = gw; e < NEXP; e += NGW) {
            const GAS f32x4* ur = (const GAS f32x4*)(F.A.in[18] + (size_t)e * D) + lane;
            f32x4 v[8]; float ss = 0.f;
#pragma unroll
            for (int j = 0; j < 8; ++j) { v[j] = __builtin_nontemporal_load(ur + 64 * j) * gg[j]; ss += (v[j].x * v[j].x + v[j].y * v[j].y) + (v[j].z * v[j].z + v[j].w * v[j].w); }
            const float rms = __builtin_amdgcn_sqrtf(wave_sum(ss) * (1.0f / D));
            const float sc = rms > 0.f ? 7.0f / (2.8f * rms) : 1.0f;
            GAS unsigned* o4 = (GAS unsigned*)(F.U8() + (size_t)e * 1024) + (lane >> 1);
#pragma unroll
            for (int j = 0; j < 8; ++j) {
                const int c0 = (int)fminf(fmaxf(__builtin_rintf(v[j].x * sc), -7.f), 7.f) & 15, c1 = (int)fminf(fmaxf(__builtin_rintf(v[j].y * sc), -7.f), 7.f) & 15;
                const int c2 = (int)fminf(fmaxf(__builtin_rintf(v[j].z * sc), -7.f), 7.f) & 15, c3 = (int)fminf(fmaxf(__builtin_rintf(v[j].w * sc), -7.f), 7.f) & 15;
                const unsigned cw = (unsigned)c0 | ((unsigned)c1 << 8) | ((unsigned)c2 << 16) | ((unsigned)c3 << 24);
                const unsigned pw = (unsigned)__shfl_xor((int)cw, 1);
                if ((lane & 1) == 0) __builtin_nontemporal_store(cw | (pw << 4), o4 + 32 * j);
            }
            if (lane == 0) F.USCALE()[e] = rms > 0.f ? 2.8f * rms * (1.0f / 7.0f) : 1.0f;
        }
    }
    __syncthreads();
    for (int un = blockIdx.x; un < NEXP / 64; un += F.G) {
        const int e0 = un * 64;
        for (int rr = 0; rr < 8; ++rr) {
            const int el = F.wave * 8 + rr, e = e0 + el;
            const GAS f32x4* vr = (const GAS f32x4*)(F.A.in[19] + (size_t)e * D) + lane;
            f32x4 v[8]; float mx = 0.f;
#pragma unroll
            for (int j = 0; j < 8; ++j) { v[j] = __builtin_nontemporal_load(vr + 64 * j); mx = fmaxf(mx, fmaxf(fmaxf(fabsf(v[j].x), fabsf(v[j].y)), fmaxf(fabsf(v[j].z), fabsf(v[j].w)))); }
#pragma unroll
            for (int o = 1; o < 64; o <<= 1) mx = fmaxf(mx, __shfl_xor(mx, o));
            const float sc = mx > 0.f ? 127.0f / mx : 1.0f;
#pragma unroll
            for (int j = 0; j < 8; ++j) *(LAS unsigned*)(F.lds + el * 2056 + j * 256 + lane * 4) = pack_i8x4(v[j].x * sc, v[j].y * sc, v[j].z * sc, v[j].w * sc);
            if (lane == 0) F.VSCALE()[e] = mx > 0.f ? mx * (1.0f / 127.0f) : 1.0f;
        }
        __syncthreads();
        for (int cc = 0; cc < 32; ++cc) { const int c = F.wave * 32 + cc;
            const v2u w = *(const LAS v2u*)(F.lds + lane * 2056 + c * 8);
            __builtin_nontemporal_store(w, (v2u*)(F.V8T() + ((size_t)c * NEXP + e0 + lane) * 8)); }
        __syncthreads();
    }
    for (size_t ch = gt; ch < (size_t)8 * 128 * 128 / 8; ch += NGT) {
        const size_t e0 = ch * 8;
        const f32x4 a = *(const GAS f32x4*)(F.A.in[12] + e0), b = *(const GAS f32x4*)(F.A.in[12] + e0 + 4);
        v4u o; o.x = pk2(a.x, a.y); o.y = pk2(a.z, a.w); o.z = pk2(b.x, b.y); o.w = pk2(b.z, b.w);
        *(GAS v4u*)(F.WSB() + e0) = o;
    }
    for (size_t ch = gt; ch < (size_t)16 * 128 * 128 / 8; ch += NGT) {
        const size_t e0 = ch * 8;
        const f32x4 a = *(const GAS f32x4*)(F.A.in[17] + e0), b = *(const GAS f32x4*)(F.A.in[17] + e0 + 4);
        v4u hi; hi.x = pk2(a.x, a.y); hi.y = pk2(a.z, a.w); hi.z = pk2(b.x, b.y); hi.w = pk2(b.z, b.w);
        *(GAS v4u*)(F.KH() + e0) = hi;
    }
    for (int m = gw; m < M; m += NGW) {
        const GAS f32x4* xr = (const GAS f32x4*)(F.A.in[0] + (size_t)m * D) + lane;
        f32x4 v[8]; float s = 0.f;
#pragma unroll
        for (int j = 0; j < 8; ++j) { v[j] = __builtin_nontemporal_load(xr + 64 * j); s += (v[j].x * v[j].x + v[j].y * v[j].y) + (v[j].z * v[j].z + v[j].w * v[j].w); }
        const float rstd = __builtin_amdgcn_rsqf(wave_sum(s) * (1.f / D) + 1e-6f);
        GAS unsigned long long* o8 = (GAS unsigned long long*)(F.XN() + (size_t)m * D) + lane;
#pragma unroll
        for (int j = 0; j < 8; ++j) o8[64 * j] = (unsigned long long)pk2(v[j].x * rstd, v[j].y * rstd) | ((unsigned long long)pk2(v[j].z * rstd, v[j].w * rstd) << 32);
    }
}
constexpr int LRU_XR = 0, LRU_XC = 33792, LRU_GR = 33792 + 40960;
constexpr float LOG2E = 1.4426950408889634f;
__device__ __forceinline__ int xc_off(int tok, int ch) { return tok * 320 + (tok >> 5) * 16 + ch * 2; }
template <bool APPLY, int DIR>
__device__ __forceinline__ void lru_dir(Frame& F, int unit, int b, int c, int h, const bf16x8 (&Ba)[4], const bf16x8 (&Bx)[4], float (&hsum)[8][4]) {
    const int lane = F.lane, w = F.wave, fr = lane & 15, fq = lane >> 4;
    LAS unsigned char* XC = F.lds + LRU_XC;
    const int chl = 16 * w + fr, chg = h * 128 + chl;
    v4u* au = (v4u*)F.AU() + ((size_t)((unit * 2 + DIR) * NWAVES + w) * 8) * 64 + lane;
    f32x4 R[8], I[8];
    float carry = 0.f;
    if (APPLY) {
        carry = F.CARRY()[(size_t)((b * 2 + DIR) * NCHUNK + c) * LW + chg];
        v4u q[8];
#pragma unroll
        for (int m = 0; m < 8; ++m) q[m] = __builtin_nontemporal_load(au + m * 64);
#pragma unroll
        for (int m = 0; m < 8; ++m) {
            R[m] = (f32x4){__builtin_amdgcn_exp2f(bf_lo(q[m].x)), __builtin_amdgcn_exp2f(bf_lo(q[m].y)), __builtin_amdgcn_exp2f(bf_lo(q[m].z)), __builtin_amdgcn_exp2f(bf_lo(q[m].w))};
            I[m] = (f32x4){bf_hi(q[m].x), bf_hi(q[m].y), bf_hi(q[m].z), bf_hi(q[m].w)}; }
    } else {
        const float ba = F.A.in[6][DIR * LW + chg], bx = F.A.in[8][DIR * LW + chg], lam = F.A.in[9][DIR * LW + chg];
        const float cl = -8.0f * log1pf(__expf(-lam)) * LOG2E;
        const int arow = (fr >> 2) * 32 + (fr & 3);
#pragma unroll
        for (int m = 0; m < 8; ++m) {
            R[m] = (f32x4){0.f, 0.f, 0.f, 0.f}; I[m] = (f32x4){0.f, 0.f, 0.f, 0.f};
#pragma unroll
            for (int ks = 0; ks < 4; ++ks) {
                const bf16x8 a = *(const LAS bf16x8*)(XC + xc_off(arow + 4 * m, 32 * ks + 8 * fq));
                R[m] = __builtin_amdgcn_mfma_f32_16x16x32_bf16(a, Ba[ks], R[m], 0, 0, 0);
                I[m] = __builtin_amdgcn_mfma_f32_16x16x32_bf16(a, Bx[ks], I[m], 0, 0, 0);
            }
        }
#pragma unroll
        for (int m = 0; m < 8; ++m) {
            float la[4];
#pragma unroll
            for (int j = 0; j < 4; ++j) {
                const float r = sigmoidf_(R[m][j] + ba), ig = sigmoidf_(I[m][j] + bx);
                la[j] = cl * r;
                const float a = __builtin_amdgcn_exp2f(la[j]);
                const float xc = bf1(*(const LAS unsigned short*)(XC + xc_off(32 * fq + 4 * m + j, chl)));
                R[m][j] = a; I[m][j] = __builtin_amdgcn_sqrtf(fmaxf(1.0f - a * a, 0.0f)) * (ig * xc);
            }
            __builtin_nontemporal_store((v4u){pk2(la[0], I[m][0]), pk2(la[1], I[m][1]), pk2(la[2], I[m][2]), pk2(la[3], I[m][3])}, au + m * 64);
        }
    }
    float P = 1.f, L = 0.f;
#pragma unroll
    for (int mm = 0; mm < 8; ++mm) {
        const int m = DIR == 0 ? mm : 7 - mm;
#pragma unroll
        for (int jj = 0; jj < 4; ++jj) {
            const int j = DIR == 0 ? jj : 3 - jj;
            const float a = R[m][j], u = I[m][j];
            L = a * L + u; P = a * P;
            R[m][j] = P; I[m][j] = L;
        }
    }
    const int src1 = DIR == 0 ? lane - 16 : lane + 16, src2 = DIR == 0 ? lane - 32 : lane + 32;
    const bool v1 = DIR == 0 ? (fq >= 1) : (fq <= 2), v2 = DIR == 0 ? (fq >= 2) : (fq <= 1);
    float A = P, B = L;
    { const float pa = __shfl(A, src1), pb = __shfl(B, src1); if (v1) { B = A * pb + B; A = A * pa; } }
    { const float pa = __shfl(A, src2), pb = __shfl(B, src2); if (v2) { B = A * pb + B; A = A * pa; } }
    if (APPLY) {
        float EA = __shfl(A, src1), EB = __shfl(B, src1); if (!v1) { EA = 1.f; EB = 0.f; }
        const float hin = EA * carry + EB;
#pragma unroll
        for (int m = 0; m < 8; ++m)
#pragma unroll
            for (int j = 0; j < 4; ++j) { const float hh = R[m][j] * hin + I[m][j]; if (DIR == 0) hsum[m][j] = hh; else hsum[m][j] += hh; }
    } else {
        const bool lastlane = DIR == 0 ? (fq == 3) : (fq == 0);
        if (lastlane) { f32x2* agg = (f32x2*)F.AGG() + (size_t)((b * 2 + DIR) * NCHUNK + c) * LW + chg; *agg = (f32x2){A, B}; }
    }
}

template <bool APPLY>
__device__ __forceinline__ void lru_unit(Frame& F, int unit) {
    const int h = unit & 7, c = (unit >> 3) & 63, b = unit >> 9;
    const int tid = F.tid, lane = F.lane, w = F.wave, fr = lane & 15, fq = lane >> 4;
    const size_t t0 = (size_t)b * SEQ + (size_t)c * CHUNK;
    LAS unsigned char* XR = F.lds + LRU_XR; LAS unsigned char* XC = F.lds + LRU_XC; LAS unsigned char* GR = F.lds + LRU_GR;
    bf16x8 Ba0[4], Bx0[4], Ba1[4], Bx1[4];
    if (!APPLY) {
        const bf16* wb = F.LRUW() + (size_t)h * 16384 + (size_t)(16 * w + fr) * 128 + 8 * fq;
#pragma unroll
        for (int ks = 0; ks < 4; ++ks) { Ba0[ks] = *(const GAS bf16x8*)(wb + 32 * ks); Ba1[ks] = *(const GAS bf16x8*)(wb + (size_t)8 * 16384 + 32 * ks);
            Bx0[ks] = *(const GAS bf16x8*)(wb + (size_t)16 * 16384 + 32 * ks); Bx1[ks] = *(const GAS bf16x8*)(wb + (size_t)24 * 16384 + 32 * ks); }
        for (int p = tid; p < 131 * 16; p += 512) { const int r = p >> 4, cg = p & 15; const int s = c * CHUNK - 2 + r; v4u v = (v4u){0u, 0u, 0u, 0u};
            if (s >= 0 && s < SEQ) v = *(const GAS v4u*)(F.Z() + ((size_t)b * SEQ + s) * NIN + h * 128 + cg * 8);
            *(LAS v4u*)(XR + r * 256 + cg * 16) = v; }
        __syncthreads();
        {
            const int ch2 = tid & 63, tg = tid >> 6, chg = h * 128 + 2 * ch2;
            float w0[4], w1[4];
#pragma unroll
            for (int k = 0; k < 4; ++k) { w0[k] = F.A.in[3][k * LW + chg]; w1[k] = F.A.in[3][k * LW + chg + 1]; }
            const float b0 = F.A.in[4][chg], b1 = F.A.in[4][chg + 1];
            float x0[4], x1[4];
#pragma unroll
            for (int k = 0; k < 3; ++k) { const unsigned u = *(const LAS unsigned*)(XR + (16 * tg + k) * 256 + ch2 * 4); x0[k] = bf_lo(u); x1[k] = bf_hi(u); }
#pragma unroll
            for (int j = 0; j < 16; ++j) {
                const unsigned u = *(const LAS unsigned*)(XR + (16 * tg + j + 3) * 256 + ch2 * 4); x0[3] = bf_lo(u); x1[3] = bf_hi(u);
                const float y0 = b0 + ((w0[0] * x0[0] + w0[1] * x0[1]) + (w0[2] * x0[2] + w0[3] * x0[3]));
                const float y1 = b1 + ((w1[0] * x1[0] + w1[1] * x1[1]) + (w1[2] * x1[2] + w1[3] * x1[3]));
                *(LAS unsigned*)(XC + xc_off(16 * tg + j, 2 * ch2)) = pk2(y0, y1);
                x0[0] = x0[1]; x0[1] = x0[2]; x0[2] = x0[3]; x1[0] = x1[1]; x1[1] = x1[2]; x1[2] = x1[3];
            }
        }
        __syncthreads();
    } else {
#pragma unroll
        for (int ks = 0; ks < 4; ++ks) { Ba0[ks] = Ba1[ks] = Bx0[ks] = Bx1[ks] = (bf16x8){0, 0, 0, 0, 0, 0, 0, 0}; }
        for (int p = tid; p < 128 * 32; p += 512) { const int r = p >> 5, cg = p & 31;
            *(LAS v2u*)(GR + r * 264 + cg * 8) = *(const GAS v2u*)(F.Z() + (t0 + r) * NIN + LW + h * 128 + cg * 4); }
    }
    float hsum[8][4];
    lru_dir<APPLY, 0>(F, unit, b, c, h, Ba0, Bx0, hsum);
    asm volatile("" ::: "memory"); __builtin_amdgcn_sched_barrier(0);
    lru_dir<APPLY, 1>(F, unit, b, c, h, Ba1, Bx1, hsum);
    if (APPLY) {
        const int chl = 16 * w + fr;
        __syncthreads();
#pragma unroll
        for (int m = 0; m < 8; ++m)
#pragma unroll
            for (int j = 0; j < 4; ++j) { LAS unsigned short* p = (LAS unsigned short*)(GR + (32 * fq + 4 * m + j) * 264 + chl * 2); *p = (unsigned short)f2bf(bf1(*p) * hsum[m][j]); }
        __syncthreads();
        for (int p = tid; p < 128 * 32; p += 512) { const int r = p >> 5, cg = p & 31;
            *(GAS v2u*)(F.MIX() + (t0 + r) * D + h * 128 + cg * 4) = *(const LAS v2u*)(GR + r * 264 + cg * 8); }
    }
    __syncthreads();
}

constexpr int LRU_PT = LRU_GR + 33792, LRU_CR = LRU_PT + 8192;
template <int DIR>
__device__ __forceinline__ void lru_scan_dir(Frame& F, int b, int c, int h, const bf16x8 (&Ba)[4], const bf16x8 (&Bx)[4], f32x4 (&R)[8], f32x4 (&I)[8], float& EA, float& EB) {
    const int lane = F.lane, w = F.wave, fr = lane & 15, fq = lane >> 4;
    LAS unsigned char* XC = F.lds + LRU_XC;
    const int chl = 16 * w + fr, chg = h * 128 + chl;
    {
        const float ba = F.A.in[6][DIR * LW + chg], bx = F.A.in[8][DIR * LW + chg], lam = F.A.in[9][DIR * LW + chg];
        const float cl = -8.0f * log1pf(__expf(-lam)) * LOG2E;
        const int arow = (fr >> 2) * 32 + (fr & 3);
#define LRU_MMA(m_) do { R[m_] = (f32x4){0.f, 0.f, 0.f, 0.f}; I[m_] = (f32x4){0.f, 0.f, 0.f, 0.f}; \
            _Pragma("unroll") for (int ks = 0; ks < 4; ++ks) { const bf16x8 a = *(const LAS bf16x8*)(XC + xc_off(arow + 4 * (m_), 32 * ks + 8 * fq)); \
                R[m_] = __builtin_amdgcn_mfma_f32_16x16x32_bf16(a, Ba[ks], R[m_], 0, 0, 0); I[m_] = __builtin_amdgcn_mfma_f32_16x16x32_bf16(a, Bx[ks], I[m_], 0, 0, 0); } } while (0)
        LRU_MMA(0);
#pragma unroll
        for (int m = 0; m < 8; ++m) {
            if (m + 1 < 8) LRU_MMA(m + 1);
#pragma unroll
            for (int j = 0; j < 4; ++j) {
                const float r = sigmoidf_(R[m][j] + ba), ig = sigmoidf_(I[m][j] + bx);
                const float a = __builtin_amdgcn_exp2f(cl * r);
                const float xc = bf1(*(const LAS unsigned short*)(XC + xc_off(32 * fq + 4 * m + j, chl)));
                R[m][j] = a; I[m][j] = __builtin_amdgcn_sqrtf(fmaxf(1.0f - a * a, 0.0f)) * (ig * xc);
            }
            __builtin_amdgcn_sched_barrier(0);
        }
#undef LRU_MMA
    }
    float P = 1.f, L = 0.f;
#pragma unroll
    for (int mm = 0; mm < 8; ++mm) {
        const int m = DIR == 0 ? mm : 7 - mm;
#pragma unroll
        for (int jj = 0; jj < 4; ++jj) {
            const int j = DIR == 0 ? jj : 3 - jj;
            const float a = R[m][j], u = I[m][j];
            L = a * L + u; P = a * P;
            R[m][j] = P; I[m][j] = L;
        }
    }
    const int src1 = DIR == 0 ? lane - 16 : lane + 16, src2 = DIR == 0 ? lane - 32 : lane + 32;
    const bool v1 = DIR == 0 ? (fq >= 1) : (fq <= 2), v2 = DIR == 0 ? (fq >= 2) : (fq <= 1);
    float A = P, B = L;
    { const float pa = __shfl(A, src1), pb = __shfl(B, src1); if (v1) { B = A * pb + B; A = A * pa; } }
    { const float pa = __shfl(A, src2), pb = __shfl(B, src2); if (v2) { B = A * pb + B; A = A * pa; } }
    EA = __shfl(A, src1); EB = __shfl(B, src1); if (!v1) { EA = 1.f; EB = 0.f; }
    const bool lastlane = DIR == 0 ? (fq == 3) : (fq == 0);
    if (lastlane) {
        const unsigned long long word = (unsigned long long)(__builtin_bit_cast(unsigned, A) | 1u) | ((unsigned long long)__builtin_bit_cast(unsigned, B) << 32);
        __hip_atomic_store((unsigned long long*)F.AGG() + (size_t)((b * 2 + DIR) * NCHUNK + c) * LW + chg, word, RLX_AGENT);
    }
}
__device__ __forceinline__ void lru_decode(int unit, int& b, int& c, int& h) { const int rnd = unit >> 8, within = unit & 255; b = rnd >> 1; h = (rnd & 1) * 4 + (within & 3); c = within >> 2; }
__device__ __forceinline__ void lru_prefetch(Frame& F, int unit, int tid, v4u (&xr)[5]) {
    int b, c, h; lru_decode(unit, b, c, h);
#pragma unroll
    for (int i = 0; i < 5; ++i) { const int p = tid + 512 * i, r = p >> 4, cg = p & 15; const int s = c * CHUNK - 2 + r; xr[i] = (v4u){0u, 0u, 0u, 0u};
        if (p < 131 * 16 && s >= 0 && s < SEQ) xr[i] = *(const GAS v4u*)(F.Z() + ((size_t)b * SEQ + s) * NIN + h * 128 + cg * 8); }
}
__device__ __forceinline__ void lru_conv(Frame& F, int unit, int tid, const v4u (&xr)[5]) {
    int b, c, h; lru_decode(unit, b, c, h);
    LAS unsigned char* XR = F.lds + LRU_XR; LAS unsigned char* XC = F.lds + LRU_XC;
#pragma unroll
    for (int i = 0; i < 5; ++i) { const int p = tid + 512 * i, r = p >> 4, cg = p & 15; if (p < 131 * 16) *(LAS v4u*)(XR + r * 256 + cg * 16) = xr[i]; }
    __syncthreads();
    const int ch2 = tid & 63, tg = tid >> 6, chg = h * 128 + 2 * ch2;
    float w0[4], w1[4];
#pragma unroll
    for (int k = 0; k < 4; ++k) { w0[k] = F.A.in[3][k * LW + chg]; w1[k] = F.A.in[3][k * LW + chg + 1]; }
    const float b0 = F.A.in[4][chg], b1 = F.A.in[4][chg + 1];
    float x0[4], x1[4];
#pragma unroll
    for (int k = 0; k < 3; ++k) { const unsigned u = *(const LAS unsigned*)(XR + (16 * tg + k) * 256 + ch2 * 4); x0[k] = bf_lo(u); x1[k] = bf_hi(u); }
#pragma unroll
    for (int j = 0; j < 16; ++j) {
        const unsigned u = *(const LAS unsigned*)(XR + (16 * tg + j + 3) * 256 + ch2 * 4); x0[3] = bf_lo(u); x1[3] = bf_hi(u);
        const float y0 = b0 + ((w0[0] * x0[0] + w0[1] * x0[1]) + (w0[2] * x0[2] + w0[3] * x0[3]));
        const float y1 = b1 + ((w1[0] * x1[0] + w1[1] * x1[1]) + (w1[2] * x1[2] + w1[3] * x1[3]));
        *(LAS unsigned*)(XC + xc_off(16 * tg + j, 2 * ch2)) = pk2(y0, y1);
        x0[0] = x0[1]; x0[1] = x0[2]; x0[2] = x0[3]; x1[0] = x1[1]; x1[1] = x1[2]; x1[2] = x1[3];
    }
}
__device__ __forceinline__ void lru_fused_unit(Frame& F, int unit, int next, v4u (&xr)[5]) {
    int b, c, h; lru_decode(unit, b, c, h);
    int tid = F.tid; asm volatile("" : "+v"(tid));
    const int lane = tid & 63, w = F.wave, fr = lane & 15, fq = lane >> 4;
    const size_t t0 = (size_t)b * SEQ + (size_t)c * CHUNK;
    LAS unsigned char* GR = F.lds + LRU_GR;
    bf16x8 Ba0[4], Bx0[4], Ba1[4], Bx1[4];
    {
        const bf16* wb = F.LRUW() + (size_t)h * 16384 + (size_t)(16 * w + fr) * 128 + 8 * fq;
#pragma unroll
        for (int ks = 0; ks < 4; ++ks) { Ba0[ks] = *(const GAS bf16x8*)(wb + 32 * ks); Ba1[ks] = *(const GAS bf16x8*)(wb + (size_t)8 * 16384 + 32 * ks);
            Bx0[ks] = *(const GAS bf16x8*)(wb + (size_t)16 * 16384 + 32 * ks); Bx1[ks] = *(const GAS bf16x8*)(wb + (size_t)24 * 16384 + 32 * ks); }
    }
    f32x4 R0[8], I0[8], R1[8], I1[8]; float EA0, EB0, EA1, EB1;
    lru_scan_dir<0>(F, b, c, h, Ba0, Bx0, R0, I0, EA0, EB0);
    asm volatile("" ::: "memory"); __builtin_amdgcn_sched_barrier(0);
    if (next >= 0) lru_prefetch(F, next, tid, xr);
    lru_scan_dir<1>(F, b, c, h, Ba1, Bx1, R1, I1, EA1, EB1);
    {
        v2u gr[8];
#pragma unroll
        for (int i = 0; i < 8; ++i) { const int p = tid + 512 * i, r = p >> 5, cg = p & 31; gr[i] = *(const GAS v2u*)(F.Z() + (t0 + r) * NIN + LW + h * 128 + cg * 4); }
        if (next >= 0) lru_conv(F, next, tid, xr); else __syncthreads();
#pragma unroll
        for (int i = 0; i < 8; ++i) { const int p = tid + 512 * i, r = p >> 5, cg = p & 31; *(LAS v2u*)(GR + r * 264 + cg * 8) = gr[i]; }
    }
    {
        const int ch = tid & 127, kq = tid >> 7;
        const unsigned long long* ab = (const unsigned long long*)F.AGG() + (size_t)b * 2 * NCHUNK * LW + h * 128 + ch;
        unsigned long long v[16];
#pragma unroll
        for (int i = 0; i < 16; ++i) { const int k = min(16 * kq + i, 62); const int row = k < c ? k : NCHUNK + k + 1;
            v[i] = __hip_atomic_load(ab + (size_t)row * LW, RLX_AGENT); }
        for (unsigned sp = 0; sp < (1u << 16); ++sp) {
            bool bad = false;
#pragma unroll
            for (int i = 0; i < 16; ++i) if (v[i] == 0ull) { const int k = min(16 * kq + i, 62); const int row = k < c ? k : NCHUNK + k + 1;
                v[i] = __hip_atomic_load(ab + (size_t)row * LW, RLX_AGENT); bad = bad || (v[i] == 0ull); }
            if (!bad) break;
            __builtin_amdgcn_s_sleep(2);
        }
        float fa = 1.f, fb = 0.f, ga = 1.f, gb = 0.f;
#pragma unroll
        for (int i = 0; i < 16; ++i) { const int k = 16 * kq + i; const float A = __builtin_bit_cast(float, (unsigned)v[i]), B = __builtin_bit_cast(float, (unsigned)(v[i] >> 32));
            if (k < c) { fb = A * fb + B; fa = A * fa; } }
#pragma unroll
        for (int i = 15; i >= 0; --i) { const int k = 16 * kq + i; const float A = __builtin_bit_cast(float, (unsigned)v[i]), B = __builtin_bit_cast(float, (unsigned)(v[i] >> 32));
            if (k >= c && k < 63) { gb = A * gb + B; ga = A * ga; } }
        *(LAS f32x4*)(F.lds + LRU_PT + (kq * 128 + ch) * 16) = (f32x4){fa, fb, ga, gb};
    }
    __syncthreads();
    if (tid < 256) {
        const int dir = tid >> 7, ch = tid & 127;
        f32x4 q[4];
#pragma unroll
        for (int k = 0; k < 4; ++k) q[k] = *(const LAS f32x4*)(F.lds + LRU_PT + (k * 128 + ch) * 16);
        float st = 0.f;
        if (dir == 0) { st = q[0].y; st = q[1].x * st + q[1].y; st = q[2].x * st + q[2].y; st = q[3].x * st + q[3].y; }
        else { st = q[3].w; st = q[2].z * st + q[2].w; st = q[1].z * st + q[1].w; st = q[0].z * st + q[0].w; }
        *(LAS float*)(F.lds + LRU_CR + tid * 4) = st;
    }
    __syncthreads();
    {
        const int chl = 16 * w + fr;
        const float hin0 = EA0 * *(const LAS float*)(F.lds + LRU_CR + chl * 4) + EB0, hin1 = EA1 * *(const LAS float*)(F.lds + LRU_CR + 512 + chl * 4) + EB1;
#pragma unroll
        for (int m = 0; m < 8; ++m)
#pragma unroll
            for (int j = 0; j < 4; ++j) { const float hs = (R0[m][j] * hin0 + I0[m][j]) + (R1[m][j] * hin1 + I1[m][j]);
                LAS unsigned short* p = (LAS unsigned short*)(GR + (32 * fq + 4 * m + j) * 264 + chl * 2); *p = (unsigned short)f2bf(bf1(*p) * hs); }
        __syncthreads();
        for (int p = tid; p < 128 * 32; p += 512) { const int r = p >> 5, cg = p & 31;
            *(GAS v2u*)(F.MIX() + (t0 + r) * D + h * 128 + cg * 4) = *(const LAS v2u*)(GR + r * 264 + cg * 8); }
    }
    __syncthreads();
}
__device__ __forceinline__ void lru_carry(Frame& F) {
    const int idx = (F.vcu * NWAVES + F.wave) * 64 + F.lane;
    if (idx >= BATCH * 2 * LW) return;
    const int ch = idx & (LW - 1), bd = idx >> 10, dir = bd & 1;
    const f32x2* agg = (const f32x2*)F.AGG() + (size_t)bd * NCHUNK * LW + ch; float* cr = F.CARRY() + (size_t)bd * NCHUNK * LW + ch;
    float st = 0.f;
#pragma unroll 8
    for (int i = 0; i < NCHUNK; ++i) { const int cc = dir == 0 ? i : NCHUNK - 1 - i; const f32x2 pe = agg[(size_t)cc * LW]; cr[(size_t)cc * LW] = st; st = pe.x * st + pe.y; }
}
constexpr int GM_ST = 0, GM_BS = 1024, GM_VN = 2048, GM_GU = 2048 + 32768;
typedef short s16x4 __attribute__((ext_vector_type(4)));
__device__ __forceinline__ unsigned vn_off(unsigned row, unsigned ch) { return 256u * row + 16u * (ch ^ (((row & 3u) << 2) | ((row >> 2) & 3u))); }
struct GmlpRegs { v4u a[4]; v2u gu[8]; bf16x8 Af[4]; f32x4 g0, g1, b0, b1; float bs; };
__device__ __forceinline__ void gmlp_load(Frame& F, size_t t0, int h, int tid, GmlpRegs& G) {
    const int lane = tid & 63, w = tid >> 6, fr = lane & 15, fq = lane >> 4;
#pragma unroll
    for (int i = 0; i < 4; ++i) { const int pid = tid + 512 * i, q = pid >> 4, cg = pid & 15; G.a[i] = *(const GAS v4u*)(F.Z() + (t0 + q) * NIN + 3 * LW + h * 128 + cg * 8); }
#pragma unroll
    for (int i = 0; i < 8; ++i) { const int pid = tid + 512 * i, r = pid >> 5, cg = pid & 31; G.gu[i] = *(const GAS v2u*)(F.Z() + (t0 + r) * NIN + 2 * LW + h * 128 + cg * 4); }
    { const int cg = tid & 15;
      G.g0 = *(const GAS f32x4*)(F.A.in[10] + h * 128 + cg * 8); G.g1 = *(const GAS f32x4*)(F.A.in[10] + h * 128 + cg * 8 + 4);
      G.b0 = *(const GAS f32x4*)(F.A.in[11] + h * 128 + cg * 8); G.b1 = *(const GAS f32x4*)(F.A.in[11] + h * 128 + cg * 8 + 4); }
    G.bs = F.A.in[13][h * 128 + (tid & 127)];
    const bf16* wsb = F.WSB() + (size_t)h * 16384 + (size_t)(16 * w + fr) * 128 + 8 * fq;
#pragma unroll
    for (int ks = 0; ks < 4; ++ks) G.Af[ks] = *(const GAS bf16x8*)(wsb + 32 * ks);
}
__device__ __forceinline__ void gmlp_unit(Frame& F, int unit) {
    int tid = F.tid; asm volatile("" : "+v"(tid));
    const int lane = tid & 63, w = F.wave, fr = lane & 15, fq = lane >> 4;
    const size_t t0 = (size_t)unit * CHUNK;
    LAS float* ST = (LAS float*)(F.lds + GM_ST); LAS float* BS = (LAS float*)(F.lds + GM_BS);
    LAS unsigned char* VN = F.lds + GM_VN; LAS unsigned char* GU = F.lds + GM_GU;
    GmlpRegs G;
    gmlp_load(F, t0, 0, tid, G);
#pragma unroll
    for (int rb = 0; rb < 2; ++rb) {
        v4u ra[8], rc[8];
#pragma unroll
        for (int rr = 0; rr < 8; ++rr) { const bf16* p = F.Z() + (t0 + 16 * w + 8 * rb + rr) * NIN + 3 * LW + lane * 8; ra[rr] = *(const GAS v4u*)p; rc[rr] = *(const GAS v4u*)(p + 512); }
#pragma unroll
        for (int rr = 0; rr < 8; ++rr) {
            const int row = 16 * w + 8 * rb + rr;
            const v4u a = ra[rr], b = rc[rr];
            float x[16] = {bf_lo(a.x), bf_hi(a.x), bf_lo(a.y), bf_hi(a.y), bf_lo(a.z), bf_hi(a.z), bf_lo(a.w), bf_hi(a.w),
                           bf_lo(b.x), bf_hi(b.x), bf_lo(b.y), bf_hi(b.y), bf_lo(b.z), bf_hi(b.z), bf_lo(b.w), bf_hi(b.w)};
            float s = 0.f;
#pragma unroll
            for (int i = 0; i < 16; ++i) s += x[i];
            const float mean = wave_sum(s) * (1.0f / LW);
            float q = 0.f;
#pragma unroll
            for (int i = 0; i < 16; ++i) { const float d = x[i] - mean; q += d * d; }
            const float rstd = __builtin_amdgcn_rsqf(wave_sum(q) * (1.0f / LW) + 1e-6f);
            if (lane == 0) { ST[2 * row] = mean; ST[2 * row + 1] = rstd; }
        }
    }
    __syncthreads();
    const unsigned trq = (unsigned)(lane & 15) >> 2, trp = (unsigned)lane & 3u;
    for (int h = 0; h < 8; ++h) {
#pragma unroll
        for (int i = 0; i < 4; ++i) { const int pid = tid + 512 * i, q = pid >> 4, cg = pid & 15;
            const v4u a = G.a[i];
            const float mean = ST[2 * q], rstd = ST[2 * q + 1];
            const f32x4 g0 = G.g0, g1 = G.g1, b0 = G.b0, b1 = G.b1;
            v4u o;
            o.x = pk2((bf_lo(a.x) - mean) * rstd * g0.x + b0.x, (bf_hi(a.x) - mean) * rstd * g0.y + b0.y);
            o.y = pk2((bf_lo(a.y) - mean) * rstd * g0.z + b0.z, (bf_hi(a.y) - mean) * rstd * g0.w + b0.w);
            o.z = pk2((bf_lo(a.z) - mean) * rstd * g1.x + b1.x, (bf_hi(a.z) - mean) * rstd * g1.y + b1.y);
            o.w = pk2((bf_lo(a.w) - mean) * rstd * g1.z + b1.z, (bf_hi(a.w) - mean) * rstd * g1.w + b1.w);
            *(LAS v4u*)(VN + vn_off((unsigned)q, (unsigned)cg)) = o;
        }
#pragma unroll
        for (int i = 0; i < 8; ++i) { const int pid = tid + 512 * i, r = pid >> 5, cg = pid & 31; *(LAS v2u*)(GU + r * 264 + cg * 8) = G.gu[i]; }
        if (tid < 128) BS[tid] = G.bs;
        bf16x8 Af[4];
#pragma unroll
        for (int ks = 0; ks < 4; ++ks) Af[ks] = G.Af[ks];
        __syncthreads();
        if (h + 1 < 8) gmlp_load(F, t0, h + 1, tid, G);
        f32x4 acc[8];
#pragma unroll
        for (int n = 0; n < 8; ++n) {
            acc[n] = (f32x4){0.f, 0.f, 0.f, 0.f};
#pragma unroll
            for (int ks = 0; ks < 4; ++ks) {
                const s16x4 b0 = __builtin_amdgcn_ds_read_tr16_b64_v4i16((LAS s16x4*)(VN + vn_off(32u * ks + 8u * fq + trq, 2u * n + (trp >> 1)) + 8u * (trp & 1u)));
                const s16x4 b1 = __builtin_amdgcn_ds_read_tr16_b64_v4i16((LAS s16x4*)(VN + vn_off(32u * ks + 8u * fq + 4u + trq, 2u * n + (trp >> 1)) + 8u * (trp & 1u)));
                const bf16x8 bb = (bf16x8){b0[0], b0[1], b0[2], b0[3], b1[0], b1[1], b1[2], b1[3]};
                acc[n] = __builtin_amdgcn_mfma_f32_16x16x32_bf16(Af[ks], bb, acc[n], 0, 0, 0);
            }
        }
#pragma unroll
        for (int n = 0; n < 8; ++n)
#pragma unroll
            for (int j = 0; j < 4; ++j) { const int p = 16 * w + 4 * fq + j; LAS unsigned short* ad = (LAS unsigned short*)(GU + p * 264 + (16 * n + fr) * 2);
                *ad = (unsigned short)f2bf(bf1(*ad) * (acc[n][j] + BS[p])); }
        __syncthreads();
#pragma unroll
        for (int i = 0; i < 8; ++i) { const int pid = tid + 512 * i, r = pid >> 5, cg = pid & 31;
            *(GAS v2u*)(F.MIX() + (t0 + r) * D + LW + h * 128 + cg * 4) = *(const LAS v2u*)(GU + r * 264 + cg * 8); }
        __syncthreads();
    }
}
__device__ __forceinline__ void h8_issue(Frame& F, int t, int lane, v4u (&a)[4]) {
    const bf16* hp = F.HB() + (size_t)t * D + lane * 16;
#pragma unroll
    for (int c = 0; c < 2; ++c)
#pragma unroll
        for (int q = 0; q < 2; ++q) a[c * 2 + q] = *(const GAS v4u*)(hp + c * 1024 + q * 8);
}
__device__ __forceinline__ void h8_finish(Frame& F, int t, int lane, const v4u (&av)[4]) {
    float hx[32]; float mx = 0.f;
#pragma unroll
    for (int c = 0; c < 2; ++c)
#pragma unroll
        for (int q = 0; q < 2; ++q) { const v4u a = av[c * 2 + q]; float* x = hx + c * 16 + q * 8;
            x[0] = bf_lo(a.x); x[1] = bf_hi(a.x); x[2] = bf_lo(a.y); x[3] = bf_hi(a.y); x[4] = bf_lo(a.z); x[5] = bf_hi(a.z); x[6] = bf_lo(a.w); x[7] = bf_hi(a.w); }
#pragma unroll
    for (int i = 0; i < 32; ++i) mx = fmaxf(mx, fabsf(hx[i]));
#pragma unroll
    for (int o = 1; o < 64; o <<= 1) mx = fmaxf(mx, __shfl_xor(mx, o));
    const float sc = mx > 0.f ? 119.0f / mx : 1.0f;
    const float MAGIC = 12582912.0f + 128.0f;
#pragma unroll
    for (int c = 0; c < 2; ++c) {
        unsigned hw[2], lw[2];
#pragma unroll
        for (int g8 = 0; g8 < 2; ++g8) {
            unsigned m[8];
#pragma unroll
            for (int i = 0; i < 8; ++i) m[i] = __builtin_bit_cast(unsigned, __builtin_fmaf(hx[c * 16 + g8 * 8 + i], sc, MAGIC));
            const unsigned B0 = __builtin_amdgcn_perm(__builtin_amdgcn_perm(m[3], m[2], 0x0c0c0400u), __builtin_amdgcn_perm(m[1], m[0], 0x0c0c0400u), 0x05040100u);
            const unsigned B1 = __builtin_amdgcn_perm(__builtin_amdgcn_perm(m[7], m[6], 0x0c0c0400u), __builtin_amdgcn_perm(m[5], m[4], 0x0c0c0400u), 0x05040100u);
            lw[g8] = (B0 & 0x0F0F0F0Fu) | ((B1 & 0x0F0F0F0Fu) << 4);
            const unsigned h0 = ((B0 + 0x08080808u) >> 4) & 0x0F0F0F0Fu, h1 = ((B1 + 0x08080808u) >> 4) & 0x0F0F0F0Fu;
            hw[g8] = (h0 | (h1 << 4)) ^ 0x88888888u; }
        unsigned char* hb_ = F.H8() + (size_t)t * D + c * 512 + lane * 8;
        *(GAS v2u*)hb_ = (v2u){hw[0], hw[1]}; *(GAS v2u*)(hb_ + 1024) = (v2u){lw[0], lw[1]};
    }
    if (lane == 0) F.HSCALE()[t] = mx > 0.f ? mx * (1.0f / 119.0f) : 1.0f;
}
__device__ __forceinline__ void h8_row(Frame& F, int t) { int lane = F.lane; asm volatile("" : "+v"(lane)); v4u a[4]; h8_issue(F, t, lane, a); h8_finish(F, t, lane, a); }
typedef float f32x16 __attribute__((ext_vector_type(16)));
__device__ __forceinline__ unsigned fkey(float f) { const int u = __builtin_bit_cast(int, f); return (unsigned)(u ^ ((u >> 31) & 0x7fffffff)); }
__device__ __forceinline__ float fkey_inv(unsigned k) { const int u = (int)k; return __builtin_bit_cast(float, u ^ ((u >> 31) & 0x7fffffff)); }
__device__ __forceinline__ unsigned umax_(unsigned a, unsigned b) { return (int)a > (int)b ? a : b; }
__device__ __forceinline__ unsigned umin_(unsigned a, unsigned b) { return (int)a < (int)b ? a : b; }
#define CE_DESC(x, y) do { const unsigned a_ = (x), b_ = (y); (x) = umax_(a_, b_); (y) = umin_(a_, b_); } while (0)
__device__ __forceinline__ void sort16_desc(unsigned (&a)[16]) {
#pragma unroll
    for (int k = 2; k <= 16; k <<= 1)
#pragma unroll
        for (int j = k >> 1; j >= 1; j >>= 1)
#pragma unroll
            for (int i = 0; i < 16; ++i) { const int l = i ^ j; if (l > i) { if ((i & k) == 0) CE_DESC(a[i], a[l]); else CE_DESC(a[l], a[i]); } }
}
__device__ __forceinline__ void merge16_desc(unsigned (&a)[16], const unsigned (&b)[16]) {
#pragma unroll
    for (int i = 0; i < 16; ++i) a[i] = umax_(a[i], b[15 - i]);
#pragma unroll
    for (int j = 8; j >= 1; j >>= 1)
#pragma unroll
        for (int i = 0; i < 16; ++i) if ((i & j) == 0) CE_DESC(a[i], a[i + j]);
}
typedef short bf16x8s __attribute__((ext_vector_type(8)));
__device__ __forceinline__ void topk_unit(Frame& F, int wu, bool doh, int th, int tstride) {
    v4u ha[4][4];
    const int tg = wu >> 3, hd = wu & 7, lane = F.lane, r = lane & 31, hh = lane >> 5;
    const int t = tg * 32 + r;
    const size_t qoff = (size_t)t * D + hd * 256 + 8 * hh;
    unsigned L[2][16];
    unsigned hh4 = (unsigned)hh << 2; asm volatile("" : "+v"(hh4));
#pragma unroll
    for (int p = 0; p < 2; ++p) {
        f32x16 acc[4];
#pragma unroll
        for (int nt = 0; nt < 4; ++nt)
#pragma unroll
            for (int i = 0; i < 16; ++i) acc[nt][i] = 0.f;
        const size_t koff = ((size_t)(hd * 2 + p) * 128 + r) * 128 + 8 * hh;
        const bf16* qp = F.QH() + qoff + p * 128; const bf16* kp0 = F.KH() + koff; const bf16* kp1 = kp0 + 32 * 128; const bf16* kp2 = kp0 + 64 * 128; const bf16* kp3 = kp0 + 96 * 128;
        asm volatile("" : "+v"(qp), "+v"(kp0), "+v"(kp1), "+v"(kp2), "+v"(kp3));
#define P6_LOAD(Q, K, ks0, n) _Pragma("unroll") for (int i_ = 0; i_ < (n); ++i_) { Q[i_] = *(const GAS bf16x8s*)(qp + 16 * ((ks0) + i_)); \
            K[i_][0] = *(const GAS bf16x8s*)(kp0 + 16 * ((ks0) + i_)); K[i_][1] = *(const GAS bf16x8s*)(kp1 + 16 * ((ks0) + i_)); \
            K[i_][2] = *(const GAS bf16x8s*)(kp2 + 16 * ((ks0) + i_)); K[i_][3] = *(const GAS bf16x8s*)(kp3 + 16 * ((ks0) + i_)); }
#define P6_MMA(Q, K, n) _Pragma("unroll") for (int i_ = 0; i_ < (n); ++i_) _Pragma("unroll") for (int nt = 0; nt < 4; ++nt) acc[nt] = __builtin_amdgcn_mfma_f32_32x32x16_bf16(K[i_][nt], Q[i_], acc[nt], 0, 0, 0);
        bf16x8s qa[3], ka[3][4], qb[3], kb[3][4];
        P6_LOAD(qa, ka, 0, 3); P6_LOAD(qb, kb, 3, 3);
        __builtin_amdgcn_sched_barrier(0);
        P6_MMA(qa, ka, 3);
        __builtin_amdgcn_sched_barrier(0);
        P6_LOAD(qa, ka, 6, 2);
        __builtin_amdgcn_sched_barrier(0);
        P6_MMA(qb, kb, 3);
        __builtin_amdgcn_sched_barrier(0);
        P6_MMA(qa, ka, 2);
        __builtin_amdgcn_sched_barrier(0);
        if (p == 1) {
#pragma unroll
            for (int i = 0; i < 4; ++i) { if (doh) h8_issue(F, th + i * tstride, lane, ha[i]); else { ha[i][0] = ha[i][1] = ha[i][2] = ha[i][3] = (v4u){0u, 0u, 0u, 0u}; } }
            __builtin_amdgcn_sched_barrier(0);
        }
#undef P6_LOAD
#undef P6_MMA
        unsigned S[4][16];
#pragma unroll
        for (int nt = 0; nt < 4; ++nt) {
#pragma unroll
            for (int rg = 0; rg < 16; ++rg) { const int nc = 32 * nt + (rg & 3) + 8 * (rg >> 2); S[nt][rg] = ((fkey(acc[nt][rg]) & ~0x7Fu) | (unsigned)(127 - nc)) ^ hh4; }
            sort16_desc(S[nt]);
        }
        merge16_desc(S[0], S[1]); merge16_desc(S[2], S[3]); merge16_desc(S[0], S[2]);
        unsigned T[16];
#pragma unroll
        for (int i = 0; i < 16; ++i) T[i] = (unsigned)__shfl_xor((int)S[0][i], 32);
        merge16_desc(S[0], T);
#pragma unroll
        for (int i = 0; i < 16; ++i) L[p][i] = S[0][i];
        __builtin_amdgcn_sched_barrier(0);
    }
    float v0[16], v1[16];
#pragma unroll
    for (int i = 0; i < 16; ++i) { v0[i] = fkey_inv(L[0][i] & ~0x7Fu); v1[i] = fkey_inv(L[1][i] & ~0x7Fu); }
    unsigned C[4][16];
    {
        int cnt = 0;
#pragma unroll
        for (int i = 0; i < 16; ++i)
#pragma unroll
            for (int j = 0; j < 16; ++j) if ((i + 1) * (j + 1) <= 16) { C[cnt >> 4][cnt & 15] = (fkey(v0[i] + v1[j]) & ~0xFFu) | (unsigned)(255 - (i * 16 + j)); ++cnt; }
#pragma unroll
        for (int q = 50; q < 64; ++q) C[q >> 4][q & 15] = 0x80000000u;
    }
    sort16_desc(C[0]); sort16_desc(C[1]); sort16_desc(C[2]); sort16_desc(C[3]);
    merge16_desc(C[0], C[1]); merge16_desc(C[2], C[3]); merge16_desc(C[0], C[2]);
    unsigned best[16];
#pragma unroll
    for (int i = 0; i < 16; ++i) best[i] = C[0][i];
    LAS unsigned* tab = (LAS unsigned*)(F.lds + F.wave * 8192) + lane;
#pragma unroll
    for (int i = 0; i < 16; ++i) { tab[i * 64] = 127u - (L[0][i] & 0x7Fu); tab[(16 + i) * 64] = 127u - (L[1][i] & 0x7Fu); }
    const float smax = fkey_inv(best[0] & ~0xFFu);
    float sv[8]; unsigned idv[8]; float ssum = 0.f;
#pragma unroll
    for (int k = 0; k < 8; ++k) {
        const unsigned bk = hh ? best[8 + k] : best[k];
        const unsigned pos = 255u - (bk & 0xFFu);
        idv[k] = tab[(pos >> 4) * 64] * 128u + tab[(16 + (pos & 15u)) * 64];
        sv[k] = __builtin_amdgcn_exp2f((fkey_inv(bk & ~0xFFu) - smax) * 1.4426950409f); ssum += sv[k];
    }
    ssum += __shfl_xor(ssum, 32);
    const float inv = 1.0f / ssum;
    {
        int* o = F.IDS() + (size_t)t * 128 + hd * 16 + 8 * hh; float* og = F.GATES() + (size_t)t * 128 + hd * 16 + 8 * hh;
        *(GAS v4u*)o = (v4u){idv[0], idv[1], idv[2], idv[3]}; *(GAS v4u*)(o + 4) = (v4u){idv[4], idv[5], idv[6], idv[7]};
        *(GAS f32x4*)og = (f32x4){sv[0] * inv, sv[1] * inv, sv[2] * inv, sv[3] * inv}; *(GAS f32x4*)(og + 4) = (f32x4){sv[4] * inv, sv[5] * inv, sv[6] * inv, sv[7] * inv};
    }
    if (doh) {
#pragma unroll
        for (int i = 0; i < 4; ++i) h8_finish(F, th + i * tstride, lane, ha[i]);
    }
}
__device__ __forceinline__ int row_sum16(int v) {
    v += __builtin_amdgcn_update_dpp(0, v, 0x128, 0xf, 0xf, false);
    v += __builtin_amdgcn_update_dpp(0, v, 0x124, 0xf, 0xf, false);
    v += __builtin_amdgcn_update_dpp(0, v, 0x122, 0xf, 0xf, false);
    v += __builtin_amdgcn_update_dpp(0, v, 0x121, 0xf, 0xf, false);
    return v;
}
__device__ __forceinline__ void peer_u_xcd(Frame& F) {
    const int lane = F.lane, x = blockIdx.x & 7, jcu = blockIdx.x >> 3, ncu = ((int)F.G - x + 7) >> 3;
    const int tpc = (M + ncu - 1) / ncu, tpw = (tpc + NWAVES - 1) / NWAVES;
    const int tbase = jcu * tpc + F.wave * tpw;
    int nw = M - tbase; { const int lim = (jcu + 1) * tpc - tbase; nw = nw < lim ? nw : lim; nw = nw < tpw ? nw : tpw; nw = nw < 0 ? 0 : nw; }
    const int NV = nw;
    LAS unsigned char* wl = F.lds + F.wave * 13312;
    LAS int* lst = (LAS int*)wl; LAS int* res = (LAS int*)(wl + 512); LAS unsigned char* hsl = wl + 1024;
    const int q4 = lane >> 4, i16 = lane & 15;
    const unsigned char* ubase = F.U8() + (size_t)x * 2048 * 1024;
    const unsigned lanepart = (unsigned)i16 * 16u;
    int r_idlo = 0, r_idhi = 0, r_t = 0; v4u r_h0 = (v4u){0u, 0u, 0u, 0u}, r_h1 = (v4u){0u, 0u, 0u, 0u};
    int v_cl0 = 0, v_cl1 = 0, v_n = 0, v_r0 = 0, v_t = 0, v_slot = 0; unsigned long long v_mlo = 0, v_mhi = 0; bool v_live = false;
    int vset = 0, nvalid = 0, idle = 0;
    if (NV == 0) return;
#define U_RAW() do { const int vi_ = vset < NV ? vset : NV - 1; r_t = tbase + vi_; \
        r_idlo = F.IDS()[(size_t)r_t * 128 + lane]; r_idhi = F.IDS()[(size_t)r_t * 128 + 64 + lane]; \
        r_h0 = *(const GAS v4u*)(F.H8() + (size_t)r_t * D + lane * 16); r_h1 = *(const GAS v4u*)(F.H8() + (size_t)r_t * D + 1024 + lane * 16); } while (0)
#define U_NEXT() do { if (v_live && v_r0 + 16 < v_n) { v_r0 += 16; } else if (vset < NV) { const bool slo = (r_idlo >> 11) == x, shi = (r_idhi >> 11) == x; \
            v_mlo = __ballot(slo); v_mhi = __ballot(shi); const int nlo = __popcll(v_mlo); v_n = nlo + __popcll(v_mhi); \
            const int plo = __builtin_amdgcn_mbcnt_hi((unsigned)(v_mlo >> 32), __builtin_amdgcn_mbcnt_lo((unsigned)v_mlo, 0)); \
            const int phi = nlo + __builtin_amdgcn_mbcnt_hi((unsigned)(v_mhi >> 32), __builtin_amdgcn_mbcnt_lo((unsigned)v_mhi, 0)); \
            if (slo) lst[plo] = (r_idlo & 2047) | (lane << 16); if (shi) lst[phi] = (r_idhi & 2047) | ((64 + lane) << 16); \
            v_slot = nvalid % 6; ++nvalid; { LAS unsigned char* sp_ = hsl + v_slot * 2048; *(LAS v4u*)(sp_ + lane * 16) = r_h0; *(LAS v4u*)(sp_ + 1024 + lane * 16) = r_h1; } \
            v_cl0 = lst[lane]; v_cl1 = lst[64 + lane]; v_t = r_t; v_r0 = 0; ++vset; v_live = true; } \
        else { v_live = false; v_n = 0; v_r0 = 0; v_mlo = 0; v_mhi = 0; ++idle; } } while (0)
#define U_ISSUE(BUF, DS) do { { const int rem_ = v_n - v_r0; DS##_cnt = rem_ < 0 ? 0 : (rem_ < 16 ? rem_ : 16); } \
        DS##_slot = v_slot; DS##_t = v_t; DS##_mlo = v_mlo; DS##_mhi = v_mhi; DS##_last = v_live && (v_r0 + 16 >= v_n); \
        _Pragma("unroll") for (int gp = 0; gp < 4; ++gp) { const int ix_ = v_r0 + 4 * gp + q4; const int a_ = __shfl(v_cl0, ix_ & 63), b_ = __shfl(v_cl1, ix_ & 63); DS##_ent[gp] = ix_ < 64 ? a_ : b_; \
            const unsigned of_ = (4 * gp + q4 < DS##_cnt ? ((unsigned)(DS##_ent[gp] & 2047) << 10) : 0u) + lanepart; \
            _Pragma("unroll") for (int c = 0; c < 4; ++c) BUF[4 * gp + c] = *(const GAS v4u*)(ubase + of_ + c * 256); } } while (0)
#define U_COMPUTE(BUF, DS) do { const LAS unsigned char* sp_ = hsl + DS##_slot * 2048; const LAS v4u* hp_ = (const LAS v4u*)(sp_ + i16 * 16); \
        _Pragma("unroll") for (int gp = 0; gp < 4; ++gp) if (4 * gp < DS##_cnt) { int ah_ = 0, al_ = 0; \
            _Pragma("unroll") for (int c = 0; c < 4; ++c) { const v4u r_ = BUF[4 * gp + c]; const v4u hh_ = hp_[c * 16], hl_ = hp_[64 + c * 16]; \
                ah_ = __builtin_amdgcn_sdot8((int)r_.x, (int)hh_.x, ah_, false); al_ = __builtin_amdgcn_sdot8((int)r_.x, (int)hl_.x, al_, false); \
                ah_ = __builtin_amdgcn_sdot8((int)r_.y, (int)hh_.y, ah_, false); al_ = __builtin_amdgcn_sdot8((int)r_.y, (int)hl_.y, al_, false); \
                ah_ = __builtin_amdgcn_sdot8((int)r_.z, (int)hh_.z, ah_, false); al_ = __builtin_amdgcn_sdot8((int)r_.z, (int)hl_.z, al_, false); \
                ah_ = __builtin_amdgcn_sdot8((int)r_.w, (int)hh_.w, ah_, false); al_ = __builtin_amdgcn_sdot8((int)r_.w, (int)hl_.w, al_, false); } \
            const int a_ = row_sum16((ah_ << 4) + al_); if (i16 == 0 && 4 * gp + q4 < DS##_cnt) res[DS##_ent[gp] >> 16] = a_; } \
        if (DS##_last) { int* po_ = F.PART() + (size_t)DS##_t * 128; \
            if ((DS##_mlo >> lane) & 1ull) po_[lane] = res[lane]; if ((DS##_mhi >> lane) & 1ull) po_[64 + lane] = res[64 + lane]; } } while (0)
    v4u bufA[16], bufB[16], bufC[16];
    int dA_cnt = 0, dA_ent[4] = {0, 0, 0, 0}, dA_t = 0, dA_slot = 0; unsigned long long dA_mlo = 0, dA_mhi = 0; bool dA_last = false;
    int dB_cnt = 0, dB_ent[4] = {0, 0, 0, 0}, dB_t = 0, dB_slot = 0; unsigned long long dB_mlo = 0, dB_mhi = 0; bool dB_last = false;
    int dC_cnt = 0, dC_ent[4] = {0, 0, 0, 0}, dC_t = 0, dC_slot = 0; unsigned long long dC_mlo = 0, dC_mhi = 0; bool dC_last = false;
    U_RAW();
    U_NEXT(); U_RAW(); U_ISSUE(bufA, dA);
    U_NEXT(); U_RAW(); U_ISSUE(bufB, dB);
    while (idle < 3) {
        U_NEXT(); U_RAW(); U_ISSUE(bufC, dC); U_COMPUTE(bufA, dA);
        U_NEXT(); U_RAW(); U_ISSUE(bufA, dA); U_COMPUTE(bufB, dB);
        U_NEXT(); U_RAW(); U_ISSUE(bufB, dB); U_COMPUTE(bufC, dC);
    }
#undef U_RAW
#undef U_NEXT
#undef U_ISSUE
#undef U_COMPUTE
}
__device__ __forceinline__ void peer_act_token(Frame& F, int t) {
    const int lane = F.lane;
    LAS unsigned char* wl = F.lds + F.wave * 4096;
    LAS float* abuf = (LAS float*)wl; LAS int* ibuf = (LAS int*)(wl + 512); LAS int* cnt = (LAS int*)(wl + 1024);
    LAS int* ovf = (LAS int*)(wl + 1280); LAS int* fre = (LAS int*)(wl + 1792); LAS int* sop = (LAS int*)(wl + 2304);
#define WFENCE() asm volatile("s_waitcnt lgkmcnt(0)" ::: "memory")
    const float sc = __builtin_amdgcn_rsqf(F.ROWSS()[t] * (1.0f / D) + 1e-6f) * F.HSCALE()[t];
    if (lane < 34) cnt[lane] = 0;
    float am = 0.f; float actv[2]; int idv[2], slotv[2];
    const int l32 = t & 31;
#pragma unroll
    for (int half = 0; half < 2; ++half) {
        const size_t o = (size_t)t * 128 + half * 64 + lane;
        const int e = F.IDS()[o]; const float g = F.GATES()[o];
        const int dsum = F.PART()[o];
        actv[half] = gelu_tanh((float)dsum * sc * F.USCALE()[e]) * g * F.VSCALE()[e]; idv[half] = e; am = fmaxf(am, fabsf(actv[half]));
    }
    WFENCE();
#pragma unroll
    for (int half = 0; half < 2; ++half) {
        const int r = idv[half] & 31;
        const int j = __hip_atomic_fetch_add(cnt + r, 1, __ATOMIC_RELAXED, __HIP_MEMORY_SCOPE_WORKGROUP);
        if (j < 4) slotv[half] = ((r - l32) & 31) + 32 * j;
        else { const int q = __hip_atomic_fetch_add(cnt + 32, 1, __ATOMIC_RELAXED, __HIP_MEMORY_SCOPE_WORKGROUP); ovf[q] = half * 64 + lane; slotv[half] = -1; }
    }
    WFENCE();
    if (lane < 32) { const int n = cnt[lane];
        for (int j = n; j < 4; ++j) { const int q = __hip_atomic_fetch_add(cnt + 33, 1, __ATOMIC_RELAXED, __HIP_MEMORY_SCOPE_WORKGROUP); fre[q] = ((lane - l32) & 31) + 32 * j; } }
    WFENCE();
    const int nov = cnt[32];
#pragma unroll
    for (int half = 0; half < 2; ++half) { const int i = half * 64 + lane; if (i < nov) sop[ovf[i]] = fre[i]; }
    WFENCE();
#pragma unroll
    for (int half = 0; half < 2; ++half) { if (slotv[half] < 0) slotv[half] = sop[half * 64 + lane]; abuf[slotv[half]] = actv[half]; ibuf[slotv[half]] = idv[half]; }
    WFENCE();
#pragma unroll
    for (int o = 1; o < 64; o <<= 1) am = fmaxf(am, __shfl_xor(am, o));
    const float asc = am > 0.f ? 127.0f / am : 1.0f;
    if (lane == 0) F.ASCALE()[t] = am > 0.f ? am * (1.0f / 127.0f) : 1.0f;
    if (lane < 32) {
        const f32x4 av = *(const LAS f32x4*)(abuf + 4 * lane); const v4u iv = *(const LAS v4u*)(ibuf + 4 * lane);
        const size_t o = ((size_t)(t >> 6) * 32 + lane) * 64 + (t & 63);
        F.IDW()[o] = (v4u){iv.x << 3, iv.y << 3, iv.z << 3, iv.w << 3};
        F.AW()[o] = pack_i8x4(av.x * asc, av.y * asc, av.z * asc, av.w * asc);
    }
    WFENCE();
#undef WFENCE
}
__device__ __forceinline__ void tr4x4(const unsigned r0, const unsigned r1, const unsigned r2, const unsigned r3, unsigned (&c)[4]) {
    const unsigned t01l = __builtin_amdgcn_perm(r1, r0, 0x05010400u), t01h = __builtin_amdgcn_perm(r1, r0, 0x07030602u);
    const unsigned t23l = __builtin_amdgcn_perm(r3, r2, 0x05010400u), t23h = __builtin_amdgcn_perm(r3, r2, 0x07030602u);
    c[0] = __builtin_amdgcn_perm(t23l, t01l, 0x05040100u); c[1] = __builtin_amdgcn_perm(t23l, t01l, 0x07060302u);
    c[2] = __builtin_amdgcn_perm(t23h, t01h, 0x05040100u); c[3] = __builtin_amdgcn_perm(t23h, t01h, 0x07060302u);
}
template <int MODE>
__device__ __forceinline__ void peer_v_slice(Frame& F, int c, bool do_atomic) {
    const int tid = F.tid, lane = F.lane;
    for (int i = tid; i < NEXP * 8 / 16; i += 512) *(LAS v4u*)(F.lds + i * 16) = *(const GAS v4u*)(F.V8T() + (size_t)c * NEXP * 8 + (size_t)i * 16);
    __syncthreads();
    const v4u* ibase = F.IDW() + lane; const unsigned* abase = F.AW() + lane;
    constexpr int NBLK = M / 64, PD = 16;
    v4u iq[PD]; unsigned aq[PD]; v2u rw[2][4];
    {
        const size_t o = (size_t)F.wave * 32 * 64;
#pragma unroll
        for (int j = 0; j < PD; ++j) { iq[j] = *(const GAS v4u*)(ibase + o + j * 64); aq[j] = abase[o + j * 64]; }
    }
#define LROW(dst, q) do { dst[0] = *(const LAS v2u*)(F.lds + (q).x); dst[1] = *(const LAS v2u*)(F.lds + (q).y); \
                          dst[2] = *(const LAS v2u*)(F.lds + (q).z); dst[3] = *(const LAS v2u*)(F.lds + (q).w); } while (0)
    for (int blk = F.wave; blk < NBLK; blk += NWAVES) {
        const int t = blk * 64 + lane;
        const size_t o = (size_t)blk * 32 * 64;
        const int nblk = (blk + NWAVES < NBLK) ? blk + NWAVES : blk;
        const size_t on = (size_t)nblk * 32 * 64;
        int acc[8];
#pragma unroll
        for (int i = 0; i < 8; ++i) acc[i] = 0;
        LROW(rw[0], iq[0]);
#pragma unroll
        for (int j = 0; j < 32; ++j) {
            if (j + 1 < 32) LROW(rw[(j + 1) & 1], iq[(j + 1) % PD]);
            const unsigned aw = aq[j % PD];
            unsigned cl[4], ch[4];
            tr4x4(rw[j & 1][0].x, rw[j & 1][1].x, rw[j & 1][2].x, rw[j & 1][3].x, cl);
            tr4x4(rw[j & 1][0].y, rw[j & 1][1].y, rw[j & 1][2].y, rw[j & 1][3].y, ch);
#pragma unroll
            for (int i = 0; i < 4; ++i) { acc[i] = __builtin_amdgcn_sdot4((int)aw, (int)cl[i], acc[i], false); acc[4 + i] = __builtin_amdgcn_sdot4((int)aw, (int)ch[i], acc[4 + i], false); }
            { const size_t oo = (j + PD < 32) ? o + (size_t)(j + PD) * 64 : on + (size_t)(j + PD - 32) * 64;
              iq[j % PD] = *(const GAS v4u*)(ibase + oo); aq[j % PD] = abase[oo]; }
            __builtin_amdgcn_sched_barrier(0);
        }
        const float asc = F.ASCALE()[t];
        float accf[8];
#pragma unroll
        for (int i = 0; i < 8; ++i) accf[i] = (float)acc[i] * asc;
        const v4u hb = *(const GAS v4u*)(F.HBT() + ((size_t)c * M + t) * 8);
        accf[0] += bf_lo(hb.x); accf[1] += bf_hi(hb.x); accf[2] += bf_lo(hb.y); accf[3] += bf_hi(hb.y);
        accf[4] += bf_lo(hb.z); accf[5] += bf_hi(hb.z); accf[6] += bf_lo(hb.w); accf[7] += bf_hi(hb.w);
        bf16* yp = (MODE == 0) ? F.Y() + ((size_t)c * M + t) * 8 : (bf16*)F.XN() + ((((size_t)c * M + t) * 8) & (size_t)0x1ffffff);
        *(GAS v4u*)yp = (v4u){pk2(accf[0], accf[1]), pk2(accf[2], accf[3]), pk2(accf[4], accf[5]), pk2(accf[6], accf[7])};
        float ss = 0.f;
#pragma unroll
        for (int i = 0; i < 8; ++i) ss += accf[i] * accf[i];
        if (do_atomic) atomicAdd(F.ROWSS2() + t, ss);
    }
#undef LROW
    __syncthreads();
}
__device__ __forceinline__ void final_unit(Frame& F, int unit) {
    const int tid = F.tid, blk = unit >> 3, cg = unit & 7, t0 = blk * 64;
    LAS float* T = (LAS float*)F.lds;
#pragma unroll
    for (int i = 0; i < 4; ++i) { const int pid = tid + 512 * i, cl = pid >> 6, tok = pid & 63;
        const v4u v = *(const GAS v4u*)(F.Y() + ((size_t)(cg * 32 + cl) * M + t0 + tok) * 8);
        *(LAS f32x4*)(T + tok * 260 + cl * 8) = (f32x4){bf_lo(v.x), bf_hi(v.x), bf_lo(v.y), bf_hi(v.y)};
        *(LAS f32x4*)(T + tok * 260 + cl * 8 + 4) = (f32x4){bf_lo(v.z), bf_hi(v.z), bf_lo(v.w), bf_hi(v.w)}; }
    __syncthreads();
#pragma unroll
    for (int i = 0; i < 8; ++i) { const int pid = tid + 512 * i, tok = pid >> 6, c4 = pid & 63;
        const float rs = __builtin_amdgcn_rsqf(F.ROWSS2()[t0 + tok] * (1.0f / D) + 1e-6f);
        const f32x4 v = *(const LAS f32x4*)(T + tok * 260 + c4 * 4);
        const f32x4 g = *(const GAS f32x4*)(F.A.in[20] + cg * 256 + c4 * 4);
        *(GAS f32x4*)(F.A.out + (size_t)(t0 + tok) * D + cg * 256 + c4 * 4) = v * rs * g; }
    __syncthreads();
}
__global__ void __launch_bounds__(NWAVES * 64, 2) mk_fwd(Args args) {
    __shared__ __attribute__((aligned(16))) unsigned char lds[LDS_BYTES];
    Frame F(args);
    F.lds = (LAS unsigned char*)lds;
    F.MISC = (volatile LAS unsigned*)(F.lds + MISC_OFF);
    F.tid = threadIdx.x; F.lane = F.tid & 63; F.wave = __builtin_amdgcn_readfirstlane(F.tid >> 6);
    F.G = gridDim.x; { const int bx = blockIdx.x; F.vcu = (F.G % 8 == 0) ? (bx % 8) * (F.G / 8) + bx / 8 : bx; }
    F.ws = args.ws;
    F.ctl = (gu32*)(args.ws + WS_CTL);
    for (int u = F.tid; u < (LDS_BYTES - LDSCTL_OFF) / 4; u += NWAVES * 64) ((LAS unsigned*)(F.lds + LDSCTL_OFF))[u] = 0u;
    __syncthreads();
    XcdBarrier bar; bar.bar = (unsigned*)(F.ctl + CW_BAR); bar.x = 0; bar.st = nullptr;
    if (N_LAUNCHES != PER_PHASE) bar = xcd_barrier_post((unsigned*)(F.ctl + CW_BAR), F.MISC + 8);
#define GRID_BAR() do { if (N_LAUNCHES != PER_PHASE) xcd_barrier(bar); } while (0)
    const int lo = args.ph_lo, hi = args.ph_hi;
#ifndef MK_PHASE_MASK
#define MK_PHASE_MASK 0x7FF
#endif
#define IN(k) (((MK_PHASE_MASK >> (k)) & 1) && lo <= (k) && (k) < hi)
#undef MK_PHASE_MASK
#define MK_PHASE_MASK 0xFFFF
#define BOTH(k) (true)
#ifndef MK_REP_MASK
#define MK_REP_MASK 0
#endif
#ifndef MK_REP_N
#define MK_REP_N 2
#endif
#ifndef H8_REP
#define H8_REP 1
#endif
#define REPS(k) for (int rep_ = 0; rep_ < ((((MK_REP_MASK) >> (k)) & 1) ? 1 + MK_REP_N : 1); ++rep_)
    const int gw = F.vcu * NWAVES + F.wave, NGW = F.G * NWAVES;
    if (IN(0)) { REPS(0) { p0_prologue(F); __syncthreads(); } if (BOTH(0)) GRID_BAR(); }
    if (IN(1)) {
        pg8::Gemm g{F.XN(), F.WIN(), M, NIN, D}; pg8::StaticOrder S; S.init(M, NIN, F.G, (int)blockIdx.x);
        pg8::EpiZ E{F.Z(), NIN, LW};
        REPS(1) pg8::gemm_phase<pg8::EpiZ, pg8::StaticOrder, true, true>(F.lds, g, S, E);
        if (BOTH(1)) GRID_BAR();
    }
    if (IN(2)) {
        REPS(12) { v4u xr[5]; int u = blockIdx.x; lru_prefetch(F, u, F.tid, xr); lru_conv(F, u, F.tid, xr); __syncthreads();
                   for (; u < BATCH * NCHUNK * 8; u += F.G) lru_fused_unit(F, u, u + F.G < BATCH * NCHUNK * 8 ? u + F.G : -1, xr); }
        asm volatile("" : "+v"(F.tid), "+v"(F.lane));
        REPS(13) for (int u = blockIdx.x; u < BATCH * NCHUNK; u += F.G) gmlp_unit(F, u);
        if (BOTH(2)) GRID_BAR();
    }
    if (IN(4)) {
        pg8::Gemm g{F.MIX(), F.WOUT(), M, D, D}; pg8::StaticOrder S; S.init(M, D, F.G, (int)blockIdx.x);
        pg8::EpiH E{F.HB(), F.HBT(), F.A.in[0], F.ROWSS(), D, M};
        pg8::gemm_phase<pg8::EpiH, pg8::StaticOrder, true, true>(F.lds, g, S, E);
        if (BOTH(4)) GRID_BAR();
    }
    if (IN(5)) {
        pg8::Gemm g{F.HB(), F.WQ(), M, D, D}; pg8::StaticOrder S; S.init(M, D, F.G, (int)blockIdx.x);
        pg8::EpiQ E{F.QH(), F.ROWSS(), D};
        REPS(5) pg8::gemm_phase<pg8::EpiQ, pg8::StaticOrder, true, true>(F.lds, g, S, E);
        if (BOTH(5)) GRID_BAR();
    }
    if (IN(6)) {
        REPS(6) { int hk = 0;
                  for (int wu = gw; wu < (M / 32) * 8; wu += NGW) { const bool doh = gw + NGW * (hk + 3) < M; topk_unit(F, wu, doh, gw + NGW * hk, NGW); if (doh) hk += 4; }
                  for (int t = gw + NGW * hk; t < M; t += NGW) h8_row(F, t); }
        if (BOTH(6)) GRID_BAR();
    }
    if (IN(7)) {
        REPS(7) peer_u_xcd(F);
        if (BOTH(7)) GRID_BAR();
    }
    if (IN(8)) {
        REPS(8) for (int t = gw; t < M; t += NGW) peer_act_token(F, t);
        if (BOTH(8)) GRID_BAR();
    }
    if (IN(9)) {
        for (int c = blockIdx.x; c < D / 8; c += F.G) peer_v_slice<0>(F, c, true);
        if ((MK_REP_MASK >> 9) & 1) { for (int rep_ = 0; rep_ < MK_REP_N; ++rep_) for (int c = blockIdx.x; c < D / 8; c += F.G) peer_v_slice<1>(F, c, false); }
        if (BOTH(9)) GRID_BAR();
    }
    if (IN(10)) {
        REPS(10) for (int u = blockIdx.x; u < (M / 64) * 8; u += F.G) final_unit(F, u);
    }
#undef IN
#undef BOTH
#undef GRID_BAR
}

extern "C" void kernel_launch(void* const* d_in, const int* in_sizes, int n_in, void* d_out, int out_size, void* d_ws, size_t ws_size, hipStream_t stream) {
    static int grid = 0;
    if (grid == 0) {
        if (n_in != 21 || in_sizes[0] != M * D || out_size != M * D || ws_size < WS_END) { fprintf(stderr, "kernel_launch: unexpected shapes (n_in %d, in0 %d, out %d, ws %zu)\n", n_in, n_in > 0 ? in_sizes[0] : -1, out_size, ws_size); grid = -1; return; }
        int dev = 0, cus = 0, per_cu = 0;
        if (hipGetDevice(&dev) != hipSuccess || hipDeviceGetAttribute(&cus, hipDeviceAttributeMultiprocessorCount, dev) != hipSuccess) { grid = -1; return; }
        if (hipOccupancyMaxActiveBlocksPerMultiprocessor(&per_cu, (const void*)mk_fwd, NWAVES * 64, 0) != hipSuccess || per_cu < 1) { fprintf(stderr, "kernel_launch: occupancy query reports %d blocks per CU\n", per_cu); }
        (void)hipGetLastError();
        grid = cus;
        if (cus < 256) { fprintf(stderr, "kernel_launch: the RG-LRU family hand-off needs >= 256 co-resident workgroups (have %d)\n", cus); grid = -1; return; }
    }
    if (grid < 0) return;
    (void)hipMemsetAsync((char*)d_ws + WS_CTL, 0, CTL_ZERO_BYTES, stream);
    Args a{};
    for (int i = 0; i < 21; ++i) a.in[i] = (const float*)d_in[i];
    a.out = (float*)d_out; a.ws = (unsigned char*)d_ws;
    for (int li = 0; li < N_LAUNCHES; ++li) {
        a.ph_lo = 0; a.ph_hi = 99;
        hipLaunchKernelGGL(mk_fwd, dim3(grid), dim3(NWAVES * 64), 0, stream, a);
    }
}
```

```cpp
#include <hip/hip_runtime.h>
#include <cstdio>
#include <cstdint>
namespace pg8 {
#define PG8_LAS __attribute__((address_space(3)))
typedef unsigned short bf16_t;
typedef short bf16x8 __attribute__((ext_vector_type(8)));
typedef float f32x4 __attribute__((ext_vector_type(4)));
typedef unsigned u32x4 __attribute__((ext_vector_type(4)));
constexpr int BM = 256, BK = 64, HALF = 128, HTB = HALF * BK * 2  , STAGE_BYTES = 8 * HTB, NXCD = 8, WGM = 8;

__host__ __device__ __forceinline__ int lds_byte(int r, int c) { const int st = (r >> 4) * 2 + (c >> 5), rr = r & 15, cc = c & 31, ob = rr * 64 + cc * 2; return st * 1024 + (ob ^ (((ob >> 9) & 1) << 5)); }
__host__ __device__ __forceinline__ void stage_rc(int b, int& R, int& C) { const int st = b / 1024, sb = b % 1024, swz = sb ^ (((sb >> 9) & 1) << 5); R = (st >> 1) * 16 + swz / 64; C = (st & 1) * 32 + (swz % 64) / 2; }
__host__ __device__ __forceinline__ int perm32(int rho) { const int n = rho >> 4, i = rho & 15; return 8 * (i >> 2) + 4 * n + (i & 3); }

struct Unit { int pm, pn; };
struct Gemm { const bf16_t* A; const bf16_t* Bt; int M, N, K; };

struct StaticOrder {
    int nM, nN, nwg, G, c;
    __host__ __device__ void init(int M, int N, int G_, int c_) { nM = M / BM; nN = N / BM; nwg = nM * nN; G = G_; c = c_; }
    __host__ __device__ bool next(int i, Unit& u) const {
        const long L = (long)i * G + c; if (L >= nwg) return false;
        int wgid = (int)L; { const int q = nwg / NXCD, r = nwg % NXCD, xcd = wgid % NXCD, off = wgid / NXCD; wgid = (xcd < r ? xcd * (q + 1) : r * (q + 1) + (xcd - r) * q) + off; }
        const int nig = WGM * nN, gid = wgid / nig, fm = gid * WGM, gsz = (nM - fm) < WGM ? (nM - fm) : WGM;
        u.pm = fm + ((wgid % nig) % gsz); u.pn = (wgid % nig) / gsz; return true;
    }
    __device__ __forceinline__ void a_ready(const Unit&) const {}
    __device__ __forceinline__ void done(const Unit&) const {}
};

__device__ __forceinline__ unsigned cvt_pk_bf16(float lo, float hi) { unsigned r; asm volatile("v_cvt_pk_bf16_f32 %0, %1, %2" : "=v"(r) : "v"(lo), "v"(hi)); return r; }
__device__ __forceinline__ float gelu_tanh(float x) {
    const float t = x * (1.0f + 0.044715f * x * x);
    const float e = __builtin_amdgcn_exp2f(-2.3022081983f * t);
    return x * __builtin_amdgcn_rcpf(1.0f + e);
}
struct EpiZ {
    static constexpr bool PERM = true, AFTER_DRAIN = false;
    bf16_t* O; int ldc; int gelu_from;
    __device__ __forceinline__ void operator()(const f32x4 (&acc)[2][2][4][2], const Unit& u, int wr, int wc, int fr, int fq) const {
        const int row0 = u.pm * BM + wr * 64 + fr; const int col0 = u.pn * BM + wc * 32 + 8 * fq;
        const bool act = (u.pn * BM) >= gelu_from;
#pragma unroll
        for (int ai = 0; ai < 2; ++ai)
#pragma unroll
            for (int m = 0; m < 4; ++m) { bf16_t* rowp = O + (size_t)(row0 + ai * HALF + m * 16) * ldc + col0;
#pragma unroll
                for (int bj = 0; bj < 2; ++bj) { f32x4 v0 = acc[ai][bj][m][0], v1 = acc[ai][bj][m][1];
                    if (act) {
#pragma unroll
                        for (int j = 0; j < 4; ++j) { v0[j] = gelu_tanh(v0[j]); v1[j] = gelu_tanh(v1[j]); } }
                    u32x4 w; w.x = cvt_pk_bf16(v0[0], v0[1]); w.y = cvt_pk_bf16(v0[2], v0[3]); w.z = cvt_pk_bf16(v1[0], v1[1]); w.w = cvt_pk_bf16(v1[2], v1[3]);
                    *(u32x4*)(rowp + bj * HALF) = w; } }
    }
};
struct EpiH {
    static constexpr bool PERM = true, AFTER_DRAIN = false;
    bf16_t* O; bf16_t* OT; const float* X; float* rowss; int ldc; int mrows;
    __device__ __forceinline__ void operator()(const f32x4 (&acc)[2][2][4][2], const Unit& u, int wr, int wc, int fr, int fq) const {
        const int row0 = u.pm * BM + wr * 64 + fr; const int col0 = u.pn * BM + wc * 32 + 8 * fq;
#pragma unroll
        for (int ai = 0; ai < 2; ++ai)
#pragma unroll
            for (int m = 0; m < 4; ++m) { const int row = row0 + ai * HALF + m * 16; const size_t off = (size_t)row * ldc + col0; float ss = 0.f;
#pragma unroll
                for (int bj = 0; bj < 2; ++bj) {
                    const f32x4 x0 = *(const f32x4*)(X + off + bj * HALF), x1 = *(const f32x4*)(X + off + bj * HALF + 4);
                    const f32x4 v0 = acc[ai][bj][m][0] + x0, v1 = acc[ai][bj][m][1] + x1;
                    ss += (v0[0] * v0[0] + v0[1] * v0[1]) + (v0[2] * v0[2] + v0[3] * v0[3]) + (v1[0] * v1[0] + v1[1] * v1[1]) + (v1[2] * v1[2] + v1[3] * v1[3]);
                    u32x4 w; w.x = cvt_pk_bf16(v0[0], v0[1]); w.y = cvt_pk_bf16(v0[2], v0[3]); w.z = cvt_pk_bf16(v1[0], v1[1]); w.w = cvt_pk_bf16(v1[2], v1[3]);
                    *(u32x4*)(O + off + bj * HALF) = w;
                    *(u32x4*)(OT + ((size_t)((col0 + bj * HALF) >> 3) * mrows + row) * 8) = w; }
                ss += __shfl_xor(ss, 16); ss += __shfl_xor(ss, 32);
                if (fq == 0) atomicAdd(rowss + row, ss); }
    }
};
struct EpiQ {
    static constexpr bool PERM = true, AFTER_DRAIN = false;
    bf16_t* QH; const float* rowss; int ldc;
    __device__ __forceinline__ void operator()(const f32x4 (&acc)[2][2][4][2], const Unit& u, int wr, int wc, int fr, int fq) const {
        const int row0 = u.pm * BM + wr * 64 + fr, col0 = u.pn * BM + wc * 32 + 8 * fq;
#pragma unroll
        for (int ai = 0; ai < 2; ++ai)
#pragma unroll
            for (int m = 0; m < 4; ++m) { const int row = row0 + ai * HALF + m * 16; const float rs = __builtin_amdgcn_rsqf(rowss[row] * (1.0f / 2048.0f) + 1e-6f);
                const size_t off = (size_t)row * ldc + col0;
#pragma unroll
                for (int bj = 0; bj < 2; ++bj) { const f32x4 v0 = acc[ai][bj][m][0] * rs, v1 = acc[ai][bj][m][1] * rs;
                    u32x4 wh; wh.x = cvt_pk_bf16(v0[0], v0[1]); wh.y = cvt_pk_bf16(v0[2], v0[3]); wh.z = cvt_pk_bf16(v1[0], v1[1]); wh.w = cvt_pk_bf16(v1[2], v1[3]);
                    *(u32x4*)(QH + off + bj * HALF) = wh; } }
    }
};
template <class Epi, class Sched, bool ALIGN_EPI = false, bool SP2 = false>
__device__ __forceinline__ void gemm_phase(PG8_LAS unsigned char* lds, const Gemm g, const Sched& S, const Epi& E) {
    const int tid = threadIdx.x, wid = __builtin_amdgcn_readfirstlane(tid >> 6), lane = tid & 63, wr = wid >> 2, wc = wid & 3, fr = lane & 15, fq = lane >> 4;
    const int K = g.K, nt = K / BK;
    unsigned voffA[2], voffB[2];
#pragma unroll
    for (int i = 0; i < 2; ++i) { int R, C; stage_rc(tid * 16 + i * 8192, R, C); const int Rb = Epi::PERM ? ((R & ~31) + perm32(R & 31)) : R;
        voffA[i] = (unsigned)(R * K + C) * 2u; voffB[i] = (unsigned)(Rb * K + C) * 2u; }
    const size_t kstep = (size_t)(BK * 2);
    const size_t hstep = (size_t)HALF * K * 2;
    const size_t tstep = 2 * hstep;
    const unsigned ldsw = (unsigned)wid * 1024u;
    const int aoff = lds_byte(wr * 64 + fr, fq * 8), boff = lds_byte(wc * 32 + fr, fq * 8);
#define PG8_SA(b, h) (((b) * 2 + (h)) * HTB)
#define PG8_SB(b, h) ((4 + (b) * 2 + (h)) * HTB)
#define PG8_STAGE(bufoff, gbase, voff) do { _Pragma("unroll") for (int _i = 0; _i < 2; ++_i) \
        __builtin_amdgcn_global_load_lds((const unsigned*)((const char*)(gbase) + (voff)[_i]), (PG8_LAS unsigned*)(lds + (bufoff) + ldsw + _i * 8192), 16, 0, 0); } while (0)
#define PG8_LDA(dst, b, h) do { _Pragma("unroll") for (int m = 0; m < 4; ++m) _Pragma("unroll") for (int k = 0; k < 2; ++k) dst[m][k] = *(const PG8_LAS bf16x8*)(lds + PG8_SA(b, h) + aoff + m * 2048 + k * 1024); } while (0)
#define PG8_LDB(dst, b, h) do { _Pragma("unroll") for (int n = 0; n < 2; ++n) _Pragma("unroll") for (int k = 0; k < 2; ++k) dst[n][k] = *(const PG8_LAS bf16x8*)(lds + PG8_SB(b, h) + boff + n * 2048 + k * 1024); } while (0)
#define PG8_MMA(ai, bj, At, Bt) do { __builtin_amdgcn_s_setprio(1); _Pragma("unroll") for (int m = 0; m < 4; ++m) _Pragma("unroll") for (int n = 0; n < 2; ++n) _Pragma("unroll") for (int k = 0; k < 2; ++k) \
        acc[ai][bj][m][n] = __builtin_amdgcn_mfma_f32_16x16x32_bf16(Bt[n][k], At[m][k], acc[ai][bj][m][n], 0, 0, 0); __builtin_amdgcn_s_setprio(0); } while (0)
#define PG8_WAIT_V(n) asm volatile("s_waitcnt vmcnt(" #n ")" ::: "memory")
#define PG8_WAIT_L(n) asm volatile("s_waitcnt lgkmcnt(" #n ")" ::: "memory")
#define PG8_BAR __builtin_amdgcn_s_barrier()
#define PG8_SCHED __builtin_amdgcn_sched_barrier(0)
    Unit cur, nxt; int ui = 0;
    if (!S.next(0, cur)) return;
    f32x4 acc[2][2][4][2];
#pragma unroll
    for (int a = 0; a < 2; ++a)
#pragma unroll
        for (int b = 0; b < 2; ++b)
#pragma unroll
            for (int m = 0; m < 4; ++m)
#pragma unroll
                for (int n = 0; n < 2; ++n) acc[a][b][m][n] = (f32x4){0.f, 0.f, 0.f, 0.f};
    bf16x8 At[4][2], B0[2][2], B1[2][2];
    const char* cA = (const char*)g.A + (size_t)cur.pm * tstep; const char* cB = (const char*)g.Bt + (size_t)cur.pn * tstep;
    S.a_ready(cur);
    if constexpr (SP2) {
        PG8_STAGE(PG8_SB(0, 0), cB, voffB); PG8_STAGE(PG8_SB(0, 1), cB + hstep, voffB); PG8_STAGE(PG8_SA(0, 0), cA, voffA); PG8_STAGE(PG8_SA(0, 1), cA + hstep, voffA);
        if (wr == 1) PG8_BAR;
        PG8_WAIT_V(2); PG8_BAR;
        PG8_STAGE(PG8_SB(1, 0), cB + kstep, voffB); PG8_STAGE(PG8_SA(1, 0), cA + kstep, voffA); PG8_STAGE(PG8_SB(1, 1), cB + hstep + kstep, voffB);
        PG8_WAIT_V(6); PG8_BAR;
    } else {
        PG8_STAGE(PG8_SB(0, 0), cB, voffB); PG8_STAGE(PG8_SA(0, 0), cA, voffA); PG8_STAGE(PG8_SB(0, 1), cB + hstep, voffB); PG8_STAGE(PG8_SA(0, 1), cA + hstep, voffA);
        if (wr == 1) PG8_BAR;
        PG8_WAIT_V(4); PG8_BAR;
        PG8_STAGE(PG8_SB(1, 0), cB + kstep, voffB); PG8_STAGE(PG8_SA(1, 0), cA + kstep, voffA); PG8_STAGE(PG8_SB(1, 1), cB + hstep + kstep, voffB);
        PG8_WAIT_V(6); PG8_BAR;
    }
    for (;;) {
        const bool has_next = S.next(ui + 1, nxt);
        const char* nA = has_next ? (const char*)g.A + (size_t)nxt.pm * tstep : cA; const char* nB = has_next ? (const char*)g.Bt + (size_t)nxt.pn * tstep : cB;
        for (int t = 0; t < nt; t += 2) {
            const bool last = (t == nt - 2);
            const char* a1 = cA + (size_t)(t + 1) * kstep;
            const char* a2 = last ? nA : cA + (size_t)(t + 2) * kstep; const char* b2 = last ? nB : cB + (size_t)(t + 2) * kstep;
            const char* a3 = a2 + kstep; const char* b3 = b2 + kstep;
            if (last && has_next) S.a_ready(nxt);
            if constexpr (SP2) {
            PG8_LDB(B0, 0, 0); PG8_LDB(B1, 0, 1); PG8_SCHED; PG8_LDA(At, 0, 0); PG8_STAGE(PG8_SA(1, 1), a1 + hstep, voffA);
            PG8_WAIT_V(8); PG8_WAIT_L(0); PG8_BAR; PG8_MMA(0, 0, At, B0); PG8_MMA(0, 1, At, B1); PG8_BAR; PG8_SCHED;
            PG8_LDA(At, 0, 1); PG8_STAGE(PG8_SB(0, 0), b2, voffB); PG8_STAGE(PG8_SB(0, 1), b2 + hstep, voffB); PG8_STAGE(PG8_SA(0, 0), a2, voffA);
            PG8_WAIT_V(8); PG8_WAIT_L(0); PG8_BAR; PG8_MMA(1, 0, At, B0); PG8_MMA(1, 1, At, B1); PG8_BAR; PG8_SCHED;
            PG8_LDB(B0, 1, 0); PG8_LDB(B1, 1, 1); PG8_SCHED; PG8_LDA(At, 1, 0); PG8_STAGE(PG8_SA(0, 1), a2 + hstep, voffA);
            PG8_WAIT_V(8); PG8_WAIT_L(0); PG8_BAR; PG8_MMA(0, 0, At, B0); PG8_MMA(0, 1, At, B1); PG8_BAR; PG8_SCHED;
            PG8_LDA(At, 1, 1); PG8_STAGE(PG8_SB(1, 0), b3, voffB); PG8_STAGE(PG8_SB(1, 1), b3 + hstep, voffB); PG8_STAGE(PG8_SA(1, 0), a3, voffA);
            PG8_WAIT_V(8); PG8_WAIT_L(0); PG8_BAR; PG8_MMA(1, 0, At, B0); PG8_MMA(1, 1, At, B1); PG8_BAR; PG8_SCHED;
            } else {
            PG8_LDB(B0, 0, 0); PG8_SCHED; PG8_LDA(At, 0, 0); PG8_STAGE(PG8_SA(1, 1), a1 + hstep, voffA);
            PG8_WAIT_L(8); PG8_BAR; PG8_WAIT_L(0); PG8_MMA(0, 0, At, B0); PG8_BAR; PG8_SCHED;
            PG8_LDB(B1, 0, 1); PG8_STAGE(PG8_SB(0, 0), b2, voffB);
            PG8_BAR; PG8_WAIT_L(0); PG8_MMA(0, 1, At, B1); PG8_BAR;
            PG8_LDA(At, 0, 1); PG8_STAGE(PG8_SA(0, 0), a2, voffA);
            PG8_BAR; PG8_WAIT_L(0); PG8_MMA(1, 0, At, B0); PG8_BAR; PG8_SCHED;
            PG8_STAGE(PG8_SB(0, 1), b2 + hstep, voffB);
            PG8_WAIT_V(6); PG8_BAR; PG8_MMA(1, 1, At, B1); PG8_BAR;
            PG8_LDB(B0, 1, 0); PG8_SCHED; PG8_LDA(At, 1, 0); PG8_STAGE(PG8_SA(0, 1), a2 + hstep, voffA);
            PG8_WAIT_L(8); PG8_BAR; PG8_WAIT_L(0); PG8_MMA(0, 0, At, B0); PG8_BAR; PG8_SCHED;
            PG8_LDB(B1, 1, 1); PG8_STAGE(PG8_SB(1, 0), b3, voffB);
            PG8_BAR; PG8_WAIT_L(0); PG8_MMA(0, 1, At, B1); PG8_BAR;
            PG8_LDA(At, 1, 1); PG8_STAGE(PG8_SA(1, 0), a3, voffA);
            PG8_BAR; PG8_WAIT_L(0); PG8_MMA(1, 0, At, B0); PG8_BAR; PG8_SCHED;
            PG8_STAGE(PG8_SB(1, 1), b3 + hstep, voffB);
            PG8_WAIT_V(6); PG8_BAR; PG8_MMA(1, 1, At, B1); PG8_BAR;
            }
        }
        if constexpr (ALIGN_EPI) { if (wr == 0) PG8_BAR; }
        if constexpr (!Epi::AFTER_DRAIN) { E(acc, cur, wr, wc, fr, fq); S.done(cur); }
        if (!has_next) break;
#pragma unroll
        for (int a = 0; a < 2; ++a)
#pragma unroll
            for (int b = 0; b < 2; ++b)
#pragma unroll
                for (int m = 0; m < 4; ++m)
#pragma unroll
                    for (int n = 0; n < 2; ++n) acc[a][b][m][n] = (f32x4){0.f, 0.f, 0.f, 0.f};
        cur = nxt; cA = nA; cB = nB; ++ui;
        if constexpr (ALIGN_EPI) { if (wr == 1) PG8_BAR; }
    }
    PG8_WAIT_V(0);
    if constexpr (!ALIGN_EPI) { if (wr == 0) PG8_BAR; }
    PG8_BAR;
    if constexpr (Epi::AFTER_DRAIN) { E.fused(acc, cur, wr, wc, fr, fq, lds, wid, lane); S.done(cur); }
#undef PG8_SA
#undef PG8_SB
#undef PG8_STAGE
#undef PG8_LDA
#undef PG8_LDB
#undef PG8_MMA
#undef PG8_WAIT_V
#undef PG8_WAIT_L
#undef PG8_BAR
#undef PG8_SCHED
}
}
constexpr int NWAVES = 8;
constexpr int BATCH = 4, SEQ = 8192, D = 2048, M = BATCH * SEQ, NIN = 4096, LW = 1024, CHUNK = 128, NCHUNK = SEQ / CHUNK;
constexpr int NEXP = 16384;
#ifndef MK_N_LAUNCHES
#define MK_N_LAUNCHES 1
#endif
constexpr int N_LAUNCHES = MK_N_LAUNCHES;
constexpr int PER_PHASE = 11;
constexpr size_t MiB = 1u << 20;
constexpr size_t WS_CTL = 48 * MiB, CTL_ZERO_BYTES = 5 * MiB;
constexpr size_t WS_ROWSS = WS_CTL + 512 * 1024;
constexpr size_t WS_WIN = 2 * MiB, WS_WOUT = 18 * MiB, WS_WQ = 26 * MiB, WS_LRUW = 34 * MiB, WS_WSB = 35 * MiB, WS_AGG = 49 * MiB;
constexpr size_t WS_U = 64 * MiB, WS_V = 128 * MiB, WS_XN = 192 * MiB  , WS_Z = 320 * MiB  ;
constexpr size_t WS_HB = 576 * MiB, WS_IDS = 704 * MiB, WS_GATES = 720 * MiB, WS_PAIRS = 736 * MiB, WS_HBT = 752 * MiB, WS_END = 884 * MiB;
constexpr size_t WS_USCALE = 40 * MiB, WS_VSCALE = 41 * MiB;
constexpr size_t WS_HSCALE = 44 * MiB, WS_CARRY = 45 * MiB;
constexpr size_t WS_H8 = WS_XN, WS_PART = WS_XN + 64 * MiB;
constexpr size_t WS_ASCALE = 42 * MiB, WS_KH = 43 * MiB;
constexpr size_t WS_IDW = WS_PAIRS, WS_AW = 880 * MiB;
constexpr size_t WS_ROWSS2 = WS_CTL + 640 * 1024;
constexpr size_t WS_Y = WS_Z;
constexpr int CW_BAR = 4096;
constexpr int CW_LRUF = 8192;
constexpr int RING_BYTES = 131072;
constexpr int LDSCTL_OFF = 143360, MISC_OFF = LDSCTL_OFF + 320;
constexpr int LDS_BYTES = 147456;
#define GAS __attribute__((address_space(1)))
#define LAS __attribute__((address_space(3)))
typedef unsigned short bf16;
typedef unsigned v4u __attribute__((ext_vector_type(4)));
typedef float f32x4 __attribute__((ext_vector_type(4)));
typedef short bf16x8 __attribute__((ext_vector_type(8)));
typedef GAS unsigned gu32;
typedef GAS unsigned long long gu64;
#define RLX_AGENT __ATOMIC_RELAXED, __HIP_MEMORY_SCOPE_AGENT
#define LDS_WAIT() asm volatile("s_waitcnt lgkmcnt(0)" ::: "memory")
#define VM_WAIT() asm volatile("s_waitcnt vmcnt(0)" ::: "memory")
__device__ __forceinline__ unsigned long long rt() { return __builtin_amdgcn_s_memrealtime(); }
__device__ __forceinline__ unsigned f2bf(float f) { unsigned u = __builtin_bit_cast(unsigned, f); return (u + 0x7fffu + ((u >> 16) & 1u)) >> 16; }
__device__ __forceinline__ unsigned pk2(float lo, float hi) { return f2bf(lo) | (f2bf(hi) << 16); }

#define XB_TMO      128
#define XB_XCNT(j)  (256  + 64 * (j))
#define XB_XSUB(j)  (1280 + 64 * (j))
#define XB_XGEN(j)  (2304 + 64 * (j))
#define XB_TOP      3328
#define XB_TOPGEN   3392
#define XCD_BAR_WORDS 3456
#define XB_SPIN_CAP (1u << 18)

__device__ __forceinline__ unsigned xb_ld(unsigned* p)              { return __hip_atomic_load(p, __ATOMIC_RELAXED, __HIP_MEMORY_SCOPE_AGENT); }
__device__ __forceinline__ unsigned xb_add(unsigned* p, unsigned v) { return __hip_atomic_fetch_add(p, v, __ATOMIC_RELAXED, __HIP_MEMORY_SCOPE_AGENT); }
__device__ __forceinline__ unsigned xb_xcc_id() { return (unsigned)__builtin_amdgcn_s_getreg((3 << 11) | 20) & 0xFu; }
#define XB_SPIN(cond, bar) do { unsigned _sp = 0; while (cond) { __builtin_amdgcn_s_sleep(1); \
    if ((++_sp & 255u) == 0u) { if (xb_ld(&(bar)[XB_TMO])) break; if (_sp > XB_SPIN_CAP) { atomicAdd(&(bar)[XB_TMO], 1u); break; } } } } while (0)

struct XcdBarrier {
    unsigned* bar; unsigned x;
    volatile LAS unsigned* st;
};

__device__ __forceinline__ XcdBarrier xcd_barrier_post(unsigned* bar, volatile LAS unsigned* st) {
    XcdBarrier b; b.bar = bar; b.x = xb_xcc_id(); b.st = st;
    if (threadIdx.x == 0) (void)xb_add(&bar[XB_XCNT(b.x)], 1u);
    return b;
}
__device__ __forceinline__ void xcd_barrier_complete(unsigned* bar, unsigned x, unsigned& nloc, unsigned& nx) {
    const unsigned G = gridDim.x * gridDim.y * gridDim.z;
    unsigned sum, cnt, mine, sp = 0u;
    for (;;) {
        sum = 0u; cnt = 0u; mine = 0u;
#pragma unroll
        for (unsigned j = 0; j < 16; ++j) { const unsigned c = xb_ld(&bar[XB_XCNT(j)]); sum += c; cnt += (c > 0u) ? 1u : 0u; mine = (j == x) ? c : mine; }
        if (sum == G) break;
        __builtin_amdgcn_s_sleep(1);
        if ((++sp & 255u) == 0u) { if (xb_ld(&bar[XB_TMO])) break; if (sp > XB_SPIN_CAP) { atomicAdd(&bar[XB_TMO], 1u); break; } }
    }
    nloc = mine > 0u ? mine : 1u; nx = cnt > 0u ? cnt : 1u;
}

__device__ __forceinline__ void xcd_barrier(const XcdBarrier& b) {
    asm volatile("s_waitcnt vmcnt(0)" ::: "memory");
    __syncthreads();
    if (threadIdx.x == 0) {
        unsigned* bar = b.bar;
        __builtin_amdgcn_s_waitcnt(0);
        unsigned nloc = b.st[0], nx = b.st[1];
        if (nloc == 0u) { xcd_barrier_complete(bar, b.x, nloc, nx); b.st[0] = nloc; b.st[1] = nx; }
        const unsigned old = xb_add(&bar[XB_XSUB(b.x)], 1u);
        const unsigned gen = old / nloc;
        if (old + 1u == (gen + 1u) * nloc) {
            __builtin_amdgcn_fence(__ATOMIC_RELEASE, "agent");
            asm volatile("s_waitcnt vmcnt(0)" ::: "memory");
            const unsigned og = xb_add(&bar[XB_TOP], 1u);
            const unsigned tg = og / nx;
            if (og + 1u == (tg + 1u) * nx) xb_add(&bar[XB_TOPGEN], 1u);
            else XB_SPIN(xb_ld(&bar[XB_TOPGEN]) == tg, bar);
            __builtin_amdgcn_fence(__ATOMIC_ACQUIRE, "agent");
            xb_add(&bar[XB_XGEN(b.x)], 1u);
            asm volatile("s_waitcnt vmcnt(0)" ::: "memory");
        } else {
            XB_SPIN(xb_ld(&bar[XB_XGEN(b.x)]) == gen, bar);
            __builtin_amdgcn_fence(__ATOMIC_ACQUIRE, "agent");
            asm volatile("s_waitcnt vmcnt(0)" ::: "memory");
        }
    }
    __syncthreads();
}
typedef unsigned v2u __attribute__((ext_vector_type(2)));
typedef float f32x2 __attribute__((ext_vector_type(2)));
struct Args { const float* in[21]; float* out; unsigned char* ws; int ph_lo, ph_hi; };
struct Frame {
    const Args& A;
    LAS unsigned char* lds;
    volatile LAS unsigned* MISC;
    gu32* ctl;
    unsigned char* ws;
    int tid, lane, wave, vcu, G;
    __device__ __forceinline__ Frame(const Args& a) : A(a) {}
#define WSP(name, type, off) __device__ __forceinline__ type* name() const { return (type*)(ws + (off)); }
    WSP(WIN, bf16, WS_WIN) WSP(WOUT, bf16, WS_WOUT) WSP(WQ, bf16, WS_WQ) WSP(LRUW, bf16, WS_LRUW) WSP(WSB, bf16, WS_WSB)
    WSP(XN, bf16, WS_XN) WSP(MIX, bf16, WS_XN) WSP(Z, bf16, WS_Z) WSP(HB, bf16, WS_HB) WSP(HBT, bf16, WS_HBT)
    WSP(U8, unsigned char, WS_U) WSP(V8T, unsigned char, WS_V)
    WSP(ROWSS, float, WS_ROWSS) WSP(ROWSS2, float, WS_ROWSS2) WSP(QH, bf16, WS_Z) WSP(QL, bf16, WS_Z + 128 * MiB) WSP(KH, bf16, WS_KH) WSP(KL, bf16, WS_KH + 512 * 1024) WSP(AGG, float, WS_AGG) WSP(CARRY, float, WS_CARRY) WSP(AU, unsigned, WS_HB) WSP(GATES, float, WS_GATES)
    WSP(USCALE, float, WS_USCALE) WSP(VSCALE, float, WS_VSCALE) WSP(Y, bf16, WS_Y) WSP(IDS, int, WS_IDS) WSP(ASCALE, float, WS_ASCALE) WSP(IDW, v4u, WS_IDW) WSP(AW, unsigned, WS_AW) WSP(H8, unsigned char, WS_H8) WSP(HSCALE, float, WS_HSCALE) WSP(PART, int, WS_PART)
#undef WSP
};
__device__ __forceinline__ float wave_sum(float v) {
#pragma unroll
    for (int o = 1; o < 64; o <<= 1) v += __shfl_xor(v, o);
    return v;
}
__device__ __forceinline__ float bf_lo(unsigned w) { return __builtin_bit_cast(float, w << 16); }
__device__ __forceinline__ float bf_hi(unsigned w) { return __builtin_bit_cast(float, w & 0xffff0000u); }
__device__ __forceinline__ float bf1(unsigned short h) { return __builtin_bit_cast(float, (unsigned)h << 16); }
__device__ __forceinline__ float sigmoidf_(float x) { return __builtin_amdgcn_rcpf(1.0f + __builtin_amdgcn_exp2f(-1.4426950409f * x)); }
using pg8::gelu_tanh;
__device__ __forceinline__ unsigned pack_i8x4(float a, float b, float c, float d) {
    const int ia = (int)__builtin_rintf(a), ib = (int)__builtin_rintf(b), ic = (int)__builtin_rintf(c), id = (int)__builtin_rintf(d);
    return (unsigned)(ia & 0xff) | ((unsigned)(ib & 0xff) << 8) | ((unsigned)(ic & 0xff) << 16) | ((unsigned)id << 24);
}

__device__ __forceinline__ void p0_transpose_item(const float* W, int K, int N, bf16* WT, const float* kscale, LAS float* scr, int item, int lane) {
    const int nblk = N / 32, kb = item / nblk, nb = item % nblk, k0 = 64 * kb, n0 = 32 * nb;
#pragma unroll 8
    for (int i = 0; i < 32; ++i) { const int kk = 2 * i + (lane >> 5); const float sc = kscale ? kscale[k0 + kk] : 1.0f; scr[kk * 33 + (lane & 31)] = W[(size_t)(k0 + kk) * N + n0 + (lane & 31)] * sc; }
    LDS_WAIT(); asm volatile("" ::: "memory");
    const int c = lane & 7;
#pragma unroll
    for (int j = 0; j < 4; ++j) { const int n = (lane >> 3) + 8 * j; const LAS float* s = scr + (8 * c) * 33 + n;
        v4u o; o.x = pk2(s[0 * 33], s[1 * 33]); o.y = pk2(s[2 * 33], s[3 * 33]); o.z = pk2(s[4 * 33], s[5 * 33]); o.w = pk2(s[6 * 33], s[7 * 33]);
        *(GAS v4u*)(WT + (size_t)(n0 + n) * K + k0 + 8 * c) = o; }
    LDS_WAIT(); asm volatile("" ::: "memory");
}
__device__ __forceinline__ void p0_prologue(Frame& F) {
    LAS float* scr = (LAS float*)(F.lds + F.wave * 16384);
    const int gw = F.vcu * NWAVES + F.wave, NGW = F.G * NWAVES, lane = F.lane;
    constexpr int I_IN = (D / 64) * (NIN / 32), I_OUT = (D / 64) * (D / 32), I_Q = I_OUT, I_LRU = 32 * 8;
    constexpr int NITEMS = I_IN + I_OUT + I_Q + I_LRU;
    for (int it = gw; it < NITEMS; it += NGW) {
        int r = it;
        if (r < I_IN) { p0_transpose_item(F.A.in[2], D, NIN, F.WIN(), F.A.in[1], scr, r, lane); continue; } r -= I_IN;
        if (r < I_OUT) { p0_transpose_item(F.A.in[14], D, D, F.WOUT(), nullptr, scr, r, lane); continue; } r -= I_OUT;
        if (r < I_Q) { p0_transpose_item(F.A.in[16], D, D, F.WQ(), F.A.in[15], scr, r, lane); continue; } r -= I_Q;
        { const int mi = r >> 3, sub = r & 7, gate = mi >> 4, rest = mi & 15;
          const float* src = (gate ? F.A.in[7] : F.A.in[5]) + (size_t)rest * 16384;
          p0_transpose_item(src, 128, 128, F.LRUW() + (size_t)mi * 16384, nullptr, scr, sub, lane); }
    }
    const size_t gt = (size_t)gw * 64 + lane, NGT = (size_t)NGW * 64;
    {
        const float* g2 = F.A.in[15];
        f32x4 gg[8];
#pragma unroll
        for (int j = 0; j < 8; ++j) gg[j] = *(const GAS f32x4*)(g2 + j * 256 + lane * 4);
        for (int e = gw; e < NEXP; e += NGW) {
            const GAS f32x4* ur = (const GAS f32x4*)(F.A.in[18] + (size_t)e * D) + lane;
            f32x4 v[8]; float ss = 0.f;
#pragma unroll
            for (int j = 0; j < 8; ++j) { v[j] = __builtin_nontemporal_load(ur + 64 * j) * gg[j]; ss += (v[j].x * v[j].x + v[j].y * v[j].y) + (v[j].z * v[j].z + v[j].w * v[j].w); }
            const float rms = __builtin_amdgcn_sqrtf(wave_sum(ss) * (1.0f / D));
            const float sc = rms > 0.f ? 7.0f / (2.8f * rms) : 1.0f;
            GAS unsigned* o4 = (GAS unsigned*)(F.U8() + (size_t)e * 1024) + (lane >> 1);
#pragma unroll
            for (int j = 0; j < 8; ++j) {
                const int c0 = (int)fminf(fmaxf(__builtin_rintf(v[j].x * sc), -7.f), 7.f) & 15, c1 = (int)fminf(fmaxf(__builtin_rintf(v[j].y * sc), -7.f), 7.f) & 15;
                const int c2 = (int)fminf(fmaxf(__builtin_rintf(v[j].z * sc), -7.f), 7.f) & 15, c3 = (int)fminf(fmaxf(__builtin_rintf(v[j].w * sc), -7.f), 7.f) & 15;
                const unsigned cw = (unsigned)c0 | ((unsigned)c1 << 8) | ((unsigned)c2 << 16) | ((unsigned)c3 << 24);
                const unsigned pw = (unsigned)__shfl_xor((int)cw, 1);
                if ((lane & 1) == 0) __builtin_nontemporal_store(cw | (pw << 4), o4 + 32 * j);
            }
            if (lane == 0) F.USCALE()[e] = rms > 0.f ? 2.8f * rms * (1.0f / 7.0f) : 1.0f;
        }
    }
    __syncthreads();
    for (int un = blockIdx.x; un < NEXP / 64; un += F.G) {
        const int e0 = un * 64;
        for (int rr = 0; rr < 8; ++rr) {
            const int el = F.wave * 8 + rr, e = e0 + el;
            const GAS f32x4* vr = (const GAS f32x4*)(F.A.in[19] + (size_t)e * D) + lane;
            f32x4 v[8]; float mx = 0.f;
#pragma unroll
            for (int j = 0; j < 8; ++j) { v[j] = __builtin_nontemporal_load(vr + 64 * j); mx = fmaxf(mx, fmaxf(fmaxf(fabsf(v[j].x), fabsf(v[j].y)), fmaxf(fabsf(v[j].z), fabsf(v[j].w)))); }
#pragma unroll
            for (int o = 1; o < 64; o <<= 1) mx = fmaxf(mx, __shfl_xor(mx, o));
            const float sc = mx > 0.f ? 127.0f / mx : 1.0f;
#pragma unroll
            for (int j = 0; j < 8; ++j) *(LAS unsigned*)(F.lds + el * 2056 + j * 256 + lane * 4) = pack_i8x4(v[j].x * sc, v[j].y * sc, v[j].z * sc, v[j].w * sc);
            if (lane == 0) F.VSCALE()[e] = mx > 0.f ? mx * (1.0f / 127.0f) : 1.0f;
        }
        __syncthreads();
        for (int cc = 0; cc < 32; ++cc) { const int c = F.wave * 32 + cc;
            const v2u w = *(const LAS v2u*)(F.lds + lane * 2056 + c * 8);
            __builtin_nontemporal_store(w, (v2u*)(F.V8T() + ((size_t)c * NEXP + e0 + lane) * 8)); }
        __syncthreads();
    }
    for (size_t ch = gt; ch < (size_t)8 * 128 * 128 / 8; ch += NGT) {
        const size_t e0 = ch * 8;
        const f32x4 a = *(const GAS f32x4*)(F.A.in[12] + e0), b = *(const GAS f32x4*)(F.A.in[12] + e0 + 4);
        v4u o; o.x = pk2(a.x, a.y); o.y = pk2(a.z, a.w); o.z = pk2(b.x, b.y); o.w = pk2(b.z, b.w);
        *(GAS v4u*)(F.WSB() + e0) = o;
    }
    for (size_t ch = gt; ch < (size_t)16 * 128 * 128 / 8; ch += NGT) {
        const size_t e0 = ch * 8;
        const f32x4 a = *(const GAS f32x4*)(F.A.in[17] + e0), b = *(const GAS f32x4*)(F.A.in[17] + e0 + 4);
        v4u hi; hi.x = pk2(a.x, a.y); hi.y = pk2(a.z, a.w); hi.z = pk2(b.x, b.y); hi.w = pk2(b.z, b.w);
        *(GAS v4u*)(F.KH() + e0) = hi;
    }
    for (int m = gw; m < M; m += NGW) {
        const GAS f32x4* xr = (const GAS f32x4*)(F.A.in[0] + (size_t)m * D) + lane;
        f32x4 v[8]; float s = 0.f;
#pragma unroll
        for (int j = 0; j < 8; ++j) { v[j] = __builtin_nontemporal_load(xr + 64 * j); s += (v[j].x * v[j].x + v[j].y * v[j].y) + (v[j].z * v[j].z + v[j].w * v[j].w); }
        const float rstd = __builtin_amdgcn_rsqf(wave_sum(s) * (1.f / D) + 1e-6f);
        GAS unsigned long long* o8 = (GAS unsigned long long*)(F.XN() + (size_t)m * D) + lane;
#pragma unroll
        for (int j = 0; j < 8; ++j) o8[64 * j] = (unsigned long long)pk2(v[j].x * rstd, v[j].y * rstd) | ((unsigned long long)pk2(v[j].z * rstd, v[j].w * rstd) << 32);
    }
}
constexpr int LRU_XR = 0, LRU_XC = 33792, LRU_GR = 33792 + 40960;
constexpr float LOG2E = 1.4426950408889634f;
__device__ __forceinline__ int xc_off(int tok, int ch) { return tok * 320 + (tok >> 5) * 16 + ch * 2; }
template <bool APPLY, int DIR>
__device__ __forceinline__ void lru_dir(Frame& F, int unit, int b, int c, int h, const bf16x8 (&Ba)[4], const bf16x8 (&Bx)[4], float (&hsum)[8][4]) {
    const int lane = F.lane, w = F.wave, fr = lane & 15, fq = lane >> 4;
    LAS unsigned char* XC = F.lds + LRU_XC;
    const int chl = 16 * w + fr, chg = h * 128 + chl;
    v4u* au = (v4u*)F.AU() + ((size_t)((unit * 2 + DIR) * NWAVES + w) * 8) * 64 + lane;
    f32x4 R[8], I[8];
    float carry = 0.f;
    if (APPLY) {
        carry = F.CARRY()[(size_t)((b * 2 + DIR) * NCHUNK + c) * LW + chg];
        v4u q[8];
#pragma unroll
        for (int m = 0; m < 8; ++m) q[m] = __builtin_nontemporal_load(au + m * 64);
#pragma unroll
        for (int m = 0; m < 8; ++m) {
            R[m] = (f32x4){__builtin_amdgcn_exp2f(bf_lo(q[m].x)), __builtin_amdgcn_exp2f(bf_lo(q[m].y)), __builtin_amdgcn_exp2f(bf_lo(q[m].z)), __builtin_amdgcn_exp2f(bf_lo(q[m].w))};
            I[m] = (f32x4){bf_hi(q[m].x), bf_hi(q[m].y), bf_hi(q[m].z), bf_hi(q[m].w)}; }
    } else {
        const float ba = F.A.in[6][DIR * LW + chg], bx = F.A.in[8][DIR * LW + chg], lam = F.A.in[9][DIR * LW + chg];
        const float cl = -8.0f * log1pf(__expf(-lam)) * LOG2E;
        const int arow = (fr >> 2) * 32 + (fr & 3);
#pragma unroll
        for (int m = 0; m < 8; ++m) {
            R[m] = (f32x4){0.f, 0.f, 0.f, 0.f}; I[m] = (f32x4){0.f, 0.f, 0.f, 0.f};
#pragma unroll
            for (int ks = 0; ks < 4; ++ks) {
                const bf16x8 a = *(const LAS bf16x8*)(XC + xc_off(arow + 4 * m, 32 * ks + 8 * fq));
                R[m] = __builtin_amdgcn_mfma_f32_16x16x32_bf16(a, Ba[ks], R[m], 0, 0, 0);
                I[m] = __builtin_amdgcn_mfma_f32_16x16x32_bf16(a, Bx[ks], I[m], 0, 0, 0);
            }
        }
#pragma unroll
        for (int m = 0; m < 8; ++m) {
            float la[4];
#pragma unroll
            for (int j = 0; j < 4; ++j) {
                const float r = sigmoidf_(R[m][j] + ba), ig = sigmoidf_(I[m][j] + bx);
                la[j] = cl * r;
                const float a = __builtin_amdgcn_exp2f(la[j]);
                const float xc = bf1(*(const LAS unsigned short*)(XC + xc_off(32 * fq + 4 * m + j, chl)));
                R[m][j] = a; I[m][j] = __builtin_amdgcn_sqrtf(fmaxf(1.0f - a * a, 0.0f)) * (ig * xc);
            }
            __builtin_nontemporal_store((v4u){pk2(la[0], I[m][0]), pk2(la[1], I[m][1]), pk2(la[2], I[m][2]), pk2(la[3], I[m][3])}, au + m * 64);
        }
    }
    float P = 1.f, L = 0.f;
#pragma unroll
    for (int mm = 0; mm < 8; ++mm) {
        const int m = DIR == 0 ? mm : 7 - mm;
#pragma unroll
        for (int jj = 0; jj < 4; ++jj) {
            const int j = DIR == 0 ? jj : 3 - jj;
            const float a = R[m][j], u = I[m][j];
            L = a * L + u; P = a * P;
            R[m][j] = P; I[m][j] = L;
        }
    }
    const int src1 = DIR == 0 ? lane - 16 : lane + 16, src2 = DIR == 0 ? lane - 32 : lane + 32;
    const bool v1 = DIR == 0 ? (fq >= 1) : (fq <= 2), v2 = DIR == 0 ? (fq >= 2) : (fq <= 1);
    float A = P, B = L;
    { const float pa = __shfl(A, src1), pb = __shfl(B, src1); if (v1) { B = A * pb + B; A = A * pa; } }
    { const float pa = __shfl(A, src2), pb = __shfl(B, src2); if (v2) { B = A * pb + B; A = A * pa; } }
    if (APPLY) {
        float EA = __shfl(A, src1), EB = __shfl(B, src1); if (!v1) { EA = 1.f; EB = 0.f; }
        const float hin = EA * carry + EB;
#pragma unroll
        for (int m = 0; m < 8; ++m)
#pragma unroll
            for (int j = 0; j < 4; ++j) { const float hh = R[m][j] * hin + I[m][j]; if (DIR == 0) hsum[m][j] = hh; else hsum[m][j] += hh; }
    } else {
        const bool lastlane = DIR == 0 ? (fq == 3) : (fq == 0);
        if (lastlane) { f32x2* agg = (f32x2*)F.AGG() + (size_t)((b * 2 + DIR) * NCHUNK + c) * LW + chg; *agg = (f32x2){A, B}; }
    }
}

template <bool APPLY>
__device__ __forceinline__ void lru_unit(Frame& F, int unit) {
    const int h = unit & 7, c = (unit >> 3) & 63, b = unit >> 9;
    const int tid = F.tid, lane = F.lane, w = F.wave, fr = lane & 15, fq = lane >> 4;
    const size_t t0 = (size_t)b * SEQ + (size_t)c * CHUNK;
    LAS unsigned char* XR = F.lds + LRU_XR; LAS unsigned char* XC = F.lds + LRU_XC; LAS unsigned char* GR = F.lds + LRU_GR;
    bf16x8 Ba0[4], Bx0[4], Ba1[4], Bx1[4];
    if (!APPLY) {
        const bf16* wb = F.LRUW() + (size_t)h * 16384 + (size_t)(16 * w + fr) * 128 + 8 * fq;
#pragma unroll
        for (int ks = 0; ks < 4; ++ks) { Ba0[ks] = *(const GAS bf16x8*)(wb + 32 * ks); Ba1[ks] = *(const GAS bf16x8*)(wb + (size_t)8 * 16384 + 32 * ks);
            Bx0[ks] = *(const GAS bf16x8*)(wb + (size_t)16 * 16384 + 32 * ks); Bx1[ks] = *(const GAS bf16x8*)(wb + (size_t)24 * 16384 + 32 * ks); }
        for (int p = tid; p < 131 * 16; p += 512) { const int r = p >> 4, cg = p & 15; const int s = c * CHUNK - 2 + r; v4u v = (v4u){0u, 0u, 0u, 0u};
            if (s >= 0 && s < SEQ) v = *(const GAS v4u*)(F.Z() + ((size_t)b * SEQ + s) * NIN + h * 128 + cg * 8);
            *(LAS v4u*)(XR + r * 256 + cg * 16) = v; }
        __syncthreads();
        {
            const int ch2 = tid & 63, tg = tid >> 6, chg = h * 128 + 2 * ch2;
            float w0[4], w1[4];
#pragma unroll
            for (int k = 0; k < 4; ++k) { w0[k] = F.A.in[3][k * LW + chg]; w1[k] = F.A.in[3][k * LW + chg + 1]; }
            const float b0 = F.A.in[4][chg], b1 = F.A.in[4][chg + 1];
            float x0[4], x1[4];
#pragma unroll
            for (int k = 0; k < 3; ++k) { const unsigned u = *(const LAS unsigned*)(XR + (16 * tg + k) * 256 + ch2 * 4); x0[k] = bf_lo(u); x1[k] = bf_hi(u); }
#pragma unroll
            for (int j = 0; j < 16; ++j) {
                const unsigned u = *(const LAS unsigned*)(XR + (16 * tg + j + 3) * 256 + ch2 * 4); x0[3] = bf_lo(u); x1[3] = bf_hi(u);
                const float y0 = b0 + ((w0[0] * x0[0] + w0[1] * x0[1]) + (w0[2] * x0[2] + w0[3] * x0[3]));
                const float y1 = b1 + ((w1[0] * x1[0] + w1[1] * x1[1]) + (w1[2] * x1[2] + w1[3] * x1[3]));
                *(LAS unsigned*)(XC + xc_off(16 * tg + j, 2 * ch2)) = pk2(y0, y1);
                x0[0] = x0[1]; x0[1] = x0[2]; x0[2] = x0[3]; x1[0] = x1[1]; x1[1] = x1[2]; x1[2] = x1[3];
            }
        }
        __syncthreads();
    } else {
#pragma unroll
        for (int ks = 0; ks < 4; ++ks) { Ba0[ks] = Ba1[ks] = Bx0[ks] = Bx1[ks] = (bf16x8){0, 0, 0, 0, 0, 0, 0, 0}; }
        for (int p = tid; p < 128 * 32; p += 512) { const int r = p >> 5, cg = p & 31;
            *(LAS v2u*)(GR + r * 264 + cg * 8) = *(const GAS v2u*)(F.Z() + (t0 + r) * NIN + LW + h * 128 + cg * 4); }
    }
    float hsum[8][4];
    lru_dir<APPLY, 0>(F, unit, b, c, h, Ba0, Bx0, hsum);
    asm volatile("" ::: "memory"); __builtin_amdgcn_sched_barrier(0);
    lru_dir<APPLY, 1>(F, unit, b, c, h, Ba1, Bx1, hsum);
    if (APPLY) {
        const int chl = 16 * w + fr;
        __syncthreads();
#pragma unroll
        for (int m = 0; m < 8; ++m)
#pragma unroll
            for (int j = 0; j < 4; ++j) { LAS unsigned short* p = (LAS unsigned short*)(GR + (32 * fq + 4 * m + j) * 264 + chl * 2); *p = (unsigned short)f2bf(bf1(*p) * hsum[m][j]); }
        __syncthreads();
        for (int p = tid; p < 128 * 32; p += 512) { const int r = p >> 5, cg = p & 31;
            *(GAS v2u*)(F.MIX() + (t0 + r) * D + h * 128 + cg * 4) = *(const LAS v2u*)(GR + r * 264 + cg * 8); }
    }
    __syncthreads();
}

constexpr int LRU_PT = LRU_GR + 33792, LRU_CR = LRU_PT + 8192;
template <int DIR>
__device__ __forceinline__ void lru_scan_dir(Frame& F, int b, int c, int h, const bf16x8 (&Ba)[4], const bf16x8 (&Bx)[4], f32x4 (&R)[8], f32x4 (&I)[8], float& EA, float& EB) {
    const int lane = F.lane, w = F.wave, fr = lane & 15, fq = lane >> 4;
    LAS unsigned char* XC = F.lds + LRU_XC;
    const int chl = 16 * w + fr, chg = h * 128 + chl;
    {
        const float ba = F.A.in[6][DIR * LW + chg], bx = F.A.in[8][DIR * LW + chg], lam = F.A.in[9][DIR * LW + chg];
        const float cl = -8.0f * log1pf(__expf(-lam)) * LOG2E;
        const int arow = (fr >> 2) * 32 + (fr & 3);
#define LRU_MMA(m_) do { R[m_] = (f32x4){0.f, 0.f, 0.f, 0.f}; I[m_] = (f32x4){0.f, 0.f, 0.f, 0.f}; \
            _Pragma("unroll") for (int ks = 0; ks < 4; ++ks) { const bf16x8 a = *(const LAS bf16x8*)(XC + xc_off(arow + 4 * (m_), 32 * ks + 8 * fq)); \
                R[m_] = __builtin_amdgcn_mfma_f32_16x16x32_bf16(a, Ba[ks], R[m_], 0, 0, 0); I[m_] = __builtin_amdgcn_mfma_f32_16x16x32_bf16(a, Bx[ks], I[m_], 0, 0, 0); } } while (0)
        LRU_MMA(0);
#pragma unroll
        for (int m = 0; m < 8; ++m) {
            if (m + 1 < 8) LRU_MMA(m + 1);
#pragma unroll
            for (int j = 0; j < 4; ++j) {
                const float r = sigmoidf_(R[m][j] + ba), ig = sigmoidf_(I[m][j] + bx);
                const float a = __builtin_amdgcn_exp2f(cl * r);
                const float xc = bf1(*(const LAS unsigned short*)(XC + xc_off(32 * fq + 4 * m + j, chl)));
                R[m][j] = a; I[m][j] = __builtin_amdgcn_sqrtf(fmaxf(1.0f - a * a, 0.0f)) * (ig * xc);
            }
            __builtin_amdgcn_sched_barrier(0);
        }
#undef LRU_MMA
    }
    float P = 1.f, L = 0.f;
#pragma unroll
    for (int mm = 0; mm < 8; ++mm) {
        const int m = DIR == 0 ? mm : 7 - mm;
#pragma unroll
        for (int jj = 0; jj < 4; ++jj) {
            const int j = DIR == 0 ? jj : 3 - jj;
            const float a = R[m][j], u = I[m][j];
            L = a * L + u; P = a * P;
            R[m][j] = P; I[m][j] = L;
        }
    }
    const int src1 = DIR == 0 ? lane - 16 : lane + 16, src2 = DIR == 0 ? lane - 32 : lane + 32;
    const bool v1 = DIR == 0 ? (fq >= 1) : (fq <= 2), v2 = DIR == 0 ? (fq >= 2) : (fq <= 1);
    float A = P, B = L;
    { const float pa = __shfl(A, src1), pb = __shfl(B, src1); if (v1) { B = A * pb + B; A = A * pa; } }
    { const float pa = __shfl(A, src2), pb = __shfl(B, src2); if (v2) { B = A * pb + B; A = A * pa; } }
    EA = __shfl(A, src1); EB = __shfl(B, src1); if (!v1) { EA = 1.f; EB = 0.f; }
    const bool lastlane = DIR == 0 ? (fq == 3) : (fq == 0);
    if (lastlane) {
        const unsigned long long word = (unsigned long long)(__builtin_bit_cast(unsigned, A) | 1u) | ((unsigned long long)__builtin_bit_cast(unsigned, B) << 32);
        __hip_atomic_store((unsigned long long*)F.AGG() + (size_t)((b * 2 + DIR) * NCHUNK + c) * LW + chg, word, RLX_AGENT);
    }
}
__device__ __forceinline__ void lru_decode(int unit, int& b, int& c, int& h) { const int rnd = unit >> 8, within = unit & 255; b = rnd >> 1; h = (rnd & 1) * 4 + (within & 3); c = within >> 2; }
__device__ __forceinline__ void lru_prefetch(Frame& F, int unit, int tid, v4u (&xr)[5]) {
    int b, c, h; lru_decode(unit, b, c, h);
#pragma unroll
    for (int i = 0; i < 5; ++i) { const int p = tid + 512 * i, r = p >> 4, cg = p & 15; const int s = c * CHUNK - 2 + r; xr[i] = (v4u){0u, 0u, 0u, 0u};
        if (p < 131 * 16 && s >= 0 && s < SEQ) xr[i] = *(const GAS v4u*)(F.Z() + ((size_t)b * SEQ + s) * NIN + h * 128 + cg * 8); }
}
__device__ __forceinline__ void lru_conv(Frame& F, int unit, int tid, const v4u (&xr)[5]) {
    int b, c, h; lru_decode(unit, b, c, h);
    LAS unsigned char* XR = F.lds + LRU_XR; LAS unsigned char* XC = F.lds + LRU_XC;
#pragma unroll
    for (int i = 0; i < 5; ++i) { const int p = tid + 512 * i, r = p >> 4, cg = p & 15; if (p < 131 * 16) *(LAS v4u*)(XR + r * 256 + cg * 16) = xr[i]; }
    __syncthreads();
    const int ch2 = tid & 63, tg = tid >> 6, chg = h * 128 + 2 * ch2;
    float w0[4], w1[4];
#pragma unroll
    for (int k = 0; k < 4; ++k) { w0[k] = F.A.in[3][k * LW + chg]; w1[k] = F.A.in[3][k * LW + chg + 1]; }
    const float b0 = F.A.in[4][chg], b1 = F.A.in[4][chg + 1];
    float x0[4], x1[4];
#pragma unroll
    for (int k = 0; k < 3; ++k) { const unsigned u = *(const LAS unsigned*)(XR + (16 * tg + k) * 256 + ch2 * 4); x0[k] = bf_lo(u); x1[k] = bf_hi(u); }
#pragma unroll
    for (int j = 0; j < 16; ++j) {
        const unsigned u = *(const LAS unsigned*)(XR + (16 * tg + j + 3) * 256 + ch2 * 4); x0[3] = bf_lo(u); x1[3] = bf_hi(u);
        const float y0 = b0 + ((w0[0] * x0[0] + w0[1] * x0[1]) + (w0[2] * x0[2] + w0[3] * x0[3]));
        const float y1 = b1 + ((w1[0] * x1[0] + w1[1] * x1[1]) + (w1[2] * x1[2] + w1[3] * x1[3]));
        *(LAS unsigned*)(XC + xc_off(16 * tg + j, 2 * ch2)) = pk2(y0, y1);
        x0[0] = x0[1]; x0[1] = x0[2]; x0[2] = x0[3]; x1[0] = x1[1]; x1[1] = x1[2]; x1[2] = x1[3];
    }
}
__device__ __forceinline__ void lru_fused_unit(Frame& F, int unit, int next, v4u (&xr)[5]) {
    int b, c, h; lru_decode(unit, b, c, h);
    int tid = F.tid; asm volatile("" : "+v"(tid));
    const int lane = tid & 63, w = F.wave, fr = lane & 15, fq = lane >> 4;
    const size_t t0 = (size_t)b * SEQ + (size_t)c * CHUNK;
    LAS unsigned char* GR = F.lds + LRU_GR;
    bf16x8 Ba0[4], Bx0[4], Ba1[4], Bx1[4];
    {
        const bf16* wb = F.LRUW() + (size_t)h * 16384 + (size_t)(16 * w + fr) * 128 + 8 * fq;
#pragma unroll
        for (int ks = 0; ks < 4; ++ks) { Ba0[ks] = *(const GAS bf16x8*)(wb + 32 * ks); Ba1[ks] = *(const GAS bf16x8*)(wb + (size_t)8 * 16384 + 32 * ks);
            Bx0[ks] = *(const GAS bf16x8*)(wb + (size_t)16 * 16384 + 32 * ks); Bx1[ks] = *(const GAS bf16x8*)(wb + (size_t)24 * 16384 + 32 * ks); }
    }
    f32x4 R0[8], I0[8], R1[8], I1[8]; float EA0, EB0, EA1, EB1;
    lru_scan_dir<0>(F, b, c, h, Ba0, Bx0, R0, I0, EA0, EB0);
    asm volatile("" ::: "memory"); __builtin_amdgcn_sched_barrier(0);
    if (next >= 0) lru_prefetch(F, next, tid, xr);
    lru_scan_dir<1>(F, b, c, h, Ba1, Bx1, R1, I1, EA1, EB1);
    {
        v2u gr[8];
#pragma unroll
        for (int i = 0; i < 8; ++i) { const int p = tid + 512 * i, r = p >> 5, cg = p & 31; gr[i] = *(const GAS v2u*)(F.Z() + (t0 + r) * NIN + LW + h * 128 + cg * 4); }
        if (next >= 0) lru_conv(F, next, tid, xr); else __syncthreads();
#pragma unroll
        for (int i = 0; i < 8; ++i) { const int p = tid + 512 * i, r = p >> 5, cg = p & 31; *(LAS v2u*)(GR + r * 264 + cg * 8) = gr[i]; }
    }
    {
        const int ch = tid & 127, kq = tid >> 7;
        const unsigned long long* ab = (const unsigned long long*)F.AGG() + (size_t)b * 2 * NCHUNK * LW + h * 128 + ch;
        unsigned long long v[16];
#pragma unroll
        for (int i = 0; i < 16; ++i) { const int k = min(16 * kq + i, 62); const int row = k < c ? k : NCHUNK + k + 1;
            v[i] = __hip_atomic_load(ab + (size_t)row * LW, RLX_AGENT); }
        for (unsigned sp = 0; sp < (1u << 16); ++sp) {
            bool bad = false;
#pragma unroll
            for (int i = 0; i < 16; ++i) if (v[i] == 0ull) { const int k = min(16 * kq + i, 62); const int row = k < c ? k : NCHUNK + k + 1;
                v[i] = __hip_atomic_load(ab + (size_t)row * LW, RLX_AGENT); bad = bad || (v[i] == 0ull); }
            if (!bad) break;
            __builtin_amdgcn_s_sleep(2);
        }
        float fa = 1.f, fb = 0.f, ga = 1.f, gb = 0.f;
#pragma unroll
        for (int i = 0; i < 16; ++i) { const int k = 16 * kq + i; const float A = __builtin_bit_cast(float, (unsigned)v[i]), B = __builtin_bit_cast(float, (unsigned)(v[i] >> 32));
            if (k < c) { fb = A * fb + B; fa = A * fa; } }
#pragma unroll
        for (int i = 15; i >= 0; --i) { const int k = 16 * kq + i; const float A = __builtin_bit_cast(float, (unsigned)v[i]), B = __builtin_bit_cast(float, (unsigned)(v[i] >> 32));
            if (k >= c && k < 63) { gb = A * gb + B; ga = A * ga; } }
        *(LAS f32x4*)(F.lds + LRU_PT + (kq * 128 + ch) * 16) = (f32x4){fa, fb, ga, gb};
    }
    __syncthreads();
    if (tid < 256) {
        const int dir = tid >> 7, ch = tid & 127;
        f32x4 q[4];
#pragma unroll
        for (int k = 0; k < 4; ++k) q[k] = *(const LAS f32x4*)(F.lds + LRU_PT + (k * 128 + ch) * 16);
        float st = 0.f;
        if (dir == 0) { st = q[0].y; st = q[1].x * st + q[1].y; st = q[2].x * st + q[2].y; st = q[3].x * st + q[3].y; }
        else { st = q[3].w; st = q[2].z * st + q[2].w; st = q[1].z * st + q[1].w; st = q[0].z * st + q[0].w; }
        *(LAS float*)(F.lds + LRU_CR + tid * 4) = st;
    }
    __syncthreads();
    {
        const int chl = 16 * w + fr;
        const float hin0 = EA0 * *(const LAS float*)(F.lds + LRU_CR + chl * 4) + EB0, hin1 = EA1 * *(const LAS float*)(F.lds + LRU_CR + 512 + chl * 4) + EB1;
#pragma unroll
        for (int m = 0; m < 8; ++m)
#pragma unroll
            for (int j = 0; j < 4; ++j) { const float hs = (R0[m][j] * hin0 + I0[m][j]) + (R1[m][j] * hin1 + I1[m][j]);
                LAS unsigned short* p = (LAS unsigned short*)(GR + (32 * fq + 4 * m + j) * 264 + chl * 2); *p = (unsigned short)f2bf(bf1(*p) * hs); }
        __syncthreads();
        for (int p = tid; p < 128 * 32; p += 512) { const int r = p >> 5, cg = p & 31;
            *(GAS v2u*)(F.MIX() + (t0 + r) * D + h * 128 + cg * 4) = *(const LAS v2u*)(GR + r * 264 + cg * 8); }
    }
    __syncthreads();
}
__device__ __forceinline__ void lru_carry(Frame& F) {
    const int idx = (F.vcu * NWAVES + F.wave) * 64 + F.lane;
    if (idx >= BATCH * 2 * LW) return;
    const int ch = idx & (LW - 1), bd = idx >> 10, dir = bd & 1;
    const f32x2* agg = (const f32x2*)F.AGG() + (size_t)bd * NCHUNK * LW + ch; float* cr = F.CARRY() + (size_t)bd * NCHUNK * LW + ch;
    float st = 0.f;
#pragma unroll 8
    for (int i = 0; i < NCHUNK; ++i) { const int cc = dir == 0 ? i : NCHUNK - 1 - i; const f32x2 pe = agg[(size_t)cc * LW]; cr[(size_t)cc * LW] = st; st = pe.x * st + pe.y; }
}
constexpr int GM_ST = 0, GM_BS = 1024, GM_VN = 2048, GM_GU = 2048 + 32768;
typedef short s16x4 __attribute__((ext_vector_type(4)));
__device__ __forceinline__ unsigned vn_off(unsigned row, unsigned ch) { return 256u * row + 16u * (ch ^ (((row & 3u) << 2) | ((row >> 2) & 3u))); }
struct GmlpRegs { v4u a[4]; v2u gu[8]; bf16x8 Af[4]; f32x4 g0, g1, b0, b1; float bs; };
__device__ __forceinline__ void gmlp_load(Frame& F, size_t t0, int h, int tid, GmlpRegs& G) {
    const int lane = tid & 63, w = tid >> 6, fr = lane & 15, fq = lane >> 4;
#pragma unroll
    for (int i = 0; i < 4; ++i) { const int pid = tid + 512 * i, q = pid >> 4, cg = pid & 15; G.a[i] = *(const GAS v4u*)(F.Z() + (t0 + q) * NIN + 3 * LW + h * 128 + cg * 8); }
#pragma unroll
    for (int i = 0; i < 8; ++i) { const int pid = tid + 512 * i, r = pid >> 5, cg = pid & 31; G.gu[i] = *(const GAS v2u*)(F.Z() + (t0 + r) * NIN + 2 * LW + h * 128 + cg * 4); }
    { const int cg = tid & 15;
      G.g0 = *(const GAS f32x4*)(F.A.in[10] + h * 128 + cg * 8); G.g1 = *(const GAS f32x4*)(F.A.in[10] + h * 128 + cg * 8 + 4);
      G.b0 = *(const GAS f32x4*)(F.A.in[11] + h * 128 + cg * 8); G.b1 = *(const GAS f32x4*)(F.A.in[11] + h * 128 + cg * 8 + 4); }
    G.bs = F.A.in[13][h * 128 + (tid & 127)];
    const bf16* wsb = F.WSB() + (size_t)h * 16384 + (size_t)(16 * w + fr) * 128 + 8 * fq;
#pragma unroll
    for (int ks = 0; ks < 4; ++ks) G.Af[ks] = *(const GAS bf16x8*)(wsb + 32 * ks);
}
__device__ __forceinline__ void gmlp_unit(Frame& F, int unit) {
    int tid = F.tid; asm volatile("" : "+v"(tid));
    const int lane = tid & 63, w = F.wave, fr = lane & 15, fq = lane >> 4;
    const size_t t0 = (size_t)unit * CHUNK;
    LAS float* ST = (LAS float*)(F.lds + GM_ST); LAS float* BS = (LAS float*)(F.lds + GM_BS);
    LAS unsigned char* VN = F.lds + GM_VN; LAS unsigned char* GU = F.lds + GM_GU;
    GmlpRegs G;
    gmlp_load(F, t0, 0, tid, G);
#pragma unroll
    for (int rb = 0; rb < 2; ++rb) {
        v4u ra[8], rc[8];
#pragma unroll
        for (int rr = 0; rr < 8; ++rr) { const bf16* p = F.Z() + (t0 + 16 * w + 8 * rb + rr) * NIN + 3 * LW + lane * 8; ra[rr] = *(const GAS v4u*)p; rc[rr] = *(const GAS v4u*)(p + 512); }
#pragma unroll
        for (int rr = 0; rr < 8; ++rr) {
            const int row = 16 * w + 8 * rb + rr;
            const v4u a = ra[rr], b = rc[rr];
            float x[16] = {bf_lo(a.x), bf_hi(a.x), bf_lo(a.y), bf_hi(a.y), bf_lo(a.z), bf_hi(a.z), bf_lo(a.w), bf_hi(a.w),
                           bf_lo(b.x), bf_hi(b.x), bf_lo(b.y), bf_hi(b.y), bf_lo(b.z), bf_hi(b.z), bf_lo(b.w), bf_hi(b.w)};
            float s = 0.f;
#pragma unroll
            for (int i = 0; i < 16; ++i) s += x[i];
            const float mean = wave_sum(s) * (1.0f / LW);
            float q = 0.f;
#pragma unroll
            for (int i = 0; i < 16; ++i) { const float d = x[i] - mean; q += d * d; }
            const float rstd = __builtin_amdgcn_rsqf(wave_sum(q) * (1.0f / LW) + 1e-6f);
            if (lane == 0) { ST[2 * row] = mean; ST[2 * row + 1] = rstd; }
        }
    }
    __syncthreads();
    const unsigned trq = (unsigned)(lane & 15) >> 2, trp = (unsigned)lane & 3u;
    for (int h = 0; h < 8; ++h) {
#pragma unroll
        for (int i = 0; i < 4; ++i) { const int pid = tid + 512 * i, q = pid >> 4, cg = pid & 15;
            const v4u a = G.a[i];
            const float mean = ST[2 * q], rstd = ST[2 * q + 1];
            const f32x4 g0 = G.g0, g1 = G.g1, b0 = G.b0, b1 = G.b1;
            v4u o;
            o.x = pk2((bf_lo(a.x) - mean) * rstd * g0.x + b0.x, (bf_hi(a.x) - mean) * rstd * g0.y + b0.y);
            o.y = pk2((bf_lo(a.y) - mean) * rstd * g0.z + b0.z, (bf_hi(a.y) - mean) * rstd * g0.w + b0.w);
            o.z = pk2((bf_lo(a.z) - mean) * rstd * g1.x + b1.x, (bf_hi(a.z) - mean) * rstd * g1.y + b1.y);
            o.w = pk2((bf_lo(a.w) - mean) * rstd * g1.z + b1.z, (bf_hi(a.w) - mean) * rstd * g1.w + b1.w);
            *(LAS v4u*)(VN + vn_off((unsigned)q, (unsigned)cg)) = o;
        }
#pragma unroll
        for (int i = 0; i < 8; ++i) { const int pid = tid + 512 * i, r = pid >> 5, cg = pid & 31; *(LAS v2u*)(GU + r * 264 + cg * 8) = G.gu[i]; }
        if (tid < 128) BS[tid] = G.bs;
        bf16x8 Af[4];
#pragma unroll
        for (int ks = 0; ks < 4; ++ks) Af[ks] = G.Af[ks];
        __syncthreads();
        if (h + 1 < 8) gmlp_load(F, t0, h + 1, tid, G);
        f32x4 acc[8];
#pragma unroll
        for (int n = 0; n < 8; ++n) {
            acc[n] = (f32x4){0.f, 0.f, 0.f, 0.f};
#pragma unroll
            for (int ks = 0; ks < 4; ++ks) {
                const s16x4 b0 = __builtin_amdgcn_ds_read_tr16_b64_v4i16((LAS s16x4*)(VN + vn_off(32u * ks + 8u * fq + trq, 2u * n + (trp >> 1)) + 8u * (trp & 1u)));
                const s16x4 b1 = __builtin_amdgcn_ds_read_tr16_b64_v4i16((LAS s16x4*)(VN + vn_off(32u * ks + 8u * fq + 4u + trq, 2u * n + (trp >> 1)) + 8u * (trp & 1u)));
                const bf16x8 bb = (bf16x8){b0[0], b0[1], b0[2], b0[3], b1[0], b1[1], b1[2], b1[3]};
                acc[n] = __builtin_amdgcn_mfma_f32_16x16x32_bf16(Af[ks], bb, acc[n], 0, 0, 0);
            }
        }
#pragma unroll
        for (int n = 0; n < 8; ++n)
#pragma unroll
            for (int j = 0; j < 4; ++j) { const int p = 16 * w + 4 * fq + j; LAS unsigned short* ad = (LAS unsigned short*)(GU + p * 264 + (16 * n + fr) * 2);
                *ad = (unsigned short)f2bf(bf1(*ad) * (acc[n][j] + BS[p])); }
        __syncthreads();
#pragma unroll
        for (int i = 0; i < 8; ++i) { const int pid = tid + 512 * i, r = pid >> 5, cg = pid & 31;
            *(GAS v2u*)(F.MIX() + (t0 + r) * D + LW + h * 128 + cg * 4) = *(const LAS v2u*)(GU + r * 264 + cg * 8); }
        __syncthreads();
    }
}
__device__ __forceinline__ void h8_issue(Frame& F, int t, int lane, v4u (&a)[4]) {
    const bf16* hp = F.HB() + (size_t)t * D + lane * 16;
#pragma unroll
    for (int c = 0; c < 2; ++c)
#pragma unroll
        for (int q = 0; q < 2; ++q) a[c * 2 + q] = __builtin_nontemporal_load((const v4u*)(hp + c * 1024 + q * 8));
}
__device__ __forceinline__ void h8_finish(Frame& F, int t, int lane, const v4u (&av)[4]) {
    float hx[32]; float mx = 0.f;
#pragma unroll
    for (int c = 0; c < 2; ++c)
#pragma unroll
        for (int q = 0; q < 2; ++q) { const v4u a = av[c * 2 + q]; float* x = hx + c * 16 + q * 8;
            x[0] = bf_lo(a.x); x[1] = bf_hi(a.x); x[2] = bf_lo(a.y); x[3] = bf_hi(a.y); x[4] = bf_lo(a.z); x[5] = bf_hi(a.z); x[6] = bf_lo(a.w); x[7] = bf_hi(a.w); }
#pragma unroll
    for (int i = 0; i < 32; ++i) mx = fmaxf(mx, fabsf(hx[i]));
#pragma unroll
    for (int o = 1; o < 64; o <<= 1) mx = fmaxf(mx, __shfl_xor(mx, o));
    const float sc = mx > 0.f ? 119.0f / mx : 1.0f;
    const float MAGIC = 12582912.0f + 128.0f;
#pragma unroll
    for (int c = 0; c < 2; ++c) {
        unsigned hw[2], lw[2];
#pragma unroll
        for (int g8 = 0; g8 < 2; ++g8) {
            unsigned m[8];
#pragma unroll
            for (int i = 0; i < 8; ++i) m[i] = __builtin_bit_cast(unsigned, __builtin_fmaf(hx[c * 16 + g8 * 8 + i], sc, MAGIC));
            const unsigned B0 = __builtin_amdgcn_perm(__builtin_amdgcn_perm(m[3], m[2], 0x0c0c0400u), __builtin_amdgcn_perm(m[1], m[0], 0x0c0c0400u), 0x05040100u);
            const unsigned B1 = __builtin_amdgcn_perm(__builtin_amdgcn_perm(m[7], m[6], 0x0c0c0400u), __builtin_amdgcn_perm(m[5], m[4], 0x0c0c0400u), 0x05040100u);
            lw[g8] = (B0 & 0x0F0F0F0Fu) | ((B1 & 0x0F0F0F0Fu) << 4);
            const unsigned h0 = ((B0 + 0x08080808u) >> 4) & 0x0F0F0F0Fu, h1 = ((B1 + 0x08080808u) >> 4) & 0x0F0F0F0Fu;
            hw[g8] = (h0 | (h1 << 4)) ^ 0x88888888u; }
        unsigned char* hb_ = F.H8() + (size_t)t * D + c * 512 + lane * 8;
        *(GAS v2u*)hb_ = (v2u){hw[0], hw[1]}; *(GAS v2u*)(hb_ + 1024) = (v2u){lw[0], lw[1]};
    }
    if (lane == 0) F.HSCALE()[t] = mx > 0.f ? mx * (1.0f / 119.0f) : 1.0f;
}
__device__ __forceinline__ void h8_row(Frame& F, int t) { int lane = F.lane; asm volatile("" : "+v"(lane)); v4u a[4]; h8_issue(F, t, lane, a); h8_finish(F, t, lane, a); }
typedef float f32x16 __attribute__((ext_vector_type(16)));
__device__ __forceinline__ unsigned fkey(float f) { const int u = __builtin_bit_cast(int, f); return (unsigned)(u ^ ((u >> 31) & 0x7fffffff)); }
__device__ __forceinline__ float fkey_inv(unsigned k) { const int u = (int)k; return __builtin_bit_cast(float, u ^ ((u >> 31) & 0x7fffffff)); }
__device__ __forceinline__ unsigned umax_(unsigned a, unsigned b) { return (int)a > (int)b ? a : b; }
__device__ __forceinline__ unsigned umin_(unsigned a, unsigned b) { return (int)a < (int)b ? a : b; }
#define CE_DESC(x, y) do { const unsigned a_ = (x), b_ = (y); (x) = umax_(a_, b_); (y) = umin_(a_, b_); } while (0)
__device__ __forceinline__ void sort16_desc(unsigned (&a)[16]) {
#pragma unroll
    for (int k = 2; k <= 16; k <<= 1)
#pragma unroll
        for (int j = k >> 1; j >= 1; j >>= 1)
#pragma unroll
            for (int i = 0; i < 16; ++i) { const int l = i ^ j; if (l > i) { if ((i & k) == 0) CE_DESC(a[i], a[l]); else CE_DESC(a[l], a[i]); } }
}
__device__ __forceinline__ void merge16_desc(unsigned (&a)[16], const unsigned (&b)[16]) {
#pragma unroll
    for (int i = 0; i < 16; ++i) a[i] = umax_(a[i], b[15 - i]);
#pragma unroll
    for (int j = 8; j >= 1; j >>= 1)
#pragma unroll
        for (int i = 0; i < 16; ++i) if ((i & j) == 0) CE_DESC(a[i], a[i + j]);
}
typedef short bf16x8s __attribute__((ext_vector_type(8)));
__device__ __forceinline__ void topk_unit(Frame& F, int wu, bool doh, int th, int tstride) {
    v4u ha[4][4];
    const int tg = wu >> 3, hd = wu & 7, lane = F.lane, r = lane & 31, hh = lane >> 5;
    const int t = tg * 32 + r;
    const size_t qoff = (size_t)t * D + hd * 256 + 8 * hh;
    unsigned L[2][16];
    unsigned hh4 = (unsigned)hh << 2; asm volatile("" : "+v"(hh4));
#pragma unroll
    for (int p = 0; p < 2; ++p) {
        f32x16 acc[4];
#pragma unroll
        for (int nt = 0; nt < 4; ++nt)
#pragma unroll
            for (int i = 0; i < 16; ++i) acc[nt][i] = 0.f;
        const size_t koff = ((size_t)(hd * 2 + p) * 128 + r) * 128 + 8 * hh;
        const bf16* qp = F.QH() + qoff + p * 128; const bf16* kp0 = F.KH() + koff; const bf16* kp1 = kp0 + 32 * 128; const bf16* kp2 = kp0 + 64 * 128; const bf16* kp3 = kp0 + 96 * 128;
        asm volatile("" : "+v"(qp), "+v"(kp0), "+v"(kp1), "+v"(kp2), "+v"(kp3));
#define P6_LOAD(Q, K, ks0, n) _Pragma("unroll") for (int i_ = 0; i_ < (n); ++i_) { Q[i_] = *(const GAS bf16x8s*)(qp + 16 * ((ks0) + i_)); \
            K[i_][0] = *(const GAS bf16x8s*)(kp0 + 16 * ((ks0) + i_)); K[i_][1] = *(const GAS bf16x8s*)(kp1 + 16 * ((ks0) + i_)); \
            K[i_][2] = *(const GAS bf16x8s*)(kp2 + 16 * ((ks0) + i_)); K[i_][3] = *(const GAS bf16x8s*)(kp3 + 16 * ((ks0) + i_)); }
#define P6_MMA(Q, K, n) _Pragma("unroll") for (int i_ = 0; i_ < (n); ++i_) _Pragma("unroll") for (int nt = 0; nt < 4; ++nt) acc[nt] = __builtin_amdgcn_mfma_f32_32x32x16_bf16(K[i_][nt], Q[i_], acc[nt], 0, 0, 0);
        bf16x8s qa[3], ka[3][4], qb[3], kb[3][4];
        P6_LOAD(qa, ka, 0, 3); P6_LOAD(qb, kb, 3, 3);
        __builtin_amdgcn_sched_barrier(0);
        P6_MMA(qa, ka, 3);
        __builtin_amdgcn_sched_barrier(0);
        P6_LOAD(qa, ka, 6, 2);
        __builtin_amdgcn_sched_barrier(0);
        P6_MMA(qb, kb, 3);
        __builtin_amdgcn_sched_barrier(0);
        P6_MMA(qa, ka, 2);
        __builtin_amdgcn_sched_barrier(0);
        if (p == 1) {
#pragma unroll
            for (int i = 0; i < 4; ++i) { if (doh) h8_issue(F, th + i * tstride, lane, ha[i]); else { ha[i][0] = ha[i][1] = ha[i][2] = ha[i][3] = (v4u){0u, 0u, 0u, 0u}; } }
            __builtin_amdgcn_sched_barrier(0);
        }
#undef P6_LOAD
#undef P6_MMA
        unsigned S[4][16];
#pragma unroll
        for (int nt = 0; nt < 4; ++nt) {
#pragma unroll
            for (int rg = 0; rg < 16; ++rg) { const int nc = 32 * nt + (rg & 3) + 8 * (rg >> 2); S[nt][rg] = ((fkey(acc[nt][rg]) & ~0x7Fu) | (unsigned)(127 - nc)) ^ hh4; }
            sort16_desc(S[nt]);
        }
        merge16_desc(S[0], S[1]); merge16_desc(S[2], S[3]); merge16_desc(S[0], S[2]);
        unsigned T[16];
#pragma unroll
        for (int i = 0; i < 16; ++i) T[i] = (unsigned)__shfl_xor((int)S[0][i], 32);
        merge16_desc(S[0], T);
#pragma unroll
        for (int i = 0; i < 16; ++i) L[p][i] = S[0][i];
        __builtin_amdgcn_sched_barrier(0);
    }
    float v0[16], v1[16];
#pragma unroll
    for (int i = 0; i < 16; ++i) { v0[i] = fkey_inv(L[0][i] & ~0x7Fu); v1[i] = fkey_inv(L[1][i] & ~0x7Fu); }
    unsigned C[4][16];
    {
        int cnt = 0;
#pragma unroll
        for (int i = 0; i < 16; ++i)
#pragma unroll
            for (int j = 0; j < 16; ++j) if ((i + 1) * (j + 1) <= 16) { C[cnt >> 4][cnt & 15] = (fkey(v0[i] + v1[j]) & ~0xFFu) | (unsigned)(255 - (i * 16 + j)); ++cnt; }
#pragma unroll
        for (int q = 50; q < 64; ++q) C[q >> 4][q & 15] = 0x80000000u;
    }
    sort16_desc(C[0]); sort16_desc(C[1]); sort16_desc(C[2]); sort16_desc(C[3]);
    merge16_desc(C[0], C[1]); merge16_desc(C[2], C[3]); merge16_desc(C[0], C[2]);
    unsigned best[16];
#pragma unroll
    for (int i = 0; i < 16; ++i) best[i] = C[0][i];
    LAS unsigned* tab = (LAS unsigned*)(F.lds + F.wave * 8192) + lane;
#pragma unroll
    for (int i = 0; i < 16; ++i) { tab[i * 64] = 127u - (L[0][i] & 0x7Fu); tab[(16 + i) * 64] = 127u - (L[1][i] & 0x7Fu); }
    const float smax = fkey_inv(best[0] & ~0xFFu);
    float sv[8]; unsigned idv[8]; float ssum = 0.f;
#pragma unroll
    for (int k = 0; k < 8; ++k) {
        const unsigned bk = hh ? best[8 + k] : best[k];
        const unsigned pos = 255u - (bk & 0xFFu);
        idv[k] = tab[(pos >> 4) * 64] * 128u + tab[(16 + (pos & 15u)) * 64];
        sv[k] = __builtin_amdgcn_exp2f((fkey_inv(bk & ~0xFFu) - smax) * 1.4426950409f); ssum += sv[k];
    }
    ssum += __shfl_xor(ssum, 32);
    const float inv = 1.0f / ssum;
    {
        int* o = F.IDS() + (size_t)t * 128 + hd * 16 + 8 * hh; float* og = F.GATES() + (size_t)t * 128 + hd * 16 + 8 * hh;
        *(GAS v4u*)o = (v4u){idv[0], idv[1], idv[2], idv[3]}; *(GAS v4u*)(o + 4) = (v4u){idv[4], idv[5], idv[6], idv[7]};
        *(GAS f32x4*)og = (f32x4){sv[0] * inv, sv[1] * inv, sv[2] * inv, sv[3] * inv}; *(GAS f32x4*)(og + 4) = (f32x4){sv[4] * inv, sv[5] * inv, sv[6] * inv, sv[7] * inv};
    }
    if (doh) {
#pragma unroll
        for (int i = 0; i < 4; ++i) h8_finish(F, th + i * tstride, lane, ha[i]);
    }
}
__device__ __forceinline__ int row_sum16(int v) {
    v += __builtin_amdgcn_update_dpp(0, v, 0x128, 0xf, 0xf, false);
    v += __builtin_amdgcn_update_dpp(0, v, 0x124, 0xf, 0xf, false);
    v += __builtin_amdgcn_update_dpp(0, v, 0x122, 0xf, 0xf, false);
    v += __builtin_amdgcn_update_dpp(0, v, 0x121, 0xf, 0xf, false);
    return v;
}
__device__ __forceinline__ void peer_u_xcd(Frame& F) {
    const int lane = F.lane, x = blockIdx.x & 7, jcu = blockIdx.x >> 3, ncu = ((int)F.G - x + 7) >> 3;
    const int tpc = (M + ncu - 1) / ncu, tpw = (tpc + NWAVES - 1) / NWAVES;
    const int tbase = jcu * tpc + F.wave * tpw;
    int nw = M - tbase; { const int lim = (jcu + 1) * tpc - tbase; nw = nw < lim ? nw : lim; nw = nw < tpw ? nw : tpw; nw = nw < 0 ? 0 : nw; }
    const int NV = nw;
    LAS unsigned char* wl = F.lds + F.wave * 13312;
    LAS int* lst = (LAS int*)wl; LAS int* res = (LAS int*)(wl + 512); LAS unsigned char* hsl = wl + 1024;
    const int q4 = lane >> 4, i16 = lane & 15;
    const unsigned char* ubase = F.U8() + (size_t)x * 2048 * 1024;
    const unsigned lanepart = (unsigned)i16 * 16u;
    int r_idlo = 0, r_idhi = 0, r_t = 0; v4u r_h0 = (v4u){0u, 0u, 0u, 0u}, r_h1 = (v4u){0u, 0u, 0u, 0u};
    int v_cl0 = 0, v_cl1 = 0, v_n = 0, v_r0 = 0, v_t = 0, v_slot = 0; unsigned long long v_mlo = 0, v_mhi = 0; bool v_live = false;
    int vset = 0, nvalid = 0, idle = 0;
    if (NV == 0) return;
#define U_RAW() do { const int vi_ = vset < NV ? vset : NV - 1; r_t = tbase + vi_; \
        r_idlo = F.IDS()[(size_t)r_t * 128 + lane]; r_idhi = F.IDS()[(size_t)r_t * 128 + 64 + lane]; \
        r_h0 = *(const GAS v4u*)(F.H8() + (size_t)r_t * D + lane * 16); r_h1 = *(const GAS v4u*)(F.H8() + (size_t)r_t * D + 1024 + lane * 16); } while (0)
#define U_NEXT() do { if (v_live && v_r0 + 16 < v_n) { v_r0 += 16; } else if (vset < NV) { const bool slo = (r_idlo >> 11) == x, shi = (r_idhi >> 11) == x; \
            v_mlo = __ballot(slo); v_mhi = __ballot(shi); const int nlo = __popcll(v_mlo); v_n = nlo + __popcll(v_mhi); \
            const int plo = __builtin_amdgcn_mbcnt_hi((unsigned)(v_mlo >> 32), __builtin_amdgcn_mbcnt_lo((unsigned)v_mlo, 0)); \
            const int phi = nlo + __builtin_amdgcn_mbcnt_hi((unsigned)(v_mhi >> 32), __builtin_amdgcn_mbcnt_lo((unsigned)v_mhi, 0)); \
            if (slo) lst[plo] = (r_idlo & 2047) | (lane << 16); if (shi) lst[phi] = (r_idhi & 2047) | ((64 + lane) << 16); \
            v_slot = nvalid % 6; ++nvalid; { LAS unsigned char* sp_ = hsl + v_slot * 2048; *(LAS v4u*)(sp_ + lane * 16) = r_h0; *(LAS v4u*)(sp_ + 1024 + lane * 16) = r_h1; } \
            v_cl0 = lst[lane]; v_cl1 = lst[64 + lane]; v_t = r_t; v_r0 = 0; ++vset; v_live = true; } \
        else { v_live = false; v_n = 0; v_r0 = 0; v_mlo = 0; v_mhi = 0; ++idle; } } while (0)
#define U_ISSUE(BUF, DS) do { { const int rem_ = v_n - v_r0; DS##_cnt = rem_ < 0 ? 0 : (rem_ < 16 ? rem_ : 16); } \
        DS##_slot = v_slot; DS##_t = v_t; DS##_mlo = v_mlo; DS##_mhi = v_mhi; DS##_last = v_live && (v_r0 + 16 >= v_n); \
        _Pragma("unroll") for (int gp = 0; gp < 4; ++gp) { const int ix_ = v_r0 + 4 * gp + q4; const int a_ = __shfl(v_cl0, ix_ & 63), b_ = __shfl(v_cl1, ix_ & 63); DS##_ent[gp] = ix_ < 64 ? a_ : b_; \
            const unsigned of_ = (4 * gp + q4 < DS##_cnt ? ((unsigned)(DS##_ent[gp] & 2047) << 10) : 0u) + lanepart; \
            _Pragma("unroll") for (int c = 0; c < 4; ++c) BUF[4 * gp + c] = *(const GAS v4u*)(ubase + of_ + c * 256); } } while (0)
#define U_COMPUTE(BUF, DS) do { const LAS unsigned char* sp_ = hsl + DS##_slot * 2048; const LAS v4u* hp_ = (const LAS v4u*)(sp_ + i16 * 16); \
        _Pragma("unroll") for (int gp = 0; gp < 4; ++gp) if (4 * gp < DS##_cnt) { int ah_ = 0, al_ = 0; \
            _Pragma("unroll") for (int c = 0; c < 4; ++c) { const v4u r_ = BUF[4 * gp + c]; const v4u hh_ = hp_[c * 16], hl_ = hp_[64 + c * 16]; \
                ah_ = __builtin_amdgcn_sdot8((int)r_.x, (int)hh_.x, ah_, false); al_ = __builtin_amdgcn_sdot8((int)r_.x, (int)hl_.x, al_, false); \
                ah_ = __builtin_amdgcn_sdot8((int)r_.y, (int)hh_.y, ah_, false); al_ = __builtin_amdgcn_sdot8((int)r_.y, (int)hl_.y, al_, false); \
                ah_ = __builtin_amdgcn_sdot8((int)r_.z, (int)hh_.z, ah_, false); al_ = __builtin_amdgcn_sdot8((int)r_.z, (int)hl_.z, al_, false); \
                ah_ = __builtin_amdgcn_sdot8((int)r_.w, (int)hh_.w, ah_, false); al_ = __builtin_amdgcn_sdot8((int)r_.w, (int)hl_.w, al_, false); } \
            const int a_ = row_sum16((ah_ << 4) + al_); if (i16 == 0 && 4 * gp + q4 < DS##_cnt) res[DS##_ent[gp] >> 16] = a_; } \
        if (DS##_last) { int* po_ = F.PART() + (size_t)DS##_t * 128; \
            if ((DS##_mlo >> lane) & 1ull) po_[lane] = res[lane]; if ((DS##_mhi >> lane) & 1ull) po_[64 + lane] = res[64 + lane]; } } while (0)
    v4u bufA[16], bufB[16], bufC[16];
    int dA_cnt = 0, dA_ent[4] = {0, 0, 0, 0}, dA_t = 0, dA_slot = 0; unsigned long long dA_mlo = 0, dA_mhi = 0; bool dA_last = false;
    int dB_cnt = 0, dB_ent[4] = {0, 0, 0, 0}, dB_t = 0, dB_slot = 0; unsigned long long dB_mlo = 0, dB_mhi = 0; bool dB_last = false;
    int dC_cnt = 0, dC_ent[4] = {0, 0, 0, 0}, dC_t = 0, dC_slot = 0; unsigned long long dC_mlo = 0, dC_mhi = 0; bool dC_last = false;
    U_RAW();
    U_NEXT(); U_RAW(); U_ISSUE(bufA, dA);
    U_NEXT(); U_RAW(); U_ISSUE(bufB, dB);
    while (idle < 3) {
        U_NEXT(); U_RAW(); U_ISSUE(bufC, dC); U_COMPUTE(bufA, dA);
        U_NEXT(); U_RAW(); U_ISSUE(bufA, dA); U_COMPUTE(bufB, dB);
        U_NEXT(); U_RAW(); U_ISSUE(bufB, dB); U_COMPUTE(bufC, dC);
    }
#undef U_RAW
#undef U_NEXT
#undef U_ISSUE
#undef U_COMPUTE
}
__device__ __forceinline__ void peer_act_token(Frame& F, int t) {
    const int lane = F.lane;
    LAS unsigned char* wl = F.lds + F.wave * 4096;
    LAS float* abuf = (LAS float*)wl; LAS int* ibuf = (LAS int*)(wl + 512); LAS int* cnt = (LAS int*)(wl + 1024);
    LAS int* ovf = (LAS int*)(wl + 1280); LAS int* fre = (LAS int*)(wl + 1792); LAS int* sop = (LAS int*)(wl + 2304);
#define WFENCE() asm volatile("s_waitcnt lgkmcnt(0)" ::: "memory")
    const float sc = __builtin_amdgcn_rsqf(F.ROWSS()[t] * (1.0f / D) + 1e-6f) * F.HSCALE()[t];
    if (lane < 34) cnt[lane] = 0;
    float am = 0.f; float actv[2]; int idv[2], slotv[2];
    const int l32 = t & 31;
#pragma unroll
    for (int half = 0; half < 2; ++half) {
        const size_t o = (size_t)t * 128 + half * 64 + lane;
        const int e = F.IDS()[o]; const float g = F.GATES()[o];
        const int dsum = F.PART()[o];
        actv[half] = gelu_tanh((float)dsum * sc * F.USCALE()[e]) * g * F.VSCALE()[e]; idv[half] = e; am = fmaxf(am, fabsf(actv[half]));
    }
    WFENCE();
#pragma unroll
    for (int half = 0; half < 2; ++half) {
        const int r = idv[half] & 31;
        const int j = __hip_atomic_fetch_add(cnt + r, 1, __ATOMIC_RELAXED, __HIP_MEMORY_SCOPE_WORKGROUP);
        if (j < 4) slotv[half] = ((r - l32) & 31) + 32 * j;
        else { const int q = __hip_atomic_fetch_add(cnt + 32, 1, __ATOMIC_RELAXED, __HIP_MEMORY_SCOPE_WORKGROUP); ovf[q] = half * 64 + lane; slotv[half] = -1; }
    }
    WFENCE();
    if (lane < 32) { const int n = cnt[lane];
        for (int j = n; j < 4; ++j) { const int q = __hip_atomic_fetch_add(cnt + 33, 1, __ATOMIC_RELAXED, __HIP_MEMORY_SCOPE_WORKGROUP); fre[q] = ((lane - l32) & 31) + 32 * j; } }
    WFENCE();
    const int nov = cnt[32];
#pragma unroll
    for (int half = 0; half < 2; ++half) { const int i = half * 64 + lane; if (i < nov) sop[ovf[i]] = fre[i]; }
    WFENCE();
#pragma unroll
    for (int half = 0; half < 2; ++half) { if (slotv[half] < 0) slotv[half] = sop[half * 64 + lane]; abuf[slotv[half]] = actv[half]; ibuf[slotv[half]] = idv[half]; }
    WFENCE();
#pragma unroll
    for (int o = 1; o < 64; o <<= 1) am = fmaxf(am, __shfl_xor(am, o));
    const float asc = am > 0.f ? 127.0f / am : 1.0f;
    if (lane == 0) F.ASCALE()[t] = am > 0.f ? am * (1.0f / 127.0f) : 1.0f;
    if (lane < 32) {
        const f32x4 av = *(const LAS f32x4*)(abuf + 4 * lane); const v4u iv = *(const LAS v4u*)(ibuf + 4 * lane);
        const size_t o = ((size_t)(t >> 6) * 32 + lane) * 64 + (t & 63);
        F.IDW()[o] = (v4u){iv.x << 3, iv.y << 3, iv.z << 3, iv.w << 3};
        F.AW()[o] = pack_i8x4(av.x * asc, av.y * asc, av.z * asc, av.w * asc);
    }
    WFENCE();
#undef WFENCE
}
__device__ __forceinline__ void tr4x4(const unsigned r0, const unsigned r1, const unsigned r2, const unsigned r3, unsigned (&c)[4]) {
    const unsigned t01l = __builtin_amdgcn_perm(r1, r0, 0x05010400u), t01h = __builtin_amdgcn_perm(r1, r0, 0x07030602u);
    const unsigned t23l = __builtin_amdgcn_perm(r3, r2, 0x05010400u), t23h = __builtin_amdgcn_perm(r3, r2, 0x07030602u);
    c[0] = __builtin_amdgcn_perm(t23l, t01l, 0x05040100u); c[1] = __builtin_amdgcn_perm(t23l, t01l, 0x07060302u);
    c[2] = __builtin_amdgcn_perm(t23h, t01h, 0x05040100u); c[3] = __builtin_amdgcn_perm(t23h, t01h, 0x07060302u);
}
template <int MODE>
__device__ __forceinline__ void peer_v_slice(Frame& F, int c, bool do_atomic) {
    const int tid = F.tid, lane = F.lane;
    for (int i = tid; i < NEXP * 8 / 16; i += 512) *(LAS v4u*)(F.lds + i * 16) = *(const GAS v4u*)(F.V8T() + (size_t)c * NEXP * 8 + (size_t)i * 16);
    __syncthreads();
    const v4u* ibase = F.IDW() + lane; const unsigned* abase = F.AW() + lane;
    constexpr int NBLK = M / 64, PD = 16;
    v4u iq[PD]; unsigned aq[PD]; v2u rw[2][4];
    {
        const size_t o = (size_t)F.wave * 32 * 64;
#pragma unroll
        for (int j = 0; j < PD; ++j) { iq[j] = *(const GAS v4u*)(ibase + o + j * 64); aq[j] = abase[o + j * 64]; }
    }
#define LROW(dst, q) do { dst[0] = *(const LAS v2u*)(F.lds + (q).x); dst[1] = *(const LAS v2u*)(F.lds + (q).y); \
                          dst[2] = *(const LAS v2u*)(F.lds + (q).z); dst[3] = *(const LAS v2u*)(F.lds + (q).w); } while (0)
    for (int blk = F.wave; blk < NBLK; blk += NWAVES) {
        const int t = blk * 64 + lane;
        const size_t o = (size_t)blk * 32 * 64;
        const int nblk = (blk + NWAVES < NBLK) ? blk + NWAVES : blk;
        const size_t on = (size_t)nblk * 32 * 64;
        int acc[8];
#pragma unroll
        for (int i = 0; i < 8; ++i) acc[i] = 0;
        LROW(rw[0], iq[0]);
#pragma unroll
        for (int j = 0; j < 32; ++j) {
            if (j + 1 < 32) LROW(rw[(j + 1) & 1], iq[(j + 1) % PD]);
            const unsigned aw = aq[j % PD];
            unsigned cl[4], ch[4];
            tr4x4(rw[j & 1][0].x, rw[j & 1][1].x, rw[j & 1][2].x, rw[j & 1][3].x, cl);
            tr4x4(rw[j & 1][0].y, rw[j & 1][1].y, rw[j & 1][2].y, rw[j & 1][3].y, ch);
#pragma unroll
            for (int i = 0; i < 4; ++i) { acc[i] = __builtin_amdgcn_sdot4((int)aw, (int)cl[i], acc[i], false); acc[4 + i] = __builtin_amdgcn_sdot4((int)aw, (int)ch[i], acc[4 + i], false); }
            { const size_t oo = (j + PD < 32) ? o + (size_t)(j + PD) * 64 : on + (size_t)(j + PD - 32) * 64;
              iq[j % PD] = *(const GAS v4u*)(ibase + oo); aq[j % PD] = abase[oo]; }
            __builtin_amdgcn_sched_barrier(0);
        }
        const float asc = F.ASCALE()[t];
        float accf[8];
#pragma unroll
        for (int i = 0; i < 8; ++i) accf[i] = (float)acc[i] * asc;
        const v4u hb = *(const GAS v4u*)(F.HBT() + ((size_t)c * M + t) * 8);
        accf[0] += bf_lo(hb.x); accf[1] += bf_hi(hb.x); accf[2] += bf_lo(hb.y); accf[3] += bf_hi(hb.y);
        accf[4] += bf_lo(hb.z); accf[5] += bf_hi(hb.z); accf[6] += bf_lo(hb.w); accf[7] += bf_hi(hb.w);
        bf16* yp = (MODE == 0) ? F.Y() + ((size_t)c * M + t) * 8 : (bf16*)F.XN() + ((((size_t)c * M + t) * 8) & (size_t)0x1ffffff);
        *(GAS v4u*)yp = (v4u){pk2(accf[0], accf[1]), pk2(accf[2], accf[3]), pk2(accf[4], accf[5]), pk2(accf[6], accf[7])};
        float ss = 0.f;
#pragma unroll
        for (int i = 0; i < 8; ++i) ss += accf[i] * accf[i];
        if (do_atomic) atomicAdd(F.ROWSS2() + t, ss);
    }
#undef LROW
    __syncthreads();
}
__device__ __forceinline__ void final_unit(Frame& F, int unit) {
    const int tid = F.tid, blk = unit >> 3, cg = unit & 7, t0 = blk * 64;
    LAS float* T = (LAS float*)F.lds;
#pragma unroll
    for (int i = 0; i < 4; ++i) { const int pid = tid + 512 * i, cl = pid >> 6, tok = pid & 63;
        const v4u v = *(const GAS v4u*)(F.Y() + ((size_t)(cg * 32 + cl) * M + t0 + tok) * 8);
        *(LAS f32x4*)(T + tok * 260 + cl * 8) = (f32x4){bf_lo(v.x), bf_hi(v.x), bf_lo(v.y), bf_hi(v.y)};
        *(LAS f32x4*)(T + tok * 260 + cl * 8 + 4) = (f32x4){bf_lo(v.z), bf_hi(v.z), bf_lo(v.w), bf_hi(v.w)}; }
    __syncthreads();
#pragma unroll
    for (int i = 0; i < 8; ++i) { const int pid = tid + 512 * i, tok = pid >> 6, c4 = pid & 63;
        const float rs = __builtin_amdgcn_rsqf(F.ROWSS2()[t0 + tok] * (1.0f / D) + 1e-6f);
        const f32x4 v = *(const LAS f32x4*)(T + tok * 260 + c4 * 4);
        const f32x4 g = *(const GAS f32x4*)(F.A.in[20] + cg * 256 + c4 * 4);
        *(GAS f32x4*)(F.A.out + (size_t)(t0 + tok) * D + cg * 256 + c4 * 4) = v * rs * g; }
    __syncthreads();
}
__global__ void __launch_bounds__(NWAVES * 64, 2) mk_fwd(Args args) {
    __shared__ __attribute__((aligned(16))) unsigned char lds[LDS_BYTES];
    Frame F(args);
    F.lds = (LAS unsigned char*)lds;
    F.MISC = (volatile LAS unsigned*)(F.lds + MISC_OFF);
    F.tid = threadIdx.x; F.lane = F.tid & 63; F.wave = __builtin_amdgcn_readfirstlane(F.tid >> 6);
    F.G = gridDim.x; { const int bx = blockIdx.x; F.vcu = (F.G % 8 == 0) ? (bx % 8) * (F.G / 8) + bx / 8 : bx; }
    F.ws = args.ws;
    F.ctl = (gu32*)(args.ws + WS_CTL);
    for (int u = F.tid; u < (LDS_BYTES - LDSCTL_OFF) / 4; u += NWAVES * 64) ((LAS unsigned*)(F.lds + LDSCTL_OFF))[u] = 0u;
    __syncthreads();
    XcdBarrier bar; bar.bar = (unsigned*)(F.ctl + CW_BAR); bar.x = 0; bar.st = nullptr;
    if (N_LAUNCHES != PER_PHASE) bar = xcd_barrier_post((unsigned*)(F.ctl + CW_BAR), F.MISC + 8);
#define GRID_BAR() do { if (N_LAUNCHES != PER_PHASE) xcd_barrier(bar); } while (0)
    const int lo = args.ph_lo, hi = args.ph_hi;
#ifndef MK_PHASE_MASK
#define MK_PHASE_MASK 0x7FF
#endif
#define IN(k) (((MK_PHASE_MASK >> (k)) & 1) && lo <= (k) && (k) < hi)
#undef MK_PHASE_MASK
#define MK_PHASE_MASK 0xFFFF
#define BOTH(k) (true)
#ifndef MK_REP_MASK
#define MK_REP_MASK 0
#endif
#ifndef MK_REP_N
#define MK_REP_N 2
#endif
#ifndef H8_REP
#define H8_REP 1
#endif
#define REPS(k) for (int rep_ = 0; rep_ < ((((MK_REP_MASK) >> (k)) & 1) ? 1 + MK_REP_N : 1); ++rep_)
    const int gw = F.vcu * NWAVES + F.wave, NGW = F.G * NWAVES;
    if (IN(0)) { REPS(0) { p0_prologue(F); __syncthreads(); } if (BOTH(0)) GRID_BAR(); }
    if (IN(1)) {
        pg8::Gemm g{F.XN(), F.WIN(), M, NIN, D}; pg8::StaticOrder S; S.init(M, NIN, F.G, (int)blockIdx.x);
        pg8::EpiZ E{F.Z(), NIN, LW};
        REPS(1) pg8::gemm_phase<pg8::EpiZ, pg8::StaticOrder, true, true>(F.lds, g, S, E);
        if (BOTH(1)) GRID_BAR();
    }
    if (IN(2)) {
        REPS(12) { v4u xr[5]; int u = blockIdx.x; lru_prefetch(F, u, F.tid, xr); lru_conv(F, u, F.tid, xr); __syncthreads();
                   for (; u < BATCH * NCHUNK * 8; u += F.G) lru_fused_unit(F, u, u + F.G < BATCH * NCHUNK * 8 ? u + F.G : -1, xr); }
        asm volatile("" : "+v"(F.tid), "+v"(F.lane));
        REPS(13) for (int u = blockIdx.x; u < BATCH * NCHUNK; u += F.G) gmlp_unit(F, u);
        if (BOTH(2)) GRID_BAR();
    }
    if (IN(4)) {
        pg8::Gemm g{F.MIX(), F.WOUT(), M, D, D}; pg8::StaticOrder S; S.init(M, D, F.G, (int)blockIdx.x);
        pg8::EpiH E{F.HB(), F.HBT(), F.A.in[0], F.ROWSS(), D, M};
        pg8::gemm_phase<pg8::EpiH, pg8::StaticOrder, true, true>(F.lds, g, S, E);
        if (BOTH(4)) GRID_BAR();
    }
    if (IN(5)) {
        pg8::Gemm g{F.HB(), F.WQ(), M, D, D}; pg8::StaticOrder S; S.init(M, D, F.G, (int)blockIdx.x);
        pg8::EpiQ E{F.QH(), F.ROWSS(), D};
        REPS(5) pg8::gemm_phase<pg8::EpiQ, pg8::StaticOrder, true, true>(F.lds, g, S, E);
        if (BOTH(5)) GRID_BAR();
    }
    if (IN(6)) {
        REPS(6) { int hk = 0;
                  for (int wu = gw; wu < (M / 32) * 8; wu += NGW) { const bool doh = gw + NGW * (hk + 3) < M; topk_unit(F, wu, doh, gw + NGW * hk, NGW); if (doh) hk += 4; }
                  for (int t = gw + NGW * hk; t < M; t += NGW) h8_row(F, t); }
        if (BOTH(6)) GRID_BAR();
    }
    if (IN(7)) {
        REPS(7) peer_u_xcd(F);
        if (BOTH(7)) GRID_BAR();
    }
    if (IN(8)) {
        REPS(8) for (int t = gw; t < M; t += NGW) peer_act_token(F, t);
        if (BOTH(8)) GRID_BAR();
    }
    if (IN(9)) {
        for (int c = blockIdx.x; c < D / 8; c += F.G) peer_v_slice<0>(F, c, true);
        if ((MK_REP_MASK >> 9) & 1) { for (int rep_ = 0; rep_ < MK_REP_N; ++rep_) for (int c = blockIdx.x; c < D / 8; c += F.G) peer_v_slice<1>(F, c, false); }
        if (BOTH(9)) GRID_BAR();
    }
    if (IN(10)) {
        REPS(10) for (int u = blockIdx.x; u < (M / 64) * 8; u += F.G) final_unit(F, u);
    }
#undef IN
#undef BOTH
#undef GRID_BAR
}

extern "C" void kernel_launch(void* const* d_in, const int* in_sizes, int n_in, void* d_out, int out_size, void* d_ws, size_t ws_size, hipStream_t stream) {
    static int grid = 0;
    if (grid == 0) {
        if (n_in != 21 || in_sizes[0] != M * D || out_size != M * D || ws_size < WS_END) { fprintf(stderr, "kernel_launch: unexpected shapes (n_in %d, in0 %d, out %d, ws %zu)\n", n_in, n_in > 0 ? in_sizes[0] : -1, out_size, ws_size); grid = -1; return; }
        int dev = 0, cus = 0, per_cu = 0;
        if (hipGetDevice(&dev) != hipSuccess || hipDeviceGetAttribute(&cus, hipDeviceAttributeMultiprocessorCount, dev) != hipSuccess) { grid = -1; return; }
        if (hipOccupancyMaxActiveBlocksPerMultiprocessor(&per_cu, (const void*)mk_fwd, NWAVES * 64, 0) != hipSuccess || per_cu < 1) { fprintf(stderr, "kernel_launch: occupancy query reports %d blocks per CU\n", per_cu); }
        (void)hipGetLastError();
        grid = cus;
        if (cus < 256) { fprintf(stderr, "kernel_launch: the RG-LRU family hand-off needs >= 256 co-resident workgroups (have %d)\n", cus); grid = -1; return; }
    }
    if (grid < 0) return;
    (void)hipMemsetAsync((char*)d_ws + WS_CTL, 0, CTL_ZERO_BYTES, stream);
    Args a{};
    for (int i = 0; i < 21; ++i) a.in[i] = (const float*)d_in[i];
    a.out = (float*)d_out; a.ws = (unsigned char*)d_ws;
    for (int li = 0; li < N_LAUNCHES; ++li) {
        a.ph_lo = 0; a.ph_hi = 99;
        hipLaunchKernelGGL(mk_fwd, dim3(grid), dim3(NWAVES * 64), 0, stream, a);
    }
}
```

```cpp
#include <hip/hip_runtime.h>
#include <cstdio>
#include <cstdint>
namespace pg8 {
#define PG8_LAS __attribute__((address_space(3)))
typedef unsigned short bf16_t;
typedef short bf16x8 __attribute__((ext_vector_type(8)));
typedef float f32x4 __attribute__((ext_vector_type(4)));
typedef unsigned u32x4 __attribute__((ext_vector_type(4)));
typedef int i32x4 __attribute__((ext_vector_type(4)));
constexpr int BM = 256, BK = 64, HALF = 128, HTB = HALF * BK * 2  , STAGE_BYTES = 8 * HTB, NXCD = 8, WGM = 8;

__host__ __device__ __forceinline__ int lds_byte(int r, int c) { const int st = (r >> 4) * 2 + (c >> 5), rr = r & 15, cc = c & 31, ob = rr * 64 + cc * 2; return st * 1024 + (ob ^ (((ob >> 9) & 1) << 5)); }
__host__ __device__ __forceinline__ void stage_rc(int b, int& R, int& C) { const int st = b / 1024, sb = b % 1024, swz = sb ^ (((sb >> 9) & 1) << 5); R = (st >> 1) * 16 + swz / 64; C = (st & 1) * 32 + (swz % 64) / 2; }
__host__ __device__ __forceinline__ int perm32(int rho) { const int n = rho >> 4, i = rho & 15; return 8 * (i >> 2) + 4 * n + (i & 3); }

struct Unit { int pm, pn; };
struct Gemm { const bf16_t* A; const bf16_t* Bt; int M, N, K; };

struct StaticOrder {
    int nM, nN, nwg, G, c; bool rev;
    __host__ __device__ void init(int M, int N, int G_, int c_, bool rev_ = false) { nM = M / BM; nN = N / BM; nwg = nM * nN; G = G_; c = c_; rev = rev_; }
    __host__ __device__ bool next(int i, Unit& u) const {
        const long L = (long)i * G + c; if (L >= nwg) return false;
        int wgid = (int)L; { const int q = nwg / NXCD, r = nwg % NXCD, xcd = wgid % NXCD, off = wgid / NXCD; wgid = (xcd < r ? xcd * (q + 1) : r * (q + 1) + (xcd - r) * q) + off; }
        const int nig = WGM * nN, gid = wgid / nig, fm = gid * WGM, gsz = (nM - fm) < WGM ? (nM - fm) : WGM;
        u.pm = fm + ((wgid % nig) % gsz); u.pn = (wgid % nig) / gsz; if (rev) u.pm = nM - 1 - u.pm; return true;
    }
    __device__ __forceinline__ void a_ready(const Unit&) const {}
    __device__ __forceinline__ void done(const Unit&) const {}
};

__device__ __forceinline__ unsigned cvt_pk_bf16(float lo, float hi) { unsigned r; asm volatile("v_cvt_pk_bf16_f32 %0, %1, %2" : "=v"(r) : "v"(lo), "v"(hi)); return r; }
__device__ __forceinline__ float gelu_tanh(float x) {
    const float t = x * (1.0f + 0.044715f * x * x);
    const float e = __builtin_amdgcn_exp2f(-2.3022081983f * t);
    return x * __builtin_amdgcn_rcpf(1.0f + e);
}
typedef float f32x2p __attribute__((ext_vector_type(2)));
__device__ __forceinline__ f32x2p gelu_tanh2(f32x2p x) {
    const f32x2p s = x * ((x * x) * (-2.3022081983f * 0.044715f) + (-2.3022081983f));
    f32x2p d; d.x = __builtin_amdgcn_exp2f(s.x); d.y = __builtin_amdgcn_exp2f(s.y);
    d = d + 1.0f;
    f32x2p r; r.x = __builtin_amdgcn_rcpf(d.x); r.y = __builtin_amdgcn_rcpf(d.y);
    return x * r;
}
struct EpiZ8 {
    static constexpr bool PERM = true, AFTER_DRAIN = false;
    bf16_t* O; int ldc; int gelu_from; const float* rs; const float* cs;
    __device__ __forceinline__ void operator()(const f32x4 (&acc)[2][2][4][2], const Unit& u, int wr, int wc, int fr, int fq) const {
        const int row0 = u.pm * BM + wr * 64 + fr; const int col0 = u.pn * BM + wc * 32 + 8 * fq;
        const bool act = (u.pn * BM) >= gelu_from;
        f32x4 c0[2], c1[2];
#pragma unroll
        for (int bj = 0; bj < 2; ++bj) { c0[bj] = *(const f32x4*)(cs + col0 + bj * HALF); c1[bj] = *(const f32x4*)(cs + col0 + bj * HALF + 4); }
#pragma unroll
        for (int ai = 0; ai < 2; ++ai)
#pragma unroll
            for (int m = 0; m < 4; ++m) { const int row = row0 + ai * HALF + m * 16; const float rsc = rs[row]; bf16_t* rowp = O + (size_t)row * ldc + col0;
#pragma unroll
                for (int bj = 0; bj < 2; ++bj) { const i32x4 i0 = __builtin_bit_cast(i32x4, acc[ai][bj][m][0]), i1 = __builtin_bit_cast(i32x4, acc[ai][bj][m][1]);
                    f32x4 v0 = (f32x4){(float)i0[0], (float)i0[1], (float)i0[2], (float)i0[3]} * (c0[bj] * rsc), v1 = (f32x4){(float)i1[0], (float)i1[1], (float)i1[2], (float)i1[3]} * (c1[bj] * rsc);
                    if (act) {
#pragma unroll
                        for (int j = 0; j < 4; j += 2) { const f32x2p a = gelu_tanh2((f32x2p){v0[j], v0[j + 1]}), b = gelu_tanh2((f32x2p){v1[j], v1[j + 1]}); v0[j] = a.x; v0[j + 1] = a.y; v1[j] = b.x; v1[j + 1] = b.y; } }
                    u32x4 w; w.x = cvt_pk_bf16(v0[0], v0[1]); w.y = cvt_pk_bf16(v0[2], v0[3]); w.z = cvt_pk_bf16(v1[0], v1[1]); w.w = cvt_pk_bf16(v1[2], v1[3]);
                    *(u32x4*)(rowp + bj * HALF) = w; } }
    }
};
struct EpiH8 {
    static constexpr bool PERM = true, AFTER_DRAIN = false;
    bf16_t* O; bf16_t* OT; const float* X; float* rowss; int ldc; int mrows; const float* rs; const float* cs;
    __device__ __forceinline__ void operator()(const f32x4 (&acc)[2][2][4][2], const Unit& u, int wr, int wc, int fr, int fq) const {
        const int row0 = u.pm * BM + wr * 64 + fr; const int col0 = u.pn * BM + wc * 32 + 8 * fq;
        f32x4 c0[2], c1[2];
#pragma unroll
        for (int bj = 0; bj < 2; ++bj) { c0[bj] = *(const f32x4*)(cs + col0 + bj * HALF); c1[bj] = *(const f32x4*)(cs + col0 + bj * HALF + 4); }
#pragma unroll
        for (int ai = 0; ai < 2; ++ai)
#pragma unroll
            for (int m = 0; m < 4; ++m) { const int row = row0 + ai * HALF + m * 16; const size_t off = (size_t)row * ldc + col0; float ss = 0.f; const float rsc = rs[row];
#pragma unroll
                for (int bj = 0; bj < 2; ++bj) {
                    const f32x4 x0 = *(const f32x4*)(X + off + bj * HALF), x1 = *(const f32x4*)(X + off + bj * HALF + 4);
                    const i32x4 i0 = __builtin_bit_cast(i32x4, acc[ai][bj][m][0]), i1 = __builtin_bit_cast(i32x4, acc[ai][bj][m][1]);
                    const f32x4 v0 = (f32x4){(float)i0[0], (float)i0[1], (float)i0[2], (float)i0[3]} * (c0[bj] * rsc) + x0, v1 = (f32x4){(float)i1[0], (float)i1[1], (float)i1[2], (float)i1[3]} * (c1[bj] * rsc) + x1;
                    ss += (v0[0] * v0[0] + v0[1] * v0[1]) + (v0[2] * v0[2] + v0[3] * v0[3]) + (v1[0] * v1[0] + v1[1] * v1[1]) + (v1[2] * v1[2] + v1[3] * v1[3]);
                    u32x4 w; w.x = cvt_pk_bf16(v0[0], v0[1]); w.y = cvt_pk_bf16(v0[2], v0[3]); w.z = cvt_pk_bf16(v1[0], v1[1]); w.w = cvt_pk_bf16(v1[2], v1[3]);
                    *(u32x4*)(O + off + bj * HALF) = w;
                    *(u32x4*)(OT + ((size_t)((col0 + bj * HALF) >> 3) * mrows + row) * 8) = w; }
                ss += __shfl_xor(ss, 16); ss += __shfl_xor(ss, 32);
                if (fq == 0) atomicAdd(rowss + row, ss); }
    }
};
struct EpiQ8 {
    static constexpr bool PERM = true, AFTER_DRAIN = false;
    bf16_t* QH; const float* rowss; int ldc; const float* rs; const float* cs;
    __device__ __forceinline__ void operator()(const f32x4 (&acc)[2][2][4][2], const Unit& u, int wr, int wc, int fr, int fq) const {
        const int row0 = u.pm * BM + wr * 64 + fr, col0 = u.pn * BM + wc * 32 + 8 * fq;
        f32x4 c0[2], c1[2];
#pragma unroll
        for (int bj = 0; bj < 2; ++bj) { c0[bj] = *(const f32x4*)(cs + col0 + bj * HALF); c1[bj] = *(const f32x4*)(cs + col0 + bj * HALF + 4); }
#pragma unroll
        for (int ai = 0; ai < 2; ++ai)
#pragma unroll
            for (int m = 0; m < 4; ++m) { const int row = row0 + ai * HALF + m * 16; const float rsc = __builtin_amdgcn_rsqf(rowss[row] * (1.0f / 2048.0f) + 1e-6f) * rs[row];
                const size_t off = (size_t)row * ldc + col0;
#pragma unroll
                for (int bj = 0; bj < 2; ++bj) { const i32x4 i0 = __builtin_bit_cast(i32x4, acc[ai][bj][m][0]), i1 = __builtin_bit_cast(i32x4, acc[ai][bj][m][1]);
                    const f32x4 v0 = (f32x4){(float)i0[0], (float)i0[1], (float)i0[2], (float)i0[3]} * (c0[bj] * rsc), v1 = (f32x4){(float)i1[0], (float)i1[1], (float)i1[2], (float)i1[3]} * (c1[bj] * rsc);
                    u32x4 wh; wh.x = cvt_pk_bf16(v0[0], v0[1]); wh.y = cvt_pk_bf16(v0[2], v0[3]); wh.z = cvt_pk_bf16(v1[0], v1[1]); wh.w = cvt_pk_bf16(v1[2], v1[3]);
                    *(u32x4*)(QH + off + bj * HALF) = wh; } }
    }
};
template <class Epi, class Sched, bool ALIGN_EPI = false, bool SP2 = false, bool I8 = false>
__device__ __forceinline__ void gemm_phase(PG8_LAS unsigned char* lds, const Gemm g, const Sched& S, const Epi& E) {
    const int tid = threadIdx.x, wid = __builtin_amdgcn_readfirstlane(tid >> 6), lane = tid & 63, wr = wid >> 2, wc = wid & 3, fr = lane & 15, fq = lane >> 4;
    const int K = g.K, nt = K / BK;
    unsigned voffA[2], voffB[2];
#pragma unroll
    for (int i = 0; i < 2; ++i) { int R, C; stage_rc(tid * 16 + i * 8192, R, C); const int Rb = Epi::PERM ? ((R & ~31) + perm32(R & 31)) : R;
        voffA[i] = (unsigned)(R * K + C) * 2u; voffB[i] = (unsigned)(Rb * K + C) * 2u; }
    const size_t kstep = (size_t)(BK * 2);
    const size_t hstep = (size_t)HALF * K * 2;
    const size_t tstep = 2 * hstep;
    const unsigned ldsw = (unsigned)wid * 1024u;
    const int aoff = lds_byte(wr * 64 + fr, fq * 8), boff = lds_byte(wc * 32 + fr, fq * 8);
#define PG8_SA(b, h) (((b) * 2 + (h)) * HTB)
#define PG8_SB(b, h) ((4 + (b) * 2 + (h)) * HTB)
#define PG8_STAGE(bufoff, gbase, voff) do { _Pragma("unroll") for (int _i = 0; _i < 2; ++_i) \
        __builtin_amdgcn_global_load_lds((const unsigned*)((const char*)(gbase) + (voff)[_i]), (PG8_LAS unsigned*)(lds + (bufoff) + ldsw + _i * 8192), 16, 0, 0); } while (0)
#define PG8_LDA(dst, b, h) do { _Pragma("unroll") for (int m = 0; m < 4; ++m) _Pragma("unroll") for (int k = 0; k < 2; ++k) dst[m][k] = *(const PG8_LAS bf16x8*)(lds + PG8_SA(b, h) + aoff + m * 2048 + k * 1024); } while (0)
#define PG8_LDB(dst, b, h) do { _Pragma("unroll") for (int n = 0; n < 2; ++n) _Pragma("unroll") for (int k = 0; k < 2; ++k) dst[n][k] = *(const PG8_LAS bf16x8*)(lds + PG8_SB(b, h) + boff + n * 2048 + k * 1024); } while (0)
#define PG8_MMA(ai, bj, At, Bt) do { __builtin_amdgcn_s_setprio(1); _Pragma("unroll") for (int m = 0; m < 4; ++m) _Pragma("unroll") for (int n = 0; n < 2; ++n) _Pragma("unroll") for (int k = 0; k < 2; ++k) { \
        if constexpr (I8) acc[ai][bj][m][n] = __builtin_bit_cast(f32x4, __builtin_amdgcn_mfma_i32_16x16x64_i8(__builtin_bit_cast(i32x4, Bt[n][k]), __builtin_bit_cast(i32x4, At[m][k]), __builtin_bit_cast(i32x4, acc[ai][bj][m][n]), 0, 0, 0)); \
        else acc[ai][bj][m][n] = __builtin_amdgcn_mfma_f32_16x16x32_bf16(Bt[n][k], At[m][k], acc[ai][bj][m][n], 0, 0, 0); } __builtin_amdgcn_s_setprio(0); } while (0)
#define PG8_WAIT_V(n) asm volatile("s_waitcnt vmcnt(" #n ")" ::: "memory")
#define PG8_WAIT_L(n) asm volatile("s_waitcnt lgkmcnt(" #n ")" ::: "memory")
#define PG8_BAR __builtin_amdgcn_s_barrier()
#define PG8_SCHED __builtin_amdgcn_sched_barrier(0)
    Unit cur, nxt; int ui = 0;
    if (!S.next(0, cur)) return;
    f32x4 acc[2][2][4][2];
#pragma unroll
    for (int a = 0; a < 2; ++a)
#pragma unroll
        for (int b = 0; b < 2; ++b)
#pragma unroll
            for (int m = 0; m < 4; ++m)
#pragma unroll
                for (int n = 0; n < 2; ++n) acc[a][b][m][n] = (f32x4){0.f, 0.f, 0.f, 0.f};
    bf16x8 At[4][2], B0[2][2], B1[2][2];
    const char* cA = (const char*)g.A + (size_t)cur.pm * tstep; const char* cB = (const char*)g.Bt + (size_t)cur.pn * tstep;
    S.a_ready(cur);
    if constexpr (SP2) {
        PG8_STAGE(PG8_SB(0, 0), cB, voffB); PG8_STAGE(PG8_SB(0, 1), cB + hstep, voffB); PG8_STAGE(PG8_SA(0, 0), cA, voffA); PG8_STAGE(PG8_SA(0, 1), cA + hstep, voffA);
        if (wr == 1) PG8_BAR;
        PG8_WAIT_V(2); PG8_BAR;
        PG8_STAGE(PG8_SB(1, 0), cB + kstep, voffB); PG8_STAGE(PG8_SA(1, 0), cA + kstep, voffA); PG8_STAGE(PG8_SB(1, 1), cB + hstep + kstep, voffB);
        PG8_WAIT_V(6); PG8_BAR;
    } else {
        PG8_STAGE(PG8_SB(0, 0), cB, voffB); PG8_STAGE(PG8_SA(0, 0), cA, voffA); PG8_STAGE(PG8_SB(0, 1), cB + hstep, voffB); PG8_STAGE(PG8_SA(0, 1), cA + hstep, voffA);
        if (wr == 1) PG8_BAR;
        PG8_WAIT_V(4); PG8_BAR;
        PG8_STAGE(PG8_SB(1, 0), cB + kstep, voffB); PG8_STAGE(PG8_SA(1, 0), cA + kstep, voffA); PG8_STAGE(PG8_SB(1, 1), cB + hstep + kstep, voffB);
        PG8_WAIT_V(6); PG8_BAR;
    }
    for (;;) {
        const bool has_next = S.next(ui + 1, nxt);
        const char* nA = has_next ? (const char*)g.A + (size_t)nxt.pm * tstep : cA; const char* nB = has_next ? (const char*)g.Bt + (size_t)nxt.pn * tstep : cB;
        for (int t = 0; t < nt; t += 2) {
            const bool last = (t == nt - 2);
            const char* a1 = cA + (size_t)(t + 1) * kstep;
            const char* a2 = last ? nA : cA + (size_t)(t + 2) * kstep; const char* b2 = last ? nB : cB + (size_t)(t + 2) * kstep;
            const char* a3 = a2 + kstep; const char* b3 = b2 + kstep;
            if (last && has_next) S.a_ready(nxt);
            if constexpr (SP2) {
            PG8_LDB(B0, 0, 0); PG8_LDB(B1, 0, 1); PG8_SCHED; PG8_LDA(At, 0, 0); PG8_STAGE(PG8_SA(1, 1), a1 + hstep, voffA);
            PG8_WAIT_V(8); PG8_WAIT_L(0); PG8_BAR; PG8_MMA(0, 0, At, B0); PG8_MMA(0, 1, At, B1); PG8_BAR; PG8_SCHED;
            PG8_LDA(At, 0, 1); PG8_STAGE(PG8_SB(0, 0), b2, voffB); PG8_STAGE(PG8_SB(0, 1), b2 + hstep, voffB); PG8_STAGE(PG8_SA(0, 0), a2, voffA);
            PG8_WAIT_V(8); PG8_WAIT_L(0); PG8_BAR; PG8_MMA(1, 0, At, B0); PG8_MMA(1, 1, At, B1); PG8_BAR; PG8_SCHED;
            PG8_LDB(B0, 1, 0); PG8_LDB(B1, 1, 1); PG8_SCHED; PG8_LDA(At, 1, 0); PG8_STAGE(PG8_SA(0, 1), a2 + hstep, voffA);
            PG8_WAIT_V(8); PG8_WAIT_L(0); PG8_BAR; PG8_MMA(0, 0, At, B0); PG8_MMA(0, 1, At, B1); PG8_BAR; PG8_SCHED;
            PG8_LDA(At, 1, 1); PG8_STAGE(PG8_SB(1, 0), b3, voffB); PG8_STAGE(PG8_SB(1, 1), b3 + hstep, voffB); PG8_STAGE(PG8_SA(1, 0), a3, voffA);
            PG8_WAIT_V(8); PG8_WAIT_L(0); PG8_BAR; PG8_MMA(1, 0, At, B0); PG8_MMA(1, 1, At, B1); PG8_BAR; PG8_SCHED;
            } else {
            PG8_LDB(B0, 0, 0); PG8_SCHED; PG8_LDA(At, 0, 0); PG8_STAGE(PG8_SA(1, 1), a1 + hstep, voffA);
            PG8_WAIT_L(8); PG8_BAR; PG8_WAIT_L(0); PG8_MMA(0, 0, At, B0); PG8_BAR; PG8_SCHED;
            PG8_LDB(B1, 0, 1); PG8_STAGE(PG8_SB(0, 0), b2, voffB);
            PG8_BAR; PG8_WAIT_L(0); PG8_MMA(0, 1, At, B1); PG8_BAR;
            PG8_LDA(At, 0, 1); PG8_STAGE(PG8_SA(0, 0), a2, voffA);
            PG8_BAR; PG8_WAIT_L(0); PG8_MMA(1, 0, At, B0); PG8_BAR; PG8_SCHED;
            PG8_STAGE(PG8_SB(0, 1), b2 + hstep, voffB);
            PG8_WAIT_V(6); PG8_BAR; PG8_MMA(1, 1, At, B1); PG8_BAR;
            PG8_LDB(B0, 1, 0); PG8_SCHED; PG8_LDA(At, 1, 0); PG8_STAGE(PG8_SA(0, 1), a2 + hstep, voffA);
            PG8_WAIT_L(8); PG8_BAR; PG8_WAIT_L(0); PG8_MMA(0, 0, At, B0); PG8_BAR; PG8_SCHED;
            PG8_LDB(B1, 1, 1); PG8_STAGE(PG8_SB(1, 0), b3, voffB);
            PG8_BAR; PG8_WAIT_L(0); PG8_MMA(0, 1, At, B1); PG8_BAR;
            PG8_LDA(At, 1, 1); PG8_STAGE(PG8_SA(1, 0), a3, voffA);
            PG8_BAR; PG8_WAIT_L(0); PG8_MMA(1, 0, At, B0); PG8_BAR; PG8_SCHED;
            PG8_STAGE(PG8_SB(1, 1), b3 + hstep, voffB);
            PG8_WAIT_V(6); PG8_BAR; PG8_MMA(1, 1, At, B1); PG8_BAR;
            }
        }
        if constexpr (ALIGN_EPI) { if (wr == 0) PG8_BAR; }
        if constexpr (!Epi::AFTER_DRAIN) { E(acc, cur, wr, wc, fr, fq); S.done(cur); }
        if (!has_next) break;
#pragma unroll
        for (int a = 0; a < 2; ++a)
#pragma unroll
            for (int b = 0; b < 2; ++b)
#pragma unroll
                for (int m = 0; m < 4; ++m)
#pragma unroll
                    for (int n = 0; n < 2; ++n) acc[a][b][m][n] = (f32x4){0.f, 0.f, 0.f, 0.f};
        cur = nxt; cA = nA; cB = nB; ++ui;
        if constexpr (ALIGN_EPI) { if (wr == 1) PG8_BAR; }
    }
    PG8_WAIT_V(0);
    if constexpr (!ALIGN_EPI) { if (wr == 0) PG8_BAR; }
    PG8_BAR;
    if constexpr (Epi::AFTER_DRAIN) { E.fused(acc, cur, wr, wc, fr, fq, lds, wid, lane); S.done(cur); }
#undef PG8_SA
#undef PG8_SB
#undef PG8_STAGE
#undef PG8_LDA
#undef PG8_LDB
#undef PG8_MMA
#undef PG8_WAIT_V
#undef PG8_WAIT_L
#undef PG8_BAR
#undef PG8_SCHED
}
}
constexpr int NWAVES = 8;
constexpr int BATCH = 4, SEQ = 8192, D = 2048, M = BATCH * SEQ, NIN = 4096, LW = 1024, CHUNK = 128, NCHUNK = SEQ / CHUNK;
constexpr int NEXP = 16384;
#ifndef MK_N_LAUNCHES
#define MK_N_LAUNCHES 1
#endif
constexpr int N_LAUNCHES = MK_N_LAUNCHES;
constexpr int PER_PHASE = 11;
constexpr size_t MiB = 1u << 20;
constexpr size_t WS_CTL = 48 * MiB, CTL_ZERO_BYTES = 5 * MiB;
constexpr size_t WS_ROWSS = WS_CTL + 512 * 1024;
constexpr size_t WS_WIN = 2 * MiB, WS_WOUT = 18 * MiB, WS_WQ = 26 * MiB, WS_LRUW = 34 * MiB, WS_WSB = 35 * MiB, WS_AGG = 49 * MiB;
constexpr size_t WS_U = 64 * MiB, WS_V = 128 * MiB, WS_XN = 192 * MiB  , WS_Z = 320 * MiB  ;
constexpr size_t WS_HB = 576 * MiB, WS_IDS = 704 * MiB, WS_GATES = 720 * MiB, WS_PAIRS = 736 * MiB, WS_HBT = 752 * MiB, WS_END = 884 * MiB;
constexpr size_t WS_USCALE = 40 * MiB, WS_VSCALE = 41 * MiB;
constexpr size_t WS_HSCALE = 44 * MiB, WS_CARRY = 45 * MiB;
constexpr size_t WS_H8 = WS_XN, WS_PART = WS_XN + 64 * MiB;
constexpr size_t WS_ASCALE = 42 * MiB, WS_KH = 43 * MiB;
constexpr size_t WS_IDW = WS_PAIRS, WS_AW = 880 * MiB;
constexpr size_t WS_ROWSS2 = WS_CTL + 640 * 1024;
constexpr size_t WS_Y = WS_Z;
constexpr int CW_BAR = 4096;
constexpr size_t WS_HQ8 = WS_Z + 128 * MiB, WS_WS3 = 46 * MiB + 128 * 1024, WS_CMAX3 = WS_CTL + 768 * 1024 + 32768;
constexpr size_t WS_MIX8 = WS_Z + 128 * MiB, WS_MIXS = 47 * MiB, WS_WS2 = 46 * MiB + 64 * 1024, WS_CMAX2 = WS_CTL + 768 * 1024 + 16384;
constexpr size_t WS_XS = 45 * MiB, WS_WS1 = 46 * MiB, WS_CMAX = WS_CTL + 768 * 1024;
constexpr int CW_LRUF = 8192;
constexpr int RING_BYTES = 131072;
constexpr int LDSCTL_OFF = 143360, MISC_OFF = LDSCTL_OFF + 320;
constexpr int LDS_BYTES = 147456;
#define GAS __attribute__((address_space(1)))
#define LAS __attribute__((address_space(3)))
typedef unsigned short bf16;
typedef unsigned v4u __attribute__((ext_vector_type(4)));
typedef float f32x4 __attribute__((ext_vector_type(4)));
typedef short bf16x8 __attribute__((ext_vector_type(8)));
typedef GAS unsigned gu32;
typedef GAS unsigned long long gu64;
#define RLX_AGENT __ATOMIC_RELAXED, __HIP_MEMORY_SCOPE_AGENT
#define LDS_WAIT() asm volatile("s_waitcnt lgkmcnt(0)" ::: "memory")
#define VM_WAIT() asm volatile("s_waitcnt vmcnt(0)" ::: "memory")
__device__ __forceinline__ unsigned long long rt() { return __builtin_amdgcn_s_memrealtime(); }
__device__ __forceinline__ unsigned pk2(float lo, float hi) { unsigned r; asm("v_cvt_pk_bf16_f32 %0, %1, %2" : "=v"(r) : "v"(lo), "v"(hi)); return r; }
__device__ __forceinline__ unsigned f2bf(float f) { return pk2(f, 0.0f); }

#define XB_TMO      128
#define XB_XCNT(j)  (256  + 64 * (j))
#define XB_XSUB(j)  (1280 + 64 * (j))
#define XB_XGEN(j)  (2304 + 64 * (j))
#define XB_TOP      3328
#define XB_TOPGEN   3392
#define XCD_BAR_WORDS 3456
#define XB_SPIN_CAP (1u << 18)

__device__ __forceinline__ unsigned xb_ld(unsigned* p)              { return __hip_atomic_load(p, __ATOMIC_RELAXED, __HIP_MEMORY_SCOPE_AGENT); }
__device__ __forceinline__ unsigned xb_add(unsigned* p, unsigned v) { return __hip_atomic_fetch_add(p, v, __ATOMIC_RELAXED, __HIP_MEMORY_SCOPE_AGENT); }
__device__ __forceinline__ unsigned xb_xcc_id() { return (unsigned)__builtin_amdgcn_s_getreg((3 << 11) | 20) & 0xFu; }
#define XB_SPIN(cond, bar) do { unsigned _sp = 0; while (cond) { __builtin_amdgcn_s_sleep(1); \
    if ((++_sp & 255u) == 0u) { if (xb_ld(&(bar)[XB_TMO])) break; if (_sp > XB_SPIN_CAP) { atomicAdd(&(bar)[XB_TMO], 1u); break; } } } } while (0)

struct XcdBarrier {
    unsigned* bar; unsigned x;
    volatile LAS unsigned* st;
};

__device__ __forceinline__ XcdBarrier xcd_barrier_post(unsigned* bar, volatile LAS unsigned* st) {
    XcdBarrier b; b.bar = bar; b.x = xb_xcc_id(); b.st = st;
    if (threadIdx.x == 0) (void)xb_add(&bar[XB_XCNT(b.x)], 1u);
    return b;
}
__device__ __forceinline__ void xcd_barrier_complete(unsigned* bar, unsigned x, unsigned& nloc, unsigned& nx) {
    const unsigned G = gridDim.x * gridDim.y * gridDim.z;
    unsigned sum, cnt, mine, sp = 0u;
    for (;;) {
        sum = 0u; cnt = 0u; mine = 0u;
#pragma unroll
        for (unsigned j = 0; j < 16; ++j) { const unsigned c = xb_ld(&bar[XB_XCNT(j)]); sum += c; cnt += (c > 0u) ? 1u : 0u; mine = (j == x) ? c : mine; }
        if (sum == G) break;
        __builtin_amdgcn_s_sleep(1);
        if ((++sp & 255u) == 0u) { if (xb_ld(&bar[XB_TMO])) break; if (sp > XB_SPIN_CAP) { atomicAdd(&bar[XB_TMO], 1u); break; } }
    }
    nloc = mine > 0u ? mine : 1u; nx = cnt > 0u ? cnt : 1u;
}

__device__ __forceinline__ void xcd_barrier(const XcdBarrier& b) {
    asm volatile("s_waitcnt vmcnt(0)" ::: "memory");
    __syncthreads();
    if (threadIdx.x == 0) {
        unsigned* bar = b.bar;
        __builtin_amdgcn_s_waitcnt(0);
        unsigned nloc = b.st[0], nx = b.st[1];
        if (nloc == 0u) { xcd_barrier_complete(bar, b.x, nloc, nx); b.st[0] = nloc; b.st[1] = nx; }
        const unsigned old = xb_add(&bar[XB_XSUB(b.x)], 1u);
        const unsigned gen = old / nloc;
        if (old + 1u == (gen + 1u) * nloc) {
            __builtin_amdgcn_fence(__ATOMIC_RELEASE, "agent");
            asm volatile("s_waitcnt vmcnt(0)" ::: "memory");
            const unsigned og = xb_add(&bar[XB_TOP], 1u);
            const unsigned tg = og / nx;
            if (og + 1u == (tg + 1u) * nx) xb_add(&bar[XB_TOPGEN], 1u);
            else XB_SPIN(xb_ld(&bar[XB_TOPGEN]) == tg, bar);
            __builtin_amdgcn_fence(__ATOMIC_ACQUIRE, "agent");
            xb_add(&bar[XB_XGEN(b.x)], 1u);
            asm volatile("s_waitcnt vmcnt(0)" ::: "memory");
        } else {
            XB_SPIN(xb_ld(&bar[XB_XGEN(b.x)]) == gen, bar);
            __builtin_amdgcn_fence(__ATOMIC_ACQUIRE, "agent");
            asm volatile("s_waitcnt vmcnt(0)" ::: "memory");
        }
    }
    __syncthreads();
}
typedef unsigned v2u __attribute__((ext_vector_type(2)));
typedef float f32x2 __attribute__((ext_vector_type(2)));
struct Args { const float* in[21]; float* out; unsigned char* ws; int ph_lo, ph_hi; };
struct Frame {
    const Args& A;
    LAS unsigned char* lds;
    volatile LAS unsigned* MISC;
    gu32* ctl;
    unsigned char* ws;
    int tid, lane, wave, vcu, G;
    __device__ __forceinline__ Frame(const Args& a) : A(a) {}
#define WSP(name, type, off) __device__ __forceinline__ type* name() const { return (type*)(ws + (off)); }
    WSP(WIN, bf16, WS_WIN) WSP(WOUT, bf16, WS_WOUT) WSP(WQ, bf16, WS_WQ) WSP(LRUW, bf16, WS_LRUW) WSP(WSB, bf16, WS_WSB)
    WSP(XN, bf16, WS_XN) WSP(MIX, bf16, WS_XN) WSP(Z, bf16, WS_Z) WSP(HB, bf16, WS_HB) WSP(HBT, bf16, WS_HBT)
    WSP(U8, unsigned char, WS_U) WSP(V8T, unsigned char, WS_V)
    WSP(ROWSS, float, WS_ROWSS) WSP(ROWSS2, float, WS_ROWSS2) WSP(QH, bf16, WS_Z) WSP(QL, bf16, WS_Z + 128 * MiB) WSP(KH, bf16, WS_KH) WSP(KL, bf16, WS_KH + 512 * 1024) WSP(AGG, float, WS_AGG) WSP(CARRY, float, WS_CARRY) WSP(AU, unsigned, WS_HB) WSP(GATES, float, WS_GATES)
    WSP(USCALE, float, WS_USCALE) WSP(VSCALE, float, WS_VSCALE) WSP(Y, bf16, WS_Y) WSP(IDS, int, WS_IDS) WSP(ASCALE, float, WS_ASCALE) WSP(IDW, v4u, WS_IDW) WSP(AW, unsigned, WS_AW) WSP(H8, unsigned char, WS_H8) WSP(HSCALE, float, WS_HSCALE) WSP(PART, int, WS_PART)
#undef WSP
};
__device__ __forceinline__ float wave_sum(float v) {
#pragma unroll
    for (int o = 1; o < 64; o <<= 1) v += __shfl_xor(v, o);
    return v;
}
__device__ __forceinline__ float bf_lo(unsigned w) { return __builtin_bit_cast(float, w << 16); }
__device__ __forceinline__ float bf_hi(unsigned w) { return __builtin_bit_cast(float, w & 0xffff0000u); }
__device__ __forceinline__ float bf1(unsigned short h) { return __builtin_bit_cast(float, (unsigned)h << 16); }
__device__ __forceinline__ float sigmoidf_(float x) { return __builtin_amdgcn_rcpf(1.0f + __builtin_amdgcn_exp2f(-1.4426950409f * x)); }
using pg8::gelu_tanh;
__device__ __forceinline__ unsigned pack_i8x4(float a, float b, float c, float d) {
    const int ia = (int)__builtin_rintf(a), ib = (int)__builtin_rintf(b), ic = (int)__builtin_rintf(c), id = (int)__builtin_rintf(d);
    return (unsigned)(ia & 0xff) | ((unsigned)(ib & 0xff) << 8) | ((unsigned)(ic & 0xff) << 16) | ((unsigned)id << 24);
}

__device__ __forceinline__ void p0_transpose_item(const float* W, int K, int N, bf16* WT, const float* kscale, LAS float* scr, int item, int lane) {
    const int nblk = N / 32, kb = item / nblk, nb = item % nblk, k0 = 64 * kb, n0 = 32 * nb;
#pragma unroll 8
    for (int i = 0; i < 32; ++i) { const int kk = 2 * i + (lane >> 5); const float sc = kscale ? kscale[k0 + kk] : 1.0f; scr[kk * 33 + (lane & 31)] = W[(size_t)(k0 + kk) * N + n0 + (lane & 31)] * sc; }
    LDS_WAIT(); asm volatile("" ::: "memory");
    const int c = lane & 7;
#pragma unroll
    for (int j = 0; j < 4; ++j) { const int n = (lane >> 3) + 8 * j; const LAS float* s = scr + (8 * c) * 33 + n;
        v4u o; o.x = pk2(s[0 * 33], s[1 * 33]); o.y = pk2(s[2 * 33], s[3 * 33]); o.z = pk2(s[4 * 33], s[5 * 33]); o.w = pk2(s[6 * 33], s[7 * 33]);
        *(GAS v4u*)(WT + (size_t)(n0 + n) * K + k0 + 8 * c) = o; }
    LDS_WAIT(); asm volatile("" ::: "memory");
}
constexpr int P0W_ROW = 2052;
__device__ __forceinline__ void p0_weight_cols_i8(Frame& F, const float* W, int N, const float* gain, unsigned char* WT8, float* cscale, int nb) {
    const int tid = F.tid, cg = tid & 7, kq = tid >> 3, n0 = 32 * nb;
    LAS unsigned char* T = F.lds; LAS float* MX = (LAS float*)(F.lds + 32 * P0W_ROW); LAS float* CM = MX + 64 * 32;
    const float* wp = W + n0 + 4 * cg;
    f32x4 mx = (f32x4){0.f, 0.f, 0.f, 0.f};
#pragma unroll 2
    for (int it = 0; it < 8; ++it) {
#pragma unroll
        for (int r = 0; r < 4; ++r) { const int k = 4 * kq + 256 * it + r; const float gk = gain ? gain[k] : 1.0f; const f32x4 v = *(const GAS f32x4*)(wp + (size_t)k * N) * gk;
            mx.x = fmaxf(mx.x, fabsf(v.x)); mx.y = fmaxf(mx.y, fabsf(v.y)); mx.z = fmaxf(mx.z, fabsf(v.z)); mx.w = fmaxf(mx.w, fabsf(v.w)); } }
    *(LAS f32x4*)(MX + kq * 32 + 4 * cg) = mx;
    __syncthreads();
    if (tid < 32) { float m = 0.f;
#pragma unroll 8
        for (int i = 0; i < 64; ++i) m = fmaxf(m, MX[i * 32 + tid]);
        CM[tid] = m; cscale[n0 + tid] = m * (1.0f / 127.0f); }
    __syncthreads();
    const f32x4 cm = *(const LAS f32x4*)(CM + 4 * cg);
    const f32x4 q = (f32x4){cm.x > 0.f ? 127.0f / cm.x : 0.f, cm.y > 0.f ? 127.0f / cm.y : 0.f, cm.z > 0.f ? 127.0f / cm.z : 0.f, cm.w > 0.f ? 127.0f / cm.w : 0.f};
#pragma unroll 2
    for (int it = 0; it < 8; ++it) { f32x4 v[4];
#pragma unroll
        for (int r = 0; r < 4; ++r) { const int k = 4 * kq + 256 * it + r; const float gk = gain ? gain[k] : 1.0f; v[r] = *(const GAS f32x4*)(wp + (size_t)k * N) * gk * q; }
        LAS unsigned char* tp = T + (4 * cg) * P0W_ROW + 4 * kq + 256 * it;
        *(LAS unsigned*)(tp) = pack_i8x4(v[0].x, v[1].x, v[2].x, v[3].x); *(LAS unsigned*)(tp + P0W_ROW) = pack_i8x4(v[0].y, v[1].y, v[2].y, v[3].y);
        *(LAS unsigned*)(tp + 2 * P0W_ROW) = pack_i8x4(v[0].z, v[1].z, v[2].z, v[3].z); *(LAS unsigned*)(tp + 3 * P0W_ROW) = pack_i8x4(v[0].w, v[1].w, v[2].w, v[3].w); }
    __syncthreads();
#pragma unroll
    for (int i = 0; i < 16; ++i) { const int id = tid + 512 * i, row = id >> 8, ch = id & 255;
        const LAS unsigned* sp = (const LAS unsigned*)(T + row * P0W_ROW + ch * 8);
        *(GAS v2u*)(WT8 + (size_t)(n0 + row) * D + ch * 8) = (v2u){sp[0], sp[1]}; }
    __syncthreads();
}
__device__ __forceinline__ void p0_prologue(Frame& F) {
    LAS float* scr = (LAS float*)(F.lds + F.wave * 16384);
    const int gw = F.vcu * NWAVES + F.wave, NGW = F.G * NWAVES, lane = F.lane;
    for (int blk = F.vcu; blk < 256; blk += F.G) {
        if (blk < 128) p0_weight_cols_i8(F, F.A.in[2], NIN, F.A.in[1], (unsigned char*)F.WIN(), (float*)(F.ws + WS_WS1), blk);
        else if (blk < 192) p0_weight_cols_i8(F, F.A.in[14], D, nullptr, (unsigned char*)F.WOUT(), (float*)(F.ws + WS_WS2), blk - 128);
        else p0_weight_cols_i8(F, F.A.in[16], D, F.A.in[15], (unsigned char*)F.WQ(), (float*)(F.ws + WS_WS3), blk - 192);
    }
    constexpr int I_LRU = 32 * 8;
    for (int it = gw; it < I_LRU; it += NGW) {
        const int r = it;
        { const int mi = r >> 3, sub = r & 7, gate = mi >> 4, rest = mi & 15;
          const float* src = (gate ? F.A.in[7] : F.A.in[5]) + (size_t)rest * 16384;
          p0_transpose_item(src, 128, 128, F.LRUW() + (size_t)mi * 16384, nullptr, scr, sub, lane); }
    }
    const size_t gt = (size_t)gw * 64 + lane, NGT = (size_t)NGW * 64;
    {
        const float* g2 = F.A.in[15];
        f32x4 gg[8];
#pragma unroll
        for (int j = 0; j < 8; ++j) gg[j] = *(const GAS f32x4*)(g2 + j * 256 + lane * 4);
        for (int e = gw; e < NEXP; e += NGW) {
            const GAS f32x4* ur = (const GAS f32x4*)(F.A.in[18] + (size_t)e * D) + lane;
            f32x4 v[8]; float ss = 0.f;
#pragma unroll
            for (int j = 0; j < 8; ++j) { v[j] = __builtin_nontemporal_load(ur + 64 * j) * gg[j]; ss += (v[j].x * v[j].x + v[j].y * v[j].y) + (v[j].z * v[j].z + v[j].w * v[j].w); }
            const float rms = __builtin_amdgcn_sqrtf(wave_sum(ss) * (1.0f / D));
            const float sc = rms > 0.f ? 7.0f / (2.8f * rms) : 1.0f;
            GAS unsigned* o4 = (GAS unsigned*)(F.U8() + (size_t)e * 1024) + (lane >> 1);
#pragma unroll
            for (int j = 0; j < 8; ++j) {
                const int c0 = (int)fminf(fmaxf(__builtin_rintf(v[j].x * sc), -7.f), 7.f) & 15, c1 = (int)fminf(fmaxf(__builtin_rintf(v[j].y * sc), -7.f), 7.f) & 15;
                const int c2 = (int)fminf(fmaxf(__builtin_rintf(v[j].z * sc), -7.f), 7.f) & 15, c3 = (int)fminf(fmaxf(__builtin_rintf(v[j].w * sc), -7.f), 7.f) & 15;
                const unsigned cw = (unsigned)c0 | ((unsigned)c1 << 8) | ((unsigned)c2 << 16) | ((unsigned)c3 << 24);
                const unsigned pw = (unsigned)__shfl_xor((int)cw, 1);
                if ((lane & 1) == 0) __builtin_nontemporal_store(cw | (pw << 4), o4 + 32 * j);
            }
            if (lane == 0) F.USCALE()[2 * e] = rms > 0.f ? 2.8f * rms * (1.0f / 7.0f) : 1.0f;
        }
    }
    __syncthreads();
    for (int un = blockIdx.x; un < NEXP / 64; un += F.G) {
        const int e0 = un * 64;
        for (int rr = 0; rr < 8; ++rr) {
            const int el = F.wave * 8 + rr, e = e0 + el;
            const GAS f32x4* vr = (const GAS f32x4*)(F.A.in[19] + (size_t)e * D) + lane;
            f32x4 v[8]; float mx = 0.f;
#pragma unroll
            for (int j = 0; j < 8; ++j) { v[j] = __builtin_nontemporal_load(vr + 64 * j); mx = fmaxf(mx, fmaxf(fmaxf(fabsf(v[j].x), fabsf(v[j].y)), fmaxf(fabsf(v[j].z), fabsf(v[j].w)))); }
#pragma unroll
            for (int o = 1; o < 64; o <<= 1) mx = fmaxf(mx, __shfl_xor(mx, o));
            const float sc = mx > 0.f ? 127.0f / mx : 1.0f;
#pragma unroll
            for (int j = 0; j < 8; ++j) *(LAS unsigned*)(F.lds + el * 2056 + j * 256 + lane * 4) = pack_i8x4(v[j].x * sc, v[j].y * sc, v[j].z * sc, v[j].w * sc);
            if (lane == 0) F.USCALE()[2 * e + 1] = mx > 0.f ? mx * (1.0f / 127.0f) : 1.0f;
        }
        __syncthreads();
        for (int cc = 0; cc < 32; ++cc) { const int c = F.wave * 32 + cc;
            const v2u w = *(const LAS v2u*)(F.lds + lane * 2056 + c * 8);
            __builtin_nontemporal_store(w, (v2u*)(F.V8T() + ((size_t)c * NEXP + e0 + lane) * 8)); }
        __syncthreads();
    }
    for (size_t ch = gt; ch < (size_t)8 * 128 * 128 / 8; ch += NGT) {
        const size_t e0 = ch * 8;
        const f32x4 a = *(const GAS f32x4*)(F.A.in[12] + e0), b = *(const GAS f32x4*)(F.A.in[12] + e0 + 4);
        v4u o; o.x = pk2(a.x, a.y); o.y = pk2(a.z, a.w); o.z = pk2(b.x, b.y); o.w = pk2(b.z, b.w);
        *(GAS v4u*)(F.WSB() + e0) = o;
    }
    for (size_t ch = gt; ch < (size_t)16 * 128 * 128 / 8; ch += NGT) {
        const size_t e0 = ch * 8;
        const f32x4 a = *(const GAS f32x4*)(F.A.in[17] + e0), b = *(const GAS f32x4*)(F.A.in[17] + e0 + 4);
        v4u hi; hi.x = pk2(a.x, a.y); hi.y = pk2(a.z, a.w); hi.z = pk2(b.x, b.y); hi.w = pk2(b.z, b.w);
        *(GAS v4u*)(F.KH() + e0) = hi;
    }
    for (int m = gw; m < M; m += NGW) {
        const GAS f32x4* xr = (const GAS f32x4*)(F.A.in[0] + (size_t)m * D) + lane;
        f32x4 v[8]; float s = 0.f;
#pragma unroll
        for (int j = 0; j < 8; ++j) { v[j] = __builtin_nontemporal_load(xr + 64 * j); s += (v[j].x * v[j].x + v[j].y * v[j].y) + (v[j].z * v[j].z + v[j].w * v[j].w); }
        const float rstd = __builtin_amdgcn_rsqf(wave_sum(s) * (1.f / D) + 1e-6f);
        float mx = 0.f;
#pragma unroll
        for (int j = 0; j < 8; ++j) mx = fmaxf(mx, fmaxf(fmaxf(fabsf(v[j].x), fabsf(v[j].y)), fmaxf(fabsf(v[j].z), fabsf(v[j].w))));
#pragma unroll
        for (int o = 1; o < 64; o <<= 1) mx = fmaxf(mx, __shfl_xor(mx, o));
        const float q = mx > 0.f ? 127.0f / mx : 0.f;
        GAS unsigned* o4 = (GAS unsigned*)((unsigned char*)F.XN() + (size_t)m * D) + lane;
#pragma unroll
        for (int j = 0; j < 8; ++j) o4[64 * j] = pack_i8x4(v[j].x * q, v[j].y * q, v[j].z * q, v[j].w * q);
        if (lane == 0) ((float*)(F.ws + WS_XS))[m] = mx * rstd * (1.0f / 127.0f);
    }
}
constexpr int LRU_XR = 0, LRU_XC = 33792, LRU_GR = 33792 + 40960;
constexpr float LOG2E = 1.4426950408889634f;
__device__ __forceinline__ int xc_off(int tok, int ch) { return tok * 320 + (tok >> 5) * 16 + ch * 2; }
constexpr int LRU_PT = LRU_GR + 33792, LRU_CR = LRU_PT + 8192;
template <int DIR>
__device__ __forceinline__ void lru_scan_dir(Frame& F, int b, int c, int h, const bf16x8 (&Ba)[4], const bf16x8 (&Bx)[4], f32x4 (&R)[8], f32x4 (&I)[8], float& EA, float& EB) {
    const int lane = F.lane, w = F.wave, fr = lane & 15, fq = lane >> 4;
    LAS unsigned char* XC = F.lds + LRU_XC;
    const int chl = 16 * w + fr, chg = h * 128 + chl;
    {
        const float ba = F.A.in[6][DIR * LW + chg], bx = F.A.in[8][DIR * LW + chg], lam = F.A.in[9][DIR * LW + chg];
        const float cl = -8.0f * log1pf(__expf(-lam)) * LOG2E;
        const float nba = -LOG2E * ba, nbx = -LOG2E * bx;
        const int arow = (fr >> 2) * 32 + (fr & 3);
#define LRU_MMA(m_) do { R[m_] = (f32x4){0.f, 0.f, 0.f, 0.f}; I[m_] = (f32x4){0.f, 0.f, 0.f, 0.f}; \
            _Pragma("unroll") for (int ks = 0; ks < 4; ++ks) { const bf16x8 a = *(const LAS bf16x8*)(XC + xc_off(arow + 4 * (m_), 32 * ks + 8 * fq)); \
                R[m_] = __builtin_amdgcn_mfma_f32_16x16x32_bf16(a, Ba[ks], R[m_], 0, 0, 0); I[m_] = __builtin_amdgcn_mfma_f32_16x16x32_bf16(a, Bx[ks], I[m_], 0, 0, 0); } } while (0)
        LRU_MMA(0);
#pragma unroll
        for (int m = 0; m < 8; ++m) {
            if (m + 1 < 8) LRU_MMA(m + 1);
#pragma unroll
            for (int j = 0; j < 4; ++j) {
                const float r = __builtin_amdgcn_rcpf(1.0f + __builtin_amdgcn_exp2f(__builtin_fmaf(R[m][j], -LOG2E, nba))), ig = __builtin_amdgcn_rcpf(1.0f + __builtin_amdgcn_exp2f(__builtin_fmaf(I[m][j], -LOG2E, nbx)));
                const float a = __builtin_amdgcn_exp2f(cl * r);
                const float xc = bf1(*(const LAS unsigned short*)(XC + xc_off(32 * fq + 4 * m + j, chl)));
                R[m][j] = a; I[m][j] = __builtin_amdgcn_sqrtf(fmaxf(1.0f - a * a, 0.0f)) * (ig * xc);
            }
            __builtin_amdgcn_sched_barrier(0);
        }
#undef LRU_MMA
    }
    float P = 1.f, L = 0.f;
#pragma unroll
    for (int mm = 0; mm < 8; ++mm) {
        const int m = DIR == 0 ? mm : 7 - mm;
#pragma unroll
        for (int jj = 0; jj < 4; ++jj) {
            const int j = DIR == 0 ? jj : 3 - jj;
            const float a = R[m][j], u = I[m][j];
            L = a * L + u; P = a * P;
            R[m][j] = P; I[m][j] = L;
        }
    }
    const int src1 = DIR == 0 ? lane - 16 : lane + 16, src2 = DIR == 0 ? lane - 32 : lane + 32;
    const bool v1 = DIR == 0 ? (fq >= 1) : (fq <= 2), v2 = DIR == 0 ? (fq >= 2) : (fq <= 1);
    float A = P, B = L;
    { const float pa = __shfl(A, src1), pb = __shfl(B, src1); if (v1) { B = A * pb + B; A = A * pa; } }
    { const float pa = __shfl(A, src2), pb = __shfl(B, src2); if (v2) { B = A * pb + B; A = A * pa; } }
    EA = __shfl(A, src1); EB = __shfl(B, src1); if (!v1) { EA = 1.f; EB = 0.f; }
    const bool lastlane = DIR == 0 ? (fq == 3) : (fq == 0);
    if (lastlane) {
        const unsigned long long word = (unsigned long long)(__builtin_bit_cast(unsigned, A) | 1u) | ((unsigned long long)__builtin_bit_cast(unsigned, B) << 32);
        __hip_atomic_store((unsigned long long*)F.AGG() + (size_t)((b * 2 + DIR) * NCHUNK + c) * LW + chg, word, RLX_AGENT);
    }
}
__device__ __forceinline__ void lru_decode(int unit, int& b, int& c, int& h) { const int rnd = unit >> 8, within = unit & 255; b = rnd >> 1; h = (rnd & 1) * 4 + (within & 3); c = within >> 2; }
__device__ __forceinline__ void lru_prefetch(Frame& F, int unit, int tid, v4u (&xr)[5]) {
    int b, c, h; lru_decode(unit, b, c, h);
#pragma unroll
    for (int i = 0; i < 5; ++i) { const int p = tid + 512 * i, r = p >> 4, cg = p & 15; const int s = c * CHUNK - 2 + r; xr[i] = (v4u){0u, 0u, 0u, 0u};
        if (p < 131 * 16 && s >= 0 && s < SEQ) xr[i] = *(const GAS v4u*)(F.Z() + ((size_t)b * SEQ + s) * NIN + h * 128 + cg * 8); }
}
__device__ __forceinline__ void lru_conv(Frame& F, int unit, int tid, const v4u (&xr)[5]) {
    int b, c, h; lru_decode(unit, b, c, h);
    LAS unsigned char* XR = F.lds + LRU_XR; LAS unsigned char* XC = F.lds + LRU_XC;
#pragma unroll
    for (int i = 0; i < 5; ++i) { const int p = tid + 512 * i, r = p >> 4, cg = p & 15; if (p < 131 * 16) *(LAS v4u*)(XR + r * 256 + cg * 16) = xr[i]; }
    __syncthreads();
    const int ch2 = tid & 63, tg = tid >> 6, chg = h * 128 + 2 * ch2;
    float w0[4], w1[4];
#pragma unroll
    for (int k = 0; k < 4; ++k) { w0[k] = F.A.in[3][k * LW + chg]; w1[k] = F.A.in[3][k * LW + chg + 1]; }
    const float b0 = F.A.in[4][chg], b1 = F.A.in[4][chg + 1];
    float x0[4], x1[4];
#pragma unroll
    for (int k = 0; k < 3; ++k) { const unsigned u = *(const LAS unsigned*)(XR + (16 * tg + k) * 256 + ch2 * 4); x0[k] = bf_lo(u); x1[k] = bf_hi(u); }
#pragma unroll
    for (int j = 0; j < 16; ++j) {
        const unsigned u = *(const LAS unsigned*)(XR + (16 * tg + j + 3) * 256 + ch2 * 4); x0[3] = bf_lo(u); x1[3] = bf_hi(u);
        const float y0 = b0 + ((w0[0] * x0[0] + w0[1] * x0[1]) + (w0[2] * x0[2] + w0[3] * x0[3]));
        const float y1 = b1 + ((w1[0] * x1[0] + w1[1] * x1[1]) + (w1[2] * x1[2] + w1[3] * x1[3]));
        *(LAS unsigned*)(XC + xc_off(16 * tg + j, 2 * ch2)) = pk2(y0, y1);
        x0[0] = x0[1]; x0[1] = x0[2]; x0[2] = x0[3]; x1[0] = x1[1]; x1[1] = x1[2]; x1[2] = x1[3];
    }
}
__device__ __forceinline__ void lru_fused_unit(Frame& F, int unit, int next, v4u (&xr)[5]) {
    int b, c, h; lru_decode(unit, b, c, h);
    int tid = F.tid; asm volatile("" : "+v"(tid));
    const int lane = tid & 63, w = F.wave, fr = lane & 15, fq = lane >> 4;
    const size_t t0 = (size_t)b * SEQ + (size_t)c * CHUNK;
    LAS unsigned char* GR = F.lds + LRU_GR;
    bf16x8 Ba0[4], Bx0[4], Ba1[4], Bx1[4];
    {
        const bf16* wb = F.LRUW() + (size_t)h * 16384 + (size_t)(16 * w + fr) * 128 + 8 * fq;
#pragma unroll
        for (int ks = 0; ks < 4; ++ks) { Ba0[ks] = *(const GAS bf16x8*)(wb + 32 * ks); Ba1[ks] = *(const GAS bf16x8*)(wb + (size_t)8 * 16384 + 32 * ks);
            Bx0[ks] = *(const GAS bf16x8*)(wb + (size_t)16 * 16384 + 32 * ks); Bx1[ks] = *(const GAS bf16x8*)(wb + (size_t)24 * 16384 + 32 * ks); }
    }
    f32x4 R0[8], I0[8], R1[8], I1[8]; float EA0, EB0, EA1, EB1;
    lru_scan_dir<0>(F, b, c, h, Ba0, Bx0, R0, I0, EA0, EB0);
    asm volatile("" ::: "memory"); __builtin_amdgcn_sched_barrier(0);
    if (next >= 0) lru_prefetch(F, next, tid, xr);
    lru_scan_dir<1>(F, b, c, h, Ba1, Bx1, R1, I1, EA1, EB1);
    {
        v2u gr[8];
#pragma unroll
        for (int i = 0; i < 8; ++i) { const int p = tid + 512 * i, r = p >> 5, cg = p & 31; gr[i] = *(const GAS v2u*)(F.Z() + (t0 + r) * NIN + LW + h * 128 + cg * 4); }
        if (next >= 0) lru_conv(F, next, tid, xr); else __syncthreads();
#pragma unroll
        for (int i = 0; i < 8; ++i) { const int p = tid + 512 * i, r = p >> 5, cg = p & 31; *(LAS v2u*)(GR + r * 264 + cg * 8) = gr[i]; }
    }
    {
        const int ch = tid & 127, kq = tid >> 7;
        const unsigned long long* ab = (const unsigned long long*)F.AGG() + (size_t)b * 2 * NCHUNK * LW + h * 128 + ch;
        unsigned long long v[16];
#pragma unroll
        for (int i = 0; i < 16; ++i) { const int k = min(16 * kq + i, 62); const int row = k < c ? k : NCHUNK + k + 1;
            v[i] = __hip_atomic_load(ab + (size_t)row * LW, RLX_AGENT); }
        for (unsigned sp = 0; sp < (1u << 16); ++sp) {
            bool bad = false;
#pragma unroll
            for (int i = 0; i < 16; ++i) if (v[i] == 0ull) { const int k = min(16 * kq + i, 62); const int row = k < c ? k : NCHUNK + k + 1;
                v[i] = __hip_atomic_load(ab + (size_t)row * LW, RLX_AGENT); bad = bad || (v[i] == 0ull); }
            if (!bad) break;
            __builtin_amdgcn_s_sleep(2);
        }
        float fa = 1.f, fb = 0.f, ga = 1.f, gb = 0.f;
#pragma unroll
        for (int i = 0; i < 16; ++i) { const int k = 16 * kq + i; const float A = __builtin_bit_cast(float, (unsigned)v[i]), B = __builtin_bit_cast(float, (unsigned)(v[i] >> 32));
            if (k < c) { fb = A * fb + B; fa = A * fa; } }
#pragma unroll
        for (int i = 15; i >= 0; --i) { const int k = 16 * kq + i; const float A = __builtin_bit_cast(float, (unsigned)v[i]), B = __builtin_bit_cast(float, (unsigned)(v[i] >> 32));
            if (k >= c && k < 63) { gb = A * gb + B; ga = A * ga; } }
        *(LAS f32x4*)(F.lds + LRU_PT + (kq * 128 + ch) * 16) = (f32x4){fa, fb, ga, gb};
    }
    __syncthreads();
    {
        const int chl = 16 * w + fr;
        float c0, c1;
        { f32x4 q[4];
#pragma unroll
          for (int k = 0; k < 4; ++k) q[k] = *(const LAS f32x4*)(F.lds + LRU_PT + (k * 128 + chl) * 16);
          c0 = q[0].y; c0 = q[1].x * c0 + q[1].y; c0 = q[2].x * c0 + q[2].y; c0 = q[3].x * c0 + q[3].y;
          c1 = q[3].w; c1 = q[2].z * c1 + q[2].w; c1 = q[1].z * c1 + q[1].w; c1 = q[0].z * c1 + q[0].w; }
        const float hin0 = EA0 * c0 + EB0, hin1 = EA1 * c1 + EB1;
        unsigned short gv_[8][4];
#pragma unroll
        for (int m = 0; m < 8; ++m)
#pragma unroll
            for (int j = 0; j < 4; ++j) gv_[m][j] = *(const LAS unsigned short*)(GR + (32 * fq + 4 * m + j) * 264 + chl * 2);
#pragma unroll
        for (int m = 0; m < 8; ++m)
#pragma unroll
            for (int j = 0; j < 4; ++j) { const float hs = (R0[m][j] * hin0 + I0[m][j]) + (R1[m][j] * hin1 + I1[m][j]);
                *(LAS unsigned short*)(GR + (32 * fq + 4 * m + j) * 264 + chl * 2) = (unsigned short)f2bf(bf1(gv_[m][j]) * hs); }
        __syncthreads();
        for (int p = tid; p < 128 * 32; p += 512) { const int r = p >> 5, cg = p & 31;
            *(GAS v2u*)(F.MIX() + (t0 + r) * D + h * 128 + cg * 4) = *(const LAS v2u*)(GR + r * 264 + cg * 8); }
    }
    __syncthreads();
}
__device__ __forceinline__ void mixq_issue(Frame& F, int t, int lane, v4u (&a)[4]) {
    const bf16* hp = F.MIX() + (size_t)t * D + lane * 16;
#pragma unroll
    for (int c = 0; c < 2; ++c)
#pragma unroll
        for (int q = 0; q < 2; ++q) a[c * 2 + q] = *(const GAS v4u*)(hp + c * 1024 + q * 8);
}
__device__ __forceinline__ void mixq_finish(Frame& F, int t, int lane, const v4u (&a)[4]) {
    float x[32]; float mx = 0.f;
#pragma unroll
    for (int i = 0; i < 4; ++i) { x[8 * i] = bf_lo(a[i].x); x[8 * i + 1] = bf_hi(a[i].x); x[8 * i + 2] = bf_lo(a[i].y); x[8 * i + 3] = bf_hi(a[i].y);
        x[8 * i + 4] = bf_lo(a[i].z); x[8 * i + 5] = bf_hi(a[i].z); x[8 * i + 6] = bf_lo(a[i].w); x[8 * i + 7] = bf_hi(a[i].w); }
#pragma unroll
    for (int i = 0; i < 32; ++i) mx = fmaxf(mx, fabsf(x[i]));
#pragma unroll
    for (int o = 1; o < 64; o <<= 1) mx = fmaxf(mx, __shfl_xor(mx, o));
    const float q = mx > 0.f ? 127.0f / mx : 0.f;
    unsigned char* ob = (unsigned char*)(F.ws + WS_MIX8) + (size_t)t * D + lane * 16;
#pragma unroll
    for (int c = 0; c < 2; ++c) { v4u o; unsigned w[4];
#pragma unroll
        for (int k = 0; k < 4; ++k) w[k] = pack_i8x4(x[c * 16 + 4 * k] * q, x[c * 16 + 4 * k + 1] * q, x[c * 16 + 4 * k + 2] * q, x[c * 16 + 4 * k + 3] * q);
        o.x = w[0]; o.y = w[1]; o.z = w[2]; o.w = w[3];
        *(GAS v4u*)(ob + c * 1024) = o; }
    if (lane == 0) ((float*)(F.ws + WS_MIXS))[t] = mx * (1.0f / 127.0f);
}
constexpr int GM_ST = 0, GM_BS = 1024, GM_VN = 2048, GM_GU = 2048 + 32768;
typedef short s16x4 __attribute__((ext_vector_type(4)));
__device__ __forceinline__ unsigned vn_off(unsigned row, unsigned ch) { return 256u * row + 16u * (ch ^ (((row & 3u) << 2) | ((row >> 2) & 3u))); }
struct GmlpRegs { v4u a[4]; v2u gu[8]; bf16x8 Af[4]; f32x4 g0, g1, b0, b1; float bs; };
__device__ __forceinline__ void gmlp_load(Frame& F, size_t t0, int h, int tid, GmlpRegs& G) {
    const int lane = tid & 63, w = tid >> 6, fr = lane & 15, fq = lane >> 4;
#pragma unroll
    for (int i = 0; i < 4; ++i) { const int pid = tid + 512 * i, q = pid >> 4, cg = pid & 15; G.a[i] = *(const GAS v4u*)(F.Z() + (t0 + q) * NIN + 3 * LW + h * 128 + cg * 8); }
#pragma unroll
    for (int i = 0; i < 8; ++i) { const int pid = tid + 512 * i, r = pid >> 5, cg = pid & 31; G.gu[i] = *(const GAS v2u*)(F.Z() + (t0 + r) * NIN + 2 * LW + h * 128 + cg * 4); }
    { const int cg = tid & 15;
      G.g0 = *(const GAS f32x4*)(F.A.in[10] + h * 128 + cg * 8); G.g1 = *(const GAS f32x4*)(F.A.in[10] + h * 128 + cg * 8 + 4);
      G.b0 = *(const GAS f32x4*)(F.A.in[11] + h * 128 + cg * 8); G.b1 = *(const GAS f32x4*)(F.A.in[11] + h * 128 + cg * 8 + 4); }
    G.bs = F.A.in[13][h * 128 + (tid & 127)];
    const bf16* wsb = F.WSB() + (size_t)h * 16384 + (size_t)(16 * w + fr) * 128 + 8 * fq;
#pragma unroll
    for (int ks = 0; ks < 4; ++ks) G.Af[ks] = *(const GAS bf16x8*)(wsb + 32 * ks);
}
__device__ __forceinline__ void gmlp_unit(Frame& F, int unit) {
    int tid = F.tid; asm volatile("" : "+v"(tid));
    const int lane = tid & 63, w = F.wave, fr = lane & 15, fq = lane >> 4;
    const size_t t0 = (size_t)unit * CHUNK;
    LAS float* ST = (LAS float*)(F.lds + GM_ST); LAS float* BS = (LAS float*)(F.lds + GM_BS);
    LAS unsigned char* VN = F.lds + GM_VN; LAS unsigned char* GU = F.lds + GM_GU;
    GmlpRegs G;
    gmlp_load(F, t0, 0, tid, G);
#pragma unroll
    for (int rb = 0; rb < 2; ++rb) {
        v4u ra[8], rc[8];
#pragma unroll
        for (int rr = 0; rr < 8; ++rr) { const bf16* p = F.Z() + (t0 + 16 * w + 8 * rb + rr) * NIN + 3 * LW + lane * 8; ra[rr] = *(const GAS v4u*)p; rc[rr] = *(const GAS v4u*)(p + 512); }
#pragma unroll
        for (int rr = 0; rr < 8; ++rr) {
            const int row = 16 * w + 8 * rb + rr;
            const v4u a = ra[rr], b = rc[rr];
            float x[16] = {bf_lo(a.x), bf_hi(a.x), bf_lo(a.y), bf_hi(a.y), bf_lo(a.z), bf_hi(a.z), bf_lo(a.w), bf_hi(a.w),
                           bf_lo(b.x), bf_hi(b.x), bf_lo(b.y), bf_hi(b.y), bf_lo(b.z), bf_hi(b.z), bf_lo(b.w), bf_hi(b.w)};
            float s = 0.f;
#pragma unroll
            for (int i = 0; i < 16; ++i) s += x[i];
            const float mean = wave_sum(s) * (1.0f / LW);
            float q = 0.f;
#pragma unroll
            for (int i = 0; i < 16; ++i) { const float d = x[i] - mean; q += d * d; }
            const float rstd = __builtin_amdgcn_rsqf(wave_sum(q) * (1.0f / LW) + 1e-6f);
            if (lane == 0) { ST[2 * row] = mean; ST[2 * row + 1] = rstd; }
        }
    }
    __syncthreads();
    const unsigned trq = (unsigned)(lane & 15) >> 2, trp = (unsigned)lane & 3u;
    for (int h = 0; h < 8; ++h) {
#pragma unroll
        for (int i = 0; i < 4; ++i) { const int pid = tid + 512 * i, q = pid >> 4, cg = pid & 15;
            const v4u a = G.a[i];
            const float mean = ST[2 * q], rstd = ST[2 * q + 1];
            const f32x4 g0 = G.g0, g1 = G.g1, b0 = G.b0, b1 = G.b1;
            v4u o;
            o.x = pk2((bf_lo(a.x) - mean) * rstd * g0.x + b0.x, (bf_hi(a.x) - mean) * rstd * g0.y + b0.y);
            o.y = pk2((bf_lo(a.y) - mean) * rstd * g0.z + b0.z, (bf_hi(a.y) - mean) * rstd * g0.w + b0.w);
            o.z = pk2((bf_lo(a.z) - mean) * rstd * g1.x + b1.x, (bf_hi(a.z) - mean) * rstd * g1.y + b1.y);
            o.w = pk2((bf_lo(a.w) - mean) * rstd * g1.z + b1.z, (bf_hi(a.w) - mean) * rstd * g1.w + b1.w);
            *(LAS v4u*)(VN + vn_off((unsigned)q, (unsigned)cg)) = o;
        }
#pragma unroll
        for (int i = 0; i < 8; ++i) { const int pid = tid + 512 * i, r = pid >> 5, cg = pid & 31; *(LAS v2u*)(GU + r * 264 + cg * 8) = G.gu[i]; }
        if (tid < 128) BS[tid] = G.bs;
        bf16x8 Af[4];
#pragma unroll
        for (int ks = 0; ks < 4; ++ks) Af[ks] = G.Af[ks];
        __syncthreads();
        if (h + 1 < 8) gmlp_load(F, t0, h + 1, tid, G);
        f32x4 acc[8];
#pragma unroll
        for (int n = 0; n < 8; ++n) {
            acc[n] = (f32x4){0.f, 0.f, 0.f, 0.f};
#pragma unroll
            for (int ks = 0; ks < 4; ++ks) {
                const s16x4 b0 = __builtin_amdgcn_ds_read_tr16_b64_v4i16((LAS s16x4*)(VN + vn_off(32u * ks + 8u * fq + trq, 2u * n + (trp >> 1)) + 8u * (trp & 1u)));
                const s16x4 b1 = __builtin_amdgcn_ds_read_tr16_b64_v4i16((LAS s16x4*)(VN + vn_off(32u * ks + 8u * fq + 4u + trq, 2u * n + (trp >> 1)) + 8u * (trp & 1u)));
                const bf16x8 bb = (bf16x8){b0[0], b0[1], b0[2], b0[3], b1[0], b1[1], b1[2], b1[3]};
                acc[n] = __builtin_amdgcn_mfma_f32_16x16x32_bf16(Af[ks], bb, acc[n], 0, 0, 0);
            }
        }
        {
            unsigned short gv_[8][4]; float bsv_[4];
#pragma unroll
            for (int j = 0; j < 4; ++j) bsv_[j] = BS[16 * w + 4 * fq + j];
#pragma unroll
            for (int n = 0; n < 8; ++n)
#pragma unroll
                for (int j = 0; j < 4; ++j) gv_[n][j] = *(const LAS unsigned short*)(GU + (16 * w + 4 * fq + j) * 264 + (16 * n + fr) * 2);
#pragma unroll
            for (int n = 0; n < 8; ++n)
#pragma unroll
                for (int j = 0; j < 4; ++j) *(LAS unsigned short*)(GU + (16 * w + 4 * fq + j) * 264 + (16 * n + fr) * 2) = (unsigned short)f2bf(bf1(gv_[n][j]) * (acc[n][j] + bsv_[j]));
        }
        __syncthreads();
#pragma unroll
        for (int i = 0; i < 8; ++i) { const int pid = tid + 512 * i, r = pid >> 5, cg = pid & 31;
            *(GAS v2u*)(F.MIX() + (t0 + r) * D + LW + h * 128 + cg * 4) = *(const LAS v2u*)(GU + r * 264 + cg * 8); }
        __syncthreads();
    }
}
__device__ __forceinline__ void h8_issue(Frame& F, int t, int lane, v4u (&a)[4]) {
    const bf16* hp = F.HB() + (size_t)t * D + lane * 16;
#pragma unroll
    for (int c = 0; c < 2; ++c)
#pragma unroll
        for (int q = 0; q < 2; ++q) a[c * 2 + q] = *(const GAS v4u*)(hp + c * 1024 + q * 8);
}
__device__ __forceinline__ void h8_finish(Frame& F, int t, int lane, const v4u (&av)[4]) {
    float hx[32]; float mx = 0.f;
#pragma unroll
    for (int c = 0; c < 2; ++c)
#pragma unroll
        for (int q = 0; q < 2; ++q) { const v4u a = av[c * 2 + q]; float* x = hx + c * 16 + q * 8;
            x[0] = bf_lo(a.x); x[1] = bf_hi(a.x); x[2] = bf_lo(a.y); x[3] = bf_hi(a.y); x[4] = bf_lo(a.z); x[5] = bf_hi(a.z); x[6] = bf_lo(a.w); x[7] = bf_hi(a.w); }
#pragma unroll
    for (int i = 0; i < 32; ++i) mx = fmaxf(mx, fabsf(hx[i]));
#pragma unroll
    for (int o = 1; o < 64; o <<= 1) mx = fmaxf(mx, __shfl_xor(mx, o));
    const float sc = mx > 0.f ? 119.0f / mx : 1.0f;
    const float MAGIC = 12582912.0f + 128.0f;
#pragma unroll
    for (int c = 0; c < 2; ++c) {
        unsigned hw[2], lw[2]; v4u pq;
#pragma unroll
        for (int g8 = 0; g8 < 2; ++g8) {
            unsigned m[8];
#pragma unroll
            for (int i = 0; i < 8; ++i) m[i] = __builtin_bit_cast(unsigned, __builtin_fmaf(hx[c * 16 + g8 * 8 + i], sc, MAGIC));
            const unsigned B0 = __builtin_amdgcn_perm(__builtin_amdgcn_perm(m[3], m[2], 0x0c0c0400u), __builtin_amdgcn_perm(m[1], m[0], 0x0c0c0400u), 0x05040100u);
            const unsigned B1 = __builtin_amdgcn_perm(__builtin_amdgcn_perm(m[7], m[6], 0x0c0c0400u), __builtin_amdgcn_perm(m[5], m[4], 0x0c0c0400u), 0x05040100u);
            lw[g8] = (B0 & 0x0F0F0F0Fu) | ((B1 & 0x0F0F0F0Fu) << 4);
            const unsigned h0 = ((B0 + 0x08080808u) >> 4) & 0x0F0F0F0Fu, h1 = ((B1 + 0x08080808u) >> 4) & 0x0F0F0F0Fu;
            hw[g8] = (h0 | (h1 << 4)) ^ 0x88888888u;
            if (g8 == 0) { pq.x = B0 ^ 0x80808080u; pq.y = B1 ^ 0x80808080u; } else { pq.z = B0 ^ 0x80808080u; pq.w = B1 ^ 0x80808080u; } }
        unsigned char* hb_ = F.H8() + (size_t)t * D + c * 512 + lane * 8;
        (void)hb_; (void)hw; (void)lw;
        *(GAS v4u*)((unsigned char*)(F.ws + WS_HQ8) + (size_t)t * D + c * 1024 + lane * 16) = pq;
    }
    if (lane == 0) F.HSCALE()[t] = mx > 0.f ? mx * (1.0f / 119.0f) : 1.0f;
}
__device__ __forceinline__ void h8_row(Frame& F, int t) { int lane = F.lane; asm volatile("" : "+v"(lane)); v4u a[4]; h8_issue(F, t, lane, a); h8_finish(F, t, lane, a); }
typedef float f32x16 __attribute__((ext_vector_type(16)));
__device__ __forceinline__ unsigned fkey(float f) { return __builtin_bit_cast(unsigned, f); }
__device__ __forceinline__ float fkey_inv(unsigned k) { return __builtin_bit_cast(float, k); }
__device__ __forceinline__ unsigned umax_(unsigned a, unsigned b) { unsigned r; asm("v_max_f32 %0, %1, %2" : "=v"(r) : "v"(a), "v"(b)); return r; }
__device__ __forceinline__ unsigned umin_(unsigned a, unsigned b) { unsigned r; asm("v_min_f32 %0, %1, %2" : "=v"(r) : "v"(a), "v"(b)); return r; }
#define CE_DESC(x, y) do { const unsigned a_ = (x), b_ = (y); (x) = umax_(a_, b_); (y) = umin_(a_, b_); } while (0)
__device__ __forceinline__ void sort16_desc(unsigned (&a)[16]) {
    CE_DESC(a[0], a[13]); CE_DESC(a[1], a[12]); CE_DESC(a[2], a[15]); CE_DESC(a[3], a[14]); CE_DESC(a[4], a[8]); CE_DESC(a[5], a[6]); CE_DESC(a[7], a[11]); CE_DESC(a[9], a[10]);
    CE_DESC(a[0], a[5]); CE_DESC(a[1], a[7]); CE_DESC(a[2], a[9]); CE_DESC(a[3], a[4]); CE_DESC(a[6], a[13]); CE_DESC(a[8], a[14]); CE_DESC(a[10], a[15]); CE_DESC(a[11], a[12]);
    CE_DESC(a[0], a[1]); CE_DESC(a[2], a[3]); CE_DESC(a[4], a[5]); CE_DESC(a[6], a[8]); CE_DESC(a[7], a[9]); CE_DESC(a[10], a[11]); CE_DESC(a[12], a[13]); CE_DESC(a[14], a[15]);
    CE_DESC(a[0], a[2]); CE_DESC(a[1], a[3]); CE_DESC(a[4], a[10]); CE_DESC(a[5], a[11]); CE_DESC(a[6], a[7]); CE_DESC(a[8], a[9]); CE_DESC(a[12], a[14]); CE_DESC(a[13], a[15]);
    CE_DESC(a[1], a[2]); CE_DESC(a[3], a[12]); CE_DESC(a[4], a[6]); CE_DESC(a[5], a[7]); CE_DESC(a[8], a[10]); CE_DESC(a[9], a[11]); CE_DESC(a[13], a[14]);
    CE_DESC(a[1], a[4]); CE_DESC(a[2], a[6]); CE_DESC(a[5], a[8]); CE_DESC(a[7], a[10]); CE_DESC(a[9], a[13]); CE_DESC(a[11], a[14]);
    CE_DESC(a[2], a[4]); CE_DESC(a[3], a[6]); CE_DESC(a[9], a[12]); CE_DESC(a[11], a[13]);
    CE_DESC(a[3], a[5]); CE_DESC(a[6], a[8]); CE_DESC(a[7], a[9]); CE_DESC(a[10], a[12]);
    CE_DESC(a[3], a[4]); CE_DESC(a[5], a[6]); CE_DESC(a[7], a[8]); CE_DESC(a[9], a[10]); CE_DESC(a[11], a[12]);
    CE_DESC(a[6], a[7]); CE_DESC(a[8], a[9]);
}
__device__ __forceinline__ void merge16_desc(unsigned (&a)[16], const unsigned (&b)[16]) {
#pragma unroll
    for (int i = 0; i < 16; ++i) a[i] = umax_(a[i], b[15 - i]);
#pragma unroll
    for (int j = 8; j >= 1; j >>= 1)
#pragma unroll
        for (int i = 0; i < 16; ++i) if ((i & j) == 0) CE_DESC(a[i], a[i + j]);
}
typedef short bf16x8s __attribute__((ext_vector_type(8)));
constexpr int P6_KEYS = 65536, P6_KROW = 272;
__device__ __forceinline__ void topk_unit(Frame& F, int wu, bool doh, int th, int tstride) {
    v4u ha[4][4];
    const int tg = wu, hd = F.vcu & 7, lane = F.lane, r = lane & 31, hh = lane >> 5;
    const int t = tg * 32 + r;
    const size_t qoff = (size_t)t * D + hd * 256 + 8 * hh;
    unsigned L[2][16];
    unsigned hh4 = (unsigned)hh << 2; asm volatile("" : "+v"(hh4));
    typedef short bf16x8s_ __attribute__((ext_vector_type(8)));
    bf16x8s_ qa[3], ka[3][4], qb[3], kb[3][4];
    const bf16* qp; unsigned kl;
#define P6_PTRS(pp) do { qp = F.QH() + qoff + (pp) * 128; kl = (unsigned)(P6_KEYS + ((pp) * 128 + r) * P6_KROW + 16 * hh); \
        asm volatile("" : "+v"(qp), "+v"(kl)); } while (0)
#pragma unroll
    for (int p = 0; p < 2; ++p) {
        f32x16 acc[4];
#pragma unroll
        for (int nt = 0; nt < 4; ++nt)
#pragma unroll
            for (int i = 0; i < 16; ++i) acc[nt][i] = 0.f;
#define P6_LOAD(Q, K, ks0, n) _Pragma("unroll") for (int i_ = 0; i_ < (n); ++i_) { Q[i_] = *(const GAS bf16x8s*)(qp + 16 * ((ks0) + i_)); \
            _Pragma("unroll") for (int nt_ = 0; nt_ < 4; ++nt_) K[i_][nt_] = *(const LAS bf16x8s*)(F.lds + kl + nt_ * 32 * P6_KROW + 32 * ((ks0) + i_)); }
#define P6_MMA(Q, K, n) _Pragma("unroll") for (int i_ = 0; i_ < (n); ++i_) _Pragma("unroll") for (int nt = 0; nt < 4; ++nt) acc[nt] = __builtin_amdgcn_mfma_f32_32x32x16_bf16(K[i_][nt], Q[i_], acc[nt], 0, 0, 0);
        if (p == 0) { P6_PTRS(0); P6_LOAD(qa, ka, 0, 3); P6_LOAD(qb, kb, 3, 3); }
        __builtin_amdgcn_sched_barrier(0);
        P6_MMA(qa, ka, 3);
        __builtin_amdgcn_sched_barrier(0);
        P6_LOAD(qa, ka, 6, 2);
        __builtin_amdgcn_sched_barrier(0);
        P6_MMA(qb, kb, 3);
        __builtin_amdgcn_sched_barrier(0);
        P6_MMA(qa, ka, 2);
        __builtin_amdgcn_sched_barrier(0);
        if (p == 0) { P6_PTRS(1); P6_LOAD(qa, ka, 0, 3); P6_LOAD(qb, kb, 3, 3); __builtin_amdgcn_sched_barrier(0); }
        if (p == 1) {
#pragma unroll
            for (int i = 0; i < 4; ++i) { if (doh) h8_issue(F, th + i * tstride, lane, ha[i]); else { ha[i][0] = ha[i][1] = ha[i][2] = ha[i][3] = (v4u){0u, 0u, 0u, 0u}; } }
            __builtin_amdgcn_sched_barrier(0);
        }
#undef P6_LOAD
#undef P6_MMA
        unsigned S[4][16];
#pragma unroll
        for (int nt = 0; nt < 4; ++nt) {
#pragma unroll
            for (int rg = 0; rg < 16; ++rg) { const int nc = 32 * nt + (rg & 3) + 8 * (rg >> 2); S[nt][rg] = (fkey(acc[nt][rg]) & ~0x7Fu) | (unsigned)(127 - nc); }
            sort16_desc(S[nt]);
        }
        merge16_desc(S[0], S[1]); merge16_desc(S[2], S[3]); merge16_desc(S[0], S[2]);
#pragma unroll
        for (int i = 0; i < 16; ++i) S[0][i] &= ~hh4;
        unsigned T[16];
#pragma unroll
        for (int i = 0; i < 16; ++i) T[i] = (unsigned)__shfl_xor((int)S[0][i], 32);
        merge16_desc(S[0], T);
#pragma unroll
        for (int i = 0; i < 16; ++i) L[p][i] = S[0][i];
        __builtin_amdgcn_sched_barrier(0);
    }
    float v0[16], v1[16];
#pragma unroll
    for (int i = 0; i < 16; ++i) { v0[i] = fkey_inv(L[0][i] & ~0x7Fu); v1[i] = fkey_inv(L[1][i] & ~0x7Fu); }
    unsigned Ca[16], Cb[16];
    {
        unsigned K0[32], K1[32];
        int cnt = 0;
#pragma unroll
        for (int i = 0; i < 16; ++i)
#pragma unroll
            for (int j = 0; j < 16; ++j) if ((i + 1) * (j + 1) <= 16) { const unsigned k = (fkey(v0[i] + v1[j]) & ~0xFFu) | (unsigned)(255 - (i * 16 + j));
                if (cnt < 32) K0[cnt] = k; else K1[cnt - 32] = k; ++cnt; }
#pragma unroll
        for (int q = 18; q < 32; ++q) K1[q] = 0xFF800000u;
#pragma unroll
        for (int q = 0; q < 16; ++q) { Ca[q] = hh ? K1[q] : K0[q]; Cb[q] = hh ? K1[16 + q] : K0[16 + q]; }
    }
    sort16_desc(Ca); sort16_desc(Cb); merge16_desc(Ca, Cb);
    unsigned best[16];
    {
        unsigned T[16];
#pragma unroll
        for (int i = 0; i < 16; ++i) T[i] = (unsigned)__shfl_xor((int)Ca[i], 32);
        merge16_desc(Ca, T);
    }
#pragma unroll
    for (int i = 0; i < 16; ++i) best[i] = Ca[i];
    LAS unsigned* tab = (LAS unsigned*)(F.lds + F.wave * 8192) + lane;
#pragma unroll
    for (int i = 0; i < 16; ++i) { tab[i * 64] = 127u - (L[0][i] & 0x7Fu); tab[(16 + i) * 64] = 127u - (L[1][i] & 0x7Fu); }
    const float smax = fkey_inv(best[0] & ~0xFFu);
    float sv[8]; unsigned idv[8]; float ssum = 0.f;
#pragma unroll
    for (int k = 0; k < 8; ++k) {
        const unsigned bk = hh ? best[8 + k] : best[k];
        const unsigned pos = 255u - (bk & 0xFFu);
        idv[k] = tab[(pos >> 4) * 64] * 128u + tab[(16 + (pos & 15u)) * 64];
        sv[k] = __builtin_amdgcn_exp2f((fkey_inv(bk & ~0xFFu) - smax) * 1.4426950409f); ssum += sv[k];
    }
    ssum += __shfl_xor(ssum, 32);
    const float inv = 1.0f / ssum;
    {
        int* o = F.IDS() + (size_t)t * 64 + hd * 8 + 4 * hh; float* og = F.GATES() + (size_t)t * 128 + hd * 8 + 4 * hh;
        *(GAS v4u*)o = (v4u){idv[0] | (idv[4] << 16), idv[1] | (idv[5] << 16), idv[2] | (idv[6] << 16), idv[3] | (idv[7] << 16)};
        *(GAS f32x4*)og = (f32x4){sv[0] * inv, sv[1] * inv, sv[2] * inv, sv[3] * inv}; *(GAS f32x4*)(og + 64) = (f32x4){sv[4] * inv, sv[5] * inv, sv[6] * inv, sv[7] * inv};
    }
    if (doh) {
#pragma unroll
        for (int i = 0; i < 4; ++i) h8_finish(F, th + i * tstride, lane, ha[i]);
    }
}
__device__ __forceinline__ int row_sum16(int v) {
    v += __builtin_amdgcn_update_dpp(0, v, 0x128, 0xf, 0xf, false);
    v += __builtin_amdgcn_update_dpp(0, v, 0x124, 0xf, 0xf, false);
    v += __builtin_amdgcn_update_dpp(0, v, 0x122, 0xf, 0xf, false);
    v += __builtin_amdgcn_update_dpp(0, v, 0x121, 0xf, 0xf, false);
    return v;
}
__device__ __forceinline__ void peer_u_xcd(Frame& F) {
    const int lane = F.lane, x = blockIdx.x & 7, jcu = blockIdx.x >> 3, ncu = ((int)F.G - x + 7) >> 3;
    const int tpc = (M + ncu - 1) / ncu, tpw = (tpc + NWAVES - 1) / NWAVES;
    const int tbase = jcu * tpc + F.wave * tpw;
    int nw = M - tbase; { const int lim = (jcu + 1) * tpc - tbase; nw = nw < lim ? nw : lim; nw = nw < tpw ? nw : tpw; nw = nw < 0 ? 0 : nw; }
    const int NV = nw;
    LAS unsigned char* wl = F.lds + F.wave * 13312;
    LAS int* lst = (LAS int*)wl; LAS int* res = (LAS int*)(wl + 512); LAS unsigned char* hsl = wl + 1024;
    const int q4 = lane >> 4, i16 = lane & 15;
    const unsigned char* ubase = F.U8() + (size_t)x * 2048 * 1024;
    const unsigned lanepart = (unsigned)i16 * 16u;
    int r_idlo = 0, r_idhi = 0, r_t = 0; v4u r_h0 = (v4u){0u, 0u, 0u, 0u}, r_h1 = (v4u){0u, 0u, 0u, 0u};
    int v_cl0 = 0, v_cl1 = 0, v_n = 0, v_r0 = 0, v_t = 0, v_slot = 0; unsigned long long v_mlo = 0, v_mhi = 0; bool v_live = false;
    int vset = 0, nvalid = 0, idle = 0;
    if (NV == 0) return;
#define H_SPLIT(b0, b1, hi, lo) do { const unsigned a0_ = ((((b0) ^ 0x80808080u) + 0x08080808u) >> 4) & 0x0F0F0F0Fu, a1_ = ((((b1) ^ 0x80808080u) + 0x08080808u) >> 4) & 0x0F0F0F0Fu; \
        (hi) = (a0_ | (a1_ << 4)) ^ 0x88888888u; (lo) = ((b0) & 0x0F0F0F0Fu) | (((b1) & 0x0F0F0F0Fu) << 4); } while (0)
#define U_RAW() do { const int vi_ = vset < NV ? vset : NV - 1; r_t = tbase + vi_; \
        { const int w_ = F.IDS()[(size_t)r_t * 64 + lane]; r_idlo = w_ & 0xffff; r_idhi = (int)((unsigned)w_ >> 16); } \
        r_h0 = *(const GAS v4u*)((const unsigned char*)(F.ws + WS_HQ8) + (size_t)r_t * D + lane * 32); r_h1 = *(const GAS v4u*)((const unsigned char*)(F.ws + WS_HQ8) + (size_t)r_t * D + lane * 32 + 16); } while (0)
#define U_NEXT() do { if (v_live && v_r0 + 16 < v_n) { v_r0 += 16; } else if (vset < NV) { const bool slo = (r_idlo >> 11) == x, shi = (r_idhi >> 11) == x; \
            v_mlo = __ballot(slo); v_mhi = __ballot(shi); const int nlo = __popcll(v_mlo); v_n = nlo + __popcll(v_mhi); \
            const int plo = __builtin_amdgcn_mbcnt_hi((unsigned)(v_mlo >> 32), __builtin_amdgcn_mbcnt_lo((unsigned)v_mlo, 0)); \
            const int phi = nlo + __builtin_amdgcn_mbcnt_hi((unsigned)(v_mhi >> 32), __builtin_amdgcn_mbcnt_lo((unsigned)v_mhi, 0)); \
            if (slo) lst[plo] = (r_idlo & 2047) | (lane << 16); if (shi) lst[phi] = (r_idhi & 2047) | ((64 + lane) << 16); \
            v_slot = nvalid % 6; ++nvalid; { LAS unsigned char* sp_ = hsl + v_slot * 2048; v4u ph_, pl_; H_SPLIT(r_h0.x, r_h0.y, ph_.x, pl_.x); H_SPLIT(r_h0.z, r_h0.w, ph_.y, pl_.y); H_SPLIT(r_h1.x, r_h1.y, ph_.z, pl_.z); H_SPLIT(r_h1.z, r_h1.w, ph_.w, pl_.w); \
              *(LAS v4u*)(sp_ + lane * 16) = ph_; *(LAS v4u*)(sp_ + 1024 + lane * 16) = pl_; } \
            v_cl0 = lst[lane]; v_cl1 = lst[64 + lane]; v_t = r_t; v_r0 = 0; ++vset; v_live = true; } \
        else { v_live = false; v_n = 0; v_r0 = 0; v_mlo = 0; v_mhi = 0; ++idle; } } while (0)
#define U_ISSUE(BUF, DS) do { { const int rem_ = v_n - v_r0; DS##_cnt = rem_ < 0 ? 0 : (rem_ < 16 ? rem_ : 16); } \
        DS##_slot = v_slot; DS##_t = v_t; DS##_mlo = v_mlo; DS##_mhi = v_mhi; DS##_last = v_live && (v_r0 + 16 >= v_n); \
        _Pragma("unroll") for (int gp = 0; gp < 4; ++gp) { const int ix_ = v_r0 + 4 * gp + q4; const int a_ = __shfl(v_cl0, ix_ & 63), b_ = __shfl(v_cl1, ix_ & 63); DS##_ent[gp] = ix_ < 64 ? a_ : b_; \
            const unsigned of_ = (4 * gp + q4 < DS##_cnt ? ((unsigned)(DS##_ent[gp] & 2047) << 10) : 0u) + lanepart; \
            _Pragma("unroll") for (int c = 0; c < 4; ++c) BUF[4 * gp + c] = *(const GAS v4u*)(ubase + of_ + c * 256); } } while (0)
#define U_COMPUTE(BUF, DS) do { const LAS unsigned char* sp_ = hsl + DS##_slot * 2048; const LAS v4u* hp_ = (const LAS v4u*)(sp_ + i16 * 16); \
        _Pragma("unroll") for (int gp = 0; gp < 4; ++gp) if (4 * gp < DS##_cnt) { int ah_ = 0, al_ = 0; \
            _Pragma("unroll") for (int c = 0; c < 4; ++c) { const v4u r_ = BUF[4 * gp + c]; const v4u hh_ = hp_[c * 16], hl_ = hp_[64 + c * 16]; \
                ah_ = __builtin_amdgcn_sdot8((int)r_.x, (int)hh_.x, ah_, false); al_ = __builtin_amdgcn_sdot8((int)r_.x, (int)hl_.x, al_, false); \
                ah_ = __builtin_amdgcn_sdot8((int)r_.y, (int)hh_.y, ah_, false); al_ = __builtin_amdgcn_sdot8((int)r_.y, (int)hl_.y, al_, false); \
                ah_ = __builtin_amdgcn_sdot8((int)r_.z, (int)hh_.z, ah_, false); al_ = __builtin_amdgcn_sdot8((int)r_.z, (int)hl_.z, al_, false); \
                ah_ = __builtin_amdgcn_sdot8((int)r_.w, (int)hh_.w, ah_, false); al_ = __builtin_amdgcn_sdot8((int)r_.w, (int)hl_.w, al_, false); } \
            const int a_ = row_sum16((ah_ << 4) + al_); if (i16 == 0 && 4 * gp + q4 < DS##_cnt) res[DS##_ent[gp] >> 16] = a_; } \
        if (DS##_last) { int* po_ = F.PART() + (size_t)DS##_t * 128; \
            if ((DS##_mlo >> lane) & 1ull) po_[lane] = res[lane]; if ((DS##_mhi >> lane) & 1ull) po_[64 + lane] = res[64 + lane]; } } while (0)
    v4u bufA[16], bufB[16], bufC[16];
    int dA_cnt = 0, dA_ent[4] = {0, 0, 0, 0}, dA_t = 0, dA_slot = 0; unsigned long long dA_mlo = 0, dA_mhi = 0; bool dA_last = false;
    int dB_cnt = 0, dB_ent[4] = {0, 0, 0, 0}, dB_t = 0, dB_slot = 0; unsigned long long dB_mlo = 0, dB_mhi = 0; bool dB_last = false;
    int dC_cnt = 0, dC_ent[4] = {0, 0, 0, 0}, dC_t = 0, dC_slot = 0; unsigned long long dC_mlo = 0, dC_mhi = 0; bool dC_last = false;
    U_RAW();
    U_NEXT(); U_RAW(); U_ISSUE(bufA, dA);
    U_NEXT(); U_RAW(); U_ISSUE(bufB, dB);
    while (idle < 3) {
        U_NEXT(); U_RAW(); U_ISSUE(bufC, dC); U_COMPUTE(bufA, dA);
        U_NEXT(); U_RAW(); U_ISSUE(bufA, dA); U_COMPUTE(bufB, dB);
        U_NEXT(); U_RAW(); U_ISSUE(bufB, dB); U_COMPUTE(bufC, dC);
    }
#undef U_RAW
#undef H_SPLIT
#undef U_NEXT
#undef U_ISSUE
#undef U_COMPUTE
}
__device__ __forceinline__ void peer_act_token(Frame& F, int t) {
    const int lane = F.lane;
    LAS unsigned char* wl = F.lds + F.wave * 4096;
    LAS float* abuf = (LAS float*)wl; LAS int* ibuf = (LAS int*)(wl + 512); LAS int* cnt = (LAS int*)(wl + 1024);
    LAS int* ovf = (LAS int*)(wl + 1280); LAS int* fre = (LAS int*)(wl + 1792); LAS int* sop = (LAS int*)(wl + 2304);
#define WFENCE() asm volatile("s_waitcnt lgkmcnt(0)" ::: "memory")
    const float sc = __builtin_amdgcn_rsqf(F.ROWSS()[t] * (1.0f / D) + 1e-6f) * F.HSCALE()[t];
    if (lane < 34) cnt[lane] = 0;
    float am = 0.f; float actv[2]; int idv[2], slotv[2];
    const int l32 = t & 31;
#pragma unroll
    for (int half = 0; half < 2; ++half) {
        const size_t o = (size_t)t * 128 + half * 64 + lane;
        const int e = half ? (int)((unsigned)F.IDS()[(size_t)t * 64 + lane] >> 16) : (F.IDS()[(size_t)t * 64 + lane] & 0xffff); const float g = F.GATES()[o];
        const int dsum = F.PART()[o];
        const f32x2 uv = *(const GAS f32x2*)(F.USCALE() + 2 * e);
        actv[half] = gelu_tanh((float)dsum * sc * uv.x) * g * uv.y; idv[half] = e; am = fmaxf(am, fabsf(actv[half]));
    }
    WFENCE();
#pragma unroll
    for (int half = 0; half < 2; ++half) {
        const int r = idv[half] & 31;
        const int j = __hip_atomic_fetch_add(cnt + r, 1, __ATOMIC_RELAXED, __HIP_MEMORY_SCOPE_WORKGROUP);
        if (j < 4) slotv[half] = ((r - l32) & 31) + 32 * j;
        else { const int q = __hip_atomic_fetch_add(cnt + 32, 1, __ATOMIC_RELAXED, __HIP_MEMORY_SCOPE_WORKGROUP); ovf[q] = half * 64 + lane; slotv[half] = -1; }
    }
    WFENCE();
    if (lane < 32) { const int n = cnt[lane];
        for (int j = n; j < 4; ++j) { const int q = __hip_atomic_fetch_add(cnt + 33, 1, __ATOMIC_RELAXED, __HIP_MEMORY_SCOPE_WORKGROUP); fre[q] = ((lane - l32) & 31) + 32 * j; } }
    WFENCE();
    const int nov = cnt[32];
#pragma unroll
    for (int half = 0; half < 2; ++half) { const int i = half * 64 + lane; if (i < nov) sop[ovf[i]] = fre[i]; }
    WFENCE();
#pragma unroll
    for (int half = 0; half < 2; ++half) { if (slotv[half] < 0) slotv[half] = sop[half * 64 + lane]; abuf[slotv[half]] = actv[half]; ibuf[slotv[half]] = idv[half]; }
    WFENCE();
#pragma unroll
    for (int o = 1; o < 64; o <<= 1) am = fmaxf(am, __shfl_xor(am, o));
    const float asc = am > 0.f ? 127.0f / am : 1.0f;
    if (lane == 0) F.ASCALE()[t] = am > 0.f ? am * (1.0f / 127.0f) : 1.0f;
    if (lane < 32) {
        const f32x4 av = *(const LAS f32x4*)(abuf + 4 * lane); const v4u iv = *(const LAS v4u*)(ibuf + 4 * lane);
        const size_t o = ((size_t)(t >> 6) * 32 + lane) * 64 + (t & 63);
        F.IDW()[o] = (v4u){iv.x << 3, iv.y << 3, iv.z << 3, iv.w << 3};
        F.AW()[(((size_t)(t >> 6) * 8 + (lane >> 2)) * 64 + (t & 63)) * 4 + (lane & 3)] = pack_i8x4(av.x * asc, av.y * asc, av.z * asc, av.w * asc);
    }
    WFENCE();
#undef WFENCE
}
__device__ __forceinline__ void tr4x4(const unsigned r0, const unsigned r1, const unsigned r2, const unsigned r3, unsigned (&c)[4]) {
    const unsigned t01l = __builtin_amdgcn_perm(r1, r0, 0x05010400u), t01h = __builtin_amdgcn_perm(r1, r0, 0x07030602u);
    const unsigned t23l = __builtin_amdgcn_perm(r3, r2, 0x05010400u), t23h = __builtin_amdgcn_perm(r3, r2, 0x07030602u);
    c[0] = __builtin_amdgcn_perm(t23l, t01l, 0x05040100u); c[1] = __builtin_amdgcn_perm(t23l, t01l, 0x07060302u);
    c[2] = __builtin_amdgcn_perm(t23h, t01h, 0x05040100u); c[3] = __builtin_amdgcn_perm(t23h, t01h, 0x07060302u);
}
template <int MODE>
__device__ __forceinline__ void peer_v_slice(Frame& F, int c, bool do_atomic) {
    const int tid = F.tid, lane = F.lane;
    for (int i = tid; i < NEXP * 8 / 16; i += 512) *(LAS v4u*)(F.lds + i * 16) = *(const GAS v4u*)(F.V8T() + (size_t)c * NEXP * 8 + (size_t)i * 16);
    __syncthreads();
    const v4u* ibase = F.IDW() + lane; const v4u* abase = (const v4u*)F.AW() + lane;
    constexpr int NBLK = M / 64, PD = 16;
    v4u iq[PD]; v4u aq[PD / 4]; v2u rw[2][4];
    {
        const size_t o = (size_t)F.wave * 32 * 64;
#pragma unroll
        for (int j = 0; j < PD; ++j) iq[j] = *(const GAS v4u*)(ibase + o + j * 64);
#pragma unroll
        for (int j = 0; j < PD / 4; ++j) aq[j] = *(const GAS v4u*)(abase + (size_t)F.wave * 8 * 64 + j * 64);
    }
#define LROW(dst, q) do { dst[0] = *(const LAS v2u*)(F.lds + (q).x); dst[1] = *(const LAS v2u*)(F.lds + (q).y); \
                          dst[2] = *(const LAS v2u*)(F.lds + (q).z); dst[3] = *(const LAS v2u*)(F.lds + (q).w); } while (0)
    for (int blk = F.wave; blk < NBLK; blk += NWAVES) {
        const int t = blk * 64 + lane;
        const size_t o = (size_t)blk * 32 * 64;
        const int nblk = (blk + NWAVES < NBLK) ? blk + NWAVES : blk;
        const size_t on = (size_t)nblk * 32 * 64;
        int acc[8];
#pragma unroll
        for (int i = 0; i < 8; ++i) acc[i] = 0;
        LROW(rw[0], iq[0]);
#pragma unroll
        for (int j = 0; j < 32; ++j) {
            if (j + 1 < 32) LROW(rw[(j + 1) & 1], iq[(j + 1) % PD]);
            const unsigned aw = aq[(j >> 2) % (PD / 4)][j & 3];
            unsigned cl[4], ch[4];
            tr4x4(rw[j & 1][0].x, rw[j & 1][1].x, rw[j & 1][2].x, rw[j & 1][3].x, cl);
            tr4x4(rw[j & 1][0].y, rw[j & 1][1].y, rw[j & 1][2].y, rw[j & 1][3].y, ch);
#pragma unroll
            for (int i = 0; i < 4; ++i) { acc[i] = __builtin_amdgcn_sdot4((int)aw, (int)cl[i], acc[i], false); acc[4 + i] = __builtin_amdgcn_sdot4((int)aw, (int)ch[i], acc[4 + i], false); }
            { const size_t oo = (j + PD < 32) ? o + (size_t)(j + PD) * 64 : on + (size_t)(j + PD - 32) * 64;
              iq[j % PD] = *(const GAS v4u*)(ibase + oo);
              if ((j & 3) == 3) { const int jq = (j >> 2) + PD / 4;
                  aq[(j >> 2) % (PD / 4)] = *(const GAS v4u*)(abase + (jq < 8 ? (size_t)blk * 8 * 64 + (size_t)jq * 64 : (size_t)nblk * 8 * 64 + (size_t)(jq - 8) * 64)); } }
            __builtin_amdgcn_sched_barrier(0);
        }
        const float asc = F.ASCALE()[t];
        float accf[8];
        const v4u hb = *(const GAS v4u*)(F.HBT() + ((size_t)c * M + t) * 8);
        const float hres[8] = {bf_lo(hb.x), bf_hi(hb.x), bf_lo(hb.y), bf_hi(hb.y), bf_lo(hb.z), bf_hi(hb.z), bf_lo(hb.w), bf_hi(hb.w)};
#pragma unroll
        for (int i = 0; i < 8; ++i) accf[i] = __builtin_fmaf((float)acc[i], asc, hres[i]);
        bf16* yp = (MODE == 0) ? F.Y() + ((size_t)c * M + t) * 8 : (bf16*)F.XN() + ((((size_t)c * M + t) * 8) & (size_t)0x1ffffff);
        *(GAS v4u*)yp = (v4u){pk2(accf[0], accf[1]), pk2(accf[2], accf[3]), pk2(accf[4], accf[5]), pk2(accf[6], accf[7])};
        float ss = 0.f;
#pragma unroll
        for (int i = 0; i < 8; ++i) ss += accf[i] * accf[i];
        if (do_atomic) atomicAdd(F.ROWSS2() + t, ss);
    }
#undef LROW
    __syncthreads();
}
__device__ __forceinline__ void final_unit(Frame& F, int unit) {
    const int tid = F.tid, blk = unit >> 3, cg = unit & 7, t0 = blk * 64;
    LAS float* T = (LAS float*)F.lds;
#pragma unroll
    for (int i = 0; i < 4; ++i) { const int pid = tid + 512 * i, cl = pid >> 6, tok = pid & 63;
        const v4u v = *(const GAS v4u*)(F.Y() + ((size_t)(cg * 32 + cl) * M + t0 + tok) * 8);
        *(LAS f32x4*)(T + tok * 260 + cl * 8) = (f32x4){bf_lo(v.x), bf_hi(v.x), bf_lo(v.y), bf_hi(v.y)};
        *(LAS f32x4*)(T + tok * 260 + cl * 8 + 4) = (f32x4){bf_lo(v.z), bf_hi(v.z), bf_lo(v.w), bf_hi(v.w)}; }
    __syncthreads();
#pragma unroll
    for (int i = 0; i < 8; ++i) { const int pid = tid + 512 * i, tok = pid >> 6, c4 = pid & 63;
        const float rs = __builtin_amdgcn_rsqf(F.ROWSS2()[t0 + tok] * (1.0f / D) + 1e-6f);
        const f32x4 v = *(const LAS f32x4*)(T + tok * 260 + c4 * 4);
        const f32x4 g = *(const GAS f32x4*)(F.A.in[20] + cg * 256 + c4 * 4);
        *(GAS f32x4*)(F.A.out + (size_t)(t0 + tok) * D + cg * 256 + c4 * 4) = v * rs * g; }
    __syncthreads();
}
__global__ void __launch_bounds__(NWAVES * 64, 2) mk_fwd(Args args) {
    __shared__ __attribute__((aligned(16))) unsigned char lds[LDS_BYTES];
    Frame F(args);
    F.lds = (LAS unsigned char*)lds;
    F.MISC = (volatile LAS unsigned*)(F.lds + MISC_OFF);
    F.tid = threadIdx.x; F.lane = F.tid & 63; F.wave = __builtin_amdgcn_readfirstlane(F.tid >> 6);
    F.G = gridDim.x; { const int bx = blockIdx.x; F.vcu = (F.G % 8 == 0) ? (bx % 8) * (F.G / 8) + bx / 8 : bx; }
    F.ws = args.ws;
    F.ctl = (gu32*)(args.ws + WS_CTL);
    for (int u = F.tid; u < (LDS_BYTES - LDSCTL_OFF) / 4; u += NWAVES * 64) ((LAS unsigned*)(F.lds + LDSCTL_OFF))[u] = 0u;
    __syncthreads();
    XcdBarrier bar; bar.bar = (unsigned*)(F.ctl + CW_BAR); bar.x = 0; bar.st = nullptr;
    if (N_LAUNCHES != PER_PHASE) bar = xcd_barrier_post((unsigned*)(F.ctl + CW_BAR), F.MISC + 8);
#define GRID_BAR() do { if (N_LAUNCHES != PER_PHASE) xcd_barrier(bar); } while (0)
    const int lo = args.ph_lo, hi = args.ph_hi;
#ifndef MK_PHASE_MASK
#define MK_PHASE_MASK 0x7FF
#endif
#define IN(k) (((MK_PHASE_MASK >> (k)) & 1) && lo <= (k) && (k) < hi)
#undef MK_PHASE_MASK
#define MK_PHASE_MASK 0xFFFF
#define BOTH(k) (true)
#ifndef MK_REP_MASK
#define MK_REP_MASK 0
#endif
#ifndef MK_REP_N
#define MK_REP_N 2
#endif
#define REPS(k) for (int rep_ = 0; rep_ < ((((MK_REP_MASK) >> (k)) & 1) ? 1 + MK_REP_N : 1); ++rep_)
    const int gw = F.vcu * NWAVES + F.wave, NGW = F.G * NWAVES;
    if (IN(0)) { REPS(0) { p0_prologue(F); __syncthreads(); } if (BOTH(0)) GRID_BAR(); }
    if (IN(1)) {
        pg8::Gemm g{F.XN(), F.WIN(), M, NIN, D / 2}; pg8::StaticOrder S; S.init(M, NIN, F.G, (int)blockIdx.x, false);
        pg8::EpiZ8 E{F.Z(), NIN, LW, (const float*)(F.ws + WS_XS), (const float*)(F.ws + WS_WS1)};
        REPS(1) pg8::gemm_phase<pg8::EpiZ8, pg8::StaticOrder, true, true, true>(F.lds, g, S, E);
        if (BOTH(1)) GRID_BAR();
    }
    if (IN(2)) {
        REPS(12) { v4u xr[5]; int u = blockIdx.x; lru_prefetch(F, u, F.tid, xr); lru_conv(F, u, F.tid, xr); __syncthreads();
                   for (; u < BATCH * NCHUNK * 8; u += F.G) lru_fused_unit(F, u, u + F.G < BATCH * NCHUNK * 8 ? u + F.G : -1, xr); }
        asm volatile("" : "+v"(F.tid), "+v"(F.lane));
        REPS(13) for (int u = blockIdx.x; u < BATCH * NCHUNK; u += F.G) gmlp_unit(F, u);
        if (BOTH(2)) GRID_BAR();
    }
    if (IN(3)) {
        {
            int lane = F.lane; asm volatile("" : "+v"(lane));
            v4u ra[4], rb[4]; int t = M - 1 - gw;
            if (t >= 0) mixq_issue(F, t, lane, ra);
            for (; t >= 0; t -= 2 * NGW) {
                if (t - NGW >= 0) mixq_issue(F, t - NGW, lane, rb);
                mixq_finish(F, t, lane, ra);
                if (t - NGW >= 0) { if (t - 2 * NGW >= 0) mixq_issue(F, t - 2 * NGW, lane, ra); mixq_finish(F, t - NGW, lane, rb); }
            }
        }
        GRID_BAR();
    }
    if (IN(4)) {
        pg8::Gemm g{(const bf16*)(F.ws + WS_MIX8), F.WOUT(), M, D, D / 2}; pg8::StaticOrder S; S.init(M, D, F.G, (int)blockIdx.x, false);
        pg8::EpiH8 E{F.HB(), F.HBT(), F.A.in[0], F.ROWSS(), D, M, (const float*)(F.ws + WS_MIXS), (const float*)(F.ws + WS_WS2)};
        pg8::gemm_phase<pg8::EpiH8, pg8::StaticOrder, true, true, true>(F.lds, g, S, E);
        if (BOTH(4)) GRID_BAR();
    }
    if (IN(5)) {
        {
            int lane = F.lane; asm volatile("" : "+v"(lane));
            v4u ra[4], rb[4]; int t = M - 1 - gw;
            if (t >= 0) h8_issue(F, t, lane, ra);
            for (; t >= 0; t -= 2 * NGW) {
                if (t - NGW >= 0) h8_issue(F, t - NGW, lane, rb);
                h8_finish(F, t, lane, ra);
                if (t - NGW >= 0) { if (t - 2 * NGW >= 0) h8_issue(F, t - 2 * NGW, lane, ra); h8_finish(F, t - NGW, lane, rb); }
            }
        }
        GRID_BAR();
        pg8::Gemm g{(const bf16*)(F.ws + WS_HQ8), F.WQ(), M, D, D / 2}; pg8::StaticOrder S; S.init(M, D, F.G, (int)blockIdx.x, false);
        pg8::EpiQ8 E{F.QH(), F.ROWSS(), D, F.HSCALE(), (const float*)(F.ws + WS_WS3)};
        REPS(5) pg8::gemm_phase<pg8::EpiQ8, pg8::StaticOrder, true, true, true>(F.lds, g, S, E);
        if (BOTH(5)) GRID_BAR();
    }
    if (IN(6)) {
        {
            const int hd = F.vcu & 7;
            for (int i = F.tid; i < 2 * 128 * 16; i += NWAVES * 64) { const int row = i >> 4, cg = i & 15;
                *(LAS v4u*)(F.lds + P6_KEYS + row * P6_KROW + cg * 16) = *(const GAS v4u*)(F.KH() + ((size_t)hd * 256 + row) * 128 + cg * 8); }
            __syncthreads();
        }
        REPS(6) { int hk = 0;
                  const int ngrp = (F.G >> 3) * NWAVES;
                  for (int wu = (F.vcu >> 3) * NWAVES + F.wave; wu < M / 32; wu += ngrp) topk_unit(F, wu, false, 0, 0);
                  (void)hk; }
        if (BOTH(6)) GRID_BAR();
    }
    if (IN(7)) {
        REPS(7) peer_u_xcd(F);
        if (BOTH(7)) GRID_BAR();
    }
    if (IN(8)) {
        REPS(8) for (int t = gw; t < M; t += NGW) peer_act_token(F, t);
        if (BOTH(8)) GRID_BAR();
    }
    if (IN(9)) {
        for (int c = blockIdx.x; c < D / 8; c += F.G) peer_v_slice<0>(F, c, true);
        if ((MK_REP_MASK >> 9) & 1) { for (int rep_ = 0; rep_ < MK_REP_N; ++rep_) for (int c = blockIdx.x; c < D / 8; c += F.G) peer_v_slice<1>(F, c, false); }
        if (BOTH(9)) GRID_BAR();
    }
    if (IN(10)) {
        REPS(10) for (int u = blockIdx.x; u < (M / 64) * 8; u += F.G) final_unit(F, u);
    }
#undef IN
#undef BOTH
#undef GRID_BAR
}

extern "C" void kernel_launch(void* const* d_in, const int* in_sizes, int n_in, void* d_out, int out_size, void* d_ws, size_t ws_size, hipStream_t stream) {
    static int grid = 0;
    if (grid == 0) {
        if (n_in != 21 || in_sizes[0] != M * D || out_size != M * D || ws_size < WS_END) { fprintf(stderr, "kernel_launch: unexpected shapes (n_in %d, in0 %d, out %d, ws %zu)\n", n_in, n_in > 0 ? in_sizes[0] : -1, out_size, ws_size); grid = -1; return; }
        int dev = 0, cus = 0, per_cu = 0;
        if (hipGetDevice(&dev) != hipSuccess || hipDeviceGetAttribute(&cus, hipDeviceAttributeMultiprocessorCount, dev) != hipSuccess) { grid = -1; return; }
        if (hipOccupancyMaxActiveBlocksPerMultiprocessor(&per_cu, (const void*)mk_fwd, NWAVES * 64, 0) != hipSuccess || per_cu < 1) { fprintf(stderr, "kernel_launch: occupancy query reports %d blocks per CU\n", per_cu); }
        (void)hipGetLastError();
        grid = cus;
        if (cus < 256) { fprintf(stderr, "kernel_launch: the RG-LRU family hand-off needs >= 256 co-resident workgroups (have %d)\n", cus); grid = -1; return; }
    }
    if (grid < 0) return;
    (void)hipMemsetAsync((char*)d_ws + WS_CTL, 0, CTL_ZERO_BYTES, stream);
    Args a{};
    for (int i = 0; i < 21; ++i) a.in[i] = (const float*)d_in[i];
    a.out = (float*)d_out; a.ws = (unsigned char*)d_ws;
    for (int li = 0; li < N_LAUNCHES; ++li) {
        a.ph_lo = 0; a.ph_hi = 99;
        hipLaunchKernelGGL(mk_fwd, dim3(grid), dim3(NWAVES * 64), 0, stream, a);
    }
}
```
